# Optimizing an MI355X kernel written in HIP

```python
import jax, jax.numpy as jnp
from jax import lax
import numpy as np

D_MODEL = 1024
BATCH = 2
SEQ = 8192
DEPTH = 2

HEAD_DIM = 64
SB_HEADS = 8
SB_WIDTH = SB_HEADS * HEAD_DIM
SC_WIDTH = 512
SC_KERNEL = 3
DSA_HEADS = 8
DSA_WIDTH = DSA_HEADS * HEAD_DIM
IDX_HEADS = 8
IDX_DIM = 64
DSA_TOPK_MAX = 256
MEM_LEN = 256
XA_HEADS = 4
XA_HEAD_DIM = D_MODEL // XA_HEADS
D_FF = 2816
FFN_KERNEL = 3
Q_BLOCK = 128
N_BRANCH = 3
RMS_EPS = 1e-6
IN_SIZES = (3 * SB_WIDTH, 3 * SC_WIDTH, 3 * DSA_WIDTH, IDX_HEADS * IDX_DIM, IDX_DIM, IDX_HEADS, N_BRANCH * D_MODEL)
D_IN = sum(IN_SIZES)

kernel_name = "hybrid_stickbreak_shortconv_dsa_gated_block"

F32 = jnp.float32


def rmsnorm(x, g):
    xf = x.astype(F32)
    y = xf * lax.rsqrt(jnp.mean(xf * xf, axis=-1, keepdims=True) + RMS_EPS)
    return (y * g.astype(F32)).astype(x.dtype)


def causal_dwconv(u, w):
    K = w.shape[0]
    S = u.shape[1]
    up = jnp.pad(u, ((0, 0), (K - 1, 0), (0, 0)))
    return sum(w[k] * up[:, k:k + S] for k in range(K))


def to_blocks(a):
    B, S = a.shape[:2]
    return a.reshape((B, S // Q_BLOCK, Q_BLOCK) + a.shape[2:]).swapaxes(0, 1)


def from_blocks(a):
    a = a.swapaxes(0, 1)
    return a.reshape((a.shape[0], a.shape[1] * a.shape[2]) + a.shape[3:])


def stick_breaking_attention(q, k, v):
    B, S, H, Dh = q.shape
    nb = S // Q_BLOCK
    scale = Dh ** -0.5
    kf = k.astype(F32)
    vf = v.astype(F32)
    key_pos = jnp.arange(S)

    def block(args):
        qi, i = args
        z = jnp.einsum('bqhd,bshd->bhqs', qi.astype(F32), kf) * scale
        q_pos = i * Q_BLOCK + jnp.arange(Q_BLOCK)
        causal = key_pos[None, :] < q_pos[:, None]
        log_1m = jnp.where(causal, jax.nn.log_sigmoid(-z), 0.0)
        after = lax.cumsum(log_1m, axis=3, reverse=True) - log_1m
        w = jnp.where(causal, jnp.exp(jax.nn.log_sigmoid(z) + after), 0.0)
        return jnp.einsum('bhqs,bshd->bqhd', w, vf)

    out = lax.map(block, (to_blocks(q), jnp.arange(nb)))
    return from_blocks(out).astype(q.dtype)


def dsa_attention(q, k, v, q_idx, k_idx, w_idx):
    B, S, H, Dh = q.shape
    nb = S // Q_BLOCK
    top_k = min(DSA_TOPK_MAX, S // 4)
    kif = k_idx.astype(F32)
    key_pos = jnp.arange(S)

    def gather_rows(a, idx):
        return jax.vmap(lambda ab, ib: ab[ib])(a, idx)

    def block(args):
        qi, qii, wi, i = args
        q_pos = i * Q_BLOCK + jnp.arange(Q_BLOCK)
        idx_logits = jnp.einsum('bqhd,bsd->bqhs', qii.astype(F32), kif) * (IDX_DIM ** -0.5)
        score = jnp.einsum('bqh,bqhs->bqs', wi.astype(F32) * (IDX_HEADS ** -0.5), jax.nn.relu(idx_logits))
        admissible = key_pos[None, :] <= q_pos[:, None]
        score = jnp.where(admissible[None], score, -jnp.inf)
        _, sel = lax.top_k(score, top_k)
        valid = sel <= q_pos[None, :, None]
        flat = sel.reshape(B, Q_BLOCK * top_k)
        ks = gather_rows(k, flat).reshape(B, Q_BLOCK, top_k, H, Dh).astype(F32)
        vs = gather_rows(v, flat).reshape(B, Q_BLOCK, top_k, H, Dh).astype(F32)
        logits = jnp.einsum('bqhd,bqkhd->bhqk', qi.astype(F32), ks) * (Dh ** -0.5)
        logits = jnp.where(valid[:, None], logits, -jnp.inf)
        p = jax.nn.softmax(logits, axis=-1)
        return jnp.einsum('bhqk,bqkhd->bqhd', p, vs)

    out = lax.map(block, (to_blocks(q), to_blocks(q_idx), to_blocks(w_idx), jnp.arange(nb)))
    return from_blocks(out).astype(q.dtype)


def hybrid_mixer(h, w_in, sc_conv_w, w_sb_out, w_sc_out, w_dsa_out, w_mix_o):
    B, S, _ = h.shape
    z = h @ w_in
    sb_qkv, sc_bcx, dsa_qkv, idx_q, idx_k, idx_w, gates = jnp.split(z, list(np.cumsum(IN_SIZES)[:-1]), axis=-1)
    sb = sb_qkv.reshape(B, S, 3, SB_HEADS, HEAD_DIM)
    y_a = stick_breaking_attention(sb[:, :, 0], sb[:, :, 1], sb[:, :, 2]).reshape(B, S, SB_WIDTH)
    b_gate, c_gate, x_in = jnp.split(sc_bcx, 3, axis=-1)
    y_b = b_gate * causal_dwconv(c_gate * x_in, sc_conv_w)
    dq = dsa_qkv.reshape(B, S, 3, DSA_HEADS, HEAD_DIM)
    y_c = dsa_attention(dq[:, :, 0], dq[:, :, 1], dq[:, :, 2],
                        idx_q.reshape(B, S, IDX_HEADS, IDX_DIM), idx_k, idx_w).reshape(B, S, DSA_WIDTH)
    g = jax.nn.sigmoid(gates.reshape(B, S, N_BRANCH, D_MODEL).astype(F32)).astype(h.dtype)
    merged = g[:, :, 0] * (y_a @ w_sb_out) + g[:, :, 1] * (y_b @ w_sc_out) + g[:, :, 2] * (y_c @ w_dsa_out)
    return merged @ w_mix_o


def memory_cross_attention(h, mem_n, w_q, w_kv, w_o):
    B, S, _ = h.shape
    M = mem_n.shape[1]
    q = (h @ w_q).reshape(B, S, XA_HEADS, XA_HEAD_DIM).astype(F32)
    kv = (mem_n @ w_kv).reshape(B, M, 2, XA_HEADS, XA_HEAD_DIM).astype(F32)
    logits = jnp.einsum('bshd,bmhd->bhsm', q, kv[:, :, 0]) * (XA_HEAD_DIM ** -0.5)
    p = jax.nn.softmax(logits, axis=-1)
    o = jnp.einsum('bhsm,bmhd->bshd', p, kv[:, :, 1]).astype(h.dtype)
    return o.reshape(B, S, D_MODEL) @ w_o


def conv_ffn(h, w_in, conv_w, conv_b, w_down):
    a, u = jnp.split(h @ w_in, 2, axis=-1)
    a = causal_dwconv(a, conv_w) + conv_b
    return (jax.nn.gelu(a) * u) @ w_down


def setup_inputs(seed: int = 0) -> dict:
    key = jax.random.key(seed)
    ks = jax.random.split(key, 24)

    def nrm(k, shape, fan_in):
        return jax.random.normal(k, shape, F32) * (fan_in ** -0.5)

    def gain(k, shape):
        return 1.0 + 0.05 * jax.random.normal(k, shape, F32)

    L = DEPTH
    return {
        "x": jax.random.normal(ks[0], (BATCH, SEQ, D_MODEL), F32),
        "mem": jax.random.normal(ks[1], (BATCH, MEM_LEN, D_MODEL), F32),
        "norm_mix": gain(ks[2], (L, D_MODEL)),
        "w_in": nrm(ks[3], (L, D_MODEL, D_IN), D_MODEL),
        "sc_conv_w": nrm(ks[4], (L, SC_KERNEL, SC_WIDTH), SC_KERNEL),
        "w_sb_out": nrm(ks[5], (L, SB_WIDTH, D_MODEL), SB_WIDTH),
        "w_sc_out": nrm(ks[6], (L, SC_WIDTH, D_MODEL), SC_WIDTH),
        "w_dsa_out": nrm(ks[7], (L, DSA_WIDTH, D_MODEL), DSA_WIDTH),
        "w_mix_o": nrm(ks[8], (L, D_MODEL, D_MODEL), D_MODEL),
        "norm_xa": gain(ks[9], (L, D_MODEL)),
        "norm_mem": gain(ks[10], (L, D_MODEL)),
        "w_xa_q": nrm(ks[11], (L, D_MODEL, D_MODEL), D_MODEL),
        "w_xa_kv": nrm(ks[12], (L, D_MODEL, 2 * D_MODEL), D_MODEL),
        "w_xa_o": nrm(ks[13], (L, D_MODEL, D_MODEL), D_MODEL),
        "norm_ffn": gain(ks[14], (L, D_MODEL)),
        "w_ffn_in": nrm(ks[15], (L, D_MODEL, 2 * D_FF), D_MODEL),
        "ffn_conv_w": nrm(ks[16], (L, FFN_KERNEL, D_FF), FFN_KERNEL),
        "ffn_conv_b": 0.02 * jax.random.normal(ks[17], (L, D_FF), F32),
        "w_ffn_down": nrm(ks[18], (L, D_FF, D_MODEL), D_FF),
        "norm_final": gain(ks[19], (D_MODEL,)),
    }


def reference(x, mem, norm_mix, w_in, sc_conv_w, w_sb_out, w_sc_out, w_dsa_out, w_mix_o,
              norm_xa, norm_mem, w_xa_q, w_xa_kv, w_xa_o,
              norm_ffn, w_ffn_in, ffn_conv_w, ffn_conv_b, w_ffn_down, norm_final):
    for l in range(DEPTH):
        h = rmsnorm(x, norm_mix[l])
        x = x + hybrid_mixer(h, w_in[l], sc_conv_w[l], w_sb_out[l], w_sc_out[l], w_dsa_out[l], w_mix_o[l])
        h = rmsnorm(x, norm_xa[l])
        x = x + memory_cross_attention(h, rmsnorm(mem, norm_mem[l]), w_xa_q[l], w_xa_kv[l], w_xa_o[l])
        h = rmsnorm(x, norm_ffn[l])
        x = x + conv_ffn(h, w_ffn_in[l], ffn_conv_w[l], ffn_conv_b[l], w_ffn_down[l])
    return rmsnorm(x, norm_final)
```

```cpp
#include <hip/hip_runtime.h>
#include <stdint.h>
#include <stdio.h>

typedef unsigned short bf16_t;
typedef short bf16x8 __attribute__((ext_vector_type(8)));
typedef float f32x16 __attribute__((ext_vector_type(16)));
typedef float f32x4 __attribute__((ext_vector_type(4)));
#define DEV __device__ __forceinline__

constexpr int NB = 2, S = 8192, D = 1024, T = NB * S, DEPTH = 2;
constexpr int DIN = 8264, DFF = 2816, MEM = 256;
constexpr int NIN = 5376;
constexpr float LOG2E = 1.4426950408889634f;
constexpr float QSCALE = 0.125f * LOG2E;
constexpr float WSCALE = 0.125f * 0.35355339059327373f;
constexpr float XSCALE = 0.0625f * LOG2E;
constexpr float EPS = 1e-6f;

constexpr size_t MiB = 1u << 20;
constexpr size_t WS_GT = 1 * MiB;
constexpr size_t WS_HT = 9 * MiB;
constexpr size_t WS_WUP = 17 * MiB, WS_WDOWN = 28 * MiB;
constexpr size_t WS_XN = 34 * MiB;
constexpr size_t WS_WMIX = 66 * MiB, WS_WBR = 68 * MiB, WS_WG = 71 * MiB, WS_WIN = 77 * MiB;
constexpr size_t WS_QA = 88 * MiB, WS_SCB = 104 * MiB, WS_QC = 120 * MiB, WS_KA = 136 * MiB, WS_VA = 152 * MiB, WS_KC = 168 * MiB, WS_VC = 184 * MiB,
                 WS_IQ = 200 * MiB, WS_CX = 216 * MiB, WS_IK = 232 * MiB, WS_IW = 234 * MiB, WS_BM = 235 * MiB;
constexpr size_t WS_GATES = 136 * MiB;
constexpr size_t WS_XTMP = 235 * MiB;
constexpr size_t WS_LOG = 88 * MiB, WS_PXA = 152 * MiB;
constexpr size_t WS_FA = 66 * MiB, WS_FU = 154 * MiB;
constexpr size_t WS_WQ = 200 * MiB  , WS_WOT = 204 * MiB  , WS_WKVT = 208 * MiB  , WS_MEMN = 216 * MiB  , WS_KVM = 218 * MiB  ;
constexpr size_t WS_NEED = 256 * MiB;

DEV bf16_t f2bf(float f) { unsigned u = __float_as_uint(f); u += 0x7fffu + ((u >> 16) & 1u); return (bf16_t)(u >> 16); }
DEV float bf2f(bf16_t h) { return __uint_as_float(((unsigned)h) << 16); }
DEV float wave_sum(float v) {
#pragma unroll
    for (int o = 1; o < 64; o <<= 1) v += __shfl_xor(v, o);
    return v;
}
DEV float wave_max(float v) {
#pragma unroll
    for (int o = 1; o < 64; o <<= 1) v = fmaxf(v, __shfl_xor(v, o));
    return v;
}

__global__ void __launch_bounds__(256) k_tcvt(const float* __restrict__ W, int ldw, int K, int col0, int ncols, bf16_t* out, int ldo, int row0) {
    __shared__ float tile[32][33];
    const int kb = blockIdx.x * 32, nb = blockIdx.y * 32, tx = threadIdx.x & 31, ty = threadIdx.x >> 5;
    for (int i = ty; i < 32; i += 8) { const int k = kb + i, n = nb + tx; tile[i][tx] = (k < K && n < ncols) ? W[(size_t)k * ldw + col0 + n] : 0.f; }
    __syncthreads();
    for (int i = ty; i < 32; i += 8) { const int n = nb + i, k = kb + tx; if (n < ncols && k < K) out[(size_t)(row0 + n) * ldo + k] = f2bf(tile[tx][i]); }
}
__global__ void k_cvt(const float* __restrict__ in, bf16_t* out, size_t n) { for (size_t i = blockIdx.x * (size_t)blockDim.x + threadIdx.x; i < n; i += (size_t)gridDim.x * blockDim.x) out[i] = f2bf(in[i]); }
__global__ void k_zero16(bf16_t* out, size_t n) { for (size_t i = blockIdx.x * (size_t)blockDim.x + threadIdx.x; i < n; i += (size_t)gridDim.x * blockDim.x) out[i] = 0; }

__global__ void __launch_bounds__(256) k_rmsnorm(const float* x, const float* __restrict__ g, bf16_t* outb, float* outf, int rows) {
    const int row = blockIdx.x * 4 + (threadIdx.x >> 6), lane = threadIdx.x & 63;
    if (row >= rows) return;
    const f32x4* xr = (const f32x4*)(x + (size_t)row * D);
    f32x4 v[4]; float s = 0.f;
#pragma unroll
    for (int j = 0; j < 4; ++j) { v[j] = xr[lane + 64 * j]; s += v[j].x * v[j].x + v[j].y * v[j].y + v[j].z * v[j].z + v[j].w * v[j].w; }
    const float r = rsqrtf(wave_sum(s) * (1.f / D) + EPS);
#pragma unroll
    for (int j = 0; j < 4; ++j) {
        const f32x4 gg = ((const f32x4*)g)[lane + 64 * j];
        const f32x4 o = {v[j].x * r * gg.x, v[j].y * r * gg.y, v[j].z * r * gg.z, v[j].w * r * gg.w};
        if (outb) { bf16_t* p = outb + (size_t)row * D + (lane + 64 * j) * 4; p[0] = f2bf(o.x); p[1] = f2bf(o.y); p[2] = f2bf(o.z); p[3] = f2bf(o.w); }
        if (outf) ((f32x4*)(outf + (size_t)row * D))[lane + 64 * j] = o;
    }
}

template <class Epi> __global__ void __launch_bounds__(256) k_gemm(const bf16_t* __restrict__ A, int lda, const bf16_t* __restrict__ Bt, int ldb, int K, Epi e) {
    const int wid = threadIdx.x >> 6, lane = threadIdx.x & 63, r32 = lane & 31, hi = lane >> 5;
    const int m0 = blockIdx.y * 128 + (wid >> 1) * 64, n0 = blockIdx.x * 128 + (wid & 1) * 64;
    const bf16_t* ap = A + (size_t)(m0 + r32) * lda + 8 * hi;
    const bf16_t* bp = Bt + (size_t)(n0 + r32) * ldb + 8 * hi;
    f32x16 acc[2][2];
#pragma unroll
    for (int i = 0; i < 2; ++i)
#pragma unroll
        for (int j = 0; j < 2; ++j)
#pragma unroll
            for (int r = 0; r < 16; ++r) acc[i][j][r] = 0.f;
    for (int k = 0; k < K; k += 16) {
        const bf16x8 a0 = *(const bf16x8*)(ap + k), a1 = *(const bf16x8*)(ap + (size_t)32 * lda + k);
        const bf16x8 b0 = *(const bf16x8*)(bp + k), b1 = *(const bf16x8*)(bp + (size_t)32 * ldb + k);
        acc[0][0] = __builtin_amdgcn_mfma_f32_32x32x16_bf16(a0, b0, acc[0][0], 0, 0, 0);
        acc[0][1] = __builtin_amdgcn_mfma_f32_32x32x16_bf16(a0, b1, acc[0][1], 0, 0, 0);
        acc[1][0] = __builtin_amdgcn_mfma_f32_32x32x16_bf16(a1, b0, acc[1][0], 0, 0, 0);
        acc[1][1] = __builtin_amdgcn_mfma_f32_32x32x16_bf16(a1, b1, acc[1][1], 0, 0, 0);
    }
#pragma unroll
    for (int i = 0; i < 2; ++i)
#pragma unroll
        for (int j = 0; j < 2; ++j)
#pragma unroll
            for (int r = 0; r < 16; ++r) e(m0 + 32 * i + (r & 3) + 8 * (r >> 2) + 4 * hi, n0 + 32 * j + r32, acc[i][j][r]);
}

struct EpiInProj {
    bf16_t *qa, *ka, *va, *qc, *kc, *vc, *iq, *scb, *cpart, *xpart, *ik; float* iw;
    DEV void operator()(int t, int n, float v) const {
        const size_t r = (size_t)t * 512;
        if (n < 512) qa[r + n] = f2bf(v * QSCALE);
        else if (n < 1024) ka[r + n - 512] = f2bf(v);
        else if (n < 1536) va[r + n - 1024] = f2bf(v);
        else if (n < 2048) qc[r + n - 1536] = f2bf(v * QSCALE);
        else if (n < 2560) kc[r + n - 2048] = f2bf(v);
        else if (n < 3072) vc[r + n - 2560] = f2bf(v);
        else if (n < 3584) iq[r + n - 3072] = f2bf(v);
        else if (n < 4096) scb[r + n - 3584] = f2bf(v);
        else if (n < 5120) { const int j = (n - 4096) >> 8, w = (n - 4096) & 255; if (w < 128) cpart[r + 128 * j + w] = f2bf(v); else xpart[r + 128 * j + w - 128] = f2bf(v); }
        else { const int w = n - 5120; if (w < 64) ik[(size_t)t * 64 + w] = f2bf(v); else if (w < 72) iw[(size_t)t * 8 + w - 64] = v * WSCALE; }
    }
};
struct EpiGates { bf16_t* g; DEV void operator()(int t, int n, float v) const { g[(size_t)(n >> 10) * T * D + (size_t)t * D + (n & 1023)] = f2bf(1.f / (1.f + __expf(-v))); } };
struct EpiMerge { bf16_t* merged; const bf16_t* gate; int first, pad; DEV void operator()(int t, int n, float v) const {
    const size_t o = (size_t)t * D + n; const float p = bf2f(gate[o]) * v; merged[o] = f2bf(first ? p : bf2f(merged[o]) + p); } };
struct EpiResid { const float* xin; float* xout; int row0, pad; DEV void operator()(int t, int n, float v) const { const size_t o = (size_t)(t + row0) * D + n; xout[o] = xin[o] + v; } };
struct EpiF32 { float* out; int ldc, row0; DEV void operator()(int t, int n, float v) const { out[(size_t)(t + row0) * ldc + n] = v; } };
struct EpiBf { bf16_t* out; int ldc; float scale; DEV void operator()(int t, int n, float v) const { out[(size_t)t * ldc + n] = f2bf(v * scale); } };
struct EpiUp { bf16_t *fa, *fu; DEV void operator()(int t, int n, float v) const { const int j = n >> 8, w = n & 255; if (w < 128) fa[(size_t)t * DFF + 128 * j + w] = f2bf(v); else fu[(size_t)t * DFF + 128 * j + w - 128] = f2bf(v); } };

__global__ void __launch_bounds__(256) k_sb_naive(const bf16_t* Q, const bf16_t* __restrict__ Kk, const bf16_t* __restrict__ V, bf16_t* O) {
    __shared__ float wsh[4][64], qsh[4][64];
    const int wid = threadIdx.x >> 6, lane = threadIdx.x & 63;
    const int gid = blockIdx.x * 4 + wid;
    const int t = gid % S, h = (gid / S) & 7, b = gid / (S * 8);
    const size_t rowb = (size_t)b * S;
    qsh[wid][lane] = bf2f(Q[(rowb + t) * 512 + h * 64 + lane]);
    __syncthreads();
    float o = 0.f, carry = 1.f;
    for (int c = (t - 1) >> 6; c >= 0 && t > 0; --c) {
        const int s = 64 * c + lane; const bool valid = s < t;
        const bf16_t* kr = Kk + (rowb + s) * 512 + h * 64;
        float z = 0.f;
#pragma unroll
        for (int d8 = 0; d8 < 8; ++d8) { const bf16x8 kv = *(const bf16x8*)(kr + 8 * d8);
#pragma unroll
            for (int j = 0; j < 8; ++j) z += qsh[wid][8 * d8 + j] * bf2f((bf16_t)kv[j]); }
        const float e = exp2f(fminf(z, 126.f));
        const float u = valid ? 1.f / (1.f + e) : 1.f, sg = valid ? 1.f - u : 0.f;
        float p = u;
#pragma unroll
        for (int off = 1; off < 64; off <<= 1) { const float tmp = __shfl_down(p, off); if (lane + off < 64) p *= tmp; }
        float ex = __shfl_down(p, 1); if (lane == 63) ex = 1.f;
        wsh[wid][lane] = sg * ex * carry;
        carry *= __shfl(p, 0);
        __builtin_amdgcn_s_waitcnt(0xc07f); __builtin_amdgcn_wave_barrier();
        const bf16_t* vr = V + (rowb + 64 * c) * 512 + h * 64 + lane;
#pragma unroll 8
        for (int j = 0; j < 64; ++j) o += wsh[wid][j] * bf2f(vr[(size_t)j * 512]);
        __builtin_amdgcn_wave_barrier();
    }
    O[(rowb + t) * 512 + h * 64 + lane] = f2bf(o);
}

__global__ void k_conv_sc(bf16_t* scb, const bf16_t* __restrict__ cp, const bf16_t* __restrict__ xp, const float* __restrict__ w) {
    const size_t i = blockIdx.x * (size_t)blockDim.x + threadIdx.x; if (i >= (size_t)T * 512) return;
    const int c = i & 511; const int t = (int)(i >> 9), tl = t % S;
    float acc = 0.f;
#pragma unroll
    for (int k = 0; k < 3; ++k) { const int tt = tl - 2 + k; if (tt >= 0) { const size_t o = (size_t)(t - 2 + k) * 512 + c; acc += w[k * 512 + c] * (bf2f(cp[o]) * bf2f(xp[o])); } }
    scb[i] = f2bf(bf2f(scb[i]) * acc);
}

DEV unsigned fkey(float v) { v += 0.f; const unsigned u = __float_as_uint(v); return (u & 0x80000000u) ? ~u : (u | 0x80000000u); }
__global__ void __launch_bounds__(256) k_index_naive(const bf16_t* __restrict__ IQ, const bf16_t* __restrict__ IK, const float* __restrict__ IW, unsigned* BM) {
    __shared__ float qi[512]; __shared__ float wq[8]; __shared__ unsigned cnt; __shared__ unsigned pre[257]; __shared__ unsigned keys[8192];
    const int t = blockIdx.x % S, b = blockIdx.x / S, j = threadIdx.x;
    const size_t row = (size_t)b * S + t;
    qi[j] = bf2f(IQ[row * 512 + j]); qi[j + 256] = bf2f(IQ[row * 512 + j + 256]);
    if (j < 8) wq[j] = IW[row * 8 + j];
    __syncthreads();
    const int n = t + 1;
    for (int s = j; s < 8192; s += 256) {
        unsigned kk = 0u;
        if (s <= t) {
            const bf16_t* kr = IK + ((size_t)b * S + s) * 64;
            float kf[64];
#pragma unroll
            for (int d8 = 0; d8 < 8; ++d8) { const bf16x8 kv = *(const bf16x8*)(kr + 8 * d8);
#pragma unroll
                for (int q = 0; q < 8; ++q) kf[8 * d8 + q] = bf2f((bf16_t)kv[q]); }
            float sc = 0.f;
#pragma unroll
            for (int h = 0; h < 8; ++h) { float dd = 0.f;
#pragma unroll
                for (int d = 0; d < 64; ++d) dd += qi[h * 64 + d] * kf[d];
                sc += wq[h] * fmaxf(dd, 0.f); }
            kk = fkey(sc);
        }
        keys[s] = kk;
    }
    __syncthreads();
    unsigned word = 0u;
    if (n <= 256) {
        for (int i = 0; i < 32; ++i) if (32 * j + i <= t) word |= 1u << i;
    } else {
        unsigned X = 0u;
        for (int bit = 31; bit >= 0; --bit) {
            const unsigned cand = X | (1u << bit);
            unsigned c = 0;
            for (int i = 0; i < 32; ++i) c += keys[32 * j + ((i + j) & 31)] >= cand;
            if (j == 0) cnt = 0; __syncthreads(); atomicAdd(&cnt, c); __syncthreads();
            if (cnt >= 256u) X = cand;
            __syncthreads();
        }
        unsigned cg = 0, ce = 0;
        for (int i = 0; i < 32; ++i) { const unsigned k = keys[32 * j + ((i + j) & 31)]; cg += k > X; ce += k == X; }
        if (j == 0) cnt = 0; __syncthreads(); atomicAdd(&cnt, cg); pre[j + 1] = ce; __syncthreads();
        const unsigned m = 256u - cnt;
        if (j == 0) { pre[0] = 0; for (int q = 1; q <= 256; ++q) pre[q] += pre[q - 1]; }
        __syncthreads();
        unsigned rank = pre[j];
        for (int i = 0; i < 32; ++i) { const unsigned k = keys[32 * j + i]; if (k > X) word |= 1u << i; else if (k == X) { if (rank < m) word |= 1u << i; ++rank; } }
    }
    BM[((size_t)b * 256 + j) * S + t] = word;
}

__global__ void __launch_bounds__(512) k_dsa_naive(const bf16_t* Q, const bf16_t* __restrict__ Kk, const bf16_t* __restrict__ V, const unsigned* __restrict__ BM, bf16_t* O) {
    __shared__ int sel[256]; __shared__ unsigned pre[257]; __shared__ float qs[512]; __shared__ float ps[8][256];
    const int t = blockIdx.x % S, b = blockIdx.x / S, tid = threadIdx.x, h = tid >> 6, lane = tid & 63;
    const size_t rowb = (size_t)b * S;
    qs[tid] = bf2f(Q[(rowb + t) * 512 + tid]);
    unsigned word = 0;
    if (tid < 256) { word = (32 * tid <= t) ? BM[((size_t)b * 256 + tid) * S + t] : 0u; pre[tid + 1] = __popc(word); }
    __syncthreads();
    if (tid == 0) { pre[0] = 0; for (int q = 1; q <= 256; ++q) pre[q] += pre[q - 1]; }
    __syncthreads();
    if (tid < 256) { unsigned r = pre[tid]; for (int i = 0; i < 32; ++i) if (word >> i & 1u) { if (r < 256) sel[r] = 32 * tid + i; ++r; } }
    __syncthreads();
    const int nsel = min((int)pre[256], 256);
    float lg[4]; float mx = -INFINITY;
#pragma unroll
    for (int c = 0; c < 4; ++c) {
        const int i = 64 * c + lane; float z = -INFINITY;
        if (i < nsel) { const bf16_t* kr = Kk + (rowb + sel[i]) * 512 + h * 64; z = 0.f;
#pragma unroll
            for (int d8 = 0; d8 < 8; ++d8) { const bf16x8 kv = *(const bf16x8*)(kr + 8 * d8);
#pragma unroll
                for (int q = 0; q < 8; ++q) z += qs[h * 64 + 8 * d8 + q] * bf2f((bf16_t)kv[q]); } }
        lg[c] = z; mx = fmaxf(mx, z);
    }
    mx = wave_max(mx);
    float sum = 0.f;
#pragma unroll
    for (int c = 0; c < 4; ++c) { const float p = (64 * c + lane < nsel) ? exp2f(lg[c] - mx) : 0.f; ps[h][64 * c + lane] = p; sum += p; }
    sum = wave_sum(sum);
    __syncthreads();
    float o = 0.f;
    for (int i = 0; i < nsel; ++i) o += ps[h][i] * bf2f(V[(rowb + sel[i]) * 512 + h * 64 + lane]);
    O[(rowb + t) * 512 + tid] = f2bf(o / sum);
}

__global__ void __launch_bounds__(256) k_softmax256(const float* __restrict__ lg, bf16_t* P) {
    const size_t w = blockIdx.x * 4 + (threadIdx.x >> 6); const int lane = threadIdx.x & 63;
    const f32x4 v = ((const f32x4*)(lg + w * 256))[lane];
    const float mx = wave_max(fmaxf(fmaxf(v.x, v.y), fmaxf(v.z, v.w)));
    const float e0 = exp2f(v.x - mx), e1 = exp2f(v.y - mx), e2 = exp2f(v.z - mx), e3 = exp2f(v.w - mx);
    const float r = 1.f / wave_sum(e0 + e1 + e2 + e3);
    bf16_t* p = P + w * 256 + lane * 4; p[0] = f2bf(e0 * r); p[1] = f2bf(e1 * r); p[2] = f2bf(e2 * r); p[3] = f2bf(e3 * r);
}

__global__ void k_ffn_mid(const bf16_t* __restrict__ fa, bf16_t* fu, const float* __restrict__ cw, const float* __restrict__ cb) {
    const size_t i = blockIdx.x * (size_t)blockDim.x + threadIdx.x; if (i >= (size_t)T * DFF) return;
    const int c = (int)(i % DFF); const int t = (int)(i / DFF), tl = t % S;
    float a = cb[c];
#pragma unroll
    for (int k = 0; k < 3; ++k) { const int tt = tl - 2 + k; if (tt >= 0) a += cw[k * DFF + c] * bf2f(fa[(size_t)(t - 2 + k) * DFF + c]); }
    const float g = a / (1.f + __expf(-1.5957691216057308f * (a + 0.044715f * a * a * a)));
    fu[i] = f2bf(g * bf2f(fu[i]));
}

template <class Epi> static void gemm(hipStream_t st, const bf16_t* A, int lda, const bf16_t* Bt, int ldb, int M, int N, int K, Epi e) {
    hipLaunchKernelGGL((k_gemm<Epi>), dim3(N / 128, M / 128), dim3(256), 0, st, A, lda, Bt, ldb, K, e);
}
static void tcvt(hipStream_t st, const float* W, int ldw, int K, int col0, int ncols, bf16_t* out, int ldo, int row0) {
    hipLaunchKernelGGL(k_tcvt, dim3((K + 31) / 32, (ncols + 31) / 32), dim3(256), 0, st, W, ldw, K, col0, ncols, out, ldo, row0);
}

extern "C" void kernel_launch(void* const* d_in, const int* in_sizes, int n_in, void* d_out, int out_size, void* d_ws, size_t ws_size, hipStream_t st) {
    if (n_in != 20 || ws_size < WS_NEED || out_size != T * D) { fprintf(stderr, "kernel_launch: unexpected sizes n_in %d ws %zu out %d\n", n_in, ws_size, out_size); return; }
    const float* x = (const float*)d_in[0]; const float* mem = (const float*)d_in[1];
    const float* norm_mix = (const float*)d_in[2]; const float* w_in = (const float*)d_in[3]; const float* sc_conv_w = (const float*)d_in[4];
    const float* w_sb_out = (const float*)d_in[5]; const float* w_sc_out = (const float*)d_in[6]; const float* w_dsa_out = (const float*)d_in[7];
    const float* w_mix_o = (const float*)d_in[8]; const float* norm_xa = (const float*)d_in[9]; const float* norm_mem = (const float*)d_in[10];
    const float* w_xa_q = (const float*)d_in[11]; const float* w_xa_kv = (const float*)d_in[12]; const float* w_xa_o = (const float*)d_in[13];
    const float* norm_ffn = (const float*)d_in[14]; const float* w_ffn_in = (const float*)d_in[15]; const float* ffn_conv_w = (const float*)d_in[16];
    const float* ffn_conv_b = (const float*)d_in[17]; const float* w_ffn_down = (const float*)d_in[18]; const float* norm_final = (const float*)d_in[19];
    char* ws = (char*)d_ws; float* X = (float*)d_out;
#define BP(off) ((bf16_t*)(ws + (off)))
    bf16_t *XN = BP(WS_XN), *MERGED = BP(WS_XN), *WUP = BP(WS_WUP), *WDOWN = BP(WS_WDOWN), *WMIX = BP(WS_WMIX), *WBR = BP(WS_WBR), *WG = BP(WS_WG), *WIN = BP(WS_WIN);
    bf16_t *QA = BP(WS_QA), *SCB = BP(WS_SCB), *QC = BP(WS_QC), *KA = BP(WS_KA), *VA = BP(WS_VA), *KC = BP(WS_KC), *VC = BP(WS_VC), *IQ = BP(WS_IQ), *CX = BP(WS_CX), *IK = BP(WS_IK);
    float* IW = (float*)(ws + WS_IW); unsigned* BMK = (unsigned*)(ws + WS_BM); bf16_t* XTMP = BP(WS_XTMP); bf16_t* GATES = BP(WS_GATES);
    float* LOG = (float*)(ws + WS_LOG); bf16_t* PXA = BP(WS_PXA); bf16_t *FA = BP(WS_FA), *FU = BP(WS_FU);

    for (int l = 0; l < DEPTH; ++l) {
        bf16_t* WQ = BP(WS_WQ + l * 2 * MiB); bf16_t* WOT = BP(WS_WOT + l * 2 * MiB); bf16_t* WKVT = BP(WS_WKVT + l * 4 * MiB);
        bf16_t* MEMN = BP(WS_MEMN + l * 1 * MiB); bf16_t* KVM = BP(WS_KVM + l * 2 * MiB);
        hipLaunchKernelGGL(k_cvt, dim3(1024), dim3(256), 0, st, w_xa_q + (size_t)l * D * D, WQ, (size_t)D * D);
        tcvt(st, w_xa_o + (size_t)l * D * D, D, D, 0, D, WOT, D, 0);
        tcvt(st, w_xa_kv + (size_t)l * D * 2 * D, 2 * D, D, 0, 2 * D, WKVT, D, 0);
        hipLaunchKernelGGL(k_rmsnorm, dim3(NB * MEM / 4), dim3(256), 0, st, mem, norm_mem + l * D, MEMN, (float*)nullptr, NB * MEM);
        gemm(st, MEMN, D, WKVT, D, NB * MEM, 2 * D, D, EpiBf{KVM, 2 * D, 1.f});
        for (int b = 0; b < NB; ++b) for (int h = 0; h < 4; ++h) {
            bf16_t* GT = BP(WS_GT + (size_t)(l * 2 + b) * 2 * MiB); bf16_t* HT = BP(WS_HT + (size_t)(l * 2 + b) * 2 * MiB);
            gemm(st, KVM + (size_t)b * MEM * 2 * D + h * 256, 2 * D, WQ + h * 256, D, 256, D, 256, EpiBf{GT + (size_t)h * 256 * D, D, XSCALE});
            gemm(st, WOT + h * 256, D, KVM + (size_t)b * MEM * 2 * D + D + h * 256, 2 * D, D, 256, 256, EpiBf{HT + h * 256, D, 1.f});
        }
    }
    for (int l = 0; l < DEPTH; ++l) {
        const float* Xin = l == 0 ? x : X;
        const float* wi = w_in + (size_t)l * D * DIN;
        tcvt(st, wi, DIN, D, 0, 1536, WIN, D, 0);
        tcvt(st, wi, DIN, D, 3072, 1536, WIN, D, 1536);
        tcvt(st, wi, DIN, D, 4608, 512, WIN, D, 3072);
        tcvt(st, wi, DIN, D, 1536, 512, WIN, D, 3584);
        for (int j = 0; j < 4; ++j) { tcvt(st, wi, DIN, D, 2048 + 128 * j, 128, WIN, D, 4096 + 256 * j); tcvt(st, wi, DIN, D, 2560 + 128 * j, 128, WIN, D, 4096 + 256 * j + 128); }
        tcvt(st, wi, DIN, D, 5120, 72, WIN, D, 5120);
        hipLaunchKernelGGL(k_zero16, dim3(256), dim3(256), 0, st, WIN + (size_t)5192 * D, (size_t)184 * D);
        tcvt(st, wi, DIN, D, 5192, 3072, WG, D, 0);
        tcvt(st, w_sb_out + (size_t)l * 512 * D, D, 512, 0, D, WBR, 512, 0);
        tcvt(st, w_sc_out + (size_t)l * 512 * D, D, 512, 0, D, WBR + (size_t)D * 512, 512, 0);
        tcvt(st, w_dsa_out + (size_t)l * 512 * D, D, 512, 0, D, WBR + (size_t)2 * D * 512, 512, 0);
        tcvt(st, w_mix_o + (size_t)l * D * D, D, D, 0, D, WMIX, D, 0);
        const float* wf = w_ffn_in + (size_t)l * D * 2 * DFF;
        for (int j = 0; j < 22; ++j) { tcvt(st, wf, 2 * DFF, D, 128 * j, 128, WUP, D, 256 * j); tcvt(st, wf, 2 * DFF, D, DFF + 128 * j, 128, WUP, D, 256 * j + 128); }
        tcvt(st, w_ffn_down + (size_t)l * DFF * D, D, DFF, 0, D, WDOWN, DFF, 0);
        hipLaunchKernelGGL(k_rmsnorm, dim3(T / 4), dim3(256), 0, st, Xin, norm_mix + l * D, XN, (float*)nullptr, T);
        gemm(st, XN, D, WIN, D, T, NIN, D, EpiInProj{QA, KA, VA, QC, KC, VC, IQ, SCB, CX, XTMP, IK, IW});
        hipLaunchKernelGGL(k_conv_sc, dim3(T * 512 / 256), dim3(256), 0, st, SCB, CX, XTMP, sc_conv_w + l * 3 * 512);
        hipLaunchKernelGGL(k_sb_naive, dim3(T * 8 / 4), dim3(256), 0, st, QA, KA, VA, QA);
        hipLaunchKernelGGL(k_index_naive, dim3(T), dim3(256), 0, st, IQ, IK, IW, BMK);
        hipLaunchKernelGGL(k_dsa_naive, dim3(T), dim3(512), 0, st, QC, KC, VC, BMK, QC);
        gemm(st, XN, D, WG, D, T, 3 * D, D, EpiGates{GATES});
        gemm(st, QA, 512, WBR, 512, T, D, 512, EpiMerge{MERGED, GATES, 1, 0});
        gemm(st, SCB, 512, WBR + (size_t)D * 512, 512, T, D, 512, EpiMerge{MERGED, GATES + (size_t)T * D, 0, 0});
        gemm(st, QC, 512, WBR + (size_t)2 * D * 512, 512, T, D, 512, EpiMerge{MERGED, GATES + (size_t)2 * T * D, 0, 0});
        gemm(st, MERGED, D, WMIX, D, T, D, D, EpiResid{Xin, X, 0, 0});
        hipLaunchKernelGGL(k_rmsnorm, dim3(T / 4), dim3(256), 0, st, X, norm_xa + l * D, XN, (float*)nullptr, T);
        for (int b = 0; b < NB; ++b) gemm(st, XN + (size_t)b * S * D, D, BP(WS_GT + (size_t)(l * 2 + b) * 2 * MiB), D, S, D, D, EpiF32{LOG, D, b * S});
        hipLaunchKernelGGL(k_softmax256, dim3(T * 4 / 4), dim3(256), 0, st, LOG, PXA);
        for (int b = 0; b < NB; ++b) gemm(st, PXA + (size_t)b * S * D, D, BP(WS_HT + (size_t)(l * 2 + b) * 2 * MiB), D, S, D, D, EpiResid{X, X, b * S, 0});
        hipLaunchKernelGGL(k_rmsnorm, dim3(T / 4), dim3(256), 0, st, X, norm_ffn + l * D, XN, (float*)nullptr, T);
        gemm(st, XN, D, WUP, D, T, 2 * DFF, D, EpiUp{FA, FU});
        hipLaunchKernelGGL(k_ffn_mid, dim3((unsigned)(((size_t)T * DFF + 255) / 256)), dim3(256), 0, st, FA, FU, ffn_conv_w + l * 3 * DFF, ffn_conv_b + l * DFF);
        gemm(st, FU, DFF, WDOWN, DFF, T, D, DFF, EpiResid{X, X, 0, 0});
    }
    hipLaunchKernelGGL(k_rmsnorm, dim3(T / 4), dim3(256), 0, st, X, norm_final, (bf16_t*)nullptr, X, T);
}
```

```cpp
#include <hip/hip_runtime.h>
#include <stdint.h>
#include <stdio.h>

typedef unsigned short bf16_t;
typedef short bf16x8 __attribute__((ext_vector_type(8)));
typedef float f32x16 __attribute__((ext_vector_type(16)));
typedef float f32x4 __attribute__((ext_vector_type(4)));
#define DEV __device__ __forceinline__

constexpr int NB = 2, S = 8192, D = 1024, T = NB * S, DEPTH = 2;
constexpr int DIN = 8264, DFF = 2816, MEM = 256;
constexpr int NIN = 5376;
constexpr float LOG2E = 1.4426950408889634f;
constexpr float QSCALE = 0.125f * LOG2E;
constexpr float WSCALE = 0.125f * 0.35355339059327373f;
constexpr float XSCALE = 0.0625f * LOG2E;
constexpr float EPS = 1e-6f;
#ifndef MK_FUSE
#define MK_FUSE 1
#endif

constexpr size_t MiB = 1u << 20;
constexpr size_t WS_GT = 1 * MiB;
constexpr size_t WS_HT = 9 * MiB;
constexpr size_t WS_WUP = 17 * MiB, WS_WDOWN = 28 * MiB;
constexpr size_t WS_XN = 34 * MiB;
constexpr size_t WS_WMIX = 66 * MiB, WS_WBR = 68 * MiB, WS_WG = 71 * MiB, WS_WIN = 77 * MiB;
constexpr size_t WS_QA = 88 * MiB, WS_SCB = 104 * MiB, WS_QC = 120 * MiB, WS_KA = 136 * MiB, WS_VA = 152 * MiB, WS_KC = 168 * MiB, WS_VC = 184 * MiB,
                 WS_IQ = 200 * MiB, WS_CX = 216 * MiB, WS_IK = 232 * MiB, WS_IW = 234 * MiB, WS_BM = 235 * MiB;
constexpr size_t WS_GATES = 136 * MiB;
constexpr size_t WS_XTMP = 235 * MiB;
constexpr size_t WS_LOG = 88 * MiB, WS_PXA = 152 * MiB;
constexpr size_t WS_FA = 66 * MiB, WS_FU = 154 * MiB;
constexpr size_t WS_WQ = 200 * MiB  , WS_WOT = 204 * MiB  , WS_WKVT = 208 * MiB  , WS_MEMN = 216 * MiB  , WS_KVM = 218 * MiB  ;
constexpr size_t WS_NEED = 256 * MiB;

DEV bf16_t f2bf(float f) { unsigned u = __float_as_uint(f); u += 0x7fffu + ((u >> 16) & 1u); return (bf16_t)(u >> 16); }
DEV float bf2f(bf16_t h) { return __uint_as_float(((unsigned)h) << 16); }
DEV float wave_sum(float v) {
#pragma unroll
    for (int o = 1; o < 64; o <<= 1) v += __shfl_xor(v, o);
    return v;
}
DEV float wave_max(float v) {
#pragma unroll
    for (int o = 1; o < 64; o <<= 1) v = fmaxf(v, __shfl_xor(v, o));
    return v;
}

__global__ void __launch_bounds__(256) k_tcvt(const float* __restrict__ W, int ldw, int K, int col0, int ncols, bf16_t* out, int ldo, int row0) {
    __shared__ float tile[32][33];
    const int kb = blockIdx.x * 32, nb = blockIdx.y * 32, tx = threadIdx.x & 31, ty = threadIdx.x >> 5;
    for (int i = ty; i < 32; i += 8) { const int k = kb + i, n = nb + tx; tile[i][tx] = (k < K && n < ncols) ? W[(size_t)k * ldw + col0 + n] : 0.f; }
    __syncthreads();
    for (int i = ty; i < 32; i += 8) { const int n = nb + i, k = kb + tx; if (n < ncols && k < K) out[(size_t)(row0 + n) * ldo + k] = f2bf(tile[tx][i]); }
}
__global__ void k_cvt(const float* __restrict__ in, bf16_t* out, size_t n) { for (size_t i = blockIdx.x * (size_t)blockDim.x + threadIdx.x; i < n; i += (size_t)gridDim.x * blockDim.x) out[i] = f2bf(in[i]); }
__global__ void k_zero16(bf16_t* out, size_t n) { for (size_t i = blockIdx.x * (size_t)blockDim.x + threadIdx.x; i < n; i += (size_t)gridDim.x * blockDim.x) out[i] = 0; }

__global__ void __launch_bounds__(256) k_rmsnorm(const float* x, const float* __restrict__ g, bf16_t* outb, float* outf, int rows) {
    const int row = blockIdx.x * 4 + (threadIdx.x >> 6), lane = threadIdx.x & 63;
    if (row >= rows) return;
    const f32x4* xr = (const f32x4*)(x + (size_t)row * D);
    f32x4 v[4]; float s = 0.f;
#pragma unroll
    for (int j = 0; j < 4; ++j) { v[j] = xr[lane + 64 * j]; s += v[j].x * v[j].x + v[j].y * v[j].y + v[j].z * v[j].z + v[j].w * v[j].w; }
    const float r = rsqrtf(wave_sum(s) * (1.f / D) + EPS);
#pragma unroll
    for (int j = 0; j < 4; ++j) {
        const f32x4 gg = ((const f32x4*)g)[lane + 64 * j];
        const f32x4 o = {v[j].x * r * gg.x, v[j].y * r * gg.y, v[j].z * r * gg.z, v[j].w * r * gg.w};
        if (outb) { bf16_t* p = outb + (size_t)row * D + (lane + 64 * j) * 4; p[0] = f2bf(o.x); p[1] = f2bf(o.y); p[2] = f2bf(o.z); p[3] = f2bf(o.w); }
        if (outf) ((f32x4*)(outf + (size_t)row * D))[lane + 64 * j] = o;
    }
}

template <class Epi> __global__ void __launch_bounds__(256) k_gemm(const bf16_t* __restrict__ A, int lda, const bf16_t* __restrict__ Bt, int ldb, int K, Epi e) {
    const int wid = threadIdx.x >> 6, lane = threadIdx.x & 63, r32 = lane & 31, hi = lane >> 5;
    const int m0 = blockIdx.y * 128 + (wid >> 1) * 64, n0 = blockIdx.x * 128 + (wid & 1) * 64;
    const bf16_t* ap = A + (size_t)(m0 + r32) * lda + 8 * hi;
    const bf16_t* bp = Bt + (size_t)(n0 + r32) * ldb + 8 * hi;
    f32x16 acc[2][2];
#pragma unroll
    for (int i = 0; i < 2; ++i)
#pragma unroll
        for (int j = 0; j < 2; ++j)
#pragma unroll
            for (int r = 0; r < 16; ++r) acc[i][j][r] = 0.f;
    for (int k = 0; k < K; k += 16) {
        const bf16x8 a0 = *(const bf16x8*)(ap + k), a1 = *(const bf16x8*)(ap + (size_t)32 * lda + k);
        const bf16x8 b0 = *(const bf16x8*)(bp + k), b1 = *(const bf16x8*)(bp + (size_t)32 * ldb + k);
        acc[0][0] = __builtin_amdgcn_mfma_f32_32x32x16_bf16(a0, b0, acc[0][0], 0, 0, 0);
        acc[0][1] = __builtin_amdgcn_mfma_f32_32x32x16_bf16(a0, b1, acc[0][1], 0, 0, 0);
        acc[1][0] = __builtin_amdgcn_mfma_f32_32x32x16_bf16(a1, b0, acc[1][0], 0, 0, 0);
        acc[1][1] = __builtin_amdgcn_mfma_f32_32x32x16_bf16(a1, b1, acc[1][1], 0, 0, 0);
    }
#pragma unroll
    for (int i = 0; i < 2; ++i)
#pragma unroll
        for (int j = 0; j < 2; ++j)
#pragma unroll
            for (int r = 0; r < 16; ++r) e(m0 + 32 * i + (r & 3) + 8 * (r >> 2) + 4 * hi, n0 + 32 * j + r32, acc[i][j][r]);
}

struct EpiInProjN {
    bf16_t *qa, *ka, *va, *qc, *kc, *vc, *iq, *scb, *cpart, *xpart, *ik; float* iw;
    DEV void operator()(int t, int n, float v) const {
        const size_t r = (size_t)t * 512;
        if (n < 512) qa[r + n] = f2bf(v * QSCALE);
        else if (n < 1024) ka[r + n - 512] = f2bf(v);
        else if (n < 1536) va[r + n - 1024] = f2bf(v);
        else if (n < 2048) qc[r + n - 1536] = f2bf(v * QSCALE);
        else if (n < 2560) kc[r + n - 2048] = f2bf(v);
        else if (n < 3072) vc[r + n - 2560] = f2bf(v);
        else if (n < 3584) iq[r + n - 3072] = f2bf(v);
        else if (n < 4096) scb[r + n - 3584] = f2bf(v);
        else if (n < 5120) { const int j = (n - 4096) >> 8, w = (n - 4096) & 255; if (w < 128) cpart[r + 128 * j + w] = f2bf(v); else xpart[r + 128 * j + w - 128] = f2bf(v); }
        else { const int w = n - 5120; if (w < 64) ik[(size_t)t * 64 + w] = f2bf(v); else if (w < 72) iw[(size_t)t * 8 + w - 64] = v * WSCALE; }
    }
};
struct EpiGatesN { bf16_t* g; DEV void operator()(int t, int n, float v) const { g[(size_t)(n >> 10) * T * D + (size_t)t * D + (n & 1023)] = f2bf(1.f / (1.f + __expf(-v))); } };
struct EpiMergeN { bf16_t* merged; const bf16_t* gate; int first, pad; DEV void operator()(int t, int n, float v) const {
    const size_t o = (size_t)t * D + n; const float p = bf2f(gate[o]) * v; merged[o] = f2bf(first ? p : bf2f(merged[o]) + p); } };
struct EpiResidN { const float* xin; float* xout; int row0, pad; DEV void operator()(int t, int n, float v) const { const size_t o = (size_t)(t + row0) * D + n; xout[o] = xin[o] + v; } };
struct EpiF32 { float* out; int ldc, row0; DEV void operator()(int t, int n, float v) const { out[(size_t)(t + row0) * ldc + n] = v; } };
struct EpiBf { bf16_t* out; int ldc; float scale; DEV void operator()(int t, int n, float v) const { out[(size_t)t * ldc + n] = f2bf(v * scale); } };
struct EpiUpN { bf16_t *fa, *fu; DEV void operator()(int t, int n, float v) const { const int j = n >> 8, w = n & 255; if (w < 128) fa[(size_t)t * DFF + 128 * j + w] = f2bf(v); else fu[(size_t)t * DFF + 128 * j + w - 128] = f2bf(v); } };

__global__ void __launch_bounds__(256) k_sb_naive(const bf16_t* Q, const bf16_t* __restrict__ Kk, const bf16_t* __restrict__ V, bf16_t* O) {
    __shared__ float wsh[4][64], qsh[4][64];
    const int wid = threadIdx.x >> 6, lane = threadIdx.x & 63;
    const int gid = blockIdx.x * 4 + wid;
    const int t = gid % S, h = (gid / S) & 7, b = gid / (S * 8);
    const size_t rowb = (size_t)b * S;
    qsh[wid][lane] = bf2f(Q[(rowb + t) * 512 + h * 64 + lane]);
    __syncthreads();
    float o = 0.f, carry = 1.f;
    for (int c = (t - 1) >> 6; c >= 0 && t > 0; --c) {
        const int s = 64 * c + lane; const bool valid = s < t;
        const bf16_t* kr = Kk + (rowb + s) * 512 + h * 64;
        float z = 0.f;
#pragma unroll
        for (int d8 = 0; d8 < 8; ++d8) { const bf16x8 kv = *(const bf16x8*)(kr + 8 * d8);
#pragma unroll
            for (int j = 0; j < 8; ++j) z += qsh[wid][8 * d8 + j] * bf2f((bf16_t)kv[j]); }
        const float e = exp2f(fminf(z, 126.f));
        const float u = valid ? 1.f / (1.f + e) : 1.f, sg = valid ? 1.f - u : 0.f;
        float p = u;
#pragma unroll
        for (int off = 1; off < 64; off <<= 1) { const float tmp = __shfl_down(p, off); if (lane + off < 64) p *= tmp; }
        float ex = __shfl_down(p, 1); if (lane == 63) ex = 1.f;
        wsh[wid][lane] = sg * ex * carry;
        carry *= __shfl(p, 0);
        __builtin_amdgcn_s_waitcnt(0xc07f); __builtin_amdgcn_wave_barrier();
        const bf16_t* vr = V + (rowb + 64 * c) * 512 + h * 64 + lane;
#pragma unroll 8
        for (int j = 0; j < 64; ++j) o += wsh[wid][j] * bf2f(vr[(size_t)j * 512]);
        __builtin_amdgcn_wave_barrier();
    }
    O[(rowb + t) * 512 + h * 64 + lane] = f2bf(o);
}

__global__ void k_cxmul(bf16_t* cx, const bf16_t* __restrict__ xp) { const size_t i = blockIdx.x * (size_t)blockDim.x + threadIdx.x; if (i < (size_t)T * 512) cx[i] = f2bf(bf2f(cx[i]) * bf2f(xp[i])); }
__global__ void k_conv_sc(bf16_t* scb, const bf16_t* __restrict__ cx, const float* __restrict__ w) {
    const size_t i = blockIdx.x * (size_t)blockDim.x + threadIdx.x; if (i >= (size_t)T * 512) return;
    const int c = i & 511; const int t = (int)(i >> 9), tl = t % S;
    float acc = 0.f;
#pragma unroll
    for (int k = 0; k < 3; ++k) { const int tt = tl - 2 + k; if (tt >= 0) acc += w[k * 512 + c] * bf2f(cx[(size_t)(t - 2 + k) * 512 + c]); }
    scb[i] = f2bf(bf2f(scb[i]) * acc);
}

DEV unsigned fkey(float v) { v += 0.f; const unsigned u = __float_as_uint(v); return (u & 0x80000000u) ? ~u : (u | 0x80000000u); }
__global__ void __launch_bounds__(256) k_index_naive(const bf16_t* __restrict__ IQ, const bf16_t* __restrict__ IK, const float* __restrict__ IW, unsigned* BM) {
    __shared__ float qi[512]; __shared__ float wq[8]; __shared__ unsigned cnt; __shared__ unsigned pre[257]; __shared__ unsigned keys[8192];
    const int t = blockIdx.x % S, b = blockIdx.x / S, j = threadIdx.x;
    const size_t row = (size_t)b * S + t;
    qi[j] = bf2f(IQ[row * 512 + j]); qi[j + 256] = bf2f(IQ[row * 512 + j + 256]);
    if (j < 8) wq[j] = IW[row * 8 + j];
    __syncthreads();
    const int n = t + 1;
    for (int s = j; s < 8192; s += 256) {
        unsigned kk = 0u;
        if (s <= t) {
            const bf16_t* kr = IK + ((size_t)b * S + s) * 64;
            float kf[64];
#pragma unroll
            for (int d8 = 0; d8 < 8; ++d8) { const bf16x8 kv = *(const bf16x8*)(kr + 8 * d8);
#pragma unroll
                for (int q = 0; q < 8; ++q) kf[8 * d8 + q] = bf2f((bf16_t)kv[q]); }
            float sc = 0.f;
#pragma unroll
            for (int h = 0; h < 8; ++h) { float dd = 0.f;
#pragma unroll
                for (int d = 0; d < 64; ++d) dd += qi[h * 64 + d] * kf[d];
                sc += wq[h] * fmaxf(dd, 0.f); }
            kk = fkey(sc);
        }
        keys[s] = kk;
    }
    __syncthreads();
    unsigned word = 0u;
    if (n <= 256) {
        for (int i = 0; i < 32; ++i) if (32 * j + i <= t) word |= 1u << i;
    } else {
        unsigned X = 0u;
        for (int bit = 31; bit >= 0; --bit) {
            const unsigned cand = X | (1u << bit);
            unsigned c = 0;
            for (int i = 0; i < 32; ++i) c += keys[32 * j + ((i + j) & 31)] >= cand;
            if (j == 0) cnt = 0; __syncthreads(); atomicAdd(&cnt, c); __syncthreads();
            if (cnt >= 256u) X = cand;
            __syncthreads();
        }
        unsigned cg = 0, ce = 0;
        for (int i = 0; i < 32; ++i) { const unsigned k = keys[32 * j + ((i + j) & 31)]; cg += k > X; ce += k == X; }
        if (j == 0) cnt = 0; __syncthreads(); atomicAdd(&cnt, cg); pre[j + 1] = ce; __syncthreads();
        const unsigned m = 256u - cnt;
        if (j == 0) { pre[0] = 0; for (int q = 1; q <= 256; ++q) pre[q] += pre[q - 1]; }
        __syncthreads();
        unsigned rank = pre[j];
        for (int i = 0; i < 32; ++i) { const unsigned k = keys[32 * j + i]; if (k > X) word |= 1u << i; else if (k == X) { if (rank < m) word |= 1u << i; ++rank; } }
    }
    BM[((size_t)b * 256 + j) * S + t] = word;
}

__global__ void __launch_bounds__(512) k_dsa_naive(const bf16_t* Q, const bf16_t* __restrict__ Kk, const bf16_t* __restrict__ V, const unsigned* __restrict__ BM, bf16_t* O) {
    __shared__ int sel[256]; __shared__ unsigned pre[257]; __shared__ float qs[512]; __shared__ float ps[8][256];
    const int t = blockIdx.x % S, b = blockIdx.x / S, tid = threadIdx.x, h = tid >> 6, lane = tid & 63;
    const size_t rowb = (size_t)b * S;
    qs[tid] = bf2f(Q[(rowb + t) * 512 + tid]);
    unsigned word = 0;
    if (tid < 256) { word = (32 * tid <= t) ? BM[((size_t)b * 256 + tid) * S + t] : 0u; pre[tid + 1] = __popc(word); }
    __syncthreads();
    if (tid == 0) { pre[0] = 0; for (int q = 1; q <= 256; ++q) pre[q] += pre[q - 1]; }
    __syncthreads();
    if (tid < 256) { unsigned r = pre[tid]; for (int i = 0; i < 32; ++i) if (word >> i & 1u) { if (r < 256) sel[r] = 32 * tid + i; ++r; } }
    __syncthreads();
    const int nsel = min((int)pre[256], 256);
    float lg[4]; float mx = -INFINITY;
#pragma unroll
    for (int c = 0; c < 4; ++c) {
        const int i = 64 * c + lane; float z = -INFINITY;
        if (i < nsel) { const bf16_t* kr = Kk + (rowb + sel[i]) * 512 + h * 64; z = 0.f;
#pragma unroll
            for (int d8 = 0; d8 < 8; ++d8) { const bf16x8 kv = *(const bf16x8*)(kr + 8 * d8);
#pragma unroll
                for (int q = 0; q < 8; ++q) z += qs[h * 64 + 8 * d8 + q] * bf2f((bf16_t)kv[q]); } }
        lg[c] = z; mx = fmaxf(mx, z);
    }
    mx = wave_max(mx);
    float sum = 0.f;
#pragma unroll
    for (int c = 0; c < 4; ++c) { const float p = (64 * c + lane < nsel) ? exp2f(lg[c] - mx) : 0.f; ps[h][64 * c + lane] = p; sum += p; }
    sum = wave_sum(sum);
    __syncthreads();
    float o = 0.f;
    for (int i = 0; i < nsel; ++i) o += ps[h][i] * bf2f(V[(rowb + sel[i]) * 512 + h * 64 + lane]);
    O[(rowb + t) * 512 + tid] = f2bf(o / sum);
}

__global__ void __launch_bounds__(256) k_softmax256(const float* __restrict__ lg, bf16_t* P) {
    const size_t w = blockIdx.x * 4 + (threadIdx.x >> 6); const int lane = threadIdx.x & 63;
    const f32x4 v = ((const f32x4*)(lg + w * 256))[lane];
    const float mx = wave_max(fmaxf(fmaxf(v.x, v.y), fmaxf(v.z, v.w)));
    const float e0 = exp2f(v.x - mx), e1 = exp2f(v.y - mx), e2 = exp2f(v.z - mx), e3 = exp2f(v.w - mx);
    const float r = 1.f / wave_sum(e0 + e1 + e2 + e3);
    bf16_t* p = P + w * 256 + lane * 4; p[0] = f2bf(e0 * r); p[1] = f2bf(e1 * r); p[2] = f2bf(e2 * r); p[3] = f2bf(e3 * r);
}

__global__ void k_ffn_mid(const bf16_t* __restrict__ fa, bf16_t* fu, const float* __restrict__ cw, const float* __restrict__ cb) {
    const size_t i = blockIdx.x * (size_t)blockDim.x + threadIdx.x; if (i >= (size_t)T * DFF) return;
    const int c = (int)(i % DFF); const int t = (int)(i / DFF), tl = t % S;
    float a = cb[c];
#pragma unroll
    for (int k = 0; k < 3; ++k) { const int tt = tl - 2 + k; if (tt >= 0) a += cw[k * DFF + c] * bf2f(fa[(size_t)(t - 2 + k) * DFF + c]); }
    const float g = a / (1.f + __expf(-1.5957691216057308f * (a + 0.044715f * a * a * a)));
    fu[i] = f2bf(g * bf2f(fu[i]));
}


#define LAS __attribute__((address_space(3)))
#define GAS __attribute__((address_space(1)))
typedef unsigned u32x4 __attribute__((ext_vector_type(4)));
typedef unsigned u32x2 __attribute__((ext_vector_type(2)));
typedef float f32x2 __attribute__((ext_vector_type(2)));
#define LDS_WAIT() asm volatile("s_waitcnt lgkmcnt(0)" ::: "memory")
#define VM_WAIT() asm volatile("s_waitcnt vmcnt(0)" ::: "memory")
typedef __bf16 bf16x2_t __attribute__((ext_vector_type(2)));
DEV unsigned cvt_pk_bf16(float lo, float hi) { const f32x2 v = {lo, hi}; return __builtin_bit_cast(unsigned, __builtin_convertvector(v, bf16x2_t)); }
DEV float bflo(unsigned w) { return __uint_as_float(w << 16); }
DEV float bfhi(unsigned w) { return __uint_as_float(w & 0xffff0000u); }

namespace pg8 {
constexpr int BM = 256, BK = 64, HALF = 128, HTB = HALF * BK * 2, STAGE_BYTES = 8 * HTB, NXCD = 8, WGM = 8;
__host__ __device__ __forceinline__ int lds_byte(int r, int c) { const int st = (r >> 4) * 2 + (c >> 5), rr = r & 15, cc = c & 31, ob = rr * 64 + cc * 2; return st * 1024 + (ob ^ (((ob >> 9) & 1) << 5)); }
__host__ __device__ __forceinline__ void stage_rc(int b, int& R, int& C) { const int st = b / 1024, sb = b % 1024, swz = sb ^ (((sb >> 9) & 1) << 5); R = (st >> 1) * 16 + swz / 64; C = (st & 1) * 32 + (swz % 64) / 2; }
__host__ __device__ __forceinline__ int perm32(int rho) { const int n = rho >> 4, i = rho & 15; return 8 * (i >> 2) + 4 * n + (i & 3); }

struct Unit { int pm, pn, job; };
struct Order {
    int nM, nN, nwg, ntot, G, c;
    DEV void init(int nM_, int nN_, int njob, int G_, int c_) { nM = nM_; nN = nN_; nwg = nM * nN; ntot = nwg * njob; G = G_; c = c_; }
    DEV bool next(int i, Unit& u) const {
        const int L = i * G + c; if (L >= ntot) return false;
        u.job = L / nwg; int wgid = L - u.job * nwg;
        { const int q = nwg / NXCD, r = nwg % NXCD, xcd = wgid % NXCD, off = wgid / NXCD; wgid = (xcd < r ? xcd * (q + 1) : r * (q + 1) + (xcd - r) * q) + off; }
        const int nig = WGM * nN, gid = wgid / nig, fm = gid * WGM, gsz = (nM - fm) < WGM ? (nM - fm) : WGM;
        u.pm = fm + ((wgid % nig) % gsz); u.pn = (wgid % nig) / gsz; return true;
    }
};
template <class Epi, class Ptr, bool ALIGN_EPI, bool SP2>
DEV void gemm_phase(LAS unsigned char* lds, const int lda, const int ldb, const int K, const Order& S, const Ptr& P, const Epi& E) {
    int tid_ = threadIdx.x; asm volatile("" : "+v"(tid_));
    const int tid = tid_, wid = __builtin_amdgcn_readfirstlane(tid >> 6), lane = tid & 63, wr = wid >> 2, wc = wid & 3, fr = lane & 15, fq = lane >> 4;
    const int nt = K / BK;
    unsigned voffA[2], voffB[2];
#pragma unroll
    for (int i = 0; i < 2; ++i) { int R, C; stage_rc(tid * 16 + i * 8192, R, C); const int Rb = Epi::PERM ? ((R & ~31) + perm32(R & 31)) : R;
        voffA[i] = (unsigned)(R * lda + C) * 2u; voffB[i] = (unsigned)(Rb * ldb + C) * 2u; }
    const size_t kstep = (size_t)(BK * 2);
    const size_t hstepA = (size_t)HALF * lda * 2, hstepB = (size_t)HALF * ldb * 2;
    const unsigned ldsw = (unsigned)wid * 1024u;
    const int aoff = lds_byte(wr * 64 + fr, fq * 8), boff = lds_byte(wc * 32 + fr, fq * 8);
#define PG8_SA(b, h) (((b) * 2 + (h)) * HTB)
#define PG8_SB(b, h) ((4 + (b) * 2 + (h)) * HTB)
#define PG8_STAGE(bufoff, gbase, voff) do { _Pragma("unroll") for (int _i = 0; _i < 2; ++_i) \
        __builtin_amdgcn_global_load_lds((const unsigned*)((const char*)(gbase) + (voff)[_i]), (LAS unsigned*)(lds + (bufoff) + ldsw + _i * 8192), 16, 0, 0); } while (0)
#define PG8_LDA(dst, b, h) do { _Pragma("unroll") for (int m = 0; m < 4; ++m) _Pragma("unroll") for (int k = 0; k < 2; ++k) dst[m][k] = *(const LAS bf16x8*)(lds + PG8_SA(b, h) + aoff + m * 2048 + k * 1024); } while (0)
#define PG8_LDB(dst, b, h) do { _Pragma("unroll") for (int n = 0; n < 2; ++n) _Pragma("unroll") for (int k = 0; k < 2; ++k) dst[n][k] = *(const LAS bf16x8*)(lds + PG8_SB(b, h) + boff + n * 2048 + k * 1024); } while (0)
#define PG8_MMA(ai, bj, At, Bt) do { __builtin_amdgcn_s_setprio(1); _Pragma("unroll") for (int m = 0; m < 4; ++m) _Pragma("unroll") for (int n = 0; n < 2; ++n) _Pragma("unroll") for (int k = 0; k < 2; ++k) \
        acc[ai][bj][m][n] = __builtin_amdgcn_mfma_f32_16x16x32_bf16(Bt[n][k], At[m][k], acc[ai][bj][m][n], 0, 0, 0); __builtin_amdgcn_s_setprio(0); } while (0)
#define PG8_WAIT_V(n) asm volatile("s_waitcnt vmcnt(" #n ")" ::: "memory")
#define PG8_WAIT_L(n) asm volatile("s_waitcnt lgkmcnt(" #n ")" ::: "memory")
#define PG8_BAR __builtin_amdgcn_s_barrier()
#define PG8_SCHED __builtin_amdgcn_sched_barrier(0)
    Unit cur, nxt; int ui = 0;
    if (!S.next(0, cur)) return;
    f32x4 acc[2][2][4][2];
#pragma unroll
    for (int a = 0; a < 2; ++a)
#pragma unroll
        for (int b = 0; b < 2; ++b)
#pragma unroll
            for (int m = 0; m < 4; ++m)
#pragma unroll
                for (int n = 0; n < 2; ++n) acc[a][b][m][n] = (f32x4){0.f, 0.f, 0.f, 0.f};
    bf16x8 At[4][2], B0[2][2], B1[2][2];
    const char* cA = P.a(cur); const char* cB = P.b(cur);
    if constexpr (SP2) {
        PG8_STAGE(PG8_SB(0, 0), cB, voffB); PG8_STAGE(PG8_SB(0, 1), cB + hstepB, voffB); PG8_STAGE(PG8_SA(0, 0), cA, voffA); PG8_STAGE(PG8_SA(0, 1), cA + hstepA, voffA);
        if (wr == 1) PG8_BAR;
        PG8_WAIT_V(2); PG8_BAR;
        PG8_STAGE(PG8_SB(1, 0), cB + kstep, voffB); PG8_STAGE(PG8_SA(1, 0), cA + kstep, voffA); PG8_STAGE(PG8_SB(1, 1), cB + hstepB + kstep, voffB);
        PG8_WAIT_V(6); PG8_BAR;
    } else {
        PG8_STAGE(PG8_SB(0, 0), cB, voffB); PG8_STAGE(PG8_SA(0, 0), cA, voffA); PG8_STAGE(PG8_SB(0, 1), cB + hstepB, voffB); PG8_STAGE(PG8_SA(0, 1), cA + hstepA, voffA);
        if (wr == 1) PG8_BAR;
        PG8_WAIT_V(4); PG8_BAR;
        PG8_STAGE(PG8_SB(1, 0), cB + kstep, voffB); PG8_STAGE(PG8_SA(1, 0), cA + kstep, voffA); PG8_STAGE(PG8_SB(1, 1), cB + hstepB + kstep, voffB);
        PG8_WAIT_V(6); PG8_BAR;
    }
#pragma unroll 1
    for (;;) {
        const bool has_next = S.next(ui + 1, nxt);
        const char* nA = has_next ? P.a(nxt) : cA; const char* nB = has_next ? P.b(nxt) : cB;
#pragma unroll 1
        for (int t = 0; t < nt; t += 2) {
            const bool last = (t == nt - 2);
            const char* a1 = cA + (size_t)(t + 1) * kstep;
            const char* a2 = last ? nA : cA + (size_t)(t + 2) * kstep; const char* b2 = last ? nB : cB + (size_t)(t + 2) * kstep;
            const char* a3 = a2 + kstep; const char* b3 = b2 + kstep;
            if constexpr (SP2) {
            PG8_LDB(B0, 0, 0); PG8_LDB(B1, 0, 1); PG8_SCHED; PG8_LDA(At, 0, 0); PG8_STAGE(PG8_SA(1, 1), a1 + hstepA, voffA);
            PG8_WAIT_V(8); PG8_WAIT_L(0); PG8_BAR; PG8_MMA(0, 0, At, B0); PG8_MMA(0, 1, At, B1); PG8_BAR; PG8_SCHED;
            PG8_LDA(At, 0, 1); PG8_STAGE(PG8_SB(0, 0), b2, voffB); PG8_STAGE(PG8_SB(0, 1), b2 + hstepB, voffB); PG8_STAGE(PG8_SA(0, 0), a2, voffA);
            PG8_WAIT_V(8); PG8_WAIT_L(0); PG8_BAR; PG8_MMA(1, 0, At, B0); PG8_MMA(1, 1, At, B1); PG8_BAR; PG8_SCHED;
            PG8_LDB(B0, 1, 0); PG8_LDB(B1, 1, 1); PG8_SCHED; PG8_LDA(At, 1, 0); PG8_STAGE(PG8_SA(0, 1), a2 + hstepA, voffA);
            PG8_WAIT_V(8); PG8_WAIT_L(0); PG8_BAR; PG8_MMA(0, 0, At, B0); PG8_MMA(0, 1, At, B1); PG8_BAR; PG8_SCHED;
            PG8_LDA(At, 1, 1); PG8_STAGE(PG8_SB(1, 0), b3, voffB); PG8_STAGE(PG8_SB(1, 1), b3 + hstepB, voffB); PG8_STAGE(PG8_SA(1, 0), a3, voffA);
            PG8_WAIT_V(8); PG8_WAIT_L(0); PG8_BAR; PG8_MMA(1, 0, At, B0); PG8_MMA(1, 1, At, B1); PG8_BAR; PG8_SCHED;
            } else {
            PG8_LDB(B0, 0, 0); PG8_SCHED; PG8_LDA(At, 0, 0); PG8_STAGE(PG8_SA(1, 1), a1 + hstepA, voffA);
            PG8_WAIT_L(8); PG8_BAR; PG8_WAIT_L(0); PG8_MMA(0, 0, At, B0); PG8_BAR; PG8_SCHED;
            PG8_LDB(B1, 0, 1); PG8_STAGE(PG8_SB(0, 0), b2, voffB);
            PG8_BAR; PG8_WAIT_L(0); PG8_MMA(0, 1, At, B1); PG8_BAR;
            PG8_LDA(At, 0, 1); PG8_STAGE(PG8_SA(0, 0), a2, voffA);
            PG8_BAR; PG8_WAIT_L(0); PG8_MMA(1, 0, At, B0); PG8_BAR; PG8_SCHED;
            PG8_STAGE(PG8_SB(0, 1), b2 + hstepB, voffB);
            PG8_WAIT_V(6); PG8_BAR; PG8_MMA(1, 1, At, B1); PG8_BAR;
            PG8_LDB(B0, 1, 0); PG8_SCHED; PG8_LDA(At, 1, 0); PG8_STAGE(PG8_SA(0, 1), a2 + hstepA, voffA);
            PG8_WAIT_L(8); PG8_BAR; PG8_WAIT_L(0); PG8_MMA(0, 0, At, B0); PG8_BAR; PG8_SCHED;
            PG8_LDB(B1, 1, 1); PG8_STAGE(PG8_SB(1, 0), b3, voffB);
            PG8_BAR; PG8_WAIT_L(0); PG8_MMA(0, 1, At, B1); PG8_BAR;
            PG8_LDA(At, 1, 1); PG8_STAGE(PG8_SA(1, 0), a3, voffA);
            PG8_BAR; PG8_WAIT_L(0); PG8_MMA(1, 0, At, B0); PG8_BAR; PG8_SCHED;
            PG8_STAGE(PG8_SB(1, 1), b3 + hstepB, voffB);
            PG8_WAIT_V(6); PG8_BAR; PG8_MMA(1, 1, At, B1); PG8_BAR;
            }
        }
        if constexpr (ALIGN_EPI) { if (wr == 0) PG8_BAR; }
        if constexpr (!Epi::AFTER_DRAIN) { E(acc, cur, wr, wc, fr, fq); }
        if (!has_next) break;
#pragma unroll
        for (int a = 0; a < 2; ++a)
#pragma unroll
            for (int b = 0; b < 2; ++b)
#pragma unroll
                for (int m = 0; m < 4; ++m)
#pragma unroll
                    for (int n = 0; n < 2; ++n) acc[a][b][m][n] = (f32x4){0.f, 0.f, 0.f, 0.f};
        cur = nxt; cA = nA; cB = nB; ++ui;
        if constexpr (ALIGN_EPI) { if (wr == 1) PG8_BAR; }
    }
    PG8_WAIT_V(0);
    if constexpr (!ALIGN_EPI) { if (wr == 0) PG8_BAR; }
    PG8_BAR;
    if constexpr (Epi::AFTER_DRAIN) { E.fused(acc, cur, wr, wc, fr, fq, lds, wid, lane); }
#undef PG8_SA
#undef PG8_SB
#undef PG8_STAGE
#undef PG8_LDA
#undef PG8_LDB
#undef PG8_MMA
#undef PG8_WAIT_V
#undef PG8_WAIT_L
#undef PG8_BAR
#undef PG8_SCHED
}
typedef f32x4 Acc[2][2][4][2];

struct PtrStd {
    const char* A; const char* B; size_t aj, bj, bb, arow, brow;
    DEV const char* a(const Unit& u) const { return A + (size_t)u.job * aj + (size_t)u.pm * arow; }
    DEV const char* b(const Unit& u) const { return B + (size_t)u.job * bj + (size_t)(u.pm >> 5) * bb + (size_t)u.pn * brow; }
};
struct PtrG {
    const char* KVM; const char* WQ;
    DEV const char* a(const Unit& u) const { return KVM + (size_t)(u.job >> 2) * MiB + (size_t)(u.job & 3) * 512; }
    DEV const char* b(const Unit& u) const { return WQ + (size_t)(u.job >> 3) * 2 * MiB + (size_t)(u.job & 3) * 512 + (size_t)u.pn * 256 * 1024 * 2; }
};
struct PtrH {
    const char* KVM; const char* WOT;
    DEV const char* a(const Unit& u) const { return WOT + (size_t)(u.job >> 3) * 2 * MiB + (size_t)(u.job & 3) * 512 + (size_t)u.pm * 256 * 1024 * 2; }
    DEV const char* b(const Unit& u) const { return KVM + (size_t)(u.job >> 2) * MiB + 2048 + (size_t)(u.job & 3) * 512; }
};

#define EPI_ROWS(u) const int row0 = (u).pm * BM + wr * 64 + fr
DEV u32x4 pack8(const f32x4 v0, const f32x4 v1) { u32x4 w; w.x = cvt_pk_bf16(v0[0], v0[1]); w.y = cvt_pk_bf16(v0[2], v0[3]); w.z = cvt_pk_bf16(v1[0], v1[1]); w.w = cvt_pk_bf16(v1[2], v1[3]); return w; }

struct EpiInProj {
    static constexpr bool PERM = true, AFTER_DRAIN = false;
    unsigned char* ws;
    DEV void operator()(const Acc& acc, const Unit& u, int wr, int wc, int fr, int fq) const {
        EPI_ROWS(u); const int pn = u.pn, cb = wc * 32 + 8 * fq;
        if (pn < 16) {
            const int g = pn >> 1;
            const size_t off = g == 0 ? WS_QA : g == 1 ? WS_KA : g == 2 ? WS_VA : g == 3 ? WS_QC : g == 4 ? WS_KC : g == 5 ? WS_VC : g == 6 ? WS_IQ : WS_SCB;
            const float sc = (g == 0 || g == 3) ? QSCALE : 1.f;
            bf16_t* base = (bf16_t*)(ws + off) + (pn & 1) * 256 + cb;
#pragma unroll
            for (int ai = 0; ai < 2; ++ai)
#pragma unroll
                for (int m = 0; m < 4; ++m) { bf16_t* rowp = base + (size_t)(row0 + ai * HALF + m * 16) * 512;
#pragma unroll
                    for (int bj = 0; bj < 2; ++bj) *(u32x4*)(rowp + bj * HALF) = pack8(acc[ai][bj][m][0] * sc, acc[ai][bj][m][1] * sc); }
        } else if (pn < 20) {
            bf16_t* base = (bf16_t*)(ws + WS_CX) + (pn - 16) * 128 + cb;
#pragma unroll
            for (int ai = 0; ai < 2; ++ai)
#pragma unroll
                for (int m = 0; m < 4; ++m) *(u32x4*)(base + (size_t)(row0 + ai * HALF + m * 16) * 512) = pack8(acc[ai][0][m][0] * acc[ai][1][m][0], acc[ai][0][m][1] * acc[ai][1][m][1]);
        } else {
            if (wc < 2) { bf16_t* base = (bf16_t*)(ws + WS_IK) + cb;
#pragma unroll
                for (int ai = 0; ai < 2; ++ai)
#pragma unroll
                    for (int m = 0; m < 4; ++m) *(u32x4*)(base + (size_t)(row0 + ai * HALF + m * 16) * 64) = pack8(acc[ai][0][m][0], acc[ai][0][m][1]);
            } else if (wc == 2 && fq == 0) { float* base = (float*)(ws + WS_IW);
#pragma unroll
                for (int ai = 0; ai < 2; ++ai)
#pragma unroll
                    for (int m = 0; m < 4; ++m) { float* p = base + (size_t)(row0 + ai * HALF + m * 16) * 8; *(f32x4*)p = acc[ai][0][m][0] * WSCALE; *(f32x4*)(p + 4) = acc[ai][0][m][1] * WSCALE; }
            }
        }
    }
};
DEV f32x4 sigm4(const f32x4 v) { f32x4 o;
#pragma unroll
    for (int i = 0; i < 4; ++i) o[i] = __builtin_amdgcn_rcpf(1.f + __builtin_amdgcn_exp2f(-LOG2E * v[i])); return o; }
struct EpiGates {
    static constexpr bool PERM = true, AFTER_DRAIN = false;
    bf16_t* G;
    DEV void operator()(const Acc& acc, const Unit& u, int wr, int wc, int fr, int fq) const {
        EPI_ROWS(u); bf16_t* base = G + (size_t)(u.pn >> 2) * T * D + (u.pn & 3) * 256 + wc * 32 + 8 * fq;
#pragma unroll
        for (int ai = 0; ai < 2; ++ai)
#pragma unroll
            for (int m = 0; m < 4; ++m) { bf16_t* rowp = base + (size_t)(row0 + ai * HALF + m * 16) * D;
#pragma unroll
                for (int bj = 0; bj < 2; ++bj) *(u32x4*)(rowp + bj * HALF) = pack8(sigm4(acc[ai][bj][m][0]), sigm4(acc[ai][bj][m][1])); }
    }
};
struct EpiMerge {
    static constexpr bool PERM = true, AFTER_DRAIN = false;
    bf16_t* M; const bf16_t* G;
    DEV void operator()(const Acc& acc, const Unit& u, int wr, int wc, int fr, int fq) const {
        EPI_ROWS(u); const size_t cofs = (size_t)u.pn * 256 + wc * 32 + 8 * fq; const bf16_t* gb = G + (size_t)u.job * T * D;
#pragma unroll
        for (int ai = 0; ai < 2; ++ai)
#pragma unroll
            for (int m = 0; m < 4; ++m) { const size_t ro = (size_t)(row0 + ai * HALF + m * 16) * D + cofs;
#pragma unroll
                for (int bj = 0; bj < 2; ++bj) { const size_t o = ro + bj * HALF; const u32x4 g = *(const u32x4*)(gb + o);
                    f32x4 v0 = acc[ai][bj][m][0], v1 = acc[ai][bj][m][1];
                    v0[0] *= bflo(g.x); v0[1] *= bfhi(g.x); v0[2] *= bflo(g.y); v0[3] *= bfhi(g.y); v1[0] *= bflo(g.z); v1[1] *= bfhi(g.z); v1[2] *= bflo(g.w); v1[3] *= bfhi(g.w);
                    if (u.job > 0) { const u32x4 p = __builtin_nontemporal_load((const u32x4*)(M + o));
                        v0[0] += bflo(p.x); v0[1] += bfhi(p.x); v0[2] += bflo(p.y); v0[3] += bfhi(p.y); v1[0] += bflo(p.z); v1[1] += bfhi(p.z); v1[2] += bflo(p.w); v1[3] += bfhi(p.w); }
                    *(u32x4*)(M + o) = pack8(v0, v1); } }
    }
};
struct EpiResid {
    static constexpr bool PERM = false, AFTER_DRAIN = false;
    const float* xin; float* xout;
    DEV void operator()(const Acc& acc, const Unit& u, int wr, int wc, int fr, int fq) const {
        EPI_ROWS(u); const size_t cofs = (size_t)u.pn * 256 + wc * 32 + 4 * fq;
#pragma unroll
        for (int ai = 0; ai < 2; ++ai)
#pragma unroll
            for (int m = 0; m < 4; ++m) { const size_t ro = (size_t)(row0 + ai * HALF + m * 16) * D + cofs;
#pragma unroll
                for (int bj = 0; bj < 2; ++bj)
#pragma unroll
                    for (int n = 0; n < 2; ++n) { const size_t o = ro + bj * HALF + n * 16; *(f32x4*)(xout + o) = *(const f32x4*)(xin + o) + acc[ai][bj][m][n]; } }
    }
};
struct EpiUp {
    static constexpr bool PERM = true, AFTER_DRAIN = false;
    bf16_t *fa, *fu;
    DEV void operator()(const Acc& acc, const Unit& u, int wr, int wc, int fr, int fq) const {
        EPI_ROWS(u); const size_t cofs = (size_t)u.pn * 128 + wc * 32 + 8 * fq;
#pragma unroll
        for (int ai = 0; ai < 2; ++ai)
#pragma unroll
            for (int m = 0; m < 4; ++m) { const size_t o = (size_t)(row0 + ai * HALF + m * 16) * DFF + cofs;
                *(u32x4*)(fa + o) = pack8(acc[ai][0][m][0], acc[ai][0][m][1]); *(u32x4*)(fu + o) = pack8(acc[ai][1][m][0], acc[ai][1][m][1]); }
    }
};
struct EpiPrep {
    static constexpr bool PERM = true, AFTER_DRAIN = false;
    unsigned char* ws; int mode;
    DEV void operator()(const Acc& acc, const Unit& u, int wr, int wc, int fr, int fq) const {
        EPI_ROWS(u); bf16_t* base; int ldc; float sc = 1.f;
        if (mode == 0) { base = (bf16_t*)(ws + WS_KVM + (size_t)u.job * 2 * MiB); ldc = 2 * D; }
        else if (mode == 1) { base = (bf16_t*)(ws + WS_GT + (size_t)(u.job >> 2) * 2 * MiB) + (size_t)(u.job & 3) * 256 * D; ldc = D; sc = XSCALE; }
        else { base = (bf16_t*)(ws + WS_HT + (size_t)(u.job >> 2) * 2 * MiB) + (u.job & 3) * 256; ldc = D; }
        base += (size_t)u.pn * 256 + wc * 32 + 8 * fq;
#pragma unroll
        for (int ai = 0; ai < 2; ++ai)
#pragma unroll
            for (int m = 0; m < 4; ++m) { bf16_t* rowp = base + (size_t)(row0 + ai * HALF + m * 16) * ldc;
#pragma unroll
                for (int bj = 0; bj < 2; ++bj) *(u32x4*)(rowp + bj * HALF) = pack8(acc[ai][bj][m][0] * sc, acc[ai][bj][m][1] * sc); }
    }
};
struct EpiSoftmax {
    static constexpr bool PERM = true, AFTER_DRAIN = true;
    bf16_t* P;
    DEV void fused(Acc& acc, const Unit& u, int wr, int wc, int fr, int fq, LAS unsigned char* lds, int wid, int lane) const {
        LAS float* PM = (LAS float*)lds; LAS float* PS = (LAS float*)(lds + 4096);
#pragma unroll
        for (int ai = 0; ai < 2; ++ai)
#pragma unroll
            for (int m = 0; m < 4; ++m) { float mx = -INFINITY;
#pragma unroll
                for (int bj = 0; bj < 2; ++bj)
#pragma unroll
                    for (int n = 0; n < 2; ++n) { const f32x4 x = acc[ai][bj][m][n]; mx = fmaxf(mx, fmaxf(fmaxf(x[0], x[1]), fmaxf(x[2], x[3]))); }
                mx = fmaxf(mx, __shfl_xor(mx, 16)); mx = fmaxf(mx, __shfl_xor(mx, 32));
                if (fq == 0) PM[(ai * HALF + wr * 64 + m * 16 + fr) * 4 + wc] = mx; }
        LDS_WAIT(); __builtin_amdgcn_s_barrier(); asm volatile("" ::: "memory");
#pragma unroll
        for (int ai = 0; ai < 2; ++ai)
#pragma unroll
            for (int m = 0; m < 4; ++m) { const int r = ai * HALF + wr * 64 + m * 16 + fr; const f32x4 q = *(const LAS f32x4*)(PM + r * 4);
                const float mx = fmaxf(fmaxf(q[0], q[1]), fmaxf(q[2], q[3])); float s = 0.f;
#pragma unroll
                for (int bj = 0; bj < 2; ++bj)
#pragma unroll
                    for (int n = 0; n < 2; ++n) { f32x4 x = acc[ai][bj][m][n];
#pragma unroll
                        for (int i = 0; i < 4; ++i) { x[i] = __builtin_amdgcn_exp2f(x[i] - mx); s += x[i]; } acc[ai][bj][m][n] = x; }
                s += __shfl_xor(s, 16); s += __shfl_xor(s, 32);
                if (fq == 0) PS[r * 4 + wc] = s; }
        LDS_WAIT(); __builtin_amdgcn_s_barrier(); asm volatile("" ::: "memory");
        EPI_ROWS(u); bf16_t* base = P + (size_t)u.pn * 256 + wc * 32 + 8 * fq;
#pragma unroll
        for (int ai = 0; ai < 2; ++ai)
#pragma unroll
            for (int m = 0; m < 4; ++m) { const int r = ai * HALF + wr * 64 + m * 16 + fr; const f32x4 q = *(const LAS f32x4*)(PS + r * 4);
                const float inv = 1.f / ((q[0] + q[1]) + (q[2] + q[3])); bf16_t* rowp = base + (size_t)(row0 + ai * HALF + m * 16) * D;
#pragma unroll
                for (int bj = 0; bj < 2; ++bj) *(u32x4*)(rowp + bj * HALF) = pack8(acc[ai][bj][m][0] * inv, acc[ai][bj][m][1] * inv); }
        LDS_WAIT(); __builtin_amdgcn_s_barrier();
    }
};
}

typedef GAS unsigned gu32;
#define XB_TMO      128
#define XB_XCNT(j)  (256  + 64 * (j))
#define XB_XSUB(j)  (1280 + 64 * (j))
#define XB_XGEN(j)  (2304 + 64 * (j))
#define XB_TOP      3328
#define XB_TOPGEN   3392
#define XCD_BAR_WORDS 3456
#define XB_SPIN_CAP (1u << 22)
DEV unsigned xb_ld(unsigned* p) { return __hip_atomic_load(p, __ATOMIC_RELAXED, __HIP_MEMORY_SCOPE_AGENT); }
DEV unsigned xb_add(unsigned* p, unsigned v) { return __hip_atomic_fetch_add(p, v, __ATOMIC_RELAXED, __HIP_MEMORY_SCOPE_AGENT); }
DEV unsigned xb_xcc_id() { return (unsigned)__builtin_amdgcn_s_getreg((3 << 11) | 20) & 0xFu; }
#define XB_SPIN(cond, bar) do { unsigned _sp = 0; while (cond) { __builtin_amdgcn_s_sleep(1); \
    if ((++_sp & 255u) == 0u) { if (xb_ld(&(bar)[XB_TMO])) break; if (_sp > XB_SPIN_CAP) { atomicAdd(&(bar)[XB_TMO], 1u); break; } } } } while (0)
struct XcdBarrier { unsigned* bar; unsigned x; volatile LAS unsigned* st; };
DEV XcdBarrier xcd_barrier_post(unsigned* bar, volatile LAS unsigned* st) {
    XcdBarrier b; b.bar = bar; b.x = xb_xcc_id(); b.st = st;
    if (threadIdx.x == 0) (void)xb_add(&bar[XB_XCNT(b.x)], 1u);
    return b;
}
DEV void xcd_barrier_complete(unsigned* bar, unsigned x, unsigned& nloc, unsigned& nx) {
    const unsigned G = gridDim.x * gridDim.y * gridDim.z;
    unsigned sum, cnt, mine, sp = 0u;
    for (;;) {
        sum = 0u; cnt = 0u; mine = 0u;
#pragma unroll
        for (unsigned j = 0; j < 16; ++j) { const unsigned c = xb_ld(&bar[XB_XCNT(j)]); sum += c; cnt += (c > 0u) ? 1u : 0u; mine = (j == x) ? c : mine; }
        if (sum == G) break;
        __builtin_amdgcn_s_sleep(1);
        if ((++sp & 255u) == 0u) { if (xb_ld(&bar[XB_TMO])) break; if (sp > XB_SPIN_CAP) { atomicAdd(&bar[XB_TMO], 1u); break; } }
    }
    nloc = mine > 0u ? mine : 1u; nx = cnt > 0u ? cnt : 1u;
}
DEV void xcd_barrier(const XcdBarrier& b) {
    asm volatile("s_waitcnt vmcnt(0)" ::: "memory");
    __syncthreads();
    if (threadIdx.x == 0) {
        unsigned* bar = b.bar;
        __builtin_amdgcn_s_waitcnt(0);
        unsigned nloc = b.st[0], nx = b.st[1];
        if (nloc == 0u) { xcd_barrier_complete(bar, b.x, nloc, nx); b.st[0] = nloc; b.st[1] = nx; }
        const unsigned old = xb_add(&bar[XB_XSUB(b.x)], 1u);
        const unsigned gen = old / nloc;
        if (old + 1u == (gen + 1u) * nloc) {
            __builtin_amdgcn_fence(__ATOMIC_RELEASE, "agent");
            asm volatile("s_waitcnt vmcnt(0)" ::: "memory");
            const unsigned og = xb_add(&bar[XB_TOP], 1u);
            const unsigned tg = og / nx;
            if (og + 1u == (tg + 1u) * nx) xb_add(&bar[XB_TOPGEN], 1u);
            else XB_SPIN(xb_ld(&bar[XB_TOPGEN]) == tg, bar);
            __builtin_amdgcn_fence(__ATOMIC_ACQUIRE, "agent");
            xb_add(&bar[XB_XGEN(b.x)], 1u);
            asm volatile("s_waitcnt vmcnt(0)" ::: "memory");
        } else {
            XB_SPIN(xb_ld(&bar[XB_XGEN(b.x)]) == gen, bar);
            __builtin_amdgcn_fence(__ATOMIC_ACQUIRE, "agent");
            asm volatile("s_waitcnt vmcnt(0)" ::: "memory");
        }
    }
    __syncthreads();
}


struct WaveId { int gw, ngw, wave, lane; };
DEV unsigned f2bf_u(float f) { return (unsigned)f2bf(f); }
DEV unsigned pk2(float lo, float hi) { return cvt_pk_bf16(lo, hi); }

DEV void norm_rows(const WaveId& W, const float* x, const float* g, bf16_t* outb, float* outf, int rows) {
    for (int row = W.gw; row < rows; row += W.ngw) {
        const f32x4* xr = (const f32x4*)(x + (size_t)row * D) + W.lane;
        f32x4 v[4]; float s = 0.f;
#pragma unroll
        for (int j = 0; j < 4; ++j) { v[j] = xr[64 * j]; s += (v[j].x * v[j].x + v[j].y * v[j].y) + (v[j].z * v[j].z + v[j].w * v[j].w); }
        const float r = rsqrtf(wave_sum(s) * (1.f / D) + EPS);
#pragma unroll
        for (int j = 0; j < 4; ++j) {
            const f32x4 gg = ((const f32x4*)g)[W.lane + 64 * j];
            const f32x4 o = {v[j].x * r * gg.x, v[j].y * r * gg.y, v[j].z * r * gg.z, v[j].w * r * gg.w};
            if (outb) { u32x2 w; w.x = pk2(o.x, o.y); w.y = pk2(o.z, o.w); ((u32x2*)(outb + (size_t)row * D))[W.lane + 64 * j] = w; }
            else ((f32x4*)(outf + (size_t)row * D))[W.lane + 64 * j] = o;
        }
    }
}
DEV void cvt_piece(const WaveId& W, LAS float* scr, int& base, const float* Wsrc, int ldw, int K, int col0, int ncols, bf16_t* dst, int ldo, int row0) {
    const int nblk = ncols / 32, nitems = (K / 64) * nblk;
    int first = (W.gw - base) % W.ngw; if (first < 0) first += W.ngw;
    base = (base + nitems) % W.ngw;
    for (int item = first; item < nitems; item += W.ngw) {
        const int kb = item / nblk, nb = item - kb * nblk, k0 = 64 * kb, n0 = 32 * nb;
#pragma unroll 8
        for (int i = 0; i < 32; ++i) { const int kk = 2 * i + (W.lane >> 5); scr[kk * 33 + (W.lane & 31)] = Wsrc[(size_t)(k0 + kk) * ldw + col0 + n0 + (W.lane & 31)]; }
        LDS_WAIT(); asm volatile("" ::: "memory");
        const int c = W.lane & 7;
#pragma unroll
        for (int j = 0; j < 4; ++j) { const int n = (W.lane >> 3) + 8 * j; const LAS float* s = scr + (8 * c) * 33 + n;
            u32x4 o; o.x = pk2(s[0 * 33], s[1 * 33]); o.y = pk2(s[2 * 33], s[3 * 33]); o.z = pk2(s[4 * 33], s[5 * 33]); o.w = pk2(s[6 * 33], s[7 * 33]);
            *(u32x4*)(dst + (size_t)(row0 + n0 + n) * ldo + k0 + 8 * c) = o; }
        LDS_WAIT(); asm volatile("" ::: "memory");
    }
}
DEV void convert_layer_weights(const WaveId& W, LAS float* scr, int& base, unsigned char* ws, const float* const* in, int l) {
    const float* wi = in[3] + (size_t)l * D * DIN;
    bf16_t* WIN = (bf16_t*)(ws + WS_WIN);
    cvt_piece(W, scr, base, wi, DIN, D, 0, 1536, WIN, D, 0);
    cvt_piece(W, scr, base, wi, DIN, D, 3072, 1536, WIN, D, 1536);
    cvt_piece(W, scr, base, wi, DIN, D, 4608, 512, WIN, D, 3072);
    cvt_piece(W, scr, base, wi, DIN, D, 1536, 512, WIN, D, 3584);
#pragma unroll 1
    for (int j = 0; j < 4; ++j) { cvt_piece(W, scr, base, wi, DIN, D, 2048 + 128 * j, 128, WIN, D, 4096 + 256 * j); cvt_piece(W, scr, base, wi, DIN, D, 2560 + 128 * j, 128, WIN, D, 4096 + 256 * j + 128); }
    cvt_piece(W, scr, base, wi, DIN, D, 5120, 96, WIN, D, 5120);
    cvt_piece(W, scr, base, wi, DIN, D, 5192, 3072, (bf16_t*)(ws + WS_WG), D, 0);
#pragma unroll 1
    for (int i = 0; i < 3; ++i) cvt_piece(W, scr, base, in[5 + i] + (size_t)l * 512 * D, D, 512, 0, D, (bf16_t*)(ws + WS_WBR) + (size_t)i * D * 512, 512, 0);
    cvt_piece(W, scr, base, in[8] + (size_t)l * D * D, D, D, 0, D, (bf16_t*)(ws + WS_WMIX), D, 0);
    const float* wf = in[15] + (size_t)l * D * 2 * DFF;
#pragma unroll 1
    for (int j = 0; j < 22; ++j) { cvt_piece(W, scr, base, wf, 2 * DFF, D, 128 * j, 128, (bf16_t*)(ws + WS_WUP), D, 256 * j); cvt_piece(W, scr, base, wf, 2 * DFF, D, DFF + 128 * j, 128, (bf16_t*)(ws + WS_WUP), D, 256 * j + 128); }
    cvt_piece(W, scr, base, in[18] + (size_t)l * DFF * D, D, DFF, 0, D, (bf16_t*)(ws + WS_WDOWN), DFF, 0);
}
DEV void prep0_phase(const WaveId& W, LAS float* scr, unsigned char* ws, const float* const* in) {
    int base = 0;
#pragma unroll 1
    for (int l = 0; l < DEPTH; ++l) {
        const float* wq = in[11] + (size_t)l * D * D; bf16_t* WQ = (bf16_t*)(ws + WS_WQ + (size_t)l * 2 * MiB);
        for (size_t i = (size_t)(W.gw * 64 + W.lane) * 4; i < (size_t)D * D; i += (size_t)W.ngw * 256) { const f32x4 v = *(const f32x4*)(wq + i); u32x2 o; o.x = pk2(v.x, v.y); o.y = pk2(v.z, v.w); *(u32x2*)(WQ + i) = o; }
        cvt_piece(W, scr, base, in[13] + (size_t)l * D * D, D, D, 0, D, (bf16_t*)(ws + WS_WOT + (size_t)l * 2 * MiB), D, 0);
        cvt_piece(W, scr, base, in[12] + (size_t)l * D * 2 * D, 2 * D, D, 0, 2 * D, (bf16_t*)(ws + WS_WKVT + (size_t)l * 4 * MiB), D, 0);
        norm_rows(W, in[1], in[10] + l * D, (bf16_t*)(ws + WS_MEMN + (size_t)l * MiB), nullptr, NB * MEM);
    }
    convert_layer_weights(W, scr, base, ws, in, 0);
    norm_rows(W, in[0], in[2], (bf16_t*)(ws + WS_XN), nullptr, T);
}
DEV void conv_sc_phase(int gtid, int gthreads, bf16_t* scb, const bf16_t* cx, const float* w) {
    for (int i = gtid; i < T * 64; i += gthreads) {
        const int c8 = (i & 63) * 8, t = i >> 6, tl = t & (S - 1);
        const size_t o = (size_t)t * 512 + c8;
        const u32x4 z = {0u, 0u, 0u, 0u};
        const u32x4 x2 = *(const u32x4*)(cx + o), x1 = tl >= 1 ? *(const u32x4*)(cx + o - 512) : z, x0 = tl >= 2 ? *(const u32x4*)(cx + o - 1024) : z, bb = *(const u32x4*)(scb + o);
        const f32x4 w0a = *(const f32x4*)(w + c8), w0b = *(const f32x4*)(w + c8 + 4), w1a = *(const f32x4*)(w + 512 + c8), w1b = *(const f32x4*)(w + 512 + c8 + 4), w2a = *(const f32x4*)(w + 1024 + c8), w2b = *(const f32x4*)(w + 1024 + c8 + 4);
        float r[8];
#define CONV1(k, W0, W1, W2, X0, X1, X2, BBv, F) r[k] = F(BBv) * (W0 * F(X0) + W1 * F(X1) + W2 * F(X2))
        CONV1(0, w0a.x, w1a.x, w2a.x, x0.x, x1.x, x2.x, bb.x, bflo); CONV1(1, w0a.y, w1a.y, w2a.y, x0.x, x1.x, x2.x, bb.x, bfhi);
        CONV1(2, w0a.z, w1a.z, w2a.z, x0.y, x1.y, x2.y, bb.y, bflo); CONV1(3, w0a.w, w1a.w, w2a.w, x0.y, x1.y, x2.y, bb.y, bfhi);
        CONV1(4, w0b.x, w1b.x, w2b.x, x0.z, x1.z, x2.z, bb.z, bflo); CONV1(5, w0b.y, w1b.y, w2b.y, x0.z, x1.z, x2.z, bb.z, bfhi);
        CONV1(6, w0b.z, w1b.z, w2b.z, x0.w, x1.w, x2.w, bb.w, bflo); CONV1(7, w0b.w, w1b.w, w2b.w, x0.w, x1.w, x2.w, bb.w, bfhi);
#undef CONV1
        u32x4 ov; ov.x = pk2(r[0], r[1]); ov.y = pk2(r[2], r[3]); ov.z = pk2(r[4], r[5]); ov.w = pk2(r[6], r[7]);
        *(u32x4*)(scb + o) = ov;
    }
}
DEV float gelu_t(float a) { return a * __builtin_amdgcn_rcpf(1.f + __builtin_amdgcn_exp2f(-1.5957691216057308f * LOG2E * (a + 0.044715f * a * a * a))); }
DEV void ffn_mid_phase(int gtid, int gthreads, const bf16_t* fa, bf16_t* fu, const float* cw, const float* cb) {
    constexpr int C8 = DFF / 8;
    for (int i = gtid; i < T * C8; i += gthreads) {
        const int t = i / C8, c8 = (i - t * C8) * 8, tl = t & (S - 1);
        const size_t o = (size_t)t * DFF + c8;
        const u32x4 z = {0u, 0u, 0u, 0u};
        const u32x4 x2 = *(const u32x4*)(fa + o), x1 = tl >= 1 ? *(const u32x4*)(fa + o - DFF) : z, x0 = tl >= 2 ? *(const u32x4*)(fa + o - 2 * DFF) : z, uu = *(const u32x4*)(fu + o);
        const f32x4 w0a = *(const f32x4*)(cw + c8), w0b = *(const f32x4*)(cw + c8 + 4), w1a = *(const f32x4*)(cw + DFF + c8), w1b = *(const f32x4*)(cw + DFF + c8 + 4), w2a = *(const f32x4*)(cw + 2 * DFF + c8), w2b = *(const f32x4*)(cw + 2 * DFF + c8 + 4);
        const f32x4 ba = *(const f32x4*)(cb + c8), bb = *(const f32x4*)(cb + c8 + 4);
        float r[8];
#define FM1(k, B0, W0, W1, W2, X0, X1, X2, Uv, F) r[k] = gelu_t(B0 + W0 * F(X0) + W1 * F(X1) + W2 * F(X2)) * F(Uv)
        FM1(0, ba.x, w0a.x, w1a.x, w2a.x, x0.x, x1.x, x2.x, uu.x, bflo); FM1(1, ba.y, w0a.y, w1a.y, w2a.y, x0.x, x1.x, x2.x, uu.x, bfhi);
        FM1(2, ba.z, w0a.z, w1a.z, w2a.z, x0.y, x1.y, x2.y, uu.y, bflo); FM1(3, ba.w, w0a.w, w1a.w, w2a.w, x0.y, x1.y, x2.y, uu.y, bfhi);
        FM1(4, bb.x, w0b.x, w1b.x, w2b.x, x0.z, x1.z, x2.z, uu.z, bflo); FM1(5, bb.y, w0b.y, w1b.y, w2b.y, x0.z, x1.z, x2.z, uu.z, bfhi);
        FM1(6, bb.z, w0b.z, w1b.z, w2b.z, x0.w, x1.w, x2.w, uu.w, bflo); FM1(7, bb.w, w0b.w, w1b.w, w2b.w, x0.w, x1.w, x2.w, uu.w, bfhi);
#undef FM1
        u32x4 ov; ov.x = pk2(r[0], r[1]); ov.y = pk2(r[2], r[3]); ov.z = pk2(r[4], r[5]); ov.w = pk2(r[6], r[7]);
        *(u32x4*)(fu + o) = ov;
    }
}

typedef short s16x4 __attribute__((ext_vector_type(4)));
DEV s16x4 vtr(const LAS unsigned char* p) { return __builtin_bit_cast(s16x4, __builtin_amdgcn_ds_read_tr16_b64_v4i16((LAS s16x4*)p)); }
DEV bf16x8 cat8(const s16x4 a, const s16x4 b) { return (bf16x8){a[0], a[1], a[2], a[3], b[0], b[1], b[2], b[3]}; }
DEV bf16x8 pk8(float a0, float a1, float a2, float a3, float a4, float a5, float a6, float a7) {
    u32x4 w; w.x = pk2(a0, a1); w.y = pk2(a2, a3); w.z = pk2(a4, a5); w.w = pk2(a6, a7); return __builtin_bit_cast(bf16x8, w); }
constexpr int VPITCH = 192;
DEV void pv_tile(f32x16& o0, f32x16& o1, const LAS unsigned char* vt, int lane, const bf16x8 (&pk)[4]) {
    const int hi = lane >> 5;
    const LAS unsigned char* vb = vt + (4 * hi + ((lane & 15) >> 2)) * VPITCH + ((lane >> 4) & 1) * 32 + (lane & 3) * 8;
#pragma unroll
    for (int ks = 0; ks < 4; ++ks) {
        const bf16x8 va = cat8(vtr(vb + (16 * ks) * VPITCH), vtr(vb + (16 * ks + 8) * VPITCH));
        const bf16x8 vb2 = cat8(vtr(vb + (16 * ks) * VPITCH + 64), vtr(vb + (16 * ks + 8) * VPITCH + 64));
        o0 = __builtin_amdgcn_mfma_f32_32x32x16_bf16(va, pk[ks], o0, 0, 0, 0);
        o1 = __builtin_amdgcn_mfma_f32_32x32x16_bf16(vb2, pk[ks], o1, 0, 0, 0);
    }
}
DEV void store_ot(bf16_t* orow, const f32x16& o0, const f32x16& o1, int hi, float sc) {
#pragma unroll
    for (int g4 = 0; g4 < 4; ++g4) {
        u32x2 a; a.x = pk2(o0[4 * g4] * sc, o0[4 * g4 + 1] * sc); a.y = pk2(o0[4 * g4 + 2] * sc, o0[4 * g4 + 3] * sc);
        u32x2 b; b.x = pk2(o1[4 * g4] * sc, o1[4 * g4 + 1] * sc); b.y = pk2(o1[4 * g4 + 2] * sc, o1[4 * g4 + 3] * sc);
        *(u32x2*)(orow + 8 * g4 + 4 * hi) = a; *(u32x2*)(orow + 32 + 8 * g4 + 4 * hi) = b;
    }
}

DEV void sb_item(LAS unsigned char* vl, const bf16_t* Q, const bf16_t* Kk, const bf16_t* V, bf16_t* O, int b, int h, int qb, int lane) {
    const int r32 = lane & 31, hi = lane >> 5, t0 = 32 * qb, t = t0 + r32; const size_t rowb = (size_t)b * S;
    bf16x8 qr[4]; { const bf16_t* qp = Q + (rowb + t0 + r32) * 512 + h * 64 + 8 * hi;
#pragma unroll
        for (int d0 = 0; d0 < 4; ++d0) qr[d0] = *(const bf16x8*)(qp + 16 * d0); }
    f32x16 o0, o1;
#pragma unroll
    for (int r = 0; r < 16; ++r) { o0[r] = 0.f; o1[r] = 0.f; }
    float carry = 1.f;
    const int c_hi = (t0 + 30) >> 6;
#pragma unroll 1
    for (int c = c_hi; c >= 0; --c) {
        const bf16_t* kp = Kk + (rowb + 64 * c + r32) * 512 + h * 64 + 8 * hi;
        bf16x8 k0[4], k1[4];
#pragma unroll
        for (int d0 = 0; d0 < 4; ++d0) { k0[d0] = *(const bf16x8*)(kp + 16 * d0); k1[d0] = *(const bf16x8*)(kp + (size_t)32 * 512 + 16 * d0); }
#pragma unroll
        for (int j = 0; j < 8; ++j) { const int row = (lane >> 3) + 8 * j; *(LAS u32x4*)(vl + row * VPITCH + (lane & 7) * 16) = *(const u32x4*)(V + (rowb + 64 * c + row) * 512 + h * 64 + (lane & 7) * 8); }
        f32x16 p0, p1;
#pragma unroll
        for (int r = 0; r < 16; ++r) { p0[r] = 0.f; p1[r] = 0.f; }
#pragma unroll
        for (int d0 = 0; d0 < 4; ++d0) { p0 = __builtin_amdgcn_mfma_f32_32x32x16_bf16(k0[d0], qr[d0], p0, 0, 0, 0); p1 = __builtin_amdgcn_mfma_f32_32x32x16_bf16(k1[d0], qr[d0], p1, 0, 0, 0); }
        float u[32];
        const bool diag = (c == c_hi);
#pragma unroll
        for (int e = 0; e < 32; ++e) {
            const float z = e < 16 ? p0[e] : p1[e - 16];
            float uu = __builtin_amdgcn_rcpf(1.f + __builtin_amdgcn_exp2f(fminf(z, 126.f)));
            if (diag) { const int kv = 64 * c + 8 * ((e >> 2) & 3) + 4 * hi + (e & 3) + 32 * (e >> 4); if (kv >= t) uu = 1.f; }
            u[e] = uu;
        }
        float gl[8], gh[8];
#pragma unroll
        for (int i = 0; i < 8; ++i) { const float gp = (u[4 * i] * u[4 * i + 1]) * (u[4 * i + 2] * u[4 * i + 3]);
            const auto rr = __builtin_amdgcn_permlane32_swap(__float_as_uint(gp), __float_as_uint(gp), false, false); gl[i] = __uint_as_float(rr[0]); gh[i] = __uint_as_float(rr[1]); }
        float ag[8]; float run = carry;
#pragma unroll
        for (int i = 7; i >= 0; --i) { const float a_hi = run; run *= gh[i]; const float a_lo = run; run *= gl[i]; ag[i] = hi ? a_hi : a_lo; }
        carry = run;
        bf16x8 pk[4];
#pragma unroll
        for (int ks = 0; ks < 4; ++ks) { float w[8];
#pragma unroll
            for (int g = 0; g < 2; ++g) { const int i = 2 * ks + g;
                const float a3 = ag[i], a2 = a3 * u[4 * i + 3], a1 = a2 * u[4 * i + 2], a0 = a1 * u[4 * i + 1];
                w[4 * g] = (1.f - u[4 * i]) * a0; w[4 * g + 1] = (1.f - u[4 * i + 1]) * a1; w[4 * g + 2] = (1.f - u[4 * i + 2]) * a2; w[4 * g + 3] = (1.f - u[4 * i + 3]) * a3; }
            pk[ks] = pk8(w[0], w[1], w[2], w[3], w[4], w[5], w[6], w[7]); }
        pv_tile(o0, o1, vl, lane, pk);
        if (__all(carry < 7.8e-31f)) break;
    }
    store_ot(O + (rowb + t0 + r32) * 512 + h * 64, o0, o1, hi, 1.f);
}
DEV void sb_phase(const WaveId& W, LAS unsigned char* lds, unsigned char* ws) {
    LAS unsigned char* vl = lds + W.wave * 12288;
    const bf16_t* Q = (const bf16_t*)(ws + WS_QA); const bf16_t* Kk = (const bf16_t*)(ws + WS_KA); const bf16_t* V = (const bf16_t*)(ws + WS_VA);
    constexpr int NITEM = NB * 8 * (S / 32);
    for (int it = W.gw; it < NITEM; it += W.ngw) {
        const int qb = it & 255, h = (it >> 8) & 7, b = it >> 11;
        sb_item(vl, Q, Kk, V, (bf16_t*)(ws + WS_QA), b, h, qb, W.lane);
    }
}

constexpr int IDX_CTL_OFF = 131072 + 1024;
DEV unsigned fkey2(float v) { v += 0.f; const unsigned u = __float_as_uint(v); return (u & 0x80000000u) ? ~u : (u | 0x80000000u); }
DEV void idx_unit(LAS unsigned char* lds, const bf16_t* IQ, const bf16_t* IK, const float* IWp, unsigned* BM, int b, int t0, int wid, int lane) {
    const int r32 = lane & 31, hh = lane >> 5; const size_t rowb = (size_t)b * S;
    LAS unsigned* cntbuf = (LAS unsigned*)(lds + IDX_CTL_OFF);
    LAS unsigned* eqc = (LAS unsigned*)(lds + IDX_CTL_OFF + 1024);
    bf16x8 afr[4]; { const int qi = 2 * (r32 >> 4) + ((r32 >> 2) & 1), head = (r32 & 3) + 4 * ((r32 >> 3) & 1);
        const bf16_t* ap = IQ + (rowb + t0 + qi) * 512 + head * 64 + 8 * hh;
#pragma unroll
        for (int ks = 0; ks < 4; ++ks) afr[ks] = *(const bf16x8*)(ap + 16 * ks); }
    float w[16];
#pragma unroll
    for (int r = 0; r < 16; ++r) w[r] = IWp[(rowb + t0 + 2 * (r >> 3) + hh) * 8 + (r & 7)];
    const int tmax = t0 + 3;
    LAS unsigned* SCO = (LAS unsigned*)lds;
    bf16x8 bcur[4], bnxt[4];
    { const bf16_t* bp = IK + (rowb + 32 * wid + r32) * 64 + 8 * hh;
#pragma unroll
      for (int ks = 0; ks < 4; ++ks) { bcur[ks] = *(const bf16x8*)(bp + 16 * ks); bnxt[ks] = bcur[ks]; } }
#pragma unroll 1
    for (int j = wid; 32 * j <= tmax; j += 8) {
        if (32 * (j + 8) <= tmax) { const bf16_t* bp = IK + (rowb + 32 * (j + 8) + r32) * 64 + 8 * hh;
#pragma unroll
            for (int ks = 0; ks < 4; ++ks) bnxt[ks] = *(const bf16x8*)(bp + 16 * ks); }
        f32x16 acc;
#pragma unroll
        for (int r = 0; r < 16; ++r) acc[r] = 0.f;
#pragma unroll
        for (int ks = 0; ks < 4; ++ks) acc = __builtin_amdgcn_mfma_f32_32x32x16_bf16(afr[ks], bcur[ks], acc, 0, 0, 0);
        float s0 = 0.f, s1 = 0.f;
#pragma unroll
        for (int hd = 0; hd < 8; ++hd) { s0 += w[hd] * fmaxf(acc[hd], 0.f); s1 += w[8 + hd] * fmaxf(acc[8 + hd], 0.f); }
        const int key = 32 * j + r32;
        SCO[hh * 8192 + key] = key <= t0 + hh ? fkey2(s0) : 0u;
        SCO[(2 + hh) * 8192 + key] = key <= t0 + 2 + hh ? fkey2(s1) : 0u;
#pragma unroll
        for (int ks = 0; ks < 4; ++ks) bcur[ks] = bnxt[ks];
    }
    unsigned sc[32][2];
#pragma unroll
    for (int s = 0; s < 32; ++s) { const int j = wid + 8 * s; const bool v = 32 * j <= tmax;
        sc[s][0] = v ? SCO[hh * 8192 + 32 * j + r32] : 0u; sc[s][1] = v ? SCO[(2 + hh) * 8192 + 32 * j + r32] : 0u; }
    unsigned lo[4], hiK[4], chi[4], xgt[4], xeq[4], mt[4]; bool done[4];
#pragma unroll
    for (int q = 0; q < 4; ++q) { lo[q] = 1u; hiK[q] = 0xffffffffu; chi[q] = 0u; xeq[q] = 0u; mt[q] = 0u; xgt[q] = 1u; done[q] = (t0 + q + 1) <= 256; }
    int par = 0;
#pragma unroll 1
    for (int pass = 0; pass < 40; ++pass) {
        if (done[0] && done[1] && done[2] && done[3]) break;
        unsigned cand[4];
#pragma unroll
        for (int q = 0; q < 4; ++q) cand[q] = lo[q] + ((hiK[q] - lo[q]) >> 1);
        const unsigned c0 = hh ? cand[1] : cand[0], c1 = hh ? cand[3] : cand[2];
        unsigned n0 = 0, n1 = 0;
#pragma unroll
        for (int s = 0; s < 32; ++s) { n0 += sc[s][0] >= c0; n1 += sc[s][1] >= c1; }
#pragma unroll
        for (int o = 1; o < 32; o <<= 1) { n0 += __shfl_xor(n0, o); n1 += __shfl_xor(n1, o); }
        if (r32 == 0) { cntbuf[(par * 8 + wid) * 4 + hh] = n0; cntbuf[(par * 8 + wid) * 4 + 2 + hh] = n1; }
        LDS_WAIT(); __builtin_amdgcn_s_barrier(); asm volatile("" ::: "memory");
        unsigned tot[4] = {0u, 0u, 0u, 0u};
#pragma unroll
        for (int wv = 0; wv < 8; ++wv) { const u32x4 v = *(const LAS u32x4*)(cntbuf + (par * 8 + wv) * 4); tot[0] += v.x; tot[1] += v.y; tot[2] += v.z; tot[3] += v.w; }
        par ^= 1;
#pragma unroll
        for (int q = 0; q < 4; ++q) if (!done[q]) {
            if (tot[q] == 256u) { xgt[q] = cand[q]; mt[q] = 0u; done[q] = true; }
            else { if (tot[q] > 256u) lo[q] = cand[q]; else { hiK[q] = cand[q]; chi[q] = tot[q]; }
                   if (hiK[q] - lo[q] == 1u) { xgt[q] = hiK[q]; xeq[q] = lo[q]; mt[q] = 256u - chi[q]; done[q] = true; } }
        }
    }
    const unsigned xg0 = hh ? xgt[1] : xgt[0], xg1 = hh ? xgt[3] : xgt[2], xe0 = hh ? xeq[1] : xeq[0], xe1 = hh ? xeq[3] : xeq[2], m0 = hh ? mt[1] : mt[0], m1 = hh ? mt[3] : mt[2];
    const bool ties = (mt[0] | mt[1] | mt[2] | mt[3]) != 0u;
    if (ties) {
        __builtin_amdgcn_s_barrier();
#pragma unroll
        for (int s = 0; s < 32; ++s) { const int j = wid + 8 * s;
            const unsigned long long e0 = __ballot(sc[s][0] == xe0 && m0 != 0u), e1 = __ballot(sc[s][1] == xe1 && m1 != 0u);
            if (lane == 0) { eqc[0 * 256 + j] = __popc((unsigned)e0); eqc[1 * 256 + j] = __popc((unsigned)(e0 >> 32)); eqc[2 * 256 + j] = __popc((unsigned)e1); eqc[3 * 256 + j] = __popc((unsigned)(e1 >> 32)); } }
        LDS_WAIT(); __builtin_amdgcn_s_barrier(); asm volatile("" ::: "memory");
        if (wid < 4) { unsigned v[4], s4 = 0;
#pragma unroll
            for (int i = 0; i < 4; ++i) { v[i] = eqc[wid * 256 + 4 * lane + i]; s4 += v[i]; }
            unsigned inc = s4;
#pragma unroll
            for (int o = 1; o < 64; o <<= 1) { const unsigned tv = __shfl_up(inc, o); if (lane >= o) inc += tv; }
            unsigned run = inc - s4;
#pragma unroll
            for (int i = 0; i < 4; ++i) { eqc[wid * 256 + 4 * lane + i] = run; run += v[i]; } }
        LDS_WAIT(); __builtin_amdgcn_s_barrier(); asm volatile("" ::: "memory");
    }
    const unsigned lower = (1u << r32) - 1u;
#pragma unroll
    for (int s = 0; s < 32; ++s) { const int j = wid + 8 * s;
        bool s0 = sc[s][0] >= xg0, s1 = sc[s][1] >= xg1;
        if (ties) {
            const unsigned long long e0 = __ballot(sc[s][0] == xe0 && m0 != 0u), e1 = __ballot(sc[s][1] == xe1 && m1 != 0u);
            const unsigned h0 = hh ? (unsigned)(e0 >> 32) : (unsigned)e0, h1 = hh ? (unsigned)(e1 >> 32) : (unsigned)e1;
            const unsigned rk0 = eqc[hh * 256 + j] + __popc(h0 & lower), rk1 = eqc[(2 + hh) * 256 + j] + __popc(h1 & lower);
            s0 = s0 || (sc[s][0] == xe0 && rk0 < m0); s1 = s1 || (sc[s][1] == xe1 && rk1 < m1);
        }
        const unsigned long long b0 = __ballot(s0), b1 = __ballot(s1);
        if (lane == 0) { u32x4 o; o.x = (unsigned)b0; o.y = (unsigned)(b0 >> 32); o.z = (unsigned)b1; o.w = (unsigned)(b1 >> 32); *(u32x4*)(BM + ((size_t)b * 256 + j) * S + t0) = o; }
    }
    __builtin_amdgcn_s_barrier();
}
DEV void idx_phase(LAS unsigned char* lds, unsigned char* ws, int vcu, int G, int wid, int lane) {
    constexpr int NUNIT = T / 4;
    for (int un = vcu; un < NUNIT; un += G) {
        const int b = un / (S / 4), t0 = (un - b * (S / 4)) * 4;
        idx_unit(lds, (const bf16_t*)(ws + WS_IQ), (const bf16_t*)(ws + WS_IK), (const float*)(ws + WS_IW), (unsigned*)(ws + WS_BM), b, t0, wid, lane);
    }
}

constexpr int DSA_KOFF = 0, DSA_VOFF = 2 * 8192, DSA_STAGE = 8192 + 64 * VPITCH;
DEV void dsa_unit(LAS unsigned char* lds, const bf16_t* Q, const bf16_t* Kk, const bf16_t* V, const unsigned* BM, bf16_t* O, int b, int h, int qblk, int tid, int wid, int lane) {
    const int r32 = lane & 31, hi = lane >> 5, q0 = 256 * qblk, t0 = q0 + 32 * wid, t = t0 + r32; const size_t rowb = (size_t)b * S;
    bf16x8 qr[4]; { const bf16_t* qp = Q + (rowb + t) * 512 + h * 64 + 8 * hi;
#pragma unroll
        for (int d0 = 0; d0 < 4; ++d0) qr[d0] = *(const bf16x8*)(qp + 16 * d0); }
    f32x16 o0, o1;
#pragma unroll
    for (int r = 0; r < 16; ++r) { o0[r] = 0.f; o1[r] = 0.f; }
    float mrow = -INFINITY, lsum = 0.f;
    const int ntile = (q0 + 256) / 64, wlast = (t0 + 31) >> 6;
    const int srow = tid >> 3, sch = tid & 7;
    const bf16_t* kg = Kk + (rowb + srow) * 512 + h * 64 + sch * 8; const bf16_t* vg = V + (rowb + srow) * 512 + h * 64 + sch * 8;
    const int kdst = srow * 128 + ((sch ^ (srow & 7)) * 16), vdst = srow * VPITCH + sch * 16;
    u32x4 kreg = *(const u32x4*)kg, vreg = *(const u32x4*)vg;
    *(LAS u32x4*)(lds + kdst) = kreg; *(LAS u32x4*)(lds + 8192 + vdst) = vreg;
    const unsigned* bmp = BM + (size_t)b * 256 * S + t;
    unsigned mw0 = bmp[0], mw1 = bmp[(size_t)S];
    __syncthreads();
#pragma unroll 1
    for (int c = 0; c < ntile; ++c) {
        const LAS unsigned char* kt = lds + (c & 1) * DSA_STAGE; const LAS unsigned char* vt = kt + 8192;
        if (c + 1 < ntile) { kreg = *(const u32x4*)(kg + (size_t)(c + 1) * 64 * 512); vreg = *(const u32x4*)(vg + (size_t)(c + 1) * 64 * 512); }
        unsigned nw0 = 0u, nw1 = 0u;
        if (c + 1 <= wlast) { nw0 = bmp[(size_t)(2 * c + 2) * S]; nw1 = bmp[(size_t)(2 * c + 3) * S]; }
        if (c <= wlast) {
            f32x16 p0, p1;
#pragma unroll
            for (int r = 0; r < 16; ++r) { p0[r] = 0.f; p1[r] = 0.f; }
#pragma unroll
            for (int d0 = 0; d0 < 4; ++d0) {
                const int ch = 2 * d0 + hi;
                const bf16x8 ka = *(const LAS bf16x8*)(kt + r32 * 128 + ((ch ^ (r32 & 7)) * 16));
                const bf16x8 kb = *(const LAS bf16x8*)(kt + (32 + r32) * 128 + ((ch ^ (r32 & 7)) * 16));
                p0 = __builtin_amdgcn_mfma_f32_32x32x16_bf16(ka, qr[d0], p0, 0, 0, 0);
                p1 = __builtin_amdgcn_mfma_f32_32x32x16_bf16(kb, qr[d0], p1, 0, 0, 0);
            }
            const unsigned m0 = mw0 >> (4 * hi), m1 = mw1 >> (4 * hi);
            float tmax = -INFINITY;
#pragma unroll
            for (int r = 0; r < 16; ++r) { const int bit = (r & 3) + 8 * (r >> 2);
                p0[r] = ((m0 >> bit) & 1u) ? p0[r] : -INFINITY; p1[r] = ((m1 >> bit) & 1u) ? p1[r] : -INFINITY;
                tmax = fmaxf(tmax, fmaxf(p0[r], p1[r])); }
            { const auto rr = __builtin_amdgcn_permlane32_swap(__float_as_uint(tmax), __float_as_uint(tmax), false, false); tmax = fmaxf(__uint_as_float(rr[0]), __uint_as_float(rr[1])); }
            const float mnew = fmaxf(mrow, tmax);
            const float muse = mnew == -INFINITY ? 0.f : mnew;
            if (!__all(mnew == mrow)) {
                const float alpha = __builtin_amdgcn_exp2f(mrow - muse);
                lsum *= alpha;
#pragma unroll
                for (int r = 0; r < 16; ++r) { o0[r] *= alpha; o1[r] *= alpha; }
                mrow = mnew;
            }
            float ps = 0.f;
#pragma unroll
            for (int r = 0; r < 16; ++r) { p0[r] = __builtin_amdgcn_exp2f(p0[r] - muse); p1[r] = __builtin_amdgcn_exp2f(p1[r] - muse); ps += p0[r] + p1[r]; }
            lsum += ps;
            bf16x8 pk[4];
            pk[0] = pk8(p0[0], p0[1], p0[2], p0[3], p0[4], p0[5], p0[6], p0[7]); pk[1] = pk8(p0[8], p0[9], p0[10], p0[11], p0[12], p0[13], p0[14], p0[15]);
            pk[2] = pk8(p1[0], p1[1], p1[2], p1[3], p1[4], p1[5], p1[6], p1[7]); pk[3] = pk8(p1[8], p1[9], p1[10], p1[11], p1[12], p1[13], p1[14], p1[15]);
            pv_tile(o0, o1, vt, lane, pk);
        }
        mw0 = nw0; mw1 = nw1;
        if (c + 1 < ntile) { LAS unsigned char* nb = lds + ((c + 1) & 1) * DSA_STAGE; *(LAS u32x4*)(nb + kdst) = kreg; *(LAS u32x4*)(nb + 8192 + vdst) = vreg; }
        __syncthreads();
    }
    { const auto rr = __builtin_amdgcn_permlane32_swap(__float_as_uint(lsum), __float_as_uint(lsum), false, false); lsum = __uint_as_float(rr[0]) + __uint_as_float(rr[1]); }
    store_ot(O + (rowb + t) * 512 + h * 64, o0, o1, hi, 1.f / lsum);
}
DEV void dsa_phase(LAS unsigned char* lds, unsigned char* ws, int vcu, int G, int tid, int wid, int lane) {
    constexpr int NPAIR = NB * 8 * 16;
    for (int pr = vcu; pr < NPAIR; pr += G) {
        const int bh = pr >> 4, s = pr & 15, b = bh >> 3, h = bh & 7;
#pragma unroll 1
        for (int k = 0; k < 2; ++k) {
            const int qblk = k == 0 ? s : 31 - s;
            dsa_unit(lds, (const bf16_t*)(ws + WS_QC), (const bf16_t*)(ws + WS_KC), (const bf16_t*)(ws + WS_VC), (const unsigned*)(ws + WS_BM), (bf16_t*)(ws + WS_QC), b, h, qblk, tid, wid, lane);
        }
    }
}
constexpr int MK_THREADS = 512;
constexpr int RING_BYTES = 131072, MISC_OFF = RING_BYTES + 320, MK_LDS_BYTES = 147456;
constexpr size_t WS_CTL = 0, CTL_ZERO_BYTES = 65536; constexpr int CW_BAR = 4096;
constexpr int PH_PREP0 = 0, PH_KV = 1, PH_GH = 2, PH_L0 = 3, PH_PER_LAYER = 14, NPH = PH_L0 + 2 * PH_PER_LAYER;
enum { Q_INPROJ = 0, Q_SBIDX, Q_DSA, Q_GATES, Q_MERGE, Q_MIX, Q_NORMXA, Q_XALOG, Q_XAOUT, Q_NORMFFN, Q_UP, Q_FFNMID, Q_DOWN, Q_NEXT };

#ifndef QBUILD
#define QBUILD 0xffffu
#endif
#define QON(x) ((QBUILD >> (x)) & 1u)
struct Args { const float* in[20]; float* out; unsigned char* ws; int ph_lo, ph_hi; };

__global__ void __launch_bounds__(MK_THREADS, 2) mk_fwd(Args args) {
    __shared__ __attribute__((aligned(16))) unsigned char lds_raw[MK_LDS_BYTES];
    LAS unsigned char* lds = (LAS unsigned char*)lds_raw;
    volatile LAS unsigned* MISC = (volatile LAS unsigned*)(lds + MISC_OFF);
    const int G = gridDim.x, bx = blockIdx.x;
    unsigned char* ws0 = args.ws;
    for (int u = threadIdx.x; u < (MK_LDS_BYTES - RING_BYTES) / 4; u += MK_THREADS) ((LAS unsigned*)(lds + RING_BYTES))[u] = 0u;
    __syncthreads();
    const int lo = args.ph_lo, hi = args.ph_hi;
    XcdBarrier bar; bar.bar = (unsigned*)(ws0 + WS_CTL) + CW_BAR; bar.x = 0; bar.st = nullptr;
    if (hi - lo > 1) bar = xcd_barrier_post((unsigned*)(ws0 + WS_CTL) + CW_BAR, MISC + 8);
#define BPW(off) ((bf16_t*)(ws + (off)))
    const int vcu = (G % 8 == 0) ? (bx % 8) * (G / 8) + bx / 8 : bx;
    for (int p = lo; p < hi; ++p) {
        int oz = 0; asm volatile("" : "+s"(oz));
        int tid = threadIdx.x; asm volatile("" : "+v"(tid));
        const int wave = __builtin_amdgcn_readfirstlane(tid >> 6), lane = tid & 63;
        WaveId W; W.gw = vcu * 8 + wave; W.ngw = G * 8; W.wave = wave; W.lane = lane;
        unsigned char* ws = args.ws + oz; float* X = args.out + oz;
#define INP(k) (args.in[(k) + oz])
        if (p == PH_PREP0) {
            prep0_phase(W, (LAS float*)(lds + wave * 16384), ws, args.in + oz);
        } else if (p == PH_KV && QON(14)) {
            pg8::Order S; S.init(2, 8, 2, G, bx);
            pg8::PtrStd P{(const char*)(ws + WS_MEMN), (const char*)(ws + WS_WKVT), 1 * MiB, 4 * MiB, 0, (size_t)256 * D * 2, (size_t)256 * D * 2};
            pg8::EpiPrep E{ws, 0};
            pg8::gemm_phase<pg8::EpiPrep, pg8::PtrStd, true, true>(lds, D, D, D, S, P, E);
        } else if (p == PH_GH && QON(15)) {
            { pg8::Order S; S.init(1, 4, 16, G, bx); pg8::PtrG P{(const char*)(ws + WS_KVM), (const char*)(ws + WS_WQ)}; pg8::EpiPrep E{ws, 1};
              pg8::gemm_phase<pg8::EpiPrep, pg8::PtrG, true, true>(lds, 2 * D, D, 256, S, P, E); }
            { pg8::Order S; S.init(4, 1, 16, G, (bx + 64) % G); pg8::PtrH P{(const char*)(ws + WS_KVM), (const char*)(ws + WS_WOT)}; pg8::EpiPrep E{ws, 2};
              pg8::gemm_phase<pg8::EpiPrep, pg8::PtrH, true, true>(lds, D, 2 * D, 256, S, P, E); }
        } else if (p >= PH_L0) {
            const int l = (p - PH_L0) / PH_PER_LAYER, q = (p - PH_L0) % PH_PER_LAYER;
            const float* Xin = l == 0 ? INP(0) : X;
            if (q == Q_SBIDX) {
#ifndef NO_SB
                sb_phase(W, lds, ws);
#endif
                __syncthreads();
#ifndef NO_IDX
                idx_phase(lds, ws, vcu, G, wave, lane);
#endif
                conv_sc_phase(vcu * MK_THREADS + tid, G * MK_THREADS, BPW(WS_SCB), BPW(WS_CX), INP(4) + l * 3 * 512);
            } else if (q == Q_DSA) {
#ifndef NO_DSA
                dsa_phase(lds, ws, vcu, G, tid, wave, lane);
#endif
            } else if (q == Q_NORMXA) {
                norm_rows(W, X, INP(9) + l * D, BPW(WS_XN), nullptr, T);
            } else if (q == Q_NORMFFN) {
                norm_rows(W, X, INP(14) + l * D, BPW(WS_XN), nullptr, T);
            } else if (q == Q_FFNMID) {
                ffn_mid_phase(vcu * MK_THREADS + tid, G * MK_THREADS, BPW(WS_FA), BPW(WS_FU), INP(16) + l * 3 * DFF, INP(17) + l * DFF);
            } else if (q == Q_NEXT) {
                if (l + 1 < DEPTH) { int base = 0; convert_layer_weights(W, (LAS float*)(lds + wave * 16384), base, ws, args.in + oz, l + 1); norm_rows(W, X, INP(2) + (l + 1) * D, BPW(WS_XN), nullptr, T); }
                else norm_rows(W, X, INP(19), nullptr, X, T);
            } else if (q == Q_INPROJ && QON(Q_INPROJ)) {
                pg8::Order S; S.init(T / 256, NIN / 256, 1, G, bx);
                pg8::PtrStd P{(const char*)(ws + WS_XN), (const char*)(ws + WS_WIN), 0, 0, 0, (size_t)256 * D * 2, (size_t)256 * D * 2};
                pg8::EpiInProj E{ws};
                pg8::gemm_phase<pg8::EpiInProj, pg8::PtrStd, true, true>(lds, D, D, D, S, P, E);
            } else if (q == Q_GATES && QON(Q_GATES)) {
                pg8::Order S; S.init(T / 256, 12, 1, G, bx);
                pg8::PtrStd P{(const char*)(ws + WS_XN), (const char*)(ws + WS_WG), 0, 0, 0, (size_t)256 * D * 2, (size_t)256 * D * 2};
                pg8::EpiGates E{BPW(WS_GATES)};
                pg8::gemm_phase<pg8::EpiGates, pg8::PtrStd, true, true>(lds, D, D, D, S, P, E);
            } else if (q == Q_MERGE && QON(Q_MERGE)) {
                pg8::Order S; S.init(T / 256, 4, 3, G, bx);
                pg8::PtrStd P{(const char*)(ws + WS_QA), (const char*)(ws + WS_WBR), 16 * MiB, (size_t)D * 512 * 2, 0, (size_t)256 * 512 * 2, (size_t)256 * 512 * 2};
                pg8::EpiMerge E{BPW(WS_XN), BPW(WS_GATES)};
                pg8::gemm_phase<pg8::EpiMerge, pg8::PtrStd, true, true>(lds, 512, 512, 512, S, P, E);
            } else if (q == Q_MIX && QON(Q_MIX)) {
                pg8::Order S; S.init(T / 256, 4, 1, G, bx);
                pg8::PtrStd P{(const char*)(ws + WS_XN), (const char*)(ws + WS_WMIX), 0, 0, 0, (size_t)256 * D * 2, (size_t)256 * D * 2};
                pg8::EpiResid E{Xin, X};
                pg8::gemm_phase<pg8::EpiResid, pg8::PtrStd, true, true>(lds, D, D, D, S, P, E);
            } else if (q == Q_XALOG && QON(Q_XALOG)) {
                pg8::Order S; S.init(T / 256, 4, 1, G, bx);
                pg8::PtrStd P{(const char*)(ws + WS_XN), (const char*)(ws + WS_GT + (size_t)l * 4 * MiB), 0, 0, 2 * MiB, (size_t)256 * D * 2, (size_t)256 * D * 2};
                pg8::EpiSoftmax E{BPW(WS_PXA)};
                pg8::gemm_phase<pg8::EpiSoftmax, pg8::PtrStd, false, true>(lds, D, D, D, S, P, E);
            } else if (q == Q_XAOUT && QON(Q_XAOUT)) {
                pg8::Order S; S.init(T / 256, 4, 1, G, bx);
                pg8::PtrStd P{(const char*)(ws + WS_PXA), (const char*)(ws + WS_HT + (size_t)l * 4 * MiB), 0, 0, 2 * MiB, (size_t)256 * D * 2, (size_t)256 * D * 2};
                pg8::EpiResid E{X, X};
                pg8::gemm_phase<pg8::EpiResid, pg8::PtrStd, true, true>(lds, D, D, D, S, P, E);
            } else if (q == Q_UP && QON(Q_UP)) {
                pg8::Order S; S.init(T / 256, 22, 1, G, bx);
                pg8::PtrStd P{(const char*)(ws + WS_XN), (const char*)(ws + WS_WUP), 0, 0, 0, (size_t)256 * D * 2, (size_t)256 * D * 2};
                pg8::EpiUp E{BPW(WS_FA), BPW(WS_FU)};
                pg8::gemm_phase<pg8::EpiUp, pg8::PtrStd, true, true>(lds, D, D, D, S, P, E);
            } else if (q == Q_DOWN && QON(Q_DOWN)) {
                pg8::Order S; S.init(T / 256, 4, 1, G, bx);
                pg8::PtrStd P{(const char*)(ws + WS_FU), (const char*)(ws + WS_WDOWN), 0, 0, 0, (size_t)256 * DFF * 2, (size_t)256 * DFF * 2};
                pg8::EpiResid E{X, X};
                pg8::gemm_phase<pg8::EpiResid, pg8::PtrStd, true, true>(lds, DFF, DFF, DFF, S, P, E);
            }
        }
        if (p + 1 < hi) xcd_barrier(bar);
    }
}

template <class Epi> static void gemm(hipStream_t st, const bf16_t* A, int lda, const bf16_t* Bt, int ldb, int M, int N, int K, Epi e) {
    hipLaunchKernelGGL((k_gemm<Epi>), dim3(N / 128, M / 128), dim3(256), 0, st, A, lda, Bt, ldb, K, e);
}
static void tcvt(hipStream_t st, const float* W, int ldw, int K, int col0, int ncols, bf16_t* out, int ldo, int row0) {
    hipLaunchKernelGGL(k_tcvt, dim3((K + 31) / 32, (ncols + 31) / 32), dim3(256), 0, st, W, ldw, K, col0, ncols, out, ldo, row0);
}
#ifndef MK_MASK
#define MK_MASK 0x7fffffffull
#endif
static bool use_mk(int p) {
    if (!((MK_MASK >> p) & 1ull)) return false;
    return true;
}

extern "C" void kernel_launch(void* const* d_in, const int* in_sizes, int n_in, void* d_out, int out_size, void* d_ws, size_t ws_size, hipStream_t st) {
    if (n_in != 20 || ws_size < WS_NEED || out_size != T * D) { fprintf(stderr, "kernel_launch: unexpected sizes n_in %d ws %zu out %d\n", n_in, ws_size, out_size); return; }
    static int grid = 0;
    if (grid == 0) {
        int dev = 0, cus = 0, per_cu = 0;
        hipGetDevice(&dev); hipDeviceGetAttribute(&cus, hipDeviceAttributeMultiprocessorCount, dev);
        if (hipOccupancyMaxActiveBlocksPerMultiprocessor(&per_cu, (const void*)mk_fwd, MK_THREADS, 0) != hipSuccess || per_cu < 1) { fprintf(stderr, "kernel_launch: occupancy query says %d blocks/CU\n", per_cu); grid = -1; return; }
        (void)hipGetLastError();
        if (cus != 256) { fprintf(stderr, "kernel_launch: built for a 256-CU device, found %d\n", cus); grid = -1; return; }
        grid = cus;
    }
    if (grid < 0) return;
    const float* x = (const float*)d_in[0]; const float* mem = (const float*)d_in[1];
    const float* norm_mix = (const float*)d_in[2]; const float* w_in = (const float*)d_in[3]; const float* sc_conv_w = (const float*)d_in[4];
    const float* w_sb_out = (const float*)d_in[5]; const float* w_sc_out = (const float*)d_in[6]; const float* w_dsa_out = (const float*)d_in[7];
    const float* w_mix_o = (const float*)d_in[8]; const float* norm_xa = (const float*)d_in[9]; const float* norm_mem = (const float*)d_in[10];
    const float* w_xa_q = (const float*)d_in[11]; const float* w_xa_kv = (const float*)d_in[12]; const float* w_xa_o = (const float*)d_in[13];
    const float* norm_ffn = (const float*)d_in[14]; const float* w_ffn_in = (const float*)d_in[15]; const float* ffn_conv_w = (const float*)d_in[16];
    const float* ffn_conv_b = (const float*)d_in[17]; const float* w_ffn_down = (const float*)d_in[18]; const float* norm_final = (const float*)d_in[19];
    char* ws = (char*)d_ws; float* X = (float*)d_out;
#define BP(off) ((bf16_t*)(ws + (off)))
    bf16_t *XN = BP(WS_XN), *MERGED = BP(WS_XN), *WUP = BP(WS_WUP), *WDOWN = BP(WS_WDOWN), *WMIX = BP(WS_WMIX), *WBR = BP(WS_WBR), *WG = BP(WS_WG), *WIN = BP(WS_WIN);
    bf16_t *QA = BP(WS_QA), *SCB = BP(WS_SCB), *QC = BP(WS_QC), *KA = BP(WS_KA), *VA = BP(WS_VA), *KC = BP(WS_KC), *VC = BP(WS_VC), *IQ = BP(WS_IQ), *CX = BP(WS_CX), *IK = BP(WS_IK);
    float* IW = (float*)(ws + WS_IW); unsigned* BMK = (unsigned*)(ws + WS_BM); bf16_t* XTMP = BP(WS_XTMP); bf16_t* GATES = BP(WS_GATES);
    float* LOG = (float*)(ws + WS_LOG); bf16_t* PXA = BP(WS_PXA); bf16_t *FA = BP(WS_FA), *FU = BP(WS_FU);

    hipMemsetAsync(ws + WS_CTL, 0, CTL_ZERO_BYTES, st);
    Args a{};
    for (int i = 0; i < 20; ++i) a.in[i] = (const float*)d_in[i];
    a.out = X; a.ws = (unsigned char*)d_ws;
    auto mk = [&](int lo, int hi) { a.ph_lo = lo; a.ph_hi = hi; hipLaunchKernelGGL(mk_fwd, dim3(grid), dim3(MK_THREADS), 0, st, a); };
    auto convert_layer = [&](int l) {
        const float* wi = w_in + (size_t)l * D * DIN;
        tcvt(st, wi, DIN, D, 0, 1536, WIN, D, 0);
        tcvt(st, wi, DIN, D, 3072, 1536, WIN, D, 1536);
        tcvt(st, wi, DIN, D, 4608, 512, WIN, D, 3072);
        tcvt(st, wi, DIN, D, 1536, 512, WIN, D, 3584);
        for (int j = 0; j < 4; ++j) { tcvt(st, wi, DIN, D, 2048 + 128 * j, 128, WIN, D, 4096 + 256 * j); tcvt(st, wi, DIN, D, 2560 + 128 * j, 128, WIN, D, 4096 + 256 * j + 128); }
        tcvt(st, wi, DIN, D, 5120, 72, WIN, D, 5120);
        hipLaunchKernelGGL(k_zero16, dim3(256), dim3(256), 0, st, WIN + (size_t)5192 * D, (size_t)184 * D);
        tcvt(st, wi, DIN, D, 5192, 3072, WG, D, 0);
        tcvt(st, w_sb_out + (size_t)l * 512 * D, D, 512, 0, D, WBR, 512, 0);
        tcvt(st, w_sc_out + (size_t)l * 512 * D, D, 512, 0, D, WBR + (size_t)D * 512, 512, 0);
        tcvt(st, w_dsa_out + (size_t)l * 512 * D, D, 512, 0, D, WBR + (size_t)2 * D * 512, 512, 0);
        tcvt(st, w_mix_o + (size_t)l * D * D, D, D, 0, D, WMIX, D, 0);
        const float* wf = w_ffn_in + (size_t)l * D * 2 * DFF;
        for (int j = 0; j < 22; ++j) { tcvt(st, wf, 2 * DFF, D, 128 * j, 128, WUP, D, 256 * j); tcvt(st, wf, 2 * DFF, D, DFF + 128 * j, 128, WUP, D, 256 * j + 128); }
        tcvt(st, w_ffn_down + (size_t)l * DFF * D, D, DFF, 0, D, WDOWN, DFF, 0);
    };
    for (int p = 0; p < NPH; ++p) {
        if (use_mk(p)) { int e = p + 1; while (e < NPH && use_mk(e) && MK_FUSE) ++e; mk(p, e); p = e - 1; continue; }
        if (p == PH_PREP0) {
            for (int l = 0; l < DEPTH; ++l) {
                hipLaunchKernelGGL(k_cvt, dim3(1024), dim3(256), 0, st, w_xa_q + (size_t)l * D * D, BP(WS_WQ + l * 2 * MiB), (size_t)D * D);
                tcvt(st, w_xa_o + (size_t)l * D * D, D, D, 0, D, BP(WS_WOT + l * 2 * MiB), D, 0);
                tcvt(st, w_xa_kv + (size_t)l * D * 2 * D, 2 * D, D, 0, 2 * D, BP(WS_WKVT + l * 4 * MiB), D, 0);
                hipLaunchKernelGGL(k_rmsnorm, dim3(NB * MEM / 4), dim3(256), 0, st, mem, norm_mem + l * D, BP(WS_MEMN + l * 1 * MiB), (float*)nullptr, NB * MEM);
            }
            convert_layer(0);
            hipLaunchKernelGGL(k_rmsnorm, dim3(T / 4), dim3(256), 0, st, x, norm_mix, XN, (float*)nullptr, T);
        } else if (p == PH_KV) {
            for (int l = 0; l < DEPTH; ++l) gemm(st, BP(WS_MEMN + l * MiB), D, BP(WS_WKVT + l * 4 * MiB), D, NB * MEM, 2 * D, D, EpiBf{BP(WS_KVM + l * 2 * MiB), 2 * D, 1.f});
        } else if (p == PH_GH) {
            for (int l = 0; l < DEPTH; ++l) for (int b = 0; b < NB; ++b) for (int h = 0; h < 4; ++h) {
                bf16_t* KVM = BP(WS_KVM + l * 2 * MiB); bf16_t* GT = BP(WS_GT + (size_t)(l * 2 + b) * 2 * MiB); bf16_t* HT = BP(WS_HT + (size_t)(l * 2 + b) * 2 * MiB);
                gemm(st, KVM + (size_t)b * MEM * 2 * D + h * 256, 2 * D, BP(WS_WQ + l * 2 * MiB) + h * 256, D, 256, D, 256, EpiBf{GT + (size_t)h * 256 * D, D, XSCALE});
                gemm(st, BP(WS_WOT + l * 2 * MiB) + h * 256, D, KVM + (size_t)b * MEM * 2 * D + D + h * 256, 2 * D, D, 256, 256, EpiBf{HT + h * 256, D, 1.f});
            }
        } else {
            const int l = (p - PH_L0) / PH_PER_LAYER, q = (p - PH_L0) % PH_PER_LAYER;
            const float* Xin = l == 0 ? x : X;
            switch (q) {
            case Q_INPROJ: gemm(st, XN, D, WIN, D, T, NIN, D, EpiInProjN{QA, KA, VA, QC, KC, VC, IQ, SCB, CX, XTMP, IK, IW});
                           hipLaunchKernelGGL(k_cxmul, dim3(T * 512 / 256), dim3(256), 0, st, CX, XTMP); break;
            case Q_SBIDX:  hipLaunchKernelGGL(k_conv_sc, dim3(T * 512 / 256), dim3(256), 0, st, SCB, CX, sc_conv_w + l * 3 * 512);
                           hipLaunchKernelGGL(k_sb_naive, dim3(T * 8 / 4), dim3(256), 0, st, QA, KA, VA, QA);
                           hipLaunchKernelGGL(k_index_naive, dim3(T), dim3(256), 0, st, IQ, IK, IW, BMK); break;
            case Q_DSA:    hipLaunchKernelGGL(k_dsa_naive, dim3(T), dim3(512), 0, st, QC, KC, VC, BMK, QC); break;
            case Q_GATES:  gemm(st, XN, D, WG, D, T, 3 * D, D, EpiGatesN{GATES}); break;
            case Q_MERGE:  gemm(st, QA, 512, WBR, 512, T, D, 512, EpiMergeN{MERGED, GATES, 1, 0});
                           gemm(st, SCB, 512, WBR + (size_t)D * 512, 512, T, D, 512, EpiMergeN{MERGED, GATES + (size_t)T * D, 0, 0});
                           gemm(st, QC, 512, WBR + (size_t)2 * D * 512, 512, T, D, 512, EpiMergeN{MERGED, GATES + (size_t)2 * T * D, 0, 0}); break;
            case Q_MIX:    gemm(st, MERGED, D, WMIX, D, T, D, D, EpiResidN{Xin, X, 0, 0}); break;
            case Q_NORMXA: hipLaunchKernelGGL(k_rmsnorm, dim3(T / 4), dim3(256), 0, st, X, norm_xa + l * D, XN, (float*)nullptr, T); break;
            case Q_XALOG:  for (int b = 0; b < NB; ++b) gemm(st, XN + (size_t)b * S * D, D, BP(WS_GT + (size_t)(l * 2 + b) * 2 * MiB), D, S, D, D, EpiF32{LOG, D, b * S});
                           hipLaunchKernelGGL(k_softmax256, dim3(T * 4 / 4), dim3(256), 0, st, LOG, PXA); break;
            case Q_XAOUT:  for (int b = 0; b < NB; ++b) gemm(st, PXA + (size_t)b * S * D, D, BP(WS_HT + (size_t)(l * 2 + b) * 2 * MiB), D, S, D, D, EpiResidN{X, X, b * S, 0}); break;
            case Q_NORMFFN: hipLaunchKernelGGL(k_rmsnorm, dim3(T / 4), dim3(256), 0, st, X, norm_ffn + l * D, XN, (float*)nullptr, T); break;
            case Q_UP:     gemm(st, XN, D, WUP, D, T, 2 * DFF, D, EpiUpN{FA, FU}); break;
            case Q_FFNMID: hipLaunchKernelGGL(k_ffn_mid, dim3((unsigned)(((size_t)T * DFF + 255) / 256)), dim3(256), 0, st, FA, FU, ffn_conv_w + l * 3 * DFF, ffn_conv_b + l * DFF); break;
            case Q_DOWN:   gemm(st, FU, DFF, WDOWN, DFF, T, D, DFF, EpiResidN{X, X, 0, 0}); break;
            case Q_NEXT:   if (l + 1 < DEPTH) { convert_layer(l + 1); hipLaunchKernelGGL(k_rmsnorm, dim3(T / 4), dim3(256), 0, st, X, norm_mix + (l + 1) * D, XN, (float*)nullptr, T); }
                           else hipLaunchKernelGGL(k_rmsnorm, dim3(T / 4), dim3(256), 0, st, X, norm_final, (bf16_t*)nullptr, X, T);
                           break;
            }
        }
    }
}
```

```cpp
#include <hip/hip_runtime.h>
#include <stdint.h>
#include <stdio.h>

typedef unsigned short bf16_t;
typedef short bf16x8 __attribute__((ext_vector_type(8)));
typedef float f32x16 __attribute__((ext_vector_type(16)));
typedef float f32x4 __attribute__((ext_vector_type(4)));
#define DEV __device__ __forceinline__

constexpr int NB = 2, S = 8192, D = 1024, T = NB * S, DEPTH = 2;
constexpr int DIN = 8264, DFF = 2816, MEM = 256;
constexpr int NIN = 5376;
constexpr float LOG2E = 1.4426950408889634f;
constexpr float QSCALE = 0.125f * LOG2E;
constexpr float WSCALE = 0.125f * 0.35355339059327373f;
constexpr float XSCALE = 0.0625f * LOG2E;
constexpr float EPS = 1e-6f;
#ifndef MK_FUSE
#define MK_FUSE 1
#endif

constexpr size_t MiB = 1u << 20;
constexpr size_t WS_GT = 1 * MiB;
constexpr size_t WS_HT = 9 * MiB;
constexpr size_t WS_WUP = 17 * MiB, WS_WDOWN = 28 * MiB;
constexpr size_t WS_XN = 34 * MiB;
constexpr size_t WS_WMIX = 66 * MiB, WS_WBR = 68 * MiB, WS_WG = 71 * MiB, WS_WIN = 77 * MiB;
constexpr size_t WS_QA = 88 * MiB, WS_SCB = 104 * MiB, WS_QC = 120 * MiB, WS_KA = 136 * MiB, WS_VA = 152 * MiB, WS_KC = 168 * MiB, WS_VC = 184 * MiB,
                 WS_IQ = 200 * MiB, WS_CX = 216 * MiB, WS_IK = 232 * MiB, WS_IW = 234 * MiB, WS_BM = 235 * MiB;
constexpr size_t WS_GATES = 136 * MiB;
constexpr size_t WS_XTMP = 235 * MiB;
constexpr size_t WS_LOG = 88 * MiB, WS_PXA = 168 * MiB;
constexpr size_t WS_XBXA = 136 * MiB;
constexpr size_t WS_SS = 65536;
constexpr size_t WS_FA = 66 * MiB, WS_FU = 154 * MiB;
constexpr size_t WS_WQ = 200 * MiB  , WS_WOT = 204 * MiB  , WS_WKVT = 208 * MiB  , WS_MEMN = 216 * MiB  , WS_KVM = 218 * MiB  ;
constexpr size_t WS_NEED = 256 * MiB;

DEV bf16_t f2bf(float f) { unsigned u = __float_as_uint(f); u += 0x7fffu + ((u >> 16) & 1u); return (bf16_t)(u >> 16); }
DEV float bf2f(bf16_t h) { return __uint_as_float(((unsigned)h) << 16); }
DEV float wave_sum(float v) {
#pragma unroll
    for (int o = 1; o < 64; o <<= 1) v += __shfl_xor(v, o);
    return v;
}
DEV float wave_max(float v) {
#pragma unroll
    for (int o = 1; o < 64; o <<= 1) v = fmaxf(v, __shfl_xor(v, o));
    return v;
}


#define LAS __attribute__((address_space(3)))
#define GAS __attribute__((address_space(1)))
typedef unsigned u32x4 __attribute__((ext_vector_type(4)));
typedef unsigned u32x2 __attribute__((ext_vector_type(2)));
typedef float f32x2 __attribute__((ext_vector_type(2)));
#define LDS_WAIT() asm volatile("s_waitcnt lgkmcnt(0)" ::: "memory")
#define VM_WAIT() asm volatile("s_waitcnt vmcnt(0)" ::: "memory")
typedef __bf16 bf16x2_t __attribute__((ext_vector_type(2)));
DEV unsigned cvt_pk_bf16(float lo, float hi) { const f32x2 v = {lo, hi}; return __builtin_bit_cast(unsigned, __builtin_convertvector(v, bf16x2_t)); }
DEV float bflo(unsigned w) { return __uint_as_float(w << 16); }
DEV float bfhi(unsigned w) { return __uint_as_float(w & 0xffff0000u); }

namespace pg8 {
constexpr int BM = 256, BK = 64, HALF = 128, HTB = HALF * BK * 2, STAGE_BYTES = 8 * HTB, NXCD = 8, WGM = 8;
__host__ __device__ __forceinline__ int lds_byte(int r, int c) { const int st = (r >> 4) * 2 + (c >> 5), rr = r & 15, cc = c & 31, ob = rr * 64 + cc * 2; return st * 1024 + (ob ^ (((ob >> 9) & 1) << 5)); }
__host__ __device__ __forceinline__ void stage_rc(int b, int& R, int& C) { const int st = b / 1024, sb = b % 1024, swz = sb ^ (((sb >> 9) & 1) << 5); R = (st >> 1) * 16 + swz / 64; C = (st & 1) * 32 + (swz % 64) / 2; }
__host__ __device__ __forceinline__ int perm32(int rho) { const int n = rho >> 4, i = rho & 15; return 8 * (i >> 2) + 4 * n + (i & 3); }

struct Unit { int pm, pn, job; };
struct Order {
    int nM, nN, nwg, ntot, G, c;
    DEV void init(int nM_, int nN_, int njob, int G_, int c_) { nM = nM_; nN = nN_; nwg = nM * nN; ntot = nwg * njob; G = G_; c = c_; }
    DEV bool next(int i, Unit& u) const {
        const int L = i * G + c; if (L >= ntot) return false;
        u.job = L / nwg; int wgid = L - u.job * nwg;
        { const int q = nwg / NXCD, r = nwg % NXCD, xcd = wgid % NXCD, off = wgid / NXCD; wgid = (xcd < r ? xcd * (q + 1) : r * (q + 1) + (xcd - r) * q) + off; }
        const int nig = WGM * nN, gid = wgid / nig, fm = gid * WGM, gsz = (nM - fm) < WGM ? (nM - fm) : WGM;
        u.pm = fm + ((wgid % nig) % gsz); u.pn = (wgid % nig) / gsz; return true;
    }
};
template <class Epi, class Ptr, bool ALIGN_EPI, bool SP2>
DEV void gemm_phase(LAS unsigned char* lds, const int lda, const int ldb, const int K, const Order& S, const Ptr& P, const Epi& E) {
    int tid_ = threadIdx.x; asm volatile("" : "+v"(tid_));
    const int tid = tid_, wid = __builtin_amdgcn_readfirstlane(tid >> 6), lane = tid & 63, wr = wid >> 2, wc = wid & 3, fr = lane & 15, fq = lane >> 4;
    const int nt = K / BK;
    unsigned voffA[2], voffB[2];
#pragma unroll
    for (int i = 0; i < 2; ++i) { int R, C; stage_rc(tid * 16 + i * 8192, R, C); const int Rb = Epi::PERM ? ((R & ~31) + perm32(R & 31)) : R;
        voffA[i] = (unsigned)(R * lda + C) * 2u; voffB[i] = (unsigned)(Rb * ldb + C) * 2u; }
    const size_t kstep = (size_t)(BK * 2);
    const size_t hstepA = (size_t)HALF * lda * 2, hstepB = (size_t)HALF * ldb * 2;
    const unsigned ldsw = (unsigned)wid * 1024u;
    const int aoff = lds_byte(wr * 64 + fr, fq * 8), boff = lds_byte(wc * 32 + fr, fq * 8);
#define PG8_SA(b, h) (((b) * 2 + (h)) * HTB)
#define PG8_SB(b, h) ((4 + (b) * 2 + (h)) * HTB)
#define PG8_STAGE(bufoff, gbase, voff) do { _Pragma("unroll") for (int _i = 0; _i < 2; ++_i) \
        __builtin_amdgcn_global_load_lds((const unsigned*)((const char*)(gbase) + (voff)[_i]), (LAS unsigned*)(lds + (bufoff) + ldsw + _i * 8192), 16, 0, 0); } while (0)
#define PG8_LDA(dst, b, h) do { _Pragma("unroll") for (int m = 0; m < 4; ++m) _Pragma("unroll") for (int k = 0; k < 2; ++k) dst[m][k] = *(const LAS bf16x8*)(lds + PG8_SA(b, h) + aoff + m * 2048 + k * 1024); } while (0)
#define PG8_LDB(dst, b, h) do { _Pragma("unroll") for (int n = 0; n < 2; ++n) _Pragma("unroll") for (int k = 0; k < 2; ++k) dst[n][k] = *(const LAS bf16x8*)(lds + PG8_SB(b, h) + boff + n * 2048 + k * 1024); } while (0)
#define PG8_MMA(ai, bj, At, Bt) do { __builtin_amdgcn_s_setprio(1); _Pragma("unroll") for (int m = 0; m < 4; ++m) _Pragma("unroll") for (int n = 0; n < 2; ++n) _Pragma("unroll") for (int k = 0; k < 2; ++k) \
        acc[ai][bj][m][n] = __builtin_amdgcn_mfma_f32_16x16x32_bf16(Bt[n][k], At[m][k], acc[ai][bj][m][n], 0, 0, 0); __builtin_amdgcn_s_setprio(0); } while (0)
#define PG8_WAIT_V(n) asm volatile("s_waitcnt vmcnt(" #n ")" ::: "memory")
#define PG8_WAIT_L(n) asm volatile("s_waitcnt lgkmcnt(" #n ")" ::: "memory")
#define PG8_BAR __builtin_amdgcn_s_barrier()
#define PG8_SCHED __builtin_amdgcn_sched_barrier(0)
    Unit cur, nxt; int ui = 0;
    if (!S.next(0, cur)) return;
    f32x4 acc[2][2][4][2];
#pragma unroll
    for (int a = 0; a < 2; ++a)
#pragma unroll
        for (int b = 0; b < 2; ++b)
#pragma unroll
            for (int m = 0; m < 4; ++m)
#pragma unroll
                for (int n = 0; n < 2; ++n) acc[a][b][m][n] = (f32x4){0.f, 0.f, 0.f, 0.f};
    bf16x8 At[4][2], B0[2][2], B1[2][2];
    const char* cA = P.a(cur); const char* cB = P.b(cur);
    typename Epi::Pre pre; E.prefetch(pre, cur, wr, fr);
    if constexpr (SP2) {
        PG8_STAGE(PG8_SB(0, 0), cB, voffB); PG8_STAGE(PG8_SB(0, 1), cB + hstepB, voffB); PG8_STAGE(PG8_SA(0, 0), cA, voffA); PG8_STAGE(PG8_SA(0, 1), cA + hstepA, voffA);
        if (wr == 1) PG8_BAR;
        PG8_WAIT_V(2); PG8_BAR;
        PG8_STAGE(PG8_SB(1, 0), cB + kstep, voffB); PG8_STAGE(PG8_SA(1, 0), cA + kstep, voffA); PG8_STAGE(PG8_SB(1, 1), cB + hstepB + kstep, voffB);
        PG8_WAIT_V(6); PG8_BAR;
    } else {
        PG8_STAGE(PG8_SB(0, 0), cB, voffB); PG8_STAGE(PG8_SA(0, 0), cA, voffA); PG8_STAGE(PG8_SB(0, 1), cB + hstepB, voffB); PG8_STAGE(PG8_SA(0, 1), cA + hstepA, voffA);
        if (wr == 1) PG8_BAR;
        PG8_WAIT_V(4); PG8_BAR;
        PG8_STAGE(PG8_SB(1, 0), cB + kstep, voffB); PG8_STAGE(PG8_SA(1, 0), cA + kstep, voffA); PG8_STAGE(PG8_SB(1, 1), cB + hstepB + kstep, voffB);
        PG8_WAIT_V(6); PG8_BAR;
    }
#pragma unroll 1
    for (;;) {
        const bool has_next = S.next(ui + 1, nxt);
        const char* nA = has_next ? P.a(nxt) : cA; const char* nB = has_next ? P.b(nxt) : cB;
#pragma unroll 1
        for (int t = 0; t < nt; t += 2) {
            const bool last = (t == nt - 2);
            const char* a1 = cA + (size_t)(t + 1) * kstep;
            const char* a2 = last ? nA : cA + (size_t)(t + 2) * kstep; const char* b2 = last ? nB : cB + (size_t)(t + 2) * kstep;
            const char* a3 = a2 + kstep; const char* b3 = b2 + kstep;
            if constexpr (SP2) {
            PG8_LDB(B0, 0, 0); PG8_LDB(B1, 0, 1); PG8_SCHED; PG8_LDA(At, 0, 0); PG8_STAGE(PG8_SA(1, 1), a1 + hstepA, voffA);
            PG8_WAIT_V(8); PG8_WAIT_L(0); PG8_BAR; PG8_MMA(0, 0, At, B0); PG8_MMA(0, 1, At, B1); PG8_BAR; PG8_SCHED;
            PG8_LDA(At, 0, 1); PG8_STAGE(PG8_SB(0, 0), b2, voffB); PG8_STAGE(PG8_SB(0, 1), b2 + hstepB, voffB); PG8_STAGE(PG8_SA(0, 0), a2, voffA);
            PG8_WAIT_V(8); PG8_WAIT_L(0); PG8_BAR; PG8_MMA(1, 0, At, B0); PG8_MMA(1, 1, At, B1); PG8_BAR; PG8_SCHED;
            PG8_LDB(B0, 1, 0); PG8_LDB(B1, 1, 1); PG8_SCHED; PG8_LDA(At, 1, 0); PG8_STAGE(PG8_SA(0, 1), a2 + hstepA, voffA);
            PG8_WAIT_V(8); PG8_WAIT_L(0); PG8_BAR; PG8_MMA(0, 0, At, B0); PG8_MMA(0, 1, At, B1); PG8_BAR; PG8_SCHED;
            PG8_LDA(At, 1, 1); PG8_STAGE(PG8_SB(1, 0), b3, voffB); PG8_STAGE(PG8_SB(1, 1), b3 + hstepB, voffB); PG8_STAGE(PG8_SA(1, 0), a3, voffA);
            PG8_WAIT_V(8); PG8_WAIT_L(0); PG8_BAR; PG8_MMA(1, 0, At, B0); PG8_MMA(1, 1, At, B1); PG8_BAR; PG8_SCHED;
            } else {
            PG8_LDB(B0, 0, 0); PG8_SCHED; PG8_LDA(At, 0, 0); PG8_STAGE(PG8_SA(1, 1), a1 + hstepA, voffA);
            PG8_WAIT_L(8); PG8_BAR; PG8_WAIT_L(0); PG8_MMA(0, 0, At, B0); PG8_BAR; PG8_SCHED;
            PG8_LDB(B1, 0, 1); PG8_STAGE(PG8_SB(0, 0), b2, voffB);
            PG8_BAR; PG8_WAIT_L(0); PG8_MMA(0, 1, At, B1); PG8_BAR;
            PG8_LDA(At, 0, 1); PG8_STAGE(PG8_SA(0, 0), a2, voffA);
            PG8_BAR; PG8_WAIT_L(0); PG8_MMA(1, 0, At, B0); PG8_BAR; PG8_SCHED;
            PG8_STAGE(PG8_SB(0, 1), b2 + hstepB, voffB);
            PG8_WAIT_V(6); PG8_BAR; PG8_MMA(1, 1, At, B1); PG8_BAR;
            PG8_LDB(B0, 1, 0); PG8_SCHED; PG8_LDA(At, 1, 0); PG8_STAGE(PG8_SA(0, 1), a2 + hstepA, voffA);
            PG8_WAIT_L(8); PG8_BAR; PG8_WAIT_L(0); PG8_MMA(0, 0, At, B0); PG8_BAR; PG8_SCHED;
            PG8_LDB(B1, 1, 1); PG8_STAGE(PG8_SB(1, 0), b3, voffB);
            PG8_BAR; PG8_WAIT_L(0); PG8_MMA(0, 1, At, B1); PG8_BAR;
            PG8_LDA(At, 1, 1); PG8_STAGE(PG8_SA(1, 0), a3, voffA);
            PG8_BAR; PG8_WAIT_L(0); PG8_MMA(1, 0, At, B0); PG8_BAR; PG8_SCHED;
            PG8_STAGE(PG8_SB(1, 1), b3 + hstepB, voffB);
            PG8_WAIT_V(6); PG8_BAR; PG8_MMA(1, 1, At, B1); PG8_BAR;
            }
        }
        if constexpr (ALIGN_EPI) { if (wr == 0) PG8_BAR; }
        if constexpr (!Epi::AFTER_DRAIN) { E(acc, cur, wr, wc, fr, fq, pre); }
        if (!has_next) break;
#pragma unroll
        for (int a = 0; a < 2; ++a)
#pragma unroll
            for (int b = 0; b < 2; ++b)
#pragma unroll
                for (int m = 0; m < 4; ++m)
#pragma unroll
                    for (int n = 0; n < 2; ++n) acc[a][b][m][n] = (f32x4){0.f, 0.f, 0.f, 0.f};
        cur = nxt; cA = nA; cB = nB; ++ui; E.prefetch(pre, cur, wr, fr);
        if constexpr (ALIGN_EPI) { if (wr == 1) PG8_BAR; }
    }
    PG8_WAIT_V(0);
    if constexpr (!ALIGN_EPI) { if (wr == 0) PG8_BAR; }
    PG8_BAR;
    if constexpr (Epi::AFTER_DRAIN) { E.fused(acc, cur, wr, wc, fr, fq, lds, wid, lane, pre); }
#undef PG8_SA
#undef PG8_SB
#undef PG8_STAGE
#undef PG8_LDA
#undef PG8_LDB
#undef PG8_MMA
#undef PG8_WAIT_V
#undef PG8_WAIT_L
#undef PG8_BAR
#undef PG8_SCHED
}
typedef f32x4 Acc[2][2][4][2];

struct PtrStd {
    const char* A; const char* B; size_t aj, bj, bb, arow, brow;
    DEV const char* a(const Unit& u) const { return A + (size_t)u.job * aj + (size_t)u.pm * arow; }
    DEV const char* b(const Unit& u) const { return B + (size_t)u.job * bj + (size_t)(u.pm >> 5) * bb + (size_t)u.pn * brow; }
};
struct PtrG {
    const char* KVM; const char* WQ;
    DEV const char* a(const Unit& u) const { return KVM + (size_t)(u.job >> 2) * MiB + (size_t)(u.job & 3) * 512; }
    DEV const char* b(const Unit& u) const { return WQ + (size_t)(u.job >> 3) * 2 * MiB + (size_t)(u.job & 3) * 512 + (size_t)u.pn * 256 * 1024 * 2; }
};
struct PtrH {
    const char* KVM; const char* WOT;
    DEV const char* a(const Unit& u) const { return WOT + (size_t)(u.job >> 3) * 2 * MiB + (size_t)(u.job & 3) * 512 + (size_t)u.pm * 256 * 1024 * 2; }
    DEV const char* b(const Unit& u) const { return KVM + (size_t)(u.job >> 2) * MiB + 2048 + (size_t)(u.job & 3) * 512; }
};

#define EPI_ROWS(u) const int row0 = (u).pm * BM + wr * 64 + fr
DEV u32x4 pack8(const f32x4 v0, const f32x4 v1) { u32x4 w; w.x = cvt_pk_bf16(v0[0], v0[1]); w.y = cvt_pk_bf16(v0[2], v0[3]); w.z = cvt_pk_bf16(v1[0], v1[1]); w.w = cvt_pk_bf16(v1[2], v1[3]); return w; }

struct PreNone {};
struct PreRs { float v[2][4]; };
DEV void pre_rs(PreRs& p, const float* ss, int row0) {
#pragma unroll
    for (int ai = 0; ai < 2; ++ai)
#pragma unroll
        for (int m = 0; m < 4; ++m) p.v[ai][m] = __builtin_nontemporal_load(ss + row0 + ai * HALF + m * 16);
}
DEV void rs_of(float (&rs)[2][4], const PreRs& p) {
#pragma unroll
    for (int ai = 0; ai < 2; ++ai)
#pragma unroll
        for (int m = 0; m < 4; ++m) rs[ai][m] = rsqrtf(p.v[ai][m] * (1.f / D) + EPS);
}
DEV void load_rs(float (&rs)[2][4], const float* ss, int row0) {
#pragma unroll
    for (int ai = 0; ai < 2; ++ai)
#pragma unroll
        for (int m = 0; m < 4; ++m) rs[ai][m] = rsqrtf(__builtin_nontemporal_load(ss + row0 + ai * HALF + m * 16) * (1.f / D) + EPS);
}
struct EpiInProj {
    typedef PreRs Pre;
    DEV void prefetch(PreRs& p, const Unit& u, int wr, int fr) const { pre_rs(p, ss, u.pm * BM + wr * 64 + fr); }
    static constexpr bool PERM = true, AFTER_DRAIN = false;
    unsigned char* ws; const float* ss;
    DEV void operator()(const Acc& acc, const Unit& u, int wr, int wc, int fr, int fq, const PreRs& pre) const {
        EPI_ROWS(u); const int pn = u.pn, cb = wc * 32 + 8 * fq;
        float rs[2][4]; rs_of(rs, pre);
        if (pn < 16) {
            const int g = pn >> 1;
            const size_t off = g == 0 ? WS_QA : g == 1 ? WS_KA : g == 2 ? WS_VA : g == 3 ? WS_QC : g == 4 ? WS_KC : g == 5 ? WS_VC : g == 6 ? WS_IQ : WS_SCB;
            const float sc = (g == 0 || g == 3) ? QSCALE : 1.f;
            bf16_t* base = (bf16_t*)(ws + off) + (pn & 1) * 256 + cb;
#pragma unroll
            for (int ai = 0; ai < 2; ++ai)
#pragma unroll
                for (int m = 0; m < 4; ++m) { bf16_t* rowp = base + (size_t)(row0 + ai * HALF + m * 16) * 512;
#pragma unroll
                    for (int bj = 0; bj < 2; ++bj) *(u32x4*)(rowp + bj * HALF) = pack8(acc[ai][bj][m][0] * (sc * rs[ai][m]), acc[ai][bj][m][1] * (sc * rs[ai][m])); }
        } else if (pn < 20) {
            bf16_t* base = (bf16_t*)(ws + WS_CX) + (pn - 16) * 128 + cb;
#pragma unroll
            for (int ai = 0; ai < 2; ++ai)
#pragma unroll
                for (int m = 0; m < 4; ++m) { const float r2 = rs[ai][m] * rs[ai][m]; *(u32x4*)(base + (size_t)(row0 + ai * HALF + m * 16) * 512) = pack8(acc[ai][0][m][0] * acc[ai][1][m][0] * r2, acc[ai][0][m][1] * acc[ai][1][m][1] * r2); }
        } else {
            if (wc < 2) { bf16_t* base = (bf16_t*)(ws + WS_IK);
#pragma unroll
                for (int ai = 0; ai < 2; ++ai)
#pragma unroll
                    for (int m = 0; m < 4; ++m) { const int t = row0 + ai * HALF + m * 16;
                        *(u32x4*)(base + (size_t)(t >> 5) * 2048 + (((cb >> 3) * 32 + (t & 31)) * 8)) = pack8(acc[ai][0][m][0] * rs[ai][m], acc[ai][0][m][1] * rs[ai][m]); }
            } else if (wc == 2 && fq == 0) { float* base = (float*)(ws + WS_IW);
#pragma unroll
                for (int ai = 0; ai < 2; ++ai)
#pragma unroll
                    for (int m = 0; m < 4; ++m) { float* p = base + (size_t)(row0 + ai * HALF + m * 16) * 8; *(f32x4*)p = acc[ai][0][m][0] * (WSCALE * rs[ai][m]); *(f32x4*)(p + 4) = acc[ai][0][m][1] * (WSCALE * rs[ai][m]); }
            }
        }
    }
};
DEV f32x4 sigm4(const f32x4 v) { f32x4 o;
#pragma unroll
    for (int i = 0; i < 4; ++i) o[i] = __builtin_amdgcn_rcpf(1.f + __builtin_amdgcn_exp2f(-LOG2E * v[i])); return o; }
struct EpiGates {
    typedef PreRs Pre;
    DEV void prefetch(PreRs& p, const Unit& u, int wr, int fr) const { pre_rs(p, ss, u.pm * BM + wr * 64 + fr); }
    static constexpr bool PERM = true, AFTER_DRAIN = false;
    bf16_t* G; const float* ss;
    DEV void operator()(const Acc& acc, const Unit& u, int wr, int wc, int fr, int fq, const PreRs& pre) const {
        EPI_ROWS(u); float rs[2][4]; rs_of(rs, pre); bf16_t* base = G + (size_t)(u.pn >> 2) * T * D + (u.pn & 3) * 256 + wc * 32 + 8 * fq;
#pragma unroll
        for (int ai = 0; ai < 2; ++ai)
#pragma unroll
            for (int m = 0; m < 4; ++m) { bf16_t* rowp = base + (size_t)(row0 + ai * HALF + m * 16) * D;
#pragma unroll
                for (int bj = 0; bj < 2; ++bj) *(u32x4*)(rowp + bj * HALF) = pack8(sigm4(acc[ai][bj][m][0] * rs[ai][m]), sigm4(acc[ai][bj][m][1] * rs[ai][m])); }
    }
};
struct EpiMerge {
    typedef PreNone Pre;
    DEV void prefetch(PreNone&, const Unit&, int, int) const {}
    static constexpr bool PERM = true, AFTER_DRAIN = false;
    bf16_t* M; const bf16_t* G;
    DEV void operator()(const Acc& acc, const Unit& u, int wr, int wc, int fr, int fq, const PreNone&) const {
        EPI_ROWS(u); const size_t cofs = (size_t)u.pn * 256 + wc * 32 + 8 * fq; const bf16_t* gb = G + (size_t)u.job * T * D;
#pragma unroll
        for (int ai = 0; ai < 2; ++ai)
#pragma unroll
            for (int m = 0; m < 4; ++m) { const size_t ro = (size_t)(row0 + ai * HALF + m * 16) * D + cofs;
#pragma unroll
                for (int bj = 0; bj < 2; ++bj) { const size_t o = ro + bj * HALF; const u32x4 g = *(const u32x4*)(gb + o);
                    f32x4 v0 = acc[ai][bj][m][0], v1 = acc[ai][bj][m][1];
                    v0[0] *= bflo(g.x); v0[1] *= bfhi(g.x); v0[2] *= bflo(g.y); v0[3] *= bfhi(g.y); v1[0] *= bflo(g.z); v1[1] *= bfhi(g.z); v1[2] *= bflo(g.w); v1[3] *= bfhi(g.w);
                    if (u.job > 0) { const u32x4 p = __builtin_nontemporal_load((const u32x4*)(M + o));
                        v0[0] += bflo(p.x); v0[1] += bfhi(p.x); v0[2] += bflo(p.y); v0[3] += bfhi(p.y); v1[0] += bflo(p.z); v1[1] += bfhi(p.z); v1[2] += bflo(p.w); v1[3] += bfhi(p.w); }
                    *(u32x4*)(M + o) = pack8(v0, v1); } }
    }
};
struct EpiResid {
    typedef PreNone Pre;
    DEV void prefetch(PreNone&, const Unit&, int, int) const {}
    static constexpr bool PERM = false, AFTER_DRAIN = false;
    const float* xin; float* xout; bf16_t* xb; float* ss;
    DEV void operator()(const Acc& acc, const Unit& u, int wr, int wc, int fr, int fq, const PreNone&) const {
        EPI_ROWS(u); const size_t cofs = (size_t)u.pn * 256 + wc * 32 + 4 * fq;
#pragma unroll
        for (int ai = 0; ai < 2; ++ai)
#pragma unroll
            for (int m = 0; m < 4; ++m) { const size_t ro = (size_t)(row0 + ai * HALF + m * 16) * D + cofs; float sq = 0.f;
#pragma unroll
                for (int bj = 0; bj < 2; ++bj)
#pragma unroll
                    for (int n = 0; n < 2; ++n) { const size_t o = ro + bj * HALF + n * 16; const f32x4 x = *(const f32x4*)(xin + o) + acc[ai][bj][m][n]; *(f32x4*)(xout + o) = x;
                        u32x2 w; w.x = cvt_pk_bf16(x[0], x[1]); w.y = cvt_pk_bf16(x[2], x[3]); *(u32x2*)(xb + o) = w;
                        sq += (x[0] * x[0] + x[1] * x[1]) + (x[2] * x[2] + x[3] * x[3]); }
                sq += __shfl_xor(sq, 16); sq += __shfl_xor(sq, 32);
                if (fq == 0) atomicAdd(ss + row0 + ai * HALF + m * 16, sq); }
    }
};
struct EpiUp {
    typedef PreRs Pre;
    DEV void prefetch(PreRs& p, const Unit& u, int wr, int fr) const { pre_rs(p, ss, u.pm * BM + wr * 64 + fr); }
    static constexpr bool PERM = true, AFTER_DRAIN = false;
    bf16_t *fa, *fu; const float* ss;
    DEV void operator()(const Acc& acc, const Unit& u, int wr, int wc, int fr, int fq, const PreRs& pre) const {
        EPI_ROWS(u); float rs[2][4]; rs_of(rs, pre); const size_t cofs = (size_t)u.pn * 128 + wc * 32 + 8 * fq;
#pragma unroll
        for (int ai = 0; ai < 2; ++ai)
#pragma unroll
            for (int m = 0; m < 4; ++m) { const size_t o = (size_t)(row0 + ai * HALF + m * 16) * DFF + cofs;
                *(u32x4*)(fa + o) = pack8(acc[ai][0][m][0] * rs[ai][m], acc[ai][0][m][1] * rs[ai][m]); *(u32x4*)(fu + o) = pack8(acc[ai][1][m][0] * rs[ai][m], acc[ai][1][m][1] * rs[ai][m]); }
    }
};
struct EpiPrep {
    typedef PreNone Pre;
    DEV void prefetch(PreNone&, const Unit&, int, int) const {}
    static constexpr bool PERM = true, AFTER_DRAIN = false;
    unsigned char* ws; int mode;
    DEV void operator()(const Acc& acc, const Unit& u, int wr, int wc, int fr, int fq, const PreNone&) const {
        EPI_ROWS(u); bf16_t* base; int ldc; float sc = 1.f;
        if (mode == 0) { base = (bf16_t*)(ws + WS_KVM + (size_t)u.job * 2 * MiB); ldc = 2 * D; }
        else if (mode == 1) { base = (bf16_t*)(ws + WS_GT + (size_t)(u.job >> 2) * 2 * MiB) + (size_t)(u.job & 3) * 256 * D; ldc = D; sc = XSCALE; }
        else { base = (bf16_t*)(ws + WS_HT + (size_t)(u.job >> 2) * 2 * MiB) + (u.job & 3) * 256; ldc = D; }
        base += (size_t)u.pn * 256 + wc * 32 + 8 * fq;
#pragma unroll
        for (int ai = 0; ai < 2; ++ai)
#pragma unroll
            for (int m = 0; m < 4; ++m) { bf16_t* rowp = base + (size_t)(row0 + ai * HALF + m * 16) * ldc;
#pragma unroll
                for (int bj = 0; bj < 2; ++bj) *(u32x4*)(rowp + bj * HALF) = pack8(acc[ai][bj][m][0] * sc, acc[ai][bj][m][1] * sc); }
    }
};
struct EpiSoftmax {
    typedef PreRs Pre;
    DEV void prefetch(PreRs& p, const Unit& u, int wr, int fr) const { pre_rs(p, ss, u.pm * BM + wr * 64 + fr); }
    static constexpr bool PERM = true, AFTER_DRAIN = true;
    bf16_t* P; const float* ss;
    DEV void fused(Acc& acc, const Unit& u, int wr, int wc, int fr, int fq, LAS unsigned char* lds, int wid, int lane, const PreRs& pre) const {
        LAS float* PM = (LAS float*)lds; LAS float* PS = (LAS float*)(lds + 4096);
        { const int row0_ = u.pm * BM + wr * 64 + fr; float rs[2][4]; rs_of(rs, pre);
#pragma unroll
          for (int ai = 0; ai < 2; ++ai)
#pragma unroll
              for (int m = 0; m < 4; ++m)
#pragma unroll
                  for (int bj = 0; bj < 2; ++bj)
#pragma unroll
                      for (int n = 0; n < 2; ++n) acc[ai][bj][m][n] = acc[ai][bj][m][n] * rs[ai][m]; }
#pragma unroll
        for (int ai = 0; ai < 2; ++ai)
#pragma unroll
            for (int m = 0; m < 4; ++m) { float mx = -INFINITY;
#pragma unroll
                for (int bj = 0; bj < 2; ++bj)
#pragma unroll
                    for (int n = 0; n < 2; ++n) { const f32x4 x = acc[ai][bj][m][n]; mx = fmaxf(mx, fmaxf(fmaxf(x[0], x[1]), fmaxf(x[2], x[3]))); }
                mx = fmaxf(mx, __shfl_xor(mx, 16)); mx = fmaxf(mx, __shfl_xor(mx, 32));
                if (fq == 0) PM[(ai * HALF + wr * 64 + m * 16 + fr) * 4 + wc] = mx; }
        LDS_WAIT(); __builtin_amdgcn_s_barrier(); asm volatile("" ::: "memory");
#pragma unroll
        for (int ai = 0; ai < 2; ++ai)
#pragma unroll
            for (int m = 0; m < 4; ++m) { const int r = ai * HALF + wr * 64 + m * 16 + fr; const f32x4 q = *(const LAS f32x4*)(PM + r * 4);
                const float mx = fmaxf(fmaxf(q[0], q[1]), fmaxf(q[2], q[3])); float s = 0.f;
#pragma unroll
                for (int bj = 0; bj < 2; ++bj)
#pragma unroll
                    for (int n = 0; n < 2; ++n) { f32x4 x = acc[ai][bj][m][n];
#pragma unroll
                        for (int i = 0; i < 4; ++i) { x[i] = __builtin_amdgcn_exp2f(x[i] - mx); s += x[i]; } acc[ai][bj][m][n] = x; }
                s += __shfl_xor(s, 16); s += __shfl_xor(s, 32);
                if (fq == 0) PS[r * 4 + wc] = s; }
        LDS_WAIT(); __builtin_amdgcn_s_barrier(); asm volatile("" ::: "memory");
        EPI_ROWS(u); bf16_t* base = P + (size_t)u.pn * 256 + wc * 32 + 8 * fq;
#pragma unroll
        for (int ai = 0; ai < 2; ++ai)
#pragma unroll
            for (int m = 0; m < 4; ++m) { const int r = ai * HALF + wr * 64 + m * 16 + fr; const f32x4 q = *(const LAS f32x4*)(PS + r * 4);
                const float inv = 1.f / ((q[0] + q[1]) + (q[2] + q[3])); bf16_t* rowp = base + (size_t)(row0 + ai * HALF + m * 16) * D;
#pragma unroll
                for (int bj = 0; bj < 2; ++bj) *(u32x4*)(rowp + bj * HALF) = pack8(acc[ai][bj][m][0] * inv, acc[ai][bj][m][1] * inv); }
        LDS_WAIT(); __builtin_amdgcn_s_barrier();
    }
};
}

typedef GAS unsigned gu32;
#define XB_TMO      128
#define XB_XCNT(j)  (256  + 64 * (j))
#define XB_XSUB(j)  (1280 + 64 * (j))
#define XB_XGEN(j)  (2304 + 64 * (j))
#define XB_TOP      3328
#define XB_TOPGEN   3392
#define XCD_BAR_WORDS 3456
#define XB_SPIN_CAP (1u << 22)
DEV unsigned xb_ld(unsigned* p) { return __hip_atomic_load(p, __ATOMIC_RELAXED, __HIP_MEMORY_SCOPE_AGENT); }
DEV unsigned xb_add(unsigned* p, unsigned v) { return __hip_atomic_fetch_add(p, v, __ATOMIC_RELAXED, __HIP_MEMORY_SCOPE_AGENT); }
DEV unsigned xb_xcc_id() { return (unsigned)__builtin_amdgcn_s_getreg((3 << 11) | 20) & 0xFu; }
#define XB_SPIN(cond, bar) do { unsigned _sp = 0; while (cond) { __builtin_amdgcn_s_sleep(1); \
    if ((++_sp & 255u) == 0u) { if (xb_ld(&(bar)[XB_TMO])) break; if (_sp > XB_SPIN_CAP) { atomicAdd(&(bar)[XB_TMO], 1u); break; } } } } while (0)
struct XcdBarrier { unsigned* bar; unsigned x; volatile LAS unsigned* st; };
DEV XcdBarrier xcd_barrier_post(unsigned* bar, volatile LAS unsigned* st) {
    XcdBarrier b; b.bar = bar; b.x = xb_xcc_id(); b.st = st;
    if (threadIdx.x == 0) (void)xb_add(&bar[XB_XCNT(b.x)], 1u);
    return b;
}
DEV void xcd_barrier_complete(unsigned* bar, unsigned x, unsigned& nloc, unsigned& nx) {
    const unsigned G = gridDim.x * gridDim.y * gridDim.z;
    unsigned sum, cnt, mine, sp = 0u;
    for (;;) {
        sum = 0u; cnt = 0u; mine = 0u;
#pragma unroll
        for (unsigned j = 0; j < 16; ++j) { const unsigned c = xb_ld(&bar[XB_XCNT(j)]); sum += c; cnt += (c > 0u) ? 1u : 0u; mine = (j == x) ? c : mine; }
        if (sum == G) break;
        __builtin_amdgcn_s_sleep(1);
        if ((++sp & 255u) == 0u) { if (xb_ld(&bar[XB_TMO])) break; if (sp > XB_SPIN_CAP) { atomicAdd(&bar[XB_TMO], 1u); break; } }
    }
    nloc = mine > 0u ? mine : 1u; nx = cnt > 0u ? cnt : 1u;
}
DEV void xcd_barrier(const XcdBarrier& b) {
    asm volatile("s_waitcnt vmcnt(0)" ::: "memory");
    __syncthreads();
    if (threadIdx.x == 0) {
        unsigned* bar = b.bar;
        __builtin_amdgcn_s_waitcnt(0);
        unsigned nloc = b.st[0], nx = b.st[1];
        if (nloc == 0u) { xcd_barrier_complete(bar, b.x, nloc, nx); b.st[0] = nloc; b.st[1] = nx; }
        const unsigned old = xb_add(&bar[XB_XSUB(b.x)], 1u);
        const unsigned gen = old / nloc;
        if (old + 1u == (gen + 1u) * nloc) {
            __builtin_amdgcn_fence(__ATOMIC_RELEASE, "agent");
            asm volatile("s_waitcnt vmcnt(0)" ::: "memory");
            const unsigned og = xb_add(&bar[XB_TOP], 1u);
            const unsigned tg = og / nx;
            if (og + 1u == (tg + 1u) * nx) xb_add(&bar[XB_TOPGEN], 1u);
            else XB_SPIN(xb_ld(&bar[XB_TOPGEN]) == tg, bar);
            __builtin_amdgcn_fence(__ATOMIC_ACQUIRE, "agent");
            xb_add(&bar[XB_XGEN(b.x)], 1u);
            asm volatile("s_waitcnt vmcnt(0)" ::: "memory");
        } else {
            XB_SPIN(xb_ld(&bar[XB_XGEN(b.x)]) == gen, bar);
            __builtin_amdgcn_fence(__ATOMIC_ACQUIRE, "agent");
            asm volatile("s_waitcnt vmcnt(0)" ::: "memory");
        }
    }
    __syncthreads();
}


struct WaveId { int gw, ngw, wave, lane; };
DEV unsigned f2bf_u(float f) { return (unsigned)f2bf(f); }
DEV unsigned pk2(float lo, float hi) { return cvt_pk_bf16(lo, hi); }

DEV void norm_rows(const WaveId& W, const float* x, const float* g, bf16_t* outb, float* outf, int rows) {
    for (int row = W.gw; row < rows; row += W.ngw) {
        const f32x4* xr = (const f32x4*)(x + (size_t)row * D) + W.lane;
        f32x4 v[4]; float s = 0.f;
#pragma unroll
        for (int j = 0; j < 4; ++j) { v[j] = xr[64 * j]; s += (v[j].x * v[j].x + v[j].y * v[j].y) + (v[j].z * v[j].z + v[j].w * v[j].w); }
        const float r = rsqrtf(wave_sum(s) * (1.f / D) + EPS);
#pragma unroll
        for (int j = 0; j < 4; ++j) {
            const f32x4 gg = ((const f32x4*)g)[W.lane + 64 * j];
            const f32x4 o = {v[j].x * r * gg.x, v[j].y * r * gg.y, v[j].z * r * gg.z, v[j].w * r * gg.w};
            if (outb) { u32x2 w; w.x = pk2(o.x, o.y); w.y = pk2(o.z, o.w); ((u32x2*)(outb + (size_t)row * D))[W.lane + 64 * j] = w; }
            else ((f32x4*)(outf + (size_t)row * D))[W.lane + 64 * j] = o;
        }
    }
}
DEV void cvt_piece(const WaveId& W, LAS float* scr, int& base, const float* Wsrc, int ldw, int K, int col0, int ncols, bf16_t* dst, int ldo, int row0, const float* gain = nullptr) {
    const int nblk = ncols / 32, nitems = (K / 64) * nblk;
    int first = (W.gw - base) % W.ngw; if (first < 0) first += W.ngw;
    base = (base + nitems) % W.ngw;
    for (int item = first; item < nitems; item += W.ngw) {
        const int kb = item / nblk, nb = item - kb * nblk, k0 = 64 * kb, n0 = 32 * nb;
#pragma unroll 8
        for (int i = 0; i < 32; ++i) { const int kk = 2 * i + (W.lane >> 5); scr[kk * 33 + (W.lane & 31)] = Wsrc[(size_t)(k0 + kk) * ldw + col0 + n0 + (W.lane & 31)] * (gain ? gain[k0 + kk] : 1.f); }
        LDS_WAIT(); asm volatile("" ::: "memory");
        const int c = W.lane & 7;
#pragma unroll
        for (int j = 0; j < 4; ++j) { const int n = (W.lane >> 3) + 8 * j; const LAS float* s = scr + (8 * c) * 33 + n;
            u32x4 o; o.x = pk2(s[0 * 33], s[1 * 33]); o.y = pk2(s[2 * 33], s[3 * 33]); o.z = pk2(s[4 * 33], s[5 * 33]); o.w = pk2(s[6 * 33], s[7 * 33]);
            *(u32x4*)(dst + (size_t)(row0 + n0 + n) * ldo + k0 + 8 * c) = o; }
        LDS_WAIT(); asm volatile("" ::: "memory");
    }
}
DEV void convert_layer_weights(const WaveId& W, LAS float* scr, int& base, unsigned char* ws, const float* const* in, int l) {
    const float* wi = in[3] + (size_t)l * D * DIN;
    bf16_t* WIN = (bf16_t*)(ws + WS_WIN); const float* gm = in[2] + l * D; const float* gf = in[14] + l * D;
    cvt_piece(W, scr, base, wi, DIN, D, 0, 1536, WIN, D, 0, gm);
    cvt_piece(W, scr, base, wi, DIN, D, 3072, 1536, WIN, D, 1536, gm);
    cvt_piece(W, scr, base, wi, DIN, D, 4608, 512, WIN, D, 3072, gm);
    cvt_piece(W, scr, base, wi, DIN, D, 1536, 512, WIN, D, 3584, gm);
#pragma unroll 1
    for (int j = 0; j < 4; ++j) { cvt_piece(W, scr, base, wi, DIN, D, 2048 + 128 * j, 128, WIN, D, 4096 + 256 * j, gm); cvt_piece(W, scr, base, wi, DIN, D, 2560 + 128 * j, 128, WIN, D, 4096 + 256 * j + 128, gm); }
    cvt_piece(W, scr, base, wi, DIN, D, 5120, 96, WIN, D, 5120, gm);
    cvt_piece(W, scr, base, wi, DIN, D, 5192, 3072, (bf16_t*)(ws + WS_WG), D, 0, gm);
#pragma unroll 1
    for (int i = 0; i < 3; ++i) cvt_piece(W, scr, base, in[5 + i] + (size_t)l * 512 * D, D, 512, 0, D, (bf16_t*)(ws + WS_WBR) + (size_t)i * D * 512, 512, 0);
    cvt_piece(W, scr, base, in[8] + (size_t)l * D * D, D, D, 0, D, (bf16_t*)(ws + WS_WMIX), D, 0);
    const float* wf = in[15] + (size_t)l * D * 2 * DFF;
#pragma unroll 1
    for (int j = 0; j < 22; ++j) { cvt_piece(W, scr, base, wf, 2 * DFF, D, 128 * j, 128, (bf16_t*)(ws + WS_WUP), D, 256 * j, gf); cvt_piece(W, scr, base, wf, 2 * DFF, D, DFF + 128 * j, 128, (bf16_t*)(ws + WS_WUP), D, 256 * j + 128, gf); }
    cvt_piece(W, scr, base, in[18] + (size_t)l * DFF * D, D, DFF, 0, D, (bf16_t*)(ws + WS_WDOWN), DFF, 0);
}
DEV void prep0_phase(const WaveId& W, LAS float* scr, unsigned char* ws, const float* const* in) {
    int base = 0;
#pragma unroll 1
    for (int l = 0; l < DEPTH; ++l) {
        const float* wq = in[11] + (size_t)l * D * D; bf16_t* WQ = (bf16_t*)(ws + WS_WQ + (size_t)l * 2 * MiB); const float* gx = in[9] + l * D;
        for (size_t i = (size_t)(W.gw * 64 + W.lane) * 4; i < (size_t)D * D; i += (size_t)W.ngw * 256) { const float g = gx[i >> 10]; const f32x4 v = *(const f32x4*)(wq + i); u32x2 o; o.x = pk2(v.x * g, v.y * g); o.y = pk2(v.z * g, v.w * g); *(u32x2*)(WQ + i) = o; }
        cvt_piece(W, scr, base, in[13] + (size_t)l * D * D, D, D, 0, D, (bf16_t*)(ws + WS_WOT + (size_t)l * 2 * MiB), D, 0);
        cvt_piece(W, scr, base, in[12] + (size_t)l * D * 2 * D, 2 * D, D, 0, 2 * D, (bf16_t*)(ws + WS_WKVT + (size_t)l * 4 * MiB), D, 0);
        norm_rows(W, in[1], in[10] + l * D, (bf16_t*)(ws + WS_MEMN + (size_t)l * MiB), nullptr, NB * MEM);
    }
    convert_layer_weights(W, scr, base, ws, in, 0);
    bf16_t* XB = (bf16_t*)(ws + WS_XN); float* ss0 = (float*)(ws + WS_SS);
    for (int row = W.gw; row < T; row += W.ngw) {
        const f32x4* xr = (const f32x4*)(in[0] + (size_t)row * D) + W.lane; float s = 0.f;
#pragma unroll
        for (int j = 0; j < 4; ++j) { const f32x4 v = xr[64 * j]; s += (v.x * v.x + v.y * v.y) + (v.z * v.z + v.w * v.w);
            u32x2 w; w.x = pk2(v.x, v.y); w.y = pk2(v.z, v.w); ((u32x2*)(XB + (size_t)row * D))[W.lane + 64 * j] = w; }
        s = wave_sum(s); if (W.lane == 0) ss0[row] = s;
    }
}
DEV void final_norm(const WaveId& W, float* x, const float* g, const float* ss) {
    for (int row = W.gw; row < T; row += W.ngw) {
        const float r = rsqrtf(ss[row] * (1.f / D) + EPS); f32x4* xr = (f32x4*)(x + (size_t)row * D) + W.lane;
#pragma unroll
        for (int j = 0; j < 4; ++j) { const f32x4 gg = ((const f32x4*)g)[W.lane + 64 * j]; f32x4 v = xr[64 * j]; v.x *= r * gg.x; v.y *= r * gg.y; v.z *= r * gg.z; v.w *= r * gg.w; xr[64 * j] = v; }
    }
}
DEV void conv_sc_phase(int gtid, int gthreads, bf16_t* scb, const bf16_t* cx, const float* w) {
    for (int i = gtid; i < T * 64; i += gthreads) {
        const int c8 = (i & 63) * 8, t = i >> 6, tl = t & (S - 1);
        const size_t o = (size_t)t * 512 + c8;
        const u32x4 z = {0u, 0u, 0u, 0u};
        const u32x4 x2 = *(const u32x4*)(cx + o), x1 = tl >= 1 ? *(const u32x4*)(cx + o - 512) : z, x0 = tl >= 2 ? *(const u32x4*)(cx + o - 1024) : z, bb = *(const u32x4*)(scb + o);
        const f32x4 w0a = *(const f32x4*)(w + c8), w0b = *(const f32x4*)(w + c8 + 4), w1a = *(const f32x4*)(w + 512 + c8), w1b = *(const f32x4*)(w + 512 + c8 + 4), w2a = *(const f32x4*)(w + 1024 + c8), w2b = *(const f32x4*)(w + 1024 + c8 + 4);
        float r[8];
#define CONV1(k, W0, W1, W2, X0, X1, X2, BBv, F) r[k] = F(BBv) * (W0 * F(X0) + W1 * F(X1) + W2 * F(X2))
        CONV1(0, w0a.x, w1a.x, w2a.x, x0.x, x1.x, x2.x, bb.x, bflo); CONV1(1, w0a.y, w1a.y, w2a.y, x0.x, x1.x, x2.x, bb.x, bfhi);
        CONV1(2, w0a.z, w1a.z, w2a.z, x0.y, x1.y, x2.y, bb.y, bflo); CONV1(3, w0a.w, w1a.w, w2a.w, x0.y, x1.y, x2.y, bb.y, bfhi);
        CONV1(4, w0b.x, w1b.x, w2b.x, x0.z, x1.z, x2.z, bb.z, bflo); CONV1(5, w0b.y, w1b.y, w2b.y, x0.z, x1.z, x2.z, bb.z, bfhi);
        CONV1(6, w0b.z, w1b.z, w2b.z, x0.w, x1.w, x2.w, bb.w, bflo); CONV1(7, w0b.w, w1b.w, w2b.w, x0.w, x1.w, x2.w, bb.w, bfhi);
#undef CONV1
        u32x4 ov; ov.x = pk2(r[0], r[1]); ov.y = pk2(r[2], r[3]); ov.z = pk2(r[4], r[5]); ov.w = pk2(r[6], r[7]);
        *(u32x4*)(scb + o) = ov;
    }
}
DEV float gelu_t(float a) { return a * __builtin_amdgcn_rcpf(1.f + __builtin_amdgcn_exp2f(-1.5957691216057308f * LOG2E * (a + 0.044715f * a * a * a))); }
DEV void ffn_mid_phase(int gtid, int gthreads, const bf16_t* fa, bf16_t* fu, const float* cw, const float* cb) {
    constexpr int C8 = DFF / 8;
    for (int i = gtid; i < T * C8; i += gthreads) {
        const int t = i / C8, c8 = (i - t * C8) * 8, tl = t & (S - 1);
        const size_t o = (size_t)t * DFF + c8;
        const u32x4 z = {0u, 0u, 0u, 0u};
        const u32x4 x2 = *(const u32x4*)(fa + o), x1 = tl >= 1 ? *(const u32x4*)(fa + o - DFF) : z, x0 = tl >= 2 ? *(const u32x4*)(fa + o - 2 * DFF) : z, uu = *(const u32x4*)(fu + o);
        const f32x4 w0a = *(const f32x4*)(cw + c8), w0b = *(const f32x4*)(cw + c8 + 4), w1a = *(const f32x4*)(cw + DFF + c8), w1b = *(const f32x4*)(cw + DFF + c8 + 4), w2a = *(const f32x4*)(cw + 2 * DFF + c8), w2b = *(const f32x4*)(cw + 2 * DFF + c8 + 4);
        const f32x4 ba = *(const f32x4*)(cb + c8), bb = *(const f32x4*)(cb + c8 + 4);
        float r[8];
#define FM1(k, B0, W0, W1, W2, X0, X1, X2, Uv, F) r[k] = gelu_t(B0 + W0 * F(X0) + W1 * F(X1) + W2 * F(X2)) * F(Uv)
        FM1(0, ba.x, w0a.x, w1a.x, w2a.x, x0.x, x1.x, x2.x, uu.x, bflo); FM1(1, ba.y, w0a.y, w1a.y, w2a.y, x0.x, x1.x, x2.x, uu.x, bfhi);
        FM1(2, ba.z, w0a.z, w1a.z, w2a.z, x0.y, x1.y, x2.y, uu.y, bflo); FM1(3, ba.w, w0a.w, w1a.w, w2a.w, x0.y, x1.y, x2.y, uu.y, bfhi);
        FM1(4, bb.x, w0b.x, w1b.x, w2b.x, x0.z, x1.z, x2.z, uu.z, bflo); FM1(5, bb.y, w0b.y, w1b.y, w2b.y, x0.z, x1.z, x2.z, uu.z, bfhi);
        FM1(6, bb.z, w0b.z, w1b.z, w2b.z, x0.w, x1.w, x2.w, uu.w, bflo); FM1(7, bb.w, w0b.w, w1b.w, w2b.w, x0.w, x1.w, x2.w, uu.w, bfhi);
#undef FM1
        u32x4 ov; ov.x = pk2(r[0], r[1]); ov.y = pk2(r[2], r[3]); ov.z = pk2(r[4], r[5]); ov.w = pk2(r[6], r[7]);
        *(u32x4*)(fu + o) = ov;
    }
}

typedef short s16x4 __attribute__((ext_vector_type(4)));
DEV s16x4 vtr(const LAS unsigned char* p) { return __builtin_bit_cast(s16x4, __builtin_amdgcn_ds_read_tr16_b64_v4i16((LAS s16x4*)p)); }
DEV bf16x8 cat8(const s16x4 a, const s16x4 b) { return (bf16x8){a[0], a[1], a[2], a[3], b[0], b[1], b[2], b[3]}; }
DEV bf16x8 pk8(float a0, float a1, float a2, float a3, float a4, float a5, float a6, float a7) {
    u32x4 w; w.x = pk2(a0, a1); w.y = pk2(a2, a3); w.z = pk2(a4, a5); w.w = pk2(a6, a7); return __builtin_bit_cast(bf16x8, w); }
constexpr int VPITCH = 192;
DEV void pv_tile(f32x16& o0, f32x16& o1, const LAS unsigned char* vt, int lane, const bf16x8 (&pk)[4]) {
    const int hi = lane >> 5;
    const LAS unsigned char* vb = vt + (4 * hi + ((lane & 15) >> 2)) * VPITCH + ((lane >> 4) & 1) * 32 + (lane & 3) * 8;
#pragma unroll
    for (int ks = 0; ks < 4; ++ks) {
        const bf16x8 va = cat8(vtr(vb + (16 * ks) * VPITCH), vtr(vb + (16 * ks + 8) * VPITCH));
        const bf16x8 vb2 = cat8(vtr(vb + (16 * ks) * VPITCH + 64), vtr(vb + (16 * ks + 8) * VPITCH + 64));
        o0 = __builtin_amdgcn_mfma_f32_32x32x16_bf16(va, pk[ks], o0, 0, 0, 0);
        o1 = __builtin_amdgcn_mfma_f32_32x32x16_bf16(vb2, pk[ks], o1, 0, 0, 0);
    }
}
DEV void store_ot(bf16_t* orow, const f32x16& o0, const f32x16& o1, int hi, float sc) {
#pragma unroll
    for (int g4 = 0; g4 < 4; ++g4) {
        u32x2 a; a.x = pk2(o0[4 * g4] * sc, o0[4 * g4 + 1] * sc); a.y = pk2(o0[4 * g4 + 2] * sc, o0[4 * g4 + 3] * sc);
        u32x2 b; b.x = pk2(o1[4 * g4] * sc, o1[4 * g4 + 1] * sc); b.y = pk2(o1[4 * g4 + 2] * sc, o1[4 * g4 + 3] * sc);
        *(u32x2*)(orow + 8 * g4 + 4 * hi) = a; *(u32x2*)(orow + 32 + 8 * g4 + 4 * hi) = b;
    }
}

DEV void sb_item(LAS unsigned char* vl, const bf16_t* Q, const bf16_t* Kk, const bf16_t* V, bf16_t* O, int b, int h, int qb, int lane) {
    const int r32 = lane & 31, hi = lane >> 5, t0 = 32 * qb, t = t0 + r32; const size_t rowb = (size_t)b * S;
    bf16x8 qr[4]; { const bf16_t* qp = Q + (rowb + t0 + r32) * 512 + h * 64 + 8 * hi;
#pragma unroll
        for (int d0 = 0; d0 < 4; ++d0) qr[d0] = *(const bf16x8*)(qp + 16 * d0); }
    f32x16 o0, o1;
#pragma unroll
    for (int r = 0; r < 16; ++r) { o0[r] = 0.f; o1[r] = 0.f; }
    float carry = 1.f;
    const int c_hi = (t0 + 30) >> 6;
#pragma unroll 1
    for (int c = c_hi; c >= 0; --c) {
        const bf16_t* kp = Kk + (rowb + 64 * c + r32) * 512 + h * 64 + 8 * hi;
        bf16x8 k0[4], k1[4];
#pragma unroll
        for (int d0 = 0; d0 < 4; ++d0) { k0[d0] = *(const bf16x8*)(kp + 16 * d0); k1[d0] = *(const bf16x8*)(kp + (size_t)32 * 512 + 16 * d0); }
#pragma unroll
        for (int j = 0; j < 8; ++j) { const int row = (lane >> 3) + 8 * j; *(LAS u32x4*)(vl + row * VPITCH + (lane & 7) * 16) = *(const u32x4*)(V + (rowb + 64 * c + row) * 512 + h * 64 + (lane & 7) * 8); }
        f32x16 p0, p1;
#pragma unroll
        for (int r = 0; r < 16; ++r) { p0[r] = 0.f; p1[r] = 0.f; }
#pragma unroll
        for (int d0 = 0; d0 < 4; ++d0) { p0 = __builtin_amdgcn_mfma_f32_32x32x16_bf16(k0[d0], qr[d0], p0, 0, 0, 0); p1 = __builtin_amdgcn_mfma_f32_32x32x16_bf16(k1[d0], qr[d0], p1, 0, 0, 0); }
        float u[32];
        const bool diag = (c == c_hi);
#pragma unroll
        for (int e = 0; e < 32; ++e) {
            const float z = e < 16 ? p0[e] : p1[e - 16];
            float uu = __builtin_amdgcn_rcpf(1.f + __builtin_amdgcn_exp2f(fminf(z, 126.f)));
            if (diag) { const int kv = 64 * c + 8 * ((e >> 2) & 3) + 4 * hi + (e & 3) + 32 * (e >> 4); if (kv >= t) uu = 1.f; }
            u[e] = uu;
        }
        float gl[8], gh[8];
#pragma unroll
        for (int i = 0; i < 8; ++i) { const float gp = (u[4 * i] * u[4 * i + 1]) * (u[4 * i + 2] * u[4 * i + 3]);
            const auto rr = __builtin_amdgcn_permlane32_swap(__float_as_uint(gp), __float_as_uint(gp), false, false); gl[i] = __uint_as_float(rr[0]); gh[i] = __uint_as_float(rr[1]); }
        float ag[8]; float run = carry;
#pragma unroll
        for (int i = 7; i >= 0; --i) { const float a_hi = run; run *= gh[i]; const float a_lo = run; run *= gl[i]; ag[i] = hi ? a_hi : a_lo; }
        carry = run;
        bf16x8 pk[4];
#pragma unroll
        for (int ks = 0; ks < 4; ++ks) { float w[8];
#pragma unroll
            for (int g = 0; g < 2; ++g) { const int i = 2 * ks + g;
                const float a3 = ag[i], a2 = a3 * u[4 * i + 3], a1 = a2 * u[4 * i + 2], a0 = a1 * u[4 * i + 1];
                w[4 * g] = (1.f - u[4 * i]) * a0; w[4 * g + 1] = (1.f - u[4 * i + 1]) * a1; w[4 * g + 2] = (1.f - u[4 * i + 2]) * a2; w[4 * g + 3] = (1.f - u[4 * i + 3]) * a3; }
            pk[ks] = pk8(w[0], w[1], w[2], w[3], w[4], w[5], w[6], w[7]); }
        pv_tile(o0, o1, vl, lane, pk);
        if (__all(carry < 7.8e-31f)) break;
    }
    store_ot(O + (rowb + t0 + r32) * 512 + h * 64, o0, o1, hi, 1.f);
}
DEV void sb_phase(const WaveId& W, LAS unsigned char* lds, unsigned char* ws) {
    LAS unsigned char* vl = lds + W.wave * 12288;
    const bf16_t* Q = (const bf16_t*)(ws + WS_QA); const bf16_t* Kk = (const bf16_t*)(ws + WS_KA); const bf16_t* V = (const bf16_t*)(ws + WS_VA);
    constexpr int NITEM = NB * 8 * (S / 32);
    for (int it = W.gw; it < NITEM; it += W.ngw) {
        const int qb = it & 255, h = (it >> 8) & 7, b = it >> 11;
        sb_item(vl, Q, Kk, V, (bf16_t*)(ws + WS_QA), b, h, qb, W.lane);
    }
}

constexpr int IDX_CTL_OFF = 131072 + 1024;
DEV unsigned fkey2(float v) { const int u = (int)__float_as_uint(v); return (unsigned)(u ^ ((u >> 31) | (int)0x80000000)); }
DEV float relu1(float x) { return __builtin_amdgcn_fmed3f(x, 0.f, 3.0e38f); }
DEV void idx_unit(LAS unsigned char* lds, const bf16_t* IQ, const bf16_t* IK, const float* IWp, unsigned* BM, int b, int t0, int wid, int lane, int mslot) {
    const int r32 = lane & 31, hh = lane >> 5; const size_t rowb = (size_t)b * S;
    LAS unsigned* cntbuf = (LAS unsigned*)(lds + IDX_CTL_OFF);
    LAS unsigned* eqc = (LAS unsigned*)(lds + IDX_CTL_OFF + 1024);
    bf16x8 afr[4]; { const int qi = 2 * (r32 >> 4) + ((r32 >> 2) & 1), head = (r32 & 3) + 4 * ((r32 >> 3) & 1);
        const bf16_t* ap = IQ + (rowb + t0 + qi) * 512 + head * 64 + 8 * hh;
#pragma unroll
        for (int ks = 0; ks < 4; ++ks) afr[ks] = *(const bf16x8*)(ap + 16 * ks); }
    float w[16];
#pragma unroll
    for (int r = 0; r < 16; ++r) w[r] = IWp[(rowb + t0 + 2 * (r >> 3) + hh) * 8 + (r & 7)];
    const int tmax = t0 + 3, jmax = tmax >> 5;
    LAS unsigned* SCO = (LAS unsigned*)lds;
    bf16x8 b0[4], b1[4], b2[4];
#pragma unroll
    for (int ks = 0; ks < 4; ++ks) { b0[ks] = afr[ks]; b1[ks] = afr[ks]; b2[ks] = afr[ks]; }
#define IDX_LOADB(dst, jj) do { const int jc_ = (jj) < jmax ? (jj) : jmax; const bf16_t* bp_ = IK + ((rowb >> 5) + jc_) * 2048 + (hh * 32 + r32) * 8; \
        _Pragma("unroll") for (int ks = 0; ks < 4; ++ks) dst[ks] = *(const bf16x8*)(bp_ + ks * 512); } while (0)
#define IDX_COMP(src, jj) do { f32x16 acc; _Pragma("unroll") for (int r = 0; r < 16; ++r) acc[r] = 0.f; \
        _Pragma("unroll") for (int ks = 0; ks < 4; ++ks) acc = __builtin_amdgcn_mfma_f32_32x32x16_bf16(afr[ks], src[ks], acc, 0, 0, 0); \
        float s0 = 0.f, s1 = 0.f; _Pragma("unroll") for (int hd = 0; hd < 8; ++hd) { s0 += w[hd] * relu1(acc[hd]); s1 += w[8 + hd] * relu1(acc[8 + hd]); } \
        unsigned k0_ = fkey2(s0), k1_ = fkey2(s1); const int key = 32 * (jj) + r32; \
        if ((jj) >= jmax) { k0_ = key <= t0 + hh ? k0_ : 0u; k1_ = key <= t0 + 2 + hh ? k1_ : 0u; }     \
        if ((jj) <= jmax) { SCO[hh * 8192 + key] = k0_; SCO[(2 + hh) * 8192 + key] = k1_; } } while (0)
#ifndef IDX_REP_MFMA
#define IDX_REP_MFMA 1
#endif
#ifndef IDX_REP_SEL
#define IDX_REP_SEL 1
#endif
#pragma unroll 1
    for (int rpm = 0; rpm < IDX_REP_MFMA; ++rpm) {
    IDX_LOADB(b0, wid); IDX_LOADB(b1, wid + 8);
#pragma unroll 1
    for (int j = wid; j <= jmax; j += 24) {
        IDX_LOADB(b2, j + 16); IDX_COMP(b0, j);
        IDX_LOADB(b0, j + 24); IDX_COMP(b1, j + 8);
        IDX_LOADB(b1, j + 32); IDX_COMP(b2, j + 16);
    }
    }
#undef IDX_LOADB
#undef IDX_COMP
    unsigned sc[32][2];
#pragma unroll
    for (int s = 0; s < 32; ++s) { const int j = wid + 8 * s; const bool v = j <= jmax;
        sc[s][0] = v ? SCO[hh * 8192 + 32 * j + r32] : 0u; sc[s][1] = v ? SCO[(2 + hh) * 8192 + 32 * j + r32] : 0u; }
    const int qrow = lane & 3;
    unsigned lo_, hi_, chi_, xgt_, xeq_, mt_; float glo_, ghi_; int side_; bool done_;
#pragma unroll 1
    for (int rps = 0; rps < IDX_REP_SEL; ++rps) {
    { unsigned mx0 = 0u, mx1 = 0u;
#pragma unroll
      for (int s = 0; s < 32; ++s) { mx0 = max(mx0, sc[s][0]); mx1 = max(mx1, sc[s][1]); }
      LAS unsigned* mxs = cntbuf + 64 + 4 * mslot;
      if (wid == 0 && lane < 4) cntbuf[64 + 4 * (mslot ^ 1) + lane] = 0u;
      __hip_atomic_fetch_max(mxs + hh, mx0, __ATOMIC_RELAXED, __HIP_MEMORY_SCOPE_WORKGROUP); __hip_atomic_fetch_max(mxs + 2 + hh, mx1, __ATOMIC_RELAXED, __HIP_MEMORY_SCOPE_WORKGROUP);
      LDS_WAIT(); __builtin_amdgcn_s_barrier(); asm volatile("" ::: "memory");
      const int n = t0 + qrow + 1;
      lo_ = 1u; glo_ = __log2f((float)n) - 8.f; hi_ = mxs[qrow] + 1u; chi_ = 0u; ghi_ = -9.f; side_ = 0; xeq_ = 0u; mt_ = 0u; xgt_ = 1u; done_ = n <= 256; }
    int par = 0;
#pragma unroll 1
    for (int pass = 0; pass < 160; ++pass) {
        if (__all(done_)) break;
        unsigned cand_;
        { const unsigned wdt = hi_ - lo_;
          unsigned off;
          if (pass < 2) {
              const unsigned mkey = hi_ - 1u; const unsigned tgt = pass == 0 ? mkey - (1u << 23) : mkey - (3u << 23);
              const bool ok = pass == 0 ? (mkey > 0x81000000u) : (mkey > 0x82000000u && tgt > lo_ && tgt < hi_);
              off = ok ? tgt - lo_ : wdt >> 1;
          } else if ((pass & 3) == 3) off = wdt >> 1;
          else off = (unsigned)(glo_ * __builtin_amdgcn_rcpf(glo_ - ghi_) * (float)wdt);
          off = off < 1u ? 1u : (off > wdt - 1u ? wdt - 1u : off);
          cand_ = done_ ? xgt_ : lo_ + off; }
        const unsigned cq0 = (unsigned)__builtin_amdgcn_readlane((int)cand_, 0), cq1 = (unsigned)__builtin_amdgcn_readlane((int)cand_, 1),
                       cq2 = (unsigned)__builtin_amdgcn_readlane((int)cand_, 2), cq3 = (unsigned)__builtin_amdgcn_readlane((int)cand_, 3);
        const unsigned c0 = hh ? cq1 : cq0, c1 = hh ? cq3 : cq2;
        unsigned n0 = 0, n1 = 0;
#pragma unroll
        for (int s = 0; s < 32; ++s) { n0 += sc[s][0] >= c0; n1 += sc[s][1] >= c1; }
        int pk = (int)(n0 | (n1 << 16));
        pk += __builtin_amdgcn_update_dpp(0, pk, 0x111, 0xf, 0xf, false);
        pk += __builtin_amdgcn_update_dpp(0, pk, 0x112, 0xf, 0xf, false);
        pk += __builtin_amdgcn_update_dpp(0, pk, 0x114, 0xf, 0xf, false);
        pk += __builtin_amdgcn_update_dpp(0, pk, 0x118, 0xf, 0xf, false);
        pk += __builtin_amdgcn_update_dpp(0, pk, 0x142, 0xa, 0xf, false);
        if (lane == 31) { cntbuf[(par * 8 + wid) * 4 + 0] = (unsigned)pk & 0xffffu; cntbuf[(par * 8 + wid) * 4 + 2] = (unsigned)pk >> 16; }
        if (lane == 63) { cntbuf[(par * 8 + wid) * 4 + 1] = (unsigned)pk & 0xffffu; cntbuf[(par * 8 + wid) * 4 + 3] = (unsigned)pk >> 16; }
        LDS_WAIT(); __builtin_amdgcn_s_barrier(); asm volatile("" ::: "memory");
        unsigned tot = 0u;
#pragma unroll
        for (int wv = 0; wv < 8; ++wv) tot += cntbuf[(par * 8 + wv) * 4 + qrow];
        par ^= 1;
        {
            const float gc = __log2f(fmaxf((float)tot, 0.5f)) - 8.f;
            const bool act = !done_, eq = tot == 256u, gt = tot > 256u;
            const bool upl = act && !eq && gt, uph = act && !eq && !gt;
            if (upl) { if (side_ == 1) ghi_ *= 0.5f; lo_ = cand_; glo_ = gc; side_ = 1; }
            if (uph) { if (side_ == 2) glo_ *= 0.5f; hi_ = cand_; ghi_ = gc; chi_ = tot; side_ = 2; }
            if (act && eq) { xgt_ = cand_; mt_ = 0u; done_ = true; }
            if ((upl || uph) && hi_ - lo_ == 1u) { xgt_ = hi_; xeq_ = lo_; mt_ = 256u - chi_; done_ = true; }
        }
    }
    }
    unsigned xgt[4], xeq[4], mt[4];
#pragma unroll
    for (int q = 0; q < 4; ++q) { xgt[q] = (unsigned)__builtin_amdgcn_readlane((int)xgt_, q); xeq[q] = (unsigned)__builtin_amdgcn_readlane((int)xeq_, q); mt[q] = (unsigned)__builtin_amdgcn_readlane((int)mt_, q); }
    const unsigned xg0 = hh ? xgt[1] : xgt[0], xg1 = hh ? xgt[3] : xgt[2], xe0 = hh ? xeq[1] : xeq[0], xe1 = hh ? xeq[3] : xeq[2], m0 = hh ? mt[1] : mt[0], m1 = hh ? mt[3] : mt[2];
    const bool ties = (mt[0] | mt[1] | mt[2] | mt[3]) != 0u;
    if (ties) {
        __builtin_amdgcn_s_barrier();
#pragma unroll
        for (int s = 0; s < 32; ++s) { const int j = wid + 8 * s;
            const unsigned long long e0 = __ballot(sc[s][0] == xe0 && m0 != 0u), e1 = __ballot(sc[s][1] == xe1 && m1 != 0u);
            if (lane == 0) { eqc[0 * 256 + j] = __popc((unsigned)e0); eqc[1 * 256 + j] = __popc((unsigned)(e0 >> 32)); eqc[2 * 256 + j] = __popc((unsigned)e1); eqc[3 * 256 + j] = __popc((unsigned)(e1 >> 32)); } }
        LDS_WAIT(); __builtin_amdgcn_s_barrier(); asm volatile("" ::: "memory");
        if (wid < 4) { unsigned v[4], s4 = 0;
#pragma unroll
            for (int i = 0; i < 4; ++i) { v[i] = eqc[wid * 256 + 4 * lane + i]; s4 += v[i]; }
            unsigned inc = s4;
#pragma unroll
            for (int o = 1; o < 64; o <<= 1) { const unsigned tv = __shfl_up(inc, o); if (lane >= o) inc += tv; }
            unsigned run = inc - s4;
#pragma unroll
            for (int i = 0; i < 4; ++i) { eqc[wid * 256 + 4 * lane + i] = run; run += v[i]; } }
        LDS_WAIT(); __builtin_amdgcn_s_barrier(); asm volatile("" ::: "memory");
    }
    const unsigned lower = (1u << r32) - 1u;
#pragma unroll
    for (int s = 0; s < 32; ++s) { const int j = wid + 8 * s;
        bool s0 = sc[s][0] >= xg0, s1 = sc[s][1] >= xg1;
        if (ties) {
            const unsigned long long e0 = __ballot(sc[s][0] == xe0 && m0 != 0u), e1 = __ballot(sc[s][1] == xe1 && m1 != 0u);
            const unsigned h0 = hh ? (unsigned)(e0 >> 32) : (unsigned)e0, h1 = hh ? (unsigned)(e1 >> 32) : (unsigned)e1;
            const unsigned rk0 = eqc[hh * 256 + j] + __popc(h0 & lower), rk1 = eqc[(2 + hh) * 256 + j] + __popc(h1 & lower);
            s0 = s0 || (sc[s][0] == xe0 && rk0 < m0); s1 = s1 || (sc[s][1] == xe1 && rk1 < m1);
        }
        const unsigned long long b0 = __ballot(s0), b1 = __ballot(s1);
        if (lane == 0) { u32x4 o; o.x = (unsigned)b0; o.y = (unsigned)(b0 >> 32); o.z = (unsigned)b1; o.w = (unsigned)(b1 >> 32); *(u32x4*)(BM + ((size_t)b * 256 + j) * S + t0) = o; }
    }
    __builtin_amdgcn_s_barrier();
}
DEV void idx_phase(LAS unsigned char* lds, unsigned char* ws, int vcu, int G, int wid, int lane) {
    constexpr int NUNIT = T / 4;
    if (wid == 0 && lane < 8) ((LAS unsigned*)(lds + IDX_CTL_OFF))[64 + lane] = 0u;
    LDS_WAIT(); __builtin_amdgcn_s_barrier();
    int k = 0;
    for (int un = vcu; un < NUNIT; un += G, ++k) {
        const int b = un / (S / 4), t0 = (un - b * (S / 4)) * 4;
        idx_unit(lds, (const bf16_t*)(ws + WS_IQ), (const bf16_t*)(ws + WS_IK), (const float*)(ws + WS_IW), (unsigned*)(ws + WS_BM), b, t0, wid, lane, k & 1);
    }
}

constexpr int DSA_KOFF = 0, DSA_VOFF = 2 * 8192, DSA_STAGE = 8192 + 64 * VPITCH;
DEV void dsa_unit(LAS unsigned char* lds, const bf16_t* Q, const bf16_t* Kk, const bf16_t* V, const unsigned* BM, bf16_t* O, int b, int h, int qblk, int tid, int wid, int lane) {
    const int r32 = lane & 31, hi = lane >> 5, q0 = 256 * qblk, t0 = q0 + 32 * wid, t = t0 + r32; const size_t rowb = (size_t)b * S;
    bf16x8 qr[4]; { const bf16_t* qp = Q + (rowb + t) * 512 + h * 64 + 8 * hi;
#pragma unroll
        for (int d0 = 0; d0 < 4; ++d0) qr[d0] = *(const bf16x8*)(qp + 16 * d0); }
    f32x16 o0, o1;
#pragma unroll
    for (int r = 0; r < 16; ++r) { o0[r] = 0.f; o1[r] = 0.f; }
    float mrow = -INFINITY, lsum = 0.f;
    const int ntile = (q0 + 256) / 64, wlast = (t0 + 31) >> 6;
    const int srow = tid >> 3, sch = tid & 7;
    const bf16_t* kg = Kk + (rowb + srow) * 512 + h * 64 + sch * 8; const bf16_t* vg = V + (rowb + srow) * 512 + h * 64 + sch * 8;
    const int kdst = srow * 128 + ((sch ^ (srow & 7)) * 16), vdst = srow * VPITCH + sch * 16;
    u32x4 kreg = *(const u32x4*)kg, vreg = *(const u32x4*)vg;
    *(LAS u32x4*)(lds + kdst) = kreg; *(LAS u32x4*)(lds + 8192 + vdst) = vreg;
    const unsigned* bmp = BM + (size_t)b * 256 * S + t;
    unsigned mw0 = bmp[0], mw1 = bmp[(size_t)S];
    __syncthreads();
#pragma unroll 1
    for (int c = 0; c < ntile; ++c) {
        const LAS unsigned char* kt = lds + (c & 1) * DSA_STAGE; const LAS unsigned char* vt = kt + 8192;
        if (c + 1 < ntile) { kreg = *(const u32x4*)(kg + (size_t)(c + 1) * 64 * 512); vreg = *(const u32x4*)(vg + (size_t)(c + 1) * 64 * 512); }
        unsigned nw0 = 0u, nw1 = 0u;
        if (c + 1 <= wlast) { nw0 = bmp[(size_t)(2 * c + 2) * S]; nw1 = bmp[(size_t)(2 * c + 3) * S]; }
        if (c <= wlast) {
            f32x16 p0, p1;
#pragma unroll
            for (int r = 0; r < 16; ++r) { p0[r] = 0.f; p1[r] = 0.f; }
#pragma unroll
            for (int d0 = 0; d0 < 4; ++d0) {
                const int ch = 2 * d0 + hi;
                const bf16x8 ka = *(const LAS bf16x8*)(kt + r32 * 128 + ((ch ^ (r32 & 7)) * 16));
                const bf16x8 kb = *(const LAS bf16x8*)(kt + (32 + r32) * 128 + ((ch ^ (r32 & 7)) * 16));
                p0 = __builtin_amdgcn_mfma_f32_32x32x16_bf16(ka, qr[d0], p0, 0, 0, 0);
                p1 = __builtin_amdgcn_mfma_f32_32x32x16_bf16(kb, qr[d0], p1, 0, 0, 0);
            }
            const unsigned m0 = mw0 >> (4 * hi), m1 = mw1 >> (4 * hi);
            float tmax = -INFINITY;
#pragma unroll
            for (int r = 0; r < 16; ++r) { const int bit = (r & 3) + 8 * (r >> 2);
                const unsigned e0 = (unsigned)__builtin_amdgcn_sbfe((int)m0, bit, 1), e1 = (unsigned)__builtin_amdgcn_sbfe((int)m1, bit, 1);
                p0[r] = __uint_as_float((__float_as_uint(p0[r]) & e0) | (0xff800000u & ~e0)); p1[r] = __uint_as_float((__float_as_uint(p1[r]) & e1) | (0xff800000u & ~e1)); }
#pragma unroll
            for (int r = 0; r < 16; r += 2) tmax = fmaxf(tmax, fmaxf(fmaxf(p0[r], p0[r + 1]), fmaxf(p1[r], p1[r + 1])));
            { const auto rr = __builtin_amdgcn_permlane32_swap(__float_as_uint(tmax), __float_as_uint(tmax), false, false); tmax = fmaxf(__uint_as_float(rr[0]), __uint_as_float(rr[1])); }
            const float mnew = fmaxf(mrow, tmax);
            const float muse = mnew == -INFINITY ? 0.f : mnew;
            if (!__all(mnew == mrow)) {
                const float alpha = __builtin_amdgcn_exp2f(mrow - muse);
                lsum *= alpha;
#pragma unroll
                for (int r = 0; r < 16; ++r) { o0[r] *= alpha; o1[r] *= alpha; }
                mrow = mnew;
            }
            float ps = 0.f;
#pragma unroll
            for (int r = 0; r < 16; ++r) { p0[r] = __builtin_amdgcn_exp2f(p0[r] - muse); p1[r] = __builtin_amdgcn_exp2f(p1[r] - muse); ps += p0[r] + p1[r]; }
            lsum += ps;
            bf16x8 pk[4];
            pk[0] = pk8(p0[0], p0[1], p0[2], p0[3], p0[4], p0[5], p0[6], p0[7]); pk[1] = pk8(p0[8], p0[9], p0[10], p0[11], p0[12], p0[13], p0[14], p0[15]);
            pk[2] = pk8(p1[0], p1[1], p1[2], p1[3], p1[4], p1[5], p1[6], p1[7]); pk[3] = pk8(p1[8], p1[9], p1[10], p1[11], p1[12], p1[13], p1[14], p1[15]);
            pv_tile(o0, o1, vt, lane, pk);
        }
        mw0 = nw0; mw1 = nw1;
        if (c + 1 < ntile) { LAS unsigned char* nb = lds + ((c + 1) & 1) * DSA_STAGE; *(LAS u32x4*)(nb + kdst) = kreg; *(LAS u32x4*)(nb + 8192 + vdst) = vreg; }
        __syncthreads();
    }
    { const auto rr = __builtin_amdgcn_permlane32_swap(__float_as_uint(lsum), __float_as_uint(lsum), false, false); lsum = __uint_as_float(rr[0]) + __uint_as_float(rr[1]); }
    store_ot(O + (rowb + t) * 512 + h * 64, o0, o1, hi, 1.f / lsum);
}
DEV void dsa_phase(LAS unsigned char* lds, unsigned char* ws, int vcu, int G, int tid, int wid, int lane, bf16_t* Oout) {
    constexpr int NPAIR = NB * 8 * 16;
    for (int pr = vcu; pr < NPAIR; pr += G) {
        const int bh = pr >> 4, s = pr & 15, b = bh >> 3, h = bh & 7;
#pragma unroll 1
        for (int k = 0; k < 2; ++k) {
            const int qblk = k == 0 ? s : 31 - s;
            dsa_unit(lds, (const bf16_t*)(ws + WS_QC), (const bf16_t*)(ws + WS_KC), (const bf16_t*)(ws + WS_VC), (const unsigned*)(ws + WS_BM), Oout, b, h, qblk, tid, wid, lane);
        }
    }
}
constexpr int MK_THREADS = 512;
constexpr int RING_BYTES = 131072, MISC_OFF = RING_BYTES + 320, MK_LDS_BYTES = 147456;
constexpr size_t WS_CTL = 0, CTL_ZERO_BYTES = 65536 + 7 * 65536; constexpr int CW_BAR = 4096;
constexpr int PH_PREP0 = 0, PH_KV = 1, PH_GH = 2, PH_L0 = 3, PH_PER_LAYER = 14, NPH = PH_L0 + 2 * PH_PER_LAYER;
enum { Q_INPROJ = 0, Q_SBIDX, Q_DSA, Q_GATES, Q_MERGE, Q_MIX, Q_NORMXA, Q_XALOG, Q_XAOUT, Q_NORMFFN, Q_UP, Q_FFNMID, Q_DOWN, Q_NEXT };

#ifndef QBUILD
#define QBUILD 0xffffu
#endif
#define QON(x) ((QBUILD >> (x)) & 1u)
struct Args { const float* in[20]; float* out; unsigned char* ws; int ph_lo, ph_hi; };

__global__ void __launch_bounds__(MK_THREADS, 2) mk_fwd(Args args) {
    __shared__ __attribute__((aligned(16))) unsigned char lds_raw[MK_LDS_BYTES];
    LAS unsigned char* lds = (LAS unsigned char*)lds_raw;
    volatile LAS unsigned* MISC = (volatile LAS unsigned*)(lds + MISC_OFF);
    const int G = gridDim.x, bx = blockIdx.x;
    unsigned char* ws0 = args.ws;
    for (int u = threadIdx.x; u < (MK_LDS_BYTES - RING_BYTES) / 4; u += MK_THREADS) ((LAS unsigned*)(lds + RING_BYTES))[u] = 0u;
    __syncthreads();
    const int lo = args.ph_lo, hi = args.ph_hi;
    XcdBarrier bar; bar.bar = (unsigned*)(ws0 + WS_CTL) + CW_BAR; bar.x = 0; bar.st = nullptr;
    if (hi - lo > 1) bar = xcd_barrier_post((unsigned*)(ws0 + WS_CTL) + CW_BAR, MISC + 8);
#define BPW(off) ((bf16_t*)(ws + (off)))
    const int vcu = (G % 8 == 0) ? (bx % 8) * (G / 8) + bx / 8 : bx;
    for (int p = lo; p < hi; ++p) {
#ifdef PROBE_REP
        const int reps = (p >= PH_L0 && ((PROBE_REP >> ((p - PH_L0) % PH_PER_LAYER)) & 1)) ? 2 : 1;
#else
        const int reps = 1;
#endif
#ifdef PROBE_REP
#pragma unroll 1
        for (int rep = 0; rep < reps; ++rep) {
        const bool dry = rep + 1 < reps;
#else
        { constexpr bool dry = false;
#endif
        int oz = 0; asm volatile("" : "+s"(oz));
        int tid = threadIdx.x; asm volatile("" : "+v"(tid));
        const int wave = __builtin_amdgcn_readfirstlane(tid >> 6), lane = tid & 63;
        WaveId W; W.gw = vcu * 8 + wave; W.ngw = G * 8; W.wave = wave; W.lane = lane;
        unsigned char* ws = args.ws + oz; float* X = args.out + oz;
#define INP(k) (args.in[(k) + oz])
        if (p == PH_PREP0) {
            prep0_phase(W, (LAS float*)(lds + wave * 16384), ws, args.in + oz);
        } else if (p == PH_KV && QON(14)) {
            pg8::Order S; S.init(2, 8, 2, G, bx);
            pg8::PtrStd P{(const char*)(ws + WS_MEMN), (const char*)(ws + WS_WKVT), 1 * MiB, 4 * MiB, 0, (size_t)256 * D * 2, (size_t)256 * D * 2};
            pg8::EpiPrep E{ws, 0};
            pg8::gemm_phase<pg8::EpiPrep, pg8::PtrStd, true, true>(lds, D, D, D, S, P, E);
        } else if (p == PH_GH && QON(15)) {
            { pg8::Order S; S.init(1, 4, 16, G, bx); pg8::PtrG P{(const char*)(ws + WS_KVM), (const char*)(ws + WS_WQ)}; pg8::EpiPrep E{ws, 1};
              pg8::gemm_phase<pg8::EpiPrep, pg8::PtrG, true, true>(lds, 2 * D, D, 256, S, P, E); }
            { pg8::Order S; S.init(4, 1, 16, G, (bx + 64) % G); pg8::PtrH P{(const char*)(ws + WS_KVM), (const char*)(ws + WS_WOT)}; pg8::EpiPrep E{ws, 2};
              pg8::gemm_phase<pg8::EpiPrep, pg8::PtrH, true, true>(lds, D, 2 * D, 256, S, P, E); }
        } else if (p >= PH_L0) {
            const int l = (p - PH_L0) / PH_PER_LAYER, q = (p - PH_L0) % PH_PER_LAYER;
            const float* Xin = l == 0 ? INP(0) : X;
            float* SSb = (float*)(ws + WS_SS);
#define SSA(i) (SSb + (size_t)(i) * T)
            if (q == Q_SBIDX) {
#ifndef NO_SB
                if (!dry) sb_phase(W, lds, ws);
#endif
                __syncthreads();
#ifndef NO_IDX
                idx_phase(lds, ws, vcu, G, wave, lane);
#endif
                if (!dry) conv_sc_phase(vcu * MK_THREADS + tid, G * MK_THREADS, BPW(WS_SCB), BPW(WS_CX), INP(4) + l * 3 * 512);
            } else if (q == Q_DSA) {
#ifndef NO_DSA
                dsa_phase(lds, ws, vcu, G, tid, wave, lane, dry ? BPW(WS_KA) : BPW(WS_QC));
#endif
            } else if (q == Q_FFNMID) {
                if (!dry) ffn_mid_phase(vcu * MK_THREADS + tid, G * MK_THREADS, BPW(WS_FA), BPW(WS_FU), INP(16) + l * 3 * DFF, INP(17) + l * DFF);
            } else if (q == Q_NEXT) {
                if (l + 1 < DEPTH) { int base = 0; convert_layer_weights(W, (LAS float*)(lds + wave * 16384), base, ws, args.in + oz, l + 1); }
                else if (!dry) final_norm(W, X, INP(19), SSA(6));
            } else if (q == Q_INPROJ && QON(Q_INPROJ)) {
                pg8::Order S; S.init(T / 256, NIN / 256, 1, G, bx);
                pg8::PtrStd P{(const char*)(ws + WS_XN), (const char*)(ws + WS_WIN), 0, 0, 0, (size_t)256 * D * 2, (size_t)256 * D * 2};
                pg8::EpiInProj E{ws, SSA(3 * l)};
                pg8::gemm_phase<pg8::EpiInProj, pg8::PtrStd, true, true>(lds, D, D, D, S, P, E);
            } else if (q == Q_GATES && QON(Q_GATES)) {
                pg8::Order S; S.init(T / 256, 12, 1, G, bx);
                pg8::PtrStd P{(const char*)(ws + WS_XN), (const char*)(ws + WS_WG), 0, 0, 0, (size_t)256 * D * 2, (size_t)256 * D * 2};
                pg8::EpiGates E{BPW(WS_GATES), SSA(3 * l)};
                pg8::gemm_phase<pg8::EpiGates, pg8::PtrStd, true, true>(lds, D, D, D, S, P, E);
            } else if (q == Q_MERGE && QON(Q_MERGE)) {
                pg8::Order S; S.init(T / 256, 4, 3, G, bx);
                pg8::PtrStd P{(const char*)(ws + WS_QA), (const char*)(ws + WS_WBR), 16 * MiB, (size_t)D * 512 * 2, 0, (size_t)256 * 512 * 2, (size_t)256 * 512 * 2};
                pg8::EpiMerge E{BPW(WS_XN), BPW(WS_GATES)};
                pg8::gemm_phase<pg8::EpiMerge, pg8::PtrStd, true, true>(lds, 512, 512, 512, S, P, E);
            } else if (q == Q_MIX && QON(Q_MIX)) {
                pg8::Order S; S.init(T / 256, 4, 1, G, bx);
                pg8::PtrStd P{(const char*)(ws + WS_XN), (const char*)(ws + WS_WMIX), 0, 0, 0, (size_t)256 * D * 2, (size_t)256 * D * 2};
                pg8::EpiResid E{Xin, dry ? (float*)(ws + WS_LOG) : X, dry ? BPW(WS_FU) : BPW(WS_XBXA), dry ? SSA(7) : SSA(1 + 3 * l)};
                pg8::gemm_phase<pg8::EpiResid, pg8::PtrStd, true, true>(lds, D, D, D, S, P, E);
            } else if (q == Q_XALOG && QON(Q_XALOG)) {
                pg8::Order S; S.init(T / 256, 4, 1, G, bx);
                pg8::PtrStd P{(const char*)(ws + WS_XBXA), (const char*)(ws + WS_GT + (size_t)l * 4 * MiB), 0, 0, 2 * MiB, (size_t)256 * D * 2, (size_t)256 * D * 2};
                pg8::EpiSoftmax E{BPW(WS_PXA), SSA(1 + 3 * l)};
                pg8::gemm_phase<pg8::EpiSoftmax, pg8::PtrStd, false, true>(lds, D, D, D, S, P, E);
            } else if (q == Q_XAOUT && QON(Q_XAOUT)) {
                pg8::Order S; S.init(T / 256, 4, 1, G, bx);
                pg8::PtrStd P{(const char*)(ws + WS_PXA), (const char*)(ws + WS_HT + (size_t)l * 4 * MiB), 0, 0, 2 * MiB, (size_t)256 * D * 2, (size_t)256 * D * 2};
                pg8::EpiResid E{X, dry ? (float*)(ws + WS_LOG) : X, dry ? BPW(WS_FU) : BPW(WS_XN), dry ? SSA(7) : SSA(2 + 3 * l)};
                pg8::gemm_phase<pg8::EpiResid, pg8::PtrStd, true, true>(lds, D, D, D, S, P, E);
            } else if (q == Q_UP && QON(Q_UP)) {
                pg8::Order S; S.init(T / 256, 22, 1, G, bx);
                pg8::PtrStd P{(const char*)(ws + WS_XN), (const char*)(ws + WS_WUP), 0, 0, 0, (size_t)256 * D * 2, (size_t)256 * D * 2};
                pg8::EpiUp E{BPW(WS_FA), BPW(WS_FU), SSA(2 + 3 * l)};
                pg8::gemm_phase<pg8::EpiUp, pg8::PtrStd, true, true>(lds, D, D, D, S, P, E);
            } else if (q == Q_DOWN && QON(Q_DOWN)) {
                pg8::Order S; S.init(T / 256, 4, 1, G, bx);
                pg8::PtrStd P{(const char*)(ws + WS_FU), (const char*)(ws + WS_WDOWN), 0, 0, 0, (size_t)256 * DFF * 2, (size_t)256 * DFF * 2};
                pg8::EpiResid E{X, dry ? (float*)(ws + WS_FA) : X, dry ? BPW(WS_QA) : BPW(WS_XN), dry ? SSA(7) : SSA(3 + 3 * l)};
                pg8::gemm_phase<pg8::EpiResid, pg8::PtrStd, true, true>(lds, DFF, DFF, DFF, S, P, E);
            }
        }
        }
        if (p + 1 < hi && !(p >= PH_L0 && ((p - PH_L0) % PH_PER_LAYER == Q_NORMXA || (p - PH_L0) % PH_PER_LAYER == Q_NORMFFN))) xcd_barrier(bar);
    }
}

extern "C" void kernel_launch(void* const* d_in, const int* in_sizes, int n_in, void* d_out, int out_size, void* d_ws, size_t ws_size, hipStream_t st) {
    if (n_in != 20 || ws_size < WS_NEED || out_size != T * D) { fprintf(stderr, "kernel_launch: unexpected sizes n_in %d ws %zu out %d\n", n_in, ws_size, out_size); return; }
    static int grid = 0;
    if (grid == 0) {
        int dev = 0, cus = 0, per_cu = 0;
        (void)hipGetDevice(&dev); (void)hipDeviceGetAttribute(&cus, hipDeviceAttributeMultiprocessorCount, dev);
        if (hipOccupancyMaxActiveBlocksPerMultiprocessor(&per_cu, (const void*)mk_fwd, MK_THREADS, 0) != hipSuccess || per_cu < 1) { fprintf(stderr, "kernel_launch: occupancy query says %d blocks/CU\n", per_cu); grid = -1; return; }
        (void)hipGetLastError();
        if (cus != 256) { fprintf(stderr, "kernel_launch: built for a 256-CU device, found %d\n", cus); grid = -1; return; }
        grid = cus;
    }
    if (grid < 0) return;
    (void)hipMemsetAsync((char*)d_ws + WS_CTL, 0, CTL_ZERO_BYTES, st);
    Args a{};
    for (int i = 0; i < 20; ++i) a.in[i] = (const float*)d_in[i];
    a.out = (float*)d_out; a.ws = (unsigned char*)d_ws; a.ph_lo = 0; a.ph_hi = NPH;
    hipLaunchKernelGGL(mk_fwd, dim3(grid), dim3(MK_THREADS), 0, st, a);
}
```

```cpp
#include <hip/hip_runtime.h>
#include <stdint.h>
#include <stdio.h>

typedef unsigned short bf16_t;
typedef short bf16x8 __attribute__((ext_vector_type(8)));
typedef float f32x16 __attribute__((ext_vector_type(16)));
typedef float f32x4 __attribute__((ext_vector_type(4)));
#define DEV __device__ __forceinline__

constexpr int NB = 2, S = 8192, D = 1024, T = NB * S, DEPTH = 2;
constexpr int DIN = 8264, DFF = 2816, MEM = 256;
constexpr int NIN = 5376;
constexpr float LOG2E = 1.4426950408889634f;
constexpr float QSCALE = 0.125f * LOG2E;
constexpr float WSCALE = 0.125f * 0.35355339059327373f;
constexpr float XSCALE = 0.0625f * LOG2E;
constexpr float EPS = 1e-6f;
#ifndef MK_FUSE
#define MK_FUSE 1
#endif

constexpr size_t MiB = 1u << 20;
constexpr size_t WS_GT = 1 * MiB;
constexpr size_t WS_HT = 9 * MiB;
constexpr size_t WS_WUP = 17 * MiB, WS_WDOWN = 28 * MiB;
constexpr size_t WS_XN = 34 * MiB;
constexpr size_t WS_WMIX = 66 * MiB, WS_WBR = 68 * MiB, WS_WG = 71 * MiB, WS_WIN = 77 * MiB;
constexpr size_t WS_QA = 88 * MiB, WS_SCB = 104 * MiB, WS_QC = 120 * MiB, WS_KA = 136 * MiB, WS_VA = 152 * MiB, WS_KC = 168 * MiB, WS_VC = 184 * MiB,
                 WS_IQ = 200 * MiB, WS_CX = 216 * MiB, WS_IK = 232 * MiB, WS_IW = 234 * MiB, WS_BM = 235 * MiB;
constexpr size_t WS_GATES = 136 * MiB;
constexpr size_t WS_XTMP = 235 * MiB;
constexpr size_t WS_LOG = 88 * MiB, WS_PXA = 168 * MiB;
constexpr size_t WS_XBXA = 136 * MiB;
constexpr size_t WS_SS = 65536;
constexpr size_t WS_FA = 66 * MiB, WS_FU = 154 * MiB;
constexpr size_t WS_WQ = 200 * MiB  , WS_WOT = 204 * MiB  , WS_WKVT = 208 * MiB  , WS_MEMN = 216 * MiB  , WS_KVM = 218 * MiB  ;
constexpr size_t WS_NEED = 256 * MiB;

DEV bf16_t f2bf(float f) { unsigned u = __float_as_uint(f); u += 0x7fffu + ((u >> 16) & 1u); return (bf16_t)(u >> 16); }
DEV float bf2f(bf16_t h) { return __uint_as_float(((unsigned)h) << 16); }
DEV float wave_sum(float v) {
#pragma unroll
    for (int o = 1; o < 64; o <<= 1) v += __shfl_xor(v, o);
    return v;
}
DEV float wave_max(float v) {
#pragma unroll
    for (int o = 1; o < 64; o <<= 1) v = fmaxf(v, __shfl_xor(v, o));
    return v;
}


#define LAS __attribute__((address_space(3)))
#define GAS __attribute__((address_space(1)))
typedef unsigned u32x4 __attribute__((ext_vector_type(4)));
typedef unsigned u32x2 __attribute__((ext_vector_type(2)));
typedef float f32x2 __attribute__((ext_vector_type(2)));
#define LDS_WAIT() asm volatile("s_waitcnt lgkmcnt(0)" ::: "memory")
#define VM_WAIT() asm volatile("s_waitcnt vmcnt(0)" ::: "memory")
typedef __bf16 bf16x2_t __attribute__((ext_vector_type(2)));
DEV unsigned cvt_pk_bf16(float lo, float hi) { const f32x2 v = {lo, hi}; return __builtin_bit_cast(unsigned, __builtin_convertvector(v, bf16x2_t)); }
DEV float bflo(unsigned w) { return __uint_as_float(w << 16); }
DEV float bfhi(unsigned w) { return __uint_as_float(w & 0xffff0000u); }

namespace pg8 {
constexpr int BM = 256, BK = 64, HALF = 128, HTB = HALF * BK * 2, STAGE_BYTES = 8 * HTB, NXCD = 8, WGM = 8;
__host__ __device__ __forceinline__ int lds_byte(int r, int c) { const int st = (r >> 4) * 2 + (c >> 5), rr = r & 15, cc = c & 31, ob = rr * 64 + cc * 2; return st * 1024 + (ob ^ (((ob >> 9) & 1) << 5)); }
__host__ __device__ __forceinline__ void stage_rc(int b, int& R, int& C) { const int st = b / 1024, sb = b % 1024, swz = sb ^ (((sb >> 9) & 1) << 5); R = (st >> 1) * 16 + swz / 64; C = (st & 1) * 32 + (swz % 64) / 2; }
__host__ __device__ __forceinline__ int perm32(int rho) { const int n = rho >> 4, i = rho & 15; return 8 * (i >> 2) + 4 * n + (i & 3); }

struct Unit { int pm, pn, job; };
struct Order {
    int nM, nN, nwg, ntot, G, c;
    DEV void init(int nM_, int nN_, int njob, int G_, int c_) { nM = nM_; nN = nN_; nwg = nM * nN; ntot = nwg * njob; G = G_; c = c_; }
    DEV bool next(int i, Unit& u) const {
        const int L = i * G + c; if (L >= ntot) return false;
        u.job = L / nwg; int wgid = L - u.job * nwg;
        { const int q = nwg / NXCD, r = nwg % NXCD, xcd = wgid % NXCD, off = wgid / NXCD; wgid = (xcd < r ? xcd * (q + 1) : r * (q + 1) + (xcd - r) * q) + off; }
        const int nig = WGM * nN, gid = wgid / nig, fm = gid * WGM, gsz = (nM - fm) < WGM ? (nM - fm) : WGM;
        u.pm = fm + ((wgid % nig) % gsz); u.pn = (wgid % nig) / gsz; return true;
    }
};
template <class Epi, class Ptr, bool ALIGN_EPI, bool SP2>
DEV void gemm_phase(LAS unsigned char* lds, const int lda, const int ldb, const int K, const Order& S, const Ptr& P, const Epi& E) {
    int tid_ = threadIdx.x; asm volatile("" : "+v"(tid_));
    const int tid = tid_, wid = __builtin_amdgcn_readfirstlane(tid >> 6), lane = tid & 63, wr = wid >> 2, wc = wid & 3, fr = lane & 15, fq = lane >> 4;
    const int nt = K / BK;
    unsigned voffA[2], voffB[2];
#pragma unroll
    for (int i = 0; i < 2; ++i) { int R, C; stage_rc(tid * 16 + i * 8192, R, C); const int Rb = Epi::PERM ? ((R & ~31) + perm32(R & 31)) : R;
        voffA[i] = (unsigned)(R * lda + C) * 2u; voffB[i] = (unsigned)(Rb * ldb + C) * 2u; }
    const size_t kstep = (size_t)(BK * 2);
    const size_t hstepA = (size_t)HALF * lda * 2, hstepB = (size_t)HALF * ldb * 2;
    const unsigned ldsw = (unsigned)wid * 1024u;
    const int aoff = lds_byte(wr * 64 + fr, fq * 8), boff = lds_byte(wc * 32 + fr, fq * 8);
#define PG8_SA(b, h) (((b) * 2 + (h)) * HTB)
#define PG8_SB(b, h) ((4 + (b) * 2 + (h)) * HTB)
#define PG8_STAGE(bufoff, gbase, voff) do { _Pragma("unroll") for (int _i = 0; _i < 2; ++_i) \
        __builtin_amdgcn_global_load_lds((const unsigned*)((const char*)(gbase) + (voff)[_i]), (LAS unsigned*)(lds + (bufoff) + ldsw + _i * 8192), 16, 0, 0); } while (0)
#define PG8_LDA(dst, b, h) do { _Pragma("unroll") for (int m = 0; m < 4; ++m) _Pragma("unroll") for (int k = 0; k < 2; ++k) dst[m][k] = *(const LAS bf16x8*)(lds + PG8_SA(b, h) + aoff + m * 2048 + k * 1024); } while (0)
#define PG8_LDB(dst, b, h) do { _Pragma("unroll") for (int n = 0; n < 2; ++n) _Pragma("unroll") for (int k = 0; k < 2; ++k) dst[n][k] = *(const LAS bf16x8*)(lds + PG8_SB(b, h) + boff + n * 2048 + k * 1024); } while (0)
#define PG8_MMA(ai, bj, At, Bt) do { __builtin_amdgcn_s_setprio(1); _Pragma("unroll") for (int m = 0; m < 4; ++m) _Pragma("unroll") for (int n = 0; n < 2; ++n) _Pragma("unroll") for (int k = 0; k < 2; ++k) \
        acc[ai][bj][m][n] = __builtin_amdgcn_mfma_f32_16x16x32_bf16(Bt[n][k], At[m][k], acc[ai][bj][m][n], 0, 0, 0); __builtin_amdgcn_s_setprio(0); } while (0)
#define PG8_WAIT_V(n) asm volatile("s_waitcnt vmcnt(" #n ")" ::: "memory")
#define PG8_WAIT_L(n) asm volatile("s_waitcnt lgkmcnt(" #n ")" ::: "memory")
#define PG8_BAR __builtin_amdgcn_s_barrier()
#define PG8_SCHED __builtin_amdgcn_sched_barrier(0)
    Unit cur, nxt; int ui = 0;
    if (!S.next(0, cur)) return;
    f32x4 acc[2][2][4][2];
#pragma unroll
    for (int a = 0; a < 2; ++a)
#pragma unroll
        for (int b = 0; b < 2; ++b)
#pragma unroll
            for (int m = 0; m < 4; ++m)
#pragma unroll
                for (int n = 0; n < 2; ++n) acc[a][b][m][n] = (f32x4){0.f, 0.f, 0.f, 0.f};
    bf16x8 At[4][2], B0[2][2], B1[2][2];
    const char* cA = P.a(cur); const char* cB = P.b(cur);
    typename Epi::Pre pre; E.prefetch(pre, cur, wr, fr);
    if constexpr (SP2) {
        PG8_STAGE(PG8_SB(0, 0), cB, voffB); PG8_STAGE(PG8_SB(0, 1), cB + hstepB, voffB); PG8_STAGE(PG8_SA(0, 0), cA, voffA); PG8_STAGE(PG8_SA(0, 1), cA + hstepA, voffA);
        if (wr == 1) PG8_BAR;
        PG8_WAIT_V(2); PG8_BAR;
        PG8_STAGE(PG8_SB(1, 0), cB + kstep, voffB); PG8_STAGE(PG8_SA(1, 0), cA + kstep, voffA); PG8_STAGE(PG8_SB(1, 1), cB + hstepB + kstep, voffB);
        PG8_WAIT_V(6); PG8_BAR;
    } else {
        PG8_STAGE(PG8_SB(0, 0), cB, voffB); PG8_STAGE(PG8_SA(0, 0), cA, voffA); PG8_STAGE(PG8_SB(0, 1), cB + hstepB, voffB); PG8_STAGE(PG8_SA(0, 1), cA + hstepA, voffA);
        if (wr == 1) PG8_BAR;
        PG8_WAIT_V(4); PG8_BAR;
        PG8_STAGE(PG8_SB(1, 0), cB + kstep, voffB); PG8_STAGE(PG8_SA(1, 0), cA + kstep, voffA); PG8_STAGE(PG8_SB(1, 1), cB + hstepB + kstep, voffB);
        PG8_WAIT_V(6); PG8_BAR;
    }
#pragma unroll 1
    for (;;) {
        const bool has_next = S.next(ui + 1, nxt);
        const char* nA = has_next ? P.a(nxt) : cA; const char* nB = has_next ? P.b(nxt) : cB;
#pragma unroll 1
        for (int t = 0; t < nt; t += 2) {
            const bool last = (t == nt - 2);
            const char* a1 = cA + (size_t)(t + 1) * kstep;
            const char* a2 = last ? nA : cA + (size_t)(t + 2) * kstep; const char* b2 = last ? nB : cB + (size_t)(t + 2) * kstep;
            const char* a3 = a2 + kstep; const char* b3 = b2 + kstep;
            if constexpr (SP2) {
            PG8_LDB(B0, 0, 0); PG8_LDB(B1, 0, 1); PG8_SCHED; PG8_LDA(At, 0, 0); PG8_STAGE(PG8_SA(1, 1), a1 + hstepA, voffA);
            PG8_WAIT_V(8); PG8_WAIT_L(0); PG8_BAR; PG8_MMA(0, 0, At, B0); PG8_MMA(0, 1, At, B1); PG8_BAR; PG8_SCHED;
            PG8_LDA(At, 0, 1); PG8_STAGE(PG8_SB(0, 0), b2, voffB); PG8_STAGE(PG8_SB(0, 1), b2 + hstepB, voffB); PG8_STAGE(PG8_SA(0, 0), a2, voffA);
            PG8_WAIT_V(8); PG8_WAIT_L(0); PG8_BAR; PG8_MMA(1, 0, At, B0); PG8_MMA(1, 1, At, B1); PG8_BAR; PG8_SCHED;
            PG8_LDB(B0, 1, 0); PG8_LDB(B1, 1, 1); PG8_SCHED; PG8_LDA(At, 1, 0); PG8_STAGE(PG8_SA(0, 1), a2 + hstepA, voffA);
            PG8_WAIT_V(8); PG8_WAIT_L(0); PG8_BAR; PG8_MMA(0, 0, At, B0); PG8_MMA(0, 1, At, B1); PG8_BAR; PG8_SCHED;
            PG8_LDA(At, 1, 1); PG8_STAGE(PG8_SB(1, 0), b3, voffB); PG8_STAGE(PG8_SB(1, 1), b3 + hstepB, voffB); PG8_STAGE(PG8_SA(1, 0), a3, voffA);
            PG8_WAIT_V(8); PG8_WAIT_L(0); PG8_BAR; PG8_MMA(1, 0, At, B0); PG8_MMA(1, 1, At, B1); PG8_BAR; PG8_SCHED;
            } else {
            PG8_LDB(B0, 0, 0); PG8_SCHED; PG8_LDA(At, 0, 0); PG8_STAGE(PG8_SA(1, 1), a1 + hstepA, voffA);
            PG8_WAIT_L(8); PG8_BAR; PG8_WAIT_L(0); PG8_MMA(0, 0, At, B0); PG8_BAR; PG8_SCHED;
            PG8_LDB(B1, 0, 1); PG8_STAGE(PG8_SB(0, 0), b2, voffB);
            PG8_BAR; PG8_WAIT_L(0); PG8_MMA(0, 1, At, B1); PG8_BAR;
            PG8_LDA(At, 0, 1); PG8_STAGE(PG8_SA(0, 0), a2, voffA);
            PG8_BAR; PG8_WAIT_L(0); PG8_MMA(1, 0, At, B0); PG8_BAR; PG8_SCHED;
            PG8_STAGE(PG8_SB(0, 1), b2 + hstepB, voffB);
            PG8_WAIT_V(6); PG8_BAR; PG8_MMA(1, 1, At, B1); PG8_BAR;
            PG8_LDB(B0, 1, 0); PG8_SCHED; PG8_LDA(At, 1, 0); PG8_STAGE(PG8_SA(0, 1), a2 + hstepA, voffA);
            PG8_WAIT_L(8); PG8_BAR; PG8_WAIT_L(0); PG8_MMA(0, 0, At, B0); PG8_BAR; PG8_SCHED;
            PG8_LDB(B1, 1, 1); PG8_STAGE(PG8_SB(1, 0), b3, voffB);
            PG8_BAR; PG8_WAIT_L(0); PG8_MMA(0, 1, At, B1); PG8_BAR;
            PG8_LDA(At, 1, 1); PG8_STAGE(PG8_SA(1, 0), a3, voffA);
            PG8_BAR; PG8_WAIT_L(0); PG8_MMA(1, 0, At, B0); PG8_BAR; PG8_SCHED;
            PG8_STAGE(PG8_SB(1, 1), b3 + hstepB, voffB);
            PG8_WAIT_V(6); PG8_BAR; PG8_MMA(1, 1, At, B1); PG8_BAR;
            }
        }
        if constexpr (ALIGN_EPI) { if (wr == 0) PG8_BAR; }
        if constexpr (!Epi::AFTER_DRAIN) { E(acc, cur, wr, wc, fr, fq, pre); }
        if (!has_next) break;
#pragma unroll
        for (int a = 0; a < 2; ++a)
#pragma unroll
            for (int b = 0; b < 2; ++b)
#pragma unroll
                for (int m = 0; m < 4; ++m)
#pragma unroll
                    for (int n = 0; n < 2; ++n) acc[a][b][m][n] = (f32x4){0.f, 0.f, 0.f, 0.f};
        cur = nxt; cA = nA; cB = nB; ++ui; E.prefetch(pre, cur, wr, fr);
        if constexpr (ALIGN_EPI) { if (wr == 1) PG8_BAR; }
    }
    PG8_WAIT_V(0);
    if constexpr (!ALIGN_EPI) { if (wr == 0) PG8_BAR; }
    PG8_BAR;
    if constexpr (Epi::AFTER_DRAIN) { E.fused(acc, cur, wr, wc, fr, fq, lds, wid, lane, pre); }
#undef PG8_SA
#undef PG8_SB
#undef PG8_STAGE
#undef PG8_LDA
#undef PG8_LDB
#undef PG8_MMA
#undef PG8_WAIT_V
#undef PG8_WAIT_L
#undef PG8_BAR
#undef PG8_SCHED
}
typedef f32x4 Acc[2][2][4][2];

struct PtrStd {
    const char* A; const char* B; size_t aj, bj, bb, arow, brow;
    DEV const char* a(const Unit& u) const { return A + (size_t)u.job * aj + (size_t)u.pm * arow; }
    DEV const char* b(const Unit& u) const { return B + (size_t)u.job * bj + (size_t)(u.pm >> 5) * bb + (size_t)u.pn * brow; }
};
struct PtrG {
    const char* KVM; const char* WQ;
    DEV const char* a(const Unit& u) const { return KVM + (size_t)(u.job >> 2) * MiB + (size_t)(u.job & 3) * 512; }
    DEV const char* b(const Unit& u) const { return WQ + (size_t)(u.job >> 3) * 2 * MiB + (size_t)(u.job & 3) * 512 + (size_t)u.pn * 256 * 1024 * 2; }
};
struct PtrH {
    const char* KVM; const char* WOT;
    DEV const char* a(const Unit& u) const { return WOT + (size_t)(u.job >> 3) * 2 * MiB + (size_t)(u.job & 3) * 512 + (size_t)u.pm * 256 * 1024 * 2; }
    DEV const char* b(const Unit& u) const { return KVM + (size_t)(u.job >> 2) * MiB + 2048 + (size_t)(u.job & 3) * 512; }
};

#define EPI_ROWS(u) const int row0 = (u).pm * BM + wr * 64 + fr
DEV u32x4 pack8(const f32x4 v0, const f32x4 v1) { u32x4 w; w.x = cvt_pk_bf16(v0[0], v0[1]); w.y = cvt_pk_bf16(v0[2], v0[3]); w.z = cvt_pk_bf16(v1[0], v1[1]); w.w = cvt_pk_bf16(v1[2], v1[3]); return w; }

struct PreNone {};
typedef unsigned long long u64;
constexpr float SS_SCALE = 65536.f;
struct PreRs { u64 v[2][4]; };
DEV void pre_rs(PreRs& p, const u64* ss, int row0) {
#pragma unroll
    for (int ai = 0; ai < 2; ++ai)
#pragma unroll
        for (int m = 0; m < 4; ++m) p.v[ai][m] = __builtin_nontemporal_load(ss + row0 + ai * HALF + m * 16);
}
DEV void rs_of(float (&rs)[2][4], const PreRs& p) {
#pragma unroll
    for (int ai = 0; ai < 2; ++ai)
#pragma unroll
        for (int m = 0; m < 4; ++m) rs[ai][m] = rsqrtf((float)p.v[ai][m] * (1.f / (SS_SCALE * D)) + EPS);
}
struct EpiInProj {
    typedef PreRs Pre;
    DEV void prefetch(PreRs& p, const Unit& u, int wr, int fr) const { pre_rs(p, ss, u.pm * BM + wr * 64 + fr); }
    static constexpr bool PERM = true, AFTER_DRAIN = false;
    unsigned char* ws; const u64* ss;
    DEV void operator()(const Acc& acc, const Unit& u, int wr, int wc, int fr, int fq, const PreRs& pre) const {
        EPI_ROWS(u); const int pn = u.pn, cb = wc * 32 + 8 * fq;
        float rs[2][4]; rs_of(rs, pre);
        if (pn < 16) {
            const int g = pn >> 1;
            const size_t off = g == 0 ? WS_QA : g == 1 ? WS_KA : g == 2 ? WS_VA : g == 3 ? WS_QC : g == 4 ? WS_KC : g == 5 ? WS_VC : g == 6 ? WS_IQ : WS_SCB;
            const float sc = (g == 0 || g == 3) ? QSCALE : 1.f;
            bf16_t* base = (bf16_t*)(ws + off) + (pn & 1) * 256 + cb;
#pragma unroll
            for (int ai = 0; ai < 2; ++ai)
#pragma unroll
                for (int m = 0; m < 4; ++m) { bf16_t* rowp = base + (size_t)(row0 + ai * HALF + m * 16) * 512;
#pragma unroll
                    for (int bj = 0; bj < 2; ++bj) *(u32x4*)(rowp + bj * HALF) = pack8(acc[ai][bj][m][0] * (sc * rs[ai][m]), acc[ai][bj][m][1] * (sc * rs[ai][m])); }
        } else if (pn < 20) {
            bf16_t* base = (bf16_t*)(ws + WS_CX) + (pn - 16) * 128 + cb;
#pragma unroll
            for (int ai = 0; ai < 2; ++ai)
#pragma unroll
                for (int m = 0; m < 4; ++m) { const float r2 = rs[ai][m] * rs[ai][m]; *(u32x4*)(base + (size_t)(row0 + ai * HALF + m * 16) * 512) = pack8(acc[ai][0][m][0] * acc[ai][1][m][0] * r2, acc[ai][0][m][1] * acc[ai][1][m][1] * r2); }
        } else {
            if (wc < 2) { bf16_t* base = (bf16_t*)(ws + WS_IK);
#pragma unroll
                for (int ai = 0; ai < 2; ++ai)
#pragma unroll
                    for (int m = 0; m < 4; ++m) { const int t = row0 + ai * HALF + m * 16;
                        *(u32x4*)(base + (size_t)(t >> 5) * 2048 + (((cb >> 3) * 32 + (t & 31)) * 8)) = pack8(acc[ai][0][m][0] * rs[ai][m], acc[ai][0][m][1] * rs[ai][m]); }
            } else if (wc == 2 && fq == 0) { float* base = (float*)(ws + WS_IW);
#pragma unroll
                for (int ai = 0; ai < 2; ++ai)
#pragma unroll
                    for (int m = 0; m < 4; ++m) { float* p = base + (size_t)(row0 + ai * HALF + m * 16) * 8; *(f32x4*)p = acc[ai][0][m][0] * (WSCALE * rs[ai][m]); *(f32x4*)(p + 4) = acc[ai][0][m][1] * (WSCALE * rs[ai][m]); }
            }
        }
    }
};
DEV f32x4 sigm4(const f32x4 v) { f32x4 o;
#pragma unroll
    for (int i = 0; i < 4; ++i) o[i] = __builtin_amdgcn_rcpf(1.f + __builtin_amdgcn_exp2f(-LOG2E * v[i])); return o; }
struct EpiGates {
    typedef PreRs Pre;
    DEV void prefetch(PreRs& p, const Unit& u, int wr, int fr) const { pre_rs(p, ss, u.pm * BM + wr * 64 + fr); }
    static constexpr bool PERM = true, AFTER_DRAIN = false;
    bf16_t* G; const u64* ss;
    DEV void operator()(const Acc& acc, const Unit& u, int wr, int wc, int fr, int fq, const PreRs& pre) const {
        EPI_ROWS(u); float rs[2][4]; rs_of(rs, pre); bf16_t* base = G + (size_t)(u.pn >> 2) * T * D + (u.pn & 3) * 256 + wc * 32 + 8 * fq;
#pragma unroll
        for (int ai = 0; ai < 2; ++ai)
#pragma unroll
            for (int m = 0; m < 4; ++m) { bf16_t* rowp = base + (size_t)(row0 + ai * HALF + m * 16) * D;
#pragma unroll
                for (int bj = 0; bj < 2; ++bj) *(u32x4*)(rowp + bj * HALF) = pack8(sigm4(acc[ai][bj][m][0] * rs[ai][m]), sigm4(acc[ai][bj][m][1] * rs[ai][m])); }
    }
};
struct EpiMerge {
    typedef PreNone Pre;
    DEV void prefetch(PreNone&, const Unit&, int, int) const {}
    static constexpr bool PERM = true, AFTER_DRAIN = false;
    bf16_t* M; const bf16_t* G;
    DEV void operator()(const Acc& acc, const Unit& u, int wr, int wc, int fr, int fq, const PreNone&) const {
        EPI_ROWS(u); const size_t cofs = (size_t)u.pn * 256 + wc * 32 + 8 * fq; const bf16_t* gb = G + (size_t)u.job * T * D;
#pragma unroll
        for (int ai = 0; ai < 2; ++ai)
#pragma unroll
            for (int m = 0; m < 4; ++m) { const size_t ro = (size_t)(row0 + ai * HALF + m * 16) * D + cofs;
#pragma unroll
                for (int bj = 0; bj < 2; ++bj) { const size_t o = ro + bj * HALF; const u32x4 g = *(const u32x4*)(gb + o);
                    f32x4 v0 = acc[ai][bj][m][0], v1 = acc[ai][bj][m][1];
                    v0[0] *= bflo(g.x); v0[1] *= bfhi(g.x); v0[2] *= bflo(g.y); v0[3] *= bfhi(g.y); v1[0] *= bflo(g.z); v1[1] *= bfhi(g.z); v1[2] *= bflo(g.w); v1[3] *= bfhi(g.w);
                    if (u.job > 0) { const u32x4 p = __builtin_nontemporal_load((const u32x4*)(M + o));
                        v0[0] += bflo(p.x); v0[1] += bfhi(p.x); v0[2] += bflo(p.y); v0[3] += bfhi(p.y); v1[0] += bflo(p.z); v1[1] += bfhi(p.z); v1[2] += bflo(p.w); v1[3] += bfhi(p.w); }
                    *(u32x4*)(M + o) = pack8(v0, v1); } }
    }
};
template <bool IN_F32> struct EpiResid {
    typedef PreNone Pre;
    DEV void prefetch(PreNone&, const Unit&, int, int) const {}
    static constexpr bool PERM = true, AFTER_DRAIN = false;
    const void* xin; bf16_t* xb; u64* ss;
    DEV void operator()(const Acc& acc, const Unit& u, int wr, int wc, int fr, int fq, const PreNone&) const {
        EPI_ROWS(u); const size_t cofs = (size_t)u.pn * 256 + wc * 32 + 8 * fq;
#pragma unroll
        for (int ai = 0; ai < 2; ++ai)
#pragma unroll
            for (int m = 0; m < 4; ++m) { const size_t ro = (size_t)(row0 + ai * HALF + m * 16) * D + cofs; float sq = 0.f;
#pragma unroll
                for (int bj = 0; bj < 2; ++bj) { const size_t o = ro + bj * HALF; f32x4 v0 = acc[ai][bj][m][0], v1 = acc[ai][bj][m][1];
                    if (IN_F32) { v0 = v0 + *(const f32x4*)((const float*)xin + o); v1 = v1 + *(const f32x4*)((const float*)xin + o + 4); }
                    else { const u32x4 p = *(const u32x4*)((const bf16_t*)xin + o);
                        v0[0] += bflo(p.x); v0[1] += bfhi(p.x); v0[2] += bflo(p.y); v0[3] += bfhi(p.y); v1[0] += bflo(p.z); v1[1] += bfhi(p.z); v1[2] += bflo(p.w); v1[3] += bfhi(p.w); }
                    *(u32x4*)(xb + o) = pack8(v0, v1);
                    sq += ((v0[0] * v0[0] + v0[1] * v0[1]) + (v0[2] * v0[2] + v0[3] * v0[3])) + ((v1[0] * v1[0] + v1[1] * v1[1]) + (v1[2] * v1[2] + v1[3] * v1[3])); }
                sq += __shfl_xor(sq, 16); sq += __shfl_xor(sq, 32);
                if (fq == 0) atomicAdd(ss + row0 + ai * HALF + m * 16, (u64)(sq * SS_SCALE + 0.5f)); }
    }
};
struct EpiUp {
    typedef PreRs Pre;
    DEV void prefetch(PreRs& p, const Unit& u, int wr, int fr) const { pre_rs(p, ss, u.pm * BM + wr * 64 + fr); }
    static constexpr bool PERM = true, AFTER_DRAIN = false;
    bf16_t *fa, *fu; const u64* ss;
    DEV void operator()(const Acc& acc, const Unit& u, int wr, int wc, int fr, int fq, const PreRs& pre) const {
        EPI_ROWS(u); float rs[2][4]; rs_of(rs, pre); const size_t cofs = (size_t)u.pn * 128 + wc * 32 + 8 * fq;
#pragma unroll
        for (int ai = 0; ai < 2; ++ai)
#pragma unroll
            for (int m = 0; m < 4; ++m) { const size_t o = (size_t)(row0 + ai * HALF + m * 16) * DFF + cofs;
                *(u32x4*)(fa + o) = pack8(acc[ai][0][m][0] * rs[ai][m], acc[ai][0][m][1] * rs[ai][m]); *(u32x4*)(fu + o) = pack8(acc[ai][1][m][0] * rs[ai][m], acc[ai][1][m][1] * rs[ai][m]); }
    }
};
struct EpiPrep {
    typedef PreNone Pre;
    DEV void prefetch(PreNone&, const Unit&, int, int) const {}
    static constexpr bool PERM = true, AFTER_DRAIN = false;
    unsigned char* ws; int mode;
    DEV void operator()(const Acc& acc, const Unit& u, int wr, int wc, int fr, int fq, const PreNone&) const {
        EPI_ROWS(u); bf16_t* base; int ldc; float sc = 1.f;
        if (mode == 0) { base = (bf16_t*)(ws + WS_KVM + (size_t)u.job * 2 * MiB); ldc = 2 * D; }
        else if (mode == 1) { base = (bf16_t*)(ws + WS_GT + (size_t)(u.job >> 2) * 2 * MiB) + (size_t)(u.job & 3) * 256 * D; ldc = D; sc = XSCALE; }
        else { base = (bf16_t*)(ws + WS_HT + (size_t)(u.job >> 2) * 2 * MiB) + (u.job & 3) * 256; ldc = D; }
        base += (size_t)u.pn * 256 + wc * 32 + 8 * fq;
#pragma unroll
        for (int ai = 0; ai < 2; ++ai)
#pragma unroll
            for (int m = 0; m < 4; ++m) { bf16_t* rowp = base + (size_t)(row0 + ai * HALF + m * 16) * ldc;
#pragma unroll
                for (int bj = 0; bj < 2; ++bj) *(u32x4*)(rowp + bj * HALF) = pack8(acc[ai][bj][m][0] * sc, acc[ai][bj][m][1] * sc); }
    }
};
struct EpiSoftmax {
    typedef PreRs Pre;
    DEV void prefetch(PreRs& p, const Unit& u, int wr, int fr) const { pre_rs(p, ss, u.pm * BM + wr * 64 + fr); }
    static constexpr bool PERM = true, AFTER_DRAIN = true;
    bf16_t* P; const u64* ss;
    DEV void fused(Acc& acc, const Unit& u, int wr, int wc, int fr, int fq, LAS unsigned char* lds, int wid, int lane, const PreRs& pre) const {
        LAS float* PM = (LAS float*)lds; LAS float* PS = (LAS float*)(lds + 4096);
        { const int row0_ = u.pm * BM + wr * 64 + fr; float rs[2][4]; rs_of(rs, pre);
#pragma unroll
          for (int ai = 0; ai < 2; ++ai)
#pragma unroll
              for (int m = 0; m < 4; ++m)
#pragma unroll
                  for (int bj = 0; bj < 2; ++bj)
#pragma unroll
                      for (int n = 0; n < 2; ++n) acc[ai][bj][m][n] = acc[ai][bj][m][n] * rs[ai][m]; }
#pragma unroll
        for (int ai = 0; ai < 2; ++ai)
#pragma unroll
            for (int m = 0; m < 4; ++m) { float mx = -INFINITY;
#pragma unroll
                for (int bj = 0; bj < 2; ++bj)
#pragma unroll
                    for (int n = 0; n < 2; ++n) { const f32x4 x = acc[ai][bj][m][n]; mx = fmaxf(mx, fmaxf(fmaxf(x[0], x[1]), fmaxf(x[2], x[3]))); }
                mx = fmaxf(mx, __shfl_xor(mx, 16)); mx = fmaxf(mx, __shfl_xor(mx, 32));
                if (fq == 0) PM[(ai * HALF + wr * 64 + m * 16 + fr) * 4 + wc] = mx; }
        LDS_WAIT(); __builtin_amdgcn_s_barrier(); asm volatile("" ::: "memory");
#pragma unroll
        for (int ai = 0; ai < 2; ++ai)
#pragma unroll
            for (int m = 0; m < 4; ++m) { const int r = ai * HALF + wr * 64 + m * 16 + fr; const f32x4 q = *(const LAS f32x4*)(PM + r * 4);
                const float mx = fmaxf(fmaxf(q[0], q[1]), fmaxf(q[2], q[3])); float s = 0.f;
#pragma unroll
                for (int bj = 0; bj < 2; ++bj)
#pragma unroll
                    for (int n = 0; n < 2; ++n) { f32x4 x = acc[ai][bj][m][n];
#pragma unroll
                        for (int i = 0; i < 4; ++i) { x[i] = __builtin_amdgcn_exp2f(x[i] - mx); s += x[i]; } acc[ai][bj][m][n] = x; }
                s += __shfl_xor(s, 16); s += __shfl_xor(s, 32);
                if (fq == 0) PS[r * 4 + wc] = s; }
        LDS_WAIT(); __builtin_amdgcn_s_barrier(); asm volatile("" ::: "memory");
        EPI_ROWS(u); bf16_t* base = P + (size_t)u.pn * 256 + wc * 32 + 8 * fq;
#pragma unroll
        for (int ai = 0; ai < 2; ++ai)
#pragma unroll
            for (int m = 0; m < 4; ++m) { const int r = ai * HALF + wr * 64 + m * 16 + fr; const f32x4 q = *(const LAS f32x4*)(PS + r * 4);
                const float inv = 1.f / ((q[0] + q[1]) + (q[2] + q[3])); bf16_t* rowp = base + (size_t)(row0 + ai * HALF + m * 16) * D;
#pragma unroll
                for (int bj = 0; bj < 2; ++bj) *(u32x4*)(rowp + bj * HALF) = pack8(acc[ai][bj][m][0] * inv, acc[ai][bj][m][1] * inv); }
        LDS_WAIT(); __builtin_amdgcn_s_barrier();
    }
};
}

typedef GAS unsigned gu32;
#define XB_TMO      128
#define XB_XCNT(j)  (256  + 64 * (j))
#define XB_XSUB(j)  (1280 + 64 * (j))
#define XB_XGEN(j)  (2304 + 64 * (j))
#define XB_TOP      3328
#define XB_TOPGEN   3392
#define XCD_BAR_WORDS 3456
#define XB_SPIN_CAP (1u << 22)
DEV unsigned xb_ld(unsigned* p) { return __hip_atomic_load(p, __ATOMIC_RELAXED, __HIP_MEMORY_SCOPE_AGENT); }
DEV unsigned xb_add(unsigned* p, unsigned v) { return __hip_atomic_fetch_add(p, v, __ATOMIC_RELAXED, __HIP_MEMORY_SCOPE_AGENT); }
DEV unsigned xb_xcc_id() { return (unsigned)__builtin_amdgcn_s_getreg((3 << 11) | 20) & 0xFu; }
#define XB_SPIN(cond, bar) do { unsigned _sp = 0; while (cond) { __builtin_amdgcn_s_sleep(1); \
    if ((++_sp & 255u) == 0u) { if (xb_ld(&(bar)[XB_TMO])) break; if (_sp > XB_SPIN_CAP) { atomicAdd(&(bar)[XB_TMO], 1u); break; } } } } while (0)
struct XcdBarrier { unsigned* bar; unsigned x; volatile LAS unsigned* st; };
DEV XcdBarrier xcd_barrier_post(unsigned* bar, volatile LAS unsigned* st) {
    XcdBarrier b; b.bar = bar; b.x = xb_xcc_id(); b.st = st;
    if (threadIdx.x == 0) (void)xb_add(&bar[XB_XCNT(b.x)], 1u);
    return b;
}
DEV void xcd_barrier_complete(unsigned* bar, unsigned x, unsigned& nloc, unsigned& nx) {
    const unsigned G = gridDim.x * gridDim.y * gridDim.z;
    unsigned sum, cnt, mine, sp = 0u;
    for (;;) {
        sum = 0u; cnt = 0u; mine = 0u;
#pragma unroll
        for (unsigned j = 0; j < 16; ++j) { const unsigned c = xb_ld(&bar[XB_XCNT(j)]); sum += c; cnt += (c > 0u) ? 1u : 0u; mine = (j == x) ? c : mine; }
        if (sum == G) break;
        __builtin_amdgcn_s_sleep(1);
        if ((++sp & 255u) == 0u) { if (xb_ld(&bar[XB_TMO])) break; if (sp > XB_SPIN_CAP) { atomicAdd(&bar[XB_TMO], 1u); break; } }
    }
    nloc = mine > 0u ? mine : 1u; nx = cnt > 0u ? cnt : 1u;
}
DEV void xcd_barrier(const XcdBarrier& b) {
    asm volatile("s_waitcnt vmcnt(0)" ::: "memory");
    __syncthreads();
    if (threadIdx.x == 0) {
        unsigned* bar = b.bar;
        __builtin_amdgcn_s_waitcnt(0);
        unsigned nloc = b.st[0], nx = b.st[1];
        if (nloc == 0u) { xcd_barrier_complete(bar, b.x, nloc, nx); b.st[0] = nloc; b.st[1] = nx; }
        const unsigned old = xb_add(&bar[XB_XSUB(b.x)], 1u);
        const unsigned gen = old / nloc;
        if (old + 1u == (gen + 1u) * nloc) {
            __builtin_amdgcn_fence(__ATOMIC_RELEASE, "agent");
            asm volatile("s_waitcnt vmcnt(0)" ::: "memory");
            const unsigned og = xb_add(&bar[XB_TOP], 1u);
            const unsigned tg = og / nx;
            if (og + 1u == (tg + 1u) * nx) xb_add(&bar[XB_TOPGEN], 1u);
            else XB_SPIN(xb_ld(&bar[XB_TOPGEN]) == tg, bar);
            __builtin_amdgcn_fence(__ATOMIC_ACQUIRE, "agent");
            xb_add(&bar[XB_XGEN(b.x)], 1u);
            asm volatile("s_waitcnt vmcnt(0)" ::: "memory");
        } else {
            XB_SPIN(xb_ld(&bar[XB_XGEN(b.x)]) == gen, bar);
            __builtin_amdgcn_fence(__ATOMIC_ACQUIRE, "agent");
            asm volatile("s_waitcnt vmcnt(0)" ::: "memory");
        }
    }
    __syncthreads();
}


struct WaveId { int gw, ngw, wave, lane; };
DEV unsigned f2bf_u(float f) { return (unsigned)f2bf(f); }
DEV unsigned pk2(float lo, float hi) { return cvt_pk_bf16(lo, hi); }

DEV void norm_rows(const WaveId& W, const float* x, const float* g, bf16_t* outb, float* outf, int rows) {
    for (int row = W.gw; row < rows; row += W.ngw) {
        const f32x4* xr = (const f32x4*)(x + (size_t)row * D) + W.lane;
        f32x4 v[4]; float s = 0.f;
#pragma unroll
        for (int j = 0; j < 4; ++j) { v[j] = xr[64 * j]; s += (v[j].x * v[j].x + v[j].y * v[j].y) + (v[j].z * v[j].z + v[j].w * v[j].w); }
        const float r = rsqrtf(wave_sum(s) * (1.f / D) + EPS);
#pragma unroll
        for (int j = 0; j < 4; ++j) {
            const f32x4 gg = ((const f32x4*)g)[W.lane + 64 * j];
            const f32x4 o = {v[j].x * r * gg.x, v[j].y * r * gg.y, v[j].z * r * gg.z, v[j].w * r * gg.w};
            if (outb) { u32x2 w; w.x = pk2(o.x, o.y); w.y = pk2(o.z, o.w); ((u32x2*)(outb + (size_t)row * D))[W.lane + 64 * j] = w; }
            else ((f32x4*)(outf + (size_t)row * D))[W.lane + 64 * j] = o;
        }
    }
}
DEV void cvt_piece(const WaveId& W, LAS float* scr, int& base, const float* Wsrc, int ldw, int K, int col0, int ncols, bf16_t* dst, int ldo, int row0, const float* gain = nullptr) {
    const int nblk = ncols / 32, nitems = (K / 64) * nblk;
    int first = (W.gw - base) % W.ngw; if (first < 0) first += W.ngw;
    base = (base + nitems) % W.ngw;
    for (int item = first; item < nitems; item += W.ngw) {
        const int kb = item / nblk, nb = item - kb * nblk, k0 = 64 * kb, n0 = 32 * nb;
#pragma unroll 8
        for (int i = 0; i < 32; ++i) { const int kk = 2 * i + (W.lane >> 5); scr[kk * 33 + (W.lane & 31)] = Wsrc[(size_t)(k0 + kk) * ldw + col0 + n0 + (W.lane & 31)] * (gain ? gain[k0 + kk] : 1.f); }
        LDS_WAIT(); asm volatile("" ::: "memory");
        const int c = W.lane & 7;
#pragma unroll
        for (int j = 0; j < 4; ++j) { const int n = (W.lane >> 3) + 8 * j; const LAS float* s = scr + (8 * c) * 33 + n;
            u32x4 o; o.x = pk2(s[0 * 33], s[1 * 33]); o.y = pk2(s[2 * 33], s[3 * 33]); o.z = pk2(s[4 * 33], s[5 * 33]); o.w = pk2(s[6 * 33], s[7 * 33]);
            *(u32x4*)(dst + (size_t)(row0 + n0 + n) * ldo + k0 + 8 * c) = o; }
        LDS_WAIT(); asm volatile("" ::: "memory");
    }
}
DEV void convert_layer_weights(const WaveId& W, LAS float* scr, int& base, unsigned char* ws, const float* const* in, int l) {
    const float* wi = in[3] + (size_t)l * D * DIN;
    bf16_t* WIN = (bf16_t*)(ws + WS_WIN); const float* gm = in[2] + l * D; const float* gf = in[14] + l * D;
    cvt_piece(W, scr, base, wi, DIN, D, 0, 1536, WIN, D, 0, gm);
    cvt_piece(W, scr, base, wi, DIN, D, 3072, 1536, WIN, D, 1536, gm);
    cvt_piece(W, scr, base, wi, DIN, D, 4608, 512, WIN, D, 3072, gm);
    cvt_piece(W, scr, base, wi, DIN, D, 1536, 512, WIN, D, 3584, gm);
#pragma unroll 1
    for (int j = 0; j < 4; ++j) { cvt_piece(W, scr, base, wi, DIN, D, 2048 + 128 * j, 128, WIN, D, 4096 + 256 * j, gm); cvt_piece(W, scr, base, wi, DIN, D, 2560 + 128 * j, 128, WIN, D, 4096 + 256 * j + 128, gm); }
    cvt_piece(W, scr, base, wi, DIN, D, 5120, 96, WIN, D, 5120, gm);
    cvt_piece(W, scr, base, wi, DIN, D, 5192, 3072, (bf16_t*)(ws + WS_WG), D, 0, gm);
#pragma unroll 1
    for (int i = 0; i < 3; ++i) cvt_piece(W, scr, base, in[5 + i] + (size_t)l * 512 * D, D, 512, 0, D, (bf16_t*)(ws + WS_WBR) + (size_t)i * D * 512, 512, 0);
    cvt_piece(W, scr, base, in[8] + (size_t)l * D * D, D, D, 0, D, (bf16_t*)(ws + WS_WMIX), D, 0);
    const float* wf = in[15] + (size_t)l * D * 2 * DFF;
#pragma unroll 1
    for (int j = 0; j < 22; ++j) { cvt_piece(W, scr, base, wf, 2 * DFF, D, 128 * j, 128, (bf16_t*)(ws + WS_WUP), D, 256 * j, gf); cvt_piece(W, scr, base, wf, 2 * DFF, D, DFF + 128 * j, 128, (bf16_t*)(ws + WS_WUP), D, 256 * j + 128, gf); }
    cvt_piece(W, scr, base, in[18] + (size_t)l * DFF * D, D, DFF, 0, D, (bf16_t*)(ws + WS_WDOWN), DFF, 0);
}
DEV void prep0_phase(const WaveId& W, LAS float* scr, unsigned char* ws, const float* const* in, bf16_t* XB) {
    int base = 0;
#pragma unroll 1
    for (int l = 0; l < DEPTH; ++l) {
        const float* wq = in[11] + (size_t)l * D * D; bf16_t* WQ = (bf16_t*)(ws + WS_WQ + (size_t)l * 2 * MiB); const float* gx = in[9] + l * D;
        for (size_t i = (size_t)(W.gw * 64 + W.lane) * 4; i < (size_t)D * D; i += (size_t)W.ngw * 256) { const float g = gx[i >> 10]; const f32x4 v = *(const f32x4*)(wq + i); u32x2 o; o.x = pk2(v.x * g, v.y * g); o.y = pk2(v.z * g, v.w * g); *(u32x2*)(WQ + i) = o; }
        cvt_piece(W, scr, base, in[13] + (size_t)l * D * D, D, D, 0, D, (bf16_t*)(ws + WS_WOT + (size_t)l * 2 * MiB), D, 0);
        cvt_piece(W, scr, base, in[12] + (size_t)l * D * 2 * D, 2 * D, D, 0, 2 * D, (bf16_t*)(ws + WS_WKVT + (size_t)l * 4 * MiB), D, 0);
        norm_rows(W, in[1], in[10] + l * D, (bf16_t*)(ws + WS_MEMN + (size_t)l * MiB), nullptr, NB * MEM);
    }
    convert_layer_weights(W, scr, base, ws, in, 0);
    pg8::u64* ss0 = (pg8::u64*)(ws + WS_SS);
    for (int row = W.gw; row < T; row += W.ngw) {
        const f32x4* xr = (const f32x4*)(in[0] + (size_t)row * D) + W.lane; float s = 0.f;
#pragma unroll
        for (int j = 0; j < 4; ++j) { const f32x4 v = xr[64 * j]; s += (v.x * v.x + v.y * v.y) + (v.z * v.z + v.w * v.w);
            u32x2 w; w.x = pk2(v.x, v.y); w.y = pk2(v.z, v.w); ((u32x2*)(XB + (size_t)row * D))[W.lane + 64 * j] = w; }
        s = wave_sum(s); if (W.lane == 0) ss0[row] = (pg8::u64)(s * pg8::SS_SCALE + 0.5f);
    }
}
DEV void final_norm(const WaveId& W, const bf16_t* x, float* out, const float* g, const pg8::u64* ss) {
    for (int row = W.gw; row < T; row += W.ngw) {
        const float r = rsqrtf((float)ss[row] * (1.f / (pg8::SS_SCALE * D)) + EPS); const u32x2* xr = (const u32x2*)(x + (size_t)row * D) + W.lane; f32x4* orow = (f32x4*)(out + (size_t)row * D) + W.lane;
#pragma unroll
        for (int j = 0; j < 4; ++j) { const f32x4 gg = ((const f32x4*)g)[W.lane + 64 * j]; const u32x2 v = xr[64 * j];
            const f32x4 o = {bflo(v.x) * r * gg.x, bfhi(v.x) * r * gg.y, bflo(v.y) * r * gg.z, bfhi(v.y) * r * gg.w}; orow[64 * j] = o; }
    }
}
DEV void conv_sc_phase(int gtid, int gthreads, bf16_t* scb, const bf16_t* cx, const float* w, bool dry) {
    for (int i = gtid; i < T * 64; i += gthreads) {
        const int c8 = (i & 63) * 8, t = i >> 6, tl = t & (S - 1);
        const size_t o = (size_t)t * 512 + c8;
        const u32x4 z = {0u, 0u, 0u, 0u};
        const u32x4 x2 = *(const u32x4*)(cx + o), x1 = tl >= 1 ? *(const u32x4*)(cx + o - 512) : z, x0 = tl >= 2 ? *(const u32x4*)(cx + o - 1024) : z, bb = *(const u32x4*)(scb + o);
        const f32x4 w0a = *(const f32x4*)(w + c8), w0b = *(const f32x4*)(w + c8 + 4), w1a = *(const f32x4*)(w + 512 + c8), w1b = *(const f32x4*)(w + 512 + c8 + 4), w2a = *(const f32x4*)(w + 1024 + c8), w2b = *(const f32x4*)(w + 1024 + c8 + 4);
        float r[8];
#define CONV1(k, W0, W1, W2, X0, X1, X2, BBv, F) r[k] = F(BBv) * (W0 * F(X0) + W1 * F(X1) + W2 * F(X2))
        CONV1(0, w0a.x, w1a.x, w2a.x, x0.x, x1.x, x2.x, bb.x, bflo); CONV1(1, w0a.y, w1a.y, w2a.y, x0.x, x1.x, x2.x, bb.x, bfhi);
        CONV1(2, w0a.z, w1a.z, w2a.z, x0.y, x1.y, x2.y, bb.y, bflo); CONV1(3, w0a.w, w1a.w, w2a.w, x0.y, x1.y, x2.y, bb.y, bfhi);
        CONV1(4, w0b.x, w1b.x, w2b.x, x0.z, x1.z, x2.z, bb.z, bflo); CONV1(5, w0b.y, w1b.y, w2b.y, x0.z, x1.z, x2.z, bb.z, bfhi);
        CONV1(6, w0b.z, w1b.z, w2b.z, x0.w, x1.w, x2.w, bb.w, bflo); CONV1(7, w0b.w, w1b.w, w2b.w, x0.w, x1.w, x2.w, bb.w, bfhi);
#undef CONV1
        u32x4 ov; ov.x = pk2(r[0], r[1]); ov.y = pk2(r[2], r[3]); ov.z = pk2(r[4], r[5]); ov.w = pk2(r[6], r[7]);
        if (!dry) *(u32x4*)(scb + o) = ov; else asm volatile("" :: "v"(ov));
    }
}
DEV float gelu_t(float a) { return a * __builtin_amdgcn_rcpf(1.f + __builtin_amdgcn_exp2f(-1.5957691216057308f * LOG2E * (a + 0.044715f * a * a * a))); }
DEV void ffn_mid_phase(int gtid, int gthreads, const bf16_t* fa, bf16_t* fu, const float* cw, const float* cb, bool dry) {
    constexpr int C8 = DFF / 8;
    for (int i = gtid; i < T * C8; i += gthreads) {
        const int t = i / C8, c8 = (i - t * C8) * 8, tl = t & (S - 1);
        const size_t o = (size_t)t * DFF + c8;
        const u32x4 z = {0u, 0u, 0u, 0u};
        const u32x4 x2 = *(const u32x4*)(fa + o), x1 = tl >= 1 ? *(const u32x4*)(fa + o - DFF) : z, x0 = tl >= 2 ? *(const u32x4*)(fa + o - 2 * DFF) : z, uu = *(const u32x4*)(fu + o);
        const f32x4 w0a = *(const f32x4*)(cw + c8), w0b = *(const f32x4*)(cw + c8 + 4), w1a = *(const f32x4*)(cw + DFF + c8), w1b = *(const f32x4*)(cw + DFF + c8 + 4), w2a = *(const f32x4*)(cw + 2 * DFF + c8), w2b = *(const f32x4*)(cw + 2 * DFF + c8 + 4);
        const f32x4 ba = *(const f32x4*)(cb + c8), bb = *(const f32x4*)(cb + c8 + 4);
        float r[8];
#define FM1(k, B0, W0, W1, W2, X0, X1, X2, Uv, F) r[k] = gelu_t(B0 + W0 * F(X0) + W1 * F(X1) + W2 * F(X2)) * F(Uv)
        FM1(0, ba.x, w0a.x, w1a.x, w2a.x, x0.x, x1.x, x2.x, uu.x, bflo); FM1(1, ba.y, w0a.y, w1a.y, w2a.y, x0.x, x1.x, x2.x, uu.x, bfhi);
        FM1(2, ba.z, w0a.z, w1a.z, w2a.z, x0.y, x1.y, x2.y, uu.y, bflo); FM1(3, ba.w, w0a.w, w1a.w, w2a.w, x0.y, x1.y, x2.y, uu.y, bfhi);
        FM1(4, bb.x, w0b.x, w1b.x, w2b.x, x0.z, x1.z, x2.z, uu.z, bflo); FM1(5, bb.y, w0b.y, w1b.y, w2b.y, x0.z, x1.z, x2.z, uu.z, bfhi);
        FM1(6, bb.z, w0b.z, w1b.z, w2b.z, x0.w, x1.w, x2.w, uu.w, bflo); FM1(7, bb.w, w0b.w, w1b.w, w2b.w, x0.w, x1.w, x2.w, uu.w, bfhi);
#undef FM1
        u32x4 ov; ov.x = pk2(r[0], r[1]); ov.y = pk2(r[2], r[3]); ov.z = pk2(r[4], r[5]); ov.w = pk2(r[6], r[7]);
        if (!dry) *(u32x4*)(fu + o) = ov; else asm volatile("" :: "v"(ov));
    }
}

typedef short s16x4 __attribute__((ext_vector_type(4)));
DEV s16x4 vtr(const LAS unsigned char* p) { return __builtin_bit_cast(s16x4, __builtin_amdgcn_ds_read_tr16_b64_v4i16((LAS s16x4*)p)); }
DEV bf16x8 cat8(const s16x4 a, const s16x4 b) { return (bf16x8){a[0], a[1], a[2], a[3], b[0], b[1], b[2], b[3]}; }
DEV bf16x8 pk8(float a0, float a1, float a2, float a3, float a4, float a5, float a6, float a7) {
    u32x4 w; w.x = pk2(a0, a1); w.y = pk2(a2, a3); w.z = pk2(a4, a5); w.w = pk2(a6, a7); return __builtin_bit_cast(bf16x8, w); }
constexpr int VPITCH = 192;
DEV void pv_tile(f32x16& o0, f32x16& o1, const LAS unsigned char* vt, int lane, const bf16x8 (&pk)[4]) {
    const int hi = lane >> 5;
    const LAS unsigned char* vb = vt + (4 * hi + ((lane & 15) >> 2)) * VPITCH + ((lane >> 4) & 1) * 32 + (lane & 3) * 8;
#pragma unroll
    for (int ks = 0; ks < 4; ++ks) {
        const bf16x8 va = cat8(vtr(vb + (16 * ks) * VPITCH), vtr(vb + (16 * ks + 8) * VPITCH));
        const bf16x8 vb2 = cat8(vtr(vb + (16 * ks) * VPITCH + 64), vtr(vb + (16 * ks + 8) * VPITCH + 64));
        o0 = __builtin_amdgcn_mfma_f32_32x32x16_bf16(va, pk[ks], o0, 0, 0, 0);
        o1 = __builtin_amdgcn_mfma_f32_32x32x16_bf16(vb2, pk[ks], o1, 0, 0, 0);
    }
}
DEV void store_ot(bf16_t* orow, const f32x16& o0, const f32x16& o1, int hi, float sc) {
#pragma unroll
    for (int g4 = 0; g4 < 4; ++g4) {
        u32x2 a; a.x = pk2(o0[4 * g4] * sc, o0[4 * g4 + 1] * sc); a.y = pk2(o0[4 * g4 + 2] * sc, o0[4 * g4 + 3] * sc);
        u32x2 b; b.x = pk2(o1[4 * g4] * sc, o1[4 * g4 + 1] * sc); b.y = pk2(o1[4 * g4 + 2] * sc, o1[4 * g4 + 3] * sc);
        *(u32x2*)(orow + 8 * g4 + 4 * hi) = a; *(u32x2*)(orow + 32 + 8 * g4 + 4 * hi) = b;
    }
}

DEV void sb_item(LAS unsigned char* vl, const bf16_t* Q, const bf16_t* Kk, const bf16_t* V, bf16_t* O, int b, int h, int qb, int lane, bool dry) {
    const int r32 = lane & 31, hi = lane >> 5, t0 = 32 * qb, t = t0 + r32; const size_t rowb = (size_t)b * S;
    bf16x8 qr[4]; { const bf16_t* qp = Q + (rowb + t0 + r32) * 512 + h * 64 + 8 * hi;
#pragma unroll
        for (int d0 = 0; d0 < 4; ++d0) qr[d0] = *(const bf16x8*)(qp + 16 * d0); }
    f32x16 o0, o1;
#pragma unroll
    for (int r = 0; r < 16; ++r) { o0[r] = 0.f; o1[r] = 0.f; }
    float carry = 1.f;
    const int c_hi = (t0 + 30) >> 6;
#pragma unroll 1
    for (int c = c_hi; c >= 0; --c) {
        const bf16_t* kp = Kk + (rowb + 64 * c + r32) * 512 + h * 64 + 8 * hi;
        bf16x8 k0[4], k1[4];
#pragma unroll
        for (int d0 = 0; d0 < 4; ++d0) { k0[d0] = *(const bf16x8*)(kp + 16 * d0); k1[d0] = *(const bf16x8*)(kp + (size_t)32 * 512 + 16 * d0); }
#pragma unroll
        for (int j = 0; j < 8; ++j) { const int row = (lane >> 3) + 8 * j; *(LAS u32x4*)(vl + row * VPITCH + (lane & 7) * 16) = *(const u32x4*)(V + (rowb + 64 * c + row) * 512 + h * 64 + (lane & 7) * 8); }
        f32x16 p0, p1;
#pragma unroll
        for (int r = 0; r < 16; ++r) { p0[r] = 0.f; p1[r] = 0.f; }
#pragma unroll
        for (int d0 = 0; d0 < 4; ++d0) { p0 = __builtin_amdgcn_mfma_f32_32x32x16_bf16(k0[d0], qr[d0], p0, 0, 0, 0); p1 = __builtin_amdgcn_mfma_f32_32x32x16_bf16(k1[d0], qr[d0], p1, 0, 0, 0); }
        float u[32];
        const bool diag = (c == c_hi);
#pragma unroll
        for (int e = 0; e < 32; ++e) {
            const float z = e < 16 ? p0[e] : p1[e - 16];
            float uu = __builtin_amdgcn_rcpf(1.f + __builtin_amdgcn_exp2f(fminf(z, 126.f)));
            if (diag) { const int kv = 64 * c + 8 * ((e >> 2) & 3) + 4 * hi + (e & 3) + 32 * (e >> 4); if (kv >= t) uu = 1.f; }
            u[e] = uu;
        }
        float gl[8], gh[8];
#pragma unroll
        for (int i = 0; i < 8; ++i) { const float gp = (u[4 * i] * u[4 * i + 1]) * (u[4 * i + 2] * u[4 * i + 3]);
            const auto rr = __builtin_amdgcn_permlane32_swap(__float_as_uint(gp), __float_as_uint(gp), false, false); gl[i] = __uint_as_float(rr[0]); gh[i] = __uint_as_float(rr[1]); }
        float ag[8]; float run = carry;
#pragma unroll
        for (int i = 7; i >= 0; --i) { const float a_hi = run; run *= gh[i]; const float a_lo = run; run *= gl[i]; ag[i] = hi ? a_hi : a_lo; }
        carry = run;
        bf16x8 pk[4];
#pragma unroll
        for (int ks = 0; ks < 4; ++ks) { float w[8];
#pragma unroll
            for (int g = 0; g < 2; ++g) { const int i = 2 * ks + g;
                const float a3 = ag[i], a2 = a3 * u[4 * i + 3], a1 = a2 * u[4 * i + 2], a0 = a1 * u[4 * i + 1];
                w[4 * g] = (1.f - u[4 * i]) * a0; w[4 * g + 1] = (1.f - u[4 * i + 1]) * a1; w[4 * g + 2] = (1.f - u[4 * i + 2]) * a2; w[4 * g + 3] = (1.f - u[4 * i + 3]) * a3; }
            pk[ks] = pk8(w[0], w[1], w[2], w[3], w[4], w[5], w[6], w[7]); }
        pv_tile(o0, o1, vl, lane, pk);
        if (__all(carry < 7.8e-31f)) break;
    }
    if (!dry) store_ot(O + (rowb + t0 + r32) * 512 + h * 64, o0, o1, hi, 1.f); else asm volatile("" :: "v"(o0), "v"(o1));
}
DEV void sb_phase(const WaveId& W, LAS unsigned char* lds, unsigned char* ws, bool dry) {
    LAS unsigned char* vl = lds + W.wave * 12288;
    const bf16_t* Q = (const bf16_t*)(ws + WS_QA); const bf16_t* Kk = (const bf16_t*)(ws + WS_KA); const bf16_t* V = (const bf16_t*)(ws + WS_VA);
    constexpr int NITEM = NB * 8 * (S / 32);
    for (int it = W.gw; it < NITEM; it += W.ngw) {
        const int qb = it & 255, h = (it >> 8) & 7, b = it >> 11;
        sb_item(vl, Q, Kk, V, (bf16_t*)(ws + WS_QA), b, h, qb, W.lane, dry);
    }
}

constexpr int IDX_CTL_OFF = 131072 + 1024;
DEV unsigned fkey2(float v) { const int u = (int)__float_as_uint(v); return (unsigned)(u ^ ((u >> 31) | (int)0x80000000)); }
DEV float relu1(float x) { return __builtin_amdgcn_fmed3f(x, 0.f, 3.0e38f); }
DEV void idx_unit(LAS unsigned char* lds, const bf16_t* IQ, const bf16_t* IK, const float* IWp, unsigned* BM, int b, int t0, int wid, int lane, int mslot) {
    const int r32 = lane & 31, hh = lane >> 5; const size_t rowb = (size_t)b * S;
    LAS unsigned* cntbuf = (LAS unsigned*)(lds + IDX_CTL_OFF);
    LAS unsigned* eqc = (LAS unsigned*)(lds + IDX_CTL_OFF + 1024);
    bf16x8 afr[4]; { const int qi = 2 * (r32 >> 4) + ((r32 >> 2) & 1), head = (r32 & 3) + 4 * ((r32 >> 3) & 1);
        const bf16_t* ap = IQ + (rowb + t0 + qi) * 512 + head * 64 + 8 * hh;
#pragma unroll
        for (int ks = 0; ks < 4; ++ks) afr[ks] = *(const bf16x8*)(ap + 16 * ks); }
    float w[16];
#pragma unroll
    for (int r = 0; r < 16; ++r) w[r] = IWp[(rowb + t0 + 2 * (r >> 3) + hh) * 8 + (r & 7)];
    const int tmax = t0 + 3, jmax = tmax >> 5;
    LAS unsigned* SCO = (LAS unsigned*)lds;
    bf16x8 b0[4], b1[4], b2[4];
#pragma unroll
    for (int ks = 0; ks < 4; ++ks) { b0[ks] = afr[ks]; b1[ks] = afr[ks]; b2[ks] = afr[ks]; }
#define IDX_LOADB(dst, jj) do { const int jc_ = (jj) < jmax ? (jj) : jmax; const bf16_t* bp_ = IK + ((rowb >> 5) + jc_) * 2048 + (hh * 32 + r32) * 8; \
        _Pragma("unroll") for (int ks = 0; ks < 4; ++ks) dst[ks] = *(const bf16x8*)(bp_ + ks * 512); } while (0)
#define IDX_COMP(src, jj) do { f32x16 acc; _Pragma("unroll") for (int r = 0; r < 16; ++r) acc[r] = 0.f; \
        _Pragma("unroll") for (int ks = 0; ks < 4; ++ks) acc = __builtin_amdgcn_mfma_f32_32x32x16_bf16(afr[ks], src[ks], acc, 0, 0, 0); \
        float s0 = 0.f, s1 = 0.f; _Pragma("unroll") for (int hd = 0; hd < 8; ++hd) { s0 += w[hd] * relu1(acc[hd]); s1 += w[8 + hd] * relu1(acc[8 + hd]); } \
        unsigned k0_ = fkey2(s0), k1_ = fkey2(s1); const int key = 32 * (jj) + r32; \
        if ((jj) >= jmax) { k0_ = key <= t0 + hh ? k0_ : 0u; k1_ = key <= t0 + 2 + hh ? k1_ : 0u; }     \
        if ((jj) <= jmax) { SCO[hh * 8192 + key] = k0_; SCO[(2 + hh) * 8192 + key] = k1_; } } while (0)
#ifndef IDX_REP_MFMA
#define IDX_REP_MFMA 1
#endif
#ifndef IDX_REP_SEL
#define IDX_REP_SEL 1
#endif
#pragma unroll 1
    for (int rpm = 0; rpm < IDX_REP_MFMA; ++rpm) {
    IDX_LOADB(b0, wid); IDX_LOADB(b1, wid + 8);
#pragma unroll 1
    for (int j = wid; j <= jmax; j += 24) {
        IDX_LOADB(b2, j + 16); IDX_COMP(b0, j);
        IDX_LOADB(b0, j + 24); IDX_COMP(b1, j + 8);
        IDX_LOADB(b1, j + 32); IDX_COMP(b2, j + 16);
    }
    }
#undef IDX_LOADB
#undef IDX_COMP
    unsigned sc[32][2];
#pragma unroll
    for (int s = 0; s < 32; ++s) { const int j = wid + 8 * s; const bool v = j <= jmax;
        sc[s][0] = v ? SCO[hh * 8192 + 32 * j + r32] : 0u; sc[s][1] = v ? SCO[(2 + hh) * 8192 + 32 * j + r32] : 0u; }
    const int qrow = lane & 3;
    unsigned lo_, hi_, chi_, xgt_, xeq_, mt_; float glo_, ghi_; int side_; bool done_;
#pragma unroll 1
    for (int rps = 0; rps < IDX_REP_SEL; ++rps) {
    { unsigned mx0 = 0u, mx1 = 0u;
#pragma unroll
      for (int s = 0; s < 32; ++s) { mx0 = max(mx0, sc[s][0]); mx1 = max(mx1, sc[s][1]); }
      LAS unsigned* mxs = cntbuf + 64 + 4 * mslot;
      if (wid == 0 && lane < 4) cntbuf[64 + 4 * (mslot ^ 1) + lane] = 0u;
      __hip_atomic_fetch_max(mxs + hh, mx0, __ATOMIC_RELAXED, __HIP_MEMORY_SCOPE_WORKGROUP); __hip_atomic_fetch_max(mxs + 2 + hh, mx1, __ATOMIC_RELAXED, __HIP_MEMORY_SCOPE_WORKGROUP);
      LDS_WAIT(); __builtin_amdgcn_s_barrier(); asm volatile("" ::: "memory");
      const int n = t0 + qrow + 1;
      lo_ = 1u; glo_ = __log2f((float)n) - 8.f; hi_ = mxs[qrow] + 1u; chi_ = 0u; ghi_ = -9.f; side_ = 0; xeq_ = 0u; mt_ = 0u; xgt_ = 1u; done_ = n <= 256; }
    int par = 0;
#pragma unroll 1
    for (int pass = 0; pass < 160; ++pass) {
        if (__all(done_)) break;
        unsigned cand_;
        { const unsigned wdt = hi_ - lo_;
          unsigned off;
          if (pass < 2) {
              const unsigned mkey = hi_ - 1u; const unsigned tgt = pass == 0 ? mkey - (1u << 23) : mkey - (3u << 23);
              const bool ok = pass == 0 ? (mkey > 0x81000000u) : (mkey > 0x82000000u && tgt > lo_ && tgt < hi_);
              off = ok ? tgt - lo_ : wdt >> 1;
          } else if ((pass & 3) == 3) off = wdt >> 1;
          else off = (unsigned)(glo_ * __builtin_amdgcn_rcpf(glo_ - ghi_) * (float)wdt);
          off = off < 1u ? 1u : (off > wdt - 1u ? wdt - 1u : off);
          cand_ = done_ ? xgt_ : lo_ + off; }
        const unsigned cq0 = (unsigned)__builtin_amdgcn_readlane((int)cand_, 0), cq1 = (unsigned)__builtin_amdgcn_readlane((int)cand_, 1),
                       cq2 = (unsigned)__builtin_amdgcn_readlane((int)cand_, 2), cq3 = (unsigned)__builtin_amdgcn_readlane((int)cand_, 3);
        const unsigned c0 = hh ? cq1 : cq0, c1 = hh ? cq3 : cq2;
        unsigned n0 = 0, n1 = 0;
#pragma unroll
        for (int s = 0; s < 32; ++s) { n0 += sc[s][0] >= c0; n1 += sc[s][1] >= c1; }
        int pk = (int)(n0 | (n1 << 16));
        pk += __builtin_amdgcn_update_dpp(0, pk, 0x111, 0xf, 0xf, false);
        pk += __builtin_amdgcn_update_dpp(0, pk, 0x112, 0xf, 0xf, false);
        pk += __builtin_amdgcn_update_dpp(0, pk, 0x114, 0xf, 0xf, false);
        pk += __builtin_amdgcn_update_dpp(0, pk, 0x118, 0xf, 0xf, false);
        pk += __builtin_amdgcn_update_dpp(0, pk, 0x142, 0xa, 0xf, false);
        if (lane == 31) { cntbuf[(par * 8 + wid) * 4 + 0] = (unsigned)pk & 0xffffu; cntbuf[(par * 8 + wid) * 4 + 2] = (unsigned)pk >> 16; }
        if (lane == 63) { cntbuf[(par * 8 + wid) * 4 + 1] = (unsigned)pk & 0xffffu; cntbuf[(par * 8 + wid) * 4 + 3] = (unsigned)pk >> 16; }
        LDS_WAIT(); __builtin_amdgcn_s_barrier(); asm volatile("" ::: "memory");
        unsigned tot = 0u;
#pragma unroll
        for (int wv = 0; wv < 8; ++wv) tot += cntbuf[(par * 8 + wv) * 4 + qrow];
        par ^= 1;
        {
            const float gc = __log2f(fmaxf((float)tot, 0.5f)) - 8.f;
            const bool act = !done_, eq = tot == 256u, gt = tot > 256u;
            const bool upl = act && !eq && gt, uph = act && !eq && !gt;
            if (upl) { if (side_ == 1) ghi_ *= 0.5f; lo_ = cand_; glo_ = gc; side_ = 1; }
            if (uph) { if (side_ == 2) glo_ *= 0.5f; hi_ = cand_; ghi_ = gc; chi_ = tot; side_ = 2; }
            if (act && eq) { xgt_ = cand_; mt_ = 0u; done_ = true; }
            if ((upl || uph) && hi_ - lo_ == 1u) { xgt_ = hi_; xeq_ = lo_; mt_ = 256u - chi_; done_ = true; }
        }
    }
    }
    unsigned xgt[4], xeq[4], mt[4];
#pragma unroll
    for (int q = 0; q < 4; ++q) { xgt[q] = (unsigned)__builtin_amdgcn_readlane((int)xgt_, q); xeq[q] = (unsigned)__builtin_amdgcn_readlane((int)xeq_, q); mt[q] = (unsigned)__builtin_amdgcn_readlane((int)mt_, q); }
    const unsigned xg0 = hh ? xgt[1] : xgt[0], xg1 = hh ? xgt[3] : xgt[2], xe0 = hh ? xeq[1] : xeq[0], xe1 = hh ? xeq[3] : xeq[2], m0 = hh ? mt[1] : mt[0], m1 = hh ? mt[3] : mt[2];
    const bool ties = (mt[0] | mt[1] | mt[2] | mt[3]) != 0u;
    if (ties) {
        __builtin_amdgcn_s_barrier();
#pragma unroll
        for (int s = 0; s < 32; ++s) { const int j = wid + 8 * s;
            const unsigned long long e0 = __ballot(sc[s][0] == xe0 && m0 != 0u), e1 = __ballot(sc[s][1] == xe1 && m1 != 0u);
            if (lane == 0) { eqc[0 * 256 + j] = __popc((unsigned)e0); eqc[1 * 256 + j] = __popc((unsigned)(e0 >> 32)); eqc[2 * 256 + j] = __popc((unsigned)e1); eqc[3 * 256 + j] = __popc((unsigned)(e1 >> 32)); } }
        LDS_WAIT(); __builtin_amdgcn_s_barrier(); asm volatile("" ::: "memory");
        if (wid < 4) { unsigned v[4], s4 = 0;
#pragma unroll
            for (int i = 0; i < 4; ++i) { v[i] = eqc[wid * 256 + 4 * lane + i]; s4 += v[i]; }
            unsigned inc = s4;
#pragma unroll
            for (int o = 1; o < 64; o <<= 1) { const unsigned tv = __shfl_up(inc, o); if (lane >= o) inc += tv; }
            unsigned run = inc - s4;
#pragma unroll
            for (int i = 0; i < 4; ++i) { eqc[wid * 256 + 4 * lane + i] = run; run += v[i]; } }
        LDS_WAIT(); __builtin_amdgcn_s_barrier(); asm volatile("" ::: "memory");
    }
    const unsigned lower = (1u << r32) - 1u;
#pragma unroll
    for (int s = 0; s < 32; ++s) { const int j = wid + 8 * s;
        bool s0 = sc[s][0] >= xg0, s1 = sc[s][1] >= xg1;
        if (ties) {
            const unsigned long long e0 = __ballot(sc[s][0] == xe0 && m0 != 0u), e1 = __ballot(sc[s][1] == xe1 && m1 != 0u);
            const unsigned h0 = hh ? (unsigned)(e0 >> 32) : (unsigned)e0, h1 = hh ? (unsigned)(e1 >> 32) : (unsigned)e1;
            const unsigned rk0 = eqc[hh * 256 + j] + __popc(h0 & lower), rk1 = eqc[(2 + hh) * 256 + j] + __popc(h1 & lower);
            s0 = s0 || (sc[s][0] == xe0 && rk0 < m0); s1 = s1 || (sc[s][1] == xe1 && rk1 < m1);
        }
        const unsigned long long b0 = __ballot(s0), b1 = __ballot(s1);
        if (lane == 0) { u32x4 o; o.x = (unsigned)b0; o.y = (unsigned)(b0 >> 32); o.z = (unsigned)b1; o.w = (unsigned)(b1 >> 32); *(u32x4*)(BM + ((size_t)b * 256 + j) * S + t0) = o; }
    }
    __builtin_amdgcn_s_barrier();
}
DEV void idx_phase(LAS unsigned char* lds, unsigned char* ws, int vcu, int G, int wid, int lane) {
    constexpr int NUNIT = T / 4;
    if (wid == 0 && lane < 8) ((LAS unsigned*)(lds + IDX_CTL_OFF))[64 + lane] = 0u;
    LDS_WAIT(); __builtin_amdgcn_s_barrier();
    int k = 0;
    for (int un = vcu; un < NUNIT; un += G, ++k) {
        const int b = un / (S / 4), t0 = (un - b * (S / 4)) * 4;
        idx_unit(lds, (const bf16_t*)(ws + WS_IQ), (const bf16_t*)(ws + WS_IK), (const float*)(ws + WS_IW), (unsigned*)(ws + WS_BM), b, t0, wid, lane, k & 1);
    }
}

constexpr int DSA_KOFF = 0, DSA_VOFF = 2 * 8192, DSA_STAGE = 8192 + 64 * VPITCH;
DEV void dsa_unit(LAS unsigned char* lds, const bf16_t* Q, const bf16_t* Kk, const bf16_t* V, const unsigned* BM, bf16_t* O, int b, int h, int qblk, int tid, int wid, int lane) {
    const int r32 = lane & 31, hi = lane >> 5, q0 = 256 * qblk, t0 = q0 + 32 * wid, t = t0 + r32; const size_t rowb = (size_t)b * S;
    bf16x8 qr[4]; { const bf16_t* qp = Q + (rowb + t) * 512 + h * 64 + 8 * hi;
#pragma unroll
        for (int d0 = 0; d0 < 4; ++d0) qr[d0] = *(const bf16x8*)(qp + 16 * d0); }
    f32x16 o0, o1;
#pragma unroll
    for (int r = 0; r < 16; ++r) { o0[r] = 0.f; o1[r] = 0.f; }
    float mrow = -INFINITY, lsum = 0.f;
    const int ntile = (q0 + 256) / 64, wlast = (t0 + 31) >> 6;
    const int srow = tid >> 3, sch = tid & 7;
    const bf16_t* kg = Kk + (rowb + srow) * 512 + h * 64 + sch * 8; const bf16_t* vg = V + (rowb + srow) * 512 + h * 64 + sch * 8;
    const int kdst = srow * 128 + ((sch ^ (srow & 7)) * 16), vdst = srow * VPITCH + sch * 16;
    u32x4 kreg = *(const u32x4*)kg, vreg = *(const u32x4*)vg;
    *(LAS u32x4*)(lds + kdst) = kreg; *(LAS u32x4*)(lds + 8192 + vdst) = vreg;
    const unsigned* bmp = BM + (size_t)b * 256 * S + t;
    unsigned mw0 = bmp[0], mw1 = bmp[(size_t)S];
    __syncthreads();
#pragma unroll 1
    for (int c = 0; c < ntile; ++c) {
        const LAS unsigned char* kt = lds + (c & 1) * DSA_STAGE; const LAS unsigned char* vt = kt + 8192;
        if (c + 1 < ntile) { kreg = *(const u32x4*)(kg + (size_t)(c + 1) * 64 * 512); vreg = *(const u32x4*)(vg + (size_t)(c + 1) * 64 * 512); }
        unsigned nw0 = 0u, nw1 = 0u;
        if (c + 1 <= wlast) { nw0 = bmp[(size_t)(2 * c + 2) * S]; nw1 = bmp[(size_t)(2 * c + 3) * S]; }
        if (c <= wlast) {
            f32x16 p0, p1;
#pragma unroll
            for (int r = 0; r < 16; ++r) { p0[r] = 0.f; p1[r] = 0.f; }
#pragma unroll
            for (int d0 = 0; d0 < 4; ++d0) {
                const int ch = 2 * d0 + hi;
                const bf16x8 ka = *(const LAS bf16x8*)(kt + r32 * 128 + ((ch ^ (r32 & 7)) * 16));
                const bf16x8 kb = *(const LAS bf16x8*)(kt + (32 + r32) * 128 + ((ch ^ (r32 & 7)) * 16));
                p0 = __builtin_amdgcn_mfma_f32_32x32x16_bf16(ka, qr[d0], p0, 0, 0, 0);
                p1 = __builtin_amdgcn_mfma_f32_32x32x16_bf16(kb, qr[d0], p1, 0, 0, 0);
            }
            const unsigned m0 = mw0 >> (4 * hi), m1 = mw1 >> (4 * hi);
            float tmax = -INFINITY;
#pragma unroll
            for (int r = 0; r < 16; ++r) { const int bit = (r & 3) + 8 * (r >> 2);
                const unsigned e0 = (unsigned)__builtin_amdgcn_sbfe((int)m0, bit, 1), e1 = (unsigned)__builtin_amdgcn_sbfe((int)m1, bit, 1);
                p0[r] = __uint_as_float((__float_as_uint(p0[r]) & e0) | (0xff800000u & ~e0)); p1[r] = __uint_as_float((__float_as_uint(p1[r]) & e1) | (0xff800000u & ~e1)); }
#pragma unroll
            for (int r = 0; r < 16; r += 2) tmax = fmaxf(tmax, fmaxf(fmaxf(p0[r], p0[r + 1]), fmaxf(p1[r], p1[r + 1])));
            { const auto rr = __builtin_amdgcn_permlane32_swap(__float_as_uint(tmax), __float_as_uint(tmax), false, false); tmax = fmaxf(__uint_as_float(rr[0]), __uint_as_float(rr[1])); }
            const float mnew = fmaxf(mrow, tmax);
            const float muse = mnew == -INFINITY ? 0.f : mnew;
            if (!__all(mnew == mrow)) {
                const float alpha = __builtin_amdgcn_exp2f(mrow - muse);
                lsum *= alpha;
#pragma unroll
                for (int r = 0; r < 16; ++r) { o0[r] *= alpha; o1[r] *= alpha; }
                mrow = mnew;
            }
            float ps = 0.f;
#pragma unroll
            for (int r = 0; r < 16; ++r) { p0[r] = __builtin_amdgcn_exp2f(p0[r] - muse); p1[r] = __builtin_amdgcn_exp2f(p1[r] - muse); ps += p0[r] + p1[r]; }
            lsum += ps;
            bf16x8 pk[4];
            pk[0] = pk8(p0[0], p0[1], p0[2], p0[3], p0[4], p0[5], p0[6], p0[7]); pk[1] = pk8(p0[8], p0[9], p0[10], p0[11], p0[12], p0[13], p0[14], p0[15]);
            pk[2] = pk8(p1[0], p1[1], p1[2], p1[3], p1[4], p1[5], p1[6], p1[7]); pk[3] = pk8(p1[8], p1[9], p1[10], p1[11], p1[12], p1[13], p1[14], p1[15]);
            pv_tile(o0, o1, vt, lane, pk);
        }
        mw0 = nw0; mw1 = nw1;
        if (c + 1 < ntile) { LAS unsigned char* nb = lds + ((c + 1) & 1) * DSA_STAGE; *(LAS u32x4*)(nb + kdst) = kreg; *(LAS u32x4*)(nb + 8192 + vdst) = vreg; }
        __syncthreads();
    }
    { const auto rr = __builtin_amdgcn_permlane32_swap(__float_as_uint(lsum), __float_as_uint(lsum), false, false); lsum = __uint_as_float(rr[0]) + __uint_as_float(rr[1]); }
    store_ot(O + (rowb + t) * 512 + h * 64, o0, o1, hi, 1.f / lsum);
}
DEV void dsa_phase(LAS unsigned char* lds, unsigned char* ws, int vcu, int G, int tid, int wid, int lane, bf16_t* Oout) {
    constexpr int NPAIR = NB * 8 * 16;
    for (int pr = vcu; pr < NPAIR; pr += G) {
        const int bh = pr >> 4, s = pr & 15, b = bh >> 3, h = bh & 7;
#pragma unroll 1
        for (int k = 0; k < 2; ++k) {
            const int qblk = k == 0 ? s : 31 - s;
            dsa_unit(lds, (const bf16_t*)(ws + WS_QC), (const bf16_t*)(ws + WS_KC), (const bf16_t*)(ws + WS_VC), (const unsigned*)(ws + WS_BM), Oout, b, h, qblk, tid, wid, lane);
        }
    }
}
constexpr int MK_THREADS = 512;
constexpr int RING_BYTES = 131072, MISC_OFF = RING_BYTES + 320, MK_LDS_BYTES = 147456;
constexpr size_t WS_CTL = 0, CTL_ZERO_BYTES = 65536 + 7 * 131072; constexpr int CW_BAR = 4096;
constexpr int PH_PREP0 = 0, PH_KV = 1, PH_GH = 2, PH_L0 = 3, PH_PER_LAYER = 14, NPH = PH_L0 + 2 * PH_PER_LAYER;
enum { Q_INPROJ = 0, Q_SBIDX, Q_DSA, Q_GATES, Q_MERGE, Q_MIX, Q_NORMXA, Q_XALOG, Q_XAOUT, Q_NORMFFN, Q_UP, Q_FFNMID, Q_DOWN, Q_NEXT };

#ifndef QBUILD
#define QBUILD 0xffffu
#endif
#define QON(x) ((QBUILD >> (x)) & 1u)
struct Args { const float* in[20]; float* out; unsigned char* ws; int ph_lo, ph_hi; };

__global__ void __launch_bounds__(MK_THREADS, 2) mk_fwd(Args args) {
    __shared__ __attribute__((aligned(16))) unsigned char lds_raw[MK_LDS_BYTES];
    LAS unsigned char* lds = (LAS unsigned char*)lds_raw;
    volatile LAS unsigned* MISC = (volatile LAS unsigned*)(lds + MISC_OFF);
    const int G = gridDim.x, bx = blockIdx.x;
    unsigned char* ws0 = args.ws;
    for (int u = threadIdx.x; u < (MK_LDS_BYTES - RING_BYTES) / 4; u += MK_THREADS) ((LAS unsigned*)(lds + RING_BYTES))[u] = 0u;
    __syncthreads();
    const int lo = args.ph_lo, hi = args.ph_hi;
    XcdBarrier bar; bar.bar = (unsigned*)(ws0 + WS_CTL) + CW_BAR; bar.x = 0; bar.st = nullptr;
    if (hi - lo > 1) bar = xcd_barrier_post((unsigned*)(ws0 + WS_CTL) + CW_BAR, MISC + 8);
#define BPW(off) ((bf16_t*)(ws + (off)))
    const int vcu = (G % 8 == 0) ? (bx % 8) * (G / 8) + bx / 8 : bx;
    for (int p = lo; p < hi; ++p) {
#ifdef PROBE_REP
        const int reps = (p >= PH_L0 && ((PROBE_REP >> ((p - PH_L0) % PH_PER_LAYER)) & 1)) ? 2 : 1;
#else
        const int reps = 1;
#endif
#ifdef PROBE_REP
#pragma unroll 1
        for (int rep = 0; rep < reps; ++rep) {
        const bool dry = rep + 1 < reps;
#else
        { constexpr bool dry = false;
#endif
        int oz = 0; asm volatile("" : "+s"(oz));
        int tid = threadIdx.x; asm volatile("" : "+v"(tid));
        const int wave = __builtin_amdgcn_readfirstlane(tid >> 6), lane = tid & 63;
        WaveId W; W.gw = vcu * 8 + wave; W.ngw = G * 8; W.wave = wave; W.lane = lane;
        unsigned char* ws = args.ws + oz; float* X = args.out + oz;
#define INP(k) (args.in[(k) + oz])
        if (p == PH_PREP0) {
            prep0_phase(W, (LAS float*)(lds + wave * 16384), ws, args.in + oz, (bf16_t*)X);
        } else if (p == PH_KV && QON(14)) {
            pg8::Order S; S.init(2, 8, 2, G, bx);
            pg8::PtrStd P{(const char*)(ws + WS_MEMN), (const char*)(ws + WS_WKVT), 1 * MiB, 4 * MiB, 0, (size_t)256 * D * 2, (size_t)256 * D * 2};
            pg8::EpiPrep E{ws, 0};
            pg8::gemm_phase<pg8::EpiPrep, pg8::PtrStd, true, true>(lds, D, D, D, S, P, E);
        } else if (p == PH_GH && QON(15)) {
            { pg8::Order S; S.init(1, 4, 16, G, bx); pg8::PtrG P{(const char*)(ws + WS_KVM), (const char*)(ws + WS_WQ)}; pg8::EpiPrep E{ws, 1};
              pg8::gemm_phase<pg8::EpiPrep, pg8::PtrG, true, true>(lds, 2 * D, D, 256, S, P, E); }
            { pg8::Order S; S.init(4, 1, 16, G, (bx + 64) % G); pg8::PtrH P{(const char*)(ws + WS_KVM), (const char*)(ws + WS_WOT)}; pg8::EpiPrep E{ws, 2};
              pg8::gemm_phase<pg8::EpiPrep, pg8::PtrH, true, true>(lds, D, 2 * D, 256, S, P, E); }
        } else if (p >= PH_L0) {
            const int l = (p - PH_L0) / PH_PER_LAYER, q = (p - PH_L0) % PH_PER_LAYER;
            const float* Xin = l == 0 ? INP(0) : X;
            pg8::u64* SSb = (pg8::u64*)(ws + WS_SS);
#define SSA(i) (SSb + (size_t)(i) * T)
            if (q == Q_SBIDX) {
#ifndef NO_SB
                sb_phase(W, lds, ws, dry);
#endif
                __syncthreads();
#ifndef NO_IDX
#ifdef PROBE_SB_ONLY
                if (!dry)
#endif
                idx_phase(lds, ws, vcu, G, wave, lane);
#endif
                conv_sc_phase(vcu * MK_THREADS + tid, G * MK_THREADS, BPW(WS_SCB), BPW(WS_CX), INP(4) + l * 3 * 512, dry);
            } else if (q == Q_DSA) {
#ifndef NO_DSA
                dsa_phase(lds, ws, vcu, G, tid, wave, lane, dry ? BPW(WS_KA) : BPW(WS_QC));
#endif
            } else if (q == Q_FFNMID) {
                ffn_mid_phase(vcu * MK_THREADS + tid, G * MK_THREADS, BPW(WS_FA), BPW(WS_FU), INP(16) + l * 3 * DFF, INP(17) + l * DFF, dry);
            } else if (q == Q_NEXT) {
                if (l + 1 < DEPTH) { int base = 0; convert_layer_weights(W, (LAS float*)(lds + wave * 16384), base, ws, args.in + oz, l + 1); }
                else if (!dry) final_norm(W, BPW(WS_XN), X, INP(19), SSA(6));
            } else if (q == Q_INPROJ && QON(Q_INPROJ)) {
                pg8::Order S; S.init(T / 256, NIN / 256, 1, G, bx);
                pg8::PtrStd P{(const char*)X, (const char*)(ws + WS_WIN), 0, 0, 0, (size_t)256 * D * 2, (size_t)256 * D * 2};
                pg8::EpiInProj E{ws, SSA(3 * l)};
                pg8::gemm_phase<pg8::EpiInProj, pg8::PtrStd, true, true>(lds, D, D, D, S, P, E);
            } else if (q == Q_GATES && QON(Q_GATES)) {
                pg8::Order S; S.init(T / 256, 12, 1, G, bx);
                pg8::PtrStd P{(const char*)X, (const char*)(ws + WS_WG), 0, 0, 0, (size_t)256 * D * 2, (size_t)256 * D * 2};
                pg8::EpiGates E{BPW(WS_GATES), SSA(3 * l)};
                pg8::gemm_phase<pg8::EpiGates, pg8::PtrStd, true, true>(lds, D, D, D, S, P, E);
            } else if (q == Q_MERGE && QON(Q_MERGE)) {
                pg8::Order S; S.init(T / 256, 4, 3, G, bx);
                pg8::PtrStd P{(const char*)(ws + WS_QA), (const char*)(ws + WS_WBR), 16 * MiB, (size_t)D * 512 * 2, 0, (size_t)256 * 512 * 2, (size_t)256 * 512 * 2};
                pg8::EpiMerge E{BPW(WS_XN), BPW(WS_GATES)};
                pg8::gemm_phase<pg8::EpiMerge, pg8::PtrStd, true, true>(lds, 512, 512, 512, S, P, E);
            } else if (q == Q_MIX && QON(Q_MIX)) {
                pg8::Order S; S.init(T / 256, 4, 1, G, bx);
                pg8::PtrStd P{(const char*)(ws + WS_XN), (const char*)(ws + WS_WMIX), 0, 0, 0, (size_t)256 * D * 2, (size_t)256 * D * 2};
                if (l == 0) { pg8::EpiResid<true> E{(const void*)INP(0), dry ? BPW(WS_FU) : BPW(WS_XBXA), dry ? SSA(0) : SSA(1)};
                    pg8::gemm_phase<pg8::EpiResid<true>, pg8::PtrStd, true, true>(lds, D, D, D, S, P, E); }
                else { pg8::EpiResid<false> E{(const void*)X, dry ? BPW(WS_FU) : BPW(WS_XBXA), dry ? SSA(0) : SSA(4)};
                    pg8::gemm_phase<pg8::EpiResid<false>, pg8::PtrStd, true, true>(lds, D, D, D, S, P, E); }

            } else if (q == Q_XALOG && QON(Q_XALOG)) {
                pg8::Order S; S.init(T / 256, 4, 1, G, bx);
                pg8::PtrStd P{(const char*)(ws + WS_XBXA), (const char*)(ws + WS_GT + (size_t)l * 4 * MiB), 0, 0, 2 * MiB, (size_t)256 * D * 2, (size_t)256 * D * 2};
                pg8::EpiSoftmax E{BPW(WS_PXA), SSA(1 + 3 * l)};
                pg8::gemm_phase<pg8::EpiSoftmax, pg8::PtrStd, false, true>(lds, D, D, D, S, P, E);
            } else if (q == Q_XAOUT && QON(Q_XAOUT)) {
                pg8::Order S; S.init(T / 256, 4, 1, G, bx);
                pg8::PtrStd P{(const char*)(ws + WS_PXA), (const char*)(ws + WS_HT + (size_t)l * 4 * MiB), 0, 0, 2 * MiB, (size_t)256 * D * 2, (size_t)256 * D * 2};
                pg8::EpiResid<false> E{(const void*)BPW(WS_XBXA), dry ? BPW(WS_FU) : BPW(WS_XN), dry ? SSA(0) : SSA(2 + 3 * l)};
                pg8::gemm_phase<pg8::EpiResid<false>, pg8::PtrStd, true, true>(lds, D, D, D, S, P, E);
            } else if (q == Q_UP && QON(Q_UP)) {
                pg8::Order S; S.init(T / 256, 22, 1, G, bx);
                pg8::PtrStd P{(const char*)(ws + WS_XN), (const char*)(ws + WS_WUP), 0, 0, 0, (size_t)256 * D * 2, (size_t)256 * D * 2};
                pg8::EpiUp E{BPW(WS_FA), BPW(WS_FU), SSA(2 + 3 * l)};
                pg8::gemm_phase<pg8::EpiUp, pg8::PtrStd, true, true>(lds, D, D, D, S, P, E);
            } else if (q == Q_DOWN && QON(Q_DOWN)) {
                pg8::Order S; S.init(T / 256, 4, 1, G, bx);
                pg8::PtrStd P{(const char*)(ws + WS_FU), (const char*)(ws + WS_WDOWN), 0, 0, 0, (size_t)256 * DFF * 2, (size_t)256 * DFF * 2};
                pg8::EpiResid<false> E{(const void*)BPW(WS_XN), dry ? BPW(WS_QA) : (l + 1 < DEPTH ? (bf16_t*)X : BPW(WS_XN)), dry ? SSA(0) : SSA(3 + 3 * l)};
                pg8::gemm_phase<pg8::EpiResid<false>, pg8::PtrStd, true, true>(lds, DFF, DFF, DFF, S, P, E);
            }
        }
        }
        if (p + 1 < hi && !(p >= PH_L0 && ((p - PH_L0) % PH_PER_LAYER == Q_NORMXA || (p - PH_L0) % PH_PER_LAYER == Q_NORMFFN))) xcd_barrier(bar);
    }
}

extern "C" void kernel_launch(void* const* d_in, const int* in_sizes, int n_in, void* d_out, int out_size, void* d_ws, size_t ws_size, hipStream_t st) {
    if (n_in != 20 || ws_size < WS_NEED || out_size != T * D) { fprintf(stderr, "kernel_launch: unexpected sizes n_in %d ws %zu out %d\n", n_in, ws_size, out_size); return; }
    static int grid = 0;
    if (grid == 0) {
        int dev = 0, cus = 0, per_cu = 0;
        (void)hipGetDevice(&dev); (void)hipDeviceGetAttribute(&cus, hipDeviceAttributeMultiprocessorCount, dev);
        if (hipOccupancyMaxActiveBlocksPerMultiprocessor(&per_cu, (const void*)mk_fwd, MK_THREADS, 0) != hipSuccess || per_cu < 1) { fprintf(stderr, "kernel_launch: occupancy query says %d blocks/CU\n", per_cu); grid = -1; return; }
        (void)hipGetLastError();
        if (cus != 256) { fprintf(stderr, "kernel_launch: built for a 256-CU device, found %d\n", cus); grid = -1; return; }
        grid = cus;
    }
    if (grid < 0) return;
    (void)hipMemsetAsync((char*)d_ws + WS_CTL, 0, CTL_ZERO_BYTES, st);
    Args a{};
    for (int i = 0; i < 20; ++i) a.in[i] = (const float*)d_in[i];
    a.out = (float*)d_out; a.ws = (unsigned char*)d_ws; a.ph_lo = 0; a.ph_hi = NPH;
    hipLaunchKernelGGL(mk_fwd, dim3(grid), dim3(MK_THREADS), 0, st, a);
}
```

```cpp
#include <hip/hip_runtime.h>
#include <stdint.h>
#include <stdio.h>

typedef unsigned short bf16_t;
typedef short bf16x8 __attribute__((ext_vector_type(8)));
typedef float f32x16 __attribute__((ext_vector_type(16)));
typedef float f32x4 __attribute__((ext_vector_type(4)));
#define DEV __device__ __forceinline__

constexpr int NB = 2, S = 8192, D = 1024, T = NB * S, DEPTH = 2;
constexpr int DIN = 8264, DFF = 2816, MEM = 256;
constexpr int NIN = 5376;
constexpr float LOG2E = 1.4426950408889634f;
constexpr float QSCALE = 0.125f * LOG2E;
constexpr float WSCALE = 0.125f * 0.35355339059327373f;
constexpr float XSCALE = 0.0625f * LOG2E;
constexpr float EPS = 1e-6f;
#ifndef MK_FUSE
#define MK_FUSE 1
#endif

constexpr size_t MiB = 1u << 20;
constexpr size_t WS_GT = 1 * MiB;
constexpr size_t WS_HT = 9 * MiB;
constexpr size_t WS_WUP = 17 * MiB, WS_WDOWN = 28 * MiB;
constexpr size_t WS_XN = 34 * MiB;
constexpr size_t WS_WMIX = 66 * MiB, WS_WBR = 68 * MiB, WS_WG = 71 * MiB, WS_WIN = 77 * MiB;
constexpr size_t WS_QA = 88 * MiB, WS_SCB = 104 * MiB, WS_QC = 120 * MiB, WS_KA = 136 * MiB, WS_VA = 152 * MiB, WS_KC = 168 * MiB, WS_VC = 184 * MiB,
                 WS_IQ = 200 * MiB, WS_CX = 216 * MiB, WS_IK = 232 * MiB, WS_IW = 234 * MiB, WS_BM = 235 * MiB;
constexpr size_t WS_GATES = 136 * MiB;
constexpr size_t WS_XTMP = 235 * MiB;
constexpr size_t WS_LOG = 88 * MiB, WS_PXA = 168 * MiB;
constexpr size_t WS_XBXA = 136 * MiB;
constexpr size_t WS_SS = 65536;
constexpr size_t WS_FA = 66 * MiB, WS_FU = 154 * MiB;
constexpr size_t WS_WQ = 200 * MiB  , WS_WOT = 204 * MiB  , WS_WKVT = 208 * MiB  , WS_MEMN = 216 * MiB  , WS_KVM = 218 * MiB  ;
constexpr size_t WS_NEED = 256 * MiB;

DEV bf16_t f2bf(float f) { unsigned u = __float_as_uint(f); u += 0x7fffu + ((u >> 16) & 1u); return (bf16_t)(u >> 16); }
DEV float bf2f(bf16_t h) { return __uint_as_float(((unsigned)h) << 16); }
DEV float wave_sum(float v) {
#pragma unroll
    for (int o = 1; o < 64; o <<= 1) v += __shfl_xor(v, o);
    return v;
}
DEV float wave_max(float v) {
#pragma unroll
    for (int o = 1; o < 64; o <<= 1) v = fmaxf(v, __shfl_xor(v, o));
    return v;
}


#define LAS __attribute__((address_space(3)))
#define GAS __attribute__((address_space(1)))
typedef unsigned u32x4 __attribute__((ext_vector_type(4)));
typedef unsigned u32x2 __attribute__((ext_vector_type(2)));
typedef float f32x2 __attribute__((ext_vector_type(2)));
#define LDS_WAIT() asm volatile("s_waitcnt lgkmcnt(0)" ::: "memory")
#define VM_WAIT() asm volatile("s_waitcnt vmcnt(0)" ::: "memory")
typedef __bf16 bf16x2_t __attribute__((ext_vector_type(2)));
DEV unsigned cvt_pk_bf16(float lo, float hi) { const f32x2 v = {lo, hi}; return __builtin_bit_cast(unsigned, __builtin_convertvector(v, bf16x2_t)); }
DEV float bflo(unsigned w) { return __uint_as_float(w << 16); }
DEV float bfhi(unsigned w) { return __uint_as_float(w & 0xffff0000u); }

namespace pg8 {
constexpr int BM = 256, BK = 64, HALF = 128, HTB = HALF * BK * 2, STAGE_BYTES = 8 * HTB, NXCD = 8, WGM = 8;
__host__ __device__ __forceinline__ int lds_byte(int r, int c) { const int st = (r >> 4) * 2 + (c >> 5), rr = r & 15, cc = c & 31, ob = rr * 64 + cc * 2; return st * 1024 + (ob ^ (((ob >> 9) & 1) << 5)); }
__host__ __device__ __forceinline__ void stage_rc(int b, int& R, int& C) { const int st = b / 1024, sb = b % 1024, swz = sb ^ (((sb >> 9) & 1) << 5); R = (st >> 1) * 16 + swz / 64; C = (st & 1) * 32 + (swz % 64) / 2; }
__host__ __device__ __forceinline__ int perm32(int rho) { const int n = rho >> 4, i = rho & 15; return 8 * (i >> 2) + 4 * n + (i & 3); }

struct Unit { int pm, pn, job; };
struct Order {
    int nM, nN, nwg, ntot, G, c;
    DEV void init(int nM_, int nN_, int njob, int G_, int c_) { nM = nM_; nN = nN_; nwg = nM * nN; ntot = nwg * njob; G = G_; c = c_; }
    DEV bool next(int i, Unit& u) const {
        const int L = i * G + c; if (L >= ntot) return false;
        u.job = L / nwg; int wgid = L - u.job * nwg;
        { const int q = nwg / NXCD, r = nwg % NXCD, xcd = wgid % NXCD, off = wgid / NXCD; wgid = (xcd < r ? xcd * (q + 1) : r * (q + 1) + (xcd - r) * q) + off; }
        const int nig = WGM * nN, gid = wgid / nig, fm = gid * WGM, gsz = (nM - fm) < WGM ? (nM - fm) : WGM;
        u.pm = fm + ((wgid % nig) % gsz); u.pn = (wgid % nig) / gsz; return true;
    }
};
template <class Epi, class Ptr, bool ALIGN_EPI, bool SP2>
DEV void gemm_phase(LAS unsigned char* lds, const int lda, const int ldb, const int K, const Order& S, const Ptr& P, const Epi& E) {
    int tid_ = threadIdx.x; asm volatile("" : "+v"(tid_));
    const int tid = tid_, wid = __builtin_amdgcn_readfirstlane(tid >> 6), lane = tid & 63, wr = wid >> 2, wc = wid & 3, fr = lane & 15, fq = lane >> 4;
    const int nt = K / BK;
    unsigned voffA[2], voffB[2];
#pragma unroll
    for (int i = 0; i < 2; ++i) { int R, C; stage_rc(tid * 16 + i * 8192, R, C); const int Rb = Epi::PERM ? ((R & ~31) + perm32(R & 31)) : R;
        voffA[i] = (unsigned)(R * lda + C) * 2u; voffB[i] = (unsigned)(Rb * ldb + C) * 2u; }
    const size_t kstep = (size_t)(BK * 2);
    const size_t hstepA = (size_t)HALF * lda * 2, hstepB = (size_t)HALF * ldb * 2;
    const unsigned ldsw = (unsigned)wid * 1024u;
    const int aoff = lds_byte(wr * 64 + fr, fq * 8), boff = lds_byte(wc * 32 + fr, fq * 8);
#define PG8_SA(b, h) (((b) * 2 + (h)) * HTB)
#define PG8_SB(b, h) ((4 + (b) * 2 + (h)) * HTB)
#define PG8_STAGE(bufoff, gbase, voff) do { _Pragma("unroll") for (int _i = 0; _i < 2; ++_i) \
        __builtin_amdgcn_global_load_lds((const unsigned*)((const char*)(gbase) + (voff)[_i]), (LAS unsigned*)(lds + (bufoff) + ldsw + _i * 8192), 16, 0, 0); } while (0)
#define PG8_LDA(dst, b, h) do { _Pragma("unroll") for (int m = 0; m < 4; ++m) _Pragma("unroll") for (int k = 0; k < 2; ++k) dst[m][k] = *(const LAS bf16x8*)(lds + PG8_SA(b, h) + aoff + m * 2048 + k * 1024); } while (0)
#define PG8_LDB(dst, b, h) do { _Pragma("unroll") for (int n = 0; n < 2; ++n) _Pragma("unroll") for (int k = 0; k < 2; ++k) dst[n][k] = *(const LAS bf16x8*)(lds + PG8_SB(b, h) + boff + n * 2048 + k * 1024); } while (0)
#define PG8_MMA(ai, bj, At, Bt) do { __builtin_amdgcn_s_setprio(1); _Pragma("unroll") for (int m = 0; m < 4; ++m) _Pragma("unroll") for (int n = 0; n < 2; ++n) _Pragma("unroll") for (int k = 0; k < 2; ++k) \
        acc[ai][bj][m][n] = __builtin_amdgcn_mfma_f32_16x16x32_bf16(Bt[n][k], At[m][k], acc[ai][bj][m][n], 0, 0, 0); __builtin_amdgcn_s_setprio(0); } while (0)
#define PG8_WAIT_V(n) asm volatile("s_waitcnt vmcnt(" #n ")" ::: "memory")
#define PG8_WAIT_L(n) asm volatile("s_waitcnt lgkmcnt(" #n ")" ::: "memory")
#define PG8_BAR __builtin_amdgcn_s_barrier()
#define PG8_SCHED __builtin_amdgcn_sched_barrier(0)
    Unit cur, nxt; int ui = 0;
    if (!S.next(0, cur)) return;
    f32x4 acc[2][2][4][2];
#pragma unroll
    for (int a = 0; a < 2; ++a)
#pragma unroll
        for (int b = 0; b < 2; ++b)
#pragma unroll
            for (int m = 0; m < 4; ++m)
#pragma unroll
                for (int n = 0; n < 2; ++n) acc[a][b][m][n] = (f32x4){0.f, 0.f, 0.f, 0.f};
    bf16x8 At[4][2], B0[2][2], B1[2][2];
    const char* cA = P.a(cur); const char* cB = P.b(cur);
    typename Epi::Pre pre; E.prefetch(pre, cur, wr, fr);
    if constexpr (SP2) {
        PG8_STAGE(PG8_SB(0, 0), cB, voffB); PG8_STAGE(PG8_SB(0, 1), cB + hstepB, voffB); PG8_STAGE(PG8_SA(0, 0), cA, voffA); PG8_STAGE(PG8_SA(0, 1), cA + hstepA, voffA);
        if (wr == 1) PG8_BAR;
        PG8_WAIT_V(2); PG8_BAR;
        PG8_STAGE(PG8_SB(1, 0), cB + kstep, voffB); PG8_STAGE(PG8_SA(1, 0), cA + kstep, voffA); PG8_STAGE(PG8_SB(1, 1), cB + hstepB + kstep, voffB);
        PG8_WAIT_V(6); PG8_BAR;
    } else {
        PG8_STAGE(PG8_SB(0, 0), cB, voffB); PG8_STAGE(PG8_SA(0, 0), cA, voffA); PG8_STAGE(PG8_SB(0, 1), cB + hstepB, voffB); PG8_STAGE(PG8_SA(0, 1), cA + hstepA, voffA);
        if (wr == 1) PG8_BAR;
        PG8_WAIT_V(4); PG8_BAR;
        PG8_STAGE(PG8_SB(1, 0), cB + kstep, voffB); PG8_STAGE(PG8_SA(1, 0), cA + kstep, voffA); PG8_STAGE(PG8_SB(1, 1), cB + hstepB + kstep, voffB);
        PG8_WAIT_V(6); PG8_BAR;
    }
#pragma unroll 1
    for (;;) {
        const bool has_next = S.next(ui + 1, nxt);
        const char* nA = has_next ? P.a(nxt) : cA; const char* nB = has_next ? P.b(nxt) : cB;
#pragma unroll 1
        for (int t = 0; t < nt; t += 2) {
            const bool last = (t == nt - 2);
            const char* a1 = cA + (size_t)(t + 1) * kstep;
            const char* a2 = last ? nA : cA + (size_t)(t + 2) * kstep; const char* b2 = last ? nB : cB + (size_t)(t + 2) * kstep;
            const char* a3 = a2 + kstep; const char* b3 = b2 + kstep;
            if constexpr (SP2) {
            PG8_LDB(B0, 0, 0); PG8_LDB(B1, 0, 1); PG8_SCHED; PG8_LDA(At, 0, 0); PG8_STAGE(PG8_SA(1, 1), a1 + hstepA, voffA);
            PG8_WAIT_V(8); PG8_WAIT_L(0); PG8_BAR; PG8_MMA(0, 0, At, B0); PG8_MMA(0, 1, At, B1); PG8_BAR; PG8_SCHED;
            PG8_LDA(At, 0, 1); PG8_STAGE(PG8_SB(0, 0), b2, voffB); PG8_STAGE(PG8_SB(0, 1), b2 + hstepB, voffB); PG8_STAGE(PG8_SA(0, 0), a2, voffA);
            PG8_WAIT_V(8); PG8_WAIT_L(0); PG8_BAR; PG8_MMA(1, 0, At, B0); PG8_MMA(1, 1, At, B1); PG8_BAR; PG8_SCHED;
            PG8_LDB(B0, 1, 0); PG8_LDB(B1, 1, 1); PG8_SCHED; PG8_LDA(At, 1, 0); PG8_STAGE(PG8_SA(0, 1), a2 + hstepA, voffA);
            PG8_WAIT_V(8); PG8_WAIT_L(0); PG8_BAR; PG8_MMA(0, 0, At, B0); PG8_MMA(0, 1, At, B1); PG8_BAR; PG8_SCHED;
            PG8_LDA(At, 1, 1); PG8_STAGE(PG8_SB(1, 0), b3, voffB); PG8_STAGE(PG8_SB(1, 1), b3 + hstepB, voffB); PG8_STAGE(PG8_SA(1, 0), a3, voffA);
            PG8_WAIT_V(8); PG8_WAIT_L(0); PG8_BAR; PG8_MMA(1, 0, At, B0); PG8_MMA(1, 1, At, B1); PG8_BAR; PG8_SCHED;
            } else {
            PG8_LDB(B0, 0, 0); PG8_SCHED; PG8_LDA(At, 0, 0); PG8_STAGE(PG8_SA(1, 1), a1 + hstepA, voffA);
            PG8_WAIT_L(8); PG8_BAR; PG8_WAIT_L(0); PG8_MMA(0, 0, At, B0); PG8_BAR; PG8_SCHED;
            PG8_LDB(B1, 0, 1); PG8_STAGE(PG8_SB(0, 0), b2, voffB);
            PG8_BAR; PG8_WAIT_L(0); PG8_MMA(0, 1, At, B1); PG8_BAR;
            PG8_LDA(At, 0, 1); PG8_STAGE(PG8_SA(0, 0), a2, voffA);
            PG8_BAR; PG8_WAIT_L(0); PG8_MMA(1, 0, At, B0); PG8_BAR; PG8_SCHED;
            PG8_STAGE(PG8_SB(0, 1), b2 + hstepB, voffB);
            PG8_WAIT_V(6); PG8_BAR; PG8_MMA(1, 1, At, B1); PG8_BAR;
            PG8_LDB(B0, 1, 0); PG8_SCHED; PG8_LDA(At, 1, 0); PG8_STAGE(PG8_SA(0, 1), a2 + hstepA, voffA);
            PG8_WAIT_L(8); PG8_BAR; PG8_WAIT_L(0); PG8_MMA(0, 0, At, B0); PG8_BAR; PG8_SCHED;
            PG8_LDB(B1, 1, 1); PG8_STAGE(PG8_SB(1, 0), b3, voffB);
            PG8_BAR; PG8_WAIT_L(0); PG8_MMA(0, 1, At, B1); PG8_BAR;
            PG8_LDA(At, 1, 1); PG8_STAGE(PG8_SA(1, 0), a3, voffA);
            PG8_BAR; PG8_WAIT_L(0); PG8_MMA(1, 0, At, B0); PG8_BAR; PG8_SCHED;
            PG8_STAGE(PG8_SB(1, 1), b3 + hstepB, voffB);
            PG8_WAIT_V(6); PG8_BAR; PG8_MMA(1, 1, At, B1); PG8_BAR;
            }
        }
        if constexpr (ALIGN_EPI) { if (wr == 0) PG8_BAR; }
        if constexpr (!Epi::AFTER_DRAIN) { E(acc, cur, wr, wc, fr, fq, pre); }
        if (!has_next) break;
#pragma unroll
        for (int a = 0; a < 2; ++a)
#pragma unroll
            for (int b = 0; b < 2; ++b)
#pragma unroll
                for (int m = 0; m < 4; ++m)
#pragma unroll
                    for (int n = 0; n < 2; ++n) acc[a][b][m][n] = (f32x4){0.f, 0.f, 0.f, 0.f};
        cur = nxt; cA = nA; cB = nB; ++ui; E.prefetch(pre, cur, wr, fr);
        if constexpr (ALIGN_EPI) { if (wr == 1) PG8_BAR; }
    }
    PG8_WAIT_V(0);
    if constexpr (!ALIGN_EPI) { if (wr == 0) PG8_BAR; }
    PG8_BAR;
    if constexpr (Epi::AFTER_DRAIN) { E.fused(acc, cur, wr, wc, fr, fq, lds, wid, lane, pre); }
#undef PG8_SA
#undef PG8_SB
#undef PG8_STAGE
#undef PG8_LDA
#undef PG8_LDB
#undef PG8_MMA
#undef PG8_WAIT_V
#undef PG8_WAIT_L
#undef PG8_BAR
#undef PG8_SCHED
}
typedef f32x4 Acc[2][2][4][2];

struct PtrStd {
    const char* A; const char* B; size_t aj, bj, bb, arow, brow;
    DEV const char* a(const Unit& u) const { return A + (size_t)u.job * aj + (size_t)u.pm * arow; }
    DEV const char* b(const Unit& u) const { return B + (size_t)u.job * bj + (size_t)(u.pm >> 5) * bb + (size_t)u.pn * brow; }
};
struct PtrG {
    const char* KVM; const char* WQ;
    DEV const char* a(const Unit& u) const { return KVM + (size_t)(u.job >> 2) * MiB + (size_t)(u.job & 3) * 512; }
    DEV const char* b(const Unit& u) const { return WQ + (size_t)(u.job >> 3) * 2 * MiB + (size_t)(u.job & 3) * 512 + (size_t)u.pn * 256 * 1024 * 2; }
};
struct PtrH {
    const char* KVM; const char* WOT;
    DEV const char* a(const Unit& u) const { return WOT + (size_t)(u.job >> 3) * 2 * MiB + (size_t)(u.job & 3) * 512 + (size_t)u.pm * 256 * 1024 * 2; }
    DEV const char* b(const Unit& u) const { return KVM + (size_t)(u.job >> 2) * MiB + 2048 + (size_t)(u.job & 3) * 512; }
};

#define EPI_ROWS(u) const int row0 = (u).pm * BM + wr * 64 + fr
DEV u32x4 pack8(const f32x4 v0, const f32x4 v1) { u32x4 w; w.x = cvt_pk_bf16(v0[0], v0[1]); w.y = cvt_pk_bf16(v0[2], v0[3]); w.z = cvt_pk_bf16(v1[0], v1[1]); w.w = cvt_pk_bf16(v1[2], v1[3]); return w; }

struct PreNone {};
typedef unsigned long long u64;
constexpr float SS_SCALE = 65536.f;
struct PreRs { u64 v[2][4]; };
DEV void pre_rs(PreRs& p, const u64* ss, int row0) {
#pragma unroll
    for (int ai = 0; ai < 2; ++ai)
#pragma unroll
        for (int m = 0; m < 4; ++m) p.v[ai][m] = __builtin_nontemporal_load(ss + row0 + ai * HALF + m * 16);
}
DEV void rs_of(float (&rs)[2][4], const PreRs& p) {
#pragma unroll
    for (int ai = 0; ai < 2; ++ai)
#pragma unroll
        for (int m = 0; m < 4; ++m) rs[ai][m] = rsqrtf((float)p.v[ai][m] * (1.f / (SS_SCALE * D)) + EPS);
}
struct EpiInProj {
    typedef PreRs Pre;
    DEV void prefetch(PreRs& p, const Unit& u, int wr, int fr) const { pre_rs(p, ss, u.pm * BM + wr * 64 + fr); }
    static constexpr bool PERM = true, AFTER_DRAIN = false;
    unsigned char* ws; const u64* ss;
    DEV void operator()(const Acc& acc, const Unit& u, int wr, int wc, int fr, int fq, const PreRs& pre) const {
        EPI_ROWS(u); const int pn = u.pn, cb = wc * 32 + 8 * fq;
        float rs[2][4]; rs_of(rs, pre);
        if (pn < 16) {
            const int g = pn >> 1;
            const size_t off = g == 0 ? WS_QA : g == 1 ? WS_KA : g == 2 ? WS_VA : g == 3 ? WS_QC : g == 4 ? WS_KC : g == 5 ? WS_VC : g == 6 ? WS_IQ : WS_SCB;
            const float sc = (g == 0 || g == 3) ? QSCALE : 1.f;
            bf16_t* base = (bf16_t*)(ws + off) + (pn & 1) * 256 + cb;
#pragma unroll
            for (int ai = 0; ai < 2; ++ai)
#pragma unroll
                for (int m = 0; m < 4; ++m) { bf16_t* rowp = base + (size_t)(row0 + ai * HALF + m * 16) * 512;
#pragma unroll
                    for (int bj = 0; bj < 2; ++bj) *(u32x4*)(rowp + bj * HALF) = pack8(acc[ai][bj][m][0] * (sc * rs[ai][m]), acc[ai][bj][m][1] * (sc * rs[ai][m])); }
        } else if (pn < 20) {
            bf16_t* base = (bf16_t*)(ws + WS_CX) + (pn - 16) * 128 + cb;
#pragma unroll
            for (int ai = 0; ai < 2; ++ai)
#pragma unroll
                for (int m = 0; m < 4; ++m) { const float r2 = rs[ai][m] * rs[ai][m]; *(u32x4*)(base + (size_t)(row0 + ai * HALF + m * 16) * 512) = pack8(acc[ai][0][m][0] * acc[ai][1][m][0] * r2, acc[ai][0][m][1] * acc[ai][1][m][1] * r2); }
        } else {
            if (wc < 2) { bf16_t* base = (bf16_t*)(ws + WS_IK);
#pragma unroll
                for (int ai = 0; ai < 2; ++ai)
#pragma unroll
                    for (int m = 0; m < 4; ++m) { const int t = row0 + ai * HALF + m * 16;
                        *(u32x4*)(base + (size_t)(t >> 5) * 2048 + (((cb >> 3) * 32 + (t & 31)) * 8)) = pack8(acc[ai][0][m][0] * rs[ai][m], acc[ai][0][m][1] * rs[ai][m]); }
            } else if (wc == 2 && fq == 0) { float* base = (float*)(ws + WS_IW);
#pragma unroll
                for (int ai = 0; ai < 2; ++ai)
#pragma unroll
                    for (int m = 0; m < 4; ++m) { float* p = base + (size_t)(row0 + ai * HALF + m * 16) * 8; *(f32x4*)p = acc[ai][0][m][0] * (WSCALE * rs[ai][m]); *(f32x4*)(p + 4) = acc[ai][0][m][1] * (WSCALE * rs[ai][m]); }
            }
        }
    }
};
DEV f32x4 sigm4(const f32x4 v) { f32x4 o;
#pragma unroll
    for (int i = 0; i < 4; ++i) o[i] = __builtin_amdgcn_rcpf(1.f + __builtin_amdgcn_exp2f(-LOG2E * v[i])); return o; }
struct EpiGates {
    typedef PreRs Pre;
    DEV void prefetch(PreRs& p, const Unit& u, int wr, int fr) const { pre_rs(p, ss, u.pm * BM + wr * 64 + fr); }
    static constexpr bool PERM = true, AFTER_DRAIN = false;
    bf16_t* G; const u64* ss;
    DEV void operator()(const Acc& acc, const Unit& u, int wr, int wc, int fr, int fq, const PreRs& pre) const {
        EPI_ROWS(u); float rs[2][4]; rs_of(rs, pre); bf16_t* base = G + (size_t)(u.pn >> 2) * T * D + (u.pn & 3) * 256 + wc * 32 + 8 * fq;
#pragma unroll
        for (int ai = 0; ai < 2; ++ai)
#pragma unroll
            for (int m = 0; m < 4; ++m) { bf16_t* rowp = base + (size_t)(row0 + ai * HALF + m * 16) * D;
#pragma unroll
                for (int bj = 0; bj < 2; ++bj) *(u32x4*)(rowp + bj * HALF) = pack8(sigm4(acc[ai][bj][m][0] * rs[ai][m]), sigm4(acc[ai][bj][m][1] * rs[ai][m])); }
    }
};
struct EpiMerge {
    typedef PreNone Pre;
    DEV void prefetch(PreNone&, const Unit&, int, int) const {}
    static constexpr bool PERM = true, AFTER_DRAIN = false;
    bf16_t* M; const bf16_t* G;
    DEV void operator()(const Acc& acc, const Unit& u, int wr, int wc, int fr, int fq, const PreNone&) const {
        EPI_ROWS(u); const size_t cofs = (size_t)u.pn * 256 + wc * 32 + 8 * fq; const bf16_t* gb = G + (size_t)u.job * T * D;
#pragma unroll
        for (int ai = 0; ai < 2; ++ai)
#pragma unroll
            for (int m = 0; m < 4; ++m) { const size_t ro = (size_t)(row0 + ai * HALF + m * 16) * D + cofs;
#pragma unroll
                for (int bj = 0; bj < 2; ++bj) { const size_t o = ro + bj * HALF; const u32x4 g = *(const u32x4*)(gb + o);
                    f32x4 v0 = acc[ai][bj][m][0], v1 = acc[ai][bj][m][1];
                    v0[0] *= bflo(g.x); v0[1] *= bfhi(g.x); v0[2] *= bflo(g.y); v0[3] *= bfhi(g.y); v1[0] *= bflo(g.z); v1[1] *= bfhi(g.z); v1[2] *= bflo(g.w); v1[3] *= bfhi(g.w);
                    if (u.job > 0) { const u32x4 p = __builtin_nontemporal_load((const u32x4*)(M + o));
                        v0[0] += bflo(p.x); v0[1] += bfhi(p.x); v0[2] += bflo(p.y); v0[3] += bfhi(p.y); v1[0] += bflo(p.z); v1[1] += bfhi(p.z); v1[2] += bflo(p.w); v1[3] += bfhi(p.w); }
                    *(u32x4*)(M + o) = pack8(v0, v1); } }
    }
};
template <bool IN_F32> struct EpiResid {
    typedef PreNone Pre;
    DEV void prefetch(PreNone&, const Unit&, int, int) const {}
    static constexpr bool PERM = true, AFTER_DRAIN = false;
    const void* xin; bf16_t* xb; u64* ss;
    DEV void operator()(const Acc& acc, const Unit& u, int wr, int wc, int fr, int fq, const PreNone&) const {
        EPI_ROWS(u); const size_t cofs = (size_t)u.pn * 256 + wc * 32 + 8 * fq;
#pragma unroll
        for (int ai = 0; ai < 2; ++ai)
#pragma unroll
            for (int m = 0; m < 4; ++m) { const size_t ro = (size_t)(row0 + ai * HALF + m * 16) * D + cofs; float sq = 0.f;
#pragma unroll
                for (int bj = 0; bj < 2; ++bj) { const size_t o = ro + bj * HALF; f32x4 v0 = acc[ai][bj][m][0], v1 = acc[ai][bj][m][1];
                    if (IN_F32) { v0 = v0 + *(const f32x4*)((const float*)xin + o); v1 = v1 + *(const f32x4*)((const float*)xin + o + 4); }
                    else { const u32x4 p = *(const u32x4*)((const bf16_t*)xin + o);
                        v0[0] += bflo(p.x); v0[1] += bfhi(p.x); v0[2] += bflo(p.y); v0[3] += bfhi(p.y); v1[0] += bflo(p.z); v1[1] += bfhi(p.z); v1[2] += bflo(p.w); v1[3] += bfhi(p.w); }
                    *(u32x4*)(xb + o) = pack8(v0, v1);
                    sq += ((v0[0] * v0[0] + v0[1] * v0[1]) + (v0[2] * v0[2] + v0[3] * v0[3])) + ((v1[0] * v1[0] + v1[1] * v1[1]) + (v1[2] * v1[2] + v1[3] * v1[3])); }
                sq += __shfl_xor(sq, 16); sq += __shfl_xor(sq, 32);
                if (fq == 0) atomicAdd(ss + row0 + ai * HALF + m * 16, (u64)(sq * SS_SCALE + 0.5f)); }
    }
};
struct EpiUp {
    typedef PreRs Pre;
    DEV void prefetch(PreRs& p, const Unit& u, int wr, int fr) const { pre_rs(p, ss, u.pm * BM + wr * 64 + fr); }
    static constexpr bool PERM = true, AFTER_DRAIN = false;
    bf16_t *fa, *fu; const u64* ss;
    DEV void operator()(const Acc& acc, const Unit& u, int wr, int wc, int fr, int fq, const PreRs& pre) const {
        EPI_ROWS(u); float rs[2][4]; rs_of(rs, pre); const size_t cofs = (size_t)u.pn * 128 + wc * 32 + 8 * fq;
#pragma unroll
        for (int ai = 0; ai < 2; ++ai)
#pragma unroll
            for (int m = 0; m < 4; ++m) { const size_t o = (size_t)(row0 + ai * HALF + m * 16) * DFF + cofs;
                *(u32x4*)(fa + o) = pack8(acc[ai][0][m][0] * rs[ai][m], acc[ai][0][m][1] * rs[ai][m]); *(u32x4*)(fu + o) = pack8(acc[ai][1][m][0] * rs[ai][m], acc[ai][1][m][1] * rs[ai][m]); }
    }
};
struct EpiPrep {
    typedef PreNone Pre;
    DEV void prefetch(PreNone&, const Unit&, int, int) const {}
    static constexpr bool PERM = true, AFTER_DRAIN = false;
    unsigned char* ws; int mode;
    DEV void operator()(const Acc& acc, const Unit& u, int wr, int wc, int fr, int fq, const PreNone&) const {
        EPI_ROWS(u); bf16_t* base; int ldc; float sc = 1.f;
        if (mode == 0) { base = (bf16_t*)(ws + WS_KVM + (size_t)u.job * 2 * MiB); ldc = 2 * D; }
        else if (mode == 1) { base = (bf16_t*)(ws + WS_GT + (size_t)(u.job >> 2) * 2 * MiB) + (size_t)(u.job & 3) * 256 * D; ldc = D; sc = XSCALE; }
        else { base = (bf16_t*)(ws + WS_HT + (size_t)(u.job >> 2) * 2 * MiB) + (u.job & 3) * 256; ldc = D; }
        base += (size_t)u.pn * 256 + wc * 32 + 8 * fq;
#pragma unroll
        for (int ai = 0; ai < 2; ++ai)
#pragma unroll
            for (int m = 0; m < 4; ++m) { bf16_t* rowp = base + (size_t)(row0 + ai * HALF + m * 16) * ldc;
#pragma unroll
                for (int bj = 0; bj < 2; ++bj) *(u32x4*)(rowp + bj * HALF) = pack8(acc[ai][bj][m][0] * sc, acc[ai][bj][m][1] * sc); }
    }
};
struct EpiSoftmax {
    typedef PreRs Pre;
    DEV void prefetch(PreRs& p, const Unit& u, int wr, int fr) const { pre_rs(p, ss, u.pm * BM + wr * 64 + fr); }
    static constexpr bool PERM = true, AFTER_DRAIN = true;
    bf16_t* P; const u64* ss;
    DEV void fused(Acc& acc, const Unit& u, int wr, int wc, int fr, int fq, LAS unsigned char* lds, int wid, int lane, const PreRs& pre) const {
        LAS float* PM = (LAS float*)lds; LAS float* PS = (LAS float*)(lds + 4096);
        { const int row0_ = u.pm * BM + wr * 64 + fr; float rs[2][4]; rs_of(rs, pre);
#pragma unroll
          for (int ai = 0; ai < 2; ++ai)
#pragma unroll
              for (int m = 0; m < 4; ++m)
#pragma unroll
                  for (int bj = 0; bj < 2; ++bj)
#pragma unroll
                      for (int n = 0; n < 2; ++n) acc[ai][bj][m][n] = acc[ai][bj][m][n] * rs[ai][m]; }
#pragma unroll
        for (int ai = 0; ai < 2; ++ai)
#pragma unroll
            for (int m = 0; m < 4; ++m) { float mx = -INFINITY;
#pragma unroll
                for (int bj = 0; bj < 2; ++bj)
#pragma unroll
                    for (int n = 0; n < 2; ++n) { const f32x4 x = acc[ai][bj][m][n]; mx = fmaxf(mx, fmaxf(fmaxf(x[0], x[1]), fmaxf(x[2], x[3]))); }
                mx = fmaxf(mx, __shfl_xor(mx, 16)); mx = fmaxf(mx, __shfl_xor(mx, 32));
                if (fq == 0) PM[(ai * HALF + wr * 64 + m * 16 + fr) * 4 + wc] = mx; }
        LDS_WAIT(); __builtin_amdgcn_s_barrier(); asm volatile("" ::: "memory");
#pragma unroll
        for (int ai = 0; ai < 2; ++ai)
#pragma unroll
            for (int m = 0; m < 4; ++m) { const int r = ai * HALF + wr * 64 + m * 16 + fr; const f32x4 q = *(const LAS f32x4*)(PM + r * 4);
                const float mx = fmaxf(fmaxf(q[0], q[1]), fmaxf(q[2], q[3])); float s = 0.f;
#pragma unroll
                for (int bj = 0; bj < 2; ++bj)
#pragma unroll
                    for (int n = 0; n < 2; ++n) { f32x4 x = acc[ai][bj][m][n];
#pragma unroll
                        for (int i = 0; i < 4; ++i) { x[i] = __builtin_amdgcn_exp2f(x[i] - mx); s += x[i]; } acc[ai][bj][m][n] = x; }
                s += __shfl_xor(s, 16); s += __shfl_xor(s, 32);
                if (fq == 0) PS[r * 4 + wc] = s; }
        LDS_WAIT(); __builtin_amdgcn_s_barrier(); asm volatile("" ::: "memory");
        EPI_ROWS(u); bf16_t* base = P + (size_t)u.pn * 256 + wc * 32 + 8 * fq;
#pragma unroll
        for (int ai = 0; ai < 2; ++ai)
#pragma unroll
            for (int m = 0; m < 4; ++m) { const int r = ai * HALF + wr * 64 + m * 16 + fr; const f32x4 q = *(const LAS f32x4*)(PS + r * 4);
                const float inv = 1.f / ((q[0] + q[1]) + (q[2] + q[3])); bf16_t* rowp = base + (size_t)(row0 + ai * HALF + m * 16) * D;
#pragma unroll
                for (int bj = 0; bj < 2; ++bj) *(u32x4*)(rowp + bj * HALF) = pack8(acc[ai][bj][m][0] * inv, acc[ai][bj][m][1] * inv); }
        LDS_WAIT(); __builtin_amdgcn_s_barrier();
    }
};
}

typedef GAS unsigned gu32;
#define XB_TMO      128
#define XB_XCNT(j)  (256  + 64 * (j))
#define XB_XSUB(j)  (1280 + 64 * (j))
#define XB_XGEN(j)  (2304 + 64 * (j))
#define XB_TOP      3328
#define XB_TOPGEN   3392
#define XCD_BAR_WORDS 3456
#define XB_SPIN_CAP (1u << 22)
DEV unsigned xb_ld(unsigned* p) { return __hip_atomic_load(p, __ATOMIC_RELAXED, __HIP_MEMORY_SCOPE_AGENT); }
DEV unsigned xb_add(unsigned* p, unsigned v) { return __hip_atomic_fetch_add(p, v, __ATOMIC_RELAXED, __HIP_MEMORY_SCOPE_AGENT); }
DEV unsigned xb_xcc_id() { return (unsigned)__builtin_amdgcn_s_getreg((3 << 11) | 20) & 0xFu; }
#define XB_SPIN(cond, bar) do { unsigned _sp = 0; while (cond) { __builtin_amdgcn_s_sleep(1); \
    if ((++_sp & 255u) == 0u) { if (xb_ld(&(bar)[XB_TMO])) break; if (_sp > XB_SPIN_CAP) { atomicAdd(&(bar)[XB_TMO], 1u); break; } } } } while (0)
struct XcdBarrier { unsigned* bar; unsigned x; volatile LAS unsigned* st; };
DEV XcdBarrier xcd_barrier_post(unsigned* bar, volatile LAS unsigned* st) {
    XcdBarrier b; b.bar = bar; b.x = xb_xcc_id(); b.st = st;
    if (threadIdx.x == 0) (void)xb_add(&bar[XB_XCNT(b.x)], 1u);
    return b;
}
DEV void xcd_barrier_complete(unsigned* bar, unsigned x, unsigned& nloc, unsigned& nx) {
    const unsigned G = gridDim.x * gridDim.y * gridDim.z;
    unsigned sum, cnt, mine, sp = 0u;
    for (;;) {
        sum = 0u; cnt = 0u; mine = 0u;
#pragma unroll
        for (unsigned j = 0; j < 16; ++j) { const unsigned c = xb_ld(&bar[XB_XCNT(j)]); sum += c; cnt += (c > 0u) ? 1u : 0u; mine = (j == x) ? c : mine; }
        if (sum == G) break;
        __builtin_amdgcn_s_sleep(1);
        if ((++sp & 255u) == 0u) { if (xb_ld(&bar[XB_TMO])) break; if (sp > XB_SPIN_CAP) { atomicAdd(&bar[XB_TMO], 1u); break; } }
    }
    nloc = mine > 0u ? mine : 1u; nx = cnt > 0u ? cnt : 1u;
}
DEV void xcd_barrier(const XcdBarrier& b) {
    asm volatile("s_waitcnt vmcnt(0)" ::: "memory");
    __syncthreads();
    if (threadIdx.x == 0) {
        unsigned* bar = b.bar;
        __builtin_amdgcn_s_waitcnt(0);
        unsigned nloc = b.st[0], nx = b.st[1];
        if (nloc == 0u) { xcd_barrier_complete(bar, b.x, nloc, nx); b.st[0] = nloc; b.st[1] = nx; }
        const unsigned old = xb_add(&bar[XB_XSUB(b.x)], 1u);
        const unsigned gen = old / nloc;
        if (old + 1u == (gen + 1u) * nloc) {
            __builtin_amdgcn_fence(__ATOMIC_RELEASE, "agent");
            asm volatile("s_waitcnt vmcnt(0)" ::: "memory");
            const unsigned og = xb_add(&bar[XB_TOP], 1u);
            const unsigned tg = og / nx;
            if (og + 1u == (tg + 1u) * nx) xb_add(&bar[XB_TOPGEN], 1u);
            else XB_SPIN(xb_ld(&bar[XB_TOPGEN]) == tg, bar);
            __builtin_amdgcn_fence(__ATOMIC_ACQUIRE, "agent");
            xb_add(&bar[XB_XGEN(b.x)], 1u);
            asm volatile("s_waitcnt vmcnt(0)" ::: "memory");
        } else {
            XB_SPIN(xb_ld(&bar[XB_XGEN(b.x)]) == gen, bar);
            __builtin_amdgcn_fence(__ATOMIC_ACQUIRE, "agent");
            asm volatile("s_waitcnt vmcnt(0)" ::: "memory");
        }
    }
    __syncthreads();
}


struct WaveId { int gw, ngw, wave, lane; };
DEV unsigned f2bf_u(float f) { return (unsigned)f2bf(f); }
DEV unsigned pk2(float lo, float hi) { return cvt_pk_bf16(lo, hi); }

DEV void norm_rows(const WaveId& W, const float* x, const float* g, bf16_t* outb, float* outf, int rows) {
    for (int row = W.gw; row < rows; row += W.ngw) {
        const f32x4* xr = (const f32x4*)(x + (size_t)row * D) + W.lane;
        f32x4 v[4]; float s = 0.f;
#pragma unroll
        for (int j = 0; j < 4; ++j) { v[j] = xr[64 * j]; s += (v[j].x * v[j].x + v[j].y * v[j].y) + (v[j].z * v[j].z + v[j].w * v[j].w); }
        const float r = rsqrtf(wave_sum(s) * (1.f / D) + EPS);
#pragma unroll
        for (int j = 0; j < 4; ++j) {
            const f32x4 gg = ((const f32x4*)g)[W.lane + 64 * j];
            const f32x4 o = {v[j].x * r * gg.x, v[j].y * r * gg.y, v[j].z * r * gg.z, v[j].w * r * gg.w};
            if (outb) { u32x2 w; w.x = pk2(o.x, o.y); w.y = pk2(o.z, o.w); ((u32x2*)(outb + (size_t)row * D))[W.lane + 64 * j] = w; }
            else ((f32x4*)(outf + (size_t)row * D))[W.lane + 64 * j] = o;
        }
    }
}
DEV void cvt_piece(const WaveId& W, LAS float* scr, int& base, const float* Wsrc, int ldw, int K, int col0, int ncols, bf16_t* dst, int ldo, int row0, const float* gain = nullptr) {
    const int nblk = ncols / 32, nitems = (K / 64) * nblk;
    int first = (W.gw - base) % W.ngw; if (first < 0) first += W.ngw;
    base = (base + nitems) % W.ngw;
    for (int item = first; item < nitems; item += W.ngw) {
        const int kb = item / nblk, nb = item - kb * nblk, k0 = 64 * kb, n0 = 32 * nb;
#pragma unroll 8
        for (int i = 0; i < 32; ++i) { const int kk = 2 * i + (W.lane >> 5); scr[kk * 33 + (W.lane & 31)] = Wsrc[(size_t)(k0 + kk) * ldw + col0 + n0 + (W.lane & 31)] * (gain ? gain[k0 + kk] : 1.f); }
        LDS_WAIT(); asm volatile("" ::: "memory");
        const int c = W.lane & 7;
#pragma unroll
        for (int j = 0; j < 4; ++j) { const int n = (W.lane >> 3) + 8 * j; const LAS float* s = scr + (8 * c) * 33 + n;
            u32x4 o; o.x = pk2(s[0 * 33], s[1 * 33]); o.y = pk2(s[2 * 33], s[3 * 33]); o.z = pk2(s[4 * 33], s[5 * 33]); o.w = pk2(s[6 * 33], s[7 * 33]);
            *(u32x4*)(dst + (size_t)(row0 + n0 + n) * ldo + k0 + 8 * c) = o; }
        LDS_WAIT(); asm volatile("" ::: "memory");
    }
}
DEV void convert_layer_weights(const WaveId& W, LAS float* scr, int& base, unsigned char* ws, const float* const* in, int l) {
    const float* wi = in[3] + (size_t)l * D * DIN;
    bf16_t* WIN = (bf16_t*)(ws + WS_WIN); const float* gm = in[2] + l * D; const float* gf = in[14] + l * D;
    cvt_piece(W, scr, base, wi, DIN, D, 0, 1536, WIN, D, 0, gm);
    cvt_piece(W, scr, base, wi, DIN, D, 3072, 1536, WIN, D, 1536, gm);
    cvt_piece(W, scr, base, wi, DIN, D, 4608, 512, WIN, D, 3072, gm);
    cvt_piece(W, scr, base, wi, DIN, D, 1536, 512, WIN, D, 3584, gm);
#pragma unroll 1
    for (int j = 0; j < 4; ++j) { cvt_piece(W, scr, base, wi, DIN, D, 2048 + 128 * j, 128, WIN, D, 4096 + 256 * j, gm); cvt_piece(W, scr, base, wi, DIN, D, 2560 + 128 * j, 128, WIN, D, 4096 + 256 * j + 128, gm); }
    cvt_piece(W, scr, base, wi, DIN, D, 5120, 96, WIN, D, 5120, gm);
    cvt_piece(W, scr, base, wi, DIN, D, 5192, 3072, (bf16_t*)(ws + WS_WG), D, 0, gm);
#pragma unroll 1
    for (int i = 0; i < 3; ++i) cvt_piece(W, scr, base, in[5 + i] + (size_t)l * 512 * D, D, 512, 0, D, (bf16_t*)(ws + WS_WBR) + (size_t)i * D * 512, 512, 0);
    cvt_piece(W, scr, base, in[8] + (size_t)l * D * D, D, D, 0, D, (bf16_t*)(ws + WS_WMIX), D, 0);
    const float* wf = in[15] + (size_t)l * D * 2 * DFF;
#pragma unroll 1
    for (int j = 0; j < 22; ++j) { cvt_piece(W, scr, base, wf, 2 * DFF, D, 128 * j, 128, (bf16_t*)(ws + WS_WUP), D, 256 * j, gf); cvt_piece(W, scr, base, wf, 2 * DFF, D, DFF + 128 * j, 128, (bf16_t*)(ws + WS_WUP), D, 256 * j + 128, gf); }
    cvt_piece(W, scr, base, in[18] + (size_t)l * DFF * D, D, DFF, 0, D, (bf16_t*)(ws + WS_WDOWN), DFF, 0);
}
DEV void prep0_phase(const WaveId& W, LAS float* scr, unsigned char* ws, const float* const* in, bf16_t* XB) {
    int base = 0;
#pragma unroll 1
    for (int l = 0; l < DEPTH; ++l) {
        const float* wq = in[11] + (size_t)l * D * D; bf16_t* WQ = (bf16_t*)(ws + WS_WQ + (size_t)l * 2 * MiB); const float* gx = in[9] + l * D;
        for (size_t i = (size_t)(W.gw * 64 + W.lane) * 4; i < (size_t)D * D; i += (size_t)W.ngw * 256) { const float g = gx[i >> 10]; const f32x4 v = *(const f32x4*)(wq + i); u32x2 o; o.x = pk2(v.x * g, v.y * g); o.y = pk2(v.z * g, v.w * g); *(u32x2*)(WQ + i) = o; }
        cvt_piece(W, scr, base, in[13] + (size_t)l * D * D, D, D, 0, D, (bf16_t*)(ws + WS_WOT + (size_t)l * 2 * MiB), D, 0);
        cvt_piece(W, scr, base, in[12] + (size_t)l * D * 2 * D, 2 * D, D, 0, 2 * D, (bf16_t*)(ws + WS_WKVT + (size_t)l * 4 * MiB), D, 0);
        norm_rows(W, in[1], in[10] + l * D, (bf16_t*)(ws + WS_MEMN + (size_t)l * MiB), nullptr, NB * MEM);
    }
    convert_layer_weights(W, scr, base, ws, in, 0);
    pg8::u64* ss0 = (pg8::u64*)(ws + WS_SS);
    for (int row = W.gw; row < T; row += W.ngw) {
        const f32x4* xr = (const f32x4*)(in[0] + (size_t)row * D) + W.lane; float s = 0.f;
#pragma unroll
        for (int j = 0; j < 4; ++j) { const f32x4 v = xr[64 * j]; s += (v.x * v.x + v.y * v.y) + (v.z * v.z + v.w * v.w);
            u32x2 w; w.x = pk2(v.x, v.y); w.y = pk2(v.z, v.w); ((u32x2*)(XB + (size_t)row * D))[W.lane + 64 * j] = w; }
        s = wave_sum(s); if (W.lane == 0) ss0[row] = (pg8::u64)(s * pg8::SS_SCALE + 0.5f);
    }
}
DEV void final_norm(const WaveId& W, const bf16_t* x, float* out, const float* g, const pg8::u64* ss) {
    for (int row = W.gw; row < T; row += W.ngw) {
        const float r = rsqrtf((float)ss[row] * (1.f / (pg8::SS_SCALE * D)) + EPS); const u32x2* xr = (const u32x2*)(x + (size_t)row * D) + W.lane; f32x4* orow = (f32x4*)(out + (size_t)row * D) + W.lane;
#pragma unroll
        for (int j = 0; j < 4; ++j) { const f32x4 gg = ((const f32x4*)g)[W.lane + 64 * j]; const u32x2 v = xr[64 * j];
            const f32x4 o = {bflo(v.x) * r * gg.x, bfhi(v.x) * r * gg.y, bflo(v.y) * r * gg.z, bfhi(v.y) * r * gg.w}; orow[64 * j] = o; }
    }
}
DEV void conv_sc_phase(int gtid, int gthreads, bf16_t* scb, const bf16_t* cx, const float* w, bool dry) {
    for (int i = gtid; i < T * 64; i += gthreads) {
        const int c8 = (i & 63) * 8, t = i >> 6, tl = t & (S - 1);
        const size_t o = (size_t)t * 512 + c8;
        const u32x4 z = {0u, 0u, 0u, 0u};
        const u32x4 x2 = *(const u32x4*)(cx + o), x1 = tl >= 1 ? *(const u32x4*)(cx + o - 512) : z, x0 = tl >= 2 ? *(const u32x4*)(cx + o - 1024) : z, bb = *(const u32x4*)(scb + o);
        const f32x4 w0a = *(const f32x4*)(w + c8), w0b = *(const f32x4*)(w + c8 + 4), w1a = *(const f32x4*)(w + 512 + c8), w1b = *(const f32x4*)(w + 512 + c8 + 4), w2a = *(const f32x4*)(w + 1024 + c8), w2b = *(const f32x4*)(w + 1024 + c8 + 4);
        float r[8];
#define CONV1(k, W0, W1, W2, X0, X1, X2, BBv, F) r[k] = F(BBv) * (W0 * F(X0) + W1 * F(X1) + W2 * F(X2))
        CONV1(0, w0a.x, w1a.x, w2a.x, x0.x, x1.x, x2.x, bb.x, bflo); CONV1(1, w0a.y, w1a.y, w2a.y, x0.x, x1.x, x2.x, bb.x, bfhi);
        CONV1(2, w0a.z, w1a.z, w2a.z, x0.y, x1.y, x2.y, bb.y, bflo); CONV1(3, w0a.w, w1a.w, w2a.w, x0.y, x1.y, x2.y, bb.y, bfhi);
        CONV1(4, w0b.x, w1b.x, w2b.x, x0.z, x1.z, x2.z, bb.z, bflo); CONV1(5, w0b.y, w1b.y, w2b.y, x0.z, x1.z, x2.z, bb.z, bfhi);
        CONV1(6, w0b.z, w1b.z, w2b.z, x0.w, x1.w, x2.w, bb.w, bflo); CONV1(7, w0b.w, w1b.w, w2b.w, x0.w, x1.w, x2.w, bb.w, bfhi);
#undef CONV1
        u32x4 ov; ov.x = pk2(r[0], r[1]); ov.y = pk2(r[2], r[3]); ov.z = pk2(r[4], r[5]); ov.w = pk2(r[6], r[7]);
        if (!dry) *(u32x4*)(scb + o) = ov; else asm volatile("" :: "v"(ov));
    }
}
DEV float gelu_t(float a) { return a * __builtin_amdgcn_rcpf(1.f + __builtin_amdgcn_exp2f(-1.5957691216057308f * LOG2E * (a + 0.044715f * a * a * a))); }
DEV void ffn_mid_phase(int gtid, int gthreads, const bf16_t* fa, bf16_t* fu, const float* cw, const float* cb, bool dry) {
    constexpr int C8 = DFF / 8;
    for (int i = gtid; i < T * C8; i += gthreads) {
        const int t = i / C8, c8 = (i - t * C8) * 8, tl = t & (S - 1);
        const size_t o = (size_t)t * DFF + c8;
        const u32x4 z = {0u, 0u, 0u, 0u};
        const u32x4 x2 = *(const u32x4*)(fa + o), x1 = tl >= 1 ? *(const u32x4*)(fa + o - DFF) : z, x0 = tl >= 2 ? *(const u32x4*)(fa + o - 2 * DFF) : z, uu = *(const u32x4*)(fu + o);
        const f32x4 w0a = *(const f32x4*)(cw + c8), w0b = *(const f32x4*)(cw + c8 + 4), w1a = *(const f32x4*)(cw + DFF + c8), w1b = *(const f32x4*)(cw + DFF + c8 + 4), w2a = *(const f32x4*)(cw + 2 * DFF + c8), w2b = *(const f32x4*)(cw + 2 * DFF + c8 + 4);
        const f32x4 ba = *(const f32x4*)(cb + c8), bb = *(const f32x4*)(cb + c8 + 4);
        float r[8];
#define FM1(k, B0, W0, W1, W2, X0, X1, X2, Uv, F) r[k] = gelu_t(B0 + W0 * F(X0) + W1 * F(X1) + W2 * F(X2)) * F(Uv)
        FM1(0, ba.x, w0a.x, w1a.x, w2a.x, x0.x, x1.x, x2.x, uu.x, bflo); FM1(1, ba.y, w0a.y, w1a.y, w2a.y, x0.x, x1.x, x2.x, uu.x, bfhi);
        FM1(2, ba.z, w0a.z, w1a.z, w2a.z, x0.y, x1.y, x2.y, uu.y, bflo); FM1(3, ba.w, w0a.w, w1a.w, w2a.w, x0.y, x1.y, x2.y, uu.y, bfhi);
        FM1(4, bb.x, w0b.x, w1b.x, w2b.x, x0.z, x1.z, x2.z, uu.z, bflo); FM1(5, bb.y, w0b.y, w1b.y, w2b.y, x0.z, x1.z, x2.z, uu.z, bfhi);
        FM1(6, bb.z, w0b.z, w1b.z, w2b.z, x0.w, x1.w, x2.w, uu.w, bflo); FM1(7, bb.w, w0b.w, w1b.w, w2b.w, x0.w, x1.w, x2.w, uu.w, bfhi);
#undef FM1
        u32x4 ov; ov.x = pk2(r[0], r[1]); ov.y = pk2(r[2], r[3]); ov.z = pk2(r[4], r[5]); ov.w = pk2(r[6], r[7]);
        if (!dry) *(u32x4*)(fu + o) = ov; else asm volatile("" :: "v"(ov));
    }
}

typedef short s16x4 __attribute__((ext_vector_type(4)));
DEV s16x4 vtr(const LAS unsigned char* p) { return __builtin_bit_cast(s16x4, __builtin_amdgcn_ds_read_tr16_b64_v4i16((LAS s16x4*)p)); }
DEV bf16x8 cat8(const s16x4 a, const s16x4 b) { return (bf16x8){a[0], a[1], a[2], a[3], b[0], b[1], b[2], b[3]}; }
DEV bf16x8 pk8(float a0, float a1, float a2, float a3, float a4, float a5, float a6, float a7) {
    u32x4 w; w.x = pk2(a0, a1); w.y = pk2(a2, a3); w.z = pk2(a4, a5); w.w = pk2(a6, a7); return __builtin_bit_cast(bf16x8, w); }
constexpr int VPITCH = 192;
DEV void pv_tile(f32x16& o0, f32x16& o1, const LAS unsigned char* vt, int lane, const bf16x8 (&pk)[4]) {
    const int hi = lane >> 5;
    const LAS unsigned char* vb = vt + (4 * hi + ((lane & 15) >> 2)) * VPITCH + ((lane >> 4) & 1) * 32 + (lane & 3) * 8;
    bf16x8 va[4], vc[4];
#pragma unroll
    for (int ks = 0; ks < 4; ++ks) {
        va[ks] = cat8(vtr(vb + (16 * ks) * VPITCH), vtr(vb + (16 * ks + 8) * VPITCH));
        vc[ks] = cat8(vtr(vb + (16 * ks) * VPITCH + 64), vtr(vb + (16 * ks + 8) * VPITCH + 64));
    }
    asm volatile("" : "+v"(va[0]), "+v"(va[1]), "+v"(va[2]), "+v"(va[3]), "+v"(vc[0]), "+v"(vc[1]), "+v"(vc[2]), "+v"(vc[3]));
#pragma unroll
    for (int ks = 0; ks < 4; ++ks) {
        o0 = __builtin_amdgcn_mfma_f32_32x32x16_bf16(va[ks], pk[ks], o0, 0, 0, 0);
        o1 = __builtin_amdgcn_mfma_f32_32x32x16_bf16(vc[ks], pk[ks], o1, 0, 0, 0);
    }
}
DEV void store_ot(bf16_t* orow, const f32x16& o0, const f32x16& o1, int hi, float sc) {
#pragma unroll
    for (int g4 = 0; g4 < 4; ++g4) {
        u32x2 a; a.x = pk2(o0[4 * g4] * sc, o0[4 * g4 + 1] * sc); a.y = pk2(o0[4 * g4 + 2] * sc, o0[4 * g4 + 3] * sc);
        u32x2 b; b.x = pk2(o1[4 * g4] * sc, o1[4 * g4 + 1] * sc); b.y = pk2(o1[4 * g4 + 2] * sc, o1[4 * g4 + 3] * sc);
        *(u32x2*)(orow + 8 * g4 + 4 * hi) = a; *(u32x2*)(orow + 32 + 8 * g4 + 4 * hi) = b;
    }
}

DEV void sb_item(LAS unsigned char* vl, const bf16_t* Q, const bf16_t* Kk, const bf16_t* V, bf16_t* O, int b, int h, int qb, int lane, bool dry) {
    const int r32 = lane & 31, hi = lane >> 5, t0 = 32 * qb, t = t0 + r32; const size_t rowb = (size_t)b * S;
    bf16x8 qr[4]; { const bf16_t* qp = Q + (rowb + t0 + r32) * 512 + h * 64 + 8 * hi;
#pragma unroll
        for (int d0 = 0; d0 < 4; ++d0) qr[d0] = *(const bf16x8*)(qp + 16 * d0); }
    f32x16 o0, o1;
#pragma unroll
    for (int r = 0; r < 16; ++r) { o0[r] = 0.f; o1[r] = 0.f; }
    float carry = 1.f;
    const int c_hi = (t0 + 30) >> 6;
#pragma unroll 1
    for (int c = c_hi; c >= 0; --c) {
        const bf16_t* kp = Kk + (rowb + 64 * c + r32) * 512 + h * 64 + 8 * hi;
        bf16x8 k0[4], k1[4];
#pragma unroll
        for (int d0 = 0; d0 < 4; ++d0) { k0[d0] = *(const bf16x8*)(kp + 16 * d0); k1[d0] = *(const bf16x8*)(kp + (size_t)32 * 512 + 16 * d0); }
#pragma unroll
        for (int j = 0; j < 8; ++j) { const int row = (lane >> 3) + 8 * j; *(LAS u32x4*)(vl + row * VPITCH + (lane & 7) * 16) = *(const u32x4*)(V + (rowb + 64 * c + row) * 512 + h * 64 + (lane & 7) * 8); }
        f32x16 p0, p1;
#pragma unroll
        for (int r = 0; r < 16; ++r) { p0[r] = 0.f; p1[r] = 0.f; }
#pragma unroll
        for (int d0 = 0; d0 < 4; ++d0) { p0 = __builtin_amdgcn_mfma_f32_32x32x16_bf16(k0[d0], qr[d0], p0, 0, 0, 0); p1 = __builtin_amdgcn_mfma_f32_32x32x16_bf16(k1[d0], qr[d0], p1, 0, 0, 0); }
        float u[32];
        const bool diag = (c == c_hi);
#pragma unroll
        for (int e = 0; e < 32; ++e) {
            const float z = e < 16 ? p0[e] : p1[e - 16];
            float uu = __builtin_amdgcn_rcpf(1.f + __builtin_amdgcn_exp2f(fminf(z, 126.f)));
            if (diag) { const int kv = 64 * c + 8 * ((e >> 2) & 3) + 4 * hi + (e & 3) + 32 * (e >> 4); if (kv >= t) uu = 1.f; }
            u[e] = uu;
        }
        float gl[8], gh[8];
#pragma unroll
        for (int i = 0; i < 8; ++i) { const float gp = (u[4 * i] * u[4 * i + 1]) * (u[4 * i + 2] * u[4 * i + 3]);
            const auto rr = __builtin_amdgcn_permlane32_swap(__float_as_uint(gp), __float_as_uint(gp), false, false); gl[i] = __uint_as_float(rr[0]); gh[i] = __uint_as_float(rr[1]); }
        float ag[8]; float run = carry;
#pragma unroll
        for (int i = 7; i >= 0; --i) { const float a_hi = run; run *= gh[i]; const float a_lo = run; run *= gl[i]; ag[i] = hi ? a_hi : a_lo; }
        carry = run;
        bf16x8 pk[4];
#pragma unroll
        for (int ks = 0; ks < 4; ++ks) { float w[8];
#pragma unroll
            for (int g = 0; g < 2; ++g) { const int i = 2 * ks + g;
                const float a3 = ag[i], a2 = a3 * u[4 * i + 3], a1 = a2 * u[4 * i + 2], a0 = a1 * u[4 * i + 1];
                w[4 * g] = (1.f - u[4 * i]) * a0; w[4 * g + 1] = (1.f - u[4 * i + 1]) * a1; w[4 * g + 2] = (1.f - u[4 * i + 2]) * a2; w[4 * g + 3] = (1.f - u[4 * i + 3]) * a3; }
            pk[ks] = pk8(w[0], w[1], w[2], w[3], w[4], w[5], w[6], w[7]); }
        pv_tile(o0, o1, vl, lane, pk);
        if (__all(carry < 7.8e-31f)) break;
    }
    if (!dry) store_ot(O + (rowb + t0 + r32) * 512 + h * 64, o0, o1, hi, 1.f); else asm volatile("" :: "v"(o0), "v"(o1));
}
DEV void sb_phase(const WaveId& W, LAS unsigned char* lds, unsigned char* ws, bool dry) {
    LAS unsigned char* vl = lds + W.wave * 12288;
    const bf16_t* Q = (const bf16_t*)(ws + WS_QA); const bf16_t* Kk = (const bf16_t*)(ws + WS_KA); const bf16_t* V = (const bf16_t*)(ws + WS_VA);
    constexpr int NITEM = NB * 8 * (S / 32);
    for (int it = W.gw; it < NITEM; it += W.ngw) {
        const int qb = it & 255, h = (it >> 8) & 7, b = it >> 11;
        sb_item(vl, Q, Kk, V, (bf16_t*)(ws + WS_QA), b, h, qb, W.lane, dry);
    }
}

constexpr int IDX_CTL_OFF = 131072 + 1024;
DEV unsigned fkey2(float v) { const int u = (int)__float_as_uint(v); return (unsigned)(u ^ ((u >> 31) | (int)0x80000000)); }
DEV float relu1(float x) { return __builtin_amdgcn_fmed3f(x, 0.f, 3.0e38f); }
DEV void idx_unit(LAS unsigned char* lds, const bf16_t* IQ, const bf16_t* IK, const float* IWp, unsigned* BM, int b, int t0, int wid, int lane, int mslot) {
    const int r32 = lane & 31, hh = lane >> 5; const size_t rowb = (size_t)b * S;
    bf16x8 afr[4]; { const int qi = 2 * (r32 >> 4) + ((r32 >> 2) & 1), head = (r32 & 3) + 4 * ((r32 >> 3) & 1);
        const bf16_t* ap = IQ + (rowb + t0 + qi) * 512 + head * 64 + 8 * hh;
#pragma unroll
        for (int ks = 0; ks < 4; ++ks) afr[ks] = *(const bf16x8*)(ap + 16 * ks); }
    float w[16];
#pragma unroll
    for (int r = 0; r < 16; ++r) w[r] = IWp[(rowb + t0 + 2 * (r >> 3) + hh) * 8 + (r & 7)];
    const int tmax = t0 + 3, jmax = tmax >> 5;
    LAS unsigned* SCO = (LAS unsigned*)lds;
    bf16x8 b0[4], b1[4], b2[4];
#pragma unroll
    for (int ks = 0; ks < 4; ++ks) { b0[ks] = afr[ks]; b1[ks] = afr[ks]; b2[ks] = afr[ks]; }
#define IDX_LOADB(dst, jj) do { const int jc_ = (jj) < jmax ? (jj) : jmax; const bf16_t* bp_ = IK + ((rowb >> 5) + jc_) * 2048 + (hh * 32 + r32) * 8; \
        _Pragma("unroll") for (int ks = 0; ks < 4; ++ks) dst[ks] = *(const bf16x8*)(bp_ + ks * 512); } while (0)
#define IDX_COMP(src, jj) do { f32x16 acc; _Pragma("unroll") for (int r = 0; r < 16; ++r) acc[r] = 0.f; \
        _Pragma("unroll") for (int ks = 0; ks < 4; ++ks) acc = __builtin_amdgcn_mfma_f32_32x32x16_bf16(afr[ks], src[ks], acc, 0, 0, 0); \
        float s0 = 0.f, s1 = 0.f; _Pragma("unroll") for (int hd = 0; hd < 8; ++hd) { s0 += w[hd] * relu1(acc[hd]); s1 += w[8 + hd] * relu1(acc[8 + hd]); } \
        unsigned k0_ = fkey2(s0), k1_ = fkey2(s1); const int key = 32 * (jj) + r32; \
        if ((jj) >= jmax) { k0_ = key <= t0 + hh ? k0_ : 0u; k1_ = key <= t0 + 2 + hh ? k1_ : 0u; }     \
        if ((jj) <= jmax) { SCO[hh * 8192 + key] = k0_; SCO[(2 + hh) * 8192 + key] = k1_; } } while (0)
#ifndef IDX_REP_MFMA
#define IDX_REP_MFMA 1
#endif
#ifndef IDX_REP_SEL
#define IDX_REP_SEL 1
#endif
#pragma unroll 1
    for (int rpm = 0; rpm < IDX_REP_MFMA; ++rpm) {
    IDX_LOADB(b0, wid); IDX_LOADB(b1, wid + 8);
#pragma unroll 1
    for (int j = wid; j <= jmax; j += 24) {
        IDX_LOADB(b2, j + 16); IDX_COMP(b0, j);
        IDX_LOADB(b0, j + 24); IDX_COMP(b1, j + 8);
        IDX_LOADB(b1, j + 32); IDX_COMP(b2, j + 16);
    }
    }
#undef IDX_LOADB
#undef IDX_COMP
    LAS unsigned* thr = (LAS unsigned*)(lds + IDX_CTL_OFF);
    if (wid == 0 && lane < 32) ((LAS unsigned*)(lds + IDX_CTL_OFF + 64))[lane] = 0u;
    LDS_WAIT(); __builtin_amdgcn_s_barrier(); asm volatile("" ::: "memory");
    {
        const int q = wid & 3, h = wid >> 2, n = t0 + q + 1;
        volatile LAS unsigned* xme = (volatile LAS unsigned*)(lds + IDX_CTL_OFF + 64) + (q * 2 + h) * 4;
        volatile LAS unsigned* xpa = (volatile LAS unsigned*)(lds + IDX_CTL_OFF + 64) + (q * 2 + (h ^ 1)) * 4;
        unsigned T_ = 1u;
        if (n > 256) {
            LAS unsigned* row = SCO + q * 8192 + lane;
            unsigned r[64];
#pragma unroll
            for (int il = 0; il < 64; ++il) r[il] = (2 * (2 * il + h) + hh <= jmax) ? row[64 * (2 * il + h)] : 0u;
            unsigned seq = 0u;
#define IDX_XCHG(val, out) do { ++seq; const int pb_ = (seq & 1u) * 2; if (lane == 0) { xme[pb_ + 1] = (val); xme[pb_] = seq; } \
                while (xpa[pb_] != seq) __builtin_amdgcn_s_sleep(0); (out) = xpa[pb_ + 1]; } while (0)
#define IDX_XCHG16(val, out) do { ++seq; const int pb_ = (seq & 1u) * 2; if (lane == 0) xme[pb_] = (seq << 16) | (val); unsigned w_; \
                while (((w_ = xpa[pb_]) >> 16) != (seq & 0xffffu)) __builtin_amdgcn_s_sleep(0); (out) = w_ & 0xffffu; } while (0)
#pragma unroll 1
            for (int rps = 0; rps < IDX_REP_SEL; ++rps) {
            unsigned mx = 0u;
#pragma unroll
            for (int il = 0; il < 64; ++il) mx = max(mx, r[il]);
#pragma unroll
            for (int o = 1; o < 64; o <<= 1) mx = max(mx, (unsigned)__shfl_xor((int)mx, o));
            { unsigned pm_; IDX_XCHG(mx, pm_); mx = max(mx, pm_); }
            unsigned lo_ = 1u, hi_ = mx + 1u, chi_ = 0u, xgt_ = 1u, xeq_ = 0u, mt_ = 0u; float glo_ = __log2f((float)n) - 8.f, ghi_ = -9.f; int side_ = 0; bool done_ = false;
#pragma unroll 1
            for (int pass = 0; pass < 160 && !done_; ++pass) {
                const unsigned wdt = hi_ - lo_;
                unsigned off;
                if (pass < 2) {
                    const unsigned mkey = hi_ - 1u; const unsigned tgt = pass == 0 ? mkey - (1u << 23) : mkey - (3u << 23);
                    const bool ok = pass == 0 ? (mkey > 0x81000000u) : (mkey > 0x82000000u && tgt > lo_ && tgt < hi_);
                    off = ok ? tgt - lo_ : wdt >> 1;
                } else if ((pass & 3) == 3) off = wdt >> 1;
                else off = (unsigned)(glo_ * __builtin_amdgcn_rcpf(glo_ - ghi_) * (float)wdt);
                off = off < 1u ? 1u : (off > wdt - 1u ? wdt - 1u : off);
                const unsigned cand = (unsigned)__builtin_amdgcn_readfirstlane((int)(lo_ + off));
                unsigned ca_ = 0, cb_ = 0; const unsigned candv = lo_ + off;
#define IDX_CNT4(A, B, C, Dd) asm volatile("v_cmp_ge_u32_e64 s[88:89], %2, %6\n\tv_cmp_ge_u32_e64 s[90:91], %3, %6\n\tv_cmp_ge_u32_e64 s[92:93], %4, %6\n\tv_cmp_ge_u32_e64 s[94:95], %5, %6\n\t" \
                    "v_addc_co_u32_e64 %0, s[88:89], %0, 0, s[88:89]\n\tv_addc_co_u32_e64 %1, s[90:91], %1, 0, s[90:91]\n\tv_addc_co_u32_e64 %0, s[92:93], %0, 0, s[92:93]\n\tv_addc_co_u32_e64 %1, s[94:95], %1, 0, s[94:95]" \
                    : "+v"(ca_), "+v"(cb_) : "v"(A), "v"(B), "v"(C), "v"(Dd), "v"(candv) : "s88", "s89", "s90", "s91", "s92", "s93", "s94", "s95")
#pragma unroll
                for (int il = 0; il < 64; il += 4) IDX_CNT4(r[il], r[il + 1], r[il + 2], r[il + 3]);
#undef IDX_CNT4
                int pk = (int)(ca_ + cb_);
                pk += __builtin_amdgcn_update_dpp(0, pk, 0x111, 0xf, 0xf, false);
                pk += __builtin_amdgcn_update_dpp(0, pk, 0x112, 0xf, 0xf, false);
                pk += __builtin_amdgcn_update_dpp(0, pk, 0x114, 0xf, 0xf, false);
                pk += __builtin_amdgcn_update_dpp(0, pk, 0x118, 0xf, 0xf, false);
                pk += __builtin_amdgcn_update_dpp(0, pk, 0x142, 0xa, 0xf, false);
                unsigned tot = (unsigned)__builtin_amdgcn_readlane(pk, 31) + (unsigned)__builtin_amdgcn_readlane(pk, 63);
                { unsigned pt_; IDX_XCHG16(tot, pt_); tot += pt_; }
                const float gc = __log2f(fmaxf((float)tot, 0.5f)) - 8.f;
                if (tot == 256u) { xgt_ = cand; mt_ = 0u; done_ = true; }
                else { if (tot > 256u) { if (side_ == 1) ghi_ *= 0.5f; lo_ = cand; glo_ = gc; side_ = 1; }
                       else { if (side_ == 2) glo_ *= 0.5f; hi_ = cand; ghi_ = gc; chi_ = tot; side_ = 2; }
                       if (hi_ - lo_ == 1u) { xgt_ = hi_; xeq_ = lo_; mt_ = 256u - chi_; done_ = true; } }
            }
#ifdef IDX_XTRA
#pragma unroll 1
            for (int xr = 0; xr < IDX_XTRA; ++xr) { unsigned dsum = 0; const unsigned cv = xgt_ + (unsigned)xr;
#pragma unroll
                for (int il = 0; il < 64; ++il) dsum += r[il] >= cv;
                int pk = (int)dsum;
                pk += __builtin_amdgcn_update_dpp(0, pk, 0x111, 0xf, 0xf, false); pk += __builtin_amdgcn_update_dpp(0, pk, 0x112, 0xf, 0xf, false); pk += __builtin_amdgcn_update_dpp(0, pk, 0x114, 0xf, 0xf, false);
                pk += __builtin_amdgcn_update_dpp(0, pk, 0x118, 0xf, 0xf, false); pk += __builtin_amdgcn_update_dpp(0, pk, 0x142, 0xa, 0xf, false);
                unsigned tot = (unsigned)__builtin_amdgcn_readlane(pk, 31) + (unsigned)__builtin_amdgcn_readlane(pk, 63);
                { unsigned pt_; IDX_XCHG16(tot, pt_); tot += pt_; } asm volatile("" :: "s"(tot)); }
#endif
            T_ = xgt_;
            if (mt_ != 0u) {
                if (h == 0) { unsigned run = 0u;
#pragma unroll 1
                    for (int i = 0; i <= (jmax >> 1); ++i) { const bool ok_ = 2 * i + hh <= jmax; const unsigned kv = ok_ ? row[64 * i] : 0u; const bool eq = kv == xeq_; const unsigned long long bm = __ballot(eq);
                        const unsigned rank = run + __builtin_amdgcn_mbcnt_hi((unsigned)(bm >> 32), __builtin_amdgcn_mbcnt_lo((unsigned)bm, 0u));
                        if (eq && rank >= mt_) row[64 * i] = 0u;
                        run += (unsigned)__popcll(bm); } }
                T_ = xeq_;
            }
            }
#undef IDX_XCHG
#undef IDX_XCHG16
        }
        if (lane == 0 && h == 0) thr[q] = T_;
    }
    LDS_WAIT(); __builtin_amdgcn_s_barrier(); asm volatile("" ::: "memory");
    { const unsigned tq0 = thr[hh], tq1 = thr[2 + hh];
#pragma unroll 4
      for (int j = wid; j < 256; j += 8) {
          bool s0 = false, s1 = false;
          if (j <= jmax) { s0 = SCO[hh * 8192 + 32 * j + r32] >= tq0; s1 = SCO[(2 + hh) * 8192 + 32 * j + r32] >= tq1; }
          const unsigned long long b0_ = __ballot(s0), b1_ = __ballot(s1);
          if (lane == 0) { u32x4 o; o.x = (unsigned)b0_; o.y = (unsigned)(b0_ >> 32); o.z = (unsigned)b1_; o.w = (unsigned)(b1_ >> 32); *(u32x4*)(BM + ((size_t)b * 256 + j) * S + t0) = o; }
      } }
    LDS_WAIT(); __builtin_amdgcn_s_barrier();
}
DEV void idx_phase(LAS unsigned char* lds, unsigned char* ws, int vcu, int G, int wid, int lane) {
    constexpr int NUNIT = T / 4;
    int k = 0;
    for (int un = vcu; un < NUNIT; un += G, ++k) {
        const int b = un / (S / 4), t0 = (un - b * (S / 4)) * 4;
        idx_unit(lds, (const bf16_t*)(ws + WS_IQ), (const bf16_t*)(ws + WS_IK), (const float*)(ws + WS_IW), (unsigned*)(ws + WS_BM), b, t0, wid, lane, k & 1);
    }
}

constexpr int DSA_KOFF = 0, DSA_VOFF = 2 * 8192, DSA_STAGE = 8192 + 64 * VPITCH;
DEV void dsa_unit(LAS unsigned char* lds, const bf16_t* Q, const bf16_t* Kk, const bf16_t* V, const unsigned* BM, bf16_t* O, int b, int h, int qblk, int tid, int wid, int lane) {
    const int r32 = lane & 31, hi = lane >> 5, q0 = 256 * qblk, t0 = q0 + 32 * wid, t = t0 + r32; const size_t rowb = (size_t)b * S;
    bf16x8 qr[4]; { const bf16_t* qp = Q + (rowb + t) * 512 + h * 64 + 8 * hi;
#pragma unroll
        for (int d0 = 0; d0 < 4; ++d0) qr[d0] = *(const bf16x8*)(qp + 16 * d0); }
    f32x16 o0, o1, negm;
#pragma unroll
    for (int r = 0; r < 16; ++r) { o0[r] = 0.f; o1[r] = 0.f; negm[r] = 0.f; }
    float mref = 0.f, lsum = 0.f; bool seen = false;
    constexpr float THR = 8.f;
    const int ntile = (q0 + 256) / 64, wlast = (t0 + 31) >> 6;
    const int srow = tid >> 3, sch = tid & 7;
    const bf16_t* kg = Kk + (rowb + srow) * 512 + h * 64 + sch * 8; const bf16_t* vg = V + (rowb + srow) * 512 + h * 64 + sch * 8;
    const int kdst = srow * 128 + ((sch ^ (srow & 7)) * 16), vdst = srow * VPITCH + sch * 16;
    u32x4 kr0 = *(const u32x4*)kg, vr0 = *(const u32x4*)vg;
    *(LAS u32x4*)(lds + kdst) = kr0; *(LAS u32x4*)(lds + 8192 + vdst) = vr0;
    u32x4 kr1 = *(const u32x4*)(kg + (size_t)64 * 512), vr1 = *(const u32x4*)(vg + (size_t)64 * 512);
    const unsigned* bmp = BM + (size_t)b * 256 * S + t;
    unsigned mw0 = bmp[0], mw1 = bmp[(size_t)S];
    const int koff = r32 * 128;
    __syncthreads();
#define DSA_TILE(c, BUF, NBUF, KL, VL, KW, VW) do { \
        const LAS unsigned char* kt = lds + (BUF) * DSA_STAGE; const LAS unsigned char* vt = kt + 8192; \
        if ((c) + 2 < ntile) { KL = *(const u32x4*)(kg + (size_t)((c) + 2) * 64 * 512); VL = *(const u32x4*)(vg + (size_t)((c) + 2) * 64 * 512); } \
        unsigned nw0 = 0u, nw1 = 0u; \
        if ((c) + 1 <= wlast) { nw0 = bmp[(size_t)(2 * (c) + 2) * S]; nw1 = bmp[(size_t)(2 * (c) + 3) * S]; } \
        if ((c) <= wlast) { \
            bf16x8 kf[8]; \
            _Pragma("unroll") for (int d0 = 0; d0 < 4; ++d0) { const int xo = ((2 * d0 + hi) ^ (r32 & 7)) * 16; \
                kf[2 * d0] = *(const LAS bf16x8*)(kt + koff + xo); kf[2 * d0 + 1] = *(const LAS bf16x8*)(kt + koff + 4096 + xo); } \
            asm volatile("" : "+v"(kf[0]), "+v"(kf[1]), "+v"(kf[2]), "+v"(kf[3]), "+v"(kf[4]), "+v"(kf[5]), "+v"(kf[6]), "+v"(kf[7]));     \
            f32x16 p0 = negm, p1 = negm; \
            _Pragma("unroll") for (int d0 = 0; d0 < 4; ++d0) { p0 = __builtin_amdgcn_mfma_f32_32x32x16_bf16(kf[2 * d0], qr[d0], p0, 0, 0, 0); p1 = __builtin_amdgcn_mfma_f32_32x32x16_bf16(kf[2 * d0 + 1], qr[d0], p1, 0, 0, 0); } \
            const unsigned m0 = mw0 >> (4 * hi), m1 = mw1 >> (4 * hi); \
            _Pragma("unroll") for (int r = 0; r < 16; ++r) { const int bit = (r & 3) + 8 * (r >> 2); \
                const unsigned e0 = (unsigned)__builtin_amdgcn_sbfe((int)m0, bit, 1), e1 = (unsigned)__builtin_amdgcn_sbfe((int)m1, bit, 1); \
                p0[r] = __uint_as_float((__float_as_uint(p0[r]) & e0) | (0xff800000u & ~e0)); p1[r] = __uint_as_float((__float_as_uint(p1[r]) & e1) | (0xff800000u & ~e1)); } \
            float rm = -INFINITY; \
            _Pragma("unroll") for (int r = 0; r < 16; r += 2) rm = fmaxf(rm, fmaxf(fmaxf(p0[r], p0[r + 1]), fmaxf(p1[r], p1[r + 1]))); \
            { const auto rr = __builtin_amdgcn_permlane32_swap(__float_as_uint(rm), __float_as_uint(rm), false, false); rm = fmaxf(__uint_as_float(rr[0]), __uint_as_float(rr[1])); } \
            const bool shift = rm > THR || (rm < -THR && rm > -INFINITY && !seen);     \
            seen = seen || rm > -INFINITY; \
            if (__any(shift)) { \
                const float dl = shift ? rm : 0.f, f = dl > 0.f ? __builtin_amdgcn_exp2f(-dl) : 1.f; \
                mref += dl; lsum *= f; \
                _Pragma("unroll") for (int r = 0; r < 16; ++r) { p0[r] -= dl; p1[r] -= dl; o0[r] *= f; o1[r] *= f; negm[r] = -mref; } \
            } \
            float ps = 0.f; \
            _Pragma("unroll") for (int r = 0; r < 16; ++r) { p0[r] = __builtin_amdgcn_exp2f(p0[r]); p1[r] = __builtin_amdgcn_exp2f(p1[r]); ps += p0[r] + p1[r]; } \
            lsum += ps; \
            bf16x8 pk[4]; \
            pk[0] = pk8(p0[0], p0[1], p0[2], p0[3], p0[4], p0[5], p0[6], p0[7]); pk[1] = pk8(p0[8], p0[9], p0[10], p0[11], p0[12], p0[13], p0[14], p0[15]); \
            pk[2] = pk8(p1[0], p1[1], p1[2], p1[3], p1[4], p1[5], p1[6], p1[7]); pk[3] = pk8(p1[8], p1[9], p1[10], p1[11], p1[12], p1[13], p1[14], p1[15]); \
            pv_tile(o0, o1, vt, lane, pk); \
        } \
        mw0 = nw0; mw1 = nw1; \
        if ((c) + 1 < ntile) { LAS unsigned char* nb = lds + (NBUF) * DSA_STAGE; *(LAS u32x4*)(nb + kdst) = KW; *(LAS u32x4*)(nb + 8192 + vdst) = VW; } \
        asm volatile("s_waitcnt lgkmcnt(0)" ::: "memory"); __builtin_amdgcn_s_barrier(); asm volatile("" ::: "memory"); } while (0)
#pragma unroll 1
    for (int c = 0; c < ntile; c += 2) { DSA_TILE(c, 0, 1, kr0, vr0, kr1, vr1); DSA_TILE(c + 1, 1, 0, kr1, vr1, kr0, vr0); }
#undef DSA_TILE
    { const auto rr = __builtin_amdgcn_permlane32_swap(__float_as_uint(lsum), __float_as_uint(lsum), false, false); lsum = __uint_as_float(rr[0]) + __uint_as_float(rr[1]); }
    store_ot(O + (rowb + t) * 512 + h * 64, o0, o1, hi, 1.f / lsum);
}
DEV void dsa_phase(LAS unsigned char* lds, unsigned char* ws, int vcu, int G, int tid, int wid, int lane, bf16_t* Oout) {
    constexpr int NPAIR = NB * 8 * 16;
    for (int pr = vcu; pr < NPAIR; pr += G) {
        const int bh = pr >> 4, s = pr & 15, b = bh >> 3, h = bh & 7;
#pragma unroll 1
        for (int k = 0; k < 2; ++k) {
            const int qblk = k == 0 ? s : 31 - s;
            dsa_unit(lds, (const bf16_t*)(ws + WS_QC), (const bf16_t*)(ws + WS_KC), (const bf16_t*)(ws + WS_VC), (const unsigned*)(ws + WS_BM), Oout, b, h, qblk, tid, wid, lane);
        }
    }
}
constexpr int MK_THREADS = 512;
constexpr int RING_BYTES = 131072, MISC_OFF = RING_BYTES + 320, MK_LDS_BYTES = 147456;
constexpr size_t WS_CTL = 0, CTL_ZERO_BYTES = 65536 + 7 * 131072; constexpr int CW_BAR = 4096;
constexpr int PH_PREP0 = 0, PH_KV = 1, PH_GH = 2, PH_L0 = 3, PH_PER_LAYER = 14, NPH = PH_L0 + 2 * PH_PER_LAYER;
enum { Q_INPROJ = 0, Q_SBIDX, Q_DSA, Q_GATES, Q_MERGE, Q_MIX, Q_NORMXA, Q_XALOG, Q_XAOUT, Q_NORMFFN, Q_UP, Q_FFNMID, Q_DOWN, Q_NEXT };

#ifndef QBUILD
#define QBUILD 0xffffu
#endif
#define QON(x) ((QBUILD >> (x)) & 1u)
struct Args { const float* in[20]; float* out; unsigned char* ws; int ph_lo, ph_hi; };

__global__ void __launch_bounds__(MK_THREADS, 2) mk_fwd(Args args) {
    __shared__ __attribute__((aligned(16))) unsigned char lds_raw[MK_LDS_BYTES];
    LAS unsigned char* lds = (LAS unsigned char*)lds_raw;
    volatile LAS unsigned* MISC = (volatile LAS unsigned*)(lds + MISC_OFF);
    const int G = gridDim.x, bx = blockIdx.x;
    unsigned char* ws0 = args.ws;
    for (int u = threadIdx.x; u < (MK_LDS_BYTES - RING_BYTES) / 4; u += MK_THREADS) ((LAS unsigned*)(lds + RING_BYTES))[u] = 0u;
    __syncthreads();
    const int lo = args.ph_lo, hi = args.ph_hi;
    XcdBarrier bar; bar.bar = (unsigned*)(ws0 + WS_CTL) + CW_BAR; bar.x = 0; bar.st = nullptr;
    if (hi - lo > 1) bar = xcd_barrier_post((unsigned*)(ws0 + WS_CTL) + CW_BAR, MISC + 8);
#define BPW(off) ((bf16_t*)(ws + (off)))
    const int vcu = (G % 8 == 0) ? (bx % 8) * (G / 8) + bx / 8 : bx;
    for (int p = lo; p < hi; ++p) {
#ifdef PROBE_REP
        const int reps = (p >= PH_L0 && ((PROBE_REP >> ((p - PH_L0) % PH_PER_LAYER)) & 1)) ? 2 : 1;
#else
        const int reps = 1;
#endif
#ifdef PROBE_REP
#pragma unroll 1
        for (int rep = 0; rep < reps; ++rep) {
        const bool dry = rep + 1 < reps;
#else
        { constexpr bool dry = false;
#endif
        int oz = 0; asm volatile("" : "+s"(oz));
        int tid = threadIdx.x; asm volatile("" : "+v"(tid));
        const int wave = __builtin_amdgcn_readfirstlane(tid >> 6), lane = tid & 63;
        WaveId W; W.gw = vcu * 8 + wave; W.ngw = G * 8; W.wave = wave; W.lane = lane;
        unsigned char* ws = args.ws + oz; float* X = args.out + oz;
#define INP(k) (args.in[(k) + oz])
        if (p == PH_PREP0) {
            prep0_phase(W, (LAS float*)(lds + wave * 16384), ws, args.in + oz, (bf16_t*)X);
        } else if (p == PH_KV && QON(14)) {
            pg8::Order S; S.init(2, 8, 2, G, bx);
            pg8::PtrStd P{(const char*)(ws + WS_MEMN), (const char*)(ws + WS_WKVT), 1 * MiB, 4 * MiB, 0, (size_t)256 * D * 2, (size_t)256 * D * 2};
            pg8::EpiPrep E{ws, 0};
            pg8::gemm_phase<pg8::EpiPrep, pg8::PtrStd, true, true>(lds, D, D, D, S, P, E);
        } else if (p == PH_GH && QON(15)) {
            { pg8::Order S; S.init(1, 4, 16, G, bx); pg8::PtrG P{(const char*)(ws + WS_KVM), (const char*)(ws + WS_WQ)}; pg8::EpiPrep E{ws, 1};
              pg8::gemm_phase<pg8::EpiPrep, pg8::PtrG, true, true>(lds, 2 * D, D, 256, S, P, E); }
            { pg8::Order S; S.init(4, 1, 16, G, (bx + 64) % G); pg8::PtrH P{(const char*)(ws + WS_KVM), (const char*)(ws + WS_WOT)}; pg8::EpiPrep E{ws, 2};
              pg8::gemm_phase<pg8::EpiPrep, pg8::PtrH, true, true>(lds, D, 2 * D, 256, S, P, E); }
        } else if (p >= PH_L0) {
            const int l = (p - PH_L0) / PH_PER_LAYER, q = (p - PH_L0) % PH_PER_LAYER;
            const float* Xin = l == 0 ? INP(0) : X;
            pg8::u64* SSb = (pg8::u64*)(ws + WS_SS);
#define SSA(i) (SSb + (size_t)(i) * T)
            if (q == Q_SBIDX) {
#ifndef NO_SB
                sb_phase(W, lds, ws, dry);
#endif
                __syncthreads();
#ifndef NO_IDX
#ifdef PROBE_SB_ONLY
                if (!dry)
#endif
                idx_phase(lds, ws, vcu, G, wave, lane);
#endif
                conv_sc_phase(vcu * MK_THREADS + tid, G * MK_THREADS, BPW(WS_SCB), BPW(WS_CX), INP(4) + l * 3 * 512, dry);
            } else if (q == Q_DSA) {
#ifndef NO_DSA
                dsa_phase(lds, ws, vcu, G, tid, wave, lane, dry ? BPW(WS_KA) : BPW(WS_QC));
#endif
            } else if (q == Q_FFNMID) {
                ffn_mid_phase(vcu * MK_THREADS + tid, G * MK_THREADS, BPW(WS_FA), BPW(WS_FU), INP(16) + l * 3 * DFF, INP(17) + l * DFF, dry);
            } else if (q == Q_NEXT) {
                if (l + 1 < DEPTH) { int base = 0; convert_layer_weights(W, (LAS float*)(lds + wave * 16384), base, ws, args.in + oz, l + 1); }
                else if (!dry) final_norm(W, BPW(WS_XN), X, INP(19), SSA(6));
            } else if (q == Q_INPROJ && QON(Q_INPROJ)) {
                pg8::Order S; S.init(T / 256, NIN / 256, 1, G, bx);
                pg8::PtrStd P{(const char*)X, (const char*)(ws + WS_WIN), 0, 0, 0, (size_t)256 * D * 2, (size_t)256 * D * 2};
                pg8::EpiInProj E{ws, SSA(3 * l)};
                pg8::gemm_phase<pg8::EpiInProj, pg8::PtrStd, true, true>(lds, D, D, D, S, P, E);
            } else if (q == Q_GATES && QON(Q_GATES)) {
                pg8::Order S; S.init(T / 256, 12, 1, G, bx);
                pg8::PtrStd P{(const char*)X, (const char*)(ws + WS_WG), 0, 0, 0, (size_t)256 * D * 2, (size_t)256 * D * 2};
                pg8::EpiGates E{BPW(WS_GATES), SSA(3 * l)};
                pg8::gemm_phase<pg8::EpiGates, pg8::PtrStd, true, true>(lds, D, D, D, S, P, E);
            } else if (q == Q_MERGE && QON(Q_MERGE)) {
                pg8::Order S; S.init(T / 256, 4, 3, G, bx);
                pg8::PtrStd P{(const char*)(ws + WS_QA), (const char*)(ws + WS_WBR), 16 * MiB, (size_t)D * 512 * 2, 0, (size_t)256 * 512 * 2, (size_t)256 * 512 * 2};
                pg8::EpiMerge E{BPW(WS_XN), BPW(WS_GATES)};
                pg8::gemm_phase<pg8::EpiMerge, pg8::PtrStd, true, true>(lds, 512, 512, 512, S, P, E);
            } else if (q == Q_MIX && QON(Q_MIX)) {
                pg8::Order S; S.init(T / 256, 4, 1, G, bx);
                pg8::PtrStd P{(const char*)(ws + WS_XN), (const char*)(ws + WS_WMIX), 0, 0, 0, (size_t)256 * D * 2, (size_t)256 * D * 2};
                if (l == 0) { pg8::EpiResid<true> E{(const void*)INP(0), dry ? BPW(WS_FU) : BPW(WS_XBXA), dry ? SSA(0) : SSA(1)};
                    pg8::gemm_phase<pg8::EpiResid<true>, pg8::PtrStd, true, true>(lds, D, D, D, S, P, E); }
                else { pg8::EpiResid<false> E{(const void*)X, dry ? BPW(WS_FU) : BPW(WS_XBXA), dry ? SSA(0) : SSA(4)};
                    pg8::gemm_phase<pg8::EpiResid<false>, pg8::PtrStd, true, true>(lds, D, D, D, S, P, E); }

            } else if (q == Q_XALOG && QON(Q_XALOG)) {
                pg8::Order S; S.init(T / 256, 4, 1, G, bx);
                pg8::PtrStd P{(const char*)(ws + WS_XBXA), (const char*)(ws + WS_GT + (size_t)l * 4 * MiB), 0, 0, 2 * MiB, (size_t)256 * D * 2, (size_t)256 * D * 2};
                pg8::EpiSoftmax E{BPW(WS_PXA), SSA(1 + 3 * l)};
                pg8::gemm_phase<pg8::EpiSoftmax, pg8::PtrStd, false, true>(lds, D, D, D, S, P, E);
            } else if (q == Q_XAOUT && QON(Q_XAOUT)) {
                pg8::Order S; S.init(T / 256, 4, 1, G, bx);
                pg8::PtrStd P{(const char*)(ws + WS_PXA), (const char*)(ws + WS_HT + (size_t)l * 4 * MiB), 0, 0, 2 * MiB, (size_t)256 * D * 2, (size_t)256 * D * 2};
                pg8::EpiResid<false> E{(const void*)BPW(WS_XBXA), dry ? BPW(WS_FU) : BPW(WS_XN), dry ? SSA(0) : SSA(2 + 3 * l)};
                pg8::gemm_phase<pg8::EpiResid<false>, pg8::PtrStd, true, true>(lds, D, D, D, S, P, E);
            } else if (q == Q_UP && QON(Q_UP)) {
                pg8::Order S; S.init(T / 256, 22, 1, G, bx);
                pg8::PtrStd P{(const char*)(ws + WS_XN), (const char*)(ws + WS_WUP), 0, 0, 0, (size_t)256 * D * 2, (size_t)256 * D * 2};
                pg8::EpiUp E{BPW(WS_FA), BPW(WS_FU), SSA(2 + 3 * l)};
                pg8::gemm_phase<pg8::EpiUp, pg8::PtrStd, true, true>(lds, D, D, D, S, P, E);
            } else if (q == Q_DOWN && QON(Q_DOWN)) {
                pg8::Order S; S.init(T / 256, 4, 1, G, bx);
                pg8::PtrStd P{(const char*)(ws + WS_FU), (const char*)(ws + WS_WDOWN), 0, 0, 0, (size_t)256 * DFF * 2, (size_t)256 * DFF * 2};
                pg8::EpiResid<false> E{(const void*)BPW(WS_XN), dry ? BPW(WS_QA) : (l + 1 < DEPTH ? (bf16_t*)X : BPW(WS_XN)), dry ? SSA(0) : SSA(3 + 3 * l)};
                pg8::gemm_phase<pg8::EpiResid<false>, pg8::PtrStd, true, true>(lds, DFF, DFF, DFF, S, P, E);
            }
        }
        }
        if (p + 1 < hi && !(p >= PH_L0 && ((p - PH_L0) % PH_PER_LAYER == Q_NORMXA || (p - PH_L0) % PH_PER_LAYER == Q_NORMFFN))) xcd_barrier(bar);
    }
}

extern "C" void kernel_launch(void* const* d_in, const int* in_sizes, int n_in, void* d_out, int out_size, void* d_ws, size_t ws_size, hipStream_t st) {
    if (n_in != 20 || ws_size < WS_NEED || out_size != T * D) { fprintf(stderr, "kernel_launch: unexpected sizes n_in %d ws %zu out %d\n", n_in, ws_size, out_size); return; }
    static int grid = 0;
    if (grid == 0) {
        int dev = 0, cus = 0, per_cu = 0;
        (void)hipGetDevice(&dev); (void)hipDeviceGetAttribute(&cus, hipDeviceAttributeMultiprocessorCount, dev);
        if (hipOccupancyMaxActiveBlocksPerMultiprocessor(&per_cu, (const void*)mk_fwd, MK_THREADS, 0) != hipSuccess || per_cu < 1) { fprintf(stderr, "kernel_launch: occupancy query says %d blocks/CU\n", per_cu); grid = -1; return; }
        (void)hipGetLastError();
        if (cus != 256) { fprintf(stderr, "kernel_launch: built for a 256-CU device, found %d\n", cus); grid = -1; return; }
        grid = cus;
    }
    if (grid < 0) return;
    (void)hipMemsetAsync((char*)d_ws + WS_CTL, 0, CTL_ZERO_BYTES, st);
    Args a{};
    for (int i = 0; i < 20; ++i) a.in[i] = (const float*)d_in[i];
    a.out = (float*)d_out; a.ws = (unsigned char*)d_ws; a.ph_lo = 0; a.ph_hi = NPH;
    hipLaunchKernelGGL(mk_fwd, dim3(grid), dim3(MK_THREADS), 0, st, a);
}
```

```cpp
#include <hip/hip_runtime.h>
#include <stdint.h>
#include <stdio.h>

typedef unsigned short bf16_t;
typedef short bf16x8 __attribute__((ext_vector_type(8)));
typedef float f32x16 __attribute__((ext_vector_type(16)));
typedef float f32x4 __attribute__((ext_vector_type(4)));
#define DEV __device__ __forceinline__

constexpr int NB = 2, S = 8192, D = 1024, T = NB * S, DEPTH = 2;
constexpr int DIN = 8264, DFF = 2816, MEM = 256;
constexpr int NIN = 5376;
constexpr float LOG2E = 1.4426950408889634f;
constexpr float QSCALE = 0.125f * LOG2E;
constexpr float WSCALE = 0.125f * 0.35355339059327373f;
constexpr float XSCALE = 0.0625f * LOG2E;
constexpr float EPS = 1e-6f;
#ifndef MK_FUSE
#define MK_FUSE 1
#endif

constexpr size_t MiB = 1u << 20;
constexpr size_t WS_GT = 1 * MiB;
constexpr size_t WS_HT = 9 * MiB;
constexpr size_t WS_WUP = 17 * MiB, WS_WDOWN = 28 * MiB;
constexpr size_t WS_XN = 34 * MiB;
constexpr size_t WS_WMIX = 66 * MiB, WS_WBR = 68 * MiB, WS_WG = 71 * MiB, WS_WIN = 77 * MiB;
constexpr size_t WS_QA = 88 * MiB, WS_SCB = 104 * MiB, WS_QC = 120 * MiB, WS_KA = 136 * MiB, WS_VA = 152 * MiB, WS_KC = 168 * MiB, WS_VC = 184 * MiB,
                 WS_IQ = 200 * MiB, WS_CX = 216 * MiB, WS_IK = 232 * MiB, WS_IW = 234 * MiB, WS_BM = 235 * MiB;
constexpr size_t WS_GATES = 136 * MiB;
constexpr size_t WS_XTMP = 235 * MiB;
constexpr size_t WS_LOG = 88 * MiB, WS_PXA = 168 * MiB;
constexpr size_t WS_XBXA = 136 * MiB;
constexpr size_t WS_SS = 65536;
constexpr size_t WS_FA = 66 * MiB, WS_FU = 154 * MiB;
constexpr size_t WS_WQ = 200 * MiB  , WS_WOT = 204 * MiB  , WS_WKVT = 208 * MiB  , WS_MEMN = 216 * MiB  , WS_KVM = 218 * MiB  ;
constexpr size_t WS_NEED = 256 * MiB;

DEV bf16_t f2bf(float f) { unsigned u = __float_as_uint(f); u += 0x7fffu + ((u >> 16) & 1u); return (bf16_t)(u >> 16); }
DEV float bf2f(bf16_t h) { return __uint_as_float(((unsigned)h) << 16); }
DEV float wave_sum(float v) {
#pragma unroll
    for (int o = 1; o < 64; o <<= 1) v += __shfl_xor(v, o);
    return v;
}
DEV float wave_max(float v) {
#pragma unroll
    for (int o = 1; o < 64; o <<= 1) v = fmaxf(v, __shfl_xor(v, o));
    return v;
}


#define LAS __attribute__((address_space(3)))
#define GAS __attribute__((address_space(1)))
typedef unsigned u32x4 __attribute__((ext_vector_type(4)));
typedef unsigned u32x2 __attribute__((ext_vector_type(2)));
typedef float f32x2 __attribute__((ext_vector_type(2)));
#define LDS_WAIT() asm volatile("s_waitcnt lgkmcnt(0)" ::: "memory")
#define VM_WAIT() asm volatile("s_waitcnt vmcnt(0)" ::: "memory")
typedef __bf16 bf16x2_t __attribute__((ext_vector_type(2)));
DEV unsigned cvt_pk_bf16(float lo, float hi) { const f32x2 v = {lo, hi}; return __builtin_bit_cast(unsigned, __builtin_convertvector(v, bf16x2_t)); }
DEV float bflo(unsigned w) { return __uint_as_float(w << 16); }
DEV float bfhi(unsigned w) { return __uint_as_float(w & 0xffff0000u); }

namespace pg8 {
constexpr int BM = 256, BK = 64, HALF = 128, HTB = HALF * BK * 2, STAGE_BYTES = 8 * HTB, NXCD = 8, WGM = 8;
__host__ __device__ __forceinline__ int lds_byte(int r, int c) { const int st = (r >> 4) * 2 + (c >> 5), rr = r & 15, cc = c & 31, ob = rr * 64 + cc * 2; return st * 1024 + (ob ^ (((ob >> 9) & 1) << 5)); }
__host__ __device__ __forceinline__ void stage_rc(int b, int& R, int& C) { const int st = b / 1024, sb = b % 1024, swz = sb ^ (((sb >> 9) & 1) << 5); R = (st >> 1) * 16 + swz / 64; C = (st & 1) * 32 + (swz % 64) / 2; }
__host__ __device__ __forceinline__ int perm32(int rho) { const int n = rho >> 4, i = rho & 15; return 8 * (i >> 2) + 4 * n + (i & 3); }

struct Unit { int pm, pn, job; };
struct Order {
    int nM, nN, nwg, ntot, G, c;
    DEV void init(int nM_, int nN_, int njob, int G_, int c_) { nM = nM_; nN = nN_; nwg = nM * nN; ntot = nwg * njob; G = G_; c = c_; }
    DEV bool next(int i, Unit& u) const {
        const int L = i * G + c; if (L >= ntot) return false;
        u.job = L / nwg; int wgid = L - u.job * nwg;
        { const int q = nwg / NXCD, r = nwg % NXCD, xcd = wgid % NXCD, off = wgid / NXCD; wgid = (xcd < r ? xcd * (q + 1) : r * (q + 1) + (xcd - r) * q) + off; }
        const int nig = WGM * nN, gid = wgid / nig, fm = gid * WGM, gsz = (nM - fm) < WGM ? (nM - fm) : WGM;
        u.pm = fm + ((wgid % nig) % gsz); u.pn = (wgid % nig) / gsz; return true;
    }
};
template <class Epi, class Ptr, bool ALIGN_EPI, bool SP2>
DEV void gemm_phase(LAS unsigned char* lds, const int lda, const int ldb, const int K, const Order& S, const Ptr& P, const Epi& E) {
    int tid_ = threadIdx.x; asm volatile("" : "+v"(tid_));
    const int tid = tid_, wid = __builtin_amdgcn_readfirstlane(tid >> 6), lane = tid & 63, wr = wid >> 2, wc = wid & 3, fr = lane & 15, fq = lane >> 4;
    const int nt = K / BK;
    unsigned voffA[2], voffB[2];
#pragma unroll
    for (int i = 0; i < 2; ++i) { int R, C; stage_rc(tid * 16 + i * 8192, R, C); const int Rb = Epi::PERM ? ((R & ~31) + perm32(R & 31)) : R;
        voffA[i] = (unsigned)(R * lda + C) * 2u; voffB[i] = (unsigned)(Rb * ldb + C) * 2u; }
    const size_t kstep = (size_t)(BK * 2);
    const size_t hstepA = (size_t)HALF * lda * 2, hstepB = (size_t)HALF * ldb * 2;
    const unsigned ldsw = (unsigned)wid * 1024u;
    const int aoff = lds_byte(wr * 64 + fr, fq * 8), boff = lds_byte(wc * 32 + fr, fq * 8);
#define PG8_SA(b, h) (((b) * 2 + (h)) * HTB)
#define PG8_SB(b, h) ((4 + (b) * 2 + (h)) * HTB)
#define PG8_STAGE(bufoff, gbase, voff) do { _Pragma("unroll") for (int _i = 0; _i < 2; ++_i) \
        __builtin_amdgcn_global_load_lds((const unsigned*)((const char*)(gbase) + (voff)[_i]), (LAS unsigned*)(lds + (bufoff) + ldsw + _i * 8192), 16, 0, 0); } while (0)
#define PG8_LDA(dst, b, h) do { _Pragma("unroll") for (int m = 0; m < 4; ++m) _Pragma("unroll") for (int k = 0; k < 2; ++k) dst[m][k] = *(const LAS bf16x8*)(lds + PG8_SA(b, h) + aoff + m * 2048 + k * 1024); } while (0)
#define PG8_LDB(dst, b, h) do { _Pragma("unroll") for (int n = 0; n < 2; ++n) _Pragma("unroll") for (int k = 0; k < 2; ++k) dst[n][k] = *(const LAS bf16x8*)(lds + PG8_SB(b, h) + boff + n * 2048 + k * 1024); } while (0)
#define PG8_MMA(ai, bj, At, Bt) do { __builtin_amdgcn_s_setprio(1); _Pragma("unroll") for (int m = 0; m < 4; ++m) _Pragma("unroll") for (int n = 0; n < 2; ++n) _Pragma("unroll") for (int k = 0; k < 2; ++k) \
        acc[ai][bj][m][n] = __builtin_amdgcn_mfma_f32_16x16x32_bf16(Bt[n][k], At[m][k], acc[ai][bj][m][n], 0, 0, 0); __builtin_amdgcn_s_setprio(0); } while (0)
#define PG8_WAIT_V(n) asm volatile("s_waitcnt vmcnt(" #n ")" ::: "memory")
#define PG8_WAIT_L(n) asm volatile("s_waitcnt lgkmcnt(" #n ")" ::: "memory")
#define PG8_BAR __builtin_amdgcn_s_barrier()
#define PG8_SCHED __builtin_amdgcn_sched_barrier(0)
    Unit cur, nxt; int ui = 0;
    if (!S.next(0, cur)) return;
    f32x4 acc[2][2][4][2];
#pragma unroll
    for (int a = 0; a < 2; ++a)
#pragma unroll
        for (int b = 0; b < 2; ++b)
#pragma unroll
            for (int m = 0; m < 4; ++m)
#pragma unroll
                for (int n = 0; n < 2; ++n) acc[a][b][m][n] = (f32x4){0.f, 0.f, 0.f, 0.f};
    bf16x8 At[4][2], B0[2][2], B1[2][2];
    const char* cA = P.a(cur); const char* cB = P.b(cur);
    typename Epi::Pre pre; E.prefetch(pre, cur, wr, fr);
    if constexpr (SP2) {
        PG8_STAGE(PG8_SB(0, 0), cB, voffB); PG8_STAGE(PG8_SB(0, 1), cB + hstepB, voffB); PG8_STAGE(PG8_SA(0, 0), cA, voffA); PG8_STAGE(PG8_SA(0, 1), cA + hstepA, voffA);
        if (wr == 1) PG8_BAR;
        PG8_WAIT_V(2); PG8_BAR;
        PG8_STAGE(PG8_SB(1, 0), cB + kstep, voffB); PG8_STAGE(PG8_SA(1, 0), cA + kstep, voffA); PG8_STAGE(PG8_SB(1, 1), cB + hstepB + kstep, voffB);
        PG8_WAIT_V(6); PG8_BAR;
    } else {
        PG8_STAGE(PG8_SB(0, 0), cB, voffB); PG8_STAGE(PG8_SA(0, 0), cA, voffA); PG8_STAGE(PG8_SB(0, 1), cB + hstepB, voffB); PG8_STAGE(PG8_SA(0, 1), cA + hstepA, voffA);
        if (wr == 1) PG8_BAR;
        PG8_WAIT_V(4); PG8_BAR;
        PG8_STAGE(PG8_SB(1, 0), cB + kstep, voffB); PG8_STAGE(PG8_SA(1, 0), cA + kstep, voffA); PG8_STAGE(PG8_SB(1, 1), cB + hstepB + kstep, voffB);
        PG8_WAIT_V(6); PG8_BAR;
    }
#pragma unroll 1
    for (;;) {
        const bool has_next = S.next(ui + 1, nxt);
        const char* nA = has_next ? P.a(nxt) : cA; const char* nB = has_next ? P.b(nxt) : cB;
#pragma unroll 1
        for (int t = 0; t < nt; t += 2) {
            const bool last = (t == nt - 2);
            const char* a1 = cA + (size_t)(t + 1) * kstep;
            const char* a2 = last ? nA : cA + (size_t)(t + 2) * kstep; const char* b2 = last ? nB : cB + (size_t)(t + 2) * kstep;
            const char* a3 = a2 + kstep; const char* b3 = b2 + kstep;
            if constexpr (SP2) {
            PG8_LDB(B0, 0, 0); PG8_LDB(B1, 0, 1); PG8_SCHED; PG8_LDA(At, 0, 0); PG8_STAGE(PG8_SA(1, 1), a1 + hstepA, voffA);
            PG8_WAIT_V(8); PG8_WAIT_L(0); PG8_BAR; PG8_MMA(0, 0, At, B0); PG8_MMA(0, 1, At, B1); PG8_BAR; PG8_SCHED;
            PG8_LDA(At, 0, 1); PG8_STAGE(PG8_SB(0, 0), b2, voffB); PG8_STAGE(PG8_SB(0, 1), b2 + hstepB, voffB); PG8_STAGE(PG8_SA(0, 0), a2, voffA);
            PG8_WAIT_V(8); PG8_WAIT_L(0); PG8_BAR; PG8_MMA(1, 0, At, B0); PG8_MMA(1, 1, At, B1); PG8_BAR; PG8_SCHED;
            PG8_LDB(B0, 1, 0); PG8_LDB(B1, 1, 1); PG8_SCHED; PG8_LDA(At, 1, 0); PG8_STAGE(PG8_SA(0, 1), a2 + hstepA, voffA);
            PG8_WAIT_V(8); PG8_WAIT_L(0); PG8_BAR; PG8_MMA(0, 0, At, B0); PG8_MMA(0, 1, At, B1); PG8_BAR; PG8_SCHED;
            PG8_LDA(At, 1, 1); PG8_STAGE(PG8_SB(1, 0), b3, voffB); PG8_STAGE(PG8_SB(1, 1), b3 + hstepB, voffB); PG8_STAGE(PG8_SA(1, 0), a3, voffA);
            PG8_WAIT_V(8); PG8_WAIT_L(0); PG8_BAR; PG8_MMA(1, 0, At, B0); PG8_MMA(1, 1, At, B1); PG8_BAR; PG8_SCHED;
            } else {
            PG8_LDB(B0, 0, 0); PG8_SCHED; PG8_LDA(At, 0, 0); PG8_STAGE(PG8_SA(1, 1), a1 + hstepA, voffA);
            PG8_WAIT_L(8); PG8_BAR; PG8_WAIT_L(0); PG8_MMA(0, 0, At, B0); PG8_BAR; PG8_SCHED;
            PG8_LDB(B1, 0, 1); PG8_STAGE(PG8_SB(0, 0), b2, voffB);
            PG8_BAR; PG8_WAIT_L(0); PG8_MMA(0, 1, At, B1); PG8_BAR;
            PG8_LDA(At, 0, 1); PG8_STAGE(PG8_SA(0, 0), a2, voffA);
            PG8_BAR; PG8_WAIT_L(0); PG8_MMA(1, 0, At, B0); PG8_BAR; PG8_SCHED;
            PG8_STAGE(PG8_SB(0, 1), b2 + hstepB, voffB);
            PG8_WAIT_V(6); PG8_BAR; PG8_MMA(1, 1, At, B1); PG8_BAR;
            PG8_LDB(B0, 1, 0); PG8_SCHED; PG8_LDA(At, 1, 0); PG8_STAGE(PG8_SA(0, 1), a2 + hstepA, voffA);
            PG8_WAIT_L(8); PG8_BAR; PG8_WAIT_L(0); PG8_MMA(0, 0, At, B0); PG8_BAR; PG8_SCHED;
            PG8_LDB(B1, 1, 1); PG8_STAGE(PG8_SB(1, 0), b3, voffB);
            PG8_BAR; PG8_WAIT_L(0); PG8_MMA(0, 1, At, B1); PG8_BAR;
            PG8_LDA(At, 1, 1); PG8_STAGE(PG8_SA(1, 0), a3, voffA);
            PG8_BAR; PG8_WAIT_L(0); PG8_MMA(1, 0, At, B0); PG8_BAR; PG8_SCHED;
            PG8_STAGE(PG8_SB(1, 1), b3 + hstepB, voffB);
            PG8_WAIT_V(6); PG8_BAR; PG8_MMA(1, 1, At, B1); PG8_BAR;
            }
        }
        if constexpr (ALIGN_EPI) { if (wr == 0) PG8_BAR; }
        if constexpr (!Epi::AFTER_DRAIN) { E(acc, cur, wr, wc, fr, fq, pre); }
        if (!has_next) break;
#pragma unroll
        for (int a = 0; a < 2; ++a)
#pragma unroll
            for (int b = 0; b < 2; ++b)
#pragma unroll
                for (int m = 0; m < 4; ++m)
#pragma unroll
                    for (int n = 0; n < 2; ++n) acc[a][b][m][n] = (f32x4){0.f, 0.f, 0.f, 0.f};
        cur = nxt; cA = nA; cB = nB; ++ui; E.prefetch(pre, cur, wr, fr);
        if constexpr (ALIGN_EPI) { if (wr == 1) PG8_BAR; }
    }
    PG8_WAIT_V(0);
    if constexpr (!ALIGN_EPI) { if (wr == 0) PG8_BAR; }
    PG8_BAR;
    if constexpr (Epi::AFTER_DRAIN) { E.fused(acc, cur, wr, wc, fr, fq, lds, wid, lane, pre); }
#undef PG8_SA
#undef PG8_SB
#undef PG8_STAGE
#undef PG8_LDA
#undef PG8_LDB
#undef PG8_MMA
#undef PG8_WAIT_V
#undef PG8_WAIT_L
#undef PG8_BAR
#undef PG8_SCHED
}
typedef f32x4 Acc[2][2][4][2];

struct PtrStd {
    const char* A; const char* B; size_t aj, bj, bb, arow, brow;
    DEV const char* a(const Unit& u) const { return A + (size_t)u.job * aj + (size_t)u.pm * arow; }
    DEV const char* b(const Unit& u) const { return B + (size_t)u.job * bj + (size_t)(u.pm >> 5) * bb + (size_t)u.pn * brow; }
};
struct PtrG {
    const char* KVM; const char* WQ;
    DEV const char* a(const Unit& u) const { return KVM + (size_t)(u.job >> 2) * MiB + (size_t)(u.job & 3) * 512; }
    DEV const char* b(const Unit& u) const { return WQ + (size_t)(u.job >> 3) * 2 * MiB + (size_t)(u.job & 3) * 512 + (size_t)u.pn * 256 * 1024 * 2; }
};
struct PtrH {
    const char* KVM; const char* WOT;
    DEV const char* a(const Unit& u) const { return WOT + (size_t)(u.job >> 3) * 2 * MiB + (size_t)(u.job & 3) * 512 + (size_t)u.pm * 256 * 1024 * 2; }
    DEV const char* b(const Unit& u) const { return KVM + (size_t)(u.job >> 2) * MiB + 2048 + (size_t)(u.job & 3) * 512; }
};

#define EPI_ROWS(u) const int row0 = (u).pm * BM + wr * 64 + fr
DEV u32x4 pack8(const f32x4 v0, const f32x4 v1) { u32x4 w; w.x = cvt_pk_bf16(v0[0], v0[1]); w.y = cvt_pk_bf16(v0[2], v0[3]); w.z = cvt_pk_bf16(v1[0], v1[1]); w.w = cvt_pk_bf16(v1[2], v1[3]); return w; }

struct PreNone {};
typedef unsigned long long u64;
constexpr float SS_SCALE = 65536.f;
struct PreRs { u64 v[2][4]; };
DEV void pre_rs(PreRs& p, const u64* ss, int row0) {
#pragma unroll
    for (int ai = 0; ai < 2; ++ai)
#pragma unroll
        for (int m = 0; m < 4; ++m) p.v[ai][m] = __builtin_nontemporal_load(ss + row0 + ai * HALF + m * 16);
}
DEV void rs_of(float (&rs)[2][4], const PreRs& p) {
#pragma unroll
    for (int ai = 0; ai < 2; ++ai)
#pragma unroll
        for (int m = 0; m < 4; ++m) rs[ai][m] = rsqrtf((float)p.v[ai][m] * (1.f / (SS_SCALE * D)) + EPS);
}
struct EpiInProj {
    typedef PreRs Pre;
    DEV void prefetch(PreRs& p, const Unit& u, int wr, int fr) const { pre_rs(p, ss, u.pm * BM + wr * 64 + fr); }
    static constexpr bool PERM = true, AFTER_DRAIN = false;
    unsigned char* ws; const u64* ss;
    DEV void operator()(const Acc& acc, const Unit& u, int wr, int wc, int fr, int fq, const PreRs& pre) const {
        EPI_ROWS(u); const int pn = u.pn, cb = wc * 32 + 8 * fq;
        float rs[2][4]; rs_of(rs, pre);
        if (pn < 16) {
            const int g = pn >> 1;
            const size_t off = g == 0 ? WS_QA : g == 1 ? WS_KA : g == 2 ? WS_VA : g == 3 ? WS_QC : g == 4 ? WS_KC : g == 5 ? WS_VC : g == 6 ? WS_IQ : WS_SCB;
            const float sc = (g == 0 || g == 3) ? QSCALE : 1.f;
            bf16_t* base = (bf16_t*)(ws + off) + (pn & 1) * 256 + cb;
#pragma unroll
            for (int ai = 0; ai < 2; ++ai)
#pragma unroll
                for (int m = 0; m < 4; ++m) { bf16_t* rowp = base + (size_t)(row0 + ai * HALF + m * 16) * 512;
#pragma unroll
                    for (int bj = 0; bj < 2; ++bj) *(u32x4*)(rowp + bj * HALF) = pack8(acc[ai][bj][m][0] * (sc * rs[ai][m]), acc[ai][bj][m][1] * (sc * rs[ai][m])); }
        } else if (pn < 20) {
            bf16_t* base = (bf16_t*)(ws + WS_CX) + (pn - 16) * 128 + cb;
#pragma unroll
            for (int ai = 0; ai < 2; ++ai)
#pragma unroll
                for (int m = 0; m < 4; ++m) { const float r2 = rs[ai][m] * rs[ai][m]; *(u32x4*)(base + (size_t)(row0 + ai * HALF + m * 16) * 512) = pack8(acc[ai][0][m][0] * acc[ai][1][m][0] * r2, acc[ai][0][m][1] * acc[ai][1][m][1] * r2); }
        } else {
            if (wc < 2) { bf16_t* base = (bf16_t*)(ws + WS_IK);
#pragma unroll
                for (int ai = 0; ai < 2; ++ai)
#pragma unroll
                    for (int m = 0; m < 4; ++m) { const int t = row0 + ai * HALF + m * 16;
                        *(u32x4*)(base + (size_t)(t >> 5) * 2048 + (((cb >> 3) * 32 + (t & 31)) * 8)) = pack8(acc[ai][0][m][0] * rs[ai][m], acc[ai][0][m][1] * rs[ai][m]); }
            } else if (wc == 2 && fq == 0) { float* base = (float*)(ws + WS_IW);
#pragma unroll
                for (int ai = 0; ai < 2; ++ai)
#pragma unroll
                    for (int m = 0; m < 4; ++m) { float* p = base + (size_t)(row0 + ai * HALF + m * 16) * 8; *(f32x4*)p = acc[ai][0][m][0] * (WSCALE * rs[ai][m]); *(f32x4*)(p + 4) = acc[ai][0][m][1] * (WSCALE * rs[ai][m]); }
            }
        }
    }
};
DEV f32x4 sigm4(const f32x4 v) { f32x4 o;
#pragma unroll
    for (int i = 0; i < 4; ++i) o[i] = __builtin_amdgcn_rcpf(1.f + __builtin_amdgcn_exp2f(-LOG2E * v[i])); return o; }
struct EpiGates {
    typedef PreRs Pre;
    DEV void prefetch(PreRs& p, const Unit& u, int wr, int fr) const { pre_rs(p, ss, u.pm * BM + wr * 64 + fr); }
    static constexpr bool PERM = true, AFTER_DRAIN = false;
    bf16_t* G; const u64* ss;
    DEV void operator()(const Acc& acc, const Unit& u, int wr, int wc, int fr, int fq, const PreRs& pre) const {
        EPI_ROWS(u); float rs[2][4]; rs_of(rs, pre); bf16_t* base = G + (size_t)(u.pn >> 2) * T * D + (u.pn & 3) * 256 + wc * 32 + 8 * fq;
#pragma unroll
        for (int ai = 0; ai < 2; ++ai)
#pragma unroll
            for (int m = 0; m < 4; ++m) { bf16_t* rowp = base + (size_t)(row0 + ai * HALF + m * 16) * D;
#pragma unroll
                for (int bj = 0; bj < 2; ++bj) *(u32x4*)(rowp + bj * HALF) = pack8(sigm4(acc[ai][bj][m][0] * rs[ai][m]), sigm4(acc[ai][bj][m][1] * rs[ai][m])); }
    }
};
struct EpiMerge {
    typedef PreNone Pre;
    DEV void prefetch(PreNone&, const Unit&, int, int) const {}
    static constexpr bool PERM = true, AFTER_DRAIN = false;
    bf16_t* M; const bf16_t* G;
    DEV void operator()(const Acc& acc, const Unit& u, int wr, int wc, int fr, int fq, const PreNone&) const {
        EPI_ROWS(u); const size_t cofs = (size_t)u.pn * 256 + wc * 32 + 8 * fq; const bf16_t* gb = G + (size_t)u.job * T * D;
#pragma unroll
        for (int ai = 0; ai < 2; ++ai)
#pragma unroll
            for (int m = 0; m < 4; ++m) { const size_t ro = (size_t)(row0 + ai * HALF + m * 16) * D + cofs;
#pragma unroll
                for (int bj = 0; bj < 2; ++bj) { const size_t o = ro + bj * HALF; const u32x4 g = *(const u32x4*)(gb + o);
                    f32x4 v0 = acc[ai][bj][m][0], v1 = acc[ai][bj][m][1];
                    v0[0] *= bflo(g.x); v0[1] *= bfhi(g.x); v0[2] *= bflo(g.y); v0[3] *= bfhi(g.y); v1[0] *= bflo(g.z); v1[1] *= bfhi(g.z); v1[2] *= bflo(g.w); v1[3] *= bfhi(g.w);
                    if (u.job > 0) { const u32x4 p = __builtin_nontemporal_load((const u32x4*)(M + o));
                        v0[0] += bflo(p.x); v0[1] += bfhi(p.x); v0[2] += bflo(p.y); v0[3] += bfhi(p.y); v1[0] += bflo(p.z); v1[1] += bfhi(p.z); v1[2] += bflo(p.w); v1[3] += bfhi(p.w); }
                    *(u32x4*)(M + o) = pack8(v0, v1); } }
    }
};
template <bool IN_F32> struct EpiResid {
    typedef PreNone Pre;
    DEV void prefetch(PreNone&, const Unit&, int, int) const {}
    static constexpr bool PERM = true, AFTER_DRAIN = false;
    const void* xin; bf16_t* xb; u64* ss;
    DEV void operator()(const Acc& acc, const Unit& u, int wr, int wc, int fr, int fq, const PreNone&) const {
        EPI_ROWS(u); const size_t cofs = (size_t)u.pn * 256 + wc * 32 + 8 * fq;
#pragma unroll
        for (int ai = 0; ai < 2; ++ai)
#pragma unroll
            for (int m = 0; m < 4; ++m) { const size_t ro = (size_t)(row0 + ai * HALF + m * 16) * D + cofs; float sq = 0.f;
#pragma unroll
                for (int bj = 0; bj < 2; ++bj) { const size_t o = ro + bj * HALF; f32x4 v0 = acc[ai][bj][m][0], v1 = acc[ai][bj][m][1];
                    if (IN_F32) { v0 = v0 + *(const f32x4*)((const float*)xin + o); v1 = v1 + *(const f32x4*)((const float*)xin + o + 4); }
                    else { const u32x4 p = *(const u32x4*)((const bf16_t*)xin + o);
                        v0[0] += bflo(p.x); v0[1] += bfhi(p.x); v0[2] += bflo(p.y); v0[3] += bfhi(p.y); v1[0] += bflo(p.z); v1[1] += bfhi(p.z); v1[2] += bflo(p.w); v1[3] += bfhi(p.w); }
                    *(u32x4*)(xb + o) = pack8(v0, v1);
                    sq += ((v0[0] * v0[0] + v0[1] * v0[1]) + (v0[2] * v0[2] + v0[3] * v0[3])) + ((v1[0] * v1[0] + v1[1] * v1[1]) + (v1[2] * v1[2] + v1[3] * v1[3])); }
                sq += __shfl_xor(sq, 16); sq += __shfl_xor(sq, 32);
                if (fq == 0) atomicAdd(ss + row0 + ai * HALF + m * 16, (u64)(sq * SS_SCALE + 0.5f)); }
    }
};
struct EpiUp {
    typedef PreRs Pre;
    DEV void prefetch(PreRs& p, const Unit& u, int wr, int fr) const { pre_rs(p, ss, u.pm * BM + wr * 64 + fr); }
    static constexpr bool PERM = true, AFTER_DRAIN = false;
    bf16_t *fa, *fu; const u64* ss;
    DEV void operator()(const Acc& acc, const Unit& u, int wr, int wc, int fr, int fq, const PreRs& pre) const {
        EPI_ROWS(u); float rs[2][4]; rs_of(rs, pre); const size_t cofs = (size_t)u.pn * 128 + wc * 32 + 8 * fq;
#pragma unroll
        for (int ai = 0; ai < 2; ++ai)
#pragma unroll
            for (int m = 0; m < 4; ++m) { const size_t o = (size_t)(row0 + ai * HALF + m * 16) * DFF + cofs;
                *(u32x4*)(fa + o) = pack8(acc[ai][0][m][0] * rs[ai][m], acc[ai][0][m][1] * rs[ai][m]); *(u32x4*)(fu + o) = pack8(acc[ai][1][m][0] * rs[ai][m], acc[ai][1][m][1] * rs[ai][m]); }
    }
};
struct EpiPrep {
    typedef PreNone Pre;
    DEV void prefetch(PreNone&, const Unit&, int, int) const {}
    static constexpr bool PERM = true, AFTER_DRAIN = false;
    unsigned char* ws; int mode;
    DEV void operator()(const Acc& acc, const Unit& u, int wr, int wc, int fr, int fq, const PreNone&) const {
        EPI_ROWS(u); bf16_t* base; int ldc; float sc = 1.f;
        if (mode == 0) { base = (bf16_t*)(ws + WS_KVM + (size_t)u.job * 2 * MiB); ldc = 2 * D; }
        else if (mode == 1) { base = (bf16_t*)(ws + WS_GT + (size_t)(u.job >> 2) * 2 * MiB) + (size_t)(u.job & 3) * 256 * D; ldc = D; sc = XSCALE; }
        else { base = (bf16_t*)(ws + WS_HT + (size_t)(u.job >> 2) * 2 * MiB) + (u.job & 3) * 256; ldc = D; }
        base += (size_t)u.pn * 256 + wc * 32 + 8 * fq;
#pragma unroll
        for (int ai = 0; ai < 2; ++ai)
#pragma unroll
            for (int m = 0; m < 4; ++m) { bf16_t* rowp = base + (size_t)(row0 + ai * HALF + m * 16) * ldc;
#pragma unroll
                for (int bj = 0; bj < 2; ++bj) *(u32x4*)(rowp + bj * HALF) = pack8(acc[ai][bj][m][0] * sc, acc[ai][bj][m][1] * sc); }
    }
};
struct EpiSoftmax {
    typedef PreRs Pre;
    DEV void prefetch(PreRs& p, const Unit& u, int wr, int fr) const { pre_rs(p, ss, u.pm * BM + wr * 64 + fr); }
    static constexpr bool PERM = true, AFTER_DRAIN = true;
    bf16_t* P; const u64* ss;
    DEV void fused(Acc& acc, const Unit& u, int wr, int wc, int fr, int fq, LAS unsigned char* lds, int wid, int lane, const PreRs& pre) const {
        LAS float* PM = (LAS float*)lds; LAS float* PS = (LAS float*)(lds + 4096);
        { const int row0_ = u.pm * BM + wr * 64 + fr; float rs[2][4]; rs_of(rs, pre);
#pragma unroll
          for (int ai = 0; ai < 2; ++ai)
#pragma unroll
              for (int m = 0; m < 4; ++m)
#pragma unroll
                  for (int bj = 0; bj < 2; ++bj)
#pragma unroll
                      for (int n = 0; n < 2; ++n) acc[ai][bj][m][n] = acc[ai][bj][m][n] * rs[ai][m]; }
#pragma unroll
        for (int ai = 0; ai < 2; ++ai)
#pragma unroll
            for (int m = 0; m < 4; ++m) { float mx = -INFINITY;
#pragma unroll
                for (int bj = 0; bj < 2; ++bj)
#pragma unroll
                    for (int n = 0; n < 2; ++n) { const f32x4 x = acc[ai][bj][m][n]; mx = fmaxf(mx, fmaxf(fmaxf(x[0], x[1]), fmaxf(x[2], x[3]))); }
                mx = fmaxf(mx, __shfl_xor(mx, 16)); mx = fmaxf(mx, __shfl_xor(mx, 32));
                if (fq == 0) PM[(ai * HALF + wr * 64 + m * 16 + fr) * 4 + wc] = mx; }
        LDS_WAIT(); __builtin_amdgcn_s_barrier(); asm volatile("" ::: "memory");
#pragma unroll
        for (int ai = 0; ai < 2; ++ai)
#pragma unroll
            for (int m = 0; m < 4; ++m) { const int r = ai * HALF + wr * 64 + m * 16 + fr; const f32x4 q = *(const LAS f32x4*)(PM + r * 4);
                const float mx = fmaxf(fmaxf(q[0], q[1]), fmaxf(q[2], q[3])); float s = 0.f;
#pragma unroll
                for (int bj = 0; bj < 2; ++bj)
#pragma unroll
                    for (int n = 0; n < 2; ++n) { f32x4 x = acc[ai][bj][m][n];
#pragma unroll
                        for (int i = 0; i < 4; ++i) { x[i] = __builtin_amdgcn_exp2f(x[i] - mx); s += x[i]; } acc[ai][bj][m][n] = x; }
                s += __shfl_xor(s, 16); s += __shfl_xor(s, 32);
                if (fq == 0) PS[r * 4 + wc] = s; }
        LDS_WAIT(); __builtin_amdgcn_s_barrier(); asm volatile("" ::: "memory");
        EPI_ROWS(u); bf16_t* base = P + (size_t)u.pn * 256 + wc * 32 + 8 * fq;
#pragma unroll
        for (int ai = 0; ai < 2; ++ai)
#pragma unroll
            for (int m = 0; m < 4; ++m) { const int r = ai * HALF + wr * 64 + m * 16 + fr; const f32x4 q = *(const LAS f32x4*)(PS + r * 4);
                const float inv = 1.f / ((q[0] + q[1]) + (q[2] + q[3])); bf16_t* rowp = base + (size_t)(row0 + ai * HALF + m * 16) * D;
#pragma unroll
                for (int bj = 0; bj < 2; ++bj) *(u32x4*)(rowp + bj * HALF) = pack8(acc[ai][bj][m][0] * inv, acc[ai][bj][m][1] * inv); }
        LDS_WAIT(); __builtin_amdgcn_s_barrier();
    }
};
}

typedef GAS unsigned gu32;
#define XB_TMO      128
#define XB_XCNT(j)  (256  + 64 * (j))
#define XB_XSUB(j)  (1280 + 64 * (j))
#define XB_XGEN(j)  (2304 + 64 * (j))
#define XB_TOP      3328
#define XB_TOPGEN   3392
#define XCD_BAR_WORDS 3456
#define XB_SPIN_CAP (1u << 22)
DEV unsigned xb_ld(unsigned* p) { return __hip_atomic_load(p, __ATOMIC_RELAXED, __HIP_MEMORY_SCOPE_AGENT); }
DEV unsigned xb_add(unsigned* p, unsigned v) { return __hip_atomic_fetch_add(p, v, __ATOMIC_RELAXED, __HIP_MEMORY_SCOPE_AGENT); }
DEV unsigned xb_xcc_id() { return (unsigned)__builtin_amdgcn_s_getreg((3 << 11) | 20) & 0xFu; }
#define XB_SPIN(cond, bar) do { unsigned _sp = 0; while (cond) { __builtin_amdgcn_s_sleep(1); \
    if ((++_sp & 255u) == 0u) { if (xb_ld(&(bar)[XB_TMO])) break; if (_sp > XB_SPIN_CAP) { atomicAdd(&(bar)[XB_TMO], 1u); break; } } } } while (0)
struct XcdBarrier { unsigned* bar; unsigned x; volatile LAS unsigned* st; };
DEV XcdBarrier xcd_barrier_post(unsigned* bar, volatile LAS unsigned* st) {
    XcdBarrier b; b.bar = bar; b.x = xb_xcc_id(); b.st = st;
    if (threadIdx.x == 0) (void)xb_add(&bar[XB_XCNT(b.x)], 1u);
    return b;
}
DEV void xcd_barrier_complete(unsigned* bar, unsigned x, unsigned& nloc, unsigned& nx) {
    const unsigned G = gridDim.x * gridDim.y * gridDim.z;
    unsigned sum, cnt, mine, sp = 0u;
    for (;;) {
        sum = 0u; cnt = 0u; mine = 0u;
#pragma unroll
        for (unsigned j = 0; j < 16; ++j) { const unsigned c = xb_ld(&bar[XB_XCNT(j)]); sum += c; cnt += (c > 0u) ? 1u : 0u; mine = (j == x) ? c : mine; }
        if (sum == G) break;
        __builtin_amdgcn_s_sleep(1);
        if ((++sp & 255u) == 0u) { if (xb_ld(&bar[XB_TMO])) break; if (sp > XB_SPIN_CAP) { atomicAdd(&bar[XB_TMO], 1u); break; } }
    }
    nloc = mine > 0u ? mine : 1u; nx = cnt > 0u ? cnt : 1u;
}
DEV void xcd_barrier(const XcdBarrier& b) {
    asm volatile("s_waitcnt vmcnt(0)" ::: "memory");
    __syncthreads();
    if (threadIdx.x == 0) {
        unsigned* bar = b.bar;
        __builtin_amdgcn_s_waitcnt(0);
        unsigned nloc = b.st[0], nx = b.st[1];
        if (nloc == 0u) { xcd_barrier_complete(bar, b.x, nloc, nx); b.st[0] = nloc; b.st[1] = nx; }
        const unsigned old = xb_add(&bar[XB_XSUB(b.x)], 1u);
        const unsigned gen = old / nloc;
        if (old + 1u == (gen + 1u) * nloc) {
            __builtin_amdgcn_fence(__ATOMIC_RELEASE, "agent");
            asm volatile("s_waitcnt vmcnt(0)" ::: "memory");
            const unsigned og = xb_add(&bar[XB_TOP], 1u);
            const unsigned tg = og / nx;
            if (og + 1u == (tg + 1u) * nx) xb_add(&bar[XB_TOPGEN], 1u);
            else XB_SPIN(xb_ld(&bar[XB_TOPGEN]) == tg, bar);
            __builtin_amdgcn_fence(__ATOMIC_ACQUIRE, "agent");
            xb_add(&bar[XB_XGEN(b.x)], 1u);
            asm volatile("s_waitcnt vmcnt(0)" ::: "memory");
        } else {
            XB_SPIN(xb_ld(&bar[XB_XGEN(b.x)]) == gen, bar);
            __builtin_amdgcn_fence(__ATOMIC_ACQUIRE, "agent");
            asm volatile("s_waitcnt vmcnt(0)" ::: "memory");
        }
    }
    __syncthreads();
}


struct WaveId { int gw, ngw, wave, lane; };
DEV unsigned f2bf_u(float f) { return (unsigned)f2bf(f); }
DEV unsigned pk2(float lo, float hi) { return cvt_pk_bf16(lo, hi); }

DEV void norm_rows(const WaveId& W, const float* x, const float* g, bf16_t* outb, float* outf, int rows) {
    for (int row = W.gw; row < rows; row += W.ngw) {
        const f32x4* xr = (const f32x4*)(x + (size_t)row * D) + W.lane;
        f32x4 v[4]; float s = 0.f;
#pragma unroll
        for (int j = 0; j < 4; ++j) { v[j] = xr[64 * j]; s += (v[j].x * v[j].x + v[j].y * v[j].y) + (v[j].z * v[j].z + v[j].w * v[j].w); }
        const float r = rsqrtf(wave_sum(s) * (1.f / D) + EPS);
#pragma unroll
        for (int j = 0; j < 4; ++j) {
            const f32x4 gg = ((const f32x4*)g)[W.lane + 64 * j];
            const f32x4 o = {v[j].x * r * gg.x, v[j].y * r * gg.y, v[j].z * r * gg.z, v[j].w * r * gg.w};
            if (outb) { u32x2 w; w.x = pk2(o.x, o.y); w.y = pk2(o.z, o.w); ((u32x2*)(outb + (size_t)row * D))[W.lane + 64 * j] = w; }
            else ((f32x4*)(outf + (size_t)row * D))[W.lane + 64 * j] = o;
        }
    }
}
DEV void cvt_piece(const WaveId& W, LAS float* scr, int& base, const float* Wsrc, int ldw, int K, int col0, int ncols, bf16_t* dst, int ldo, int row0, const float* gain = nullptr) {
    const int nblk = ncols / 32, nitems = (K / 64) * nblk;
    int first = (W.gw - base) % W.ngw; if (first < 0) first += W.ngw;
    base = (base + nitems) % W.ngw;
    for (int item = first; item < nitems; item += W.ngw) {
        const int kb = item / nblk, nb = item - kb * nblk, k0 = 64 * kb, n0 = 32 * nb;
#pragma unroll 8
        for (int i = 0; i < 32; ++i) { const int kk = 2 * i + (W.lane >> 5); scr[kk * 33 + (W.lane & 31)] = Wsrc[(size_t)(k0 + kk) * ldw + col0 + n0 + (W.lane & 31)] * (gain ? gain[k0 + kk] : 1.f); }
        LDS_WAIT(); asm volatile("" ::: "memory");
        const int c = W.lane & 7;
#pragma unroll
        for (int j = 0; j < 4; ++j) { const int n = (W.lane >> 3) + 8 * j; const LAS float* s = scr + (8 * c) * 33 + n;
            u32x4 o; o.x = pk2(s[0 * 33], s[1 * 33]); o.y = pk2(s[2 * 33], s[3 * 33]); o.z = pk2(s[4 * 33], s[5 * 33]); o.w = pk2(s[6 * 33], s[7 * 33]);
            *(u32x4*)(dst + (size_t)(row0 + n0 + n) * ldo + k0 + 8 * c) = o; }
        LDS_WAIT(); asm volatile("" ::: "memory");
    }
}
DEV void convert_layer_weights(const WaveId& W, LAS float* scr, int& base, unsigned char* ws, const float* const* in, int l) {
    const float* wi = in[3] + (size_t)l * D * DIN;
    bf16_t* WIN = (bf16_t*)(ws + WS_WIN); const float* gm = in[2] + l * D; const float* gf = in[14] + l * D;
    cvt_piece(W, scr, base, wi, DIN, D, 0, 1536, WIN, D, 0, gm);
    cvt_piece(W, scr, base, wi, DIN, D, 3072, 1536, WIN, D, 1536, gm);
    cvt_piece(W, scr, base, wi, DIN, D, 4608, 512, WIN, D, 3072, gm);
    cvt_piece(W, scr, base, wi, DIN, D, 1536, 512, WIN, D, 3584, gm);
#pragma unroll 1
    for (int j = 0; j < 4; ++j) { cvt_piece(W, scr, base, wi, DIN, D, 2048 + 128 * j, 128, WIN, D, 4096 + 256 * j, gm); cvt_piece(W, scr, base, wi, DIN, D, 2560 + 128 * j, 128, WIN, D, 4096 + 256 * j + 128, gm); }
    cvt_piece(W, scr, base, wi, DIN, D, 5120, 96, WIN, D, 5120, gm);
    cvt_piece(W, scr, base, wi, DIN, D, 5192, 3072, (bf16_t*)(ws + WS_WG), D, 0, gm);
#pragma unroll 1
    for (int i = 0; i < 3; ++i) cvt_piece(W, scr, base, in[5 + i] + (size_t)l * 512 * D, D, 512, 0, D, (bf16_t*)(ws + WS_WBR) + (size_t)i * D * 512, 512, 0);
    cvt_piece(W, scr, base, in[8] + (size_t)l * D * D, D, D, 0, D, (bf16_t*)(ws + WS_WMIX), D, 0);
    const float* wf = in[15] + (size_t)l * D * 2 * DFF;
#pragma unroll 1
    for (int j = 0; j < 22; ++j) { cvt_piece(W, scr, base, wf, 2 * DFF, D, 128 * j, 128, (bf16_t*)(ws + WS_WUP), D, 256 * j, gf); cvt_piece(W, scr, base, wf, 2 * DFF, D, DFF + 128 * j, 128, (bf16_t*)(ws + WS_WUP), D, 256 * j + 128, gf); }
    cvt_piece(W, scr, base, in[18] + (size_t)l * DFF * D, D, DFF, 0, D, (bf16_t*)(ws + WS_WDOWN), DFF, 0);
}
DEV void prep0_phase(const WaveId& W, LAS float* scr, unsigned char* ws, const float* const* in, bf16_t* XB) {
    int base = 0;
#pragma unroll 1
    for (int l = 0; l < DEPTH; ++l) {
        const float* wq = in[11] + (size_t)l * D * D; bf16_t* WQ = (bf16_t*)(ws + WS_WQ + (size_t)l * 2 * MiB); const float* gx = in[9] + l * D;
        for (size_t i = (size_t)(W.gw * 64 + W.lane) * 4; i < (size_t)D * D; i += (size_t)W.ngw * 256) { const float g = gx[i >> 10]; const f32x4 v = *(const f32x4*)(wq + i); u32x2 o; o.x = pk2(v.x * g, v.y * g); o.y = pk2(v.z * g, v.w * g); *(u32x2*)(WQ + i) = o; }
        cvt_piece(W, scr, base, in[13] + (size_t)l * D * D, D, D, 0, D, (bf16_t*)(ws + WS_WOT + (size_t)l * 2 * MiB), D, 0);
        cvt_piece(W, scr, base, in[12] + (size_t)l * D * 2 * D, 2 * D, D, 0, 2 * D, (bf16_t*)(ws + WS_WKVT + (size_t)l * 4 * MiB), D, 0);
        norm_rows(W, in[1], in[10] + l * D, (bf16_t*)(ws + WS_MEMN + (size_t)l * MiB), nullptr, NB * MEM);
    }
    convert_layer_weights(W, scr, base, ws, in, 0);
    pg8::u64* ss0 = (pg8::u64*)(ws + WS_SS);
    for (int row = W.gw; row < T; row += W.ngw) {
        const f32x4* xr = (const f32x4*)(in[0] + (size_t)row * D) + W.lane; float s = 0.f;
#pragma unroll
        for (int j = 0; j < 4; ++j) { const f32x4 v = xr[64 * j]; s += (v.x * v.x + v.y * v.y) + (v.z * v.z + v.w * v.w);
            u32x2 w; w.x = pk2(v.x, v.y); w.y = pk2(v.z, v.w); ((u32x2*)(XB + (size_t)row * D))[W.lane + 64 * j] = w; }
        s = wave_sum(s); if (W.lane == 0) ss0[row] = (pg8::u64)(s * pg8::SS_SCALE + 0.5f);
    }
}
DEV void final_norm(const WaveId& W, const bf16_t* x, float* out, const float* g, const pg8::u64* ss) {
    for (int row = W.gw; row < T; row += W.ngw) {
        const float r = rsqrtf((float)ss[row] * (1.f / (pg8::SS_SCALE * D)) + EPS); const u32x2* xr = (const u32x2*)(x + (size_t)row * D) + W.lane; f32x4* orow = (f32x4*)(out + (size_t)row * D) + W.lane;
#pragma unroll
        for (int j = 0; j < 4; ++j) { const f32x4 gg = ((const f32x4*)g)[W.lane + 64 * j]; const u32x2 v = xr[64 * j];
            const f32x4 o = {bflo(v.x) * r * gg.x, bfhi(v.x) * r * gg.y, bflo(v.y) * r * gg.z, bfhi(v.y) * r * gg.w}; orow[64 * j] = o; }
    }
}
DEV void conv_sc_phase(int gtid, int gthreads, bf16_t* scb, const bf16_t* cx, const float* w, bool dry) {
    for (int i = gtid; i < T * 64; i += gthreads) {
        const int c8 = (i & 63) * 8, t = i >> 6, tl = t & (S - 1);
        const size_t o = (size_t)t * 512 + c8;
        const u32x4 z = {0u, 0u, 0u, 0u};
        const u32x4 x2 = *(const u32x4*)(cx + o), x1 = tl >= 1 ? *(const u32x4*)(cx + o - 512) : z, x0 = tl >= 2 ? *(const u32x4*)(cx + o - 1024) : z, bb = *(const u32x4*)(scb + o);
        const f32x4 w0a = *(const f32x4*)(w + c8), w0b = *(const f32x4*)(w + c8 + 4), w1a = *(const f32x4*)(w + 512 + c8), w1b = *(const f32x4*)(w + 512 + c8 + 4), w2a = *(const f32x4*)(w + 1024 + c8), w2b = *(const f32x4*)(w + 1024 + c8 + 4);
        float r[8];
#define CONV1(k, W0, W1, W2, X0, X1, X2, BBv, F) r[k] = F(BBv) * (W0 * F(X0) + W1 * F(X1) + W2 * F(X2))
        CONV1(0, w0a.x, w1a.x, w2a.x, x0.x, x1.x, x2.x, bb.x, bflo); CONV1(1, w0a.y, w1a.y, w2a.y, x0.x, x1.x, x2.x, bb.x, bfhi);
        CONV1(2, w0a.z, w1a.z, w2a.z, x0.y, x1.y, x2.y, bb.y, bflo); CONV1(3, w0a.w, w1a.w, w2a.w, x0.y, x1.y, x2.y, bb.y, bfhi);
        CONV1(4, w0b.x, w1b.x, w2b.x, x0.z, x1.z, x2.z, bb.z, bflo); CONV1(5, w0b.y, w1b.y, w2b.y, x0.z, x1.z, x2.z, bb.z, bfhi);
        CONV1(6, w0b.z, w1b.z, w2b.z, x0.w, x1.w, x2.w, bb.w, bflo); CONV1(7, w0b.w, w1b.w, w2b.w, x0.w, x1.w, x2.w, bb.w, bfhi);
#undef CONV1
        u32x4 ov; ov.x = pk2(r[0], r[1]); ov.y = pk2(r[2], r[3]); ov.z = pk2(r[4], r[5]); ov.w = pk2(r[6], r[7]);
        if (!dry) *(u32x4*)(scb + o) = ov; else asm volatile("" :: "v"(ov));
    }
}
DEV float gelu_t(float a) { return a * __builtin_amdgcn_rcpf(1.f + __builtin_amdgcn_exp2f(-1.5957691216057308f * LOG2E * (a + 0.044715f * a * a * a))); }
DEV void ffn_mid_phase(int gtid, int gthreads, const bf16_t* fa, bf16_t* fu, const float* cw, const float* cb, bool dry) {
    constexpr int C8 = DFF / 8;
    for (int i = gtid; i < T * C8; i += gthreads) {
        const int t = i / C8, c8 = (i - t * C8) * 8, tl = t & (S - 1);
        const size_t o = (size_t)t * DFF + c8;
        const u32x4 z = {0u, 0u, 0u, 0u};
        const u32x4 x2 = *(const u32x4*)(fa + o), x1 = tl >= 1 ? *(const u32x4*)(fa + o - DFF) : z, x0 = tl >= 2 ? *(const u32x4*)(fa + o - 2 * DFF) : z, uu = *(const u32x4*)(fu + o);
        const f32x4 w0a = *(const f32x4*)(cw + c8), w0b = *(const f32x4*)(cw + c8 + 4), w1a = *(const f32x4*)(cw + DFF + c8), w1b = *(const f32x4*)(cw + DFF + c8 + 4), w2a = *(const f32x4*)(cw + 2 * DFF + c8), w2b = *(const f32x4*)(cw + 2 * DFF + c8 + 4);
        const f32x4 ba = *(const f32x4*)(cb + c8), bb = *(const f32x4*)(cb + c8 + 4);
        float r[8];
#define FM1(k, B0, W0, W1, W2, X0, X1, X2, Uv, F) r[k] = gelu_t(B0 + W0 * F(X0) + W1 * F(X1) + W2 * F(X2)) * F(Uv)
        FM1(0, ba.x, w0a.x, w1a.x, w2a.x, x0.x, x1.x, x2.x, uu.x, bflo); FM1(1, ba.y, w0a.y, w1a.y, w2a.y, x0.x, x1.x, x2.x, uu.x, bfhi);
        FM1(2, ba.z, w0a.z, w1a.z, w2a.z, x0.y, x1.y, x2.y, uu.y, bflo); FM1(3, ba.w, w0a.w, w1a.w, w2a.w, x0.y, x1.y, x2.y, uu.y, bfhi);
        FM1(4, bb.x, w0b.x, w1b.x, w2b.x, x0.z, x1.z, x2.z, uu.z, bflo); FM1(5, bb.y, w0b.y, w1b.y, w2b.y, x0.z, x1.z, x2.z, uu.z, bfhi);
        FM1(6, bb.z, w0b.z, w1b.z, w2b.z, x0.w, x1.w, x2.w, uu.w, bflo); FM1(7, bb.w, w0b.w, w1b.w, w2b.w, x0.w, x1.w, x2.w, uu.w, bfhi);
#undef FM1
        u32x4 ov; ov.x = pk2(r[0], r[1]); ov.y = pk2(r[2], r[3]); ov.z = pk2(r[4], r[5]); ov.w = pk2(r[6], r[7]);
        if (!dry) *(u32x4*)(fu + o) = ov; else asm volatile("" :: "v"(ov));
    }
}

typedef short s16x4 __attribute__((ext_vector_type(4)));
DEV s16x4 vtr(const LAS unsigned char* p) { return __builtin_bit_cast(s16x4, __builtin_amdgcn_ds_read_tr16_b64_v4i16((LAS s16x4*)p)); }
DEV bf16x8 cat8(const s16x4 a, const s16x4 b) { return (bf16x8){a[0], a[1], a[2], a[3], b[0], b[1], b[2], b[3]}; }
DEV bf16x8 pk8(float a0, float a1, float a2, float a3, float a4, float a5, float a6, float a7) {
    u32x4 w; w.x = pk2(a0, a1); w.y = pk2(a2, a3); w.z = pk2(a4, a5); w.w = pk2(a6, a7); return __builtin_bit_cast(bf16x8, w); }
constexpr int VPITCH = 192;
DEV void pv_tile(f32x16& o0, f32x16& o1, const LAS unsigned char* vt, int lane, const bf16x8 (&pk)[4]) {
    const int hi = lane >> 5;
    const LAS unsigned char* vb = vt + (4 * hi + ((lane & 15) >> 2)) * VPITCH + ((lane >> 4) & 1) * 32 + (lane & 3) * 8;
    bf16x8 va[4];
#pragma unroll
    for (int ks = 0; ks < 4; ++ks) va[ks] = cat8(vtr(vb + (16 * ks) * VPITCH), vtr(vb + (16 * ks + 8) * VPITCH));
    asm volatile("" : "+v"(va[0]), "+v"(va[1]), "+v"(va[2]), "+v"(va[3]));
#pragma unroll
    for (int ks = 0; ks < 4; ++ks) o0 = __builtin_amdgcn_mfma_f32_32x32x16_bf16(va[ks], pk[ks], o0, 0, 0, 0);
#pragma unroll
    for (int ks = 0; ks < 4; ++ks) va[ks] = cat8(vtr(vb + (16 * ks) * VPITCH + 64), vtr(vb + (16 * ks + 8) * VPITCH + 64));
    asm volatile("" : "+v"(va[0]), "+v"(va[1]), "+v"(va[2]), "+v"(va[3]));
#pragma unroll
    for (int ks = 0; ks < 4; ++ks) o1 = __builtin_amdgcn_mfma_f32_32x32x16_bf16(va[ks], pk[ks], o1, 0, 0, 0);
}
DEV void store_ot(bf16_t* orow, const f32x16& o0, const f32x16& o1, int hi, float sc) {
#pragma unroll
    for (int g4 = 0; g4 < 4; ++g4) {
        u32x2 a; a.x = pk2(o0[4 * g4] * sc, o0[4 * g4 + 1] * sc); a.y = pk2(o0[4 * g4 + 2] * sc, o0[4 * g4 + 3] * sc);
        u32x2 b; b.x = pk2(o1[4 * g4] * sc, o1[4 * g4 + 1] * sc); b.y = pk2(o1[4 * g4 + 2] * sc, o1[4 * g4 + 3] * sc);
        *(u32x2*)(orow + 8 * g4 + 4 * hi) = a; *(u32x2*)(orow + 32 + 8 * g4 + 4 * hi) = b;
    }
}

DEV void sb_item(LAS unsigned char* vl, const bf16_t* Q, const bf16_t* Kk, const bf16_t* V, bf16_t* O, int b, int h, int qb, int lane, bool dry) {
    const int r32 = lane & 31, hi = lane >> 5, t0 = 32 * qb, t = t0 + r32; const size_t rowb = (size_t)b * S;
    bf16x8 qr[4]; { const bf16_t* qp = Q + (rowb + t0 + r32) * 512 + h * 64 + 8 * hi;
#pragma unroll
        for (int d0 = 0; d0 < 4; ++d0) qr[d0] = *(const bf16x8*)(qp + 16 * d0); }
    f32x16 o0, o1;
#pragma unroll
    for (int r = 0; r < 16; ++r) { o0[r] = 0.f; o1[r] = 0.f; }
    float carry = 1.f;
    const int c_hi = (t0 + 30) >> 6;
#pragma unroll 1
    for (int c = c_hi; c >= 0; --c) {
        const bf16_t* kp = Kk + (rowb + 64 * c + r32) * 512 + h * 64 + 8 * hi;
        bf16x8 k0[4], k1[4];
#pragma unroll
        for (int d0 = 0; d0 < 4; ++d0) { k0[d0] = *(const bf16x8*)(kp + 16 * d0); k1[d0] = *(const bf16x8*)(kp + (size_t)32 * 512 + 16 * d0); }
#pragma unroll
        for (int j = 0; j < 8; ++j) { const int row = (lane >> 3) + 8 * j; *(LAS u32x4*)(vl + row * VPITCH + (lane & 7) * 16) = *(const u32x4*)(V + (rowb + 64 * c + row) * 512 + h * 64 + (lane & 7) * 8); }
        f32x16 p0, p1;
#pragma unroll
        for (int r = 0; r < 16; ++r) { p0[r] = 0.f; p1[r] = 0.f; }
#pragma unroll
        for (int d0 = 0; d0 < 4; ++d0) { p0 = __builtin_amdgcn_mfma_f32_32x32x16_bf16(k0[d0], qr[d0], p0, 0, 0, 0); p1 = __builtin_amdgcn_mfma_f32_32x32x16_bf16(k1[d0], qr[d0], p1, 0, 0, 0); }
        float u[32];
        const bool diag = (c == c_hi);
#pragma unroll
        for (int e = 0; e < 32; ++e) {
            const float z = e < 16 ? p0[e] : p1[e - 16];
            float uu = __builtin_amdgcn_rcpf(1.f + __builtin_amdgcn_exp2f(fminf(z, 126.f)));
            if (diag) { const int kv = 64 * c + 8 * ((e >> 2) & 3) + 4 * hi + (e & 3) + 32 * (e >> 4); if (kv >= t) uu = 1.f; }
            u[e] = uu;
        }
        float gl[8], gh[8];
#pragma unroll
        for (int i = 0; i < 8; ++i) { const float gp = (u[4 * i] * u[4 * i + 1]) * (u[4 * i + 2] * u[4 * i + 3]);
            const auto rr = __builtin_amdgcn_permlane32_swap(__float_as_uint(gp), __float_as_uint(gp), false, false); gl[i] = __uint_as_float(rr[0]); gh[i] = __uint_as_float(rr[1]); }
        float ag[8]; float run = carry;
#pragma unroll
        for (int i = 7; i >= 0; --i) { const float a_hi = run; run *= gh[i]; const float a_lo = run; run *= gl[i]; ag[i] = hi ? a_hi : a_lo; }
        carry = run;
        bf16x8 pk[4];
#pragma unroll
        for (int ks = 0; ks < 4; ++ks) { float w[8];
#pragma unroll
            for (int g = 0; g < 2; ++g) { const int i = 2 * ks + g;
                const float a3 = ag[i], a2 = a3 * u[4 * i + 3], a1 = a2 * u[4 * i + 2], a0 = a1 * u[4 * i + 1];
                w[4 * g] = (1.f - u[4 * i]) * a0; w[4 * g + 1] = (1.f - u[4 * i + 1]) * a1; w[4 * g + 2] = (1.f - u[4 * i + 2]) * a2; w[4 * g + 3] = (1.f - u[4 * i + 3]) * a3; }
            pk[ks] = pk8(w[0], w[1], w[2], w[3], w[4], w[5], w[6], w[7]); }
        pv_tile(o0, o1, vl, lane, pk);
        if (__all(carry < 7.8e-31f)) break;
    }
    if (!dry) store_ot(O + (rowb + t0 + r32) * 512 + h * 64, o0, o1, hi, 1.f); else asm volatile("" :: "v"(o0), "v"(o1));
}
DEV void sb_phase(const WaveId& W, LAS unsigned char* lds, unsigned char* ws, bool dry) {
    LAS unsigned char* vl = lds + W.wave * 12288;
    const bf16_t* Q = (const bf16_t*)(ws + WS_QA); const bf16_t* Kk = (const bf16_t*)(ws + WS_KA); const bf16_t* V = (const bf16_t*)(ws + WS_VA);
    constexpr int NITEM = NB * 8 * (S / 32);
    for (int it = W.gw; it < NITEM; it += W.ngw) {
        const int qb = it & 255, h = (it >> 8) & 7, b = it >> 11;
        sb_item(vl, Q, Kk, V, (bf16_t*)(ws + WS_QA), b, h, qb, W.lane, dry);
    }
}

constexpr int IDX_CTL_OFF = 131072 + 1024;
DEV unsigned fkey2(float v) { const int u = (int)__float_as_uint(v); return (unsigned)(u ^ ((u >> 31) | (int)0x80000000)); }
DEV float relu1(float x) { return __builtin_amdgcn_fmed3f(x, 0.f, 3.0e38f); }
DEV void idx_unit(LAS unsigned char* lds, const bf16_t* IQ, const bf16_t* IK, const float* IWp, unsigned* BM, int b, int t0, int wid, int lane, int mslot) {
    const int r32 = lane & 31, hh = lane >> 5; const size_t rowb = (size_t)b * S;
    bf16x8 afr[4]; { const int qi = 2 * (r32 >> 4) + ((r32 >> 2) & 1), head = (r32 & 3) + 4 * ((r32 >> 3) & 1);
        const bf16_t* ap = IQ + (rowb + t0 + qi) * 512 + head * 64 + 8 * hh;
#pragma unroll
        for (int ks = 0; ks < 4; ++ks) afr[ks] = *(const bf16x8*)(ap + 16 * ks); }
    float w[16];
#pragma unroll
    for (int r = 0; r < 16; ++r) w[r] = IWp[(rowb + t0 + 2 * (r >> 3) + hh) * 8 + (r & 7)];
    const int tmax = t0 + 3, jmax = tmax >> 5;
    LAS unsigned* SCO = (LAS unsigned*)lds;
    bf16x8 b0[4], b1[4], b2[4];
#pragma unroll
    for (int ks = 0; ks < 4; ++ks) { b0[ks] = afr[ks]; b1[ks] = afr[ks]; b2[ks] = afr[ks]; }
#define IDX_LOADB(dst, jj) do { const int jc_ = (jj) < jmax ? (jj) : jmax; const bf16_t* bp_ = IK + ((rowb >> 5) + jc_) * 2048 + (hh * 32 + r32) * 8; \
        _Pragma("unroll") for (int ks = 0; ks < 4; ++ks) dst[ks] = *(const bf16x8*)(bp_ + ks * 512); } while (0)
#define IDX_COMP(src, jj) do { f32x16 acc; _Pragma("unroll") for (int r = 0; r < 16; ++r) acc[r] = 0.f; \
        _Pragma("unroll") for (int ks = 0; ks < 4; ++ks) acc = __builtin_amdgcn_mfma_f32_32x32x16_bf16(afr[ks], src[ks], acc, 0, 0, 0); \
        float s0 = 0.f, s1 = 0.f; _Pragma("unroll") for (int hd = 0; hd < 8; ++hd) { s0 += w[hd] * relu1(acc[hd]); s1 += w[8 + hd] * relu1(acc[8 + hd]); } \
        unsigned k0_ = fkey2(s0), k1_ = fkey2(s1); const int key = 32 * (jj) + r32; \
        if ((jj) >= jmax) { k0_ = key <= t0 + hh ? k0_ : 0u; k1_ = key <= t0 + 2 + hh ? k1_ : 0u; }     \
        if ((jj) <= jmax) { SCO[hh * 8192 + key] = k0_; SCO[(2 + hh) * 8192 + key] = k1_; } } while (0)
#ifndef IDX_REP_MFMA
#define IDX_REP_MFMA 1
#endif
#ifndef IDX_REP_SEL
#define IDX_REP_SEL 1
#endif
#pragma unroll 1
    for (int rpm = 0; rpm < IDX_REP_MFMA; ++rpm) {
    IDX_LOADB(b0, wid); IDX_LOADB(b1, wid + 8);
#pragma unroll 1
    for (int j = wid; j <= jmax; j += 24) {
        IDX_LOADB(b2, j + 16); IDX_COMP(b0, j);
        IDX_LOADB(b0, j + 24); IDX_COMP(b1, j + 8);
        IDX_LOADB(b1, j + 32); IDX_COMP(b2, j + 16);
    }
    }
#undef IDX_LOADB
#undef IDX_COMP
    LAS unsigned* thr = (LAS unsigned*)(lds + IDX_CTL_OFF);
    if (wid == 0 && lane < 32) ((LAS unsigned*)(lds + IDX_CTL_OFF + 64))[lane] = 0u;
    LDS_WAIT(); __builtin_amdgcn_s_barrier(); asm volatile("" ::: "memory");
    {
        const int q = wid & 3, h = wid >> 2, n = t0 + q + 1;
        volatile LAS unsigned* xme = (volatile LAS unsigned*)(lds + IDX_CTL_OFF + 64) + (q * 2 + h) * 4;
        volatile LAS unsigned* xpa = (volatile LAS unsigned*)(lds + IDX_CTL_OFF + 64) + (q * 2 + (h ^ 1)) * 4;
        unsigned T_ = 1u;
        if (n > 256) {
            LAS unsigned* row = SCO + q * 8192 + lane;
            unsigned r[64];
#pragma unroll
            for (int il = 0; il < 64; ++il) r[il] = (2 * (2 * il + h) + hh <= jmax) ? row[64 * (2 * il + h)] : 0u;
            unsigned seq = 0u;
#define IDX_XCHG(val, out) do { ++seq; const int pb_ = (seq & 1u) * 2; if (lane == 0) { xme[pb_ + 1] = (val); xme[pb_] = seq; } \
                while (xpa[pb_] != seq) __builtin_amdgcn_s_sleep(0); (out) = xpa[pb_ + 1]; } while (0)
#define IDX_XCHG16(val, out) do { ++seq; const int pb_ = (seq & 1u) * 2; if (lane == 0) xme[pb_] = (seq << 16) | (val); unsigned w_; \
                while (((w_ = xpa[pb_]) >> 16) != (seq & 0xffffu)) __builtin_amdgcn_s_sleep(0); (out) = w_ & 0xffffu; } while (0)
#pragma unroll 1
            for (int rps = 0; rps < IDX_REP_SEL; ++rps) {
            unsigned mx = 0u;
#pragma unroll
            for (int il = 0; il < 64; ++il) mx = max(mx, r[il]);
#pragma unroll
            for (int o = 1; o < 64; o <<= 1) mx = max(mx, (unsigned)__shfl_xor((int)mx, o));
            { unsigned pm_; IDX_XCHG(mx, pm_); mx = max(mx, pm_); }
            unsigned lo_ = 1u, hi_ = mx + 1u, chi_ = 0u, xgt_ = 1u, xeq_ = 0u, mt_ = 0u; float glo_ = __log2f((float)n) - 8.f, ghi_ = -9.f; int side_ = 0; bool done_ = false;
#pragma unroll 1
            for (int pass = 0; pass < 160 && !done_; ++pass) {
                const unsigned wdt = hi_ - lo_;
                unsigned off;
                if (pass < 2) {
                    const unsigned mkey = hi_ - 1u; const unsigned tgt = pass == 0 ? mkey - (1u << 23) : mkey - (3u << 23);
                    const bool ok = pass == 0 ? (mkey > 0x81000000u) : (mkey > 0x82000000u && tgt > lo_ && tgt < hi_);
                    off = ok ? tgt - lo_ : wdt >> 1;
                } else if ((pass & 3) == 3) off = wdt >> 1;
                else off = (unsigned)(glo_ * __builtin_amdgcn_rcpf(glo_ - ghi_) * (float)wdt);
                off = off < 1u ? 1u : (off > wdt - 1u ? wdt - 1u : off);
                const unsigned cand = (unsigned)__builtin_amdgcn_readfirstlane((int)(lo_ + off));
                unsigned ca_ = 0, cb_ = 0; const unsigned candv = lo_ + off;
#define IDX_CNT4(A, B, C, Dd) asm volatile("v_cmp_ge_u32_e64 s[88:89], %2, %6\n\tv_cmp_ge_u32_e64 s[90:91], %3, %6\n\tv_cmp_ge_u32_e64 s[92:93], %4, %6\n\tv_cmp_ge_u32_e64 s[94:95], %5, %6\n\t" \
                    "v_addc_co_u32_e64 %0, s[88:89], %0, 0, s[88:89]\n\tv_addc_co_u32_e64 %1, s[90:91], %1, 0, s[90:91]\n\tv_addc_co_u32_e64 %0, s[92:93], %0, 0, s[92:93]\n\tv_addc_co_u32_e64 %1, s[94:95], %1, 0, s[94:95]" \
                    : "+v"(ca_), "+v"(cb_) : "v"(A), "v"(B), "v"(C), "v"(Dd), "v"(candv) : "s88", "s89", "s90", "s91", "s92", "s93", "s94", "s95")
#pragma unroll
                for (int il = 0; il < 64; il += 4) IDX_CNT4(r[il], r[il + 1], r[il + 2], r[il + 3]);
#undef IDX_CNT4
                int pk = (int)(ca_ + cb_);
                pk += __builtin_amdgcn_update_dpp(0, pk, 0x111, 0xf, 0xf, false);
                pk += __builtin_amdgcn_update_dpp(0, pk, 0x112, 0xf, 0xf, false);
                pk += __builtin_amdgcn_update_dpp(0, pk, 0x114, 0xf, 0xf, false);
                pk += __builtin_amdgcn_update_dpp(0, pk, 0x118, 0xf, 0xf, false);
                pk += __builtin_amdgcn_update_dpp(0, pk, 0x142, 0xa, 0xf, false);
                unsigned tot = (unsigned)__builtin_amdgcn_readlane(pk, 31) + (unsigned)__builtin_amdgcn_readlane(pk, 63);
                { unsigned pt_; IDX_XCHG16(tot, pt_); tot += pt_; }
                const float gc = __log2f(fmaxf((float)tot, 0.5f)) - 8.f;
                if (tot == 256u) { xgt_ = cand; mt_ = 0u; done_ = true; }
                else { if (tot > 256u) { if (side_ == 1) ghi_ *= 0.5f; lo_ = cand; glo_ = gc; side_ = 1; }
                       else { if (side_ == 2) glo_ *= 0.5f; hi_ = cand; ghi_ = gc; chi_ = tot; side_ = 2; }
                       if (hi_ - lo_ == 1u) { xgt_ = hi_; xeq_ = lo_; mt_ = 256u - chi_; done_ = true; } }
            }
#ifdef IDX_XTRA
#pragma unroll 1
            for (int xr = 0; xr < IDX_XTRA; ++xr) { unsigned dsum = 0; const unsigned cv = xgt_ + (unsigned)xr;
#pragma unroll
                for (int il = 0; il < 64; ++il) dsum += r[il] >= cv;
                int pk = (int)dsum;
                pk += __builtin_amdgcn_update_dpp(0, pk, 0x111, 0xf, 0xf, false); pk += __builtin_amdgcn_update_dpp(0, pk, 0x112, 0xf, 0xf, false); pk += __builtin_amdgcn_update_dpp(0, pk, 0x114, 0xf, 0xf, false);
                pk += __builtin_amdgcn_update_dpp(0, pk, 0x118, 0xf, 0xf, false); pk += __builtin_amdgcn_update_dpp(0, pk, 0x142, 0xa, 0xf, false);
                unsigned tot = (unsigned)__builtin_amdgcn_readlane(pk, 31) + (unsigned)__builtin_amdgcn_readlane(pk, 63);
                { unsigned pt_; IDX_XCHG16(tot, pt_); tot += pt_; } asm volatile("" :: "s"(tot)); }
#endif
            T_ = xgt_;
            if (mt_ != 0u) {
                if (h == 0) { unsigned run = 0u;
#pragma unroll 1
                    for (int i = 0; i <= (jmax >> 1); ++i) { const bool ok_ = 2 * i + hh <= jmax; const unsigned kv = ok_ ? row[64 * i] : 0u; const bool eq = kv == xeq_; const unsigned long long bm = __ballot(eq);
                        const unsigned rank = run + __builtin_amdgcn_mbcnt_hi((unsigned)(bm >> 32), __builtin_amdgcn_mbcnt_lo((unsigned)bm, 0u));
                        if (eq && rank >= mt_) row[64 * i] = 0u;
                        run += (unsigned)__popcll(bm); } }
                T_ = xeq_;
            }
            }
#undef IDX_XCHG
#undef IDX_XCHG16
        }
        if (lane == 0 && h == 0) thr[q] = T_;
    }
#ifdef PROBE_VALU
    { float a0 = (float)lane, a1 = a0 + 1.f, a2 = a0 + 2.f, a3 = a0 + 3.f, a4 = a0 + 4.f, a5 = a0 + 5.f, a6 = a0 + 6.f, a7 = a0 + 7.f; const float m = 1.0000001f, c = 1e-9f;
#pragma unroll 1
      for (int it = 0; it < 64; ++it) {
#pragma unroll
          for (int u = 0; u < 8; ++u) { a0 = a0 * m + c; a1 = a1 * m + c; a2 = a2 * m + c; a3 = a3 * m + c; a4 = a4 * m + c; a5 = a5 * m + c; a6 = a6 * m + c; a7 = a7 * m + c; } }
      asm volatile("" :: "v"(a0), "v"(a1), "v"(a2), "v"(a3), "v"(a4), "v"(a5), "v"(a6), "v"(a7)); }
#endif
    LDS_WAIT(); __builtin_amdgcn_s_barrier(); asm volatile("" ::: "memory");
    { const unsigned tq0 = thr[hh], tq1 = thr[2 + hh];
#pragma unroll 4
      for (int j = wid; j < 256; j += 8) {
          bool s0 = false, s1 = false;
          if (j <= jmax) { s0 = SCO[hh * 8192 + 32 * j + r32] >= tq0; s1 = SCO[(2 + hh) * 8192 + 32 * j + r32] >= tq1; }
          const unsigned long long b0_ = __ballot(s0), b1_ = __ballot(s1);
          if (lane == 0) { u32x4 o; o.x = (unsigned)b0_; o.y = (unsigned)(b0_ >> 32); o.z = (unsigned)b1_; o.w = (unsigned)(b1_ >> 32); *(u32x4*)(BM + ((size_t)b * 256 + j) * S + t0) = o; }
      } }
    LDS_WAIT(); __builtin_amdgcn_s_barrier();
}
DEV void idx_phase(LAS unsigned char* lds, unsigned char* ws, int vcu, int G, int wid, int lane) {
    constexpr int NUNIT = T / 4;
    int k = 0;
    for (int un = vcu; un < NUNIT; un += G, ++k) {
        const int b = un / (S / 4), t0 = (un - b * (S / 4)) * 4;
        idx_unit(lds, (const bf16_t*)(ws + WS_IQ), (const bf16_t*)(ws + WS_IK), (const float*)(ws + WS_IW), (unsigned*)(ws + WS_BM), b, t0, wid, lane, k & 1);
    }
}

constexpr int DSA_STAGE = 8192 + 64 * VPITCH;
DEV void dsa_unit(LAS unsigned char* lds, const bf16_t* Q, const bf16_t* Kk, const bf16_t* V, const unsigned* BM, bf16_t* O, int b, int h, int qblk, int tid, int wid, int lane) {
    const int r32 = lane & 31, hi = lane >> 5, q0 = 256 * qblk, t0 = q0 + 32 * wid, t = t0 + r32; const size_t rowb = (size_t)b * S;
    bf16x8 qr[4]; { const bf16_t* qp = Q + (rowb + t) * 512 + h * 64 + 8 * hi;
#pragma unroll
        for (int d0 = 0; d0 < 4; ++d0) qr[d0] = *(const bf16x8*)(qp + 16 * d0); }
    f32x16 o0, o1, negm;
#pragma unroll
    for (int r = 0; r < 16; ++r) { o0[r] = 0.f; o1[r] = 0.f; negm[r] = 0.f; }
    float mref = 0.f, lsum = 0.f; bool seen = false;
    constexpr float THR = 8.f;
    const int ntile = (q0 + 256) / 64, wlast = (t0 + 31) >> 6;
    const int srow = tid >> 3, sch = tid & 7;
    const bf16_t* kg = Kk + (rowb + srow) * 512 + h * 64 + sch * 8; const bf16_t* vg = V + (rowb + srow) * 512 + h * 64 + sch * 8;
    const int kdst = srow * 128 + ((sch ^ (srow & 7)) * 16), vdst = srow * VPITCH + sch * 16;
    u32x4 kr0 = *(const u32x4*)kg, vr0 = *(const u32x4*)vg;
    *(LAS u32x4*)(lds + kdst) = kr0; *(LAS u32x4*)(lds + 8192 + vdst) = vr0;
    u32x4 kr1 = *(const u32x4*)(kg + (size_t)64 * 512), vr1 = *(const u32x4*)(vg + (size_t)64 * 512);
    const unsigned* bmp = BM + (size_t)b * 256 * S + t;
    unsigned mw0 = bmp[0], mw1 = bmp[(size_t)S];
    const int koff = r32 * 128;
    __syncthreads();
#define DSA_TILE(c, BUF, NBUF, KL, VL, KW, VW) do { \
        const LAS unsigned char* kt = lds + (BUF) * DSA_STAGE; const LAS unsigned char* vt = kt + 8192; \
        if ((c) + 2 < ntile) { KL = *(const u32x4*)(kg + (size_t)((c) + 2) * 64 * 512); VL = *(const u32x4*)(vg + (size_t)((c) + 2) * 64 * 512); } \
        unsigned nw0 = 0u, nw1 = 0u; \
        if ((c) + 1 <= wlast) { nw0 = bmp[(size_t)(2 * (c) + 2) * S]; nw1 = bmp[(size_t)(2 * (c) + 3) * S]; } \
        if ((c) <= wlast) { \
            bf16x8 kf[8]; \
            _Pragma("unroll") for (int d0 = 0; d0 < 4; ++d0) { const int xo = ((2 * d0 + hi) ^ (r32 & 7)) * 16; \
                kf[2 * d0] = *(const LAS bf16x8*)(kt + koff + xo); kf[2 * d0 + 1] = *(const LAS bf16x8*)(kt + koff + 4096 + xo); } \
            asm volatile("" : "+v"(kf[0]), "+v"(kf[1]), "+v"(kf[2]), "+v"(kf[3]), "+v"(kf[4]), "+v"(kf[5]), "+v"(kf[6]), "+v"(kf[7]));     \
            f32x16 p0 = negm, p1 = negm; \
            _Pragma("unroll") for (int d0 = 0; d0 < 4; ++d0) { p0 = __builtin_amdgcn_mfma_f32_32x32x16_bf16(kf[2 * d0], qr[d0], p0, 0, 0, 0); p1 = __builtin_amdgcn_mfma_f32_32x32x16_bf16(kf[2 * d0 + 1], qr[d0], p1, 0, 0, 0); } \
            const unsigned m0 = mw0 >> (4 * hi), m1 = mw1 >> (4 * hi); \
            _Pragma("unroll") for (int r = 0; r < 16; ++r) { const int bit = (r & 3) + 8 * (r >> 2); \
                const unsigned e0 = (unsigned)__builtin_amdgcn_sbfe((int)m0, bit, 1), e1 = (unsigned)__builtin_amdgcn_sbfe((int)m1, bit, 1); \
                p0[r] = __uint_as_float((__float_as_uint(p0[r]) & e0) | (0xff800000u & ~e0)); p1[r] = __uint_as_float((__float_as_uint(p1[r]) & e1) | (0xff800000u & ~e1)); } \
            float rm = -INFINITY; \
            _Pragma("unroll") for (int r = 0; r < 16; r += 2) rm = fmaxf(rm, fmaxf(fmaxf(p0[r], p0[r + 1]), fmaxf(p1[r], p1[r + 1]))); \
            { const auto rr = __builtin_amdgcn_permlane32_swap(__float_as_uint(rm), __float_as_uint(rm), false, false); rm = fmaxf(__uint_as_float(rr[0]), __uint_as_float(rr[1])); } \
            const bool shift = rm > THR || (rm < -THR && rm > -INFINITY && !seen);     \
            seen = seen || rm > -INFINITY; \
            if (__any(shift)) { \
                const float dl = shift ? rm : 0.f, f = dl > 0.f ? __builtin_amdgcn_exp2f(-dl) : 1.f; \
                mref += dl; lsum *= f; \
                _Pragma("unroll") for (int r = 0; r < 16; ++r) { p0[r] -= dl; p1[r] -= dl; o0[r] *= f; o1[r] *= f; negm[r] = -mref; } \
            } \
            float ps = 0.f; \
            _Pragma("unroll") for (int r = 0; r < 16; ++r) { p0[r] = __builtin_amdgcn_exp2f(p0[r]); p1[r] = __builtin_amdgcn_exp2f(p1[r]); ps += p0[r] + p1[r]; } \
            lsum += ps; \
            bf16x8 pk[4]; \
            pk[0] = pk8(p0[0], p0[1], p0[2], p0[3], p0[4], p0[5], p0[6], p0[7]); pk[1] = pk8(p0[8], p0[9], p0[10], p0[11], p0[12], p0[13], p0[14], p0[15]); \
            pk[2] = pk8(p1[0], p1[1], p1[2], p1[3], p1[4], p1[5], p1[6], p1[7]); pk[3] = pk8(p1[8], p1[9], p1[10], p1[11], p1[12], p1[13], p1[14], p1[15]); \
            pv_tile(o0, o1, vt, lane, pk); \
        } \
        mw0 = nw0; mw1 = nw1; \
        if ((c) + 1 < ntile) { LAS unsigned char* nb = lds + (NBUF) * DSA_STAGE; *(LAS u32x4*)(nb + kdst) = KW; *(LAS u32x4*)(nb + 8192 + vdst) = VW; } \
        asm volatile("s_waitcnt lgkmcnt(0)" ::: "memory"); __builtin_amdgcn_s_barrier(); asm volatile("" ::: "memory"); } while (0)
#pragma unroll 1
    for (int c = 0; c < ntile; c += 2) { DSA_TILE(c, 0, 1, kr0, vr0, kr1, vr1); DSA_TILE(c + 1, 1, 0, kr1, vr1, kr0, vr0); }
#undef DSA_TILE
    { const auto rr = __builtin_amdgcn_permlane32_swap(__float_as_uint(lsum), __float_as_uint(lsum), false, false); lsum = __uint_as_float(rr[0]) + __uint_as_float(rr[1]); }
    store_ot(O + (rowb + t) * 512 + h * 64, o0, o1, hi, 1.f / lsum);
}
DEV void dsa_phase(LAS unsigned char* lds, unsigned char* ws, int vcu, int G, int tid, int wid, int lane, bf16_t* Oout) {
    constexpr int NPAIR = NB * 8 * 16;
    for (int pr = vcu; pr < NPAIR; pr += G) {
        const int bh = pr >> 4, s = pr & 15, b = bh >> 3, h = bh & 7;
#pragma unroll 1
        for (int k = 0; k < 2; ++k) {
            const int qblk = k == 0 ? s : 31 - s;
            dsa_unit(lds, (const bf16_t*)(ws + WS_QC), (const bf16_t*)(ws + WS_KC), (const bf16_t*)(ws + WS_VC), (const unsigned*)(ws + WS_BM), Oout, b, h, qblk, tid, wid, lane);
        }
    }
}
constexpr int MK_THREADS = 512;
constexpr int RING_BYTES = 131072, MISC_OFF = RING_BYTES + 320, MK_LDS_BYTES = 147456;
constexpr size_t WS_CTL = 0, CTL_ZERO_BYTES = 65536 + 7 * 131072; constexpr int CW_BAR = 4096;
constexpr int PH_PREP0 = 0, PH_KV = 1, PH_GH = 2, PH_L0 = 3, PH_PER_LAYER = 14, NPH = PH_L0 + 2 * PH_PER_LAYER;
enum { Q_INPROJ = 0, Q_SBIDX, Q_DSA, Q_GATES, Q_MERGE, Q_MIX, Q_NORMXA, Q_XALOG, Q_XAOUT, Q_NORMFFN, Q_UP, Q_FFNMID, Q_DOWN, Q_NEXT };

#ifndef QBUILD
#define QBUILD 0xffffu
#endif
#define QON(x) ((QBUILD >> (x)) & 1u)
struct Args { const float* in[20]; float* out; unsigned char* ws; int ph_lo, ph_hi; };

__global__ void __launch_bounds__(MK_THREADS, 2) mk_fwd(Args args) {
    __shared__ __attribute__((aligned(16))) unsigned char lds_raw[MK_LDS_BYTES];
    LAS unsigned char* lds = (LAS unsigned char*)lds_raw;
    volatile LAS unsigned* MISC = (volatile LAS unsigned*)(lds + MISC_OFF);
    const int G = gridDim.x, bx = blockIdx.x;
    unsigned char* ws0 = args.ws;
    for (int u = threadIdx.x; u < (MK_LDS_BYTES - RING_BYTES) / 4; u += MK_THREADS) ((LAS unsigned*)(lds + RING_BYTES))[u] = 0u;
    __syncthreads();
    const int lo = args.ph_lo, hi = args.ph_hi;
    XcdBarrier bar; bar.bar = (unsigned*)(ws0 + WS_CTL) + CW_BAR; bar.x = 0; bar.st = nullptr;
    if (hi - lo > 1) bar = xcd_barrier_post((unsigned*)(ws0 + WS_CTL) + CW_BAR, MISC + 8);
#define BPW(off) ((bf16_t*)(ws + (off)))
    const int vcu = (G % 8 == 0) ? (bx % 8) * (G / 8) + bx / 8 : bx;
    for (int p = lo; p < hi; ++p) {
#ifdef PROBE_REP
        const int reps = (p >= PH_L0 && ((PROBE_REP >> ((p - PH_L0) % PH_PER_LAYER)) & 1)) ? 2 : 1;
#else
        const int reps = 1;
#endif
#ifdef PROBE_REP
#pragma unroll 1
        for (int rep = 0; rep < reps; ++rep) {
        const bool dry = rep + 1 < reps;
#else
        { constexpr bool dry = false;
#endif
        int oz = 0; asm volatile("" : "+s"(oz));
        int tid = threadIdx.x; asm volatile("" : "+v"(tid));
        const int wave = __builtin_amdgcn_readfirstlane(tid >> 6), lane = tid & 63;
        WaveId W; W.gw = vcu * 8 + wave; W.ngw = G * 8; W.wave = wave; W.lane = lane;
        unsigned char* ws = args.ws + oz; float* X = args.out + oz;
#define INP(k) (args.in[(k) + oz])
        if (p == PH_PREP0) {
            prep0_phase(W, (LAS float*)(lds + wave * 16384), ws, args.in + oz, (bf16_t*)X);
        } else if (p == PH_KV && QON(14)) {
            pg8::Order S; S.init(2, 8, 2, G, bx);
            pg8::PtrStd P{(const char*)(ws + WS_MEMN), (const char*)(ws + WS_WKVT), 1 * MiB, 4 * MiB, 0, (size_t)256 * D * 2, (size_t)256 * D * 2};
            pg8::EpiPrep E{ws, 0};
            pg8::gemm_phase<pg8::EpiPrep, pg8::PtrStd, true, true>(lds, D, D, D, S, P, E);
        } else if (p == PH_GH && QON(15)) {
            { pg8::Order S; S.init(1, 4, 16, G, bx); pg8::PtrG P{(const char*)(ws + WS_KVM), (const char*)(ws + WS_WQ)}; pg8::EpiPrep E{ws, 1};
              pg8::gemm_phase<pg8::EpiPrep, pg8::PtrG, true, true>(lds, 2 * D, D, 256, S, P, E); }
            { pg8::Order S; S.init(4, 1, 16, G, (bx + 64) % G); pg8::PtrH P{(const char*)(ws + WS_KVM), (const char*)(ws + WS_WOT)}; pg8::EpiPrep E{ws, 2};
              pg8::gemm_phase<pg8::EpiPrep, pg8::PtrH, true, true>(lds, D, 2 * D, 256, S, P, E); }
        } else if (p >= PH_L0) {
            const int l = (p - PH_L0) / PH_PER_LAYER, q = (p - PH_L0) % PH_PER_LAYER;
            const float* Xin = l == 0 ? INP(0) : X;
            pg8::u64* SSb = (pg8::u64*)(ws + WS_SS);
#define SSA(i) (SSb + (size_t)(i) * T)
            if (q == Q_SBIDX) {
#ifndef NO_SB
                sb_phase(W, lds, ws, dry);
#endif
                __syncthreads();
#ifndef NO_IDX
#ifdef PROBE_SB_ONLY
                if (!dry)
#endif
                idx_phase(lds, ws, vcu, G, wave, lane);
#endif
                conv_sc_phase(vcu * MK_THREADS + tid, G * MK_THREADS, BPW(WS_SCB), BPW(WS_CX), INP(4) + l * 3 * 512, dry);
            } else if (q == Q_DSA) {
#ifndef NO_DSA
                dsa_phase(lds, ws, vcu, G, tid, wave, lane, dry ? BPW(WS_KA) : BPW(WS_QC));
#endif
            } else if (q == Q_FFNMID) {
                ffn_mid_phase(vcu * MK_THREADS + tid, G * MK_THREADS, BPW(WS_FA), BPW(WS_FU), INP(16) + l * 3 * DFF, INP(17) + l * DFF, dry);
            } else if (q == Q_NEXT) {
                if (l + 1 < DEPTH) { int base = 0; convert_layer_weights(W, (LAS float*)(lds + wave * 16384), base, ws, args.in + oz, l + 1); }
                else if (!dry) final_norm(W, BPW(WS_XN), X, INP(19), SSA(6));
            } else if (q == Q_INPROJ && QON(Q_INPROJ)) {
                pg8::Order S; S.init(T / 256, NIN / 256, 1, G, bx);
                pg8::PtrStd P{(const char*)X, (const char*)(ws + WS_WIN), 0, 0, 0, (size_t)256 * D * 2, (size_t)256 * D * 2};
                pg8::EpiInProj E{ws, SSA(3 * l)};
                pg8::gemm_phase<pg8::EpiInProj, pg8::PtrStd, true, true>(lds, D, D, D, S, P, E);
            } else if (q == Q_GATES && QON(Q_GATES)) {
                pg8::Order S; S.init(T / 256, 12, 1, G, bx);
                pg8::PtrStd P{(const char*)X, (const char*)(ws + WS_WG), 0, 0, 0, (size_t)256 * D * 2, (size_t)256 * D * 2};
                pg8::EpiGates E{BPW(WS_GATES), SSA(3 * l)};
                pg8::gemm_phase<pg8::EpiGates, pg8::PtrStd, true, true>(lds, D, D, D, S, P, E);
            } else if (q == Q_MERGE && QON(Q_MERGE)) {
                pg8::Order S; S.init(T / 256, 4, 3, G, bx);
                pg8::PtrStd P{(const char*)(ws + WS_QA), (const char*)(ws + WS_WBR), 16 * MiB, (size_t)D * 512 * 2, 0, (size_t)256 * 512 * 2, (size_t)256 * 512 * 2};
                pg8::EpiMerge E{BPW(WS_XN), BPW(WS_GATES)};
                pg8::gemm_phase<pg8::EpiMerge, pg8::PtrStd, true, true>(lds, 512, 512, 512, S, P, E);
            } else if (q == Q_MIX && QON(Q_MIX)) {
                pg8::Order S; S.init(T / 256, 4, 1, G, bx);
                pg8::PtrStd P{(const char*)(ws + WS_XN), (const char*)(ws + WS_WMIX), 0, 0, 0, (size_t)256 * D * 2, (size_t)256 * D * 2};
                if (l == 0) { pg8::EpiResid<true> E{(const void*)INP(0), dry ? BPW(WS_FU) : BPW(WS_XBXA), dry ? SSA(0) : SSA(1)};
                    pg8::gemm_phase<pg8::EpiResid<true>, pg8::PtrStd, true, true>(lds, D, D, D, S, P, E); }
                else { pg8::EpiResid<false> E{(const void*)X, dry ? BPW(WS_FU) : BPW(WS_XBXA), dry ? SSA(0) : SSA(4)};
                    pg8::gemm_phase<pg8::EpiResid<false>, pg8::PtrStd, true, true>(lds, D, D, D, S, P, E); }

            } else if (q == Q_XALOG && QON(Q_XALOG)) {
                pg8::Order S; S.init(T / 256, 4, 1, G, bx);
                pg8::PtrStd P{(const char*)(ws + WS_XBXA), (const char*)(ws + WS_GT + (size_t)l * 4 * MiB), 0, 0, 2 * MiB, (size_t)256 * D * 2, (size_t)256 * D * 2};
                pg8::EpiSoftmax E{BPW(WS_PXA), SSA(1 + 3 * l)};
                pg8::gemm_phase<pg8::EpiSoftmax, pg8::PtrStd, false, true>(lds, D, D, D, S, P, E);
            } else if (q == Q_XAOUT && QON(Q_XAOUT)) {
                pg8::Order S; S.init(T / 256, 4, 1, G, bx);
                pg8::PtrStd P{(const char*)(ws + WS_PXA), (const char*)(ws + WS_HT + (size_t)l * 4 * MiB), 0, 0, 2 * MiB, (size_t)256 * D * 2, (size_t)256 * D * 2};
                pg8::EpiResid<false> E{(const void*)BPW(WS_XBXA), dry ? BPW(WS_FU) : BPW(WS_XN), dry ? SSA(0) : SSA(2 + 3 * l)};
                pg8::gemm_phase<pg8::EpiResid<false>, pg8::PtrStd, true, true>(lds, D, D, D, S, P, E);
            } else if (q == Q_UP && QON(Q_UP)) {
                pg8::Order S; S.init(T / 256, 22, 1, G, bx);
                pg8::PtrStd P{(const char*)(ws + WS_XN), (const char*)(ws + WS_WUP), 0, 0, 0, (size_t)256 * D * 2, (size_t)256 * D * 2};
                pg8::EpiUp E{BPW(WS_FA), BPW(WS_FU), SSA(2 + 3 * l)};
                pg8::gemm_phase<pg8::EpiUp, pg8::PtrStd, true, true>(lds, D, D, D, S, P, E);
            } else if (q == Q_DOWN && QON(Q_DOWN)) {
                pg8::Order S; S.init(T / 256, 4, 1, G, bx);
                pg8::PtrStd P{(const char*)(ws + WS_FU), (const char*)(ws + WS_WDOWN), 0, 0, 0, (size_t)256 * DFF * 2, (size_t)256 * DFF * 2};
                pg8::EpiResid<false> E{(const void*)BPW(WS_XN), dry ? BPW(WS_QA) : (l + 1 < DEPTH ? (bf16_t*)X : BPW(WS_XN)), dry ? SSA(0) : SSA(3 + 3 * l)};
                pg8::gemm_phase<pg8::EpiResid<false>, pg8::PtrStd, true, true>(lds, DFF, DFF, DFF, S, P, E);
            }
        }
        }
        if (p + 1 < hi && !(p >= PH_L0 && ((p - PH_L0) % PH_PER_LAYER == Q_NORMXA || (p - PH_L0) % PH_PER_LAYER == Q_NORMFFN))) xcd_barrier(bar);
    }
}

extern "C" void kernel_launch(void* const* d_in, const int* in_sizes, int n_in, void* d_out, int out_size, void* d_ws, size_t ws_size, hipStream_t st) {
    if (n_in != 20 || ws_size < WS_NEED || out_size != T * D) { fprintf(stderr, "kernel_launch: unexpected sizes n_in %d ws %zu out %d\n", n_in, ws_size, out_size); return; }
    static int grid = 0;
    if (grid == 0) {
        int dev = 0, cus = 0, per_cu = 0;
        (void)hipGetDevice(&dev); (void)hipDeviceGetAttribute(&cus, hipDeviceAttributeMultiprocessorCount, dev);
        if (hipOccupancyMaxActiveBlocksPerMultiprocessor(&per_cu, (const void*)mk_fwd, MK_THREADS, 0) != hipSuccess || per_cu < 1) { fprintf(stderr, "kernel_launch: occupancy query says %d blocks/CU\n", per_cu); grid = -1; return; }
        (void)hipGetLastError();
        if (cus != 256) { fprintf(stderr, "kernel_launch: built for a 256-CU device, found %d\n", cus); grid = -1; return; }
        grid = cus;
    }
    if (grid < 0) return;
    (void)hipMemsetAsync((char*)d_ws + WS_CTL, 0, CTL_ZERO_BYTES, st);
    Args a{};
    for (int i = 0; i < 20; ++i) a.in[i] = (const float*)d_in[i];
    a.out = (float*)d_out; a.ws = (unsigned char*)d_ws; a.ph_lo = 0; a.ph_hi = NPH;
    hipLaunchKernelGGL(mk_fwd, dim3(grid), dim3(MK_THREADS), 0, st, a);
}
```

```cpp
#include <hip/hip_runtime.h>
#include <stdint.h>
#include <stdio.h>

typedef unsigned short bf16_t;
typedef short bf16x8 __attribute__((ext_vector_type(8)));
typedef float f32x16 __attribute__((ext_vector_type(16)));
typedef float f32x4 __attribute__((ext_vector_type(4)));
#define DEV __device__ __forceinline__

constexpr int NB = 2, S = 8192, D = 1024, T = NB * S, DEPTH = 2;
constexpr int DIN = 8264, DFF = 2816, MEM = 256;
constexpr int NIN = 5376;
constexpr float LOG2E = 1.4426950408889634f;
constexpr float QSCALE = 0.125f * LOG2E;
constexpr float WSCALE = 0.125f * 0.35355339059327373f;
constexpr float XSCALE = 0.0625f * LOG2E;
constexpr float EPS = 1e-6f;
#ifndef MK_FUSE
#define MK_FUSE 1
#endif

constexpr size_t MiB = 1u << 20;
constexpr size_t WS_GT = 1 * MiB;
constexpr size_t WS_HT = 9 * MiB;
constexpr size_t WS_WUP = 17 * MiB, WS_WDOWN = 28 * MiB;
constexpr size_t WS_XN = 34 * MiB;
constexpr size_t WS_WMIX = 66 * MiB, WS_WBR = 68 * MiB, WS_WG = 71 * MiB, WS_WIN = 77 * MiB;
constexpr size_t WS_QA = 88 * MiB, WS_SCB = 104 * MiB, WS_QC = 120 * MiB, WS_KA = 136 * MiB, WS_VA = 152 * MiB, WS_KC = 168 * MiB, WS_VC = 184 * MiB,
                 WS_IQ = 200 * MiB, WS_CX = 216 * MiB, WS_IK = 232 * MiB, WS_IW = 234 * MiB, WS_BM = 235 * MiB;
constexpr size_t WS_GATES = 136 * MiB;
constexpr size_t WS_XTMP = 235 * MiB;
constexpr size_t WS_LOG = 88 * MiB, WS_PXA = 168 * MiB;
constexpr size_t WS_XBXA = 136 * MiB;
constexpr size_t WS_SS = 65536;
constexpr size_t WS_FA = 66 * MiB, WS_FU = 154 * MiB;
constexpr size_t WS_WQ = 200 * MiB  , WS_WOT = 204 * MiB  , WS_WKVT = 208 * MiB  , WS_MEMN = 216 * MiB  , WS_KVM = 218 * MiB  ;
constexpr size_t WS_NEED = 256 * MiB;

DEV bf16_t f2bf(float f) { unsigned u = __float_as_uint(f); u += 0x7fffu + ((u >> 16) & 1u); return (bf16_t)(u >> 16); }
DEV float bf2f(bf16_t h) { return __uint_as_float(((unsigned)h) << 16); }
DEV float wave_sum(float v) {
#pragma unroll
    for (int o = 1; o < 64; o <<= 1) v += __shfl_xor(v, o);
    return v;
}
DEV float wave_max(float v) {
#pragma unroll
    for (int o = 1; o < 64; o <<= 1) v = fmaxf(v, __shfl_xor(v, o));
    return v;
}


#define LAS __attribute__((address_space(3)))
#define GAS __attribute__((address_space(1)))
typedef unsigned u32x4 __attribute__((ext_vector_type(4)));
typedef unsigned u32x2 __attribute__((ext_vector_type(2)));
typedef float f32x2 __attribute__((ext_vector_type(2)));
#define LDS_WAIT() asm volatile("s_waitcnt lgkmcnt(0)" ::: "memory")
#define VM_WAIT() asm volatile("s_waitcnt vmcnt(0)" ::: "memory")
typedef __bf16 bf16x2_t __attribute__((ext_vector_type(2)));
DEV unsigned cvt_pk_bf16(float lo, float hi) { const f32x2 v = {lo, hi}; return __builtin_bit_cast(unsigned, __builtin_convertvector(v, bf16x2_t)); }
DEV float bflo(unsigned w) { return __uint_as_float(w << 16); }
DEV float bfhi(unsigned w) { return __uint_as_float(w & 0xffff0000u); }

namespace pg8 {
constexpr int BM = 256, BK = 64, HALF = 128, HTB = HALF * BK * 2, STAGE_BYTES = 8 * HTB, NXCD = 8, WGM = 8;
__host__ __device__ __forceinline__ int lds_byte(int r, int c) { const int st = (r >> 4) * 2 + (c >> 5), rr = r & 15, cc = c & 31, ob = rr * 64 + cc * 2; return st * 1024 + (ob ^ (((ob >> 9) & 1) << 5)); }
__host__ __device__ __forceinline__ void stage_rc(int b, int& R, int& C) { const int st = b / 1024, sb = b % 1024, swz = sb ^ (((sb >> 9) & 1) << 5); R = (st >> 1) * 16 + swz / 64; C = (st & 1) * 32 + (swz % 64) / 2; }
__host__ __device__ __forceinline__ int perm32(int rho) { const int n = rho >> 4, i = rho & 15; return 8 * (i >> 2) + 4 * n + (i & 3); }

struct Unit { int pm, pn, job; };
struct Order {
    int nM, nN, nwg, ntot, G, c;
    DEV void init(int nM_, int nN_, int njob, int G_, int c_) { nM = nM_; nN = nN_; nwg = nM * nN; ntot = nwg * njob; G = G_; c = c_; }
    DEV bool next(int i, Unit& u) const {
        const int L = i * G + c; if (L >= ntot) return false;
        u.job = L / nwg; int wgid = L - u.job * nwg;
        { const int q = nwg / NXCD, r = nwg % NXCD, xcd = wgid % NXCD, off = wgid / NXCD; wgid = (xcd < r ? xcd * (q + 1) : r * (q + 1) + (xcd - r) * q) + off; }
        const int nig = WGM * nN, gid = wgid / nig, fm = gid * WGM, gsz = (nM - fm) < WGM ? (nM - fm) : WGM;
        u.pm = fm + ((wgid % nig) % gsz); u.pn = (wgid % nig) / gsz; return true;
    }
};
template <class Epi, class Ptr, bool ALIGN_EPI, bool SP2>
DEV void gemm_phase(LAS unsigned char* lds, const int lda, const int ldb, const int K, const Order& S, const Ptr& P, const Epi& E) {
    int tid_ = threadIdx.x; asm volatile("" : "+v"(tid_));
    const int tid = tid_, wid = __builtin_amdgcn_readfirstlane(tid >> 6), lane = tid & 63, wr = wid >> 2, wc = wid & 3, fr = lane & 15, fq = lane >> 4;
    const int nt = K / BK;
    unsigned voffA[2], voffB[2];
#pragma unroll
    for (int i = 0; i < 2; ++i) { int R, C; stage_rc(tid * 16 + i * 8192, R, C); const int Rb = Epi::PERM ? ((R & ~31) + perm32(R & 31)) : R;
        voffA[i] = (unsigned)(R * lda + C) * 2u; voffB[i] = (unsigned)(Rb * ldb + C) * 2u; }
    const size_t kstep = (size_t)(BK * 2);
    const size_t hstepA = (size_t)HALF * lda * 2, hstepB = (size_t)HALF * ldb * 2;
    const unsigned ldsw = (unsigned)wid * 1024u;
    const int aoff = lds_byte(wr * 64 + fr, fq * 8), boff = lds_byte(wc * 32 + fr, fq * 8);
#define PG8_SA(b, h) (((b) * 2 + (h)) * HTB)
#define PG8_SB(b, h) ((4 + (b) * 2 + (h)) * HTB)
#define PG8_STAGE(bufoff, gbase, voff) do { _Pragma("unroll") for (int _i = 0; _i < 2; ++_i) \
        __builtin_amdgcn_global_load_lds((const unsigned*)((const char*)(gbase) + (voff)[_i]), (LAS unsigned*)(lds + (bufoff) + ldsw + _i * 8192), 16, 0, 0); } while (0)
#define PG8_LDA(dst, b, h) do { _Pragma("unroll") for (int m = 0; m < 4; ++m) _Pragma("unroll") for (int k = 0; k < 2; ++k) dst[m][k] = *(const LAS bf16x8*)(lds + PG8_SA(b, h) + aoff + m * 2048 + k * 1024); } while (0)
#define PG8_LDB(dst, b, h) do { _Pragma("unroll") for (int n = 0; n < 2; ++n) _Pragma("unroll") for (int k = 0; k < 2; ++k) dst[n][k] = *(const LAS bf16x8*)(lds + PG8_SB(b, h) + boff + n * 2048 + k * 1024); } while (0)
#define PG8_MMA(ai, bj, At, Bt) do { __builtin_amdgcn_s_setprio(1); _Pragma("unroll") for (int m = 0; m < 4; ++m) _Pragma("unroll") for (int n = 0; n < 2; ++n) _Pragma("unroll") for (int k = 0; k < 2; ++k) \
        acc[ai][bj][m][n] = __builtin_amdgcn_mfma_f32_16x16x32_bf16(Bt[n][k], At[m][k], acc[ai][bj][m][n], 0, 0, 0); __builtin_amdgcn_s_setprio(0); } while (0)
#define PG8_WAIT_V(n) asm volatile("s_waitcnt vmcnt(" #n ")" ::: "memory")
#define PG8_WAIT_L(n) asm volatile("s_waitcnt lgkmcnt(" #n ")" ::: "memory")
#define PG8_BAR __builtin_amdgcn_s_barrier()
#define PG8_SCHED __builtin_amdgcn_sched_barrier(0)
    Unit cur, nxt; int ui = 0;
    if (!S.next(0, cur)) return;
    f32x4 acc[2][2][4][2];
#pragma unroll
    for (int a = 0; a < 2; ++a)
#pragma unroll
        for (int b = 0; b < 2; ++b)
#pragma unroll
            for (int m = 0; m < 4; ++m)
#pragma unroll
                for (int n = 0; n < 2; ++n) acc[a][b][m][n] = (f32x4){0.f, 0.f, 0.f, 0.f};
    bf16x8 At[4][2], B0[2][2], B1[2][2];
    const char* cA = P.a(cur); const char* cB = P.b(cur);
    typename Epi::Pre pre; E.prefetch(pre, cur, wr, fr);
    if constexpr (SP2) {
        PG8_STAGE(PG8_SB(0, 0), cB, voffB); PG8_STAGE(PG8_SB(0, 1), cB + hstepB, voffB); PG8_STAGE(PG8_SA(0, 0), cA, voffA); PG8_STAGE(PG8_SA(0, 1), cA + hstepA, voffA);
        if (wr == 1) PG8_BAR;
        PG8_WAIT_V(2); PG8_BAR;
        PG8_STAGE(PG8_SB(1, 0), cB + kstep, voffB); PG8_STAGE(PG8_SA(1, 0), cA + kstep, voffA); PG8_STAGE(PG8_SB(1, 1), cB + hstepB + kstep, voffB);
        PG8_WAIT_V(6); PG8_BAR;
    } else {
        PG8_STAGE(PG8_SB(0, 0), cB, voffB); PG8_STAGE(PG8_SA(0, 0), cA, voffA); PG8_STAGE(PG8_SB(0, 1), cB + hstepB, voffB); PG8_STAGE(PG8_SA(0, 1), cA + hstepA, voffA);
        if (wr == 1) PG8_BAR;
        PG8_WAIT_V(4); PG8_BAR;
        PG8_STAGE(PG8_SB(1, 0), cB + kstep, voffB); PG8_STAGE(PG8_SA(1, 0), cA + kstep, voffA); PG8_STAGE(PG8_SB(1, 1), cB + hstepB + kstep, voffB);
        PG8_WAIT_V(6); PG8_BAR;
    }
#pragma unroll 1
    for (;;) {
        const bool has_next = S.next(ui + 1, nxt);
        const char* nA = has_next ? P.a(nxt) : cA; const char* nB = has_next ? P.b(nxt) : cB;
#pragma unroll 1
        for (int t = 0; t < nt; t += 2) {
            const bool last = (t == nt - 2);
            const char* a1 = cA + (size_t)(t + 1) * kstep;
            const char* a2 = last ? nA : cA + (size_t)(t + 2) * kstep; const char* b2 = last ? nB : cB + (size_t)(t + 2) * kstep;
            const char* a3 = a2 + kstep; const char* b3 = b2 + kstep;
            if constexpr (SP2) {
            PG8_LDB(B0, 0, 0); PG8_LDB(B1, 0, 1); PG8_SCHED; PG8_LDA(At, 0, 0); PG8_STAGE(PG8_SA(1, 1), a1 + hstepA, voffA);
            PG8_WAIT_V(8); PG8_WAIT_L(0); PG8_BAR; PG8_MMA(0, 0, At, B0); PG8_MMA(0, 1, At, B1); PG8_BAR; PG8_SCHED;
            PG8_LDA(At, 0, 1); PG8_STAGE(PG8_SB(0, 0), b2, voffB); PG8_STAGE(PG8_SB(0, 1), b2 + hstepB, voffB); PG8_STAGE(PG8_SA(0, 0), a2, voffA);
            PG8_WAIT_V(8); PG8_WAIT_L(0); PG8_BAR; PG8_MMA(1, 0, At, B0); PG8_MMA(1, 1, At, B1); PG8_BAR; PG8_SCHED;
            PG8_LDB(B0, 1, 0); PG8_LDB(B1, 1, 1); PG8_SCHED; PG8_LDA(At, 1, 0); PG8_STAGE(PG8_SA(0, 1), a2 + hstepA, voffA);
            PG8_WAIT_V(8); PG8_WAIT_L(0); PG8_BAR; PG8_MMA(0, 0, At, B0); PG8_MMA(0, 1, At, B1); PG8_BAR; PG8_SCHED;
            PG8_LDA(At, 1, 1); PG8_STAGE(PG8_SB(1, 0), b3, voffB); PG8_STAGE(PG8_SB(1, 1), b3 + hstepB, voffB); PG8_STAGE(PG8_SA(1, 0), a3, voffA);
            PG8_WAIT_V(8); PG8_WAIT_L(0); PG8_BAR; PG8_MMA(1, 0, At, B0); PG8_MMA(1, 1, At, B1); PG8_BAR; PG8_SCHED;
            } else {
            PG8_LDB(B0, 0, 0); PG8_SCHED; PG8_LDA(At, 0, 0); PG8_STAGE(PG8_SA(1, 1), a1 + hstepA, voffA);
            PG8_WAIT_L(8); PG8_BAR; PG8_WAIT_L(0); PG8_MMA(0, 0, At, B0); PG8_BAR; PG8_SCHED;
            PG8_LDB(B1, 0, 1); PG8_STAGE(PG8_SB(0, 0), b2, voffB);
            PG8_BAR; PG8_WAIT_L(0); PG8_MMA(0, 1, At, B1); PG8_BAR;
            PG8_LDA(At, 0, 1); PG8_STAGE(PG8_SA(0, 0), a2, voffA);
            PG8_BAR; PG8_WAIT_L(0); PG8_MMA(1, 0, At, B0); PG8_BAR; PG8_SCHED;
            PG8_STAGE(PG8_SB(0, 1), b2 + hstepB, voffB);
            PG8_WAIT_V(6); PG8_BAR; PG8_MMA(1, 1, At, B1); PG8_BAR;
            PG8_LDB(B0, 1, 0); PG8_SCHED; PG8_LDA(At, 1, 0); PG8_STAGE(PG8_SA(0, 1), a2 + hstepA, voffA);
            PG8_WAIT_L(8); PG8_BAR; PG8_WAIT_L(0); PG8_MMA(0, 0, At, B0); PG8_BAR; PG8_SCHED;
            PG8_LDB(B1, 1, 1); PG8_STAGE(PG8_SB(1, 0), b3, voffB);
            PG8_BAR; PG8_WAIT_L(0); PG8_MMA(0, 1, At, B1); PG8_BAR;
            PG8_LDA(At, 1, 1); PG8_STAGE(PG8_SA(1, 0), a3, voffA);
            PG8_BAR; PG8_WAIT_L(0); PG8_MMA(1, 0, At, B0); PG8_BAR; PG8_SCHED;
            PG8_STAGE(PG8_SB(1, 1), b3 + hstepB, voffB);
            PG8_WAIT_V(6); PG8_BAR; PG8_MMA(1, 1, At, B1); PG8_BAR;
            }
        }
        if constexpr (ALIGN_EPI) { if (wr == 0) PG8_BAR; }
        if constexpr (!Epi::AFTER_DRAIN) { E(acc, cur, wr, wc, fr, fq, pre); }
        if (!has_next) break;
#pragma unroll
        for (int a = 0; a < 2; ++a)
#pragma unroll
            for (int b = 0; b < 2; ++b)
#pragma unroll
                for (int m = 0; m < 4; ++m)
#pragma unroll
                    for (int n = 0; n < 2; ++n) acc[a][b][m][n] = (f32x4){0.f, 0.f, 0.f, 0.f};
        cur = nxt; cA = nA; cB = nB; ++ui; E.prefetch(pre, cur, wr, fr);
        if constexpr (ALIGN_EPI) { if (wr == 1) PG8_BAR; }
    }
    PG8_WAIT_V(0);
    if constexpr (!ALIGN_EPI) { if (wr == 0) PG8_BAR; }
    PG8_BAR;
    if constexpr (Epi::AFTER_DRAIN) { E.fused(acc, cur, wr, wc, fr, fq, lds, wid, lane, pre); }
#undef PG8_SA
#undef PG8_SB
#undef PG8_STAGE
#undef PG8_LDA
#undef PG8_LDB
#undef PG8_MMA
#undef PG8_WAIT_V
#undef PG8_WAIT_L
#undef PG8_BAR
#undef PG8_SCHED
}
typedef f32x4 Acc[2][2][4][2];

struct PtrStd {
    const char* A; const char* B; size_t aj, bj, bb, arow, brow;
    DEV const char* a(const Unit& u) const { return A + (size_t)u.job * aj + (size_t)u.pm * arow; }
    DEV const char* b(const Unit& u) const { return B + (size_t)u.job * bj + (size_t)(u.pm >> 5) * bb + (size_t)u.pn * brow; }
};
struct PtrG {
    const char* KVM; const char* WQ;
    DEV const char* a(const Unit& u) const { return KVM + (size_t)(u.job >> 2) * MiB + (size_t)(u.job & 3) * 512; }
    DEV const char* b(const Unit& u) const { return WQ + (size_t)(u.job >> 3) * 2 * MiB + (size_t)(u.job & 3) * 512 + (size_t)u.pn * 256 * 1024 * 2; }
};
struct PtrH {
    const char* KVM; const char* WOT;
    DEV const char* a(const Unit& u) const { return WOT + (size_t)(u.job >> 3) * 2 * MiB + (size_t)(u.job & 3) * 512 + (size_t)u.pm * 256 * 1024 * 2; }
    DEV const char* b(const Unit& u) const { return KVM + (size_t)(u.job >> 2) * MiB + 2048 + (size_t)(u.job & 3) * 512; }
};

#define EPI_ROWS(u) const int row0 = (u).pm * BM + wr * 64 + fr
DEV u32x4 pack8(const f32x4 v0, const f32x4 v1) { u32x4 w; w.x = cvt_pk_bf16(v0[0], v0[1]); w.y = cvt_pk_bf16(v0[2], v0[3]); w.z = cvt_pk_bf16(v1[0], v1[1]); w.w = cvt_pk_bf16(v1[2], v1[3]); return w; }

struct PreNone {};
typedef unsigned long long u64;
constexpr float SS_SCALE = 65536.f;
struct PreRs { u64 v[2][4]; };
DEV void pre_rs(PreRs& p, const u64* ss, int row0) {
#pragma unroll
    for (int ai = 0; ai < 2; ++ai)
#pragma unroll
        for (int m = 0; m < 4; ++m) p.v[ai][m] = __builtin_nontemporal_load(ss + row0 + ai * HALF + m * 16);
}
DEV void rs_of(float (&rs)[2][4], const PreRs& p) {
#pragma unroll
    for (int ai = 0; ai < 2; ++ai)
#pragma unroll
        for (int m = 0; m < 4; ++m) rs[ai][m] = rsqrtf((float)p.v[ai][m] * (1.f / (SS_SCALE * D)) + EPS);
}
struct EpiInProj {
    typedef PreRs Pre;
    DEV void prefetch(PreRs& p, const Unit& u, int wr, int fr) const { pre_rs(p, ss, u.pm * BM + wr * 64 + fr); }
    static constexpr bool PERM = true, AFTER_DRAIN = false;
    unsigned char* ws; const u64* ss;
    DEV void operator()(const Acc& acc, const Unit& u, int wr, int wc, int fr, int fq, const PreRs& pre) const {
        EPI_ROWS(u); const int pn = u.pn, cb = wc * 32 + 8 * fq;
        float rs[2][4]; rs_of(rs, pre);
        if (pn < 16) {
            const int g = pn >> 1;
            const size_t off = g == 0 ? WS_QA : g == 1 ? WS_KA : g == 2 ? WS_VA : g == 3 ? WS_QC : g == 4 ? WS_KC : g == 5 ? WS_VC : g == 6 ? WS_IQ : WS_SCB;
            const float sc = (g == 0 || g == 3) ? QSCALE : 1.f;
            bf16_t* base = (bf16_t*)(ws + off) + (pn & 1) * 256 + cb;
#pragma unroll
            for (int ai = 0; ai < 2; ++ai)
#pragma unroll
                for (int m = 0; m < 4; ++m) { bf16_t* rowp = base + (size_t)(row0 + ai * HALF + m * 16) * 512;
#pragma unroll
                    for (int bj = 0; bj < 2; ++bj) *(u32x4*)(rowp + bj * HALF) = pack8(acc[ai][bj][m][0] * (sc * rs[ai][m]), acc[ai][bj][m][1] * (sc * rs[ai][m])); }
        } else if (pn < 20) {
            bf16_t* base = (bf16_t*)(ws + WS_CX) + (pn - 16) * 128 + cb;
#pragma unroll
            for (int ai = 0; ai < 2; ++ai)
#pragma unroll
                for (int m = 0; m < 4; ++m) { const float r2 = rs[ai][m] * rs[ai][m]; *(u32x4*)(base + (size_t)(row0 + ai * HALF + m * 16) * 512) = pack8(acc[ai][0][m][0] * acc[ai][1][m][0] * r2, acc[ai][0][m][1] * acc[ai][1][m][1] * r2); }
        } else {
            if (wc < 2) { bf16_t* base = (bf16_t*)(ws + WS_IK);
#pragma unroll
                for (int ai = 0; ai < 2; ++ai)
#pragma unroll
                    for (int m = 0; m < 4; ++m) { const int t = row0 + ai * HALF + m * 16;
                        *(u32x4*)(base + (size_t)(t >> 5) * 2048 + (((cb >> 3) * 32 + (t & 31)) * 8)) = pack8(acc[ai][0][m][0] * rs[ai][m], acc[ai][0][m][1] * rs[ai][m]); }
            } else if (wc == 2 && fq == 0) { float* base = (float*)(ws + WS_IW);
#pragma unroll
                for (int ai = 0; ai < 2; ++ai)
#pragma unroll
                    for (int m = 0; m < 4; ++m) { float* p = base + (size_t)(row0 + ai * HALF + m * 16) * 8; *(f32x4*)p = acc[ai][0][m][0] * (WSCALE * rs[ai][m]); *(f32x4*)(p + 4) = acc[ai][0][m][1] * (WSCALE * rs[ai][m]); }
            }
        }
    }
};
DEV f32x4 sigm4(const f32x4 v) { f32x4 o;
#pragma unroll
    for (int i = 0; i < 4; ++i) o[i] = __builtin_amdgcn_rcpf(1.f + __builtin_amdgcn_exp2f(-LOG2E * v[i])); return o; }
struct EpiGates {
    typedef PreRs Pre;
    DEV void prefetch(PreRs& p, const Unit& u, int wr, int fr) const { pre_rs(p, ss, u.pm * BM + wr * 64 + fr); }
    static constexpr bool PERM = true, AFTER_DRAIN = false;
    bf16_t* G; const u64* ss;
    DEV void operator()(const Acc& acc, const Unit& u, int wr, int wc, int fr, int fq, const PreRs& pre) const {
        EPI_ROWS(u); float rs[2][4]; rs_of(rs, pre); bf16_t* base = G + (size_t)(u.pn >> 2) * T * D + (u.pn & 3) * 256 + wc * 32 + 8 * fq;
#pragma unroll
        for (int ai = 0; ai < 2; ++ai)
#pragma unroll
            for (int m = 0; m < 4; ++m) { bf16_t* rowp = base + (size_t)(row0 + ai * HALF + m * 16) * D;
#pragma unroll
                for (int bj = 0; bj < 2; ++bj) *(u32x4*)(rowp + bj * HALF) = pack8(sigm4(acc[ai][bj][m][0] * rs[ai][m]), sigm4(acc[ai][bj][m][1] * rs[ai][m])); }
    }
};
struct EpiMerge {
    typedef PreNone Pre;
    DEV void prefetch(PreNone&, const Unit&, int, int) const {}
    static constexpr bool PERM = true, AFTER_DRAIN = false;
    bf16_t* M; const bf16_t* G;
    DEV void operator()(const Acc& acc, const Unit& u, int wr, int wc, int fr, int fq, const PreNone&) const {
        EPI_ROWS(u); const size_t cofs = (size_t)u.pn * 256 + wc * 32 + 8 * fq; const bf16_t* gb = G + (size_t)u.job * T * D;
#pragma unroll
        for (int ai = 0; ai < 2; ++ai)
#pragma unroll
            for (int m = 0; m < 4; ++m) { const size_t ro = (size_t)(row0 + ai * HALF + m * 16) * D + cofs;
#pragma unroll
                for (int bj = 0; bj < 2; ++bj) { const size_t o = ro + bj * HALF; const u32x4 g = *(const u32x4*)(gb + o);
                    f32x4 v0 = acc[ai][bj][m][0], v1 = acc[ai][bj][m][1];
                    v0[0] *= bflo(g.x); v0[1] *= bfhi(g.x); v0[2] *= bflo(g.y); v0[3] *= bfhi(g.y); v1[0] *= bflo(g.z); v1[1] *= bfhi(g.z); v1[2] *= bflo(g.w); v1[3] *= bfhi(g.w);
                    if (u.job > 0) { const u32x4 p = __builtin_nontemporal_load((const u32x4*)(M + o));
                        v0[0] += bflo(p.x); v0[1] += bfhi(p.x); v0[2] += bflo(p.y); v0[3] += bfhi(p.y); v1[0] += bflo(p.z); v1[1] += bfhi(p.z); v1[2] += bflo(p.w); v1[3] += bfhi(p.w); }
                    *(u32x4*)(M + o) = pack8(v0, v1); } }
    }
};
template <bool IN_F32> struct EpiResid {
    typedef PreNone Pre;
    DEV void prefetch(PreNone&, const Unit&, int, int) const {}
    static constexpr bool PERM = true, AFTER_DRAIN = false;
    const void* xin; bf16_t* xb; u64* ss;
    DEV void operator()(const Acc& acc, const Unit& u, int wr, int wc, int fr, int fq, const PreNone&) const {
        EPI_ROWS(u); const size_t cofs = (size_t)u.pn * 256 + wc * 32 + 8 * fq;
#pragma unroll
        for (int ai = 0; ai < 2; ++ai)
#pragma unroll
            for (int m = 0; m < 4; ++m) { const size_t ro = (size_t)(row0 + ai * HALF + m * 16) * D + cofs; float sq = 0.f;
#pragma unroll
                for (int bj = 0; bj < 2; ++bj) { const size_t o = ro + bj * HALF; f32x4 v0 = acc[ai][bj][m][0], v1 = acc[ai][bj][m][1];
                    if (IN_F32) { v0 = v0 + *(const f32x4*)((const float*)xin + o); v1 = v1 + *(const f32x4*)((const float*)xin + o + 4); }
                    else { const u32x4 p = *(const u32x4*)((const bf16_t*)xin + o);
                        v0[0] += bflo(p.x); v0[1] += bfhi(p.x); v0[2] += bflo(p.y); v0[3] += bfhi(p.y); v1[0] += bflo(p.z); v1[1] += bfhi(p.z); v1[2] += bflo(p.w); v1[3] += bfhi(p.w); }
                    *(u32x4*)(xb + o) = pack8(v0, v1);
                    sq += ((v0[0] * v0[0] + v0[1] * v0[1]) + (v0[2] * v0[2] + v0[3] * v0[3])) + ((v1[0] * v1[0] + v1[1] * v1[1]) + (v1[2] * v1[2] + v1[3] * v1[3])); }
                sq += __shfl_xor(sq, 16); sq += __shfl_xor(sq, 32);
                if (fq == 0) atomicAdd(ss + row0 + ai * HALF + m * 16, (u64)(sq * SS_SCALE + 0.5f)); }
    }
};
struct EpiUp {
    typedef PreRs Pre;
    DEV void prefetch(PreRs& p, const Unit& u, int wr, int fr) const { pre_rs(p, ss, u.pm * BM + wr * 64 + fr); }
    static constexpr bool PERM = true, AFTER_DRAIN = false;
    bf16_t *fa, *fu; const u64* ss;
    DEV void operator()(const Acc& acc, const Unit& u, int wr, int wc, int fr, int fq, const PreRs& pre) const {
        EPI_ROWS(u); float rs[2][4]; rs_of(rs, pre); const size_t cofs = (size_t)u.pn * 128 + wc * 32 + 8 * fq;
#pragma unroll
        for (int ai = 0; ai < 2; ++ai)
#pragma unroll
            for (int m = 0; m < 4; ++m) { const size_t o = (size_t)(row0 + ai * HALF + m * 16) * DFF + cofs;
                *(u32x4*)(fa + o) = pack8(acc[ai][0][m][0] * rs[ai][m], acc[ai][0][m][1] * rs[ai][m]); *(u32x4*)(fu + o) = pack8(acc[ai][1][m][0] * rs[ai][m], acc[ai][1][m][1] * rs[ai][m]); }
    }
};
struct EpiPrep {
    typedef PreNone Pre;
    DEV void prefetch(PreNone&, const Unit&, int, int) const {}
    static constexpr bool PERM = true, AFTER_DRAIN = false;
    unsigned char* ws; int mode;
    DEV void operator()(const Acc& acc, const Unit& u, int wr, int wc, int fr, int fq, const PreNone&) const {
        EPI_ROWS(u); bf16_t* base; int ldc; float sc = 1.f;
        if (mode == 0) { base = (bf16_t*)(ws + WS_KVM + (size_t)u.job * 2 * MiB); ldc = 2 * D; }
        else if (mode == 1) { base = (bf16_t*)(ws + WS_GT + (size_t)(u.job >> 2) * 2 * MiB) + (size_t)(u.job & 3) * 256 * D; ldc = D; sc = XSCALE; }
        else { base = (bf16_t*)(ws + WS_HT + (size_t)(u.job >> 2) * 2 * MiB) + (u.job & 3) * 256; ldc = D; }
        base += (size_t)u.pn * 256 + wc * 32 + 8 * fq;
#pragma unroll
        for (int ai = 0; ai < 2; ++ai)
#pragma unroll
            for (int m = 0; m < 4; ++m) { bf16_t* rowp = base + (size_t)(row0 + ai * HALF + m * 16) * ldc;
#pragma unroll
                for (int bj = 0; bj < 2; ++bj) *(u32x4*)(rowp + bj * HALF) = pack8(acc[ai][bj][m][0] * sc, acc[ai][bj][m][1] * sc); }
    }
};
struct EpiSoftmax {
    typedef PreRs Pre;
    DEV void prefetch(PreRs& p, const Unit& u, int wr, int fr) const { pre_rs(p, ss, u.pm * BM + wr * 64 + fr); }
    static constexpr bool PERM = true, AFTER_DRAIN = true;
    bf16_t* P; const u64* ss;
    DEV void fused(Acc& acc, const Unit& u, int wr, int wc, int fr, int fq, LAS unsigned char* lds, int wid, int lane, const PreRs& pre) const {
        LAS float* PM = (LAS float*)lds; LAS float* PS = (LAS float*)(lds + 4096);
        { const int row0_ = u.pm * BM + wr * 64 + fr; float rs[2][4]; rs_of(rs, pre);
#pragma unroll
          for (int ai = 0; ai < 2; ++ai)
#pragma unroll
              for (int m = 0; m < 4; ++m)
#pragma unroll
                  for (int bj = 0; bj < 2; ++bj)
#pragma unroll
                      for (int n = 0; n < 2; ++n) acc[ai][bj][m][n] = acc[ai][bj][m][n] * rs[ai][m]; }
#pragma unroll
        for (int ai = 0; ai < 2; ++ai)
#pragma unroll
            for (int m = 0; m < 4; ++m) { float mx = -INFINITY;
#pragma unroll
                for (int bj = 0; bj < 2; ++bj)
#pragma unroll
                    for (int n = 0; n < 2; ++n) { const f32x4 x = acc[ai][bj][m][n]; mx = fmaxf(mx, fmaxf(fmaxf(x[0], x[1]), fmaxf(x[2], x[3]))); }
                mx = fmaxf(mx, __shfl_xor(mx, 16)); mx = fmaxf(mx, __shfl_xor(mx, 32));
                if (fq == 0) PM[(ai * HALF + wr * 64 + m * 16 + fr) * 4 + wc] = mx; }
        LDS_WAIT(); __builtin_amdgcn_s_barrier(); asm volatile("" ::: "memory");
#pragma unroll
        for (int ai = 0; ai < 2; ++ai)
#pragma unroll
            for (int m = 0; m < 4; ++m) { const int r = ai * HALF + wr * 64 + m * 16 + fr; const f32x4 q = *(const LAS f32x4*)(PM + r * 4);
                const float mx = fmaxf(fmaxf(q[0], q[1]), fmaxf(q[2], q[3])); float s = 0.f;
#pragma unroll
                for (int bj = 0; bj < 2; ++bj)
#pragma unroll
                    for (int n = 0; n < 2; ++n) { f32x4 x = acc[ai][bj][m][n];
#pragma unroll
                        for (int i = 0; i < 4; ++i) { x[i] = __builtin_amdgcn_exp2f(x[i] - mx); s += x[i]; } acc[ai][bj][m][n] = x; }
                s += __shfl_xor(s, 16); s += __shfl_xor(s, 32);
                if (fq == 0) PS[r * 4 + wc] = s; }
        LDS_WAIT(); __builtin_amdgcn_s_barrier(); asm volatile("" ::: "memory");
        EPI_ROWS(u); bf16_t* base = P + (size_t)u.pn * 256 + wc * 32 + 8 * fq;
#pragma unroll
        for (int ai = 0; ai < 2; ++ai)
#pragma unroll
            for (int m = 0; m < 4; ++m) { const int r = ai * HALF + wr * 64 + m * 16 + fr; const f32x4 q = *(const LAS f32x4*)(PS + r * 4);
                const float inv = 1.f / ((q[0] + q[1]) + (q[2] + q[3])); bf16_t* rowp = base + (size_t)(row0 + ai * HALF + m * 16) * D;
#pragma unroll
                for (int bj = 0; bj < 2; ++bj) *(u32x4*)(rowp + bj * HALF) = pack8(acc[ai][bj][m][0] * inv, acc[ai][bj][m][1] * inv); }
        LDS_WAIT(); __builtin_amdgcn_s_barrier();
    }
};
}

typedef GAS unsigned gu32;
#define XB_TMO      128
#define XB_XCNT(j)  (256  + 64 * (j))
#define XB_XSUB(j)  (1280 + 64 * (j))
#define XB_XGEN(j)  (2304 + 64 * (j))
#define XB_TOP      3328
#define XB_TOPGEN   3392
#define XCD_BAR_WORDS 3456
#define XB_SPIN_CAP (1u << 22)
DEV unsigned xb_ld(unsigned* p) { return __hip_atomic_load(p, __ATOMIC_RELAXED, __HIP_MEMORY_SCOPE_AGENT); }
DEV unsigned xb_add(unsigned* p, unsigned v) { return __hip_atomic_fetch_add(p, v, __ATOMIC_RELAXED, __HIP_MEMORY_SCOPE_AGENT); }
DEV unsigned xb_xcc_id() { return (unsigned)__builtin_amdgcn_s_getreg((3 << 11) | 20) & 0xFu; }
#define XB_SPIN(cond, bar) do { unsigned _sp = 0; while (cond) { __builtin_amdgcn_s_sleep(1); \
    if ((++_sp & 255u) == 0u) { if (xb_ld(&(bar)[XB_TMO])) break; if (_sp > XB_SPIN_CAP) { atomicAdd(&(bar)[XB_TMO], 1u); break; } } } } while (0)
struct XcdBarrier { unsigned* bar; unsigned x; volatile LAS unsigned* st; };
DEV XcdBarrier xcd_barrier_post(unsigned* bar, volatile LAS unsigned* st) {
    XcdBarrier b; b.bar = bar; b.x = xb_xcc_id(); b.st = st;
    if (threadIdx.x == 0) (void)xb_add(&bar[XB_XCNT(b.x)], 1u);
    return b;
}
DEV void xcd_barrier_complete(unsigned* bar, unsigned x, unsigned& nloc, unsigned& nx) {
    const unsigned G = gridDim.x * gridDim.y * gridDim.z;
    unsigned sum, cnt, mine, sp = 0u;
    for (;;) {
        sum = 0u; cnt = 0u; mine = 0u;
#pragma unroll
        for (unsigned j = 0; j < 16; ++j) { const unsigned c = xb_ld(&bar[XB_XCNT(j)]); sum += c; cnt += (c > 0u) ? 1u : 0u; mine = (j == x) ? c : mine; }
        if (sum == G) break;
        __builtin_amdgcn_s_sleep(1);
        if ((++sp & 255u) == 0u) { if (xb_ld(&bar[XB_TMO])) break; if (sp > XB_SPIN_CAP) { atomicAdd(&bar[XB_TMO], 1u); break; } }
    }
    nloc = mine > 0u ? mine : 1u; nx = cnt > 0u ? cnt : 1u;
}
DEV void xcd_barrier(const XcdBarrier& b) {
    asm volatile("s_waitcnt vmcnt(0)" ::: "memory");
    __syncthreads();
    if (threadIdx.x == 0) {
        unsigned* bar = b.bar;
        __builtin_amdgcn_s_waitcnt(0);
        unsigned nloc = b.st[0], nx = b.st[1];
        if (nloc == 0u) { xcd_barrier_complete(bar, b.x, nloc, nx); b.st[0] = nloc; b.st[1] = nx; }
        const unsigned old = xb_add(&bar[XB_XSUB(b.x)], 1u);
        const unsigned gen = old / nloc;
        if (old + 1u == (gen + 1u) * nloc) {
            __builtin_amdgcn_fence(__ATOMIC_RELEASE, "agent");
            asm volatile("s_waitcnt vmcnt(0)" ::: "memory");
            const unsigned og = xb_add(&bar[XB_TOP], 1u);
            const unsigned tg = og / nx;
            if (og + 1u == (tg + 1u) * nx) xb_add(&bar[XB_TOPGEN], 1u);
            else XB_SPIN(xb_ld(&bar[XB_TOPGEN]) == tg, bar);
            __builtin_amdgcn_fence(__ATOMIC_ACQUIRE, "agent");
            xb_add(&bar[XB_XGEN(b.x)], 1u);
            asm volatile("s_waitcnt vmcnt(0)" ::: "memory");
        } else {
            XB_SPIN(xb_ld(&bar[XB_XGEN(b.x)]) == gen, bar);
            __builtin_amdgcn_fence(__ATOMIC_ACQUIRE, "agent");
            asm volatile("s_waitcnt vmcnt(0)" ::: "memory");
        }
    }
    __syncthreads();
}


struct WaveId { int gw, ngw, wave, lane; };
DEV unsigned f2bf_u(float f) { return (unsigned)f2bf(f); }
DEV unsigned pk2(float lo, float hi) { return cvt_pk_bf16(lo, hi); }

DEV void norm_rows(const WaveId& W, const float* x, const float* g, bf16_t* outb, float* outf, int rows) {
    for (int row = W.gw; row < rows; row += W.ngw) {
        const f32x4* xr = (const f32x4*)(x + (size_t)row * D) + W.lane;
        f32x4 v[4]; float s = 0.f;
#pragma unroll
        for (int j = 0; j < 4; ++j) { v[j] = xr[64 * j]; s += (v[j].x * v[j].x + v[j].y * v[j].y) + (v[j].z * v[j].z + v[j].w * v[j].w); }
        const float r = rsqrtf(wave_sum(s) * (1.f / D) + EPS);
#pragma unroll
        for (int j = 0; j < 4; ++j) {
            const f32x4 gg = ((const f32x4*)g)[W.lane + 64 * j];
            const f32x4 o = {v[j].x * r * gg.x, v[j].y * r * gg.y, v[j].z * r * gg.z, v[j].w * r * gg.w};
            if (outb) { u32x2 w; w.x = pk2(o.x, o.y); w.y = pk2(o.z, o.w); ((u32x2*)(outb + (size_t)row * D))[W.lane + 64 * j] = w; }
            else ((f32x4*)(outf + (size_t)row * D))[W.lane + 64 * j] = o;
        }
    }
}
DEV void cvt_piece(const WaveId& W, LAS float* scr, int& base, const float* Wsrc, int ldw, int K, int col0, int ncols, bf16_t* dst, int ldo, int row0, const float* gain = nullptr) {
    const int nblk = ncols / 32, nitems = (K / 64) * nblk;
    int first = (W.gw - base) % W.ngw; if (first < 0) first += W.ngw;
    base = (base + nitems) % W.ngw;
    for (int item = first; item < nitems; item += W.ngw) {
        const int kb = item / nblk, nb = item - kb * nblk, k0 = 64 * kb, n0 = 32 * nb;
#pragma unroll 8
        for (int i = 0; i < 32; ++i) { const int kk = 2 * i + (W.lane >> 5); scr[kk * 33 + (W.lane & 31)] = Wsrc[(size_t)(k0 + kk) * ldw + col0 + n0 + (W.lane & 31)] * (gain ? gain[k0 + kk] : 1.f); }
        LDS_WAIT(); asm volatile("" ::: "memory");
        const int c = W.lane & 7;
#pragma unroll
        for (int j = 0; j < 4; ++j) { const int n = (W.lane >> 3) + 8 * j; const LAS float* s = scr + (8 * c) * 33 + n;
            u32x4 o; o.x = pk2(s[0 * 33], s[1 * 33]); o.y = pk2(s[2 * 33], s[3 * 33]); o.z = pk2(s[4 * 33], s[5 * 33]); o.w = pk2(s[6 * 33], s[7 * 33]);
            *(u32x4*)(dst + (size_t)(row0 + n0 + n) * ldo + k0 + 8 * c) = o; }
        LDS_WAIT(); asm volatile("" ::: "memory");
    }
}
DEV void convert_layer_weights(const WaveId& W, LAS float* scr, int& base, unsigned char* ws, const float* const* in, int l) {
    const float* wi = in[3] + (size_t)l * D * DIN;
    bf16_t* WIN = (bf16_t*)(ws + WS_WIN); const float* gm = in[2] + l * D; const float* gf = in[14] + l * D;
    cvt_piece(W, scr, base, wi, DIN, D, 0, 1536, WIN, D, 0, gm);
    cvt_piece(W, scr, base, wi, DIN, D, 3072, 1536, WIN, D, 1536, gm);
    cvt_piece(W, scr, base, wi, DIN, D, 4608, 512, WIN, D, 3072, gm);
    cvt_piece(W, scr, base, wi, DIN, D, 1536, 512, WIN, D, 3584, gm);
#pragma unroll 1
    for (int j = 0; j < 4; ++j) { cvt_piece(W, scr, base, wi, DIN, D, 2048 + 128 * j, 128, WIN, D, 4096 + 256 * j, gm); cvt_piece(W, scr, base, wi, DIN, D, 2560 + 128 * j, 128, WIN, D, 4096 + 256 * j + 128, gm); }
    cvt_piece(W, scr, base, wi, DIN, D, 5120, 96, WIN, D, 5120, gm);
    cvt_piece(W, scr, base, wi, DIN, D, 5192, 3072, (bf16_t*)(ws + WS_WG), D, 0, gm);
#pragma unroll 1
    for (int i = 0; i < 3; ++i) cvt_piece(W, scr, base, in[5 + i] + (size_t)l * 512 * D, D, 512, 0, D, (bf16_t*)(ws + WS_WBR) + (size_t)i * D * 512, 512, 0);
    cvt_piece(W, scr, base, in[8] + (size_t)l * D * D, D, D, 0, D, (bf16_t*)(ws + WS_WMIX), D, 0);
    const float* wf = in[15] + (size_t)l * D * 2 * DFF;
#pragma unroll 1
    for (int j = 0; j < 22; ++j) { cvt_piece(W, scr, base, wf, 2 * DFF, D, 128 * j, 128, (bf16_t*)(ws + WS_WUP), D, 256 * j, gf); cvt_piece(W, scr, base, wf, 2 * DFF, D, DFF + 128 * j, 128, (bf16_t*)(ws + WS_WUP), D, 256 * j + 128, gf); }
    cvt_piece(W, scr, base, in[18] + (size_t)l * DFF * D, D, DFF, 0, D, (bf16_t*)(ws + WS_WDOWN), DFF, 0);
}
DEV void prep0_phase(const WaveId& W, LAS float* scr, unsigned char* ws, const float* const* in, bf16_t* XB) {
    int base = 0;
#pragma unroll 1
    for (int l = 0; l < DEPTH; ++l) {
        const float* wq = in[11] + (size_t)l * D * D; bf16_t* WQ = (bf16_t*)(ws + WS_WQ + (size_t)l * 2 * MiB); const float* gx = in[9] + l * D;
        for (size_t i = (size_t)(W.gw * 64 + W.lane) * 4; i < (size_t)D * D; i += (size_t)W.ngw * 256) { const float g = gx[i >> 10]; const f32x4 v = *(const f32x4*)(wq + i); u32x2 o; o.x = pk2(v.x * g, v.y * g); o.y = pk2(v.z * g, v.w * g); *(u32x2*)(WQ + i) = o; }
        cvt_piece(W, scr, base, in[13] + (size_t)l * D * D, D, D, 0, D, (bf16_t*)(ws + WS_WOT + (size_t)l * 2 * MiB), D, 0);
        cvt_piece(W, scr, base, in[12] + (size_t)l * D * 2 * D, 2 * D, D, 0, 2 * D, (bf16_t*)(ws + WS_WKVT + (size_t)l * 4 * MiB), D, 0);
        norm_rows(W, in[1], in[10] + l * D, (bf16_t*)(ws + WS_MEMN + (size_t)l * MiB), nullptr, NB * MEM);
    }
    convert_layer_weights(W, scr, base, ws, in, 0);
    pg8::u64* ss0 = (pg8::u64*)(ws + WS_SS);
    for (int row = W.gw; row < T; row += W.ngw) {
        const f32x4* xr = (const f32x4*)(in[0] + (size_t)row * D) + W.lane; float s = 0.f;
#pragma unroll
        for (int j = 0; j < 4; ++j) { const f32x4 v = xr[64 * j]; s += (v.x * v.x + v.y * v.y) + (v.z * v.z + v.w * v.w);
            u32x2 w; w.x = pk2(v.x, v.y); w.y = pk2(v.z, v.w); ((u32x2*)(XB + (size_t)row * D))[W.lane + 64 * j] = w; }
        s = wave_sum(s); if (W.lane == 0) ss0[row] = (pg8::u64)(s * pg8::SS_SCALE + 0.5f);
    }
}
DEV void final_norm(const WaveId& W, const bf16_t* x, float* out, const float* g, const pg8::u64* ss) {
    for (int row = W.gw; row < T; row += W.ngw) {
        const float r = rsqrtf((float)ss[row] * (1.f / (pg8::SS_SCALE * D)) + EPS); const u32x2* xr = (const u32x2*)(x + (size_t)row * D) + W.lane; f32x4* orow = (f32x4*)(out + (size_t)row * D) + W.lane;
#pragma unroll
        for (int j = 0; j < 4; ++j) { const f32x4 gg = ((const f32x4*)g)[W.lane + 64 * j]; const u32x2 v = xr[64 * j];
            const f32x4 o = {bflo(v.x) * r * gg.x, bfhi(v.x) * r * gg.y, bflo(v.y) * r * gg.z, bfhi(v.y) * r * gg.w}; orow[64 * j] = o; }
    }
}
DEV void conv_sc_phase(int gtid, int gthreads, bf16_t* scb, const bf16_t* cx, const float* w, bool dry) {
    for (int i = gtid; i < T * 64; i += gthreads) {
        const int c8 = (i & 63) * 8, t = i >> 6, tl = t & (S - 1);
        const size_t o = (size_t)t * 512 + c8;
        const u32x4 z = {0u, 0u, 0u, 0u};
        const u32x4 x2 = *(const u32x4*)(cx + o), x1 = tl >= 1 ? *(const u32x4*)(cx + o - 512) : z, x0 = tl >= 2 ? *(const u32x4*)(cx + o - 1024) : z, bb = *(const u32x4*)(scb + o);
        const f32x4 w0a = *(const f32x4*)(w + c8), w0b = *(const f32x4*)(w + c8 + 4), w1a = *(const f32x4*)(w + 512 + c8), w1b = *(const f32x4*)(w + 512 + c8 + 4), w2a = *(const f32x4*)(w + 1024 + c8), w2b = *(const f32x4*)(w + 1024 + c8 + 4);
        float r[8];
#define CONV1(k, W0, W1, W2, X0, X1, X2, BBv, F) r[k] = F(BBv) * (W0 * F(X0) + W1 * F(X1) + W2 * F(X2))
        CONV1(0, w0a.x, w1a.x, w2a.x, x0.x, x1.x, x2.x, bb.x, bflo); CONV1(1, w0a.y, w1a.y, w2a.y, x0.x, x1.x, x2.x, bb.x, bfhi);
        CONV1(2, w0a.z, w1a.z, w2a.z, x0.y, x1.y, x2.y, bb.y, bflo); CONV1(3, w0a.w, w1a.w, w2a.w, x0.y, x1.y, x2.y, bb.y, bfhi);
        CONV1(4, w0b.x, w1b.x, w2b.x, x0.z, x1.z, x2.z, bb.z, bflo); CONV1(5, w0b.y, w1b.y, w2b.y, x0.z, x1.z, x2.z, bb.z, bfhi);
        CONV1(6, w0b.z, w1b.z, w2b.z, x0.w, x1.w, x2.w, bb.w, bflo); CONV1(7, w0b.w, w1b.w, w2b.w, x0.w, x1.w, x2.w, bb.w, bfhi);
#undef CONV1
        u32x4 ov; ov.x = pk2(r[0], r[1]); ov.y = pk2(r[2], r[3]); ov.z = pk2(r[4], r[5]); ov.w = pk2(r[6], r[7]);
        if (!dry) *(u32x4*)(scb + o) = ov; else asm volatile("" :: "v"(ov));
    }
}
DEV float gelu_t(float a) { return a * __builtin_amdgcn_rcpf(1.f + __builtin_amdgcn_exp2f(-1.5957691216057308f * LOG2E * (a + 0.044715f * a * a * a))); }
DEV void ffn_mid_phase(int gtid, int gthreads, const bf16_t* fa, bf16_t* fu, const float* cw, const float* cb, bool dry) {
    constexpr int C8 = DFF / 8;
    for (int i = gtid; i < T * C8; i += gthreads) {
        const int t = i / C8, c8 = (i - t * C8) * 8, tl = t & (S - 1);
        const size_t o = (size_t)t * DFF + c8;
        const u32x4 z = {0u, 0u, 0u, 0u};
        const u32x4 x2 = *(const u32x4*)(fa + o), x1 = tl >= 1 ? *(const u32x4*)(fa + o - DFF) : z, x0 = tl >= 2 ? *(const u32x4*)(fa + o - 2 * DFF) : z, uu = *(const u32x4*)(fu + o);
        const f32x4 w0a = *(const f32x4*)(cw + c8), w0b = *(const f32x4*)(cw + c8 + 4), w1a = *(const f32x4*)(cw + DFF + c8), w1b = *(const f32x4*)(cw + DFF + c8 + 4), w2a = *(const f32x4*)(cw + 2 * DFF + c8), w2b = *(const f32x4*)(cw + 2 * DFF + c8 + 4);
        const f32x4 ba = *(const f32x4*)(cb + c8), bb = *(const f32x4*)(cb + c8 + 4);
        float r[8];
#define FM1(k, B0, W0, W1, W2, X0, X1, X2, Uv, F) r[k] = gelu_t(B0 + W0 * F(X0) + W1 * F(X1) + W2 * F(X2)) * F(Uv)
        FM1(0, ba.x, w0a.x, w1a.x, w2a.x, x0.x, x1.x, x2.x, uu.x, bflo); FM1(1, ba.y, w0a.y, w1a.y, w2a.y, x0.x, x1.x, x2.x, uu.x, bfhi);
        FM1(2, ba.z, w0a.z, w1a.z, w2a.z, x0.y, x1.y, x2.y, uu.y, bflo); FM1(3, ba.w, w0a.w, w1a.w, w2a.w, x0.y, x1.y, x2.y, uu.y, bfhi);
        FM1(4, bb.x, w0b.x, w1b.x, w2b.x, x0.z, x1.z, x2.z, uu.z, bflo); FM1(5, bb.y, w0b.y, w1b.y, w2b.y, x0.z, x1.z, x2.z, uu.z, bfhi);
        FM1(6, bb.z, w0b.z, w1b.z, w2b.z, x0.w, x1.w, x2.w, uu.w, bflo); FM1(7, bb.w, w0b.w, w1b.w, w2b.w, x0.w, x1.w, x2.w, uu.w, bfhi);
#undef FM1
        u32x4 ov; ov.x = pk2(r[0], r[1]); ov.y = pk2(r[2], r[3]); ov.z = pk2(r[4], r[5]); ov.w = pk2(r[6], r[7]);
        if (!dry) *(u32x4*)(fu + o) = ov; else asm volatile("" :: "v"(ov));
    }
}

typedef short s16x4 __attribute__((ext_vector_type(4)));
DEV s16x4 vtr(const LAS unsigned char* p) { return __builtin_bit_cast(s16x4, __builtin_amdgcn_ds_read_tr16_b64_v4i16((LAS s16x4*)p)); }
DEV bf16x8 cat8(const s16x4 a, const s16x4 b) { return (bf16x8){a[0], a[1], a[2], a[3], b[0], b[1], b[2], b[3]}; }
DEV bf16x8 pk8(float a0, float a1, float a2, float a3, float a4, float a5, float a6, float a7) {
    u32x4 w; w.x = pk2(a0, a1); w.y = pk2(a2, a3); w.z = pk2(a4, a5); w.w = pk2(a6, a7); return __builtin_bit_cast(bf16x8, w); }
constexpr int VPITCH = 192;
DEV void pv_tile(f32x16& o0, f32x16& o1, const LAS unsigned char* vt, int lane, const bf16x8 (&pk)[4]) {
    const int hi = lane >> 5;
    const LAS unsigned char* vb = vt + (4 * hi + ((lane & 15) >> 2)) * VPITCH + ((lane >> 4) & 1) * 32 + (lane & 3) * 8;
    bf16x8 va[4];
#pragma unroll
    for (int ks = 0; ks < 4; ++ks) va[ks] = cat8(vtr(vb + (16 * ks) * VPITCH), vtr(vb + (16 * ks + 8) * VPITCH));
    asm volatile("" : "+v"(va[0]), "+v"(va[1]), "+v"(va[2]), "+v"(va[3]));
#pragma unroll
    for (int ks = 0; ks < 4; ++ks) o0 = __builtin_amdgcn_mfma_f32_32x32x16_bf16(va[ks], pk[ks], o0, 0, 0, 0);
#pragma unroll
    for (int ks = 0; ks < 4; ++ks) va[ks] = cat8(vtr(vb + (16 * ks) * VPITCH + 64), vtr(vb + (16 * ks + 8) * VPITCH + 64));
    asm volatile("" : "+v"(va[0]), "+v"(va[1]), "+v"(va[2]), "+v"(va[3]));
#pragma unroll
    for (int ks = 0; ks < 4; ++ks) o1 = __builtin_amdgcn_mfma_f32_32x32x16_bf16(va[ks], pk[ks], o1, 0, 0, 0);
}
DEV void store_ot(bf16_t* orow, const f32x16& o0, const f32x16& o1, int hi, float sc) {
#pragma unroll
    for (int g4 = 0; g4 < 4; ++g4) {
        u32x2 a; a.x = pk2(o0[4 * g4] * sc, o0[4 * g4 + 1] * sc); a.y = pk2(o0[4 * g4 + 2] * sc, o0[4 * g4 + 3] * sc);
        u32x2 b; b.x = pk2(o1[4 * g4] * sc, o1[4 * g4 + 1] * sc); b.y = pk2(o1[4 * g4 + 2] * sc, o1[4 * g4 + 3] * sc);
        *(u32x2*)(orow + 8 * g4 + 4 * hi) = a; *(u32x2*)(orow + 32 + 8 * g4 + 4 * hi) = b;
    }
}

DEV void sb_item(LAS unsigned char* vl, const bf16_t* Q, const bf16_t* Kk, const bf16_t* V, bf16_t* O, int b, int h, int qb, int lane, bool dry) {
    const int r32 = lane & 31, hi = lane >> 5, t0 = 32 * qb, t = t0 + r32; const size_t rowb = (size_t)b * S;
    bf16x8 qr[4]; { const bf16_t* qp = Q + (rowb + t0 + r32) * 512 + h * 64 + 8 * hi;
#pragma unroll
        for (int d0 = 0; d0 < 4; ++d0) qr[d0] = *(const bf16x8*)(qp + 16 * d0); }
    f32x16 o0, o1;
#pragma unroll
    for (int r = 0; r < 16; ++r) { o0[r] = 0.f; o1[r] = 0.f; }
    float carry = 1.f;
    const int c_hi = (t0 + 30) >> 6;
#pragma unroll 1
    for (int c = c_hi; c >= 0; --c) {
        const bf16_t* kp = Kk + (rowb + 64 * c + r32) * 512 + h * 64 + 8 * hi;
        bf16x8 k0[4], k1[4];
#pragma unroll
        for (int d0 = 0; d0 < 4; ++d0) { k0[d0] = *(const bf16x8*)(kp + 16 * d0); k1[d0] = *(const bf16x8*)(kp + (size_t)32 * 512 + 16 * d0); }
#pragma unroll
        for (int j = 0; j < 8; ++j) { const int row = (lane >> 3) + 8 * j; *(LAS u32x4*)(vl + row * VPITCH + (lane & 7) * 16) = *(const u32x4*)(V + (rowb + 64 * c + row) * 512 + h * 64 + (lane & 7) * 8); }
        f32x16 p0, p1;
#pragma unroll
        for (int r = 0; r < 16; ++r) { p0[r] = 0.f; p1[r] = 0.f; }
#pragma unroll
        for (int d0 = 0; d0 < 4; ++d0) { p0 = __builtin_amdgcn_mfma_f32_32x32x16_bf16(k0[d0], qr[d0], p0, 0, 0, 0); p1 = __builtin_amdgcn_mfma_f32_32x32x16_bf16(k1[d0], qr[d0], p1, 0, 0, 0); }
        float u[32];
        const bool diag = (c == c_hi);
#pragma unroll
        for (int e = 0; e < 32; ++e) {
            const float z = e < 16 ? p0[e] : p1[e - 16];
            float uu = __builtin_amdgcn_rcpf(1.f + __builtin_amdgcn_exp2f(fminf(z, 126.f)));
            if (diag) { const int kv = 64 * c + 8 * ((e >> 2) & 3) + 4 * hi + (e & 3) + 32 * (e >> 4); if (kv >= t) uu = 1.f; }
            u[e] = uu;
        }
        float gl[8], gh[8];
#pragma unroll
        for (int i = 0; i < 8; ++i) { const float gp = (u[4 * i] * u[4 * i + 1]) * (u[4 * i + 2] * u[4 * i + 3]);
            const auto rr = __builtin_amdgcn_permlane32_swap(__float_as_uint(gp), __float_as_uint(gp), false, false); gl[i] = __uint_as_float(rr[0]); gh[i] = __uint_as_float(rr[1]); }
        float ag[8]; float run = carry;
#pragma unroll
        for (int i = 7; i >= 0; --i) { const float a_hi = run; run *= gh[i]; const float a_lo = run; run *= gl[i]; ag[i] = hi ? a_hi : a_lo; }
        carry = run;
        bf16x8 pk[4];
#pragma unroll
        for (int ks = 0; ks < 4; ++ks) { float w[8];
#pragma unroll
            for (int g = 0; g < 2; ++g) { const int i = 2 * ks + g;
                const float a3 = ag[i], a2 = a3 * u[4 * i + 3], a1 = a2 * u[4 * i + 2], a0 = a1 * u[4 * i + 1];
                w[4 * g] = (1.f - u[4 * i]) * a0; w[4 * g + 1] = (1.f - u[4 * i + 1]) * a1; w[4 * g + 2] = (1.f - u[4 * i + 2]) * a2; w[4 * g + 3] = (1.f - u[4 * i + 3]) * a3; }
            pk[ks] = pk8(w[0], w[1], w[2], w[3], w[4], w[5], w[6], w[7]); }
        pv_tile(o0, o1, vl, lane, pk);
        if (__all(carry < 7.8e-31f)) break;
    }
    if (!dry) store_ot(O + (rowb + t0 + r32) * 512 + h * 64, o0, o1, hi, 1.f); else asm volatile("" :: "v"(o0), "v"(o1));
}
DEV void sb_phase(const WaveId& W, LAS unsigned char* lds, unsigned char* ws, bool dry) {
    LAS unsigned char* vl = lds + W.wave * 12288;
    const bf16_t* Q = (const bf16_t*)(ws + WS_QA); const bf16_t* Kk = (const bf16_t*)(ws + WS_KA); const bf16_t* V = (const bf16_t*)(ws + WS_VA);
    constexpr int NITEM = NB * 8 * (S / 32);
    for (int it = W.gw; it < NITEM; it += W.ngw) {
        const int qb = it & 255, h = (it >> 8) & 7, b = it >> 11;
        sb_item(vl, Q, Kk, V, (bf16_t*)(ws + WS_QA), b, h, qb, W.lane, dry);
    }
}

constexpr int IDX_CTL_OFF = 131072 + 1024;
DEV unsigned fkey2(float v) { const int u = (int)__float_as_uint(v); return (unsigned)(u ^ ((u >> 31) | (int)0x80000000)); }
DEV float relu1(float x) { return __builtin_amdgcn_fmed3f(x, 0.f, 3.0e38f); }
DEV void idx_unit(LAS unsigned char* lds, const bf16_t* IQ, const bf16_t* IK, const float* IWp, unsigned* BM, int b, int t0, int wid, int lane, int mslot) {
    const int r32 = lane & 31, hh = lane >> 5; const size_t rowb = (size_t)b * S;
    bf16x8 afr[4]; { const int qi = 2 * (r32 >> 4) + ((r32 >> 2) & 1), head = (r32 & 3) + 4 * ((r32 >> 3) & 1);
        const bf16_t* ap = IQ + (rowb + t0 + qi) * 512 + head * 64 + 8 * hh;
#pragma unroll
        for (int ks = 0; ks < 4; ++ks) afr[ks] = *(const bf16x8*)(ap + 16 * ks); }
    float w[16];
#pragma unroll
    for (int r = 0; r < 16; ++r) w[r] = IWp[(rowb + t0 + 2 * (r >> 3) + hh) * 8 + (r & 7)];
    const int tmax = t0 + 3, jmax = tmax >> 5;
    LAS unsigned* SCO = (LAS unsigned*)lds;
    bf16x8 b0[4], b1[4], b2[4];
#pragma unroll
    for (int ks = 0; ks < 4; ++ks) { b0[ks] = afr[ks]; b1[ks] = afr[ks]; b2[ks] = afr[ks]; }
#define IDX_LOADB(dst, jj) do { const int jc_ = (jj) < jmax ? (jj) : jmax; const bf16_t* bp_ = IK + ((rowb >> 5) + jc_) * 2048 + (hh * 32 + r32) * 8; \
        _Pragma("unroll") for (int ks = 0; ks < 4; ++ks) dst[ks] = *(const bf16x8*)(bp_ + ks * 512); } while (0)
#define IDX_COMP(src, jj) do { f32x16 acc; _Pragma("unroll") for (int r = 0; r < 16; ++r) acc[r] = 0.f; \
        _Pragma("unroll") for (int ks = 0; ks < 4; ++ks) acc = __builtin_amdgcn_mfma_f32_32x32x16_bf16(afr[ks], src[ks], acc, 0, 0, 0); \
        float s0 = 0.f, s1 = 0.f; _Pragma("unroll") for (int hd = 0; hd < 8; ++hd) { s0 += w[hd] * relu1(acc[hd]); s1 += w[8 + hd] * relu1(acc[8 + hd]); } \
        unsigned k0_ = fkey2(s0), k1_ = fkey2(s1); const int key = 32 * (jj) + r32; \
        if ((jj) >= jmax) { k0_ = key <= t0 + hh ? k0_ : 0u; k1_ = key <= t0 + 2 + hh ? k1_ : 0u; }     \
        if ((jj) <= jmax) { SCO[hh * 8192 + key] = k0_; SCO[(2 + hh) * 8192 + key] = k1_; } } while (0)
#ifndef IDX_REP_MFMA
#define IDX_REP_MFMA 1
#endif
#ifndef IDX_REP_SEL
#define IDX_REP_SEL 1
#endif
#pragma unroll 1
    for (int rpm = 0; rpm < IDX_REP_MFMA; ++rpm) {
    IDX_LOADB(b0, wid); IDX_LOADB(b1, wid + 8);
#pragma unroll 1
    for (int j = wid; j <= jmax; j += 24) {
        IDX_LOADB(b2, j + 16); IDX_COMP(b0, j);
        IDX_LOADB(b0, j + 24); IDX_COMP(b1, j + 8);
        IDX_LOADB(b1, j + 32); IDX_COMP(b2, j + 16);
    }
    }
#undef IDX_LOADB
#undef IDX_COMP
    LAS unsigned* thr = (LAS unsigned*)(lds + IDX_CTL_OFF);
    if (wid == 0 && lane < 32) ((LAS unsigned*)(lds + IDX_CTL_OFF + 64))[lane] = 0u;
    LDS_WAIT(); __builtin_amdgcn_s_barrier(); asm volatile("" ::: "memory");
    {
        const int q = wid & 3, h = wid >> 2, n = t0 + q + 1;
        volatile LAS unsigned* xme = (volatile LAS unsigned*)(lds + IDX_CTL_OFF + 64) + (q * 2 + h) * 4;
        volatile LAS unsigned* xpa = (volatile LAS unsigned*)(lds + IDX_CTL_OFF + 64) + (q * 2 + (h ^ 1)) * 4;
        unsigned T_ = 1u;
        if (n > 256) {
            LAS unsigned* row = SCO + q * 8192 + lane;
            unsigned r[64];
#pragma unroll
            for (int il = 0; il < 64; ++il) r[il] = (2 * (2 * il + h) + hh <= jmax) ? row[64 * (2 * il + h)] : 0u;
            unsigned seq = 0u;
#define IDX_XCHG(val, out) do { ++seq; const int pb_ = (seq & 1u) * 2; if (lane == 0) { xme[pb_ + 1] = (val); xme[pb_] = seq; } \
                while (xpa[pb_] != seq) __builtin_amdgcn_s_sleep(0); (out) = xpa[pb_ + 1]; } while (0)
#define IDX_XCHG16(val, out) do { ++seq; const int pb_ = (seq & 1u) * 2; if (lane == 0) xme[pb_] = (seq << 16) | (val); unsigned w_; \
                while (((w_ = xpa[pb_]) >> 16) != (seq & 0xffffu)) __builtin_amdgcn_s_sleep(0); (out) = w_ & 0xffffu; } while (0)
#pragma unroll 1
            for (int rps = 0; rps < IDX_REP_SEL; ++rps) {
            unsigned mx = 0u;
#pragma unroll
            for (int il = 0; il < 64; ++il) mx = max(mx, r[il]);
#pragma unroll
            for (int o = 1; o < 64; o <<= 1) mx = max(mx, (unsigned)__shfl_xor((int)mx, o));
            { unsigned pm_; IDX_XCHG(mx, pm_); mx = max(mx, pm_); }
            unsigned lo_ = 1u, hi_ = mx + 1u, chi_ = 0u, xgt_ = 1u, xeq_ = 0u, mt_ = 0u; float glo_ = __log2f((float)n) - 8.f, ghi_ = -9.f; int side_ = 0; bool done_ = false;
#pragma unroll 1
            for (int pass = 0; pass < 2 && !done_; ++pass) {
                const unsigned wdt = hi_ - lo_;
                unsigned off;
                if (pass < 2) {
                    const unsigned mkey = hi_ - 1u; const unsigned tgt = pass == 0 ? mkey - (1u << 23) : mkey - (3u << 23);
                    const bool ok = pass == 0 ? (mkey > 0x81000000u) : (mkey > 0x82000000u && tgt > lo_ && tgt < hi_);
                    off = ok ? tgt - lo_ : wdt >> 1;
                } else if ((pass & 3) == 3) off = wdt >> 1;
                else off = (unsigned)(glo_ * __builtin_amdgcn_rcpf(glo_ - ghi_) * (float)wdt);
                off = off < 1u ? 1u : (off > wdt - 1u ? wdt - 1u : off);
                const unsigned cand = (unsigned)__builtin_amdgcn_readfirstlane((int)(lo_ + off));
                unsigned ca_ = 0, cb_ = 0; const unsigned candv = lo_ + off;
#define IDX_CNT4(A, B, C, Dd) asm volatile("v_cmp_ge_u32_e64 s[88:89], %2, %6\n\tv_cmp_ge_u32_e64 s[90:91], %3, %6\n\tv_cmp_ge_u32_e64 s[92:93], %4, %6\n\tv_cmp_ge_u32_e64 s[94:95], %5, %6\n\t" \
                    "v_addc_co_u32_e64 %0, s[88:89], %0, 0, s[88:89]\n\tv_addc_co_u32_e64 %1, s[90:91], %1, 0, s[90:91]\n\tv_addc_co_u32_e64 %0, s[92:93], %0, 0, s[92:93]\n\tv_addc_co_u32_e64 %1, s[94:95], %1, 0, s[94:95]" \
                    : "+v"(ca_), "+v"(cb_) : "v"(A), "v"(B), "v"(C), "v"(Dd), "v"(candv) : "s88", "s89", "s90", "s91", "s92", "s93", "s94", "s95")
#pragma unroll
                for (int il = 0; il < 64; il += 4) IDX_CNT4(r[il], r[il + 1], r[il + 2], r[il + 3]);
#undef IDX_CNT4
                int pk = (int)(ca_ + cb_);
                pk += __builtin_amdgcn_update_dpp(0, pk, 0x111, 0xf, 0xf, false);
                pk += __builtin_amdgcn_update_dpp(0, pk, 0x112, 0xf, 0xf, false);
                pk += __builtin_amdgcn_update_dpp(0, pk, 0x114, 0xf, 0xf, false);
                pk += __builtin_amdgcn_update_dpp(0, pk, 0x118, 0xf, 0xf, false);
                pk += __builtin_amdgcn_update_dpp(0, pk, 0x142, 0xa, 0xf, false);
                unsigned tot = (unsigned)__builtin_amdgcn_readlane(pk, 31) + (unsigned)__builtin_amdgcn_readlane(pk, 63);
                { unsigned pt_; IDX_XCHG16(tot, pt_); tot += pt_; }
                const float gc = __log2f(fmaxf((float)tot, 0.5f)) - 8.f;
                if (tot == 256u) { xgt_ = cand; mt_ = 0u; done_ = true; }
                else { if (tot > 256u) { if (side_ == 1) ghi_ *= 0.5f; lo_ = cand; glo_ = gc; side_ = 1; }
                       else { if (side_ == 2) glo_ *= 0.5f; hi_ = cand; ghi_ = gc; chi_ = tot; side_ = 2; }
                       if (hi_ - lo_ == 1u) { xgt_ = hi_; xeq_ = lo_; mt_ = 256u - chi_; done_ = true; } }
            }
            { LAS unsigned* hist = (LAS unsigned*)(lds + IDX_CTL_OFF + 1024) + q * 256;
#pragma unroll 1
              for (int round = 0; round < 6 && !done_; ++round) {
                const unsigned wdt = hi_ - lo_;
                const int sh = wdt <= 256u ? 0 : 24 - (int)__builtin_clz(wdt - 1u);
                hist[128 * h + lane] = 0u; hist[128 * h + 64 + lane] = 0u;
                LDS_WAIT(); { unsigned d_; IDX_XCHG16(0u, d_); (void)d_; }
                const unsigned lov = lo_;
#pragma unroll
                for (int il = 0; il < 64; ++il) { const unsigned d = r[il] - lov; if (d < wdt) __hip_atomic_fetch_add(hist + (d >> sh), 1u, __ATOMIC_RELAXED, __HIP_MEMORY_SCOPE_WORKGROUP); }
                LDS_WAIT(); { unsigned d_; IDX_XCHG16(0u, d_); (void)d_; }
                const u32x4 hb = *(const LAS u32x4*)(hist + 4 * lane);
                const unsigned s4 = (hb.x + hb.y) + (hb.z + hb.w);
                unsigned suf = s4;
#pragma unroll
                for (int o = 1; o < 64; o <<= 1) { const unsigned tv = (unsigned)__shfl_down((int)suf, o); if (lane + o < 64) suf += tv; }
                const unsigned long long okm = __ballot(chi_ + suf >= 256u);
                const int L = 63 - (int)__builtin_clzll(okm);
                const unsigned above = chi_ + (unsigned)__builtin_amdgcn_readlane((int)(suf - s4), L);
                const unsigned h0 = (unsigned)__builtin_amdgcn_readlane((int)hb.x, L), h1 = (unsigned)__builtin_amdgcn_readlane((int)hb.y, L),
                               h2 = (unsigned)__builtin_amdgcn_readlane((int)hb.z, L), h3 = (unsigned)__builtin_amdgcn_readlane((int)hb.w, L);
                unsigned Bsel, cab, cnb;
                if (above + h3 >= 256u) { Bsel = 3u; cab = above; cnb = h3; }
                else if (above + h3 + h2 >= 256u) { Bsel = 2u; cab = above + h3; cnb = h2; }
                else if (above + h3 + h2 + h1 >= 256u) { Bsel = 1u; cab = above + h3 + h2; cnb = h1; }
                else { Bsel = 0u; cab = above + h3 + h2 + h1; cnb = h0; }
                Bsel += 4u * (unsigned)L;
                const unsigned nlo = lo_ + (Bsel << sh); unsigned nhi = nlo + (1u << sh); if (nhi > hi_ || nhi < nlo) nhi = hi_;
                if (cab + cnb == 256u) { xgt_ = nlo; mt_ = 0u; done_ = true; }
                else if (sh == 0) { xgt_ = nlo + 1u; xeq_ = nlo; mt_ = 256u - cab; done_ = true; }
                else { lo_ = nlo; hi_ = nhi; chi_ = cab; }
              } }
#ifdef IDX_XTRA
#pragma unroll 1
            for (int xr = 0; xr < IDX_XTRA; ++xr) { unsigned dsum = 0; const unsigned cv = xgt_ + (unsigned)xr;
#pragma unroll
                for (int il = 0; il < 64; ++il) dsum += r[il] >= cv;
                int pk = (int)dsum;
                pk += __builtin_amdgcn_update_dpp(0, pk, 0x111, 0xf, 0xf, false); pk += __builtin_amdgcn_update_dpp(0, pk, 0x112, 0xf, 0xf, false); pk += __builtin_amdgcn_update_dpp(0, pk, 0x114, 0xf, 0xf, false);
                pk += __builtin_amdgcn_update_dpp(0, pk, 0x118, 0xf, 0xf, false); pk += __builtin_amdgcn_update_dpp(0, pk, 0x142, 0xa, 0xf, false);
                unsigned tot = (unsigned)__builtin_amdgcn_readlane(pk, 31) + (unsigned)__builtin_amdgcn_readlane(pk, 63);
                { unsigned pt_; IDX_XCHG16(tot, pt_); tot += pt_; } asm volatile("" :: "s"(tot)); }
#endif
            T_ = xgt_;
            if (mt_ != 0u) {
                if (h == 0) { unsigned run = 0u;
#pragma unroll 1
                    for (int i = 0; i <= (jmax >> 1); ++i) { const bool ok_ = 2 * i + hh <= jmax; const unsigned kv = ok_ ? row[64 * i] : 0u; const bool eq = kv == xeq_; const unsigned long long bm = __ballot(eq);
                        const unsigned rank = run + __builtin_amdgcn_mbcnt_hi((unsigned)(bm >> 32), __builtin_amdgcn_mbcnt_lo((unsigned)bm, 0u));
                        if (eq && rank >= mt_) row[64 * i] = 0u;
                        run += (unsigned)__popcll(bm); } }
                T_ = xeq_;
            }
            }
#undef IDX_XCHG
#undef IDX_XCHG16
        }
        if (lane == 0 && h == 0) thr[q] = T_;
    }
#ifdef PROBE_VALU
    { float a0 = (float)lane, a1 = a0 + 1.f, a2 = a0 + 2.f, a3 = a0 + 3.f, a4 = a0 + 4.f, a5 = a0 + 5.f, a6 = a0 + 6.f, a7 = a0 + 7.f; const float m = 1.0000001f, c = 1e-9f;
#pragma unroll 1
      for (int it = 0; it < 64; ++it) {
#pragma unroll
          for (int u = 0; u < 8; ++u) { a0 = a0 * m + c; a1 = a1 * m + c; a2 = a2 * m + c; a3 = a3 * m + c; a4 = a4 * m + c; a5 = a5 * m + c; a6 = a6 * m + c; a7 = a7 * m + c; } }
      asm volatile("" :: "v"(a0), "v"(a1), "v"(a2), "v"(a3), "v"(a4), "v"(a5), "v"(a6), "v"(a7)); }
#endif
    LDS_WAIT(); __builtin_amdgcn_s_barrier(); asm volatile("" ::: "memory");
    { const unsigned tq0 = thr[hh], tq1 = thr[2 + hh];
#pragma unroll 4
      for (int j = wid; j < 256; j += 8) {
          bool s0 = false, s1 = false;
          if (j <= jmax) { s0 = SCO[hh * 8192 + 32 * j + r32] >= tq0; s1 = SCO[(2 + hh) * 8192 + 32 * j + r32] >= tq1; }
          const unsigned long long b0_ = __ballot(s0), b1_ = __ballot(s1);
          if (lane == 0) { u32x4 o; o.x = (unsigned)b0_; o.y = (unsigned)(b0_ >> 32); o.z = (unsigned)b1_; o.w = (unsigned)(b1_ >> 32); *(u32x4*)(BM + ((size_t)b * 256 + j) * S + t0) = o; }
      } }
    LDS_WAIT(); __builtin_amdgcn_s_barrier();
}
DEV void idx_phase(LAS unsigned char* lds, unsigned char* ws, int vcu, int G, int wid, int lane) {
    constexpr int NUNIT = T / 4;
    int k = 0;
    for (int un = vcu; un < NUNIT; un += G, ++k) {
        const int b = un / (S / 4), t0 = (un - b * (S / 4)) * 4;
        idx_unit(lds, (const bf16_t*)(ws + WS_IQ), (const bf16_t*)(ws + WS_IK), (const float*)(ws + WS_IW), (unsigned*)(ws + WS_BM), b, t0, wid, lane, k & 1);
    }
}

constexpr int DSA_STAGE = 8192 + 64 * VPITCH;
DEV void dsa_unit(LAS unsigned char* lds, const bf16_t* Q, const bf16_t* Kk, const bf16_t* V, const unsigned* BM, bf16_t* O, int b, int h, int qblk, int tid, int wid, int lane) {
    const int r32 = lane & 31, hi = lane >> 5, q0 = 256 * qblk, t0 = q0 + 32 * wid, t = t0 + r32; const size_t rowb = (size_t)b * S;
    bf16x8 qr[4]; { const bf16_t* qp = Q + (rowb + t) * 512 + h * 64 + 8 * hi;
#pragma unroll
        for (int d0 = 0; d0 < 4; ++d0) qr[d0] = *(const bf16x8*)(qp + 16 * d0); }
    f32x16 o0, o1, negm;
#pragma unroll
    for (int r = 0; r < 16; ++r) { o0[r] = 0.f; o1[r] = 0.f; negm[r] = 0.f; }
    float mref = 0.f, lsum = 0.f; bool seen = false;
    constexpr float THR = 8.f;
    const int ntile = (q0 + 256) / 64, wlast = (t0 + 31) >> 6;
    const int srow = tid >> 3, sch = tid & 7;
    const bf16_t* kg = Kk + (rowb + srow) * 512 + h * 64 + sch * 8; const bf16_t* vg = V + (rowb + srow) * 512 + h * 64 + sch * 8;
    const int kdst = srow * 128 + ((sch ^ (srow & 7)) * 16), vdst = srow * VPITCH + sch * 16;
    u32x4 kr0 = *(const u32x4*)kg, vr0 = *(const u32x4*)vg;
    *(LAS u32x4*)(lds + kdst) = kr0; *(LAS u32x4*)(lds + 8192 + vdst) = vr0;
    u32x4 kr1 = *(const u32x4*)(kg + (size_t)64 * 512), vr1 = *(const u32x4*)(vg + (size_t)64 * 512);
    const unsigned* bmp = BM + (size_t)b * 256 * S + t;
    unsigned mw0 = bmp[0], mw1 = bmp[(size_t)S];
    const int koff = r32 * 128;
    __syncthreads();
#define DSA_TILE(c, BUF, NBUF, KL, VL, KW, VW) do { \
        const LAS unsigned char* kt = lds + (BUF) * DSA_STAGE; const LAS unsigned char* vt = kt + 8192; \
        if ((c) + 2 < ntile) { KL = *(const u32x4*)(kg + (size_t)((c) + 2) * 64 * 512); VL = *(const u32x4*)(vg + (size_t)((c) + 2) * 64 * 512); } \
        unsigned nw0 = 0u, nw1 = 0u; \
        if ((c) + 1 <= wlast) { nw0 = bmp[(size_t)(2 * (c) + 2) * S]; nw1 = bmp[(size_t)(2 * (c) + 3) * S]; } \
        if ((c) <= wlast) { \
            bf16x8 kf[8]; \
            _Pragma("unroll") for (int d0 = 0; d0 < 4; ++d0) { const int xo = ((2 * d0 + hi) ^ (r32 & 7)) * 16; \
                kf[2 * d0] = *(const LAS bf16x8*)(kt + koff + xo); kf[2 * d0 + 1] = *(const LAS bf16x8*)(kt + koff + 4096 + xo); } \
            asm volatile("" : "+v"(kf[0]), "+v"(kf[1]), "+v"(kf[2]), "+v"(kf[3]), "+v"(kf[4]), "+v"(kf[5]), "+v"(kf[6]), "+v"(kf[7]));     \
            f32x16 p0 = negm, p1 = negm; \
            _Pragma("unroll") for (int d0 = 0; d0 < 4; ++d0) { p0 = __builtin_amdgcn_mfma_f32_32x32x16_bf16(kf[2 * d0], qr[d0], p0, 0, 0, 0); p1 = __builtin_amdgcn_mfma_f32_32x32x16_bf16(kf[2 * d0 + 1], qr[d0], p1, 0, 0, 0); } \
            const unsigned m0 = mw0 >> (4 * hi), m1 = mw1 >> (4 * hi); \
            _Pragma("unroll") for (int r = 0; r < 16; ++r) { const int bit = (r & 3) + 8 * (r >> 2); \
                const unsigned e0 = (unsigned)__builtin_amdgcn_sbfe((int)m0, bit, 1), e1 = (unsigned)__builtin_amdgcn_sbfe((int)m1, bit, 1); \
                p0[r] = __uint_as_float((__float_as_uint(p0[r]) & e0) | (0xff800000u & ~e0)); p1[r] = __uint_as_float((__float_as_uint(p1[r]) & e1) | (0xff800000u & ~e1)); } \
            float rm = -INFINITY; \
            _Pragma("unroll") for (int r = 0; r < 16; r += 2) rm = fmaxf(rm, fmaxf(fmaxf(p0[r], p0[r + 1]), fmaxf(p1[r], p1[r + 1]))); \
            { const auto rr = __builtin_amdgcn_permlane32_swap(__float_as_uint(rm), __float_as_uint(rm), false, false); rm = fmaxf(__uint_as_float(rr[0]), __uint_as_float(rr[1])); } \
            const bool shift = rm > THR || (rm < -THR && rm > -INFINITY && !seen);     \
            seen = seen || rm > -INFINITY; \
            if (__any(shift)) { \
                const float dl = shift ? rm : 0.f, f = dl > 0.f ? __builtin_amdgcn_exp2f(-dl) : 1.f; \
                mref += dl; lsum *= f; \
                _Pragma("unroll") for (int r = 0; r < 16; ++r) { p0[r] -= dl; p1[r] -= dl; o0[r] *= f; o1[r] *= f; negm[r] = -mref; } \
            } \
            float ps = 0.f; \
            _Pragma("unroll") for (int r = 0; r < 16; ++r) { p0[r] = __builtin_amdgcn_exp2f(p0[r]); p1[r] = __builtin_amdgcn_exp2f(p1[r]); ps += p0[r] + p1[r]; } \
            lsum += ps; \
            bf16x8 pk[4]; \
            pk[0] = pk8(p0[0], p0[1], p0[2], p0[3], p0[4], p0[5], p0[6], p0[7]); pk[1] = pk8(p0[8], p0[9], p0[10], p0[11], p0[12], p0[13], p0[14], p0[15]); \
            pk[2] = pk8(p1[0], p1[1], p1[2], p1[3], p1[4], p1[5], p1[6], p1[7]); pk[3] = pk8(p1[8], p1[9], p1[10], p1[11], p1[12], p1[13], p1[14], p1[15]); \
            pv_tile(o0, o1, vt, lane, pk); \
        } \
        mw0 = nw0; mw1 = nw1; \
        if ((c) + 1 < ntile) { LAS unsigned char* nb = lds + (NBUF) * DSA_STAGE; *(LAS u32x4*)(nb + kdst) = KW; *(LAS u32x4*)(nb + 8192 + vdst) = VW; } \
        asm volatile("s_waitcnt lgkmcnt(0)" ::: "memory"); __builtin_amdgcn_s_barrier(); asm volatile("" ::: "memory"); } while (0)
#pragma unroll 1
    for (int c = 0; c < ntile; c += 2) { DSA_TILE(c, 0, 1, kr0, vr0, kr1, vr1); DSA_TILE(c + 1, 1, 0, kr1, vr1, kr0, vr0); }
#undef DSA_TILE
    { const auto rr = __builtin_amdgcn_permlane32_swap(__float_as_uint(lsum), __float_as_uint(lsum), false, false); lsum = __uint_as_float(rr[0]) + __uint_as_float(rr[1]); }
    store_ot(O + (rowb + t) * 512 + h * 64, o0, o1, hi, 1.f / lsum);
}
DEV void dsa_phase(LAS unsigned char* lds, unsigned char* ws, int vcu, int G, int tid, int wid, int lane, bf16_t* Oout) {
    constexpr int NPAIR = NB * 8 * 16;
    for (int pr = vcu; pr < NPAIR; pr += G) {
        const int bh = pr >> 4, s = pr & 15, b = bh >> 3, h = bh & 7;
#pragma unroll 1
        for (int k = 0; k < 2; ++k) {
            const int qblk = k == 0 ? s : 31 - s;
            dsa_unit(lds, (const bf16_t*)(ws + WS_QC), (const bf16_t*)(ws + WS_KC), (const bf16_t*)(ws + WS_VC), (const unsigned*)(ws + WS_BM), Oout, b, h, qblk, tid, wid, lane);
        }
    }
}
constexpr int MK_THREADS = 512;
constexpr int RING_BYTES = 131072, MISC_OFF = RING_BYTES + 320, MK_LDS_BYTES = 147456;
constexpr size_t WS_CTL = 0, CTL_ZERO_BYTES = 65536 + 7 * 131072; constexpr int CW_BAR = 4096;
constexpr int PH_PREP0 = 0, PH_KV = 1, PH_GH = 2, PH_L0 = 3, PH_PER_LAYER = 14, NPH = PH_L0 + 2 * PH_PER_LAYER;
enum { Q_INPROJ = 0, Q_SBIDX, Q_DSA, Q_GATES, Q_MERGE, Q_MIX, Q_NORMXA, Q_XALOG, Q_XAOUT, Q_NORMFFN, Q_UP, Q_FFNMID, Q_DOWN, Q_NEXT };

#ifndef QBUILD
#define QBUILD 0xffffu
#endif
#define QON(x) ((QBUILD >> (x)) & 1u)
struct Args { const float* in[20]; float* out; unsigned char* ws; int ph_lo, ph_hi; };

__global__ void __launch_bounds__(MK_THREADS, 2) mk_fwd(Args args) {
    __shared__ __attribute__((aligned(16))) unsigned char lds_raw[MK_LDS_BYTES];
    LAS unsigned char* lds = (LAS unsigned char*)lds_raw;
    volatile LAS unsigned* MISC = (volatile LAS unsigned*)(lds + MISC_OFF);
    const int G = gridDim.x, bx = blockIdx.x;
    unsigned char* ws0 = args.ws;
    for (int u = threadIdx.x; u < (MK_LDS_BYTES - RING_BYTES) / 4; u += MK_THREADS) ((LAS unsigned*)(lds + RING_BYTES))[u] = 0u;
    __syncthreads();
    const int lo = args.ph_lo, hi = args.ph_hi;
    XcdBarrier bar; bar.bar = (unsigned*)(ws0 + WS_CTL) + CW_BAR; bar.x = 0; bar.st = nullptr;
    if (hi - lo > 1) bar = xcd_barrier_post((unsigned*)(ws0 + WS_CTL) + CW_BAR, MISC + 8);
#define BPW(off) ((bf16_t*)(ws + (off)))
    const int vcu = (G % 8 == 0) ? (bx % 8) * (G / 8) + bx / 8 : bx;
    for (int p = lo; p < hi; ++p) {
#ifdef PROBE_REP
        const int reps = (p >= PH_L0 && ((PROBE_REP >> ((p - PH_L0) % PH_PER_LAYER)) & 1)) ? 2 : 1;
#else
        const int reps = 1;
#endif
#ifdef PROBE_REP
#pragma unroll 1
        for (int rep = 0; rep < reps; ++rep) {
        const bool dry = rep + 1 < reps;
#else
        { constexpr bool dry = false;
#endif
        int oz = 0; asm volatile("" : "+s"(oz));
        int tid = threadIdx.x; asm volatile("" : "+v"(tid));
        const int wave = __builtin_amdgcn_readfirstlane(tid >> 6), lane = tid & 63;
        WaveId W; W.gw = vcu * 8 + wave; W.ngw = G * 8; W.wave = wave; W.lane = lane;
        unsigned char* ws = args.ws + oz; float* X = args.out + oz;
#define INP(k) (args.in[(k) + oz])
        if (p == PH_PREP0) {
            prep0_phase(W, (LAS float*)(lds + wave * 16384), ws, args.in + oz, (bf16_t*)X);
        } else if (p == PH_KV && QON(14)) {
            pg8::Order S; S.init(2, 8, 2, G, bx);
            pg8::PtrStd P{(const char*)(ws + WS_MEMN), (const char*)(ws + WS_WKVT), 1 * MiB, 4 * MiB, 0, (size_t)256 * D * 2, (size_t)256 * D * 2};
            pg8::EpiPrep E{ws, 0};
            pg8::gemm_phase<pg8::EpiPrep, pg8::PtrStd, true, true>(lds, D, D, D, S, P, E);
        } else if (p == PH_GH && QON(15)) {
            { pg8::Order S; S.init(1, 4, 16, G, bx); pg8::PtrG P{(const char*)(ws + WS_KVM), (const char*)(ws + WS_WQ)}; pg8::EpiPrep E{ws, 1};
              pg8::gemm_phase<pg8::EpiPrep, pg8::PtrG, true, true>(lds, 2 * D, D, 256, S, P, E); }
            { pg8::Order S; S.init(4, 1, 16, G, (bx + 64) % G); pg8::PtrH P{(const char*)(ws + WS_KVM), (const char*)(ws + WS_WOT)}; pg8::EpiPrep E{ws, 2};
              pg8::gemm_phase<pg8::EpiPrep, pg8::PtrH, true, true>(lds, D, 2 * D, 256, S, P, E); }
        } else if (p >= PH_L0) {
            const int l = (p - PH_L0) / PH_PER_LAYER, q = (p - PH_L0) % PH_PER_LAYER;
            const float* Xin = l == 0 ? INP(0) : X;
            pg8::u64* SSb = (pg8::u64*)(ws + WS_SS);
#define SSA(i) (SSb + (size_t)(i) * T)
            if (q == Q_SBIDX) {
#ifndef NO_SB
                sb_phase(W, lds, ws, dry);
#endif
                __syncthreads();
#ifndef NO_IDX
#ifdef PROBE_SB_ONLY
                if (!dry)
#endif
                idx_phase(lds, ws, vcu, G, wave, lane);
#endif
                conv_sc_phase(vcu * MK_THREADS + tid, G * MK_THREADS, BPW(WS_SCB), BPW(WS_CX), INP(4) + l * 3 * 512, dry);
            } else if (q == Q_DSA) {
#ifndef NO_DSA
                dsa_phase(lds, ws, vcu, G, tid, wave, lane, dry ? BPW(WS_KA) : BPW(WS_QC));
#endif
            } else if (q == Q_FFNMID) {
                ffn_mid_phase(vcu * MK_THREADS + tid, G * MK_THREADS, BPW(WS_FA), BPW(WS_FU), INP(16) + l * 3 * DFF, INP(17) + l * DFF, dry);
            } else if (q == Q_NEXT) {
                if (l + 1 < DEPTH) { int base = 0; convert_layer_weights(W, (LAS float*)(lds + wave * 16384), base, ws, args.in + oz, l + 1); }
                else if (!dry) final_norm(W, BPW(WS_XN), X, INP(19), SSA(6));
            } else if (q == Q_INPROJ && QON(Q_INPROJ)) {
                pg8::Order S; S.init(T / 256, NIN / 256, 1, G, bx);
                pg8::PtrStd P{(const char*)X, (const char*)(ws + WS_WIN), 0, 0, 0, (size_t)256 * D * 2, (size_t)256 * D * 2};
                pg8::EpiInProj E{ws, SSA(3 * l)};
                pg8::gemm_phase<pg8::EpiInProj, pg8::PtrStd, true, true>(lds, D, D, D, S, P, E);
            } else if (q == Q_GATES && QON(Q_GATES)) {
                pg8::Order S; S.init(T / 256, 12, 1, G, bx);
                pg8::PtrStd P{(const char*)X, (const char*)(ws + WS_WG), 0, 0, 0, (size_t)256 * D * 2, (size_t)256 * D * 2};
                pg8::EpiGates E{BPW(WS_GATES), SSA(3 * l)};
                pg8::gemm_phase<pg8::EpiGates, pg8::PtrStd, true, true>(lds, D, D, D, S, P, E);
            } else if (q == Q_MERGE && QON(Q_MERGE)) {
                pg8::Order S; S.init(T / 256, 4, 3, G, bx);
                pg8::PtrStd P{(const char*)(ws + WS_QA), (const char*)(ws + WS_WBR), 16 * MiB, (size_t)D * 512 * 2, 0, (size_t)256 * 512 * 2, (size_t)256 * 512 * 2};
                pg8::EpiMerge E{BPW(WS_XN), BPW(WS_GATES)};
                pg8::gemm_phase<pg8::EpiMerge, pg8::PtrStd, true, true>(lds, 512, 512, 512, S, P, E);
            } else if (q == Q_MIX && QON(Q_MIX)) {
                pg8::Order S; S.init(T / 256, 4, 1, G, bx);
                pg8::PtrStd P{(const char*)(ws + WS_XN), (const char*)(ws + WS_WMIX), 0, 0, 0, (size_t)256 * D * 2, (size_t)256 * D * 2};
                if (l == 0) { pg8::EpiResid<true> E{(const void*)INP(0), dry ? BPW(WS_FU) : BPW(WS_XBXA), dry ? SSA(0) : SSA(1)};
                    pg8::gemm_phase<pg8::EpiResid<true>, pg8::PtrStd, true, true>(lds, D, D, D, S, P, E); }
                else { pg8::EpiResid<false> E{(const void*)X, dry ? BPW(WS_FU) : BPW(WS_XBXA), dry ? SSA(0) : SSA(4)};
                    pg8::gemm_phase<pg8::EpiResid<false>, pg8::PtrStd, true, true>(lds, D, D, D, S, P, E); }

            } else if (q == Q_XALOG && QON(Q_XALOG)) {
                pg8::Order S; S.init(T / 256, 4, 1, G, bx);
                pg8::PtrStd P{(const char*)(ws + WS_XBXA), (const char*)(ws + WS_GT + (size_t)l * 4 * MiB), 0, 0, 2 * MiB, (size_t)256 * D * 2, (size_t)256 * D * 2};
                pg8::EpiSoftmax E{BPW(WS_PXA), SSA(1 + 3 * l)};
                pg8::gemm_phase<pg8::EpiSoftmax, pg8::PtrStd, false, true>(lds, D, D, D, S, P, E);
            } else if (q == Q_XAOUT && QON(Q_XAOUT)) {
                pg8::Order S; S.init(T / 256, 4, 1, G, bx);
                pg8::PtrStd P{(const char*)(ws + WS_PXA), (const char*)(ws + WS_HT + (size_t)l * 4 * MiB), 0, 0, 2 * MiB, (size_t)256 * D * 2, (size_t)256 * D * 2};
                pg8::EpiResid<false> E{(const void*)BPW(WS_XBXA), dry ? BPW(WS_FU) : BPW(WS_XN), dry ? SSA(0) : SSA(2 + 3 * l)};
                pg8::gemm_phase<pg8::EpiResid<false>, pg8::PtrStd, true, true>(lds, D, D, D, S, P, E);
            } else if (q == Q_UP && QON(Q_UP)) {
                pg8::Order S; S.init(T / 256, 22, 1, G, bx);
                pg8::PtrStd P{(const char*)(ws + WS_XN), (const char*)(ws + WS_WUP), 0, 0, 0, (size_t)256 * D * 2, (size_t)256 * D * 2};
                pg8::EpiUp E{BPW(WS_FA), BPW(WS_FU), SSA(2 + 3 * l)};
                pg8::gemm_phase<pg8::EpiUp, pg8::PtrStd, true, true>(lds, D, D, D, S, P, E);
            } else if (q == Q_DOWN && QON(Q_DOWN)) {
                pg8::Order S; S.init(T / 256, 4, 1, G, bx);
                pg8::PtrStd P{(const char*)(ws + WS_FU), (const char*)(ws + WS_WDOWN), 0, 0, 0, (size_t)256 * DFF * 2, (size_t)256 * DFF * 2};
                pg8::EpiResid<false> E{(const void*)BPW(WS_XN), dry ? BPW(WS_QA) : (l + 1 < DEPTH ? (bf16_t*)X : BPW(WS_XN)), dry ? SSA(0) : SSA(3 + 3 * l)};
                pg8::gemm_phase<pg8::EpiResid<false>, pg8::PtrStd, true, true>(lds, DFF, DFF, DFF, S, P, E);
            }
        }
        }
        if (p + 1 < hi && !(p >= PH_L0 && ((p - PH_L0) % PH_PER_LAYER == Q_NORMXA || (p - PH_L0) % PH_PER_LAYER == Q_NORMFFN))) xcd_barrier(bar);
    }
}

extern "C" void kernel_launch(void* const* d_in, const int* in_sizes, int n_in, void* d_out, int out_size, void* d_ws, size_t ws_size, hipStream_t st) {
    if (n_in != 20 || ws_size < WS_NEED || out_size != T * D) { fprintf(stderr, "kernel_launch: unexpected sizes n_in %d ws %zu out %d\n", n_in, ws_size, out_size); return; }
    static int grid = 0;
    if (grid == 0) {
        int dev = 0, cus = 0, per_cu = 0;
        (void)hipGetDevice(&dev); (void)hipDeviceGetAttribute(&cus, hipDeviceAttributeMultiprocessorCount, dev);
        if (hipOccupancyMaxActiveBlocksPerMultiprocessor(&per_cu, (const void*)mk_fwd, MK_THREADS, 0) != hipSuccess || per_cu < 1) { fprintf(stderr, "kernel_launch: occupancy query says %d blocks/CU\n", per_cu); grid = -1; return; }
        (void)hipGetLastError();
        if (cus != 256) { fprintf(stderr, "kernel_launch: built for a 256-CU device, found %d\n", cus); grid = -1; return; }
        grid = cus;
    }
    if (grid < 0) return;
    (void)hipMemsetAsync((char*)d_ws + WS_CTL, 0, CTL_ZERO_BYTES, st);
    Args a{};
    for (int i = 0; i < 20; ++i) a.in[i] = (const float*)d_in[i];
    a.out = (float*)d_out; a.ws = (unsigned char*)d_ws; a.ph_lo = 0; a.ph_hi = NPH;
    hipLaunchKernelGGL(mk_fwd, dim3(grid), dim3(MK_THREADS), 0, st, a);
}
```

```cpp
#include <hip/hip_runtime.h>
#include <stdint.h>
#include <stdio.h>

typedef unsigned short bf16_t;
typedef short bf16x8 __attribute__((ext_vector_type(8)));
typedef float f32x16 __attribute__((ext_vector_type(16)));
typedef float f32x4 __attribute__((ext_vector_type(4)));
#define DEV __device__ __forceinline__

constexpr int NB = 2, S = 8192, D = 1024, T = NB * S, DEPTH = 2;
constexpr int DIN = 8264, DFF = 2816, MEM = 256;
constexpr int NIN = 5376;
constexpr float LOG2E = 1.4426950408889634f;
constexpr float QSCALE = 0.125f * LOG2E;
constexpr float WSCALE = 0.125f * 0.35355339059327373f;
constexpr float XSCALE = 0.0625f * LOG2E;
constexpr float EPS = 1e-6f;
#ifndef MK_FUSE
#define MK_FUSE 1
#endif

constexpr size_t MiB = 1u << 20;
constexpr size_t WS_GT = 1 * MiB;
constexpr size_t WS_HT = 9 * MiB;
constexpr size_t WS_WUP = 17 * MiB, WS_WDOWN = 28 * MiB;
constexpr size_t WS_XN = 34 * MiB;
constexpr size_t WS_WMIX = 66 * MiB, WS_WBR = 68 * MiB, WS_WG = 71 * MiB, WS_WIN = 77 * MiB;
constexpr size_t WS_QA = 88 * MiB, WS_SCB = 104 * MiB, WS_QC = 120 * MiB, WS_KA = 136 * MiB, WS_VA = 152 * MiB, WS_KC = 168 * MiB, WS_VC = 184 * MiB,
                 WS_IQ = 200 * MiB, WS_CX = 216 * MiB, WS_IK = 232 * MiB, WS_IW = 234 * MiB, WS_BM = 235 * MiB;
constexpr size_t WS_GATES = 136 * MiB;
constexpr size_t WS_XTMP = 235 * MiB;
constexpr size_t WS_LOG = 88 * MiB, WS_PXA = 168 * MiB;
constexpr size_t WS_XBXA = 136 * MiB;
constexpr size_t WS_SS = 65536;
constexpr size_t WS_FA = 66 * MiB, WS_FU = 154 * MiB;
constexpr size_t WS_WQ = 200 * MiB  , WS_WOT = 204 * MiB  , WS_WKVT = 208 * MiB  , WS_MEMN = 216 * MiB  , WS_KVM = 218 * MiB  ;
constexpr size_t WS_NEED = 256 * MiB;

DEV bf16_t f2bf(float f) { unsigned u = __float_as_uint(f); u += 0x7fffu + ((u >> 16) & 1u); return (bf16_t)(u >> 16); }
DEV float bf2f(bf16_t h) { return __uint_as_float(((unsigned)h) << 16); }
DEV float wave_sum(float v) {
#pragma unroll
    for (int o = 1; o < 64; o <<= 1) v += __shfl_xor(v, o);
    return v;
}
DEV float wave_max(float v) {
#pragma unroll
    for (int o = 1; o < 64; o <<= 1) v = fmaxf(v, __shfl_xor(v, o));
    return v;
}


#define LAS __attribute__((address_space(3)))
#define GAS __attribute__((address_space(1)))
typedef unsigned u32x4 __attribute__((ext_vector_type(4)));
typedef unsigned u32x2 __attribute__((ext_vector_type(2)));
typedef float f32x2 __attribute__((ext_vector_type(2)));
#define LDS_WAIT() asm volatile("s_waitcnt lgkmcnt(0)" ::: "memory")
DEV int mk_tid(int wave_s) { unsigned ones = ~0u; asm volatile("" : "+s"(ones)); return wave_s * 64 + (int)__builtin_amdgcn_mbcnt_hi(ones, __builtin_amdgcn_mbcnt_lo(ones, 0u)); }
#define VM_WAIT() asm volatile("s_waitcnt vmcnt(0)" ::: "memory")
typedef __bf16 bf16x2_t __attribute__((ext_vector_type(2)));
DEV unsigned cvt_pk_bf16(float lo, float hi) { const f32x2 v = {lo, hi}; return __builtin_bit_cast(unsigned, __builtin_convertvector(v, bf16x2_t)); }
DEV float bflo(unsigned w) { return __uint_as_float(w << 16); }
DEV float bfhi(unsigned w) { return __uint_as_float(w & 0xffff0000u); }

namespace pg8 {
constexpr int BM = 256, BK = 64, HALF = 128, HTB = HALF * BK * 2, STAGE_BYTES = 8 * HTB, NXCD = 8, WGM = 8;
__host__ __device__ __forceinline__ int lds_byte(int r, int c) { const int st = (r >> 4) * 2 + (c >> 5), rr = r & 15, cc = c & 31, ob = rr * 64 + cc * 2; return st * 1024 + (ob ^ (((ob >> 9) & 1) << 5)); }
__host__ __device__ __forceinline__ void stage_rc(int b, int& R, int& C) { const int st = b / 1024, sb = b % 1024, swz = sb ^ (((sb >> 9) & 1) << 5); R = (st >> 1) * 16 + swz / 64; C = (st & 1) * 32 + (swz % 64) / 2; }
__host__ __device__ __forceinline__ int perm32(int rho) { const int n = rho >> 4, i = rho & 15; return 8 * (i >> 2) + 4 * n + (i & 3); }

struct Unit { int pm, pn, job; };
struct Order {
    int nM, nN, nwg, ntot, G, c;
    DEV void init(int nM_, int nN_, int njob, int G_, int c_) { nM = nM_; nN = nN_; nwg = nM * nN; ntot = nwg * njob; G = G_; c = c_; }
    DEV bool next(int i, Unit& u) const {
        const int L = i * G + c; if (L >= ntot) return false;
        u.job = L / nwg; int wgid = L - u.job * nwg;
        { const int q = nwg / NXCD, r = nwg % NXCD, xcd = wgid % NXCD, off = wgid / NXCD; wgid = (xcd < r ? xcd * (q + 1) : r * (q + 1) + (xcd - r) * q) + off; }
        const int nig = WGM * nN, gid = wgid / nig, fm = gid * WGM, gsz = (nM - fm) < WGM ? (nM - fm) : WGM;
        u.pm = fm + ((wgid % nig) % gsz); u.pn = (wgid % nig) / gsz; return true;
    }
};
template <class Epi, class Ptr, bool ALIGN_EPI, bool SP2>
DEV void gemm_phase(LAS unsigned char* lds, const int tid_in, const int lda, const int ldb, const int K, const Order& S, const Ptr& P, const Epi& E) {
    int tid_ = tid_in; asm volatile("" : "+v"(tid_));
    const int tid = tid_, wid = __builtin_amdgcn_readfirstlane(tid >> 6), lane = tid & 63, wr = wid >> 2, wc = wid & 3, fr = lane & 15, fq = lane >> 4;
    const int nt = K / BK;
    unsigned voffA[2], voffB[2];
#pragma unroll
    for (int i = 0; i < 2; ++i) { int R, C; stage_rc(tid * 16 + i * 8192, R, C); const int Rb = Epi::PERM ? ((R & ~31) + perm32(R & 31)) : R;
        voffA[i] = (unsigned)(R * lda + C) * 2u; voffB[i] = (unsigned)(Rb * ldb + C) * 2u; }
    const size_t kstep = (size_t)(BK * 2);
    const size_t hstepA = (size_t)HALF * lda * 2, hstepB = (size_t)HALF * ldb * 2;
    const unsigned ldsw = (unsigned)wid * 1024u;
    const int aoff = lds_byte(wr * 64 + fr, fq * 8), boff = lds_byte(wc * 32 + fr, fq * 8);
#define PG8_SA(b, h) (((b) * 2 + (h)) * HTB)
#define PG8_SB(b, h) ((4 + (b) * 2 + (h)) * HTB)
#define PG8_STAGE(bufoff, gbase, voff) do { _Pragma("unroll") for (int _i = 0; _i < 2; ++_i) \
        __builtin_amdgcn_global_load_lds((const unsigned*)((const char*)(gbase) + (voff)[_i]), (LAS unsigned*)(lds + (bufoff) + ldsw + _i * 8192), 16, 0, 0); } while (0)
#define PG8_LDA(dst, b, h) do { _Pragma("unroll") for (int m = 0; m < 4; ++m) _Pragma("unroll") for (int k = 0; k < 2; ++k) dst[m][k] = *(const LAS bf16x8*)(lds + PG8_SA(b, h) + aoff + m * 2048 + k * 1024); } while (0)
#define PG8_LDB(dst, b, h) do { _Pragma("unroll") for (int n = 0; n < 2; ++n) _Pragma("unroll") for (int k = 0; k < 2; ++k) dst[n][k] = *(const LAS bf16x8*)(lds + PG8_SB(b, h) + boff + n * 2048 + k * 1024); } while (0)
#define PG8_MMA(ai, bj, At, Bt) do { __builtin_amdgcn_s_setprio(1); _Pragma("unroll") for (int m = 0; m < 4; ++m) _Pragma("unroll") for (int n = 0; n < 2; ++n) _Pragma("unroll") for (int k = 0; k < 2; ++k) \
        acc[ai][bj][m][n] = __builtin_amdgcn_mfma_f32_16x16x32_bf16(Bt[n][k], At[m][k], acc[ai][bj][m][n], 0, 0, 0); __builtin_amdgcn_s_setprio(0); } while (0)
#define PG8_WAIT_V(n) asm volatile("s_waitcnt vmcnt(" #n ")" ::: "memory")
#define PG8_WAIT_L(n) asm volatile("s_waitcnt lgkmcnt(" #n ")" ::: "memory")
#define PG8_BAR __builtin_amdgcn_s_barrier()
#define PG8_SCHED __builtin_amdgcn_sched_barrier(0)
    Unit cur, nxt; int ui = 0;
    if (!S.next(0, cur)) return;
    f32x4 acc[2][2][4][2];
#pragma unroll
    for (int a = 0; a < 2; ++a)
#pragma unroll
        for (int b = 0; b < 2; ++b)
#pragma unroll
            for (int m = 0; m < 4; ++m)
#pragma unroll
                for (int n = 0; n < 2; ++n) acc[a][b][m][n] = (f32x4){0.f, 0.f, 0.f, 0.f};
    bf16x8 At[4][2], B0[2][2], B1[2][2];
    const char* cA = P.a(cur); const char* cB = P.b(cur);
    typename Epi::Pre pre; E.prefetch(pre, cur, wr, fr);
    if constexpr (SP2) {
        PG8_STAGE(PG8_SB(0, 0), cB, voffB); PG8_STAGE(PG8_SB(0, 1), cB + hstepB, voffB); PG8_STAGE(PG8_SA(0, 0), cA, voffA); PG8_STAGE(PG8_SA(0, 1), cA + hstepA, voffA);
        if (wr == 1) PG8_BAR;
        PG8_WAIT_V(2); PG8_BAR;
        PG8_STAGE(PG8_SB(1, 0), cB + kstep, voffB); PG8_STAGE(PG8_SA(1, 0), cA + kstep, voffA); PG8_STAGE(PG8_SB(1, 1), cB + hstepB + kstep, voffB);
        PG8_WAIT_V(6); PG8_BAR;
    } else {
        PG8_STAGE(PG8_SB(0, 0), cB, voffB); PG8_STAGE(PG8_SA(0, 0), cA, voffA); PG8_STAGE(PG8_SB(0, 1), cB + hstepB, voffB); PG8_STAGE(PG8_SA(0, 1), cA + hstepA, voffA);
        if (wr == 1) PG8_BAR;
        PG8_WAIT_V(4); PG8_BAR;
        PG8_STAGE(PG8_SB(1, 0), cB + kstep, voffB); PG8_STAGE(PG8_SA(1, 0), cA + kstep, voffA); PG8_STAGE(PG8_SB(1, 1), cB + hstepB + kstep, voffB);
        PG8_WAIT_V(6); PG8_BAR;
    }
#pragma unroll 1
    for (;;) {
        const bool has_next = S.next(ui + 1, nxt);
        const char* nA = has_next ? P.a(nxt) : cA; const char* nB = has_next ? P.b(nxt) : cB;
#pragma unroll 1
        for (int t = 0; t < nt; t += 2) {
            const bool last = (t == nt - 2);
            const char* a1 = cA + (size_t)(t + 1) * kstep;
            const char* a2 = last ? nA : cA + (size_t)(t + 2) * kstep; const char* b2 = last ? nB : cB + (size_t)(t + 2) * kstep;
            const char* a3 = a2 + kstep; const char* b3 = b2 + kstep;
            if constexpr (SP2) {
            PG8_LDB(B0, 0, 0); PG8_LDB(B1, 0, 1); PG8_SCHED; PG8_LDA(At, 0, 0); PG8_STAGE(PG8_SA(1, 1), a1 + hstepA, voffA);
            PG8_WAIT_V(8); PG8_WAIT_L(0); PG8_BAR; PG8_MMA(0, 0, At, B0); PG8_MMA(0, 1, At, B1); PG8_BAR; PG8_SCHED;
            PG8_LDA(At, 0, 1); PG8_STAGE(PG8_SB(0, 0), b2, voffB); PG8_STAGE(PG8_SB(0, 1), b2 + hstepB, voffB); PG8_STAGE(PG8_SA(0, 0), a2, voffA);
            PG8_WAIT_V(8); PG8_WAIT_L(0); PG8_BAR; PG8_MMA(1, 0, At, B0); PG8_MMA(1, 1, At, B1); PG8_BAR; PG8_SCHED;
            PG8_LDB(B0, 1, 0); PG8_LDB(B1, 1, 1); PG8_SCHED; PG8_LDA(At, 1, 0); PG8_STAGE(PG8_SA(0, 1), a2 + hstepA, voffA);
            PG8_WAIT_V(8); PG8_WAIT_L(0); PG8_BAR; PG8_MMA(0, 0, At, B0); PG8_MMA(0, 1, At, B1); PG8_BAR; PG8_SCHED;
            PG8_LDA(At, 1, 1); PG8_STAGE(PG8_SB(1, 0), b3, voffB); PG8_STAGE(PG8_SB(1, 1), b3 + hstepB, voffB); PG8_STAGE(PG8_SA(1, 0), a3, voffA);
            PG8_WAIT_V(8); PG8_WAIT_L(0); PG8_BAR; PG8_MMA(1, 0, At, B0); PG8_MMA(1, 1, At, B1); PG8_BAR; PG8_SCHED;
            } else {
            PG8_LDB(B0, 0, 0); PG8_SCHED; PG8_LDA(At, 0, 0); PG8_STAGE(PG8_SA(1, 1), a1 + hstepA, voffA);
            PG8_WAIT_L(8); PG8_BAR; PG8_WAIT_L(0); PG8_MMA(0, 0, At, B0); PG8_BAR; PG8_SCHED;
            PG8_LDB(B1, 0, 1); PG8_STAGE(PG8_SB(0, 0), b2, voffB);
            PG8_BAR; PG8_WAIT_L(0); PG8_MMA(0, 1, At, B1); PG8_BAR;
            PG8_LDA(At, 0, 1); PG8_STAGE(PG8_SA(0, 0), a2, voffA);
            PG8_BAR; PG8_WAIT_L(0); PG8_MMA(1, 0, At, B0); PG8_BAR; PG8_SCHED;
            PG8_STAGE(PG8_SB(0, 1), b2 + hstepB, voffB);
            PG8_WAIT_V(6); PG8_BAR; PG8_MMA(1, 1, At, B1); PG8_BAR;
            PG8_LDB(B0, 1, 0); PG8_SCHED; PG8_LDA(At, 1, 0); PG8_STAGE(PG8_SA(0, 1), a2 + hstepA, voffA);
            PG8_WAIT_L(8); PG8_BAR; PG8_WAIT_L(0); PG8_MMA(0, 0, At, B0); PG8_BAR; PG8_SCHED;
            PG8_LDB(B1, 1, 1); PG8_STAGE(PG8_SB(1, 0), b3, voffB);
            PG8_BAR; PG8_WAIT_L(0); PG8_MMA(0, 1, At, B1); PG8_BAR;
            PG8_LDA(At, 1, 1); PG8_STAGE(PG8_SA(1, 0), a3, voffA);
            PG8_BAR; PG8_WAIT_L(0); PG8_MMA(1, 0, At, B0); PG8_BAR; PG8_SCHED;
            PG8_STAGE(PG8_SB(1, 1), b3 + hstepB, voffB);
            PG8_WAIT_V(6); PG8_BAR; PG8_MMA(1, 1, At, B1); PG8_BAR;
            }
        }
        if constexpr (ALIGN_EPI) { if (wr == 0) PG8_BAR; }
        if constexpr (!Epi::AFTER_DRAIN) { int fr_ = fr, fq_ = fq; asm volatile("" : "+v"(fr_), "+v"(fq_));
            E(acc, cur, wr, wc, fr_, fq_, pre); }
        if (!has_next) break;
#pragma unroll
        for (int a = 0; a < 2; ++a)
#pragma unroll
            for (int b = 0; b < 2; ++b)
#pragma unroll
                for (int m = 0; m < 4; ++m)
#pragma unroll
                    for (int n = 0; n < 2; ++n) acc[a][b][m][n] = (f32x4){0.f, 0.f, 0.f, 0.f};
        cur = nxt; cA = nA; cB = nB; ++ui; E.prefetch(pre, cur, wr, fr);
        if constexpr (ALIGN_EPI) { if (wr == 1) PG8_BAR; }
    }
    PG8_WAIT_V(0);
    if constexpr (!ALIGN_EPI) { if (wr == 0) PG8_BAR; }
    PG8_BAR;
    if constexpr (Epi::AFTER_DRAIN) { E.fused(acc, cur, wr, wc, fr, fq, lds, wid, lane, pre); }
#undef PG8_SA
#undef PG8_SB
#undef PG8_STAGE
#undef PG8_LDA
#undef PG8_LDB
#undef PG8_MMA
#undef PG8_WAIT_V
#undef PG8_WAIT_L
#undef PG8_BAR
#undef PG8_SCHED
}
typedef f32x4 Acc[2][2][4][2];

struct PtrStd {
    const char* A; const char* B; size_t aj, bj, bb, arow, brow;
    DEV const char* a(const Unit& u) const { return A + (size_t)u.job * aj + (size_t)u.pm * arow; }
    DEV const char* b(const Unit& u) const { return B + (size_t)u.job * bj + (size_t)(u.pm >> 5) * bb + (size_t)u.pn * brow; }
};
struct PtrG {
    const char* KVM; const char* WQ;
    DEV const char* a(const Unit& u) const { return KVM + (size_t)(u.job >> 2) * MiB + (size_t)(u.job & 3) * 512; }
    DEV const char* b(const Unit& u) const { return WQ + (size_t)(u.job >> 3) * 2 * MiB + (size_t)(u.job & 3) * 512 + (size_t)u.pn * 256 * 1024 * 2; }
};
struct PtrH {
    const char* KVM; const char* WOT;
    DEV const char* a(const Unit& u) const { return WOT + (size_t)(u.job >> 3) * 2 * MiB + (size_t)(u.job & 3) * 512 + (size_t)u.pm * 256 * 1024 * 2; }
    DEV const char* b(const Unit& u) const { return KVM + (size_t)(u.job >> 2) * MiB + 2048 + (size_t)(u.job & 3) * 512; }
};

#define EPI_ROWS(u) const int row0 = (u).pm * BM + wr * 64 + fr
DEV u32x4 pack8(const f32x4 v0, const f32x4 v1) { u32x4 w; w.x = cvt_pk_bf16(v0[0], v0[1]); w.y = cvt_pk_bf16(v0[2], v0[3]); w.z = cvt_pk_bf16(v1[0], v1[1]); w.w = cvt_pk_bf16(v1[2], v1[3]); return w; }

struct PreNone {};
typedef unsigned long long u64;
constexpr float SS_SCALE = 65536.f;
struct PreRs { u64 v[2][4]; };
DEV void pre_rs(PreRs& p, const u64* ss, int row0) {
#pragma unroll
    for (int ai = 0; ai < 2; ++ai)
#pragma unroll
        for (int m = 0; m < 4; ++m) p.v[ai][m] = __builtin_nontemporal_load(ss + row0 + ai * HALF + m * 16);
}
DEV void rs_of(float (&rs)[2][4], const PreRs& p) {
#pragma unroll
    for (int ai = 0; ai < 2; ++ai)
#pragma unroll
        for (int m = 0; m < 4; ++m) rs[ai][m] = rsqrtf((float)p.v[ai][m] * (1.f / (SS_SCALE * D)) + EPS);
}
struct EpiInProj {
    typedef PreRs Pre;
    DEV void prefetch(PreRs& p, const Unit& u, int wr, int fr) const { pre_rs(p, ss, u.pm * BM + wr * 64 + fr); }
    static constexpr bool PERM = true, AFTER_DRAIN = false;
    unsigned char* ws; const u64* ss;
    DEV void operator()(const Acc& acc, const Unit& u, int wr, int wc, int fr, int fq, const PreRs& pre) const {
        EPI_ROWS(u); const int pn = u.pn, cb = wc * 32 + 8 * fq;
        float rs[2][4]; rs_of(rs, pre);
        if (pn < 16) {
            const int g = pn >> 1;
            const size_t off = g == 0 ? WS_QA : g == 1 ? WS_KA : g == 2 ? WS_VA : g == 3 ? WS_QC : g == 4 ? WS_KC : g == 5 ? WS_VC : g == 6 ? WS_IQ : WS_SCB;
            const float sc = (g == 0 || g == 3) ? QSCALE : 1.f;
            bf16_t* base = (bf16_t*)(ws + off) + (pn & 1) * 256 + cb;
#pragma unroll
            for (int ai = 0; ai < 2; ++ai)
#pragma unroll
                for (int m = 0; m < 4; ++m) { bf16_t* rowp = base + (size_t)(row0 + ai * HALF + m * 16) * 512;
#pragma unroll
                    for (int bj = 0; bj < 2; ++bj) *(u32x4*)(rowp + bj * HALF) = pack8(acc[ai][bj][m][0] * (sc * rs[ai][m]), acc[ai][bj][m][1] * (sc * rs[ai][m])); }
        } else if (pn < 20) {
            bf16_t* base = (bf16_t*)(ws + WS_CX) + (pn - 16) * 128 + cb;
#pragma unroll
            for (int ai = 0; ai < 2; ++ai)
#pragma unroll
                for (int m = 0; m < 4; ++m) { const float r2 = rs[ai][m] * rs[ai][m]; *(u32x4*)(base + (size_t)(row0 + ai * HALF + m * 16) * 512) = pack8(acc[ai][0][m][0] * acc[ai][1][m][0] * r2, acc[ai][0][m][1] * acc[ai][1][m][1] * r2); }
        } else {
            if (wc < 2) { bf16_t* base = (bf16_t*)(ws + WS_IK);
#pragma unroll
                for (int ai = 0; ai < 2; ++ai)
#pragma unroll
                    for (int m = 0; m < 4; ++m) { const int t = row0 + ai * HALF + m * 16;
                        *(u32x4*)(base + (size_t)(t >> 5) * 2048 + (((cb >> 3) * 32 + (t & 31)) * 8)) = pack8(acc[ai][0][m][0] * rs[ai][m], acc[ai][0][m][1] * rs[ai][m]); }
            } else if (wc == 2 && fq == 0) { float* base = (float*)(ws + WS_IW);
#pragma unroll
                for (int ai = 0; ai < 2; ++ai)
#pragma unroll
                    for (int m = 0; m < 4; ++m) { float* p = base + (size_t)(row0 + ai * HALF + m * 16) * 8; *(f32x4*)p = acc[ai][0][m][0] * (WSCALE * rs[ai][m]); *(f32x4*)(p + 4) = acc[ai][0][m][1] * (WSCALE * rs[ai][m]); }
            }
        }
    }
};
DEV f32x4 sigm4(const f32x4 v) { f32x4 o;
#pragma unroll
    for (int i = 0; i < 4; ++i) o[i] = __builtin_amdgcn_rcpf(1.f + __builtin_amdgcn_exp2f(-LOG2E * v[i])); return o; }
struct EpiGates {
    typedef PreRs Pre;
    DEV void prefetch(PreRs& p, const Unit& u, int wr, int fr) const { pre_rs(p, ss, u.pm * BM + wr * 64 + fr); }
    static constexpr bool PERM = true, AFTER_DRAIN = false;
    bf16_t* G; const u64* ss;
    DEV void operator()(const Acc& acc, const Unit& u, int wr, int wc, int fr, int fq, const PreRs& pre) const {
        EPI_ROWS(u); float rs[2][4]; rs_of(rs, pre); bf16_t* base = G + (size_t)(u.pn >> 2) * T * D + (u.pn & 3) * 256 + wc * 32 + 8 * fq;
#pragma unroll
        for (int ai = 0; ai < 2; ++ai)
#pragma unroll
            for (int m = 0; m < 4; ++m) { bf16_t* rowp = base + (size_t)(row0 + ai * HALF + m * 16) * D;
#pragma unroll
                for (int bj = 0; bj < 2; ++bj) *(u32x4*)(rowp + bj * HALF) = pack8(sigm4(acc[ai][bj][m][0] * rs[ai][m]), sigm4(acc[ai][bj][m][1] * rs[ai][m])); }
    }
};
struct EpiMerge {
    typedef PreNone Pre;
    DEV void prefetch(PreNone&, const Unit&, int, int) const {}
    static constexpr bool PERM = true, AFTER_DRAIN = false;
    bf16_t* M; const bf16_t* G;
    DEV void operator()(const Acc& acc, const Unit& u, int wr, int wc, int fr, int fq, const PreNone&) const {
        EPI_ROWS(u); const size_t cofs = (size_t)u.pn * 256 + wc * 32 + 8 * fq; const bf16_t* gb = G + (size_t)u.job * T * D;
#pragma unroll
        for (int ai = 0; ai < 2; ++ai)
#pragma unroll
            for (int m = 0; m < 4; ++m) { const size_t ro = (size_t)(row0 + ai * HALF + m * 16) * D + cofs;
#pragma unroll
                for (int bj = 0; bj < 2; ++bj) { const size_t o = ro + bj * HALF; const u32x4 g = *(const u32x4*)(gb + o);
                    f32x4 v0 = acc[ai][bj][m][0], v1 = acc[ai][bj][m][1];
                    v0[0] *= bflo(g.x); v0[1] *= bfhi(g.x); v0[2] *= bflo(g.y); v0[3] *= bfhi(g.y); v1[0] *= bflo(g.z); v1[1] *= bfhi(g.z); v1[2] *= bflo(g.w); v1[3] *= bfhi(g.w);
                    if (u.job > 0) { const u32x4 p = __builtin_nontemporal_load((const u32x4*)(M + o));
                        v0[0] += bflo(p.x); v0[1] += bfhi(p.x); v0[2] += bflo(p.y); v0[3] += bfhi(p.y); v1[0] += bflo(p.z); v1[1] += bfhi(p.z); v1[2] += bflo(p.w); v1[3] += bfhi(p.w); }
                    *(u32x4*)(M + o) = pack8(v0, v1); } }
    }
};
template <bool IN_F32> struct EpiResid {
    typedef PreNone Pre;
    DEV void prefetch(PreNone&, const Unit&, int, int) const {}
    static constexpr bool PERM = true, AFTER_DRAIN = false;
    const void* xin; bf16_t* xb; u64* ss;
    DEV void operator()(const Acc& acc, const Unit& u, int wr, int wc, int fr, int fq, const PreNone&) const {
        EPI_ROWS(u); const size_t cofs = (size_t)u.pn * 256 + wc * 32 + 8 * fq;
#pragma unroll
        for (int ai = 0; ai < 2; ++ai)
#pragma unroll
            for (int m = 0; m < 4; ++m) { const size_t ro = (size_t)(row0 + ai * HALF + m * 16) * D + cofs; float sq = 0.f;
#pragma unroll
                for (int bj = 0; bj < 2; ++bj) { const size_t o = ro + bj * HALF; f32x4 v0 = acc[ai][bj][m][0], v1 = acc[ai][bj][m][1];
                    if (IN_F32) { v0 = v0 + *(const f32x4*)((const float*)xin + o); v1 = v1 + *(const f32x4*)((const float*)xin + o + 4); }
                    else { const u32x4 p = *(const u32x4*)((const bf16_t*)xin + o);
                        v0[0] += bflo(p.x); v0[1] += bfhi(p.x); v0[2] += bflo(p.y); v0[3] += bfhi(p.y); v1[0] += bflo(p.z); v1[1] += bfhi(p.z); v1[2] += bflo(p.w); v1[3] += bfhi(p.w); }
                    *(u32x4*)(xb + o) = pack8(v0, v1);
                    sq += ((v0[0] * v0[0] + v0[1] * v0[1]) + (v0[2] * v0[2] + v0[3] * v0[3])) + ((v1[0] * v1[0] + v1[1] * v1[1]) + (v1[2] * v1[2] + v1[3] * v1[3])); }
                sq += __shfl_xor(sq, 16); sq += __shfl_xor(sq, 32);
                if (fq == 0) atomicAdd(ss + row0 + ai * HALF + m * 16, (u64)(sq * SS_SCALE + 0.5f)); }
    }
};
struct EpiUp {
    typedef PreRs Pre;
    DEV void prefetch(PreRs& p, const Unit& u, int wr, int fr) const { pre_rs(p, ss, u.pm * BM + wr * 64 + fr); }
    static constexpr bool PERM = true, AFTER_DRAIN = false;
    bf16_t *fa, *fu; const u64* ss;
    DEV void operator()(const Acc& acc, const Unit& u, int wr, int wc, int fr, int fq, const PreRs& pre) const {
        EPI_ROWS(u); float rs[2][4]; rs_of(rs, pre); const size_t cofs = (size_t)u.pn * 128 + wc * 32 + 8 * fq;
#pragma unroll
        for (int ai = 0; ai < 2; ++ai)
#pragma unroll
            for (int m = 0; m < 4; ++m) { const size_t o = (size_t)(row0 + ai * HALF + m * 16) * DFF + cofs;
                *(u32x4*)(fa + o) = pack8(acc[ai][0][m][0] * rs[ai][m], acc[ai][0][m][1] * rs[ai][m]); *(u32x4*)(fu + o) = pack8(acc[ai][1][m][0] * rs[ai][m], acc[ai][1][m][1] * rs[ai][m]); }
    }
};
struct EpiPrep {
    typedef PreNone Pre;
    DEV void prefetch(PreNone&, const Unit&, int, int) const {}
    static constexpr bool PERM = true, AFTER_DRAIN = false;
    unsigned char* ws; int mode;
    DEV void operator()(const Acc& acc, const Unit& u, int wr, int wc, int fr, int fq, const PreNone&) const {
        EPI_ROWS(u); bf16_t* base; int ldc; float sc = 1.f;
        if (mode == 0) { base = (bf16_t*)(ws + WS_KVM + (size_t)u.job * 2 * MiB); ldc = 2 * D; }
        else if (mode == 1) { base = (bf16_t*)(ws + WS_GT + (size_t)(u.job >> 2) * 2 * MiB) + (size_t)(u.job & 3) * 256 * D; ldc = D; sc = XSCALE; }
        else { base = (bf16_t*)(ws + WS_HT + (size_t)(u.job >> 2) * 2 * MiB) + (u.job & 3) * 256; ldc = D; }
        base += (size_t)u.pn * 256 + wc * 32 + 8 * fq;
#pragma unroll
        for (int ai = 0; ai < 2; ++ai)
#pragma unroll
            for (int m = 0; m < 4; ++m) { bf16_t* rowp = base + (size_t)(row0 + ai * HALF + m * 16) * ldc;
#pragma unroll
                for (int bj = 0; bj < 2; ++bj) *(u32x4*)(rowp + bj * HALF) = pack8(acc[ai][bj][m][0] * sc, acc[ai][bj][m][1] * sc); }
    }
};
struct EpiSoftmax {
    typedef PreRs Pre;
    DEV void prefetch(PreRs& p, const Unit& u, int wr, int fr) const { pre_rs(p, ss, u.pm * BM + wr * 64 + fr); }
    static constexpr bool PERM = true, AFTER_DRAIN = true;
    bf16_t* P; const u64* ss;
    DEV void fused(Acc& acc, const Unit& u, int wr, int wc, int fr, int fq, LAS unsigned char* lds, int wid, int lane, const PreRs& pre) const {
        LAS float* PM = (LAS float*)lds; LAS float* PS = (LAS float*)(lds + 4096);
        { const int row0_ = u.pm * BM + wr * 64 + fr; float rs[2][4]; rs_of(rs, pre);
#pragma unroll
          for (int ai = 0; ai < 2; ++ai)
#pragma unroll
              for (int m = 0; m < 4; ++m)
#pragma unroll
                  for (int bj = 0; bj < 2; ++bj)
#pragma unroll
                      for (int n = 0; n < 2; ++n) acc[ai][bj][m][n] = acc[ai][bj][m][n] * rs[ai][m]; }
#pragma unroll
        for (int ai = 0; ai < 2; ++ai)
#pragma unroll
            for (int m = 0; m < 4; ++m) { float mx = -INFINITY;
#pragma unroll
                for (int bj = 0; bj < 2; ++bj)
#pragma unroll
                    for (int n = 0; n < 2; ++n) { const f32x4 x = acc[ai][bj][m][n]; mx = fmaxf(mx, fmaxf(fmaxf(x[0], x[1]), fmaxf(x[2], x[3]))); }
                mx = fmaxf(mx, __shfl_xor(mx, 16)); mx = fmaxf(mx, __shfl_xor(mx, 32));
                if (fq == 0) PM[(ai * HALF + wr * 64 + m * 16 + fr) * 4 + wc] = mx; }
        LDS_WAIT(); __builtin_amdgcn_s_barrier(); asm volatile("" ::: "memory");
#pragma unroll
        for (int ai = 0; ai < 2; ++ai)
#pragma unroll
            for (int m = 0; m < 4; ++m) { const int r = ai * HALF + wr * 64 + m * 16 + fr; const f32x4 q = *(const LAS f32x4*)(PM + r * 4);
                const float mx = fmaxf(fmaxf(q[0], q[1]), fmaxf(q[2], q[3])); float s = 0.f;
#pragma unroll
                for (int bj = 0; bj < 2; ++bj)
#pragma unroll
                    for (int n = 0; n < 2; ++n) { f32x4 x = acc[ai][bj][m][n];
#pragma unroll
                        for (int i = 0; i < 4; ++i) { x[i] = __builtin_amdgcn_exp2f(x[i] - mx); s += x[i]; } acc[ai][bj][m][n] = x; }
                s += __shfl_xor(s, 16); s += __shfl_xor(s, 32);
                if (fq == 0) PS[r * 4 + wc] = s; }
        LDS_WAIT(); __builtin_amdgcn_s_barrier(); asm volatile("" ::: "memory");
        EPI_ROWS(u); bf16_t* base = P + (size_t)u.pn * 256 + wc * 32 + 8 * fq;
#pragma unroll
        for (int ai = 0; ai < 2; ++ai)
#pragma unroll
            for (int m = 0; m < 4; ++m) { const int r = ai * HALF + wr * 64 + m * 16 + fr; const f32x4 q = *(const LAS f32x4*)(PS + r * 4);
                const float inv = 1.f / ((q[0] + q[1]) + (q[2] + q[3])); bf16_t* rowp = base + (size_t)(row0 + ai * HALF + m * 16) * D;
#pragma unroll
                for (int bj = 0; bj < 2; ++bj) *(u32x4*)(rowp + bj * HALF) = pack8(acc[ai][bj][m][0] * inv, acc[ai][bj][m][1] * inv); }
        LDS_WAIT(); __builtin_amdgcn_s_barrier();
    }
};
}

typedef GAS unsigned gu32;
#define XB_TMO      128
#define XB_XCNT(j)  (256  + 64 * (j))
#define XB_XSUB(j)  (1280 + 64 * (j))
#define XB_XGEN(j)  (2304 + 64 * (j))
#define XB_TOP      3328
#define XB_TOPGEN   3392
#define XCD_BAR_WORDS 3456
#define XB_SPIN_CAP (1u << 22)
DEV unsigned xb_ld(unsigned* p) { return __hip_atomic_load(p, __ATOMIC_RELAXED, __HIP_MEMORY_SCOPE_AGENT); }
DEV unsigned xb_add(unsigned* p, unsigned v) { return __hip_atomic_fetch_add(p, v, __ATOMIC_RELAXED, __HIP_MEMORY_SCOPE_AGENT); }
DEV unsigned xb_xcc_id() { return (unsigned)__builtin_amdgcn_s_getreg((3 << 11) | 20) & 0xFu; }
#define XB_SPIN(cond, bar) do { unsigned _sp = 0; while (cond) { __builtin_amdgcn_s_sleep(1); \
    if ((++_sp & 255u) == 0u) { if (xb_ld(&(bar)[XB_TMO])) break; if (_sp > XB_SPIN_CAP) { atomicAdd(&(bar)[XB_TMO], 1u); break; } } } } while (0)
struct XcdBarrier { unsigned* bar; unsigned x; volatile LAS unsigned* st; };
DEV XcdBarrier xcd_barrier_post(unsigned* bar, volatile LAS unsigned* st, int tid) {
    XcdBarrier b; b.bar = bar; b.x = xb_xcc_id(); b.st = st;
    if (tid == 0) (void)xb_add(&bar[XB_XCNT(b.x)], 1u);
    return b;
}
DEV void xcd_barrier_complete(unsigned* bar, unsigned x, unsigned& nloc, unsigned& nx) {
    const unsigned G = gridDim.x * gridDim.y * gridDim.z;
    unsigned sum, cnt, mine, sp = 0u;
    for (;;) {
        sum = 0u; cnt = 0u; mine = 0u;
#pragma unroll
        for (unsigned j = 0; j < 16; ++j) { const unsigned c = xb_ld(&bar[XB_XCNT(j)]); sum += c; cnt += (c > 0u) ? 1u : 0u; mine = (j == x) ? c : mine; }
        if (sum == G) break;
        __builtin_amdgcn_s_sleep(1);
        if ((++sp & 255u) == 0u) { if (xb_ld(&bar[XB_TMO])) break; if (sp > XB_SPIN_CAP) { atomicAdd(&bar[XB_TMO], 1u); break; } }
    }
    nloc = mine > 0u ? mine : 1u; nx = cnt > 0u ? cnt : 1u;
}
DEV void xcd_barrier(const XcdBarrier& b, int tid) {
    asm volatile("s_waitcnt vmcnt(0)" ::: "memory");
    __syncthreads();
    if (tid == 0) {
        unsigned* bar = b.bar;
        __builtin_amdgcn_s_waitcnt(0);
        unsigned nloc = b.st[0], nx = b.st[1];
        if (nloc == 0u) { xcd_barrier_complete(bar, b.x, nloc, nx); b.st[0] = nloc; b.st[1] = nx; }
        const unsigned old = xb_add(&bar[XB_XSUB(b.x)], 1u);
        const unsigned gen = old / nloc;
        if (old + 1u == (gen + 1u) * nloc) {
            __builtin_amdgcn_fence(__ATOMIC_RELEASE, "agent");
            asm volatile("s_waitcnt vmcnt(0)" ::: "memory");
            const unsigned og = xb_add(&bar[XB_TOP], 1u);
            const unsigned tg = og / nx;
            if (og + 1u == (tg + 1u) * nx) xb_add(&bar[XB_TOPGEN], 1u);
            else XB_SPIN(xb_ld(&bar[XB_TOPGEN]) == tg, bar);
            __builtin_amdgcn_fence(__ATOMIC_ACQUIRE, "agent");
            xb_add(&bar[XB_XGEN(b.x)], 1u);
            asm volatile("s_waitcnt vmcnt(0)" ::: "memory");
        } else {
            XB_SPIN(xb_ld(&bar[XB_XGEN(b.x)]) == gen, bar);
            __builtin_amdgcn_fence(__ATOMIC_ACQUIRE, "agent");
            asm volatile("s_waitcnt vmcnt(0)" ::: "memory");
        }
    }
    __syncthreads();
}


struct WaveId { int gw, ngw, wave, lane; };
DEV unsigned f2bf_u(float f) { return (unsigned)f2bf(f); }
DEV unsigned pk2(float lo, float hi) { return cvt_pk_bf16(lo, hi); }

DEV void norm_rows(const WaveId& W, const float* x, const float* g, bf16_t* outb, float* outf, int rows) {
    for (int row = W.gw; row < rows; row += W.ngw) {
        const f32x4* xr = (const f32x4*)(x + (size_t)row * D) + W.lane;
        f32x4 v[4]; float s = 0.f;
#pragma unroll
        for (int j = 0; j < 4; ++j) { v[j] = xr[64 * j]; s += (v[j].x * v[j].x + v[j].y * v[j].y) + (v[j].z * v[j].z + v[j].w * v[j].w); }
        const float r = rsqrtf(wave_sum(s) * (1.f / D) + EPS);
#pragma unroll
        for (int j = 0; j < 4; ++j) {
            const f32x4 gg = ((const f32x4*)g)[W.lane + 64 * j];
            const f32x4 o = {v[j].x * r * gg.x, v[j].y * r * gg.y, v[j].z * r * gg.z, v[j].w * r * gg.w};
            if (outb) { u32x2 w; w.x = pk2(o.x, o.y); w.y = pk2(o.z, o.w); ((u32x2*)(outb + (size_t)row * D))[W.lane + 64 * j] = w; }
            else ((f32x4*)(outf + (size_t)row * D))[W.lane + 64 * j] = o;
        }
    }
}
DEV void cvt_piece(const WaveId& W, LAS float* scr, int& base, const float* Wsrc, int ldw, int K, int col0, int ncols, bf16_t* dst, int ldo, int row0, const float* gain = nullptr) {
    const int nblk = ncols / 32, nitems = (K / 64) * nblk;
    int first = (W.gw - base) % W.ngw; if (first < 0) first += W.ngw;
    base = (base + nitems) % W.ngw;
    for (int item = first; item < nitems; item += W.ngw) {
        const int kb = item / nblk, nb = item - kb * nblk, k0 = 64 * kb, n0 = 32 * nb;
#pragma unroll 8
        for (int i = 0; i < 32; ++i) { const int kk = 2 * i + (W.lane >> 5); scr[kk * 33 + (W.lane & 31)] = Wsrc[(size_t)(k0 + kk) * ldw + col0 + n0 + (W.lane & 31)] * (gain ? gain[k0 + kk] : 1.f); }
        LDS_WAIT(); asm volatile("" ::: "memory");
        const int c = W.lane & 7;
#pragma unroll
        for (int j = 0; j < 4; ++j) { const int n = (W.lane >> 3) + 8 * j; const LAS float* s = scr + (8 * c) * 33 + n;
            u32x4 o; o.x = pk2(s[0 * 33], s[1 * 33]); o.y = pk2(s[2 * 33], s[3 * 33]); o.z = pk2(s[4 * 33], s[5 * 33]); o.w = pk2(s[6 * 33], s[7 * 33]);
            *(u32x4*)(dst + (size_t)(row0 + n0 + n) * ldo + k0 + 8 * c) = o; }
        LDS_WAIT(); asm volatile("" ::: "memory");
    }
}
DEV void convert_layer_weights(const WaveId& W, LAS float* scr, int& base, unsigned char* ws, const float* const* in, int l) {
    const float* wi = in[3] + (size_t)l * D * DIN;
    bf16_t* WIN = (bf16_t*)(ws + WS_WIN); const float* gm = in[2] + l * D; const float* gf = in[14] + l * D;
    cvt_piece(W, scr, base, wi, DIN, D, 0, 1536, WIN, D, 0, gm);
    cvt_piece(W, scr, base, wi, DIN, D, 3072, 1536, WIN, D, 1536, gm);
    cvt_piece(W, scr, base, wi, DIN, D, 4608, 512, WIN, D, 3072, gm);
    cvt_piece(W, scr, base, wi, DIN, D, 1536, 512, WIN, D, 3584, gm);
#pragma unroll 1
    for (int j = 0; j < 4; ++j) { cvt_piece(W, scr, base, wi, DIN, D, 2048 + 128 * j, 128, WIN, D, 4096 + 256 * j, gm); cvt_piece(W, scr, base, wi, DIN, D, 2560 + 128 * j, 128, WIN, D, 4096 + 256 * j + 128, gm); }
    cvt_piece(W, scr, base, wi, DIN, D, 5120, 96, WIN, D, 5120, gm);
    cvt_piece(W, scr, base, wi, DIN, D, 5192, 3072, (bf16_t*)(ws + WS_WG), D, 0, gm);
#pragma unroll 1
    for (int i = 0; i < 3; ++i) cvt_piece(W, scr, base, in[5 + i] + (size_t)l * 512 * D, D, 512, 0, D, (bf16_t*)(ws + WS_WBR) + (size_t)i * D * 512, 512, 0);
    cvt_piece(W, scr, base, in[8] + (size_t)l * D * D, D, D, 0, D, (bf16_t*)(ws + WS_WMIX), D, 0);
    const float* wf = in[15] + (size_t)l * D * 2 * DFF;
#pragma unroll 1
    for (int j = 0; j < 22; ++j) { cvt_piece(W, scr, base, wf, 2 * DFF, D, 128 * j, 128, (bf16_t*)(ws + WS_WUP), D, 256 * j, gf); cvt_piece(W, scr, base, wf, 2 * DFF, D, DFF + 128 * j, 128, (bf16_t*)(ws + WS_WUP), D, 256 * j + 128, gf); }
    cvt_piece(W, scr, base, in[18] + (size_t)l * DFF * D, D, DFF, 0, D, (bf16_t*)(ws + WS_WDOWN), DFF, 0);
}
DEV void prep0_phase(const WaveId& W, LAS float* scr, unsigned char* ws, const float* const* in, bf16_t* XB) {
    int base = 0;
#pragma unroll 1
    for (int l = 0; l < DEPTH; ++l) {
        const float* wq = in[11] + (size_t)l * D * D; bf16_t* WQ = (bf16_t*)(ws + WS_WQ + (size_t)l * 2 * MiB); const float* gx = in[9] + l * D;
        for (size_t i = (size_t)(W.gw * 64 + W.lane) * 4; i < (size_t)D * D; i += (size_t)W.ngw * 256) { const float g = gx[i >> 10]; const f32x4 v = *(const f32x4*)(wq + i); u32x2 o; o.x = pk2(v.x * g, v.y * g); o.y = pk2(v.z * g, v.w * g); *(u32x2*)(WQ + i) = o; }
        cvt_piece(W, scr, base, in[13] + (size_t)l * D * D, D, D, 0, D, (bf16_t*)(ws + WS_WOT + (size_t)l * 2 * MiB), D, 0);
        cvt_piece(W, scr, base, in[12] + (size_t)l * D * 2 * D, 2 * D, D, 0, 2 * D, (bf16_t*)(ws + WS_WKVT + (size_t)l * 4 * MiB), D, 0);
        norm_rows(W, in[1], in[10] + l * D, (bf16_t*)(ws + WS_MEMN + (size_t)l * MiB), nullptr, NB * MEM);
    }
    convert_layer_weights(W, scr, base, ws, in, 0);
    pg8::u64* ss0 = (pg8::u64*)(ws + WS_SS);
    for (int row = W.gw; row < T; row += W.ngw) {
        const f32x4* xr = (const f32x4*)(in[0] + (size_t)row * D) + W.lane; float s = 0.f;
#pragma unroll
        for (int j = 0; j < 4; ++j) { const f32x4 v = xr[64 * j]; s += (v.x * v.x + v.y * v.y) + (v.z * v.z + v.w * v.w);
            u32x2 w; w.x = pk2(v.x, v.y); w.y = pk2(v.z, v.w); ((u32x2*)(XB + (size_t)row * D))[W.lane + 64 * j] = w; }
        s = wave_sum(s); if (W.lane == 0) ss0[row] = (pg8::u64)(s * pg8::SS_SCALE + 0.5f);
    }
}
DEV void final_norm(const WaveId& W, const bf16_t* x, float* out, const float* g, const pg8::u64* ss) {
    for (int row = W.gw; row < T; row += W.ngw) {
        const float r = rsqrtf((float)ss[row] * (1.f / (pg8::SS_SCALE * D)) + EPS); const u32x2* xr = (const u32x2*)(x + (size_t)row * D) + W.lane; f32x4* orow = (f32x4*)(out + (size_t)row * D) + W.lane;
#pragma unroll
        for (int j = 0; j < 4; ++j) { const f32x4 gg = ((const f32x4*)g)[W.lane + 64 * j]; const u32x2 v = xr[64 * j];
            const f32x4 o = {bflo(v.x) * r * gg.x, bfhi(v.x) * r * gg.y, bflo(v.y) * r * gg.z, bfhi(v.y) * r * gg.w}; orow[64 * j] = o; }
    }
}
DEV void conv_sc_phase(int gtid, int gthreads, bf16_t* scb, const bf16_t* cx, const float* w, bool dry) {
    for (int i = gtid; i < T * 64; i += gthreads) {
        const int c8 = (i & 63) * 8, t = i >> 6, tl = t & (S - 1);
        const size_t o = (size_t)t * 512 + c8;
        const u32x4 z = {0u, 0u, 0u, 0u};
        const u32x4 x2 = *(const u32x4*)(cx + o), x1 = tl >= 1 ? *(const u32x4*)(cx + o - 512) : z, x0 = tl >= 2 ? *(const u32x4*)(cx + o - 1024) : z, bb = *(const u32x4*)(scb + o);
        const f32x4 w0a = *(const f32x4*)(w + c8), w0b = *(const f32x4*)(w + c8 + 4), w1a = *(const f32x4*)(w + 512 + c8), w1b = *(const f32x4*)(w + 512 + c8 + 4), w2a = *(const f32x4*)(w + 1024 + c8), w2b = *(const f32x4*)(w + 1024 + c8 + 4);
        float r[8];
#define CONV1(k, W0, W1, W2, X0, X1, X2, BBv, F) r[k] = F(BBv) * (W0 * F(X0) + W1 * F(X1) + W2 * F(X2))
        CONV1(0, w0a.x, w1a.x, w2a.x, x0.x, x1.x, x2.x, bb.x, bflo); CONV1(1, w0a.y, w1a.y, w2a.y, x0.x, x1.x, x2.x, bb.x, bfhi);
        CONV1(2, w0a.z, w1a.z, w2a.z, x0.y, x1.y, x2.y, bb.y, bflo); CONV1(3, w0a.w, w1a.w, w2a.w, x0.y, x1.y, x2.y, bb.y, bfhi);
        CONV1(4, w0b.x, w1b.x, w2b.x, x0.z, x1.z, x2.z, bb.z, bflo); CONV1(5, w0b.y, w1b.y, w2b.y, x0.z, x1.z, x2.z, bb.z, bfhi);
        CONV1(6, w0b.z, w1b.z, w2b.z, x0.w, x1.w, x2.w, bb.w, bflo); CONV1(7, w0b.w, w1b.w, w2b.w, x0.w, x1.w, x2.w, bb.w, bfhi);
#undef CONV1
        u32x4 ov; ov.x = pk2(r[0], r[1]); ov.y = pk2(r[2], r[3]); ov.z = pk2(r[4], r[5]); ov.w = pk2(r[6], r[7]);
        if (!dry) *(u32x4*)(scb + o) = ov; else asm volatile("" :: "v"(ov));
    }
}
DEV float gelu_t(float a) { return a * __builtin_amdgcn_rcpf(1.f + __builtin_amdgcn_exp2f(-1.5957691216057308f * LOG2E * (a + 0.044715f * a * a * a))); }
DEV void ffn_mid_phase(int gtid, int gthreads, const bf16_t* fa, bf16_t* fu, const float* cw, const float* cb, bool dry) {
    constexpr int C8 = DFF / 8;
    for (int i = gtid; i < T * C8; i += gthreads) {
        const int t = i / C8, c8 = (i - t * C8) * 8, tl = t & (S - 1);
        const size_t o = (size_t)t * DFF + c8;
        const u32x4 z = {0u, 0u, 0u, 0u};
        const u32x4 x2 = *(const u32x4*)(fa + o), x1 = tl >= 1 ? *(const u32x4*)(fa + o - DFF) : z, x0 = tl >= 2 ? *(const u32x4*)(fa + o - 2 * DFF) : z, uu = *(const u32x4*)(fu + o);
        const f32x4 w0a = *(const f32x4*)(cw + c8), w0b = *(const f32x4*)(cw + c8 + 4), w1a = *(const f32x4*)(cw + DFF + c8), w1b = *(const f32x4*)(cw + DFF + c8 + 4), w2a = *(const f32x4*)(cw + 2 * DFF + c8), w2b = *(const f32x4*)(cw + 2 * DFF + c8 + 4);
        const f32x4 ba = *(const f32x4*)(cb + c8), bb = *(const f32x4*)(cb + c8 + 4);
        float r[8];
#define FM1(k, B0, W0, W1, W2, X0, X1, X2, Uv, F) r[k] = gelu_t(B0 + W0 * F(X0) + W1 * F(X1) + W2 * F(X2)) * F(Uv)
        FM1(0, ba.x, w0a.x, w1a.x, w2a.x, x0.x, x1.x, x2.x, uu.x, bflo); FM1(1, ba.y, w0a.y, w1a.y, w2a.y, x0.x, x1.x, x2.x, uu.x, bfhi);
        FM1(2, ba.z, w0a.z, w1a.z, w2a.z, x0.y, x1.y, x2.y, uu.y, bflo); FM1(3, ba.w, w0a.w, w1a.w, w2a.w, x0.y, x1.y, x2.y, uu.y, bfhi);
        FM1(4, bb.x, w0b.x, w1b.x, w2b.x, x0.z, x1.z, x2.z, uu.z, bflo); FM1(5, bb.y, w0b.y, w1b.y, w2b.y, x0.z, x1.z, x2.z, uu.z, bfhi);
        FM1(6, bb.z, w0b.z, w1b.z, w2b.z, x0.w, x1.w, x2.w, uu.w, bflo); FM1(7, bb.w, w0b.w, w1b.w, w2b.w, x0.w, x1.w, x2.w, uu.w, bfhi);
#undef FM1
        u32x4 ov; ov.x = pk2(r[0], r[1]); ov.y = pk2(r[2], r[3]); ov.z = pk2(r[4], r[5]); ov.w = pk2(r[6], r[7]);
        if (!dry) *(u32x4*)(fu + o) = ov; else asm volatile("" :: "v"(ov));
    }
}

typedef short s16x4 __attribute__((ext_vector_type(4)));
DEV s16x4 vtr(const LAS unsigned char* p) { return __builtin_bit_cast(s16x4, __builtin_amdgcn_ds_read_tr16_b64_v4i16((LAS s16x4*)p)); }
DEV bf16x8 cat8(const s16x4 a, const s16x4 b) { return (bf16x8){a[0], a[1], a[2], a[3], b[0], b[1], b[2], b[3]}; }
DEV bf16x8 pk8(float a0, float a1, float a2, float a3, float a4, float a5, float a6, float a7) {
    u32x4 w; w.x = pk2(a0, a1); w.y = pk2(a2, a3); w.z = pk2(a4, a5); w.w = pk2(a6, a7); return __builtin_bit_cast(bf16x8, w); }
constexpr int VPITCH = 192;
DEV void pv_tile(f32x16& o0, f32x16& o1, const LAS unsigned char* vt, int lane, const bf16x8 (&pk)[4]) {
    const int hi = lane >> 5;
    const LAS unsigned char* vb = vt + (4 * hi + ((lane & 15) >> 2)) * VPITCH + ((lane >> 4) & 1) * 32 + (lane & 3) * 8;
    bf16x8 va[4];
#pragma unroll
    for (int ks = 0; ks < 4; ++ks) va[ks] = cat8(vtr(vb + (16 * ks) * VPITCH), vtr(vb + (16 * ks + 8) * VPITCH));
    asm volatile("" : "+v"(va[0]), "+v"(va[1]), "+v"(va[2]), "+v"(va[3]));
#pragma unroll
    for (int ks = 0; ks < 4; ++ks) o0 = __builtin_amdgcn_mfma_f32_32x32x16_bf16(va[ks], pk[ks], o0, 0, 0, 0);
#pragma unroll
    for (int ks = 0; ks < 4; ++ks) va[ks] = cat8(vtr(vb + (16 * ks) * VPITCH + 64), vtr(vb + (16 * ks + 8) * VPITCH + 64));
    asm volatile("" : "+v"(va[0]), "+v"(va[1]), "+v"(va[2]), "+v"(va[3]));
#pragma unroll
    for (int ks = 0; ks < 4; ++ks) o1 = __builtin_amdgcn_mfma_f32_32x32x16_bf16(va[ks], pk[ks], o1, 0, 0, 0);
}
DEV void store_ot(bf16_t* orow, const f32x16& o0, const f32x16& o1, int hi, float sc) {
#pragma unroll
    for (int g4 = 0; g4 < 4; ++g4) {
        u32x2 a; a.x = pk2(o0[4 * g4] * sc, o0[4 * g4 + 1] * sc); a.y = pk2(o0[4 * g4 + 2] * sc, o0[4 * g4 + 3] * sc);
        u32x2 b; b.x = pk2(o1[4 * g4] * sc, o1[4 * g4 + 1] * sc); b.y = pk2(o1[4 * g4 + 2] * sc, o1[4 * g4 + 3] * sc);
        *(u32x2*)(orow + 8 * g4 + 4 * hi) = a; *(u32x2*)(orow + 32 + 8 * g4 + 4 * hi) = b;
    }
}

DEV void sb_item(LAS unsigned char* vl, const bf16_t* Q, const bf16_t* Kk, const bf16_t* V, bf16_t* O, int b, int h, int qb, int lane, bool dry) {
    const int r32 = lane & 31, hi = lane >> 5, t0 = 32 * qb, t = t0 + r32; const size_t rowb = (size_t)b * S;
    bf16x8 qr[4]; { const bf16_t* qp = Q + (rowb + t0 + r32) * 512 + h * 64 + 8 * hi;
#pragma unroll
        for (int d0 = 0; d0 < 4; ++d0) qr[d0] = *(const bf16x8*)(qp + 16 * d0); }
    f32x16 o0, o1;
#pragma unroll
    for (int r = 0; r < 16; ++r) { o0[r] = 0.f; o1[r] = 0.f; }
    float carry = 1.f;
    const int c_hi = (t0 + 30) >> 6;
#pragma unroll 1
    for (int c = c_hi; c >= 0; --c) {
        const bf16_t* kp = Kk + (rowb + 64 * c + r32) * 512 + h * 64 + 8 * hi;
        bf16x8 k0[4], k1[4];
#pragma unroll
        for (int d0 = 0; d0 < 4; ++d0) { k0[d0] = *(const bf16x8*)(kp + 16 * d0); k1[d0] = *(const bf16x8*)(kp + (size_t)32 * 512 + 16 * d0); }
#pragma unroll
        for (int j = 0; j < 8; ++j) { const int row = (lane >> 3) + 8 * j; *(LAS u32x4*)(vl + row * VPITCH + (lane & 7) * 16) = *(const u32x4*)(V + (rowb + 64 * c + row) * 512 + h * 64 + (lane & 7) * 8); }
        f32x16 p0, p1;
#pragma unroll
        for (int r = 0; r < 16; ++r) { p0[r] = 0.f; p1[r] = 0.f; }
#pragma unroll
        for (int d0 = 0; d0 < 4; ++d0) { p0 = __builtin_amdgcn_mfma_f32_32x32x16_bf16(k0[d0], qr[d0], p0, 0, 0, 0); p1 = __builtin_amdgcn_mfma_f32_32x32x16_bf16(k1[d0], qr[d0], p1, 0, 0, 0); }
        float u[32];
        const bool diag = (c == c_hi);
#pragma unroll
        for (int e = 0; e < 32; ++e) {
            const float z = e < 16 ? p0[e] : p1[e - 16];
            float uu = __builtin_amdgcn_rcpf(1.f + __builtin_amdgcn_exp2f(fminf(z, 126.f)));
            if (diag) { const int kv = 64 * c + 8 * ((e >> 2) & 3) + 4 * hi + (e & 3) + 32 * (e >> 4); if (kv >= t) uu = 1.f; }
            u[e] = uu;
        }
        float gl[8], gh[8];
#pragma unroll
        for (int i = 0; i < 8; ++i) { const float gp = (u[4 * i] * u[4 * i + 1]) * (u[4 * i + 2] * u[4 * i + 3]);
            const auto rr = __builtin_amdgcn_permlane32_swap(__float_as_uint(gp), __float_as_uint(gp), false, false); gl[i] = __uint_as_float(rr[0]); gh[i] = __uint_as_float(rr[1]); }
        float ag[8]; float run = carry;
#pragma unroll
        for (int i = 7; i >= 0; --i) { const float a_hi = run; run *= gh[i]; const float a_lo = run; run *= gl[i]; ag[i] = hi ? a_hi : a_lo; }
        carry = run;
        bf16x8 pk[4];
#pragma unroll
        for (int ks = 0; ks < 4; ++ks) { float w[8];
#pragma unroll
            for (int g = 0; g < 2; ++g) { const int i = 2 * ks + g;
                const float a3 = ag[i], a2 = a3 * u[4 * i + 3], a1 = a2 * u[4 * i + 2], a0 = a1 * u[4 * i + 1];
                w[4 * g] = (1.f - u[4 * i]) * a0; w[4 * g + 1] = (1.f - u[4 * i + 1]) * a1; w[4 * g + 2] = (1.f - u[4 * i + 2]) * a2; w[4 * g + 3] = (1.f - u[4 * i + 3]) * a3; }
            pk[ks] = pk8(w[0], w[1], w[2], w[3], w[4], w[5], w[6], w[7]); }
        pv_tile(o0, o1, vl, lane, pk);
        if (__all(carry < 7.8e-31f)) break;
    }
    if (!dry) store_ot(O + (rowb + t0 + r32) * 512 + h * 64, o0, o1, hi, 1.f); else asm volatile("" :: "v"(o0), "v"(o1));
}
DEV void sb_phase(const WaveId& W, LAS unsigned char* lds, unsigned char* ws, bool dry) {
    LAS unsigned char* vl = lds + W.wave * 12288;
    const bf16_t* Q = (const bf16_t*)(ws + WS_QA); const bf16_t* Kk = (const bf16_t*)(ws + WS_KA); const bf16_t* V = (const bf16_t*)(ws + WS_VA);
    constexpr int NITEM = NB * 8 * (S / 32);
    for (int it = W.gw; it < NITEM; it += W.ngw) {
        const int qb = it & 255, h = (it >> 8) & 7, b = it >> 11;
        sb_item(vl, Q, Kk, V, (bf16_t*)(ws + WS_QA), b, h, qb, W.lane, dry);
    }
}

constexpr int IDX_CTL_OFF = 131072 + 1024;
DEV unsigned fkey2(float v) { const int u = (int)__float_as_uint(v); return (unsigned)(u ^ ((u >> 31) | (int)0x80000000)); }
DEV float relu1(float x) { return __builtin_amdgcn_fmed3f(x, 0.f, 3.0e38f); }
DEV void idx_unit(LAS unsigned char* lds, const bf16_t* IQ, const bf16_t* IK, const float* IWp, unsigned* BM, int b, int t0, int wid, int lane, int mslot) {
    const int r32 = lane & 31, hh = lane >> 5; const size_t rowb = (size_t)b * S;
    bf16x8 afr[4]; { const int qi = 2 * (r32 >> 4) + ((r32 >> 2) & 1), head = (r32 & 3) + 4 * ((r32 >> 3) & 1);
        const bf16_t* ap = IQ + (rowb + t0 + qi) * 512 + head * 64 + 8 * hh;
#pragma unroll
        for (int ks = 0; ks < 4; ++ks) afr[ks] = *(const bf16x8*)(ap + 16 * ks); }
    float w[16];
#pragma unroll
    for (int r = 0; r < 16; ++r) w[r] = IWp[(rowb + t0 + 2 * (r >> 3) + hh) * 8 + (r & 7)];
    const int tmax = t0 + 3, jmax = tmax >> 5;
    LAS unsigned* SCO = (LAS unsigned*)lds;
    bf16x8 b0[4], b1[4], b2[4];
#pragma unroll
    for (int ks = 0; ks < 4; ++ks) { b0[ks] = afr[ks]; b1[ks] = afr[ks]; b2[ks] = afr[ks]; }
#define IDX_LOADB(dst, jj) do { const int jc_ = (jj) < jmax ? (jj) : jmax; const bf16_t* bp_ = IK + ((rowb >> 5) + jc_) * 2048 + (hh * 32 + r32) * 8; \
        _Pragma("unroll") for (int ks = 0; ks < 4; ++ks) dst[ks] = *(const bf16x8*)(bp_ + ks * 512); } while (0)
#define IDX_COMP(src, jj) do { f32x16 acc; _Pragma("unroll") for (int r = 0; r < 16; ++r) acc[r] = 0.f; \
        _Pragma("unroll") for (int ks = 0; ks < 4; ++ks) acc = __builtin_amdgcn_mfma_f32_32x32x16_bf16(afr[ks], src[ks], acc, 0, 0, 0); \
        float s0 = 0.f, s1 = 0.f; _Pragma("unroll") for (int hd = 0; hd < 8; ++hd) { s0 += w[hd] * relu1(acc[hd]); s1 += w[8 + hd] * relu1(acc[8 + hd]); } \
        unsigned k0_ = fkey2(s0), k1_ = fkey2(s1); const int key = 32 * (jj) + r32; \
        if ((jj) >= jmax) { k0_ = key <= t0 + hh ? k0_ : 0u; k1_ = key <= t0 + 2 + hh ? k1_ : 0u; }     \
        if ((jj) <= jmax) { SCO[hh * 8192 + key] = k0_; SCO[(2 + hh) * 8192 + key] = k1_; } } while (0)
#ifndef IDX_REP_MFMA
#define IDX_REP_MFMA 1
#endif
#ifndef IDX_REP_SEL
#define IDX_REP_SEL 1
#endif
#pragma unroll 1
    for (int rpm = 0; rpm < IDX_REP_MFMA; ++rpm) {
    IDX_LOADB(b0, wid); IDX_LOADB(b1, wid + 8);
#pragma unroll 1
    for (int j = wid; j <= jmax; j += 24) {
        IDX_LOADB(b2, j + 16); IDX_COMP(b0, j);
        IDX_LOADB(b0, j + 24); IDX_COMP(b1, j + 8);
        IDX_LOADB(b1, j + 32); IDX_COMP(b2, j + 16);
    }
    }
#undef IDX_LOADB
#undef IDX_COMP
    LAS unsigned* thr = (LAS unsigned*)(lds + IDX_CTL_OFF);
    if (wid == 0 && lane < 32) ((LAS unsigned*)(lds + IDX_CTL_OFF + 64))[lane] = 0u;
    LDS_WAIT(); __builtin_amdgcn_s_barrier(); asm volatile("" ::: "memory");
    {
        const int q = wid & 3, h = wid >> 2, n = t0 + q + 1;
        volatile LAS unsigned* xme = (volatile LAS unsigned*)(lds + IDX_CTL_OFF + 64) + (q * 2 + h) * 4;
        volatile LAS unsigned* xpa = (volatile LAS unsigned*)(lds + IDX_CTL_OFF + 64) + (q * 2 + (h ^ 1)) * 4;
        unsigned T_ = 1u;
        if (n > 256) {
            LAS unsigned* row = SCO + q * 8192 + lane;
            unsigned r[64];
#pragma unroll
            for (int il = 0; il < 64; ++il) r[il] = (2 * (2 * il + h) + hh <= jmax) ? row[64 * (2 * il + h)] : 0u;
            unsigned seq = 0u;
#define IDX_XCHG(val, out) do { ++seq; const int pb_ = (seq & 1u) * 2; if (lane == 0) { xme[pb_ + 1] = (val); xme[pb_] = seq; } \
                while (xpa[pb_] != seq) __builtin_amdgcn_s_sleep(0); (out) = xpa[pb_ + 1]; } while (0)
#define IDX_XCHG16(val, out) do { ++seq; const int pb_ = (seq & 1u) * 2; if (lane == 0) xme[pb_] = (seq << 16) | (val); unsigned w_; \
                while (((w_ = xpa[pb_]) >> 16) != (seq & 0xffffu)) __builtin_amdgcn_s_sleep(0); (out) = w_ & 0xffffu; } while (0)
#pragma unroll 1
            for (int rps = 0; rps < IDX_REP_SEL; ++rps) {
            unsigned mx = 0u;
#pragma unroll
            for (int il = 0; il < 64; ++il) mx = max(mx, r[il]);
#pragma unroll
            for (int o = 1; o < 64; o <<= 1) mx = max(mx, (unsigned)__shfl_xor((int)mx, o));
            { unsigned pm_; IDX_XCHG(mx, pm_); mx = max(mx, pm_); }
            unsigned lo_ = 1u, hi_ = mx + 1u, chi_ = 0u, xgt_ = 1u, xeq_ = 0u, mt_ = 0u; float glo_ = __log2f((float)n) - 8.f, ghi_ = -9.f; int side_ = 0; bool done_ = false;
#pragma unroll 1
            for (int pass = 0; pass < 2 && !done_; ++pass) {
                const unsigned wdt = hi_ - lo_;
                unsigned off;
                if (pass < 2) {
                    const unsigned mkey = hi_ - 1u; const unsigned tgt = pass == 0 ? mkey - (1u << 23) : mkey - (3u << 23);
                    const bool ok = pass == 0 ? (mkey > 0x81000000u) : (mkey > 0x82000000u && tgt > lo_ && tgt < hi_);
                    off = ok ? tgt - lo_ : wdt >> 1;
                } else if ((pass & 3) == 3) off = wdt >> 1;
                else off = (unsigned)(glo_ * __builtin_amdgcn_rcpf(glo_ - ghi_) * (float)wdt);
                off = off < 1u ? 1u : (off > wdt - 1u ? wdt - 1u : off);
                const unsigned cand = (unsigned)__builtin_amdgcn_readfirstlane((int)(lo_ + off));
                unsigned ca_ = 0, cb_ = 0; const unsigned candv = lo_ + off;
#define IDX_CNT4(A, B, C, Dd) asm volatile("v_cmp_ge_u32_e64 s[88:89], %2, %6\n\tv_cmp_ge_u32_e64 s[90:91], %3, %6\n\tv_cmp_ge_u32_e64 s[92:93], %4, %6\n\tv_cmp_ge_u32_e64 s[94:95], %5, %6\n\t" \
                    "v_addc_co_u32_e64 %0, s[88:89], %0, 0, s[88:89]\n\tv_addc_co_u32_e64 %1, s[90:91], %1, 0, s[90:91]\n\tv_addc_co_u32_e64 %0, s[92:93], %0, 0, s[92:93]\n\tv_addc_co_u32_e64 %1, s[94:95], %1, 0, s[94:95]" \
                    : "+v"(ca_), "+v"(cb_) : "v"(A), "v"(B), "v"(C), "v"(Dd), "v"(candv) : "s88", "s89", "s90", "s91", "s92", "s93", "s94", "s95")
#pragma unroll
                for (int il = 0; il < 64; il += 4) IDX_CNT4(r[il], r[il + 1], r[il + 2], r[il + 3]);
#undef IDX_CNT4
                int pk = (int)(ca_ + cb_);
                pk += __builtin_amdgcn_update_dpp(0, pk, 0x111, 0xf, 0xf, false);
                pk += __builtin_amdgcn_update_dpp(0, pk, 0x112, 0xf, 0xf, false);
                pk += __builtin_amdgcn_update_dpp(0, pk, 0x114, 0xf, 0xf, false);
                pk += __builtin_amdgcn_update_dpp(0, pk, 0x118, 0xf, 0xf, false);
                pk += __builtin_amdgcn_update_dpp(0, pk, 0x142, 0xa, 0xf, false);
                unsigned tot = (unsigned)__builtin_amdgcn_readlane(pk, 31) + (unsigned)__builtin_amdgcn_readlane(pk, 63);
                { unsigned pt_; IDX_XCHG16(tot, pt_); tot += pt_; }
                const float gc = __log2f(fmaxf((float)tot, 0.5f)) - 8.f;
                if (tot == 256u) { xgt_ = cand; mt_ = 0u; done_ = true; }
                else { if (tot > 256u) { if (side_ == 1) ghi_ *= 0.5f; lo_ = cand; glo_ = gc; side_ = 1; }
                       else { if (side_ == 2) glo_ *= 0.5f; hi_ = cand; ghi_ = gc; chi_ = tot; side_ = 2; }
                       if (hi_ - lo_ == 1u) { xgt_ = hi_; xeq_ = lo_; mt_ = 256u - chi_; done_ = true; } }
            }
            { LAS unsigned* hist = (LAS unsigned*)(lds + IDX_CTL_OFF + 1024) + q * 256;
#pragma unroll 1
              for (int round = 0; round < 6 && !done_; ++round) {
                const unsigned wdt = hi_ - lo_;
                const int sh = wdt <= 256u ? 0 : 24 - (int)__builtin_clz(wdt - 1u);
                hist[128 * h + lane] = 0u; hist[128 * h + 64 + lane] = 0u;
                LDS_WAIT(); { unsigned d_; IDX_XCHG16(0u, d_); (void)d_; }
                const unsigned lov = lo_;
#pragma unroll
                for (int il = 0; il < 64; ++il) { const unsigned d = r[il] - lov; if (d < wdt) __hip_atomic_fetch_add(hist + (d >> sh), 1u, __ATOMIC_RELAXED, __HIP_MEMORY_SCOPE_WORKGROUP); }
                LDS_WAIT(); { unsigned d_; IDX_XCHG16(0u, d_); (void)d_; }
                const u32x4 hb = *(const LAS u32x4*)(hist + 4 * lane);
                const unsigned s4 = (hb.x + hb.y) + (hb.z + hb.w);
                unsigned suf = s4;
#pragma unroll
                for (int o = 1; o < 64; o <<= 1) { const unsigned tv = (unsigned)__shfl_down((int)suf, o); if (lane + o < 64) suf += tv; }
                const unsigned long long okm = __ballot(chi_ + suf >= 256u);
                const int L = 63 - (int)__builtin_clzll(okm);
                const unsigned above = chi_ + (unsigned)__builtin_amdgcn_readlane((int)(suf - s4), L);
                const unsigned h0 = (unsigned)__builtin_amdgcn_readlane((int)hb.x, L), h1 = (unsigned)__builtin_amdgcn_readlane((int)hb.y, L),
                               h2 = (unsigned)__builtin_amdgcn_readlane((int)hb.z, L), h3 = (unsigned)__builtin_amdgcn_readlane((int)hb.w, L);
                unsigned Bsel, cab, cnb;
                if (above + h3 >= 256u) { Bsel = 3u; cab = above; cnb = h3; }
                else if (above + h3 + h2 >= 256u) { Bsel = 2u; cab = above + h3; cnb = h2; }
                else if (above + h3 + h2 + h1 >= 256u) { Bsel = 1u; cab = above + h3 + h2; cnb = h1; }
                else { Bsel = 0u; cab = above + h3 + h2 + h1; cnb = h0; }
                Bsel += 4u * (unsigned)L;
                const unsigned nlo = lo_ + (Bsel << sh); unsigned nhi = nlo + (1u << sh); if (nhi > hi_ || nhi < nlo) nhi = hi_;
                if (cab + cnb == 256u) { xgt_ = nlo; mt_ = 0u; done_ = true; }
                else if (sh == 0) { xgt_ = nlo + 1u; xeq_ = nlo; mt_ = 256u - cab; done_ = true; }
                else { lo_ = nlo; hi_ = nhi; chi_ = cab; }
              } }
#ifdef IDX_XTRA
#pragma unroll 1
            for (int xr = 0; xr < IDX_XTRA; ++xr) { unsigned dsum = 0; const unsigned cv = xgt_ + (unsigned)xr;
#pragma unroll
                for (int il = 0; il < 64; ++il) dsum += r[il] >= cv;
                int pk = (int)dsum;
                pk += __builtin_amdgcn_update_dpp(0, pk, 0x111, 0xf, 0xf, false); pk += __builtin_amdgcn_update_dpp(0, pk, 0x112, 0xf, 0xf, false); pk += __builtin_amdgcn_update_dpp(0, pk, 0x114, 0xf, 0xf, false);
                pk += __builtin_amdgcn_update_dpp(0, pk, 0x118, 0xf, 0xf, false); pk += __builtin_amdgcn_update_dpp(0, pk, 0x142, 0xa, 0xf, false);
                unsigned tot = (unsigned)__builtin_amdgcn_readlane(pk, 31) + (unsigned)__builtin_amdgcn_readlane(pk, 63);
                { unsigned pt_; IDX_XCHG16(tot, pt_); tot += pt_; } asm volatile("" :: "s"(tot)); }
#endif
            T_ = xgt_;
            if (mt_ != 0u) {
                if (h == 0) { unsigned run = 0u;
#pragma unroll 1
                    for (int i = 0; i <= (jmax >> 1); ++i) { const bool ok_ = 2 * i + hh <= jmax; const unsigned kv = ok_ ? row[64 * i] : 0u; const bool eq = kv == xeq_; const unsigned long long bm = __ballot(eq);
                        const unsigned rank = run + __builtin_amdgcn_mbcnt_hi((unsigned)(bm >> 32), __builtin_amdgcn_mbcnt_lo((unsigned)bm, 0u));
                        if (eq && rank >= mt_) row[64 * i] = 0u;
                        run += (unsigned)__popcll(bm); } }
                T_ = xeq_;
            }
            }
#undef IDX_XCHG
#undef IDX_XCHG16
        }
        if (lane == 0 && h == 0) thr[q] = T_;
    }
#ifdef PROBE_VALU
    { float a0 = (float)lane, a1 = a0 + 1.f, a2 = a0 + 2.f, a3 = a0 + 3.f, a4 = a0 + 4.f, a5 = a0 + 5.f, a6 = a0 + 6.f, a7 = a0 + 7.f; const float m = 1.0000001f, c = 1e-9f;
#pragma unroll 1
      for (int it = 0; it < 64; ++it) {
#pragma unroll
          for (int u = 0; u < 8; ++u) { a0 = a0 * m + c; a1 = a1 * m + c; a2 = a2 * m + c; a3 = a3 * m + c; a4 = a4 * m + c; a5 = a5 * m + c; a6 = a6 * m + c; a7 = a7 * m + c; } }
      asm volatile("" :: "v"(a0), "v"(a1), "v"(a2), "v"(a3), "v"(a4), "v"(a5), "v"(a6), "v"(a7)); }
#endif
    LDS_WAIT(); __builtin_amdgcn_s_barrier(); asm volatile("" ::: "memory");
    { const unsigned tq0 = thr[hh], tq1 = thr[2 + hh];
#pragma unroll 4
      for (int j = wid; j <= ((t0 | 63) >> 5); j += 8) {
          bool s0 = false, s1 = false;
          if (j <= jmax) { s0 = SCO[hh * 8192 + 32 * j + r32] >= tq0; s1 = SCO[(2 + hh) * 8192 + 32 * j + r32] >= tq1; }
          const unsigned long long b0_ = __ballot(s0), b1_ = __ballot(s1);
          if (lane == 0) { u32x4 o; o.x = (unsigned)b0_; o.y = (unsigned)(b0_ >> 32); o.z = (unsigned)b1_; o.w = (unsigned)(b1_ >> 32); *(u32x4*)(BM + ((size_t)b * 256 + j) * S + t0) = o; }
      } }
    LDS_WAIT(); __builtin_amdgcn_s_barrier();
}
DEV void idx_phase(LAS unsigned char* lds, unsigned char* ws, int vcu, int G, int wid, int lane) {
    constexpr int NUNIT = T / 4;
    for (int k = 0; k * G < NUNIT; ++k) {
        const int un = k * G + ((k & 1) ? G - 1 - vcu : vcu); if (un >= NUNIT) break;
        const int b = un / (S / 4), t0 = (un - b * (S / 4)) * 4;
        idx_unit(lds, (const bf16_t*)(ws + WS_IQ), (const bf16_t*)(ws + WS_IK), (const float*)(ws + WS_IW), (unsigned*)(ws + WS_BM), b, t0, wid, lane, k & 1);
    }
}

constexpr int DSA_STAGE = 8192 + 64 * VPITCH;
DEV void dsa_unit(LAS unsigned char* lds, const bf16_t* Q, const bf16_t* Kk, const bf16_t* V, const unsigned* BM, bf16_t* O, int b, int h, int qblk, int tid, int wid, int lane) {
    const int r32 = lane & 31, hi = lane >> 5, q0 = 256 * qblk, t0 = q0 + 32 * wid, t = t0 + r32; const size_t rowb = (size_t)b * S;
    bf16x8 qr[4]; { const bf16_t* qp = Q + (rowb + t) * 512 + h * 64 + 8 * hi;
#pragma unroll
        for (int d0 = 0; d0 < 4; ++d0) qr[d0] = *(const bf16x8*)(qp + 16 * d0); }
    f32x16 o0, o1, negm;
#pragma unroll
    for (int r = 0; r < 16; ++r) { o0[r] = 0.f; o1[r] = 0.f; negm[r] = 0.f; }
    float mref = 0.f, lsum = 0.f; bool seen = false;
    constexpr float THR = 8.f;
    const int ntile = (q0 + 256) / 64, wlast = (t0 + 31) >> 6;
    const int srow = tid >> 3, sch = tid & 7;
    const bf16_t* kg = Kk + (rowb + srow) * 512 + h * 64 + sch * 8; const bf16_t* vg = V + (rowb + srow) * 512 + h * 64 + sch * 8;
    const int kdst = srow * 128 + ((sch ^ (srow & 7)) * 16), vdst = srow * VPITCH + sch * 16;
    u32x4 kr0 = *(const u32x4*)kg, vr0 = *(const u32x4*)vg;
    *(LAS u32x4*)(lds + kdst) = kr0; *(LAS u32x4*)(lds + 8192 + vdst) = vr0;
    u32x4 kr1 = *(const u32x4*)(kg + (size_t)64 * 512), vr1 = *(const u32x4*)(vg + (size_t)64 * 512);
    const unsigned* bmp = BM + (size_t)b * 256 * S + t;
    unsigned mw0 = bmp[0], mw1 = bmp[(size_t)S];
    const int koff = r32 * 128;
    __syncthreads();
#define DSA_TILE(c, BUF, NBUF, KL, VL, KW, VW) do { \
        const LAS unsigned char* kt = lds + (BUF) * DSA_STAGE; const LAS unsigned char* vt = kt + 8192; \
        if ((c) + 2 < ntile) { KL = *(const u32x4*)(kg + (size_t)((c) + 2) * 64 * 512); VL = *(const u32x4*)(vg + (size_t)((c) + 2) * 64 * 512); } \
        unsigned nw0 = 0u, nw1 = 0u; \
        if ((c) + 1 <= wlast) { nw0 = bmp[(size_t)(2 * (c) + 2) * S]; nw1 = bmp[(size_t)(2 * (c) + 3) * S]; } \
        if ((c) <= wlast) { \
            bf16x8 kf[8]; \
            _Pragma("unroll") for (int d0 = 0; d0 < 4; ++d0) { const int xo = ((2 * d0 + hi) ^ (r32 & 7)) * 16; \
                kf[2 * d0] = *(const LAS bf16x8*)(kt + koff + xo); kf[2 * d0 + 1] = *(const LAS bf16x8*)(kt + koff + 4096 + xo); } \
            asm volatile("" : "+v"(kf[0]), "+v"(kf[1]), "+v"(kf[2]), "+v"(kf[3]), "+v"(kf[4]), "+v"(kf[5]), "+v"(kf[6]), "+v"(kf[7]));     \
            f32x16 p0 = negm, p1 = negm; \
            _Pragma("unroll") for (int d0 = 0; d0 < 4; ++d0) { p0 = __builtin_amdgcn_mfma_f32_32x32x16_bf16(kf[2 * d0], qr[d0], p0, 0, 0, 0); p1 = __builtin_amdgcn_mfma_f32_32x32x16_bf16(kf[2 * d0 + 1], qr[d0], p1, 0, 0, 0); } \
            const unsigned m0 = mw0 >> (4 * hi), m1 = mw1 >> (4 * hi); \
            _Pragma("unroll") for (int r = 0; r < 16; ++r) { const int bit = (r & 3) + 8 * (r >> 2); \
                const unsigned e0 = (unsigned)__builtin_amdgcn_sbfe((int)m0, bit, 1), e1 = (unsigned)__builtin_amdgcn_sbfe((int)m1, bit, 1); \
                p0[r] = __uint_as_float((__float_as_uint(p0[r]) & e0) | (0xff800000u & ~e0)); p1[r] = __uint_as_float((__float_as_uint(p1[r]) & e1) | (0xff800000u & ~e1)); } \
            float rm = -INFINITY; \
            _Pragma("unroll") for (int r = 0; r < 16; r += 2) rm = fmaxf(rm, fmaxf(fmaxf(p0[r], p0[r + 1]), fmaxf(p1[r], p1[r + 1]))); \
            { const auto rr = __builtin_amdgcn_permlane32_swap(__float_as_uint(rm), __float_as_uint(rm), false, false); rm = fmaxf(__uint_as_float(rr[0]), __uint_as_float(rr[1])); } \
            const bool shift = rm > THR || (rm < -THR && rm > -INFINITY && !seen);     \
            seen = seen || rm > -INFINITY; \
            if (__any(shift)) { \
                const float dl = shift ? rm : 0.f, f = dl > 0.f ? __builtin_amdgcn_exp2f(-dl) : 1.f; \
                mref += dl; lsum *= f; \
                _Pragma("unroll") for (int r = 0; r < 16; ++r) { p0[r] -= dl; p1[r] -= dl; o0[r] *= f; o1[r] *= f; negm[r] = -mref; } \
            } \
            float ps = 0.f; \
            _Pragma("unroll") for (int r = 0; r < 16; ++r) { p0[r] = __builtin_amdgcn_exp2f(p0[r]); p1[r] = __builtin_amdgcn_exp2f(p1[r]); ps += p0[r] + p1[r]; } \
            lsum += ps; \
            bf16x8 pk[4]; \
            pk[0] = pk8(p0[0], p0[1], p0[2], p0[3], p0[4], p0[5], p0[6], p0[7]); pk[1] = pk8(p0[8], p0[9], p0[10], p0[11], p0[12], p0[13], p0[14], p0[15]); \
            pk[2] = pk8(p1[0], p1[1], p1[2], p1[3], p1[4], p1[5], p1[6], p1[7]); pk[3] = pk8(p1[8], p1[9], p1[10], p1[11], p1[12], p1[13], p1[14], p1[15]); \
            pv_tile(o0, o1, vt, lane, pk); \
        } \
        mw0 = nw0; mw1 = nw1; \
        if ((c) + 1 < ntile) { LAS unsigned char* nb = lds + (NBUF) * DSA_STAGE; *(LAS u32x4*)(nb + kdst) = KW; *(LAS u32x4*)(nb + 8192 + vdst) = VW; } \
        asm volatile("s_waitcnt lgkmcnt(0)" ::: "memory"); __builtin_amdgcn_s_barrier(); asm volatile("" ::: "memory"); } while (0)
#pragma unroll 1
    for (int c = 0; c < ntile; c += 2) { DSA_TILE(c, 0, 1, kr0, vr0, kr1, vr1); DSA_TILE(c + 1, 1, 0, kr1, vr1, kr0, vr0); }
#undef DSA_TILE
    { const auto rr = __builtin_amdgcn_permlane32_swap(__float_as_uint(lsum), __float_as_uint(lsum), false, false); lsum = __uint_as_float(rr[0]) + __uint_as_float(rr[1]); }
    store_ot(O + (rowb + t) * 512 + h * 64, o0, o1, hi, 1.f / lsum);
}
DEV void dsa_phase(LAS unsigned char* lds, unsigned char* ws, int vcu, int G, int tid, int wid, int lane, bf16_t* Oout) {
    constexpr int NPAIR = NB * 8 * 16;
    for (int pr = vcu; pr < NPAIR; pr += G) {
        const int bh = pr >> 4, s = pr & 15, b = bh >> 3, h = bh & 7;
#pragma unroll 1
        for (int k = 0; k < 2; ++k) {
            const int qblk = k == 0 ? s : 31 - s;
            dsa_unit(lds, (const bf16_t*)(ws + WS_QC), (const bf16_t*)(ws + WS_KC), (const bf16_t*)(ws + WS_VC), (const unsigned*)(ws + WS_BM), Oout, b, h, qblk, tid, wid, lane);
        }
    }
}
constexpr int MK_THREADS = 512;
constexpr int RING_BYTES = 131072, MISC_OFF = RING_BYTES + 320, MK_LDS_BYTES = 147456;
constexpr size_t WS_CTL = 0, CTL_ZERO_BYTES = 65536 + 7 * 131072; constexpr int CW_BAR = 4096;
constexpr int PH_PREP0 = 0, PH_KV = 1, PH_GH = 2, PH_L0 = 3, PH_PER_LAYER = 14, NPH = PH_L0 + 2 * PH_PER_LAYER;
enum { Q_INPROJ = 0, Q_SBIDX, Q_DSA, Q_GATES, Q_MERGE, Q_MIX, Q_NORMXA, Q_XALOG, Q_XAOUT, Q_NORMFFN, Q_UP, Q_FFNMID, Q_DOWN, Q_NEXT };

#ifndef QBUILD
#define QBUILD 0xffffu
#endif
#define QON(x) ((QBUILD >> (x)) & 1u)
struct Args { const float* in[20]; float* out; unsigned char* ws; int ph_lo, ph_hi; };

__global__ void __launch_bounds__(MK_THREADS, 2) mk_fwd(Args args) {
    __shared__ __attribute__((aligned(16))) unsigned char lds_raw[MK_LDS_BYTES];
    LAS unsigned char* lds = (LAS unsigned char*)lds_raw;
    volatile LAS unsigned* MISC = (volatile LAS unsigned*)(lds + MISC_OFF);
    const int G = gridDim.x, bx = blockIdx.x;
    unsigned char* ws0 = args.ws;
    const int wave_s = __builtin_amdgcn_readfirstlane((int)threadIdx.x >> 6);
    for (int u = mk_tid(wave_s); u < (MK_LDS_BYTES - RING_BYTES) / 4; u += MK_THREADS) ((LAS unsigned*)(lds + RING_BYTES))[u] = 0u;
    __syncthreads();
    const int lo = args.ph_lo, hi = args.ph_hi;
    XcdBarrier bar; bar.bar = (unsigned*)(ws0 + WS_CTL) + CW_BAR; bar.x = 0; bar.st = nullptr;
    if (hi - lo > 1) bar = xcd_barrier_post((unsigned*)(ws0 + WS_CTL) + CW_BAR, MISC + 8, mk_tid(wave_s));
#define BPW(off) ((bf16_t*)(ws + (off)))
    const int vcu = (G % 8 == 0) ? (bx % 8) * (G / 8) + bx / 8 : bx;
    for (int p = lo; p < hi; ++p) {
#ifdef PROBE_REP
        const int reps = (p >= PH_L0 && ((PROBE_REP >> ((p - PH_L0) % PH_PER_LAYER)) & 1)) ? 2 : 1;
#else
        const int reps = 1;
#endif
#ifdef PROBE_REP
#pragma unroll 1
        for (int rep = 0; rep < reps; ++rep) {
        const bool dry = rep + 1 < reps;
#else
        { constexpr bool dry = false;
#endif
        int oz = 0; asm volatile("" : "+s"(oz));
        int tid = mk_tid(wave_s); asm volatile("" : "+v"(tid));
        const int wave = __builtin_amdgcn_readfirstlane(tid >> 6), lane = tid & 63;
        WaveId W; W.gw = vcu * 8 + wave; W.ngw = G * 8; W.wave = wave; W.lane = lane;
        unsigned char* ws = args.ws + oz; float* X = args.out + oz;
#define INP(k) (args.in[(k) + oz])
        if (p == PH_PREP0) {
            prep0_phase(W, (LAS float*)(lds + wave * 16384), ws, args.in + oz, (bf16_t*)X);
        } else if (p == PH_KV && QON(14)) {
            pg8::Order S; S.init(2, 8, 2, G, bx);
            pg8::PtrStd P{(const char*)(ws + WS_MEMN), (const char*)(ws + WS_WKVT), 1 * MiB, 4 * MiB, 0, (size_t)256 * D * 2, (size_t)256 * D * 2};
            pg8::EpiPrep E{ws, 0};
            pg8::gemm_phase<pg8::EpiPrep, pg8::PtrStd, true, true>(lds, tid, D, D, D, S, P, E);
        } else if (p == PH_GH && QON(15)) {
            { pg8::Order S; S.init(1, 4, 16, G, bx); pg8::PtrG P{(const char*)(ws + WS_KVM), (const char*)(ws + WS_WQ)}; pg8::EpiPrep E{ws, 1};
              pg8::gemm_phase<pg8::EpiPrep, pg8::PtrG, true, true>(lds, tid, 2 * D, D, 256, S, P, E); }
            { pg8::Order S; S.init(4, 1, 16, G, (bx + 64) % G); pg8::PtrH P{(const char*)(ws + WS_KVM), (const char*)(ws + WS_WOT)}; pg8::EpiPrep E{ws, 2};
              pg8::gemm_phase<pg8::EpiPrep, pg8::PtrH, true, true>(lds, tid, D, 2 * D, 256, S, P, E); }
        } else if (p >= PH_L0) {
            const int l = (p - PH_L0) / PH_PER_LAYER, q = (p - PH_L0) % PH_PER_LAYER;
            const float* Xin = l == 0 ? INP(0) : X;
            pg8::u64* SSb = (pg8::u64*)(ws + WS_SS);
#define SSA(i) (SSb + (size_t)(i) * T)
            if (q == Q_SBIDX) {
#ifndef NO_SB
                sb_phase(W, lds, ws, dry);
#endif
                __syncthreads();
#ifndef NO_IDX
#ifdef PROBE_SB_ONLY
                if (!dry)
#endif
                idx_phase(lds, ws, vcu, G, wave, lane);
#endif
                conv_sc_phase(vcu * MK_THREADS + tid, G * MK_THREADS, BPW(WS_SCB), BPW(WS_CX), INP(4) + l * 3 * 512, dry);
            } else if (q == Q_DSA) {
#ifndef NO_DSA
                dsa_phase(lds, ws, vcu, G, tid, wave, lane, dry ? BPW(WS_KA) : BPW(WS_QC));
#endif
            } else if (q == Q_FFNMID) {
                ffn_mid_phase(vcu * MK_THREADS + tid, G * MK_THREADS, BPW(WS_FA), BPW(WS_FU), INP(16) + l * 3 * DFF, INP(17) + l * DFF, dry);
            } else if (q == Q_NEXT) {
                if (l + 1 < DEPTH) { int base = 0; convert_layer_weights(W, (LAS float*)(lds + wave * 16384), base, ws, args.in + oz, l + 1); }
                else if (!dry) final_norm(W, BPW(WS_XN), X, INP(19), SSA(6));
            } else if (q == Q_INPROJ && QON(Q_INPROJ)) {
                pg8::Order S; S.init(T / 256, NIN / 256, 1, G, bx);
                pg8::PtrStd P{(const char*)X, (const char*)(ws + WS_WIN), 0, 0, 0, (size_t)256 * D * 2, (size_t)256 * D * 2};
                pg8::EpiInProj E{ws, SSA(3 * l)};
                pg8::gemm_phase<pg8::EpiInProj, pg8::PtrStd, true, true>(lds, tid, D, D, D, S, P, E);
            } else if (q == Q_GATES && QON(Q_GATES)) {
                pg8::Order S; S.init(T / 256, 12, 1, G, bx);
                pg8::PtrStd P{(const char*)X, (const char*)(ws + WS_WG), 0, 0, 0, (size_t)256 * D * 2, (size_t)256 * D * 2};
                pg8::EpiGates E{BPW(WS_GATES), SSA(3 * l)};
                pg8::gemm_phase<pg8::EpiGates, pg8::PtrStd, true, true>(lds, tid, D, D, D, S, P, E);
            } else if (q == Q_MERGE && QON(Q_MERGE)) {
                pg8::Order S; S.init(T / 256, 4, 3, G, bx);
                pg8::PtrStd P{(const char*)(ws + WS_QA), (const char*)(ws + WS_WBR), 16 * MiB, (size_t)D * 512 * 2, 0, (size_t)256 * 512 * 2, (size_t)256 * 512 * 2};
                pg8::EpiMerge E{BPW(WS_XN), BPW(WS_GATES)};
                pg8::gemm_phase<pg8::EpiMerge, pg8::PtrStd, true, true>(lds, tid, 512, 512, 512, S, P, E);
            } else if (q == Q_MIX && QON(Q_MIX)) {
                pg8::Order S; S.init(T / 256, 4, 1, G, bx);
                pg8::PtrStd P{(const char*)(ws + WS_XN), (const char*)(ws + WS_WMIX), 0, 0, 0, (size_t)256 * D * 2, (size_t)256 * D * 2};
                if (l == 0) { pg8::EpiResid<true> E{(const void*)INP(0), dry ? BPW(WS_FU) : BPW(WS_XBXA), dry ? SSA(0) : SSA(1)};
                    pg8::gemm_phase<pg8::EpiResid<true>, pg8::PtrStd, true, true>(lds, tid, D, D, D, S, P, E); }
                else { pg8::EpiResid<false> E{(const void*)X, dry ? BPW(WS_FU) : BPW(WS_XBXA), dry ? SSA(0) : SSA(4)};
                    pg8::gemm_phase<pg8::EpiResid<false>, pg8::PtrStd, true, true>(lds, tid, D, D, D, S, P, E); }

            } else if (q == Q_XALOG && QON(Q_XALOG)) {
                pg8::Order S; S.init(T / 256, 4, 1, G, bx);
                pg8::PtrStd P{(const char*)(ws + WS_XBXA), (const char*)(ws + WS_GT + (size_t)l * 4 * MiB), 0, 0, 2 * MiB, (size_t)256 * D * 2, (size_t)256 * D * 2};
                pg8::EpiSoftmax E{BPW(WS_PXA), SSA(1 + 3 * l)};
                pg8::gemm_phase<pg8::EpiSoftmax, pg8::PtrStd, false, true>(lds, tid, D, D, D, S, P, E);
            } else if (q == Q_XAOUT && QON(Q_XAOUT)) {
                pg8::Order S; S.init(T / 256, 4, 1, G, bx);
                pg8::PtrStd P{(const char*)(ws + WS_PXA), (const char*)(ws + WS_HT + (size_t)l * 4 * MiB), 0, 0, 2 * MiB, (size_t)256 * D * 2, (size_t)256 * D * 2};
                pg8::EpiResid<false> E{(const void*)BPW(WS_XBXA), dry ? BPW(WS_FU) : BPW(WS_XN), dry ? SSA(0) : SSA(2 + 3 * l)};
                pg8::gemm_phase<pg8::EpiResid<false>, pg8::PtrStd, true, true>(lds, tid, D, D, D, S, P, E);
            } else if (q == Q_UP && QON(Q_UP)) {
                pg8::Order S; S.init(T / 256, 22, 1, G, bx);
                pg8::PtrStd P{(const char*)(ws + WS_XN), (const char*)(ws + WS_WUP), 0, 0, 0, (size_t)256 * D * 2, (size_t)256 * D * 2};
                pg8::EpiUp E{BPW(WS_FA), BPW(WS_FU), SSA(2 + 3 * l)};
                pg8::gemm_phase<pg8::EpiUp, pg8::PtrStd, true, true>(lds, tid, D, D, D, S, P, E);
            } else if (q == Q_DOWN && QON(Q_DOWN)) {
                pg8::Order S; S.init(T / 256, 4, 1, G, bx);
                pg8::PtrStd P{(const char*)(ws + WS_FU), (const char*)(ws + WS_WDOWN), 0, 0, 0, (size_t)256 * DFF * 2, (size_t)256 * DFF * 2};
                pg8::EpiResid<false> E{(const void*)BPW(WS_XN), dry ? BPW(WS_QA) : (l + 1 < DEPTH ? (bf16_t*)X : BPW(WS_XN)), dry ? SSA(0) : SSA(3 + 3 * l)};
                pg8::gemm_phase<pg8::EpiResid<false>, pg8::PtrStd, true, true>(lds, tid, DFF, DFF, DFF, S, P, E);
            }
        }
        }
        if (p + 1 < hi && !(p >= PH_L0 && ((p - PH_L0) % PH_PER_LAYER == Q_NORMXA || (p - PH_L0) % PH_PER_LAYER == Q_NORMFFN))) xcd_barrier(bar, mk_tid(wave_s));
    }
}

extern "C" void kernel_launch(void* const* d_in, const int* in_sizes, int n_in, void* d_out, int out_size, void* d_ws, size_t ws_size, hipStream_t st) {
    if (n_in != 20 || ws_size < WS_NEED || out_size != T * D) { fprintf(stderr, "kernel_launch: unexpected sizes n_in %d ws %zu out %d\n", n_in, ws_size, out_size); return; }
    static int grid = 0;
    if (grid == 0) {
        int dev = 0, cus = 0, per_cu = 0;
        (void)hipGetDevice(&dev); (void)hipDeviceGetAttribute(&cus, hipDeviceAttributeMultiprocessorCount, dev);
        if (hipOccupancyMaxActiveBlocksPerMultiprocessor(&per_cu, (const void*)mk_fwd, MK_THREADS, 0) != hipSuccess || per_cu < 1) { fprintf(stderr, "kernel_launch: occupancy query says %d blocks/CU\n", per_cu); grid = -1; return; }
        (void)hipGetLastError();
        if (cus != 256) { fprintf(stderr, "kernel_launch: built for a 256-CU device, found %d\n", cus); grid = -1; return; }
        grid = cus;
    }
    if (grid < 0) return;
    (void)hipMemsetAsync((char*)d_ws + WS_CTL, 0, CTL_ZERO_BYTES, st);
    Args a{};
    for (int i = 0; i < 20; ++i) a.in[i] = (const float*)d_in[i];
    a.out = (float*)d_out; a.ws = (unsigned char*)d_ws; a.ph_lo = 0; a.ph_hi = NPH;
    hipLaunchKernelGGL(mk_fwd, dim3(grid), dim3(MK_THREADS), 0, st, a);
}
```

```cpp
#include <hip/hip_runtime.h>
#include <stdint.h>
#include <stdio.h>

typedef unsigned short bf16_t;
typedef short bf16x8 __attribute__((ext_vector_type(8)));
typedef float f32x16 __attribute__((ext_vector_type(16)));
typedef float f32x4 __attribute__((ext_vector_type(4)));
#define DEV __device__ __forceinline__

constexpr int NB = 2, S = 8192, D = 1024, T = NB * S, DEPTH = 2;
constexpr int DIN = 8264, DFF = 2816, MEM = 256;
constexpr int NIN = 5376;
constexpr float LOG2E = 1.4426950408889634f;
constexpr float QSCALE = 0.125f * LOG2E;
constexpr float WSCALE = 0.125f * 0.35355339059327373f;
constexpr float XSCALE = 0.0625f * LOG2E;
constexpr float EPS = 1e-6f;
#ifndef MK_FUSE
#define MK_FUSE 1
#endif

constexpr size_t MiB = 1u << 20;
constexpr size_t WS_GT = 1 * MiB;
constexpr size_t WS_HT = 9 * MiB;
constexpr size_t WS_WUP = 17 * MiB, WS_WDOWN = 28 * MiB;
constexpr size_t WS_XN = 34 * MiB;
constexpr size_t WS_WMIX = 66 * MiB, WS_WBR = 68 * MiB, WS_WG = 71 * MiB, WS_WIN = 77 * MiB;
constexpr size_t WS_QA = 88 * MiB, WS_SCB = 104 * MiB, WS_QC = 120 * MiB, WS_KA = 136 * MiB, WS_VA = 152 * MiB, WS_KC = 168 * MiB, WS_VC = 184 * MiB,
                 WS_IQ = 200 * MiB, WS_CX = 216 * MiB, WS_IK = 232 * MiB, WS_IW = 234 * MiB, WS_BM = 235 * MiB;
constexpr size_t WS_GATES = 136 * MiB;
constexpr size_t WS_XTMP = 235 * MiB;
constexpr size_t WS_LOG = 88 * MiB, WS_PXA = 168 * MiB;
constexpr size_t WS_XBXA = 136 * MiB;
constexpr size_t WS_SS = 65536;
constexpr size_t WS_FA = 66 * MiB, WS_FU = 154 * MiB;
constexpr size_t WS_WQ = 200 * MiB  , WS_WOT = 204 * MiB  , WS_WKVT = 208 * MiB  , WS_MEMN = 216 * MiB  , WS_KVM = 218 * MiB  ;
constexpr size_t WS_NEED = 256 * MiB;

DEV bf16_t f2bf(float f) { unsigned u = __float_as_uint(f); u += 0x7fffu + ((u >> 16) & 1u); return (bf16_t)(u >> 16); }
DEV float bf2f(bf16_t h) { return __uint_as_float(((unsigned)h) << 16); }
DEV float wave_sum(float v) {
#pragma unroll
    for (int o = 1; o < 64; o <<= 1) v += __shfl_xor(v, o);
    return v;
}
DEV float wave_max(float v) {
#pragma unroll
    for (int o = 1; o < 64; o <<= 1) v = fmaxf(v, __shfl_xor(v, o));
    return v;
}


#define LAS __attribute__((address_space(3)))
#define GAS __attribute__((address_space(1)))
typedef unsigned u32x4 __attribute__((ext_vector_type(4)));
typedef unsigned u32x2 __attribute__((ext_vector_type(2)));
typedef float f32x2 __attribute__((ext_vector_type(2)));
#define LDS_WAIT() asm volatile("s_waitcnt lgkmcnt(0)" ::: "memory")
DEV int mk_tid(int wave_s) { unsigned ones = ~0u; asm volatile("" : "+s"(ones)); return wave_s * 64 + (int)__builtin_amdgcn_mbcnt_hi(ones, __builtin_amdgcn_mbcnt_lo(ones, 0u)); }
#define VM_WAIT() asm volatile("s_waitcnt vmcnt(0)" ::: "memory")
typedef __bf16 bf16x2_t __attribute__((ext_vector_type(2)));
DEV unsigned cvt_pk_bf16(float lo, float hi) { const f32x2 v = {lo, hi}; return __builtin_bit_cast(unsigned, __builtin_convertvector(v, bf16x2_t)); }
DEV float bflo(unsigned w) { return __uint_as_float(w << 16); }
DEV float bfhi(unsigned w) { return __uint_as_float(w & 0xffff0000u); }

namespace pg8 {
constexpr int BM = 256, BK = 64, HALF = 128, HTB = HALF * BK * 2, STAGE_BYTES = 8 * HTB, NXCD = 8, WGM = 8;
__host__ __device__ __forceinline__ int lds_byte(int r, int c) { const int st = (r >> 4) * 2 + (c >> 5), rr = r & 15, cc = c & 31, ob = rr * 64 + cc * 2; return st * 1024 + (ob ^ (((ob >> 9) & 1) << 5)); }
__host__ __device__ __forceinline__ void stage_rc(int b, int& R, int& C) { const int st = b / 1024, sb = b % 1024, swz = sb ^ (((sb >> 9) & 1) << 5); R = (st >> 1) * 16 + swz / 64; C = (st & 1) * 32 + (swz % 64) / 2; }
__host__ __device__ __forceinline__ int perm32(int rho) { const int n = rho >> 4, i = rho & 15; return 8 * (i >> 2) + 4 * n + (i & 3); }

struct Unit { int pm, pn, job; };
struct Order {
    int nM, nN, nwg, ntot, G, c;
    DEV void init(int nM_, int nN_, int njob, int G_, int c_) { nM = nM_; nN = nN_; nwg = nM * nN; ntot = nwg * njob; G = G_; c = c_; }
    DEV bool next(int i, Unit& u) const {
        const int L = i * G + c; if (L >= ntot) return false;
        u.job = L / nwg; int wgid = L - u.job * nwg;
        { const int q = nwg / NXCD, r = nwg % NXCD, xcd = wgid % NXCD, off = wgid / NXCD; wgid = (xcd < r ? xcd * (q + 1) : r * (q + 1) + (xcd - r) * q) + off; }
        const int nig = WGM * nN, gid = wgid / nig, fm = gid * WGM, gsz = (nM - fm) < WGM ? (nM - fm) : WGM;
        u.pm = fm + ((wgid % nig) % gsz); u.pn = (wgid % nig) / gsz; return true;
    }
};
template <class Epi, class Ptr, bool ALIGN_EPI, bool SP2>
DEV void gemm_phase(LAS unsigned char* lds, const int tid_in, const int lda, const int ldb, const int K, const Order& S, const Ptr& P, const Epi& E) {
    int tid_ = tid_in; asm volatile("" : "+v"(tid_));
    const int tid = tid_, wid = __builtin_amdgcn_readfirstlane(tid >> 6), lane = tid & 63, wr = wid >> 2, wc = wid & 3, fr = lane & 15, fq = lane >> 4;
    const int nt = K / BK;
    unsigned voffA[2], voffB[2];
#pragma unroll
    for (int i = 0; i < 2; ++i) { int R, C; stage_rc(tid * 16 + i * 8192, R, C); const int Rb = Epi::PERM ? ((R & ~31) + perm32(R & 31)) : R;
        voffA[i] = (unsigned)(R * lda + C) * 2u; voffB[i] = (unsigned)(Rb * ldb + C) * 2u; }
    const size_t kstep = (size_t)(BK * 2);
    const size_t hstepA = (size_t)HALF * lda * 2, hstepB = (size_t)HALF * ldb * 2;
    const unsigned ldsw = (unsigned)wid * 1024u;
    const int aoff = lds_byte(wr * 64 + fr, fq * 8), boff = lds_byte(wc * 32 + fr, fq * 8);
#define PG8_SA(b, h) (((b) * 2 + (h)) * HTB)
#define PG8_SB(b, h) ((4 + (b) * 2 + (h)) * HTB)
#define PG8_STAGE(bufoff, gbase, voff) do { _Pragma("unroll") for (int _i = 0; _i < 2; ++_i) \
        __builtin_amdgcn_global_load_lds((const unsigned*)((const char*)(gbase) + (voff)[_i]), (LAS unsigned*)(lds + (bufoff) + ldsw + _i * 8192), 16, 0, 0); } while (0)
#define PG8_LDA(dst, b, h) do { _Pragma("unroll") for (int m = 0; m < 4; ++m) _Pragma("unroll") for (int k = 0; k < 2; ++k) dst[m][k] = *(const LAS bf16x8*)(lds + PG8_SA(b, h) + aoff + m * 2048 + k * 1024); } while (0)
#define PG8_LDB(dst, b, h) do { _Pragma("unroll") for (int n = 0; n < 2; ++n) _Pragma("unroll") for (int k = 0; k < 2; ++k) dst[n][k] = *(const LAS bf16x8*)(lds + PG8_SB(b, h) + boff + n * 2048 + k * 1024); } while (0)
#define PG8_MMA(ai, bj, At, Bt) do { __builtin_amdgcn_s_setprio(1); _Pragma("unroll") for (int m = 0; m < 4; ++m) _Pragma("unroll") for (int n = 0; n < 2; ++n) _Pragma("unroll") for (int k = 0; k < 2; ++k) \
        acc[ai][bj][m][n] = __builtin_amdgcn_mfma_f32_16x16x32_bf16(Bt[n][k], At[m][k], acc[ai][bj][m][n], 0, 0, 0); __builtin_amdgcn_s_setprio(0); } while (0)
#define PG8_WAIT_V(n) asm volatile("s_waitcnt vmcnt(" #n ")" ::: "memory")
#define PG8_WAIT_L(n) asm volatile("s_waitcnt lgkmcnt(" #n ")" ::: "memory")
#define PG8_BAR __builtin_amdgcn_s_barrier()
#define PG8_SCHED __builtin_amdgcn_sched_barrier(0)
    Unit cur, nxt; int ui = 0;
    if (!S.next(0, cur)) return;
    f32x4 acc[2][2][4][2];
#pragma unroll
    for (int a = 0; a < 2; ++a)
#pragma unroll
        for (int b = 0; b < 2; ++b)
#pragma unroll
            for (int m = 0; m < 4; ++m)
#pragma unroll
                for (int n = 0; n < 2; ++n) acc[a][b][m][n] = (f32x4){0.f, 0.f, 0.f, 0.f};
    bf16x8 At[4][2], B0[2][2], B1[2][2];
    const char* cA = P.a(cur); const char* cB = P.b(cur);
    typename Epi::Pre pre; E.prefetch(pre, cur, wr, fr);
    if constexpr (SP2) {
        PG8_STAGE(PG8_SB(0, 0), cB, voffB); PG8_STAGE(PG8_SB(0, 1), cB + hstepB, voffB); PG8_STAGE(PG8_SA(0, 0), cA, voffA); PG8_STAGE(PG8_SA(0, 1), cA + hstepA, voffA);
        if (wr == 1) PG8_BAR;
        PG8_WAIT_V(2); PG8_BAR;
        PG8_STAGE(PG8_SB(1, 0), cB + kstep, voffB); PG8_STAGE(PG8_SA(1, 0), cA + kstep, voffA); PG8_STAGE(PG8_SB(1, 1), cB + hstepB + kstep, voffB);
        PG8_WAIT_V(6); PG8_BAR;
    } else {
        PG8_STAGE(PG8_SB(0, 0), cB, voffB); PG8_STAGE(PG8_SA(0, 0), cA, voffA); PG8_STAGE(PG8_SB(0, 1), cB + hstepB, voffB); PG8_STAGE(PG8_SA(0, 1), cA + hstepA, voffA);
        if (wr == 1) PG8_BAR;
        PG8_WAIT_V(4); PG8_BAR;
        PG8_STAGE(PG8_SB(1, 0), cB + kstep, voffB); PG8_STAGE(PG8_SA(1, 0), cA + kstep, voffA); PG8_STAGE(PG8_SB(1, 1), cB + hstepB + kstep, voffB);
        PG8_WAIT_V(6); PG8_BAR;
    }
#pragma unroll 1
    for (;;) {
        const bool has_next = S.next(ui + 1, nxt);
        const char* nA = has_next ? P.a(nxt) : cA; const char* nB = has_next ? P.b(nxt) : cB;
#pragma unroll 1
        for (int t = 0; t < nt; t += 2) {
            const bool last = (t == nt - 2);
            const char* a1 = cA + (size_t)(t + 1) * kstep;
            const char* a2 = last ? nA : cA + (size_t)(t + 2) * kstep; const char* b2 = last ? nB : cB + (size_t)(t + 2) * kstep;
            const char* a3 = a2 + kstep; const char* b3 = b2 + kstep;
            if constexpr (SP2) {
            PG8_LDB(B0, 0, 0); PG8_LDB(B1, 0, 1); PG8_SCHED; PG8_LDA(At, 0, 0); PG8_STAGE(PG8_SA(1, 1), a1 + hstepA, voffA);
            PG8_WAIT_V(8); PG8_WAIT_L(0); PG8_BAR; PG8_MMA(0, 0, At, B0); PG8_MMA(0, 1, At, B1); PG8_BAR; PG8_SCHED;
            PG8_LDA(At, 0, 1); PG8_STAGE(PG8_SB(0, 0), b2, voffB); PG8_STAGE(PG8_SB(0, 1), b2 + hstepB, voffB); PG8_STAGE(PG8_SA(0, 0), a2, voffA);
            PG8_WAIT_V(8); PG8_WAIT_L(0); PG8_BAR; PG8_MMA(1, 0, At, B0); PG8_MMA(1, 1, At, B1); PG8_BAR; PG8_SCHED;
            PG8_LDB(B0, 1, 0); PG8_LDB(B1, 1, 1); PG8_SCHED; PG8_LDA(At, 1, 0); PG8_STAGE(PG8_SA(0, 1), a2 + hstepA, voffA);
            PG8_WAIT_V(8); PG8_WAIT_L(0); PG8_BAR; PG8_MMA(0, 0, At, B0); PG8_MMA(0, 1, At, B1); PG8_BAR; PG8_SCHED;
            PG8_LDA(At, 1, 1); PG8_STAGE(PG8_SB(1, 0), b3, voffB); PG8_STAGE(PG8_SB(1, 1), b3 + hstepB, voffB); PG8_STAGE(PG8_SA(1, 0), a3, voffA);
            PG8_WAIT_V(8); PG8_WAIT_L(0); PG8_BAR; PG8_MMA(1, 0, At, B0); PG8_MMA(1, 1, At, B1); PG8_BAR; PG8_SCHED;
            } else {
            PG8_LDB(B0, 0, 0); PG8_SCHED; PG8_LDA(At, 0, 0); PG8_STAGE(PG8_SA(1, 1), a1 + hstepA, voffA);
            PG8_WAIT_L(8); PG8_BAR; PG8_WAIT_L(0); PG8_MMA(0, 0, At, B0); PG8_BAR; PG8_SCHED;
            PG8_LDB(B1, 0, 1); PG8_STAGE(PG8_SB(0, 0), b2, voffB);
            PG8_BAR; PG8_WAIT_L(0); PG8_MMA(0, 1, At, B1); PG8_BAR;
            PG8_LDA(At, 0, 1); PG8_STAGE(PG8_SA(0, 0), a2, voffA);
            PG8_BAR; PG8_WAIT_L(0); PG8_MMA(1, 0, At, B0); PG8_BAR; PG8_SCHED;
            PG8_STAGE(PG8_SB(0, 1), b2 + hstepB, voffB);
            PG8_WAIT_V(6); PG8_BAR; PG8_MMA(1, 1, At, B1); PG8_BAR;
            PG8_LDB(B0, 1, 0); PG8_SCHED; PG8_LDA(At, 1, 0); PG8_STAGE(PG8_SA(0, 1), a2 + hstepA, voffA);
            PG8_WAIT_L(8); PG8_BAR; PG8_WAIT_L(0); PG8_MMA(0, 0, At, B0); PG8_BAR; PG8_SCHED;
            PG8_LDB(B1, 1, 1); PG8_STAGE(PG8_SB(1, 0), b3, voffB);
            PG8_BAR; PG8_WAIT_L(0); PG8_MMA(0, 1, At, B1); PG8_BAR;
            PG8_LDA(At, 1, 1); PG8_STAGE(PG8_SA(1, 0), a3, voffA);
            PG8_BAR; PG8_WAIT_L(0); PG8_MMA(1, 0, At, B0); PG8_BAR; PG8_SCHED;
            PG8_STAGE(PG8_SB(1, 1), b3 + hstepB, voffB);
            PG8_WAIT_V(6); PG8_BAR; PG8_MMA(1, 1, At, B1); PG8_BAR;
            }
        }
        if constexpr (ALIGN_EPI) { if (wr == 0) PG8_BAR; }
        if constexpr (!Epi::AFTER_DRAIN) { int fr_ = fr, fq_ = fq; asm volatile("" : "+v"(fr_), "+v"(fq_));
            E(acc, cur, wr, wc, fr_, fq_, pre); }
        if (!has_next) break;
#pragma unroll
        for (int a = 0; a < 2; ++a)
#pragma unroll
            for (int b = 0; b < 2; ++b)
#pragma unroll
                for (int m = 0; m < 4; ++m)
#pragma unroll
                    for (int n = 0; n < 2; ++n) acc[a][b][m][n] = (f32x4){0.f, 0.f, 0.f, 0.f};
        cur = nxt; cA = nA; cB = nB; ++ui; E.prefetch(pre, cur, wr, fr);
        if constexpr (ALIGN_EPI) { if (wr == 1) PG8_BAR; }
    }
    PG8_WAIT_V(0);
    if constexpr (!ALIGN_EPI) { if (wr == 0) PG8_BAR; }
    PG8_BAR;
    if constexpr (Epi::AFTER_DRAIN) { E.fused(acc, cur, wr, wc, fr, fq, lds, wid, lane, pre); }
#undef PG8_SA
#undef PG8_SB
#undef PG8_STAGE
#undef PG8_LDA
#undef PG8_LDB
#undef PG8_MMA
#undef PG8_WAIT_V
#undef PG8_WAIT_L
#undef PG8_BAR
#undef PG8_SCHED
}
typedef f32x4 Acc[2][2][4][2];

struct PtrStd {
    const char* A; const char* B; size_t aj, bj, bb, arow, brow;
    DEV const char* a(const Unit& u) const { return A + (size_t)u.job * aj + (size_t)u.pm * arow; }
    DEV const char* b(const Unit& u) const { return B + (size_t)u.job * bj + (size_t)(u.pm >> 5) * bb + (size_t)u.pn * brow; }
};
struct PtrG {
    const char* KVM; const char* WQ;
    DEV const char* a(const Unit& u) const { return KVM + (size_t)(u.job >> 2) * MiB + (size_t)(u.job & 3) * 512; }
    DEV const char* b(const Unit& u) const { return WQ + (size_t)(u.job >> 3) * 2 * MiB + (size_t)(u.job & 3) * 512 + (size_t)u.pn * 256 * 1024 * 2; }
};
struct PtrH {
    const char* KVM; const char* WOT;
    DEV const char* a(const Unit& u) const { return WOT + (size_t)(u.job >> 3) * 2 * MiB + (size_t)(u.job & 3) * 512 + (size_t)u.pm * 256 * 1024 * 2; }
    DEV const char* b(const Unit& u) const { return KVM + (size_t)(u.job >> 2) * MiB + 2048 + (size_t)(u.job & 3) * 512; }
};

#define EPI_ROWS(u) const int row0 = (u).pm * BM + wr * 64 + fr
DEV u32x4 pack8(const f32x4 v0, const f32x4 v1) { u32x4 w; w.x = cvt_pk_bf16(v0[0], v0[1]); w.y = cvt_pk_bf16(v0[2], v0[3]); w.z = cvt_pk_bf16(v1[0], v1[1]); w.w = cvt_pk_bf16(v1[2], v1[3]); return w; }

struct PreNone {};
typedef unsigned long long u64;
constexpr float SS_SCALE = 65536.f;
struct PreRs { u64 v[2][4]; };
DEV void pre_rs(PreRs& p, const u64* ss, int row0) {
#pragma unroll
    for (int ai = 0; ai < 2; ++ai)
#pragma unroll
        for (int m = 0; m < 4; ++m) p.v[ai][m] = __builtin_nontemporal_load(ss + row0 + ai * HALF + m * 16);
}
DEV void rs_of(float (&rs)[2][4], const PreRs& p) {
#pragma unroll
    for (int ai = 0; ai < 2; ++ai)
#pragma unroll
        for (int m = 0; m < 4; ++m) rs[ai][m] = rsqrtf((float)p.v[ai][m] * (1.f / (SS_SCALE * D)) + EPS);
}
struct EpiInProj {
    typedef PreRs Pre;
    DEV void prefetch(PreRs& p, const Unit& u, int wr, int fr) const { pre_rs(p, ss, u.pm * BM + wr * 64 + fr); }
    static constexpr bool PERM = true, AFTER_DRAIN = false;
    unsigned char* ws; const u64* ss;
    DEV void operator()(const Acc& acc, const Unit& u, int wr, int wc, int fr, int fq, const PreRs& pre) const {
        EPI_ROWS(u); const int pn = u.pn, cb = wc * 32 + 8 * fq;
        float rs[2][4]; rs_of(rs, pre);
        if (pn < 16) {
            const int g = pn >> 1;
            const size_t off = g == 0 ? WS_QA : g == 1 ? WS_KA : g == 2 ? WS_VA : g == 3 ? WS_QC : g == 4 ? WS_KC : g == 5 ? WS_VC : g == 6 ? WS_IQ : WS_SCB;
            const float sc = (g == 0 || g == 3) ? QSCALE : 1.f;
            bf16_t* base = (bf16_t*)(ws + off) + (pn & 1) * 256 + cb;
#pragma unroll
            for (int ai = 0; ai < 2; ++ai)
#pragma unroll
                for (int m = 0; m < 4; ++m) { bf16_t* rowp = base + (size_t)(row0 + ai * HALF + m * 16) * 512;
#pragma unroll
                    for (int bj = 0; bj < 2; ++bj) *(u32x4*)(rowp + bj * HALF) = pack8(acc[ai][bj][m][0] * (sc * rs[ai][m]), acc[ai][bj][m][1] * (sc * rs[ai][m])); }
        } else if (pn < 20) {
            bf16_t* base = (bf16_t*)(ws + WS_CX) + (pn - 16) * 128 + cb;
#pragma unroll
            for (int ai = 0; ai < 2; ++ai)
#pragma unroll
                for (int m = 0; m < 4; ++m) { const float r2 = rs[ai][m] * rs[ai][m]; *(u32x4*)(base + (size_t)(row0 + ai * HALF + m * 16) * 512) = pack8(acc[ai][0][m][0] * acc[ai][1][m][0] * r2, acc[ai][0][m][1] * acc[ai][1][m][1] * r2); }
        } else {
            if (wc < 2) { bf16_t* base = (bf16_t*)(ws + WS_IK);
#pragma unroll
                for (int ai = 0; ai < 2; ++ai)
#pragma unroll
                    for (int m = 0; m < 4; ++m) { const int t = row0 + ai * HALF + m * 16;
                        *(u32x4*)(base + (size_t)(t >> 5) * 2048 + (((cb >> 3) * 32 + (t & 31)) * 8)) = pack8(acc[ai][0][m][0] * rs[ai][m], acc[ai][0][m][1] * rs[ai][m]); }
            } else if (wc == 2 && fq == 0) { float* base = (float*)(ws + WS_IW);
#pragma unroll
                for (int ai = 0; ai < 2; ++ai)
#pragma unroll
                    for (int m = 0; m < 4; ++m) { float* p = base + (size_t)(row0 + ai * HALF + m * 16) * 8; *(f32x4*)p = acc[ai][0][m][0] * (WSCALE * rs[ai][m]); *(f32x4*)(p + 4) = acc[ai][0][m][1] * (WSCALE * rs[ai][m]); }
            }
        }
    }
};
DEV f32x4 sigm4(const f32x4 v) { f32x4 o;
#pragma unroll
    for (int i = 0; i < 4; ++i) o[i] = __builtin_amdgcn_rcpf(1.f + __builtin_amdgcn_exp2f(-LOG2E * v[i])); return o; }
struct EpiGates {
    typedef PreRs Pre;
    DEV void prefetch(PreRs& p, const Unit& u, int wr, int fr) const { pre_rs(p, ss, u.pm * BM + wr * 64 + fr); }
    static constexpr bool PERM = true, AFTER_DRAIN = false;
    bf16_t* G; const u64* ss;
    DEV void operator()(const Acc& acc, const Unit& u, int wr, int wc, int fr, int fq, const PreRs& pre) const {
        EPI_ROWS(u); float rs[2][4]; rs_of(rs, pre); bf16_t* base = G + (size_t)(u.pn >> 2) * T * D + (u.pn & 3) * 256 + wc * 32 + 8 * fq;
#pragma unroll
        for (int ai = 0; ai < 2; ++ai)
#pragma unroll
            for (int m = 0; m < 4; ++m) { bf16_t* rowp = base + (size_t)(row0 + ai * HALF + m * 16) * D;
#pragma unroll
                for (int bj = 0; bj < 2; ++bj) *(u32x4*)(rowp + bj * HALF) = pack8(sigm4(acc[ai][bj][m][0] * rs[ai][m]), sigm4(acc[ai][bj][m][1] * rs[ai][m])); }
    }
};
struct EpiMerge {
    typedef PreNone Pre;
    DEV void prefetch(PreNone&, const Unit&, int, int) const {}
    static constexpr bool PERM = true, AFTER_DRAIN = false;
    bf16_t* M; const bf16_t* G;
    DEV void operator()(const Acc& acc, const Unit& u, int wr, int wc, int fr, int fq, const PreNone&) const {
        EPI_ROWS(u); const size_t cofs = (size_t)u.pn * 256 + wc * 32 + 8 * fq; const bf16_t* gb = G + (size_t)u.job * T * D;
#pragma unroll
        for (int ai = 0; ai < 2; ++ai)
#pragma unroll
            for (int m = 0; m < 4; ++m) { const size_t ro = (size_t)(row0 + ai * HALF + m * 16) * D + cofs;
#pragma unroll
                for (int bj = 0; bj < 2; ++bj) { const size_t o = ro + bj * HALF; const u32x4 g = *(const u32x4*)(gb + o);
                    f32x4 v0 = acc[ai][bj][m][0], v1 = acc[ai][bj][m][1];
                    v0[0] *= bflo(g.x); v0[1] *= bfhi(g.x); v0[2] *= bflo(g.y); v0[3] *= bfhi(g.y); v1[0] *= bflo(g.z); v1[1] *= bfhi(g.z); v1[2] *= bflo(g.w); v1[3] *= bfhi(g.w);
                    if (u.job > 0) { const u32x4 p = __builtin_nontemporal_load((const u32x4*)(M + o));
                        v0[0] += bflo(p.x); v0[1] += bfhi(p.x); v0[2] += bflo(p.y); v0[3] += bfhi(p.y); v1[0] += bflo(p.z); v1[1] += bfhi(p.z); v1[2] += bflo(p.w); v1[3] += bfhi(p.w); }
                    *(u32x4*)(M + o) = pack8(v0, v1); } }
    }
};
template <bool IN_F32> struct EpiResid {
    typedef PreNone Pre;
    DEV void prefetch(PreNone&, const Unit&, int, int) const {}
    static constexpr bool PERM = true, AFTER_DRAIN = false;
    const void* xin; bf16_t* xb; u64* ss;
    DEV void operator()(const Acc& acc, const Unit& u, int wr, int wc, int fr, int fq, const PreNone&) const {
        EPI_ROWS(u); const size_t cofs = (size_t)u.pn * 256 + wc * 32 + 8 * fq;
#pragma unroll
        for (int ai = 0; ai < 2; ++ai)
#pragma unroll
            for (int m = 0; m < 4; ++m) { const size_t ro = (size_t)(row0 + ai * HALF + m * 16) * D + cofs; float sq = 0.f;
#pragma unroll
                for (int bj = 0; bj < 2; ++bj) { const size_t o = ro + bj * HALF; f32x4 v0 = acc[ai][bj][m][0], v1 = acc[ai][bj][m][1];
                    if (IN_F32) { v0 = v0 + *(const f32x4*)((const float*)xin + o); v1 = v1 + *(const f32x4*)((const float*)xin + o + 4); }
                    else { const u32x4 p = *(const u32x4*)((const bf16_t*)xin + o);
                        v0[0] += bflo(p.x); v0[1] += bfhi(p.x); v0[2] += bflo(p.y); v0[3] += bfhi(p.y); v1[0] += bflo(p.z); v1[1] += bfhi(p.z); v1[2] += bflo(p.w); v1[3] += bfhi(p.w); }
                    *(u32x4*)(xb + o) = pack8(v0, v1);
                    sq += ((v0[0] * v0[0] + v0[1] * v0[1]) + (v0[2] * v0[2] + v0[3] * v0[3])) + ((v1[0] * v1[0] + v1[1] * v1[1]) + (v1[2] * v1[2] + v1[3] * v1[3])); }
                sq += __shfl_xor(sq, 16); sq += __shfl_xor(sq, 32);
                if (fq == 0) atomicAdd(ss + row0 + ai * HALF + m * 16, (u64)(sq * SS_SCALE + 0.5f)); }
    }
};
struct EpiUp {
    typedef PreRs Pre;
    DEV void prefetch(PreRs& p, const Unit& u, int wr, int fr) const { pre_rs(p, ss, u.pm * BM + wr * 64 + fr); }
    static constexpr bool PERM = true, AFTER_DRAIN = false;
    bf16_t *fa, *fu; const u64* ss;
    DEV void operator()(const Acc& acc, const Unit& u, int wr, int wc, int fr, int fq, const PreRs& pre) const {
        EPI_ROWS(u); float rs[2][4]; rs_of(rs, pre); const size_t cofs = (size_t)u.pn * 128 + wc * 32 + 8 * fq;
#pragma unroll
        for (int ai = 0; ai < 2; ++ai)
#pragma unroll
            for (int m = 0; m < 4; ++m) { const size_t o = (size_t)(row0 + ai * HALF + m * 16) * DFF + cofs;
                *(u32x4*)(fa + o) = pack8(acc[ai][0][m][0] * rs[ai][m], acc[ai][0][m][1] * rs[ai][m]); *(u32x4*)(fu + o) = pack8(acc[ai][1][m][0] * rs[ai][m], acc[ai][1][m][1] * rs[ai][m]); }
    }
};
struct EpiPrep {
    typedef PreNone Pre;
    DEV void prefetch(PreNone&, const Unit&, int, int) const {}
    static constexpr bool PERM = true, AFTER_DRAIN = false;
    unsigned char* ws; int mode;
    DEV void operator()(const Acc& acc, const Unit& u, int wr, int wc, int fr, int fq, const PreNone&) const {
        EPI_ROWS(u); bf16_t* base; int ldc; float sc = 1.f;
        if (mode == 0) { base = (bf16_t*)(ws + WS_KVM + (size_t)u.job * 2 * MiB); ldc = 2 * D; }
        else if (mode == 1) { base = (bf16_t*)(ws + WS_GT + (size_t)(u.job >> 2) * 2 * MiB) + (size_t)(u.job & 3) * 256 * D; ldc = D; sc = XSCALE; }
        else { base = (bf16_t*)(ws + WS_HT + (size_t)(u.job >> 2) * 2 * MiB) + (u.job & 3) * 256; ldc = D; }
        base += (size_t)u.pn * 256 + wc * 32 + 8 * fq;
#pragma unroll
        for (int ai = 0; ai < 2; ++ai)
#pragma unroll
            for (int m = 0; m < 4; ++m) { bf16_t* rowp = base + (size_t)(row0 + ai * HALF + m * 16) * ldc;
#pragma unroll
                for (int bj = 0; bj < 2; ++bj) *(u32x4*)(rowp + bj * HALF) = pack8(acc[ai][bj][m][0] * sc, acc[ai][bj][m][1] * sc); }
    }
};
struct EpiSoftmax {
    typedef PreRs Pre;
    DEV void prefetch(PreRs& p, const Unit& u, int wr, int fr) const { pre_rs(p, ss, u.pm * BM + wr * 64 + fr); }
    static constexpr bool PERM = true, AFTER_DRAIN = true;
    bf16_t* P; const u64* ss;
    DEV void fused(Acc& acc, const Unit& u, int wr, int wc, int fr, int fq, LAS unsigned char* lds, int wid, int lane, const PreRs& pre) const {
        LAS float* PM = (LAS float*)lds; LAS float* PS = (LAS float*)(lds + 4096);
        { const int row0_ = u.pm * BM + wr * 64 + fr; float rs[2][4]; rs_of(rs, pre);
#pragma unroll
          for (int ai = 0; ai < 2; ++ai)
#pragma unroll
              for (int m = 0; m < 4; ++m)
#pragma unroll
                  for (int bj = 0; bj < 2; ++bj)
#pragma unroll
                      for (int n = 0; n < 2; ++n) acc[ai][bj][m][n] = acc[ai][bj][m][n] * rs[ai][m]; }
#pragma unroll
        for (int ai = 0; ai < 2; ++ai)
#pragma unroll
            for (int m = 0; m < 4; ++m) { float mx = -INFINITY;
#pragma unroll
                for (int bj = 0; bj < 2; ++bj)
#pragma unroll
                    for (int n = 0; n < 2; ++n) { const f32x4 x = acc[ai][bj][m][n]; mx = fmaxf(mx, fmaxf(fmaxf(x[0], x[1]), fmaxf(x[2], x[3]))); }
                mx = fmaxf(mx, __shfl_xor(mx, 16)); mx = fmaxf(mx, __shfl_xor(mx, 32));
                if (fq == 0) PM[(ai * HALF + wr * 64 + m * 16 + fr) * 4 + wc] = mx; }
        LDS_WAIT(); __builtin_amdgcn_s_barrier(); asm volatile("" ::: "memory");
#pragma unroll
        for (int ai = 0; ai < 2; ++ai)
#pragma unroll
            for (int m = 0; m < 4; ++m) { const int r = ai * HALF + wr * 64 + m * 16 + fr; const f32x4 q = *(const LAS f32x4*)(PM + r * 4);
                const float mx = fmaxf(fmaxf(q[0], q[1]), fmaxf(q[2], q[3])); float s = 0.f;
#pragma unroll
                for (int bj = 0; bj < 2; ++bj)
#pragma unroll
                    for (int n = 0; n < 2; ++n) { f32x4 x = acc[ai][bj][m][n];
#pragma unroll
                        for (int i = 0; i < 4; ++i) { x[i] = __builtin_amdgcn_exp2f(x[i] - mx); s += x[i]; } acc[ai][bj][m][n] = x; }
                s += __shfl_xor(s, 16); s += __shfl_xor(s, 32);
                if (fq == 0) PS[r * 4 + wc] = s; }
        LDS_WAIT(); __builtin_amdgcn_s_barrier(); asm volatile("" ::: "memory");
        EPI_ROWS(u); bf16_t* base = P + (size_t)u.pn * 256 + wc * 32 + 8 * fq;
#pragma unroll
        for (int ai = 0; ai < 2; ++ai)
#pragma unroll
            for (int m = 0; m < 4; ++m) { const int r = ai * HALF + wr * 64 + m * 16 + fr; const f32x4 q = *(const LAS f32x4*)(PS + r * 4);
                const float inv = 1.f / ((q[0] + q[1]) + (q[2] + q[3])); bf16_t* rowp = base + (size_t)(row0 + ai * HALF + m * 16) * D;
#pragma unroll
                for (int bj = 0; bj < 2; ++bj) *(u32x4*)(rowp + bj * HALF) = pack8(acc[ai][bj][m][0] * inv, acc[ai][bj][m][1] * inv); }
        LDS_WAIT(); __builtin_amdgcn_s_barrier();
    }
};
}

typedef GAS unsigned gu32;
#define XB_TMO      128
#define XB_XCNT(j)  (256  + 64 * (j))
#define XB_XSUB(j)  (1280 + 64 * (j))
#define XB_XGEN(j)  (2304 + 64 * (j))
#define XB_TOP      3328
#define XB_TOPGEN   3392
#define XCD_BAR_WORDS 3456
#define XB_SPIN_CAP (1u << 22)
DEV unsigned xb_ld(unsigned* p) { return __hip_atomic_load(p, __ATOMIC_RELAXED, __HIP_MEMORY_SCOPE_AGENT); }
DEV unsigned xb_add(unsigned* p, unsigned v) { return __hip_atomic_fetch_add(p, v, __ATOMIC_RELAXED, __HIP_MEMORY_SCOPE_AGENT); }
DEV unsigned xb_xcc_id() { return (unsigned)__builtin_amdgcn_s_getreg((3 << 11) | 20) & 0xFu; }
#define XB_SPIN(cond, bar) do { unsigned _sp = 0; while (cond) { __builtin_amdgcn_s_sleep(1); \
    if ((++_sp & 255u) == 0u) { if (xb_ld(&(bar)[XB_TMO])) break; if (_sp > XB_SPIN_CAP) { atomicAdd(&(bar)[XB_TMO], 1u); break; } } } } while (0)
struct XcdBarrier { unsigned* bar; unsigned x; volatile LAS unsigned* st; };
DEV XcdBarrier xcd_barrier_post(unsigned* bar, volatile LAS unsigned* st, int tid) {
    XcdBarrier b; b.bar = bar; b.x = xb_xcc_id(); b.st = st;
    if (tid == 0) (void)xb_add(&bar[XB_XCNT(b.x)], 1u);
    return b;
}
DEV void xcd_barrier_complete(unsigned* bar, unsigned x, unsigned& nloc, unsigned& nx) {
    const unsigned G = gridDim.x * gridDim.y * gridDim.z;
    unsigned sum, cnt, mine, sp = 0u;
    for (;;) {
        sum = 0u; cnt = 0u; mine = 0u;
#pragma unroll
        for (unsigned j = 0; j < 16; ++j) { const unsigned c = xb_ld(&bar[XB_XCNT(j)]); sum += c; cnt += (c > 0u) ? 1u : 0u; mine = (j == x) ? c : mine; }
        if (sum == G) break;
        __builtin_amdgcn_s_sleep(1);
        if ((++sp & 255u) == 0u) { if (xb_ld(&bar[XB_TMO])) break; if (sp > XB_SPIN_CAP) { atomicAdd(&bar[XB_TMO], 1u); break; } }
    }
    nloc = mine > 0u ? mine : 1u; nx = cnt > 0u ? cnt : 1u;
}
DEV void xcd_barrier(const XcdBarrier& b, int tid) {
    asm volatile("s_waitcnt vmcnt(0)" ::: "memory");
    __syncthreads();
    if (tid == 0) {
        unsigned* bar = b.bar;
        __builtin_amdgcn_s_waitcnt(0);
        unsigned nloc = b.st[0], nx = b.st[1];
        if (nloc == 0u) { xcd_barrier_complete(bar, b.x, nloc, nx); b.st[0] = nloc; b.st[1] = nx; }
        const unsigned old = xb_add(&bar[XB_XSUB(b.x)], 1u);
        const unsigned gen = old / nloc;
        if (old + 1u == (gen + 1u) * nloc) {
            __builtin_amdgcn_fence(__ATOMIC_RELEASE, "agent");
            asm volatile("s_waitcnt vmcnt(0)" ::: "memory");
            const unsigned og = xb_add(&bar[XB_TOP], 1u);
            const unsigned tg = og / nx;
            if (og + 1u == (tg + 1u) * nx) xb_add(&bar[XB_TOPGEN], 1u);
            else XB_SPIN(xb_ld(&bar[XB_TOPGEN]) == tg, bar);
            __builtin_amdgcn_fence(__ATOMIC_ACQUIRE, "agent");
            xb_add(&bar[XB_XGEN(b.x)], 1u);
            asm volatile("s_waitcnt vmcnt(0)" ::: "memory");
        } else {
            XB_SPIN(xb_ld(&bar[XB_XGEN(b.x)]) == gen, bar);
            __builtin_amdgcn_fence(__ATOMIC_ACQUIRE, "agent");
            asm volatile("s_waitcnt vmcnt(0)" ::: "memory");
        }
    }
    __syncthreads();
}


struct WaveId { int gw, ngw, wave, lane; };
DEV unsigned f2bf_u(float f) { return (unsigned)f2bf(f); }
DEV unsigned pk2(float lo, float hi) { return cvt_pk_bf16(lo, hi); }

DEV void norm_rows(const WaveId& W, const float* x, const float* g, bf16_t* outb, float* outf, int rows) {
    for (int row = W.gw; row < rows; row += W.ngw) {
        const f32x4* xr = (const f32x4*)(x + (size_t)row * D) + W.lane;
        f32x4 v[4]; float s = 0.f;
#pragma unroll
        for (int j = 0; j < 4; ++j) { v[j] = xr[64 * j]; s += (v[j].x * v[j].x + v[j].y * v[j].y) + (v[j].z * v[j].z + v[j].w * v[j].w); }
        const float r = rsqrtf(wave_sum(s) * (1.f / D) + EPS);
#pragma unroll
        for (int j = 0; j < 4; ++j) {
            const f32x4 gg = ((const f32x4*)g)[W.lane + 64 * j];
            const f32x4 o = {v[j].x * r * gg.x, v[j].y * r * gg.y, v[j].z * r * gg.z, v[j].w * r * gg.w};
            if (outb) { u32x2 w; w.x = pk2(o.x, o.y); w.y = pk2(o.z, o.w); ((u32x2*)(outb + (size_t)row * D))[W.lane + 64 * j] = w; }
            else ((f32x4*)(outf + (size_t)row * D))[W.lane + 64 * j] = o;
        }
    }
}
DEV void cvt_piece(const WaveId& W, LAS float* scr, int& base, const float* Wsrc, int ldw, int K, int col0, int ncols, bf16_t* dst, int ldo, int row0, const float* gain = nullptr) {
    const int nblk = ncols / 32, nitems = (K / 64) * nblk;
    int first = (W.gw - base) % W.ngw; if (first < 0) first += W.ngw;
    base = (base + nitems) % W.ngw;
    for (int item = first; item < nitems; item += W.ngw) {
        const int kb = item / nblk, nb = item - kb * nblk, k0 = 64 * kb, n0 = 32 * nb;
#pragma unroll 8
        for (int i = 0; i < 32; ++i) { const int kk = 2 * i + (W.lane >> 5); scr[kk * 33 + (W.lane & 31)] = Wsrc[(size_t)(k0 + kk) * ldw + col0 + n0 + (W.lane & 31)] * (gain ? gain[k0 + kk] : 1.f); }
        LDS_WAIT(); asm volatile("" ::: "memory");
        const int c = W.lane & 7;
#pragma unroll
        for (int j = 0; j < 4; ++j) { const int n = (W.lane >> 3) + 8 * j; const LAS float* s = scr + (8 * c) * 33 + n;
            u32x4 o; o.x = pk2(s[0 * 33], s[1 * 33]); o.y = pk2(s[2 * 33], s[3 * 33]); o.z = pk2(s[4 * 33], s[5 * 33]); o.w = pk2(s[6 * 33], s[7 * 33]);
            *(u32x4*)(dst + (size_t)(row0 + n0 + n) * ldo + k0 + 8 * c) = o; }
        LDS_WAIT(); asm volatile("" ::: "memory");
    }
}
DEV void convert_layer_weights(const WaveId& W, LAS float* scr, int& base, unsigned char* ws, const float* const* in, int l) {
    const float* wi = in[3] + (size_t)l * D * DIN;
    bf16_t* WIN = (bf16_t*)(ws + WS_WIN); const float* gm = in[2] + l * D; const float* gf = in[14] + l * D;
    cvt_piece(W, scr, base, wi, DIN, D, 0, 1536, WIN, D, 0, gm);
    cvt_piece(W, scr, base, wi, DIN, D, 3072, 1536, WIN, D, 1536, gm);
    cvt_piece(W, scr, base, wi, DIN, D, 4608, 512, WIN, D, 3072, gm);
    cvt_piece(W, scr, base, wi, DIN, D, 1536, 512, WIN, D, 3584, gm);
#pragma unroll 1
    for (int j = 0; j < 4; ++j) { cvt_piece(W, scr, base, wi, DIN, D, 2048 + 128 * j, 128, WIN, D, 4096 + 256 * j, gm); cvt_piece(W, scr, base, wi, DIN, D, 2560 + 128 * j, 128, WIN, D, 4096 + 256 * j + 128, gm); }
    cvt_piece(W, scr, base, wi, DIN, D, 5120, 96, WIN, D, 5120, gm);
    cvt_piece(W, scr, base, wi, DIN, D, 5192, 3072, (bf16_t*)(ws + WS_WG), D, 0, gm);
#pragma unroll 1
    for (int i = 0; i < 3; ++i) cvt_piece(W, scr, base, in[5 + i] + (size_t)l * 512 * D, D, 512, 0, D, (bf16_t*)(ws + WS_WBR) + (size_t)i * D * 512, 512, 0);
    cvt_piece(W, scr, base, in[8] + (size_t)l * D * D, D, D, 0, D, (bf16_t*)(ws + WS_WMIX), D, 0);
    const float* wf = in[15] + (size_t)l * D * 2 * DFF;
#pragma unroll 1
    for (int j = 0; j < 22; ++j) { cvt_piece(W, scr, base, wf, 2 * DFF, D, 128 * j, 128, (bf16_t*)(ws + WS_WUP), D, 256 * j, gf); cvt_piece(W, scr, base, wf, 2 * DFF, D, DFF + 128 * j, 128, (bf16_t*)(ws + WS_WUP), D, 256 * j + 128, gf); }
    cvt_piece(W, scr, base, in[18] + (size_t)l * DFF * D, D, DFF, 0, D, (bf16_t*)(ws + WS_WDOWN), DFF, 0);
}
DEV void prep0_phase(const WaveId& W, LAS float* scr, unsigned char* ws, const float* const* in, bf16_t* XB) {
    int base = 0;
#pragma unroll 1
    for (int l = 0; l < DEPTH; ++l) {
        const float* wq = in[11] + (size_t)l * D * D; bf16_t* WQ = (bf16_t*)(ws + WS_WQ + (size_t)l * 2 * MiB); const float* gx = in[9] + l * D;
        for (size_t i = (size_t)(W.gw * 64 + W.lane) * 4; i < (size_t)D * D; i += (size_t)W.ngw * 256) { const float g = gx[i >> 10]; const f32x4 v = *(const f32x4*)(wq + i); u32x2 o; o.x = pk2(v.x * g, v.y * g); o.y = pk2(v.z * g, v.w * g); *(u32x2*)(WQ + i) = o; }
        cvt_piece(W, scr, base, in[13] + (size_t)l * D * D, D, D, 0, D, (bf16_t*)(ws + WS_WOT + (size_t)l * 2 * MiB), D, 0);
        cvt_piece(W, scr, base, in[12] + (size_t)l * D * 2 * D, 2 * D, D, 0, 2 * D, (bf16_t*)(ws + WS_WKVT + (size_t)l * 4 * MiB), D, 0);
        norm_rows(W, in[1], in[10] + l * D, (bf16_t*)(ws + WS_MEMN + (size_t)l * MiB), nullptr, NB * MEM);
    }
    convert_layer_weights(W, scr, base, ws, in, 0);
    pg8::u64* ss0 = (pg8::u64*)(ws + WS_SS);
    for (int row = W.gw; row < T; row += W.ngw) {
        const f32x4* xr = (const f32x4*)(in[0] + (size_t)row * D) + W.lane; float s = 0.f;
#pragma unroll
        for (int j = 0; j < 4; ++j) { const f32x4 v = xr[64 * j]; s += (v.x * v.x + v.y * v.y) + (v.z * v.z + v.w * v.w);
            u32x2 w; w.x = pk2(v.x, v.y); w.y = pk2(v.z, v.w); ((u32x2*)(XB + (size_t)row * D))[W.lane + 64 * j] = w; }
        s = wave_sum(s); if (W.lane == 0) ss0[row] = (pg8::u64)(s * pg8::SS_SCALE + 0.5f);
    }
}
DEV void final_norm(const WaveId& W, const bf16_t* x, float* out, const float* g, const pg8::u64* ss) {
    for (int row = W.gw; row < T; row += W.ngw) {
        const float r = rsqrtf((float)ss[row] * (1.f / (pg8::SS_SCALE * D)) + EPS); const u32x2* xr = (const u32x2*)(x + (size_t)row * D) + W.lane; f32x4* orow = (f32x4*)(out + (size_t)row * D) + W.lane;
#pragma unroll
        for (int j = 0; j < 4; ++j) { const f32x4 gg = ((const f32x4*)g)[W.lane + 64 * j]; const u32x2 v = xr[64 * j];
            const f32x4 o = {bflo(v.x) * r * gg.x, bfhi(v.x) * r * gg.y, bflo(v.y) * r * gg.z, bfhi(v.y) * r * gg.w}; orow[64 * j] = o; }
    }
}
DEV void conv_sc_phase(int gtid, int gthreads, bf16_t* scb, const bf16_t* cx, const float* w, bool dry) {
    for (int i = gtid; i < T * 64; i += gthreads) {
        const int c8 = (i & 63) * 8, t = i >> 6, tl = t & (S - 1);
        const size_t o = (size_t)t * 512 + c8;
        const u32x4 z = {0u, 0u, 0u, 0u};
        const u32x4 x2 = *(const u32x4*)(cx + o), x1 = tl >= 1 ? *(const u32x4*)(cx + o - 512) : z, x0 = tl >= 2 ? *(const u32x4*)(cx + o - 1024) : z, bb = *(const u32x4*)(scb + o);
        const f32x4 w0a = *(const f32x4*)(w + c8), w0b = *(const f32x4*)(w + c8 + 4), w1a = *(const f32x4*)(w + 512 + c8), w1b = *(const f32x4*)(w + 512 + c8 + 4), w2a = *(const f32x4*)(w + 1024 + c8), w2b = *(const f32x4*)(w + 1024 + c8 + 4);
        float r[8];
#define CONV1(k, W0, W1, W2, X0, X1, X2, BBv, F) r[k] = F(BBv) * (W0 * F(X0) + W1 * F(X1) + W2 * F(X2))
        CONV1(0, w0a.x, w1a.x, w2a.x, x0.x, x1.x, x2.x, bb.x, bflo); CONV1(1, w0a.y, w1a.y, w2a.y, x0.x, x1.x, x2.x, bb.x, bfhi);
        CONV1(2, w0a.z, w1a.z, w2a.z, x0.y, x1.y, x2.y, bb.y, bflo); CONV1(3, w0a.w, w1a.w, w2a.w, x0.y, x1.y, x2.y, bb.y, bfhi);
        CONV1(4, w0b.x, w1b.x, w2b.x, x0.z, x1.z, x2.z, bb.z, bflo); CONV1(5, w0b.y, w1b.y, w2b.y, x0.z, x1.z, x2.z, bb.z, bfhi);
        CONV1(6, w0b.z, w1b.z, w2b.z, x0.w, x1.w, x2.w, bb.w, bflo); CONV1(7, w0b.w, w1b.w, w2b.w, x0.w, x1.w, x2.w, bb.w, bfhi);
#undef CONV1
        u32x4 ov; ov.x = pk2(r[0], r[1]); ov.y = pk2(r[2], r[3]); ov.z = pk2(r[4], r[5]); ov.w = pk2(r[6], r[7]);
        if (!dry) *(u32x4*)(scb + o) = ov; else asm volatile("" :: "v"(ov));
    }
}
DEV float gelu_t(float a) { return a * __builtin_amdgcn_rcpf(1.f + __builtin_amdgcn_exp2f(-1.5957691216057308f * LOG2E * (a + 0.044715f * a * a * a))); }
DEV void ffn_mid_phase(int gtid, int gthreads, const bf16_t* fa, bf16_t* fu, const float* cw, const float* cb, bool dry) {
    constexpr int C8 = DFF / 8;
    for (int i = gtid; i < T * C8; i += gthreads) {
        const int t = i / C8, c8 = (i - t * C8) * 8, tl = t & (S - 1);
        const size_t o = (size_t)t * DFF + c8;
        const u32x4 z = {0u, 0u, 0u, 0u};
        const u32x4 x2 = *(const u32x4*)(fa + o), x1 = tl >= 1 ? *(const u32x4*)(fa + o - DFF) : z, x0 = tl >= 2 ? *(const u32x4*)(fa + o - 2 * DFF) : z, uu = *(const u32x4*)(fu + o);
        const f32x4 w0a = *(const f32x4*)(cw + c8), w0b = *(const f32x4*)(cw + c8 + 4), w1a = *(const f32x4*)(cw + DFF + c8), w1b = *(const f32x4*)(cw + DFF + c8 + 4), w2a = *(const f32x4*)(cw + 2 * DFF + c8), w2b = *(const f32x4*)(cw + 2 * DFF + c8 + 4);
        const f32x4 ba = *(const f32x4*)(cb + c8), bb = *(const f32x4*)(cb + c8 + 4);
        float r[8];
#define FM1(k, B0, W0, W1, W2, X0, X1, X2, Uv, F) r[k] = gelu_t(B0 + W0 * F(X0) + W1 * F(X1) + W2 * F(X2)) * F(Uv)
        FM1(0, ba.x, w0a.x, w1a.x, w2a.x, x0.x, x1.x, x2.x, uu.x, bflo); FM1(1, ba.y, w0a.y, w1a.y, w2a.y, x0.x, x1.x, x2.x, uu.x, bfhi);
        FM1(2, ba.z, w0a.z, w1a.z, w2a.z, x0.y, x1.y, x2.y, uu.y, bflo); FM1(3, ba.w, w0a.w, w1a.w, w2a.w, x0.y, x1.y, x2.y, uu.y, bfhi);
        FM1(4, bb.x, w0b.x, w1b.x, w2b.x, x0.z, x1.z, x2.z, uu.z, bflo); FM1(5, bb.y, w0b.y, w1b.y, w2b.y, x0.z, x1.z, x2.z, uu.z, bfhi);
        FM1(6, bb.z, w0b.z, w1b.z, w2b.z, x0.w, x1.w, x2.w, uu.w, bflo); FM1(7, bb.w, w0b.w, w1b.w, w2b.w, x0.w, x1.w, x2.w, uu.w, bfhi);
#undef FM1
        u32x4 ov; ov.x = pk2(r[0], r[1]); ov.y = pk2(r[2], r[3]); ov.z = pk2(r[4], r[5]); ov.w = pk2(r[6], r[7]);
        if (!dry) *(u32x4*)(fu + o) = ov; else asm volatile("" :: "v"(ov));
    }
}

typedef short s16x4 __attribute__((ext_vector_type(4)));
DEV s16x4 vtr(const LAS unsigned char* p) { return __builtin_bit_cast(s16x4, __builtin_amdgcn_ds_read_tr16_b64_v4i16((LAS s16x4*)p)); }
DEV bf16x8 cat8(const s16x4 a, const s16x4 b) { return (bf16x8){a[0], a[1], a[2], a[3], b[0], b[1], b[2], b[3]}; }
DEV bf16x8 pk8(float a0, float a1, float a2, float a3, float a4, float a5, float a6, float a7) {
    u32x4 w; w.x = pk2(a0, a1); w.y = pk2(a2, a3); w.z = pk2(a4, a5); w.w = pk2(a6, a7); return __builtin_bit_cast(bf16x8, w); }
constexpr int VPITCH = 192;
DEV void pv_tile(f32x16& o0, f32x16& o1, const LAS unsigned char* vt, int lane, const bf16x8 (&pk)[4]) {
    const int hi = lane >> 5;
    const LAS unsigned char* vb = vt + (4 * hi + ((lane & 15) >> 2)) * VPITCH + ((lane >> 4) & 1) * 32 + (lane & 3) * 8;
    bf16x8 va[4];
#pragma unroll
    for (int ks = 0; ks < 4; ++ks) va[ks] = cat8(vtr(vb + (16 * ks) * VPITCH), vtr(vb + (16 * ks + 8) * VPITCH));
    asm volatile("" : "+v"(va[0]), "+v"(va[1]), "+v"(va[2]), "+v"(va[3]));
#pragma unroll
    for (int ks = 0; ks < 4; ++ks) o0 = __builtin_amdgcn_mfma_f32_32x32x16_bf16(va[ks], pk[ks], o0, 0, 0, 0);
#pragma unroll
    for (int ks = 0; ks < 4; ++ks) va[ks] = cat8(vtr(vb + (16 * ks) * VPITCH + 64), vtr(vb + (16 * ks + 8) * VPITCH + 64));
    asm volatile("" : "+v"(va[0]), "+v"(va[1]), "+v"(va[2]), "+v"(va[3]));
#pragma unroll
    for (int ks = 0; ks < 4; ++ks) o1 = __builtin_amdgcn_mfma_f32_32x32x16_bf16(va[ks], pk[ks], o1, 0, 0, 0);
}
DEV void store_ot(bf16_t* orow, const f32x16& o0, const f32x16& o1, int hi, float sc) {
#pragma unroll
    for (int g4 = 0; g4 < 4; ++g4) {
        u32x2 a; a.x = pk2(o0[4 * g4] * sc, o0[4 * g4 + 1] * sc); a.y = pk2(o0[4 * g4 + 2] * sc, o0[4 * g4 + 3] * sc);
        u32x2 b; b.x = pk2(o1[4 * g4] * sc, o1[4 * g4 + 1] * sc); b.y = pk2(o1[4 * g4 + 2] * sc, o1[4 * g4 + 3] * sc);
        *(u32x2*)(orow + 8 * g4 + 4 * hi) = a; *(u32x2*)(orow + 32 + 8 * g4 + 4 * hi) = b;
    }
}

DEV void sb_item(LAS unsigned char* vl, const bf16_t* Q, const bf16_t* Kk, const bf16_t* V, bf16_t* O, int b, int h, int qb, int lane, bool dry) {
    const int r32 = lane & 31, hi = lane >> 5, t0 = 32 * qb, t = t0 + r32; const size_t rowb = (size_t)b * S;
    bf16x8 qr[4]; { const bf16_t* qp = Q + (rowb + t0 + r32) * 512 + h * 64 + 8 * hi;
#pragma unroll
        for (int d0 = 0; d0 < 4; ++d0) qr[d0] = *(const bf16x8*)(qp + 16 * d0); }
    f32x16 o0, o1;
#pragma unroll
    for (int r = 0; r < 16; ++r) { o0[r] = 0.f; o1[r] = 0.f; }
    float carry = 1.f;
    const int c_hi = (t0 + 30) >> 6;
#pragma unroll 1
    for (int c = c_hi; c >= 0; --c) {
        const bf16_t* kp = Kk + (rowb + 64 * c + r32) * 512 + h * 64 + 8 * hi;
        bf16x8 k0[4], k1[4];
#pragma unroll
        for (int d0 = 0; d0 < 4; ++d0) { k0[d0] = *(const bf16x8*)(kp + 16 * d0); k1[d0] = *(const bf16x8*)(kp + (size_t)32 * 512 + 16 * d0); }
#pragma unroll
        for (int j = 0; j < 8; ++j) { const int row = (lane >> 3) + 8 * j; *(LAS u32x4*)(vl + row * VPITCH + (lane & 7) * 16) = *(const u32x4*)(V + (rowb + 64 * c + row) * 512 + h * 64 + (lane & 7) * 8); }
        f32x16 p0, p1;
#pragma unroll
        for (int r = 0; r < 16; ++r) { p0[r] = 0.f; p1[r] = 0.f; }
#pragma unroll
        for (int d0 = 0; d0 < 4; ++d0) { p0 = __builtin_amdgcn_mfma_f32_32x32x16_bf16(k0[d0], qr[d0], p0, 0, 0, 0); p1 = __builtin_amdgcn_mfma_f32_32x32x16_bf16(k1[d0], qr[d0], p1, 0, 0, 0); }
        float u[32];
        const bool diag = (c == c_hi);
#pragma unroll
        for (int e = 0; e < 32; ++e) {
            const float z = e < 16 ? p0[e] : p1[e - 16];
            float uu = __builtin_amdgcn_rcpf(1.f + __builtin_amdgcn_exp2f(fminf(z, 126.f)));
            if (diag) { const int kv = 64 * c + 8 * ((e >> 2) & 3) + 4 * hi + (e & 3) + 32 * (e >> 4); if (kv >= t) uu = 1.f; }
            u[e] = uu;
        }
        float gl[8], gh[8];
#pragma unroll
        for (int i = 0; i < 8; ++i) { const float gp = (u[4 * i] * u[4 * i + 1]) * (u[4 * i + 2] * u[4 * i + 3]);
            const auto rr = __builtin_amdgcn_permlane32_swap(__float_as_uint(gp), __float_as_uint(gp), false, false); gl[i] = __uint_as_float(rr[0]); gh[i] = __uint_as_float(rr[1]); }
        float ag[8]; float run = carry;
#pragma unroll
        for (int i = 7; i >= 0; --i) { const float a_hi = run; run *= gh[i]; const float a_lo = run; run *= gl[i]; ag[i] = hi ? a_hi : a_lo; }
        carry = run;
        bf16x8 pk[4];
#pragma unroll
        for (int ks = 0; ks < 4; ++ks) { float w[8];
#pragma unroll
            for (int g = 0; g < 2; ++g) { const int i = 2 * ks + g;
                const float a3 = ag[i], a2 = a3 * u[4 * i + 3], a1 = a2 * u[4 * i + 2], a0 = a1 * u[4 * i + 1];
                w[4 * g] = (1.f - u[4 * i]) * a0; w[4 * g + 1] = (1.f - u[4 * i + 1]) * a1; w[4 * g + 2] = (1.f - u[4 * i + 2]) * a2; w[4 * g + 3] = (1.f - u[4 * i + 3]) * a3; }
            pk[ks] = pk8(w[0], w[1], w[2], w[3], w[4], w[5], w[6], w[7]); }
        pv_tile(o0, o1, vl, lane, pk);
        if (__all(carry < 7.8e-31f)) break;
    }
    if (!dry) store_ot(O + (rowb + t0 + r32) * 512 + h * 64, o0, o1, hi, 1.f); else asm volatile("" :: "v"(o0), "v"(o1));
}
DEV void sb_phase(const WaveId& W, LAS unsigned char* lds, unsigned char* ws, bool dry) {
    LAS unsigned char* vl = lds + W.wave * 12288;
    const bf16_t* Q = (const bf16_t*)(ws + WS_QA); const bf16_t* Kk = (const bf16_t*)(ws + WS_KA); const bf16_t* V = (const bf16_t*)(ws + WS_VA);
    constexpr int NITEM = NB * 8 * (S / 32);
    for (int it = W.gw; it < NITEM; it += W.ngw) {
        const int qb = it & 255, h = (it >> 8) & 7, b = it >> 11;
        sb_item(vl, Q, Kk, V, (bf16_t*)(ws + WS_QA), b, h, qb, W.lane, dry);
    }
}

constexpr int IDX_CTL_OFF = 131072 + 1024;
DEV unsigned fkey2(float v) { const int u = (int)__float_as_uint(v); return (unsigned)(u ^ ((u >> 31) | (int)0x80000000)); }
DEV float relu1(float x) { return __builtin_amdgcn_fmed3f(x, 0.f, 3.0e38f); }
DEV void idx_prefetch(bf16x8 (&afr)[4], float (&w)[16], bf16x8 (&b0)[4], bf16x8 (&b1)[4], const bf16_t* IQ, const bf16_t* IK, const float* IWp, int b, int t0, int wid, int lane) {
    const int r32 = lane & 31, hh = lane >> 5; const size_t rowb = (size_t)b * S;
    { const int qi = 2 * (r32 >> 4) + ((r32 >> 2) & 1), head = (r32 & 3) + 4 * ((r32 >> 3) & 1);
        const bf16_t* ap = IQ + (rowb + t0 + qi) * 512 + head * 64 + 8 * hh;
#pragma unroll
        for (int ks = 0; ks < 4; ++ks) afr[ks] = *(const bf16x8*)(ap + 16 * ks); }
#pragma unroll
    for (int r = 0; r < 16; ++r) w[r] = IWp[(rowb + t0 + 2 * (r >> 3) + hh) * 8 + (r & 7)];
    const int jmax = (t0 + 3) >> 5;
    { const int j0 = wid < jmax ? wid : jmax, j1 = wid + 8 < jmax ? wid + 8 : jmax;
      const bf16_t* p0 = IK + ((rowb >> 5) + j0) * 2048 + (hh * 32 + r32) * 8; const bf16_t* p1 = IK + ((rowb >> 5) + j1) * 2048 + (hh * 32 + r32) * 8;
#pragma unroll
      for (int ks = 0; ks < 4; ++ks) { b0[ks] = *(const bf16x8*)(p0 + ks * 512); b1[ks] = *(const bf16x8*)(p1 + ks * 512); } }
}
DEV void idx_unit(LAS unsigned char* lds, const bf16_t* IQ, const bf16_t* IK, const float* IWp, unsigned* BM, int b, int t0, int nb, int nt0, int wid, int lane,
                  bf16x8 (&afr)[4], float (&w)[16], bf16x8 (&b0)[4], bf16x8 (&b1)[4]) {
    const int r32 = lane & 31, hh = lane >> 5; const size_t rowb = (size_t)b * S;
    const int tmax = t0 + 3, jmax = tmax >> 5;
    LAS unsigned* SCO = (LAS unsigned*)lds;
    bf16x8 b2[4];
#pragma unroll
    for (int ks = 0; ks < 4; ++ks) b2[ks] = afr[ks];
#define IDX_LOADB(dst, jj) do { const int jc_ = (jj) < jmax ? (jj) : jmax; const bf16_t* bp_ = IK + ((rowb >> 5) + jc_) * 2048 + (hh * 32 + r32) * 8; \
        _Pragma("unroll") for (int ks = 0; ks < 4; ++ks) dst[ks] = *(const bf16x8*)(bp_ + ks * 512); } while (0)
#define IDX_COMP(src, jj) do { f32x16 acc; _Pragma("unroll") for (int r = 0; r < 16; ++r) acc[r] = 0.f; \
        _Pragma("unroll") for (int ks = 0; ks < 4; ++ks) acc = __builtin_amdgcn_mfma_f32_32x32x16_bf16(afr[ks], src[ks], acc, 0, 0, 0); \
        float s0 = 0.f, s1 = 0.f; _Pragma("unroll") for (int hd = 0; hd < 8; ++hd) { s0 += w[hd] * relu1(acc[hd]); s1 += w[8 + hd] * relu1(acc[8 + hd]); } \
        unsigned k0_ = fkey2(s0), k1_ = fkey2(s1); const int key = 32 * (jj) + r32; \
        if ((jj) >= jmax) { k0_ = key <= t0 + hh ? k0_ : 0u; k1_ = key <= t0 + 2 + hh ? k1_ : 0u; }     \
        if ((jj) <= jmax) { SCO[hh * 8192 + key] = k0_; SCO[(2 + hh) * 8192 + key] = k1_; } } while (0)
#ifndef IDX_REP_MFMA
#define IDX_REP_MFMA 1
#endif
#ifndef IDX_REP_SEL
#define IDX_REP_SEL 1
#endif
#pragma unroll 1
    for (int rpm = 0; rpm < IDX_REP_MFMA; ++rpm) {
#pragma unroll 1
    for (int j = wid; j <= jmax; j += 24) {
        IDX_LOADB(b2, j + 16); IDX_COMP(b0, j);
        IDX_LOADB(b0, j + 24); IDX_COMP(b1, j + 8);
        IDX_LOADB(b1, j + 32); IDX_COMP(b2, j + 16);
    }
    }
#undef IDX_LOADB
#undef IDX_COMP
    if (nt0 >= 0) idx_prefetch(afr, w, b0, b1, IQ, IK, IWp, nb, nt0, wid, lane);
    LAS unsigned* thr = (LAS unsigned*)(lds + IDX_CTL_OFF);
    if (wid == 0 && lane < 32) ((LAS unsigned*)(lds + IDX_CTL_OFF + 64))[lane] = 0u;
    LDS_WAIT(); __builtin_amdgcn_s_barrier(); asm volatile("" ::: "memory");
    {
        const int q = wid & 3, h = wid >> 2, n = t0 + q + 1;
        volatile LAS unsigned* xme = (volatile LAS unsigned*)(lds + IDX_CTL_OFF + 64) + (q * 2 + h) * 4;
        volatile LAS unsigned* xpa = (volatile LAS unsigned*)(lds + IDX_CTL_OFF + 64) + (q * 2 + (h ^ 1)) * 4;
        unsigned T_ = 1u;
        if (n > 256) {
            LAS unsigned* row = SCO + q * 8192 + lane;
            unsigned r[64];
            const int nil = (jmax >> 1) >= h ? (((jmax >> 1) - h) >> 1) + 1 : 0;
#define IDX_FOR_LIVE(BODY) _Pragma("unroll") for (int g8_ = 0; g8_ < 8; ++g8_) if (8 * g8_ < nil) { _Pragma("unroll") for (int u8_ = 0; u8_ < 8; ++u8_) { const int il = 8 * g8_ + u8_; BODY } }
            IDX_FOR_LIVE( r[il] = (2 * (2 * il + h) + hh <= jmax) ? row[64 * (2 * il + h)] : 0u; )
            unsigned seq = 0u;
#define IDX_XCHG(val, out) do { ++seq; const int pb_ = (seq & 1u) * 2; if (lane == 0) { xme[pb_ + 1] = (val); xme[pb_] = seq; } \
                while (xpa[pb_] != seq) __builtin_amdgcn_s_sleep(0); (out) = xpa[pb_ + 1]; } while (0)
#define IDX_XCHG16(val, out) do { ++seq; const int pb_ = (seq & 1u) * 2; if (lane == 0) xme[pb_] = (seq << 16) | (val); unsigned w_; \
                while (((w_ = xpa[pb_]) >> 16) != (seq & 0xffffu)) __builtin_amdgcn_s_sleep(0); (out) = w_ & 0xffffu; } while (0)
#pragma unroll 1
            for (int rps = 0; rps < IDX_REP_SEL; ++rps) {
            unsigned mx = 0u;
            IDX_FOR_LIVE( mx = max(mx, r[il]); )
#pragma unroll
            for (int o = 1; o < 64; o <<= 1) mx = max(mx, (unsigned)__shfl_xor((int)mx, o));
            { unsigned pm_; IDX_XCHG(mx, pm_); mx = max(mx, pm_); }
            unsigned lo_ = 1u, hi_ = mx + 1u, chi_ = 0u, xgt_ = 1u, xeq_ = 0u, mt_ = 0u; float glo_ = __log2f((float)n) - 8.f, ghi_ = -9.f; int side_ = 0; bool done_ = false;
#pragma unroll 1
            for (int pass = 0; pass < 2 && !done_; ++pass) {
                const unsigned wdt = hi_ - lo_;
                unsigned off;
                if (pass < 2) {
                    const unsigned mkey = hi_ - 1u; const unsigned tgt = pass == 0 ? mkey - (1u << 23) : mkey - (3u << 23);
                    const bool ok = pass == 0 ? (mkey > 0x81000000u) : (mkey > 0x82000000u && tgt > lo_ && tgt < hi_);
                    off = ok ? tgt - lo_ : wdt >> 1;
                } else if ((pass & 3) == 3) off = wdt >> 1;
                else off = (unsigned)(glo_ * __builtin_amdgcn_rcpf(glo_ - ghi_) * (float)wdt);
                off = off < 1u ? 1u : (off > wdt - 1u ? wdt - 1u : off);
                const unsigned cand = (unsigned)__builtin_amdgcn_readfirstlane((int)(lo_ + off));
                unsigned ca_ = 0, cb_ = 0; const unsigned candv = lo_ + off;
#define IDX_CNT4(A, B, C, Dd) asm volatile("v_cmp_ge_u32_e64 s[88:89], %2, %6\n\tv_cmp_ge_u32_e64 s[90:91], %3, %6\n\tv_cmp_ge_u32_e64 s[92:93], %4, %6\n\tv_cmp_ge_u32_e64 s[94:95], %5, %6\n\t" \
                    "v_addc_co_u32_e64 %0, s[88:89], %0, 0, s[88:89]\n\tv_addc_co_u32_e64 %1, s[90:91], %1, 0, s[90:91]\n\tv_addc_co_u32_e64 %0, s[92:93], %0, 0, s[92:93]\n\tv_addc_co_u32_e64 %1, s[94:95], %1, 0, s[94:95]" \
                    : "+v"(ca_), "+v"(cb_) : "v"(A), "v"(B), "v"(C), "v"(Dd), "v"(candv) : "s88", "s89", "s90", "s91", "s92", "s93", "s94", "s95")
#pragma unroll
                for (int g8_ = 0; g8_ < 8; ++g8_) if (8 * g8_ < nil) { IDX_CNT4(r[8 * g8_], r[8 * g8_ + 1], r[8 * g8_ + 2], r[8 * g8_ + 3]); IDX_CNT4(r[8 * g8_ + 4], r[8 * g8_ + 5], r[8 * g8_ + 6], r[8 * g8_ + 7]); }
#undef IDX_CNT4
                int pk = (int)(ca_ + cb_);
                pk += __builtin_amdgcn_update_dpp(0, pk, 0x111, 0xf, 0xf, false);
                pk += __builtin_amdgcn_update_dpp(0, pk, 0x112, 0xf, 0xf, false);
                pk += __builtin_amdgcn_update_dpp(0, pk, 0x114, 0xf, 0xf, false);
                pk += __builtin_amdgcn_update_dpp(0, pk, 0x118, 0xf, 0xf, false);
                pk += __builtin_amdgcn_update_dpp(0, pk, 0x142, 0xa, 0xf, false);
                unsigned tot = (unsigned)__builtin_amdgcn_readlane(pk, 31) + (unsigned)__builtin_amdgcn_readlane(pk, 63);
                { unsigned pt_; IDX_XCHG16(tot, pt_); tot += pt_; }
                const float gc = __log2f(fmaxf((float)tot, 0.5f)) - 8.f;
                if (tot == 256u) { xgt_ = cand; mt_ = 0u; done_ = true; }
                else { if (tot > 256u) { if (side_ == 1) ghi_ *= 0.5f; lo_ = cand; glo_ = gc; side_ = 1; }
                       else { if (side_ == 2) glo_ *= 0.5f; hi_ = cand; ghi_ = gc; chi_ = tot; side_ = 2; }
                       if (hi_ - lo_ == 1u) { xgt_ = hi_; xeq_ = lo_; mt_ = 256u - chi_; done_ = true; } }
            }
            { LAS unsigned* hist = (LAS unsigned*)(lds + IDX_CTL_OFF + 1024) + q * 256;
#pragma unroll 1
              for (int round = 0; round < 6 && !done_; ++round) {
                const unsigned wdt = hi_ - lo_;
                const int sh = wdt <= 256u ? 0 : 24 - (int)__builtin_clz(wdt - 1u);
                hist[128 * h + lane] = 0u; hist[128 * h + 64 + lane] = 0u;
                LDS_WAIT(); { unsigned d_; IDX_XCHG16(0u, d_); (void)d_; }
                const unsigned lov = lo_;
                IDX_FOR_LIVE( const unsigned d = r[il] - lov; if (d < wdt) __hip_atomic_fetch_add(hist + (d >> sh), 1u, __ATOMIC_RELAXED, __HIP_MEMORY_SCOPE_WORKGROUP); )
                LDS_WAIT(); { unsigned d_; IDX_XCHG16(0u, d_); (void)d_; }
                const u32x4 hb = *(const LAS u32x4*)(hist + 4 * lane);
                const unsigned s4 = (hb.x + hb.y) + (hb.z + hb.w);
                unsigned suf = s4;
#pragma unroll
                for (int o = 1; o < 64; o <<= 1) { const unsigned tv = (unsigned)__shfl_down((int)suf, o); if (lane + o < 64) suf += tv; }
                const unsigned long long okm = __ballot(chi_ + suf >= 256u);
                const int L = 63 - (int)__builtin_clzll(okm);
                const unsigned above = chi_ + (unsigned)__builtin_amdgcn_readlane((int)(suf - s4), L);
                const unsigned h0 = (unsigned)__builtin_amdgcn_readlane((int)hb.x, L), h1 = (unsigned)__builtin_amdgcn_readlane((int)hb.y, L),
                               h2 = (unsigned)__builtin_amdgcn_readlane((int)hb.z, L), h3 = (unsigned)__builtin_amdgcn_readlane((int)hb.w, L);
                unsigned Bsel, cab, cnb;
                if (above + h3 >= 256u) { Bsel = 3u; cab = above; cnb = h3; }
                else if (above + h3 + h2 >= 256u) { Bsel = 2u; cab = above + h3; cnb = h2; }
                else if (above + h3 + h2 + h1 >= 256u) { Bsel = 1u; cab = above + h3 + h2; cnb = h1; }
                else { Bsel = 0u; cab = above + h3 + h2 + h1; cnb = h0; }
                Bsel += 4u * (unsigned)L;
                const unsigned nlo = lo_ + (Bsel << sh); unsigned nhi = nlo + (1u << sh); if (nhi > hi_ || nhi < nlo) nhi = hi_;
                if (cab + cnb == 256u) { xgt_ = nlo; mt_ = 0u; done_ = true; }
                else if (sh == 0) { xgt_ = nlo + 1u; xeq_ = nlo; mt_ = 256u - cab; done_ = true; }
                else { lo_ = nlo; hi_ = nhi; chi_ = cab; }
              } }
#ifdef IDX_XTRA
#pragma unroll 1
            for (int xr = 0; xr < IDX_XTRA; ++xr) { unsigned dsum = 0; const unsigned cv = xgt_ + (unsigned)xr;
                IDX_FOR_LIVE( dsum += r[il] >= cv; )
                int pk = (int)dsum;
                pk += __builtin_amdgcn_update_dpp(0, pk, 0x111, 0xf, 0xf, false); pk += __builtin_amdgcn_update_dpp(0, pk, 0x112, 0xf, 0xf, false); pk += __builtin_amdgcn_update_dpp(0, pk, 0x114, 0xf, 0xf, false);
                pk += __builtin_amdgcn_update_dpp(0, pk, 0x118, 0xf, 0xf, false); pk += __builtin_amdgcn_update_dpp(0, pk, 0x142, 0xa, 0xf, false);
                unsigned tot = (unsigned)__builtin_amdgcn_readlane(pk, 31) + (unsigned)__builtin_amdgcn_readlane(pk, 63);
                { unsigned pt_; IDX_XCHG16(tot, pt_); tot += pt_; } asm volatile("" :: "s"(tot)); }
#endif
            T_ = xgt_;
            if (mt_ != 0u) {
                if (h == 0) { unsigned run = 0u;
#pragma unroll 1
                    for (int i = 0; i <= (jmax >> 1); ++i) { const bool ok_ = 2 * i + hh <= jmax; const unsigned kv = ok_ ? row[64 * i] : 0u; const bool eq = kv == xeq_; const unsigned long long bm = __ballot(eq);
                        const unsigned rank = run + __builtin_amdgcn_mbcnt_hi((unsigned)(bm >> 32), __builtin_amdgcn_mbcnt_lo((unsigned)bm, 0u));
                        if (eq && rank >= mt_) row[64 * i] = 0u;
                        run += (unsigned)__popcll(bm); } }
                T_ = xeq_;
            }
            }
#undef IDX_XCHG
#undef IDX_XCHG16
#undef IDX_FOR_LIVE
        }
        if (lane == 0 && h == 0) thr[q] = T_;
    }
#ifdef PROBE_VALU
    { float a0 = (float)lane, a1 = a0 + 1.f, a2 = a0 + 2.f, a3 = a0 + 3.f, a4 = a0 + 4.f, a5 = a0 + 5.f, a6 = a0 + 6.f, a7 = a0 + 7.f; const float m = 1.0000001f, c = 1e-9f;
#pragma unroll 1
      for (int it = 0; it < 64; ++it) {
#pragma unroll
          for (int u = 0; u < 8; ++u) { a0 = a0 * m + c; a1 = a1 * m + c; a2 = a2 * m + c; a3 = a3 * m + c; a4 = a4 * m + c; a5 = a5 * m + c; a6 = a6 * m + c; a7 = a7 * m + c; } }
      asm volatile("" :: "v"(a0), "v"(a1), "v"(a2), "v"(a3), "v"(a4), "v"(a5), "v"(a6), "v"(a7)); }
#endif
    LDS_WAIT(); __builtin_amdgcn_s_barrier(); asm volatile("" ::: "memory");
    { const unsigned tq0 = thr[hh], tq1 = thr[2 + hh];
#pragma unroll 4
      for (int j = wid; j <= ((t0 | 63) >> 5); j += 8) {
          bool s0 = false, s1 = false;
          if (j <= jmax) { s0 = SCO[hh * 8192 + 32 * j + r32] >= tq0; s1 = SCO[(2 + hh) * 8192 + 32 * j + r32] >= tq1; }
          const unsigned long long b0_ = __ballot(s0), b1_ = __ballot(s1);
          if (lane == 0) { u32x4 o; o.x = (unsigned)b0_; o.y = (unsigned)(b0_ >> 32); o.z = (unsigned)b1_; o.w = (unsigned)(b1_ >> 32); *(u32x4*)(BM + ((size_t)b * 256 + j) * S + t0) = o; }
      } }
    LDS_WAIT(); __builtin_amdgcn_s_barrier();
}
DEV void idx_phase(LAS unsigned char* lds, unsigned char* ws, int vcu, int G, int wid, int lane) {
    constexpr int NUNIT = T / 4;
    const bf16_t* IQ = (const bf16_t*)(ws + WS_IQ); const bf16_t* IK = (const bf16_t*)(ws + WS_IK); const float* IW = (const float*)(ws + WS_IW);
#define IDX_UNIT_OF(k) ((k) * G + (((k) & 1) ? G - 1 - vcu : vcu))
    bf16x8 afr[4], b0[4], b1[4]; float w[16];
    int un = IDX_UNIT_OF(0);
    if (un < NUNIT) { const int b = un / (S / 4); idx_prefetch(afr, w, b0, b1, IQ, IK, IW, b, (un - b * (S / 4)) * 4, wid, lane); }
#pragma unroll 1
    for (int k = 0; un < NUNIT; ++k) {
        const int b = un / (S / 4), t0 = (un - b * (S / 4)) * 4;
        const int nun = IDX_UNIT_OF(k + 1); const int nb = nun / (S / 4), nt0 = nun < NUNIT ? (nun - nb * (S / 4)) * 4 : -1;
        idx_unit(lds, IQ, IK, IW, (unsigned*)(ws + WS_BM), b, t0, nb, nt0, wid, lane, afr, w, b0, b1);
        un = nun;
    }
#undef IDX_UNIT_OF
}

constexpr int DSA_STAGE = 8192 + 64 * VPITCH;
DEV void dsa_unit(LAS unsigned char* lds, const bf16_t* Q, const bf16_t* Kk, const bf16_t* V, const unsigned* BM, bf16_t* O, int b, int h, int qblk, int tid, int wid, int lane) {
    const int r32 = lane & 31, hi = lane >> 5, q0 = 256 * qblk, t0 = q0 + 32 * wid, t = t0 + r32; const size_t rowb = (size_t)b * S;
    bf16x8 qr[4]; { const bf16_t* qp = Q + (rowb + t) * 512 + h * 64 + 8 * hi;
#pragma unroll
        for (int d0 = 0; d0 < 4; ++d0) qr[d0] = *(const bf16x8*)(qp + 16 * d0); }
    f32x16 o0, o1, negm;
#pragma unroll
    for (int r = 0; r < 16; ++r) { o0[r] = 0.f; o1[r] = 0.f; negm[r] = 0.f; }
    float mref = 0.f, lsum = 0.f; bool seen = false;
    constexpr float THR = 8.f;
    const int ntile = (q0 + 256) / 64, wlast = (t0 + 31) >> 6;
    const int srow = tid >> 3, sch = tid & 7;
    const bf16_t* kg = Kk + (rowb + srow) * 512 + h * 64 + sch * 8; const bf16_t* vg = V + (rowb + srow) * 512 + h * 64 + sch * 8;
    const int kdst = srow * 128 + ((sch ^ (srow & 7)) * 16), vdst = srow * VPITCH + sch * 16;
    u32x4 kr0 = *(const u32x4*)kg, vr0 = *(const u32x4*)vg;
    *(LAS u32x4*)(lds + kdst) = kr0; *(LAS u32x4*)(lds + 8192 + vdst) = vr0;
    u32x4 kr1 = *(const u32x4*)(kg + (size_t)64 * 512), vr1 = *(const u32x4*)(vg + (size_t)64 * 512);
    const unsigned* bmp = BM + (size_t)b * 256 * S + t;
    unsigned mw0 = bmp[0], mw1 = bmp[(size_t)S];
    const int koff = r32 * 128;
    __syncthreads();
#define DSA_TILE(c, BUF, NBUF, KL, VL, KW, VW) do { \
        const LAS unsigned char* kt = lds + (BUF) * DSA_STAGE; const LAS unsigned char* vt = kt + 8192; \
        if ((c) + 2 < ntile) { KL = *(const u32x4*)(kg + (size_t)((c) + 2) * 64 * 512); VL = *(const u32x4*)(vg + (size_t)((c) + 2) * 64 * 512); } \
        unsigned nw0 = 0u, nw1 = 0u; \
        if ((c) + 1 <= wlast) { nw0 = bmp[(size_t)(2 * (c) + 2) * S]; nw1 = bmp[(size_t)(2 * (c) + 3) * S]; } \
        if ((c) <= wlast) { \
            bf16x8 kf[8]; \
            _Pragma("unroll") for (int d0 = 0; d0 < 4; ++d0) { const int xo = ((2 * d0 + hi) ^ (r32 & 7)) * 16; \
                kf[2 * d0] = *(const LAS bf16x8*)(kt + koff + xo); kf[2 * d0 + 1] = *(const LAS bf16x8*)(kt + koff + 4096 + xo); } \
            asm volatile("" : "+v"(kf[0]), "+v"(kf[1]), "+v"(kf[2]), "+v"(kf[3]), "+v"(kf[4]), "+v"(kf[5]), "+v"(kf[6]), "+v"(kf[7]));     \
            f32x16 p0 = negm, p1 = negm; \
            _Pragma("unroll") for (int d0 = 0; d0 < 4; ++d0) { p0 = __builtin_amdgcn_mfma_f32_32x32x16_bf16(kf[2 * d0], qr[d0], p0, 0, 0, 0); p1 = __builtin_amdgcn_mfma_f32_32x32x16_bf16(kf[2 * d0 + 1], qr[d0], p1, 0, 0, 0); } \
            const unsigned m0 = mw0 >> (4 * hi), m1 = mw1 >> (4 * hi); \
            _Pragma("unroll") for (int r = 0; r < 16; ++r) { const int bit = (r & 3) + 8 * (r >> 2); \
                const unsigned e0 = (unsigned)__builtin_amdgcn_sbfe((int)m0, bit, 1), e1 = (unsigned)__builtin_amdgcn_sbfe((int)m1, bit, 1); \
                p0[r] = __uint_as_float((__float_as_uint(p0[r]) & e0) | (0xff800000u & ~e0)); p1[r] = __uint_as_float((__float_as_uint(p1[r]) & e1) | (0xff800000u & ~e1)); } \
            float rm = -INFINITY; \
            _Pragma("unroll") for (int r = 0; r < 16; r += 2) rm = fmaxf(rm, fmaxf(fmaxf(p0[r], p0[r + 1]), fmaxf(p1[r], p1[r + 1]))); \
            { const auto rr = __builtin_amdgcn_permlane32_swap(__float_as_uint(rm), __float_as_uint(rm), false, false); rm = fmaxf(__uint_as_float(rr[0]), __uint_as_float(rr[1])); } \
            const bool shift = rm > THR || (rm < -THR && rm > -INFINITY && !seen);     \
            seen = seen || rm > -INFINITY; \
            if (__any(shift)) { \
                const float dl = shift ? rm : 0.f, f = dl > 0.f ? __builtin_amdgcn_exp2f(-dl) : 1.f; \
                mref += dl; lsum *= f; \
                _Pragma("unroll") for (int r = 0; r < 16; ++r) { p0[r] -= dl; p1[r] -= dl; o0[r] *= f; o1[r] *= f; negm[r] = -mref; } \
            } \
            float ps = 0.f; \
            _Pragma("unroll") for (int r = 0; r < 16; ++r) { p0[r] = __builtin_amdgcn_exp2f(p0[r]); p1[r] = __builtin_amdgcn_exp2f(p1[r]); ps += p0[r] + p1[r]; } \
            lsum += ps; \
            bf16x8 pk[4]; \
            pk[0] = pk8(p0[0], p0[1], p0[2], p0[3], p0[4], p0[5], p0[6], p0[7]); pk[1] = pk8(p0[8], p0[9], p0[10], p0[11], p0[12], p0[13], p0[14], p0[15]); \
            pk[2] = pk8(p1[0], p1[1], p1[2], p1[3], p1[4], p1[5], p1[6], p1[7]); pk[3] = pk8(p1[8], p1[9], p1[10], p1[11], p1[12], p1[13], p1[14], p1[15]); \
            pv_tile(o0, o1, vt, lane, pk); \
        } \
        mw0 = nw0; mw1 = nw1; \
        if ((c) + 1 < ntile) { LAS unsigned char* nb = lds + (NBUF) * DSA_STAGE; *(LAS u32x4*)(nb + kdst) = KW; *(LAS u32x4*)(nb + 8192 + vdst) = VW; } \
        asm volatile("s_waitcnt lgkmcnt(0)" ::: "memory"); __builtin_amdgcn_s_barrier(); asm volatile("" ::: "memory"); } while (0)
#pragma unroll 1
    for (int c = 0; c < ntile; c += 2) { DSA_TILE(c, 0, 1, kr0, vr0, kr1, vr1); DSA_TILE(c + 1, 1, 0, kr1, vr1, kr0, vr0); }
#undef DSA_TILE
    { const auto rr = __builtin_amdgcn_permlane32_swap(__float_as_uint(lsum), __float_as_uint(lsum), false, false); lsum = __uint_as_float(rr[0]) + __uint_as_float(rr[1]); }
    store_ot(O + (rowb + t) * 512 + h * 64, o0, o1, hi, 1.f / lsum);
}
DEV void dsa_phase(LAS unsigned char* lds, unsigned char* ws, int vcu, int G, int tid, int wid, int lane, bf16_t* Oout) {
    constexpr int NPAIR = NB * 8 * 16;
    for (int pr = vcu; pr < NPAIR; pr += G) {
        const int bh = pr >> 4, s = pr & 15, b = bh >> 3, h = bh & 7;
#pragma unroll 1
        for (int k = 0; k < 2; ++k) {
            const int qblk = k == 0 ? s : 31 - s;
            dsa_unit(lds, (const bf16_t*)(ws + WS_QC), (const bf16_t*)(ws + WS_KC), (const bf16_t*)(ws + WS_VC), (const unsigned*)(ws + WS_BM), Oout, b, h, qblk, tid, wid, lane);
        }
    }
}
constexpr int MK_THREADS = 512;
constexpr int RING_BYTES = 131072, MISC_OFF = RING_BYTES + 320, MK_LDS_BYTES = 147456;
constexpr size_t WS_CTL = 0, CTL_ZERO_BYTES = 65536 + 7 * 131072; constexpr int CW_BAR = 4096;
constexpr int PH_PREP0 = 0, PH_KV = 1, PH_GH = 2, PH_L0 = 3, PH_PER_LAYER = 14, NPH = PH_L0 + 2 * PH_PER_LAYER;
enum { Q_INPROJ = 0, Q_SBIDX, Q_DSA, Q_GATES, Q_MERGE, Q_MIX, Q_NORMXA, Q_XALOG, Q_XAOUT, Q_NORMFFN, Q_UP, Q_FFNMID, Q_DOWN, Q_NEXT };

#ifndef QBUILD
#define QBUILD 0xffffu
#endif
#define QON(x) ((QBUILD >> (x)) & 1u)
struct Args { const float* in[20]; float* out; unsigned char* ws; int ph_lo, ph_hi; };

__global__ void __launch_bounds__(MK_THREADS, 2) mk_fwd(Args args) {
    __shared__ __attribute__((aligned(16))) unsigned char lds_raw[MK_LDS_BYTES];
    LAS unsigned char* lds = (LAS unsigned char*)lds_raw;
    volatile LAS unsigned* MISC = (volatile LAS unsigned*)(lds + MISC_OFF);
    const int G = gridDim.x, bx = blockIdx.x;
    unsigned char* ws0 = args.ws;
    const int wave_s = __builtin_amdgcn_readfirstlane((int)threadIdx.x >> 6);
    for (int u = mk_tid(wave_s); u < (MK_LDS_BYTES - RING_BYTES) / 4; u += MK_THREADS) ((LAS unsigned*)(lds + RING_BYTES))[u] = 0u;
    __syncthreads();
    const int lo = args.ph_lo, hi = args.ph_hi;
    XcdBarrier bar; bar.bar = (unsigned*)(ws0 + WS_CTL) + CW_BAR; bar.x = 0; bar.st = nullptr;
    if (hi - lo > 1) bar = xcd_barrier_post((unsigned*)(ws0 + WS_CTL) + CW_BAR, MISC + 8, mk_tid(wave_s));
#define BPW(off) ((bf16_t*)(ws + (off)))
    const int vcu = (G % 8 == 0) ? (bx % 8) * (G / 8) + bx / 8 : bx;
    for (int p = lo; p < hi; ++p) {
#ifdef PROBE_REP
        const int reps = (p >= PH_L0 && ((PROBE_REP >> ((p - PH_L0) % PH_PER_LAYER)) & 1)) ? 2 : 1;
#else
        const int reps = 1;
#endif
#ifdef PROBE_REP
#pragma unroll 1
        for (int rep = 0; rep < reps; ++rep) {
        const bool dry = rep + 1 < reps;
#else
        { constexpr bool dry = false;
#endif
        int oz = 0; asm volatile("" : "+s"(oz));
        int tid = mk_tid(wave_s); asm volatile("" : "+v"(tid));
        const int wave = __builtin_amdgcn_readfirstlane(tid >> 6), lane = tid & 63;
        WaveId W; W.gw = vcu * 8 + wave; W.ngw = G * 8; W.wave = wave; W.lane = lane;
        unsigned char* ws = args.ws + oz; float* X = args.out + oz;
#define INP(k) (args.in[(k) + oz])
        if (p == PH_PREP0) {
            prep0_phase(W, (LAS float*)(lds + wave * 16384), ws, args.in + oz, (bf16_t*)X);
        } else if (p == PH_KV && QON(14)) {
            pg8::Order S; S.init(2, 8, 2, G, bx);
            pg8::PtrStd P{(const char*)(ws + WS_MEMN), (const char*)(ws + WS_WKVT), 1 * MiB, 4 * MiB, 0, (size_t)256 * D * 2, (size_t)256 * D * 2};
            pg8::EpiPrep E{ws, 0};
            pg8::gemm_phase<pg8::EpiPrep, pg8::PtrStd, true, true>(lds, tid, D, D, D, S, P, E);
        } else if (p == PH_GH && QON(15)) {
            { pg8::Order S; S.init(1, 4, 16, G, bx); pg8::PtrG P{(const char*)(ws + WS_KVM), (const char*)(ws + WS_WQ)}; pg8::EpiPrep E{ws, 1};
              pg8::gemm_phase<pg8::EpiPrep, pg8::PtrG, true, true>(lds, tid, 2 * D, D, 256, S, P, E); }
            { pg8::Order S; S.init(4, 1, 16, G, (bx + 64) % G); pg8::PtrH P{(const char*)(ws + WS_KVM), (const char*)(ws + WS_WOT)}; pg8::EpiPrep E{ws, 2};
              pg8::gemm_phase<pg8::EpiPrep, pg8::PtrH, true, true>(lds, tid, D, 2 * D, 256, S, P, E); }
        } else if (p >= PH_L0) {
            const int l = (p - PH_L0) / PH_PER_LAYER, q = (p - PH_L0) % PH_PER_LAYER;
            const float* Xin = l == 0 ? INP(0) : X;
            pg8::u64* SSb = (pg8::u64*)(ws + WS_SS);
#define SSA(i) (SSb + (size_t)(i) * T)
            if (q == Q_SBIDX) {
#ifndef NO_SB
                sb_phase(W, lds, ws, dry);
#endif
                __syncthreads();
#ifndef NO_IDX
#ifdef PROBE_SB_ONLY
                if (!dry)
#endif
                idx_phase(lds, ws, vcu, G, wave, lane);
#endif
                conv_sc_phase(vcu * MK_THREADS + tid, G * MK_THREADS, BPW(WS_SCB), BPW(WS_CX), INP(4) + l * 3 * 512, dry);
            } else if (q == Q_DSA) {
#ifndef NO_DSA
                dsa_phase(lds, ws, vcu, G, tid, wave, lane, dry ? BPW(WS_KA) : BPW(WS_QC));
#endif
            } else if (q == Q_FFNMID) {
                ffn_mid_phase(vcu * MK_THREADS + tid, G * MK_THREADS, BPW(WS_FA), BPW(WS_FU), INP(16) + l * 3 * DFF, INP(17) + l * DFF, dry);
            } else if (q == Q_NEXT) {
                if (l + 1 < DEPTH) { int base = 0; convert_layer_weights(W, (LAS float*)(lds + wave * 16384), base, ws, args.in + oz, l + 1); }
                else if (!dry) final_norm(W, BPW(WS_XN), X, INP(19), SSA(6));
            } else if (q == Q_INPROJ && QON(Q_INPROJ)) {
                pg8::Order S; S.init(T / 256, NIN / 256, 1, G, bx);
                pg8::PtrStd P{(const char*)X, (const char*)(ws + WS_WIN), 0, 0, 0, (size_t)256 * D * 2, (size_t)256 * D * 2};
                pg8::EpiInProj E{ws, SSA(3 * l)};
                pg8::gemm_phase<pg8::EpiInProj, pg8::PtrStd, true, true>(lds, tid, D, D, D, S, P, E);
            } else if (q == Q_GATES && QON(Q_GATES)) {
                pg8::Order S; S.init(T / 256, 12, 1, G, bx);
                pg8::PtrStd P{(const char*)X, (const char*)(ws + WS_WG), 0, 0, 0, (size_t)256 * D * 2, (size_t)256 * D * 2};
                pg8::EpiGates E{BPW(WS_GATES), SSA(3 * l)};
                pg8::gemm_phase<pg8::EpiGates, pg8::PtrStd, true, true>(lds, tid, D, D, D, S, P, E);
            } else if (q == Q_MERGE && QON(Q_MERGE)) {
                pg8::Order S; S.init(T / 256, 4, 3, G, bx);
                pg8::PtrStd P{(const char*)(ws + WS_QA), (const char*)(ws + WS_WBR), 16 * MiB, (size_t)D * 512 * 2, 0, (size_t)256 * 512 * 2, (size_t)256 * 512 * 2};
                pg8::EpiMerge E{BPW(WS_XN), BPW(WS_GATES)};
                pg8::gemm_phase<pg8::EpiMerge, pg8::PtrStd, true, true>(lds, tid, 512, 512, 512, S, P, E);
            } else if (q == Q_MIX && QON(Q_MIX)) {
                pg8::Order S; S.init(T / 256, 4, 1, G, bx);
                pg8::PtrStd P{(const char*)(ws + WS_XN), (const char*)(ws + WS_WMIX), 0, 0, 0, (size_t)256 * D * 2, (size_t)256 * D * 2};
                if (l == 0) { pg8::EpiResid<true> E{(const void*)INP(0), dry ? BPW(WS_FU) : BPW(WS_XBXA), dry ? SSA(0) : SSA(1)};
                    pg8::gemm_phase<pg8::EpiResid<true>, pg8::PtrStd, true, true>(lds, tid, D, D, D, S, P, E); }
                else { pg8::EpiResid<false> E{(const void*)X, dry ? BPW(WS_FU) : BPW(WS_XBXA), dry ? SSA(0) : SSA(4)};
                    pg8::gemm_phase<pg8::EpiResid<false>, pg8::PtrStd, true, true>(lds, tid, D, D, D, S, P, E); }

            } else if (q == Q_XALOG && QON(Q_XALOG)) {
                pg8::Order S; S.init(T / 256, 4, 1, G, bx);
                pg8::PtrStd P{(const char*)(ws + WS_XBXA), (const char*)(ws + WS_GT + (size_t)l * 4 * MiB), 0, 0, 2 * MiB, (size_t)256 * D * 2, (size_t)256 * D * 2};
                pg8::EpiSoftmax E{BPW(WS_PXA), SSA(1 + 3 * l)};
                pg8::gemm_phase<pg8::EpiSoftmax, pg8::PtrStd, false, true>(lds, tid, D, D, D, S, P, E);
            } else if (q == Q_XAOUT && QON(Q_XAOUT)) {
                pg8::Order S; S.init(T / 256, 4, 1, G, bx);
                pg8::PtrStd P{(const char*)(ws + WS_PXA), (const char*)(ws + WS_HT + (size_t)l * 4 * MiB), 0, 0, 2 * MiB, (size_t)256 * D * 2, (size_t)256 * D * 2};
                pg8::EpiResid<false> E{(const void*)BPW(WS_XBXA), dry ? BPW(WS_FU) : BPW(WS_XN), dry ? SSA(0) : SSA(2 + 3 * l)};
                pg8::gemm_phase<pg8::EpiResid<false>, pg8::PtrStd, true, true>(lds, tid, D, D, D, S, P, E);
            } else if (q == Q_UP && QON(Q_UP)) {
                pg8::Order S; S.init(T / 256, 22, 1, G, bx);
                pg8::PtrStd P{(const char*)(ws + WS_XN), (const char*)(ws + WS_WUP), 0, 0, 0, (size_t)256 * D * 2, (size_t)256 * D * 2};
                pg8::EpiUp E{BPW(WS_FA), BPW(WS_FU), SSA(2 + 3 * l)};
                pg8::gemm_phase<pg8::EpiUp, pg8::PtrStd, true, true>(lds, tid, D, D, D, S, P, E);
            } else if (q == Q_DOWN && QON(Q_DOWN)) {
                pg8::Order S; S.init(T / 256, 4, 1, G, bx);
                pg8::PtrStd P{(const char*)(ws + WS_FU), (const char*)(ws + WS_WDOWN), 0, 0, 0, (size_t)256 * DFF * 2, (size_t)256 * DFF * 2};
                pg8::EpiResid<false> E{(const void*)BPW(WS_XN), dry ? BPW(WS_QA) : (l + 1 < DEPTH ? (bf16_t*)X : BPW(WS_XN)), dry ? SSA(0) : SSA(3 + 3 * l)};
                pg8::gemm_phase<pg8::EpiResid<false>, pg8::PtrStd, true, true>(lds, tid, DFF, DFF, DFF, S, P, E);
            }
        }
        }
        if (p + 1 < hi && !(p >= PH_L0 && ((p - PH_L0) % PH_PER_LAYER == Q_NORMXA || (p - PH_L0) % PH_PER_LAYER == Q_NORMFFN))) xcd_barrier(bar, mk_tid(wave_s));
    }
}

extern "C" void kernel_launch(void* const* d_in, const int* in_sizes, int n_in, void* d_out, int out_size, void* d_ws, size_t ws_size, hipStream_t st) {
    if (n_in != 20 || ws_size < WS_NEED || out_size != T * D) { fprintf(stderr, "kernel_launch: unexpected sizes n_in %d ws %zu out %d\n", n_in, ws_size, out_size); return; }
    static int grid = 0;
    if (grid == 0) {
        int dev = 0, cus = 0, per_cu = 0;
        (void)hipGetDevice(&dev); (void)hipDeviceGetAttribute(&cus, hipDeviceAttributeMultiprocessorCount, dev);
        if (hipOccupancyMaxActiveBlocksPerMultiprocessor(&per_cu, (const void*)mk_fwd, MK_THREADS, 0) != hipSuccess || per_cu < 1) { fprintf(stderr, "kernel_launch: occupancy query says %d blocks/CU\n", per_cu); grid = -1; return; }
        (void)hipGetLastError();
        if (cus != 256) { fprintf(stderr, "kernel_launch: built for a 256-CU device, found %d\n", cus); grid = -1; return; }
        grid = cus;
    }
    if (grid < 0) return;
    (void)hipMemsetAsync((char*)d_ws + WS_CTL, 0, CTL_ZERO_BYTES, st);
    Args a{};
    for (int i = 0; i < 20; ++i) a.in[i] = (const float*)d_in[i];
    a.out = (float*)d_out; a.ws = (unsigned char*)d_ws; a.ph_lo = 0; a.ph_hi = NPH;
    hipLaunchKernelGGL(mk_fwd, dim3(grid), dim3(MK_THREADS), 0, st, a);
}
```

```cpp
#include <hip/hip_runtime.h>
#include <stdint.h>
#include <stdio.h>

typedef unsigned short bf16_t;
typedef short bf16x8 __attribute__((ext_vector_type(8)));
typedef float f32x16 __attribute__((ext_vector_type(16)));
typedef float f32x4 __attribute__((ext_vector_type(4)));
#define DEV __device__ __forceinline__

constexpr int NB = 2, S = 8192, D = 1024, T = NB * S, DEPTH = 2;
constexpr int DIN = 8264, DFF = 2816, MEM = 256;
constexpr int NIN = 5376;
constexpr float LOG2E = 1.4426950408889634f;
constexpr float QSCALE = 0.125f * LOG2E;
constexpr float WSCALE = 0.125f * 0.35355339059327373f;
constexpr float XSCALE = 0.0625f * LOG2E;
constexpr float EPS = 1e-6f;
#ifndef MK_FUSE
#define MK_FUSE 1
#endif

constexpr size_t MiB = 1u << 20;
constexpr size_t WS_KN = 983040;
constexpr size_t WS_GT = 1 * MiB;
constexpr size_t WS_HT = 9 * MiB;
constexpr size_t WS_WUP = 17 * MiB, WS_WDOWN = 28 * MiB;
constexpr size_t WS_XN = 34 * MiB;
constexpr size_t WS_WMIX = 66 * MiB, WS_WBR = 68 * MiB, WS_WG = 71 * MiB, WS_WIN = 77 * MiB;
constexpr size_t WS_QA = 88 * MiB, WS_SCB = 104 * MiB, WS_QC = 120 * MiB, WS_KA = 136 * MiB, WS_VA = 152 * MiB, WS_KC = 168 * MiB, WS_VC = 184 * MiB,
                 WS_IQ = 200 * MiB, WS_CX = 216 * MiB, WS_IK = 232 * MiB, WS_IW = 234 * MiB, WS_BM = 235 * MiB;
constexpr size_t WS_GATES = 136 * MiB;
constexpr size_t WS_XTMP = 235 * MiB;
constexpr size_t WS_LOG = 88 * MiB, WS_PXA = 168 * MiB;
constexpr size_t WS_XBXA = 136 * MiB;
constexpr size_t WS_SS = 65536;
constexpr size_t WS_FA = 66 * MiB, WS_FU = 154 * MiB;
constexpr size_t WS_WQ = 200 * MiB  , WS_WOT = 204 * MiB  , WS_WKVT = 208 * MiB  , WS_MEMN = 216 * MiB  , WS_KVM = 218 * MiB  ;
constexpr size_t WS_NEED = 256 * MiB;

DEV bf16_t f2bf(float f) { unsigned u = __float_as_uint(f); u += 0x7fffu + ((u >> 16) & 1u); return (bf16_t)(u >> 16); }
DEV float bf2f(bf16_t h) { return __uint_as_float(((unsigned)h) << 16); }
DEV float wave_sum(float v) {
#pragma unroll
    for (int o = 1; o < 64; o <<= 1) v += __shfl_xor(v, o);
    return v;
}
DEV float wave_max(float v) {
#pragma unroll
    for (int o = 1; o < 64; o <<= 1) v = fmaxf(v, __shfl_xor(v, o));
    return v;
}


#define LAS __attribute__((address_space(3)))
#define GAS __attribute__((address_space(1)))
typedef unsigned u32x4 __attribute__((ext_vector_type(4)));
typedef unsigned u32x2 __attribute__((ext_vector_type(2)));
typedef float f32x2 __attribute__((ext_vector_type(2)));
#define LDS_WAIT() asm volatile("s_waitcnt lgkmcnt(0)" ::: "memory")
DEV int mk_tid(int wave_s) { unsigned ones = ~0u; asm volatile("" : "+s"(ones)); return wave_s * 64 + (int)__builtin_amdgcn_mbcnt_hi(ones, __builtin_amdgcn_mbcnt_lo(ones, 0u)); }
#define VM_WAIT() asm volatile("s_waitcnt vmcnt(0)" ::: "memory")
typedef __bf16 bf16x2_t __attribute__((ext_vector_type(2)));
DEV unsigned cvt_pk_bf16(float lo, float hi) { const f32x2 v = {lo, hi}; return __builtin_bit_cast(unsigned, __builtin_convertvector(v, bf16x2_t)); }
DEV float bflo(unsigned w) { return __uint_as_float(w << 16); }
DEV float bfhi(unsigned w) { return __uint_as_float(w & 0xffff0000u); }

namespace pg8 {
constexpr int BM = 256, BK = 64, HALF = 128, HTB = HALF * BK * 2, STAGE_BYTES = 8 * HTB, NXCD = 8, WGM = 8;
__host__ __device__ __forceinline__ int lds_byte(int r, int c) { const int st = (r >> 4) * 2 + (c >> 5), rr = r & 15, cc = c & 31, ob = rr * 64 + cc * 2; return st * 1024 + (ob ^ (((ob >> 9) & 1) << 5)); }
__host__ __device__ __forceinline__ void stage_rc(int b, int& R, int& C) { const int st = b / 1024, sb = b % 1024, swz = sb ^ (((sb >> 9) & 1) << 5); R = (st >> 1) * 16 + swz / 64; C = (st & 1) * 32 + (swz % 64) / 2; }
__host__ __device__ __forceinline__ int perm32(int rho) { const int n = rho >> 4, i = rho & 15; return 8 * (i >> 2) + 4 * n + (i & 3); }

struct Unit { int pm, pn, job; };
struct Order {
    int nM, nN, nwg, ntot, G, c;
    DEV void init(int nM_, int nN_, int njob, int G_, int c_) { nM = nM_; nN = nN_; nwg = nM * nN; ntot = nwg * njob; G = G_; c = c_; }
    DEV bool next(int i, Unit& u) const {
        const int L = i * G + c; if (L >= ntot) return false;
        u.job = L / nwg; int wgid = L - u.job * nwg;
        { const int q = nwg / NXCD, r = nwg % NXCD, xcd = wgid % NXCD, off = wgid / NXCD; wgid = (xcd < r ? xcd * (q + 1) : r * (q + 1) + (xcd - r) * q) + off; }
        const int nig = WGM * nN, gid = wgid / nig, fm = gid * WGM, gsz = (nM - fm) < WGM ? (nM - fm) : WGM;
        u.pm = fm + ((wgid % nig) % gsz); u.pn = (wgid % nig) / gsz; return true;
    }
};
template <class Epi, class Ptr, bool ALIGN_EPI, bool SP2>
DEV void gemm_phase(LAS unsigned char* lds, const int tid_in, const int lda, const int ldb, const int K, const Order& S, const Ptr& P, const Epi& E) {
    int tid_ = tid_in; asm volatile("" : "+v"(tid_));
    const int tid = tid_, wid = __builtin_amdgcn_readfirstlane(tid >> 6), lane = tid & 63, wr = wid >> 2, wc = wid & 3, fr = lane & 15, fq = lane >> 4;
    const int nt = K / BK;
    unsigned voffA[2], voffB[2];
#pragma unroll
    for (int i = 0; i < 2; ++i) { int R, C; stage_rc(tid * 16 + i * 8192, R, C); const int Rb = Epi::PERM ? ((R & ~31) + perm32(R & 31)) : R;
        voffA[i] = (unsigned)(R * lda + C) * 2u; voffB[i] = (unsigned)(Rb * ldb + C) * 2u; }
    const size_t kstep = (size_t)(BK * 2);
    const size_t hstepA = (size_t)HALF * lda * 2, hstepB = (size_t)HALF * ldb * 2;
    const unsigned ldsw = (unsigned)wid * 1024u;
    const int aoff = lds_byte(wr * 64 + fr, fq * 8), boff = lds_byte(wc * 32 + fr, fq * 8);
#define PG8_SA(b, h) (((b) * 2 + (h)) * HTB)
#define PG8_SB(b, h) ((4 + (b) * 2 + (h)) * HTB)
#define PG8_STAGE(bufoff, gbase, voff) do { _Pragma("unroll") for (int _i = 0; _i < 2; ++_i) \
        __builtin_amdgcn_global_load_lds((const unsigned*)((const char*)(gbase) + (voff)[_i]), (LAS unsigned*)(lds + (bufoff) + ldsw + _i * 8192), 16, 0, 0); } while (0)
#define PG8_LDA(dst, b, h) do { _Pragma("unroll") for (int m = 0; m < 4; ++m) _Pragma("unroll") for (int k = 0; k < 2; ++k) dst[m][k] = *(const LAS bf16x8*)(lds + PG8_SA(b, h) + aoff + m * 2048 + k * 1024); } while (0)
#define PG8_LDB(dst, b, h) do { _Pragma("unroll") for (int n = 0; n < 2; ++n) _Pragma("unroll") for (int k = 0; k < 2; ++k) dst[n][k] = *(const LAS bf16x8*)(lds + PG8_SB(b, h) + boff + n * 2048 + k * 1024); } while (0)
#define PG8_MMA(ai, bj, At, Bt) do { __builtin_amdgcn_s_setprio(1); _Pragma("unroll") for (int m = 0; m < 4; ++m) _Pragma("unroll") for (int n = 0; n < 2; ++n) _Pragma("unroll") for (int k = 0; k < 2; ++k) \
        acc[ai][bj][m][n] = __builtin_amdgcn_mfma_f32_16x16x32_bf16(Bt[n][k], At[m][k], acc[ai][bj][m][n], 0, 0, 0); __builtin_amdgcn_s_setprio(0); } while (0)
#define PG8_WAIT_V(n) asm volatile("s_waitcnt vmcnt(" #n ")" ::: "memory")
#define PG8_WAIT_L(n) asm volatile("s_waitcnt lgkmcnt(" #n ")" ::: "memory")
#define PG8_BAR __builtin_amdgcn_s_barrier()
#define PG8_SCHED __builtin_amdgcn_sched_barrier(0)
    Unit cur, nxt; int ui = 0;
    if (!S.next(0, cur)) return;
    f32x4 acc[2][2][4][2];
#pragma unroll
    for (int a = 0; a < 2; ++a)
#pragma unroll
        for (int b = 0; b < 2; ++b)
#pragma unroll
            for (int m = 0; m < 4; ++m)
#pragma unroll
                for (int n = 0; n < 2; ++n) acc[a][b][m][n] = (f32x4){0.f, 0.f, 0.f, 0.f};
    bf16x8 At[4][2], B0[2][2], B1[2][2];
    const char* cA = P.a(cur); const char* cB = P.b(cur);
    typename Epi::Pre pre; E.prefetch(pre, cur, wr, fr);
    if constexpr (SP2) {
        PG8_STAGE(PG8_SB(0, 0), cB, voffB); PG8_STAGE(PG8_SB(0, 1), cB + hstepB, voffB); PG8_STAGE(PG8_SA(0, 0), cA, voffA); PG8_STAGE(PG8_SA(0, 1), cA + hstepA, voffA);
        if (wr == 1) PG8_BAR;
        PG8_WAIT_V(2); PG8_BAR;
        PG8_STAGE(PG8_SB(1, 0), cB + kstep, voffB); PG8_STAGE(PG8_SA(1, 0), cA + kstep, voffA); PG8_STAGE(PG8_SB(1, 1), cB + hstepB + kstep, voffB);
        PG8_WAIT_V(6); PG8_BAR;
    } else {
        PG8_STAGE(PG8_SB(0, 0), cB, voffB); PG8_STAGE(PG8_SA(0, 0), cA, voffA); PG8_STAGE(PG8_SB(0, 1), cB + hstepB, voffB); PG8_STAGE(PG8_SA(0, 1), cA + hstepA, voffA);
        if (wr == 1) PG8_BAR;
        PG8_WAIT_V(4); PG8_BAR;
        PG8_STAGE(PG8_SB(1, 0), cB + kstep, voffB); PG8_STAGE(PG8_SA(1, 0), cA + kstep, voffA); PG8_STAGE(PG8_SB(1, 1), cB + hstepB + kstep, voffB);
        PG8_WAIT_V(6); PG8_BAR;
    }
#pragma unroll 1
    for (;;) {
        const bool has_next = S.next(ui + 1, nxt);
        const char* nA = has_next ? P.a(nxt) : cA; const char* nB = has_next ? P.b(nxt) : cB;
#pragma unroll 1
        for (int t = 0; t < nt; t += 2) {
            const bool last = (t == nt - 2);
            const char* a1 = cA + (size_t)(t + 1) * kstep;
            const char* a2 = last ? nA : cA + (size_t)(t + 2) * kstep; const char* b2 = last ? nB : cB + (size_t)(t + 2) * kstep;
            const char* a3 = a2 + kstep; const char* b3 = b2 + kstep;
            if constexpr (SP2) {
            PG8_LDB(B0, 0, 0); PG8_LDB(B1, 0, 1); PG8_SCHED; PG8_LDA(At, 0, 0); PG8_STAGE(PG8_SA(1, 1), a1 + hstepA, voffA);
            PG8_WAIT_V(8); PG8_WAIT_L(0); PG8_BAR; PG8_MMA(0, 0, At, B0); PG8_MMA(0, 1, At, B1); PG8_BAR; PG8_SCHED;
            PG8_LDA(At, 0, 1); PG8_STAGE(PG8_SB(0, 0), b2, voffB); PG8_STAGE(PG8_SB(0, 1), b2 + hstepB, voffB); PG8_STAGE(PG8_SA(0, 0), a2, voffA);
            PG8_WAIT_V(8); PG8_WAIT_L(0); PG8_BAR; PG8_MMA(1, 0, At, B0); PG8_MMA(1, 1, At, B1); PG8_BAR; PG8_SCHED;
            PG8_LDB(B0, 1, 0); PG8_LDB(B1, 1, 1); PG8_SCHED; PG8_LDA(At, 1, 0); PG8_STAGE(PG8_SA(0, 1), a2 + hstepA, voffA);
            PG8_WAIT_V(8); PG8_WAIT_L(0); PG8_BAR; PG8_MMA(0, 0, At, B0); PG8_MMA(0, 1, At, B1); PG8_BAR; PG8_SCHED;
            PG8_LDA(At, 1, 1); PG8_STAGE(PG8_SB(1, 0), b3, voffB); PG8_STAGE(PG8_SB(1, 1), b3 + hstepB, voffB); PG8_STAGE(PG8_SA(1, 0), a3, voffA);
            PG8_WAIT_V(8); PG8_WAIT_L(0); PG8_BAR; PG8_MMA(1, 0, At, B0); PG8_MMA(1, 1, At, B1); PG8_BAR; PG8_SCHED;
            } else {
            PG8_LDB(B0, 0, 0); PG8_SCHED; PG8_LDA(At, 0, 0); PG8_STAGE(PG8_SA(1, 1), a1 + hstepA, voffA);
            PG8_WAIT_L(8); PG8_BAR; PG8_WAIT_L(0); PG8_MMA(0, 0, At, B0); PG8_BAR; PG8_SCHED;
            PG8_LDB(B1, 0, 1); PG8_STAGE(PG8_SB(0, 0), b2, voffB);
            PG8_BAR; PG8_WAIT_L(0); PG8_MMA(0, 1, At, B1); PG8_BAR;
            PG8_LDA(At, 0, 1); PG8_STAGE(PG8_SA(0, 0), a2, voffA);
            PG8_BAR; PG8_WAIT_L(0); PG8_MMA(1, 0, At, B0); PG8_BAR; PG8_SCHED;
            PG8_STAGE(PG8_SB(0, 1), b2 + hstepB, voffB);
            PG8_WAIT_V(6); PG8_BAR; PG8_MMA(1, 1, At, B1); PG8_BAR;
            PG8_LDB(B0, 1, 0); PG8_SCHED; PG8_LDA(At, 1, 0); PG8_STAGE(PG8_SA(0, 1), a2 + hstepA, voffA);
            PG8_WAIT_L(8); PG8_BAR; PG8_WAIT_L(0); PG8_MMA(0, 0, At, B0); PG8_BAR; PG8_SCHED;
            PG8_LDB(B1, 1, 1); PG8_STAGE(PG8_SB(1, 0), b3, voffB);
            PG8_BAR; PG8_WAIT_L(0); PG8_MMA(0, 1, At, B1); PG8_BAR;
            PG8_LDA(At, 1, 1); PG8_STAGE(PG8_SA(1, 0), a3, voffA);
            PG8_BAR; PG8_WAIT_L(0); PG8_MMA(1, 0, At, B0); PG8_BAR; PG8_SCHED;
            PG8_STAGE(PG8_SB(1, 1), b3 + hstepB, voffB);
            PG8_WAIT_V(6); PG8_BAR; PG8_MMA(1, 1, At, B1); PG8_BAR;
            }
        }
        if constexpr (ALIGN_EPI) { if (wr == 0) PG8_BAR; }
        if constexpr (!Epi::AFTER_DRAIN) { int fr_ = fr, fq_ = fq; asm volatile("" : "+v"(fr_), "+v"(fq_));
            E(acc, cur, wr, wc, fr_, fq_, pre); }
        if (!has_next) break;
#pragma unroll
        for (int a = 0; a < 2; ++a)
#pragma unroll
            for (int b = 0; b < 2; ++b)
#pragma unroll
                for (int m = 0; m < 4; ++m)
#pragma unroll
                    for (int n = 0; n < 2; ++n) acc[a][b][m][n] = (f32x4){0.f, 0.f, 0.f, 0.f};
        cur = nxt; cA = nA; cB = nB; ++ui; E.prefetch(pre, cur, wr, fr);
        if constexpr (ALIGN_EPI) { if (wr == 1) PG8_BAR; }
    }
    PG8_WAIT_V(0);
    if constexpr (!ALIGN_EPI) { if (wr == 0) PG8_BAR; }
    PG8_BAR;
    if constexpr (Epi::AFTER_DRAIN) { E.fused(acc, cur, wr, wc, fr, fq, lds, wid, lane, pre); }
#undef PG8_SA
#undef PG8_SB
#undef PG8_STAGE
#undef PG8_LDA
#undef PG8_LDB
#undef PG8_MMA
#undef PG8_WAIT_V
#undef PG8_WAIT_L
#undef PG8_BAR
#undef PG8_SCHED
}
typedef f32x4 Acc[2][2][4][2];

struct PtrStd {
    const char* A; const char* B; size_t aj, bj, bb, arow, brow;
    DEV const char* a(const Unit& u) const { return A + (size_t)u.job * aj + (size_t)u.pm * arow; }
    DEV const char* b(const Unit& u) const { return B + (size_t)u.job * bj + (size_t)(u.pm >> 5) * bb + (size_t)u.pn * brow; }
};
struct PtrG {
    const char* KVM; const char* WQ;
    DEV const char* a(const Unit& u) const { return KVM + (size_t)(u.job >> 2) * MiB + (size_t)(u.job & 3) * 512; }
    DEV const char* b(const Unit& u) const { return WQ + (size_t)(u.job >> 3) * 2 * MiB + (size_t)(u.job & 3) * 512 + (size_t)u.pn * 256 * 1024 * 2; }
};
struct PtrH {
    const char* KVM; const char* WOT;
    DEV const char* a(const Unit& u) const { return WOT + (size_t)(u.job >> 3) * 2 * MiB + (size_t)(u.job & 3) * 512 + (size_t)u.pm * 256 * 1024 * 2; }
    DEV const char* b(const Unit& u) const { return KVM + (size_t)(u.job >> 2) * MiB + 2048 + (size_t)(u.job & 3) * 512; }
};

#define EPI_ROWS(u) const int row0 = (u).pm * BM + wr * 64 + fr
DEV u32x4 pack8(const f32x4 v0, const f32x4 v1) { u32x4 w; w.x = cvt_pk_bf16(v0[0], v0[1]); w.y = cvt_pk_bf16(v0[2], v0[3]); w.z = cvt_pk_bf16(v1[0], v1[1]); w.w = cvt_pk_bf16(v1[2], v1[3]); return w; }

struct PreNone {};
typedef unsigned long long u64;
constexpr float SS_SCALE = 65536.f;
struct PreRs { u64 v[2][4]; };
DEV void pre_rs(PreRs& p, const u64* ss, int row0) {
#pragma unroll
    for (int ai = 0; ai < 2; ++ai)
#pragma unroll
        for (int m = 0; m < 4; ++m) p.v[ai][m] = __builtin_nontemporal_load(ss + row0 + ai * HALF + m * 16);
}
DEV void rs_of(float (&rs)[2][4], const PreRs& p) {
#pragma unroll
    for (int ai = 0; ai < 2; ++ai)
#pragma unroll
        for (int m = 0; m < 4; ++m) rs[ai][m] = rsqrtf((float)p.v[ai][m] * (1.f / (SS_SCALE * D)) + EPS);
}
struct EpiInProj {
    typedef PreRs Pre;
    DEV void prefetch(PreRs& p, const Unit& u, int wr, int fr) const { pre_rs(p, ss, u.pm * BM + wr * 64 + fr); }
    static constexpr bool PERM = true, AFTER_DRAIN = false;
    unsigned char* ws; const u64* ss;
    DEV void operator()(const Acc& acc, const Unit& u, int wr, int wc, int fr, int fq, const PreRs& pre) const {
        EPI_ROWS(u); const int pn = u.pn, cb = wc * 32 + 8 * fq;
        float rs[2][4]; rs_of(rs, pre);
        if (pn < 16) {
            const int g = pn >> 1;
            const size_t off = g == 0 ? WS_QA : g == 1 ? WS_KA : g == 2 ? WS_VA : g == 3 ? WS_QC : g == 4 ? WS_KC : g == 5 ? WS_VC : g == 6 ? WS_IQ : WS_SCB;
            const float sc = (g == 0 || g == 3) ? QSCALE : 1.f;
            bf16_t* base = (bf16_t*)(ws + off) + (pn & 1) * 256 + cb;
#pragma unroll
            for (int ai = 0; ai < 2; ++ai)
#pragma unroll
                for (int m = 0; m < 4; ++m) { bf16_t* rowp = base + (size_t)(row0 + ai * HALF + m * 16) * 512;
#pragma unroll
                    for (int bj = 0; bj < 2; ++bj) *(u32x4*)(rowp + bj * HALF) = pack8(acc[ai][bj][m][0] * (sc * rs[ai][m]), acc[ai][bj][m][1] * (sc * rs[ai][m])); }
        } else if (pn < 20) {
            bf16_t* base = (bf16_t*)(ws + WS_CX) + (pn - 16) * 128 + cb;
#pragma unroll
            for (int ai = 0; ai < 2; ++ai)
#pragma unroll
                for (int m = 0; m < 4; ++m) { const float r2 = rs[ai][m] * rs[ai][m]; *(u32x4*)(base + (size_t)(row0 + ai * HALF + m * 16) * 512) = pack8(acc[ai][0][m][0] * acc[ai][1][m][0] * r2, acc[ai][0][m][1] * acc[ai][1][m][1] * r2); }
        } else {
            if (wc < 2) { bf16_t* base = (bf16_t*)(ws + WS_IK);
#pragma unroll
                for (int ai = 0; ai < 2; ++ai)
#pragma unroll
                    for (int m = 0; m < 4; ++m) { const int t = row0 + ai * HALF + m * 16;
                        *(u32x4*)(base + (size_t)(t >> 5) * 2048 + (((cb >> 3) * 32 + (t & 31)) * 8)) = pack8(acc[ai][0][m][0] * rs[ai][m], acc[ai][0][m][1] * rs[ai][m]); }
            } else if (wc == 2 && fq == 0) { float* base = (float*)(ws + WS_IW);
#pragma unroll
                for (int ai = 0; ai < 2; ++ai)
#pragma unroll
                    for (int m = 0; m < 4; ++m) { float* p = base + (size_t)(row0 + ai * HALF + m * 16) * 8; *(f32x4*)p = acc[ai][0][m][0] * (WSCALE * rs[ai][m]); *(f32x4*)(p + 4) = acc[ai][0][m][1] * (WSCALE * rs[ai][m]); }
            }
        }
    }
};
DEV f32x4 sigm4(const f32x4 v) { f32x4 o;
#pragma unroll
    for (int i = 0; i < 4; ++i) o[i] = __builtin_amdgcn_rcpf(1.f + __builtin_amdgcn_exp2f(-LOG2E * v[i])); return o; }
struct EpiGates {
    typedef PreRs Pre;
    DEV void prefetch(PreRs& p, const Unit& u, int wr, int fr) const { pre_rs(p, ss, u.pm * BM + wr * 64 + fr); }
    static constexpr bool PERM = true, AFTER_DRAIN = false;
    bf16_t* G; const u64* ss;
    DEV void operator()(const Acc& acc, const Unit& u, int wr, int wc, int fr, int fq, const PreRs& pre) const {
        EPI_ROWS(u); float rs[2][4]; rs_of(rs, pre); bf16_t* base = G + (size_t)(u.pn >> 2) * T * D + (u.pn & 3) * 256 + wc * 32 + 8 * fq;
#pragma unroll
        for (int ai = 0; ai < 2; ++ai)
#pragma unroll
            for (int m = 0; m < 4; ++m) { bf16_t* rowp = base + (size_t)(row0 + ai * HALF + m * 16) * D;
#pragma unroll
                for (int bj = 0; bj < 2; ++bj) *(u32x4*)(rowp + bj * HALF) = pack8(sigm4(acc[ai][bj][m][0] * rs[ai][m]), sigm4(acc[ai][bj][m][1] * rs[ai][m])); }
    }
};
struct EpiMerge {
    typedef PreNone Pre;
    DEV void prefetch(PreNone&, const Unit&, int, int) const {}
    static constexpr bool PERM = true, AFTER_DRAIN = false;
    bf16_t* M; const bf16_t* G;
    DEV void operator()(const Acc& acc, const Unit& u, int wr, int wc, int fr, int fq, const PreNone&) const {
        EPI_ROWS(u); const size_t cofs = (size_t)u.pn * 256 + wc * 32 + 8 * fq; const bf16_t* gb = G + (size_t)u.job * T * D;
#pragma unroll
        for (int ai = 0; ai < 2; ++ai)
#pragma unroll
            for (int m = 0; m < 4; ++m) { const size_t ro = (size_t)(row0 + ai * HALF + m * 16) * D + cofs;
#pragma unroll
                for (int bj = 0; bj < 2; ++bj) { const size_t o = ro + bj * HALF; const u32x4 g = *(const u32x4*)(gb + o);
                    f32x4 v0 = acc[ai][bj][m][0], v1 = acc[ai][bj][m][1];
                    v0[0] *= bflo(g.x); v0[1] *= bfhi(g.x); v0[2] *= bflo(g.y); v0[3] *= bfhi(g.y); v1[0] *= bflo(g.z); v1[1] *= bfhi(g.z); v1[2] *= bflo(g.w); v1[3] *= bfhi(g.w);
                    if (u.job > 0) { const u32x4 p = __builtin_nontemporal_load((const u32x4*)(M + o));
                        v0[0] += bflo(p.x); v0[1] += bfhi(p.x); v0[2] += bflo(p.y); v0[3] += bfhi(p.y); v1[0] += bflo(p.z); v1[1] += bfhi(p.z); v1[2] += bflo(p.w); v1[3] += bfhi(p.w); }
                    *(u32x4*)(M + o) = pack8(v0, v1); } }
    }
};
template <bool IN_F32> struct EpiResid {
    typedef PreNone Pre;
    DEV void prefetch(PreNone&, const Unit&, int, int) const {}
    static constexpr bool PERM = true, AFTER_DRAIN = false;
    const void* xin; bf16_t* xb; u64* ss;
    DEV void operator()(const Acc& acc, const Unit& u, int wr, int wc, int fr, int fq, const PreNone&) const {
        EPI_ROWS(u); const size_t cofs = (size_t)u.pn * 256 + wc * 32 + 8 * fq;
#pragma unroll
        for (int ai = 0; ai < 2; ++ai)
#pragma unroll
            for (int m = 0; m < 4; ++m) { const size_t ro = (size_t)(row0 + ai * HALF + m * 16) * D + cofs; float sq = 0.f;
#pragma unroll
                for (int bj = 0; bj < 2; ++bj) { const size_t o = ro + bj * HALF; f32x4 v0 = acc[ai][bj][m][0], v1 = acc[ai][bj][m][1];
                    if (IN_F32) { v0 = v0 + *(const f32x4*)((const float*)xin + o); v1 = v1 + *(const f32x4*)((const float*)xin + o + 4); }
                    else { const u32x4 p = *(const u32x4*)((const bf16_t*)xin + o);
                        v0[0] += bflo(p.x); v0[1] += bfhi(p.x); v0[2] += bflo(p.y); v0[3] += bfhi(p.y); v1[0] += bflo(p.z); v1[1] += bfhi(p.z); v1[2] += bflo(p.w); v1[3] += bfhi(p.w); }
                    *(u32x4*)(xb + o) = pack8(v0, v1);
                    sq += ((v0[0] * v0[0] + v0[1] * v0[1]) + (v0[2] * v0[2] + v0[3] * v0[3])) + ((v1[0] * v1[0] + v1[1] * v1[1]) + (v1[2] * v1[2] + v1[3] * v1[3])); }
                sq += __shfl_xor(sq, 16); sq += __shfl_xor(sq, 32);
                if (fq == 0) atomicAdd(ss + row0 + ai * HALF + m * 16, (u64)(sq * SS_SCALE + 0.5f)); }
    }
};
struct EpiUp {
    typedef PreRs Pre;
    DEV void prefetch(PreRs& p, const Unit& u, int wr, int fr) const { pre_rs(p, ss, u.pm * BM + wr * 64 + fr); }
    static constexpr bool PERM = true, AFTER_DRAIN = false;
    bf16_t *fa, *fu; const u64* ss;
    DEV void operator()(const Acc& acc, const Unit& u, int wr, int wc, int fr, int fq, const PreRs& pre) const {
        EPI_ROWS(u); float rs[2][4]; rs_of(rs, pre); const size_t cofs = (size_t)u.pn * 128 + wc * 32 + 8 * fq;
#pragma unroll
        for (int ai = 0; ai < 2; ++ai)
#pragma unroll
            for (int m = 0; m < 4; ++m) { const size_t o = (size_t)(row0 + ai * HALF + m * 16) * DFF + cofs;
                *(u32x4*)(fa + o) = pack8(acc[ai][0][m][0] * rs[ai][m], acc[ai][0][m][1] * rs[ai][m]); *(u32x4*)(fu + o) = pack8(acc[ai][1][m][0] * rs[ai][m], acc[ai][1][m][1] * rs[ai][m]); }
    }
};
struct EpiPrep {
    typedef PreNone Pre;
    DEV void prefetch(PreNone&, const Unit&, int, int) const {}
    static constexpr bool PERM = true, AFTER_DRAIN = false;
    unsigned char* ws; int mode;
    DEV void operator()(const Acc& acc, const Unit& u, int wr, int wc, int fr, int fq, const PreNone&) const {
        EPI_ROWS(u); bf16_t* base; int ldc; float sc = 1.f;
        if (mode == 0) { base = (bf16_t*)(ws + WS_KVM + (size_t)u.job * 2 * MiB); ldc = 2 * D; }
        else if (mode == 1) { base = (bf16_t*)(ws + WS_GT + (size_t)(u.job >> 2) * 2 * MiB) + (size_t)(u.job & 3) * 256 * D; ldc = D; sc = XSCALE; }
        else { base = (bf16_t*)(ws + WS_HT + (size_t)(u.job >> 2) * 2 * MiB) + (u.job & 3) * 256; ldc = D; }
        base += (size_t)u.pn * 256 + wc * 32 + 8 * fq;
#pragma unroll
        for (int ai = 0; ai < 2; ++ai)
#pragma unroll
            for (int m = 0; m < 4; ++m) { bf16_t* rowp = base + (size_t)(row0 + ai * HALF + m * 16) * ldc;
#pragma unroll
                for (int bj = 0; bj < 2; ++bj) *(u32x4*)(rowp + bj * HALF) = pack8(acc[ai][bj][m][0] * sc, acc[ai][bj][m][1] * sc); }
    }
};
struct EpiSoftmax {
    typedef PreRs Pre;
    DEV void prefetch(PreRs& p, const Unit& u, int wr, int fr) const { pre_rs(p, ss, u.pm * BM + wr * 64 + fr); }
    static constexpr bool PERM = true, AFTER_DRAIN = true;
    bf16_t* P; const u64* ss;
    DEV void fused(Acc& acc, const Unit& u, int wr, int wc, int fr, int fq, LAS unsigned char* lds, int wid, int lane, const PreRs& pre) const {
        LAS float* PM = (LAS float*)lds; LAS float* PS = (LAS float*)(lds + 4096);
        { const int row0_ = u.pm * BM + wr * 64 + fr; float rs[2][4]; rs_of(rs, pre);
#pragma unroll
          for (int ai = 0; ai < 2; ++ai)
#pragma unroll
              for (int m = 0; m < 4; ++m)
#pragma unroll
                  for (int bj = 0; bj < 2; ++bj)
#pragma unroll
                      for (int n = 0; n < 2; ++n) acc[ai][bj][m][n] = acc[ai][bj][m][n] * rs[ai][m]; }
#pragma unroll
        for (int ai = 0; ai < 2; ++ai)
#pragma unroll
            for (int m = 0; m < 4; ++m) { float mx = -INFINITY;
#pragma unroll
                for (int bj = 0; bj < 2; ++bj)
#pragma unroll
                    for (int n = 0; n < 2; ++n) { const f32x4 x = acc[ai][bj][m][n]; mx = fmaxf(mx, fmaxf(fmaxf(x[0], x[1]), fmaxf(x[2], x[3]))); }
                mx = fmaxf(mx, __shfl_xor(mx, 16)); mx = fmaxf(mx, __shfl_xor(mx, 32));
                if (fq == 0) PM[(ai * HALF + wr * 64 + m * 16 + fr) * 4 + wc] = mx; }
        LDS_WAIT(); __builtin_amdgcn_s_barrier(); asm volatile("" ::: "memory");
#pragma unroll
        for (int ai = 0; ai < 2; ++ai)
#pragma unroll
            for (int m = 0; m < 4; ++m) { const int r = ai * HALF + wr * 64 + m * 16 + fr; const f32x4 q = *(const LAS f32x4*)(PM + r * 4);
                const float mx = fmaxf(fmaxf(q[0], q[1]), fmaxf(q[2], q[3])); float s = 0.f;
#pragma unroll
                for (int bj = 0; bj < 2; ++bj)
#pragma unroll
                    for (int n = 0; n < 2; ++n) { f32x4 x = acc[ai][bj][m][n];
#pragma unroll
                        for (int i = 0; i < 4; ++i) { x[i] = __builtin_amdgcn_exp2f(x[i] - mx); s += x[i]; } acc[ai][bj][m][n] = x; }
                s += __shfl_xor(s, 16); s += __shfl_xor(s, 32);
                if (fq == 0) PS[r * 4 + wc] = s; }
        LDS_WAIT(); __builtin_amdgcn_s_barrier(); asm volatile("" ::: "memory");
        EPI_ROWS(u); bf16_t* base = P + (size_t)u.pn * 256 + wc * 32 + 8 * fq;
#pragma unroll
        for (int ai = 0; ai < 2; ++ai)
#pragma unroll
            for (int m = 0; m < 4; ++m) { const int r = ai * HALF + wr * 64 + m * 16 + fr; const f32x4 q = *(const LAS f32x4*)(PS + r * 4);
                const float inv = 1.f / ((q[0] + q[1]) + (q[2] + q[3])); bf16_t* rowp = base + (size_t)(row0 + ai * HALF + m * 16) * D;
#pragma unroll
                for (int bj = 0; bj < 2; ++bj) *(u32x4*)(rowp + bj * HALF) = pack8(acc[ai][bj][m][0] * inv, acc[ai][bj][m][1] * inv); }
        LDS_WAIT(); __builtin_amdgcn_s_barrier();
    }
};
}

typedef GAS unsigned gu32;
#define XB_TMO      128
#define XB_XCNT(j)  (256  + 64 * (j))
#define XB_XSUB(j)  (1280 + 64 * (j))
#define XB_XGEN(j)  (2304 + 64 * (j))
#define XB_TOP      3328
#define XB_TOPGEN   3392
#define XCD_BAR_WORDS 3456
#define XB_SPIN_CAP (1u << 22)
DEV unsigned xb_ld(unsigned* p) { return __hip_atomic_load(p, __ATOMIC_RELAXED, __HIP_MEMORY_SCOPE_AGENT); }
DEV unsigned xb_add(unsigned* p, unsigned v) { return __hip_atomic_fetch_add(p, v, __ATOMIC_RELAXED, __HIP_MEMORY_SCOPE_AGENT); }
DEV unsigned xb_xcc_id() { return (unsigned)__builtin_amdgcn_s_getreg((3 << 11) | 20) & 0xFu; }
#define XB_SPIN(cond, bar) do { unsigned _sp = 0; while (cond) { __builtin_amdgcn_s_sleep(1); \
    if ((++_sp & 255u) == 0u) { if (xb_ld(&(bar)[XB_TMO])) break; if (_sp > XB_SPIN_CAP) { atomicAdd(&(bar)[XB_TMO], 1u); break; } } } } while (0)
struct XcdBarrier { unsigned* bar; unsigned x; volatile LAS unsigned* st; };
DEV XcdBarrier xcd_barrier_post(unsigned* bar, volatile LAS unsigned* st, int tid) {
    XcdBarrier b; b.bar = bar; b.x = xb_xcc_id(); b.st = st;
    if (tid == 0) (void)xb_add(&bar[XB_XCNT(b.x)], 1u);
    return b;
}
DEV void xcd_barrier_complete(unsigned* bar, unsigned x, unsigned& nloc, unsigned& nx) {
    const unsigned G = gridDim.x * gridDim.y * gridDim.z;
    unsigned sum, cnt, mine, sp = 0u;
    for (;;) {
        sum = 0u; cnt = 0u; mine = 0u;
#pragma unroll
        for (unsigned j = 0; j < 16; ++j) { const unsigned c = xb_ld(&bar[XB_XCNT(j)]); sum += c; cnt += (c > 0u) ? 1u : 0u; mine = (j == x) ? c : mine; }
        if (sum == G) break;
        __builtin_amdgcn_s_sleep(1);
        if ((++sp & 255u) == 0u) { if (xb_ld(&bar[XB_TMO])) break; if (sp > XB_SPIN_CAP) { atomicAdd(&bar[XB_TMO], 1u); break; } }
    }
    nloc = mine > 0u ? mine : 1u; nx = cnt > 0u ? cnt : 1u;
}
DEV void xcd_barrier(const XcdBarrier& b, int tid) {
    asm volatile("s_waitcnt vmcnt(0)" ::: "memory");
    __syncthreads();
    if (tid == 0) {
        unsigned* bar = b.bar;
        __builtin_amdgcn_s_waitcnt(0);
        unsigned nloc = b.st[0], nx = b.st[1];
        if (nloc == 0u) { xcd_barrier_complete(bar, b.x, nloc, nx); b.st[0] = nloc; b.st[1] = nx; }
        const unsigned old = xb_add(&bar[XB_XSUB(b.x)], 1u);
        const unsigned gen = old / nloc;
        if (old + 1u == (gen + 1u) * nloc) {
            __builtin_amdgcn_fence(__ATOMIC_RELEASE, "agent");
            asm volatile("s_waitcnt vmcnt(0)" ::: "memory");
            const unsigned og = xb_add(&bar[XB_TOP], 1u);
            const unsigned tg = og / nx;
            if (og + 1u == (tg + 1u) * nx) xb_add(&bar[XB_TOPGEN], 1u);
            else XB_SPIN(xb_ld(&bar[XB_TOPGEN]) == tg, bar);
            __builtin_amdgcn_fence(__ATOMIC_ACQUIRE, "agent");
            xb_add(&bar[XB_XGEN(b.x)], 1u);
            asm volatile("s_waitcnt vmcnt(0)" ::: "memory");
        } else {
            XB_SPIN(xb_ld(&bar[XB_XGEN(b.x)]) == gen, bar);
            __builtin_amdgcn_fence(__ATOMIC_ACQUIRE, "agent");
            asm volatile("s_waitcnt vmcnt(0)" ::: "memory");
        }
    }
    __syncthreads();
}


struct WaveId { int gw, ngw, wave, lane; };
DEV unsigned f2bf_u(float f) { return (unsigned)f2bf(f); }
DEV unsigned pk2(float lo, float hi) { return cvt_pk_bf16(lo, hi); }

DEV void norm_rows(const WaveId& W, const float* x, const float* g, bf16_t* outb, float* outf, int rows) {
    for (int row = W.gw; row < rows; row += W.ngw) {
        const f32x4* xr = (const f32x4*)(x + (size_t)row * D) + W.lane;
        f32x4 v[4]; float s = 0.f;
#pragma unroll
        for (int j = 0; j < 4; ++j) { v[j] = xr[64 * j]; s += (v[j].x * v[j].x + v[j].y * v[j].y) + (v[j].z * v[j].z + v[j].w * v[j].w); }
        const float r = rsqrtf(wave_sum(s) * (1.f / D) + EPS);
#pragma unroll
        for (int j = 0; j < 4; ++j) {
            const f32x4 gg = ((const f32x4*)g)[W.lane + 64 * j];
            const f32x4 o = {v[j].x * r * gg.x, v[j].y * r * gg.y, v[j].z * r * gg.z, v[j].w * r * gg.w};
            if (outb) { u32x2 w; w.x = pk2(o.x, o.y); w.y = pk2(o.z, o.w); ((u32x2*)(outb + (size_t)row * D))[W.lane + 64 * j] = w; }
            else ((f32x4*)(outf + (size_t)row * D))[W.lane + 64 * j] = o;
        }
    }
}
DEV void cvt_piece(const WaveId& W, LAS float* scr, int& base, const float* Wsrc, int ldw, int K, int col0, int ncols, bf16_t* dst, int ldo, int row0, const float* gain = nullptr) {
    const int nblk = ncols / 32, nitems = (K / 64) * nblk;
    int first = (W.gw - base) % W.ngw; if (first < 0) first += W.ngw;
    base = (base + nitems) % W.ngw;
    for (int item = first; item < nitems; item += W.ngw) {
        const int kb = item / nblk, nb = item - kb * nblk, k0 = 64 * kb, n0 = 32 * nb;
#pragma unroll 8
        for (int i = 0; i < 32; ++i) { const int kk = 2 * i + (W.lane >> 5); scr[kk * 33 + (W.lane & 31)] = Wsrc[(size_t)(k0 + kk) * ldw + col0 + n0 + (W.lane & 31)] * (gain ? gain[k0 + kk] : 1.f); }
        LDS_WAIT(); asm volatile("" ::: "memory");
        const int c = W.lane & 7;
#pragma unroll
        for (int j = 0; j < 4; ++j) { const int n = (W.lane >> 3) + 8 * j; const LAS float* s = scr + (8 * c) * 33 + n;
            u32x4 o; o.x = pk2(s[0 * 33], s[1 * 33]); o.y = pk2(s[2 * 33], s[3 * 33]); o.z = pk2(s[4 * 33], s[5 * 33]); o.w = pk2(s[6 * 33], s[7 * 33]);
            *(u32x4*)(dst + (size_t)(row0 + n0 + n) * ldo + k0 + 8 * c) = o; }
        LDS_WAIT(); asm volatile("" ::: "memory");
    }
}
DEV void convert_layer_weights(const WaveId& W, LAS float* scr, int& base, unsigned char* ws, const float* const* in, int l) {
    const float* wi = in[3] + (size_t)l * D * DIN;
    bf16_t* WIN = (bf16_t*)(ws + WS_WIN); const float* gm = in[2] + l * D; const float* gf = in[14] + l * D;
    cvt_piece(W, scr, base, wi, DIN, D, 0, 1536, WIN, D, 0, gm);
    cvt_piece(W, scr, base, wi, DIN, D, 3072, 1536, WIN, D, 1536, gm);
    cvt_piece(W, scr, base, wi, DIN, D, 4608, 512, WIN, D, 3072, gm);
    cvt_piece(W, scr, base, wi, DIN, D, 1536, 512, WIN, D, 3584, gm);
#pragma unroll 1
    for (int j = 0; j < 4; ++j) { cvt_piece(W, scr, base, wi, DIN, D, 2048 + 128 * j, 128, WIN, D, 4096 + 256 * j, gm); cvt_piece(W, scr, base, wi, DIN, D, 2560 + 128 * j, 128, WIN, D, 4096 + 256 * j + 128, gm); }
    cvt_piece(W, scr, base, wi, DIN, D, 5120, 96, WIN, D, 5120, gm);
    cvt_piece(W, scr, base, wi, DIN, D, 5192, 3072, (bf16_t*)(ws + WS_WG), D, 0, gm);
#pragma unroll 1
    for (int i = 0; i < 3; ++i) cvt_piece(W, scr, base, in[5 + i] + (size_t)l * 512 * D, D, 512, 0, D, (bf16_t*)(ws + WS_WBR) + (size_t)i * D * 512, 512, 0);
    cvt_piece(W, scr, base, in[8] + (size_t)l * D * D, D, D, 0, D, (bf16_t*)(ws + WS_WMIX), D, 0);
    const float* wf = in[15] + (size_t)l * D * 2 * DFF;
#pragma unroll 1
    for (int j = 0; j < 22; ++j) { cvt_piece(W, scr, base, wf, 2 * DFF, D, 128 * j, 128, (bf16_t*)(ws + WS_WUP), D, 256 * j, gf); cvt_piece(W, scr, base, wf, 2 * DFF, D, DFF + 128 * j, 128, (bf16_t*)(ws + WS_WUP), D, 256 * j + 128, gf); }
    cvt_piece(W, scr, base, in[18] + (size_t)l * DFF * D, D, DFF, 0, D, (bf16_t*)(ws + WS_WDOWN), DFF, 0);
}
DEV void prep0_phase(const WaveId& W, LAS float* scr, unsigned char* ws, const float* const* in, bf16_t* XB) {
    int base = 0;
#pragma unroll 1
    for (int l = 0; l < DEPTH; ++l) {
        const float* wq = in[11] + (size_t)l * D * D; bf16_t* WQ = (bf16_t*)(ws + WS_WQ + (size_t)l * 2 * MiB); const float* gx = in[9] + l * D;
        for (size_t i = (size_t)(W.gw * 64 + W.lane) * 4; i < (size_t)D * D; i += (size_t)W.ngw * 256) { const float g = gx[i >> 10]; const f32x4 v = *(const f32x4*)(wq + i); u32x2 o; o.x = pk2(v.x * g, v.y * g); o.y = pk2(v.z * g, v.w * g); *(u32x2*)(WQ + i) = o; }
        cvt_piece(W, scr, base, in[13] + (size_t)l * D * D, D, D, 0, D, (bf16_t*)(ws + WS_WOT + (size_t)l * 2 * MiB), D, 0);
        cvt_piece(W, scr, base, in[12] + (size_t)l * D * 2 * D, 2 * D, D, 0, 2 * D, (bf16_t*)(ws + WS_WKVT + (size_t)l * 4 * MiB), D, 0);
        norm_rows(W, in[1], in[10] + l * D, (bf16_t*)(ws + WS_MEMN + (size_t)l * MiB), nullptr, NB * MEM);
    }
    convert_layer_weights(W, scr, base, ws, in, 0);
    pg8::u64* ss0 = (pg8::u64*)(ws + WS_SS);
    for (int row = W.gw; row < T; row += W.ngw) {
        const f32x4* xr = (const f32x4*)(in[0] + (size_t)row * D) + W.lane; float s = 0.f;
#pragma unroll
        for (int j = 0; j < 4; ++j) { const f32x4 v = xr[64 * j]; s += (v.x * v.x + v.y * v.y) + (v.z * v.z + v.w * v.w);
            u32x2 w; w.x = pk2(v.x, v.y); w.y = pk2(v.z, v.w); ((u32x2*)(XB + (size_t)row * D))[W.lane + 64 * j] = w; }
        s = wave_sum(s); if (W.lane == 0) ss0[row] = (pg8::u64)(s * pg8::SS_SCALE + 0.5f);
    }
}
DEV void final_norm(const WaveId& W, const bf16_t* x, float* out, const float* g, const pg8::u64* ss) {
    for (int row = W.gw; row < T; row += W.ngw) {
        const float r = rsqrtf((float)ss[row] * (1.f / (pg8::SS_SCALE * D)) + EPS); const u32x2* xr = (const u32x2*)(x + (size_t)row * D) + W.lane; f32x4* orow = (f32x4*)(out + (size_t)row * D) + W.lane;
#pragma unroll
        for (int j = 0; j < 4; ++j) { const f32x4 gg = ((const f32x4*)g)[W.lane + 64 * j]; const u32x2 v = xr[64 * j];
            const f32x4 o = {bflo(v.x) * r * gg.x, bfhi(v.x) * r * gg.y, bflo(v.y) * r * gg.z, bfhi(v.y) * r * gg.w}; orow[64 * j] = o; }
    }
}
DEV void conv_sc_phase(int gtid, int gthreads, bf16_t* scb, const bf16_t* cx, const float* w, bool dry) {
    for (int i = gtid; i < T * 64; i += gthreads) {
        const int c8 = (i & 63) * 8, t = i >> 6, tl = t & (S - 1);
        const size_t o = (size_t)t * 512 + c8;
        const u32x4 z = {0u, 0u, 0u, 0u};
        const u32x4 x2 = *(const u32x4*)(cx + o), x1 = tl >= 1 ? *(const u32x4*)(cx + o - 512) : z, x0 = tl >= 2 ? *(const u32x4*)(cx + o - 1024) : z, bb = *(const u32x4*)(scb + o);
        const f32x4 w0a = *(const f32x4*)(w + c8), w0b = *(const f32x4*)(w + c8 + 4), w1a = *(const f32x4*)(w + 512 + c8), w1b = *(const f32x4*)(w + 512 + c8 + 4), w2a = *(const f32x4*)(w + 1024 + c8), w2b = *(const f32x4*)(w + 1024 + c8 + 4);
        float r[8];
#define CONV1(k, W0, W1, W2, X0, X1, X2, BBv, F) r[k] = F(BBv) * (W0 * F(X0) + W1 * F(X1) + W2 * F(X2))
        CONV1(0, w0a.x, w1a.x, w2a.x, x0.x, x1.x, x2.x, bb.x, bflo); CONV1(1, w0a.y, w1a.y, w2a.y, x0.x, x1.x, x2.x, bb.x, bfhi);
        CONV1(2, w0a.z, w1a.z, w2a.z, x0.y, x1.y, x2.y, bb.y, bflo); CONV1(3, w0a.w, w1a.w, w2a.w, x0.y, x1.y, x2.y, bb.y, bfhi);
        CONV1(4, w0b.x, w1b.x, w2b.x, x0.z, x1.z, x2.z, bb.z, bflo); CONV1(5, w0b.y, w1b.y, w2b.y, x0.z, x1.z, x2.z, bb.z, bfhi);
        CONV1(6, w0b.z, w1b.z, w2b.z, x0.w, x1.w, x2.w, bb.w, bflo); CONV1(7, w0b.w, w1b.w, w2b.w, x0.w, x1.w, x2.w, bb.w, bfhi);
#undef CONV1
        u32x4 ov; ov.x = pk2(r[0], r[1]); ov.y = pk2(r[2], r[3]); ov.z = pk2(r[4], r[5]); ov.w = pk2(r[6], r[7]);
        if (!dry) *(u32x4*)(scb + o) = ov; else asm volatile("" :: "v"(ov));
    }
}
DEV float gelu_t(float a) { return a * __builtin_amdgcn_rcpf(1.f + __builtin_amdgcn_exp2f(-1.5957691216057308f * LOG2E * (a + 0.044715f * a * a * a))); }
DEV void ffn_mid_phase(int gtid, int gthreads, const bf16_t* fa, bf16_t* fu, const float* cw, const float* cb, bool dry) {
    constexpr int C8 = DFF / 8;
    for (int i = gtid; i < T * C8; i += gthreads) {
        const int t = i / C8, c8 = (i - t * C8) * 8, tl = t & (S - 1);
        const size_t o = (size_t)t * DFF + c8;
        const u32x4 z = {0u, 0u, 0u, 0u};
        const u32x4 x2 = *(const u32x4*)(fa + o), x1 = tl >= 1 ? *(const u32x4*)(fa + o - DFF) : z, x0 = tl >= 2 ? *(const u32x4*)(fa + o - 2 * DFF) : z, uu = *(const u32x4*)(fu + o);
        const f32x4 w0a = *(const f32x4*)(cw + c8), w0b = *(const f32x4*)(cw + c8 + 4), w1a = *(const f32x4*)(cw + DFF + c8), w1b = *(const f32x4*)(cw + DFF + c8 + 4), w2a = *(const f32x4*)(cw + 2 * DFF + c8), w2b = *(const f32x4*)(cw + 2 * DFF + c8 + 4);
        const f32x4 ba = *(const f32x4*)(cb + c8), bb = *(const f32x4*)(cb + c8 + 4);
        float r[8];
#define FM1(k, B0, W0, W1, W2, X0, X1, X2, Uv, F) r[k] = gelu_t(B0 + W0 * F(X0) + W1 * F(X1) + W2 * F(X2)) * F(Uv)
        FM1(0, ba.x, w0a.x, w1a.x, w2a.x, x0.x, x1.x, x2.x, uu.x, bflo); FM1(1, ba.y, w0a.y, w1a.y, w2a.y, x0.x, x1.x, x2.x, uu.x, bfhi);
        FM1(2, ba.z, w0a.z, w1a.z, w2a.z, x0.y, x1.y, x2.y, uu.y, bflo); FM1(3, ba.w, w0a.w, w1a.w, w2a.w, x0.y, x1.y, x2.y, uu.y, bfhi);
        FM1(4, bb.x, w0b.x, w1b.x, w2b.x, x0.z, x1.z, x2.z, uu.z, bflo); FM1(5, bb.y, w0b.y, w1b.y, w2b.y, x0.z, x1.z, x2.z, uu.z, bfhi);
        FM1(6, bb.z, w0b.z, w1b.z, w2b.z, x0.w, x1.w, x2.w, uu.w, bflo); FM1(7, bb.w, w0b.w, w1b.w, w2b.w, x0.w, x1.w, x2.w, uu.w, bfhi);
#undef FM1
        u32x4 ov; ov.x = pk2(r[0], r[1]); ov.y = pk2(r[2], r[3]); ov.z = pk2(r[4], r[5]); ov.w = pk2(r[6], r[7]);
        if (!dry) *(u32x4*)(fu + o) = ov; else asm volatile("" :: "v"(ov));
    }
}

typedef short s16x4 __attribute__((ext_vector_type(4)));
DEV s16x4 vtr(const LAS unsigned char* p) { return __builtin_bit_cast(s16x4, __builtin_amdgcn_ds_read_tr16_b64_v4i16((LAS s16x4*)p)); }
DEV bf16x8 cat8(const s16x4 a, const s16x4 b) { return (bf16x8){a[0], a[1], a[2], a[3], b[0], b[1], b[2], b[3]}; }
DEV bf16x8 pk8(float a0, float a1, float a2, float a3, float a4, float a5, float a6, float a7) {
    u32x4 w; w.x = pk2(a0, a1); w.y = pk2(a2, a3); w.z = pk2(a4, a5); w.w = pk2(a6, a7); return __builtin_bit_cast(bf16x8, w); }
constexpr int VPITCH = 192;
DEV void pv_tile(f32x16& o0, f32x16& o1, const LAS unsigned char* vt, int lane, const bf16x8 (&pk)[4]) {
    const int hi = lane >> 5;
    const LAS unsigned char* vb = vt + (4 * hi + ((lane & 15) >> 2)) * VPITCH + ((lane >> 4) & 1) * 32 + (lane & 3) * 8;
    bf16x8 va[4];
#pragma unroll
    for (int ks = 0; ks < 4; ++ks) va[ks] = cat8(vtr(vb + (16 * ks) * VPITCH), vtr(vb + (16 * ks + 8) * VPITCH));
    asm volatile("" : "+v"(va[0]), "+v"(va[1]), "+v"(va[2]), "+v"(va[3]));
#pragma unroll
    for (int ks = 0; ks < 4; ++ks) o0 = __builtin_amdgcn_mfma_f32_32x32x16_bf16(va[ks], pk[ks], o0, 0, 0, 0);
#pragma unroll
    for (int ks = 0; ks < 4; ++ks) va[ks] = cat8(vtr(vb + (16 * ks) * VPITCH + 64), vtr(vb + (16 * ks + 8) * VPITCH + 64));
    asm volatile("" : "+v"(va[0]), "+v"(va[1]), "+v"(va[2]), "+v"(va[3]));
#pragma unroll
    for (int ks = 0; ks < 4; ++ks) o1 = __builtin_amdgcn_mfma_f32_32x32x16_bf16(va[ks], pk[ks], o1, 0, 0, 0);
}
DEV void store_ot(bf16_t* orow, const f32x16& o0, const f32x16& o1, int hi, float sc) {
#pragma unroll
    for (int g4 = 0; g4 < 4; ++g4) {
        u32x2 a; a.x = pk2(o0[4 * g4] * sc, o0[4 * g4 + 1] * sc); a.y = pk2(o0[4 * g4 + 2] * sc, o0[4 * g4 + 3] * sc);
        u32x2 b; b.x = pk2(o1[4 * g4] * sc, o1[4 * g4 + 1] * sc); b.y = pk2(o1[4 * g4 + 2] * sc, o1[4 * g4 + 3] * sc);
        *(u32x2*)(orow + 8 * g4 + 4 * hi) = a; *(u32x2*)(orow + 32 + 8 * g4 + 4 * hi) = b;
    }
}

DEV void sb_item(LAS unsigned char* vl, const bf16_t* Q, const bf16_t* Kk, const bf16_t* V, bf16_t* O, int b, int h, int qb, int lane, bool dry) {
    const int r32 = lane & 31, hi = lane >> 5, t0 = 32 * qb, t = t0 + r32; const size_t rowb = (size_t)b * S;
    bf16x8 qr[4]; { const bf16_t* qp = Q + (rowb + t0 + r32) * 512 + h * 64 + 8 * hi;
#pragma unroll
        for (int d0 = 0; d0 < 4; ++d0) qr[d0] = *(const bf16x8*)(qp + 16 * d0); }
    f32x16 o0, o1;
#pragma unroll
    for (int r = 0; r < 16; ++r) { o0[r] = 0.f; o1[r] = 0.f; }
    float carry = 1.f;
    const int c_hi = (t0 + 30) >> 6;
#pragma unroll 1
    for (int c = c_hi; c >= 0; --c) {
        const bf16_t* kp = Kk + (rowb + 64 * c + r32) * 512 + h * 64 + 8 * hi;
        bf16x8 k0[4], k1[4];
#pragma unroll
        for (int d0 = 0; d0 < 4; ++d0) { k0[d0] = *(const bf16x8*)(kp + 16 * d0); k1[d0] = *(const bf16x8*)(kp + (size_t)32 * 512 + 16 * d0); }
#pragma unroll
        for (int j = 0; j < 8; ++j) { const int row = (lane >> 3) + 8 * j; *(LAS u32x4*)(vl + row * VPITCH + (lane & 7) * 16) = *(const u32x4*)(V + (rowb + 64 * c + row) * 512 + h * 64 + (lane & 7) * 8); }
        f32x16 p0, p1;
#pragma unroll
        for (int r = 0; r < 16; ++r) { p0[r] = 0.f; p1[r] = 0.f; }
#pragma unroll
        for (int d0 = 0; d0 < 4; ++d0) { p0 = __builtin_amdgcn_mfma_f32_32x32x16_bf16(k0[d0], qr[d0], p0, 0, 0, 0); p1 = __builtin_amdgcn_mfma_f32_32x32x16_bf16(k1[d0], qr[d0], p1, 0, 0, 0); }
        float u[32];
        const bool diag = (c == c_hi);
#pragma unroll
        for (int e = 0; e < 32; ++e) {
            const float z = e < 16 ? p0[e] : p1[e - 16];
            float uu = __builtin_amdgcn_rcpf(1.f + __builtin_amdgcn_exp2f(fminf(z, 126.f)));
            if (diag) { const int kv = 64 * c + 8 * ((e >> 2) & 3) + 4 * hi + (e & 3) + 32 * (e >> 4); if (kv >= t) uu = 1.f; }
            u[e] = uu;
        }
        float gl[8], gh[8];
#pragma unroll
        for (int i = 0; i < 8; ++i) { const float gp = (u[4 * i] * u[4 * i + 1]) * (u[4 * i + 2] * u[4 * i + 3]);
            const auto rr = __builtin_amdgcn_permlane32_swap(__float_as_uint(gp), __float_as_uint(gp), false, false); gl[i] = __uint_as_float(rr[0]); gh[i] = __uint_as_float(rr[1]); }
        float ag[8]; float run = carry;
#pragma unroll
        for (int i = 7; i >= 0; --i) { const float a_hi = run; run *= gh[i]; const float a_lo = run; run *= gl[i]; ag[i] = hi ? a_hi : a_lo; }
        carry = run;
        bf16x8 pk[4];
#pragma unroll
        for (int ks = 0; ks < 4; ++ks) { float w[8];
#pragma unroll
            for (int g = 0; g < 2; ++g) { const int i = 2 * ks + g;
                const float a3 = ag[i], a2 = a3 * u[4 * i + 3], a1 = a2 * u[4 * i + 2], a0 = a1 * u[4 * i + 1];
                w[4 * g] = (1.f - u[4 * i]) * a0; w[4 * g + 1] = (1.f - u[4 * i + 1]) * a1; w[4 * g + 2] = (1.f - u[4 * i + 2]) * a2; w[4 * g + 3] = (1.f - u[4 * i + 3]) * a3; }
            pk[ks] = pk8(w[0], w[1], w[2], w[3], w[4], w[5], w[6], w[7]); }
        pv_tile(o0, o1, vl, lane, pk);
        if (__all(carry < 7.8e-31f)) break;
    }
    if (!dry) store_ot(O + (rowb + t0 + r32) * 512 + h * 64, o0, o1, hi, 1.f); else asm volatile("" :: "v"(o0), "v"(o1));
}
DEV void sb_phase(const WaveId& W, LAS unsigned char* lds, unsigned char* ws, bool dry) {
    LAS unsigned char* vl = lds + W.wave * 12288;
    const bf16_t* Q = (const bf16_t*)(ws + WS_QA); const bf16_t* Kk = (const bf16_t*)(ws + WS_KA); const bf16_t* V = (const bf16_t*)(ws + WS_VA);
    constexpr int NITEM = NB * 8 * (S / 32);
    for (int it = W.gw; it < NITEM; it += W.ngw) {
        const int qb = it & 255, h = (it >> 8) & 7, b = it >> 11;
        sb_item(vl, Q, Kk, V, (bf16_t*)(ws + WS_QA), b, h, qb, W.lane, dry);
    }
}

constexpr int IDX_CTL_OFF = 131072 + 1024;
DEV unsigned fkey2(float v) { const int u = (int)__float_as_uint(v); return (unsigned)(u ^ ((u >> 31) | (int)0x80000000)); }
DEV float relu1(float x) { return __builtin_amdgcn_fmed3f(x, 0.f, 3.0e38f); }
DEV void idx_prefetch(bf16x8 (&afr)[4], float (&w)[16], bf16x8 (&b0)[4], bf16x8 (&b1)[4], const bf16_t* IQ, const bf16_t* IK, const float* IWp, int b, int t0, int wid, int lane) {
    const int r32 = lane & 31, hh = lane >> 5; const size_t rowb = (size_t)b * S;
    { const int qi = 2 * (r32 >> 4) + ((r32 >> 2) & 1), head = (r32 & 3) + 4 * ((r32 >> 3) & 1);
        const bf16_t* ap = IQ + (rowb + t0 + qi) * 512 + head * 64 + 8 * hh;
#pragma unroll
        for (int ks = 0; ks < 4; ++ks) afr[ks] = *(const bf16x8*)(ap + 16 * ks); }
#pragma unroll
    for (int r = 0; r < 16; ++r) w[r] = IWp[(rowb + t0 + 2 * (r >> 3) + hh) * 8 + (r & 7)];
    const int jmax = (t0 + 3) >> 5;
    { const int j0 = wid < jmax ? wid : jmax, j1 = wid + 8 < jmax ? wid + 8 : jmax;
      const bf16_t* p0 = IK + ((rowb >> 5) + j0) * 2048 + (hh * 32 + r32) * 8; const bf16_t* p1 = IK + ((rowb >> 5) + j1) * 2048 + (hh * 32 + r32) * 8;
#pragma unroll
      for (int ks = 0; ks < 4; ++ks) { b0[ks] = *(const bf16x8*)(p0 + ks * 512); b1[ks] = *(const bf16x8*)(p1 + ks * 512); } }
}
DEV void idx_unit(LAS unsigned char* lds, const bf16_t* IQ, const bf16_t* IK, const float* IWp, unsigned* BM, int b, int t0, int nb, int nt0, int wid, int lane,
                  bf16x8 (&afr)[4], float (&w)[16], bf16x8 (&b0)[4], bf16x8 (&b1)[4]) {
    const int r32 = lane & 31, hh = lane >> 5; const size_t rowb = (size_t)b * S;
    const int tmax = t0 + 3, jmax = tmax >> 5;
    LAS unsigned* SCO = (LAS unsigned*)lds;
    bf16x8 b2[4];
#pragma unroll
    for (int ks = 0; ks < 4; ++ks) b2[ks] = afr[ks];
#define IDX_LOADB(dst, jj) do { const int jc_ = (jj) < jmax ? (jj) : jmax; const bf16_t* bp_ = IK + ((rowb >> 5) + jc_) * 2048 + (hh * 32 + r32) * 8; \
        _Pragma("unroll") for (int ks = 0; ks < 4; ++ks) dst[ks] = *(const bf16x8*)(bp_ + ks * 512); } while (0)
#define IDX_COMP(src, jj) do { f32x16 acc; _Pragma("unroll") for (int r = 0; r < 16; ++r) acc[r] = 0.f; \
        _Pragma("unroll") for (int ks = 0; ks < 4; ++ks) acc = __builtin_amdgcn_mfma_f32_32x32x16_bf16(afr[ks], src[ks], acc, 0, 0, 0); \
        float s0 = 0.f, s1 = 0.f; _Pragma("unroll") for (int hd = 0; hd < 8; ++hd) { s0 += w[hd] * relu1(acc[hd]); s1 += w[8 + hd] * relu1(acc[8 + hd]); } \
        unsigned k0_ = fkey2(s0), k1_ = fkey2(s1); const int key = 32 * (jj) + r32; \
        if ((jj) >= jmax) { k0_ = key <= t0 + hh ? k0_ : 0u; k1_ = key <= t0 + 2 + hh ? k1_ : 0u; }     \
        if ((jj) <= jmax) { SCO[hh * 8192 + key] = k0_; SCO[(2 + hh) * 8192 + key] = k1_; } } while (0)
#ifndef IDX_REP_MFMA
#define IDX_REP_MFMA 1
#endif
#ifndef IDX_REP_SEL
#define IDX_REP_SEL 1
#endif
#ifdef IDX_DRY_COMPUTE
#pragma unroll 1
    for (int j = wid; j <= jmax; j += 24) { IDX_COMP(b0, j); asm volatile("" : "+v"(b0[0]), "+v"(b1[0]), "+v"(b2[0])); IDX_COMP(b1, j + 8); IDX_COMP(b2, j + 16); }
#endif
#pragma unroll 1
    for (int rpm = 0; rpm < IDX_REP_MFMA; ++rpm) {
#pragma unroll 1
    for (int j = wid; j <= jmax; j += 24) {
        IDX_LOADB(b2, j + 16); IDX_COMP(b0, j);
        IDX_LOADB(b0, j + 24); IDX_COMP(b1, j + 8);
        IDX_LOADB(b1, j + 32); IDX_COMP(b2, j + 16);
    }
    }
#undef IDX_LOADB
#undef IDX_COMP
    if (nt0 >= 0) idx_prefetch(afr, w, b0, b1, IQ, IK, IWp, nb, nt0, wid, lane);
    LAS unsigned* thr = (LAS unsigned*)(lds + IDX_CTL_OFF);
    if (wid == 0 && lane < 32) ((LAS unsigned*)(lds + IDX_CTL_OFF + 64))[lane] = 0u;
    LDS_WAIT(); __builtin_amdgcn_s_barrier(); asm volatile("" ::: "memory");
    {
        const int q = wid & 3, h = wid >> 2, n = t0 + q + 1;
        volatile LAS unsigned* xme = (volatile LAS unsigned*)(lds + IDX_CTL_OFF + 64) + (q * 2 + h) * 4;
        volatile LAS unsigned* xpa = (volatile LAS unsigned*)(lds + IDX_CTL_OFF + 64) + (q * 2 + (h ^ 1)) * 4;
        unsigned T_ = 1u;
        if (n > 256) {
            LAS unsigned* row = SCO + q * 8192 + lane;
            unsigned r[64];
            const int nil = (jmax >> 1) >= h ? (((jmax >> 1) - h) >> 1) + 1 : 0;
#define IDX_FOR_LIVE(BODY) _Pragma("unroll") for (int g8_ = 0; g8_ < 8; ++g8_) if (8 * g8_ < nil) { _Pragma("unroll") for (int u8_ = 0; u8_ < 8; ++u8_) { const int il = 8 * g8_ + u8_; BODY } }
            IDX_FOR_LIVE( r[il] = (2 * (2 * il + h) + hh <= jmax) ? row[64 * (2 * il + h)] : 0u; )
            unsigned seq = 0u;
#define IDX_XCHG(val, out) do { ++seq; const int pb_ = (seq & 1u) * 2; if (lane == 0) { xme[pb_ + 1] = (val); xme[pb_] = seq; } \
                while (xpa[pb_] != seq) __builtin_amdgcn_s_sleep(0); (out) = xpa[pb_ + 1]; } while (0)
#define IDX_XCHG16(val, out) do { ++seq; const int pb_ = (seq & 1u) * 2; if (lane == 0) xme[pb_] = (seq << 16) | (val); unsigned w_; \
                while (((w_ = xpa[pb_]) >> 16) != (seq & 0xffffu)) __builtin_amdgcn_s_sleep(0); (out) = w_ & 0xffffu; } while (0)
#pragma unroll 1
            for (int rps = 0; rps < IDX_REP_SEL; ++rps) {
            unsigned mx = 0u;
            IDX_FOR_LIVE( mx = max(mx, r[il]); )
#pragma unroll
            for (int o = 1; o < 64; o <<= 1) mx = max(mx, (unsigned)__shfl_xor((int)mx, o));
            { unsigned pm_; IDX_XCHG(mx, pm_); mx = max(mx, pm_); }
            unsigned lo_ = 1u, hi_ = mx + 1u, chi_ = 0u, xgt_ = 1u, xeq_ = 0u, mt_ = 0u; float glo_ = __log2f((float)n) - 8.f, ghi_ = -9.f; int side_ = 0; bool done_ = false;
#pragma unroll 1
            for (int pass = 0; pass < 2 && !done_; ++pass) {
                const unsigned wdt = hi_ - lo_;
                unsigned off;
                if (pass < 2) {
                    const unsigned mkey = hi_ - 1u; const unsigned tgt = pass == 0 ? mkey - (1u << 23) : mkey - (3u << 23);
                    const bool ok = pass == 0 ? (mkey > 0x81000000u) : (mkey > 0x82000000u && tgt > lo_ && tgt < hi_);
                    off = ok ? tgt - lo_ : wdt >> 1;
                } else if ((pass & 3) == 3) off = wdt >> 1;
                else off = (unsigned)(glo_ * __builtin_amdgcn_rcpf(glo_ - ghi_) * (float)wdt);
                off = off < 1u ? 1u : (off > wdt - 1u ? wdt - 1u : off);
                const unsigned cand = (unsigned)__builtin_amdgcn_readfirstlane((int)(lo_ + off));
                unsigned ca_ = 0, cb_ = 0; const unsigned candv = lo_ + off;
#define IDX_CNT4(A, B, C, Dd) asm volatile("v_cmp_ge_u32_e64 s[88:89], %2, %6\n\tv_cmp_ge_u32_e64 s[90:91], %3, %6\n\tv_cmp_ge_u32_e64 s[92:93], %4, %6\n\tv_cmp_ge_u32_e64 s[94:95], %5, %6\n\t" \
                    "v_addc_co_u32_e64 %0, s[88:89], %0, 0, s[88:89]\n\tv_addc_co_u32_e64 %1, s[90:91], %1, 0, s[90:91]\n\tv_addc_co_u32_e64 %0, s[92:93], %0, 0, s[92:93]\n\tv_addc_co_u32_e64 %1, s[94:95], %1, 0, s[94:95]" \
                    : "+v"(ca_), "+v"(cb_) : "v"(A), "v"(B), "v"(C), "v"(Dd), "v"(candv) : "s88", "s89", "s90", "s91", "s92", "s93", "s94", "s95")
#pragma unroll
                for (int g8_ = 0; g8_ < 8; ++g8_) if (8 * g8_ < nil) { IDX_CNT4(r[8 * g8_], r[8 * g8_ + 1], r[8 * g8_ + 2], r[8 * g8_ + 3]); IDX_CNT4(r[8 * g8_ + 4], r[8 * g8_ + 5], r[8 * g8_ + 6], r[8 * g8_ + 7]); }
#undef IDX_CNT4
                int pk = (int)(ca_ + cb_);
                pk += __builtin_amdgcn_update_dpp(0, pk, 0x111, 0xf, 0xf, false);
                pk += __builtin_amdgcn_update_dpp(0, pk, 0x112, 0xf, 0xf, false);
                pk += __builtin_amdgcn_update_dpp(0, pk, 0x114, 0xf, 0xf, false);
                pk += __builtin_amdgcn_update_dpp(0, pk, 0x118, 0xf, 0xf, false);
                pk += __builtin_amdgcn_update_dpp(0, pk, 0x142, 0xa, 0xf, false);
                unsigned tot = (unsigned)__builtin_amdgcn_readlane(pk, 31) + (unsigned)__builtin_amdgcn_readlane(pk, 63);
                { unsigned pt_; IDX_XCHG16(tot, pt_); tot += pt_; }
                const float gc = __log2f(fmaxf((float)tot, 0.5f)) - 8.f;
                if (tot == 256u) { xgt_ = cand; mt_ = 0u; done_ = true; }
                else { if (tot > 256u) { if (side_ == 1) ghi_ *= 0.5f; lo_ = cand; glo_ = gc; side_ = 1; }
                       else { if (side_ == 2) glo_ *= 0.5f; hi_ = cand; ghi_ = gc; chi_ = tot; side_ = 2; }
                       if (hi_ - lo_ == 1u) { xgt_ = hi_; xeq_ = lo_; mt_ = 256u - chi_; done_ = true; } }
            }
            { LAS unsigned* hist = (LAS unsigned*)(lds + IDX_CTL_OFF + 1024) + q * 256;
#pragma unroll 1
              for (int round = 0; round < 6 && !done_; ++round) {
                const unsigned wdt = hi_ - lo_;
                const int sh = wdt <= 256u ? 0 : 24 - (int)__builtin_clz(wdt - 1u);
                hist[128 * h + lane] = 0u; hist[128 * h + 64 + lane] = 0u;
                LDS_WAIT(); { unsigned d_; IDX_XCHG16(0u, d_); (void)d_; }
                const unsigned lov = lo_;
                IDX_FOR_LIVE( const unsigned d = r[il] - lov; if (d < wdt) __hip_atomic_fetch_add(hist + (d >> sh), 1u, __ATOMIC_RELAXED, __HIP_MEMORY_SCOPE_WORKGROUP); )
                LDS_WAIT(); { unsigned d_; IDX_XCHG16(0u, d_); (void)d_; }
                const u32x4 hb = *(const LAS u32x4*)(hist + 4 * lane);
                const unsigned s4 = (hb.x + hb.y) + (hb.z + hb.w);
                unsigned suf = s4;
#pragma unroll
                for (int o = 1; o < 64; o <<= 1) { const unsigned tv = (unsigned)__shfl_down((int)suf, o); if (lane + o < 64) suf += tv; }
                const unsigned long long okm = __ballot(chi_ + suf >= 256u);
                const int L = 63 - (int)__builtin_clzll(okm);
                const unsigned above = chi_ + (unsigned)__builtin_amdgcn_readlane((int)(suf - s4), L);
                const unsigned h0 = (unsigned)__builtin_amdgcn_readlane((int)hb.x, L), h1 = (unsigned)__builtin_amdgcn_readlane((int)hb.y, L),
                               h2 = (unsigned)__builtin_amdgcn_readlane((int)hb.z, L), h3 = (unsigned)__builtin_amdgcn_readlane((int)hb.w, L);
                unsigned Bsel, cab, cnb;
                if (above + h3 >= 256u) { Bsel = 3u; cab = above; cnb = h3; }
                else if (above + h3 + h2 >= 256u) { Bsel = 2u; cab = above + h3; cnb = h2; }
                else if (above + h3 + h2 + h1 >= 256u) { Bsel = 1u; cab = above + h3 + h2; cnb = h1; }
                else { Bsel = 0u; cab = above + h3 + h2 + h1; cnb = h0; }
                Bsel += 4u * (unsigned)L;
                const unsigned nlo = lo_ + (Bsel << sh); unsigned nhi = nlo + (1u << sh); if (nhi > hi_ || nhi < nlo) nhi = hi_;
                if (cab + cnb == 256u) { xgt_ = nlo; mt_ = 0u; done_ = true; }
                else if (sh == 0) { xgt_ = nlo + 1u; xeq_ = nlo; mt_ = 256u - cab; done_ = true; }
                else { lo_ = nlo; hi_ = nhi; chi_ = cab; }
              } }
#ifdef IDX_XTRA
#pragma unroll 1
            for (int xr = 0; xr < IDX_XTRA; ++xr) { unsigned dsum = 0; const unsigned cv = xgt_ + (unsigned)xr;
                IDX_FOR_LIVE( dsum += r[il] >= cv; )
                int pk = (int)dsum;
                pk += __builtin_amdgcn_update_dpp(0, pk, 0x111, 0xf, 0xf, false); pk += __builtin_amdgcn_update_dpp(0, pk, 0x112, 0xf, 0xf, false); pk += __builtin_amdgcn_update_dpp(0, pk, 0x114, 0xf, 0xf, false);
                pk += __builtin_amdgcn_update_dpp(0, pk, 0x118, 0xf, 0xf, false); pk += __builtin_amdgcn_update_dpp(0, pk, 0x142, 0xa, 0xf, false);
                unsigned tot = (unsigned)__builtin_amdgcn_readlane(pk, 31) + (unsigned)__builtin_amdgcn_readlane(pk, 63);
                { unsigned pt_; IDX_XCHG16(tot, pt_); tot += pt_; } asm volatile("" :: "s"(tot)); }
#endif
            T_ = xgt_;
            if (mt_ != 0u) {
                if (h == 0) { unsigned run = 0u;
#pragma unroll 1
                    for (int i = 0; i <= (jmax >> 1); ++i) { const bool ok_ = 2 * i + hh <= jmax; const unsigned kv = ok_ ? row[64 * i] : 0u; const bool eq = kv == xeq_; const unsigned long long bm = __ballot(eq);
                        const unsigned rank = run + __builtin_amdgcn_mbcnt_hi((unsigned)(bm >> 32), __builtin_amdgcn_mbcnt_lo((unsigned)bm, 0u));
                        if (eq && rank >= mt_) row[64 * i] = 0u;
                        run += (unsigned)__popcll(bm); } }
                T_ = xeq_;
            }
            }
#undef IDX_XCHG
#undef IDX_XCHG16
#undef IDX_FOR_LIVE
        }
        if (lane == 0 && h == 0) thr[q] = T_;
    }
#ifdef PROBE_VALU
    { float a0 = (float)lane, a1 = a0 + 1.f, a2 = a0 + 2.f, a3 = a0 + 3.f, a4 = a0 + 4.f, a5 = a0 + 5.f, a6 = a0 + 6.f, a7 = a0 + 7.f; const float m = 1.0000001f, c = 1e-9f;
#pragma unroll 1
      for (int it = 0; it < 64; ++it) {
#pragma unroll
          for (int u = 0; u < 8; ++u) { a0 = a0 * m + c; a1 = a1 * m + c; a2 = a2 * m + c; a3 = a3 * m + c; a4 = a4 * m + c; a5 = a5 * m + c; a6 = a6 * m + c; a7 = a7 * m + c; } }
      asm volatile("" :: "v"(a0), "v"(a1), "v"(a2), "v"(a3), "v"(a4), "v"(a5), "v"(a6), "v"(a7)); }
#endif
    LDS_WAIT(); __builtin_amdgcn_s_barrier(); asm volatile("" ::: "memory");
    { const unsigned tq0 = thr[hh], tq1 = thr[2 + hh];
#pragma unroll 4
      for (int j = wid; j <= ((t0 | 63) >> 5); j += 8) {
          bool s0 = false, s1 = false;
          if (j <= jmax) { s0 = SCO[hh * 8192 + 32 * j + r32] >= tq0; s1 = SCO[(2 + hh) * 8192 + 32 * j + r32] >= tq1; }
          const unsigned long long b0_ = __ballot(s0), b1_ = __ballot(s1);
          if (lane == 0) { u32x4 o; o.x = (unsigned)b0_; o.y = (unsigned)(b0_ >> 32); o.z = (unsigned)b1_; o.w = (unsigned)(b1_ >> 32); *(u32x4*)(BM + ((size_t)b * 256 + j) * S + t0) = o; }
      } }
    LDS_WAIT(); __builtin_amdgcn_s_barrier();
}
DEV void idx_phase(LAS unsigned char* lds, unsigned char* ws, int vcu, int G, int wid, int lane) {
    constexpr int NUNIT = T / 4;
    const bf16_t* IQ = (const bf16_t*)(ws + WS_IQ); const bf16_t* IK = (const bf16_t*)(ws + WS_IK); const float* IW = (const float*)(ws + WS_IW);
#define IDX_UNIT_OF(k) ((k) * G + (((k) & 1) ? G - 1 - vcu : vcu))
    bf16x8 afr[4], b0[4], b1[4]; float w[16];
    int un = IDX_UNIT_OF(0);
    if (un < NUNIT) { const int b = un / (S / 4); idx_prefetch(afr, w, b0, b1, IQ, IK, IW, b, (un - b * (S / 4)) * 4, wid, lane); }
#pragma unroll 1
    for (int k = 0; un < NUNIT; ++k) {
        const int b = un / (S / 4), t0 = (un - b * (S / 4)) * 4;
        const int nun = IDX_UNIT_OF(k + 1); const int nb = nun / (S / 4), nt0 = nun < NUNIT ? (nun - nb * (S / 4)) * 4 : -1;
        idx_unit(lds, IQ, IK, IW, (unsigned*)(ws + WS_BM), b, t0, nb, nt0, wid, lane, afr, w, b0, b1);
        un = nun;
    }
#undef IDX_UNIT_OF
}

DEV void kn_phase(const WaveId& W, const bf16_t* Kk, float* KN) {
    for (int item = W.gw; item < NB * 8 * (S / 64); item += W.ngw) {
        const int b = item / (8 * (S / 64)), h = (item / (S / 64)) & 7, tile = item % (S / 64);
        const bf16_t* kp = Kk + ((size_t)b * S + tile * 64 + W.lane) * 512 + h * 64;
        float ss = 0.f;
#pragma unroll
        for (int c = 0; c < 8; ++c) { const u32x4 v = *(const u32x4*)(kp + 8 * c);
#pragma unroll
            for (int e = 0; e < 4; ++e) { const float lo = __uint_as_float(v[e] << 16), hi = __uint_as_float(v[e] & 0xffff0000u); ss += lo * lo + hi * hi; } }
        const float m = wave_max(ss);
        if (W.lane == 0) KN[item] = sqrtf(m) * 1.01f;
    }
}

constexpr int DSA_STAGE = 8192 + 64 * VPITCH;
DEV void dsa_unit(LAS unsigned char* lds, const bf16_t* Q, const bf16_t* Kk, const bf16_t* V, const unsigned* BM, const float* KN, bf16_t* O, int b, int h, int qblk, int tid, int wid, int lane) {
    const int r32 = lane & 31, hi = lane >> 5, q0 = 256 * qblk, t0 = q0 + 32 * wid, t = t0 + r32; const size_t rowb = (size_t)b * S;
    bf16x8 qr[4]; { const bf16_t* qp = Q + (rowb + t) * 512 + h * 64 + 8 * hi;
#pragma unroll
        for (int d0 = 0; d0 < 4; ++d0) qr[d0] = *(const bf16x8*)(qp + 16 * d0); }
    f32x16 o0, o1, negm;
#pragma unroll
    for (int r = 0; r < 16; ++r) { o0[r] = 0.f; o1[r] = 0.f; negm[r] = 0.f; }
    float mref = 0.f, lsum = 0.f; bool seen = false;
    float qn; { float qs = 0.f;
#pragma unroll
        for (int d0 = 0; d0 < 4; ++d0)
#pragma unroll
            for (int e = 0; e < 8; ++e) { const float x = __uint_as_float(((unsigned)(unsigned short)qr[d0][e]) << 16); qs += x * x; }
        const auto rr = __builtin_amdgcn_permlane32_swap(__float_as_uint(qs), __float_as_uint(qs), false, false); qn = sqrtf(__uint_as_float(rr[0]) + __uint_as_float(rr[1])) * 1.01f; }
    constexpr float FASTB = 60.f;
    int zlane = 0; asm volatile("" : "+v"(zlane));
    const float* knp = KN + (b * 8 + h) * (S / 64) + zlane;
    float knv = knp[0];
    constexpr float THR = 8.f;
    const int ntile = (q0 + 256) / 64, wlast = (t0 + 31) >> 6;
    const int srow = tid >> 3, sch = tid & 7;
    const bf16_t* kg = Kk + (rowb + srow) * 512 + h * 64 + sch * 8; const bf16_t* vg = V + (rowb + srow) * 512 + h * 64 + sch * 8;
    const int kdst = srow * 128 + ((sch ^ (srow & 7)) * 16), vdst = srow * VPITCH + sch * 16;
    u32x4 kr0 = *(const u32x4*)kg, vr0 = *(const u32x4*)vg;
    *(LAS u32x4*)(lds + kdst) = kr0; *(LAS u32x4*)(lds + 8192 + vdst) = vr0;
    u32x4 kr1 = *(const u32x4*)(kg + (size_t)64 * 512), vr1 = *(const u32x4*)(vg + (size_t)64 * 512);
    const unsigned* bmp = BM + (size_t)b * 256 * S + t;
    unsigned mw0 = bmp[0], mw1 = bmp[(size_t)S];
    const int koff = r32 * 128;
    __syncthreads();
#define DSA_TILE(c, BUF, NBUF, KL, VL, KW, VW) do { \
        const LAS unsigned char* kt = lds + (BUF) * DSA_STAGE; const LAS unsigned char* vt = kt + 8192; \
        if ((c) + 2 < ntile) { KL = *(const u32x4*)(kg + (size_t)((c) + 2) * 64 * 512); VL = *(const u32x4*)(vg + (size_t)((c) + 2) * 64 * 512); } \
        unsigned nw0 = 0u, nw1 = 0u; float nkn = 0.f; \
        if ((c) + 1 <= wlast) { nw0 = bmp[(size_t)(2 * (c) + 2) * S]; nw1 = bmp[(size_t)(2 * (c) + 3) * S]; nkn = knp[(c) + 1]; } \
        if ((c) <= wlast) { \
            bf16x8 kf[8]; \
            _Pragma("unroll") for (int d0 = 0; d0 < 4; ++d0) { const int xo = ((2 * d0 + hi) ^ (r32 & 7)) * 16; \
                kf[2 * d0] = *(const LAS bf16x8*)(kt + koff + xo); kf[2 * d0 + 1] = *(const LAS bf16x8*)(kt + koff + 4096 + xo); } \
            asm volatile("" : "+v"(kf[0]), "+v"(kf[1]), "+v"(kf[2]), "+v"(kf[3]), "+v"(kf[4]), "+v"(kf[5]), "+v"(kf[6]), "+v"(kf[7]));     \
            f32x16 p0 = negm, p1 = negm; \
            _Pragma("unroll") for (int d0 = 0; d0 < 4; ++d0) { p0 = __builtin_amdgcn_mfma_f32_32x32x16_bf16(kf[2 * d0], qr[d0], p0, 0, 0, 0); p1 = __builtin_amdgcn_mfma_f32_32x32x16_bf16(kf[2 * d0 + 1], qr[d0], p1, 0, 0, 0); } \
            const unsigned m0 = mw0 >> (4 * hi), m1 = mw1 >> (4 * hi); \
            _Pragma("unroll") for (int r = 0; r < 16; ++r) { const int bit = (r & 3) + 8 * (r >> 2); \
                const unsigned e0 = (unsigned)__builtin_amdgcn_sbfe((int)m0, bit, 1), e1 = (unsigned)__builtin_amdgcn_sbfe((int)m1, bit, 1); \
                p0[r] = __uint_as_float((__float_as_uint(p0[r]) & e0) | (0xff800000u & ~e0)); p1[r] = __uint_as_float((__float_as_uint(p1[r]) & e1) | (0xff800000u & ~e1)); } \
            if (__any(!(qn * knv + fabsf(mref) <= FASTB))) {     \
                float rm = -INFINITY; \
                _Pragma("unroll") for (int r = 0; r < 16; r += 2) rm = fmaxf(rm, fmaxf(fmaxf(p0[r], p0[r + 1]), fmaxf(p1[r], p1[r + 1]))); \
                { const auto rr = __builtin_amdgcn_permlane32_swap(__float_as_uint(rm), __float_as_uint(rm), false, false); rm = fmaxf(__uint_as_float(rr[0]), __uint_as_float(rr[1])); } \
                const bool shift = rm > THR || (rm < -THR && rm > -INFINITY && !seen);     \
                if (__any(shift)) { \
                    const float dl = shift ? rm : 0.f, f = dl > 0.f ? __builtin_amdgcn_exp2f(-dl) : 1.f; \
                    mref += dl; lsum *= f; \
                    _Pragma("unroll") for (int r = 0; r < 16; ++r) { p0[r] -= dl; p1[r] -= dl; o0[r] *= f; o1[r] *= f; negm[r] = -mref; } \
                } \
            } \
            seen = seen || (mw0 | mw1) != 0u;     \
            float ps = 0.f; \
            _Pragma("unroll") for (int r = 0; r < 16; ++r) { p0[r] = __builtin_amdgcn_exp2f(p0[r]); p1[r] = __builtin_amdgcn_exp2f(p1[r]); ps += p0[r] + p1[r]; } \
            lsum += ps; \
            bf16x8 pk[4]; \
            pk[0] = pk8(p0[0], p0[1], p0[2], p0[3], p0[4], p0[5], p0[6], p0[7]); pk[1] = pk8(p0[8], p0[9], p0[10], p0[11], p0[12], p0[13], p0[14], p0[15]); \
            pk[2] = pk8(p1[0], p1[1], p1[2], p1[3], p1[4], p1[5], p1[6], p1[7]); pk[3] = pk8(p1[8], p1[9], p1[10], p1[11], p1[12], p1[13], p1[14], p1[15]); \
            pv_tile(o0, o1, vt, lane, pk); \
        } \
        mw0 = nw0; mw1 = nw1; knv = nkn; \
        if ((c) + 1 < ntile) { LAS unsigned char* nb = lds + (NBUF) * DSA_STAGE; *(LAS u32x4*)(nb + kdst) = KW; *(LAS u32x4*)(nb + 8192 + vdst) = VW; } \
        asm volatile("s_waitcnt lgkmcnt(0)" ::: "memory"); __builtin_amdgcn_s_barrier(); asm volatile("" ::: "memory"); } while (0)
#pragma unroll 1
    for (int c = 0; c < ntile; c += 2) { DSA_TILE(c, 0, 1, kr0, vr0, kr1, vr1); DSA_TILE(c + 1, 1, 0, kr1, vr1, kr0, vr0); }
#undef DSA_TILE
    { const auto rr = __builtin_amdgcn_permlane32_swap(__float_as_uint(lsum), __float_as_uint(lsum), false, false); lsum = __uint_as_float(rr[0]) + __uint_as_float(rr[1]); }
    store_ot(O + (rowb + t) * 512 + h * 64, o0, o1, hi, 1.f / lsum);
}
DEV void dsa_phase(LAS unsigned char* lds, unsigned char* ws, int vcu, int G, int tid, int wid, int lane, bf16_t* Oout) {
    constexpr int NPAIR = NB * 8 * 16;
    for (int pr = vcu; pr < NPAIR; pr += G) {
        const int bh = pr >> 4, s = pr & 15, b = bh >> 3, h = bh & 7;
#pragma unroll 1
        for (int k = 0; k < 2; ++k) {
            const int qblk = k == 0 ? s : 31 - s;
            dsa_unit(lds, (const bf16_t*)(ws + WS_QC), (const bf16_t*)(ws + WS_KC), (const bf16_t*)(ws + WS_VC), (const unsigned*)(ws + WS_BM), (const float*)(ws + WS_KN), Oout, b, h, qblk, tid, wid, lane);
        }
    }
}
constexpr int MK_THREADS = 512;
constexpr int RING_BYTES = 131072, MISC_OFF = RING_BYTES + 320, MK_LDS_BYTES = 147456;
constexpr size_t WS_CTL = 0, CTL_ZERO_BYTES = 65536 + 7 * 131072; constexpr int CW_BAR = 4096;
constexpr int PH_PREP0 = 0, PH_KV = 1, PH_GH = 2, PH_L0 = 3, PH_PER_LAYER = 14, NPH = PH_L0 + 2 * PH_PER_LAYER;
enum { Q_INPROJ = 0, Q_SBIDX, Q_DSA, Q_GATES, Q_MERGE, Q_MIX, Q_NORMXA, Q_XALOG, Q_XAOUT, Q_NORMFFN, Q_UP, Q_FFNMID, Q_DOWN, Q_NEXT };

#ifndef QBUILD
#define QBUILD 0xffffu
#endif
#define QON(x) ((QBUILD >> (x)) & 1u)
struct Args { const float* in[20]; float* out; unsigned char* ws; int ph_lo, ph_hi; };

__global__ void __launch_bounds__(MK_THREADS, 2) mk_fwd(Args args) {
    __shared__ __attribute__((aligned(16))) unsigned char lds_raw[MK_LDS_BYTES];
    LAS unsigned char* lds = (LAS unsigned char*)lds_raw;
    volatile LAS unsigned* MISC = (volatile LAS unsigned*)(lds + MISC_OFF);
    const int G = gridDim.x, bx = blockIdx.x;
    unsigned char* ws0 = args.ws;
    const int wave_s = __builtin_amdgcn_readfirstlane((int)threadIdx.x >> 6);
    for (int u = mk_tid(wave_s); u < (MK_LDS_BYTES - RING_BYTES) / 4; u += MK_THREADS) ((LAS unsigned*)(lds + RING_BYTES))[u] = 0u;
    __syncthreads();
    const int lo = args.ph_lo, hi = args.ph_hi;
    XcdBarrier bar; bar.bar = (unsigned*)(ws0 + WS_CTL) + CW_BAR; bar.x = 0; bar.st = nullptr;
    if (hi - lo > 1) bar = xcd_barrier_post((unsigned*)(ws0 + WS_CTL) + CW_BAR, MISC + 8, mk_tid(wave_s));
#define BPW(off) ((bf16_t*)(ws + (off)))
    const int vcu = (G % 8 == 0) ? (bx % 8) * (G / 8) + bx / 8 : bx;
    for (int p = lo; p < hi; ++p) {
#ifdef PROBE_REP
        const int reps = (p >= PH_L0 && ((PROBE_REP >> ((p - PH_L0) % PH_PER_LAYER)) & 1)) ? 2 : 1;
#else
        const int reps = 1;
#endif
#ifdef PROBE_REP
#pragma unroll 1
        for (int rep = 0; rep < reps; ++rep) {
        const bool dry = rep + 1 < reps;
#else
        { constexpr bool dry = false;
#endif
        int oz = 0; asm volatile("" : "+s"(oz));
        int tid = mk_tid(wave_s); asm volatile("" : "+v"(tid));
        const int wave = __builtin_amdgcn_readfirstlane(tid >> 6), lane = tid & 63;
        WaveId W; W.gw = vcu * 8 + wave; W.ngw = G * 8; W.wave = wave; W.lane = lane;
        unsigned char* ws = args.ws + oz; float* X = args.out + oz;
#define INP(k) (args.in[(k) + oz])
        if (p == PH_PREP0) {
            prep0_phase(W, (LAS float*)(lds + wave * 16384), ws, args.in + oz, (bf16_t*)X);
        } else if (p == PH_KV && QON(14)) {
            pg8::Order S; S.init(2, 8, 2, G, bx);
            pg8::PtrStd P{(const char*)(ws + WS_MEMN), (const char*)(ws + WS_WKVT), 1 * MiB, 4 * MiB, 0, (size_t)256 * D * 2, (size_t)256 * D * 2};
            pg8::EpiPrep E{ws, 0};
            pg8::gemm_phase<pg8::EpiPrep, pg8::PtrStd, true, true>(lds, tid, D, D, D, S, P, E);
        } else if (p == PH_GH && QON(15)) {
            { pg8::Order S; S.init(1, 4, 16, G, bx); pg8::PtrG P{(const char*)(ws + WS_KVM), (const char*)(ws + WS_WQ)}; pg8::EpiPrep E{ws, 1};
              pg8::gemm_phase<pg8::EpiPrep, pg8::PtrG, true, true>(lds, tid, 2 * D, D, 256, S, P, E); }
            { pg8::Order S; S.init(4, 1, 16, G, (bx + 64) % G); pg8::PtrH P{(const char*)(ws + WS_KVM), (const char*)(ws + WS_WOT)}; pg8::EpiPrep E{ws, 2};
              pg8::gemm_phase<pg8::EpiPrep, pg8::PtrH, true, true>(lds, tid, D, 2 * D, 256, S, P, E); }
        } else if (p >= PH_L0) {
            const int l = (p - PH_L0) / PH_PER_LAYER, q = (p - PH_L0) % PH_PER_LAYER;
            const float* Xin = l == 0 ? INP(0) : X;
            pg8::u64* SSb = (pg8::u64*)(ws + WS_SS);
#define SSA(i) (SSb + (size_t)(i) * T)
            if (q == Q_SBIDX) {
#ifndef NO_SB
                sb_phase(W, lds, ws, dry);
#endif
                __syncthreads();
#ifndef NO_IDX
#ifdef PROBE_SB_ONLY
                if (!dry)
#endif
                idx_phase(lds, ws, vcu, G, wave, lane);
#endif
                conv_sc_phase(vcu * MK_THREADS + tid, G * MK_THREADS, BPW(WS_SCB), BPW(WS_CX), INP(4) + l * 3 * 512, dry);
                kn_phase(W, BPW(WS_KC), (float*)(ws + WS_KN));
            } else if (q == Q_DSA) {
#ifndef NO_DSA
                dsa_phase(lds, ws, vcu, G, tid, wave, lane, dry ? BPW(WS_KA) : BPW(WS_QC));
#endif
            } else if (q == Q_FFNMID) {
                ffn_mid_phase(vcu * MK_THREADS + tid, G * MK_THREADS, BPW(WS_FA), BPW(WS_FU), INP(16) + l * 3 * DFF, INP(17) + l * DFF, dry);
            } else if (q == Q_NEXT) {
                if (l + 1 < DEPTH) { int base = 0; convert_layer_weights(W, (LAS float*)(lds + wave * 16384), base, ws, args.in + oz, l + 1); }
                else if (!dry) final_norm(W, BPW(WS_XN), X, INP(19), SSA(6));
            } else if (q == Q_INPROJ && QON(Q_INPROJ)) {
                pg8::Order S; S.init(T / 256, NIN / 256, 1, G, bx);
                pg8::PtrStd P{(const char*)X, (const char*)(ws + WS_WIN), 0, 0, 0, (size_t)256 * D * 2, (size_t)256 * D * 2};
                pg8::EpiInProj E{ws, SSA(3 * l)};
                pg8::gemm_phase<pg8::EpiInProj, pg8::PtrStd, true, true>(lds, tid, D, D, D, S, P, E);
            } else if (q == Q_GATES && QON(Q_GATES)) {
                pg8::Order S; S.init(T / 256, 12, 1, G, bx);
                pg8::PtrStd P{(const char*)X, (const char*)(ws + WS_WG), 0, 0, 0, (size_t)256 * D * 2, (size_t)256 * D * 2};
                pg8::EpiGates E{BPW(WS_GATES), SSA(3 * l)};
                pg8::gemm_phase<pg8::EpiGates, pg8::PtrStd, true, true>(lds, tid, D, D, D, S, P, E);
            } else if (q == Q_MERGE && QON(Q_MERGE)) {
                pg8::Order S; S.init(T / 256, 4, 3, G, bx);
                pg8::PtrStd P{(const char*)(ws + WS_QA), (const char*)(ws + WS_WBR), 16 * MiB, (size_t)D * 512 * 2, 0, (size_t)256 * 512 * 2, (size_t)256 * 512 * 2};
                pg8::EpiMerge E{BPW(WS_XN), BPW(WS_GATES)};
                pg8::gemm_phase<pg8::EpiMerge, pg8::PtrStd, true, true>(lds, tid, 512, 512, 512, S, P, E);
            } else if (q == Q_MIX && QON(Q_MIX)) {
                pg8::Order S; S.init(T / 256, 4, 1, G, bx);
                pg8::PtrStd P{(const char*)(ws + WS_XN), (const char*)(ws + WS_WMIX), 0, 0, 0, (size_t)256 * D * 2, (size_t)256 * D * 2};
                if (l == 0) { pg8::EpiResid<true> E{(const void*)INP(0), dry ? BPW(WS_FU) : BPW(WS_XBXA), dry ? SSA(0) : SSA(1)};
                    pg8::gemm_phase<pg8::EpiResid<true>, pg8::PtrStd, true, true>(lds, tid, D, D, D, S, P, E); }
                else { pg8::EpiResid<false> E{(const void*)X, dry ? BPW(WS_FU) : BPW(WS_XBXA), dry ? SSA(0) : SSA(4)};
                    pg8::gemm_phase<pg8::EpiResid<false>, pg8::PtrStd, true, true>(lds, tid, D, D, D, S, P, E); }

            } else if (q == Q_XALOG && QON(Q_XALOG)) {
                pg8::Order S; S.init(T / 256, 4, 1, G, bx);
                pg8::PtrStd P{(const char*)(ws + WS_XBXA), (const char*)(ws + WS_GT + (size_t)l * 4 * MiB), 0, 0, 2 * MiB, (size_t)256 * D * 2, (size_t)256 * D * 2};
                pg8::EpiSoftmax E{BPW(WS_PXA), SSA(1 + 3 * l)};
                pg8::gemm_phase<pg8::EpiSoftmax, pg8::PtrStd, false, true>(lds, tid, D, D, D, S, P, E);
            } else if (q == Q_XAOUT && QON(Q_XAOUT)) {
                pg8::Order S; S.init(T / 256, 4, 1, G, bx);
                pg8::PtrStd P{(const char*)(ws + WS_PXA), (const char*)(ws + WS_HT + (size_t)l * 4 * MiB), 0, 0, 2 * MiB, (size_t)256 * D * 2, (size_t)256 * D * 2};
                pg8::EpiResid<false> E{(const void*)BPW(WS_XBXA), dry ? BPW(WS_FU) : BPW(WS_XN), dry ? SSA(0) : SSA(2 + 3 * l)};
                pg8::gemm_phase<pg8::EpiResid<false>, pg8::PtrStd, true, true>(lds, tid, D, D, D, S, P, E);
            } else if (q == Q_UP && QON(Q_UP)) {
                pg8::Order S; S.init(T / 256, 22, 1, G, bx);
                pg8::PtrStd P{(const char*)(ws + WS_XN), (const char*)(ws + WS_WUP), 0, 0, 0, (size_t)256 * D * 2, (size_t)256 * D * 2};
                pg8::EpiUp E{BPW(WS_FA), BPW(WS_FU), SSA(2 + 3 * l)};
                pg8::gemm_phase<pg8::EpiUp, pg8::PtrStd, true, true>(lds, tid, D, D, D, S, P, E);
            } else if (q == Q_DOWN && QON(Q_DOWN)) {
                pg8::Order S; S.init(T / 256, 4, 1, G, bx);
                pg8::PtrStd P{(const char*)(ws + WS_FU), (const char*)(ws + WS_WDOWN), 0, 0, 0, (size_t)256 * DFF * 2, (size_t)256 * DFF * 2};
                pg8::EpiResid<false> E{(const void*)BPW(WS_XN), dry ? BPW(WS_QA) : (l + 1 < DEPTH ? (bf16_t*)X : BPW(WS_XN)), dry ? SSA(0) : SSA(3 + 3 * l)};
                pg8::gemm_phase<pg8::EpiResid<false>, pg8::PtrStd, true, true>(lds, tid, DFF, DFF, DFF, S, P, E);
            }
        }
        }
        if (p + 1 < hi && !(p >= PH_L0 && ((p - PH_L0) % PH_PER_LAYER == Q_NORMXA || (p - PH_L0) % PH_PER_LAYER == Q_NORMFFN))) xcd_barrier(bar, mk_tid(wave_s));
    }
}

extern "C" void kernel_launch(void* const* d_in, const int* in_sizes, int n_in, void* d_out, int out_size, void* d_ws, size_t ws_size, hipStream_t st) {
    if (n_in != 20 || ws_size < WS_NEED || out_size != T * D) { fprintf(stderr, "kernel_launch: unexpected sizes n_in %d ws %zu out %d\n", n_in, ws_size, out_size); return; }
    static int grid = 0;
    if (grid == 0) {
        int dev = 0, cus = 0, per_cu = 0;
        (void)hipGetDevice(&dev); (void)hipDeviceGetAttribute(&cus, hipDeviceAttributeMultiprocessorCount, dev);
        if (hipOccupancyMaxActiveBlocksPerMultiprocessor(&per_cu, (const void*)mk_fwd, MK_THREADS, 0) != hipSuccess || per_cu < 1) { fprintf(stderr, "kernel_launch: occupancy query says %d blocks/CU\n", per_cu); grid = -1; return; }
        (void)hipGetLastError();
        if (cus != 256) { fprintf(stderr, "kernel_launch: built for a 256-CU device, found %d\n", cus); grid = -1; return; }
        grid = cus;
    }
    if (grid < 0) return;
    (void)hipMemsetAsync((char*)d_ws + WS_CTL, 0, CTL_ZERO_BYTES, st);
    Args a{};
    for (int i = 0; i < 20; ++i) a.in[i] = (const float*)d_in[i];
    a.out = (float*)d_out; a.ws = (unsigned char*)d_ws; a.ph_lo = 0; a.ph_hi = NPH;
    hipLaunchKernelGGL(mk_fwd, dim3(grid), dim3(MK_THREADS), 0, st, a);
}
```

```cpp
#include <hip/hip_runtime.h>
#include <stdint.h>
#include <stdio.h>

typedef unsigned short bf16_t;
typedef short bf16x8 __attribute__((ext_vector_type(8)));
typedef float f32x16 __attribute__((ext_vector_type(16)));
typedef float f32x4 __attribute__((ext_vector_type(4)));
#define DEV __device__ __forceinline__

constexpr int NB = 2, S = 8192, D = 1024, T = NB * S, DEPTH = 2;
constexpr int DIN = 8264, DFF = 2816, MEM = 256;
constexpr int NIN = 5376;
constexpr float LOG2E = 1.4426950408889634f;
constexpr float QSCALE = 0.125f * LOG2E;
constexpr float WSCALE = 0.125f * 0.35355339059327373f;
constexpr float XSCALE = 0.0625f * LOG2E;
constexpr float EPS = 1e-6f;
#ifndef MK_FUSE
#define MK_FUSE 1
#endif

constexpr size_t MiB = 1u << 20;
constexpr size_t WS_KN = 983040;
constexpr size_t WS_GT = 1 * MiB;
constexpr size_t WS_HT = 9 * MiB;
constexpr size_t WS_WUP = 17 * MiB, WS_WDOWN = 28 * MiB;
constexpr size_t WS_XN = 34 * MiB;
constexpr size_t WS_WMIX = 66 * MiB, WS_WBR = 68 * MiB, WS_WG = 71 * MiB, WS_WIN = 77 * MiB;
constexpr size_t WS_QA = 88 * MiB, WS_SCB = 104 * MiB, WS_QC = 120 * MiB, WS_KA = 136 * MiB, WS_VA = 152 * MiB, WS_KC = 168 * MiB, WS_VC = 184 * MiB,
                 WS_IQ = 200 * MiB, WS_CX = 216 * MiB, WS_IK = 232 * MiB, WS_IW = 234 * MiB, WS_BM = 235 * MiB;
constexpr size_t WS_GATES = 136 * MiB;
constexpr size_t WS_XTMP = 235 * MiB;
constexpr size_t WS_LOG = 88 * MiB, WS_PXA = 168 * MiB;
constexpr size_t WS_XBXA = 136 * MiB;
constexpr size_t WS_SS = 65536;
constexpr size_t WS_FA = 66 * MiB, WS_FU = 154 * MiB;
constexpr size_t WS_WQ = 200 * MiB  , WS_WOT = 204 * MiB  , WS_WKVT = 208 * MiB  , WS_MEMN = 216 * MiB  , WS_KVM = 218 * MiB  ;
constexpr size_t WS_NEED = 256 * MiB;

DEV bf16_t f2bf(float f) { unsigned u = __float_as_uint(f); u += 0x7fffu + ((u >> 16) & 1u); return (bf16_t)(u >> 16); }
DEV float bf2f(bf16_t h) { return __uint_as_float(((unsigned)h) << 16); }
DEV float wave_sum(float v) {
#pragma unroll
    for (int o = 1; o < 64; o <<= 1) v += __shfl_xor(v, o);
    return v;
}
DEV float wave_max(float v) {
#pragma unroll
    for (int o = 1; o < 64; o <<= 1) v = fmaxf(v, __shfl_xor(v, o));
    return v;
}


#define LAS __attribute__((address_space(3)))
#define GAS __attribute__((address_space(1)))
typedef unsigned u32x4 __attribute__((ext_vector_type(4)));
typedef unsigned u32x2 __attribute__((ext_vector_type(2)));
typedef float f32x2 __attribute__((ext_vector_type(2)));
#define LDS_WAIT() asm volatile("s_waitcnt lgkmcnt(0)" ::: "memory")
DEV int mk_tid(int wave_s) { unsigned ones = ~0u; asm volatile("" : "+s"(ones)); return wave_s * 64 + (int)__builtin_amdgcn_mbcnt_hi(ones, __builtin_amdgcn_mbcnt_lo(ones, 0u)); }
#define VM_WAIT() asm volatile("s_waitcnt vmcnt(0)" ::: "memory")
typedef __bf16 bf16x2_t __attribute__((ext_vector_type(2)));
DEV unsigned cvt_pk_bf16(float lo, float hi) { const f32x2 v = {lo, hi}; return __builtin_bit_cast(unsigned, __builtin_convertvector(v, bf16x2_t)); }
DEV float bflo(unsigned w) { return __uint_as_float(w << 16); }
DEV float bfhi(unsigned w) { return __uint_as_float(w & 0xffff0000u); }

namespace pg8 {
constexpr int BM = 256, BK = 64, HALF = 128, HTB = HALF * BK * 2, STAGE_BYTES = 8 * HTB, NXCD = 8, WGM = 8;
__host__ __device__ __forceinline__ int lds_byte(int r, int c) { const int st = (r >> 4) * 2 + (c >> 5), rr = r & 15, cc = c & 31, ob = rr * 64 + cc * 2; return st * 1024 + (ob ^ (((ob >> 9) & 1) << 5)); }
__host__ __device__ __forceinline__ void stage_rc(int b, int& R, int& C) { const int st = b / 1024, sb = b % 1024, swz = sb ^ (((sb >> 9) & 1) << 5); R = (st >> 1) * 16 + swz / 64; C = (st & 1) * 32 + (swz % 64) / 2; }
__host__ __device__ __forceinline__ int perm32(int rho) { const int n = rho >> 4, i = rho & 15; return 8 * (i >> 2) + 4 * n + (i & 3); }

struct Unit { int pm, pn, job; };
struct Order {
    int nM, nN, nwg, ntot, G, c;
    DEV void init(int nM_, int nN_, int njob, int G_, int c_) { nM = nM_; nN = nN_; nwg = nM * nN; ntot = nwg * njob; G = G_; c = c_; }
    DEV bool next(int i, Unit& u) const {
        const int L = i * G + c; if (L >= ntot) return false;
        u.job = L / nwg; int wgid = L - u.job * nwg;
        { const int q = nwg / NXCD, r = nwg % NXCD, xcd = wgid % NXCD, off = wgid / NXCD; wgid = (xcd < r ? xcd * (q + 1) : r * (q + 1) + (xcd - r) * q) + off; }
        const int nig = WGM * nN, gid = wgid / nig, fm = gid * WGM, gsz = (nM - fm) < WGM ? (nM - fm) : WGM;
        u.pm = fm + ((wgid % nig) % gsz); u.pn = (wgid % nig) / gsz; return true;
    }
};
template <class Epi, class Ptr, bool ALIGN_EPI, bool SP2>
DEV void gemm_phase(LAS unsigned char* lds, const int tid_in, const int lda, const int ldb, const int K, const Order& S, const Ptr& P, const Epi& E) {
    int tid_ = tid_in; asm volatile("" : "+v"(tid_));
    const int tid = tid_, wid = __builtin_amdgcn_readfirstlane(tid >> 6), lane = tid & 63, wr = wid >> 2, wc = wid & 3, fr = lane & 15, fq = lane >> 4;
    const int nt = K / BK;
    unsigned voffA[2], voffB[2];
#pragma unroll
    for (int i = 0; i < 2; ++i) { int R, C; stage_rc(tid * 16 + i * 8192, R, C); const int Rb = Epi::PERM ? ((R & ~31) + perm32(R & 31)) : R;
        voffA[i] = (unsigned)(R * lda + C) * 2u; voffB[i] = (unsigned)(Rb * ldb + C) * 2u; }
    const size_t kstep = (size_t)(BK * 2);
    const size_t hstepA = (size_t)HALF * lda * 2, hstepB = (size_t)HALF * ldb * 2;
    const unsigned ldsw = (unsigned)wid * 1024u;
    const int aoff = lds_byte(wr * 64 + fr, fq * 8), boff = lds_byte(wc * 32 + fr, fq * 8);
#define PG8_SA(b, h) (((b) * 2 + (h)) * HTB)
#define PG8_SB(b, h) ((4 + (b) * 2 + (h)) * HTB)
#define PG8_STAGE(bufoff, gbase, voff) do { _Pragma("unroll") for (int _i = 0; _i < 2; ++_i) \
        __builtin_amdgcn_global_load_lds((const unsigned*)((const char*)(gbase) + (voff)[_i]), (LAS unsigned*)(lds + (bufoff) + ldsw + _i * 8192), 16, 0, 0); } while (0)
#define PG8_LDA(dst, b, h) do { _Pragma("unroll") for (int m = 0; m < 4; ++m) _Pragma("unroll") for (int k = 0; k < 2; ++k) dst[m][k] = *(const LAS bf16x8*)(lds + PG8_SA(b, h) + aoff + m * 2048 + k * 1024); } while (0)
#define PG8_LDB(dst, b, h) do { _Pragma("unroll") for (int n = 0; n < 2; ++n) _Pragma("unroll") for (int k = 0; k < 2; ++k) dst[n][k] = *(const LAS bf16x8*)(lds + PG8_SB(b, h) + boff + n * 2048 + k * 1024); } while (0)
#define PG8_MMA(ai, bj, At, Bt) do { __builtin_amdgcn_s_setprio(1); _Pragma("unroll") for (int m = 0; m < 4; ++m) _Pragma("unroll") for (int n = 0; n < 2; ++n) _Pragma("unroll") for (int k = 0; k < 2; ++k) \
        acc[ai][bj][m][n] = __builtin_amdgcn_mfma_f32_16x16x32_bf16(Bt[n][k], At[m][k], acc[ai][bj][m][n], 0, 0, 0); __builtin_amdgcn_s_setprio(0); } while (0)
#define PG8_WAIT_V(n) asm volatile("s_waitcnt vmcnt(" #n ")" ::: "memory")
#define PG8_WAIT_L(n) asm volatile("s_waitcnt lgkmcnt(" #n ")" ::: "memory")
#define PG8_BAR __builtin_amdgcn_s_barrier()
#define PG8_SCHED __builtin_amdgcn_sched_barrier(0)
    Unit cur, nxt; int ui = 0;
    if (!S.next(0, cur)) return;
    f32x4 acc[2][2][4][2];
#pragma unroll
    for (int a = 0; a < 2; ++a)
#pragma unroll
        for (int b = 0; b < 2; ++b)
#pragma unroll
            for (int m = 0; m < 4; ++m)
#pragma unroll
                for (int n = 0; n < 2; ++n) acc[a][b][m][n] = (f32x4){0.f, 0.f, 0.f, 0.f};
    bf16x8 At[4][2], B0[2][2], B1[2][2];
    const char* cA = P.a(cur); const char* cB = P.b(cur);
    typename Epi::Pre pre; E.prefetch(pre, cur, wr, fr);
    if constexpr (SP2) {
        PG8_STAGE(PG8_SB(0, 0), cB, voffB); PG8_STAGE(PG8_SB(0, 1), cB + hstepB, voffB); PG8_STAGE(PG8_SA(0, 0), cA, voffA); PG8_STAGE(PG8_SA(0, 1), cA + hstepA, voffA);
        if (wr == 1) PG8_BAR;
        PG8_WAIT_V(2); PG8_BAR;
        PG8_STAGE(PG8_SB(1, 0), cB + kstep, voffB); PG8_STAGE(PG8_SA(1, 0), cA + kstep, voffA); PG8_STAGE(PG8_SB(1, 1), cB + hstepB + kstep, voffB);
        PG8_WAIT_V(6); PG8_BAR;
    } else {
        PG8_STAGE(PG8_SB(0, 0), cB, voffB); PG8_STAGE(PG8_SA(0, 0), cA, voffA); PG8_STAGE(PG8_SB(0, 1), cB + hstepB, voffB); PG8_STAGE(PG8_SA(0, 1), cA + hstepA, voffA);
        if (wr == 1) PG8_BAR;
        PG8_WAIT_V(4); PG8_BAR;
        PG8_STAGE(PG8_SB(1, 0), cB + kstep, voffB); PG8_STAGE(PG8_SA(1, 0), cA + kstep, voffA); PG8_STAGE(PG8_SB(1, 1), cB + hstepB + kstep, voffB);
        PG8_WAIT_V(6); PG8_BAR;
    }
#pragma unroll 1
    for (;;) {
        const bool has_next = S.next(ui + 1, nxt);
        const char* nA = has_next ? P.a(nxt) : cA; const char* nB = has_next ? P.b(nxt) : cB;
#pragma unroll 1
        for (int t = 0; t < nt; t += 2) {
            const bool last = (t == nt - 2);
            const char* a1 = cA + (size_t)(t + 1) * kstep;
            const char* a2 = last ? nA : cA + (size_t)(t + 2) * kstep; const char* b2 = last ? nB : cB + (size_t)(t + 2) * kstep;
            const char* a3 = a2 + kstep; const char* b3 = b2 + kstep;
            if constexpr (SP2) {
            PG8_LDB(B0, 0, 0); PG8_LDB(B1, 0, 1); PG8_SCHED; PG8_LDA(At, 0, 0); PG8_STAGE(PG8_SA(1, 1), a1 + hstepA, voffA);
            PG8_WAIT_V(8); PG8_WAIT_L(0); PG8_BAR; PG8_MMA(0, 0, At, B0); PG8_MMA(0, 1, At, B1); PG8_BAR; PG8_SCHED;
            PG8_LDA(At, 0, 1); PG8_STAGE(PG8_SB(0, 0), b2, voffB); PG8_STAGE(PG8_SB(0, 1), b2 + hstepB, voffB); PG8_STAGE(PG8_SA(0, 0), a2, voffA);
            PG8_WAIT_V(8); PG8_WAIT_L(0); PG8_BAR; PG8_MMA(1, 0, At, B0); PG8_MMA(1, 1, At, B1); PG8_BAR; PG8_SCHED;
            PG8_LDB(B0, 1, 0); PG8_LDB(B1, 1, 1); PG8_SCHED; PG8_LDA(At, 1, 0); PG8_STAGE(PG8_SA(0, 1), a2 + hstepA, voffA);
            PG8_WAIT_V(8); PG8_WAIT_L(0); PG8_BAR; PG8_MMA(0, 0, At, B0); PG8_MMA(0, 1, At, B1); PG8_BAR; PG8_SCHED;
            PG8_LDA(At, 1, 1); PG8_STAGE(PG8_SB(1, 0), b3, voffB); PG8_STAGE(PG8_SB(1, 1), b3 + hstepB, voffB); PG8_STAGE(PG8_SA(1, 0), a3, voffA);
            PG8_WAIT_V(8); PG8_WAIT_L(0); PG8_BAR; PG8_MMA(1, 0, At, B0); PG8_MMA(1, 1, At, B1); PG8_BAR; PG8_SCHED;
            } else {
            PG8_LDB(B0, 0, 0); PG8_SCHED; PG8_LDA(At, 0, 0); PG8_STAGE(PG8_SA(1, 1), a1 + hstepA, voffA);
            PG8_WAIT_L(8); PG8_BAR; PG8_WAIT_L(0); PG8_MMA(0, 0, At, B0); PG8_BAR; PG8_SCHED;
            PG8_LDB(B1, 0, 1); PG8_STAGE(PG8_SB(0, 0), b2, voffB);
            PG8_BAR; PG8_WAIT_L(0); PG8_MMA(0, 1, At, B1); PG8_BAR;
            PG8_LDA(At, 0, 1); PG8_STAGE(PG8_SA(0, 0), a2, voffA);
            PG8_BAR; PG8_WAIT_L(0); PG8_MMA(1, 0, At, B0); PG8_BAR; PG8_SCHED;
            PG8_STAGE(PG8_SB(0, 1), b2 + hstepB, voffB);
            PG8_WAIT_V(6); PG8_BAR; PG8_MMA(1, 1, At, B1); PG8_BAR;
            PG8_LDB(B0, 1, 0); PG8_SCHED; PG8_LDA(At, 1, 0); PG8_STAGE(PG8_SA(0, 1), a2 + hstepA, voffA);
            PG8_WAIT_L(8); PG8_BAR; PG8_WAIT_L(0); PG8_MMA(0, 0, At, B0); PG8_BAR; PG8_SCHED;
            PG8_LDB(B1, 1, 1); PG8_STAGE(PG8_SB(1, 0), b3, voffB);
            PG8_BAR; PG8_WAIT_L(0); PG8_MMA(0, 1, At, B1); PG8_BAR;
            PG8_LDA(At, 1, 1); PG8_STAGE(PG8_SA(1, 0), a3, voffA);
            PG8_BAR; PG8_WAIT_L(0); PG8_MMA(1, 0, At, B0); PG8_BAR; PG8_SCHED;
            PG8_STAGE(PG8_SB(1, 1), b3 + hstepB, voffB);
            PG8_WAIT_V(6); PG8_BAR; PG8_MMA(1, 1, At, B1); PG8_BAR;
            }
        }
        if constexpr (ALIGN_EPI) { if (wr == 0) PG8_BAR; }
        if constexpr (!Epi::AFTER_DRAIN) { int fr_ = fr, fq_ = fq; asm volatile("" : "+v"(fr_), "+v"(fq_));
            E(acc, cur, wr, wc, fr_, fq_, pre); }
        if (!has_next) break;
#pragma unroll
        for (int a = 0; a < 2; ++a)
#pragma unroll
            for (int b = 0; b < 2; ++b)
#pragma unroll
                for (int m = 0; m < 4; ++m)
#pragma unroll
                    for (int n = 0; n < 2; ++n) acc[a][b][m][n] = (f32x4){0.f, 0.f, 0.f, 0.f};
        cur = nxt; cA = nA; cB = nB; ++ui; E.prefetch(pre, cur, wr, fr);
        if constexpr (ALIGN_EPI) { if (wr == 1) PG8_BAR; }
    }
    PG8_WAIT_V(0);
    if constexpr (!ALIGN_EPI) { if (wr == 0) PG8_BAR; }
    PG8_BAR;
    if constexpr (Epi::AFTER_DRAIN) { E.fused(acc, cur, wr, wc, fr, fq, lds, wid, lane, pre); }
#undef PG8_SA
#undef PG8_SB
#undef PG8_STAGE
#undef PG8_LDA
#undef PG8_LDB
#undef PG8_MMA
#undef PG8_WAIT_V
#undef PG8_WAIT_L
#undef PG8_BAR
#undef PG8_SCHED
}
typedef f32x4 Acc[2][2][4][2];

struct PtrStd {
    const char* A; const char* B; size_t aj, bj, bb, arow, brow;
    DEV const char* a(const Unit& u) const { return A + (size_t)u.job * aj + (size_t)u.pm * arow; }
    DEV const char* b(const Unit& u) const { return B + (size_t)u.job * bj + (size_t)(u.pm >> 5) * bb + (size_t)u.pn * brow; }
};
struct PtrG {
    const char* KVM; const char* WQ;
    DEV const char* a(const Unit& u) const { return KVM + (size_t)(u.job >> 2) * MiB + (size_t)(u.job & 3) * 512; }
    DEV const char* b(const Unit& u) const { return WQ + (size_t)(u.job >> 3) * 2 * MiB + (size_t)(u.job & 3) * 512 + (size_t)u.pn * 256 * 1024 * 2; }
};
struct PtrH {
    const char* KVM; const char* WOT;
    DEV const char* a(const Unit& u) const { return WOT + (size_t)(u.job >> 3) * 2 * MiB + (size_t)(u.job & 3) * 512 + (size_t)u.pm * 256 * 1024 * 2; }
    DEV const char* b(const Unit& u) const { return KVM + (size_t)(u.job >> 2) * MiB + 2048 + (size_t)(u.job & 3) * 512; }
};

#define EPI_ROWS(u) const int row0 = (u).pm * BM + wr * 64 + fr
DEV u32x4 pack8(const f32x4 v0, const f32x4 v1) { u32x4 w; w.x = cvt_pk_bf16(v0[0], v0[1]); w.y = cvt_pk_bf16(v0[2], v0[3]); w.z = cvt_pk_bf16(v1[0], v1[1]); w.w = cvt_pk_bf16(v1[2], v1[3]); return w; }

struct PreNone {};
typedef unsigned long long u64;
constexpr float SS_SCALE = 65536.f;
struct PreRs { u64 v[2][4]; };
DEV void pre_rs(PreRs& p, const u64* ss, int row0) {
#pragma unroll
    for (int ai = 0; ai < 2; ++ai)
#pragma unroll
        for (int m = 0; m < 4; ++m) p.v[ai][m] = __builtin_nontemporal_load(ss + row0 + ai * HALF + m * 16);
}
DEV void rs_of(float (&rs)[2][4], const PreRs& p) {
#pragma unroll
    for (int ai = 0; ai < 2; ++ai)
#pragma unroll
        for (int m = 0; m < 4; ++m) rs[ai][m] = rsqrtf((float)p.v[ai][m] * (1.f / (SS_SCALE * D)) + EPS);
}
struct EpiInProj {
    typedef PreRs Pre;
    DEV void prefetch(PreRs& p, const Unit& u, int wr, int fr) const { pre_rs(p, ss, u.pm * BM + wr * 64 + fr); }
    static constexpr bool PERM = true, AFTER_DRAIN = false;
    unsigned char* ws; const u64* ss;
    DEV void operator()(const Acc& acc, const Unit& u, int wr, int wc, int fr, int fq, const PreRs& pre) const {
        EPI_ROWS(u); const int pn = u.pn, cb = wc * 32 + 8 * fq;
        float rs[2][4]; rs_of(rs, pre);
        if (pn < 16) {
            const int g = pn >> 1;
            const size_t off = g == 0 ? WS_QA : g == 1 ? WS_KA : g == 2 ? WS_VA : g == 3 ? WS_QC : g == 4 ? WS_KC : g == 5 ? WS_VC : g == 6 ? WS_IQ : WS_SCB;
            const float sc = (g == 0 || g == 3) ? QSCALE : 1.f;
            bf16_t* base = (bf16_t*)(ws + off) + (pn & 1) * 256 + cb;
#pragma unroll
            for (int ai = 0; ai < 2; ++ai)
#pragma unroll
                for (int m = 0; m < 4; ++m) { bf16_t* rowp = base + (size_t)(row0 + ai * HALF + m * 16) * 512;
#pragma unroll
                    for (int bj = 0; bj < 2; ++bj) *(u32x4*)(rowp + bj * HALF) = pack8(acc[ai][bj][m][0] * (sc * rs[ai][m]), acc[ai][bj][m][1] * (sc * rs[ai][m])); }
        } else if (pn < 20) {
            bf16_t* base = (bf16_t*)(ws + WS_CX) + (pn - 16) * 128 + cb;
#pragma unroll
            for (int ai = 0; ai < 2; ++ai)
#pragma unroll
                for (int m = 0; m < 4; ++m) { const float r2 = rs[ai][m] * rs[ai][m]; *(u32x4*)(base + (size_t)(row0 + ai * HALF + m * 16) * 512) = pack8(acc[ai][0][m][0] * acc[ai][1][m][0] * r2, acc[ai][0][m][1] * acc[ai][1][m][1] * r2); }
        } else {
            if (wc < 2) { bf16_t* base = (bf16_t*)(ws + WS_IK);
#pragma unroll
                for (int ai = 0; ai < 2; ++ai)
#pragma unroll
                    for (int m = 0; m < 4; ++m) { const int t = row0 + ai * HALF + m * 16;
                        *(u32x4*)(base + (size_t)(t >> 5) * 2048 + (((cb >> 3) * 32 + (t & 31)) * 8)) = pack8(acc[ai][0][m][0] * rs[ai][m], acc[ai][0][m][1] * rs[ai][m]); }
            } else if (wc == 2 && fq == 0) { float* base = (float*)(ws + WS_IW);
#pragma unroll
                for (int ai = 0; ai < 2; ++ai)
#pragma unroll
                    for (int m = 0; m < 4; ++m) { float* p = base + (size_t)(row0 + ai * HALF + m * 16) * 8; *(f32x4*)p = acc[ai][0][m][0] * (WSCALE * rs[ai][m]); *(f32x4*)(p + 4) = acc[ai][0][m][1] * (WSCALE * rs[ai][m]); }
            }
        }
    }
};
DEV f32x4 sigm4(const f32x4 v) { f32x4 o;
#pragma unroll
    for (int i = 0; i < 4; ++i) o[i] = __builtin_amdgcn_rcpf(1.f + __builtin_amdgcn_exp2f(-LOG2E * v[i])); return o; }
struct EpiGates {
    typedef PreRs Pre;
    DEV void prefetch(PreRs& p, const Unit& u, int wr, int fr) const { pre_rs(p, ss, u.pm * BM + wr * 64 + fr); }
    static constexpr bool PERM = true, AFTER_DRAIN = false;
    bf16_t* G; const u64* ss;
    DEV void operator()(const Acc& acc, const Unit& u, int wr, int wc, int fr, int fq, const PreRs& pre) const {
        EPI_ROWS(u); float rs[2][4]; rs_of(rs, pre); bf16_t* base = G + (size_t)(u.pn >> 2) * T * D + (u.pn & 3) * 256 + wc * 32 + 8 * fq;
#pragma unroll
        for (int ai = 0; ai < 2; ++ai)
#pragma unroll
            for (int m = 0; m < 4; ++m) { bf16_t* rowp = base + (size_t)(row0 + ai * HALF + m * 16) * D;
#pragma unroll
                for (int bj = 0; bj < 2; ++bj) *(u32x4*)(rowp + bj * HALF) = pack8(sigm4(acc[ai][bj][m][0] * rs[ai][m]), sigm4(acc[ai][bj][m][1] * rs[ai][m])); }
    }
};
struct EpiMerge {
    typedef PreNone Pre;
    DEV void prefetch(PreNone&, const Unit&, int, int) const {}
    static constexpr bool PERM = true, AFTER_DRAIN = false;
    bf16_t* M; const bf16_t* G;
    DEV void operator()(const Acc& acc, const Unit& u, int wr, int wc, int fr, int fq, const PreNone&) const {
        EPI_ROWS(u); const size_t cofs = (size_t)u.pn * 256 + wc * 32 + 8 * fq; const bf16_t* gb = G + (size_t)u.job * T * D;
#pragma unroll
        for (int ai = 0; ai < 2; ++ai)
#pragma unroll
            for (int m = 0; m < 4; ++m) { const size_t ro = (size_t)(row0 + ai * HALF + m * 16) * D + cofs;
#pragma unroll
                for (int bj = 0; bj < 2; ++bj) { const size_t o = ro + bj * HALF; const u32x4 g = *(const u32x4*)(gb + o);
                    f32x4 v0 = acc[ai][bj][m][0], v1 = acc[ai][bj][m][1];
                    v0[0] *= bflo(g.x); v0[1] *= bfhi(g.x); v0[2] *= bflo(g.y); v0[3] *= bfhi(g.y); v1[0] *= bflo(g.z); v1[1] *= bfhi(g.z); v1[2] *= bflo(g.w); v1[3] *= bfhi(g.w);
                    if (u.job > 0) { const u32x4 p = __builtin_nontemporal_load((const u32x4*)(M + o));
                        v0[0] += bflo(p.x); v0[1] += bfhi(p.x); v0[2] += bflo(p.y); v0[3] += bfhi(p.y); v1[0] += bflo(p.z); v1[1] += bfhi(p.z); v1[2] += bflo(p.w); v1[3] += bfhi(p.w); }
                    *(u32x4*)(M + o) = pack8(v0, v1); } }
    }
};
template <bool IN_F32> struct EpiResid {
    typedef PreNone Pre;
    DEV void prefetch(PreNone&, const Unit&, int, int) const {}
    static constexpr bool PERM = true, AFTER_DRAIN = false;
    const void* xin; bf16_t* xb; u64* ss;
    DEV void operator()(const Acc& acc, const Unit& u, int wr, int wc, int fr, int fq, const PreNone&) const {
        EPI_ROWS(u); const size_t cofs = (size_t)u.pn * 256 + wc * 32 + 8 * fq;
#pragma unroll
        for (int ai = 0; ai < 2; ++ai)
#pragma unroll
            for (int m = 0; m < 4; ++m) { const size_t ro = (size_t)(row0 + ai * HALF + m * 16) * D + cofs; float sq = 0.f;
#pragma unroll
                for (int bj = 0; bj < 2; ++bj) { const size_t o = ro + bj * HALF; f32x4 v0 = acc[ai][bj][m][0], v1 = acc[ai][bj][m][1];
                    if (IN_F32) { v0 = v0 + *(const f32x4*)((const float*)xin + o); v1 = v1 + *(const f32x4*)((const float*)xin + o + 4); }
                    else { const u32x4 p = *(const u32x4*)((const bf16_t*)xin + o);
                        v0[0] += bflo(p.x); v0[1] += bfhi(p.x); v0[2] += bflo(p.y); v0[3] += bfhi(p.y); v1[0] += bflo(p.z); v1[1] += bfhi(p.z); v1[2] += bflo(p.w); v1[3] += bfhi(p.w); }
                    *(u32x4*)(xb + o) = pack8(v0, v1);
                    sq += ((v0[0] * v0[0] + v0[1] * v0[1]) + (v0[2] * v0[2] + v0[3] * v0[3])) + ((v1[0] * v1[0] + v1[1] * v1[1]) + (v1[2] * v1[2] + v1[3] * v1[3])); }
                sq += __shfl_xor(sq, 16); sq += __shfl_xor(sq, 32);
                if (fq == 0) atomicAdd(ss + row0 + ai * HALF + m * 16, (u64)(sq * SS_SCALE + 0.5f)); }
    }
};
struct EpiUp {
    typedef PreRs Pre;
    DEV void prefetch(PreRs& p, const Unit& u, int wr, int fr) const { pre_rs(p, ss, u.pm * BM + wr * 64 + fr); }
    static constexpr bool PERM = true, AFTER_DRAIN = false;
    bf16_t *fa, *fu; const u64* ss;
    DEV void operator()(const Acc& acc, const Unit& u, int wr, int wc, int fr, int fq, const PreRs& pre) const {
        EPI_ROWS(u); float rs[2][4]; rs_of(rs, pre); const size_t cofs = (size_t)u.pn * 128 + wc * 32 + 8 * fq;
#pragma unroll
        for (int ai = 0; ai < 2; ++ai)
#pragma unroll
            for (int m = 0; m < 4; ++m) { const size_t o = (size_t)(row0 + ai * HALF + m * 16) * DFF + cofs;
                *(u32x4*)(fa + o) = pack8(acc[ai][0][m][0] * rs[ai][m], acc[ai][0][m][1] * rs[ai][m]); *(u32x4*)(fu + o) = pack8(acc[ai][1][m][0] * rs[ai][m], acc[ai][1][m][1] * rs[ai][m]); }
    }
};
struct EpiPrep {
    typedef PreNone Pre;
    DEV void prefetch(PreNone&, const Unit&, int, int) const {}
    static constexpr bool PERM = true, AFTER_DRAIN = false;
    unsigned char* ws; int mode;
    DEV void operator()(const Acc& acc, const Unit& u, int wr, int wc, int fr, int fq, const PreNone&) const {
        EPI_ROWS(u); bf16_t* base; int ldc; float sc = 1.f;
        if (mode == 0) { base = (bf16_t*)(ws + WS_KVM + (size_t)u.job * 2 * MiB); ldc = 2 * D; }
        else if (mode == 1) { base = (bf16_t*)(ws + WS_GT + (size_t)(u.job >> 2) * 2 * MiB) + (size_t)(u.job & 3) * 256 * D; ldc = D; sc = XSCALE; }
        else { base = (bf16_t*)(ws + WS_HT + (size_t)(u.job >> 2) * 2 * MiB) + (u.job & 3) * 256; ldc = D; }
        base += (size_t)u.pn * 256 + wc * 32 + 8 * fq;
#pragma unroll
        for (int ai = 0; ai < 2; ++ai)
#pragma unroll
            for (int m = 0; m < 4; ++m) { bf16_t* rowp = base + (size_t)(row0 + ai * HALF + m * 16) * ldc;
#pragma unroll
                for (int bj = 0; bj < 2; ++bj) *(u32x4*)(rowp + bj * HALF) = pack8(acc[ai][bj][m][0] * sc, acc[ai][bj][m][1] * sc); }
    }
};
struct EpiSoftmax {
    typedef PreRs Pre;
    DEV void prefetch(PreRs& p, const Unit& u, int wr, int fr) const { pre_rs(p, ss, u.pm * BM + wr * 64 + fr); }
    static constexpr bool PERM = true, AFTER_DRAIN = true;
    bf16_t* P; const u64* ss;
    DEV void fused(Acc& acc, const Unit& u, int wr, int wc, int fr, int fq, LAS unsigned char* lds, int wid, int lane, const PreRs& pre) const {
        LAS float* PM = (LAS float*)lds; LAS float* PS = (LAS float*)(lds + 4096);
        { const int row0_ = u.pm * BM + wr * 64 + fr; float rs[2][4]; rs_of(rs, pre);
#pragma unroll
          for (int ai = 0; ai < 2; ++ai)
#pragma unroll
              for (int m = 0; m < 4; ++m)
#pragma unroll
                  for (int bj = 0; bj < 2; ++bj)
#pragma unroll
                      for (int n = 0; n < 2; ++n) acc[ai][bj][m][n] = acc[ai][bj][m][n] * rs[ai][m]; }
#pragma unroll
        for (int ai = 0; ai < 2; ++ai)
#pragma unroll
            for (int m = 0; m < 4; ++m) { float mx = -INFINITY;
#pragma unroll
                for (int bj = 0; bj < 2; ++bj)
#pragma unroll
                    for (int n = 0; n < 2; ++n) { const f32x4 x = acc[ai][bj][m][n]; mx = fmaxf(mx, fmaxf(fmaxf(x[0], x[1]), fmaxf(x[2], x[3]))); }
                mx = fmaxf(mx, __shfl_xor(mx, 16)); mx = fmaxf(mx, __shfl_xor(mx, 32));
                if (fq == 0) PM[(ai * HALF + wr * 64 + m * 16 + fr) * 4 + wc] = mx; }
        LDS_WAIT(); __builtin_amdgcn_s_barrier(); asm volatile("" ::: "memory");
#pragma unroll
        for (int ai = 0; ai < 2; ++ai)
#pragma unroll
            for (int m = 0; m < 4; ++m) { const int r = ai * HALF + wr * 64 + m * 16 + fr; const f32x4 q = *(const LAS f32x4*)(PM + r * 4);
                const float mx = fmaxf(fmaxf(q[0], q[1]), fmaxf(q[2], q[3])); float s = 0.f;
#pragma unroll
                for (int bj = 0; bj < 2; ++bj)
#pragma unroll
                    for (int n = 0; n < 2; ++n) { f32x4 x = acc[ai][bj][m][n];
#pragma unroll
                        for (int i = 0; i < 4; ++i) { x[i] = __builtin_amdgcn_exp2f(x[i] - mx); s += x[i]; } acc[ai][bj][m][n] = x; }
                s += __shfl_xor(s, 16); s += __shfl_xor(s, 32);
                if (fq == 0) PS[r * 4 + wc] = s; }
        LDS_WAIT(); __builtin_amdgcn_s_barrier(); asm volatile("" ::: "memory");
        EPI_ROWS(u); bf16_t* base = P + (size_t)u.pn * 256 + wc * 32 + 8 * fq;
#pragma unroll
        for (int ai = 0; ai < 2; ++ai)
#pragma unroll
            for (int m = 0; m < 4; ++m) { const int r = ai * HALF + wr * 64 + m * 16 + fr; const f32x4 q = *(const LAS f32x4*)(PS + r * 4);
                const float inv = 1.f / ((q[0] + q[1]) + (q[2] + q[3])); bf16_t* rowp = base + (size_t)(row0 + ai * HALF + m * 16) * D;
#pragma unroll
                for (int bj = 0; bj < 2; ++bj) *(u32x4*)(rowp + bj * HALF) = pack8(acc[ai][bj][m][0] * inv, acc[ai][bj][m][1] * inv); }
        LDS_WAIT(); __builtin_amdgcn_s_barrier();
    }
};
}

typedef GAS unsigned gu32;
#define XB_TMO      128
#define XB_XCNT(j)  (256  + 64 * (j))
#define XB_XSUB(j)  (1280 + 64 * (j))
#define XB_XGEN(j)  (2304 + 64 * (j))
#define XB_TOP      3328
#define XB_TOPGEN   3392
#define XCD_BAR_WORDS 3456
#define XB_SPIN_CAP (1u << 22)
DEV unsigned xb_ld(unsigned* p) { return __hip_atomic_load(p, __ATOMIC_RELAXED, __HIP_MEMORY_SCOPE_AGENT); }
DEV unsigned xb_add(unsigned* p, unsigned v) { return __hip_atomic_fetch_add(p, v, __ATOMIC_RELAXED, __HIP_MEMORY_SCOPE_AGENT); }
DEV unsigned xb_xcc_id() { return (unsigned)__builtin_amdgcn_s_getreg((3 << 11) | 20) & 0xFu; }
#define XB_SPIN(cond, bar) do { unsigned _sp = 0; while (cond) { __builtin_amdgcn_s_sleep(1); \
    if ((++_sp & 255u) == 0u) { if (xb_ld(&(bar)[XB_TMO])) break; if (_sp > XB_SPIN_CAP) { atomicAdd(&(bar)[XB_TMO], 1u); break; } } } } while (0)
struct XcdBarrier { unsigned* bar; unsigned x; volatile LAS unsigned* st; };
DEV XcdBarrier xcd_barrier_post(unsigned* bar, volatile LAS unsigned* st, int tid) {
    XcdBarrier b; b.bar = bar; b.x = xb_xcc_id(); b.st = st;
    if (tid == 0) (void)xb_add(&bar[XB_XCNT(b.x)], 1u);
    return b;
}
DEV void xcd_barrier_complete(unsigned* bar, unsigned x, unsigned& nloc, unsigned& nx) {
    const unsigned G = gridDim.x * gridDim.y * gridDim.z;
    unsigned sum, cnt, mine, sp = 0u;
    for (;;) {
        sum = 0u; cnt = 0u; mine = 0u;
#pragma unroll
        for (unsigned j = 0; j < 16; ++j) { const unsigned c = xb_ld(&bar[XB_XCNT(j)]); sum += c; cnt += (c > 0u) ? 1u : 0u; mine = (j == x) ? c : mine; }
        if (sum == G) break;
        __builtin_amdgcn_s_sleep(1);
        if ((++sp & 255u) == 0u) { if (xb_ld(&bar[XB_TMO])) break; if (sp > XB_SPIN_CAP) { atomicAdd(&bar[XB_TMO], 1u); break; } }
    }
    nloc = mine > 0u ? mine : 1u; nx = cnt > 0u ? cnt : 1u;
}
DEV void xcd_barrier(const XcdBarrier& b, int tid) {
    asm volatile("s_waitcnt vmcnt(0)" ::: "memory");
    __syncthreads();
    if (tid == 0) {
        unsigned* bar = b.bar;
        __builtin_amdgcn_s_waitcnt(0);
        unsigned nloc = b.st[0], nx = b.st[1];
        if (nloc == 0u) { xcd_barrier_complete(bar, b.x, nloc, nx); b.st[0] = nloc; b.st[1] = nx; }
        const unsigned old = xb_add(&bar[XB_XSUB(b.x)], 1u);
        const unsigned gen = old / nloc;
        if (old + 1u == (gen + 1u) * nloc) {
            __builtin_amdgcn_fence(__ATOMIC_RELEASE, "agent");
            asm volatile("s_waitcnt vmcnt(0)" ::: "memory");
            const unsigned og = xb_add(&bar[XB_TOP], 1u);
            const unsigned tg = og / nx;
            if (og + 1u == (tg + 1u) * nx) xb_add(&bar[XB_TOPGEN], 1u);
            else XB_SPIN(xb_ld(&bar[XB_TOPGEN]) == tg, bar);
            __builtin_amdgcn_fence(__ATOMIC_ACQUIRE, "agent");
            xb_add(&bar[XB_XGEN(b.x)], 1u);
            asm volatile("s_waitcnt vmcnt(0)" ::: "memory");
        } else {
            XB_SPIN(xb_ld(&bar[XB_XGEN(b.x)]) == gen, bar);
            __builtin_amdgcn_fence(__ATOMIC_ACQUIRE, "agent");
            asm volatile("s_waitcnt vmcnt(0)" ::: "memory");
        }
    }
    __syncthreads();
}


struct WaveId { int gw, ngw, wave, lane; };
DEV unsigned f2bf_u(float f) { return (unsigned)f2bf(f); }
DEV unsigned pk2(float lo, float hi) { return cvt_pk_bf16(lo, hi); }

DEV void norm_rows(const WaveId& W, const float* x, const float* g, bf16_t* outb, float* outf, int rows) {
    for (int row = W.gw; row < rows; row += W.ngw) {
        const f32x4* xr = (const f32x4*)(x + (size_t)row * D) + W.lane;
        f32x4 v[4]; float s = 0.f;
#pragma unroll
        for (int j = 0; j < 4; ++j) { v[j] = xr[64 * j]; s += (v[j].x * v[j].x + v[j].y * v[j].y) + (v[j].z * v[j].z + v[j].w * v[j].w); }
        const float r = rsqrtf(wave_sum(s) * (1.f / D) + EPS);
#pragma unroll
        for (int j = 0; j < 4; ++j) {
            const f32x4 gg = ((const f32x4*)g)[W.lane + 64 * j];
            const f32x4 o = {v[j].x * r * gg.x, v[j].y * r * gg.y, v[j].z * r * gg.z, v[j].w * r * gg.w};
            if (outb) { u32x2 w; w.x = pk2(o.x, o.y); w.y = pk2(o.z, o.w); ((u32x2*)(outb + (size_t)row * D))[W.lane + 64 * j] = w; }
            else ((f32x4*)(outf + (size_t)row * D))[W.lane + 64 * j] = o;
        }
    }
}
DEV void cvt_piece(const WaveId& W, LAS float* scr, int& base, const float* Wsrc, int ldw, int K, int col0, int ncols, bf16_t* dst, int ldo, int row0, const float* gain = nullptr) {
    const int nblk = ncols / 32, nitems = (K / 64) * nblk;
    int first = (W.gw - base) % W.ngw; if (first < 0) first += W.ngw;
    base = (base + nitems) % W.ngw;
    for (int item = first; item < nitems; item += W.ngw) {
        const int kb = item / nblk, nb = item - kb * nblk, k0 = 64 * kb, n0 = 32 * nb;
#pragma unroll 8
        for (int i = 0; i < 32; ++i) { const int kk = 2 * i + (W.lane >> 5); scr[kk * 33 + (W.lane & 31)] = Wsrc[(size_t)(k0 + kk) * ldw + col0 + n0 + (W.lane & 31)] * (gain ? gain[k0 + kk] : 1.f); }
        LDS_WAIT(); asm volatile("" ::: "memory");
        const int c = W.lane & 7;
#pragma unroll
        for (int j = 0; j < 4; ++j) { const int n = (W.lane >> 3) + 8 * j; const LAS float* s = scr + (8 * c) * 33 + n;
            u32x4 o; o.x = pk2(s[0 * 33], s[1 * 33]); o.y = pk2(s[2 * 33], s[3 * 33]); o.z = pk2(s[4 * 33], s[5 * 33]); o.w = pk2(s[6 * 33], s[7 * 33]);
            *(u32x4*)(dst + (size_t)(row0 + n0 + n) * ldo + k0 + 8 * c) = o; }
        LDS_WAIT(); asm volatile("" ::: "memory");
    }
}
DEV void convert_layer_weights(const WaveId& W, LAS float* scr, int& base, unsigned char* ws, const float* const* in, int l) {
    const float* wi = in[3] + (size_t)l * D * DIN;
    bf16_t* WIN = (bf16_t*)(ws + WS_WIN); const float* gm = in[2] + l * D; const float* gf = in[14] + l * D;
    cvt_piece(W, scr, base, wi, DIN, D, 0, 1536, WIN, D, 0, gm);
    cvt_piece(W, scr, base, wi, DIN, D, 3072, 1536, WIN, D, 1536, gm);
    cvt_piece(W, scr, base, wi, DIN, D, 4608, 512, WIN, D, 3072, gm);
    cvt_piece(W, scr, base, wi, DIN, D, 1536, 512, WIN, D, 3584, gm);
#pragma unroll 1
    for (int j = 0; j < 4; ++j) { cvt_piece(W, scr, base, wi, DIN, D, 2048 + 128 * j, 128, WIN, D, 4096 + 256 * j, gm); cvt_piece(W, scr, base, wi, DIN, D, 2560 + 128 * j, 128, WIN, D, 4096 + 256 * j + 128, gm); }
    cvt_piece(W, scr, base, wi, DIN, D, 5120, 96, WIN, D, 5120, gm);
    cvt_piece(W, scr, base, wi, DIN, D, 5192, 3072, (bf16_t*)(ws + WS_WG), D, 0, gm);
#pragma unroll 1
    for (int i = 0; i < 3; ++i) cvt_piece(W, scr, base, in[5 + i] + (size_t)l * 512 * D, D, 512, 0, D, (bf16_t*)(ws + WS_WBR) + (size_t)i * D * 512, 512, 0);
    cvt_piece(W, scr, base, in[8] + (size_t)l * D * D, D, D, 0, D, (bf16_t*)(ws + WS_WMIX), D, 0);
    const float* wf = in[15] + (size_t)l * D * 2 * DFF;
#pragma unroll 1
    for (int j = 0; j < 22; ++j) { cvt_piece(W, scr, base, wf, 2 * DFF, D, 128 * j, 128, (bf16_t*)(ws + WS_WUP), D, 256 * j, gf); cvt_piece(W, scr, base, wf, 2 * DFF, D, DFF + 128 * j, 128, (bf16_t*)(ws + WS_WUP), D, 256 * j + 128, gf); }
    cvt_piece(W, scr, base, in[18] + (size_t)l * DFF * D, D, DFF, 0, D, (bf16_t*)(ws + WS_WDOWN), DFF, 0);
}
DEV void prep0_phase(const WaveId& W, LAS float* scr, unsigned char* ws, const float* const* in, bf16_t* XB) {
    int base = 0;
#pragma unroll 1
    for (int l = 0; l < DEPTH; ++l) {
        const float* wq = in[11] + (size_t)l * D * D; bf16_t* WQ = (bf16_t*)(ws + WS_WQ + (size_t)l * 2 * MiB); const float* gx = in[9] + l * D;
        for (size_t i = (size_t)(W.gw * 64 + W.lane) * 4; i < (size_t)D * D; i += (size_t)W.ngw * 256) { const float g = gx[i >> 10]; const f32x4 v = *(const f32x4*)(wq + i); u32x2 o; o.x = pk2(v.x * g, v.y * g); o.y = pk2(v.z * g, v.w * g); *(u32x2*)(WQ + i) = o; }
        cvt_piece(W, scr, base, in[13] + (size_t)l * D * D, D, D, 0, D, (bf16_t*)(ws + WS_WOT + (size_t)l * 2 * MiB), D, 0);
        cvt_piece(W, scr, base, in[12] + (size_t)l * D * 2 * D, 2 * D, D, 0, 2 * D, (bf16_t*)(ws + WS_WKVT + (size_t)l * 4 * MiB), D, 0);
        norm_rows(W, in[1], in[10] + l * D, (bf16_t*)(ws + WS_MEMN + (size_t)l * MiB), nullptr, NB * MEM);
    }
    convert_layer_weights(W, scr, base, ws, in, 0);
    pg8::u64* ss0 = (pg8::u64*)(ws + WS_SS);
    for (int row = W.gw; row < T; row += W.ngw) {
        const f32x4* xr = (const f32x4*)(in[0] + (size_t)row * D) + W.lane; float s = 0.f;
#pragma unroll
        for (int j = 0; j < 4; ++j) { const f32x4 v = xr[64 * j]; s += (v.x * v.x + v.y * v.y) + (v.z * v.z + v.w * v.w);
            u32x2 w; w.x = pk2(v.x, v.y); w.y = pk2(v.z, v.w); ((u32x2*)(XB + (size_t)row * D))[W.lane + 64 * j] = w; }
        s = wave_sum(s); if (W.lane == 0) ss0[row] = (pg8::u64)(s * pg8::SS_SCALE + 0.5f);
    }
}
DEV void final_norm(const WaveId& W, const bf16_t* x, float* out, const float* g, const pg8::u64* ss) {
    for (int row = W.gw; row < T; row += W.ngw) {
        const float r = rsqrtf((float)ss[row] * (1.f / (pg8::SS_SCALE * D)) + EPS); const u32x2* xr = (const u32x2*)(x + (size_t)row * D) + W.lane; f32x4* orow = (f32x4*)(out + (size_t)row * D) + W.lane;
#pragma unroll
        for (int j = 0; j < 4; ++j) { const f32x4 gg = ((const f32x4*)g)[W.lane + 64 * j]; const u32x2 v = xr[64 * j];
            const f32x4 o = {bflo(v.x) * r * gg.x, bfhi(v.x) * r * gg.y, bflo(v.y) * r * gg.z, bfhi(v.y) * r * gg.w}; orow[64 * j] = o; }
    }
}
DEV void conv_sc_phase(int gtid, int gthreads, bf16_t* scb, const bf16_t* cx, const float* w, bool dry) {
    for (int i = gtid; i < T * 64; i += gthreads) {
        const int c8 = (i & 63) * 8, t = i >> 6, tl = t & (S - 1);
        const size_t o = (size_t)t * 512 + c8;
        const u32x4 z = {0u, 0u, 0u, 0u};
        const u32x4 x2 = *(const u32x4*)(cx + o), x1 = tl >= 1 ? *(const u32x4*)(cx + o - 512) : z, x0 = tl >= 2 ? *(const u32x4*)(cx + o - 1024) : z, bb = *(const u32x4*)(scb + o);
        const f32x4 w0a = *(const f32x4*)(w + c8), w0b = *(const f32x4*)(w + c8 + 4), w1a = *(const f32x4*)(w + 512 + c8), w1b = *(const f32x4*)(w + 512 + c8 + 4), w2a = *(const f32x4*)(w + 1024 + c8), w2b = *(const f32x4*)(w + 1024 + c8 + 4);
        float r[8];
#define CONV1(k, W0, W1, W2, X0, X1, X2, BBv, F) r[k] = F(BBv) * (W0 * F(X0) + W1 * F(X1) + W2 * F(X2))
        CONV1(0, w0a.x, w1a.x, w2a.x, x0.x, x1.x, x2.x, bb.x, bflo); CONV1(1, w0a.y, w1a.y, w2a.y, x0.x, x1.x, x2.x, bb.x, bfhi);
        CONV1(2, w0a.z, w1a.z, w2a.z, x0.y, x1.y, x2.y, bb.y, bflo); CONV1(3, w0a.w, w1a.w, w2a.w, x0.y, x1.y, x2.y, bb.y, bfhi);
        CONV1(4, w0b.x, w1b.x, w2b.x, x0.z, x1.z, x2.z, bb.z, bflo); CONV1(5, w0b.y, w1b.y, w2b.y, x0.z, x1.z, x2.z, bb.z, bfhi);
        CONV1(6, w0b.z, w1b.z, w2b.z, x0.w, x1.w, x2.w, bb.w, bflo); CONV1(7, w0b.w, w1b.w, w2b.w, x0.w, x1.w, x2.w, bb.w, bfhi);
#undef CONV1
        u32x4 ov; ov.x = pk2(r[0], r[1]); ov.y = pk2(r[2], r[3]); ov.z = pk2(r[4], r[5]); ov.w = pk2(r[6], r[7]);
        if (!dry) *(u32x4*)(scb + o) = ov; else asm volatile("" :: "v"(ov));
    }
}
DEV float gelu_t(float a) { return a * __builtin_amdgcn_rcpf(1.f + __builtin_amdgcn_exp2f(-1.5957691216057308f * LOG2E * (a + 0.044715f * a * a * a))); }
DEV void ffn_mid_phase(int gtid, int gthreads, const bf16_t* fa, bf16_t* fu, const float* cw, const float* cb, bool dry) {
    constexpr int C8 = DFF / 8;
    for (int i = gtid; i < T * C8; i += gthreads) {
        const int t = i / C8, c8 = (i - t * C8) * 8, tl = t & (S - 1);
        const size_t o = (size_t)t * DFF + c8;
        const u32x4 z = {0u, 0u, 0u, 0u};
        const u32x4 x2 = *(const u32x4*)(fa + o), x1 = tl >= 1 ? *(const u32x4*)(fa + o - DFF) : z, x0 = tl >= 2 ? *(const u32x4*)(fa + o - 2 * DFF) : z, uu = *(const u32x4*)(fu + o);
        const f32x4 w0a = *(const f32x4*)(cw + c8), w0b = *(const f32x4*)(cw + c8 + 4), w1a = *(const f32x4*)(cw + DFF + c8), w1b = *(const f32x4*)(cw + DFF + c8 + 4), w2a = *(const f32x4*)(cw + 2 * DFF + c8), w2b = *(const f32x4*)(cw + 2 * DFF + c8 + 4);
        const f32x4 ba = *(const f32x4*)(cb + c8), bb = *(const f32x4*)(cb + c8 + 4);
        float r[8];
#define FM1(k, B0, W0, W1, W2, X0, X1, X2, Uv, F) r[k] = gelu_t(B0 + W0 * F(X0) + W1 * F(X1) + W2 * F(X2)) * F(Uv)
        FM1(0, ba.x, w0a.x, w1a.x, w2a.x, x0.x, x1.x, x2.x, uu.x, bflo); FM1(1, ba.y, w0a.y, w1a.y, w2a.y, x0.x, x1.x, x2.x, uu.x, bfhi);
        FM1(2, ba.z, w0a.z, w1a.z, w2a.z, x0.y, x1.y, x2.y, uu.y, bflo); FM1(3, ba.w, w0a.w, w1a.w, w2a.w, x0.y, x1.y, x2.y, uu.y, bfhi);
        FM1(4, bb.x, w0b.x, w1b.x, w2b.x, x0.z, x1.z, x2.z, uu.z, bflo); FM1(5, bb.y, w0b.y, w1b.y, w2b.y, x0.z, x1.z, x2.z, uu.z, bfhi);
        FM1(6, bb.z, w0b.z, w1b.z, w2b.z, x0.w, x1.w, x2.w, uu.w, bflo); FM1(7, bb.w, w0b.w, w1b.w, w2b.w, x0.w, x1.w, x2.w, uu.w, bfhi);
#undef FM1
        u32x4 ov; ov.x = pk2(r[0], r[1]); ov.y = pk2(r[2], r[3]); ov.z = pk2(r[4], r[5]); ov.w = pk2(r[6], r[7]);
        if (!dry) *(u32x4*)(fu + o) = ov; else asm volatile("" :: "v"(ov));
    }
}

typedef short s16x4 __attribute__((ext_vector_type(4)));
DEV s16x4 vtr(const LAS unsigned char* p) { return __builtin_bit_cast(s16x4, __builtin_amdgcn_ds_read_tr16_b64_v4i16((LAS s16x4*)p)); }
DEV bf16x8 cat8(const s16x4 a, const s16x4 b) { return (bf16x8){a[0], a[1], a[2], a[3], b[0], b[1], b[2], b[3]}; }
DEV bf16x8 pk8(float a0, float a1, float a2, float a3, float a4, float a5, float a6, float a7) {
    u32x4 w; w.x = pk2(a0, a1); w.y = pk2(a2, a3); w.z = pk2(a4, a5); w.w = pk2(a6, a7); return __builtin_bit_cast(bf16x8, w); }
constexpr int VPITCH = 192;
DEV void pv_tile(f32x16& o0, f32x16& o1, const LAS unsigned char* vt, int lane, const bf16x8 (&pk)[4]) {
    const int hi = lane >> 5;
    const LAS unsigned char* vb = vt + (4 * hi + ((lane & 15) >> 2)) * VPITCH + ((lane >> 4) & 1) * 32 + (lane & 3) * 8;
    bf16x8 va[4];
#pragma unroll
    for (int ks = 0; ks < 4; ++ks) va[ks] = cat8(vtr(vb + (16 * ks) * VPITCH), vtr(vb + (16 * ks + 8) * VPITCH));
    asm volatile("" : "+v"(va[0]), "+v"(va[1]), "+v"(va[2]), "+v"(va[3]));
#pragma unroll
    for (int ks = 0; ks < 4; ++ks) o0 = __builtin_amdgcn_mfma_f32_32x32x16_bf16(va[ks], pk[ks], o0, 0, 0, 0);
#pragma unroll
    for (int ks = 0; ks < 4; ++ks) va[ks] = cat8(vtr(vb + (16 * ks) * VPITCH + 64), vtr(vb + (16 * ks + 8) * VPITCH + 64));
    asm volatile("" : "+v"(va[0]), "+v"(va[1]), "+v"(va[2]), "+v"(va[3]));
#pragma unroll
    for (int ks = 0; ks < 4; ++ks) o1 = __builtin_amdgcn_mfma_f32_32x32x16_bf16(va[ks], pk[ks], o1, 0, 0, 0);
}
DEV void store_ot(bf16_t* orow, const f32x16& o0, const f32x16& o1, int hi, float sc) {
#pragma unroll
    for (int g4 = 0; g4 < 4; ++g4) {
        u32x2 a; a.x = pk2(o0[4 * g4] * sc, o0[4 * g4 + 1] * sc); a.y = pk2(o0[4 * g4 + 2] * sc, o0[4 * g4 + 3] * sc);
        u32x2 b; b.x = pk2(o1[4 * g4] * sc, o1[4 * g4 + 1] * sc); b.y = pk2(o1[4 * g4 + 2] * sc, o1[4 * g4 + 3] * sc);
        *(u32x2*)(orow + 8 * g4 + 4 * hi) = a; *(u32x2*)(orow + 32 + 8 * g4 + 4 * hi) = b;
    }
}

DEV void sb_item(LAS unsigned char* vl, const bf16_t* Q, const bf16_t* Kk, const bf16_t* V, bf16_t* O, int b, int h, int qb, int lane, bool dry) {
    const int r32 = lane & 31, hi = lane >> 5, t0 = 32 * qb, t = t0 + r32; const size_t rowb = (size_t)b * S;
    bf16x8 qr[4]; { const bf16_t* qp = Q + (rowb + t0 + r32) * 512 + h * 64 + 8 * hi;
#pragma unroll
        for (int d0 = 0; d0 < 4; ++d0) qr[d0] = *(const bf16x8*)(qp + 16 * d0); }
    f32x16 o0, o1;
#pragma unroll
    for (int r = 0; r < 16; ++r) { o0[r] = 0.f; o1[r] = 0.f; }
    float carry = 1.f;
    const int c_hi = (t0 + 30) >> 6;
#pragma unroll 1
    for (int c = c_hi; c >= 0; --c) {
        const bf16_t* kp = Kk + (rowb + 64 * c + r32) * 512 + h * 64 + 8 * hi;
        bf16x8 k0[4], k1[4];
#pragma unroll
        for (int d0 = 0; d0 < 4; ++d0) { k0[d0] = *(const bf16x8*)(kp + 16 * d0); k1[d0] = *(const bf16x8*)(kp + (size_t)32 * 512 + 16 * d0); }
#pragma unroll
        for (int j = 0; j < 8; ++j) { const int row = (lane >> 3) + 8 * j; *(LAS u32x4*)(vl + row * VPITCH + (lane & 7) * 16) = *(const u32x4*)(V + (rowb + 64 * c + row) * 512 + h * 64 + (lane & 7) * 8); }
        f32x16 p0, p1;
#pragma unroll
        for (int r = 0; r < 16; ++r) { p0[r] = 0.f; p1[r] = 0.f; }
#pragma unroll
        for (int d0 = 0; d0 < 4; ++d0) { p0 = __builtin_amdgcn_mfma_f32_32x32x16_bf16(k0[d0], qr[d0], p0, 0, 0, 0); p1 = __builtin_amdgcn_mfma_f32_32x32x16_bf16(k1[d0], qr[d0], p1, 0, 0, 0); }
        float u[32];
        const bool diag = (c == c_hi);
#pragma unroll
        for (int e = 0; e < 32; ++e) {
            const float z = e < 16 ? p0[e] : p1[e - 16];
            float uu = __builtin_amdgcn_rcpf(1.f + __builtin_amdgcn_exp2f(fminf(z, 126.f)));
            if (diag) { const int kv = 64 * c + 8 * ((e >> 2) & 3) + 4 * hi + (e & 3) + 32 * (e >> 4); if (kv >= t) uu = 1.f; }
            u[e] = uu;
        }
        float gl[8], gh[8];
#pragma unroll
        for (int i = 0; i < 8; ++i) { const float gp = (u[4 * i] * u[4 * i + 1]) * (u[4 * i + 2] * u[4 * i + 3]);
            const auto rr = __builtin_amdgcn_permlane32_swap(__float_as_uint(gp), __float_as_uint(gp), false, false); gl[i] = __uint_as_float(rr[0]); gh[i] = __uint_as_float(rr[1]); }
        float ag[8]; float run = carry;
#pragma unroll
        for (int i = 7; i >= 0; --i) { const float a_hi = run; run *= gh[i]; const float a_lo = run; run *= gl[i]; ag[i] = hi ? a_hi : a_lo; }
        carry = run;
        bf16x8 pk[4];
#pragma unroll
        for (int ks = 0; ks < 4; ++ks) { float w[8];
#pragma unroll
            for (int g = 0; g < 2; ++g) { const int i = 2 * ks + g;
                const float a3 = ag[i], a2 = a3 * u[4 * i + 3], a1 = a2 * u[4 * i + 2], a0 = a1 * u[4 * i + 1];
                w[4 * g] = (1.f - u[4 * i]) * a0; w[4 * g + 1] = (1.f - u[4 * i + 1]) * a1; w[4 * g + 2] = (1.f - u[4 * i + 2]) * a2; w[4 * g + 3] = (1.f - u[4 * i + 3]) * a3; }
            pk[ks] = pk8(w[0], w[1], w[2], w[3], w[4], w[5], w[6], w[7]); }
        pv_tile(o0, o1, vl, lane, pk);
        if (__all(carry < 7.8e-31f)) break;
    }
    if (!dry) store_ot(O + (rowb + t0 + r32) * 512 + h * 64, o0, o1, hi, 1.f); else asm volatile("" :: "v"(o0), "v"(o1));
}
DEV void sb_phase(const WaveId& W, LAS unsigned char* lds, unsigned char* ws, bool dry) {
    LAS unsigned char* vl = lds + W.wave * 12288;
    const bf16_t* Q = (const bf16_t*)(ws + WS_QA); const bf16_t* Kk = (const bf16_t*)(ws + WS_KA); const bf16_t* V = (const bf16_t*)(ws + WS_VA);
    constexpr int NITEM = NB * 8 * (S / 32);
    for (int it = W.gw; it < NITEM; it += W.ngw) {
        const int qb = it & 255, h = (it >> 8) & 7, b = it >> 11;
        sb_item(vl, Q, Kk, V, (bf16_t*)(ws + WS_QA), b, h, qb, W.lane, dry);
    }
}

constexpr int IDX_CTL_OFF = 131072 + 1024;
DEV unsigned fkey2(float v) { const int u = (int)__float_as_uint(v); return (unsigned)(u ^ ((u >> 31) | (int)0x80000000)); }
DEV float relu1(float x) { return __builtin_amdgcn_fmed3f(x, 0.f, 3.0e38f); }
DEV void idx_prefetch(bf16x8 (&afr)[4], float (&w)[16], bf16x8 (&b0)[4], bf16x8 (&b1)[4], const bf16_t* IQ, const bf16_t* IK, const float* IWp, int b, int t0, int wid, int lane) {
    const int r32 = lane & 31, hh = lane >> 5; const size_t rowb = (size_t)b * S;
    { const int qi = 2 * (r32 >> 4) + ((r32 >> 2) & 1), head = (r32 & 3) + 4 * ((r32 >> 3) & 1);
        const bf16_t* ap = IQ + (rowb + t0 + qi) * 512 + head * 64 + 8 * hh;
#pragma unroll
        for (int ks = 0; ks < 4; ++ks) afr[ks] = *(const bf16x8*)(ap + 16 * ks); }
#pragma unroll
    for (int r = 0; r < 16; ++r) w[r] = IWp[(rowb + t0 + 2 * (r >> 3) + hh) * 8 + (r & 7)];
    const int jmax = (t0 + 3) >> 5;
    { const int j0 = wid < jmax ? wid : jmax, j1 = wid + 8 < jmax ? wid + 8 : jmax;
      const bf16_t* p0 = IK + ((rowb >> 5) + j0) * 2048 + (hh * 32 + r32) * 8; const bf16_t* p1 = IK + ((rowb >> 5) + j1) * 2048 + (hh * 32 + r32) * 8;
#pragma unroll
      for (int ks = 0; ks < 4; ++ks) { b0[ks] = *(const bf16x8*)(p0 + ks * 512); b1[ks] = *(const bf16x8*)(p1 + ks * 512); } }
}
DEV void idx_unit(LAS unsigned char* lds, const bf16_t* IQ, const bf16_t* IK, const float* IWp, unsigned* BM, int b, int t0, int nb, int nt0, int wid, int lane,
                  bf16x8 (&afr)[4], float (&w)[16], bf16x8 (&b0)[4], bf16x8 (&b1)[4]) {
    const int r32 = lane & 31, hh = lane >> 5; const size_t rowb = (size_t)b * S;
    const int tmax = t0 + 3, jmax = tmax >> 5;
    LAS unsigned* SCO = (LAS unsigned*)lds;
    bf16x8 b2[4];
#pragma unroll
    for (int ks = 0; ks < 4; ++ks) b2[ks] = afr[ks];
#define IDX_LOADB(dst, jj) do { const int jc_ = (jj) < jmax ? (jj) : jmax; const bf16_t* bp_ = IK + ((rowb >> 5) + jc_) * 2048 + (hh * 32 + r32) * 8; \
        _Pragma("unroll") for (int ks = 0; ks < 4; ++ks) dst[ks] = *(const bf16x8*)(bp_ + ks * 512); } while (0)
#define IDX_COMP(src, jj) do { f32x16 acc; _Pragma("unroll") for (int r = 0; r < 16; ++r) acc[r] = 0.f; \
        _Pragma("unroll") for (int ks = 0; ks < 4; ++ks) acc = __builtin_amdgcn_mfma_f32_32x32x16_bf16(afr[ks], src[ks], acc, 0, 0, 0); \
        float s0 = 0.f, s1 = 0.f; _Pragma("unroll") for (int hd = 0; hd < 8; ++hd) { s0 += w[hd] * relu1(acc[hd]); s1 += w[8 + hd] * relu1(acc[8 + hd]); } \
        unsigned k0_ = fkey2(s0), k1_ = fkey2(s1); const int key = 32 * (jj) + r32; \
        if ((jj) >= jmax) { k0_ = key <= t0 + hh ? k0_ : 0u; k1_ = key <= t0 + 2 + hh ? k1_ : 0u; }     \
        if ((jj) <= jmax) { SCO[hh * 8192 + key] = k0_; SCO[(2 + hh) * 8192 + key] = k1_; } } while (0)
#ifndef IDX_REP_MFMA
#define IDX_REP_MFMA 1
#endif
#ifndef IDX_REP_SEL
#define IDX_REP_SEL 1
#endif
#ifdef IDX_DRY_COMPUTE
#pragma unroll 1
    for (int j = wid; j <= jmax; j += 24) { IDX_COMP(b0, j); asm volatile("" : "+v"(b0[0]), "+v"(b1[0]), "+v"(b2[0])); IDX_COMP(b1, j + 8); IDX_COMP(b2, j + 16); }
#endif
#pragma unroll 1
    for (int rpm = 0; rpm < IDX_REP_MFMA; ++rpm) {
#pragma unroll 1
    for (int j = wid; j <= jmax; j += 24) {
        IDX_LOADB(b2, j + 16); IDX_COMP(b0, j);
        IDX_LOADB(b0, j + 24); IDX_COMP(b1, j + 8);
        IDX_LOADB(b1, j + 32); IDX_COMP(b2, j + 16);
    }
    }
#undef IDX_LOADB
#undef IDX_COMP
    if (nt0 >= 0) idx_prefetch(afr, w, b0, b1, IQ, IK, IWp, nb, nt0, wid, lane);
    LAS unsigned* thr = (LAS unsigned*)(lds + IDX_CTL_OFF);
    if (wid == 0 && lane < 32) ((LAS unsigned*)(lds + IDX_CTL_OFF + 64))[lane] = 0u;
    LDS_WAIT(); __builtin_amdgcn_s_barrier(); asm volatile("" ::: "memory");
    {
        const int q = wid & 3, h = wid >> 2, n = t0 + q + 1;
        volatile LAS unsigned* xme = (volatile LAS unsigned*)(lds + IDX_CTL_OFF + 64) + (q * 2 + h) * 4;
        volatile LAS unsigned* xpa = (volatile LAS unsigned*)(lds + IDX_CTL_OFF + 64) + (q * 2 + (h ^ 1)) * 4;
        unsigned T_ = 1u;
        if (n > 256) {
            LAS unsigned* row = SCO + q * 8192 + lane;
            unsigned r[64];
            const int nil = (jmax >> 1) >= h ? (((jmax >> 1) - h) >> 1) + 1 : 0;
#define IDX_FOR_LIVE(BODY) _Pragma("unroll") for (int g8_ = 0; g8_ < 8; ++g8_) if (8 * g8_ < nil) { _Pragma("unroll") for (int u8_ = 0; u8_ < 8; ++u8_) { const int il = 8 * g8_ + u8_; BODY } }
            IDX_FOR_LIVE( r[il] = (2 * (2 * il + h) + hh <= jmax) ? row[64 * (2 * il + h)] : 0u; )
            unsigned seq = 0u;
#define IDX_XCHG(val, out) do { ++seq; const int pb_ = (seq & 1u) * 2; if (lane == 0) { xme[pb_ + 1] = (val); xme[pb_] = seq; } \
                while (xpa[pb_] != seq) __builtin_amdgcn_s_sleep(0); (out) = xpa[pb_ + 1]; } while (0)
#define IDX_XCHG16(val, out) do { ++seq; const int pb_ = (seq & 1u) * 2; if (lane == 0) xme[pb_] = (seq << 16) | (val); unsigned w_; \
                while (((w_ = xpa[pb_]) >> 16) != (seq & 0xffffu)) __builtin_amdgcn_s_sleep(0); (out) = w_ & 0xffffu; } while (0)
#pragma unroll 1
            for (int rps = 0; rps < IDX_REP_SEL; ++rps) {
            unsigned mx = 0u;
            IDX_FOR_LIVE( mx = max(mx, r[il]); )
#pragma unroll
            for (int o = 1; o < 64; o <<= 1) mx = max(mx, (unsigned)__shfl_xor((int)mx, o));
            { unsigned pm_; IDX_XCHG(mx, pm_); mx = max(mx, pm_); }
            unsigned lo_ = 1u, hi_ = mx + 1u, chi_ = 0u, xgt_ = 1u, xeq_ = 0u, mt_ = 0u; float glo_ = __log2f((float)n) - 8.f, ghi_ = -9.f; int side_ = 0; bool done_ = false;
#pragma unroll 1
            for (int pass = 0; pass < 2 && !done_; ++pass) {
                const unsigned wdt = hi_ - lo_;
                unsigned off;
                if (pass < 2) {
                    const unsigned mkey = hi_ - 1u; const unsigned tgt = pass == 0 ? mkey - (1u << 23) : mkey - (3u << 23);
                    const bool ok = pass == 0 ? (mkey > 0x81000000u) : (mkey > 0x82000000u && tgt > lo_ && tgt < hi_);
                    off = ok ? tgt - lo_ : wdt >> 1;
                } else if ((pass & 3) == 3) off = wdt >> 1;
                else off = (unsigned)(glo_ * __builtin_amdgcn_rcpf(glo_ - ghi_) * (float)wdt);
                off = off < 1u ? 1u : (off > wdt - 1u ? wdt - 1u : off);
                const unsigned cand = (unsigned)__builtin_amdgcn_readfirstlane((int)(lo_ + off));
                unsigned ca_ = 0, cb_ = 0; const unsigned candv = lo_ + off;
#define IDX_CNT4(A, B, C, Dd) asm volatile("v_cmp_ge_u32_e64 s[88:89], %2, %6\n\tv_cmp_ge_u32_e64 s[90:91], %3, %6\n\tv_cmp_ge_u32_e64 s[92:93], %4, %6\n\tv_cmp_ge_u32_e64 s[94:95], %5, %6\n\t" \
                    "v_addc_co_u32_e64 %0, s[88:89], %0, 0, s[88:89]\n\tv_addc_co_u32_e64 %1, s[90:91], %1, 0, s[90:91]\n\tv_addc_co_u32_e64 %0, s[92:93], %0, 0, s[92:93]\n\tv_addc_co_u32_e64 %1, s[94:95], %1, 0, s[94:95]" \
                    : "+v"(ca_), "+v"(cb_) : "v"(A), "v"(B), "v"(C), "v"(Dd), "v"(candv) : "s88", "s89", "s90", "s91", "s92", "s93", "s94", "s95")
#pragma unroll
                for (int g8_ = 0; g8_ < 8; ++g8_) if (8 * g8_ < nil) { IDX_CNT4(r[8 * g8_], r[8 * g8_ + 1], r[8 * g8_ + 2], r[8 * g8_ + 3]); IDX_CNT4(r[8 * g8_ + 4], r[8 * g8_ + 5], r[8 * g8_ + 6], r[8 * g8_ + 7]); }
#undef IDX_CNT4
                int pk = (int)(ca_ + cb_);
                pk += __builtin_amdgcn_update_dpp(0, pk, 0x111, 0xf, 0xf, false);
                pk += __builtin_amdgcn_update_dpp(0, pk, 0x112, 0xf, 0xf, false);
                pk += __builtin_amdgcn_update_dpp(0, pk, 0x114, 0xf, 0xf, false);
                pk += __builtin_amdgcn_update_dpp(0, pk, 0x118, 0xf, 0xf, false);
                pk += __builtin_amdgcn_update_dpp(0, pk, 0x142, 0xa, 0xf, false);
                unsigned tot = (unsigned)__builtin_amdgcn_readlane(pk, 31) + (unsigned)__builtin_amdgcn_readlane(pk, 63);
                { unsigned pt_; IDX_XCHG16(tot, pt_); tot += pt_; }
                const float gc = __log2f(fmaxf((float)tot, 0.5f)) - 8.f;
                if (tot == 256u) { xgt_ = cand; mt_ = 0u; done_ = true; }
                else { if (tot > 256u) { if (side_ == 1) ghi_ *= 0.5f; lo_ = cand; glo_ = gc; side_ = 1; }
                       else { if (side_ == 2) glo_ *= 0.5f; hi_ = cand; ghi_ = gc; chi_ = tot; side_ = 2; }
                       if (hi_ - lo_ == 1u) { xgt_ = hi_; xeq_ = lo_; mt_ = 256u - chi_; done_ = true; } }
            }
            { LAS unsigned* hist = (LAS unsigned*)(lds + IDX_CTL_OFF + 1024) + q * 256;
#pragma unroll 1
              for (int round = 0; round < 6 && !done_; ++round) {
                const unsigned wdt = hi_ - lo_;
                const int sh = wdt <= 256u ? 0 : 24 - (int)__builtin_clz(wdt - 1u);
                hist[128 * h + lane] = 0u; hist[128 * h + 64 + lane] = 0u;
                LDS_WAIT(); { unsigned d_; IDX_XCHG16(0u, d_); (void)d_; }
                const unsigned lov = lo_;
                IDX_FOR_LIVE( const unsigned d = r[il] - lov; if (d < wdt) __hip_atomic_fetch_add(hist + (d >> sh), 1u, __ATOMIC_RELAXED, __HIP_MEMORY_SCOPE_WORKGROUP); )
                LDS_WAIT(); { unsigned d_; IDX_XCHG16(0u, d_); (void)d_; }
                const u32x4 hb = *(const LAS u32x4*)(hist + 4 * lane);
                const unsigned s4 = (hb.x + hb.y) + (hb.z + hb.w);
                unsigned suf = s4;
#pragma unroll
                for (int o = 1; o < 64; o <<= 1) { const unsigned tv = (unsigned)__shfl_down((int)suf, o); if (lane + o < 64) suf += tv; }
                const unsigned long long okm = __ballot(chi_ + suf >= 256u);
                const int L = 63 - (int)__builtin_clzll(okm);
                const unsigned above = chi_ + (unsigned)__builtin_amdgcn_readlane((int)(suf - s4), L);
                const unsigned h0 = (unsigned)__builtin_amdgcn_readlane((int)hb.x, L), h1 = (unsigned)__builtin_amdgcn_readlane((int)hb.y, L),
                               h2 = (unsigned)__builtin_amdgcn_readlane((int)hb.z, L), h3 = (unsigned)__builtin_amdgcn_readlane((int)hb.w, L);
                unsigned Bsel, cab, cnb;
                if (above + h3 >= 256u) { Bsel = 3u; cab = above; cnb = h3; }
                else if (above + h3 + h2 >= 256u) { Bsel = 2u; cab = above + h3; cnb = h2; }
                else if (above + h3 + h2 + h1 >= 256u) { Bsel = 1u; cab = above + h3 + h2; cnb = h1; }
                else { Bsel = 0u; cab = above + h3 + h2 + h1; cnb = h0; }
                Bsel += 4u * (unsigned)L;
                const unsigned nlo = lo_ + (Bsel << sh); unsigned nhi = nlo + (1u << sh); if (nhi > hi_ || nhi < nlo) nhi = hi_;
                if (cab + cnb == 256u) { xgt_ = nlo; mt_ = 0u; done_ = true; }
                else if (sh == 0) { xgt_ = nlo + 1u; xeq_ = nlo; mt_ = 256u - cab; done_ = true; }
                else { lo_ = nlo; hi_ = nhi; chi_ = cab; }
              } }
#ifdef IDX_XTRA
#pragma unroll 1
            for (int xr = 0; xr < IDX_XTRA; ++xr) { unsigned dsum = 0; const unsigned cv = xgt_ + (unsigned)xr;
                IDX_FOR_LIVE( dsum += r[il] >= cv; )
                int pk = (int)dsum;
                pk += __builtin_amdgcn_update_dpp(0, pk, 0x111, 0xf, 0xf, false); pk += __builtin_amdgcn_update_dpp(0, pk, 0x112, 0xf, 0xf, false); pk += __builtin_amdgcn_update_dpp(0, pk, 0x114, 0xf, 0xf, false);
                pk += __builtin_amdgcn_update_dpp(0, pk, 0x118, 0xf, 0xf, false); pk += __builtin_amdgcn_update_dpp(0, pk, 0x142, 0xa, 0xf, false);
                unsigned tot = (unsigned)__builtin_amdgcn_readlane(pk, 31) + (unsigned)__builtin_amdgcn_readlane(pk, 63);
                { unsigned pt_; IDX_XCHG16(tot, pt_); tot += pt_; } asm volatile("" :: "s"(tot)); }
#endif
            T_ = xgt_;
            if (mt_ != 0u) {
                if (h == 0) { unsigned run = 0u;
#pragma unroll 1
                    for (int i = 0; i <= (jmax >> 1); ++i) { const bool ok_ = 2 * i + hh <= jmax; const unsigned kv = ok_ ? row[64 * i] : 0u; const bool eq = kv == xeq_; const unsigned long long bm = __ballot(eq);
                        const unsigned rank = run + __builtin_amdgcn_mbcnt_hi((unsigned)(bm >> 32), __builtin_amdgcn_mbcnt_lo((unsigned)bm, 0u));
                        if (eq && rank >= mt_) row[64 * i] = 0u;
                        run += (unsigned)__popcll(bm); } }
                T_ = xeq_;
            }
            }
#undef IDX_XCHG
#undef IDX_XCHG16
#undef IDX_FOR_LIVE
        }
        if (lane == 0 && h == 0) thr[q] = T_;
    }
#ifdef PROBE_VALU
    { float a0 = (float)lane, a1 = a0 + 1.f, a2 = a0 + 2.f, a3 = a0 + 3.f, a4 = a0 + 4.f, a5 = a0 + 5.f, a6 = a0 + 6.f, a7 = a0 + 7.f; const float m = 1.0000001f, c = 1e-9f;
#pragma unroll 1
      for (int it = 0; it < 64; ++it) {
#pragma unroll
          for (int u = 0; u < 8; ++u) { a0 = a0 * m + c; a1 = a1 * m + c; a2 = a2 * m + c; a3 = a3 * m + c; a4 = a4 * m + c; a5 = a5 * m + c; a6 = a6 * m + c; a7 = a7 * m + c; } }
      asm volatile("" :: "v"(a0), "v"(a1), "v"(a2), "v"(a3), "v"(a4), "v"(a5), "v"(a6), "v"(a7)); }
#endif
    LDS_WAIT(); __builtin_amdgcn_s_barrier(); asm volatile("" ::: "memory");
    { const unsigned tq0 = thr[hh], tq1 = thr[2 + hh];
#pragma unroll 4
      for (int j = wid; j <= ((t0 | 255) >> 5); j += 8) {
          bool s0 = false, s1 = false;
          if (j <= jmax) { s0 = SCO[hh * 8192 + 32 * j + r32] >= tq0; s1 = SCO[(2 + hh) * 8192 + 32 * j + r32] >= tq1; }
          const unsigned long long b0_ = __ballot(s0), b1_ = __ballot(s1);
          if (lane == 0) { u32x4 o; o.x = (unsigned)b0_; o.y = (unsigned)(b0_ >> 32); o.z = (unsigned)b1_; o.w = (unsigned)(b1_ >> 32); *(u32x4*)(BM + ((size_t)b * 256 + j) * S + t0) = o; }
      } }
    LDS_WAIT(); __builtin_amdgcn_s_barrier();
}
DEV void idx_phase(LAS unsigned char* lds, unsigned char* ws, int vcu, int G, int wid, int lane) {
    constexpr int NUNIT = T / 4;
    const bf16_t* IQ = (const bf16_t*)(ws + WS_IQ); const bf16_t* IK = (const bf16_t*)(ws + WS_IK); const float* IW = (const float*)(ws + WS_IW);
#define IDX_UNIT_OF(k) ((k) * G + (((k) & 1) ? G - 1 - vcu : vcu))
    bf16x8 afr[4], b0[4], b1[4]; float w[16];
    int un = IDX_UNIT_OF(0);
    if (un < NUNIT) { const int b = un / (S / 4); idx_prefetch(afr, w, b0, b1, IQ, IK, IW, b, (un - b * (S / 4)) * 4, wid, lane); }
#pragma unroll 1
    for (int k = 0; un < NUNIT; ++k) {
        const int b = un / (S / 4), t0 = (un - b * (S / 4)) * 4;
        const int nun = IDX_UNIT_OF(k + 1); const int nb = nun / (S / 4), nt0 = nun < NUNIT ? (nun - nb * (S / 4)) * 4 : -1;
        idx_unit(lds, IQ, IK, IW, (unsigned*)(ws + WS_BM), b, t0, nb, nt0, wid, lane, afr, w, b0, b1);
        un = nun;
    }
#undef IDX_UNIT_OF
}

DEV void kn_phase(const WaveId& W, const bf16_t* Kk, float* KN) {
    for (int item = W.gw; item < NB * 8 * (S / 64); item += W.ngw) {
        const int b = item / (8 * (S / 64)), h = (item / (S / 64)) & 7, tile = item % (S / 64);
        const bf16_t* kp = Kk + ((size_t)b * S + tile * 64 + W.lane) * 512 + h * 64;
        float ss = 0.f;
#pragma unroll
        for (int c = 0; c < 8; ++c) { const u32x4 v = *(const u32x4*)(kp + 8 * c);
#pragma unroll
            for (int e = 0; e < 4; ++e) { const float lo = __uint_as_float(v[e] << 16), hi = __uint_as_float(v[e] & 0xffff0000u); ss += lo * lo + hi * hi; } }
        const float m = wave_max(ss);
        if (W.lane == 0) KN[item] = sqrtf(m) * 1.01f;
    }
}

constexpr int DSA_STAGE = 8192 + 64 * VPITCH;
DEV void dsa_unit(LAS unsigned char* lds, const bf16_t* Q, const bf16_t* Kk, const bf16_t* V, const unsigned* BM, const float* KN, bf16_t* O, int b, int h, int qblk, int tid, int wid, int lane) {
    const int r32 = lane & 31, hi = lane >> 5, q0 = 256 * qblk, t0 = q0 + 32 * wid, t = t0 + r32; const size_t rowb = (size_t)b * S;
    bf16x8 qr[4]; { const bf16_t* qp = Q + (rowb + t) * 512 + h * 64 + 8 * hi;
#pragma unroll
        for (int d0 = 0; d0 < 4; ++d0) qr[d0] = *(const bf16x8*)(qp + 16 * d0); }
    f32x16 o0, o1, negm;
#pragma unroll
    for (int r = 0; r < 16; ++r) { o0[r] = 0.f; o1[r] = 0.f; negm[r] = 0.f; }
    float mref = 0.f, lsum = 0.f; bool seen = false;
    float qn; { float qs = 0.f;
#pragma unroll
        for (int d0 = 0; d0 < 4; ++d0)
#pragma unroll
            for (int e = 0; e < 8; ++e) { const float x = __uint_as_float(((unsigned)(unsigned short)qr[d0][e]) << 16); qs += x * x; }
        const auto rr = __builtin_amdgcn_permlane32_swap(__float_as_uint(qs), __float_as_uint(qs), false, false); qn = sqrtf(__uint_as_float(rr[0]) + __uint_as_float(rr[1])) * 1.01f; }
    constexpr float FASTB = 60.f;
    int zlane = 0; asm volatile("" : "+v"(zlane));
    const float* knp = KN + (b * 8 + h) * (S / 64) + zlane;
    float knv = knp[0];
    constexpr float THR = 8.f;
    const int ntile = (q0 + 256) / 64, wlast = (t0 + 31) >> 6;
    const int srow = tid >> 3, sch = tid & 7;
    const bf16_t* kg = Kk + (rowb + srow) * 512 + h * 64 + sch * 8; const bf16_t* vg = V + (rowb + srow) * 512 + h * 64 + sch * 8;
    const int kdst = srow * 128 + ((sch ^ (srow & 7)) * 16), vdst = srow * VPITCH + sch * 16;
    u32x4 kr0 = *(const u32x4*)kg, vr0 = *(const u32x4*)vg;
    *(LAS u32x4*)(lds + kdst) = kr0; *(LAS u32x4*)(lds + 8192 + vdst) = vr0;
    u32x4 kr1 = *(const u32x4*)(kg + (size_t)64 * 512), vr1 = *(const u32x4*)(vg + (size_t)64 * 512);
    const unsigned* bmp = BM + (size_t)b * 256 * S + t;
    unsigned mw0 = bmp[0], mw1 = bmp[(size_t)S];
    const int koff = r32 * 128;
    __syncthreads();
#define DSA_TILE(c, BUF, NBUF, KL, VL, KW, VW) do { \
        const LAS unsigned char* kt = lds + (BUF) * DSA_STAGE; const LAS unsigned char* vt = kt + 8192; \
        if ((c) + 2 < ntile) { KL = *(const u32x4*)(kg + (size_t)((c) + 2) * 64 * 512); VL = *(const u32x4*)(vg + (size_t)((c) + 2) * 64 * 512); } \
        unsigned nw0 = 0u, nw1 = 0u; float nkn = 0.f; \
        if ((c) + 1 <= wlast) { nw0 = bmp[(size_t)(2 * (c) + 2) * S]; nw1 = bmp[(size_t)(2 * (c) + 3) * S]; nkn = knp[(c) + 1]; } \
        if ((c) <= wlast) { \
            bf16x8 kf[8]; \
            _Pragma("unroll") for (int d0 = 0; d0 < 4; ++d0) { const int xo = ((2 * d0 + hi) ^ (r32 & 7)) * 16; \
                kf[2 * d0] = *(const LAS bf16x8*)(kt + koff + xo); kf[2 * d0 + 1] = *(const LAS bf16x8*)(kt + koff + 4096 + xo); } \
            asm volatile("" : "+v"(kf[0]), "+v"(kf[1]), "+v"(kf[2]), "+v"(kf[3]), "+v"(kf[4]), "+v"(kf[5]), "+v"(kf[6]), "+v"(kf[7]));     \
            f32x16 p0 = negm, p1 = negm; \
            _Pragma("unroll") for (int d0 = 0; d0 < 4; ++d0) { p0 = __builtin_amdgcn_mfma_f32_32x32x16_bf16(kf[2 * d0], qr[d0], p0, 0, 0, 0); p1 = __builtin_amdgcn_mfma_f32_32x32x16_bf16(kf[2 * d0 + 1], qr[d0], p1, 0, 0, 0); } \
            const unsigned m0 = mw0 >> (4 * hi), m1 = mw1 >> (4 * hi); \
            _Pragma("unroll") for (int r = 0; r < 16; ++r) { const int bit = (r & 3) + 8 * (r >> 2); \
                const unsigned e0 = (unsigned)__builtin_amdgcn_sbfe((int)m0, bit, 1), e1 = (unsigned)__builtin_amdgcn_sbfe((int)m1, bit, 1); \
                p0[r] = __uint_as_float((__float_as_uint(p0[r]) & e0) | (0xff800000u & ~e0)); p1[r] = __uint_as_float((__float_as_uint(p1[r]) & e1) | (0xff800000u & ~e1)); } \
            if (__any(!(qn * knv + fabsf(mref) <= FASTB))) {     \
                float rm = -INFINITY; \
                _Pragma("unroll") for (int r = 0; r < 16; r += 2) rm = fmaxf(rm, fmaxf(fmaxf(p0[r], p0[r + 1]), fmaxf(p1[r], p1[r + 1]))); \
                { const auto rr = __builtin_amdgcn_permlane32_swap(__float_as_uint(rm), __float_as_uint(rm), false, false); rm = fmaxf(__uint_as_float(rr[0]), __uint_as_float(rr[1])); } \
                const bool shift = rm > THR || (rm < -THR && rm > -INFINITY && !seen);     \
                if (__any(shift)) { \
                    const float dl = shift ? rm : 0.f, f = dl > 0.f ? __builtin_amdgcn_exp2f(-dl) : 1.f; \
                    mref += dl; lsum *= f; \
                    _Pragma("unroll") for (int r = 0; r < 16; ++r) { p0[r] -= dl; p1[r] -= dl; o0[r] *= f; o1[r] *= f; negm[r] = -mref; } \
                } \
            } \
            seen = seen || (mw0 | mw1) != 0u;     \
            float ps = 0.f; \
            _Pragma("unroll") for (int r = 0; r < 16; ++r) { p0[r] = __builtin_amdgcn_exp2f(p0[r]); p1[r] = __builtin_amdgcn_exp2f(p1[r]); ps += p0[r] + p1[r]; } \
            lsum += ps; \
            bf16x8 pk[4]; \
            pk[0] = pk8(p0[0], p0[1], p0[2], p0[3], p0[4], p0[5], p0[6], p0[7]); pk[1] = pk8(p0[8], p0[9], p0[10], p0[11], p0[12], p0[13], p0[14], p0[15]); \
            pk[2] = pk8(p1[0], p1[1], p1[2], p1[3], p1[4], p1[5], p1[6], p1[7]); pk[3] = pk8(p1[8], p1[9], p1[10], p1[11], p1[12], p1[13], p1[14], p1[15]); \
            pv_tile(o0, o1, vt, lane, pk); \
        } \
        mw0 = nw0; mw1 = nw1; knv = nkn; \
        if ((c) + 1 < ntile) { LAS unsigned char* nb = lds + (NBUF) * DSA_STAGE; *(LAS u32x4*)(nb + kdst) = KW; *(LAS u32x4*)(nb + 8192 + vdst) = VW; } \
        asm volatile("s_waitcnt lgkmcnt(0)" ::: "memory"); __builtin_amdgcn_s_barrier(); asm volatile("" ::: "memory"); } while (0)
#pragma unroll 1
    for (int c = 0; c < ntile; c += 2) { DSA_TILE(c, 0, 1, kr0, vr0, kr1, vr1); DSA_TILE(c + 1, 1, 0, kr1, vr1, kr0, vr0); }
#undef DSA_TILE
    { const auto rr = __builtin_amdgcn_permlane32_swap(__float_as_uint(lsum), __float_as_uint(lsum), false, false); lsum = __uint_as_float(rr[0]) + __uint_as_float(rr[1]); }
    store_ot(O + (rowb + t) * 512 + h * 64, o0, o1, hi, 1.f / lsum);
}
DEV void dsa_phase(LAS unsigned char* lds, unsigned char* ws, int vcu, int G, int tid, int wid, int lane, bf16_t* Oout) {
    constexpr int NPAIR = NB * 8 * 16;
    for (int pr = vcu; pr < NPAIR; pr += G) {
        const int bh = pr >> 4, s = pr & 15, b = bh >> 3, h = bh & 7;
#pragma unroll 1
        for (int k = 0; k < 2; ++k) {
            const int qblk = k == 0 ? s : 31 - s;
            dsa_unit(lds, (const bf16_t*)(ws + WS_QC), (const bf16_t*)(ws + WS_KC), (const bf16_t*)(ws + WS_VC), (const unsigned*)(ws + WS_BM), (const float*)(ws + WS_KN), Oout, b, h, qblk, tid, wid, lane);
        }
    }
}
#include <hip/hip_bf16.h>
namespace attn_body {
using bf16=__hip_bfloat16;
using bf16x8=__attribute__((ext_vector_type(8)))short;
using s16x4=__attribute__((ext_vector_type(4)))short;
using f32x16=__attribute__((ext_vector_type(16)))float;
using u32x4=__attribute__((ext_vector_type(4)))unsigned;
constexpr int BATCH=2,NHEAD=8,SEQ=8192,D=64,DM=NHEAD*D;
constexpr int NW=8,QBLK=32,QB=QBLK*NW,KVBLK=64,NQB=SEQ/QB;
constexpr int ATTN_PITCH=DM, ATTN_UNIT_ROWS=QB;
__device__ __forceinline__ int crow(int r,int hi){return (r&3)+8*(r>>2)+4*hi;}
#define SBAR() __builtin_amdgcn_sched_barrier(0)
__device__ __forceinline__ void cmask(f32x16&p0,f32x16&p1,int jb,int qrel,int hi){
  const float NEG=-INFINITY; int kb=64*jb+4*hi;
  #pragma unroll
  for(int r=0;r<16;++r){int kv=kb+(r&3)+8*(r>>2); if(kv>qrel)p0[r]=NEG; if(kv+32>qrel)p1[r]=NEG;}
}

constexpr int NSLOT=3, SLOTB=8192;
constexpr int LDS_K=0, LDS_V=NSLOT*SLOTB, LDS_WS=2*NSLOT*SLOTB, LDS_OST=LDS_WS+NW*64*4, LDS_BYTES=LDS_OST+NW*4096;
constexpr float C2=0.125f*1.4426950408889634f;
__device__ __forceinline__ void glds16(const void*gsrc,unsigned lds_dst){unsigned keep;
  asm volatile("s_mov_b32 %0, m0\n\ts_mov_b32 m0, %2\n\ts_nop 0\n\tglobal_load_lds_dwordx4 %1, off\n\ts_mov_b32 m0, %0":"=&s"(keep):"v"(gsrc),"s"(lds_dst):"memory");}
__device__ __forceinline__ float max3f(float a,float b,float c){float r;asm("v_max3_f32 %0, %1, %2, %3":"=v"(r):"v"(a),"v"(b),"v"(c));return r;}
__device__ __forceinline__ float max2f(float a,float b){float r;asm("v_max_f32_e32 %0, %1, %2":"=v"(r):"v"(a),"v"(b));return r;}
__device__ __forceinline__ float fadd_s(float a,float b){float r;asm("v_add_f32_e32 %0, %1, %2":"=v"(r):"v"(a),"v"(b));return r;}
__device__ __forceinline__ float fsub_s(float a,float b){float r;asm("v_sub_f32_e32 %0, %1, %2":"=v"(r):"v"(a),"v"(b));return r;}
typedef float f32x2_t __attribute__((ext_vector_type(2))); typedef __bf16 bf16x2_t __attribute__((ext_vector_type(2)));
__device__ __forceinline__ unsigned cvtpk_s(float lo,float hi){f32x2_t v={lo,hi};bf16x2_t b=__builtin_convertvector(v,bf16x2_t);return __builtin_bit_cast(unsigned,b);}
#define WAIT_BAR(N) asm volatile("s_waitcnt vmcnt(" #N ") lgkmcnt(0)\n\ts_barrier":::"memory")

__device__ __forceinline__ void qkt(f32x16&p0,f32x16&p1,const char*Kslot,const bf16x8*qr,const f32x16&negm,int r32,int hi){
  const char*kb=Kslot+hi*1024+r32*16;
  #pragma unroll
  for(int d0=0;d0<4;++d0){
    const bf16x8 b0=*reinterpret_cast<const bf16x8*>(kb+d0*2048);
    const bf16x8 b1=*reinterpret_cast<const bf16x8*>(kb+d0*2048+512);
    if(d0==0){p0=__builtin_amdgcn_mfma_f32_32x32x16_bf16(b0,qr[0],negm,0,0,0);p1=__builtin_amdgcn_mfma_f32_32x32x16_bf16(b1,qr[0],negm,0,0,0);}
    else{p0=__builtin_amdgcn_mfma_f32_32x32x16_bf16(b0,qr[d0],p0,0,0,0);p1=__builtin_amdgcn_mfma_f32_32x32x16_bf16(b1,qr[d0],p1,0,0,0);}}
}
typedef __attribute__((address_space(3))) const char* lds_cptr;
typedef short v4i16_t __attribute__((ext_vector_type(4)));
__device__ __forceinline__ void kload8(bf16x8*kf,lds_cptr kp){
  kf[0]=*(const __attribute__((address_space(3))) bf16x8*)(kp);      kf[1]=*(const __attribute__((address_space(3))) bf16x8*)(kp+512);
  kf[2]=*(const __attribute__((address_space(3))) bf16x8*)(kp+2048); kf[3]=*(const __attribute__((address_space(3))) bf16x8*)(kp+2560);
  kf[4]=*(const __attribute__((address_space(3))) bf16x8*)(kp+4096); kf[5]=*(const __attribute__((address_space(3))) bf16x8*)(kp+4608);
  kf[6]=*(const __attribute__((address_space(3))) bf16x8*)(kp+6144); kf[7]=*(const __attribute__((address_space(3))) bf16x8*)(kp+6656);
}
__device__ __forceinline__ void kload2(bf16x8*kf,lds_cptr kp,int j){ kf[2*j]=*(const __attribute__((address_space(3))) bf16x8*)(kp+j*2048); kf[2*j+1]=*(const __attribute__((address_space(3))) bf16x8*)(kp+j*2048+512); }
__device__ __forceinline__ s16x4 vtr(lds_cptr p){ return __builtin_bit_cast(s16x4,__builtin_amdgcn_ds_read_tr16_b64_v4i16((__attribute__((address_space(3))) v4i16_t*)p)); }
__device__ __forceinline__ float rowmax(const f32x16&p0,const f32x16&p1){
  float a=max3f(p0[0],p0[1],p1[0]),b=max3f(p0[2],p0[3],p1[1]);a=max3f(a,p1[2],p1[3]);
  #pragma unroll
  for(int r=4;r<16;r+=4){a=max3f(a,p0[r],p0[r+1]);b=max3f(b,p0[r+2],p0[r+3]);a=max3f(a,p1[r],p1[r+1]);b=max3f(b,p1[r+2],p1[r+3]);}
  const float m=max2f(a,b);
  auto rr=__builtin_amdgcn_permlane32_swap(__float_as_uint(m),__float_as_uint(m),false,false);
  return max2f(__uint_as_float(rr[0]),__uint_as_float(rr[1]));
}
__device__ __forceinline__ void pv(f32x16*o,int vb,bf16x8 pa0,bf16x8 pa1,bf16x8 pa2,bf16x8 pa3){
  #pragma unroll
  for(int d0=0;d0<2;++d0){s16x4 lo[4],hi[4];
    #pragma unroll
    for(int ks=0;ks<4;++ks){
      asm volatile("ds_read_b64_tr_b16 %0,%1 offset:%c2":"=&v"(lo[ks]):"v"(vb),"i"(d0*4096+ks*1024):"memory");
      asm volatile("ds_read_b64_tr_b16 %0,%1 offset:%c2":"=&v"(hi[ks]):"v"(vb),"i"(d0*4096+ks*1024+512):"memory");}
    asm volatile("s_waitcnt lgkmcnt(0)":::"memory");SBAR();
    #define PK(k) (bf16x8){lo[k][0],lo[k][1],lo[k][2],lo[k][3],hi[k][0],hi[k][1],hi[k][2],hi[k][3]}
    o[d0]=__builtin_amdgcn_mfma_f32_32x32x16_bf16(pa0,PK(0),o[d0],0,0,0);
    o[d0]=__builtin_amdgcn_mfma_f32_32x32x16_bf16(pa1,PK(1),o[d0],0,0,0);
    o[d0]=__builtin_amdgcn_mfma_f32_32x32x16_bf16(pa2,PK(2),o[d0],0,0,0);
    o[d0]=__builtin_amdgcn_mfma_f32_32x32x16_bf16(pa3,PK(3),o[d0],0,0,0);
    #undef PK
  }
}

#ifndef ATTN_STORE16
#define ATTN_STORE16(p,v) (*(u32x4*)(p)=(v))
#endif
template<int THRL> __device__ __forceinline__ void attn_unit(int b,int h,int qb,const bf16*Q,const bf16*__restrict__ K,const bf16*__restrict__ V,bf16*O,char*shm,const unsigned*__restrict__ BMb,const float*KNbh,const int tid){
  const int lane=tid&63,r32=lane&31,hi=lane>>5; const int wid=__builtin_amdgcn_readfirstlane(tid>>6);
  const long rowbase=(long)b*SEQ; const int q0=qb*QB;
  const bf16*Qw=Q+(rowbase+q0+wid*QBLK)*DM+h*D;
  const bf16*Kh=K+rowbase*DM+h*D,*Vh=V+rowbase*DM+h*D;
  const unsigned lds0=(unsigned)(uintptr_t)shm;
  float*wsf=(float*)(shm+LDS_WS)+wid*64;
  const bf16*ksrc=Kh+(long)lane*DM+wid*8;
  const bf16*vsrc=Vh+(long)(16*(wid&3)+(lane>>2))*DM+(wid>>2)*32+(lane&3)*8;
  const unsigned kdst=lds0+LDS_K+wid*1024, vdst=lds0+LDS_V+wid*1024;
  #define DMA_K(t,slot) glds16(ksrc+(long)(t)*KVBLK*DM,(unsigned)__builtin_amdgcn_readfirstlane(kdst+(slot)))
  #define DMA_V(t,slot) glds16(vsrc+(long)(t)*KVBLK*DM,(unsigned)__builtin_amdgcn_readfirstlane(vdst+(slot)))
  const int vb0=(int)(lds0+LDS_V)+((lane>>4)&1)*32+(lane&3)*8+(4*hi+((lane&15)>>2))*64;
  const char*Kbase=shm+LDS_K; bf16x8 kf[8];
  const lds_cptr shm3=(lds_cptr)shm; const lds_cptr kp0=shm3+LDS_K+hi*1024+r32*16; const lds_cptr vp0=shm3+LDS_V+((lane>>4)&1)*32+(lane&3)*8+(4*hi+((lane&15)>>2))*64;
  const int NT=(q0+QB)/KVBLK;
  DMA_K(0,0);DMA_V(0,0);DMA_K(1,SLOTB);
  bf16x8 qr[4];
  #pragma unroll
  for(int d0=0;d0<4;++d0)qr[d0]=*reinterpret_cast<const bf16x8*>(&Qw[(long)r32*DM+d0*16+hi*8]);
  const unsigned*bmp=BMb+(q0+wid*QBLK+r32);
  unsigned mw0=bmp[0],mw1=bmp[(size_t)SEQ],mx0=bmp[(size_t)2*SEQ],mx1=bmp[(size_t)3*SEQ];
  bool seen=false;
  float qn; { float qs=0.f;
    _Pragma("unroll") for(int d0=0;d0<4;++d0) _Pragma("unroll") for(int e=0;e<8;++e){ const float x=__uint_as_float(((unsigned)(unsigned short)qr[d0][e])<<16); qs+=x*x; }
    auto rr=__builtin_amdgcn_permlane32_swap(__float_as_uint(qs),__float_as_uint(qs),false,false); qn=__builtin_sqrtf(__uint_as_float(rr[0])+__uint_as_float(rr[1]))*1.01f; }
  constexpr float FASTB=60.f;
  int zlane=0; asm volatile("":"+v"(zlane));
  const float*knp=KNbh+zlane;
  #define KNS(x) (x)
  float kn0=KNS(knp[0]),kn1=KNS(knp[1]);
  bool anysel_=false;
  #define SLOWT() (__any(!(qn*kn0<=FASTB)||mhat!=0.f))
  float mhat=0.f,l_reg=0.f;f32x16 o[2];o[0]=f32x16{};o[1]=f32x16{};const f32x16 zero16=f32x16{};
  const int qrel=wid*QBLK+r32;
  #define CMASK(P0,P1,SLOW) do{ const unsigned m0_=mw0>>(4*hi), m1_=mw1>>(4*hi); anysel_=(mw0|mw1)!=0u; \
    if(SLOW){ _Pragma("unroll") for(int r=0;r<16;++r){ P0[r]-=mhat; P1[r]-=mhat; } } \
    _Pragma("unroll") for(int r=0;r<16;++r){ const int bit_=(r&3)+8*(r>>2); \
      const unsigned e0_=(unsigned)__builtin_amdgcn_sbfe((int)m0_,bit_,1), e1_=(unsigned)__builtin_amdgcn_sbfe((int)m1_,bit_,1); \
      P0[r]=__uint_as_float((__float_as_uint(P0[r])&e0_)|(0xff800000u&~e0_)); P1[r]=__uint_as_float((__float_as_uint(P1[r])&e1_)|(0xff800000u&~e1_)); } \
    mw0=mx0; mw1=mx1; mx0=nwa_; mx1=nwb_; kn0=kn1; kn1=KNS(nk_); }while(0)
  bool resc=false;
  #define START(P0,P1,SLOW) do{ resc=false; seen=anysel_; \
    if(SLOW){ const float rm=rowmax(P0,P1); const float dl=(rm==-INFINITY)?0.f:rm; mhat=fadd_s(mhat,dl); \
      _Pragma("unroll") for(int r=0;r<16;++r){P0[r]=fsub_s(P0[r],dl);P1[r]=fsub_s(P1[r],dl);} \
      } \
    _Pragma("unroll") for(int r=0;r<16;++r)P0[r]=__builtin_amdgcn_exp2f(P0[r]); }while(0)
  #define RESC() do{ if(resc){ asm volatile("s_waitcnt lgkmcnt(0)":::"memory"); \
      _Pragma("unroll") for(int d_=0;d_<2;++d_) _Pragma("unroll") for(int r=0;r<16;++r)o[d_][r]*=wsf[crow(r,hi)]; } }while(0)
  f32x16 pA0,pA1,pB0,pB1;
  int sl_prev=0,sl_cur=0,sl_next=SLOTB;
  #define ROT() do{sl_prev=sl_cur;sl_cur=sl_next;sl_next=(sl_next==(NSLOT-1)*SLOTB)?0:sl_next+SLOTB;}while(0)
  DMA_K(2,2*SLOTB);
  WAIT_BAR(3);
  { unsigned nwa_=bmp[(size_t)4*SEQ],nwb_=bmp[(size_t)5*SEQ]; const float nk_=knp[2];
  const bool slow0_=SLOWT();
  qkt(pA0,pA1,Kbase,qr,zero16,r32,hi);asm volatile("s_nop 15\n\ts_nop 7":"+v"(pA0),"+v"(pA1));CMASK(pA0,pA1,slow0_);
  START(pA0,pA1,slow0_); }
  _Pragma("unroll") for(int r=0;r<16;++r)pA1[r]=__builtin_amdgcn_exp2f(pA1[r]);
  WAIT_BAR(0);
  DMA_K(3,0);DMA_V(1,SLOTB);
  ROT();
  kload8(kf,kp0+sl_cur);
  WAIT_BAR(2);
  s16x4 vlo[8],vhi[8]; u32x4 pw0,pw1,pw2,pw3;
  #define PKW(P,B) cvtpk_s(P[B],P[B+1])
  #define PAF(k) __builtin_bit_cast(bf16x8,pw##k)
  #define VFR(i) (bf16x8){vlo[i][0],vlo[i][1],vlo[i][2],vlo[i][3],vhi[i][0],vhi[i][1],vhi[i][2],vhi[i][3]}
  #define PIN(x) asm volatile("":"+v"(x))
  #define MX3(a,b,c) __builtin_fmaxf(__builtin_fmaxf((a),(b)),(c))
  #define GAPA(MF,A0,A1,A2,A3,W0,W1,PW) do{ MF; sacc+=A0; sacc+=A1; sacc+=A2; sacc+=A3; PIN(sacc); W0; W1; PIN(PW); SBAR(); }while(0)
  #define EX(v) __builtin_amdgcn_exp2f(v)
  #define GAPB(MF,X,B) do{ MF; X[B]=EX(X[B]); X[B+1]=EX(X[B+1]); X[B+2]=EX(X[B+2]); X[B+3]=EX(X[B+3]); PIN(X); SBAR(); }while(0)
  #define VRD(i) do{ vlo[i]=vtr(vp_+(((i)>>2)*4096+((i)&3)*1024)); vhi[i]=vtr(vp_+(((i)>>2)*4096+((i)&3)*1024+512)); }while(0)
  #define KRD(G,j) do{ if(G){ kload2(kf,kp0+sl_next,j); SBAR(); } }while(0)
  #define STEP(C0,C1,P0,P1,t,GK,GV,GL) do{ SBAR(); \
    unsigned nwa_=0u,nwb_=0u; float nk_=0.f; if((t)+2<NT){ nwa_=bmp[(size_t)(2*(t)+4)*SEQ]; nwb_=bmp[(size_t)(2*(t)+5)*SEQ]; nk_=knp[(t)+2]; }     \
    const lds_cptr vp_=vp0+sl_prev; \
    VRD(0); SBAR(); float sacc=(P0[0]+P0[1]); \
    GAPA(C0=__builtin_amdgcn_mfma_f32_32x32x16_bf16(kf[0],qr[0],zero16,0,0,0), P0[2],P0[3],P0[4],P0[5],     pw0[0]=PKW(P0,0), pw0[1]=PKW(P0,2), pw0); \
    VRD(4); SBAR(); GAPA(C1=__builtin_amdgcn_mfma_f32_32x32x16_bf16(kf[1],qr[0],zero16,0,0,0), P0[6],P0[7],P0[8],P0[9],     pw0[2]=PKW(P0,4), pw0[3]=PKW(P0,6), pw0); \
    VRD(1); SBAR(); GAPA(C0=__builtin_amdgcn_mfma_f32_32x32x16_bf16(kf[2],qr[1],C0,0,0,0),   P0[10],P0[11],P0[12],P0[13], pw1[0]=PKW(P0,8), pw1[1]=PKW(P0,10), pw1); \
    VRD(5); SBAR(); GAPA(C1=__builtin_amdgcn_mfma_f32_32x32x16_bf16(kf[3],qr[1],C1,0,0,0),   P0[14],P0[15],P1[0],P1[1],   pw1[2]=PKW(P0,12),pw1[3]=PKW(P0,14), pw1); \
    VRD(2); SBAR(); GAPA(C0=__builtin_amdgcn_mfma_f32_32x32x16_bf16(kf[4],qr[2],C0,0,0,0),   P1[2],P1[3],P1[4],P1[5],     pw2[0]=PKW(P1,0), pw2[1]=PKW(P1,2), pw2); \
    VRD(6); SBAR(); GAPA(C1=__builtin_amdgcn_mfma_f32_32x32x16_bf16(kf[5],qr[2],C1,0,0,0),   P1[6],P1[7],P1[8],P1[9],     pw2[2]=PKW(P1,4), pw2[3]=PKW(P1,6), pw2); \
    VRD(3); SBAR(); GAPA(C0=__builtin_amdgcn_mfma_f32_32x32x16_bf16(kf[6],qr[3],C0,0,0,0),   P1[10],P1[11],P1[12],P1[13], pw3[0]=PKW(P1,8), pw3[1]=PKW(P1,10), pw3); \
    VRD(7); SBAR(); GAPA(C1=__builtin_amdgcn_mfma_f32_32x32x16_bf16(kf[7],qr[3],C1,0,0,0),   P1[14],P1[15],0.f,0.f,       pw3[2]=PKW(P1,12),pw3[3]=PKW(P1,14), pw3); \
    l_reg+=sacc; \
    if(GK){DMA_K((t)+3,sl_cur);} if(GV){DMA_V((t)+1,sl_next);} \
    const bool slow_=SLOWT(); CMASK(C0,C1,slow_); resc=false; \
    if(__builtin_expect(slow_,0)){ float a=MX3(C0[0],C0[1],C1[0]),b=MX3(C0[2],C0[3],C1[1]); a=MX3(a,C1[2],C1[3]); \
      _Pragma("unroll") for(int r=4;r<16;r+=4){a=MX3(a,C0[r],C0[r+1]);b=MX3(b,C0[r+2],C0[r+3]);a=MX3(a,C1[r],C1[r+1]);b=MX3(b,C1[r+2],C1[r+3]);} \
      float rm=__builtin_fmaxf(a,b); { auto rr=__builtin_amdgcn_permlane32_swap(__float_as_uint(rm),__float_as_uint(rm),false,false); rm=__builtin_fmaxf(__uint_as_float(rr[0]),__uint_as_float(rr[1])); } \
      const bool fresh_=!seen&&rm>-INFINITY;     \
      if(__builtin_expect(__any(rm>(float)THRL||(fresh_&&rm<-(float)THRL)),0)){ const float dl=fresh_?rm:__builtin_fmaxf(rm,0.f); mhat+=dl; \
        _Pragma("unroll") for(int r=0;r<16;++r){C0[r]-=dl;C1[r]-=dl;} \
        const float f=dl>0.f?__builtin_amdgcn_exp2f(-dl):1.f; l_reg*=f; if(hi==0)wsf[r32]=f; resc=true; } } \
    seen=seen||anysel_; \
    SBAR(); \
    GAPB(o[0]=__builtin_amdgcn_mfma_f32_32x32x16_bf16(PAF(0),VFR(0),o[0],0,0,0), C0,0); \
    GAPB(o[1]=__builtin_amdgcn_mfma_f32_32x32x16_bf16(PAF(0),VFR(4),o[1],0,0,0), C0,4); \
    KRD(GL,0); GAPB(o[0]=__builtin_amdgcn_mfma_f32_32x32x16_bf16(PAF(1),VFR(1),o[0],0,0,0), C0,8); \
    KRD(GL,1); GAPB(o[1]=__builtin_amdgcn_mfma_f32_32x32x16_bf16(PAF(1),VFR(5),o[1],0,0,0), C0,12); \
    KRD(GL,2); GAPB(o[0]=__builtin_amdgcn_mfma_f32_32x32x16_bf16(PAF(2),VFR(2),o[0],0,0,0), C1,0); \
    KRD(GL,3); GAPB(o[1]=__builtin_amdgcn_mfma_f32_32x32x16_bf16(PAF(2),VFR(6),o[1],0,0,0), C1,4); \
    GAPB(o[0]=__builtin_amdgcn_mfma_f32_32x32x16_bf16(PAF(3),VFR(3),o[0],0,0,0), C1,8); \
    GAPB(o[1]=__builtin_amdgcn_mfma_f32_32x32x16_bf16(PAF(3),VFR(7),o[1],0,0,0), C1,12); \
    }while(0)
  int t=1;
  for(;t+5<NT;t+=2){
    STEP(pB0,pB1,pA0,pA1,t,true,true,true);     WAIT_BAR(2); RESC(); ROT();
    STEP(pA0,pA1,pB0,pB1,t+1,true,true,true);   WAIT_BAR(2); RESC(); ROT();
  }
  #define ENDW(tt) do{ if((tt)+3<NT){WAIT_BAR(2);} else if((tt)+2<NT){WAIT_BAR(1);} else {WAIT_BAR(0);} }while(0)
  for(;t+1<NT;t+=2){
    STEP(pB0,pB1,pA0,pA1,t,(t+3<NT),(t+1<NT),(t+1<NT));       ENDW(t);   RESC(); ROT();
    STEP(pA0,pA1,pB0,pB1,t+1,(t+4<NT),(t+2<NT),(t+2<NT));     ENDW(t+1); RESC(); ROT();
  }
  STEP(pB0,pB1,pA0,pA1,NT-1,false,false,false); RESC();
  { float sacc=pB0[0]+pB0[1]; _Pragma("unroll") for(int r=2;r<16;++r)sacc+=pB0[r]; _Pragma("unroll") for(int r=0;r<16;++r)sacc+=pB1[r]; l_reg+=sacc;
    pw0=(u32x4){PKW(pB0,0),PKW(pB0,2),PKW(pB0,4),PKW(pB0,6)};pw1=(u32x4){PKW(pB0,8),PKW(pB0,10),PKW(pB0,12),PKW(pB0,14)};pw2=(u32x4){PKW(pB1,0),PKW(pB1,2),PKW(pB1,4),PKW(pB1,6)};pw3=(u32x4){PKW(pB1,8),PKW(pB1,10),PKW(pB1,12),PKW(pB1,14)};
    SBAR(); pv(o,vb0+sl_cur,PAF(0),PAF(1),PAF(2),PAF(3)); }
  #undef PKW
  #undef PAF
  #undef VFR
  #undef PIN
  #undef MX3
  #undef GAPA
  #undef GAPB
  #undef EX
  #undef VRD
  #undef KRD
  #undef STEP
  #undef ENDW
  {auto rr=__builtin_amdgcn_permlane32_swap(__float_as_uint(l_reg),__float_as_uint(l_reg),false,false);l_reg=__uint_as_float(rr[0])+__uint_as_float(rr[1]);}
  if(hi==0)wsf[32+r32]=l_reg;asm volatile("s_waitcnt lgkmcnt(0)":::"memory");
  float rli[16];
  #pragma unroll
  for(int r=0;r<16;++r)rli[r]=__builtin_amdgcn_rcpf(wsf[32+crow(r,hi)]);
  bf16*Ow=O+(rowbase+q0+wid*QBLK)*DM+h*D;
  { bf16*stg=(bf16*)(shm+LDS_OST)+wid*2048;
    #pragma unroll
    for(int r=0;r<16;++r){const int orow=crow(r,hi);
      #pragma unroll
      for(int d0=0;d0<2;++d0)stg[orow*64+d0*32+r32]=__float2bfloat16(o[d0][r]*rli[r]);}
    asm volatile("s_waitcnt lgkmcnt(0)":::"memory");
    #pragma unroll
    for(int i=0;i<4;++i){const int row=i*8+(lane>>3),ch=lane&7; const u32x4 v=*(const u32x4*)(stg+row*64+ch*8); ATTN_STORE16(Ow+(long)row*DM+ch*8,v);} }
  asm volatile("s_waitcnt lgkmcnt(0)\n\ts_barrier":::"memory");
  #undef DMA_K
  #undef DMA_V
  #undef CMASK
  #undef SLOWT
  #undef KNS
  #undef START
  #undef RESC
  #undef ROT
}
constexpr int ATTN_LDS_BYTES=LDS_BYTES;
#undef SBAR
#undef WAIT_BAR
}
constexpr int MK_THREADS = 512;
constexpr int RING_BYTES = 131072, MISC_OFF = RING_BYTES + 320, MK_LDS_BYTES = 147456;
constexpr size_t WS_CTL = 0, CTL_ZERO_BYTES = 65536 + 7 * 131072; constexpr int CW_BAR = 4096;
constexpr int PH_PREP0 = 0, PH_KV = 1, PH_GH = 2, PH_L0 = 3, PH_PER_LAYER = 14, NPH = PH_L0 + 2 * PH_PER_LAYER;
enum { Q_INPROJ = 0, Q_SBIDX, Q_DSA, Q_GATES, Q_MERGE, Q_MIX, Q_NORMXA, Q_XALOG, Q_XAOUT, Q_NORMFFN, Q_UP, Q_FFNMID, Q_DOWN, Q_NEXT };

#ifndef QBUILD
#define QBUILD 0xffffu
#endif
#define QON(x) ((QBUILD >> (x)) & 1u)
struct Args { const float* in[20]; float* out; unsigned char* ws; int ph_lo, ph_hi; };

__global__ void __launch_bounds__(MK_THREADS, 2) mk_fwd(Args args) {
    __shared__ __attribute__((aligned(16))) unsigned char lds_raw[MK_LDS_BYTES];
    LAS unsigned char* lds = (LAS unsigned char*)lds_raw;
    volatile LAS unsigned* MISC = (volatile LAS unsigned*)(lds + MISC_OFF);
    const int G = gridDim.x, bx = blockIdx.x;
    unsigned char* ws0 = args.ws;
    const int wave_s = __builtin_amdgcn_readfirstlane((int)threadIdx.x >> 6);
    for (int u = mk_tid(wave_s); u < (MK_LDS_BYTES - RING_BYTES) / 4; u += MK_THREADS) ((LAS unsigned*)(lds + RING_BYTES))[u] = 0u;
    __syncthreads();
    const int lo = args.ph_lo, hi = args.ph_hi;
    XcdBarrier bar; bar.bar = (unsigned*)(ws0 + WS_CTL) + CW_BAR; bar.x = 0; bar.st = nullptr;
    if (hi - lo > 1) bar = xcd_barrier_post((unsigned*)(ws0 + WS_CTL) + CW_BAR, MISC + 8, mk_tid(wave_s));
#define BPW(off) ((bf16_t*)(ws + (off)))
    const int vcu = (G % 8 == 0) ? (bx % 8) * (G / 8) + bx / 8 : bx;
    for (int p = lo; p < hi; ++p) {
#ifdef PROBE_REP
        const int reps = (p >= PH_L0 && ((PROBE_REP >> ((p - PH_L0) % PH_PER_LAYER)) & 1)) ? 2 : 1;
#else
        const int reps = 1;
#endif
#ifdef PROBE_REP
#pragma unroll 1
        for (int rep = 0; rep < reps; ++rep) {
        const bool dry = rep + 1 < reps;
#else
        { constexpr bool dry = false;
#endif
        int oz = 0; asm volatile("" : "+s"(oz));
        int tid = mk_tid(wave_s); asm volatile("" : "+v"(tid));
        const int wave = __builtin_amdgcn_readfirstlane(tid >> 6), lane = tid & 63;
        WaveId W; W.gw = vcu * 8 + wave; W.ngw = G * 8; W.wave = wave; W.lane = lane;
        unsigned char* ws = args.ws + oz; float* X = args.out + oz;
#define INP(k) (args.in[(k) + oz])
        if (p == PH_PREP0) {
            prep0_phase(W, (LAS float*)(lds + wave * 16384), ws, args.in + oz, (bf16_t*)X);
        } else if (p == PH_KV && QON(14)) {
            pg8::Order S; S.init(2, 8, 2, G, bx);
            pg8::PtrStd P{(const char*)(ws + WS_MEMN), (const char*)(ws + WS_WKVT), 1 * MiB, 4 * MiB, 0, (size_t)256 * D * 2, (size_t)256 * D * 2};
            pg8::EpiPrep E{ws, 0};
            pg8::gemm_phase<pg8::EpiPrep, pg8::PtrStd, true, true>(lds, tid, D, D, D, S, P, E);
        } else if (p == PH_GH && QON(15)) {
            { pg8::Order S; S.init(1, 4, 16, G, bx); pg8::PtrG P{(const char*)(ws + WS_KVM), (const char*)(ws + WS_WQ)}; pg8::EpiPrep E{ws, 1};
              pg8::gemm_phase<pg8::EpiPrep, pg8::PtrG, true, true>(lds, tid, 2 * D, D, 256, S, P, E); }
            { pg8::Order S; S.init(4, 1, 16, G, (bx + 64) % G); pg8::PtrH P{(const char*)(ws + WS_KVM), (const char*)(ws + WS_WOT)}; pg8::EpiPrep E{ws, 2};
              pg8::gemm_phase<pg8::EpiPrep, pg8::PtrH, true, true>(lds, tid, D, 2 * D, 256, S, P, E); }
        } else if (p >= PH_L0) {
            const int l = (p - PH_L0) / PH_PER_LAYER, q = (p - PH_L0) % PH_PER_LAYER;
            const float* Xin = l == 0 ? INP(0) : X;
            pg8::u64* SSb = (pg8::u64*)(ws + WS_SS);
#define SSA(i) (SSb + (size_t)(i) * T)
            if (q == Q_SBIDX) {
#ifndef NO_SB
                sb_phase(W, lds, ws, dry);
#endif
                __syncthreads();
#ifndef NO_IDX
#ifdef PROBE_SB_ONLY
                if (!dry)
#endif
                idx_phase(lds, ws, vcu, G, wave, lane);
#endif
                conv_sc_phase(vcu * MK_THREADS + tid, G * MK_THREADS, BPW(WS_SCB), BPW(WS_CX), INP(4) + l * 3 * 512, dry);
                kn_phase(W, BPW(WS_KC), (float*)(ws + WS_KN));
            } else if (q == Q_DSA) {
#ifndef NO_DSA
                {
                    for (int pr = vcu; pr < NB * 8 * 16; pr += G) { const int bh = pr >> 4, sx = pr & 15, bb = bh >> 3, hh = bh & 7;
#pragma unroll 1
                        for (int k2 = 0; k2 < 2; ++k2)
                            attn_body::attn_unit<8>(bb, hh, k2 == 0 ? sx : 31 - sx, (const attn_body::bf16*)BPW(WS_QC), (const attn_body::bf16*)BPW(WS_KC), (const attn_body::bf16*)BPW(WS_VC),
                                                    (attn_body::bf16*)(dry ? BPW(WS_KA) : BPW(WS_QC)), (char*)lds_raw, (const unsigned*)(ws + WS_BM) + (size_t)bb * 256 * S,
                                                    (const float*)(ws + WS_KN) + bh * (S / 64), tid); }
                }
#endif
            } else if (q == Q_FFNMID) {
                ffn_mid_phase(vcu * MK_THREADS + tid, G * MK_THREADS, BPW(WS_FA), BPW(WS_FU), INP(16) + l * 3 * DFF, INP(17) + l * DFF, dry);
            } else if (q == Q_NEXT) {
                if (l + 1 < DEPTH) { int base = 0; convert_layer_weights(W, (LAS float*)(lds + wave * 16384), base, ws, args.in + oz, l + 1); }
                else if (!dry) final_norm(W, BPW(WS_XN), X, INP(19), SSA(6));
            } else if (q == Q_INPROJ && QON(Q_INPROJ)) {
                pg8::Order S; S.init(T / 256, NIN / 256, 1, G, bx);
                pg8::PtrStd P{(const char*)X, (const char*)(ws + WS_WIN), 0, 0, 0, (size_t)256 * D * 2, (size_t)256 * D * 2};
                pg8::EpiInProj E{ws, SSA(3 * l)};
                pg8::gemm_phase<pg8::EpiInProj, pg8::PtrStd, true, true>(lds, tid, D, D, D, S, P, E);
            } else if (q == Q_GATES && QON(Q_GATES)) {
                pg8::Order S; S.init(T / 256, 12, 1, G, bx);
                pg8::PtrStd P{(const char*)X, (const char*)(ws + WS_WG), 0, 0, 0, (size_t)256 * D * 2, (size_t)256 * D * 2};
                pg8::EpiGates E{BPW(WS_GATES), SSA(3 * l)};
                pg8::gemm_phase<pg8::EpiGates, pg8::PtrStd, true, true>(lds, tid, D, D, D, S, P, E);
            } else if (q == Q_MERGE && QON(Q_MERGE)) {
                pg8::Order S; S.init(T / 256, 4, 3, G, bx);
                pg8::PtrStd P{(const char*)(ws + WS_QA), (const char*)(ws + WS_WBR), 16 * MiB, (size_t)D * 512 * 2, 0, (size_t)256 * 512 * 2, (size_t)256 * 512 * 2};
                pg8::EpiMerge E{BPW(WS_XN), BPW(WS_GATES)};
                pg8::gemm_phase<pg8::EpiMerge, pg8::PtrStd, true, true>(lds, tid, 512, 512, 512, S, P, E);
            } else if (q == Q_MIX && QON(Q_MIX)) {
                pg8::Order S; S.init(T / 256, 4, 1, G, bx);
                pg8::PtrStd P{(const char*)(ws + WS_XN), (const char*)(ws + WS_WMIX), 0, 0, 0, (size_t)256 * D * 2, (size_t)256 * D * 2};
                if (l == 0) { pg8::EpiResid<true> E{(const void*)INP(0), dry ? BPW(WS_FU) : BPW(WS_XBXA), dry ? SSA(0) : SSA(1)};
                    pg8::gemm_phase<pg8::EpiResid<true>, pg8::PtrStd, true, true>(lds, tid, D, D, D, S, P, E); }
                else { pg8::EpiResid<false> E{(const void*)X, dry ? BPW(WS_FU) : BPW(WS_XBXA), dry ? SSA(0) : SSA(4)};
                    pg8::gemm_phase<pg8::EpiResid<false>, pg8::PtrStd, true, true>(lds, tid, D, D, D, S, P, E); }

            } else if (q == Q_XALOG && QON(Q_XALOG)) {
                pg8::Order S; S.init(T / 256, 4, 1, G, bx);
                pg8::PtrStd P{(const char*)(ws + WS_XBXA), (const char*)(ws + WS_GT + (size_t)l * 4 * MiB), 0, 0, 2 * MiB, (size_t)256 * D * 2, (size_t)256 * D * 2};
                pg8::EpiSoftmax E{BPW(WS_PXA), SSA(1 + 3 * l)};
                pg8::gemm_phase<pg8::EpiSoftmax, pg8::PtrStd, false, true>(lds, tid, D, D, D, S, P, E);
            } else if (q == Q_XAOUT && QON(Q_XAOUT)) {
                pg8::Order S; S.init(T / 256, 4, 1, G, bx);
                pg8::PtrStd P{(const char*)(ws + WS_PXA), (const char*)(ws + WS_HT + (size_t)l * 4 * MiB), 0, 0, 2 * MiB, (size_t)256 * D * 2, (size_t)256 * D * 2};
                pg8::EpiResid<false> E{(const void*)BPW(WS_XBXA), dry ? BPW(WS_FU) : BPW(WS_XN), dry ? SSA(0) : SSA(2 + 3 * l)};
                pg8::gemm_phase<pg8::EpiResid<false>, pg8::PtrStd, true, true>(lds, tid, D, D, D, S, P, E);
            } else if (q == Q_UP && QON(Q_UP)) {
                pg8::Order S; S.init(T / 256, 22, 1, G, bx);
                pg8::PtrStd P{(const char*)(ws + WS_XN), (const char*)(ws + WS_WUP), 0, 0, 0, (size_t)256 * D * 2, (size_t)256 * D * 2};
                pg8::EpiUp E{BPW(WS_FA), BPW(WS_FU), SSA(2 + 3 * l)};
                pg8::gemm_phase<pg8::EpiUp, pg8::PtrStd, true, true>(lds, tid, D, D, D, S, P, E);
            } else if (q == Q_DOWN && QON(Q_DOWN)) {
                pg8::Order S; S.init(T / 256, 4, 1, G, bx);
                pg8::PtrStd P{(const char*)(ws + WS_FU), (const char*)(ws + WS_WDOWN), 0, 0, 0, (size_t)256 * DFF * 2, (size_t)256 * DFF * 2};
                pg8::EpiResid<false> E{(const void*)BPW(WS_XN), dry ? BPW(WS_QA) : (l + 1 < DEPTH ? (bf16_t*)X : BPW(WS_XN)), dry ? SSA(0) : SSA(3 + 3 * l)};
                pg8::gemm_phase<pg8::EpiResid<false>, pg8::PtrStd, true, true>(lds, tid, DFF, DFF, DFF, S, P, E);
            }
        }
        }
        if (p + 1 < hi && !(p >= PH_L0 && ((p - PH_L0) % PH_PER_LAYER == Q_NORMXA || (p - PH_L0) % PH_PER_LAYER == Q_NORMFFN))) xcd_barrier(bar, mk_tid(wave_s));
    }
}

extern "C" void kernel_launch(void* const* d_in, const int* in_sizes, int n_in, void* d_out, int out_size, void* d_ws, size_t ws_size, hipStream_t st) {
    if (n_in != 20 || ws_size < WS_NEED || out_size != T * D) { fprintf(stderr, "kernel_launch: unexpected sizes n_in %d ws %zu out %d\n", n_in, ws_size, out_size); return; }
    static int grid = 0;
    if (grid == 0) {
        int dev = 0, cus = 0, per_cu = 0;
        (void)hipGetDevice(&dev); (void)hipDeviceGetAttribute(&cus, hipDeviceAttributeMultiprocessorCount, dev);
        if (hipOccupancyMaxActiveBlocksPerMultiprocessor(&per_cu, (const void*)mk_fwd, MK_THREADS, 0) != hipSuccess || per_cu < 1) { fprintf(stderr, "kernel_launch: occupancy query says %d blocks/CU\n", per_cu); grid = -1; return; }
        (void)hipGetLastError();
        if (cus != 256) { fprintf(stderr, "kernel_launch: built for a 256-CU device, found %d\n", cus); grid = -1; return; }
        grid = cus;
    }
    if (grid < 0) return;
    (void)hipMemsetAsync((char*)d_ws + WS_CTL, 0, CTL_ZERO_BYTES, st);
    Args a{};
    for (int i = 0; i < 20; ++i) a.in[i] = (const float*)d_in[i];
    a.out = (float*)d_out; a.ws = (unsigned char*)d_ws; a.ph_lo = 0; a.ph_hi = NPH;
    hipLaunchKernelGGL(mk_fwd, dim3(grid), dim3(MK_THREADS), 0, st, a);
}
```

```cpp
#include <hip/hip_runtime.h>
#include <stdint.h>
#include <stdio.h>

typedef unsigned short bf16_t;
typedef short bf16x8 __attribute__((ext_vector_type(8)));
typedef float f32x16 __attribute__((ext_vector_type(16)));
typedef float f32x4 __attribute__((ext_vector_type(4)));
#define DEV __device__ __forceinline__

constexpr int NB = 2, S = 8192, D = 1024, T = NB * S, DEPTH = 2;
constexpr int DIN = 8264, DFF = 2816, MEM = 256;
constexpr int NIN = 5376;
constexpr float LOG2E = 1.4426950408889634f;
constexpr float QSCALE = 0.125f * LOG2E;
constexpr float WSCALE = 0.125f * 0.35355339059327373f;
constexpr float XSCALE = 0.0625f * LOG2E;
constexpr float EPS = 1e-6f;
#ifndef MK_FUSE
#define MK_FUSE 1
#endif

constexpr size_t MiB = 1u << 20;
constexpr size_t WS_KN = 983040;
constexpr size_t WS_GT = 1 * MiB;
constexpr size_t WS_HT = 9 * MiB;
constexpr size_t WS_WUP = 17 * MiB, WS_WDOWN = 28 * MiB;
constexpr size_t WS_XN = 34 * MiB;
constexpr size_t WS_WMIX = 66 * MiB, WS_WBR = 68 * MiB, WS_WG = 71 * MiB, WS_WIN = 77 * MiB;
constexpr size_t WS_QA = 88 * MiB, WS_SCB = 104 * MiB, WS_QC = 120 * MiB, WS_KA = 136 * MiB, WS_VA = 152 * MiB, WS_KC = 168 * MiB, WS_VC = 184 * MiB,
                 WS_IQ = 200 * MiB, WS_CX = 216 * MiB, WS_IK = 232 * MiB, WS_IW = 234 * MiB, WS_BM = 235 * MiB;
constexpr size_t WS_GATES = 136 * MiB;
constexpr size_t WS_XTMP = 235 * MiB;
constexpr size_t WS_LOG = 88 * MiB, WS_PXA = 168 * MiB;
constexpr size_t WS_XBXA = 136 * MiB;
constexpr size_t WS_SS = 65536;
constexpr size_t WS_FA = 66 * MiB, WS_FU = 154 * MiB;
constexpr size_t WS_WQ = 34 * MiB  , WS_WOT = 38 * MiB  , WS_WKVT = 42 * MiB  , WS_MEMN = 50 * MiB  , WS_KVM = 52 * MiB  ;
constexpr size_t WS_NEED = 256 * MiB;

DEV bf16_t f2bf(float f) { unsigned u = __float_as_uint(f); u += 0x7fffu + ((u >> 16) & 1u); return (bf16_t)(u >> 16); }
DEV float bf2f(bf16_t h) { return __uint_as_float(((unsigned)h) << 16); }
DEV float wave_sum(float v) {
#pragma unroll
    for (int o = 1; o < 64; o <<= 1) v += __shfl_xor(v, o);
    return v;
}
DEV float wave_max(float v) {
#pragma unroll
    for (int o = 1; o < 64; o <<= 1) v = fmaxf(v, __shfl_xor(v, o));
    return v;
}


#define LAS __attribute__((address_space(3)))
#define GAS __attribute__((address_space(1)))
typedef unsigned u32x4 __attribute__((ext_vector_type(4)));
typedef unsigned u32x2 __attribute__((ext_vector_type(2)));
typedef float f32x2 __attribute__((ext_vector_type(2)));
#define LDS_WAIT() asm volatile("s_waitcnt lgkmcnt(0)" ::: "memory")
DEV int mk_tid(int wave_s) { unsigned ones = ~0u; asm volatile("" : "+s"(ones)); return wave_s * 64 + (int)__builtin_amdgcn_mbcnt_hi(ones, __builtin_amdgcn_mbcnt_lo(ones, 0u)); }
#define VM_WAIT() asm volatile("s_waitcnt vmcnt(0)" ::: "memory")
typedef __bf16 bf16x2_t __attribute__((ext_vector_type(2)));
DEV unsigned cvt_pk_bf16(float lo, float hi) { const f32x2 v = {lo, hi}; return __builtin_bit_cast(unsigned, __builtin_convertvector(v, bf16x2_t)); }
DEV float bflo(unsigned w) { return __uint_as_float(w << 16); }
DEV float bfhi(unsigned w) { return __uint_as_float(w & 0xffff0000u); }

namespace pg8 {
constexpr int BM = 256, BK = 64, HALF = 128, HTB = HALF * BK * 2, STAGE_BYTES = 8 * HTB, NXCD = 8, WGM = 8;
__host__ __device__ __forceinline__ int lds_byte(int r, int c) { const int st = (r >> 4) * 2 + (c >> 5), rr = r & 15, cc = c & 31, ob = rr * 64 + cc * 2; return st * 1024 + (ob ^ (((ob >> 9) & 1) << 5)); }
__host__ __device__ __forceinline__ void stage_rc(int b, int& R, int& C) { const int st = b / 1024, sb = b % 1024, swz = sb ^ (((sb >> 9) & 1) << 5); R = (st >> 1) * 16 + swz / 64; C = (st & 1) * 32 + (swz % 64) / 2; }
__host__ __device__ __forceinline__ int perm32(int rho) { const int n = rho >> 4, i = rho & 15; return 8 * (i >> 2) + 4 * n + (i & 3); }

struct Unit { int pm, pn, job; };
struct Order {
    int nM, nN, nwg, ntot, G, c;
    DEV void init(int nM_, int nN_, int njob, int G_, int c_) { nM = nM_; nN = nN_; nwg = nM * nN; ntot = nwg * njob; G = G_; c = c_; }
    DEV bool next(int i, Unit& u) const {
        const int L = i * G + c; if (L >= ntot) return false;
        u.job = L / nwg; int wgid = L - u.job * nwg;
        { const int q = nwg / NXCD, r = nwg % NXCD, xcd = wgid % NXCD, off = wgid / NXCD; wgid = (xcd < r ? xcd * (q + 1) : r * (q + 1) + (xcd - r) * q) + off; }
        const int nig = WGM * nN, gid = wgid / nig, fm = gid * WGM, gsz = (nM - fm) < WGM ? (nM - fm) : WGM;
        u.pm = fm + ((wgid % nig) % gsz); u.pn = (wgid % nig) / gsz; return true;
    }
};
template <class Epi, class Ptr, bool ALIGN_EPI, bool SP2>
DEV void gemm_phase(LAS unsigned char* lds, const int tid_in, const int lda, const int ldb, const int K, const Order& S, const Ptr& P, const Epi& E) {
    int tid_ = tid_in; asm volatile("" : "+v"(tid_));
    const int tid = tid_, wid = __builtin_amdgcn_readfirstlane(tid >> 6), lane = tid & 63, wr = wid >> 2, wc = wid & 3, fr = lane & 15, fq = lane >> 4;
    const int nt = K / BK;
    unsigned voffA[2], voffB[2];
#pragma unroll
    for (int i = 0; i < 2; ++i) { int R, C; stage_rc(tid * 16 + i * 8192, R, C); const int Rb = Epi::PERM ? ((R & ~31) + perm32(R & 31)) : R;
        voffA[i] = (unsigned)(R * lda + C) * 2u; voffB[i] = (unsigned)(Rb * ldb + C) * 2u; }
    const size_t kstep = (size_t)(BK * 2);
    const size_t hstepA = (size_t)HALF * lda * 2, hstepB = (size_t)HALF * ldb * 2;
    const unsigned ldsw = (unsigned)wid * 1024u;
    const int aoff = lds_byte(wr * 64 + fr, fq * 8), boff = lds_byte(wc * 32 + fr, fq * 8);
#define PG8_SA(b, h) (((b) * 2 + (h)) * HTB)
#define PG8_SB(b, h) ((4 + (b) * 2 + (h)) * HTB)
#define PG8_STAGE(bufoff, gbase, voff) do { _Pragma("unroll") for (int _i = 0; _i < 2; ++_i) \
        __builtin_amdgcn_global_load_lds((const unsigned*)((const char*)(gbase) + (voff)[_i]), (LAS unsigned*)(lds + (bufoff) + ldsw + _i * 8192), 16, 0, 0); } while (0)
#define PG8_LDA(dst, b, h) do { _Pragma("unroll") for (int m = 0; m < 4; ++m) _Pragma("unroll") for (int k = 0; k < 2; ++k) dst[m][k] = *(const LAS bf16x8*)(lds + PG8_SA(b, h) + aoff + m * 2048 + k * 1024); } while (0)
#define PG8_LDB(dst, b, h) do { _Pragma("unroll") for (int n = 0; n < 2; ++n) _Pragma("unroll") for (int k = 0; k < 2; ++k) dst[n][k] = *(const LAS bf16x8*)(lds + PG8_SB(b, h) + boff + n * 2048 + k * 1024); } while (0)
#define PG8_MMA(ai, bj, At, Bt) do { __builtin_amdgcn_s_setprio(1); _Pragma("unroll") for (int m = 0; m < 4; ++m) _Pragma("unroll") for (int n = 0; n < 2; ++n) _Pragma("unroll") for (int k = 0; k < 2; ++k) \
        acc[ai][bj][m][n] = __builtin_amdgcn_mfma_f32_16x16x32_bf16(Bt[n][k], At[m][k], acc[ai][bj][m][n], 0, 0, 0); __builtin_amdgcn_s_setprio(0); } while (0)
#define PG8_WAIT_V(n) asm volatile("s_waitcnt vmcnt(" #n ")" ::: "memory")
#define PG8_WAIT_L(n) asm volatile("s_waitcnt lgkmcnt(" #n ")" ::: "memory")
#define PG8_BAR __builtin_amdgcn_s_barrier()
#define PG8_SCHED __builtin_amdgcn_sched_barrier(0)
    Unit cur, nxt; int ui = 0;
    if (!S.next(0, cur)) return;
    f32x4 acc[2][2][4][2];
#pragma unroll
    for (int a = 0; a < 2; ++a)
#pragma unroll
        for (int b = 0; b < 2; ++b)
#pragma unroll
            for (int m = 0; m < 4; ++m)
#pragma unroll
                for (int n = 0; n < 2; ++n) acc[a][b][m][n] = (f32x4){0.f, 0.f, 0.f, 0.f};
    bf16x8 At[4][2], B0[2][2], B1[2][2];
    const char* cA = P.a(cur); const char* cB = P.b(cur);
    typename Epi::Pre pre; E.prefetch(pre, cur, wr, fr);
    if constexpr (SP2) {
        PG8_STAGE(PG8_SB(0, 0), cB, voffB); PG8_STAGE(PG8_SB(0, 1), cB + hstepB, voffB); PG8_STAGE(PG8_SA(0, 0), cA, voffA); PG8_STAGE(PG8_SA(0, 1), cA + hstepA, voffA);
        if (wr == 1) PG8_BAR;
        PG8_WAIT_V(2); PG8_BAR;
        PG8_STAGE(PG8_SB(1, 0), cB + kstep, voffB); PG8_STAGE(PG8_SA(1, 0), cA + kstep, voffA); PG8_STAGE(PG8_SB(1, 1), cB + hstepB + kstep, voffB);
        PG8_WAIT_V(6); PG8_BAR;
    } else {
        PG8_STAGE(PG8_SB(0, 0), cB, voffB); PG8_STAGE(PG8_SA(0, 0), cA, voffA); PG8_STAGE(PG8_SB(0, 1), cB + hstepB, voffB); PG8_STAGE(PG8_SA(0, 1), cA + hstepA, voffA);
        if (wr == 1) PG8_BAR;
        PG8_WAIT_V(4); PG8_BAR;
        PG8_STAGE(PG8_SB(1, 0), cB + kstep, voffB); PG8_STAGE(PG8_SA(1, 0), cA + kstep, voffA); PG8_STAGE(PG8_SB(1, 1), cB + hstepB + kstep, voffB);
        PG8_WAIT_V(6); PG8_BAR;
    }
#pragma unroll 1
    for (;;) {
        const bool has_next = S.next(ui + 1, nxt);
        const char* nA = has_next ? P.a(nxt) : cA; const char* nB = has_next ? P.b(nxt) : cB;
#pragma unroll 1
        for (int t = 0; t < nt; t += 2) {
            const bool last = (t == nt - 2);
            const char* a1 = cA + (size_t)(t + 1) * kstep;
            const char* a2 = last ? nA : cA + (size_t)(t + 2) * kstep; const char* b2 = last ? nB : cB + (size_t)(t + 2) * kstep;
            const char* a3 = a2 + kstep; const char* b3 = b2 + kstep;
            if constexpr (SP2) {
            PG8_LDB(B0, 0, 0); PG8_LDB(B1, 0, 1); PG8_SCHED; PG8_LDA(At, 0, 0); PG8_STAGE(PG8_SA(1, 1), a1 + hstepA, voffA);
            PG8_WAIT_V(8); PG8_WAIT_L(0); PG8_BAR; PG8_MMA(0, 0, At, B0); PG8_MMA(0, 1, At, B1); PG8_BAR; PG8_SCHED;
            PG8_LDA(At, 0, 1); PG8_STAGE(PG8_SB(0, 0), b2, voffB); PG8_STAGE(PG8_SB(0, 1), b2 + hstepB, voffB); PG8_STAGE(PG8_SA(0, 0), a2, voffA);
            PG8_WAIT_V(8); PG8_WAIT_L(0); PG8_BAR; PG8_MMA(1, 0, At, B0); PG8_MMA(1, 1, At, B1); PG8_BAR; PG8_SCHED;
            PG8_LDB(B0, 1, 0); PG8_LDB(B1, 1, 1); PG8_SCHED; PG8_LDA(At, 1, 0); PG8_STAGE(PG8_SA(0, 1), a2 + hstepA, voffA);
            PG8_WAIT_V(8); PG8_WAIT_L(0); PG8_BAR; PG8_MMA(0, 0, At, B0); PG8_MMA(0, 1, At, B1); PG8_BAR; PG8_SCHED;
            PG8_LDA(At, 1, 1); PG8_STAGE(PG8_SB(1, 0), b3, voffB); PG8_STAGE(PG8_SB(1, 1), b3 + hstepB, voffB); PG8_STAGE(PG8_SA(1, 0), a3, voffA);
            PG8_WAIT_V(8); PG8_WAIT_L(0); PG8_BAR; PG8_MMA(1, 0, At, B0); PG8_MMA(1, 1, At, B1); PG8_BAR; PG8_SCHED;
            } else {
            PG8_LDB(B0, 0, 0); PG8_SCHED; PG8_LDA(At, 0, 0); PG8_STAGE(PG8_SA(1, 1), a1 + hstepA, voffA);
            PG8_WAIT_L(8); PG8_BAR; PG8_WAIT_L(0); PG8_MMA(0, 0, At, B0); PG8_BAR; PG8_SCHED;
            PG8_LDB(B1, 0, 1); PG8_STAGE(PG8_SB(0, 0), b2, voffB);
            PG8_BAR; PG8_WAIT_L(0); PG8_MMA(0, 1, At, B1); PG8_BAR;
            PG8_LDA(At, 0, 1); PG8_STAGE(PG8_SA(0, 0), a2, voffA);
            PG8_BAR; PG8_WAIT_L(0); PG8_MMA(1, 0, At, B0); PG8_BAR; PG8_SCHED;
            PG8_STAGE(PG8_SB(0, 1), b2 + hstepB, voffB);
            PG8_WAIT_V(6); PG8_BAR; PG8_MMA(1, 1, At, B1); PG8_BAR;
            PG8_LDB(B0, 1, 0); PG8_SCHED; PG8_LDA(At, 1, 0); PG8_STAGE(PG8_SA(0, 1), a2 + hstepA, voffA);
            PG8_WAIT_L(8); PG8_BAR; PG8_WAIT_L(0); PG8_MMA(0, 0, At, B0); PG8_BAR; PG8_SCHED;
            PG8_LDB(B1, 1, 1); PG8_STAGE(PG8_SB(1, 0), b3, voffB);
            PG8_BAR; PG8_WAIT_L(0); PG8_MMA(0, 1, At, B1); PG8_BAR;
            PG8_LDA(At, 1, 1); PG8_STAGE(PG8_SA(1, 0), a3, voffA);
            PG8_BAR; PG8_WAIT_L(0); PG8_MMA(1, 0, At, B0); PG8_BAR; PG8_SCHED;
            PG8_STAGE(PG8_SB(1, 1), b3 + hstepB, voffB);
            PG8_WAIT_V(6); PG8_BAR; PG8_MMA(1, 1, At, B1); PG8_BAR;
            }
        }
        if constexpr (ALIGN_EPI) { if (wr == 0) PG8_BAR; }
        if constexpr (!Epi::AFTER_DRAIN) { int fr_ = fr, fq_ = fq; asm volatile("" : "+v"(fr_), "+v"(fq_));
            E(acc, cur, wr, wc, fr_, fq_, pre); }
        if (!has_next) break;
#pragma unroll
        for (int a = 0; a < 2; ++a)
#pragma unroll
            for (int b = 0; b < 2; ++b)
#pragma unroll
                for (int m = 0; m < 4; ++m)
#pragma unroll
                    for (int n = 0; n < 2; ++n) acc[a][b][m][n] = (f32x4){0.f, 0.f, 0.f, 0.f};
        cur = nxt; cA = nA; cB = nB; ++ui; E.prefetch(pre, cur, wr, fr);
        if constexpr (ALIGN_EPI) { if (wr == 1) PG8_BAR; }
    }
    PG8_WAIT_V(0);
    if constexpr (!ALIGN_EPI) { if (wr == 0) PG8_BAR; }
    PG8_BAR;
    if constexpr (Epi::AFTER_DRAIN) { E.fused(acc, cur, wr, wc, fr, fq, lds, wid, lane, pre); }
#undef PG8_SA
#undef PG8_SB
#undef PG8_STAGE
#undef PG8_LDA
#undef PG8_LDB
#undef PG8_MMA
#undef PG8_WAIT_V
#undef PG8_WAIT_L
#undef PG8_BAR
#undef PG8_SCHED
}
typedef f32x4 Acc[2][2][4][2];

struct PtrStd {
    const char* A; const char* B; size_t aj, bj, bb, arow, brow;
    DEV const char* a(const Unit& u) const { return A + (size_t)u.job * aj + (size_t)u.pm * arow; }
    DEV const char* b(const Unit& u) const { return B + (size_t)u.job * bj + (size_t)(u.pm >> 5) * bb + (size_t)u.pn * brow; }
};
struct PtrG {
    const char* KVM; const char* WQ;
    DEV const char* a(const Unit& u) const { return KVM + (size_t)(u.job >> 2) * MiB + (size_t)(u.job & 3) * 512; }
    DEV const char* b(const Unit& u) const { return WQ + (size_t)(u.job >> 3) * 2 * MiB + (size_t)(u.job & 3) * 512 + (size_t)u.pn * 256 * 1024 * 2; }
};
struct PtrH {
    const char* KVM; const char* WOT;
    DEV const char* a(const Unit& u) const { return WOT + (size_t)(u.job >> 3) * 2 * MiB + (size_t)(u.job & 3) * 512 + (size_t)u.pm * 256 * 1024 * 2; }
    DEV const char* b(const Unit& u) const { return KVM + (size_t)(u.job >> 2) * MiB + 2048 + (size_t)(u.job & 3) * 512; }
};

#define EPI_ROWS(u) const int row0 = (u).pm * BM + wr * 64 + fr
DEV u32x4 pack8(const f32x4 v0, const f32x4 v1) { u32x4 w; w.x = cvt_pk_bf16(v0[0], v0[1]); w.y = cvt_pk_bf16(v0[2], v0[3]); w.z = cvt_pk_bf16(v1[0], v1[1]); w.w = cvt_pk_bf16(v1[2], v1[3]); return w; }

struct PreNone {};
typedef unsigned long long u64;
constexpr float SS_SCALE = 65536.f;
struct PreRs { u64 v[2][4]; };
DEV void pre_rs(PreRs& p, const u64* ss, int row0) {
#pragma unroll
    for (int ai = 0; ai < 2; ++ai)
#pragma unroll
        for (int m = 0; m < 4; ++m) p.v[ai][m] = __builtin_nontemporal_load(ss + row0 + ai * HALF + m * 16);
}
DEV void rs_of(float (&rs)[2][4], const PreRs& p) {
#pragma unroll
    for (int ai = 0; ai < 2; ++ai)
#pragma unroll
        for (int m = 0; m < 4; ++m) rs[ai][m] = rsqrtf((float)p.v[ai][m] * (1.f / (SS_SCALE * D)) + EPS);
}
struct EpiInProj {
    typedef PreRs Pre;
    DEV void prefetch(PreRs& p, const Unit& u, int wr, int fr) const { pre_rs(p, ss, u.pm * BM + wr * 64 + fr); }
    static constexpr bool PERM = true, AFTER_DRAIN = false;
    unsigned char* ws; const u64* ss;
    DEV void operator()(const Acc& acc, const Unit& u, int wr, int wc, int fr, int fq, const PreRs& pre) const {
        EPI_ROWS(u); const int pn = u.pn, cb = wc * 32 + 8 * fq;
        float rs[2][4]; rs_of(rs, pre);
        if (pn < 16) {
            const int g = pn >> 1;
            const size_t off = g == 0 ? WS_QA : g == 1 ? WS_KA : g == 2 ? WS_VA : g == 3 ? WS_QC : g == 4 ? WS_KC : g == 5 ? WS_VC : g == 6 ? WS_IQ : WS_SCB;
            const float sc = (g == 0 || g == 3) ? QSCALE : 1.f;
            bf16_t* base = (bf16_t*)(ws + off) + (pn & 1) * 256 + cb;
#pragma unroll
            for (int ai = 0; ai < 2; ++ai)
#pragma unroll
                for (int m = 0; m < 4; ++m) { bf16_t* rowp = base + (size_t)(row0 + ai * HALF + m * 16) * 512;
#pragma unroll
                    for (int bj = 0; bj < 2; ++bj) *(u32x4*)(rowp + bj * HALF) = pack8(acc[ai][bj][m][0] * (sc * rs[ai][m]), acc[ai][bj][m][1] * (sc * rs[ai][m])); }
        } else if (pn < 20) {
            bf16_t* base = (bf16_t*)(ws + WS_CX) + (pn - 16) * 128 + cb;
#pragma unroll
            for (int ai = 0; ai < 2; ++ai)
#pragma unroll
                for (int m = 0; m < 4; ++m) { const float r2 = rs[ai][m] * rs[ai][m]; *(u32x4*)(base + (size_t)(row0 + ai * HALF + m * 16) * 512) = pack8(acc[ai][0][m][0] * acc[ai][1][m][0] * r2, acc[ai][0][m][1] * acc[ai][1][m][1] * r2); }
        } else {
            if (wc < 2) { bf16_t* base = (bf16_t*)(ws + WS_IK);
#pragma unroll
                for (int ai = 0; ai < 2; ++ai)
#pragma unroll
                    for (int m = 0; m < 4; ++m) { const int t = row0 + ai * HALF + m * 16;
                        *(u32x4*)(base + (size_t)(t >> 5) * 2048 + (((cb >> 3) * 32 + (t & 31)) * 8)) = pack8(acc[ai][0][m][0] * rs[ai][m], acc[ai][0][m][1] * rs[ai][m]); }
            } else if (wc == 2 && fq == 0) { float* base = (float*)(ws + WS_IW);
#pragma unroll
                for (int ai = 0; ai < 2; ++ai)
#pragma unroll
                    for (int m = 0; m < 4; ++m) { float* p = base + (size_t)(row0 + ai * HALF + m * 16) * 8; *(f32x4*)p = acc[ai][0][m][0] * (WSCALE * rs[ai][m]); *(f32x4*)(p + 4) = acc[ai][0][m][1] * (WSCALE * rs[ai][m]); }
            }
        }
    }
};
DEV f32x4 sigm4(const f32x4 v) { f32x4 o;
#pragma unroll
    for (int i = 0; i < 4; ++i) o[i] = __builtin_amdgcn_rcpf(1.f + __builtin_amdgcn_exp2f(-LOG2E * v[i])); return o; }
struct EpiGates {
    typedef PreRs Pre;
    DEV void prefetch(PreRs& p, const Unit& u, int wr, int fr) const { pre_rs(p, ss, u.pm * BM + wr * 64 + fr); }
    static constexpr bool PERM = true, AFTER_DRAIN = false;
    bf16_t* G; const u64* ss;
    DEV void operator()(const Acc& acc, const Unit& u, int wr, int wc, int fr, int fq, const PreRs& pre) const {
        EPI_ROWS(u); float rs[2][4]; rs_of(rs, pre); bf16_t* base = G + (size_t)(u.pn >> 2) * T * D + (u.pn & 3) * 256 + wc * 32 + 8 * fq;
#pragma unroll
        for (int ai = 0; ai < 2; ++ai)
#pragma unroll
            for (int m = 0; m < 4; ++m) { bf16_t* rowp = base + (size_t)(row0 + ai * HALF + m * 16) * D;
#pragma unroll
                for (int bj = 0; bj < 2; ++bj) *(u32x4*)(rowp + bj * HALF) = pack8(sigm4(acc[ai][bj][m][0] * rs[ai][m]), sigm4(acc[ai][bj][m][1] * rs[ai][m])); }
    }
};
struct EpiMerge {
    typedef PreNone Pre;
    DEV void prefetch(PreNone&, const Unit&, int, int) const {}
    static constexpr bool PERM = true, AFTER_DRAIN = false;
    bf16_t* M; const bf16_t* G;
    DEV void operator()(const Acc& acc, const Unit& u, int wr, int wc, int fr, int fq, const PreNone&) const {
        EPI_ROWS(u); const size_t cofs = (size_t)u.pn * 256 + wc * 32 + 8 * fq; const bf16_t* gb = G + (size_t)u.job * T * D;
#pragma unroll
        for (int ai = 0; ai < 2; ++ai)
#pragma unroll
            for (int m = 0; m < 4; ++m) { const size_t ro = (size_t)(row0 + ai * HALF + m * 16) * D + cofs;
#pragma unroll
                for (int bj = 0; bj < 2; ++bj) { const size_t o = ro + bj * HALF; const u32x4 g = *(const u32x4*)(gb + o);
                    f32x4 v0 = acc[ai][bj][m][0], v1 = acc[ai][bj][m][1];
                    v0[0] *= bflo(g.x); v0[1] *= bfhi(g.x); v0[2] *= bflo(g.y); v0[3] *= bfhi(g.y); v1[0] *= bflo(g.z); v1[1] *= bfhi(g.z); v1[2] *= bflo(g.w); v1[3] *= bfhi(g.w);
                    if (u.job > 0) { const u32x4 p = __builtin_nontemporal_load((const u32x4*)(M + o));
                        v0[0] += bflo(p.x); v0[1] += bfhi(p.x); v0[2] += bflo(p.y); v0[3] += bfhi(p.y); v1[0] += bflo(p.z); v1[1] += bfhi(p.z); v1[2] += bflo(p.w); v1[3] += bfhi(p.w); }
                    *(u32x4*)(M + o) = pack8(v0, v1); } }
    }
};
template <bool IN_F32> struct EpiResid {
    typedef PreNone Pre;
    DEV void prefetch(PreNone&, const Unit&, int, int) const {}
    static constexpr bool PERM = true, AFTER_DRAIN = false;
    const void* xin; bf16_t* xb; u64* ss;
    DEV void operator()(const Acc& acc, const Unit& u, int wr, int wc, int fr, int fq, const PreNone&) const {
        EPI_ROWS(u); const size_t cofs = (size_t)u.pn * 256 + wc * 32 + 8 * fq;
#pragma unroll
        for (int ai = 0; ai < 2; ++ai)
#pragma unroll
            for (int m = 0; m < 4; ++m) { const size_t ro = (size_t)(row0 + ai * HALF + m * 16) * D + cofs; float sq = 0.f;
#pragma unroll
                for (int bj = 0; bj < 2; ++bj) { const size_t o = ro + bj * HALF; f32x4 v0 = acc[ai][bj][m][0], v1 = acc[ai][bj][m][1];
                    if (IN_F32) { v0 = v0 + *(const f32x4*)((const float*)xin + o); v1 = v1 + *(const f32x4*)((const float*)xin + o + 4); }
                    else { const u32x4 p = *(const u32x4*)((const bf16_t*)xin + o);
                        v0[0] += bflo(p.x); v0[1] += bfhi(p.x); v0[2] += bflo(p.y); v0[3] += bfhi(p.y); v1[0] += bflo(p.z); v1[1] += bfhi(p.z); v1[2] += bflo(p.w); v1[3] += bfhi(p.w); }
                    *(u32x4*)(xb + o) = pack8(v0, v1);
                    sq += ((v0[0] * v0[0] + v0[1] * v0[1]) + (v0[2] * v0[2] + v0[3] * v0[3])) + ((v1[0] * v1[0] + v1[1] * v1[1]) + (v1[2] * v1[2] + v1[3] * v1[3])); }
                sq += __shfl_xor(sq, 16); sq += __shfl_xor(sq, 32);
                if (fq == 0) atomicAdd(ss + row0 + ai * HALF + m * 16, (u64)(sq * SS_SCALE + 0.5f)); }
    }
};
struct EpiUp {
    typedef PreRs Pre;
    DEV void prefetch(PreRs& p, const Unit& u, int wr, int fr) const { pre_rs(p, ss, u.pm * BM + wr * 64 + fr); }
    static constexpr bool PERM = true, AFTER_DRAIN = false;
    bf16_t *fa, *fu; const u64* ss;
    DEV void operator()(const Acc& acc, const Unit& u, int wr, int wc, int fr, int fq, const PreRs& pre) const {
        EPI_ROWS(u); float rs[2][4]; rs_of(rs, pre); const size_t cofs = (size_t)u.pn * 128 + wc * 32 + 8 * fq;
#pragma unroll
        for (int ai = 0; ai < 2; ++ai)
#pragma unroll
            for (int m = 0; m < 4; ++m) { const size_t o = (size_t)(row0 + ai * HALF + m * 16) * DFF + cofs;
                *(u32x4*)(fa + o) = pack8(acc[ai][0][m][0] * rs[ai][m], acc[ai][0][m][1] * rs[ai][m]); *(u32x4*)(fu + o) = pack8(acc[ai][1][m][0] * rs[ai][m], acc[ai][1][m][1] * rs[ai][m]); }
    }
};
struct EpiPrep {
    typedef PreNone Pre;
    DEV void prefetch(PreNone&, const Unit&, int, int) const {}
    static constexpr bool PERM = true, AFTER_DRAIN = false;
    unsigned char* ws; int mode;
    DEV void operator()(const Acc& acc, const Unit& u, int wr, int wc, int fr, int fq, const PreNone&) const {
        EPI_ROWS(u); bf16_t* base; int ldc; float sc = 1.f;
        if (mode == 0) { base = (bf16_t*)(ws + WS_KVM + (size_t)u.job * 2 * MiB); ldc = 2 * D; }
        else if (mode == 1) { base = (bf16_t*)(ws + WS_GT + (size_t)(u.job >> 2) * 2 * MiB) + (size_t)(u.job & 3) * 256 * D; ldc = D; sc = XSCALE; }
        else { base = (bf16_t*)(ws + WS_HT + (size_t)(u.job >> 2) * 2 * MiB) + (u.job & 3) * 256; ldc = D; }
        base += (size_t)u.pn * 256 + wc * 32 + 8 * fq;
#pragma unroll
        for (int ai = 0; ai < 2; ++ai)
#pragma unroll
            for (int m = 0; m < 4; ++m) { bf16_t* rowp = base + (size_t)(row0 + ai * HALF + m * 16) * ldc;
#pragma unroll
                for (int bj = 0; bj < 2; ++bj) *(u32x4*)(rowp + bj * HALF) = pack8(acc[ai][bj][m][0] * sc, acc[ai][bj][m][1] * sc); }
    }
};
struct EpiSoftmax {
    typedef PreRs Pre;
    DEV void prefetch(PreRs& p, const Unit& u, int wr, int fr) const { pre_rs(p, ss, u.pm * BM + wr * 64 + fr); }
    static constexpr bool PERM = true, AFTER_DRAIN = true;
    bf16_t* P; const u64* ss;
    DEV void fused(Acc& acc, const Unit& u, int wr, int wc, int fr, int fq, LAS unsigned char* lds, int wid, int lane, const PreRs& pre) const {
        LAS float* PM = (LAS float*)lds; LAS float* PS = (LAS float*)(lds + 4096);
        { const int row0_ = u.pm * BM + wr * 64 + fr; float rs[2][4]; rs_of(rs, pre);
#pragma unroll
          for (int ai = 0; ai < 2; ++ai)
#pragma unroll
              for (int m = 0; m < 4; ++m)
#pragma unroll
                  for (int bj = 0; bj < 2; ++bj)
#pragma unroll
                      for (int n = 0; n < 2; ++n) acc[ai][bj][m][n] = acc[ai][bj][m][n] * rs[ai][m]; }
#pragma unroll
        for (int ai = 0; ai < 2; ++ai)
#pragma unroll
            for (int m = 0; m < 4; ++m) { float mx = -INFINITY;
#pragma unroll
                for (int bj = 0; bj < 2; ++bj)
#pragma unroll
                    for (int n = 0; n < 2; ++n) { const f32x4 x = acc[ai][bj][m][n]; mx = fmaxf(mx, fmaxf(fmaxf(x[0], x[1]), fmaxf(x[2], x[3]))); }
                mx = fmaxf(mx, __shfl_xor(mx, 16)); mx = fmaxf(mx, __shfl_xor(mx, 32));
                if (fq == 0) PM[(ai * HALF + wr * 64 + m * 16 + fr) * 4 + wc] = mx; }
        LDS_WAIT(); __builtin_amdgcn_s_barrier(); asm volatile("" ::: "memory");
#pragma unroll
        for (int ai = 0; ai < 2; ++ai)
#pragma unroll
            for (int m = 0; m < 4; ++m) { const int r = ai * HALF + wr * 64 + m * 16 + fr; const f32x4 q = *(const LAS f32x4*)(PM + r * 4);
                const float mx = fmaxf(fmaxf(q[0], q[1]), fmaxf(q[2], q[3])); float s = 0.f;
#pragma unroll
                for (int bj = 0; bj < 2; ++bj)
#pragma unroll
                    for (int n = 0; n < 2; ++n) { f32x4 x = acc[ai][bj][m][n];
#pragma unroll
                        for (int i = 0; i < 4; ++i) { x[i] = __builtin_amdgcn_exp2f(x[i] - mx); s += x[i]; } acc[ai][bj][m][n] = x; }
                s += __shfl_xor(s, 16); s += __shfl_xor(s, 32);
                if (fq == 0) PS[r * 4 + wc] = s; }
        LDS_WAIT(); __builtin_amdgcn_s_barrier(); asm volatile("" ::: "memory");
        EPI_ROWS(u); bf16_t* base = P + (size_t)u.pn * 256 + wc * 32 + 8 * fq;
#pragma unroll
        for (int ai = 0; ai < 2; ++ai)
#pragma unroll
            for (int m = 0; m < 4; ++m) { const int r = ai * HALF + wr * 64 + m * 16 + fr; const f32x4 q = *(const LAS f32x4*)(PS + r * 4);
                const float inv = 1.f / ((q[0] + q[1]) + (q[2] + q[3])); bf16_t* rowp = base + (size_t)(row0 + ai * HALF + m * 16) * D;
#pragma unroll
                for (int bj = 0; bj < 2; ++bj) *(u32x4*)(rowp + bj * HALF) = pack8(acc[ai][bj][m][0] * inv, acc[ai][bj][m][1] * inv); }
        LDS_WAIT(); __builtin_amdgcn_s_barrier();
    }
};
}

typedef GAS unsigned gu32;
#define XB_TMO      128
#define XB_XCNT(j)  (256  + 64 * (j))
#define XB_XSUB(j)  (1280 + 64 * (j))
#define XB_XGEN(j)  (2304 + 64 * (j))
#define XB_TOP      3328
#define XB_TOPGEN   3392
#define XCD_BAR_WORDS 3456
#define XB_SPIN_CAP (1u << 22)
DEV unsigned xb_ld(unsigned* p) { return __hip_atomic_load(p, __ATOMIC_RELAXED, __HIP_MEMORY_SCOPE_AGENT); }
DEV unsigned xb_add(unsigned* p, unsigned v) { return __hip_atomic_fetch_add(p, v, __ATOMIC_RELAXED, __HIP_MEMORY_SCOPE_AGENT); }
DEV unsigned xb_xcc_id() { return (unsigned)__builtin_amdgcn_s_getreg((3 << 11) | 20) & 0xFu; }
#define XB_SPIN(cond, bar) do { unsigned _sp = 0; while (cond) { __builtin_amdgcn_s_sleep(1); \
    if ((++_sp & 255u) == 0u) { if (xb_ld(&(bar)[XB_TMO])) break; if (_sp > XB_SPIN_CAP) { atomicAdd(&(bar)[XB_TMO], 1u); break; } } } } while (0)
struct XcdBarrier { unsigned* bar; unsigned x; volatile LAS unsigned* st; };
DEV XcdBarrier xcd_barrier_post(unsigned* bar, volatile LAS unsigned* st, int tid) {
    XcdBarrier b; b.bar = bar; b.x = xb_xcc_id(); b.st = st;
    if (tid == 0) (void)xb_add(&bar[XB_XCNT(b.x)], 1u);
    return b;
}
DEV void xcd_barrier_complete(unsigned* bar, unsigned x, unsigned& nloc, unsigned& nx) {
    const unsigned G = gridDim.x * gridDim.y * gridDim.z;
    unsigned sum, cnt, mine, sp = 0u;
    for (;;) {
        sum = 0u; cnt = 0u; mine = 0u;
#pragma unroll
        for (unsigned j = 0; j < 16; ++j) { const unsigned c = xb_ld(&bar[XB_XCNT(j)]); sum += c; cnt += (c > 0u) ? 1u : 0u; mine = (j == x) ? c : mine; }
        if (sum == G) break;
        __builtin_amdgcn_s_sleep(1);
        if ((++sp & 255u) == 0u) { if (xb_ld(&bar[XB_TMO])) break; if (sp > XB_SPIN_CAP) { atomicAdd(&bar[XB_TMO], 1u); break; } }
    }
    nloc = mine > 0u ? mine : 1u; nx = cnt > 0u ? cnt : 1u;
}
DEV void xcd_barrier(const XcdBarrier& b, int tid) {
    asm volatile("s_waitcnt vmcnt(0)" ::: "memory");
    __syncthreads();
    if (tid == 0) {
        unsigned* bar = b.bar;
        __builtin_amdgcn_s_waitcnt(0);
        unsigned nloc = b.st[0], nx = b.st[1];
        if (nloc == 0u) { xcd_barrier_complete(bar, b.x, nloc, nx); b.st[0] = nloc; b.st[1] = nx; }
        const unsigned old = xb_add(&bar[XB_XSUB(b.x)], 1u);
        const unsigned gen = old / nloc;
        if (old + 1u == (gen + 1u) * nloc) {
            __builtin_amdgcn_fence(__ATOMIC_RELEASE, "agent");
            asm volatile("s_waitcnt vmcnt(0)" ::: "memory");
            const unsigned og = xb_add(&bar[XB_TOP], 1u);
            const unsigned tg = og / nx;
            if (og + 1u == (tg + 1u) * nx) xb_add(&bar[XB_TOPGEN], 1u);
            else XB_SPIN(xb_ld(&bar[XB_TOPGEN]) == tg, bar);
            __builtin_amdgcn_fence(__ATOMIC_ACQUIRE, "agent");
            xb_add(&bar[XB_XGEN(b.x)], 1u);
            asm volatile("s_waitcnt vmcnt(0)" ::: "memory");
        } else {
            XB_SPIN(xb_ld(&bar[XB_XGEN(b.x)]) == gen, bar);
            __builtin_amdgcn_fence(__ATOMIC_ACQUIRE, "agent");
            asm volatile("s_waitcnt vmcnt(0)" ::: "memory");
        }
    }
    __syncthreads();
}


struct WaveId { int gw, ngw, wave, lane; };
DEV unsigned f2bf_u(float f) { return (unsigned)f2bf(f); }
DEV unsigned pk2(float lo, float hi) { return cvt_pk_bf16(lo, hi); }

DEV void norm_rows(const WaveId& W, const float* x, const float* g, bf16_t* outb, float* outf, int rows) {
    for (int row = W.gw; row < rows; row += W.ngw) {
        const f32x4* xr = (const f32x4*)(x + (size_t)row * D) + W.lane;
        f32x4 v[4]; float s = 0.f;
#pragma unroll
        for (int j = 0; j < 4; ++j) { v[j] = xr[64 * j]; s += (v[j].x * v[j].x + v[j].y * v[j].y) + (v[j].z * v[j].z + v[j].w * v[j].w); }
        const float r = rsqrtf(wave_sum(s) * (1.f / D) + EPS);
#pragma unroll
        for (int j = 0; j < 4; ++j) {
            const f32x4 gg = ((const f32x4*)g)[W.lane + 64 * j];
            const f32x4 o = {v[j].x * r * gg.x, v[j].y * r * gg.y, v[j].z * r * gg.z, v[j].w * r * gg.w};
            if (outb) { u32x2 w; w.x = pk2(o.x, o.y); w.y = pk2(o.z, o.w); ((u32x2*)(outb + (size_t)row * D))[W.lane + 64 * j] = w; }
            else ((f32x4*)(outf + (size_t)row * D))[W.lane + 64 * j] = o;
        }
    }
}
DEV void cvt_piece(const WaveId& W, LAS float* scr, int& base, const float* Wsrc, int ldw, int K, int col0, int ncols, bf16_t* dst, int ldo, int row0, const float* gain = nullptr) {
    const int nblk = ncols / 32, nitems = (K / 64) * nblk;
    int first = (W.gw - base) % W.ngw; if (first < 0) first += W.ngw;
    base = (base + nitems) % W.ngw;
    for (int item = first; item < nitems; item += W.ngw) {
        const int kb = item / nblk, nb = item - kb * nblk, k0 = 64 * kb, n0 = 32 * nb;
#pragma unroll 8
        for (int i = 0; i < 32; ++i) { const int kk = 2 * i + (W.lane >> 5); scr[kk * 33 + (W.lane & 31)] = Wsrc[(size_t)(k0 + kk) * ldw + col0 + n0 + (W.lane & 31)] * (gain ? gain[k0 + kk] : 1.f); }
        LDS_WAIT(); asm volatile("" ::: "memory");
        const int c = W.lane & 7;
#pragma unroll
        for (int j = 0; j < 4; ++j) { const int n = (W.lane >> 3) + 8 * j; const LAS float* s = scr + (8 * c) * 33 + n;
            u32x4 o; o.x = pk2(s[0 * 33], s[1 * 33]); o.y = pk2(s[2 * 33], s[3 * 33]); o.z = pk2(s[4 * 33], s[5 * 33]); o.w = pk2(s[6 * 33], s[7 * 33]);
            *(u32x4*)(dst + (size_t)(row0 + n0 + n) * ldo + k0 + 8 * c) = o; }
        LDS_WAIT(); asm volatile("" ::: "memory");
    }
}
DEV void convert_layer_weights(const WaveId& W, LAS float* scr, int& base, unsigned char* ws, const float* const* in, int l) {
    const float* wi = in[3] + (size_t)l * D * DIN;
    bf16_t* WIN = (bf16_t*)(ws + WS_WIN); const float* gm = in[2] + l * D; const float* gf = in[14] + l * D;
    cvt_piece(W, scr, base, wi, DIN, D, 0, 1536, WIN, D, 0, gm);
    cvt_piece(W, scr, base, wi, DIN, D, 3072, 1536, WIN, D, 1536, gm);
    cvt_piece(W, scr, base, wi, DIN, D, 4608, 512, WIN, D, 3072, gm);
    cvt_piece(W, scr, base, wi, DIN, D, 1536, 512, WIN, D, 3584, gm);
#pragma unroll 1
    for (int j = 0; j < 4; ++j) { cvt_piece(W, scr, base, wi, DIN, D, 2048 + 128 * j, 128, WIN, D, 4096 + 256 * j, gm); cvt_piece(W, scr, base, wi, DIN, D, 2560 + 128 * j, 128, WIN, D, 4096 + 256 * j + 128, gm); }
    cvt_piece(W, scr, base, wi, DIN, D, 5120, 96, WIN, D, 5120, gm);
    cvt_piece(W, scr, base, wi, DIN, D, 5192, 3072, (bf16_t*)(ws + WS_WG), D, 0, gm);
#pragma unroll 1
    for (int i = 0; i < 3; ++i) cvt_piece(W, scr, base, in[5 + i] + (size_t)l * 512 * D, D, 512, 0, D, (bf16_t*)(ws + WS_WBR) + (size_t)i * D * 512, 512, 0);
    cvt_piece(W, scr, base, in[8] + (size_t)l * D * D, D, D, 0, D, (bf16_t*)(ws + WS_WMIX), D, 0);
    const float* wf = in[15] + (size_t)l * D * 2 * DFF;
#pragma unroll 1
    for (int j = 0; j < 22; ++j) { cvt_piece(W, scr, base, wf, 2 * DFF, D, 128 * j, 128, (bf16_t*)(ws + WS_WUP), D, 256 * j, gf); cvt_piece(W, scr, base, wf, 2 * DFF, D, DFF + 128 * j, 128, (bf16_t*)(ws + WS_WUP), D, 256 * j + 128, gf); }
    cvt_piece(W, scr, base, in[18] + (size_t)l * DFF * D, D, DFF, 0, D, (bf16_t*)(ws + WS_WDOWN), DFF, 0);
}
DEV void prep0_phase(const WaveId& W, LAS float* scr, unsigned char* ws, const float* const* in, bf16_t* XB) {
    int base = 0;
#pragma unroll 1
    for (int l = 0; l < DEPTH; ++l) {
        const float* wq = in[11] + (size_t)l * D * D; bf16_t* WQ = (bf16_t*)(ws + WS_WQ + (size_t)l * 2 * MiB); const float* gx = in[9] + l * D;
        for (size_t i = (size_t)(W.gw * 64 + W.lane) * 4; i < (size_t)D * D; i += (size_t)W.ngw * 256) { const float g = gx[i >> 10]; const f32x4 v = *(const f32x4*)(wq + i); u32x2 o; o.x = pk2(v.x * g, v.y * g); o.y = pk2(v.z * g, v.w * g); *(u32x2*)(WQ + i) = o; }
        cvt_piece(W, scr, base, in[13] + (size_t)l * D * D, D, D, 0, D, (bf16_t*)(ws + WS_WOT + (size_t)l * 2 * MiB), D, 0);
        cvt_piece(W, scr, base, in[12] + (size_t)l * D * 2 * D, 2 * D, D, 0, 2 * D, (bf16_t*)(ws + WS_WKVT + (size_t)l * 4 * MiB), D, 0);
        norm_rows(W, in[1], in[10] + l * D, (bf16_t*)(ws + WS_MEMN + (size_t)l * MiB), nullptr, NB * MEM);
    }
    convert_layer_weights(W, scr, base, ws, in, 0);
    pg8::u64* ss0 = (pg8::u64*)(ws + WS_SS);
    for (int row = W.gw; row < T; row += W.ngw) {
        const f32x4* xr = (const f32x4*)(in[0] + (size_t)row * D) + W.lane; float s = 0.f;
#pragma unroll
        for (int j = 0; j < 4; ++j) { const f32x4 v = xr[64 * j]; s += (v.x * v.x + v.y * v.y) + (v.z * v.z + v.w * v.w);
            u32x2 w; w.x = pk2(v.x, v.y); w.y = pk2(v.z, v.w); ((u32x2*)(XB + (size_t)row * D))[W.lane + 64 * j] = w; }
        s = wave_sum(s); if (W.lane == 0) ss0[row] = (pg8::u64)(s * pg8::SS_SCALE + 0.5f);
    }
}
DEV void final_norm(const WaveId& W, const bf16_t* x, float* out, const float* g, const pg8::u64* ss) {
    for (int row = W.gw; row < T; row += W.ngw) {
        const float r = rsqrtf((float)ss[row] * (1.f / (pg8::SS_SCALE * D)) + EPS); const u32x2* xr = (const u32x2*)(x + (size_t)row * D) + W.lane; f32x4* orow = (f32x4*)(out + (size_t)row * D) + W.lane;
#pragma unroll
        for (int j = 0; j < 4; ++j) { const f32x4 gg = ((const f32x4*)g)[W.lane + 64 * j]; const u32x2 v = xr[64 * j];
            const f32x4 o = {bflo(v.x) * r * gg.x, bfhi(v.x) * r * gg.y, bflo(v.y) * r * gg.z, bfhi(v.y) * r * gg.w}; orow[64 * j] = o; }
    }
}
DEV void conv_sc_phase(int gtid, int gthreads, bf16_t* scb, const bf16_t* cx, const float* w, bool dry) {
    for (int i = gtid; i < T * 64; i += gthreads) {
        const int c8 = (i & 63) * 8, t = i >> 6, tl = t & (S - 1);
        const size_t o = (size_t)t * 512 + c8;
        const u32x4 z = {0u, 0u, 0u, 0u};
        const u32x4 x2 = *(const u32x4*)(cx + o), x1 = tl >= 1 ? *(const u32x4*)(cx + o - 512) : z, x0 = tl >= 2 ? *(const u32x4*)(cx + o - 1024) : z, bb = *(const u32x4*)(scb + o);
        const f32x4 w0a = *(const f32x4*)(w + c8), w0b = *(const f32x4*)(w + c8 + 4), w1a = *(const f32x4*)(w + 512 + c8), w1b = *(const f32x4*)(w + 512 + c8 + 4), w2a = *(const f32x4*)(w + 1024 + c8), w2b = *(const f32x4*)(w + 1024 + c8 + 4);
        float r[8];
#define CONV1(k, W0, W1, W2, X0, X1, X2, BBv, F) r[k] = F(BBv) * (W0 * F(X0) + W1 * F(X1) + W2 * F(X2))
        CONV1(0, w0a.x, w1a.x, w2a.x, x0.x, x1.x, x2.x, bb.x, bflo); CONV1(1, w0a.y, w1a.y, w2a.y, x0.x, x1.x, x2.x, bb.x, bfhi);
        CONV1(2, w0a.z, w1a.z, w2a.z, x0.y, x1.y, x2.y, bb.y, bflo); CONV1(3, w0a.w, w1a.w, w2a.w, x0.y, x1.y, x2.y, bb.y, bfhi);
        CONV1(4, w0b.x, w1b.x, w2b.x, x0.z, x1.z, x2.z, bb.z, bflo); CONV1(5, w0b.y, w1b.y, w2b.y, x0.z, x1.z, x2.z, bb.z, bfhi);
        CONV1(6, w0b.z, w1b.z, w2b.z, x0.w, x1.w, x2.w, bb.w, bflo); CONV1(7, w0b.w, w1b.w, w2b.w, x0.w, x1.w, x2.w, bb.w, bfhi);
#undef CONV1
        u32x4 ov; ov.x = pk2(r[0], r[1]); ov.y = pk2(r[2], r[3]); ov.z = pk2(r[4], r[5]); ov.w = pk2(r[6], r[7]);
        if (!dry) *(u32x4*)(scb + o) = ov; else asm volatile("" :: "v"(ov));
    }
}
DEV float gelu_t(float a) { return a * __builtin_amdgcn_rcpf(1.f + __builtin_amdgcn_exp2f(-1.5957691216057308f * LOG2E * (a + 0.044715f * a * a * a))); }
DEV void ffn_mid_phase(int gtid, int gthreads, const bf16_t* fa, bf16_t* fu, const float* cw, const float* cb, bool dry) {
    constexpr int C8 = DFF / 8;
    for (int i = gtid; i < T * C8; i += gthreads) {
        const int t = i / C8, c8 = (i - t * C8) * 8, tl = t & (S - 1);
        const size_t o = (size_t)t * DFF + c8;
        const u32x4 z = {0u, 0u, 0u, 0u};
        const u32x4 x2 = *(const u32x4*)(fa + o), x1 = tl >= 1 ? *(const u32x4*)(fa + o - DFF) : z, x0 = tl >= 2 ? *(const u32x4*)(fa + o - 2 * DFF) : z, uu = *(const u32x4*)(fu + o);
        const f32x4 w0a = *(const f32x4*)(cw + c8), w0b = *(const f32x4*)(cw + c8 + 4), w1a = *(const f32x4*)(cw + DFF + c8), w1b = *(const f32x4*)(cw + DFF + c8 + 4), w2a = *(const f32x4*)(cw + 2 * DFF + c8), w2b = *(const f32x4*)(cw + 2 * DFF + c8 + 4);
        const f32x4 ba = *(const f32x4*)(cb + c8), bb = *(const f32x4*)(cb + c8 + 4);
        float r[8];
#define FM1(k, B0, W0, W1, W2, X0, X1, X2, Uv, F) r[k] = gelu_t(B0 + W0 * F(X0) + W1 * F(X1) + W2 * F(X2)) * F(Uv)
        FM1(0, ba.x, w0a.x, w1a.x, w2a.x, x0.x, x1.x, x2.x, uu.x, bflo); FM1(1, ba.y, w0a.y, w1a.y, w2a.y, x0.x, x1.x, x2.x, uu.x, bfhi);
        FM1(2, ba.z, w0a.z, w1a.z, w2a.z, x0.y, x1.y, x2.y, uu.y, bflo); FM1(3, ba.w, w0a.w, w1a.w, w2a.w, x0.y, x1.y, x2.y, uu.y, bfhi);
        FM1(4, bb.x, w0b.x, w1b.x, w2b.x, x0.z, x1.z, x2.z, uu.z, bflo); FM1(5, bb.y, w0b.y, w1b.y, w2b.y, x0.z, x1.z, x2.z, uu.z, bfhi);
        FM1(6, bb.z, w0b.z, w1b.z, w2b.z, x0.w, x1.w, x2.w, uu.w, bflo); FM1(7, bb.w, w0b.w, w1b.w, w2b.w, x0.w, x1.w, x2.w, uu.w, bfhi);
#undef FM1
        u32x4 ov; ov.x = pk2(r[0], r[1]); ov.y = pk2(r[2], r[3]); ov.z = pk2(r[4], r[5]); ov.w = pk2(r[6], r[7]);
        if (!dry) *(u32x4*)(fu + o) = ov; else asm volatile("" :: "v"(ov));
    }
}

typedef short s16x4 __attribute__((ext_vector_type(4)));
DEV s16x4 vtr(const LAS unsigned char* p) { return __builtin_bit_cast(s16x4, __builtin_amdgcn_ds_read_tr16_b64_v4i16((LAS s16x4*)p)); }
DEV bf16x8 cat8(const s16x4 a, const s16x4 b) { return (bf16x8){a[0], a[1], a[2], a[3], b[0], b[1], b[2], b[3]}; }
DEV bf16x8 pk8(float a0, float a1, float a2, float a3, float a4, float a5, float a6, float a7) {
    u32x4 w; w.x = pk2(a0, a1); w.y = pk2(a2, a3); w.z = pk2(a4, a5); w.w = pk2(a6, a7); return __builtin_bit_cast(bf16x8, w); }
constexpr int VPITCH = 192;
DEV void pv_tile(f32x16& o0, f32x16& o1, const LAS unsigned char* vt, int lane, const bf16x8 (&pk)[4]) {
    const int hi = lane >> 5;
    const LAS unsigned char* vb = vt + (4 * hi + ((lane & 15) >> 2)) * VPITCH + ((lane >> 4) & 1) * 32 + (lane & 3) * 8;
    bf16x8 va[4];
#pragma unroll
    for (int ks = 0; ks < 4; ++ks) va[ks] = cat8(vtr(vb + (16 * ks) * VPITCH), vtr(vb + (16 * ks + 8) * VPITCH));
    asm volatile("" : "+v"(va[0]), "+v"(va[1]), "+v"(va[2]), "+v"(va[3]));
#pragma unroll
    for (int ks = 0; ks < 4; ++ks) o0 = __builtin_amdgcn_mfma_f32_32x32x16_bf16(va[ks], pk[ks], o0, 0, 0, 0);
#pragma unroll
    for (int ks = 0; ks < 4; ++ks) va[ks] = cat8(vtr(vb + (16 * ks) * VPITCH + 64), vtr(vb + (16 * ks + 8) * VPITCH + 64));
    asm volatile("" : "+v"(va[0]), "+v"(va[1]), "+v"(va[2]), "+v"(va[3]));
#pragma unroll
    for (int ks = 0; ks < 4; ++ks) o1 = __builtin_amdgcn_mfma_f32_32x32x16_bf16(va[ks], pk[ks], o1, 0, 0, 0);
}
DEV void store_ot(bf16_t* orow, const f32x16& o0, const f32x16& o1, int hi, float sc) {
#pragma unroll
    for (int g4 = 0; g4 < 4; ++g4) {
        u32x2 a; a.x = pk2(o0[4 * g4] * sc, o0[4 * g4 + 1] * sc); a.y = pk2(o0[4 * g4 + 2] * sc, o0[4 * g4 + 3] * sc);
        u32x2 b; b.x = pk2(o1[4 * g4] * sc, o1[4 * g4 + 1] * sc); b.y = pk2(o1[4 * g4 + 2] * sc, o1[4 * g4 + 3] * sc);
        *(u32x2*)(orow + 8 * g4 + 4 * hi) = a; *(u32x2*)(orow + 32 + 8 * g4 + 4 * hi) = b;
    }
}

DEV void sb_item(LAS unsigned char* vl, const bf16_t* Q, const bf16_t* Kk, const bf16_t* V, bf16_t* O, int b, int h, int qb, int lane, bool dry) {
    const int r32 = lane & 31, hi = lane >> 5, t0 = 32 * qb, t = t0 + r32; const size_t rowb = (size_t)b * S;
    bf16x8 qr[4]; { const bf16_t* qp = Q + (rowb + t0 + r32) * 512 + h * 64 + 8 * hi;
#pragma unroll
        for (int d0 = 0; d0 < 4; ++d0) qr[d0] = *(const bf16x8*)(qp + 16 * d0); }
    f32x16 o0, o1;
#pragma unroll
    for (int r = 0; r < 16; ++r) { o0[r] = 0.f; o1[r] = 0.f; }
    float carry = 1.f;
    const int c_hi = (t0 + 30) >> 6;
#pragma unroll 1
    for (int c = c_hi; c >= 0; --c) {
        const bf16_t* kp = Kk + (rowb + 64 * c + r32) * 512 + h * 64 + 8 * hi;
        bf16x8 k0[4], k1[4];
#pragma unroll
        for (int d0 = 0; d0 < 4; ++d0) { k0[d0] = *(const bf16x8*)(kp + 16 * d0); k1[d0] = *(const bf16x8*)(kp + (size_t)32 * 512 + 16 * d0); }
#pragma unroll
        for (int j = 0; j < 8; ++j) { const int row = (lane >> 3) + 8 * j; *(LAS u32x4*)(vl + row * VPITCH + (lane & 7) * 16) = *(const u32x4*)(V + (rowb + 64 * c + row) * 512 + h * 64 + (lane & 7) * 8); }
        f32x16 p0, p1;
#pragma unroll
        for (int r = 0; r < 16; ++r) { p0[r] = 0.f; p1[r] = 0.f; }
#pragma unroll
        for (int d0 = 0; d0 < 4; ++d0) { p0 = __builtin_amdgcn_mfma_f32_32x32x16_bf16(k0[d0], qr[d0], p0, 0, 0, 0); p1 = __builtin_amdgcn_mfma_f32_32x32x16_bf16(k1[d0], qr[d0], p1, 0, 0, 0); }
        float u[32];
        const bool diag = (c == c_hi);
#pragma unroll
        for (int e = 0; e < 32; ++e) {
            const float z = e < 16 ? p0[e] : p1[e - 16];
            float uu = __builtin_amdgcn_rcpf(1.f + __builtin_amdgcn_exp2f(fminf(z, 126.f)));
            if (diag) { const int kv = 64 * c + 8 * ((e >> 2) & 3) + 4 * hi + (e & 3) + 32 * (e >> 4); if (kv >= t) uu = 1.f; }
            u[e] = uu;
        }
        float gl[8], gh[8];
#pragma unroll
        for (int i = 0; i < 8; ++i) { const float gp = (u[4 * i] * u[4 * i + 1]) * (u[4 * i + 2] * u[4 * i + 3]);
            const auto rr = __builtin_amdgcn_permlane32_swap(__float_as_uint(gp), __float_as_uint(gp), false, false); gl[i] = __uint_as_float(rr[0]); gh[i] = __uint_as_float(rr[1]); }
        float ag[8]; float run = carry;
#pragma unroll
        for (int i = 7; i >= 0; --i) { const float a_hi = run; run *= gh[i]; const float a_lo = run; run *= gl[i]; ag[i] = hi ? a_hi : a_lo; }
        carry = run;
        bf16x8 pk[4];
#pragma unroll
        for (int ks = 0; ks < 4; ++ks) { float w[8];
#pragma unroll
            for (int g = 0; g < 2; ++g) { const int i = 2 * ks + g;
                const float a3 = ag[i], a2 = a3 * u[4 * i + 3], a1 = a2 * u[4 * i + 2], a0 = a1 * u[4 * i + 1];
                w[4 * g] = (1.f - u[4 * i]) * a0; w[4 * g + 1] = (1.f - u[4 * i + 1]) * a1; w[4 * g + 2] = (1.f - u[4 * i + 2]) * a2; w[4 * g + 3] = (1.f - u[4 * i + 3]) * a3; }
            pk[ks] = pk8(w[0], w[1], w[2], w[3], w[4], w[5], w[6], w[7]); }
        pv_tile(o0, o1, vl, lane, pk);
        if (__all(carry < 7.8e-31f)) break;
    }
    if (!dry) store_ot(O + (rowb + t0 + r32) * 512 + h * 64, o0, o1, hi, 1.f); else asm volatile("" :: "v"(o0), "v"(o1));
}
DEV void sb_phase(const WaveId& W, LAS unsigned char* lds, unsigned char* ws, bool dry) {
    LAS unsigned char* vl = lds + W.wave * 12288;
    const bf16_t* Q = (const bf16_t*)(ws + WS_QA); const bf16_t* Kk = (const bf16_t*)(ws + WS_KA); const bf16_t* V = (const bf16_t*)(ws + WS_VA);
    constexpr int NITEM = NB * 8 * (S / 32);
    for (int it = W.gw; it < NITEM; it += W.ngw) {
        const int qb = it & 255, h = (it >> 8) & 7, b = it >> 11;
        sb_item(vl, Q, Kk, V, (bf16_t*)(ws + WS_QA), b, h, qb, W.lane, dry);
    }
}

constexpr int IDX_CTL_OFF = 131072 + 1024;
DEV unsigned fkey2(float v) { const int u = (int)__float_as_uint(v); return (unsigned)(u ^ ((u >> 31) | (int)0x80000000)); }
DEV float relu1(float x) { return __builtin_amdgcn_fmed3f(x, 0.f, 3.0e38f); }
DEV void idx_prefetch(bf16x8 (&afr)[4], float (&w)[16], bf16x8 (&b0)[4], bf16x8 (&b1)[4], const bf16_t* IQ, const bf16_t* IK, const float* IWp, int b, int t0, int wid, int lane) {
    const int r32 = lane & 31, hh = lane >> 5; const size_t rowb = (size_t)b * S;
    { const int qi = 2 * (r32 >> 4) + ((r32 >> 2) & 1), head = (r32 & 3) + 4 * ((r32 >> 3) & 1);
        const bf16_t* ap = IQ + (rowb + t0 + qi) * 512 + head * 64 + 8 * hh;
#pragma unroll
        for (int ks = 0; ks < 4; ++ks) afr[ks] = *(const bf16x8*)(ap + 16 * ks); }
#pragma unroll
    for (int r = 0; r < 16; ++r) w[r] = IWp[(rowb + t0 + 2 * (r >> 3) + hh) * 8 + (r & 7)];
    const int jmax = (t0 + 3) >> 5;
    { const int j0 = wid < jmax ? wid : jmax, j1 = wid + 8 < jmax ? wid + 8 : jmax;
      const bf16_t* p0 = IK + ((rowb >> 5) + j0) * 2048 + (hh * 32 + r32) * 8; const bf16_t* p1 = IK + ((rowb >> 5) + j1) * 2048 + (hh * 32 + r32) * 8;
#pragma unroll
      for (int ks = 0; ks < 4; ++ks) { b0[ks] = *(const bf16x8*)(p0 + ks * 512); b1[ks] = *(const bf16x8*)(p1 + ks * 512); } }
}
DEV void idx_unit(LAS unsigned char* lds, const bf16_t* IQ, const bf16_t* IK, const float* IWp, unsigned* BM, int b, int t0, int nb, int nt0, int wid, int lane,
                  bf16x8 (&afr)[4], float (&w)[16], bf16x8 (&b0)[4], bf16x8 (&b1)[4]) {
    const int r32 = lane & 31, hh = lane >> 5; const size_t rowb = (size_t)b * S;
    const int tmax = t0 + 3, jmax = tmax >> 5;
    LAS unsigned* SCO = (LAS unsigned*)lds;
    bf16x8 b2[4];
#pragma unroll
    for (int ks = 0; ks < 4; ++ks) b2[ks] = afr[ks];
#define IDX_LOADB(dst, jj) do { const int jc_ = (jj) < jmax ? (jj) : jmax; const bf16_t* bp_ = IK + ((rowb >> 5) + jc_) * 2048 + (hh * 32 + r32) * 8; \
        _Pragma("unroll") for (int ks = 0; ks < 4; ++ks) dst[ks] = *(const bf16x8*)(bp_ + ks * 512); } while (0)
#define IDX_COMP(src, jj) do { f32x16 acc; _Pragma("unroll") for (int r = 0; r < 16; ++r) acc[r] = 0.f; \
        _Pragma("unroll") for (int ks = 0; ks < 4; ++ks) acc = __builtin_amdgcn_mfma_f32_32x32x16_bf16(afr[ks], src[ks], acc, 0, 0, 0); \
        float s0 = 0.f, s1 = 0.f; _Pragma("unroll") for (int hd = 0; hd < 8; ++hd) { s0 += w[hd] * relu1(acc[hd]); s1 += w[8 + hd] * relu1(acc[8 + hd]); } \
        unsigned k0_ = fkey2(s0), k1_ = fkey2(s1); const int key = 32 * (jj) + r32; \
        if ((jj) >= jmax) { k0_ = key <= t0 + hh ? k0_ : 0u; k1_ = key <= t0 + 2 + hh ? k1_ : 0u; }     \
        if ((jj) <= jmax) { SCO[hh * 8192 + key] = k0_; SCO[(2 + hh) * 8192 + key] = k1_; } } while (0)
#ifndef IDX_REP_MFMA
#define IDX_REP_MFMA 1
#endif
#ifndef IDX_REP_SEL
#define IDX_REP_SEL 1
#endif
#ifdef IDX_DRY_COMPUTE
#pragma unroll 1
    for (int j = wid; j <= jmax; j += 24) { IDX_COMP(b0, j); asm volatile("" : "+v"(b0[0]), "+v"(b1[0]), "+v"(b2[0])); IDX_COMP(b1, j + 8); IDX_COMP(b2, j + 16); }
#endif
#pragma unroll 1
    for (int rpm = 0; rpm < IDX_REP_MFMA; ++rpm) {
#pragma unroll 1
    for (int j = wid; j <= jmax; j += 24) {
        IDX_LOADB(b2, j + 16); IDX_COMP(b0, j);
        IDX_LOADB(b0, j + 24); IDX_COMP(b1, j + 8);
        IDX_LOADB(b1, j + 32); IDX_COMP(b2, j + 16);
    }
    }
#undef IDX_LOADB
#undef IDX_COMP
    if (nt0 >= 0) idx_prefetch(afr, w, b0, b1, IQ, IK, IWp, nb, nt0, wid, lane);
    LAS unsigned* thr = (LAS unsigned*)(lds + IDX_CTL_OFF);
    if (wid == 0 && lane < 32) ((LAS unsigned*)(lds + IDX_CTL_OFF + 64))[lane] = 0u;
    LDS_WAIT(); __builtin_amdgcn_s_barrier(); asm volatile("" ::: "memory");
    {
        const int q = wid & 3, h = wid >> 2, n = t0 + q + 1;
        volatile LAS unsigned* xme = (volatile LAS unsigned*)(lds + IDX_CTL_OFF + 64) + (q * 2 + h) * 4;
        volatile LAS unsigned* xpa = (volatile LAS unsigned*)(lds + IDX_CTL_OFF + 64) + (q * 2 + (h ^ 1)) * 4;
        unsigned T_ = 1u;
        if (n > 256) {
            LAS unsigned* row = SCO + q * 8192 + lane;
            unsigned r[64];
            const int nil = (jmax >> 1) >= h ? (((jmax >> 1) - h) >> 1) + 1 : 0;
#define IDX_FOR_LIVE(BODY) _Pragma("unroll") for (int g8_ = 0; g8_ < 8; ++g8_) if (8 * g8_ < nil) { _Pragma("unroll") for (int u8_ = 0; u8_ < 8; ++u8_) { const int il = 8 * g8_ + u8_; BODY } }
            IDX_FOR_LIVE( r[il] = (2 * (2 * il + h) + hh <= jmax) ? row[64 * (2 * il + h)] : 0u; )
            unsigned seq = 0u;
#define IDX_XCHG(val, out) do { ++seq; const int pb_ = (seq & 1u) * 2; if (lane == 0) { xme[pb_ + 1] = (val); xme[pb_] = seq; } \
                while (xpa[pb_] != seq) __builtin_amdgcn_s_sleep(0); (out) = xpa[pb_ + 1]; } while (0)
#define IDX_XCHG16(val, out) do { ++seq; const int pb_ = (seq & 1u) * 2; if (lane == 0) xme[pb_] = (seq << 16) | (val); unsigned w_; \
                while (((w_ = xpa[pb_]) >> 16) != (seq & 0xffffu)) __builtin_amdgcn_s_sleep(0); (out) = w_ & 0xffffu; } while (0)
#pragma unroll 1
            for (int rps = 0; rps < IDX_REP_SEL; ++rps) {
            unsigned mx = 0u;
            IDX_FOR_LIVE( mx = max(mx, r[il]); )
#pragma unroll
            for (int o = 1; o < 64; o <<= 1) mx = max(mx, (unsigned)__shfl_xor((int)mx, o));
            { unsigned pm_; IDX_XCHG(mx, pm_); mx = max(mx, pm_); }
            unsigned lo_ = 1u, hi_ = mx + 1u, chi_ = 0u, xgt_ = 1u, xeq_ = 0u, mt_ = 0u; float glo_ = __log2f((float)n) - 8.f, ghi_ = -9.f; int side_ = 0; bool done_ = false;
#pragma unroll 1
            for (int pass = 0; pass < 2 && !done_; ++pass) {
                const unsigned wdt = hi_ - lo_;
                unsigned off;
                if (pass < 2) {
                    const unsigned mkey = hi_ - 1u; const unsigned tgt = pass == 0 ? mkey - (1u << 23) : mkey - (3u << 23);
                    const bool ok = pass == 0 ? (mkey > 0x81000000u) : (mkey > 0x82000000u && tgt > lo_ && tgt < hi_);
                    off = ok ? tgt - lo_ : wdt >> 1;
                } else if ((pass & 3) == 3) off = wdt >> 1;
                else off = (unsigned)(glo_ * __builtin_amdgcn_rcpf(glo_ - ghi_) * (float)wdt);
                off = off < 1u ? 1u : (off > wdt - 1u ? wdt - 1u : off);
                const unsigned cand = (unsigned)__builtin_amdgcn_readfirstlane((int)(lo_ + off));
                unsigned ca_ = 0, cb_ = 0; const unsigned candv = lo_ + off;
#define IDX_CNT4(A, B, C, Dd) asm volatile("v_cmp_ge_u32_e64 s[88:89], %2, %6\n\tv_cmp_ge_u32_e64 s[90:91], %3, %6\n\tv_cmp_ge_u32_e64 s[92:93], %4, %6\n\tv_cmp_ge_u32_e64 s[94:95], %5, %6\n\t" \
                    "v_addc_co_u32_e64 %0, s[88:89], %0, 0, s[88:89]\n\tv_addc_co_u32_e64 %1, s[90:91], %1, 0, s[90:91]\n\tv_addc_co_u32_e64 %0, s[92:93], %0, 0, s[92:93]\n\tv_addc_co_u32_e64 %1, s[94:95], %1, 0, s[94:95]" \
                    : "+v"(ca_), "+v"(cb_) : "v"(A), "v"(B), "v"(C), "v"(Dd), "v"(candv) : "s88", "s89", "s90", "s91", "s92", "s93", "s94", "s95")
#pragma unroll
                for (int g8_ = 0; g8_ < 8; ++g8_) if (8 * g8_ < nil) { IDX_CNT4(r[8 * g8_], r[8 * g8_ + 1], r[8 * g8_ + 2], r[8 * g8_ + 3]); IDX_CNT4(r[8 * g8_ + 4], r[8 * g8_ + 5], r[8 * g8_ + 6], r[8 * g8_ + 7]); }
#undef IDX_CNT4
                int pk = (int)(ca_ + cb_);
                pk += __builtin_amdgcn_update_dpp(0, pk, 0x111, 0xf, 0xf, false);
                pk += __builtin_amdgcn_update_dpp(0, pk, 0x112, 0xf, 0xf, false);
                pk += __builtin_amdgcn_update_dpp(0, pk, 0x114, 0xf, 0xf, false);
                pk += __builtin_amdgcn_update_dpp(0, pk, 0x118, 0xf, 0xf, false);
                pk += __builtin_amdgcn_update_dpp(0, pk, 0x142, 0xa, 0xf, false);
                unsigned tot = (unsigned)__builtin_amdgcn_readlane(pk, 31) + (unsigned)__builtin_amdgcn_readlane(pk, 63);
                { unsigned pt_; IDX_XCHG16(tot, pt_); tot += pt_; }
                const float gc = __log2f(fmaxf((float)tot, 0.5f)) - 8.f;
                if (tot == 256u) { xgt_ = cand; mt_ = 0u; done_ = true; }
                else { if (tot > 256u) { if (side_ == 1) ghi_ *= 0.5f; lo_ = cand; glo_ = gc; side_ = 1; }
                       else { if (side_ == 2) glo_ *= 0.5f; hi_ = cand; ghi_ = gc; chi_ = tot; side_ = 2; }
                       if (hi_ - lo_ == 1u) { xgt_ = hi_; xeq_ = lo_; mt_ = 256u - chi_; done_ = true; } }
            }
            { LAS unsigned* hist = (LAS unsigned*)(lds + IDX_CTL_OFF + 1024) + q * 256;
#pragma unroll 1
              for (int round = 0; round < 6 && !done_; ++round) {
                const unsigned wdt = hi_ - lo_;
                const int sh = wdt <= 256u ? 0 : 24 - (int)__builtin_clz(wdt - 1u);
                hist[128 * h + lane] = 0u; hist[128 * h + 64 + lane] = 0u;
                LDS_WAIT(); { unsigned d_; IDX_XCHG16(0u, d_); (void)d_; }
                const unsigned lov = lo_;
                IDX_FOR_LIVE( const unsigned d = r[il] - lov; if (d < wdt) __hip_atomic_fetch_add(hist + (d >> sh), 1u, __ATOMIC_RELAXED, __HIP_MEMORY_SCOPE_WORKGROUP); )
                LDS_WAIT(); { unsigned d_; IDX_XCHG16(0u, d_); (void)d_; }
                const u32x4 hb = *(const LAS u32x4*)(hist + 4 * lane);
                const unsigned s4 = (hb.x + hb.y) + (hb.z + hb.w);
                unsigned suf = s4;
#pragma unroll
                for (int o = 1; o < 64; o <<= 1) { const unsigned tv = (unsigned)__shfl_down((int)suf, o); if (lane + o < 64) suf += tv; }
                const unsigned long long okm = __ballot(chi_ + suf >= 256u);
                const int L = 63 - (int)__builtin_clzll(okm);
                const unsigned above = chi_ + (unsigned)__builtin_amdgcn_readlane((int)(suf - s4), L);
                const unsigned h0 = (unsigned)__builtin_amdgcn_readlane((int)hb.x, L), h1 = (unsigned)__builtin_amdgcn_readlane((int)hb.y, L),
                               h2 = (unsigned)__builtin_amdgcn_readlane((int)hb.z, L), h3 = (unsigned)__builtin_amdgcn_readlane((int)hb.w, L);
                unsigned Bsel, cab, cnb;
                if (above + h3 >= 256u) { Bsel = 3u; cab = above; cnb = h3; }
                else if (above + h3 + h2 >= 256u) { Bsel = 2u; cab = above + h3; cnb = h2; }
                else if (above + h3 + h2 + h1 >= 256u) { Bsel = 1u; cab = above + h3 + h2; cnb = h1; }
                else { Bsel = 0u; cab = above + h3 + h2 + h1; cnb = h0; }
                Bsel += 4u * (unsigned)L;
                const unsigned nlo = lo_ + (Bsel << sh); unsigned nhi = nlo + (1u << sh); if (nhi > hi_ || nhi < nlo) nhi = hi_;
                if (cab + cnb == 256u) { xgt_ = nlo; mt_ = 0u; done_ = true; }
                else if (sh == 0) { xgt_ = nlo + 1u; xeq_ = nlo; mt_ = 256u - cab; done_ = true; }
                else { lo_ = nlo; hi_ = nhi; chi_ = cab; }
              } }
#ifdef IDX_XTRA
#pragma unroll 1
            for (int xr = 0; xr < IDX_XTRA; ++xr) { unsigned dsum = 0; const unsigned cv = xgt_ + (unsigned)xr;
                IDX_FOR_LIVE( dsum += r[il] >= cv; )
                int pk = (int)dsum;
                pk += __builtin_amdgcn_update_dpp(0, pk, 0x111, 0xf, 0xf, false); pk += __builtin_amdgcn_update_dpp(0, pk, 0x112, 0xf, 0xf, false); pk += __builtin_amdgcn_update_dpp(0, pk, 0x114, 0xf, 0xf, false);
                pk += __builtin_amdgcn_update_dpp(0, pk, 0x118, 0xf, 0xf, false); pk += __builtin_amdgcn_update_dpp(0, pk, 0x142, 0xa, 0xf, false);
                unsigned tot = (unsigned)__builtin_amdgcn_readlane(pk, 31) + (unsigned)__builtin_amdgcn_readlane(pk, 63);
                { unsigned pt_; IDX_XCHG16(tot, pt_); tot += pt_; } asm volatile("" :: "s"(tot)); }
#endif
            T_ = xgt_;
            if (mt_ != 0u) {
                if (h == 0) { unsigned run = 0u;
#pragma unroll 1
                    for (int i = 0; i <= (jmax >> 1); ++i) { const bool ok_ = 2 * i + hh <= jmax; const unsigned kv = ok_ ? row[64 * i] : 0u; const bool eq = kv == xeq_; const unsigned long long bm = __ballot(eq);
                        const unsigned rank = run + __builtin_amdgcn_mbcnt_hi((unsigned)(bm >> 32), __builtin_amdgcn_mbcnt_lo((unsigned)bm, 0u));
                        if (eq && rank >= mt_) row[64 * i] = 0u;
                        run += (unsigned)__popcll(bm); } }
                T_ = xeq_;
            }
            }
#undef IDX_XCHG
#undef IDX_XCHG16
#undef IDX_FOR_LIVE
        }
        if (lane == 0 && h == 0) thr[q] = T_;
    }
#ifdef PROBE_VALU
    { float a0 = (float)lane, a1 = a0 + 1.f, a2 = a0 + 2.f, a3 = a0 + 3.f, a4 = a0 + 4.f, a5 = a0 + 5.f, a6 = a0 + 6.f, a7 = a0 + 7.f; const float m = 1.0000001f, c = 1e-9f;
#pragma unroll 1
      for (int it = 0; it < 64; ++it) {
#pragma unroll
          for (int u = 0; u < 8; ++u) { a0 = a0 * m + c; a1 = a1 * m + c; a2 = a2 * m + c; a3 = a3 * m + c; a4 = a4 * m + c; a5 = a5 * m + c; a6 = a6 * m + c; a7 = a7 * m + c; } }
      asm volatile("" :: "v"(a0), "v"(a1), "v"(a2), "v"(a3), "v"(a4), "v"(a5), "v"(a6), "v"(a7)); }
#endif
    LDS_WAIT(); __builtin_amdgcn_s_barrier(); asm volatile("" ::: "memory");
    { const unsigned tq0 = thr[hh], tq1 = thr[2 + hh];
#pragma unroll 4
      for (int j = wid; j <= ((t0 | 255) >> 5); j += 8) {
          bool s0 = false, s1 = false;
          if (j <= jmax) { s0 = SCO[hh * 8192 + 32 * j + r32] >= tq0; s1 = SCO[(2 + hh) * 8192 + 32 * j + r32] >= tq1; }
          const unsigned long long b0_ = __ballot(s0), b1_ = __ballot(s1);
          if (lane == 0) { u32x4 o; o.x = (unsigned)b0_; o.y = (unsigned)(b0_ >> 32); o.z = (unsigned)b1_; o.w = (unsigned)(b1_ >> 32); *(u32x4*)(BM + ((size_t)b * 256 + j) * S + t0) = o; }
      } }
    LDS_WAIT(); __builtin_amdgcn_s_barrier();
}
DEV void idx_phase(LAS unsigned char* lds, unsigned char* ws, int vcu, int G, int wid, int lane) {
    constexpr int NUNIT = T / 4;
    const bf16_t* IQ = (const bf16_t*)(ws + WS_IQ); const bf16_t* IK = (const bf16_t*)(ws + WS_IK); const float* IW = (const float*)(ws + WS_IW);
#define IDX_UNIT_OF(k) ((k) * G + (((k) & 1) ? G - 1 - vcu : vcu))
    bf16x8 afr[4], b0[4], b1[4]; float w[16];
    int un = IDX_UNIT_OF(0);
    if (un < NUNIT) { const int b = un / (S / 4); idx_prefetch(afr, w, b0, b1, IQ, IK, IW, b, (un - b * (S / 4)) * 4, wid, lane); }
#pragma unroll 1
    for (int k = 0; un < NUNIT; ++k) {
        const int b = un / (S / 4), t0 = (un - b * (S / 4)) * 4;
        const int nun = IDX_UNIT_OF(k + 1); const int nb = nun / (S / 4), nt0 = nun < NUNIT ? (nun - nb * (S / 4)) * 4 : -1;
        idx_unit(lds, IQ, IK, IW, (unsigned*)(ws + WS_BM), b, t0, nb, nt0, wid, lane, afr, w, b0, b1);
        un = nun;
    }
#undef IDX_UNIT_OF
}

DEV void kn_phase(const WaveId& W, const bf16_t* Kk, float* KN) {
    for (int item = W.gw; item < NB * 8 * (S / 64); item += W.ngw) {
        const int b = item / (8 * (S / 64)), h = (item / (S / 64)) & 7, tile = item % (S / 64);
        const bf16_t* kp = Kk + ((size_t)b * S + tile * 64 + W.lane) * 512 + h * 64;
        float ss = 0.f;
#pragma unroll
        for (int c = 0; c < 8; ++c) { const u32x4 v = *(const u32x4*)(kp + 8 * c);
#pragma unroll
            for (int e = 0; e < 4; ++e) { const float lo = __uint_as_float(v[e] << 16), hi = __uint_as_float(v[e] & 0xffff0000u); ss += lo * lo + hi * hi; } }
        const float m = wave_max(ss);
        if (W.lane == 0) KN[item] = sqrtf(m) * 1.01f;
    }
}

constexpr int DSA_STAGE = 8192 + 64 * VPITCH;
DEV void dsa_unit(LAS unsigned char* lds, const bf16_t* Q, const bf16_t* Kk, const bf16_t* V, const unsigned* BM, const float* KN, bf16_t* O, int b, int h, int qblk, int tid, int wid, int lane) {
    const int r32 = lane & 31, hi = lane >> 5, q0 = 256 * qblk, t0 = q0 + 32 * wid, t = t0 + r32; const size_t rowb = (size_t)b * S;
    bf16x8 qr[4]; { const bf16_t* qp = Q + (rowb + t) * 512 + h * 64 + 8 * hi;
#pragma unroll
        for (int d0 = 0; d0 < 4; ++d0) qr[d0] = *(const bf16x8*)(qp + 16 * d0); }
    f32x16 o0, o1, negm;
#pragma unroll
    for (int r = 0; r < 16; ++r) { o0[r] = 0.f; o1[r] = 0.f; negm[r] = 0.f; }
    float mref = 0.f, lsum = 0.f; bool seen = false;
    float qn; { float qs = 0.f;
#pragma unroll
        for (int d0 = 0; d0 < 4; ++d0)
#pragma unroll
            for (int e = 0; e < 8; ++e) { const float x = __uint_as_float(((unsigned)(unsigned short)qr[d0][e]) << 16); qs += x * x; }
        const auto rr = __builtin_amdgcn_permlane32_swap(__float_as_uint(qs), __float_as_uint(qs), false, false); qn = sqrtf(__uint_as_float(rr[0]) + __uint_as_float(rr[1])) * 1.01f; }
    constexpr float FASTB = 60.f;
    int zlane = 0; asm volatile("" : "+v"(zlane));
    const float* knp = KN + (b * 8 + h) * (S / 64) + zlane;
    float knv = knp[0];
    constexpr float THR = 8.f;
    const int ntile = (q0 + 256) / 64, wlast = (t0 + 31) >> 6;
    const int srow = tid >> 3, sch = tid & 7;
    const bf16_t* kg = Kk + (rowb + srow) * 512 + h * 64 + sch * 8; const bf16_t* vg = V + (rowb + srow) * 512 + h * 64 + sch * 8;
    const int kdst = srow * 128 + ((sch ^ (srow & 7)) * 16), vdst = srow * VPITCH + sch * 16;
    u32x4 kr0 = *(const u32x4*)kg, vr0 = *(const u32x4*)vg;
    *(LAS u32x4*)(lds + kdst) = kr0; *(LAS u32x4*)(lds + 8192 + vdst) = vr0;
    u32x4 kr1 = *(const u32x4*)(kg + (size_t)64 * 512), vr1 = *(const u32x4*)(vg + (size_t)64 * 512);
    const unsigned* bmp = BM + (size_t)b * 256 * S + t;
    unsigned mw0 = bmp[0], mw1 = bmp[(size_t)S];
    const int koff = r32 * 128;
    __syncthreads();
#define DSA_TILE(c, BUF, NBUF, KL, VL, KW, VW) do { \
        const LAS unsigned char* kt = lds + (BUF) * DSA_STAGE; const LAS unsigned char* vt = kt + 8192; \
        if ((c) + 2 < ntile) { KL = *(const u32x4*)(kg + (size_t)((c) + 2) * 64 * 512); VL = *(const u32x4*)(vg + (size_t)((c) + 2) * 64 * 512); } \
        unsigned nw0 = 0u, nw1 = 0u; float nkn = 0.f; \
        if ((c) + 1 <= wlast) { nw0 = bmp[(size_t)(2 * (c) + 2) * S]; nw1 = bmp[(size_t)(2 * (c) + 3) * S]; nkn = knp[(c) + 1]; } \
        if ((c) <= wlast) { \
            bf16x8 kf[8]; \
            _Pragma("unroll") for (int d0 = 0; d0 < 4; ++d0) { const int xo = ((2 * d0 + hi) ^ (r32 & 7)) * 16; \
                kf[2 * d0] = *(const LAS bf16x8*)(kt + koff + xo); kf[2 * d0 + 1] = *(const LAS bf16x8*)(kt + koff + 4096 + xo); } \
            asm volatile("" : "+v"(kf[0]), "+v"(kf[1]), "+v"(kf[2]), "+v"(kf[3]), "+v"(kf[4]), "+v"(kf[5]), "+v"(kf[6]), "+v"(kf[7]));     \
            f32x16 p0 = negm, p1 = negm; \
            _Pragma("unroll") for (int d0 = 0; d0 < 4; ++d0) { p0 = __builtin_amdgcn_mfma_f32_32x32x16_bf16(kf[2 * d0], qr[d0], p0, 0, 0, 0); p1 = __builtin_amdgcn_mfma_f32_32x32x16_bf16(kf[2 * d0 + 1], qr[d0], p1, 0, 0, 0); } \
            const unsigned m0 = mw0 >> (4 * hi), m1 = mw1 >> (4 * hi); \
            _Pragma("unroll") for (int r = 0; r < 16; ++r) { const int bit = (r & 3) + 8 * (r >> 2); \
                const unsigned e0 = (unsigned)__builtin_amdgcn_sbfe((int)m0, bit, 1), e1 = (unsigned)__builtin_amdgcn_sbfe((int)m1, bit, 1); \
                p0[r] = __uint_as_float((__float_as_uint(p0[r]) & e0) | (0xff800000u & ~e0)); p1[r] = __uint_as_float((__float_as_uint(p1[r]) & e1) | (0xff800000u & ~e1)); } \
            if (__any(!(qn * knv + fabsf(mref) <= FASTB))) {     \
                float rm = -INFINITY; \
                _Pragma("unroll") for (int r = 0; r < 16; r += 2) rm = fmaxf(rm, fmaxf(fmaxf(p0[r], p0[r + 1]), fmaxf(p1[r], p1[r + 1]))); \
                { const auto rr = __builtin_amdgcn_permlane32_swap(__float_as_uint(rm), __float_as_uint(rm), false, false); rm = fmaxf(__uint_as_float(rr[0]), __uint_as_float(rr[1])); } \
                const bool shift = rm > THR || (rm < -THR && rm > -INFINITY && !seen);     \
                if (__any(shift)) { \
                    const float dl = shift ? rm : 0.f, f = dl > 0.f ? __builtin_amdgcn_exp2f(-dl) : 1.f; \
                    mref += dl; lsum *= f; \
                    _Pragma("unroll") for (int r = 0; r < 16; ++r) { p0[r] -= dl; p1[r] -= dl; o0[r] *= f; o1[r] *= f; negm[r] = -mref; } \
                } \
            } \
            seen = seen || (mw0 | mw1) != 0u;     \
            float ps = 0.f; \
            _Pragma("unroll") for (int r = 0; r < 16; ++r) { p0[r] = __builtin_amdgcn_exp2f(p0[r]); p1[r] = __builtin_amdgcn_exp2f(p1[r]); ps += p0[r] + p1[r]; } \
            lsum += ps; \
            bf16x8 pk[4]; \
            pk[0] = pk8(p0[0], p0[1], p0[2], p0[3], p0[4], p0[5], p0[6], p0[7]); pk[1] = pk8(p0[8], p0[9], p0[10], p0[11], p0[12], p0[13], p0[14], p0[15]); \
            pk[2] = pk8(p1[0], p1[1], p1[2], p1[3], p1[4], p1[5], p1[6], p1[7]); pk[3] = pk8(p1[8], p1[9], p1[10], p1[11], p1[12], p1[13], p1[14], p1[15]); \
            pv_tile(o0, o1, vt, lane, pk); \
        } \
        mw0 = nw0; mw1 = nw1; knv = nkn; \
        if ((c) + 1 < ntile) { LAS unsigned char* nb = lds + (NBUF) * DSA_STAGE; *(LAS u32x4*)(nb + kdst) = KW; *(LAS u32x4*)(nb + 8192 + vdst) = VW; } \
        asm volatile("s_waitcnt lgkmcnt(0)" ::: "memory"); __builtin_amdgcn_s_barrier(); asm volatile("" ::: "memory"); } while (0)
#pragma unroll 1
    for (int c = 0; c < ntile; c += 2) { DSA_TILE(c, 0, 1, kr0, vr0, kr1, vr1); DSA_TILE(c + 1, 1, 0, kr1, vr1, kr0, vr0); }
#undef DSA_TILE
    { const auto rr = __builtin_amdgcn_permlane32_swap(__float_as_uint(lsum), __float_as_uint(lsum), false, false); lsum = __uint_as_float(rr[0]) + __uint_as_float(rr[1]); }
    store_ot(O + (rowb + t) * 512 + h * 64, o0, o1, hi, 1.f / lsum);
}
DEV void dsa_phase(LAS unsigned char* lds, unsigned char* ws, int vcu, int G, int tid, int wid, int lane, bf16_t* Oout) {
    constexpr int NPAIR = NB * 8 * 16;
    for (int pr = vcu; pr < NPAIR; pr += G) {
        const int bh = pr >> 4, s = pr & 15, b = bh >> 3, h = bh & 7;
#pragma unroll 1
        for (int k = 0; k < 2; ++k) {
            const int qblk = k == 0 ? s : 31 - s;
            dsa_unit(lds, (const bf16_t*)(ws + WS_QC), (const bf16_t*)(ws + WS_KC), (const bf16_t*)(ws + WS_VC), (const unsigned*)(ws + WS_BM), (const float*)(ws + WS_KN), Oout, b, h, qblk, tid, wid, lane);
        }
    }
}
#include <hip/hip_bf16.h>
namespace attn_body {
using bf16=__hip_bfloat16;
using bf16x8=__attribute__((ext_vector_type(8)))short;
using s16x4=__attribute__((ext_vector_type(4)))short;
using f32x16=__attribute__((ext_vector_type(16)))float;
using u32x4=__attribute__((ext_vector_type(4)))unsigned;
constexpr int BATCH=2,NHEAD=8,SEQ=8192,D=64,DM=NHEAD*D;
constexpr int NW=8,QBLK=32,QB=QBLK*NW,KVBLK=64,NQB=SEQ/QB;
constexpr int ATTN_PITCH=DM, ATTN_UNIT_ROWS=QB;
__device__ __forceinline__ int crow(int r,int hi){return (r&3)+8*(r>>2)+4*hi;}
#define SBAR() __builtin_amdgcn_sched_barrier(0)
__device__ __forceinline__ void cmask(f32x16&p0,f32x16&p1,int jb,int qrel,int hi){
  const float NEG=-INFINITY; int kb=64*jb+4*hi;
  #pragma unroll
  for(int r=0;r<16;++r){int kv=kb+(r&3)+8*(r>>2); if(kv>qrel)p0[r]=NEG; if(kv+32>qrel)p1[r]=NEG;}
}

constexpr int NSLOT=3, SLOTB=8192;
constexpr int LDS_K=0, LDS_V=NSLOT*SLOTB, LDS_WS=2*NSLOT*SLOTB, LDS_OST=LDS_WS+NW*64*4, LDS_BYTES=LDS_OST+NW*4096;
constexpr float C2=0.125f*1.4426950408889634f;
__device__ __forceinline__ void glds16(const void*gsrc,unsigned lds_dst){unsigned keep;
  asm volatile("s_mov_b32 %0, m0\n\ts_mov_b32 m0, %2\n\ts_nop 0\n\tglobal_load_lds_dwordx4 %1, off\n\ts_mov_b32 m0, %0":"=&s"(keep):"v"(gsrc),"s"(lds_dst):"memory");}
__device__ __forceinline__ float max3f(float a,float b,float c){float r;asm("v_max3_f32 %0, %1, %2, %3":"=v"(r):"v"(a),"v"(b),"v"(c));return r;}
__device__ __forceinline__ float max2f(float a,float b){float r;asm("v_max_f32_e32 %0, %1, %2":"=v"(r):"v"(a),"v"(b));return r;}
__device__ __forceinline__ float fadd_s(float a,float b){float r;asm("v_add_f32_e32 %0, %1, %2":"=v"(r):"v"(a),"v"(b));return r;}
__device__ __forceinline__ float fsub_s(float a,float b){float r;asm("v_sub_f32_e32 %0, %1, %2":"=v"(r):"v"(a),"v"(b));return r;}
typedef float f32x2_t __attribute__((ext_vector_type(2))); typedef __bf16 bf16x2_t __attribute__((ext_vector_type(2)));
__device__ __forceinline__ unsigned cvtpk_s(float lo,float hi){f32x2_t v={lo,hi};bf16x2_t b=__builtin_convertvector(v,bf16x2_t);return __builtin_bit_cast(unsigned,b);}
#define WAIT_BAR(N) asm volatile("s_waitcnt vmcnt(" #N ") lgkmcnt(0)\n\ts_barrier":::"memory")

__device__ __forceinline__ void qkt(f32x16&p0,f32x16&p1,const char*Kslot,const bf16x8*qr,const f32x16&negm,int r32,int hi){
  const char*kb=Kslot+hi*1024+r32*16;
  #pragma unroll
  for(int d0=0;d0<4;++d0){
    const bf16x8 b0=*reinterpret_cast<const bf16x8*>(kb+d0*2048);
    const bf16x8 b1=*reinterpret_cast<const bf16x8*>(kb+d0*2048+512);
    if(d0==0){p0=__builtin_amdgcn_mfma_f32_32x32x16_bf16(b0,qr[0],negm,0,0,0);p1=__builtin_amdgcn_mfma_f32_32x32x16_bf16(b1,qr[0],negm,0,0,0);}
    else{p0=__builtin_amdgcn_mfma_f32_32x32x16_bf16(b0,qr[d0],p0,0,0,0);p1=__builtin_amdgcn_mfma_f32_32x32x16_bf16(b1,qr[d0],p1,0,0,0);}}
}
typedef __attribute__((address_space(3))) const char* lds_cptr;
typedef short v4i16_t __attribute__((ext_vector_type(4)));
__device__ __forceinline__ void kload8(bf16x8*kf,lds_cptr kp){
  kf[0]=*(const __attribute__((address_space(3))) bf16x8*)(kp);      kf[1]=*(const __attribute__((address_space(3))) bf16x8*)(kp+512);
  kf[2]=*(const __attribute__((address_space(3))) bf16x8*)(kp+2048); kf[3]=*(const __attribute__((address_space(3))) bf16x8*)(kp+2560);
  kf[4]=*(const __attribute__((address_space(3))) bf16x8*)(kp+4096); kf[5]=*(const __attribute__((address_space(3))) bf16x8*)(kp+4608);
  kf[6]=*(const __attribute__((address_space(3))) bf16x8*)(kp+6144); kf[7]=*(const __attribute__((address_space(3))) bf16x8*)(kp+6656);
}
__device__ __forceinline__ void kload2(bf16x8*kf,lds_cptr kp,int j){ kf[2*j]=*(const __attribute__((address_space(3))) bf16x8*)(kp+j*2048); kf[2*j+1]=*(const __attribute__((address_space(3))) bf16x8*)(kp+j*2048+512); }
__device__ __forceinline__ s16x4 vtr(lds_cptr p){ return __builtin_bit_cast(s16x4,__builtin_amdgcn_ds_read_tr16_b64_v4i16((__attribute__((address_space(3))) v4i16_t*)p)); }
__device__ __forceinline__ float rowmax(const f32x16&p0,const f32x16&p1){
  float a=max3f(p0[0],p0[1],p1[0]),b=max3f(p0[2],p0[3],p1[1]);a=max3f(a,p1[2],p1[3]);
  #pragma unroll
  for(int r=4;r<16;r+=4){a=max3f(a,p0[r],p0[r+1]);b=max3f(b,p0[r+2],p0[r+3]);a=max3f(a,p1[r],p1[r+1]);b=max3f(b,p1[r+2],p1[r+3]);}
  const float m=max2f(a,b);
  auto rr=__builtin_amdgcn_permlane32_swap(__float_as_uint(m),__float_as_uint(m),false,false);
  return max2f(__uint_as_float(rr[0]),__uint_as_float(rr[1]));
}
__device__ __forceinline__ void pv(f32x16*o,int vb,bf16x8 pa0,bf16x8 pa1,bf16x8 pa2,bf16x8 pa3){
  #pragma unroll
  for(int d0=0;d0<2;++d0){s16x4 lo[4],hi[4];
    #pragma unroll
    for(int ks=0;ks<4;++ks){
      asm volatile("ds_read_b64_tr_b16 %0,%1 offset:%c2":"=&v"(lo[ks]):"v"(vb),"i"(d0*4096+ks*1024):"memory");
      asm volatile("ds_read_b64_tr_b16 %0,%1 offset:%c2":"=&v"(hi[ks]):"v"(vb),"i"(d0*4096+ks*1024+512):"memory");}
    asm volatile("s_waitcnt lgkmcnt(0)":::"memory");SBAR();
    #define PK(k) (bf16x8){lo[k][0],lo[k][1],lo[k][2],lo[k][3],hi[k][0],hi[k][1],hi[k][2],hi[k][3]}
    o[d0]=__builtin_amdgcn_mfma_f32_32x32x16_bf16(pa0,PK(0),o[d0],0,0,0);
    o[d0]=__builtin_amdgcn_mfma_f32_32x32x16_bf16(pa1,PK(1),o[d0],0,0,0);
    o[d0]=__builtin_amdgcn_mfma_f32_32x32x16_bf16(pa2,PK(2),o[d0],0,0,0);
    o[d0]=__builtin_amdgcn_mfma_f32_32x32x16_bf16(pa3,PK(3),o[d0],0,0,0);
    #undef PK
  }
}

#ifndef ATTN_STORE16
#define ATTN_STORE16(p,v) (*(u32x4*)(p)=(v))
#endif
template<int THRL> __device__ __forceinline__ void attn_unit(int b,int h,int qb,const bf16*Q,const bf16*__restrict__ K,const bf16*__restrict__ V,bf16*O,char*shm,const unsigned*__restrict__ BMb,const float*KNbh,const int tid){
  const int lane=tid&63,r32=lane&31,hi=lane>>5; const int wid=__builtin_amdgcn_readfirstlane(tid>>6);
  const long rowbase=(long)b*SEQ; const int q0=qb*QB;
  const bf16*Qw=Q+(rowbase+q0+wid*QBLK)*DM+h*D;
  const bf16*Kh=K+rowbase*DM+h*D,*Vh=V+rowbase*DM+h*D;
  const unsigned lds0=(unsigned)(uintptr_t)shm;
  float*wsf=(float*)(shm+LDS_WS)+wid*64;
  const bf16*ksrc=Kh+(long)lane*DM+wid*8;
  const bf16*vsrc=Vh+(long)(16*(wid&3)+(lane>>2))*DM+(wid>>2)*32+(lane&3)*8;
  const unsigned kdst=lds0+LDS_K+wid*1024, vdst=lds0+LDS_V+wid*1024;
  #define DMA_K(t,slot) glds16(ksrc+(long)(t)*KVBLK*DM,(unsigned)__builtin_amdgcn_readfirstlane(kdst+(slot)))
  #define DMA_V(t,slot) glds16(vsrc+(long)(t)*KVBLK*DM,(unsigned)__builtin_amdgcn_readfirstlane(vdst+(slot)))
  const int vb0=(int)(lds0+LDS_V)+((lane>>4)&1)*32+(lane&3)*8+(4*hi+((lane&15)>>2))*64;
  const char*Kbase=shm+LDS_K; bf16x8 kf[8];
  const lds_cptr shm3=(lds_cptr)shm; const lds_cptr kp0=shm3+LDS_K+hi*1024+r32*16; const lds_cptr vp0=shm3+LDS_V+((lane>>4)&1)*32+(lane&3)*8+(4*hi+((lane&15)>>2))*64;
  const int NT=(q0+QB)/KVBLK;
  DMA_K(0,0);DMA_V(0,0);DMA_K(1,SLOTB);
  bf16x8 qr[4];
  #pragma unroll
  for(int d0=0;d0<4;++d0)qr[d0]=*reinterpret_cast<const bf16x8*>(&Qw[(long)r32*DM+d0*16+hi*8]);
  const unsigned*bmp=BMb+(q0+wid*QBLK+r32);
  unsigned mwE0=bmp[0],mwE1=bmp[(size_t)SEQ],mwO0=0u,mwO1=0u;
  bool seen=false;
  float qn; { float qs=0.f;
    _Pragma("unroll") for(int d0=0;d0<4;++d0) _Pragma("unroll") for(int e=0;e<8;++e){ const float x=__uint_as_float(((unsigned)(unsigned short)qr[d0][e])<<16); qs+=x*x; }
    auto rr=__builtin_amdgcn_permlane32_swap(__float_as_uint(qs),__float_as_uint(qs),false,false); qn=__builtin_sqrtf(__uint_as_float(rr[0])+__uint_as_float(rr[1]))*1.01f; }
  constexpr float FASTB=60.f;
  int zlane=0; asm volatile("":"+v"(zlane));
  const float*knp=KNbh+zlane;
  float knE=knp[0],knO=0.f;
  bool anysel_=false;
  #define SLOWT(PS) (__any(!(qn*kn##PS<=FASTB)||mhat!=0.f))
  float mhat=0.f,l_reg=0.f;f32x16 o[2];o[0]=f32x16{};o[1]=f32x16{};const f32x16 zero16=f32x16{};
  const int qrel=wid*QBLK+r32;
  #define CMASK(P0,P1,SLOW,PS) do{ const unsigned m0_=mw##PS##0>>(4*hi), m1_=mw##PS##1>>(4*hi); anysel_=(mw##PS##0|mw##PS##1)!=0u; \
    if(SLOW){ _Pragma("unroll") for(int r=0;r<16;++r){ P0[r]-=mhat; P1[r]-=mhat; } } \
    _Pragma("unroll") for(int r=0;r<16;++r){ const int bit_=(r&3)+8*(r>>2); \
      const unsigned e0_=(unsigned)__builtin_amdgcn_sbfe((int)m0_,bit_,1), e1_=(unsigned)__builtin_amdgcn_sbfe((int)m1_,bit_,1); \
      P0[r]=__uint_as_float((__float_as_uint(P0[r])&e0_)|(0xff800000u&~e0_)); P1[r]=__uint_as_float((__float_as_uint(P1[r])&e1_)|(0xff800000u&~e1_)); } \
    }while(0)
  bool resc=false;
  #define START(P0,P1,SLOW) do{ resc=false; seen=anysel_; \
    if(SLOW){ const float rm=rowmax(P0,P1); const float dl=(rm==-INFINITY)?0.f:rm; mhat=fadd_s(mhat,dl); \
      _Pragma("unroll") for(int r=0;r<16;++r){P0[r]=fsub_s(P0[r],dl);P1[r]=fsub_s(P1[r],dl);} \
      } \
    _Pragma("unroll") for(int r=0;r<16;++r)P0[r]=__builtin_amdgcn_exp2f(P0[r]); }while(0)
  #define RESC() do{ if(resc){ asm volatile("s_waitcnt lgkmcnt(0)":::"memory"); \
      _Pragma("unroll") for(int d_=0;d_<2;++d_) _Pragma("unroll") for(int r=0;r<16;++r)o[d_][r]*=wsf[crow(r,hi)]; } }while(0)
  f32x16 pA0,pA1,pB0,pB1;
  int sl_prev=0,sl_cur=0,sl_next=SLOTB;
  #define ROT() do{sl_prev=sl_cur;sl_cur=sl_next;sl_next=(sl_next==(NSLOT-1)*SLOTB)?0:sl_next+SLOTB;}while(0)
  DMA_K(2,2*SLOTB);
  WAIT_BAR(3);
  { mwO0=bmp[(size_t)2*SEQ]; mwO1=bmp[(size_t)3*SEQ]; knO=knp[1];
  const bool slow0_=SLOWT(E);
  qkt(pA0,pA1,Kbase,qr,zero16,r32,hi);asm volatile("s_nop 15\n\ts_nop 7":"+v"(pA0),"+v"(pA1));CMASK(pA0,pA1,slow0_,E);
  START(pA0,pA1,slow0_); }
  _Pragma("unroll") for(int r=0;r<16;++r)pA1[r]=__builtin_amdgcn_exp2f(pA1[r]);
  WAIT_BAR(0);
  DMA_K(3,0);DMA_V(1,SLOTB);
  ROT();
  kload8(kf,kp0+sl_cur);
  WAIT_BAR(2);
  s16x4 vlo[8],vhi[8]; u32x4 pw0,pw1,pw2,pw3;
  #define PKW(P,B) cvtpk_s(P[B],P[B+1])
  #define PAF(k) __builtin_bit_cast(bf16x8,pw##k)
  #define VFR(i) (bf16x8){vlo[i][0],vlo[i][1],vlo[i][2],vlo[i][3],vhi[i][0],vhi[i][1],vhi[i][2],vhi[i][3]}
  #define PIN(x) asm volatile("":"+v"(x))
  #define MX3(a,b,c) __builtin_fmaxf(__builtin_fmaxf((a),(b)),(c))
  #define GAPA(MF,A0,A1,A2,A3,W0,W1,PW) do{ MF; sacc+=A0; sacc+=A1; sacc+=A2; sacc+=A3; PIN(sacc); W0; W1; PIN(PW); SBAR(); }while(0)
  #define EX(v) __builtin_amdgcn_exp2f(v)
  #define GAPB(MF,X,B) do{ MF; X[B]=EX(X[B]); X[B+1]=EX(X[B+1]); X[B+2]=EX(X[B+2]); X[B+3]=EX(X[B+3]); PIN(X); SBAR(); }while(0)
  #define VRD(i) do{ vlo[i]=vtr(vp_+(((i)>>2)*4096+((i)&3)*1024)); vhi[i]=vtr(vp_+(((i)>>2)*4096+((i)&3)*1024+512)); }while(0)
  #define KRD(G,j) do{ if(G){ kload2(kf,kp0+sl_next,j); SBAR(); } }while(0)
  #define STEP(C0,C1,P0,P1,t,GK,GV,GL,PS,NS) do{ SBAR(); \
    if((t)+1<NT){ mw##NS##0=bmp[(size_t)(2*(t)+2)*SEQ]; mw##NS##1=bmp[(size_t)(2*(t)+3)*SEQ]; kn##NS=knp[(t)+1]; }     \
    const lds_cptr vp_=vp0+sl_prev; \
    VRD(0); SBAR(); float sacc=(P0[0]+P0[1]); \
    GAPA(C0=__builtin_amdgcn_mfma_f32_32x32x16_bf16(kf[0],qr[0],zero16,0,0,0), P0[2],P0[3],P0[4],P0[5],     pw0[0]=PKW(P0,0), pw0[1]=PKW(P0,2), pw0); \
    VRD(4); SBAR(); GAPA(C1=__builtin_amdgcn_mfma_f32_32x32x16_bf16(kf[1],qr[0],zero16,0,0,0), P0[6],P0[7],P0[8],P0[9],     pw0[2]=PKW(P0,4), pw0[3]=PKW(P0,6), pw0); \
    VRD(1); SBAR(); GAPA(C0=__builtin_amdgcn_mfma_f32_32x32x16_bf16(kf[2],qr[1],C0,0,0,0),   P0[10],P0[11],P0[12],P0[13], pw1[0]=PKW(P0,8), pw1[1]=PKW(P0,10), pw1); \
    VRD(5); SBAR(); GAPA(C1=__builtin_amdgcn_mfma_f32_32x32x16_bf16(kf[3],qr[1],C1,0,0,0),   P0[14],P0[15],P1[0],P1[1],   pw1[2]=PKW(P0,12),pw1[3]=PKW(P0,14), pw1); \
    VRD(2); SBAR(); GAPA(C0=__builtin_amdgcn_mfma_f32_32x32x16_bf16(kf[4],qr[2],C0,0,0,0),   P1[2],P1[3],P1[4],P1[5],     pw2[0]=PKW(P1,0), pw2[1]=PKW(P1,2), pw2); \
    VRD(6); SBAR(); GAPA(C1=__builtin_amdgcn_mfma_f32_32x32x16_bf16(kf[5],qr[2],C1,0,0,0),   P1[6],P1[7],P1[8],P1[9],     pw2[2]=PKW(P1,4), pw2[3]=PKW(P1,6), pw2); \
    VRD(3); SBAR(); GAPA(C0=__builtin_amdgcn_mfma_f32_32x32x16_bf16(kf[6],qr[3],C0,0,0,0),   P1[10],P1[11],P1[12],P1[13], pw3[0]=PKW(P1,8), pw3[1]=PKW(P1,10), pw3); \
    VRD(7); SBAR(); GAPA(C1=__builtin_amdgcn_mfma_f32_32x32x16_bf16(kf[7],qr[3],C1,0,0,0),   P1[14],P1[15],0.f,0.f,       pw3[2]=PKW(P1,12),pw3[3]=PKW(P1,14), pw3); \
    l_reg+=sacc; \
    if(GK){DMA_K((t)+3,sl_cur);} if(GV){DMA_V((t)+1,sl_next);} \
    const bool slow_=SLOWT(PS); CMASK(C0,C1,slow_,PS); resc=false; \
    if(__builtin_expect(slow_,0)){ float a=MX3(C0[0],C0[1],C1[0]),b=MX3(C0[2],C0[3],C1[1]); a=MX3(a,C1[2],C1[3]); \
      _Pragma("unroll") for(int r=4;r<16;r+=4){a=MX3(a,C0[r],C0[r+1]);b=MX3(b,C0[r+2],C0[r+3]);a=MX3(a,C1[r],C1[r+1]);b=MX3(b,C1[r+2],C1[r+3]);} \
      float rm=__builtin_fmaxf(a,b); { auto rr=__builtin_amdgcn_permlane32_swap(__float_as_uint(rm),__float_as_uint(rm),false,false); rm=__builtin_fmaxf(__uint_as_float(rr[0]),__uint_as_float(rr[1])); } \
      const bool fresh_=!seen&&rm>-INFINITY;     \
      if(__builtin_expect(__any(rm>(float)THRL||(fresh_&&rm<-(float)THRL)),0)){ const float dl=fresh_?rm:__builtin_fmaxf(rm,0.f); mhat+=dl; \
        _Pragma("unroll") for(int r=0;r<16;++r){C0[r]-=dl;C1[r]-=dl;} \
        const float f=dl>0.f?__builtin_amdgcn_exp2f(-dl):1.f; l_reg*=f; if(hi==0)wsf[r32]=f; resc=true; } } \
    seen=seen||anysel_; \
    SBAR(); \
    GAPB(o[0]=__builtin_amdgcn_mfma_f32_32x32x16_bf16(PAF(0),VFR(0),o[0],0,0,0), C0,0); \
    GAPB(o[1]=__builtin_amdgcn_mfma_f32_32x32x16_bf16(PAF(0),VFR(4),o[1],0,0,0), C0,4); \
    KRD(GL,0); GAPB(o[0]=__builtin_amdgcn_mfma_f32_32x32x16_bf16(PAF(1),VFR(1),o[0],0,0,0), C0,8); \
    KRD(GL,1); GAPB(o[1]=__builtin_amdgcn_mfma_f32_32x32x16_bf16(PAF(1),VFR(5),o[1],0,0,0), C0,12); \
    KRD(GL,2); GAPB(o[0]=__builtin_amdgcn_mfma_f32_32x32x16_bf16(PAF(2),VFR(2),o[0],0,0,0), C1,0); \
    KRD(GL,3); GAPB(o[1]=__builtin_amdgcn_mfma_f32_32x32x16_bf16(PAF(2),VFR(6),o[1],0,0,0), C1,4); \
    GAPB(o[0]=__builtin_amdgcn_mfma_f32_32x32x16_bf16(PAF(3),VFR(3),o[0],0,0,0), C1,8); \
    GAPB(o[1]=__builtin_amdgcn_mfma_f32_32x32x16_bf16(PAF(3),VFR(7),o[1],0,0,0), C1,12); \
    }while(0)
  int t=1;
  for(;t+5<NT;t+=2){
    STEP(pB0,pB1,pA0,pA1,t,true,true,true,O,E);     WAIT_BAR(2); RESC(); ROT();
    STEP(pA0,pA1,pB0,pB1,t+1,true,true,true,E,O);   WAIT_BAR(2); RESC(); ROT();
  }
  #define ENDW(tt) do{ if((tt)+3<NT){WAIT_BAR(2);} else if((tt)+2<NT){WAIT_BAR(1);} else {WAIT_BAR(0);} }while(0)
  for(;t+1<NT;t+=2){
    STEP(pB0,pB1,pA0,pA1,t,(t+3<NT),(t+1<NT),(t+1<NT),O,E);       ENDW(t);   RESC(); ROT();
    STEP(pA0,pA1,pB0,pB1,t+1,(t+4<NT),(t+2<NT),(t+2<NT),E,O);     ENDW(t+1); RESC(); ROT();
  }
  STEP(pB0,pB1,pA0,pA1,NT-1,false,false,false,O,E); RESC();
  { float sacc=pB0[0]+pB0[1]; _Pragma("unroll") for(int r=2;r<16;++r)sacc+=pB0[r]; _Pragma("unroll") for(int r=0;r<16;++r)sacc+=pB1[r]; l_reg+=sacc;
    pw0=(u32x4){PKW(pB0,0),PKW(pB0,2),PKW(pB0,4),PKW(pB0,6)};pw1=(u32x4){PKW(pB0,8),PKW(pB0,10),PKW(pB0,12),PKW(pB0,14)};pw2=(u32x4){PKW(pB1,0),PKW(pB1,2),PKW(pB1,4),PKW(pB1,6)};pw3=(u32x4){PKW(pB1,8),PKW(pB1,10),PKW(pB1,12),PKW(pB1,14)};
    SBAR(); pv(o,vb0+sl_cur,PAF(0),PAF(1),PAF(2),PAF(3)); }
  #undef PKW
  #undef PAF
  #undef VFR
  #undef PIN
  #undef MX3
  #undef GAPA
  #undef GAPB
  #undef EX
  #undef VRD
  #undef KRD
  #undef STEP
  #undef ENDW
  {auto rr=__builtin_amdgcn_permlane32_swap(__float_as_uint(l_reg),__float_as_uint(l_reg),false,false);l_reg=__uint_as_float(rr[0])+__uint_as_float(rr[1]);}
  if(hi==0)wsf[32+r32]=l_reg;asm volatile("s_waitcnt lgkmcnt(0)":::"memory");
  float rli[16];
  #pragma unroll
  for(int r=0;r<16;++r)rli[r]=__builtin_amdgcn_rcpf(wsf[32+crow(r,hi)]);
  bf16*Ow=O+(rowbase+q0+wid*QBLK)*DM+h*D;
  { bf16*stg=(bf16*)(shm+LDS_OST)+wid*2048;
    #pragma unroll
    for(int r=0;r<16;++r){const int orow=crow(r,hi);
      #pragma unroll
      for(int d0=0;d0<2;++d0)stg[orow*64+d0*32+r32]=__float2bfloat16(o[d0][r]*rli[r]);}
    asm volatile("s_waitcnt lgkmcnt(0)":::"memory");
    #pragma unroll
    for(int i=0;i<4;++i){const int row=i*8+(lane>>3),ch=lane&7; const u32x4 v=*(const u32x4*)(stg+row*64+ch*8); ATTN_STORE16(Ow+(long)row*DM+ch*8,v);} }
  asm volatile("s_waitcnt lgkmcnt(0)\n\ts_barrier":::"memory");
  #undef DMA_K
  #undef DMA_V
  #undef CMASK
  #undef SLOWT
  #undef START
  #undef RESC
  #undef ROT
}
constexpr int ATTN_LDS_BYTES=LDS_BYTES;
#undef SBAR
#undef WAIT_BAR
}
constexpr int MK_THREADS = 512;
constexpr int RING_BYTES = 131072, MISC_OFF = RING_BYTES + 320, MK_LDS_BYTES = 147456;
constexpr size_t WS_CTL = 0, CTL_ZERO_BYTES = 65536 + 7 * 131072; constexpr int CW_BAR = 4096;
constexpr int PH_PREP0 = 0, PH_L0 = 1, PH_PER_LAYER = 14, NPH = PH_L0 + 2 * PH_PER_LAYER;
enum { Q_INPROJ = 0, Q_SBIDX, Q_DSA, Q_GATES, Q_MERGE, Q_MIX, Q_NORMXA, Q_XALOG, Q_XAOUT, Q_NORMFFN, Q_UP, Q_FFNMID, Q_DOWN, Q_NEXT };

#ifndef QBUILD
#define QBUILD 0xffffu
#endif
#define QON(x) ((QBUILD >> (x)) & 1u)
struct Args { const float* in[20]; float* out; unsigned char* ws; int ph_lo, ph_hi; };

__global__ void __launch_bounds__(MK_THREADS, 2) mk_fwd(Args args) {
    __shared__ __attribute__((aligned(16))) unsigned char lds_raw[MK_LDS_BYTES];
    LAS unsigned char* lds = (LAS unsigned char*)lds_raw;
    volatile LAS unsigned* MISC = (volatile LAS unsigned*)(lds + MISC_OFF);
    const int G = gridDim.x, bx = blockIdx.x;
    unsigned char* ws0 = args.ws;
    const int wave_s = __builtin_amdgcn_readfirstlane((int)threadIdx.x >> 6);
    for (int u = mk_tid(wave_s); u < (MK_LDS_BYTES - RING_BYTES) / 4; u += MK_THREADS) ((LAS unsigned*)(lds + RING_BYTES))[u] = 0u;
    __syncthreads();
    const int lo = args.ph_lo, hi = args.ph_hi;
    XcdBarrier bar; bar.bar = (unsigned*)(ws0 + WS_CTL) + CW_BAR; bar.x = 0; bar.st = nullptr;
    if (hi - lo > 1) bar = xcd_barrier_post((unsigned*)(ws0 + WS_CTL) + CW_BAR, MISC + 8, mk_tid(wave_s));
#define BPW(off) ((bf16_t*)(ws + (off)))
    const int vcu = (G % 8 == 0) ? (bx % 8) * (G / 8) + bx / 8 : bx;
    for (int p = lo; p < hi; ++p) {
#ifdef PROBE_REP
        const int reps = (p >= PH_L0 && ((PROBE_REP >> ((p - PH_L0) % PH_PER_LAYER)) & 1)) ? 2 : 1;
#else
        const int reps = 1;
#endif
#ifdef PROBE_REP
#pragma unroll 1
        for (int rep = 0; rep < reps; ++rep) {
        const bool dry = rep + 1 < reps;
#else
        { constexpr bool dry = false;
#endif
        int oz = 0; asm volatile("" : "+s"(oz));
        int tid = mk_tid(wave_s); asm volatile("" : "+v"(tid));
        const int wave = __builtin_amdgcn_readfirstlane(tid >> 6), lane = tid & 63;
        WaveId W; W.gw = vcu * 8 + wave; W.ngw = G * 8; W.wave = wave; W.lane = lane;
        unsigned char* ws = args.ws + oz; float* X = args.out + oz;
#define INP(k) (args.in[(k) + oz])
        if (p == PH_PREP0) {
            prep0_phase(W, (LAS float*)(lds + wave * 16384), ws, args.in + oz, (bf16_t*)X);
        } else if (p >= PH_L0) {
            const int l = (p - PH_L0) / PH_PER_LAYER, q = (p - PH_L0) % PH_PER_LAYER;
            const float* Xin = l == 0 ? INP(0) : X;
            pg8::u64* SSb = (pg8::u64*)(ws + WS_SS);
#define SSA(i) (SSb + (size_t)(i) * T)
            if (q == Q_SBIDX) {
#ifndef NO_SB
                sb_phase(W, lds, ws, dry);
#endif
                __syncthreads();
#ifndef NO_IDX
#ifdef PROBE_SB_ONLY
                if (!dry)
#endif
                idx_phase(lds, ws, vcu, G, wave, lane);
#endif
                conv_sc_phase(vcu * MK_THREADS + tid, G * MK_THREADS, BPW(WS_SCB), BPW(WS_CX), INP(4) + l * 3 * 512, dry);
                kn_phase(W, BPW(WS_KC), (float*)(ws + WS_KN));
                if (l == 0 && !dry && QON(15)) {
                    __syncthreads();
                    { pg8::Order S; S.init(1, 4, 16, G, bx); pg8::PtrG P{(const char*)(ws + WS_KVM), (const char*)(ws + WS_WQ)}; pg8::EpiPrep E{ws, 1};
                      pg8::gemm_phase<pg8::EpiPrep, pg8::PtrG, true, true>(lds, tid, 2 * D, D, 256, S, P, E); }
                    { pg8::Order S; S.init(4, 1, 16, G, (bx + 64) % G); pg8::PtrH P{(const char*)(ws + WS_KVM), (const char*)(ws + WS_WOT)}; pg8::EpiPrep E{ws, 2};
                      pg8::gemm_phase<pg8::EpiPrep, pg8::PtrH, true, true>(lds, tid, D, 2 * D, 256, S, P, E); }
                }
            } else if (q == Q_DSA) {
#ifndef NO_DSA
                {
                    for (int pr = vcu; pr < NB * 8 * 16; pr += G) { const int bh = pr >> 4, sx = pr & 15, bb = bh >> 3, hh = bh & 7;
#pragma unroll 1
                        for (int k2 = 0; k2 < 2; ++k2)
                            attn_body::attn_unit<8>(bb, hh, k2 == 0 ? sx : 31 - sx, (const attn_body::bf16*)BPW(WS_QC), (const attn_body::bf16*)BPW(WS_KC), (const attn_body::bf16*)BPW(WS_VC),
                                                    (attn_body::bf16*)(dry ? BPW(WS_KA) : BPW(WS_QC)), (char*)lds_raw, (const unsigned*)(ws + WS_BM) + (size_t)bb * 256 * S,
                                                    (const float*)(ws + WS_KN) + bh * (S / 64), tid); }
                }
#endif
            } else if (q == Q_FFNMID) {
                ffn_mid_phase(vcu * MK_THREADS + tid, G * MK_THREADS, BPW(WS_FA), BPW(WS_FU), INP(16) + l * 3 * DFF, INP(17) + l * DFF, dry);
            } else if (q == Q_NEXT) {
                if (l + 1 < DEPTH) { int base = 0; convert_layer_weights(W, (LAS float*)(lds + wave * 16384), base, ws, args.in + oz, l + 1); }
                else if (!dry) final_norm(W, BPW(WS_XN), X, INP(19), SSA(6));
            } else if (q == Q_INPROJ && QON(Q_INPROJ)) {
                pg8::Order S; S.init(T / 256, NIN / 256, 1, G, bx);
                pg8::PtrStd P{(const char*)X, (const char*)(ws + WS_WIN), 0, 0, 0, (size_t)256 * D * 2, (size_t)256 * D * 2};
                pg8::EpiInProj E{ws, SSA(3 * l)};
                pg8::gemm_phase<pg8::EpiInProj, pg8::PtrStd, true, true>(lds, tid, D, D, D, S, P, E);
                if (l == 0 && !dry && QON(14)) {
                    pg8::Order S2; S2.init(2, 8, 2, G, (bx + G - 64) % G);
                    pg8::PtrStd P2{(const char*)(ws + WS_MEMN), (const char*)(ws + WS_WKVT), 1 * MiB, 4 * MiB, 0, (size_t)256 * D * 2, (size_t)256 * D * 2};
                    pg8::EpiPrep E2{ws, 0};
                    pg8::gemm_phase<pg8::EpiPrep, pg8::PtrStd, true, true>(lds, tid, D, D, D, S2, P2, E2);
                }
            } else if (q == Q_GATES && QON(Q_GATES)) {
                pg8::Order S; S.init(T / 256, 12, 1, G, bx);
                pg8::PtrStd P{(const char*)X, (const char*)(ws + WS_WG), 0, 0, 0, (size_t)256 * D * 2, (size_t)256 * D * 2};
                pg8::EpiGates E{BPW(WS_GATES), SSA(3 * l)};
                pg8::gemm_phase<pg8::EpiGates, pg8::PtrStd, true, true>(lds, tid, D, D, D, S, P, E);
            } else if (q == Q_MERGE && QON(Q_MERGE)) {
                pg8::Order S; S.init(T / 256, 4, 3, G, bx);
                pg8::PtrStd P{(const char*)(ws + WS_QA), (const char*)(ws + WS_WBR), 16 * MiB, (size_t)D * 512 * 2, 0, (size_t)256 * 512 * 2, (size_t)256 * 512 * 2};
                pg8::EpiMerge E{BPW(WS_XN), BPW(WS_GATES)};
                pg8::gemm_phase<pg8::EpiMerge, pg8::PtrStd, true, true>(lds, tid, 512, 512, 512, S, P, E);
            } else if (q == Q_MIX && QON(Q_MIX)) {
                pg8::Order S; S.init(T / 256, 4, 1, G, bx);
                pg8::PtrStd P{(const char*)(ws + WS_XN), (const char*)(ws + WS_WMIX), 0, 0, 0, (size_t)256 * D * 2, (size_t)256 * D * 2};
                if (l == 0) { pg8::EpiResid<true> E{(const void*)INP(0), dry ? BPW(WS_FU) : BPW(WS_XBXA), dry ? SSA(0) : SSA(1)};
                    pg8::gemm_phase<pg8::EpiResid<true>, pg8::PtrStd, true, true>(lds, tid, D, D, D, S, P, E); }
                else { pg8::EpiResid<false> E{(const void*)X, dry ? BPW(WS_FU) : BPW(WS_XBXA), dry ? SSA(0) : SSA(4)};
                    pg8::gemm_phase<pg8::EpiResid<false>, pg8::PtrStd, true, true>(lds, tid, D, D, D, S, P, E); }

            } else if (q == Q_XALOG && QON(Q_XALOG)) {
                pg8::Order S; S.init(T / 256, 4, 1, G, bx);
                pg8::PtrStd P{(const char*)(ws + WS_XBXA), (const char*)(ws + WS_GT + (size_t)l * 4 * MiB), 0, 0, 2 * MiB, (size_t)256 * D * 2, (size_t)256 * D * 2};
                pg8::EpiSoftmax E{BPW(WS_PXA), SSA(1 + 3 * l)};
                pg8::gemm_phase<pg8::EpiSoftmax, pg8::PtrStd, false, true>(lds, tid, D, D, D, S, P, E);
            } else if (q == Q_XAOUT && QON(Q_XAOUT)) {
                pg8::Order S; S.init(T / 256, 4, 1, G, bx);
                pg8::PtrStd P{(const char*)(ws + WS_PXA), (const char*)(ws + WS_HT + (size_t)l * 4 * MiB), 0, 0, 2 * MiB, (size_t)256 * D * 2, (size_t)256 * D * 2};
                pg8::EpiResid<false> E{(const void*)BPW(WS_XBXA), dry ? BPW(WS_FU) : BPW(WS_XN), dry ? SSA(0) : SSA(2 + 3 * l)};
                pg8::gemm_phase<pg8::EpiResid<false>, pg8::PtrStd, true, true>(lds, tid, D, D, D, S, P, E);
            } else if (q == Q_UP && QON(Q_UP)) {
                pg8::Order S; S.init(T / 256, 22, 1, G, bx);
                pg8::PtrStd P{(const char*)(ws + WS_XN), (const char*)(ws + WS_WUP), 0, 0, 0, (size_t)256 * D * 2, (size_t)256 * D * 2};
                pg8::EpiUp E{BPW(WS_FA), BPW(WS_FU), SSA(2 + 3 * l)};
                pg8::gemm_phase<pg8::EpiUp, pg8::PtrStd, true, true>(lds, tid, D, D, D, S, P, E);
            } else if (q == Q_DOWN && QON(Q_DOWN)) {
                pg8::Order S; S.init(T / 256, 4, 1, G, bx);
                pg8::PtrStd P{(const char*)(ws + WS_FU), (const char*)(ws + WS_WDOWN), 0, 0, 0, (size_t)256 * DFF * 2, (size_t)256 * DFF * 2};
                pg8::EpiResid<false> E{(const void*)BPW(WS_XN), dry ? BPW(WS_QA) : (l + 1 < DEPTH ? (bf16_t*)X : BPW(WS_XN)), dry ? SSA(0) : SSA(3 + 3 * l)};
                pg8::gemm_phase<pg8::EpiResid<false>, pg8::PtrStd, true, true>(lds, tid, DFF, DFF, DFF, S, P, E);
            }
        }
        }
        if (p + 1 < hi && !(p >= PH_L0 && ((p - PH_L0) % PH_PER_LAYER == Q_NORMXA || (p - PH_L0) % PH_PER_LAYER == Q_NORMFFN))) xcd_barrier(bar, mk_tid(wave_s));
    }
}

extern "C" void kernel_launch(void* const* d_in, const int* in_sizes, int n_in, void* d_out, int out_size, void* d_ws, size_t ws_size, hipStream_t st) {
    if (n_in != 20 || ws_size < WS_NEED || out_size != T * D) { fprintf(stderr, "kernel_launch: unexpected sizes n_in %d ws %zu out %d\n", n_in, ws_size, out_size); return; }
    static int grid = 0;
    if (grid == 0) {
        int dev = 0, cus = 0, per_cu = 0;
        (void)hipGetDevice(&dev); (void)hipDeviceGetAttribute(&cus, hipDeviceAttributeMultiprocessorCount, dev);
        if (hipOccupancyMaxActiveBlocksPerMultiprocessor(&per_cu, (const void*)mk_fwd, MK_THREADS, 0) != hipSuccess || per_cu < 1) { fprintf(stderr, "kernel_launch: occupancy query says %d blocks/CU\n", per_cu); grid = -1; return; }
        (void)hipGetLastError();
        if (cus != 256) { fprintf(stderr, "kernel_launch: built for a 256-CU device, found %d\n", cus); grid = -1; return; }
        grid = cus;
    }
    if (grid < 0) return;
    (void)hipMemsetAsync((char*)d_ws + WS_CTL, 0, CTL_ZERO_BYTES, st);
    Args a{};
    for (int i = 0; i < 20; ++i) a.in[i] = (const float*)d_in[i];
    a.out = (float*)d_out; a.ws = (unsigned char*)d_ws; a.ph_lo = 0; a.ph_hi = NPH;
    hipLaunchKernelGGL(mk_fwd, dim3(grid), dim3(MK_THREADS), 0, st, a);
}
```

```cpp
#include <hip/hip_runtime.h>
#include <stdint.h>
#include <stdio.h>

typedef unsigned short bf16_t;
typedef short bf16x8 __attribute__((ext_vector_type(8)));
typedef float f32x16 __attribute__((ext_vector_type(16)));
typedef float f32x4 __attribute__((ext_vector_type(4)));
#define DEV __device__ __forceinline__

constexpr int NB = 2, S = 8192, D = 1024, T = NB * S, DEPTH = 2;
constexpr int DIN = 8264, DFF = 2816, MEM = 256;
constexpr int NIN = 5376;
constexpr float LOG2E = 1.4426950408889634f;
constexpr float QSCALE = 0.125f * LOG2E;
constexpr float WSCALE = 0.125f * 0.35355339059327373f;
constexpr float XSCALE = 0.0625f * LOG2E;
constexpr float EPS = 1e-6f;
#ifndef MK_FUSE
#define MK_FUSE 1
#endif

constexpr size_t MiB = 1u << 20;
constexpr size_t WS_SIDEA = 88 * MiB, WS_SIDEU = 96 * MiB;
constexpr size_t WS_KN = 983040;
constexpr size_t WS_GT = 1 * MiB;
constexpr size_t WS_HT = 9 * MiB;
constexpr size_t WS_WUP = 17 * MiB, WS_WDOWN = 28 * MiB;
constexpr size_t WS_XN = 34 * MiB;
constexpr size_t WS_WMIX = 66 * MiB, WS_WBR = 68 * MiB, WS_WG = 71 * MiB, WS_WIN = 77 * MiB;
constexpr size_t WS_QA = 88 * MiB, WS_SCB = 104 * MiB, WS_QC = 120 * MiB, WS_KA = 136 * MiB, WS_VA = 152 * MiB, WS_KC = 168 * MiB, WS_VC = 184 * MiB,
                 WS_IQ = 200 * MiB, WS_CX = 216 * MiB, WS_IK = 232 * MiB, WS_IW = 234 * MiB, WS_BM = 235 * MiB;
constexpr size_t WS_GATES = 136 * MiB;
constexpr size_t WS_XTMP = 235 * MiB;
constexpr size_t WS_LOG = 88 * MiB, WS_PXA = 168 * MiB;
constexpr size_t WS_XBXA = 136 * MiB;
constexpr size_t WS_SS = 65536;
constexpr size_t WS_FA = 66 * MiB, WS_FU = 154 * MiB;
constexpr size_t WS_WQ = 34 * MiB  , WS_WOT = 38 * MiB  , WS_WKVT = 42 * MiB  , WS_MEMN = 50 * MiB  , WS_KVM = 52 * MiB  ;
constexpr size_t WS_NEED = 256 * MiB;

DEV bf16_t f2bf(float f) { unsigned u = __float_as_uint(f); u += 0x7fffu + ((u >> 16) & 1u); return (bf16_t)(u >> 16); }
DEV float bf2f(bf16_t h) { return __uint_as_float(((unsigned)h) << 16); }
DEV float wave_sum(float v) {
#pragma unroll
    for (int o = 1; o < 64; o <<= 1) v += __shfl_xor(v, o);
    return v;
}
DEV float wave_max(float v) {
#pragma unroll
    for (int o = 1; o < 64; o <<= 1) v = fmaxf(v, __shfl_xor(v, o));
    return v;
}


#define LAS __attribute__((address_space(3)))
#define GAS __attribute__((address_space(1)))
typedef unsigned u32x4 __attribute__((ext_vector_type(4)));
typedef unsigned u32x2 __attribute__((ext_vector_type(2)));
typedef float f32x2 __attribute__((ext_vector_type(2)));
#define LDS_WAIT() asm volatile("s_waitcnt lgkmcnt(0)" ::: "memory")
DEV int mk_tid(int wave_s) { unsigned ones = ~0u; asm volatile("" : "+s"(ones)); return wave_s * 64 + (int)__builtin_amdgcn_mbcnt_hi(ones, __builtin_amdgcn_mbcnt_lo(ones, 0u)); }
#define VM_WAIT() asm volatile("s_waitcnt vmcnt(0)" ::: "memory")
typedef __bf16 bf16x2_t __attribute__((ext_vector_type(2)));
DEV unsigned cvt_pk_bf16(float lo, float hi) { const f32x2 v = {lo, hi}; return __builtin_bit_cast(unsigned, __builtin_convertvector(v, bf16x2_t)); }
DEV float bflo(unsigned w) { return __uint_as_float(w << 16); }
DEV float bfhi(unsigned w) { return __uint_as_float(w & 0xffff0000u); }

namespace pg8 {
constexpr int BM = 256, BK = 64, HALF = 128, HTB = HALF * BK * 2, STAGE_BYTES = 8 * HTB, NXCD = 8, WGM = 8;
__host__ __device__ __forceinline__ int lds_byte(int r, int c) { const int st = (r >> 4) * 2 + (c >> 5), rr = r & 15, cc = c & 31, ob = rr * 64 + cc * 2; return st * 1024 + (ob ^ (((ob >> 9) & 1) << 5)); }
__host__ __device__ __forceinline__ void stage_rc(int b, int& R, int& C) { const int st = b / 1024, sb = b % 1024, swz = sb ^ (((sb >> 9) & 1) << 5); R = (st >> 1) * 16 + swz / 64; C = (st & 1) * 32 + (swz % 64) / 2; }
__host__ __device__ __forceinline__ int perm32(int rho) { const int n = rho >> 4, i = rho & 15; return 8 * (i >> 2) + 4 * n + (i & 3); }

struct Unit { int pm, pn, job; };
struct Order {
    int nM, nN, nwg, ntot, G, c;
    DEV void init(int nM_, int nN_, int njob, int G_, int c_) { nM = nM_; nN = nN_; nwg = nM * nN; ntot = nwg * njob; G = G_; c = c_; }
    DEV bool next(int i, Unit& u) const {
        const int L = i * G + c; if (L >= ntot) return false;
        u.job = L / nwg; int wgid = L - u.job * nwg;
        { const int q = nwg / NXCD, r = nwg % NXCD, xcd = wgid % NXCD, off = wgid / NXCD; wgid = (xcd < r ? xcd * (q + 1) : r * (q + 1) + (xcd - r) * q) + off; }
        const int nig = WGM * nN, gid = wgid / nig, fm = gid * WGM, gsz = (nM - fm) < WGM ? (nM - fm) : WGM;
        u.pm = fm + ((wgid % nig) % gsz); u.pn = (wgid % nig) / gsz; return true;
    }
};
template <class Epi, class Ptr, bool ALIGN_EPI, bool SP2>
DEV void gemm_phase(LAS unsigned char* lds, const int tid_in, const int lda, const int ldb, const int K, const Order& S, const Ptr& P, const Epi& E) {
    int tid_ = tid_in; asm volatile("" : "+v"(tid_));
    const int tid = tid_, wid = __builtin_amdgcn_readfirstlane(tid >> 6), lane = tid & 63, wr = wid >> 2, wc = wid & 3, fr = lane & 15, fq = lane >> 4;
    const int nt = K / BK;
    unsigned voffA[2], voffB[2];
#pragma unroll
    for (int i = 0; i < 2; ++i) { int R, C; stage_rc(tid * 16 + i * 8192, R, C); const int Rb = Epi::PERM ? ((R & ~31) + perm32(R & 31)) : R;
        voffA[i] = (unsigned)(R * lda + C) * 2u; voffB[i] = (unsigned)(Rb * ldb + C) * 2u; }
    const size_t kstep = (size_t)(BK * 2);
    const size_t hstepA = (size_t)HALF * lda * 2, hstepB = (size_t)HALF * ldb * 2;
    const unsigned ldsw = (unsigned)wid * 1024u;
    const int aoff = lds_byte(wr * 64 + fr, fq * 8), boff = lds_byte(wc * 32 + fr, fq * 8);
#define PG8_SA(b, h) (((b) * 2 + (h)) * HTB)
#define PG8_SB(b, h) ((4 + (b) * 2 + (h)) * HTB)
#define PG8_STAGE(bufoff, gbase, voff) do { _Pragma("unroll") for (int _i = 0; _i < 2; ++_i) \
        __builtin_amdgcn_global_load_lds((const unsigned*)((const char*)(gbase) + (voff)[_i]), (LAS unsigned*)(lds + (bufoff) + ldsw + _i * 8192), 16, 0, 0); } while (0)
#define PG8_LDA(dst, b, h) do { _Pragma("unroll") for (int m = 0; m < 4; ++m) _Pragma("unroll") for (int k = 0; k < 2; ++k) dst[m][k] = *(const LAS bf16x8*)(lds + PG8_SA(b, h) + aoff + m * 2048 + k * 1024); } while (0)
#define PG8_LDB(dst, b, h) do { _Pragma("unroll") for (int n = 0; n < 2; ++n) _Pragma("unroll") for (int k = 0; k < 2; ++k) dst[n][k] = *(const LAS bf16x8*)(lds + PG8_SB(b, h) + boff + n * 2048 + k * 1024); } while (0)
#define PG8_MMA(ai, bj, At, Bt) do { __builtin_amdgcn_s_setprio(1); _Pragma("unroll") for (int m = 0; m < 4; ++m) _Pragma("unroll") for (int n = 0; n < 2; ++n) _Pragma("unroll") for (int k = 0; k < 2; ++k) \
        acc[ai][bj][m][n] = __builtin_amdgcn_mfma_f32_16x16x32_bf16(Bt[n][k], At[m][k], acc[ai][bj][m][n], 0, 0, 0); __builtin_amdgcn_s_setprio(0); } while (0)
#define PG8_WAIT_V(n) asm volatile("s_waitcnt vmcnt(" #n ")" ::: "memory")
#define PG8_WAIT_L(n) asm volatile("s_waitcnt lgkmcnt(" #n ")" ::: "memory")
#define PG8_BAR __builtin_amdgcn_s_barrier()
#define PG8_SCHED __builtin_amdgcn_sched_barrier(0)
    Unit cur, nxt; int ui = 0;
    if (!S.next(0, cur)) return;
    f32x4 acc[2][2][4][2];
#pragma unroll
    for (int a = 0; a < 2; ++a)
#pragma unroll
        for (int b = 0; b < 2; ++b)
#pragma unroll
            for (int m = 0; m < 4; ++m)
#pragma unroll
                for (int n = 0; n < 2; ++n) acc[a][b][m][n] = (f32x4){0.f, 0.f, 0.f, 0.f};
    bf16x8 At[4][2], B0[2][2], B1[2][2];
    const char* cA = P.a(cur); const char* cB = P.b(cur);
    typename Epi::Pre pre; E.prefetch(pre, cur, wr, fr);
    if constexpr (SP2) {
        PG8_STAGE(PG8_SB(0, 0), cB, voffB); PG8_STAGE(PG8_SB(0, 1), cB + hstepB, voffB); PG8_STAGE(PG8_SA(0, 0), cA, voffA); PG8_STAGE(PG8_SA(0, 1), cA + hstepA, voffA);
        if (wr == 1) PG8_BAR;
        PG8_WAIT_V(2); PG8_BAR;
        PG8_STAGE(PG8_SB(1, 0), cB + kstep, voffB); PG8_STAGE(PG8_SA(1, 0), cA + kstep, voffA); PG8_STAGE(PG8_SB(1, 1), cB + hstepB + kstep, voffB);
        PG8_WAIT_V(6); PG8_BAR;
    } else {
        PG8_STAGE(PG8_SB(0, 0), cB, voffB); PG8_STAGE(PG8_SA(0, 0), cA, voffA); PG8_STAGE(PG8_SB(0, 1), cB + hstepB, voffB); PG8_STAGE(PG8_SA(0, 1), cA + hstepA, voffA);
        if (wr == 1) PG8_BAR;
        PG8_WAIT_V(4); PG8_BAR;
        PG8_STAGE(PG8_SB(1, 0), cB + kstep, voffB); PG8_STAGE(PG8_SA(1, 0), cA + kstep, voffA); PG8_STAGE(PG8_SB(1, 1), cB + hstepB + kstep, voffB);
        PG8_WAIT_V(6); PG8_BAR;
    }
#pragma unroll 1
    for (;;) {
        const bool has_next = S.next(ui + 1, nxt);
        const char* nA = has_next ? P.a(nxt) : cA; const char* nB = has_next ? P.b(nxt) : cB;
#pragma unroll 1
        for (int t = 0; t < nt; t += 2) {
            const bool last = (t == nt - 2);
            const char* a1 = cA + (size_t)(t + 1) * kstep;
            const char* a2 = last ? nA : cA + (size_t)(t + 2) * kstep; const char* b2 = last ? nB : cB + (size_t)(t + 2) * kstep;
            const char* a3 = a2 + kstep; const char* b3 = b2 + kstep;
            if constexpr (SP2) {
            PG8_LDB(B0, 0, 0); PG8_LDB(B1, 0, 1); PG8_SCHED; PG8_LDA(At, 0, 0); PG8_STAGE(PG8_SA(1, 1), a1 + hstepA, voffA);
            PG8_WAIT_V(8); PG8_WAIT_L(0); PG8_BAR; PG8_MMA(0, 0, At, B0); PG8_MMA(0, 1, At, B1); PG8_BAR; PG8_SCHED;
            PG8_LDA(At, 0, 1); PG8_STAGE(PG8_SB(0, 0), b2, voffB); PG8_STAGE(PG8_SB(0, 1), b2 + hstepB, voffB); PG8_STAGE(PG8_SA(0, 0), a2, voffA);
            PG8_WAIT_V(8); PG8_WAIT_L(0); PG8_BAR; PG8_MMA(1, 0, At, B0); PG8_MMA(1, 1, At, B1); PG8_BAR; PG8_SCHED;
            PG8_LDB(B0, 1, 0); PG8_LDB(B1, 1, 1); PG8_SCHED; PG8_LDA(At, 1, 0); PG8_STAGE(PG8_SA(0, 1), a2 + hstepA, voffA);
            PG8_WAIT_V(8); PG8_WAIT_L(0); PG8_BAR; PG8_MMA(0, 0, At, B0); PG8_MMA(0, 1, At, B1); PG8_BAR; PG8_SCHED;
            PG8_LDA(At, 1, 1); PG8_STAGE(PG8_SB(1, 0), b3, voffB); PG8_STAGE(PG8_SB(1, 1), b3 + hstepB, voffB); PG8_STAGE(PG8_SA(1, 0), a3, voffA);
            PG8_WAIT_V(8); PG8_WAIT_L(0); PG8_BAR; PG8_MMA(1, 0, At, B0); PG8_MMA(1, 1, At, B1); PG8_BAR; PG8_SCHED;
            } else {
            PG8_LDB(B0, 0, 0); PG8_SCHED; PG8_LDA(At, 0, 0); PG8_STAGE(PG8_SA(1, 1), a1 + hstepA, voffA);
            PG8_WAIT_L(8); PG8_BAR; PG8_WAIT_L(0); PG8_MMA(0, 0, At, B0); PG8_BAR; PG8_SCHED;
            PG8_LDB(B1, 0, 1); PG8_STAGE(PG8_SB(0, 0), b2, voffB);
            PG8_BAR; PG8_WAIT_L(0); PG8_MMA(0, 1, At, B1); PG8_BAR;
            PG8_LDA(At, 0, 1); PG8_STAGE(PG8_SA(0, 0), a2, voffA);
            PG8_BAR; PG8_WAIT_L(0); PG8_MMA(1, 0, At, B0); PG8_BAR; PG8_SCHED;
            PG8_STAGE(PG8_SB(0, 1), b2 + hstepB, voffB);
            PG8_WAIT_V(6); PG8_BAR; PG8_MMA(1, 1, At, B1); PG8_BAR;
            PG8_LDB(B0, 1, 0); PG8_SCHED; PG8_LDA(At, 1, 0); PG8_STAGE(PG8_SA(0, 1), a2 + hstepA, voffA);
            PG8_WAIT_L(8); PG8_BAR; PG8_WAIT_L(0); PG8_MMA(0, 0, At, B0); PG8_BAR; PG8_SCHED;
            PG8_LDB(B1, 1, 1); PG8_STAGE(PG8_SB(1, 0), b3, voffB);
            PG8_BAR; PG8_WAIT_L(0); PG8_MMA(0, 1, At, B1); PG8_BAR;
            PG8_LDA(At, 1, 1); PG8_STAGE(PG8_SA(1, 0), a3, voffA);
            PG8_BAR; PG8_WAIT_L(0); PG8_MMA(1, 0, At, B0); PG8_BAR; PG8_SCHED;
            PG8_STAGE(PG8_SB(1, 1), b3 + hstepB, voffB);
            PG8_WAIT_V(6); PG8_BAR; PG8_MMA(1, 1, At, B1); PG8_BAR;
            }
        }
        if constexpr (ALIGN_EPI) { if (wr == 0) PG8_BAR; }
        if constexpr (!Epi::AFTER_DRAIN) { int fr_ = fr, fq_ = fq; asm volatile("" : "+v"(fr_), "+v"(fq_));
            E(acc, cur, wr, wc, fr_, fq_, pre); }
        if (!has_next) break;
#pragma unroll
        for (int a = 0; a < 2; ++a)
#pragma unroll
            for (int b = 0; b < 2; ++b)
#pragma unroll
                for (int m = 0; m < 4; ++m)
#pragma unroll
                    for (int n = 0; n < 2; ++n) acc[a][b][m][n] = (f32x4){0.f, 0.f, 0.f, 0.f};
        cur = nxt; cA = nA; cB = nB; ++ui; E.prefetch(pre, cur, wr, fr);
        if constexpr (ALIGN_EPI) { if (wr == 1) PG8_BAR; }
    }
    PG8_WAIT_V(0);
    if constexpr (!ALIGN_EPI) { if (wr == 0) PG8_BAR; }
    PG8_BAR;
    if constexpr (Epi::AFTER_DRAIN) { E.fused(acc, cur, wr, wc, fr, fq, lds, wid, lane, pre); }
#undef PG8_SA
#undef PG8_SB
#undef PG8_STAGE
#undef PG8_LDA
#undef PG8_LDB
#undef PG8_MMA
#undef PG8_WAIT_V
#undef PG8_WAIT_L
#undef PG8_BAR
#undef PG8_SCHED
}
typedef f32x4 Acc[2][2][4][2];

struct PtrStd {
    const char* A; const char* B; size_t aj, bj, bb, arow, brow;
    DEV const char* a(const Unit& u) const { return A + (size_t)u.job * aj + (size_t)u.pm * arow; }
    DEV const char* b(const Unit& u) const { return B + (size_t)u.job * bj + (size_t)(u.pm >> 5) * bb + (size_t)u.pn * brow; }
};
struct PtrG {
    const char* KVM; const char* WQ;
    DEV const char* a(const Unit& u) const { return KVM + (size_t)(u.job >> 2) * MiB + (size_t)(u.job & 3) * 512; }
    DEV const char* b(const Unit& u) const { return WQ + (size_t)(u.job >> 3) * 2 * MiB + (size_t)(u.job & 3) * 512 + (size_t)u.pn * 256 * 1024 * 2; }
};
struct PtrH {
    const char* KVM; const char* WOT;
    DEV const char* a(const Unit& u) const { return WOT + (size_t)(u.job >> 3) * 2 * MiB + (size_t)(u.job & 3) * 512 + (size_t)u.pm * 256 * 1024 * 2; }
    DEV const char* b(const Unit& u) const { return KVM + (size_t)(u.job >> 2) * MiB + 2048 + (size_t)(u.job & 3) * 512; }
};

#define EPI_ROWS(u) const int row0 = (u).pm * BM + wr * 64 + fr
DEV u32x4 pack8(const f32x4 v0, const f32x4 v1) { u32x4 w; w.x = cvt_pk_bf16(v0[0], v0[1]); w.y = cvt_pk_bf16(v0[2], v0[3]); w.z = cvt_pk_bf16(v1[0], v1[1]); w.w = cvt_pk_bf16(v1[2], v1[3]); return w; }

struct PreNone {};
typedef unsigned long long u64;
constexpr float SS_SCALE = 65536.f;
struct PreRs { u64 v[2][4]; };
DEV void pre_rs(PreRs& p, const u64* ss, int row0) {
#pragma unroll
    for (int ai = 0; ai < 2; ++ai)
#pragma unroll
        for (int m = 0; m < 4; ++m) p.v[ai][m] = __builtin_nontemporal_load(ss + row0 + ai * HALF + m * 16);
}
DEV void rs_of(float (&rs)[2][4], const PreRs& p) {
#pragma unroll
    for (int ai = 0; ai < 2; ++ai)
#pragma unroll
        for (int m = 0; m < 4; ++m) rs[ai][m] = rsqrtf((float)p.v[ai][m] * (1.f / (SS_SCALE * D)) + EPS);
}
struct EpiInProj {
    typedef PreRs Pre;
    DEV void prefetch(PreRs& p, const Unit& u, int wr, int fr) const { pre_rs(p, ss, u.pm * BM + wr * 64 + fr); }
    static constexpr bool PERM = true, AFTER_DRAIN = false;
    unsigned char* ws; const u64* ss;
    DEV void operator()(const Acc& acc, const Unit& u, int wr, int wc, int fr, int fq, const PreRs& pre) const {
        EPI_ROWS(u); const int pn = u.pn, cb = wc * 32 + 8 * fq;
        float rs[2][4]; rs_of(rs, pre);
        if (pn < 16) {
            const int g = pn >> 1;
            const size_t off = g == 0 ? WS_QA : g == 1 ? WS_KA : g == 2 ? WS_VA : g == 3 ? WS_QC : g == 4 ? WS_KC : g == 5 ? WS_VC : g == 6 ? WS_IQ : WS_SCB;
            const float sc = (g == 0 || g == 3) ? QSCALE : 1.f;
            bf16_t* base = (bf16_t*)(ws + off) + (pn & 1) * 256 + cb;
#pragma unroll
            for (int ai = 0; ai < 2; ++ai)
#pragma unroll
                for (int m = 0; m < 4; ++m) { bf16_t* rowp = base + (size_t)(row0 + ai * HALF + m * 16) * 512;
#pragma unroll
                    for (int bj = 0; bj < 2; ++bj) *(u32x4*)(rowp + bj * HALF) = pack8(acc[ai][bj][m][0] * (sc * rs[ai][m]), acc[ai][bj][m][1] * (sc * rs[ai][m])); }
        } else if (pn < 20) {
            bf16_t* base = (bf16_t*)(ws + WS_CX) + (pn - 16) * 128 + cb;
#pragma unroll
            for (int ai = 0; ai < 2; ++ai)
#pragma unroll
                for (int m = 0; m < 4; ++m) { const float r2 = rs[ai][m] * rs[ai][m]; *(u32x4*)(base + (size_t)(row0 + ai * HALF + m * 16) * 512) = pack8(acc[ai][0][m][0] * acc[ai][1][m][0] * r2, acc[ai][0][m][1] * acc[ai][1][m][1] * r2); }
        } else {
            if (wc < 2) { bf16_t* base = (bf16_t*)(ws + WS_IK);
#pragma unroll
                for (int ai = 0; ai < 2; ++ai)
#pragma unroll
                    for (int m = 0; m < 4; ++m) { const int t = row0 + ai * HALF + m * 16;
                        *(u32x4*)(base + (size_t)(t >> 5) * 2048 + (((cb >> 3) * 32 + (t & 31)) * 8)) = pack8(acc[ai][0][m][0] * rs[ai][m], acc[ai][0][m][1] * rs[ai][m]); }
            } else if (wc == 2 && fq == 0) { float* base = (float*)(ws + WS_IW);
#pragma unroll
                for (int ai = 0; ai < 2; ++ai)
#pragma unroll
                    for (int m = 0; m < 4; ++m) { float* p = base + (size_t)(row0 + ai * HALF + m * 16) * 8; *(f32x4*)p = acc[ai][0][m][0] * (WSCALE * rs[ai][m]); *(f32x4*)(p + 4) = acc[ai][0][m][1] * (WSCALE * rs[ai][m]); }
            }
        }
    }
};
DEV f32x4 sigm4(const f32x4 v) { f32x4 o;
#pragma unroll
    for (int i = 0; i < 4; ++i) o[i] = __builtin_amdgcn_rcpf(1.f + __builtin_amdgcn_exp2f(-LOG2E * v[i])); return o; }
struct EpiGates {
    typedef PreRs Pre;
    DEV void prefetch(PreRs& p, const Unit& u, int wr, int fr) const { pre_rs(p, ss, u.pm * BM + wr * 64 + fr); }
    static constexpr bool PERM = true, AFTER_DRAIN = false;
    bf16_t* G; const u64* ss;
    DEV void operator()(const Acc& acc, const Unit& u, int wr, int wc, int fr, int fq, const PreRs& pre) const {
        EPI_ROWS(u); float rs[2][4]; rs_of(rs, pre); bf16_t* base = G + (size_t)(u.pn >> 2) * T * D + (u.pn & 3) * 256 + wc * 32 + 8 * fq;
#pragma unroll
        for (int ai = 0; ai < 2; ++ai)
#pragma unroll
            for (int m = 0; m < 4; ++m) { bf16_t* rowp = base + (size_t)(row0 + ai * HALF + m * 16) * D;
#pragma unroll
                for (int bj = 0; bj < 2; ++bj) *(u32x4*)(rowp + bj * HALF) = pack8(sigm4(acc[ai][bj][m][0] * rs[ai][m]), sigm4(acc[ai][bj][m][1] * rs[ai][m])); }
    }
};
struct EpiMerge {
    typedef PreNone Pre;
    DEV void prefetch(PreNone&, const Unit&, int, int) const {}
    static constexpr bool PERM = true, AFTER_DRAIN = false;
    bf16_t* M; const bf16_t* G;
    DEV void operator()(const Acc& acc, const Unit& u, int wr, int wc, int fr, int fq, const PreNone&) const {
        EPI_ROWS(u); const size_t cofs = (size_t)u.pn * 256 + wc * 32 + 8 * fq; const bf16_t* gb = G + (size_t)u.job * T * D;
#pragma unroll
        for (int ai = 0; ai < 2; ++ai)
#pragma unroll
            for (int m = 0; m < 4; ++m) { const size_t ro = (size_t)(row0 + ai * HALF + m * 16) * D + cofs;
#pragma unroll
                for (int bj = 0; bj < 2; ++bj) { const size_t o = ro + bj * HALF; const u32x4 g = *(const u32x4*)(gb + o);
                    f32x4 v0 = acc[ai][bj][m][0], v1 = acc[ai][bj][m][1];
                    v0[0] *= bflo(g.x); v0[1] *= bfhi(g.x); v0[2] *= bflo(g.y); v0[3] *= bfhi(g.y); v1[0] *= bflo(g.z); v1[1] *= bfhi(g.z); v1[2] *= bflo(g.w); v1[3] *= bfhi(g.w);
                    if (u.job > 0) { const u32x4 p = __builtin_nontemporal_load((const u32x4*)(M + o));
                        v0[0] += bflo(p.x); v0[1] += bfhi(p.x); v0[2] += bflo(p.y); v0[3] += bfhi(p.y); v1[0] += bflo(p.z); v1[1] += bfhi(p.z); v1[2] += bflo(p.w); v1[3] += bfhi(p.w); }
                    *(u32x4*)(M + o) = pack8(v0, v1); } }
    }
};
template <bool IN_F32> struct EpiResid {
    typedef PreNone Pre;
    DEV void prefetch(PreNone&, const Unit&, int, int) const {}
    static constexpr bool PERM = true, AFTER_DRAIN = false;
    const void* xin; bf16_t* xb; u64* ss;
    DEV void operator()(const Acc& acc, const Unit& u, int wr, int wc, int fr, int fq, const PreNone&) const {
        EPI_ROWS(u); const size_t cofs = (size_t)u.pn * 256 + wc * 32 + 8 * fq;
#pragma unroll
        for (int ai = 0; ai < 2; ++ai)
#pragma unroll
            for (int m = 0; m < 4; ++m) { const size_t ro = (size_t)(row0 + ai * HALF + m * 16) * D + cofs; float sq = 0.f;
#pragma unroll
                for (int bj = 0; bj < 2; ++bj) { const size_t o = ro + bj * HALF; f32x4 v0 = acc[ai][bj][m][0], v1 = acc[ai][bj][m][1];
                    if (IN_F32) { v0 = v0 + *(const f32x4*)((const float*)xin + o); v1 = v1 + *(const f32x4*)((const float*)xin + o + 4); }
                    else { const u32x4 p = *(const u32x4*)((const bf16_t*)xin + o);
                        v0[0] += bflo(p.x); v0[1] += bfhi(p.x); v0[2] += bflo(p.y); v0[3] += bfhi(p.y); v1[0] += bflo(p.z); v1[1] += bfhi(p.z); v1[2] += bflo(p.w); v1[3] += bfhi(p.w); }
                    *(u32x4*)(xb + o) = pack8(v0, v1);
                    sq += ((v0[0] * v0[0] + v0[1] * v0[1]) + (v0[2] * v0[2] + v0[3] * v0[3])) + ((v1[0] * v1[0] + v1[1] * v1[1]) + (v1[2] * v1[2] + v1[3] * v1[3])); }
                sq += __shfl_xor(sq, 16); sq += __shfl_xor(sq, 32);
                if (fq == 0) atomicAdd(ss + row0 + ai * HALF + m * 16, (u64)(sq * SS_SCALE + 0.5f)); }
    }
};
struct EpiUp {
    typedef PreRs Pre;
    DEV void prefetch(PreRs& p, const Unit& u, int wr, int fr) const { pre_rs(p, ss, u.pm * BM + wr * 64 + fr); }
    static constexpr bool PERM = true, AFTER_DRAIN = false;
    bf16_t *fa, *fu; const u64* ss;
    DEV void operator()(const Acc& acc, const Unit& u, int wr, int wc, int fr, int fq, const PreRs& pre) const {
        EPI_ROWS(u); float rs[2][4]; rs_of(rs, pre); const size_t cofs = (size_t)u.pn * 128 + wc * 32 + 8 * fq;
#pragma unroll
        for (int ai = 0; ai < 2; ++ai)
#pragma unroll
            for (int m = 0; m < 4; ++m) { const size_t o = (size_t)(row0 + ai * HALF + m * 16) * DFF + cofs;
                *(u32x4*)(fa + o) = pack8(acc[ai][0][m][0] * rs[ai][m], acc[ai][0][m][1] * rs[ai][m]); *(u32x4*)(fu + o) = pack8(acc[ai][1][m][0] * rs[ai][m], acc[ai][1][m][1] * rs[ai][m]); }
    }
};
DEV float gelu_t(float a) { return a * __builtin_amdgcn_rcpf(1.f + __builtin_amdgcn_exp2f(-1.5957691216057308f * LOG2E * (a + 0.044715f * a * a * a))); }
DEV float row_prev1(float cur, float prevm) { const int r = __builtin_amdgcn_update_dpp(0, (int)__float_as_uint(prevm), 0x121, 0xf, 0xf, false);
    return __uint_as_float((unsigned)__builtin_amdgcn_update_dpp(r, (int)__float_as_uint(cur), 0x111, 0xf, 0xf, false)); }
DEV float row_prev2(float cur, float prevm) { const int r = __builtin_amdgcn_update_dpp(0, (int)__float_as_uint(prevm), 0x122, 0xf, 0xf, false);
    return __uint_as_float((unsigned)__builtin_amdgcn_update_dpp(r, (int)__float_as_uint(cur), 0x112, 0xf, 0xf, false)); }
struct EpiUpF {
    typedef PreRs Pre;
    DEV void prefetch(PreRs& p, const Unit& u, int wr, int fr) const { pre_rs(p, ss, u.pm * BM + wr * 64 + fr); }
    static constexpr bool PERM = true, AFTER_DRAIN = false;
    bf16_t *fu, *sa, *su; const u64* ss; const float *cw, *cb;
    DEV void operator()(const Acc& acc, const Unit& u, int wr, int wc, int fr, int fq, const PreRs& pre) const {
        EPI_ROWS(u); float rs[2][4]; rs_of(rs, pre); const size_t cofs = (size_t)u.pn * 128 + wc * 32 + 8 * fq;
        f32x4 w0[2], w1[2], w2[2], bb[2];
#pragma unroll
        for (int n = 0; n < 2; ++n) { w0[n] = *(const f32x4*)(cw + cofs + 4 * n); w1[n] = *(const f32x4*)(cw + DFF + cofs + 4 * n); w2[n] = *(const f32x4*)(cw + 2 * DFF + cofs + 4 * n); bb[n] = *(const f32x4*)(cb + cofs + 4 * n); }
#pragma unroll
        for (int ai = 0; ai < 2; ++ai) {
            const size_t strip = (size_t)u.pm * 4 + ai * 2 + wr;
            f32x4 ap[2] = {{0.f, 0.f, 0.f, 0.f}, {0.f, 0.f, 0.f, 0.f}};
#pragma unroll
            for (int m = 0; m < 4; ++m) {
                f32x4 a[2], g[2];
#pragma unroll
                for (int n = 0; n < 2; ++n) { a[n] = acc[ai][0][m][n] * rs[ai][m];
#pragma unroll
                    for (int e = 0; e < 4; ++e) { const float a1 = row_prev1(a[n][e], ap[n][e]), a2 = row_prev2(a[n][e], ap[n][e]);
                        g[n][e] = gelu_t(bb[n][e] + w0[n][e] * a2 + w1[n][e] * a1 + w2[n][e] * a[n][e]) * (acc[ai][1][m][n][e] * rs[ai][m]); } }
                if (m == 0) {
                    if (fr < 2) { *(u32x4*)(sa + (strip * 4 + fr) * DFF + cofs) = pack8(a[0], a[1]); *(u32x4*)(su + (strip * 2 + fr) * DFF + cofs) = pack8(acc[ai][1][0][0] * rs[ai][0], acc[ai][1][0][1] * rs[ai][0]); }
                    else *(u32x4*)(fu + (size_t)(row0 + ai * HALF) * DFF + cofs) = pack8(g[0], g[1]);
                } else {
                    *(u32x4*)(fu + (size_t)(row0 + ai * HALF + m * 16) * DFF + cofs) = pack8(g[0], g[1]);
                    if (m == 3 && fr >= 14) *(u32x4*)(sa + (strip * 4 + 2 + (fr - 14)) * DFF + cofs) = pack8(a[0], a[1]);
                }
                ap[0] = a[0]; ap[1] = a[1];
            }
        }
    }
};
struct EpiPrep {
    typedef PreNone Pre;
    DEV void prefetch(PreNone&, const Unit&, int, int) const {}
    static constexpr bool PERM = true, AFTER_DRAIN = false;
    unsigned char* ws; int mode;
    DEV void operator()(const Acc& acc, const Unit& u, int wr, int wc, int fr, int fq, const PreNone&) const {
        EPI_ROWS(u); bf16_t* base; int ldc; float sc = 1.f;
        if (mode == 0) { base = (bf16_t*)(ws + WS_KVM + (size_t)u.job * 2 * MiB); ldc = 2 * D; }
        else if (mode == 1) { base = (bf16_t*)(ws + WS_GT + (size_t)(u.job >> 2) * 2 * MiB) + (size_t)(u.job & 3) * 256 * D; ldc = D; sc = XSCALE; }
        else { base = (bf16_t*)(ws + WS_HT + (size_t)(u.job >> 2) * 2 * MiB) + (u.job & 3) * 256; ldc = D; }
        base += (size_t)u.pn * 256 + wc * 32 + 8 * fq;
#pragma unroll
        for (int ai = 0; ai < 2; ++ai)
#pragma unroll
            for (int m = 0; m < 4; ++m) { bf16_t* rowp = base + (size_t)(row0 + ai * HALF + m * 16) * ldc;
#pragma unroll
                for (int bj = 0; bj < 2; ++bj) *(u32x4*)(rowp + bj * HALF) = pack8(acc[ai][bj][m][0] * sc, acc[ai][bj][m][1] * sc); }
    }
};
struct EpiSoftmax {
    typedef PreRs Pre;
    DEV void prefetch(PreRs& p, const Unit& u, int wr, int fr) const { pre_rs(p, ss, u.pm * BM + wr * 64 + fr); }
    static constexpr bool PERM = true, AFTER_DRAIN = true;
    bf16_t* P; const u64* ss;
    DEV void fused(Acc& acc, const Unit& u, int wr, int wc, int fr, int fq, LAS unsigned char* lds, int wid, int lane, const PreRs& pre) const {
        LAS float* PM = (LAS float*)lds; LAS float* PS = (LAS float*)(lds + 4096);
        { const int row0_ = u.pm * BM + wr * 64 + fr; float rs[2][4]; rs_of(rs, pre);
#pragma unroll
          for (int ai = 0; ai < 2; ++ai)
#pragma unroll
              for (int m = 0; m < 4; ++m)
#pragma unroll
                  for (int bj = 0; bj < 2; ++bj)
#pragma unroll
                      for (int n = 0; n < 2; ++n) acc[ai][bj][m][n] = acc[ai][bj][m][n] * rs[ai][m]; }
#pragma unroll
        for (int ai = 0; ai < 2; ++ai)
#pragma unroll
            for (int m = 0; m < 4; ++m) { float mx = -INFINITY;
#pragma unroll
                for (int bj = 0; bj < 2; ++bj)
#pragma unroll
                    for (int n = 0; n < 2; ++n) { const f32x4 x = acc[ai][bj][m][n]; mx = fmaxf(mx, fmaxf(fmaxf(x[0], x[1]), fmaxf(x[2], x[3]))); }
                mx = fmaxf(mx, __shfl_xor(mx, 16)); mx = fmaxf(mx, __shfl_xor(mx, 32));
                if (fq == 0) PM[(ai * HALF + wr * 64 + m * 16 + fr) * 4 + wc] = mx; }
        LDS_WAIT(); __builtin_amdgcn_s_barrier(); asm volatile("" ::: "memory");
#pragma unroll
        for (int ai = 0; ai < 2; ++ai)
#pragma unroll
            for (int m = 0; m < 4; ++m) { const int r = ai * HALF + wr * 64 + m * 16 + fr; const f32x4 q = *(const LAS f32x4*)(PM + r * 4);
                const float mx = fmaxf(fmaxf(q[0], q[1]), fmaxf(q[2], q[3])); float s = 0.f;
#pragma unroll
                for (int bj = 0; bj < 2; ++bj)
#pragma unroll
                    for (int n = 0; n < 2; ++n) { f32x4 x = acc[ai][bj][m][n];
#pragma unroll
                        for (int i = 0; i < 4; ++i) { x[i] = __builtin_amdgcn_exp2f(x[i] - mx); s += x[i]; } acc[ai][bj][m][n] = x; }
                s += __shfl_xor(s, 16); s += __shfl_xor(s, 32);
                if (fq == 0) PS[r * 4 + wc] = s; }
        LDS_WAIT(); __builtin_amdgcn_s_barrier(); asm volatile("" ::: "memory");
        EPI_ROWS(u); bf16_t* base = P + (size_t)u.pn * 256 + wc * 32 + 8 * fq;
#pragma unroll
        for (int ai = 0; ai < 2; ++ai)
#pragma unroll
            for (int m = 0; m < 4; ++m) { const int r = ai * HALF + wr * 64 + m * 16 + fr; const f32x4 q = *(const LAS f32x4*)(PS + r * 4);
                const float inv = 1.f / ((q[0] + q[1]) + (q[2] + q[3])); bf16_t* rowp = base + (size_t)(row0 + ai * HALF + m * 16) * D;
#pragma unroll
                for (int bj = 0; bj < 2; ++bj) *(u32x4*)(rowp + bj * HALF) = pack8(acc[ai][bj][m][0] * inv, acc[ai][bj][m][1] * inv); }
        LDS_WAIT(); __builtin_amdgcn_s_barrier();
    }
};
}

typedef GAS unsigned gu32;
#define XB_TMO      128
#define XB_XCNT(j)  (256  + 64 * (j))
#define XB_XSUB(j)  (1280 + 64 * (j))
#define XB_XGEN(j)  (2304 + 64 * (j))
#define XB_TOP      3328
#define XB_TOPGEN   3392
#define XCD_BAR_WORDS 3456
#define XB_SPIN_CAP (1u << 22)
DEV unsigned xb_ld(unsigned* p) { return __hip_atomic_load(p, __ATOMIC_RELAXED, __HIP_MEMORY_SCOPE_AGENT); }
DEV unsigned xb_add(unsigned* p, unsigned v) { return __hip_atomic_fetch_add(p, v, __ATOMIC_RELAXED, __HIP_MEMORY_SCOPE_AGENT); }
DEV unsigned xb_xcc_id() { return (unsigned)__builtin_amdgcn_s_getreg((3 << 11) | 20) & 0xFu; }
#define XB_SPIN(cond, bar) do { unsigned _sp = 0; while (cond) { __builtin_amdgcn_s_sleep(1); \
    if ((++_sp & 255u) == 0u) { if (xb_ld(&(bar)[XB_TMO])) break; if (_sp > XB_SPIN_CAP) { atomicAdd(&(bar)[XB_TMO], 1u); break; } } } } while (0)
struct XcdBarrier { unsigned* bar; unsigned x; volatile LAS unsigned* st; };
DEV XcdBarrier xcd_barrier_post(unsigned* bar, volatile LAS unsigned* st, int tid) {
    XcdBarrier b; b.bar = bar; b.x = xb_xcc_id(); b.st = st;
    if (tid == 0) (void)xb_add(&bar[XB_XCNT(b.x)], 1u);
    return b;
}
DEV void xcd_barrier_complete(unsigned* bar, unsigned x, unsigned& nloc, unsigned& nx) {
    const unsigned G = gridDim.x * gridDim.y * gridDim.z;
    unsigned sum, cnt, mine, sp = 0u;
    for (;;) {
        sum = 0u; cnt = 0u; mine = 0u;
#pragma unroll
        for (unsigned j = 0; j < 16; ++j) { const unsigned c = xb_ld(&bar[XB_XCNT(j)]); sum += c; cnt += (c > 0u) ? 1u : 0u; mine = (j == x) ? c : mine; }
        if (sum == G) break;
        __builtin_amdgcn_s_sleep(1);
        if ((++sp & 255u) == 0u) { if (xb_ld(&bar[XB_TMO])) break; if (sp > XB_SPIN_CAP) { atomicAdd(&bar[XB_TMO], 1u); break; } }
    }
    nloc = mine > 0u ? mine : 1u; nx = cnt > 0u ? cnt : 1u;
}
DEV void xcd_barrier(const XcdBarrier& b, int tid) {
    asm volatile("s_waitcnt vmcnt(0)" ::: "memory");
    __syncthreads();
    if (tid == 0) {
        unsigned* bar = b.bar;
        __builtin_amdgcn_s_waitcnt(0);
        unsigned nloc = b.st[0], nx = b.st[1];
        if (nloc == 0u) { xcd_barrier_complete(bar, b.x, nloc, nx); b.st[0] = nloc; b.st[1] = nx; }
        const unsigned old = xb_add(&bar[XB_XSUB(b.x)], 1u);
        const unsigned gen = old / nloc;
        if (old + 1u == (gen + 1u) * nloc) {
            __builtin_amdgcn_fence(__ATOMIC_RELEASE, "agent");
            asm volatile("s_waitcnt vmcnt(0)" ::: "memory");
            const unsigned og = xb_add(&bar[XB_TOP], 1u);
            const unsigned tg = og / nx;
            if (og + 1u == (tg + 1u) * nx) xb_add(&bar[XB_TOPGEN], 1u);
            else XB_SPIN(xb_ld(&bar[XB_TOPGEN]) == tg, bar);
            __builtin_amdgcn_fence(__ATOMIC_ACQUIRE, "agent");
            xb_add(&bar[XB_XGEN(b.x)], 1u);
            asm volatile("s_waitcnt vmcnt(0)" ::: "memory");
        } else {
            XB_SPIN(xb_ld(&bar[XB_XGEN(b.x)]) == gen, bar);
            __builtin_amdgcn_fence(__ATOMIC_ACQUIRE, "agent");
            asm volatile("s_waitcnt vmcnt(0)" ::: "memory");
        }
    }
    __syncthreads();
}


using pg8::gelu_t;
struct WaveId { int gw, ngw, wave, lane; };
DEV unsigned f2bf_u(float f) { return (unsigned)f2bf(f); }
DEV unsigned pk2(float lo, float hi) { return cvt_pk_bf16(lo, hi); }

DEV void norm_rows(const WaveId& W, const float* x, const float* g, bf16_t* outb, float* outf, int rows) {
    for (int row = W.gw; row < rows; row += W.ngw) {
        const f32x4* xr = (const f32x4*)(x + (size_t)row * D) + W.lane;
        f32x4 v[4]; float s = 0.f;
#pragma unroll
        for (int j = 0; j < 4; ++j) { v[j] = xr[64 * j]; s += (v[j].x * v[j].x + v[j].y * v[j].y) + (v[j].z * v[j].z + v[j].w * v[j].w); }
        const float r = rsqrtf(wave_sum(s) * (1.f / D) + EPS);
#pragma unroll
        for (int j = 0; j < 4; ++j) {
            const f32x4 gg = ((const f32x4*)g)[W.lane + 64 * j];
            const f32x4 o = {v[j].x * r * gg.x, v[j].y * r * gg.y, v[j].z * r * gg.z, v[j].w * r * gg.w};
            if (outb) { u32x2 w; w.x = pk2(o.x, o.y); w.y = pk2(o.z, o.w); ((u32x2*)(outb + (size_t)row * D))[W.lane + 64 * j] = w; }
            else ((f32x4*)(outf + (size_t)row * D))[W.lane + 64 * j] = o;
        }
    }
}
DEV void cvt_piece(const WaveId& W, LAS float* scr, int& base, const float* Wsrc, int ldw, int K, int col0, int ncols, bf16_t* dst, int ldo, int row0, const float* gain = nullptr) {
    const int nblk = ncols / 32, nitems = (K / 64) * nblk;
    int first = (W.gw - base) % W.ngw; if (first < 0) first += W.ngw;
    base = (base + nitems) % W.ngw;
    for (int item = first; item < nitems; item += W.ngw) {
        const int kb = item / nblk, nb = item - kb * nblk, k0 = 64 * kb, n0 = 32 * nb;
#pragma unroll 8
        for (int i = 0; i < 32; ++i) { const int kk = 2 * i + (W.lane >> 5); scr[kk * 33 + (W.lane & 31)] = Wsrc[(size_t)(k0 + kk) * ldw + col0 + n0 + (W.lane & 31)] * (gain ? gain[k0 + kk] : 1.f); }
        LDS_WAIT(); asm volatile("" ::: "memory");
        const int c = W.lane & 7;
#pragma unroll
        for (int j = 0; j < 4; ++j) { const int n = (W.lane >> 3) + 8 * j; const LAS float* s = scr + (8 * c) * 33 + n;
            u32x4 o; o.x = pk2(s[0 * 33], s[1 * 33]); o.y = pk2(s[2 * 33], s[3 * 33]); o.z = pk2(s[4 * 33], s[5 * 33]); o.w = pk2(s[6 * 33], s[7 * 33]);
            *(u32x4*)(dst + (size_t)(row0 + n0 + n) * ldo + k0 + 8 * c) = o; }
        LDS_WAIT(); asm volatile("" ::: "memory");
    }
}
DEV void convert_layer_weights(const WaveId& W, LAS float* scr, int& base, unsigned char* ws, const float* const* in, int l) {
    const float* wi = in[3] + (size_t)l * D * DIN;
    bf16_t* WIN = (bf16_t*)(ws + WS_WIN); const float* gm = in[2] + l * D; const float* gf = in[14] + l * D;
    cvt_piece(W, scr, base, wi, DIN, D, 0, 1536, WIN, D, 0, gm);
    cvt_piece(W, scr, base, wi, DIN, D, 3072, 1536, WIN, D, 1536, gm);
    cvt_piece(W, scr, base, wi, DIN, D, 4608, 512, WIN, D, 3072, gm);
    cvt_piece(W, scr, base, wi, DIN, D, 1536, 512, WIN, D, 3584, gm);
#pragma unroll 1
    for (int j = 0; j < 4; ++j) { cvt_piece(W, scr, base, wi, DIN, D, 2048 + 128 * j, 128, WIN, D, 4096 + 256 * j, gm); cvt_piece(W, scr, base, wi, DIN, D, 2560 + 128 * j, 128, WIN, D, 4096 + 256 * j + 128, gm); }
    cvt_piece(W, scr, base, wi, DIN, D, 5120, 96, WIN, D, 5120, gm);
    cvt_piece(W, scr, base, wi, DIN, D, 5192, 3072, (bf16_t*)(ws + WS_WG), D, 0, gm);
#pragma unroll 1
    for (int i = 0; i < 3; ++i) cvt_piece(W, scr, base, in[5 + i] + (size_t)l * 512 * D, D, 512, 0, D, (bf16_t*)(ws + WS_WBR) + (size_t)i * D * 512, 512, 0);
    cvt_piece(W, scr, base, in[8] + (size_t)l * D * D, D, D, 0, D, (bf16_t*)(ws + WS_WMIX), D, 0);
    const float* wf = in[15] + (size_t)l * D * 2 * DFF;
#pragma unroll 1
    for (int j = 0; j < 22; ++j) { cvt_piece(W, scr, base, wf, 2 * DFF, D, 128 * j, 128, (bf16_t*)(ws + WS_WUP), D, 256 * j, gf); cvt_piece(W, scr, base, wf, 2 * DFF, D, DFF + 128 * j, 128, (bf16_t*)(ws + WS_WUP), D, 256 * j + 128, gf); }
    cvt_piece(W, scr, base, in[18] + (size_t)l * DFF * D, D, DFF, 0, D, (bf16_t*)(ws + WS_WDOWN), DFF, 0);
}
DEV void prep0_phase(const WaveId& W, LAS float* scr, unsigned char* ws, const float* const* in, bf16_t* XB) {
    int base = 0;
#pragma unroll 1
    for (int l = 0; l < DEPTH; ++l) {
        const float* wq = in[11] + (size_t)l * D * D; bf16_t* WQ = (bf16_t*)(ws + WS_WQ + (size_t)l * 2 * MiB); const float* gx = in[9] + l * D;
        for (size_t i = (size_t)(W.gw * 64 + W.lane) * 4; i < (size_t)D * D; i += (size_t)W.ngw * 256) { const float g = gx[i >> 10]; const f32x4 v = *(const f32x4*)(wq + i); u32x2 o; o.x = pk2(v.x * g, v.y * g); o.y = pk2(v.z * g, v.w * g); *(u32x2*)(WQ + i) = o; }
        cvt_piece(W, scr, base, in[13] + (size_t)l * D * D, D, D, 0, D, (bf16_t*)(ws + WS_WOT + (size_t)l * 2 * MiB), D, 0);
        cvt_piece(W, scr, base, in[12] + (size_t)l * D * 2 * D, 2 * D, D, 0, 2 * D, (bf16_t*)(ws + WS_WKVT + (size_t)l * 4 * MiB), D, 0);
        norm_rows(W, in[1], in[10] + l * D, (bf16_t*)(ws + WS_MEMN + (size_t)l * MiB), nullptr, NB * MEM);
    }
    convert_layer_weights(W, scr, base, ws, in, 0);
    pg8::u64* ss0 = (pg8::u64*)(ws + WS_SS);
    for (int row = W.gw; row < T; row += W.ngw) {
        const f32x4* xr = (const f32x4*)(in[0] + (size_t)row * D) + W.lane; float s = 0.f;
#pragma unroll
        for (int j = 0; j < 4; ++j) { const f32x4 v = xr[64 * j]; s += (v.x * v.x + v.y * v.y) + (v.z * v.z + v.w * v.w);
            u32x2 w; w.x = pk2(v.x, v.y); w.y = pk2(v.z, v.w); ((u32x2*)(XB + (size_t)row * D))[W.lane + 64 * j] = w; }
        s = wave_sum(s); if (W.lane == 0) ss0[row] = (pg8::u64)(s * pg8::SS_SCALE + 0.5f);
    }
}
DEV void final_norm(const WaveId& W, const bf16_t* x, float* out, const float* g, const pg8::u64* ss) {
    for (int row = W.gw; row < T; row += W.ngw) {
        const float r = rsqrtf((float)ss[row] * (1.f / (pg8::SS_SCALE * D)) + EPS); const u32x2* xr = (const u32x2*)(x + (size_t)row * D) + W.lane; f32x4* orow = (f32x4*)(out + (size_t)row * D) + W.lane;
#pragma unroll
        for (int j = 0; j < 4; ++j) { const f32x4 gg = ((const f32x4*)g)[W.lane + 64 * j]; const u32x2 v = xr[64 * j];
            const f32x4 o = {bflo(v.x) * r * gg.x, bfhi(v.x) * r * gg.y, bflo(v.y) * r * gg.z, bfhi(v.y) * r * gg.w}; orow[64 * j] = o; }
    }
}
DEV void conv_sc_phase(int gtid, int gthreads, bf16_t* scb, const bf16_t* cx, const float* w, bool dry) {
    for (int i = gtid; i < T * 64; i += gthreads) {
        const int c8 = (i & 63) * 8, t = i >> 6, tl = t & (S - 1);
        const size_t o = (size_t)t * 512 + c8;
        const u32x4 z = {0u, 0u, 0u, 0u};
        const u32x4 x2 = *(const u32x4*)(cx + o), x1 = tl >= 1 ? *(const u32x4*)(cx + o - 512) : z, x0 = tl >= 2 ? *(const u32x4*)(cx + o - 1024) : z, bb = *(const u32x4*)(scb + o);
        const f32x4 w0a = *(const f32x4*)(w + c8), w0b = *(const f32x4*)(w + c8 + 4), w1a = *(const f32x4*)(w + 512 + c8), w1b = *(const f32x4*)(w + 512 + c8 + 4), w2a = *(const f32x4*)(w + 1024 + c8), w2b = *(const f32x4*)(w + 1024 + c8 + 4);
        float r[8];
#define CONV1(k, W0, W1, W2, X0, X1, X2, BBv, F) r[k] = F(BBv) * (W0 * F(X0) + W1 * F(X1) + W2 * F(X2))
        CONV1(0, w0a.x, w1a.x, w2a.x, x0.x, x1.x, x2.x, bb.x, bflo); CONV1(1, w0a.y, w1a.y, w2a.y, x0.x, x1.x, x2.x, bb.x, bfhi);
        CONV1(2, w0a.z, w1a.z, w2a.z, x0.y, x1.y, x2.y, bb.y, bflo); CONV1(3, w0a.w, w1a.w, w2a.w, x0.y, x1.y, x2.y, bb.y, bfhi);
        CONV1(4, w0b.x, w1b.x, w2b.x, x0.z, x1.z, x2.z, bb.z, bflo); CONV1(5, w0b.y, w1b.y, w2b.y, x0.z, x1.z, x2.z, bb.z, bfhi);
        CONV1(6, w0b.z, w1b.z, w2b.z, x0.w, x1.w, x2.w, bb.w, bflo); CONV1(7, w0b.w, w1b.w, w2b.w, x0.w, x1.w, x2.w, bb.w, bfhi);
#undef CONV1
        u32x4 ov; ov.x = pk2(r[0], r[1]); ov.y = pk2(r[2], r[3]); ov.z = pk2(r[4], r[5]); ov.w = pk2(r[6], r[7]);
        if (!dry) *(u32x4*)(scb + o) = ov; else asm volatile("" :: "v"(ov));
    }
}
DEV void ffn_mid_phase(int gtid, int gthreads, const bf16_t* fa, bf16_t* fu, const float* cw, const float* cb, bool dry) {
    constexpr int C8 = DFF / 8;
    for (int i = gtid; i < T * C8; i += gthreads) {
        const int t = i / C8, c8 = (i - t * C8) * 8, tl = t & (S - 1);
        const size_t o = (size_t)t * DFF + c8;
        const u32x4 z = {0u, 0u, 0u, 0u};
        const u32x4 x2 = *(const u32x4*)(fa + o), x1 = tl >= 1 ? *(const u32x4*)(fa + o - DFF) : z, x0 = tl >= 2 ? *(const u32x4*)(fa + o - 2 * DFF) : z, uu = *(const u32x4*)(fu + o);
        const f32x4 w0a = *(const f32x4*)(cw + c8), w0b = *(const f32x4*)(cw + c8 + 4), w1a = *(const f32x4*)(cw + DFF + c8), w1b = *(const f32x4*)(cw + DFF + c8 + 4), w2a = *(const f32x4*)(cw + 2 * DFF + c8), w2b = *(const f32x4*)(cw + 2 * DFF + c8 + 4);
        const f32x4 ba = *(const f32x4*)(cb + c8), bb = *(const f32x4*)(cb + c8 + 4);
        float r[8];
#define FM1(k, B0, W0, W1, W2, X0, X1, X2, Uv, F) r[k] = gelu_t(B0 + W0 * F(X0) + W1 * F(X1) + W2 * F(X2)) * F(Uv)
        FM1(0, ba.x, w0a.x, w1a.x, w2a.x, x0.x, x1.x, x2.x, uu.x, bflo); FM1(1, ba.y, w0a.y, w1a.y, w2a.y, x0.x, x1.x, x2.x, uu.x, bfhi);
        FM1(2, ba.z, w0a.z, w1a.z, w2a.z, x0.y, x1.y, x2.y, uu.y, bflo); FM1(3, ba.w, w0a.w, w1a.w, w2a.w, x0.y, x1.y, x2.y, uu.y, bfhi);
        FM1(4, bb.x, w0b.x, w1b.x, w2b.x, x0.z, x1.z, x2.z, uu.z, bflo); FM1(5, bb.y, w0b.y, w1b.y, w2b.y, x0.z, x1.z, x2.z, uu.z, bfhi);
        FM1(6, bb.z, w0b.z, w1b.z, w2b.z, x0.w, x1.w, x2.w, uu.w, bflo); FM1(7, bb.w, w0b.w, w1b.w, w2b.w, x0.w, x1.w, x2.w, uu.w, bfhi);
#undef FM1
        u32x4 ov; ov.x = pk2(r[0], r[1]); ov.y = pk2(r[2], r[3]); ov.z = pk2(r[4], r[5]); ov.w = pk2(r[6], r[7]);
        if (!dry) *(u32x4*)(fu + o) = ov; else asm volatile("" :: "v"(ov));
    }
}

DEV void ffn_fix_phase(int gtid, int gthreads, const bf16_t* sa, const bf16_t* su, bf16_t* fu, const float* cw, const float* cb) {
    constexpr int C8 = DFF / 8, NS = T / 64;
    for (int i = gtid; i < NS * 2 * C8; i += gthreads) {
        const int sr = i / C8, c8 = (i - sr * C8) * 8, strip = sr >> 1, rr = sr & 1, t = strip * 64 + rr;
        const bool first = (strip & (S / 64 - 1)) == 0;
        const u32x4 z = {0u, 0u, 0u, 0u};
        const bf16_t* A = sa + (size_t)strip * 4 * DFF + c8; const bf16_t* Ap = A - 4 * DFF;
        const u32x4 x2 = *(const u32x4*)(A + rr * DFF);
        const u32x4 x1 = rr == 1 ? *(const u32x4*)A : (first ? z : *(const u32x4*)(Ap + 3 * DFF));
        const u32x4 x0 = first ? z : *(const u32x4*)(Ap + (2 + rr) * DFF);
        const u32x4 uu = *(const u32x4*)(su + ((size_t)strip * 2 + rr) * DFF + c8);
        const f32x4 w0a = *(const f32x4*)(cw + c8), w0b = *(const f32x4*)(cw + c8 + 4), w1a = *(const f32x4*)(cw + DFF + c8), w1b = *(const f32x4*)(cw + DFF + c8 + 4), w2a = *(const f32x4*)(cw + 2 * DFF + c8), w2b = *(const f32x4*)(cw + 2 * DFF + c8 + 4);
        const f32x4 ba = *(const f32x4*)(cb + c8), bb = *(const f32x4*)(cb + c8 + 4);
        float r[8];
#define FM1(k, B0, W0, W1, W2, X0, X1, X2, Uv, F) r[k] = gelu_t(B0 + W0 * F(X0) + W1 * F(X1) + W2 * F(X2)) * F(Uv)
        FM1(0, ba.x, w0a.x, w1a.x, w2a.x, x0.x, x1.x, x2.x, uu.x, bflo); FM1(1, ba.y, w0a.y, w1a.y, w2a.y, x0.x, x1.x, x2.x, uu.x, bfhi);
        FM1(2, ba.z, w0a.z, w1a.z, w2a.z, x0.y, x1.y, x2.y, uu.y, bflo); FM1(3, ba.w, w0a.w, w1a.w, w2a.w, x0.y, x1.y, x2.y, uu.y, bfhi);
        FM1(4, bb.x, w0b.x, w1b.x, w2b.x, x0.z, x1.z, x2.z, uu.z, bflo); FM1(5, bb.y, w0b.y, w1b.y, w2b.y, x0.z, x1.z, x2.z, uu.z, bfhi);
        FM1(6, bb.z, w0b.z, w1b.z, w2b.z, x0.w, x1.w, x2.w, uu.w, bflo); FM1(7, bb.w, w0b.w, w1b.w, w2b.w, x0.w, x1.w, x2.w, uu.w, bfhi);
#undef FM1
        u32x4 ov; ov.x = pk2(r[0], r[1]); ov.y = pk2(r[2], r[3]); ov.z = pk2(r[4], r[5]); ov.w = pk2(r[6], r[7]);
        *(u32x4*)(fu + (size_t)t * DFF + c8) = ov;
    }
}

typedef short s16x4 __attribute__((ext_vector_type(4)));
DEV s16x4 vtr(const LAS unsigned char* p) { return __builtin_bit_cast(s16x4, __builtin_amdgcn_ds_read_tr16_b64_v4i16((LAS s16x4*)p)); }
DEV bf16x8 cat8(const s16x4 a, const s16x4 b) { return (bf16x8){a[0], a[1], a[2], a[3], b[0], b[1], b[2], b[3]}; }
DEV bf16x8 pk8(float a0, float a1, float a2, float a3, float a4, float a5, float a6, float a7) {
    u32x4 w; w.x = pk2(a0, a1); w.y = pk2(a2, a3); w.z = pk2(a4, a5); w.w = pk2(a6, a7); return __builtin_bit_cast(bf16x8, w); }
constexpr int VPITCH = 192;
DEV void pv_tile(f32x16& o0, f32x16& o1, const LAS unsigned char* vt, int lane, const bf16x8 (&pk)[4]) {
    const int hi = lane >> 5;
    const LAS unsigned char* vb = vt + (4 * hi + ((lane & 15) >> 2)) * VPITCH + ((lane >> 4) & 1) * 32 + (lane & 3) * 8;
    bf16x8 va[4];
#pragma unroll
    for (int ks = 0; ks < 4; ++ks) va[ks] = cat8(vtr(vb + (16 * ks) * VPITCH), vtr(vb + (16 * ks + 8) * VPITCH));
    asm volatile("" : "+v"(va[0]), "+v"(va[1]), "+v"(va[2]), "+v"(va[3]));
#pragma unroll
    for (int ks = 0; ks < 4; ++ks) o0 = __builtin_amdgcn_mfma_f32_32x32x16_bf16(va[ks], pk[ks], o0, 0, 0, 0);
#pragma unroll
    for (int ks = 0; ks < 4; ++ks) va[ks] = cat8(vtr(vb + (16 * ks) * VPITCH + 64), vtr(vb + (16 * ks + 8) * VPITCH + 64));
    asm volatile("" : "+v"(va[0]), "+v"(va[1]), "+v"(va[2]), "+v"(va[3]));
#pragma unroll
    for (int ks = 0; ks < 4; ++ks) o1 = __builtin_amdgcn_mfma_f32_32x32x16_bf16(va[ks], pk[ks], o1, 0, 0, 0);
}
DEV void store_ot(bf16_t* orow, const f32x16& o0, const f32x16& o1, int hi, float sc) {
#pragma unroll
    for (int g4 = 0; g4 < 4; ++g4) {
        u32x2 a; a.x = pk2(o0[4 * g4] * sc, o0[4 * g4 + 1] * sc); a.y = pk2(o0[4 * g4 + 2] * sc, o0[4 * g4 + 3] * sc);
        u32x2 b; b.x = pk2(o1[4 * g4] * sc, o1[4 * g4 + 1] * sc); b.y = pk2(o1[4 * g4 + 2] * sc, o1[4 * g4 + 3] * sc);
        *(u32x2*)(orow + 8 * g4 + 4 * hi) = a; *(u32x2*)(orow + 32 + 8 * g4 + 4 * hi) = b;
    }
}

DEV void sb_item(LAS unsigned char* vl, const bf16_t* Q, const bf16_t* Kk, const bf16_t* V, bf16_t* O, int b, int h, int qb, int lane, bool dry) {
    const int r32 = lane & 31, hi = lane >> 5, t0 = 32 * qb, t = t0 + r32; const size_t rowb = (size_t)b * S;
    bf16x8 qr[4]; { const bf16_t* qp = Q + (rowb + t0 + r32) * 512 + h * 64 + 8 * hi;
#pragma unroll
        for (int d0 = 0; d0 < 4; ++d0) qr[d0] = *(const bf16x8*)(qp + 16 * d0); }
    f32x16 o0, o1;
#pragma unroll
    for (int r = 0; r < 16; ++r) { o0[r] = 0.f; o1[r] = 0.f; }
    float carry = 1.f;
    const int c_hi = (t0 + 30) >> 6;
#pragma unroll 1
    for (int c = c_hi; c >= 0; --c) {
        const bf16_t* kp = Kk + (rowb + 64 * c + r32) * 512 + h * 64 + 8 * hi;
        bf16x8 k0[4], k1[4];
#pragma unroll
        for (int d0 = 0; d0 < 4; ++d0) { k0[d0] = *(const bf16x8*)(kp + 16 * d0); k1[d0] = *(const bf16x8*)(kp + (size_t)32 * 512 + 16 * d0); }
#pragma unroll
        for (int j = 0; j < 8; ++j) { const int row = (lane >> 3) + 8 * j; *(LAS u32x4*)(vl + row * VPITCH + (lane & 7) * 16) = *(const u32x4*)(V + (rowb + 64 * c + row) * 512 + h * 64 + (lane & 7) * 8); }
        f32x16 p0, p1;
#pragma unroll
        for (int r = 0; r < 16; ++r) { p0[r] = 0.f; p1[r] = 0.f; }
#pragma unroll
        for (int d0 = 0; d0 < 4; ++d0) { p0 = __builtin_amdgcn_mfma_f32_32x32x16_bf16(k0[d0], qr[d0], p0, 0, 0, 0); p1 = __builtin_amdgcn_mfma_f32_32x32x16_bf16(k1[d0], qr[d0], p1, 0, 0, 0); }
        float u[32];
        const bool diag = (c == c_hi);
#pragma unroll
        for (int e = 0; e < 32; ++e) {
            const float z = e < 16 ? p0[e] : p1[e - 16];
            float uu = __builtin_amdgcn_rcpf(1.f + __builtin_amdgcn_exp2f(fminf(z, 126.f)));
            if (diag) { const int kv = 64 * c + 8 * ((e >> 2) & 3) + 4 * hi + (e & 3) + 32 * (e >> 4); if (kv >= t) uu = 1.f; }
            u[e] = uu;
        }
        float gl[8], gh[8];
#pragma unroll
        for (int i = 0; i < 8; ++i) { const float gp = (u[4 * i] * u[4 * i + 1]) * (u[4 * i + 2] * u[4 * i + 3]);
            const auto rr = __builtin_amdgcn_permlane32_swap(__float_as_uint(gp), __float_as_uint(gp), false, false); gl[i] = __uint_as_float(rr[0]); gh[i] = __uint_as_float(rr[1]); }
        float ag[8]; float run = carry;
#pragma unroll
        for (int i = 7; i >= 0; --i) { const float a_hi = run; run *= gh[i]; const float a_lo = run; run *= gl[i]; ag[i] = hi ? a_hi : a_lo; }
        carry = run;
        bf16x8 pk[4];
#pragma unroll
        for (int ks = 0; ks < 4; ++ks) { float w[8];
#pragma unroll
            for (int g = 0; g < 2; ++g) { const int i = 2 * ks + g;
                const float a3 = ag[i], a2 = a3 * u[4 * i + 3], a1 = a2 * u[4 * i + 2], a0 = a1 * u[4 * i + 1];
                w[4 * g] = (1.f - u[4 * i]) * a0; w[4 * g + 1] = (1.f - u[4 * i + 1]) * a1; w[4 * g + 2] = (1.f - u[4 * i + 2]) * a2; w[4 * g + 3] = (1.f - u[4 * i + 3]) * a3; }
            pk[ks] = pk8(w[0], w[1], w[2], w[3], w[4], w[5], w[6], w[7]); }
        pv_tile(o0, o1, vl, lane, pk);
        if (__all(carry < 7.8e-31f)) break;
    }
    if (!dry) store_ot(O + (rowb + t0 + r32) * 512 + h * 64, o0, o1, hi, 1.f); else asm volatile("" :: "v"(o0), "v"(o1));
}
DEV void sb_phase(const WaveId& W, LAS unsigned char* lds, unsigned char* ws, bool dry) {
    LAS unsigned char* vl = lds + W.wave * 12288;
    const bf16_t* Q = (const bf16_t*)(ws + WS_QA); const bf16_t* Kk = (const bf16_t*)(ws + WS_KA); const bf16_t* V = (const bf16_t*)(ws + WS_VA);
    constexpr int NITEM = NB * 8 * (S / 32);
    for (int it = W.gw; it < NITEM; it += W.ngw) {
        const int qb = it & 255, h = (it >> 8) & 7, b = it >> 11;
        sb_item(vl, Q, Kk, V, (bf16_t*)(ws + WS_QA), b, h, qb, W.lane, dry);
    }
}

constexpr int IDX_CTL_OFF = 131072 + 1024;
DEV unsigned fkey2(float v) { const int u = (int)__float_as_uint(v); return (unsigned)(u ^ ((u >> 31) | (int)0x80000000)); }
DEV float relu1(float x) { return __builtin_amdgcn_fmed3f(x, 0.f, 3.0e38f); }
DEV void idx_prefetch(bf16x8 (&afr)[4], float (&w)[16], bf16x8 (&b0)[4], bf16x8 (&b1)[4], const bf16_t* IQ, const bf16_t* IK, const float* IWp, int b, int t0, int wid, int lane) {
    const int r32 = lane & 31, hh = lane >> 5; const size_t rowb = (size_t)b * S;
    { const int qi = 2 * (r32 >> 4) + ((r32 >> 2) & 1), head = (r32 & 3) + 4 * ((r32 >> 3) & 1);
        const bf16_t* ap = IQ + (rowb + t0 + qi) * 512 + head * 64 + 8 * hh;
#pragma unroll
        for (int ks = 0; ks < 4; ++ks) afr[ks] = *(const bf16x8*)(ap + 16 * ks); }
#pragma unroll
    for (int r = 0; r < 16; ++r) w[r] = IWp[(rowb + t0 + 2 * (r >> 3) + hh) * 8 + (r & 7)];
    const int jmax = (t0 + 3) >> 5;
    { const int j0 = wid < jmax ? wid : jmax, j1 = wid + 8 < jmax ? wid + 8 : jmax;
      const bf16_t* p0 = IK + ((rowb >> 5) + j0) * 2048 + (hh * 32 + r32) * 8; const bf16_t* p1 = IK + ((rowb >> 5) + j1) * 2048 + (hh * 32 + r32) * 8;
#pragma unroll
      for (int ks = 0; ks < 4; ++ks) { b0[ks] = *(const bf16x8*)(p0 + ks * 512); b1[ks] = *(const bf16x8*)(p1 + ks * 512); } }
}
DEV void idx_unit(LAS unsigned char* lds, const bf16_t* IQ, const bf16_t* IK, const float* IWp, unsigned* BM, int b, int t0, int nb, int nt0, int wid, int lane,
                  bf16x8 (&afr)[4], float (&w)[16], bf16x8 (&b0)[4], bf16x8 (&b1)[4]) {
    const int r32 = lane & 31, hh = lane >> 5; const size_t rowb = (size_t)b * S;
    const int tmax = t0 + 3, jmax = tmax >> 5;
    LAS unsigned* SCO = (LAS unsigned*)lds;
    bf16x8 b2[4];
#pragma unroll
    for (int ks = 0; ks < 4; ++ks) b2[ks] = afr[ks];
#define IDX_LOADB(dst, jj) do { const int jc_ = (jj) < jmax ? (jj) : jmax; const bf16_t* bp_ = IK + ((rowb >> 5) + jc_) * 2048 + (hh * 32 + r32) * 8; \
        _Pragma("unroll") for (int ks = 0; ks < 4; ++ks) dst[ks] = *(const bf16x8*)(bp_ + ks * 512); } while (0)
#define IDX_COMP(src, jj) do { f32x16 acc; _Pragma("unroll") for (int r = 0; r < 16; ++r) acc[r] = 0.f; \
        _Pragma("unroll") for (int ks = 0; ks < 4; ++ks) acc = __builtin_amdgcn_mfma_f32_32x32x16_bf16(afr[ks], src[ks], acc, 0, 0, 0); \
        float s0 = 0.f, s1 = 0.f; _Pragma("unroll") for (int hd = 0; hd < 8; ++hd) { s0 += w[hd] * relu1(acc[hd]); s1 += w[8 + hd] * relu1(acc[8 + hd]); } \
        unsigned k0_ = fkey2(s0), k1_ = fkey2(s1); const int key = 32 * (jj) + r32; \
        if ((jj) >= jmax) { k0_ = key <= t0 + hh ? k0_ : 0u; k1_ = key <= t0 + 2 + hh ? k1_ : 0u; }     \
        if ((jj) <= jmax) { SCO[hh * 8192 + key] = k0_; SCO[(2 + hh) * 8192 + key] = k1_; } } while (0)
#ifndef IDX_REP_MFMA
#define IDX_REP_MFMA 1
#endif
#ifndef IDX_REP_SEL
#define IDX_REP_SEL 1
#endif
#ifdef IDX_DRY_COMPUTE
#pragma unroll 1
    for (int j = wid; j <= jmax; j += 24) { IDX_COMP(b0, j); asm volatile("" : "+v"(b0[0]), "+v"(b1[0]), "+v"(b2[0])); IDX_COMP(b1, j + 8); IDX_COMP(b2, j + 16); }
#endif
#pragma unroll 1
    for (int rpm = 0; rpm < IDX_REP_MFMA; ++rpm) {
#pragma unroll 1
    for (int j = wid; j <= jmax; j += 24) {
        IDX_LOADB(b2, j + 16); IDX_COMP(b0, j);
        IDX_LOADB(b0, j + 24); IDX_COMP(b1, j + 8);
        IDX_LOADB(b1, j + 32); IDX_COMP(b2, j + 16);
    }
    }
#undef IDX_LOADB
#undef IDX_COMP
    if (nt0 >= 0) idx_prefetch(afr, w, b0, b1, IQ, IK, IWp, nb, nt0, wid, lane);
    LAS unsigned* thr = (LAS unsigned*)(lds + IDX_CTL_OFF);
    if (wid == 0 && lane < 32) ((LAS unsigned*)(lds + IDX_CTL_OFF + 64))[lane] = 0u;
    LDS_WAIT(); __builtin_amdgcn_s_barrier(); asm volatile("" ::: "memory");
    {
        const int q = wid & 3, h = wid >> 2, n = t0 + q + 1;
        volatile LAS unsigned* xme = (volatile LAS unsigned*)(lds + IDX_CTL_OFF + 64) + (q * 2 + h) * 4;
        volatile LAS unsigned* xpa = (volatile LAS unsigned*)(lds + IDX_CTL_OFF + 64) + (q * 2 + (h ^ 1)) * 4;
        unsigned T_ = 1u;
        if (n > 256) {
            LAS unsigned* row = SCO + q * 8192 + lane;
            unsigned r[64];
            const int nil = (jmax >> 1) >= h ? (((jmax >> 1) - h) >> 1) + 1 : 0;
#define IDX_FOR_LIVE(BODY) _Pragma("unroll") for (int g8_ = 0; g8_ < 8; ++g8_) if (8 * g8_ < nil) { _Pragma("unroll") for (int u8_ = 0; u8_ < 8; ++u8_) { const int il = 8 * g8_ + u8_; BODY } }
            IDX_FOR_LIVE( r[il] = (2 * (2 * il + h) + hh <= jmax) ? row[64 * (2 * il + h)] : 0u; )
            unsigned seq = 0u;
#define IDX_XCHG(val, out) do { ++seq; const int pb_ = (seq & 1u) * 2; if (lane == 0) { xme[pb_ + 1] = (val); xme[pb_] = seq; } \
                while (xpa[pb_] != seq) __builtin_amdgcn_s_sleep(0); (out) = xpa[pb_ + 1]; } while (0)
#define IDX_XCHG16(val, out) do { ++seq; const int pb_ = (seq & 1u) * 2; if (lane == 0) xme[pb_] = (seq << 16) | (val); unsigned w_; \
                while (((w_ = xpa[pb_]) >> 16) != (seq & 0xffffu)) __builtin_amdgcn_s_sleep(0); (out) = w_ & 0xffffu; } while (0)
#pragma unroll 1
            for (int rps = 0; rps < IDX_REP_SEL; ++rps) {
            unsigned mx = 0u;
            IDX_FOR_LIVE( mx = max(mx, r[il]); )
#pragma unroll
            for (int o = 1; o < 64; o <<= 1) mx = max(mx, (unsigned)__shfl_xor((int)mx, o));
            { unsigned pm_; IDX_XCHG(mx, pm_); mx = max(mx, pm_); }
            unsigned lo_ = 1u, hi_ = mx + 1u, chi_ = 0u, xgt_ = 1u, xeq_ = 0u, mt_ = 0u; float glo_ = __log2f((float)n) - 8.f, ghi_ = -9.f; int side_ = 0; bool done_ = false;
#pragma unroll 1
            for (int pass = 0; pass < 2 && !done_; ++pass) {
                const unsigned wdt = hi_ - lo_;
                unsigned off;
                if (pass < 2) {
                    const unsigned mkey = hi_ - 1u; const unsigned tgt = pass == 0 ? mkey - (1u << 23) : mkey - (3u << 23);
                    const bool ok = pass == 0 ? (mkey > 0x81000000u) : (mkey > 0x82000000u && tgt > lo_ && tgt < hi_);
                    off = ok ? tgt - lo_ : wdt >> 1;
                } else if ((pass & 3) == 3) off = wdt >> 1;
                else off = (unsigned)(glo_ * __builtin_amdgcn_rcpf(glo_ - ghi_) * (float)wdt);
                off = off < 1u ? 1u : (off > wdt - 1u ? wdt - 1u : off);
                const unsigned cand = (unsigned)__builtin_amdgcn_readfirstlane((int)(lo_ + off));
                unsigned ca_ = 0, cb_ = 0; const unsigned candv = lo_ + off;
#define IDX_CNT4(A, B, C, Dd) asm volatile("v_cmp_ge_u32_e64 s[88:89], %2, %6\n\tv_cmp_ge_u32_e64 s[90:91], %3, %6\n\tv_cmp_ge_u32_e64 s[92:93], %4, %6\n\tv_cmp_ge_u32_e64 s[94:95], %5, %6\n\t" \
                    "v_addc_co_u32_e64 %0, s[88:89], %0, 0, s[88:89]\n\tv_addc_co_u32_e64 %1, s[90:91], %1, 0, s[90:91]\n\tv_addc_co_u32_e64 %0, s[92:93], %0, 0, s[92:93]\n\tv_addc_co_u32_e64 %1, s[94:95], %1, 0, s[94:95]" \
                    : "+v"(ca_), "+v"(cb_) : "v"(A), "v"(B), "v"(C), "v"(Dd), "v"(candv) : "s88", "s89", "s90", "s91", "s92", "s93", "s94", "s95")
#pragma unroll
                for (int g8_ = 0; g8_ < 8; ++g8_) if (8 * g8_ < nil) { IDX_CNT4(r[8 * g8_], r[8 * g8_ + 1], r[8 * g8_ + 2], r[8 * g8_ + 3]); IDX_CNT4(r[8 * g8_ + 4], r[8 * g8_ + 5], r[8 * g8_ + 6], r[8 * g8_ + 7]); }
#undef IDX_CNT4
                int pk = (int)(ca_ + cb_);
                pk += __builtin_amdgcn_update_dpp(0, pk, 0x111, 0xf, 0xf, false);
                pk += __builtin_amdgcn_update_dpp(0, pk, 0x112, 0xf, 0xf, false);
                pk += __builtin_amdgcn_update_dpp(0, pk, 0x114, 0xf, 0xf, false);
                pk += __builtin_amdgcn_update_dpp(0, pk, 0x118, 0xf, 0xf, false);
                pk += __builtin_amdgcn_update_dpp(0, pk, 0x142, 0xa, 0xf, false);
                unsigned tot = (unsigned)__builtin_amdgcn_readlane(pk, 31) + (unsigned)__builtin_amdgcn_readlane(pk, 63);
                { unsigned pt_; IDX_XCHG16(tot, pt_); tot += pt_; }
                const float gc = __log2f(fmaxf((float)tot, 0.5f)) - 8.f;
                if (tot == 256u) { xgt_ = cand; mt_ = 0u; done_ = true; }
                else { if (tot > 256u) { if (side_ == 1) ghi_ *= 0.5f; lo_ = cand; glo_ = gc; side_ = 1; }
                       else { if (side_ == 2) glo_ *= 0.5f; hi_ = cand; ghi_ = gc; chi_ = tot; side_ = 2; }
                       if (hi_ - lo_ == 1u) { xgt_ = hi_; xeq_ = lo_; mt_ = 256u - chi_; done_ = true; } }
            }
            { LAS unsigned* hist = (LAS unsigned*)(lds + IDX_CTL_OFF + 1024) + q * 256;
#pragma unroll 1
              for (int round = 0; round < 6 && !done_; ++round) {
                const unsigned wdt = hi_ - lo_;
                const int sh = wdt <= 256u ? 0 : 24 - (int)__builtin_clz(wdt - 1u);
                hist[128 * h + lane] = 0u; hist[128 * h + 64 + lane] = 0u;
                LDS_WAIT(); { unsigned d_; IDX_XCHG16(0u, d_); (void)d_; }
                const unsigned lov = lo_;
                IDX_FOR_LIVE( const unsigned d = r[il] - lov; if (d < wdt) __hip_atomic_fetch_add(hist + (d >> sh), 1u, __ATOMIC_RELAXED, __HIP_MEMORY_SCOPE_WORKGROUP); )
                LDS_WAIT(); { unsigned d_; IDX_XCHG16(0u, d_); (void)d_; }
                const u32x4 hb = *(const LAS u32x4*)(hist + 4 * lane);
                const unsigned s4 = (hb.x + hb.y) + (hb.z + hb.w);
                unsigned suf = s4;
#pragma unroll
                for (int o = 1; o < 64; o <<= 1) { const unsigned tv = (unsigned)__shfl_down((int)suf, o); if (lane + o < 64) suf += tv; }
                const unsigned long long okm = __ballot(chi_ + suf >= 256u);
                const int L = 63 - (int)__builtin_clzll(okm);
                const unsigned above = chi_ + (unsigned)__builtin_amdgcn_readlane((int)(suf - s4), L);
                const unsigned h0 = (unsigned)__builtin_amdgcn_readlane((int)hb.x, L), h1 = (unsigned)__builtin_amdgcn_readlane((int)hb.y, L),
                               h2 = (unsigned)__builtin_amdgcn_readlane((int)hb.z, L), h3 = (unsigned)__builtin_amdgcn_readlane((int)hb.w, L);
                unsigned Bsel, cab, cnb;
                if (above + h3 >= 256u) { Bsel = 3u; cab = above; cnb = h3; }
                else if (above + h3 + h2 >= 256u) { Bsel = 2u; cab = above + h3; cnb = h2; }
                else if (above + h3 + h2 + h1 >= 256u) { Bsel = 1u; cab = above + h3 + h2; cnb = h1; }
                else { Bsel = 0u; cab = above + h3 + h2 + h1; cnb = h0; }
                Bsel += 4u * (unsigned)L;
                const unsigned nlo = lo_ + (Bsel << sh); unsigned nhi = nlo + (1u << sh); if (nhi > hi_ || nhi < nlo) nhi = hi_;
                if (cab + cnb == 256u) { xgt_ = nlo; mt_ = 0u; done_ = true; }
                else if (sh == 0) { xgt_ = nlo + 1u; xeq_ = nlo; mt_ = 256u - cab; done_ = true; }
                else { lo_ = nlo; hi_ = nhi; chi_ = cab; }
              } }
#ifdef IDX_XTRA
#pragma unroll 1
            for (int xr = 0; xr < IDX_XTRA; ++xr) { unsigned dsum = 0; const unsigned cv = xgt_ + (unsigned)xr;
                IDX_FOR_LIVE( dsum += r[il] >= cv; )
                int pk = (int)dsum;
                pk += __builtin_amdgcn_update_dpp(0, pk, 0x111, 0xf, 0xf, false); pk += __builtin_amdgcn_update_dpp(0, pk, 0x112, 0xf, 0xf, false); pk += __builtin_amdgcn_update_dpp(0, pk, 0x114, 0xf, 0xf, false);
                pk += __builtin_amdgcn_update_dpp(0, pk, 0x118, 0xf, 0xf, false); pk += __builtin_amdgcn_update_dpp(0, pk, 0x142, 0xa, 0xf, false);
                unsigned tot = (unsigned)__builtin_amdgcn_readlane(pk, 31) + (unsigned)__builtin_amdgcn_readlane(pk, 63);
                { unsigned pt_; IDX_XCHG16(tot, pt_); tot += pt_; } asm volatile("" :: "s"(tot)); }
#endif
            T_ = xgt_;
            if (mt_ != 0u) {
                if (h == 0) { unsigned run = 0u;
#pragma unroll 1
                    for (int i = 0; i <= (jmax >> 1); ++i) { const bool ok_ = 2 * i + hh <= jmax; const unsigned kv = ok_ ? row[64 * i] : 0u; const bool eq = kv == xeq_; const unsigned long long bm = __ballot(eq);
                        const unsigned rank = run + __builtin_amdgcn_mbcnt_hi((unsigned)(bm >> 32), __builtin_amdgcn_mbcnt_lo((unsigned)bm, 0u));
                        if (eq && rank >= mt_) row[64 * i] = 0u;
                        run += (unsigned)__popcll(bm); } }
                T_ = xeq_;
            }
            }
#undef IDX_XCHG
#undef IDX_XCHG16
#undef IDX_FOR_LIVE
        }
        if (lane == 0 && h == 0) thr[q] = T_;
    }
#ifdef PROBE_VALU
    { float a0 = (float)lane, a1 = a0 + 1.f, a2 = a0 + 2.f, a3 = a0 + 3.f, a4 = a0 + 4.f, a5 = a0 + 5.f, a6 = a0 + 6.f, a7 = a0 + 7.f; const float m = 1.0000001f, c = 1e-9f;
#pragma unroll 1
      for (int it = 0; it < 64; ++it) {
#pragma unroll
          for (int u = 0; u < 8; ++u) { a0 = a0 * m + c; a1 = a1 * m + c; a2 = a2 * m + c; a3 = a3 * m + c; a4 = a4 * m + c; a5 = a5 * m + c; a6 = a6 * m + c; a7 = a7 * m + c; } }
      asm volatile("" :: "v"(a0), "v"(a1), "v"(a2), "v"(a3), "v"(a4), "v"(a5), "v"(a6), "v"(a7)); }
#endif
    LDS_WAIT(); __builtin_amdgcn_s_barrier(); asm volatile("" ::: "memory");
    { const unsigned tq0 = thr[hh], tq1 = thr[2 + hh];
#pragma unroll 4
      for (int j = wid; j <= ((t0 | 255) >> 5); j += 8) {
          bool s0 = false, s1 = false;
          if (j <= jmax) { s0 = SCO[hh * 8192 + 32 * j + r32] >= tq0; s1 = SCO[(2 + hh) * 8192 + 32 * j + r32] >= tq1; }
          const unsigned long long b0_ = __ballot(s0), b1_ = __ballot(s1);
          if (lane == 0) { u32x4 o; o.x = (unsigned)b0_; o.y = (unsigned)(b0_ >> 32); o.z = (unsigned)b1_; o.w = (unsigned)(b1_ >> 32); *(u32x4*)(BM + ((size_t)b * 256 + j) * S + t0) = o; }
      } }
    LDS_WAIT(); __builtin_amdgcn_s_barrier();
}
DEV void idx_phase(LAS unsigned char* lds, unsigned char* ws, int vcu, int G, int wid, int lane) {
    constexpr int NUNIT = T / 4;
    const bf16_t* IQ = (const bf16_t*)(ws + WS_IQ); const bf16_t* IK = (const bf16_t*)(ws + WS_IK); const float* IW = (const float*)(ws + WS_IW);
#define IDX_UNIT_OF(k) ((k) * G + (((k) & 1) ? G - 1 - vcu : vcu))
    bf16x8 afr[4], b0[4], b1[4]; float w[16];
    int un = IDX_UNIT_OF(0);
    if (un < NUNIT) { const int b = un / (S / 4); idx_prefetch(afr, w, b0, b1, IQ, IK, IW, b, (un - b * (S / 4)) * 4, wid, lane); }
#pragma unroll 1
    for (int k = 0; un < NUNIT; ++k) {
        const int b = un / (S / 4), t0 = (un - b * (S / 4)) * 4;
        const int nun = IDX_UNIT_OF(k + 1); const int nb = nun / (S / 4), nt0 = nun < NUNIT ? (nun - nb * (S / 4)) * 4 : -1;
        idx_unit(lds, IQ, IK, IW, (unsigned*)(ws + WS_BM), b, t0, nb, nt0, wid, lane, afr, w, b0, b1);
        un = nun;
    }
#undef IDX_UNIT_OF
}

DEV void kn_phase(const WaveId& W, const bf16_t* Kk, float* KN) {
    for (int item = W.gw; item < NB * 8 * (S / 64); item += W.ngw) {
        const int b = item / (8 * (S / 64)), h = (item / (S / 64)) & 7, tile = item % (S / 64);
        const bf16_t* kp = Kk + ((size_t)b * S + tile * 64 + W.lane) * 512 + h * 64;
        float ss = 0.f;
#pragma unroll
        for (int c = 0; c < 8; ++c) { const u32x4 v = *(const u32x4*)(kp + 8 * c);
#pragma unroll
            for (int e = 0; e < 4; ++e) { const float lo = __uint_as_float(v[e] << 16), hi = __uint_as_float(v[e] & 0xffff0000u); ss += lo * lo + hi * hi; } }
        const float m = wave_max(ss);
        if (W.lane == 0) KN[item] = sqrtf(m) * 1.01f;
    }
}

constexpr int DSA_STAGE = 8192 + 64 * VPITCH;
DEV void dsa_unit(LAS unsigned char* lds, const bf16_t* Q, const bf16_t* Kk, const bf16_t* V, const unsigned* BM, const float* KN, bf16_t* O, int b, int h, int qblk, int tid, int wid, int lane) {
    const int r32 = lane & 31, hi = lane >> 5, q0 = 256 * qblk, t0 = q0 + 32 * wid, t = t0 + r32; const size_t rowb = (size_t)b * S;
    bf16x8 qr[4]; { const bf16_t* qp = Q + (rowb + t) * 512 + h * 64 + 8 * hi;
#pragma unroll
        for (int d0 = 0; d0 < 4; ++d0) qr[d0] = *(const bf16x8*)(qp + 16 * d0); }
    f32x16 o0, o1, negm;
#pragma unroll
    for (int r = 0; r < 16; ++r) { o0[r] = 0.f; o1[r] = 0.f; negm[r] = 0.f; }
    float mref = 0.f, lsum = 0.f; bool seen = false;
    float qn; { float qs = 0.f;
#pragma unroll
        for (int d0 = 0; d0 < 4; ++d0)
#pragma unroll
            for (int e = 0; e < 8; ++e) { const float x = __uint_as_float(((unsigned)(unsigned short)qr[d0][e]) << 16); qs += x * x; }
        const auto rr = __builtin_amdgcn_permlane32_swap(__float_as_uint(qs), __float_as_uint(qs), false, false); qn = sqrtf(__uint_as_float(rr[0]) + __uint_as_float(rr[1])) * 1.01f; }
    constexpr float FASTB = 60.f;
    int zlane = 0; asm volatile("" : "+v"(zlane));
    const float* knp = KN + (b * 8 + h) * (S / 64) + zlane;
    float knv = knp[0];
    constexpr float THR = 8.f;
    const int ntile = (q0 + 256) / 64, wlast = (t0 + 31) >> 6;
    const int srow = tid >> 3, sch = tid & 7;
    const bf16_t* kg = Kk + (rowb + srow) * 512 + h * 64 + sch * 8; const bf16_t* vg = V + (rowb + srow) * 512 + h * 64 + sch * 8;
    const int kdst = srow * 128 + ((sch ^ (srow & 7)) * 16), vdst = srow * VPITCH + sch * 16;
    u32x4 kr0 = *(const u32x4*)kg, vr0 = *(const u32x4*)vg;
    *(LAS u32x4*)(lds + kdst) = kr0; *(LAS u32x4*)(lds + 8192 + vdst) = vr0;
    u32x4 kr1 = *(const u32x4*)(kg + (size_t)64 * 512), vr1 = *(const u32x4*)(vg + (size_t)64 * 512);
    const unsigned* bmp = BM + (size_t)b * 256 * S + t;
    unsigned mw0 = bmp[0], mw1 = bmp[(size_t)S];
    const int koff = r32 * 128;
    __syncthreads();
#define DSA_TILE(c, BUF, NBUF, KL, VL, KW, VW) do { \
        const LAS unsigned char* kt = lds + (BUF) * DSA_STAGE; const LAS unsigned char* vt = kt + 8192; \
        if ((c) + 2 < ntile) { KL = *(const u32x4*)(kg + (size_t)((c) + 2) * 64 * 512); VL = *(const u32x4*)(vg + (size_t)((c) + 2) * 64 * 512); } \
        unsigned nw0 = 0u, nw1 = 0u; float nkn = 0.f; \
        if ((c) + 1 <= wlast) { nw0 = bmp[(size_t)(2 * (c) + 2) * S]; nw1 = bmp[(size_t)(2 * (c) + 3) * S]; nkn = knp[(c) + 1]; } \
        if ((c) <= wlast) { \
            bf16x8 kf[8]; \
            _Pragma("unroll") for (int d0 = 0; d0 < 4; ++d0) { const int xo = ((2 * d0 + hi) ^ (r32 & 7)) * 16; \
                kf[2 * d0] = *(const LAS bf16x8*)(kt + koff + xo); kf[2 * d0 + 1] = *(const LAS bf16x8*)(kt + koff + 4096 + xo); } \
            asm volatile("" : "+v"(kf[0]), "+v"(kf[1]), "+v"(kf[2]), "+v"(kf[3]), "+v"(kf[4]), "+v"(kf[5]), "+v"(kf[6]), "+v"(kf[7]));     \
            f32x16 p0 = negm, p1 = negm; \
            _Pragma("unroll") for (int d0 = 0; d0 < 4; ++d0) { p0 = __builtin_amdgcn_mfma_f32_32x32x16_bf16(kf[2 * d0], qr[d0], p0, 0, 0, 0); p1 = __builtin_amdgcn_mfma_f32_32x32x16_bf16(kf[2 * d0 + 1], qr[d0], p1, 0, 0, 0); } \
            const unsigned m0 = mw0 >> (4 * hi), m1 = mw1 >> (4 * hi); \
            _Pragma("unroll") for (int r = 0; r < 16; ++r) { const int bit = (r & 3) + 8 * (r >> 2); \
                const unsigned e0 = (unsigned)__builtin_amdgcn_sbfe((int)m0, bit, 1), e1 = (unsigned)__builtin_amdgcn_sbfe((int)m1, bit, 1); \
                p0[r] = __uint_as_float((__float_as_uint(p0[r]) & e0) | (0xff800000u & ~e0)); p1[r] = __uint_as_float((__float_as_uint(p1[r]) & e1) | (0xff800000u & ~e1)); } \
            if (__any(!(qn * knv + fabsf(mref) <= FASTB))) {     \
                float rm = -INFINITY; \
                _Pragma("unroll") for (int r = 0; r < 16; r += 2) rm = fmaxf(rm, fmaxf(fmaxf(p0[r], p0[r + 1]), fmaxf(p1[r], p1[r + 1]))); \
                { const auto rr = __builtin_amdgcn_permlane32_swap(__float_as_uint(rm), __float_as_uint(rm), false, false); rm = fmaxf(__uint_as_float(rr[0]), __uint_as_float(rr[1])); } \
                const bool shift = rm > THR || (rm < -THR && rm > -INFINITY && !seen);     \
                if (__any(shift)) { \
                    const float dl = shift ? rm : 0.f, f = dl > 0.f ? __builtin_amdgcn_exp2f(-dl) : 1.f; \
                    mref += dl; lsum *= f; \
                    _Pragma("unroll") for (int r = 0; r < 16; ++r) { p0[r] -= dl; p1[r] -= dl; o0[r] *= f; o1[r] *= f; negm[r] = -mref; } \
                } \
            } \
            seen = seen || (mw0 | mw1) != 0u;     \
            float ps = 0.f; \
            _Pragma("unroll") for (int r = 0; r < 16; ++r) { p0[r] = __builtin_amdgcn_exp2f(p0[r]); p1[r] = __builtin_amdgcn_exp2f(p1[r]); ps += p0[r] + p1[r]; } \
            lsum += ps; \
            bf16x8 pk[4]; \
            pk[0] = pk8(p0[0], p0[1], p0[2], p0[3], p0[4], p0[5], p0[6], p0[7]); pk[1] = pk8(p0[8], p0[9], p0[10], p0[11], p0[12], p0[13], p0[14], p0[15]); \
            pk[2] = pk8(p1[0], p1[1], p1[2], p1[3], p1[4], p1[5], p1[6], p1[7]); pk[3] = pk8(p1[8], p1[9], p1[10], p1[11], p1[12], p1[13], p1[14], p1[15]); \
            pv_tile(o0, o1, vt, lane, pk); \
        } \
        mw0 = nw0; mw1 = nw1; knv = nkn; \
        if ((c) + 1 < ntile) { LAS unsigned char* nb = lds + (NBUF) * DSA_STAGE; *(LAS u32x4*)(nb + kdst) = KW; *(LAS u32x4*)(nb + 8192 + vdst) = VW; } \
        asm volatile("s_waitcnt lgkmcnt(0)" ::: "memory"); __builtin_amdgcn_s_barrier(); asm volatile("" ::: "memory"); } while (0)
#pragma unroll 1
    for (int c = 0; c < ntile; c += 2) { DSA_TILE(c, 0, 1, kr0, vr0, kr1, vr1); DSA_TILE(c + 1, 1, 0, kr1, vr1, kr0, vr0); }
#undef DSA_TILE
    { const auto rr = __builtin_amdgcn_permlane32_swap(__float_as_uint(lsum), __float_as_uint(lsum), false, false); lsum = __uint_as_float(rr[0]) + __uint_as_float(rr[1]); }
    store_ot(O + (rowb + t) * 512 + h * 64, o0, o1, hi, 1.f / lsum);
}
DEV void dsa_phase(LAS unsigned char* lds, unsigned char* ws, int vcu, int G, int tid, int wid, int lane, bf16_t* Oout) {
    constexpr int NPAIR = NB * 8 * 16;
    for (int pr = vcu; pr < NPAIR; pr += G) {
        const int bh = pr >> 4, s = pr & 15, b = bh >> 3, h = bh & 7;
#pragma unroll 1
        for (int k = 0; k < 2; ++k) {
            const int qblk = k == 0 ? s : 31 - s;
            dsa_unit(lds, (const bf16_t*)(ws + WS_QC), (const bf16_t*)(ws + WS_KC), (const bf16_t*)(ws + WS_VC), (const unsigned*)(ws + WS_BM), (const float*)(ws + WS_KN), Oout, b, h, qblk, tid, wid, lane);
        }
    }
}
#include <hip/hip_bf16.h>
namespace attn_body {
using bf16=__hip_bfloat16;
using bf16x8=__attribute__((ext_vector_type(8)))short;
using s16x4=__attribute__((ext_vector_type(4)))short;
using f32x16=__attribute__((ext_vector_type(16)))float;
using u32x4=__attribute__((ext_vector_type(4)))unsigned;
constexpr int BATCH=2,NHEAD=8,SEQ=8192,D=64,DM=NHEAD*D;
constexpr int NW=8,QBLK=32,QB=QBLK*NW,KVBLK=64,NQB=SEQ/QB;
constexpr int ATTN_PITCH=DM, ATTN_UNIT_ROWS=QB;
__device__ __forceinline__ int crow(int r,int hi){return (r&3)+8*(r>>2)+4*hi;}
#define SBAR() __builtin_amdgcn_sched_barrier(0)
__device__ __forceinline__ void cmask(f32x16&p0,f32x16&p1,int jb,int qrel,int hi){
  const float NEG=-INFINITY; int kb=64*jb+4*hi;
  #pragma unroll
  for(int r=0;r<16;++r){int kv=kb+(r&3)+8*(r>>2); if(kv>qrel)p0[r]=NEG; if(kv+32>qrel)p1[r]=NEG;}
}

constexpr int NSLOT=3, SLOTB=8192;
constexpr int LDS_K=0, LDS_V=NSLOT*SLOTB, LDS_WS=2*NSLOT*SLOTB, LDS_OST=LDS_WS+NW*64*4, LDS_BYTES=LDS_OST+NW*4096;
constexpr float C2=0.125f*1.4426950408889634f;
__device__ __forceinline__ void glds16(const void*gsrc,unsigned lds_dst){unsigned keep;
  asm volatile("s_mov_b32 %0, m0\n\ts_mov_b32 m0, %2\n\ts_nop 0\n\tglobal_load_lds_dwordx4 %1, off\n\ts_mov_b32 m0, %0":"=&s"(keep):"v"(gsrc),"s"(lds_dst):"memory");}
__device__ __forceinline__ float max3f(float a,float b,float c){float r;asm("v_max3_f32 %0, %1, %2, %3":"=v"(r):"v"(a),"v"(b),"v"(c));return r;}
__device__ __forceinline__ float max2f(float a,float b){float r;asm("v_max_f32_e32 %0, %1, %2":"=v"(r):"v"(a),"v"(b));return r;}
__device__ __forceinline__ float fadd_s(float a,float b){float r;asm("v_add_f32_e32 %0, %1, %2":"=v"(r):"v"(a),"v"(b));return r;}
__device__ __forceinline__ float fsub_s(float a,float b){float r;asm("v_sub_f32_e32 %0, %1, %2":"=v"(r):"v"(a),"v"(b));return r;}
typedef float f32x2_t __attribute__((ext_vector_type(2))); typedef __bf16 bf16x2_t __attribute__((ext_vector_type(2)));
__device__ __forceinline__ unsigned cvtpk_s(float lo,float hi){f32x2_t v={lo,hi};bf16x2_t b=__builtin_convertvector(v,bf16x2_t);return __builtin_bit_cast(unsigned,b);}
#define WAIT_BAR(N) asm volatile("s_waitcnt vmcnt(" #N ") lgkmcnt(0)\n\ts_barrier":::"memory")

__device__ __forceinline__ void qkt(f32x16&p0,f32x16&p1,const char*Kslot,const bf16x8*qr,const f32x16&negm,int r32,int hi){
  const char*kb=Kslot+hi*1024+r32*16;
  #pragma unroll
  for(int d0=0;d0<4;++d0){
    const bf16x8 b0=*reinterpret_cast<const bf16x8*>(kb+d0*2048);
    const bf16x8 b1=*reinterpret_cast<const bf16x8*>(kb+d0*2048+512);
    if(d0==0){p0=__builtin_amdgcn_mfma_f32_32x32x16_bf16(b0,qr[0],negm,0,0,0);p1=__builtin_amdgcn_mfma_f32_32x32x16_bf16(b1,qr[0],negm,0,0,0);}
    else{p0=__builtin_amdgcn_mfma_f32_32x32x16_bf16(b0,qr[d0],p0,0,0,0);p1=__builtin_amdgcn_mfma_f32_32x32x16_bf16(b1,qr[d0],p1,0,0,0);}}
}
typedef __attribute__((address_space(3))) const char* lds_cptr;
typedef short v4i16_t __attribute__((ext_vector_type(4)));
__device__ __forceinline__ void kload8(bf16x8*kf,lds_cptr kp){
  kf[0]=*(const __attribute__((address_space(3))) bf16x8*)(kp);      kf[1]=*(const __attribute__((address_space(3))) bf16x8*)(kp+512);
  kf[2]=*(const __attribute__((address_space(3))) bf16x8*)(kp+2048); kf[3]=*(const __attribute__((address_space(3))) bf16x8*)(kp+2560);
  kf[4]=*(const __attribute__((address_space(3))) bf16x8*)(kp+4096); kf[5]=*(const __attribute__((address_space(3))) bf16x8*)(kp+4608);
  kf[6]=*(const __attribute__((address_space(3))) bf16x8*)(kp+6144); kf[7]=*(const __attribute__((address_space(3))) bf16x8*)(kp+6656);
}
__device__ __forceinline__ void kload2(bf16x8*kf,lds_cptr kp,int j){ kf[2*j]=*(const __attribute__((address_space(3))) bf16x8*)(kp+j*2048); kf[2*j+1]=*(const __attribute__((address_space(3))) bf16x8*)(kp+j*2048+512); }
__device__ __forceinline__ s16x4 vtr(lds_cptr p){ return __builtin_bit_cast(s16x4,__builtin_amdgcn_ds_read_tr16_b64_v4i16((__attribute__((address_space(3))) v4i16_t*)p)); }
__device__ __forceinline__ float rowmax(const f32x16&p0,const f32x16&p1){
  float a=max3f(p0[0],p0[1],p1[0]),b=max3f(p0[2],p0[3],p1[1]);a=max3f(a,p1[2],p1[3]);
  #pragma unroll
  for(int r=4;r<16;r+=4){a=max3f(a,p0[r],p0[r+1]);b=max3f(b,p0[r+2],p0[r+3]);a=max3f(a,p1[r],p1[r+1]);b=max3f(b,p1[r+2],p1[r+3]);}
  const float m=max2f(a,b);
  auto rr=__builtin_amdgcn_permlane32_swap(__float_as_uint(m),__float_as_uint(m),false,false);
  return max2f(__uint_as_float(rr[0]),__uint_as_float(rr[1]));
}
__device__ __forceinline__ void pv(f32x16*o,int vb,bf16x8 pa0,bf16x8 pa1,bf16x8 pa2,bf16x8 pa3){
  #pragma unroll
  for(int d0=0;d0<2;++d0){s16x4 lo[4],hi[4];
    #pragma unroll
    for(int ks=0;ks<4;++ks){
      asm volatile("ds_read_b64_tr_b16 %0,%1 offset:%c2":"=&v"(lo[ks]):"v"(vb),"i"(d0*4096+ks*1024):"memory");
      asm volatile("ds_read_b64_tr_b16 %0,%1 offset:%c2":"=&v"(hi[ks]):"v"(vb),"i"(d0*4096+ks*1024+512):"memory");}
    asm volatile("s_waitcnt lgkmcnt(0)":::"memory");SBAR();
    #define PK(k) (bf16x8){lo[k][0],lo[k][1],lo[k][2],lo[k][3],hi[k][0],hi[k][1],hi[k][2],hi[k][3]}
    o[d0]=__builtin_amdgcn_mfma_f32_32x32x16_bf16(pa0,PK(0),o[d0],0,0,0);
    o[d0]=__builtin_amdgcn_mfma_f32_32x32x16_bf16(pa1,PK(1),o[d0],0,0,0);
    o[d0]=__builtin_amdgcn_mfma_f32_32x32x16_bf16(pa2,PK(2),o[d0],0,0,0);
    o[d0]=__builtin_amdgcn_mfma_f32_32x32x16_bf16(pa3,PK(3),o[d0],0,0,0);
    #undef PK
  }
}

#ifndef ATTN_STORE16
#define ATTN_STORE16(p,v) (*(u32x4*)(p)=(v))
#endif
template<int THRL> __device__ __forceinline__ void attn_unit(int b,int h,int qb,const bf16*Q,const bf16*__restrict__ K,const bf16*__restrict__ V,bf16*O,char*shm,const unsigned*__restrict__ BMb,const float*KNbh,const int tid){
  const int lane=tid&63,r32=lane&31,hi=lane>>5; const int wid=__builtin_amdgcn_readfirstlane(tid>>6);
  const long rowbase=(long)b*SEQ; const int q0=qb*QB;
  const bf16*Qw=Q+(rowbase+q0+wid*QBLK)*DM+h*D;
  const bf16*Kh=K+rowbase*DM+h*D,*Vh=V+rowbase*DM+h*D;
  const unsigned lds0=(unsigned)(uintptr_t)shm;
  float*wsf=(float*)(shm+LDS_WS)+wid*64;
  const bf16*ksrc=Kh+(long)lane*DM+wid*8;
  const bf16*vsrc=Vh+(long)(16*(wid&3)+(lane>>2))*DM+(wid>>2)*32+(lane&3)*8;
  const unsigned kdst=lds0+LDS_K+wid*1024, vdst=lds0+LDS_V+wid*1024;
  #define DMA_K(t,slot) glds16(ksrc+(long)(t)*KVBLK*DM,(unsigned)__builtin_amdgcn_readfirstlane(kdst+(slot)))
  #define DMA_V(t,slot) glds16(vsrc+(long)(t)*KVBLK*DM,(unsigned)__builtin_amdgcn_readfirstlane(vdst+(slot)))
  const int vb0=(int)(lds0+LDS_V)+((lane>>4)&1)*32+(lane&3)*8+(4*hi+((lane&15)>>2))*64;
  const char*Kbase=shm+LDS_K; bf16x8 kf[8];
  const lds_cptr shm3=(lds_cptr)shm; const lds_cptr kp0=shm3+LDS_K+hi*1024+r32*16; const lds_cptr vp0=shm3+LDS_V+((lane>>4)&1)*32+(lane&3)*8+(4*hi+((lane&15)>>2))*64;
  const int NT=(q0+QB)/KVBLK;
  DMA_K(0,0);DMA_V(0,0);DMA_K(1,SLOTB);
  bf16x8 qr[4];
  #pragma unroll
  for(int d0=0;d0<4;++d0)qr[d0]=*reinterpret_cast<const bf16x8*>(&Qw[(long)r32*DM+d0*16+hi*8]);
  const unsigned*bmp=BMb+(q0+wid*QBLK+r32);
  unsigned mwE0=bmp[0],mwE1=bmp[(size_t)SEQ],mwO0=0u,mwO1=0u;
  bool seen=false;
  float qn; { float qs=0.f;
    _Pragma("unroll") for(int d0=0;d0<4;++d0) _Pragma("unroll") for(int e=0;e<8;++e){ const float x=__uint_as_float(((unsigned)(unsigned short)qr[d0][e])<<16); qs+=x*x; }
    auto rr=__builtin_amdgcn_permlane32_swap(__float_as_uint(qs),__float_as_uint(qs),false,false); qn=__builtin_sqrtf(__uint_as_float(rr[0])+__uint_as_float(rr[1]))*1.01f; }
  constexpr float FASTB=60.f;
  int zlane=0; asm volatile("":"+v"(zlane));
  const float*knp=KNbh+zlane;
  float knE=knp[0],knO=0.f;
  bool anysel_=false;
  #define SLOWT(PS) (__any(!(qn*kn##PS<=FASTB)||mhat!=0.f))
  float mhat=0.f,l_reg=0.f;f32x16 o[2];o[0]=f32x16{};o[1]=f32x16{};const f32x16 zero16=f32x16{};
  const int qrel=wid*QBLK+r32;
  #define CMASK(P0,P1,SLOW,PS) do{ const unsigned m0_=mw##PS##0>>(4*hi), m1_=mw##PS##1>>(4*hi); anysel_=(mw##PS##0|mw##PS##1)!=0u; \
    if(SLOW){ _Pragma("unroll") for(int r=0;r<16;++r){ P0[r]-=mhat; P1[r]-=mhat; } } \
    _Pragma("unroll") for(int r=0;r<16;++r){ const int bit_=(r&3)+8*(r>>2); \
      const unsigned e0_=(unsigned)__builtin_amdgcn_sbfe((int)m0_,bit_,1), e1_=(unsigned)__builtin_amdgcn_sbfe((int)m1_,bit_,1); \
      P0[r]=__uint_as_float((__float_as_uint(P0[r])&e0_)|(0xff800000u&~e0_)); P1[r]=__uint_as_float((__float_as_uint(P1[r])&e1_)|(0xff800000u&~e1_)); } \
    }while(0)
  bool resc=false;
  #define START(P0,P1,SLOW) do{ resc=false; seen=anysel_; \
    if(SLOW){ const float rm=rowmax(P0,P1); const float dl=(rm==-INFINITY)?0.f:rm; mhat=fadd_s(mhat,dl); \
      _Pragma("unroll") for(int r=0;r<16;++r){P0[r]=fsub_s(P0[r],dl);P1[r]=fsub_s(P1[r],dl);} \
      } \
    _Pragma("unroll") for(int r=0;r<16;++r)P0[r]=__builtin_amdgcn_exp2f(P0[r]); }while(0)
  #define RESC() do{ if(resc){ asm volatile("s_waitcnt lgkmcnt(0)":::"memory"); \
      _Pragma("unroll") for(int d_=0;d_<2;++d_) _Pragma("unroll") for(int r=0;r<16;++r)o[d_][r]*=wsf[crow(r,hi)]; } }while(0)
  f32x16 pA0,pA1,pB0,pB1;
  int sl_prev=0,sl_cur=0,sl_next=SLOTB;
  #define ROT() do{sl_prev=sl_cur;sl_cur=sl_next;sl_next=(sl_next==(NSLOT-1)*SLOTB)?0:sl_next+SLOTB;}while(0)
  DMA_K(2,2*SLOTB);
  WAIT_BAR(3);
  { mwO0=bmp[(size_t)2*SEQ]; mwO1=bmp[(size_t)3*SEQ]; knO=knp[1];
  const bool slow0_=SLOWT(E);
  qkt(pA0,pA1,Kbase,qr,zero16,r32,hi);asm volatile("s_nop 15\n\ts_nop 7":"+v"(pA0),"+v"(pA1));CMASK(pA0,pA1,slow0_,E);
  START(pA0,pA1,slow0_); }
  _Pragma("unroll") for(int r=0;r<16;++r)pA1[r]=__builtin_amdgcn_exp2f(pA1[r]);
  WAIT_BAR(0);
  DMA_K(3,0);DMA_V(1,SLOTB);
  ROT();
  kload8(kf,kp0+sl_cur);
  WAIT_BAR(2);
  s16x4 vlo[8],vhi[8]; u32x4 pw0,pw1,pw2,pw3;
  #define PKW(P,B) cvtpk_s(P[B],P[B+1])
  #define PAF(k) __builtin_bit_cast(bf16x8,pw##k)
  #define VFR(i) (bf16x8){vlo[i][0],vlo[i][1],vlo[i][2],vlo[i][3],vhi[i][0],vhi[i][1],vhi[i][2],vhi[i][3]}
  #define PIN(x) asm volatile("":"+v"(x))
  #define MX3(a,b,c) __builtin_fmaxf(__builtin_fmaxf((a),(b)),(c))
  #define GAPA(MF,A0,A1,A2,A3,W0,W1,PW) do{ MF; sacc+=A0; sacc+=A1; sacc+=A2; sacc+=A3; PIN(sacc); W0; W1; PIN(PW); SBAR(); }while(0)
  #define EX(v) __builtin_amdgcn_exp2f(v)
  #define GAPB(MF,X,B) do{ MF; X[B]=EX(X[B]); X[B+1]=EX(X[B+1]); X[B+2]=EX(X[B+2]); X[B+3]=EX(X[B+3]); PIN(X); SBAR(); }while(0)
  #define VRD(i) do{ vlo[i]=vtr(vp_+(((i)>>2)*4096+((i)&3)*1024)); vhi[i]=vtr(vp_+(((i)>>2)*4096+((i)&3)*1024+512)); }while(0)
  #define KRD(G,j) do{ if(G){ kload2(kf,kp0+sl_next,j); SBAR(); } }while(0)
  #define STEP(C0,C1,P0,P1,t,GK,GV,GL,PS,NS) do{ SBAR(); \
    if((t)+1<NT){ mw##NS##0=bmp[(size_t)(2*(t)+2)*SEQ]; mw##NS##1=bmp[(size_t)(2*(t)+3)*SEQ]; kn##NS=knp[(t)+1]; }     \
    const lds_cptr vp_=vp0+sl_prev; \
    VRD(0); SBAR(); float sacc=(P0[0]+P0[1]); \
    GAPA(C0=__builtin_amdgcn_mfma_f32_32x32x16_bf16(kf[0],qr[0],zero16,0,0,0), P0[2],P0[3],P0[4],P0[5],     pw0[0]=PKW(P0,0), pw0[1]=PKW(P0,2), pw0); \
    VRD(4); SBAR(); GAPA(C1=__builtin_amdgcn_mfma_f32_32x32x16_bf16(kf[1],qr[0],zero16,0,0,0), P0[6],P0[7],P0[8],P0[9],     pw0[2]=PKW(P0,4), pw0[3]=PKW(P0,6), pw0); \
    VRD(1); SBAR(); GAPA(C0=__builtin_amdgcn_mfma_f32_32x32x16_bf16(kf[2],qr[1],C0,0,0,0),   P0[10],P0[11],P0[12],P0[13], pw1[0]=PKW(P0,8), pw1[1]=PKW(P0,10), pw1); \
    VRD(5); SBAR(); GAPA(C1=__builtin_amdgcn_mfma_f32_32x32x16_bf16(kf[3],qr[1],C1,0,0,0),   P0[14],P0[15],P1[0],P1[1],   pw1[2]=PKW(P0,12),pw1[3]=PKW(P0,14), pw1); \
    VRD(2); SBAR(); GAPA(C0=__builtin_amdgcn_mfma_f32_32x32x16_bf16(kf[4],qr[2],C0,0,0,0),   P1[2],P1[3],P1[4],P1[5],     pw2[0]=PKW(P1,0), pw2[1]=PKW(P1,2), pw2); \
    VRD(6); SBAR(); GAPA(C1=__builtin_amdgcn_mfma_f32_32x32x16_bf16(kf[5],qr[2],C1,0,0,0),   P1[6],P1[7],P1[8],P1[9],     pw2[2]=PKW(P1,4), pw2[3]=PKW(P1,6), pw2); \
    VRD(3); SBAR(); GAPA(C0=__builtin_amdgcn_mfma_f32_32x32x16_bf16(kf[6],qr[3],C0,0,0,0),   P1[10],P1[11],P1[12],P1[13], pw3[0]=PKW(P1,8), pw3[1]=PKW(P1,10), pw3); \
    VRD(7); SBAR(); GAPA(C1=__builtin_amdgcn_mfma_f32_32x32x16_bf16(kf[7],qr[3],C1,0,0,0),   P1[14],P1[15],0.f,0.f,       pw3[2]=PKW(P1,12),pw3[3]=PKW(P1,14), pw3); \
    l_reg+=sacc; \
    if(GK){DMA_K((t)+3,sl_cur);} if(GV){DMA_V((t)+1,sl_next);} \
    const bool slow_=SLOWT(PS); CMASK(C0,C1,slow_,PS); resc=false; \
    if(__builtin_expect(slow_,0)){ float a=MX3(C0[0],C0[1],C1[0]),b=MX3(C0[2],C0[3],C1[1]); a=MX3(a,C1[2],C1[3]); \
      _Pragma("unroll") for(int r=4;r<16;r+=4){a=MX3(a,C0[r],C0[r+1]);b=MX3(b,C0[r+2],C0[r+3]);a=MX3(a,C1[r],C1[r+1]);b=MX3(b,C1[r+2],C1[r+3]);} \
      float rm=__builtin_fmaxf(a,b); { auto rr=__builtin_amdgcn_permlane32_swap(__float_as_uint(rm),__float_as_uint(rm),false,false); rm=__builtin_fmaxf(__uint_as_float(rr[0]),__uint_as_float(rr[1])); } \
      const bool fresh_=!seen&&rm>-INFINITY;     \
      if(__builtin_expect(__any(rm>(float)THRL||(fresh_&&rm<-(float)THRL)),0)){ const float dl=fresh_?rm:__builtin_fmaxf(rm,0.f); mhat+=dl; \
        _Pragma("unroll") for(int r=0;r<16;++r){C0[r]-=dl;C1[r]-=dl;} \
        const float f=dl>0.f?__builtin_amdgcn_exp2f(-dl):1.f; l_reg*=f; if(hi==0)wsf[r32]=f; resc=true; } } \
    seen=seen||anysel_; \
    SBAR(); \
    GAPB(o[0]=__builtin_amdgcn_mfma_f32_32x32x16_bf16(PAF(0),VFR(0),o[0],0,0,0), C0,0); \
    GAPB(o[1]=__builtin_amdgcn_mfma_f32_32x32x16_bf16(PAF(0),VFR(4),o[1],0,0,0), C0,4); \
    KRD(GL,0); GAPB(o[0]=__builtin_amdgcn_mfma_f32_32x32x16_bf16(PAF(1),VFR(1),o[0],0,0,0), C0,8); \
    KRD(GL,1); GAPB(o[1]=__builtin_amdgcn_mfma_f32_32x32x16_bf16(PAF(1),VFR(5),o[1],0,0,0), C0,12); \
    KRD(GL,2); GAPB(o[0]=__builtin_amdgcn_mfma_f32_32x32x16_bf16(PAF(2),VFR(2),o[0],0,0,0), C1,0); \
    KRD(GL,3); GAPB(o[1]=__builtin_amdgcn_mfma_f32_32x32x16_bf16(PAF(2),VFR(6),o[1],0,0,0), C1,4); \
    GAPB(o[0]=__builtin_amdgcn_mfma_f32_32x32x16_bf16(PAF(3),VFR(3),o[0],0,0,0), C1,8); \
    GAPB(o[1]=__builtin_amdgcn_mfma_f32_32x32x16_bf16(PAF(3),VFR(7),o[1],0,0,0), C1,12); \
    }while(0)
  int t=1;
  for(;t+5<NT;t+=2){
    STEP(pB0,pB1,pA0,pA1,t,true,true,true,O,E);     WAIT_BAR(2); RESC(); ROT();
    STEP(pA0,pA1,pB0,pB1,t+1,true,true,true,E,O);   WAIT_BAR(2); RESC(); ROT();
  }
  #define ENDW(tt) do{ if((tt)+3<NT){WAIT_BAR(2);} else if((tt)+2<NT){WAIT_BAR(1);} else {WAIT_BAR(0);} }while(0)
  for(;t+1<NT;t+=2){
    STEP(pB0,pB1,pA0,pA1,t,(t+3<NT),(t+1<NT),(t+1<NT),O,E);       ENDW(t);   RESC(); ROT();
    STEP(pA0,pA1,pB0,pB1,t+1,(t+4<NT),(t+2<NT),(t+2<NT),E,O);     ENDW(t+1); RESC(); ROT();
  }
  STEP(pB0,pB1,pA0,pA1,NT-1,false,false,false,O,E); RESC();
  { float sacc=pB0[0]+pB0[1]; _Pragma("unroll") for(int r=2;r<16;++r)sacc+=pB0[r]; _Pragma("unroll") for(int r=0;r<16;++r)sacc+=pB1[r]; l_reg+=sacc;
    pw0=(u32x4){PKW(pB0,0),PKW(pB0,2),PKW(pB0,4),PKW(pB0,6)};pw1=(u32x4){PKW(pB0,8),PKW(pB0,10),PKW(pB0,12),PKW(pB0,14)};pw2=(u32x4){PKW(pB1,0),PKW(pB1,2),PKW(pB1,4),PKW(pB1,6)};pw3=(u32x4){PKW(pB1,8),PKW(pB1,10),PKW(pB1,12),PKW(pB1,14)};
    SBAR(); pv(o,vb0+sl_cur,PAF(0),PAF(1),PAF(2),PAF(3)); }
  #undef PKW
  #undef PAF
  #undef VFR
  #undef PIN
  #undef MX3
  #undef GAPA
  #undef GAPB
  #undef EX
  #undef VRD
  #undef KRD
  #undef STEP
  #undef ENDW
  {auto rr=__builtin_amdgcn_permlane32_swap(__float_as_uint(l_reg),__float_as_uint(l_reg),false,false);l_reg=__uint_as_float(rr[0])+__uint_as_float(rr[1]);}
  if(hi==0)wsf[32+r32]=l_reg;asm volatile("s_waitcnt lgkmcnt(0)":::"memory");
  float rli[16];
  #pragma unroll
  for(int r=0;r<16;++r)rli[r]=__builtin_amdgcn_rcpf(wsf[32+crow(r,hi)]);
  bf16*Ow=O+(rowbase+q0+wid*QBLK)*DM+h*D;
  { bf16*stg=(bf16*)(shm+LDS_OST)+wid*2048;
    #pragma unroll
    for(int r=0;r<16;++r){const int orow=crow(r,hi);
      #pragma unroll
      for(int d0=0;d0<2;++d0)stg[orow*64+d0*32+r32]=__float2bfloat16(o[d0][r]*rli[r]);}
    asm volatile("s_waitcnt lgkmcnt(0)":::"memory");
    #pragma unroll
    for(int i=0;i<4;++i){const int row=i*8+(lane>>3),ch=lane&7; const u32x4 v=*(const u32x4*)(stg+row*64+ch*8); ATTN_STORE16(Ow+(long)row*DM+ch*8,v);} }
  asm volatile("s_waitcnt lgkmcnt(0)\n\ts_barrier":::"memory");
  #undef DMA_K
  #undef DMA_V
  #undef CMASK
  #undef SLOWT
  #undef START
  #undef RESC
  #undef ROT
}
constexpr int ATTN_LDS_BYTES=LDS_BYTES;
#undef SBAR
#undef WAIT_BAR
}
constexpr int MK_THREADS = 512;
constexpr int RING_BYTES = 131072, MISC_OFF = RING_BYTES + 320, MK_LDS_BYTES = 147456;
constexpr size_t WS_CTL = 0, CTL_ZERO_BYTES = 65536 + 7 * 131072; constexpr int CW_BAR = 4096;
constexpr int PH_PREP0 = 0, PH_L0 = 1, PH_PER_LAYER = 14, NPH = PH_L0 + 2 * PH_PER_LAYER;
enum { Q_INPROJ = 0, Q_SBIDX, Q_DSA, Q_GATES, Q_MERGE, Q_MIX, Q_NORMXA, Q_XALOG, Q_XAOUT, Q_NORMFFN, Q_UP, Q_FFNMID, Q_DOWN, Q_NEXT };

#ifndef QBUILD
#define QBUILD 0xffffu
#endif
#define QON(x) ((QBUILD >> (x)) & 1u)
struct Args { const float* in[20]; float* out; unsigned char* ws; int ph_lo, ph_hi; };

__global__ void __launch_bounds__(MK_THREADS, 2) mk_fwd(Args args) {
    __shared__ __attribute__((aligned(16))) unsigned char lds_raw[MK_LDS_BYTES];
    LAS unsigned char* lds = (LAS unsigned char*)lds_raw;
    volatile LAS unsigned* MISC = (volatile LAS unsigned*)(lds + MISC_OFF);
    const int G = gridDim.x, bx = blockIdx.x;
    unsigned char* ws0 = args.ws;
    const int wave_s = __builtin_amdgcn_readfirstlane((int)threadIdx.x >> 6);
    for (int u = mk_tid(wave_s); u < (MK_LDS_BYTES - RING_BYTES) / 4; u += MK_THREADS) ((LAS unsigned*)(lds + RING_BYTES))[u] = 0u;
    __syncthreads();
    const int lo = args.ph_lo, hi = args.ph_hi;
    XcdBarrier bar; bar.bar = (unsigned*)(ws0 + WS_CTL) + CW_BAR; bar.x = 0; bar.st = nullptr;
    if (hi - lo > 1) bar = xcd_barrier_post((unsigned*)(ws0 + WS_CTL) + CW_BAR, MISC + 8, mk_tid(wave_s));
#define BPW(off) ((bf16_t*)(ws + (off)))
    const int vcu = (G % 8 == 0) ? (bx % 8) * (G / 8) + bx / 8 : bx;
    for (int p = lo; p < hi; ++p) {
#ifdef PROBE_REP
        const int reps = (p >= PH_L0 && ((PROBE_REP >> ((p - PH_L0) % PH_PER_LAYER)) & 1)) ? 2 : 1;
#else
        const int reps = 1;
#endif
#ifdef PROBE_REP
#pragma unroll 1
        for (int rep = 0; rep < reps; ++rep) {
        const bool dry = rep + 1 < reps;
#else
        { constexpr bool dry = false;
#endif
        int oz = 0; asm volatile("" : "+s"(oz));
        int tid = mk_tid(wave_s); asm volatile("" : "+v"(tid));
        const int wave = __builtin_amdgcn_readfirstlane(tid >> 6), lane = tid & 63;
        WaveId W; W.gw = vcu * 8 + wave; W.ngw = G * 8; W.wave = wave; W.lane = lane;
        unsigned char* ws = args.ws + oz; float* X = args.out + oz;
#define INP(k) (args.in[(k) + oz])
        if (p == PH_PREP0) {
            prep0_phase(W, (LAS float*)(lds + wave * 16384), ws, args.in + oz, (bf16_t*)X);
        } else if (p >= PH_L0) {
            const int l = (p - PH_L0) / PH_PER_LAYER, q = (p - PH_L0) % PH_PER_LAYER;
            const float* Xin = l == 0 ? INP(0) : X;
            pg8::u64* SSb = (pg8::u64*)(ws + WS_SS);
#define SSA(i) (SSb + (size_t)(i) * T)
            if (q == Q_SBIDX) {
#ifndef NO_SB
                sb_phase(W, lds, ws, dry);
#endif
                __syncthreads();
#ifndef NO_IDX
#ifdef PROBE_SB_ONLY
                if (!dry)
#endif
                idx_phase(lds, ws, vcu, G, wave, lane);
#endif
                conv_sc_phase(vcu * MK_THREADS + tid, G * MK_THREADS, BPW(WS_SCB), BPW(WS_CX), INP(4) + l * 3 * 512, dry);
                kn_phase(W, BPW(WS_KC), (float*)(ws + WS_KN));
                if (l == 0 && !dry && QON(15)) {
                    __syncthreads();
                    { pg8::Order S; S.init(1, 4, 16, G, bx); pg8::PtrG P{(const char*)(ws + WS_KVM), (const char*)(ws + WS_WQ)}; pg8::EpiPrep E{ws, 1};
                      pg8::gemm_phase<pg8::EpiPrep, pg8::PtrG, true, true>(lds, tid, 2 * D, D, 256, S, P, E); }
                    { pg8::Order S; S.init(4, 1, 16, G, (bx + 64) % G); pg8::PtrH P{(const char*)(ws + WS_KVM), (const char*)(ws + WS_WOT)}; pg8::EpiPrep E{ws, 2};
                      pg8::gemm_phase<pg8::EpiPrep, pg8::PtrH, true, true>(lds, tid, D, 2 * D, 256, S, P, E); }
                }
            } else if (q == Q_DSA) {
#ifndef NO_DSA
                {
                    for (int pr = vcu; pr < NB * 8 * 16; pr += G) { const int bh = pr >> 4, sx = pr & 15, bb = bh >> 3, hh = bh & 7;
#pragma unroll 1
                        for (int k2 = 0; k2 < 2; ++k2)
                            attn_body::attn_unit<8>(bb, hh, k2 == 0 ? sx : 31 - sx, (const attn_body::bf16*)BPW(WS_QC), (const attn_body::bf16*)BPW(WS_KC), (const attn_body::bf16*)BPW(WS_VC),
                                                    (attn_body::bf16*)(dry ? BPW(WS_KA) : BPW(WS_QC)), (char*)lds_raw, (const unsigned*)(ws + WS_BM) + (size_t)bb * 256 * S,
                                                    (const float*)(ws + WS_KN) + bh * (S / 64), tid); }
                }
#endif
            } else if (q == Q_FFNMID) {
                if (!dry) ffn_fix_phase(vcu * MK_THREADS + tid, G * MK_THREADS, BPW(WS_SIDEA), BPW(WS_SIDEU), BPW(WS_FU), INP(16) + l * 3 * DFF, INP(17) + l * DFF);
            } else if (q == Q_NEXT) {
                if (l + 1 < DEPTH) { int base = 0; convert_layer_weights(W, (LAS float*)(lds + wave * 16384), base, ws, args.in + oz, l + 1); }
                else if (!dry) final_norm(W, BPW(WS_XN), X, INP(19), SSA(6));
            } else if (q == Q_INPROJ && QON(Q_INPROJ)) {
                pg8::Order S; S.init(T / 256, NIN / 256, 1, G, bx);
                pg8::PtrStd P{(const char*)X, (const char*)(ws + WS_WIN), 0, 0, 0, (size_t)256 * D * 2, (size_t)256 * D * 2};
                pg8::EpiInProj E{ws, SSA(3 * l)};
                pg8::gemm_phase<pg8::EpiInProj, pg8::PtrStd, true, true>(lds, tid, D, D, D, S, P, E);
                if (l == 0 && !dry && QON(14)) {
                    pg8::Order S2; S2.init(2, 8, 2, G, (bx + G - 64) % G);
                    pg8::PtrStd P2{(const char*)(ws + WS_MEMN), (const char*)(ws + WS_WKVT), 1 * MiB, 4 * MiB, 0, (size_t)256 * D * 2, (size_t)256 * D * 2};
                    pg8::EpiPrep E2{ws, 0};
                    pg8::gemm_phase<pg8::EpiPrep, pg8::PtrStd, true, true>(lds, tid, D, D, D, S2, P2, E2);
                }
            } else if (q == Q_GATES && QON(Q_GATES)) {
                pg8::Order S; S.init(T / 256, 12, 1, G, bx);
                pg8::PtrStd P{(const char*)X, (const char*)(ws + WS_WG), 0, 0, 0, (size_t)256 * D * 2, (size_t)256 * D * 2};
                pg8::EpiGates E{BPW(WS_GATES), SSA(3 * l)};
                pg8::gemm_phase<pg8::EpiGates, pg8::PtrStd, true, true>(lds, tid, D, D, D, S, P, E);
            } else if (q == Q_MERGE && QON(Q_MERGE)) {
                pg8::Order S; S.init(T / 256, 4, 3, G, bx);
                pg8::PtrStd P{(const char*)(ws + WS_QA), (const char*)(ws + WS_WBR), 16 * MiB, (size_t)D * 512 * 2, 0, (size_t)256 * 512 * 2, (size_t)256 * 512 * 2};
                pg8::EpiMerge E{BPW(WS_XN), BPW(WS_GATES)};
                pg8::gemm_phase<pg8::EpiMerge, pg8::PtrStd, true, true>(lds, tid, 512, 512, 512, S, P, E);
            } else if (q == Q_MIX && QON(Q_MIX)) {
                pg8::Order S; S.init(T / 256, 4, 1, G, bx);
                pg8::PtrStd P{(const char*)(ws + WS_XN), (const char*)(ws + WS_WMIX), 0, 0, 0, (size_t)256 * D * 2, (size_t)256 * D * 2};
                if (l == 0) { pg8::EpiResid<true> E{(const void*)INP(0), dry ? BPW(WS_FU) : BPW(WS_XBXA), dry ? SSA(0) : SSA(1)};
                    pg8::gemm_phase<pg8::EpiResid<true>, pg8::PtrStd, true, true>(lds, tid, D, D, D, S, P, E); }
                else { pg8::EpiResid<false> E{(const void*)X, dry ? BPW(WS_FU) : BPW(WS_XBXA), dry ? SSA(0) : SSA(4)};
                    pg8::gemm_phase<pg8::EpiResid<false>, pg8::PtrStd, true, true>(lds, tid, D, D, D, S, P, E); }

            } else if (q == Q_XALOG && QON(Q_XALOG)) {
                pg8::Order S; S.init(T / 256, 4, 1, G, bx);
                pg8::PtrStd P{(const char*)(ws + WS_XBXA), (const char*)(ws + WS_GT + (size_t)l * 4 * MiB), 0, 0, 2 * MiB, (size_t)256 * D * 2, (size_t)256 * D * 2};
                pg8::EpiSoftmax E{BPW(WS_PXA), SSA(1 + 3 * l)};
                pg8::gemm_phase<pg8::EpiSoftmax, pg8::PtrStd, false, true>(lds, tid, D, D, D, S, P, E);
            } else if (q == Q_XAOUT && QON(Q_XAOUT)) {
                pg8::Order S; S.init(T / 256, 4, 1, G, bx);
                pg8::PtrStd P{(const char*)(ws + WS_PXA), (const char*)(ws + WS_HT + (size_t)l * 4 * MiB), 0, 0, 2 * MiB, (size_t)256 * D * 2, (size_t)256 * D * 2};
                pg8::EpiResid<false> E{(const void*)BPW(WS_XBXA), dry ? BPW(WS_FU) : BPW(WS_XN), dry ? SSA(0) : SSA(2 + 3 * l)};
                pg8::gemm_phase<pg8::EpiResid<false>, pg8::PtrStd, true, true>(lds, tid, D, D, D, S, P, E);
            } else if (q == Q_UP && QON(Q_UP)) {
                pg8::Order S; S.init(T / 256, 22, 1, G, bx);
                pg8::PtrStd P{(const char*)(ws + WS_XN), (const char*)(ws + WS_WUP), 0, 0, 0, (size_t)256 * D * 2, (size_t)256 * D * 2};
                pg8::EpiUpF E{BPW(WS_FU), BPW(WS_SIDEA), BPW(WS_SIDEU), SSA(2 + 3 * l), INP(16) + l * 3 * DFF, INP(17) + l * DFF};
                pg8::gemm_phase<pg8::EpiUpF, pg8::PtrStd, true, true>(lds, tid, D, D, D, S, P, E);
            } else if (q == Q_DOWN && QON(Q_DOWN)) {
                pg8::Order S; S.init(T / 256, 4, 1, G, bx);
                pg8::PtrStd P{(const char*)(ws + WS_FU), (const char*)(ws + WS_WDOWN), 0, 0, 0, (size_t)256 * DFF * 2, (size_t)256 * DFF * 2};
                pg8::EpiResid<false> E{(const void*)BPW(WS_XN), dry ? BPW(WS_QA) : (l + 1 < DEPTH ? (bf16_t*)X : BPW(WS_XN)), dry ? SSA(0) : SSA(3 + 3 * l)};
                pg8::gemm_phase<pg8::EpiResid<false>, pg8::PtrStd, true, true>(lds, tid, DFF, DFF, DFF, S, P, E);
            }
        }
        }
        if (p + 1 < hi && !(p >= PH_L0 && ((p - PH_L0) % PH_PER_LAYER == Q_NORMXA || (p - PH_L0) % PH_PER_LAYER == Q_NORMFFN))) xcd_barrier(bar, mk_tid(wave_s));
    }
}

extern "C" void kernel_launch(void* const* d_in, const int* in_sizes, int n_in, void* d_out, int out_size, void* d_ws, size_t ws_size, hipStream_t st) {
    if (n_in != 20 || ws_size < WS_NEED || out_size != T * D) { fprintf(stderr, "kernel_launch: unexpected sizes n_in %d ws %zu out %d\n", n_in, ws_size, out_size); return; }
    static int grid = 0;
    if (grid == 0) {
        int dev = 0, cus = 0, per_cu = 0;
        (void)hipGetDevice(&dev); (void)hipDeviceGetAttribute(&cus, hipDeviceAttributeMultiprocessorCount, dev);
        if (hipOccupancyMaxActiveBlocksPerMultiprocessor(&per_cu, (const void*)mk_fwd, MK_THREADS, 0) != hipSuccess || per_cu < 1) { fprintf(stderr, "kernel_launch: occupancy query says %d blocks/CU\n", per_cu); grid = -1; return; }
        (void)hipGetLastError();
        if (cus != 256) { fprintf(stderr, "kernel_launch: built for a 256-CU device, found %d\n", cus); grid = -1; return; }
        grid = cus;
    }
    if (grid < 0) return;
    (void)hipMemsetAsync((char*)d_ws + WS_CTL, 0, CTL_ZERO_BYTES, st);
    Args a{};
    for (int i = 0; i < 20; ++i) a.in[i] = (const float*)d_in[i];
    a.out = (float*)d_out; a.ws = (unsigned char*)d_ws; a.ph_lo = 0; a.ph_hi = NPH;
    hipLaunchKernelGGL(mk_fwd, dim3(grid), dim3(MK_THREADS), 0, st, a);
}
```

```cpp
#include <hip/hip_runtime.h>
#include <stdint.h>
#include <stdio.h>

typedef unsigned short bf16_t;
typedef short bf16x8 __attribute__((ext_vector_type(8)));
typedef float f32x16 __attribute__((ext_vector_type(16)));
typedef float f32x4 __attribute__((ext_vector_type(4)));
#define DEV __device__ __forceinline__

constexpr int NB = 2, S = 8192, D = 1024, T = NB * S, DEPTH = 2;
constexpr int DIN = 8264, DFF = 2816, MEM = 256;
constexpr int NIN = 5376;
constexpr float LOG2E = 1.4426950408889634f;
constexpr float QSCALE = 0.125f * LOG2E;
constexpr float WSCALE = 0.125f * 0.35355339059327373f;
constexpr float XSCALE = 0.0625f * LOG2E;
constexpr float EPS = 1e-6f;
#ifndef MK_FUSE
#define MK_FUSE 1
#endif

constexpr size_t MiB = 1u << 20;
constexpr size_t WS_SIDEA = 88 * MiB, WS_SIDEU = 96 * MiB;
constexpr size_t WS_KN = 983040;
constexpr size_t WS_GT = 1 * MiB;
constexpr size_t WS_HT = 9 * MiB;
constexpr size_t WS_WUP = 17 * MiB, WS_WDOWN = 28 * MiB;
constexpr size_t WS_XN = 34 * MiB;
constexpr size_t WS_WMIX = 66 * MiB, WS_WBR = 68 * MiB, WS_WG = 71 * MiB, WS_WIN = 77 * MiB;
constexpr size_t WS_QA = 88 * MiB, WS_SCB = 104 * MiB, WS_QC = 120 * MiB, WS_KA = 136 * MiB, WS_VA = 152 * MiB, WS_KC = 168 * MiB, WS_VC = 184 * MiB,
                 WS_IQ = 200 * MiB, WS_CX = 216 * MiB, WS_IK = 232 * MiB, WS_IW = 234 * MiB, WS_BM = 235 * MiB;
constexpr size_t WS_GATES = 136 * MiB;
constexpr size_t WS_XTMP = 235 * MiB;
constexpr size_t WS_LOG = 88 * MiB, WS_PXA = 168 * MiB;
constexpr size_t WS_XBXA = 136 * MiB;
constexpr size_t WS_SS = 65536;
constexpr size_t WS_FA = 66 * MiB, WS_FU = 154 * MiB;
constexpr size_t WS_WQ = 34 * MiB  , WS_WOT = 38 * MiB  , WS_WKVT = 42 * MiB  , WS_MEMN = 50 * MiB  , WS_KVM = 52 * MiB  ;
constexpr size_t WS_NEED = 256 * MiB;

DEV bf16_t f2bf(float f) { unsigned u = __float_as_uint(f); u += 0x7fffu + ((u >> 16) & 1u); return (bf16_t)(u >> 16); }
DEV float bf2f(bf16_t h) { return __uint_as_float(((unsigned)h) << 16); }
DEV float wave_sum(float v) {
#pragma unroll
    for (int o = 1; o < 64; o <<= 1) v += __shfl_xor(v, o);
    return v;
}
DEV float wave_max(float v) {
#pragma unroll
    for (int o = 1; o < 64; o <<= 1) v = fmaxf(v, __shfl_xor(v, o));
    return v;
}


#define LAS __attribute__((address_space(3)))
#define GAS __attribute__((address_space(1)))
typedef unsigned u32x4 __attribute__((ext_vector_type(4)));
typedef unsigned u32x2 __attribute__((ext_vector_type(2)));
typedef float f32x2 __attribute__((ext_vector_type(2)));
#define LDS_WAIT() asm volatile("s_waitcnt lgkmcnt(0)" ::: "memory")
DEV int mk_tid(int wave_s) { unsigned ones = ~0u; asm volatile("" : "+s"(ones)); return wave_s * 64 + (int)__builtin_amdgcn_mbcnt_hi(ones, __builtin_amdgcn_mbcnt_lo(ones, 0u)); }
#define VM_WAIT() asm volatile("s_waitcnt vmcnt(0)" ::: "memory")
typedef __bf16 bf16x2_t __attribute__((ext_vector_type(2)));
DEV unsigned cvt_pk_bf16(float lo, float hi) { const f32x2 v = {lo, hi}; return __builtin_bit_cast(unsigned, __builtin_convertvector(v, bf16x2_t)); }
DEV float bflo(unsigned w) { return __uint_as_float(w << 16); }
DEV float bfhi(unsigned w) { return __uint_as_float(w & 0xffff0000u); }

namespace pg8 {
constexpr int BM = 256, BK = 64, HALF = 128, HTB = HALF * BK * 2, STAGE_BYTES = 8 * HTB, NXCD = 8, WGM = 8;
__host__ __device__ __forceinline__ int lds_byte(int r, int c) { const int st = (r >> 4) * 2 + (c >> 5), rr = r & 15, cc = c & 31, ob = rr * 64 + cc * 2; return st * 1024 + (ob ^ (((ob >> 9) & 1) << 5)); }
__host__ __device__ __forceinline__ void stage_rc(int b, int& R, int& C) { const int st = b / 1024, sb = b % 1024, swz = sb ^ (((sb >> 9) & 1) << 5); R = (st >> 1) * 16 + swz / 64; C = (st & 1) * 32 + (swz % 64) / 2; }
__host__ __device__ __forceinline__ int perm32(int rho) { const int n = rho >> 4, i = rho & 15; return 8 * (i >> 2) + 4 * n + (i & 3); }

struct Unit { int pm, pn, job; };
struct Order {
    int nM, nN, nwg, ntot, G, c;
    DEV void init(int nM_, int nN_, int njob, int G_, int c_) { nM = nM_; nN = nN_; nwg = nM * nN; ntot = nwg * njob; G = G_; c = c_; }
    DEV bool next(int i, Unit& u) const {
        const int L = i * G + c; if (L >= ntot) return false;
        u.job = L / nwg; int wgid = L - u.job * nwg;
        { const int q = nwg / NXCD, r = nwg % NXCD, xcd = wgid % NXCD, off = wgid / NXCD; wgid = (xcd < r ? xcd * (q + 1) : r * (q + 1) + (xcd - r) * q) + off; }
        const int nig = WGM * nN, gid = wgid / nig, fm = gid * WGM, gsz = (nM - fm) < WGM ? (nM - fm) : WGM;
        u.pm = fm + ((wgid % nig) % gsz); u.pn = (wgid % nig) / gsz; return true;
    }
};
template <class Epi, class Ptr, bool ALIGN_EPI, bool SP2>
DEV void gemm_phase(LAS unsigned char* lds, const int tid_in, const int lda, const int ldb, const int K, const Order& S, const Ptr& P, const Epi& E) {
    int tid_ = tid_in; asm volatile("" : "+v"(tid_));
    const int tid = tid_, wid = __builtin_amdgcn_readfirstlane(tid >> 6), lane = tid & 63, wr = wid >> 2, wc = wid & 3, fr = lane & 15, fq = lane >> 4;
    const int nt = K / BK;
    unsigned voffA[2], voffB[2];
#pragma unroll
    for (int i = 0; i < 2; ++i) { int R, C; stage_rc(tid * 16 + i * 8192, R, C); const int Rb = Epi::PERM ? ((R & ~31) + perm32(R & 31)) : R;
        voffA[i] = (unsigned)(R * lda + C) * 2u; voffB[i] = (unsigned)(Rb * ldb + C) * 2u; }
    const size_t kstep = (size_t)(BK * 2);
    const size_t hstepA = (size_t)HALF * lda * 2, hstepB = (size_t)HALF * ldb * 2;
    const unsigned ldsw = (unsigned)wid * 1024u;
    const int aoff = lds_byte(wr * 64 + fr, fq * 8), boff = lds_byte(wc * 32 + fr, fq * 8);
#define PG8_SA(b, h) (((b) * 2 + (h)) * HTB)
#define PG8_SB(b, h) ((4 + (b) * 2 + (h)) * HTB)
#define PG8_STAGE(bufoff, gbase, voff) do { _Pragma("unroll") for (int _i = 0; _i < 2; ++_i) \
        __builtin_amdgcn_global_load_lds((const unsigned*)((const char*)(gbase) + (voff)[_i]), (LAS unsigned*)(lds + (bufoff) + ldsw + _i * 8192), 16, 0, 0); } while (0)
#define PG8_LDA(dst, b, h) do { _Pragma("unroll") for (int m = 0; m < 4; ++m) _Pragma("unroll") for (int k = 0; k < 2; ++k) dst[m][k] = *(const LAS bf16x8*)(lds + PG8_SA(b, h) + aoff + m * 2048 + k * 1024); } while (0)
#define PG8_LDB(dst, b, h) do { _Pragma("unroll") for (int n = 0; n < 2; ++n) _Pragma("unroll") for (int k = 0; k < 2; ++k) dst[n][k] = *(const LAS bf16x8*)(lds + PG8_SB(b, h) + boff + n * 2048 + k * 1024); } while (0)
#define PG8_MMA(ai, bj, At, Bt) do { __builtin_amdgcn_s_setprio(1); _Pragma("unroll") for (int m = 0; m < 4; ++m) _Pragma("unroll") for (int n = 0; n < 2; ++n) _Pragma("unroll") for (int k = 0; k < 2; ++k) \
        acc[ai][bj][m][n] = __builtin_amdgcn_mfma_f32_16x16x32_bf16(Bt[n][k], At[m][k], acc[ai][bj][m][n], 0, 0, 0); __builtin_amdgcn_s_setprio(0); } while (0)
#define PG8_WAIT_V(n) asm volatile("s_waitcnt vmcnt(" #n ")" ::: "memory")
#define PG8_WAIT_L(n) asm volatile("s_waitcnt lgkmcnt(" #n ")" ::: "memory")
#define PG8_BAR __builtin_amdgcn_s_barrier()
#define PG8_SCHED __builtin_amdgcn_sched_barrier(0)
    Unit cur, nxt; int ui = 0;
    if (!S.next(0, cur)) return;
    f32x4 acc[2][2][4][2];
#pragma unroll
    for (int a = 0; a < 2; ++a)
#pragma unroll
        for (int b = 0; b < 2; ++b)
#pragma unroll
            for (int m = 0; m < 4; ++m)
#pragma unroll
                for (int n = 0; n < 2; ++n) acc[a][b][m][n] = (f32x4){0.f, 0.f, 0.f, 0.f};
    bf16x8 At[4][2], B0[2][2], B1[2][2];
    const char* cA = P.a(cur); const char* cB = P.b(cur);
    typename Epi::Pre pre; E.prefetch(pre, cur, wr, fr);
    if constexpr (SP2) {
        PG8_STAGE(PG8_SB(0, 0), cB, voffB); PG8_STAGE(PG8_SB(0, 1), cB + hstepB, voffB); PG8_STAGE(PG8_SA(0, 0), cA, voffA); PG8_STAGE(PG8_SA(0, 1), cA + hstepA, voffA);
        if (wr == 1) PG8_BAR;
        PG8_WAIT_V(2); PG8_BAR;
        PG8_STAGE(PG8_SB(1, 0), cB + kstep, voffB); PG8_STAGE(PG8_SA(1, 0), cA + kstep, voffA); PG8_STAGE(PG8_SB(1, 1), cB + hstepB + kstep, voffB);
        PG8_WAIT_V(6); PG8_BAR;
    } else {
        PG8_STAGE(PG8_SB(0, 0), cB, voffB); PG8_STAGE(PG8_SA(0, 0), cA, voffA); PG8_STAGE(PG8_SB(0, 1), cB + hstepB, voffB); PG8_STAGE(PG8_SA(0, 1), cA + hstepA, voffA);
        if (wr == 1) PG8_BAR;
        PG8_WAIT_V(4); PG8_BAR;
        PG8_STAGE(PG8_SB(1, 0), cB + kstep, voffB); PG8_STAGE(PG8_SA(1, 0), cA + kstep, voffA); PG8_STAGE(PG8_SB(1, 1), cB + hstepB + kstep, voffB);
        PG8_WAIT_V(6); PG8_BAR;
    }
#pragma unroll 1
    for (;;) {
        const bool has_next = S.next(ui + 1, nxt);
        const char* nA = has_next ? P.a(nxt) : cA; const char* nB = has_next ? P.b(nxt) : cB;
#pragma unroll 1
        for (int t = 0; t < nt; t += 2) {
            const bool last = (t == nt - 2);
            const char* a1 = cA + (size_t)(t + 1) * kstep;
            const char* a2 = last ? nA : cA + (size_t)(t + 2) * kstep; const char* b2 = last ? nB : cB + (size_t)(t + 2) * kstep;
            const char* a3 = a2 + kstep; const char* b3 = b2 + kstep;
            if constexpr (SP2) {
            PG8_LDB(B0, 0, 0); PG8_LDB(B1, 0, 1); PG8_SCHED; PG8_LDA(At, 0, 0); PG8_STAGE(PG8_SA(1, 1), a1 + hstepA, voffA);
            PG8_WAIT_V(8); PG8_WAIT_L(0); PG8_BAR; PG8_MMA(0, 0, At, B0); PG8_MMA(0, 1, At, B1); PG8_BAR; PG8_SCHED;
            PG8_LDA(At, 0, 1); PG8_STAGE(PG8_SB(0, 0), b2, voffB); PG8_STAGE(PG8_SB(0, 1), b2 + hstepB, voffB); PG8_STAGE(PG8_SA(0, 0), a2, voffA);
            PG8_WAIT_V(8); PG8_WAIT_L(0); PG8_BAR; PG8_MMA(1, 0, At, B0); PG8_MMA(1, 1, At, B1); PG8_BAR; PG8_SCHED;
            PG8_LDB(B0, 1, 0); PG8_LDB(B1, 1, 1); PG8_SCHED; PG8_LDA(At, 1, 0); PG8_STAGE(PG8_SA(0, 1), a2 + hstepA, voffA);
            PG8_WAIT_V(8); PG8_WAIT_L(0); PG8_BAR; PG8_MMA(0, 0, At, B0); PG8_MMA(0, 1, At, B1); PG8_BAR; PG8_SCHED;
            PG8_LDA(At, 1, 1); PG8_STAGE(PG8_SB(1, 0), b3, voffB); PG8_STAGE(PG8_SB(1, 1), b3 + hstepB, voffB); PG8_STAGE(PG8_SA(1, 0), a3, voffA);
            PG8_WAIT_V(8); PG8_WAIT_L(0); PG8_BAR; PG8_MMA(1, 0, At, B0); PG8_MMA(1, 1, At, B1); PG8_BAR; PG8_SCHED;
            } else {
            PG8_LDB(B0, 0, 0); PG8_SCHED; PG8_LDA(At, 0, 0); PG8_STAGE(PG8_SA(1, 1), a1 + hstepA, voffA);
            PG8_WAIT_L(8); PG8_BAR; PG8_WAIT_L(0); PG8_MMA(0, 0, At, B0); PG8_BAR; PG8_SCHED;
            PG8_LDB(B1, 0, 1); PG8_STAGE(PG8_SB(0, 0), b2, voffB);
            PG8_BAR; PG8_WAIT_L(0); PG8_MMA(0, 1, At, B1); PG8_BAR;
            PG8_LDA(At, 0, 1); PG8_STAGE(PG8_SA(0, 0), a2, voffA);
            PG8_BAR; PG8_WAIT_L(0); PG8_MMA(1, 0, At, B0); PG8_BAR; PG8_SCHED;
            PG8_STAGE(PG8_SB(0, 1), b2 + hstepB, voffB);
            PG8_WAIT_V(6); PG8_BAR; PG8_MMA(1, 1, At, B1); PG8_BAR;
            PG8_LDB(B0, 1, 0); PG8_SCHED; PG8_LDA(At, 1, 0); PG8_STAGE(PG8_SA(0, 1), a2 + hstepA, voffA);
            PG8_WAIT_L(8); PG8_BAR; PG8_WAIT_L(0); PG8_MMA(0, 0, At, B0); PG8_BAR; PG8_SCHED;
            PG8_LDB(B1, 1, 1); PG8_STAGE(PG8_SB(1, 0), b3, voffB);
            PG8_BAR; PG8_WAIT_L(0); PG8_MMA(0, 1, At, B1); PG8_BAR;
            PG8_LDA(At, 1, 1); PG8_STAGE(PG8_SA(1, 0), a3, voffA);
            PG8_BAR; PG8_WAIT_L(0); PG8_MMA(1, 0, At, B0); PG8_BAR; PG8_SCHED;
            PG8_STAGE(PG8_SB(1, 1), b3 + hstepB, voffB);
            PG8_WAIT_V(6); PG8_BAR; PG8_MMA(1, 1, At, B1); PG8_BAR;
            }
        }
        if constexpr (ALIGN_EPI) { if (wr == 0) PG8_BAR; }
        if constexpr (!Epi::AFTER_DRAIN) { int fr_ = fr, fq_ = fq; asm volatile("" : "+v"(fr_), "+v"(fq_));
            E(acc, cur, wr, wc, fr_, fq_, pre); }
        if (!has_next) break;
#pragma unroll
        for (int a = 0; a < 2; ++a)
#pragma unroll
            for (int b = 0; b < 2; ++b)
#pragma unroll
                for (int m = 0; m < 4; ++m)
#pragma unroll
                    for (int n = 0; n < 2; ++n) acc[a][b][m][n] = (f32x4){0.f, 0.f, 0.f, 0.f};
        cur = nxt; cA = nA; cB = nB; ++ui; E.prefetch(pre, cur, wr, fr);
        if constexpr (ALIGN_EPI) { if (wr == 1) PG8_BAR; }
    }
    PG8_WAIT_V(0);
    if constexpr (!ALIGN_EPI) { if (wr == 0) PG8_BAR; }
    PG8_BAR;
    if constexpr (Epi::AFTER_DRAIN) { int fr_ = fr, fq_ = fq, lane_ = lane; asm volatile("" : "+v"(fr_), "+v"(fq_), "+v"(lane_)); E.fused(acc, cur, wr, wc, fr_, fq_, lds, wid, lane_, pre); }
#undef PG8_SA
#undef PG8_SB
#undef PG8_STAGE
#undef PG8_LDA
#undef PG8_LDB
#undef PG8_MMA
#undef PG8_WAIT_V
#undef PG8_WAIT_L
#undef PG8_BAR
#undef PG8_SCHED
}
typedef f32x4 Acc[2][2][4][2];

struct PtrStd {
    const char* A; const char* B; size_t aj, bj, bb, arow, brow;
    DEV const char* a(const Unit& u) const { return A + (size_t)u.job * aj + (size_t)u.pm * arow; }
    DEV const char* b(const Unit& u) const { return B + (size_t)u.job * bj + (size_t)(u.pm >> 5) * bb + (size_t)u.pn * brow; }
};
struct PtrG {
    const char* KVM; const char* WQ;
    DEV const char* a(const Unit& u) const { return KVM + (size_t)(u.job >> 2) * MiB + (size_t)(u.job & 3) * 512; }
    DEV const char* b(const Unit& u) const { return WQ + (size_t)(u.job >> 3) * 2 * MiB + (size_t)(u.job & 3) * 512 + (size_t)u.pn * 256 * 1024 * 2; }
};
struct PtrH {
    const char* KVM; const char* WOT;
    DEV const char* a(const Unit& u) const { return WOT + (size_t)(u.job >> 3) * 2 * MiB + (size_t)(u.job & 3) * 512 + (size_t)u.pm * 256 * 1024 * 2; }
    DEV const char* b(const Unit& u) const { return KVM + (size_t)(u.job >> 2) * MiB + 2048 + (size_t)(u.job & 3) * 512; }
};

#define EPI_ROWS(u) const int row0 = (u).pm * BM + wr * 64 + fr
DEV u32x4 pack8(const f32x4 v0, const f32x4 v1) { u32x4 w; w.x = cvt_pk_bf16(v0[0], v0[1]); w.y = cvt_pk_bf16(v0[2], v0[3]); w.z = cvt_pk_bf16(v1[0], v1[1]); w.w = cvt_pk_bf16(v1[2], v1[3]); return w; }

struct PreNone {};
typedef unsigned long long u64;
constexpr float SS_SCALE = 65536.f;
struct PreRs { u64 v[2][4]; };
DEV void pre_rs(PreRs& p, const u64* ss, int row0) {
#pragma unroll
    for (int ai = 0; ai < 2; ++ai)
#pragma unroll
        for (int m = 0; m < 4; ++m) p.v[ai][m] = __builtin_nontemporal_load(ss + row0 + ai * HALF + m * 16);
}
DEV void rs_of(float (&rs)[2][4], const PreRs& p) {
#pragma unroll
    for (int ai = 0; ai < 2; ++ai)
#pragma unroll
        for (int m = 0; m < 4; ++m) rs[ai][m] = rsqrtf((float)p.v[ai][m] * (1.f / (SS_SCALE * D)) + EPS);
}
struct EpiInProj {
    typedef PreRs Pre;
    DEV void prefetch(PreRs& p, const Unit& u, int wr, int fr) const { pre_rs(p, ss, u.pm * BM + wr * 64 + fr); }
    static constexpr bool PERM = true, AFTER_DRAIN = false;
    unsigned char* ws; const u64* ss;
    DEV void operator()(const Acc& acc, const Unit& u, int wr, int wc, int fr, int fq, const PreRs& pre) const {
        EPI_ROWS(u); const int pn = u.pn, cb = wc * 32 + 8 * fq;
        float rs[2][4]; rs_of(rs, pre);
        if (pn < 16) {
            const int g = pn >> 1;
            const size_t off = g == 0 ? WS_QA : g == 1 ? WS_KA : g == 2 ? WS_VA : g == 3 ? WS_QC : g == 4 ? WS_KC : g == 5 ? WS_VC : g == 6 ? WS_IQ : WS_SCB;
            const float sc = (g == 0 || g == 3) ? QSCALE : 1.f;
            bf16_t* base = (bf16_t*)(ws + off) + (pn & 1) * 256 + cb;
#pragma unroll
            for (int ai = 0; ai < 2; ++ai)
#pragma unroll
                for (int m = 0; m < 4; ++m) { bf16_t* rowp = base + (size_t)(row0 + ai * HALF + m * 16) * 512;
#pragma unroll
                    for (int bj = 0; bj < 2; ++bj) *(u32x4*)(rowp + bj * HALF) = pack8(acc[ai][bj][m][0] * (sc * rs[ai][m]), acc[ai][bj][m][1] * (sc * rs[ai][m])); }
        } else if (pn < 20) {
            bf16_t* base = (bf16_t*)(ws + WS_CX) + (pn - 16) * 128 + cb;
#pragma unroll
            for (int ai = 0; ai < 2; ++ai)
#pragma unroll
                for (int m = 0; m < 4; ++m) { const float r2 = rs[ai][m] * rs[ai][m]; *(u32x4*)(base + (size_t)(row0 + ai * HALF + m * 16) * 512) = pack8(acc[ai][0][m][0] * acc[ai][1][m][0] * r2, acc[ai][0][m][1] * acc[ai][1][m][1] * r2); }
        } else {
            if (wc < 2) { bf16_t* base = (bf16_t*)(ws + WS_IK);
#pragma unroll
                for (int ai = 0; ai < 2; ++ai)
#pragma unroll
                    for (int m = 0; m < 4; ++m) { const int t = row0 + ai * HALF + m * 16;
                        *(u32x4*)(base + (size_t)(t >> 5) * 2048 + (((cb >> 3) * 32 + (t & 31)) * 8)) = pack8(acc[ai][0][m][0] * rs[ai][m], acc[ai][0][m][1] * rs[ai][m]); }
            } else if (wc == 2 && fq == 0) { float* base = (float*)(ws + WS_IW);
#pragma unroll
                for (int ai = 0; ai < 2; ++ai)
#pragma unroll
                    for (int m = 0; m < 4; ++m) { float* p = base + (size_t)(row0 + ai * HALF + m * 16) * 8; *(f32x4*)p = acc[ai][0][m][0] * (WSCALE * rs[ai][m]); *(f32x4*)(p + 4) = acc[ai][0][m][1] * (WSCALE * rs[ai][m]); }
            }
        }
    }
};
DEV f32x4 sigm4(const f32x4 v) { f32x4 o;
#pragma unroll
    for (int i = 0; i < 4; ++i) o[i] = __builtin_amdgcn_rcpf(1.f + __builtin_amdgcn_exp2f(-LOG2E * v[i])); return o; }
struct EpiGates {
    typedef PreRs Pre;
    DEV void prefetch(PreRs& p, const Unit& u, int wr, int fr) const { pre_rs(p, ss, u.pm * BM + wr * 64 + fr); }
    static constexpr bool PERM = true, AFTER_DRAIN = false;
    bf16_t* G; const u64* ss;
    DEV void operator()(const Acc& acc, const Unit& u, int wr, int wc, int fr, int fq, const PreRs& pre) const {
        EPI_ROWS(u); float rs[2][4]; rs_of(rs, pre); bf16_t* base = G + (size_t)(u.pn >> 2) * T * D + (u.pn & 3) * 256 + wc * 32 + 8 * fq;
#pragma unroll
        for (int ai = 0; ai < 2; ++ai)
#pragma unroll
            for (int m = 0; m < 4; ++m) { bf16_t* rowp = base + (size_t)(row0 + ai * HALF + m * 16) * D;
#pragma unroll
                for (int bj = 0; bj < 2; ++bj) *(u32x4*)(rowp + bj * HALF) = pack8(sigm4(acc[ai][bj][m][0] * rs[ai][m]), sigm4(acc[ai][bj][m][1] * rs[ai][m])); }
    }
};
struct EpiMerge {
    typedef PreNone Pre;
    DEV void prefetch(PreNone&, const Unit&, int, int) const {}
    static constexpr bool PERM = true, AFTER_DRAIN = false;
    bf16_t* M; const bf16_t* G;
    DEV void operator()(const Acc& acc, const Unit& u, int wr, int wc, int fr, int fq, const PreNone&) const {
        EPI_ROWS(u); const size_t cofs = (size_t)u.pn * 256 + wc * 32 + 8 * fq; const bf16_t* gb = G + (size_t)u.job * T * D;
#pragma unroll
        for (int ai = 0; ai < 2; ++ai)
#pragma unroll
            for (int m = 0; m < 4; ++m) { const size_t ro = (size_t)(row0 + ai * HALF + m * 16) * D + cofs;
#pragma unroll
                for (int bj = 0; bj < 2; ++bj) { const size_t o = ro + bj * HALF; const u32x4 g = *(const u32x4*)(gb + o);
                    f32x4 v0 = acc[ai][bj][m][0], v1 = acc[ai][bj][m][1];
                    v0[0] *= bflo(g.x); v0[1] *= bfhi(g.x); v0[2] *= bflo(g.y); v0[3] *= bfhi(g.y); v1[0] *= bflo(g.z); v1[1] *= bfhi(g.z); v1[2] *= bflo(g.w); v1[3] *= bfhi(g.w);
                    if (u.job > 0) { const u32x4 p = __builtin_nontemporal_load((const u32x4*)(M + o));
                        v0[0] += bflo(p.x); v0[1] += bfhi(p.x); v0[2] += bflo(p.y); v0[3] += bfhi(p.y); v1[0] += bflo(p.z); v1[1] += bfhi(p.z); v1[2] += bflo(p.w); v1[3] += bfhi(p.w); }
                    *(u32x4*)(M + o) = pack8(v0, v1); } }
    }
};
template <bool IN_F32> struct EpiResid {
    typedef PreNone Pre;
    DEV void prefetch(PreNone&, const Unit&, int, int) const {}
    static constexpr bool PERM = true, AFTER_DRAIN = false;
    const void* xin; bf16_t* xb; u64* ss;
    DEV void operator()(const Acc& acc, const Unit& u, int wr, int wc, int fr, int fq, const PreNone&) const {
        EPI_ROWS(u); const size_t cofs = (size_t)u.pn * 256 + wc * 32 + 8 * fq;
#pragma unroll
        for (int ai = 0; ai < 2; ++ai)
#pragma unroll
            for (int m = 0; m < 4; ++m) { const size_t ro = (size_t)(row0 + ai * HALF + m * 16) * D + cofs; float sq = 0.f;
#pragma unroll
                for (int bj = 0; bj < 2; ++bj) { const size_t o = ro + bj * HALF; f32x4 v0 = acc[ai][bj][m][0], v1 = acc[ai][bj][m][1];
                    if (IN_F32) { v0 = v0 + *(const f32x4*)((const float*)xin + o); v1 = v1 + *(const f32x4*)((const float*)xin + o + 4); }
                    else { const u32x4 p = *(const u32x4*)((const bf16_t*)xin + o);
                        v0[0] += bflo(p.x); v0[1] += bfhi(p.x); v0[2] += bflo(p.y); v0[3] += bfhi(p.y); v1[0] += bflo(p.z); v1[1] += bfhi(p.z); v1[2] += bflo(p.w); v1[3] += bfhi(p.w); }
                    *(u32x4*)(xb + o) = pack8(v0, v1);
                    sq += ((v0[0] * v0[0] + v0[1] * v0[1]) + (v0[2] * v0[2] + v0[3] * v0[3])) + ((v1[0] * v1[0] + v1[1] * v1[1]) + (v1[2] * v1[2] + v1[3] * v1[3])); }
                sq += __shfl_xor(sq, 16); sq += __shfl_xor(sq, 32);
                if (fq == 0) atomicAdd(ss + row0 + ai * HALF + m * 16, (u64)(sq * SS_SCALE + 0.5f)); }
    }
};
struct EpiUp {
    typedef PreRs Pre;
    DEV void prefetch(PreRs& p, const Unit& u, int wr, int fr) const { pre_rs(p, ss, u.pm * BM + wr * 64 + fr); }
    static constexpr bool PERM = true, AFTER_DRAIN = false;
    bf16_t *fa, *fu; const u64* ss;
    DEV void operator()(const Acc& acc, const Unit& u, int wr, int wc, int fr, int fq, const PreRs& pre) const {
        EPI_ROWS(u); float rs[2][4]; rs_of(rs, pre); const size_t cofs = (size_t)u.pn * 128 + wc * 32 + 8 * fq;
#pragma unroll
        for (int ai = 0; ai < 2; ++ai)
#pragma unroll
            for (int m = 0; m < 4; ++m) { const size_t o = (size_t)(row0 + ai * HALF + m * 16) * DFF + cofs;
                *(u32x4*)(fa + o) = pack8(acc[ai][0][m][0] * rs[ai][m], acc[ai][0][m][1] * rs[ai][m]); *(u32x4*)(fu + o) = pack8(acc[ai][1][m][0] * rs[ai][m], acc[ai][1][m][1] * rs[ai][m]); }
    }
};
DEV float gelu_t(float a) { return a * __builtin_amdgcn_rcpf(1.f + __builtin_amdgcn_exp2f(-1.5957691216057308f * LOG2E * (a + 0.044715f * a * a * a))); }
DEV float row_prev1(float cur, float prevm) { const int r = __builtin_amdgcn_update_dpp(0, (int)__float_as_uint(prevm), 0x121, 0xf, 0xf, false);
    return __uint_as_float((unsigned)__builtin_amdgcn_update_dpp(r, (int)__float_as_uint(cur), 0x111, 0xf, 0xf, false)); }
DEV float row_prev2(float cur, float prevm) { const int r = __builtin_amdgcn_update_dpp(0, (int)__float_as_uint(prevm), 0x122, 0xf, 0xf, false);
    return __uint_as_float((unsigned)__builtin_amdgcn_update_dpp(r, (int)__float_as_uint(cur), 0x112, 0xf, 0xf, false)); }
struct EpiUpF {
    typedef PreRs Pre;
    DEV void prefetch(PreRs& p, const Unit& u, int wr, int fr) const { pre_rs(p, ss, u.pm * BM + wr * 64 + fr); }
    static constexpr bool PERM = true, AFTER_DRAIN = false;
    bf16_t *fu, *sa, *su; const u64* ss; const float *cw, *cb;
    DEV void operator()(const Acc& acc, const Unit& u, int wr, int wc, int fr, int fq, const PreRs& pre) const {
        EPI_ROWS(u); float rs[2][4]; rs_of(rs, pre); const size_t cofs = (size_t)u.pn * 128 + wc * 32 + 8 * fq;
        f32x4 w0[2], w1[2], w2[2], bb[2];
#pragma unroll
        for (int n = 0; n < 2; ++n) { w0[n] = *(const f32x4*)(cw + cofs + 4 * n); w1[n] = *(const f32x4*)(cw + DFF + cofs + 4 * n); w2[n] = *(const f32x4*)(cw + 2 * DFF + cofs + 4 * n); bb[n] = *(const f32x4*)(cb + cofs + 4 * n); }
#pragma unroll
        for (int ai = 0; ai < 2; ++ai) {
            const size_t strip = (size_t)u.pm * 4 + ai * 2 + wr;
            f32x4 ap[2] = {{0.f, 0.f, 0.f, 0.f}, {0.f, 0.f, 0.f, 0.f}};
#pragma unroll
            for (int m = 0; m < 4; ++m) {
                f32x4 a[2], g[2];
#pragma unroll
                for (int n = 0; n < 2; ++n) { a[n] = acc[ai][0][m][n] * rs[ai][m];
#pragma unroll
                    for (int e = 0; e < 4; ++e) { const float a1 = row_prev1(a[n][e], ap[n][e]), a2 = row_prev2(a[n][e], ap[n][e]);
                        g[n][e] = gelu_t(bb[n][e] + w0[n][e] * a2 + w1[n][e] * a1 + w2[n][e] * a[n][e]) * (acc[ai][1][m][n][e] * rs[ai][m]); } }
                if (m == 0) {
                    if (fr < 2) { *(u32x4*)(sa + (strip * 4 + fr) * DFF + cofs) = pack8(a[0], a[1]); *(u32x4*)(su + (strip * 2 + fr) * DFF + cofs) = pack8(acc[ai][1][0][0] * rs[ai][0], acc[ai][1][0][1] * rs[ai][0]); }
                    else *(u32x4*)(fu + (size_t)(row0 + ai * HALF) * DFF + cofs) = pack8(g[0], g[1]);
                } else {
                    *(u32x4*)(fu + (size_t)(row0 + ai * HALF + m * 16) * DFF + cofs) = pack8(g[0], g[1]);
                    if (m == 3 && fr >= 14) *(u32x4*)(sa + (strip * 4 + 2 + (fr - 14)) * DFF + cofs) = pack8(a[0], a[1]);
                }
                ap[0] = a[0]; ap[1] = a[1];
            }
        }
    }
};
struct EpiPrep {
    typedef PreNone Pre;
    DEV void prefetch(PreNone&, const Unit&, int, int) const {}
    static constexpr bool PERM = true, AFTER_DRAIN = false;
    unsigned char* ws; int mode;
    DEV void operator()(const Acc& acc, const Unit& u, int wr, int wc, int fr, int fq, const PreNone&) const {
        EPI_ROWS(u); bf16_t* base; int ldc; float sc = 1.f;
        if (mode == 0) { base = (bf16_t*)(ws + WS_KVM + (size_t)u.job * 2 * MiB); ldc = 2 * D; }
        else if (mode == 1) { base = (bf16_t*)(ws + WS_GT + (size_t)(u.job >> 2) * 2 * MiB) + (size_t)(u.job & 3) * 256 * D; ldc = D; sc = XSCALE; }
        else { base = (bf16_t*)(ws + WS_HT + (size_t)(u.job >> 2) * 2 * MiB) + (u.job & 3) * 256; ldc = D; }
        base += (size_t)u.pn * 256 + wc * 32 + 8 * fq;
#pragma unroll
        for (int ai = 0; ai < 2; ++ai)
#pragma unroll
            for (int m = 0; m < 4; ++m) { bf16_t* rowp = base + (size_t)(row0 + ai * HALF + m * 16) * ldc;
#pragma unroll
                for (int bj = 0; bj < 2; ++bj) *(u32x4*)(rowp + bj * HALF) = pack8(acc[ai][bj][m][0] * sc, acc[ai][bj][m][1] * sc); }
    }
};
struct EpiSoftmax {
    typedef PreRs Pre;
    DEV void prefetch(PreRs& p, const Unit& u, int wr, int fr) const { pre_rs(p, ss, u.pm * BM + wr * 64 + fr); }
    static constexpr bool PERM = true, AFTER_DRAIN = true;
    bf16_t* P; const u64* ss;
    DEV void fused(Acc& acc, const Unit& u, int wr, int wc, int fr, int fq, LAS unsigned char* lds, int wid, int lane, const PreRs& pre) const {
        LAS float* PM = (LAS float*)lds; LAS float* PS = (LAS float*)(lds + 4096);
        { const int row0_ = u.pm * BM + wr * 64 + fr; float rs[2][4]; rs_of(rs, pre);
#pragma unroll
          for (int ai = 0; ai < 2; ++ai)
#pragma unroll
              for (int m = 0; m < 4; ++m)
#pragma unroll
                  for (int bj = 0; bj < 2; ++bj)
#pragma unroll
                      for (int n = 0; n < 2; ++n) acc[ai][bj][m][n] = acc[ai][bj][m][n] * rs[ai][m]; }
#pragma unroll
        for (int ai = 0; ai < 2; ++ai)
#pragma unroll
            for (int m = 0; m < 4; ++m) { float mx = -INFINITY;
#pragma unroll
                for (int bj = 0; bj < 2; ++bj)
#pragma unroll
                    for (int n = 0; n < 2; ++n) { const f32x4 x = acc[ai][bj][m][n]; mx = fmaxf(mx, fmaxf(fmaxf(x[0], x[1]), fmaxf(x[2], x[3]))); }
                mx = fmaxf(mx, __shfl_xor(mx, 16)); mx = fmaxf(mx, __shfl_xor(mx, 32));
                if (fq == 0) PM[(ai * HALF + wr * 64 + m * 16 + fr) * 4 + wc] = mx; }
        LDS_WAIT(); __builtin_amdgcn_s_barrier(); asm volatile("" ::: "memory");
#pragma unroll
        for (int ai = 0; ai < 2; ++ai)
#pragma unroll
            for (int m = 0; m < 4; ++m) { const int r = ai * HALF + wr * 64 + m * 16 + fr; const f32x4 q = *(const LAS f32x4*)(PM + r * 4);
                const float mx = fmaxf(fmaxf(q[0], q[1]), fmaxf(q[2], q[3])); float s = 0.f;
#pragma unroll
                for (int bj = 0; bj < 2; ++bj)
#pragma unroll
                    for (int n = 0; n < 2; ++n) { f32x4 x = acc[ai][bj][m][n];
#pragma unroll
                        for (int i = 0; i < 4; ++i) { x[i] = __builtin_amdgcn_exp2f(x[i] - mx); s += x[i]; } acc[ai][bj][m][n] = x; }
                s += __shfl_xor(s, 16); s += __shfl_xor(s, 32);
                if (fq == 0) PS[r * 4 + wc] = s; }
        LDS_WAIT(); __builtin_amdgcn_s_barrier(); asm volatile("" ::: "memory");
        EPI_ROWS(u); bf16_t* base = P + (size_t)u.pn * 256 + wc * 32 + 8 * fq;
#pragma unroll
        for (int ai = 0; ai < 2; ++ai)
#pragma unroll
            for (int m = 0; m < 4; ++m) { const int r = ai * HALF + wr * 64 + m * 16 + fr; const f32x4 q = *(const LAS f32x4*)(PS + r * 4);
                const float inv = 1.f / ((q[0] + q[1]) + (q[2] + q[3])); bf16_t* rowp = base + (size_t)(row0 + ai * HALF + m * 16) * D;
#pragma unroll
                for (int bj = 0; bj < 2; ++bj) *(u32x4*)(rowp + bj * HALF) = pack8(acc[ai][bj][m][0] * inv, acc[ai][bj][m][1] * inv); }
        LDS_WAIT(); __builtin_amdgcn_s_barrier();
    }
};
}

typedef GAS unsigned gu32;
#define XB_TMO      128
#define XB_XCNT(j)  (256  + 64 * (j))
#define XB_XSUB(j)  (1280 + 64 * (j))
#define XB_XGEN(j)  (2304 + 64 * (j))
#define XB_TOP      3328
#define XB_TOPGEN   3392
#define XCD_BAR_WORDS 3456
#define XB_SPIN_CAP (1u << 22)
DEV unsigned xb_ld(unsigned* p) { return __hip_atomic_load(p, __ATOMIC_RELAXED, __HIP_MEMORY_SCOPE_AGENT); }
DEV unsigned xb_add(unsigned* p, unsigned v) { return __hip_atomic_fetch_add(p, v, __ATOMIC_RELAXED, __HIP_MEMORY_SCOPE_AGENT); }
DEV unsigned xb_xcc_id() { return (unsigned)__builtin_amdgcn_s_getreg((3 << 11) | 20) & 0xFu; }
#define XB_SPIN(cond, bar) do { unsigned _sp = 0; while (cond) { __builtin_amdgcn_s_sleep(1); \
    if ((++_sp & 255u) == 0u) { if (xb_ld(&(bar)[XB_TMO])) break; if (_sp > XB_SPIN_CAP) { atomicAdd(&(bar)[XB_TMO], 1u); break; } } } } while (0)
struct XcdBarrier { unsigned* bar; unsigned x; volatile LAS unsigned* st; };
DEV XcdBarrier xcd_barrier_post(unsigned* bar, volatile LAS unsigned* st, int tid) {
    XcdBarrier b; b.bar = bar; b.x = xb_xcc_id(); b.st = st;
    if (tid == 0) (void)xb_add(&bar[XB_XCNT(b.x)], 1u);
    return b;
}
DEV void xcd_barrier_complete(unsigned* bar, unsigned x, unsigned& nloc, unsigned& nx) {
    const unsigned G = gridDim.x * gridDim.y * gridDim.z;
    unsigned sum, cnt, mine, sp = 0u;
    for (;;) {
        sum = 0u; cnt = 0u; mine = 0u;
#pragma unroll
        for (unsigned j = 0; j < 16; ++j) { const unsigned c = xb_ld(&bar[XB_XCNT(j)]); sum += c; cnt += (c > 0u) ? 1u : 0u; mine = (j == x) ? c : mine; }
        if (sum == G) break;
        __builtin_amdgcn_s_sleep(1);
        if ((++sp & 255u) == 0u) { if (xb_ld(&bar[XB_TMO])) break; if (sp > XB_SPIN_CAP) { atomicAdd(&bar[XB_TMO], 1u); break; } }
    }
    nloc = mine > 0u ? mine : 1u; nx = cnt > 0u ? cnt : 1u;
}
DEV void xcd_barrier(const XcdBarrier& b, int tid) {
    asm volatile("s_waitcnt vmcnt(0)" ::: "memory");
    __syncthreads();
    if (tid == 0) {
        unsigned* bar = b.bar;
        __builtin_amdgcn_s_waitcnt(0);
        unsigned nloc = b.st[0], nx = b.st[1];
        if (nloc == 0u) { xcd_barrier_complete(bar, b.x, nloc, nx); b.st[0] = nloc; b.st[1] = nx; }
        const unsigned old = xb_add(&bar[XB_XSUB(b.x)], 1u);
        const unsigned gen = old / nloc;
        if (old + 1u == (gen + 1u) * nloc) {
            __builtin_amdgcn_fence(__ATOMIC_RELEASE, "agent");
            asm volatile("s_waitcnt vmcnt(0)" ::: "memory");
            const unsigned og = xb_add(&bar[XB_TOP], 1u);
            const unsigned tg = og / nx;
            if (og + 1u == (tg + 1u) * nx) xb_add(&bar[XB_TOPGEN], 1u);
            else XB_SPIN(xb_ld(&bar[XB_TOPGEN]) == tg, bar);
            __builtin_amdgcn_fence(__ATOMIC_ACQUIRE, "agent");
            xb_add(&bar[XB_XGEN(b.x)], 1u);
            asm volatile("s_waitcnt vmcnt(0)" ::: "memory");
        } else {
            XB_SPIN(xb_ld(&bar[XB_XGEN(b.x)]) == gen, bar);
            __builtin_amdgcn_fence(__ATOMIC_ACQUIRE, "agent");
            asm volatile("s_waitcnt vmcnt(0)" ::: "memory");
        }
    }
    __syncthreads();
}


using pg8::gelu_t;
struct WaveId { int gw, ngw, wave, lane; };
DEV unsigned f2bf_u(float f) { return (unsigned)f2bf(f); }
DEV unsigned pk2(float lo, float hi) { return cvt_pk_bf16(lo, hi); }

DEV void norm_rows(const WaveId& W, const float* x, const float* g, bf16_t* outb, float* outf, int rows) {
    for (int row = W.gw; row < rows; row += W.ngw) {
        const f32x4* xr = (const f32x4*)(x + (size_t)row * D) + W.lane;
        f32x4 v[4]; float s = 0.f;
#pragma unroll
        for (int j = 0; j < 4; ++j) { v[j] = xr[64 * j]; s += (v[j].x * v[j].x + v[j].y * v[j].y) + (v[j].z * v[j].z + v[j].w * v[j].w); }
        const float r = rsqrtf(wave_sum(s) * (1.f / D) + EPS);
#pragma unroll
        for (int j = 0; j < 4; ++j) {
            const f32x4 gg = ((const f32x4*)g)[W.lane + 64 * j];
            const f32x4 o = {v[j].x * r * gg.x, v[j].y * r * gg.y, v[j].z * r * gg.z, v[j].w * r * gg.w};
            if (outb) { u32x2 w; w.x = pk2(o.x, o.y); w.y = pk2(o.z, o.w); ((u32x2*)(outb + (size_t)row * D))[W.lane + 64 * j] = w; }
            else ((f32x4*)(outf + (size_t)row * D))[W.lane + 64 * j] = o;
        }
    }
}
DEV void cvt_piece(const WaveId& W, LAS float* scr, int& base, const float* Wsrc, int ldw, int K, int col0, int ncols, bf16_t* dst, int ldo, int row0, const float* gain = nullptr) {
    const int nblk = ncols / 32, nitems = (K / 64) * nblk;
    int first = (W.gw - base) % W.ngw; if (first < 0) first += W.ngw;
    base = (base + nitems) % W.ngw;
    for (int item = first; item < nitems; item += W.ngw) {
        const int kb = item / nblk, nb = item - kb * nblk, k0 = 64 * kb, n0 = 32 * nb;
        { const int lr = W.lane >> 3, lc = (W.lane & 7) * 4;
          f32x4 v[8]; float g[8];
#pragma unroll
          for (int i = 0; i < 8; ++i) { v[i] = *(const f32x4*)(Wsrc + (size_t)(k0 + lr + 8 * i) * ldw + col0 + n0 + lc); g[i] = gain ? gain[k0 + lr + 8 * i] : 1.f; }
#pragma unroll
          for (int i = 0; i < 8; ++i) { LAS float* d = scr + (lr + 8 * i) * 33 + lc; d[0] = v[i][0] * g[i]; d[1] = v[i][1] * g[i]; d[2] = v[i][2] * g[i]; d[3] = v[i][3] * g[i]; } }
        LDS_WAIT(); asm volatile("" ::: "memory");
        const int c = W.lane & 7;
#pragma unroll
        for (int j = 0; j < 4; ++j) { const int n = (W.lane >> 3) + 8 * j; const LAS float* s = scr + (8 * c) * 33 + n;
            u32x4 o; o.x = pk2(s[0 * 33], s[1 * 33]); o.y = pk2(s[2 * 33], s[3 * 33]); o.z = pk2(s[4 * 33], s[5 * 33]); o.w = pk2(s[6 * 33], s[7 * 33]);
            *(u32x4*)(dst + (size_t)(row0 + n0 + n) * ldo + k0 + 8 * c) = o; }
        LDS_WAIT(); asm volatile("" ::: "memory");
    }
}
DEV void convert_layer_weights(const WaveId& W, LAS float* scr, int& base, unsigned char* ws, const float* const* in, int l, int part = 3) {
    const float* wi = in[3] + (size_t)l * D * DIN;
    if (part & 1) {
    bf16_t* WIN = (bf16_t*)(ws + WS_WIN); const float* gm = in[2] + l * D;
    cvt_piece(W, scr, base, wi, DIN, D, 0, 1536, WIN, D, 0, gm);
    cvt_piece(W, scr, base, wi, DIN, D, 3072, 1536, WIN, D, 1536, gm);
    cvt_piece(W, scr, base, wi, DIN, D, 4608, 512, WIN, D, 3072, gm);
    cvt_piece(W, scr, base, wi, DIN, D, 1536, 512, WIN, D, 3584, gm);
#pragma unroll 1
    for (int j = 0; j < 4; ++j) { cvt_piece(W, scr, base, wi, DIN, D, 2048 + 128 * j, 128, WIN, D, 4096 + 256 * j, gm); cvt_piece(W, scr, base, wi, DIN, D, 2560 + 128 * j, 128, WIN, D, 4096 + 256 * j + 128, gm); }
    cvt_piece(W, scr, base, wi, DIN, D, 5120, 96, WIN, D, 5120, gm);
    cvt_piece(W, scr, base, wi, DIN, D, 5192, 3072, (bf16_t*)(ws + WS_WG), D, 0, gm);
#pragma unroll 1
    for (int i = 0; i < 3; ++i) cvt_piece(W, scr, base, in[5 + i] + (size_t)l * 512 * D, D, 512, 0, D, (bf16_t*)(ws + WS_WBR) + (size_t)i * D * 512, 512, 0);
    cvt_piece(W, scr, base, in[8] + (size_t)l * D * D, D, D, 0, D, (bf16_t*)(ws + WS_WMIX), D, 0);
    }
    if (!(part & 2)) return;
    const float* gf = in[14] + l * D;
    const float* wf = in[15] + (size_t)l * D * 2 * DFF;
#pragma unroll 1
    for (int j = 0; j < 22; ++j) { cvt_piece(W, scr, base, wf, 2 * DFF, D, 128 * j, 128, (bf16_t*)(ws + WS_WUP), D, 256 * j, gf); cvt_piece(W, scr, base, wf, 2 * DFF, D, DFF + 128 * j, 128, (bf16_t*)(ws + WS_WUP), D, 256 * j + 128, gf); }
    cvt_piece(W, scr, base, in[18] + (size_t)l * DFF * D, D, DFF, 0, D, (bf16_t*)(ws + WS_WDOWN), DFF, 0);
}
DEV void prep0_phase(const WaveId& W, LAS float* scr, unsigned char* ws, const float* const* in, bf16_t* XB) {
    int base = 0;
#pragma unroll 1
    for (int l = 0; l < DEPTH; ++l) {
        const float* wq = in[11] + (size_t)l * D * D; bf16_t* WQ = (bf16_t*)(ws + WS_WQ + (size_t)l * 2 * MiB); const float* gx = in[9] + l * D;
        for (size_t i = (size_t)(W.gw * 64 + W.lane) * 4; i < (size_t)D * D; i += (size_t)W.ngw * 256) { const float g = gx[i >> 10]; const f32x4 v = *(const f32x4*)(wq + i); u32x2 o; o.x = pk2(v.x * g, v.y * g); o.y = pk2(v.z * g, v.w * g); *(u32x2*)(WQ + i) = o; }
        cvt_piece(W, scr, base, in[13] + (size_t)l * D * D, D, D, 0, D, (bf16_t*)(ws + WS_WOT + (size_t)l * 2 * MiB), D, 0);
        cvt_piece(W, scr, base, in[12] + (size_t)l * D * 2 * D, 2 * D, D, 0, 2 * D, (bf16_t*)(ws + WS_WKVT + (size_t)l * 4 * MiB), D, 0);
        norm_rows(W, in[1], in[10] + l * D, (bf16_t*)(ws + WS_MEMN + (size_t)l * MiB), nullptr, NB * MEM);
    }
    convert_layer_weights(W, scr, base, ws, in, 0);
    pg8::u64* ss0 = (pg8::u64*)(ws + WS_SS);
    for (int row = W.gw; row < T; row += W.ngw) {
        const f32x4* xr = (const f32x4*)(in[0] + (size_t)row * D) + W.lane; float s = 0.f;
#pragma unroll
        for (int j = 0; j < 4; ++j) { const f32x4 v = xr[64 * j]; s += (v.x * v.x + v.y * v.y) + (v.z * v.z + v.w * v.w);
            u32x2 w; w.x = pk2(v.x, v.y); w.y = pk2(v.z, v.w); ((u32x2*)(XB + (size_t)row * D))[W.lane + 64 * j] = w; }
        s = wave_sum(s); if (W.lane == 0) ss0[row] = (pg8::u64)(s * pg8::SS_SCALE + 0.5f);
    }
}
DEV void final_norm(const WaveId& W, const bf16_t* x, float* out, const float* g, const pg8::u64* ss) {
    for (int row = W.gw; row < T; row += W.ngw) {
        const float r = rsqrtf((float)ss[row] * (1.f / (pg8::SS_SCALE * D)) + EPS); const u32x2* xr = (const u32x2*)(x + (size_t)row * D) + W.lane; f32x4* orow = (f32x4*)(out + (size_t)row * D) + W.lane;
#pragma unroll
        for (int j = 0; j < 4; ++j) { const f32x4 gg = ((const f32x4*)g)[W.lane + 64 * j]; const u32x2 v = xr[64 * j];
            const f32x4 o = {bflo(v.x) * r * gg.x, bfhi(v.x) * r * gg.y, bflo(v.y) * r * gg.z, bfhi(v.y) * r * gg.w}; orow[64 * j] = o; }
    }
}
DEV void conv_sc_phase(int gtid, int gthreads, bf16_t* scb, const bf16_t* cx, const float* w, bool dry) {
    for (int i = gtid; i < T * 64; i += gthreads) {
        const int c8 = (i & 63) * 8, t = i >> 6, tl = t & (S - 1);
        const size_t o = (size_t)t * 512 + c8;
        const u32x4 z = {0u, 0u, 0u, 0u};
        const u32x4 x2 = *(const u32x4*)(cx + o), x1 = tl >= 1 ? *(const u32x4*)(cx + o - 512) : z, x0 = tl >= 2 ? *(const u32x4*)(cx + o - 1024) : z, bb = *(const u32x4*)(scb + o);
        const f32x4 w0a = *(const f32x4*)(w + c8), w0b = *(const f32x4*)(w + c8 + 4), w1a = *(const f32x4*)(w + 512 + c8), w1b = *(const f32x4*)(w + 512 + c8 + 4), w2a = *(const f32x4*)(w + 1024 + c8), w2b = *(const f32x4*)(w + 1024 + c8 + 4);
        float r[8];
#define CONV1(k, W0, W1, W2, X0, X1, X2, BBv, F) r[k] = F(BBv) * (W0 * F(X0) + W1 * F(X1) + W2 * F(X2))
        CONV1(0, w0a.x, w1a.x, w2a.x, x0.x, x1.x, x2.x, bb.x, bflo); CONV1(1, w0a.y, w1a.y, w2a.y, x0.x, x1.x, x2.x, bb.x, bfhi);
        CONV1(2, w0a.z, w1a.z, w2a.z, x0.y, x1.y, x2.y, bb.y, bflo); CONV1(3, w0a.w, w1a.w, w2a.w, x0.y, x1.y, x2.y, bb.y, bfhi);
        CONV1(4, w0b.x, w1b.x, w2b.x, x0.z, x1.z, x2.z, bb.z, bflo); CONV1(5, w0b.y, w1b.y, w2b.y, x0.z, x1.z, x2.z, bb.z, bfhi);
        CONV1(6, w0b.z, w1b.z, w2b.z, x0.w, x1.w, x2.w, bb.w, bflo); CONV1(7, w0b.w, w1b.w, w2b.w, x0.w, x1.w, x2.w, bb.w, bfhi);
#undef CONV1
        u32x4 ov; ov.x = pk2(r[0], r[1]); ov.y = pk2(r[2], r[3]); ov.z = pk2(r[4], r[5]); ov.w = pk2(r[6], r[7]);
        if (!dry) *(u32x4*)(scb + o) = ov; else asm volatile("" :: "v"(ov));
    }
}
DEV void ffn_mid_phase(int gtid, int gthreads, const bf16_t* fa, bf16_t* fu, const float* cw, const float* cb, bool dry) {
    constexpr int C8 = DFF / 8;
    for (int i = gtid; i < T * C8; i += gthreads) {
        const int t = i / C8, c8 = (i - t * C8) * 8, tl = t & (S - 1);
        const size_t o = (size_t)t * DFF + c8;
        const u32x4 z = {0u, 0u, 0u, 0u};
        const u32x4 x2 = *(const u32x4*)(fa + o), x1 = tl >= 1 ? *(const u32x4*)(fa + o - DFF) : z, x0 = tl >= 2 ? *(const u32x4*)(fa + o - 2 * DFF) : z, uu = *(const u32x4*)(fu + o);
        const f32x4 w0a = *(const f32x4*)(cw + c8), w0b = *(const f32x4*)(cw + c8 + 4), w1a = *(const f32x4*)(cw + DFF + c8), w1b = *(const f32x4*)(cw + DFF + c8 + 4), w2a = *(const f32x4*)(cw + 2 * DFF + c8), w2b = *(const f32x4*)(cw + 2 * DFF + c8 + 4);
        const f32x4 ba = *(const f32x4*)(cb + c8), bb = *(const f32x4*)(cb + c8 + 4);
        float r[8];
#define FM1(k, B0, W0, W1, W2, X0, X1, X2, Uv, F) r[k] = gelu_t(B0 + W0 * F(X0) + W1 * F(X1) + W2 * F(X2)) * F(Uv)
        FM1(0, ba.x, w0a.x, w1a.x, w2a.x, x0.x, x1.x, x2.x, uu.x, bflo); FM1(1, ba.y, w0a.y, w1a.y, w2a.y, x0.x, x1.x, x2.x, uu.x, bfhi);
        FM1(2, ba.z, w0a.z, w1a.z, w2a.z, x0.y, x1.y, x2.y, uu.y, bflo); FM1(3, ba.w, w0a.w, w1a.w, w2a.w, x0.y, x1.y, x2.y, uu.y, bfhi);
        FM1(4, bb.x, w0b.x, w1b.x, w2b.x, x0.z, x1.z, x2.z, uu.z, bflo); FM1(5, bb.y, w0b.y, w1b.y, w2b.y, x0.z, x1.z, x2.z, uu.z, bfhi);
        FM1(6, bb.z, w0b.z, w1b.z, w2b.z, x0.w, x1.w, x2.w, uu.w, bflo); FM1(7, bb.w, w0b.w, w1b.w, w2b.w, x0.w, x1.w, x2.w, uu.w, bfhi);
#undef FM1
        u32x4 ov; ov.x = pk2(r[0], r[1]); ov.y = pk2(r[2], r[3]); ov.z = pk2(r[4], r[5]); ov.w = pk2(r[6], r[7]);
        if (!dry) *(u32x4*)(fu + o) = ov; else asm volatile("" :: "v"(ov));
    }
}

DEV void ffn_fix_phase(int gtid, int gthreads, const bf16_t* sa, const bf16_t* su, bf16_t* fu, const float* cw, const float* cb, int strip0 = 0, int nstrip = T / 64) {
    constexpr int C8 = DFF / 8;
    for (int i = gtid; i < nstrip * 2 * C8; i += gthreads) {
        const int sr = i / C8, c8 = (i - sr * C8) * 8, strip = strip0 + (sr >> 1), rr = sr & 1, t = strip * 64 + rr;
        const bool first = (strip & (S / 64 - 1)) == 0;
        const u32x4 z = {0u, 0u, 0u, 0u};
        const bf16_t* A = sa + (size_t)strip * 4 * DFF + c8; const bf16_t* Ap = A - 4 * DFF;
        const u32x4 x2 = *(const u32x4*)(A + rr * DFF);
        const u32x4 x1 = rr == 1 ? *(const u32x4*)A : (first ? z : *(const u32x4*)(Ap + 3 * DFF));
        const u32x4 x0 = first ? z : *(const u32x4*)(Ap + (2 + rr) * DFF);
        const u32x4 uu = *(const u32x4*)(su + ((size_t)strip * 2 + rr) * DFF + c8);
        const f32x4 w0a = *(const f32x4*)(cw + c8), w0b = *(const f32x4*)(cw + c8 + 4), w1a = *(const f32x4*)(cw + DFF + c8), w1b = *(const f32x4*)(cw + DFF + c8 + 4), w2a = *(const f32x4*)(cw + 2 * DFF + c8), w2b = *(const f32x4*)(cw + 2 * DFF + c8 + 4);
        const f32x4 ba = *(const f32x4*)(cb + c8), bb = *(const f32x4*)(cb + c8 + 4);
        float r[8];
#define FM1(k, B0, W0, W1, W2, X0, X1, X2, Uv, F) r[k] = gelu_t(B0 + W0 * F(X0) + W1 * F(X1) + W2 * F(X2)) * F(Uv)
        FM1(0, ba.x, w0a.x, w1a.x, w2a.x, x0.x, x1.x, x2.x, uu.x, bflo); FM1(1, ba.y, w0a.y, w1a.y, w2a.y, x0.x, x1.x, x2.x, uu.x, bfhi);
        FM1(2, ba.z, w0a.z, w1a.z, w2a.z, x0.y, x1.y, x2.y, uu.y, bflo); FM1(3, ba.w, w0a.w, w1a.w, w2a.w, x0.y, x1.y, x2.y, uu.y, bfhi);
        FM1(4, bb.x, w0b.x, w1b.x, w2b.x, x0.z, x1.z, x2.z, uu.z, bflo); FM1(5, bb.y, w0b.y, w1b.y, w2b.y, x0.z, x1.z, x2.z, uu.z, bfhi);
        FM1(6, bb.z, w0b.z, w1b.z, w2b.z, x0.w, x1.w, x2.w, uu.w, bflo); FM1(7, bb.w, w0b.w, w1b.w, w2b.w, x0.w, x1.w, x2.w, uu.w, bfhi);
#undef FM1
        u32x4 ov; ov.x = pk2(r[0], r[1]); ov.y = pk2(r[2], r[3]); ov.z = pk2(r[4], r[5]); ov.w = pk2(r[6], r[7]);
        *(u32x4*)(fu + (size_t)t * DFF + c8) = ov;
    }
}

typedef short s16x4 __attribute__((ext_vector_type(4)));
DEV s16x4 vtr(const LAS unsigned char* p) { return __builtin_bit_cast(s16x4, __builtin_amdgcn_ds_read_tr16_b64_v4i16((LAS s16x4*)p)); }
DEV bf16x8 cat8(const s16x4 a, const s16x4 b) { return (bf16x8){a[0], a[1], a[2], a[3], b[0], b[1], b[2], b[3]}; }
DEV bf16x8 pk8(float a0, float a1, float a2, float a3, float a4, float a5, float a6, float a7) {
    u32x4 w; w.x = pk2(a0, a1); w.y = pk2(a2, a3); w.z = pk2(a4, a5); w.w = pk2(a6, a7); return __builtin_bit_cast(bf16x8, w); }
constexpr int VPITCH = 192;
DEV void pv_tile(f32x16& o0, f32x16& o1, const LAS unsigned char* vt, int lane, const bf16x8 (&pk)[4]) {
    const int hi = lane >> 5;
    const LAS unsigned char* vb = vt + (4 * hi + ((lane & 15) >> 2)) * VPITCH + ((lane >> 4) & 1) * 32 + (lane & 3) * 8;
    bf16x8 va[4];
#pragma unroll
    for (int ks = 0; ks < 4; ++ks) va[ks] = cat8(vtr(vb + (16 * ks) * VPITCH), vtr(vb + (16 * ks + 8) * VPITCH));
    asm volatile("" : "+v"(va[0]), "+v"(va[1]), "+v"(va[2]), "+v"(va[3]));
#pragma unroll
    for (int ks = 0; ks < 4; ++ks) o0 = __builtin_amdgcn_mfma_f32_32x32x16_bf16(va[ks], pk[ks], o0, 0, 0, 0);
#pragma unroll
    for (int ks = 0; ks < 4; ++ks) va[ks] = cat8(vtr(vb + (16 * ks) * VPITCH + 64), vtr(vb + (16 * ks + 8) * VPITCH + 64));
    asm volatile("" : "+v"(va[0]), "+v"(va[1]), "+v"(va[2]), "+v"(va[3]));
#pragma unroll
    for (int ks = 0; ks < 4; ++ks) o1 = __builtin_amdgcn_mfma_f32_32x32x16_bf16(va[ks], pk[ks], o1, 0, 0, 0);
}
DEV void store_ot(bf16_t* orow, const f32x16& o0, const f32x16& o1, int hi, float sc) {
#pragma unroll
    for (int g4 = 0; g4 < 4; ++g4) {
        u32x2 a; a.x = pk2(o0[4 * g4] * sc, o0[4 * g4 + 1] * sc); a.y = pk2(o0[4 * g4 + 2] * sc, o0[4 * g4 + 3] * sc);
        u32x2 b; b.x = pk2(o1[4 * g4] * sc, o1[4 * g4 + 1] * sc); b.y = pk2(o1[4 * g4 + 2] * sc, o1[4 * g4 + 3] * sc);
        *(u32x2*)(orow + 8 * g4 + 4 * hi) = a; *(u32x2*)(orow + 32 + 8 * g4 + 4 * hi) = b;
    }
}

DEV void sb_item(LAS unsigned char* vl, const bf16_t* Q, const bf16_t* Kk, const bf16_t* V, bf16_t* O, int b, int h, int qb, int lane, bool dry) {
    const int r32 = lane & 31, hi = lane >> 5, t0 = 32 * qb, t = t0 + r32; const size_t rowb = (size_t)b * S;
    bf16x8 qr[4]; { const bf16_t* qp = Q + (rowb + t0 + r32) * 512 + h * 64 + 8 * hi;
#pragma unroll
        for (int d0 = 0; d0 < 4; ++d0) qr[d0] = *(const bf16x8*)(qp + 16 * d0); }
    f32x16 o0, o1;
#pragma unroll
    for (int r = 0; r < 16; ++r) { o0[r] = 0.f; o1[r] = 0.f; }
    float carry = 1.f;
    const int c_hi = (t0 + 30) >> 6;
#pragma unroll 1
    for (int c = c_hi; c >= 0; --c) {
        const bf16_t* kp = Kk + (rowb + 64 * c + r32) * 512 + h * 64 + 8 * hi;
        bf16x8 k0[4], k1[4];
#pragma unroll
        for (int d0 = 0; d0 < 4; ++d0) { k0[d0] = *(const bf16x8*)(kp + 16 * d0); k1[d0] = *(const bf16x8*)(kp + (size_t)32 * 512 + 16 * d0); }
#pragma unroll
        for (int j = 0; j < 8; ++j) { const int row = (lane >> 3) + 8 * j; *(LAS u32x4*)(vl + row * VPITCH + (lane & 7) * 16) = *(const u32x4*)(V + (rowb + 64 * c + row) * 512 + h * 64 + (lane & 7) * 8); }
        f32x16 p0, p1;
#pragma unroll
        for (int r = 0; r < 16; ++r) { p0[r] = 0.f; p1[r] = 0.f; }
#pragma unroll
        for (int d0 = 0; d0 < 4; ++d0) { p0 = __builtin_amdgcn_mfma_f32_32x32x16_bf16(k0[d0], qr[d0], p0, 0, 0, 0); p1 = __builtin_amdgcn_mfma_f32_32x32x16_bf16(k1[d0], qr[d0], p1, 0, 0, 0); }
        float u[32];
        const bool diag = (c == c_hi);
#pragma unroll
        for (int e = 0; e < 32; ++e) {
            const float z = e < 16 ? p0[e] : p1[e - 16];
            float uu = __builtin_amdgcn_rcpf(1.f + __builtin_amdgcn_exp2f(fminf(z, 126.f)));
            if (diag) { const int kv = 64 * c + 8 * ((e >> 2) & 3) + 4 * hi + (e & 3) + 32 * (e >> 4); if (kv >= t) uu = 1.f; }
            u[e] = uu;
        }
        float gl[8], gh[8];
#pragma unroll
        for (int i = 0; i < 8; ++i) { const float gp = (u[4 * i] * u[4 * i + 1]) * (u[4 * i + 2] * u[4 * i + 3]);
            const auto rr = __builtin_amdgcn_permlane32_swap(__float_as_uint(gp), __float_as_uint(gp), false, false); gl[i] = __uint_as_float(rr[0]); gh[i] = __uint_as_float(rr[1]); }
        float ag[8]; float run = carry;
#pragma unroll
        for (int i = 7; i >= 0; --i) { const float a_hi = run; run *= gh[i]; const float a_lo = run; run *= gl[i]; ag[i] = hi ? a_hi : a_lo; }
        carry = run;
        bf16x8 pk[4];
#pragma unroll
        for (int ks = 0; ks < 4; ++ks) { float w[8];
#pragma unroll
            for (int g = 0; g < 2; ++g) { const int i = 2 * ks + g;
                const float a3 = ag[i], a2 = a3 * u[4 * i + 3], a1 = a2 * u[4 * i + 2], a0 = a1 * u[4 * i + 1];
                w[4 * g] = (1.f - u[4 * i]) * a0; w[4 * g + 1] = (1.f - u[4 * i + 1]) * a1; w[4 * g + 2] = (1.f - u[4 * i + 2]) * a2; w[4 * g + 3] = (1.f - u[4 * i + 3]) * a3; }
            pk[ks] = pk8(w[0], w[1], w[2], w[3], w[4], w[5], w[6], w[7]); }
        pv_tile(o0, o1, vl, lane, pk);
        if (__all(carry < 7.8e-31f)) break;
    }
    if (!dry) store_ot(O + (rowb + t0 + r32) * 512 + h * 64, o0, o1, hi, 1.f); else asm volatile("" :: "v"(o0), "v"(o1));
}
DEV void sb_phase(const WaveId& W, LAS unsigned char* lds, unsigned char* ws, bool dry) {
    LAS unsigned char* vl = lds + W.wave * 12288;
    const bf16_t* Q = (const bf16_t*)(ws + WS_QA); const bf16_t* Kk = (const bf16_t*)(ws + WS_KA); const bf16_t* V = (const bf16_t*)(ws + WS_VA);
    constexpr int NITEM = NB * 8 * (S / 32);
    for (int it = W.gw; it < NITEM; it += W.ngw) {
        const int qb = it & 255, h = (it >> 8) & 7, b = it >> 11;
        sb_item(vl, Q, Kk, V, (bf16_t*)(ws + WS_QA), b, h, qb, W.lane, dry);
    }
}

constexpr int IDX_CTL_OFF = 131072 + 1024;
DEV unsigned fkey2(float v) { const int u = (int)__float_as_uint(v); return (unsigned)(u ^ ((u >> 31) | (int)0x80000000)); }
DEV float relu1(float x) { return __builtin_amdgcn_fmed3f(x, 0.f, 3.0e38f); }
DEV void idx_prefetch(bf16x8 (&afr)[4], float (&w)[16], bf16x8 (&b0)[4], bf16x8 (&b1)[4], const bf16_t* IQ, const bf16_t* IK, const float* IWp, int b, int t0, int wid, int lane) {
    const int r32 = lane & 31, hh = lane >> 5; const size_t rowb = (size_t)b * S;
    { const int qi = 2 * (r32 >> 4) + ((r32 >> 2) & 1), head = (r32 & 3) + 4 * ((r32 >> 3) & 1);
        const bf16_t* ap = IQ + (rowb + t0 + qi) * 512 + head * 64 + 8 * hh;
#pragma unroll
        for (int ks = 0; ks < 4; ++ks) afr[ks] = *(const bf16x8*)(ap + 16 * ks); }
#pragma unroll
    for (int r = 0; r < 16; ++r) w[r] = IWp[(rowb + t0 + 2 * (r >> 3) + hh) * 8 + (r & 7)];
    const int jmax = (t0 + 3) >> 5;
    { const int j0 = wid < jmax ? wid : jmax, j1 = wid + 8 < jmax ? wid + 8 : jmax;
      const bf16_t* p0 = IK + ((rowb >> 5) + j0) * 2048 + (hh * 32 + r32) * 8; const bf16_t* p1 = IK + ((rowb >> 5) + j1) * 2048 + (hh * 32 + r32) * 8;
#pragma unroll
      for (int ks = 0; ks < 4; ++ks) { b0[ks] = *(const bf16x8*)(p0 + ks * 512); b1[ks] = *(const bf16x8*)(p1 + ks * 512); } }
}
DEV void idx_unit(LAS unsigned char* lds, const bf16_t* IQ, const bf16_t* IK, const float* IWp, unsigned* BM, int b, int t0, int nb, int nt0, int wid, int lane,
                  bf16x8 (&afr)[4], float (&w)[16], bf16x8 (&b0)[4], bf16x8 (&b1)[4]) {
    const int r32 = lane & 31, hh = lane >> 5; const size_t rowb = (size_t)b * S;
    const int tmax = t0 + 3, jmax = tmax >> 5;
    LAS unsigned* SCO = (LAS unsigned*)lds;
    bf16x8 b2[4];
#pragma unroll
    for (int ks = 0; ks < 4; ++ks) b2[ks] = afr[ks];
#define IDX_LOADB(dst, jj) do { const int jc_ = (jj) < jmax ? (jj) : jmax; const bf16_t* bp_ = IK + ((rowb >> 5) + jc_) * 2048 + (hh * 32 + r32) * 8; \
        _Pragma("unroll") for (int ks = 0; ks < 4; ++ks) dst[ks] = *(const bf16x8*)(bp_ + ks * 512); } while (0)
#define IDX_COMP(src, jj) do { f32x16 acc; _Pragma("unroll") for (int r = 0; r < 16; ++r) acc[r] = 0.f; \
        _Pragma("unroll") for (int ks = 0; ks < 4; ++ks) acc = __builtin_amdgcn_mfma_f32_32x32x16_bf16(afr[ks], src[ks], acc, 0, 0, 0); \
        float s0 = 0.f, s1 = 0.f; _Pragma("unroll") for (int hd = 0; hd < 8; ++hd) { s0 += w[hd] * relu1(acc[hd]); s1 += w[8 + hd] * relu1(acc[8 + hd]); } \
        unsigned k0_ = fkey2(s0), k1_ = fkey2(s1); const int key = 32 * (jj) + r32; \
        if ((jj) >= jmax) { k0_ = key <= t0 + hh ? k0_ : 0u; k1_ = key <= t0 + 2 + hh ? k1_ : 0u; }     \
        if ((jj) <= jmax) { SCO[hh * 8192 + key] = k0_; SCO[(2 + hh) * 8192 + key] = k1_; } } while (0)
#ifndef IDX_REP_MFMA
#define IDX_REP_MFMA 1
#endif
#ifndef IDX_REP_SEL
#define IDX_REP_SEL 1
#endif
#ifdef IDX_DRY_COMPUTE
#pragma unroll 1
    for (int j = wid; j <= jmax; j += 24) { IDX_COMP(b0, j); asm volatile("" : "+v"(b0[0]), "+v"(b1[0]), "+v"(b2[0])); IDX_COMP(b1, j + 8); IDX_COMP(b2, j + 16); }
#endif
#pragma unroll 1
    for (int rpm = 0; rpm < IDX_REP_MFMA; ++rpm) {
#pragma unroll 1
    for (int j = wid; j <= jmax; j += 24) {
        IDX_LOADB(b2, j + 16); IDX_COMP(b0, j);
        IDX_LOADB(b0, j + 24); IDX_COMP(b1, j + 8);
        IDX_LOADB(b1, j + 32); IDX_COMP(b2, j + 16);
    }
    }
#undef IDX_LOADB
#undef IDX_COMP
    if (nt0 >= 0) idx_prefetch(afr, w, b0, b1, IQ, IK, IWp, nb, nt0, wid, lane);
    LAS unsigned* thr = (LAS unsigned*)(lds + IDX_CTL_OFF);
    if (wid == 0 && lane < 32) ((LAS unsigned*)(lds + IDX_CTL_OFF + 64))[lane] = 0u;
    LDS_WAIT(); __builtin_amdgcn_s_barrier(); asm volatile("" ::: "memory");
    {
        const int q = wid & 3, h = wid >> 2, n = t0 + q + 1;
        volatile LAS unsigned* xme = (volatile LAS unsigned*)(lds + IDX_CTL_OFF + 64) + (q * 2 + h) * 4;
        volatile LAS unsigned* xpa = (volatile LAS unsigned*)(lds + IDX_CTL_OFF + 64) + (q * 2 + (h ^ 1)) * 4;
        unsigned T_ = 1u;
        if (n > 256) {
            LAS unsigned* row = SCO + q * 8192 + lane;
            unsigned r[64];
            const int nil = (jmax >> 1) >= h ? (((jmax >> 1) - h) >> 1) + 1 : 0;
#define IDX_FOR_LIVE(BODY) _Pragma("unroll") for (int g8_ = 0; g8_ < 8; ++g8_) if (8 * g8_ < nil) { _Pragma("unroll") for (int u8_ = 0; u8_ < 8; ++u8_) { const int il = 8 * g8_ + u8_; BODY } }
            IDX_FOR_LIVE( r[il] = (2 * (2 * il + h) + hh <= jmax) ? row[64 * (2 * il + h)] : 0u; )
            unsigned seq = 0u;
#define IDX_XCHG(val, out) do { ++seq; const int pb_ = (seq & 1u) * 2; if (lane == 0) { xme[pb_ + 1] = (val); xme[pb_] = seq; } \
                while (xpa[pb_] != seq) __builtin_amdgcn_s_sleep(0); (out) = xpa[pb_ + 1]; } while (0)
#define IDX_XCHG16(val, out) do { ++seq; const int pb_ = (seq & 1u) * 2; if (lane == 0) xme[pb_] = (seq << 16) | (val); unsigned w_; \
                while (((w_ = xpa[pb_]) >> 16) != (seq & 0xffffu)) __builtin_amdgcn_s_sleep(0); (out) = w_ & 0xffffu; } while (0)
#pragma unroll 1
            for (int rps = 0; rps < IDX_REP_SEL; ++rps) {
            unsigned mx = 0u;
            IDX_FOR_LIVE( mx = max(mx, r[il]); )
#pragma unroll
            for (int o = 1; o < 64; o <<= 1) mx = max(mx, (unsigned)__shfl_xor((int)mx, o));
            { unsigned pm_; IDX_XCHG(mx, pm_); mx = max(mx, pm_); }
            unsigned lo_ = 1u, hi_ = mx + 1u, chi_ = 0u, xgt_ = 1u, xeq_ = 0u, mt_ = 0u; float glo_ = __log2f((float)n) - 8.f, ghi_ = -9.f; int side_ = 0; bool done_ = false;
#pragma unroll 1
            for (int pass = 0; pass < 2 && !done_; ++pass) {
                const unsigned wdt = hi_ - lo_;
                unsigned off;
                if (pass < 2) {
                    const unsigned mkey = hi_ - 1u; const unsigned tgt = pass == 0 ? mkey - (1u << 23) : mkey - (3u << 23);
                    const bool ok = pass == 0 ? (mkey > 0x81000000u) : (mkey > 0x82000000u && tgt > lo_ && tgt < hi_);
                    off = ok ? tgt - lo_ : wdt >> 1;
                } else if ((pass & 3) == 3) off = wdt >> 1;
                else off = (unsigned)(glo_ * __builtin_amdgcn_rcpf(glo_ - ghi_) * (float)wdt);
                off = off < 1u ? 1u : (off > wdt - 1u ? wdt - 1u : off);
                const unsigned cand = (unsigned)__builtin_amdgcn_readfirstlane((int)(lo_ + off));
                unsigned ca_ = 0, cb_ = 0; const unsigned candv = lo_ + off;
#define IDX_CNT4(A, B, C, Dd) asm volatile("v_cmp_ge_u32_e64 s[88:89], %2, %6\n\tv_cmp_ge_u32_e64 s[90:91], %3, %6\n\tv_cmp_ge_u32_e64 s[92:93], %4, %6\n\tv_cmp_ge_u32_e64 s[94:95], %5, %6\n\t" \
                    "v_addc_co_u32_e64 %0, s[88:89], %0, 0, s[88:89]\n\tv_addc_co_u32_e64 %1, s[90:91], %1, 0, s[90:91]\n\tv_addc_co_u32_e64 %0, s[92:93], %0, 0, s[92:93]\n\tv_addc_co_u32_e64 %1, s[94:95], %1, 0, s[94:95]" \
                    : "+v"(ca_), "+v"(cb_) : "v"(A), "v"(B), "v"(C), "v"(Dd), "v"(candv) : "s88", "s89", "s90", "s91", "s92", "s93", "s94", "s95")
#pragma unroll
                for (int g8_ = 0; g8_ < 8; ++g8_) if (8 * g8_ < nil) { IDX_CNT4(r[8 * g8_], r[8 * g8_ + 1], r[8 * g8_ + 2], r[8 * g8_ + 3]); IDX_CNT4(r[8 * g8_ + 4], r[8 * g8_ + 5], r[8 * g8_ + 6], r[8 * g8_ + 7]); }
#undef IDX_CNT4
                int pk = (int)(ca_ + cb_);
                pk += __builtin_amdgcn_update_dpp(0, pk, 0x111, 0xf, 0xf, false);
                pk += __builtin_amdgcn_update_dpp(0, pk, 0x112, 0xf, 0xf, false);
                pk += __builtin_amdgcn_update_dpp(0, pk, 0x114, 0xf, 0xf, false);
                pk += __builtin_amdgcn_update_dpp(0, pk, 0x118, 0xf, 0xf, false);
                pk += __builtin_amdgcn_update_dpp(0, pk, 0x142, 0xa, 0xf, false);
                unsigned tot = (unsigned)__builtin_amdgcn_readlane(pk, 31) + (unsigned)__builtin_amdgcn_readlane(pk, 63);
                { unsigned pt_; IDX_XCHG16(tot, pt_); tot += pt_; }
                const float gc = __log2f(fmaxf((float)tot, 0.5f)) - 8.f;
                if (tot == 256u) { xgt_ = cand; mt_ = 0u; done_ = true; }
                else { if (tot > 256u) { if (side_ == 1) ghi_ *= 0.5f; lo_ = cand; glo_ = gc; side_ = 1; }
                       else { if (side_ == 2) glo_ *= 0.5f; hi_ = cand; ghi_ = gc; chi_ = tot; side_ = 2; }
                       if (hi_ - lo_ == 1u) { xgt_ = hi_; xeq_ = lo_; mt_ = 256u - chi_; done_ = true; } }
            }
            { LAS unsigned* hist = (LAS unsigned*)(lds + IDX_CTL_OFF + 1024) + q * 256;
#pragma unroll 1
              for (int round = 0; round < 6 && !done_; ++round) {
                const unsigned wdt = hi_ - lo_;
                const int sh = wdt <= 256u ? 0 : 24 - (int)__builtin_clz(wdt - 1u);
                hist[128 * h + lane] = 0u; hist[128 * h + 64 + lane] = 0u;
                LDS_WAIT(); { unsigned d_; IDX_XCHG16(0u, d_); (void)d_; }
                const unsigned lov = lo_;
                if (round == 0) {
                    IDX_FOR_LIVE( const unsigned d = r[il] - lov; if (d < wdt) __hip_atomic_fetch_add(hist + (d >> sh), 1u, __ATOMIC_RELAXED, __HIP_MEMORY_SCOPE_WORKGROUP); )
                } else {
#pragma unroll
                    for (int g8_ = 0; g8_ < 8; ++g8_) if (8 * g8_ < nil) {
#pragma unroll
                        for (int u4_ = 0; u4_ < 2; ++u4_) { const int il = 8 * g8_ + 4 * u4_;
                            const unsigned d0 = r[il] - lov, d1 = r[il + 1] - lov, d2 = r[il + 2] - lov, d3 = r[il + 3] - lov;
                            if (min(min(d0, d1), min(d2, d3)) < wdt) {
                                if (d0 < wdt) __hip_atomic_fetch_add(hist + (d0 >> sh), 1u, __ATOMIC_RELAXED, __HIP_MEMORY_SCOPE_WORKGROUP);
                                if (d1 < wdt) __hip_atomic_fetch_add(hist + (d1 >> sh), 1u, __ATOMIC_RELAXED, __HIP_MEMORY_SCOPE_WORKGROUP);
                                if (d2 < wdt) __hip_atomic_fetch_add(hist + (d2 >> sh), 1u, __ATOMIC_RELAXED, __HIP_MEMORY_SCOPE_WORKGROUP);
                                if (d3 < wdt) __hip_atomic_fetch_add(hist + (d3 >> sh), 1u, __ATOMIC_RELAXED, __HIP_MEMORY_SCOPE_WORKGROUP); } } }
                }
                LDS_WAIT(); { unsigned d_; IDX_XCHG16(0u, d_); (void)d_; }
                const u32x4 hb = *(const LAS u32x4*)(hist + 4 * lane);
                const unsigned s4 = (hb.x + hb.y) + (hb.z + hb.w);
                unsigned suf = s4;
#pragma unroll
                for (int o = 1; o < 64; o <<= 1) { const unsigned tv = (unsigned)__shfl_down((int)suf, o); if (lane + o < 64) suf += tv; }
                const unsigned long long okm = __ballot(chi_ + suf >= 256u);
                const int L = 63 - (int)__builtin_clzll(okm);
                const unsigned above = chi_ + (unsigned)__builtin_amdgcn_readlane((int)(suf - s4), L);
                const unsigned h0 = (unsigned)__builtin_amdgcn_readlane((int)hb.x, L), h1 = (unsigned)__builtin_amdgcn_readlane((int)hb.y, L),
                               h2 = (unsigned)__builtin_amdgcn_readlane((int)hb.z, L), h3 = (unsigned)__builtin_amdgcn_readlane((int)hb.w, L);
                unsigned Bsel, cab, cnb;
                if (above + h3 >= 256u) { Bsel = 3u; cab = above; cnb = h3; }
                else if (above + h3 + h2 >= 256u) { Bsel = 2u; cab = above + h3; cnb = h2; }
                else if (above + h3 + h2 + h1 >= 256u) { Bsel = 1u; cab = above + h3 + h2; cnb = h1; }
                else { Bsel = 0u; cab = above + h3 + h2 + h1; cnb = h0; }
                Bsel += 4u * (unsigned)L;
                const unsigned nlo = lo_ + (Bsel << sh); unsigned nhi = nlo + (1u << sh); if (nhi > hi_ || nhi < nlo) nhi = hi_;
                if (cab + cnb == 256u) { xgt_ = nlo; mt_ = 0u; done_ = true; }
                else if (sh == 0) { xgt_ = nlo + 1u; xeq_ = nlo; mt_ = 256u - cab; done_ = true; }
                else { lo_ = nlo; hi_ = nhi; chi_ = cab; }
              } }
#ifdef IDX_XTRA
#pragma unroll 1
            for (int xr = 0; xr < IDX_XTRA; ++xr) { unsigned dsum = 0; const unsigned cv = xgt_ + (unsigned)xr;
                IDX_FOR_LIVE( dsum += r[il] >= cv; )
                int pk = (int)dsum;
                pk += __builtin_amdgcn_update_dpp(0, pk, 0x111, 0xf, 0xf, false); pk += __builtin_amdgcn_update_dpp(0, pk, 0x112, 0xf, 0xf, false); pk += __builtin_amdgcn_update_dpp(0, pk, 0x114, 0xf, 0xf, false);
                pk += __builtin_amdgcn_update_dpp(0, pk, 0x118, 0xf, 0xf, false); pk += __builtin_amdgcn_update_dpp(0, pk, 0x142, 0xa, 0xf, false);
                unsigned tot = (unsigned)__builtin_amdgcn_readlane(pk, 31) + (unsigned)__builtin_amdgcn_readlane(pk, 63);
                { unsigned pt_; IDX_XCHG16(tot, pt_); tot += pt_; } asm volatile("" :: "s"(tot)); }
#endif
            T_ = xgt_;
            if (mt_ != 0u) {
                if (h == 0) { unsigned run = 0u;
#pragma unroll 1
                    for (int i = 0; i <= (jmax >> 1); ++i) { const bool ok_ = 2 * i + hh <= jmax; const unsigned kv = ok_ ? row[64 * i] : 0u; const bool eq = kv == xeq_; const unsigned long long bm = __ballot(eq);
                        const unsigned rank = run + __builtin_amdgcn_mbcnt_hi((unsigned)(bm >> 32), __builtin_amdgcn_mbcnt_lo((unsigned)bm, 0u));
                        if (eq && rank >= mt_) row[64 * i] = 0u;
                        run += (unsigned)__popcll(bm); } }
                T_ = xeq_;
            }
            }
#undef IDX_XCHG
#undef IDX_XCHG16
#undef IDX_FOR_LIVE
        }
        if (lane == 0 && h == 0) thr[q] = T_;
    }
#ifdef PROBE_VALU
    { float a0 = (float)lane, a1 = a0 + 1.f, a2 = a0 + 2.f, a3 = a0 + 3.f, a4 = a0 + 4.f, a5 = a0 + 5.f, a6 = a0 + 6.f, a7 = a0 + 7.f; const float m = 1.0000001f, c = 1e-9f;
#pragma unroll 1
      for (int it = 0; it < 64; ++it) {
#pragma unroll
          for (int u = 0; u < 8; ++u) { a0 = a0 * m + c; a1 = a1 * m + c; a2 = a2 * m + c; a3 = a3 * m + c; a4 = a4 * m + c; a5 = a5 * m + c; a6 = a6 * m + c; a7 = a7 * m + c; } }
      asm volatile("" :: "v"(a0), "v"(a1), "v"(a2), "v"(a3), "v"(a4), "v"(a5), "v"(a6), "v"(a7)); }
#endif
    LDS_WAIT(); __builtin_amdgcn_s_barrier(); asm volatile("" ::: "memory");
    { const unsigned tq0 = thr[hh], tq1 = thr[2 + hh];
#pragma unroll 4
      for (int j = wid; j <= ((t0 | 255) >> 5); j += 8) {
          bool s0 = false, s1 = false;
          if (j <= jmax) { s0 = SCO[hh * 8192 + 32 * j + r32] >= tq0; s1 = SCO[(2 + hh) * 8192 + 32 * j + r32] >= tq1; }
          const unsigned long long b0_ = __ballot(s0), b1_ = __ballot(s1);
          if (lane == 0) { u32x4 o; o.x = (unsigned)b0_; o.y = (unsigned)(b0_ >> 32); o.z = (unsigned)b1_; o.w = (unsigned)(b1_ >> 32); *(u32x4*)(BM + ((size_t)b * 256 + j) * S + t0) = o; }
      } }
    LDS_WAIT(); __builtin_amdgcn_s_barrier();
}
DEV void idx_phase(LAS unsigned char* lds, unsigned char* ws, int vcu, int G, int wid, int lane) {
    constexpr int NUNIT = T / 4;
    const bf16_t* IQ = (const bf16_t*)(ws + WS_IQ); const bf16_t* IK = (const bf16_t*)(ws + WS_IK); const float* IW = (const float*)(ws + WS_IW);
#define IDX_UNIT_OF(k) ((k) * G + (((k) & 1) ? G - 1 - vcu : vcu))
    bf16x8 afr[4], b0[4], b1[4]; float w[16];
    int un = IDX_UNIT_OF(0);
    if (un < NUNIT) { const int b = un / (S / 4); idx_prefetch(afr, w, b0, b1, IQ, IK, IW, b, (un - b * (S / 4)) * 4, wid, lane); }
#pragma unroll 1
    for (int k = 0; un < NUNIT; ++k) {
        const int b = un / (S / 4), t0 = (un - b * (S / 4)) * 4;
        const int nun = IDX_UNIT_OF(k + 1); const int nb = nun / (S / 4), nt0 = nun < NUNIT ? (nun - nb * (S / 4)) * 4 : -1;
        idx_unit(lds, IQ, IK, IW, (unsigned*)(ws + WS_BM), b, t0, nb, nt0, wid, lane, afr, w, b0, b1);
        un = nun;
    }
#undef IDX_UNIT_OF
}

DEV void kn_phase(const WaveId& W, const bf16_t* Kk, float* KN) {
    for (int item = W.gw; item < NB * 8 * (S / 64); item += W.ngw) {
        const int b = item / (8 * (S / 64)), h = (item / (S / 64)) & 7, tile = item % (S / 64);
        const bf16_t* kp = Kk + ((size_t)b * S + tile * 64 + W.lane) * 512 + h * 64;
        float ss = 0.f;
#pragma unroll
        for (int c = 0; c < 8; ++c) { const u32x4 v = *(const u32x4*)(kp + 8 * c);
#pragma unroll
            for (int e = 0; e < 4; ++e) { const float lo = __uint_as_float(v[e] << 16), hi = __uint_as_float(v[e] & 0xffff0000u); ss += lo * lo + hi * hi; } }
        const float m = wave_max(ss);
        if (W.lane == 0) KN[item] = sqrtf(m) * 1.01f;
    }
}

constexpr int DSA_STAGE = 8192 + 64 * VPITCH;
DEV void dsa_unit(LAS unsigned char* lds, const bf16_t* Q, const bf16_t* Kk, const bf16_t* V, const unsigned* BM, const float* KN, bf16_t* O, int b, int h, int qblk, int tid, int wid, int lane) {
    const int r32 = lane & 31, hi = lane >> 5, q0 = 256 * qblk, t0 = q0 + 32 * wid, t = t0 + r32; const size_t rowb = (size_t)b * S;
    bf16x8 qr[4]; { const bf16_t* qp = Q + (rowb + t) * 512 + h * 64 + 8 * hi;
#pragma unroll
        for (int d0 = 0; d0 < 4; ++d0) qr[d0] = *(const bf16x8*)(qp + 16 * d0); }
    f32x16 o0, o1, negm;
#pragma unroll
    for (int r = 0; r < 16; ++r) { o0[r] = 0.f; o1[r] = 0.f; negm[r] = 0.f; }
    float mref = 0.f, lsum = 0.f; bool seen = false;
    float qn; { float qs = 0.f;
#pragma unroll
        for (int d0 = 0; d0 < 4; ++d0)
#pragma unroll
            for (int e = 0; e < 8; ++e) { const float x = __uint_as_float(((unsigned)(unsigned short)qr[d0][e]) << 16); qs += x * x; }
        const auto rr = __builtin_amdgcn_permlane32_swap(__float_as_uint(qs), __float_as_uint(qs), false, false); qn = sqrtf(__uint_as_float(rr[0]) + __uint_as_float(rr[1])) * 1.01f; }
    constexpr float FASTB = 60.f;
    int zlane = 0; asm volatile("" : "+v"(zlane));
    const float* knp = KN + (b * 8 + h) * (S / 64) + zlane;
    float knv = knp[0];
    constexpr float THR = 8.f;
    const int ntile = (q0 + 256) / 64, wlast = (t0 + 31) >> 6;
    const int srow = tid >> 3, sch = tid & 7;
    const bf16_t* kg = Kk + (rowb + srow) * 512 + h * 64 + sch * 8; const bf16_t* vg = V + (rowb + srow) * 512 + h * 64 + sch * 8;
    const int kdst = srow * 128 + ((sch ^ (srow & 7)) * 16), vdst = srow * VPITCH + sch * 16;
    u32x4 kr0 = *(const u32x4*)kg, vr0 = *(const u32x4*)vg;
    *(LAS u32x4*)(lds + kdst) = kr0; *(LAS u32x4*)(lds + 8192 + vdst) = vr0;
    u32x4 kr1 = *(const u32x4*)(kg + (size_t)64 * 512), vr1 = *(const u32x4*)(vg + (size_t)64 * 512);
    const unsigned* bmp = BM + (size_t)b * 256 * S + t;
    unsigned mw0 = bmp[0], mw1 = bmp[(size_t)S];
    const int koff = r32 * 128;
    __syncthreads();
#define DSA_TILE(c, BUF, NBUF, KL, VL, KW, VW) do { \
        const LAS unsigned char* kt = lds + (BUF) * DSA_STAGE; const LAS unsigned char* vt = kt + 8192; \
        if ((c) + 2 < ntile) { KL = *(const u32x4*)(kg + (size_t)((c) + 2) * 64 * 512); VL = *(const u32x4*)(vg + (size_t)((c) + 2) * 64 * 512); } \
        unsigned nw0 = 0u, nw1 = 0u; float nkn = 0.f; \
        if ((c) + 1 <= wlast) { nw0 = bmp[(size_t)(2 * (c) + 2) * S]; nw1 = bmp[(size_t)(2 * (c) + 3) * S]; nkn = knp[(c) + 1]; } \
        if ((c) <= wlast) { \
            bf16x8 kf[8]; \
            _Pragma("unroll") for (int d0 = 0; d0 < 4; ++d0) { const int xo = ((2 * d0 + hi) ^ (r32 & 7)) * 16; \
                kf[2 * d0] = *(const LAS bf16x8*)(kt + koff + xo); kf[2 * d0 + 1] = *(const LAS bf16x8*)(kt + koff + 4096 + xo); } \
            asm volatile("" : "+v"(kf[0]), "+v"(kf[1]), "+v"(kf[2]), "+v"(kf[3]), "+v"(kf[4]), "+v"(kf[5]), "+v"(kf[6]), "+v"(kf[7]));     \
            f32x16 p0 = negm, p1 = negm; \
            _Pragma("unroll") for (int d0 = 0; d0 < 4; ++d0) { p0 = __builtin_amdgcn_mfma_f32_32x32x16_bf16(kf[2 * d0], qr[d0], p0, 0, 0, 0); p1 = __builtin_amdgcn_mfma_f32_32x32x16_bf16(kf[2 * d0 + 1], qr[d0], p1, 0, 0, 0); } \
            const unsigned m0 = mw0 >> (4 * hi), m1 = mw1 >> (4 * hi); \
            _Pragma("unroll") for (int r = 0; r < 16; ++r) { const int bit = (r & 3) + 8 * (r >> 2); \
                const unsigned e0 = (unsigned)__builtin_amdgcn_sbfe((int)m0, bit, 1), e1 = (unsigned)__builtin_amdgcn_sbfe((int)m1, bit, 1); \
                p0[r] = __uint_as_float((__float_as_uint(p0[r]) & e0) | (0xff800000u & ~e0)); p1[r] = __uint_as_float((__float_as_uint(p1[r]) & e1) | (0xff800000u & ~e1)); } \
            if (__any(!(qn * knv + fabsf(mref) <= FASTB))) {     \
                float rm = -INFINITY; \
                _Pragma("unroll") for (int r = 0; r < 16; r += 2) rm = fmaxf(rm, fmaxf(fmaxf(p0[r], p0[r + 1]), fmaxf(p1[r], p1[r + 1]))); \
                { const auto rr = __builtin_amdgcn_permlane32_swap(__float_as_uint(rm), __float_as_uint(rm), false, false); rm = fmaxf(__uint_as_float(rr[0]), __uint_as_float(rr[1])); } \
                const bool shift = rm > THR || (rm < -THR && rm > -INFINITY && !seen);     \
                if (__any(shift)) { \
                    const float dl = shift ? rm : 0.f, f = dl > 0.f ? __builtin_amdgcn_exp2f(-dl) : 1.f; \
                    mref += dl; lsum *= f; \
                    _Pragma("unroll") for (int r = 0; r < 16; ++r) { p0[r] -= dl; p1[r] -= dl; o0[r] *= f; o1[r] *= f; negm[r] = -mref; } \
                } \
            } \
            seen = seen || (mw0 | mw1) != 0u;     \
            float ps = 0.f; \
            _Pragma("unroll") for (int r = 0; r < 16; ++r) { p0[r] = __builtin_amdgcn_exp2f(p0[r]); p1[r] = __builtin_amdgcn_exp2f(p1[r]); ps += p0[r] + p1[r]; } \
            lsum += ps; \
            bf16x8 pk[4]; \
            pk[0] = pk8(p0[0], p0[1], p0[2], p0[3], p0[4], p0[5], p0[6], p0[7]); pk[1] = pk8(p0[8], p0[9], p0[10], p0[11], p0[12], p0[13], p0[14], p0[15]); \
            pk[2] = pk8(p1[0], p1[1], p1[2], p1[3], p1[4], p1[5], p1[6], p1[7]); pk[3] = pk8(p1[8], p1[9], p1[10], p1[11], p1[12], p1[13], p1[14], p1[15]); \
            pv_tile(o0, o1, vt, lane, pk); \
        } \
        mw0 = nw0; mw1 = nw1; knv = nkn; \
        if ((c) + 1 < ntile) { LAS unsigned char* nb = lds + (NBUF) * DSA_STAGE; *(LAS u32x4*)(nb + kdst) = KW; *(LAS u32x4*)(nb + 8192 + vdst) = VW; } \
        asm volatile("s_waitcnt lgkmcnt(0)" ::: "memory"); __builtin_amdgcn_s_barrier(); asm volatile("" ::: "memory"); } while (0)
#pragma unroll 1
    for (int c = 0; c < ntile; c += 2) { DSA_TILE(c, 0, 1, kr0, vr0, kr1, vr1); DSA_TILE(c + 1, 1, 0, kr1, vr1, kr0, vr0); }
#undef DSA_TILE
    { const auto rr = __builtin_amdgcn_permlane32_swap(__float_as_uint(lsum), __float_as_uint(lsum), false, false); lsum = __uint_as_float(rr[0]) + __uint_as_float(rr[1]); }
    store_ot(O + (rowb + t) * 512 + h * 64, o0, o1, hi, 1.f / lsum);
}
DEV void dsa_phase(LAS unsigned char* lds, unsigned char* ws, int vcu, int G, int tid, int wid, int lane, bf16_t* Oout) {
    constexpr int NPAIR = NB * 8 * 16;
    for (int pr = vcu; pr < NPAIR; pr += G) {
        const int bh = pr >> 4, s = pr & 15, b = bh >> 3, h = bh & 7;
#pragma unroll 1
        for (int k = 0; k < 2; ++k) {
            const int qblk = k == 0 ? s : 31 - s;
            dsa_unit(lds, (const bf16_t*)(ws + WS_QC), (const bf16_t*)(ws + WS_KC), (const bf16_t*)(ws + WS_VC), (const unsigned*)(ws + WS_BM), (const float*)(ws + WS_KN), Oout, b, h, qblk, tid, wid, lane);
        }
    }
}
#include <hip/hip_bf16.h>
namespace attn_body {
using bf16=__hip_bfloat16;
using bf16x8=__attribute__((ext_vector_type(8)))short;
using s16x4=__attribute__((ext_vector_type(4)))short;
using f32x16=__attribute__((ext_vector_type(16)))float;
using u32x4=__attribute__((ext_vector_type(4)))unsigned;
constexpr int BATCH=2,NHEAD=8,SEQ=8192,D=64,DM=NHEAD*D;
constexpr int NW=8,QBLK=32,QB=QBLK*NW,KVBLK=64,NQB=SEQ/QB;
constexpr int ATTN_PITCH=DM, ATTN_UNIT_ROWS=QB;
__device__ __forceinline__ int crow(int r,int hi){return (r&3)+8*(r>>2)+4*hi;}
#define SBAR() __builtin_amdgcn_sched_barrier(0)
__device__ __forceinline__ void cmask(f32x16&p0,f32x16&p1,int jb,int qrel,int hi){
  const float NEG=-INFINITY; int kb=64*jb+4*hi;
  #pragma unroll
  for(int r=0;r<16;++r){int kv=kb+(r&3)+8*(r>>2); if(kv>qrel)p0[r]=NEG; if(kv+32>qrel)p1[r]=NEG;}
}

constexpr int NSLOT=3, SLOTB=8192;
constexpr int LDS_K=0, LDS_V=NSLOT*SLOTB, LDS_WS=2*NSLOT*SLOTB, LDS_OST=LDS_WS+NW*64*4, LDS_BYTES=LDS_OST+NW*4096;
constexpr float C2=0.125f*1.4426950408889634f;
__device__ __forceinline__ void glds16(const void*gsrc,unsigned lds_dst){unsigned keep;
  asm volatile("s_mov_b32 %0, m0\n\ts_mov_b32 m0, %2\n\ts_nop 0\n\tglobal_load_lds_dwordx4 %1, off\n\ts_mov_b32 m0, %0":"=&s"(keep):"v"(gsrc),"s"(lds_dst):"memory");}
__device__ __forceinline__ float max3f(float a,float b,float c){float r;asm("v_max3_f32 %0, %1, %2, %3":"=v"(r):"v"(a),"v"(b),"v"(c));return r;}
__device__ __forceinline__ float max2f(float a,float b){float r;asm("v_max_f32_e32 %0, %1, %2":"=v"(r):"v"(a),"v"(b));return r;}
__device__ __forceinline__ float fadd_s(float a,float b){float r;asm("v_add_f32_e32 %0, %1, %2":"=v"(r):"v"(a),"v"(b));return r;}
__device__ __forceinline__ float fsub_s(float a,float b){float r;asm("v_sub_f32_e32 %0, %1, %2":"=v"(r):"v"(a),"v"(b));return r;}
typedef float f32x2_t __attribute__((ext_vector_type(2))); typedef __bf16 bf16x2_t __attribute__((ext_vector_type(2)));
__device__ __forceinline__ unsigned cvtpk_s(float lo,float hi){f32x2_t v={lo,hi};bf16x2_t b=__builtin_convertvector(v,bf16x2_t);return __builtin_bit_cast(unsigned,b);}
#define WAIT_BAR(N) asm volatile("s_waitcnt vmcnt(" #N ") lgkmcnt(0)\n\ts_barrier":::"memory")

__device__ __forceinline__ void qkt(f32x16&p0,f32x16&p1,const char*Kslot,const bf16x8*qr,const f32x16&negm,int r32,int hi){
  const char*kb=Kslot+hi*1024+r32*16;
  #pragma unroll
  for(int d0=0;d0<4;++d0){
    const bf16x8 b0=*reinterpret_cast<const bf16x8*>(kb+d0*2048);
    const bf16x8 b1=*reinterpret_cast<const bf16x8*>(kb+d0*2048+512);
    if(d0==0){p0=__builtin_amdgcn_mfma_f32_32x32x16_bf16(b0,qr[0],negm,0,0,0);p1=__builtin_amdgcn_mfma_f32_32x32x16_bf16(b1,qr[0],negm,0,0,0);}
    else{p0=__builtin_amdgcn_mfma_f32_32x32x16_bf16(b0,qr[d0],p0,0,0,0);p1=__builtin_amdgcn_mfma_f32_32x32x16_bf16(b1,qr[d0],p1,0,0,0);}}
}
typedef __attribute__((address_space(3))) const char* lds_cptr;
typedef short v4i16_t __attribute__((ext_vector_type(4)));
__device__ __forceinline__ void kload8(bf16x8*kf,lds_cptr kp){
  kf[0]=*(const __attribute__((address_space(3))) bf16x8*)(kp);      kf[1]=*(const __attribute__((address_space(3))) bf16x8*)(kp+512);
  kf[2]=*(const __attribute__((address_space(3))) bf16x8*)(kp+2048); kf[3]=*(const __attribute__((address_space(3))) bf16x8*)(kp+2560);
  kf[4]=*(const __attribute__((address_space(3))) bf16x8*)(kp+4096); kf[5]=*(const __attribute__((address_space(3))) bf16x8*)(kp+4608);
  kf[6]=*(const __attribute__((address_space(3))) bf16x8*)(kp+6144); kf[7]=*(const __attribute__((address_space(3))) bf16x8*)(kp+6656);
}
__device__ __forceinline__ void kload2(bf16x8*kf,lds_cptr kp,int j){ kf[2*j]=*(const __attribute__((address_space(3))) bf16x8*)(kp+j*2048); kf[2*j+1]=*(const __attribute__((address_space(3))) bf16x8*)(kp+j*2048+512); }
__device__ __forceinline__ s16x4 vtr(lds_cptr p){ return __builtin_bit_cast(s16x4,__builtin_amdgcn_ds_read_tr16_b64_v4i16((__attribute__((address_space(3))) v4i16_t*)p)); }
__device__ __forceinline__ float rowmax(const f32x16&p0,const f32x16&p1){
  float a=max3f(p0[0],p0[1],p1[0]),b=max3f(p0[2],p0[3],p1[1]);a=max3f(a,p1[2],p1[3]);
  #pragma unroll
  for(int r=4;r<16;r+=4){a=max3f(a,p0[r],p0[r+1]);b=max3f(b,p0[r+2],p0[r+3]);a=max3f(a,p1[r],p1[r+1]);b=max3f(b,p1[r+2],p1[r+3]);}
  const float m=max2f(a,b);
  auto rr=__builtin_amdgcn_permlane32_swap(__float_as_uint(m),__float_as_uint(m),false,false);
  return max2f(__uint_as_float(rr[0]),__uint_as_float(rr[1]));
}
__device__ __forceinline__ void pv(f32x16*o,int vb,bf16x8 pa0,bf16x8 pa1,bf16x8 pa2,bf16x8 pa3){
  #pragma unroll
  for(int d0=0;d0<2;++d0){s16x4 lo[4],hi[4];
    #pragma unroll
    for(int ks=0;ks<4;++ks){
      asm volatile("ds_read_b64_tr_b16 %0,%1 offset:%c2":"=&v"(lo[ks]):"v"(vb),"i"(d0*4096+ks*1024):"memory");
      asm volatile("ds_read_b64_tr_b16 %0,%1 offset:%c2":"=&v"(hi[ks]):"v"(vb),"i"(d0*4096+ks*1024+512):"memory");}
    asm volatile("s_waitcnt lgkmcnt(0)":::"memory");SBAR();
    #define PK(k) (bf16x8){lo[k][0],lo[k][1],lo[k][2],lo[k][3],hi[k][0],hi[k][1],hi[k][2],hi[k][3]}
    o[d0]=__builtin_amdgcn_mfma_f32_32x32x16_bf16(pa0,PK(0),o[d0],0,0,0);
    o[d0]=__builtin_amdgcn_mfma_f32_32x32x16_bf16(pa1,PK(1),o[d0],0,0,0);
    o[d0]=__builtin_amdgcn_mfma_f32_32x32x16_bf16(pa2,PK(2),o[d0],0,0,0);
    o[d0]=__builtin_amdgcn_mfma_f32_32x32x16_bf16(pa3,PK(3),o[d0],0,0,0);
    #undef PK
  }
}

#ifndef ATTN_STORE16
#define ATTN_STORE16(p,v) (*(u32x4*)(p)=(v))
#endif
template<int THRL> __device__ __forceinline__ void attn_unit(int b,int h,int qb,const bf16*Q,const bf16*__restrict__ K,const bf16*__restrict__ V,bf16*O,char*shm,const unsigned*__restrict__ BMb,const float*KNbh,const int tid){
  const int lane=tid&63,r32=lane&31,hi=lane>>5; const int wid=__builtin_amdgcn_readfirstlane(tid>>6);
  const long rowbase=(long)b*SEQ; const int q0=qb*QB;
  const bf16*Qw=Q+(rowbase+q0+wid*QBLK)*DM+h*D;
  const bf16*Kh=K+rowbase*DM+h*D,*Vh=V+rowbase*DM+h*D;
  const unsigned lds0=(unsigned)(uintptr_t)shm;
  float*wsf=(float*)(shm+LDS_WS)+wid*64;
  const bf16*ksrc=Kh+(long)lane*DM+wid*8;
  const bf16*vsrc=Vh+(long)(16*(wid&3)+(lane>>2))*DM+(wid>>2)*32+(lane&3)*8;
  const unsigned kdst=lds0+LDS_K+wid*1024, vdst=lds0+LDS_V+wid*1024;
  #define DMA_K(t,slot) glds16(ksrc+(long)(t)*KVBLK*DM,(unsigned)__builtin_amdgcn_readfirstlane(kdst+(slot)))
  #define DMA_V(t,slot) glds16(vsrc+(long)(t)*KVBLK*DM,(unsigned)__builtin_amdgcn_readfirstlane(vdst+(slot)))
  const int vb0=(int)(lds0+LDS_V)+((lane>>4)&1)*32+(lane&3)*8+(4*hi+((lane&15)>>2))*64;
  const char*Kbase=shm+LDS_K; bf16x8 kf[8];
  const lds_cptr shm3=(lds_cptr)shm; const lds_cptr kp0=shm3+LDS_K+hi*1024+r32*16; const lds_cptr vp0=shm3+LDS_V+((lane>>4)&1)*32+(lane&3)*8+(4*hi+((lane&15)>>2))*64;
  const int NT=(q0+QB)/KVBLK;
  DMA_K(0,0);DMA_V(0,0);DMA_K(1,SLOTB);
  bf16x8 qr[4];
  #pragma unroll
  for(int d0=0;d0<4;++d0)qr[d0]=*reinterpret_cast<const bf16x8*>(&Qw[(long)r32*DM+d0*16+hi*8]);
  const unsigned*bmp=BMb+(q0+wid*QBLK+r32);
  unsigned mwE0=bmp[0],mwE1=bmp[(size_t)SEQ],mwO0=0u,mwO1=0u;
  bool seen=false;
  float qn; { float qs=0.f;
    _Pragma("unroll") for(int d0=0;d0<4;++d0) _Pragma("unroll") for(int e=0;e<8;++e){ const float x=__uint_as_float(((unsigned)(unsigned short)qr[d0][e])<<16); qs+=x*x; }
    auto rr=__builtin_amdgcn_permlane32_swap(__float_as_uint(qs),__float_as_uint(qs),false,false); qn=__builtin_sqrtf(__uint_as_float(rr[0])+__uint_as_float(rr[1]))*1.01f; }
  constexpr float FASTB=60.f;
  int zlane=0; asm volatile("":"+v"(zlane));
  const float*knp=KNbh+zlane;
  float knE=knp[0],knO=0.f;
  bool anysel_=false;
  #define SLOWT(PS) (__any(!(qn*kn##PS<=FASTB)||mhat!=0.f))
  float mhat=0.f,l_reg=0.f;f32x16 o[2];o[0]=f32x16{};o[1]=f32x16{};const f32x16 zero16=f32x16{};
  const int qrel=wid*QBLK+r32;
  #define CMASK(P0,P1,SLOW,PS) do{ const unsigned m0_=mw##PS##0>>(4*hi), m1_=mw##PS##1>>(4*hi); anysel_=(mw##PS##0|mw##PS##1)!=0u; \
    if(SLOW){ _Pragma("unroll") for(int r=0;r<16;++r){ P0[r]-=mhat; P1[r]-=mhat; } } \
    _Pragma("unroll") for(int r=0;r<16;++r){ const int bit_=(r&3)+8*(r>>2); \
      const unsigned e0_=(unsigned)__builtin_amdgcn_sbfe((int)m0_,bit_,1), e1_=(unsigned)__builtin_amdgcn_sbfe((int)m1_,bit_,1); \
      P0[r]=__uint_as_float((__float_as_uint(P0[r])&e0_)|(0xff800000u&~e0_)); P1[r]=__uint_as_float((__float_as_uint(P1[r])&e1_)|(0xff800000u&~e1_)); } \
    }while(0)
  bool resc=false;
  #define START(P0,P1,SLOW) do{ resc=false; seen=anysel_; \
    if(SLOW){ const float rm=rowmax(P0,P1); const float dl=(rm==-INFINITY)?0.f:rm; mhat=fadd_s(mhat,dl); \
      _Pragma("unroll") for(int r=0;r<16;++r){P0[r]=fsub_s(P0[r],dl);P1[r]=fsub_s(P1[r],dl);} \
      } \
    _Pragma("unroll") for(int r=0;r<16;++r)P0[r]=__builtin_amdgcn_exp2f(P0[r]); }while(0)
  #define RESC() do{ if(resc){ asm volatile("s_waitcnt lgkmcnt(0)":::"memory"); \
      _Pragma("unroll") for(int d_=0;d_<2;++d_) _Pragma("unroll") for(int r=0;r<16;++r)o[d_][r]*=wsf[crow(r,hi)]; } }while(0)
  f32x16 pA0,pA1,pB0,pB1;
  int sl_prev=0,sl_cur=0,sl_next=SLOTB;
  #define ROT() do{sl_prev=sl_cur;sl_cur=sl_next;sl_next=(sl_next==(NSLOT-1)*SLOTB)?0:sl_next+SLOTB;}while(0)
  DMA_K(2,2*SLOTB);
  WAIT_BAR(3);
  { mwO0=bmp[(size_t)2*SEQ]; mwO1=bmp[(size_t)3*SEQ]; knO=knp[1];
  const bool slow0_=SLOWT(E);
  qkt(pA0,pA1,Kbase,qr,zero16,r32,hi);asm volatile("s_nop 15\n\ts_nop 7":"+v"(pA0),"+v"(pA1));CMASK(pA0,pA1,slow0_,E);
  START(pA0,pA1,slow0_); }
  _Pragma("unroll") for(int r=0;r<16;++r)pA1[r]=__builtin_amdgcn_exp2f(pA1[r]);
  WAIT_BAR(0);
  DMA_K(3,0);DMA_V(1,SLOTB);
  ROT();
  kload8(kf,kp0+sl_cur);
  WAIT_BAR(2);
  s16x4 vlo[8],vhi[8]; u32x4 pw0,pw1,pw2,pw3;
  #define PKW(P,B) cvtpk_s(P[B],P[B+1])
  #define PAF(k) __builtin_bit_cast(bf16x8,pw##k)
  #define VFR(i) (bf16x8){vlo[i][0],vlo[i][1],vlo[i][2],vlo[i][3],vhi[i][0],vhi[i][1],vhi[i][2],vhi[i][3]}
  #define PIN(x) asm volatile("":"+v"(x))
  #define MX3(a,b,c) __builtin_fmaxf(__builtin_fmaxf((a),(b)),(c))
  #define GAPA(MF,A0,A1,A2,A3,W0,W1,PW) do{ MF; sacc+=A0; sacc+=A1; sacc+=A2; sacc+=A3; PIN(sacc); W0; W1; PIN(PW); SBAR(); }while(0)
  #define EX(v) __builtin_amdgcn_exp2f(v)
  #define GAPB(MF,X,B) do{ MF; X[B]=EX(X[B]); X[B+1]=EX(X[B+1]); X[B+2]=EX(X[B+2]); X[B+3]=EX(X[B+3]); PIN(X); SBAR(); }while(0)
  #define VRD(i) do{ vlo[i]=vtr(vp_+(((i)>>2)*4096+((i)&3)*1024)); vhi[i]=vtr(vp_+(((i)>>2)*4096+((i)&3)*1024+512)); }while(0)
  #define KRD(G,j) do{ if(G){ kload2(kf,kp0+sl_next,j); SBAR(); } }while(0)
  #define STEP(C0,C1,P0,P1,t,GK,GV,GL,PS,NS) do{ SBAR(); \
    if((t)+1<NT){ mw##NS##0=bmp[(size_t)(2*(t)+2)*SEQ]; mw##NS##1=bmp[(size_t)(2*(t)+3)*SEQ]; kn##NS=knp[(t)+1]; }     \
    const lds_cptr vp_=vp0+sl_prev; \
    VRD(0); SBAR(); float sacc=(P0[0]+P0[1]); \
    GAPA(C0=__builtin_amdgcn_mfma_f32_32x32x16_bf16(kf[0],qr[0],zero16,0,0,0), P0[2],P0[3],P0[4],P0[5],     pw0[0]=PKW(P0,0), pw0[1]=PKW(P0,2), pw0); \
    VRD(4); SBAR(); GAPA(C1=__builtin_amdgcn_mfma_f32_32x32x16_bf16(kf[1],qr[0],zero16,0,0,0), P0[6],P0[7],P0[8],P0[9],     pw0[2]=PKW(P0,4), pw0[3]=PKW(P0,6), pw0); \
    VRD(1); SBAR(); GAPA(C0=__builtin_amdgcn_mfma_f32_32x32x16_bf16(kf[2],qr[1],C0,0,0,0),   P0[10],P0[11],P0[12],P0[13], pw1[0]=PKW(P0,8), pw1[1]=PKW(P0,10), pw1); \
    VRD(5); SBAR(); GAPA(C1=__builtin_amdgcn_mfma_f32_32x32x16_bf16(kf[3],qr[1],C1,0,0,0),   P0[14],P0[15],P1[0],P1[1],   pw1[2]=PKW(P0,12),pw1[3]=PKW(P0,14), pw1); \
    VRD(2); SBAR(); GAPA(C0=__builtin_amdgcn_mfma_f32_32x32x16_bf16(kf[4],qr[2],C0,0,0,0),   P1[2],P1[3],P1[4],P1[5],     pw2[0]=PKW(P1,0), pw2[1]=PKW(P1,2), pw2); \
    VRD(6); SBAR(); GAPA(C1=__builtin_amdgcn_mfma_f32_32x32x16_bf16(kf[5],qr[2],C1,0,0,0),   P1[6],P1[7],P1[8],P1[9],     pw2[2]=PKW(P1,4), pw2[3]=PKW(P1,6), pw2); \
    VRD(3); SBAR(); GAPA(C0=__builtin_amdgcn_mfma_f32_32x32x16_bf16(kf[6],qr[3],C0,0,0,0),   P1[10],P1[11],P1[12],P1[13], pw3[0]=PKW(P1,8), pw3[1]=PKW(P1,10), pw3); \
    VRD(7); SBAR(); GAPA(C1=__builtin_amdgcn_mfma_f32_32x32x16_bf16(kf[7],qr[3],C1,0,0,0),   P1[14],P1[15],0.f,0.f,       pw3[2]=PKW(P1,12),pw3[3]=PKW(P1,14), pw3); \
    l_reg+=sacc; \
    if(GK){DMA_K((t)+3,sl_cur);} if(GV){DMA_V((t)+1,sl_next);} \
    const bool slow_=SLOWT(PS); CMASK(C0,C1,slow_,PS); resc=false; \
    if(__builtin_expect(slow_,0)){ float a=MX3(C0[0],C0[1],C1[0]),b=MX3(C0[2],C0[3],C1[1]); a=MX3(a,C1[2],C1[3]); \
      _Pragma("unroll") for(int r=4;r<16;r+=4){a=MX3(a,C0[r],C0[r+1]);b=MX3(b,C0[r+2],C0[r+3]);a=MX3(a,C1[r],C1[r+1]);b=MX3(b,C1[r+2],C1[r+3]);} \
      float rm=__builtin_fmaxf(a,b); { auto rr=__builtin_amdgcn_permlane32_swap(__float_as_uint(rm),__float_as_uint(rm),false,false); rm=__builtin_fmaxf(__uint_as_float(rr[0]),__uint_as_float(rr[1])); } \
      const bool fresh_=!seen&&rm>-INFINITY;     \
      if(__builtin_expect(__any(rm>(float)THRL||(fresh_&&rm<-(float)THRL)),0)){ const float dl=fresh_?rm:__builtin_fmaxf(rm,0.f); mhat+=dl; \
        _Pragma("unroll") for(int r=0;r<16;++r){C0[r]-=dl;C1[r]-=dl;} \
        const float f=dl>0.f?__builtin_amdgcn_exp2f(-dl):1.f; l_reg*=f; if(hi==0)wsf[r32]=f; resc=true; } } \
    seen=seen||anysel_; \
    SBAR(); \
    GAPB(o[0]=__builtin_amdgcn_mfma_f32_32x32x16_bf16(PAF(0),VFR(0),o[0],0,0,0), C0,0); \
    GAPB(o[1]=__builtin_amdgcn_mfma_f32_32x32x16_bf16(PAF(0),VFR(4),o[1],0,0,0), C0,4); \
    KRD(GL,0); GAPB(o[0]=__builtin_amdgcn_mfma_f32_32x32x16_bf16(PAF(1),VFR(1),o[0],0,0,0), C0,8); \
    KRD(GL,1); GAPB(o[1]=__builtin_amdgcn_mfma_f32_32x32x16_bf16(PAF(1),VFR(5),o[1],0,0,0), C0,12); \
    KRD(GL,2); GAPB(o[0]=__builtin_amdgcn_mfma_f32_32x32x16_bf16(PAF(2),VFR(2),o[0],0,0,0), C1,0); \
    KRD(GL,3); GAPB(o[1]=__builtin_amdgcn_mfma_f32_32x32x16_bf16(PAF(2),VFR(6),o[1],0,0,0), C1,4); \
    GAPB(o[0]=__builtin_amdgcn_mfma_f32_32x32x16_bf16(PAF(3),VFR(3),o[0],0,0,0), C1,8); \
    GAPB(o[1]=__builtin_amdgcn_mfma_f32_32x32x16_bf16(PAF(3),VFR(7),o[1],0,0,0), C1,12); \
    }while(0)
  int t=1;
  for(;t+5<NT;t+=2){
    STEP(pB0,pB1,pA0,pA1,t,true,true,true,O,E);     WAIT_BAR(2); RESC(); ROT();
    STEP(pA0,pA1,pB0,pB1,t+1,true,true,true,E,O);   WAIT_BAR(2); RESC(); ROT();
  }
  #define ENDW(tt) do{ if((tt)+3<NT){WAIT_BAR(2);} else if((tt)+2<NT){WAIT_BAR(1);} else {WAIT_BAR(0);} }while(0)
  for(;t+1<NT;t+=2){
    STEP(pB0,pB1,pA0,pA1,t,(t+3<NT),(t+1<NT),(t+1<NT),O,E);       ENDW(t);   RESC(); ROT();
    STEP(pA0,pA1,pB0,pB1,t+1,(t+4<NT),(t+2<NT),(t+2<NT),E,O);     ENDW(t+1); RESC(); ROT();
  }
  STEP(pB0,pB1,pA0,pA1,NT-1,false,false,false,O,E); RESC();
  { float sacc=pB0[0]+pB0[1]; _Pragma("unroll") for(int r=2;r<16;++r)sacc+=pB0[r]; _Pragma("unroll") for(int r=0;r<16;++r)sacc+=pB1[r]; l_reg+=sacc;
    pw0=(u32x4){PKW(pB0,0),PKW(pB0,2),PKW(pB0,4),PKW(pB0,6)};pw1=(u32x4){PKW(pB0,8),PKW(pB0,10),PKW(pB0,12),PKW(pB0,14)};pw2=(u32x4){PKW(pB1,0),PKW(pB1,2),PKW(pB1,4),PKW(pB1,6)};pw3=(u32x4){PKW(pB1,8),PKW(pB1,10),PKW(pB1,12),PKW(pB1,14)};
    SBAR(); pv(o,vb0+sl_cur,PAF(0),PAF(1),PAF(2),PAF(3)); }
  #undef PKW
  #undef PAF
  #undef VFR
  #undef PIN
  #undef MX3
  #undef GAPA
  #undef GAPB
  #undef EX
  #undef VRD
  #undef KRD
  #undef STEP
  #undef ENDW
  {auto rr=__builtin_amdgcn_permlane32_swap(__float_as_uint(l_reg),__float_as_uint(l_reg),false,false);l_reg=__uint_as_float(rr[0])+__uint_as_float(rr[1]);}
  if(hi==0)wsf[32+r32]=l_reg;asm volatile("s_waitcnt lgkmcnt(0)":::"memory");
  float rli[16];
  #pragma unroll
  for(int r=0;r<16;++r)rli[r]=__builtin_amdgcn_rcpf(wsf[32+crow(r,hi)]);
  bf16*Ow=O+(rowbase+q0+wid*QBLK)*DM+h*D;
  { bf16*stg=(bf16*)(shm+LDS_OST)+wid*2048;
    #pragma unroll
    for(int r=0;r<16;++r){const int orow=crow(r,hi);
      #pragma unroll
      for(int d0=0;d0<2;++d0)stg[orow*64+d0*32+r32]=__float2bfloat16(o[d0][r]*rli[r]);}
    asm volatile("s_waitcnt lgkmcnt(0)":::"memory");
    #pragma unroll
    for(int i=0;i<4;++i){const int row=i*8+(lane>>3),ch=lane&7; const u32x4 v=*(const u32x4*)(stg+row*64+ch*8); ATTN_STORE16(Ow+(long)row*DM+ch*8,v);} }
  asm volatile("s_waitcnt lgkmcnt(0)\n\ts_barrier":::"memory");
  #undef DMA_K
  #undef DMA_V
  #undef CMASK
  #undef SLOWT
  #undef START
  #undef RESC
  #undef ROT
}
constexpr int ATTN_LDS_BYTES=LDS_BYTES;
#undef SBAR
#undef WAIT_BAR
}
constexpr int MK_THREADS = 512;
constexpr int RING_BYTES = 131072, MISC_OFF = RING_BYTES + 320, MK_LDS_BYTES = 147456;
constexpr size_t WS_CTL = 0, CTL_ZERO_BYTES = 65536 + 7 * 131072; constexpr int CW_BAR = 4096;
constexpr int PH_PREP0 = 0, PH_L0 = 1, PH_PER_LAYER = 14, NPH = PH_L0 + 2 * PH_PER_LAYER;
enum { Q_INPROJ = 0, Q_SBIDX, Q_DSA, Q_GATES, Q_MERGE, Q_MIX, Q_NORMXA, Q_XALOG, Q_XAOUT, Q_NORMFFN, Q_UP, Q_FFNMID, Q_DOWN, Q_NEXT };

#ifndef QBUILD
#define QBUILD 0xffffu
#endif
#define QON(x) ((QBUILD >> (x)) & 1u)
struct Args { const float* in[20]; float* out; unsigned char* ws; int ph_lo, ph_hi; };

__global__ void __launch_bounds__(MK_THREADS, 2) mk_fwd(Args args) {
    __shared__ __attribute__((aligned(16))) unsigned char lds_raw[MK_LDS_BYTES];
    LAS unsigned char* lds = (LAS unsigned char*)lds_raw;
    volatile LAS unsigned* MISC = (volatile LAS unsigned*)(lds + MISC_OFF);
    const int G = gridDim.x, bx = blockIdx.x;
    unsigned char* ws0 = args.ws;
    const int wave_s = __builtin_amdgcn_readfirstlane((int)threadIdx.x >> 6);
    for (int u = mk_tid(wave_s); u < (MK_LDS_BYTES - RING_BYTES) / 4; u += MK_THREADS) ((LAS unsigned*)(lds + RING_BYTES))[u] = 0u;
    __syncthreads();
    const int lo = args.ph_lo, hi = args.ph_hi;
    XcdBarrier bar; bar.bar = (unsigned*)(ws0 + WS_CTL) + CW_BAR; bar.x = 0; bar.st = nullptr;
    if (hi - lo > 1) bar = xcd_barrier_post((unsigned*)(ws0 + WS_CTL) + CW_BAR, MISC + 8, mk_tid(wave_s));
#define BPW(off) ((bf16_t*)(ws + (off)))
    const int vcu = (G % 8 == 0) ? (bx % 8) * (G / 8) + bx / 8 : bx;
    for (int p = lo; p < hi; ++p) {
#ifdef PROBE_REP
        const int reps = (p >= PH_L0 && ((PROBE_REP >> ((p - PH_L0) % PH_PER_LAYER)) & 1)) ? 2 : 1;
#else
        const int reps = 1;
#endif
#ifdef PROBE_REP
#pragma unroll 1
        for (int rep = 0; rep < reps; ++rep) {
        const bool dry = rep + 1 < reps;
#else
        { constexpr bool dry = false;
#endif
        int oz = 0; asm volatile("" : "+s"(oz));
        int tid = mk_tid(wave_s); asm volatile("" : "+v"(tid));
        const int wave = __builtin_amdgcn_readfirstlane(tid >> 6), lane = tid & 63;
        WaveId W; W.gw = vcu * 8 + wave; W.ngw = G * 8; W.wave = wave; W.lane = lane;
        unsigned char* ws = args.ws + oz; float* X = args.out + oz;
#define INP(k) (args.in[(k) + oz])
        if (p == PH_PREP0) {
            prep0_phase(W, (LAS float*)(lds + wave * 16384), ws, args.in + oz, (bf16_t*)X);
        } else if (p >= PH_L0) {
            const int l = (p - PH_L0) / PH_PER_LAYER, q = (p - PH_L0) % PH_PER_LAYER;
            const float* Xin = l == 0 ? INP(0) : X;
            pg8::u64* SSb = (pg8::u64*)(ws + WS_SS);
#define SSA(i) (SSb + (size_t)(i) * T)
            if (q == Q_SBIDX) {
#ifndef NO_SB
                sb_phase(W, lds, ws, dry);
#endif
                __syncthreads();
#ifndef NO_IDX
#ifdef PROBE_SB_ONLY
                if (!dry)
#endif
                idx_phase(lds, ws, vcu, G, wave, lane);
#endif
                conv_sc_phase(vcu * MK_THREADS + tid, G * MK_THREADS, BPW(WS_SCB), BPW(WS_CX), INP(4) + l * 3 * 512, dry);
                kn_phase(W, BPW(WS_KC), (float*)(ws + WS_KN));
                if (l == 0 && !dry && QON(15)) {
                    __syncthreads();
                    { pg8::Order S; S.init(1, 4, 16, G, bx); pg8::PtrG P{(const char*)(ws + WS_KVM), (const char*)(ws + WS_WQ)}; pg8::EpiPrep E{ws, 1};
                      pg8::gemm_phase<pg8::EpiPrep, pg8::PtrG, true, true>(lds, tid, 2 * D, D, 256, S, P, E); }
                    { pg8::Order S; S.init(4, 1, 16, G, (bx + 64) % G); pg8::PtrH P{(const char*)(ws + WS_KVM), (const char*)(ws + WS_WOT)}; pg8::EpiPrep E{ws, 2};
                      pg8::gemm_phase<pg8::EpiPrep, pg8::PtrH, true, true>(lds, tid, D, 2 * D, 256, S, P, E); }
                }
            } else if (q == Q_DSA) {
#ifndef NO_DSA
                {
                    for (int pr = vcu; pr < NB * 8 * 16; pr += G) { const int bh = pr >> 4, sx = pr & 15, bb = bh >> 3, hh = bh & 7;
#pragma unroll 1
                        for (int k2 = 0; k2 < 2; ++k2)
                            attn_body::attn_unit<8>(bb, hh, k2 == 0 ? sx : 31 - sx, (const attn_body::bf16*)BPW(WS_QC), (const attn_body::bf16*)BPW(WS_KC), (const attn_body::bf16*)BPW(WS_VC),
                                                    (attn_body::bf16*)(dry ? BPW(WS_KA) : BPW(WS_QC)), (char*)lds_raw, (const unsigned*)(ws + WS_BM) + (size_t)bb * 256 * S,
                                                    (const float*)(ws + WS_KN) + bh * (S / 64), tid); }
                }
#endif
            } else if (q == Q_FFNMID) {
            } else if (q == Q_NEXT) {
                if (l + 1 < DEPTH) { int base = 0; convert_layer_weights(W, (LAS float*)(lds + wave * 16384), base, ws, args.in + oz, l + 1); }
                else if (!dry) final_norm(W, BPW(WS_XN), X, INP(19), SSA(6));
            } else if (q == Q_INPROJ && QON(Q_INPROJ)) {
                pg8::Order S; S.init(T / 256, NIN / 256, 1, G, bx);
                pg8::PtrStd P{(const char*)X, (const char*)(ws + WS_WIN), 0, 0, 0, (size_t)256 * D * 2, (size_t)256 * D * 2};
                pg8::EpiInProj E{ws, SSA(3 * l)};
                pg8::gemm_phase<pg8::EpiInProj, pg8::PtrStd, true, true>(lds, tid, D, D, D, S, P, E);
                if (l == 0 && !dry && QON(14)) {
                    pg8::Order S2; S2.init(2, 8, 2, G, (bx + G - 64) % G);
                    pg8::PtrStd P2{(const char*)(ws + WS_MEMN), (const char*)(ws + WS_WKVT), 1 * MiB, 4 * MiB, 0, (size_t)256 * D * 2, (size_t)256 * D * 2};
                    pg8::EpiPrep E2{ws, 0};
                    pg8::gemm_phase<pg8::EpiPrep, pg8::PtrStd, true, true>(lds, tid, D, D, D, S2, P2, E2);
                }
            } else if (q == Q_GATES && QON(Q_GATES)) {
                pg8::Order S; S.init(T / 256, 12, 1, G, bx);
                pg8::PtrStd P{(const char*)X, (const char*)(ws + WS_WG), 0, 0, 0, (size_t)256 * D * 2, (size_t)256 * D * 2};
                pg8::EpiGates E{BPW(WS_GATES), SSA(3 * l)};
                pg8::gemm_phase<pg8::EpiGates, pg8::PtrStd, true, true>(lds, tid, D, D, D, S, P, E);
            } else if (q == Q_MERGE && QON(Q_MERGE)) {
                pg8::Order S; S.init(T / 256, 4, 3, G, bx);
                pg8::PtrStd P{(const char*)(ws + WS_QA), (const char*)(ws + WS_WBR), 16 * MiB, (size_t)D * 512 * 2, 0, (size_t)256 * 512 * 2, (size_t)256 * 512 * 2};
                pg8::EpiMerge E{BPW(WS_XN), BPW(WS_GATES)};
                pg8::gemm_phase<pg8::EpiMerge, pg8::PtrStd, true, true>(lds, tid, 512, 512, 512, S, P, E);
            } else if (q == Q_MIX && QON(Q_MIX)) {
                pg8::Order S; S.init(T / 256, 4, 1, G, bx);
                pg8::PtrStd P{(const char*)(ws + WS_XN), (const char*)(ws + WS_WMIX), 0, 0, 0, (size_t)256 * D * 2, (size_t)256 * D * 2};
                if (l == 0) { pg8::EpiResid<true> E{(const void*)INP(0), dry ? BPW(WS_FU) : BPW(WS_XBXA), dry ? SSA(0) : SSA(1)};
                    pg8::gemm_phase<pg8::EpiResid<true>, pg8::PtrStd, true, true>(lds, tid, D, D, D, S, P, E); }
                else { pg8::EpiResid<false> E{(const void*)X, dry ? BPW(WS_FU) : BPW(WS_XBXA), dry ? SSA(0) : SSA(4)};
                    pg8::gemm_phase<pg8::EpiResid<false>, pg8::PtrStd, true, true>(lds, tid, D, D, D, S, P, E); }

            } else if (q == Q_XALOG && QON(Q_XALOG)) {
                pg8::Order S; S.init(T / 256, 4, 1, G, bx);
                pg8::PtrStd P{(const char*)(ws + WS_XBXA), (const char*)(ws + WS_GT + (size_t)l * 4 * MiB), 0, 0, 2 * MiB, (size_t)256 * D * 2, (size_t)256 * D * 2};
                pg8::EpiSoftmax E{BPW(WS_PXA), SSA(1 + 3 * l)};
                pg8::gemm_phase<pg8::EpiSoftmax, pg8::PtrStd, false, true>(lds, tid, D, D, D, S, P, E);
            } else if (q == Q_XAOUT && QON(Q_XAOUT)) {
                pg8::Order S; S.init(T / 256, 4, 1, G, bx);
                pg8::PtrStd P{(const char*)(ws + WS_PXA), (const char*)(ws + WS_HT + (size_t)l * 4 * MiB), 0, 0, 2 * MiB, (size_t)256 * D * 2, (size_t)256 * D * 2};
                pg8::EpiResid<false> E{(const void*)BPW(WS_XBXA), dry ? BPW(WS_FU) : BPW(WS_XN), dry ? SSA(0) : SSA(2 + 3 * l)};
                pg8::gemm_phase<pg8::EpiResid<false>, pg8::PtrStd, true, true>(lds, tid, D, D, D, S, P, E);
            } else if (q == Q_UP && QON(Q_UP)) {
                pg8::Order S; S.init(T / 256, 22, 1, G, bx);
                pg8::PtrStd P{(const char*)(ws + WS_XN), (const char*)(ws + WS_WUP), 0, 0, 0, (size_t)256 * D * 2, (size_t)256 * D * 2};
                pg8::EpiUpF E{BPW(WS_FU), BPW(WS_SIDEA), BPW(WS_SIDEU), SSA(2 + 3 * l), INP(16) + l * 3 * DFF, INP(17) + l * DFF};
                pg8::gemm_phase<pg8::EpiUpF, pg8::PtrStd, true, true>(lds, tid, D, D, D, S, P, E);
            } else if (q == Q_DOWN && QON(Q_DOWN)) {
                pg8::Order S; S.init(T / 256, 4, 1, G, bx);
                if (!dry) {
#pragma unroll 1
                    for (int i = 0; ; ++i) { pg8::Unit u0; if (!S.next(i, u0)) break; ffn_fix_phase(tid, MK_THREADS, BPW(WS_SIDEA), BPW(WS_SIDEU), BPW(WS_FU), INP(16) + l * 3 * DFF, INP(17) + l * DFF, 4 * u0.pm, 4); }
                    asm volatile("s_waitcnt vmcnt(0)" ::: "memory"); __syncthreads();
                }
                pg8::PtrStd P{(const char*)(ws + WS_FU), (const char*)(ws + WS_WDOWN), 0, 0, 0, (size_t)256 * DFF * 2, (size_t)256 * DFF * 2};
                pg8::EpiResid<false> E{(const void*)BPW(WS_XN), dry ? BPW(WS_QA) : (l + 1 < DEPTH ? (bf16_t*)X : BPW(WS_XN)), dry ? SSA(0) : SSA(3 + 3 * l)};
                pg8::gemm_phase<pg8::EpiResid<false>, pg8::PtrStd, true, true>(lds, tid, DFF, DFF, DFF, S, P, E);
            }
        }
        }
        if (p + 1 < hi && !(p >= PH_L0 && ((p - PH_L0) % PH_PER_LAYER == Q_NORMXA || (p - PH_L0) % PH_PER_LAYER == Q_NORMFFN || (p - PH_L0) % PH_PER_LAYER == Q_FFNMID))) xcd_barrier(bar, mk_tid(wave_s));
    }
}

extern "C" void kernel_launch(void* const* d_in, const int* in_sizes, int n_in, void* d_out, int out_size, void* d_ws, size_t ws_size, hipStream_t st) {
    if (n_in != 20 || ws_size < WS_NEED || out_size != T * D) { fprintf(stderr, "kernel_launch: unexpected sizes n_in %d ws %zu out %d\n", n_in, ws_size, out_size); return; }
    static int grid = 0;
    if (grid == 0) {
        int dev = 0, cus = 0, per_cu = 0;
        (void)hipGetDevice(&dev); (void)hipDeviceGetAttribute(&cus, hipDeviceAttributeMultiprocessorCount, dev);
        if (hipOccupancyMaxActiveBlocksPerMultiprocessor(&per_cu, (const void*)mk_fwd, MK_THREADS, 0) != hipSuccess || per_cu < 1) { fprintf(stderr, "kernel_launch: occupancy query says %d blocks/CU\n", per_cu); grid = -1; return; }
        (void)hipGetLastError();
        if (cus != 256) { fprintf(stderr, "kernel_launch: built for a 256-CU device, found %d\n", cus); grid = -1; return; }
        grid = cus;
    }
    if (grid < 0) return;
    (void)hipMemsetAsync((char*)d_ws + WS_CTL, 0, CTL_ZERO_BYTES, st);
    Args a{};
    for (int i = 0; i < 20; ++i) a.in[i] = (const float*)d_in[i];
    a.out = (float*)d_out; a.ws = (unsigned char*)d_ws; a.ph_lo = 0; a.ph_hi = NPH;
    hipLaunchKernelGGL(mk_fwd, dim3(grid), dim3(MK_THREADS), 0, st, a);
}
```

```cpp
#include <hip/hip_runtime.h>
#include <stdint.h>
#include <stdio.h>

typedef unsigned short bf16_t;
typedef short bf16x8 __attribute__((ext_vector_type(8)));
typedef float f32x16 __attribute__((ext_vector_type(16)));
typedef float f32x4 __attribute__((ext_vector_type(4)));
#define DEV __device__ __forceinline__

constexpr int NB = 2, S = 8192, D = 1024, T = NB * S, DEPTH = 2;
constexpr int DIN = 8264, DFF = 2816, MEM = 256;
constexpr int NIN = 5376;
constexpr float LOG2E = 1.4426950408889634f;
constexpr float QSCALE = 0.125f * LOG2E;
constexpr float WSCALE = 0.125f * 0.35355339059327373f;
constexpr float XSCALE = 0.0625f * LOG2E;
constexpr float EPS = 1e-6f;
#ifndef MK_FUSE
#define MK_FUSE 1
#endif

constexpr size_t MiB = 1u << 20;
constexpr size_t WS_SIDEA = 88 * MiB, WS_SIDEU = 96 * MiB;
constexpr size_t WS_KN = 983040;
constexpr size_t WS_GT = 1 * MiB;
constexpr size_t WS_HT = 9 * MiB;
constexpr size_t WS_WUP = 17 * MiB, WS_WDOWN = 28 * MiB;
constexpr size_t WS_XN = 34 * MiB;
constexpr size_t WS_WMIX = 66 * MiB, WS_WBR = 68 * MiB, WS_WG = 71 * MiB, WS_WIN = 77 * MiB;
constexpr size_t WS_QA = 88 * MiB, WS_SCB = 104 * MiB, WS_QC = 120 * MiB, WS_KA = 136 * MiB, WS_VA = 152 * MiB, WS_KC = 168 * MiB, WS_VC = 184 * MiB,
                 WS_IQ = 200 * MiB, WS_CX = 216 * MiB, WS_IK = 232 * MiB, WS_IW = 234 * MiB, WS_BM = 235 * MiB;
constexpr size_t WS_GATES = 136 * MiB;
constexpr size_t WS_XTMP = 235 * MiB;
constexpr size_t WS_LOG = 88 * MiB, WS_PXA = 168 * MiB;
constexpr size_t WS_XBXA = 136 * MiB;
constexpr size_t WS_SS = 65536;
constexpr size_t WS_FA = 66 * MiB, WS_FU = 154 * MiB;
constexpr size_t WS_WQ = 34 * MiB  , WS_WOT = 38 * MiB  , WS_WKVT = 42 * MiB  , WS_MEMN = 50 * MiB  , WS_KVM = 52 * MiB  ;
constexpr size_t WS_NEED = 256 * MiB;

DEV bf16_t f2bf(float f) { unsigned u = __float_as_uint(f); u += 0x7fffu + ((u >> 16) & 1u); return (bf16_t)(u >> 16); }
DEV float bf2f(bf16_t h) { return __uint_as_float(((unsigned)h) << 16); }
DEV float wave_sum(float v) {
#pragma unroll
    for (int o = 1; o < 64; o <<= 1) v += __shfl_xor(v, o);
    return v;
}
DEV float wave_max(float v) {
#pragma unroll
    for (int o = 1; o < 64; o <<= 1) v = fmaxf(v, __shfl_xor(v, o));
    return v;
}


#define LAS __attribute__((address_space(3)))
#define GAS __attribute__((address_space(1)))
typedef unsigned u32x4 __attribute__((ext_vector_type(4)));
typedef unsigned u32x2 __attribute__((ext_vector_type(2)));
typedef float f32x2 __attribute__((ext_vector_type(2)));
#define LDS_WAIT() asm volatile("s_waitcnt lgkmcnt(0)" ::: "memory")
DEV int mk_tid(int wave_s) { unsigned ones = ~0u; asm volatile("" : "+s"(ones)); return wave_s * 64 + (int)__builtin_amdgcn_mbcnt_hi(ones, __builtin_amdgcn_mbcnt_lo(ones, 0u)); }
#define VM_WAIT() asm volatile("s_waitcnt vmcnt(0)" ::: "memory")
typedef __bf16 bf16x2_t __attribute__((ext_vector_type(2)));
DEV unsigned cvt_pk_bf16(float lo, float hi) { const f32x2 v = {lo, hi}; return __builtin_bit_cast(unsigned, __builtin_convertvector(v, bf16x2_t)); }
DEV float bflo(unsigned w) { return __uint_as_float(w << 16); }
DEV float bfhi(unsigned w) { return __uint_as_float(w & 0xffff0000u); }

namespace pg8 {
constexpr int BM = 256, BK = 64, HALF = 128, HTB = HALF * BK * 2, STAGE_BYTES = 8 * HTB, NXCD = 8, WGM = 8;
__host__ __device__ __forceinline__ int lds_byte(int r, int c) { const int st = (r >> 4) * 2 + (c >> 5), rr = r & 15, cc = c & 31, ob = rr * 64 + cc * 2; return st * 1024 + (ob ^ (((ob >> 9) & 1) << 5)); }
__host__ __device__ __forceinline__ void stage_rc(int b, int& R, int& C) { const int st = b / 1024, sb = b % 1024, swz = sb ^ (((sb >> 9) & 1) << 5); R = (st >> 1) * 16 + swz / 64; C = (st & 1) * 32 + (swz % 64) / 2; }
__host__ __device__ __forceinline__ int perm32(int rho) { const int n = rho >> 4, i = rho & 15; return 8 * (i >> 2) + 4 * n + (i & 3); }

struct Unit { int pm, pn, job; };
struct Order {
    int nM, nN, nwg, ntot, G, c;
    DEV void init(int nM_, int nN_, int njob, int G_, int c_) { nM = nM_; nN = nN_; nwg = nM * nN; ntot = nwg * njob; G = G_; c = c_; }
    DEV bool next(int i, Unit& u) const {
        const int L = i * G + c; if (L >= ntot) return false;
        u.job = L / nwg; int wgid = L - u.job * nwg;
        { const int q = nwg / NXCD, r = nwg % NXCD, xcd = wgid % NXCD, off = wgid / NXCD; wgid = (xcd < r ? xcd * (q + 1) : r * (q + 1) + (xcd - r) * q) + off; }
        const int nig = WGM * nN, gid = wgid / nig, fm = gid * WGM, gsz = (nM - fm) < WGM ? (nM - fm) : WGM;
        u.pm = fm + ((wgid % nig) % gsz); u.pn = (wgid % nig) / gsz; return true;
    }
};
template <class Epi, class Ptr, bool ALIGN_EPI, bool SP2>
DEV void gemm_phase(LAS unsigned char* lds, const int tid_in, const int lda, const int ldb, const int K, const Order& S, const Ptr& P, const Epi& E) {
    int tid_ = tid_in; asm volatile("" : "+v"(tid_));
    const int tid = tid_, wid = __builtin_amdgcn_readfirstlane(tid >> 6), lane = tid & 63, wr = wid >> 2, wc = wid & 3, fr = lane & 15, fq = lane >> 4;
    const int nt = K / BK;
    unsigned voffA[2], voffB[2];
#pragma unroll
    for (int i = 0; i < 2; ++i) { int R, C; stage_rc(tid * 16 + i * 8192, R, C); const int Rb = Epi::PERM ? ((R & ~31) + perm32(R & 31)) : R;
        voffA[i] = (unsigned)(R * lda + C) * 2u; voffB[i] = (unsigned)(Rb * ldb + C) * 2u; }
    const size_t kstep = (size_t)(BK * 2);
    const size_t hstepA = (size_t)HALF * lda * 2, hstepB = (size_t)HALF * ldb * 2;
    const unsigned ldsw = (unsigned)wid * 1024u;
    const int aoff = lds_byte(wr * 64 + fr, fq * 8), boff = lds_byte(wc * 32 + fr, fq * 8);
#define PG8_SA(b, h) (((b) * 2 + (h)) * HTB)
#define PG8_SB(b, h) ((4 + (b) * 2 + (h)) * HTB)
#define PG8_STAGE(bufoff, gbase, voff) do { _Pragma("unroll") for (int _i = 0; _i < 2; ++_i) \
        __builtin_amdgcn_global_load_lds((const unsigned*)((const char*)(gbase) + (voff)[_i]), (LAS unsigned*)(lds + (bufoff) + ldsw + _i * 8192), 16, 0, 0); } while (0)
#define PG8_LDA(dst, b, h) do { _Pragma("unroll") for (int m = 0; m < 4; ++m) _Pragma("unroll") for (int k = 0; k < 2; ++k) dst[m][k] = *(const LAS bf16x8*)(lds + PG8_SA(b, h) + aoff + m * 2048 + k * 1024); } while (0)
#define PG8_LDB(dst, b, h) do { _Pragma("unroll") for (int n = 0; n < 2; ++n) _Pragma("unroll") for (int k = 0; k < 2; ++k) dst[n][k] = *(const LAS bf16x8*)(lds + PG8_SB(b, h) + boff + n * 2048 + k * 1024); } while (0)
#define PG8_MMA(ai, bj, At, Bt) do { __builtin_amdgcn_s_setprio(1); _Pragma("unroll") for (int m = 0; m < 4; ++m) _Pragma("unroll") for (int n = 0; n < 2; ++n) _Pragma("unroll") for (int k = 0; k < 2; ++k) \
        acc[ai][bj][m][n] = __builtin_amdgcn_mfma_f32_16x16x32_bf16(Bt[n][k], At[m][k], acc[ai][bj][m][n], 0, 0, 0); __builtin_amdgcn_s_setprio(0); } while (0)
#define PG8_WAIT_V(n) asm volatile("s_waitcnt vmcnt(" #n ")" ::: "memory")
#define PG8_WAIT_L(n) asm volatile("s_waitcnt lgkmcnt(" #n ")" ::: "memory")
#define PG8_BAR __builtin_amdgcn_s_barrier()
#define PG8_SCHED __builtin_amdgcn_sched_barrier(0)
    Unit cur, nxt; int ui = 0;
    if (!S.next(0, cur)) return;
    f32x4 acc[2][2][4][2];
#pragma unroll
    for (int a = 0; a < 2; ++a)
#pragma unroll
        for (int b = 0; b < 2; ++b)
#pragma unroll
            for (int m = 0; m < 4; ++m)
#pragma unroll
                for (int n = 0; n < 2; ++n) acc[a][b][m][n] = (f32x4){0.f, 0.f, 0.f, 0.f};
    bf16x8 At[4][2], B0[2][2], B1[2][2];
    const char* cA = P.a(cur); const char* cB = P.b(cur);
    typename Epi::Pre pre; E.prefetch(pre, cur, wr, fr);
    if constexpr (SP2) {
        PG8_STAGE(PG8_SB(0, 0), cB, voffB); PG8_STAGE(PG8_SB(0, 1), cB + hstepB, voffB); PG8_STAGE(PG8_SA(0, 0), cA, voffA); PG8_STAGE(PG8_SA(0, 1), cA + hstepA, voffA);
        if (wr == 1) PG8_BAR;
        PG8_WAIT_V(2); PG8_BAR;
        PG8_STAGE(PG8_SB(1, 0), cB + kstep, voffB); PG8_STAGE(PG8_SA(1, 0), cA + kstep, voffA); PG8_STAGE(PG8_SB(1, 1), cB + hstepB + kstep, voffB);
        PG8_WAIT_V(6); PG8_BAR;
    } else {
        PG8_STAGE(PG8_SB(0, 0), cB, voffB); PG8_STAGE(PG8_SA(0, 0), cA, voffA); PG8_STAGE(PG8_SB(0, 1), cB + hstepB, voffB); PG8_STAGE(PG8_SA(0, 1), cA + hstepA, voffA);
        if (wr == 1) PG8_BAR;
        PG8_WAIT_V(4); PG8_BAR;
        PG8_STAGE(PG8_SB(1, 0), cB + kstep, voffB); PG8_STAGE(PG8_SA(1, 0), cA + kstep, voffA); PG8_STAGE(PG8_SB(1, 1), cB + hstepB + kstep, voffB);
        PG8_WAIT_V(6); PG8_BAR;
    }
#pragma unroll 1
    for (;;) {
        const bool has_next = S.next(ui + 1, nxt);
        const char* nA = has_next ? P.a(nxt) : cA; const char* nB = has_next ? P.b(nxt) : cB;
#pragma unroll 1
        for (int t = 0; t < nt; t += 2) {
            const bool last = (t == nt - 2);
            const char* a1 = cA + (size_t)(t + 1) * kstep;
            const char* a2 = last ? nA : cA + (size_t)(t + 2) * kstep; const char* b2 = last ? nB : cB + (size_t)(t + 2) * kstep;
            const char* a3 = a2 + kstep; const char* b3 = b2 + kstep;
            if constexpr (SP2) {
            PG8_LDB(B0, 0, 0); PG8_LDB(B1, 0, 1); PG8_SCHED; PG8_LDA(At, 0, 0); PG8_STAGE(PG8_SA(1, 1), a1 + hstepA, voffA);
            PG8_WAIT_V(8); PG8_WAIT_L(0); PG8_BAR; PG8_MMA(0, 0, At, B0); PG8_MMA(0, 1, At, B1); PG8_BAR; PG8_SCHED;
            PG8_LDA(At, 0, 1); PG8_STAGE(PG8_SB(0, 0), b2, voffB); PG8_STAGE(PG8_SB(0, 1), b2 + hstepB, voffB); PG8_STAGE(PG8_SA(0, 0), a2, voffA);
            PG8_WAIT_V(8); PG8_WAIT_L(0); PG8_BAR; PG8_MMA(1, 0, At, B0); PG8_MMA(1, 1, At, B1); PG8_BAR; PG8_SCHED;
            PG8_LDB(B0, 1, 0); PG8_LDB(B1, 1, 1); PG8_SCHED; PG8_LDA(At, 1, 0); PG8_STAGE(PG8_SA(0, 1), a2 + hstepA, voffA);
            PG8_WAIT_V(8); PG8_WAIT_L(0); PG8_BAR; PG8_MMA(0, 0, At, B0); PG8_MMA(0, 1, At, B1); PG8_BAR; PG8_SCHED;
            PG8_LDA(At, 1, 1); PG8_STAGE(PG8_SB(1, 0), b3, voffB); PG8_STAGE(PG8_SB(1, 1), b3 + hstepB, voffB); PG8_STAGE(PG8_SA(1, 0), a3, voffA);
            PG8_WAIT_V(8); PG8_WAIT_L(0); PG8_BAR; PG8_MMA(1, 0, At, B0); PG8_MMA(1, 1, At, B1); PG8_BAR; PG8_SCHED;
            } else {
            PG8_LDB(B0, 0, 0); PG8_SCHED; PG8_LDA(At, 0, 0); PG8_STAGE(PG8_SA(1, 1), a1 + hstepA, voffA);
            PG8_WAIT_L(8); PG8_BAR; PG8_WAIT_L(0); PG8_MMA(0, 0, At, B0); PG8_BAR; PG8_SCHED;
            PG8_LDB(B1, 0, 1); PG8_STAGE(PG8_SB(0, 0), b2, voffB);
            PG8_BAR; PG8_WAIT_L(0); PG8_MMA(0, 1, At, B1); PG8_BAR;
            PG8_LDA(At, 0, 1); PG8_STAGE(PG8_SA(0, 0), a2, voffA);
            PG8_BAR; PG8_WAIT_L(0); PG8_MMA(1, 0, At, B0); PG8_BAR; PG8_SCHED;
            PG8_STAGE(PG8_SB(0, 1), b2 + hstepB, voffB);
            PG8_WAIT_V(6); PG8_BAR; PG8_MMA(1, 1, At, B1); PG8_BAR;
            PG8_LDB(B0, 1, 0); PG8_SCHED; PG8_LDA(At, 1, 0); PG8_STAGE(PG8_SA(0, 1), a2 + hstepA, voffA);
            PG8_WAIT_L(8); PG8_BAR; PG8_WAIT_L(0); PG8_MMA(0, 0, At, B0); PG8_BAR; PG8_SCHED;
            PG8_LDB(B1, 1, 1); PG8_STAGE(PG8_SB(1, 0), b3, voffB);
            PG8_BAR; PG8_WAIT_L(0); PG8_MMA(0, 1, At, B1); PG8_BAR;
            PG8_LDA(At, 1, 1); PG8_STAGE(PG8_SA(1, 0), a3, voffA);
            PG8_BAR; PG8_WAIT_L(0); PG8_MMA(1, 0, At, B0); PG8_BAR; PG8_SCHED;
            PG8_STAGE(PG8_SB(1, 1), b3 + hstepB, voffB);
            PG8_WAIT_V(6); PG8_BAR; PG8_MMA(1, 1, At, B1); PG8_BAR;
            }
        }
        if constexpr (ALIGN_EPI) { if (wr == 0) PG8_BAR; }
        if constexpr (!Epi::AFTER_DRAIN) { int fr_ = fr, fq_ = fq; asm volatile("" : "+v"(fr_), "+v"(fq_));
            E(acc, cur, wr, wc, fr_, fq_, pre); }
        if (!has_next) break;
#pragma unroll
        for (int a = 0; a < 2; ++a)
#pragma unroll
            for (int b = 0; b < 2; ++b)
#pragma unroll
                for (int m = 0; m < 4; ++m)
#pragma unroll
                    for (int n = 0; n < 2; ++n) acc[a][b][m][n] = (f32x4){0.f, 0.f, 0.f, 0.f};
        cur = nxt; cA = nA; cB = nB; ++ui; E.prefetch(pre, cur, wr, fr);
        if constexpr (ALIGN_EPI) { if (wr == 1) PG8_BAR; }
    }
    PG8_WAIT_V(0);
    if constexpr (!ALIGN_EPI) { if (wr == 0) PG8_BAR; }
    PG8_BAR;
    if constexpr (Epi::AFTER_DRAIN) { int fr_ = fr, fq_ = fq, lane_ = lane; asm volatile("" : "+v"(fr_), "+v"(fq_), "+v"(lane_)); E.fused(acc, cur, wr, wc, fr_, fq_, lds, wid, lane_, pre); }
#undef PG8_SA
#undef PG8_SB
#undef PG8_STAGE
#undef PG8_LDA
#undef PG8_LDB
#undef PG8_MMA
#undef PG8_WAIT_V
#undef PG8_WAIT_L
#undef PG8_BAR
#undef PG8_SCHED
}
typedef f32x4 Acc[2][2][4][2];

struct PtrStd {
    const char* A; const char* B; size_t aj, bj, bb, arow, brow;
    DEV const char* a(const Unit& u) const { return A + (size_t)u.job * aj + (size_t)u.pm * arow; }
    DEV const char* b(const Unit& u) const { return B + (size_t)u.job * bj + (size_t)(u.pm >> 5) * bb + (size_t)u.pn * brow; }
};
struct PtrG {
    const char* KVM; const char* WQ;
    DEV const char* a(const Unit& u) const { return KVM + (size_t)(u.job >> 2) * MiB + (size_t)(u.job & 3) * 512; }
    DEV const char* b(const Unit& u) const { return WQ + (size_t)(u.job >> 3) * 2 * MiB + (size_t)(u.job & 3) * 512 + (size_t)u.pn * 256 * 1024 * 2; }
};
struct PtrH {
    const char* KVM; const char* WOT;
    DEV const char* a(const Unit& u) const { return WOT + (size_t)(u.job >> 3) * 2 * MiB + (size_t)(u.job & 3) * 512 + (size_t)u.pm * 256 * 1024 * 2; }
    DEV const char* b(const Unit& u) const { return KVM + (size_t)(u.job >> 2) * MiB + 2048 + (size_t)(u.job & 3) * 512; }
};

#define EPI_ROWS(u) const int row0 = (u).pm * BM + wr * 64 + fr
DEV u32x4 pack8(const f32x4 v0, const f32x4 v1) { u32x4 w; w.x = cvt_pk_bf16(v0[0], v0[1]); w.y = cvt_pk_bf16(v0[2], v0[3]); w.z = cvt_pk_bf16(v1[0], v1[1]); w.w = cvt_pk_bf16(v1[2], v1[3]); return w; }

struct PreNone {};
typedef unsigned long long u64;
constexpr float SS_SCALE = 65536.f;
struct PreRs { u64 v[2][4]; };
DEV void pre_rs(PreRs& p, const u64* ss, int row0) {
#pragma unroll
    for (int ai = 0; ai < 2; ++ai)
#pragma unroll
        for (int m = 0; m < 4; ++m) p.v[ai][m] = __builtin_nontemporal_load(ss + row0 + ai * HALF + m * 16);
}
DEV void rs_of(float (&rs)[2][4], const PreRs& p) {
#pragma unroll
    for (int ai = 0; ai < 2; ++ai)
#pragma unroll
        for (int m = 0; m < 4; ++m) rs[ai][m] = rsqrtf((float)p.v[ai][m] * (1.f / (SS_SCALE * D)) + EPS);
}
struct EpiInProj {
    typedef PreRs Pre;
    DEV void prefetch(PreRs& p, const Unit& u, int wr, int fr) const { pre_rs(p, ss, u.pm * BM + wr * 64 + fr); }
    static constexpr bool PERM = true, AFTER_DRAIN = false;
    unsigned char* ws; const u64* ss;
    DEV void operator()(const Acc& acc, const Unit& u, int wr, int wc, int fr, int fq, const PreRs& pre) const {
        EPI_ROWS(u); const int pn = u.pn, cb = wc * 32 + 8 * fq;
        float rs[2][4]; rs_of(rs, pre);
        if (pn < 16) {
            const int g = pn >> 1;
            const size_t off = g == 0 ? WS_QA : g == 1 ? WS_KA : g == 2 ? WS_VA : g == 3 ? WS_QC : g == 4 ? WS_KC : g == 5 ? WS_VC : g == 6 ? WS_IQ : WS_SCB;
            const float sc = (g == 0 || g == 3) ? QSCALE : 1.f;
            bf16_t* base = (bf16_t*)(ws + off) + (pn & 1) * 256 + cb;
#pragma unroll
            for (int ai = 0; ai < 2; ++ai)
#pragma unroll
                for (int m = 0; m < 4; ++m) { bf16_t* rowp = base + (size_t)(row0 + ai * HALF + m * 16) * 512;
#pragma unroll
                    for (int bj = 0; bj < 2; ++bj) *(u32x4*)(rowp + bj * HALF) = pack8(acc[ai][bj][m][0] * (sc * rs[ai][m]), acc[ai][bj][m][1] * (sc * rs[ai][m])); }
        } else if (pn < 20) {
            bf16_t* base = (bf16_t*)(ws + WS_CX) + (pn - 16) * 128 + cb;
#pragma unroll
            for (int ai = 0; ai < 2; ++ai)
#pragma unroll
                for (int m = 0; m < 4; ++m) { const float r2 = rs[ai][m] * rs[ai][m]; *(u32x4*)(base + (size_t)(row0 + ai * HALF + m * 16) * 512) = pack8(acc[ai][0][m][0] * acc[ai][1][m][0] * r2, acc[ai][0][m][1] * acc[ai][1][m][1] * r2); }
        } else {
            if (wc < 2) { bf16_t* base = (bf16_t*)(ws + WS_IK);
#pragma unroll
                for (int ai = 0; ai < 2; ++ai)
#pragma unroll
                    for (int m = 0; m < 4; ++m) { const int t = row0 + ai * HALF + m * 16;
                        *(u32x4*)(base + (size_t)(t >> 5) * 2048 + (((cb >> 3) * 32 + (t & 31)) * 8)) = pack8(acc[ai][0][m][0] * rs[ai][m], acc[ai][0][m][1] * rs[ai][m]); }
            } else if (wc == 2 && fq == 0) { float* base = (float*)(ws + WS_IW);
#pragma unroll
                for (int ai = 0; ai < 2; ++ai)
#pragma unroll
                    for (int m = 0; m < 4; ++m) { float* p = base + (size_t)(row0 + ai * HALF + m * 16) * 8; *(f32x4*)p = acc[ai][0][m][0] * (WSCALE * rs[ai][m]); *(f32x4*)(p + 4) = acc[ai][0][m][1] * (WSCALE * rs[ai][m]); }
            }
        }
    }
};
DEV f32x4 sigm4(const f32x4 v) { f32x4 o;
#pragma unroll
    for (int i = 0; i < 4; ++i) o[i] = __builtin_amdgcn_rcpf(1.f + __builtin_amdgcn_exp2f(-LOG2E * v[i])); return o; }
struct EpiGates {
    typedef PreRs Pre;
    DEV void prefetch(PreRs& p, const Unit& u, int wr, int fr) const { pre_rs(p, ss, u.pm * BM + wr * 64 + fr); }
    static constexpr bool PERM = true, AFTER_DRAIN = false;
    bf16_t* G; const u64* ss;
    DEV void operator()(const Acc& acc, const Unit& u, int wr, int wc, int fr, int fq, const PreRs& pre) const {
        EPI_ROWS(u); float rs[2][4]; rs_of(rs, pre); bf16_t* base = G + (size_t)(u.pn >> 2) * T * D + (u.pn & 3) * 256 + wc * 32 + 8 * fq;
#pragma unroll
        for (int ai = 0; ai < 2; ++ai)
#pragma unroll
            for (int m = 0; m < 4; ++m) { bf16_t* rowp = base + (size_t)(row0 + ai * HALF + m * 16) * D;
#pragma unroll
                for (int bj = 0; bj < 2; ++bj) *(u32x4*)(rowp + bj * HALF) = pack8(sigm4(acc[ai][bj][m][0] * rs[ai][m]), sigm4(acc[ai][bj][m][1] * rs[ai][m])); }
    }
};
struct EpiMerge {
    typedef PreNone Pre;
    DEV void prefetch(PreNone&, const Unit&, int, int) const {}
    static constexpr bool PERM = true, AFTER_DRAIN = false;
    bf16_t* M; const bf16_t* G;
    DEV void operator()(const Acc& acc, const Unit& u, int wr, int wc, int fr, int fq, const PreNone&) const {
        EPI_ROWS(u); const size_t cofs = (size_t)u.pn * 256 + wc * 32 + 8 * fq; const bf16_t* gb = G + (size_t)u.job * T * D;
#pragma unroll
        for (int ai = 0; ai < 2; ++ai)
#pragma unroll
            for (int m = 0; m < 4; ++m) { const size_t ro = (size_t)(row0 + ai * HALF + m * 16) * D + cofs;
#pragma unroll
                for (int bj = 0; bj < 2; ++bj) { const size_t o = ro + bj * HALF; const u32x4 g = *(const u32x4*)(gb + o);
                    f32x4 v0 = acc[ai][bj][m][0], v1 = acc[ai][bj][m][1];
                    v0[0] *= bflo(g.x); v0[1] *= bfhi(g.x); v0[2] *= bflo(g.y); v0[3] *= bfhi(g.y); v1[0] *= bflo(g.z); v1[1] *= bfhi(g.z); v1[2] *= bflo(g.w); v1[3] *= bfhi(g.w);
                    if (u.job > 0) { const u32x4 p = __builtin_nontemporal_load((const u32x4*)(M + o));
                        v0[0] += bflo(p.x); v0[1] += bfhi(p.x); v0[2] += bflo(p.y); v0[3] += bfhi(p.y); v1[0] += bflo(p.z); v1[1] += bfhi(p.z); v1[2] += bflo(p.w); v1[3] += bfhi(p.w); }
                    *(u32x4*)(M + o) = pack8(v0, v1); } }
    }
};
template <bool IN_F32> struct EpiResid {
    typedef PreNone Pre;
    DEV void prefetch(PreNone&, const Unit&, int, int) const {}
    static constexpr bool PERM = true, AFTER_DRAIN = false;
    const void* xin; bf16_t* xb; u64* ss;
    DEV void operator()(const Acc& acc, const Unit& u, int wr, int wc, int fr, int fq, const PreNone&) const {
        EPI_ROWS(u); const size_t cofs = (size_t)u.pn * 256 + wc * 32 + 8 * fq;
#pragma unroll
        for (int ai = 0; ai < 2; ++ai)
#pragma unroll
            for (int m = 0; m < 4; ++m) { const size_t ro = (size_t)(row0 + ai * HALF + m * 16) * D + cofs; float sq = 0.f;
#pragma unroll
                for (int bj = 0; bj < 2; ++bj) { const size_t o = ro + bj * HALF; f32x4 v0 = acc[ai][bj][m][0], v1 = acc[ai][bj][m][1];
                    if (IN_F32) { v0 = v0 + *(const f32x4*)((const float*)xin + o); v1 = v1 + *(const f32x4*)((const float*)xin + o + 4); }
                    else { const u32x4 p = *(const u32x4*)((const bf16_t*)xin + o);
                        v0[0] += bflo(p.x); v0[1] += bfhi(p.x); v0[2] += bflo(p.y); v0[3] += bfhi(p.y); v1[0] += bflo(p.z); v1[1] += bfhi(p.z); v1[2] += bflo(p.w); v1[3] += bfhi(p.w); }
                    *(u32x4*)(xb + o) = pack8(v0, v1);
                    sq += ((v0[0] * v0[0] + v0[1] * v0[1]) + (v0[2] * v0[2] + v0[3] * v0[3])) + ((v1[0] * v1[0] + v1[1] * v1[1]) + (v1[2] * v1[2] + v1[3] * v1[3])); }
                sq += __shfl_xor(sq, 16); sq += __shfl_xor(sq, 32);
                if (fq == 0) atomicAdd(ss + row0 + ai * HALF + m * 16, (u64)(sq * SS_SCALE + 0.5f)); }
    }
};
struct EpiUp {
    typedef PreRs Pre;
    DEV void prefetch(PreRs& p, const Unit& u, int wr, int fr) const { pre_rs(p, ss, u.pm * BM + wr * 64 + fr); }
    static constexpr bool PERM = true, AFTER_DRAIN = false;
    bf16_t *fa, *fu; const u64* ss;
    DEV void operator()(const Acc& acc, const Unit& u, int wr, int wc, int fr, int fq, const PreRs& pre) const {
        EPI_ROWS(u); float rs[2][4]; rs_of(rs, pre); const size_t cofs = (size_t)u.pn * 128 + wc * 32 + 8 * fq;
#pragma unroll
        for (int ai = 0; ai < 2; ++ai)
#pragma unroll
            for (int m = 0; m < 4; ++m) { const size_t o = (size_t)(row0 + ai * HALF + m * 16) * DFF + cofs;
                *(u32x4*)(fa + o) = pack8(acc[ai][0][m][0] * rs[ai][m], acc[ai][0][m][1] * rs[ai][m]); *(u32x4*)(fu + o) = pack8(acc[ai][1][m][0] * rs[ai][m], acc[ai][1][m][1] * rs[ai][m]); }
    }
};
DEV float gelu_t(float a) { return a * __builtin_amdgcn_rcpf(1.f + __builtin_amdgcn_exp2f(-1.5957691216057308f * LOG2E * (a + 0.044715f * a * a * a))); }
DEV float row_prev1(float cur, float prevm) { const int r = __builtin_amdgcn_update_dpp(0, (int)__float_as_uint(prevm), 0x121, 0xf, 0xf, false);
    return __uint_as_float((unsigned)__builtin_amdgcn_update_dpp(r, (int)__float_as_uint(cur), 0x111, 0xf, 0xf, false)); }
DEV float row_prev2(float cur, float prevm) { const int r = __builtin_amdgcn_update_dpp(0, (int)__float_as_uint(prevm), 0x122, 0xf, 0xf, false);
    return __uint_as_float((unsigned)__builtin_amdgcn_update_dpp(r, (int)__float_as_uint(cur), 0x112, 0xf, 0xf, false)); }
struct EpiUpF {
    typedef PreRs Pre;
    DEV void prefetch(PreRs& p, const Unit& u, int wr, int fr) const { pre_rs(p, ss, u.pm * BM + wr * 64 + fr); }
    static constexpr bool PERM = true, AFTER_DRAIN = false;
    bf16_t *fu, *sa, *su; const u64* ss; const float *cw, *cb;
    DEV void operator()(const Acc& acc, const Unit& u, int wr, int wc, int fr, int fq, const PreRs& pre) const {
        EPI_ROWS(u); float rs[2][4]; rs_of(rs, pre); const size_t cofs = (size_t)u.pn * 128 + wc * 32 + 8 * fq;
        f32x4 w0[2], w1[2], w2[2], bb[2];
#pragma unroll
        for (int n = 0; n < 2; ++n) { w0[n] = *(const f32x4*)(cw + cofs + 4 * n); w1[n] = *(const f32x4*)(cw + DFF + cofs + 4 * n); w2[n] = *(const f32x4*)(cw + 2 * DFF + cofs + 4 * n); bb[n] = *(const f32x4*)(cb + cofs + 4 * n); }
#pragma unroll
        for (int ai = 0; ai < 2; ++ai) {
            const size_t strip = (size_t)u.pm * 4 + ai * 2 + wr;
            f32x4 ap[2] = {{0.f, 0.f, 0.f, 0.f}, {0.f, 0.f, 0.f, 0.f}};
#pragma unroll
            for (int m = 0; m < 4; ++m) {
                f32x4 a[2], g[2];
#pragma unroll
                for (int n = 0; n < 2; ++n) { a[n] = acc[ai][0][m][n] * rs[ai][m];
#pragma unroll
                    for (int e = 0; e < 4; ++e) { const float a1 = row_prev1(a[n][e], ap[n][e]), a2 = row_prev2(a[n][e], ap[n][e]);
                        g[n][e] = gelu_t(bb[n][e] + w0[n][e] * a2 + w1[n][e] * a1 + w2[n][e] * a[n][e]) * (acc[ai][1][m][n][e] * rs[ai][m]); } }
                if (m == 0) {
                    if (fr < 2) { *(u32x4*)(sa + (strip * 4 + fr) * DFF + cofs) = pack8(a[0], a[1]); *(u32x4*)(su + (strip * 2 + fr) * DFF + cofs) = pack8(acc[ai][1][0][0] * rs[ai][0], acc[ai][1][0][1] * rs[ai][0]); }
                    else *(u32x4*)(fu + (size_t)(row0 + ai * HALF) * DFF + cofs) = pack8(g[0], g[1]);
                } else {
                    *(u32x4*)(fu + (size_t)(row0 + ai * HALF + m * 16) * DFF + cofs) = pack8(g[0], g[1]);
                    if (m == 3 && fr >= 14) *(u32x4*)(sa + (strip * 4 + 2 + (fr - 14)) * DFF + cofs) = pack8(a[0], a[1]);
                }
                ap[0] = a[0]; ap[1] = a[1];
            }
        }
    }
};
struct EpiPrep {
    typedef PreNone Pre;
    DEV void prefetch(PreNone&, const Unit&, int, int) const {}
    static constexpr bool PERM = true, AFTER_DRAIN = false;
    unsigned char* ws; int mode;
    DEV void operator()(const Acc& acc, const Unit& u, int wr, int wc, int fr, int fq, const PreNone&) const {
        EPI_ROWS(u); bf16_t* base; int ldc; float sc = 1.f;
        if (mode == 0) { base = (bf16_t*)(ws + WS_KVM + (size_t)u.job * 2 * MiB); ldc = 2 * D; }
        else if (mode == 1) { base = (bf16_t*)(ws + WS_GT + (size_t)(u.job >> 2) * 2 * MiB) + (size_t)(u.job & 3) * 256 * D; ldc = D; sc = XSCALE; }
        else { base = (bf16_t*)(ws + WS_HT + (size_t)(u.job >> 2) * 2 * MiB) + (u.job & 3) * 256; ldc = D; }
        base += (size_t)u.pn * 256 + wc * 32 + 8 * fq;
#pragma unroll
        for (int ai = 0; ai < 2; ++ai)
#pragma unroll
            for (int m = 0; m < 4; ++m) { bf16_t* rowp = base + (size_t)(row0 + ai * HALF + m * 16) * ldc;
#pragma unroll
                for (int bj = 0; bj < 2; ++bj) *(u32x4*)(rowp + bj * HALF) = pack8(acc[ai][bj][m][0] * sc, acc[ai][bj][m][1] * sc); }
    }
};
struct EpiSoftmax {
    typedef PreRs Pre;
    DEV void prefetch(PreRs& p, const Unit& u, int wr, int fr) const { pre_rs(p, ss, u.pm * BM + wr * 64 + fr); }
    static constexpr bool PERM = true, AFTER_DRAIN = true;
    bf16_t* P; const u64* ss;
    DEV void fused(Acc& acc, const Unit& u, int wr, int wc, int fr, int fq, LAS unsigned char* lds, int wid, int lane, const PreRs& pre) const {
        LAS float* PM = (LAS float*)lds; LAS float* PS = (LAS float*)(lds + 4096);
        { const int row0_ = u.pm * BM + wr * 64 + fr; float rs[2][4]; rs_of(rs, pre);
#pragma unroll
          for (int ai = 0; ai < 2; ++ai)
#pragma unroll
              for (int m = 0; m < 4; ++m)
#pragma unroll
                  for (int bj = 0; bj < 2; ++bj)
#pragma unroll
                      for (int n = 0; n < 2; ++n) acc[ai][bj][m][n] = acc[ai][bj][m][n] * rs[ai][m]; }
#pragma unroll
        for (int ai = 0; ai < 2; ++ai)
#pragma unroll
            for (int m = 0; m < 4; ++m) { float mx = -INFINITY;
#pragma unroll
                for (int bj = 0; bj < 2; ++bj)
#pragma unroll
                    for (int n = 0; n < 2; ++n) { const f32x4 x = acc[ai][bj][m][n]; mx = fmaxf(mx, fmaxf(fmaxf(x[0], x[1]), fmaxf(x[2], x[3]))); }
                mx = fmaxf(mx, __shfl_xor(mx, 16)); mx = fmaxf(mx, __shfl_xor(mx, 32));
                if (fq == 0) PM[(ai * HALF + wr * 64 + m * 16 + fr) * 4 + wc] = mx; }
        LDS_WAIT(); __builtin_amdgcn_s_barrier(); asm volatile("" ::: "memory");
#pragma unroll
        for (int ai = 0; ai < 2; ++ai)
#pragma unroll
            for (int m = 0; m < 4; ++m) { const int r = ai * HALF + wr * 64 + m * 16 + fr; const f32x4 q = *(const LAS f32x4*)(PM + r * 4);
                const float mx = fmaxf(fmaxf(q[0], q[1]), fmaxf(q[2], q[3])); float s = 0.f;
#pragma unroll
                for (int bj = 0; bj < 2; ++bj)
#pragma unroll
                    for (int n = 0; n < 2; ++n) { f32x4 x = acc[ai][bj][m][n];
#pragma unroll
                        for (int i = 0; i < 4; ++i) { x[i] = __builtin_amdgcn_exp2f(x[i] - mx); s += x[i]; } acc[ai][bj][m][n] = x; }
                s += __shfl_xor(s, 16); s += __shfl_xor(s, 32);
                if (fq == 0) PS[r * 4 + wc] = s; }
        LDS_WAIT(); __builtin_amdgcn_s_barrier(); asm volatile("" ::: "memory");
        EPI_ROWS(u); bf16_t* base = P + (size_t)u.pn * 256 + wc * 32 + 8 * fq;
#pragma unroll
        for (int ai = 0; ai < 2; ++ai)
#pragma unroll
            for (int m = 0; m < 4; ++m) { const int r = ai * HALF + wr * 64 + m * 16 + fr; const f32x4 q = *(const LAS f32x4*)(PS + r * 4);
                const float inv = 1.f / ((q[0] + q[1]) + (q[2] + q[3])); bf16_t* rowp = base + (size_t)(row0 + ai * HALF + m * 16) * D;
#pragma unroll
                for (int bj = 0; bj < 2; ++bj) *(u32x4*)(rowp + bj * HALF) = pack8(acc[ai][bj][m][0] * inv, acc[ai][bj][m][1] * inv); }
        LDS_WAIT(); __builtin_amdgcn_s_barrier();
    }
};
}

typedef GAS unsigned gu32;
#define XB_TMO      128
#define XB_XCNT(j)  (256  + 64 * (j))
#define XB_XSUB(j)  (1280 + 64 * (j))
#define XB_XGEN(j)  (2304 + 64 * (j))
#define XB_TOP      3328
#define XB_TOPGEN   3392
#define XCD_BAR_WORDS 3456
#define XB_SPIN_CAP (1u << 22)
DEV unsigned xb_ld(unsigned* p) { return __hip_atomic_load(p, __ATOMIC_RELAXED, __HIP_MEMORY_SCOPE_AGENT); }
DEV unsigned xb_add(unsigned* p, unsigned v) { return __hip_atomic_fetch_add(p, v, __ATOMIC_RELAXED, __HIP_MEMORY_SCOPE_AGENT); }
DEV unsigned xb_xcc_id() { return (unsigned)__builtin_amdgcn_s_getreg((3 << 11) | 20) & 0xFu; }
#define XB_SPIN(cond, bar) do { unsigned _sp = 0; while (cond) { __builtin_amdgcn_s_sleep(1); \
    if ((++_sp & 255u) == 0u) { if (xb_ld(&(bar)[XB_TMO])) break; if (_sp > XB_SPIN_CAP) { atomicAdd(&(bar)[XB_TMO], 1u); break; } } } } while (0)
struct XcdBarrier { unsigned* bar; unsigned x; volatile LAS unsigned* st; };
DEV XcdBarrier xcd_barrier_post(unsigned* bar, volatile LAS unsigned* st, int tid) {
    XcdBarrier b; b.bar = bar; b.x = xb_xcc_id(); b.st = st;
    if (tid == 0) (void)xb_add(&bar[XB_XCNT(b.x)], 1u);
    return b;
}
DEV void xcd_barrier_complete(unsigned* bar, unsigned x, unsigned& nloc, unsigned& nx) {
    const unsigned G = gridDim.x * gridDim.y * gridDim.z;
    unsigned sum, cnt, mine, sp = 0u;
    for (;;) {
        sum = 0u; cnt = 0u; mine = 0u;
#pragma unroll
        for (unsigned j = 0; j < 16; ++j) { const unsigned c = xb_ld(&bar[XB_XCNT(j)]); sum += c; cnt += (c > 0u) ? 1u : 0u; mine = (j == x) ? c : mine; }
        if (sum == G) break;
        __builtin_amdgcn_s_sleep(1);
        if ((++sp & 255u) == 0u) { if (xb_ld(&bar[XB_TMO])) break; if (sp > XB_SPIN_CAP) { atomicAdd(&bar[XB_TMO], 1u); break; } }
    }
    nloc = mine > 0u ? mine : 1u; nx = cnt > 0u ? cnt : 1u;
}
DEV void xcd_barrier(const XcdBarrier& b, int tid) {
    asm volatile("s_waitcnt vmcnt(0)" ::: "memory");
    __syncthreads();
    if (tid == 0) {
        unsigned* bar = b.bar;
        __builtin_amdgcn_s_waitcnt(0);
        unsigned nloc = b.st[0], nx = b.st[1];
        if (nloc == 0u) { xcd_barrier_complete(bar, b.x, nloc, nx); b.st[0] = nloc; b.st[1] = nx; }
        const unsigned old = xb_add(&bar[XB_XSUB(b.x)], 1u);
        const unsigned gen = old / nloc;
        if (old + 1u == (gen + 1u) * nloc) {
            __builtin_amdgcn_fence(__ATOMIC_RELEASE, "agent");
            asm volatile("s_waitcnt vmcnt(0)" ::: "memory");
            const unsigned og = xb_add(&bar[XB_TOP], 1u);
            const unsigned tg = og / nx;
            if (og + 1u == (tg + 1u) * nx) xb_add(&bar[XB_TOPGEN], 1u);
            else XB_SPIN(xb_ld(&bar[XB_TOPGEN]) == tg, bar);
            __builtin_amdgcn_fence(__ATOMIC_ACQUIRE, "agent");
            xb_add(&bar[XB_XGEN(b.x)], 1u);
            asm volatile("s_waitcnt vmcnt(0)" ::: "memory");
        } else {
            XB_SPIN(xb_ld(&bar[XB_XGEN(b.x)]) == gen, bar);
            __builtin_amdgcn_fence(__ATOMIC_ACQUIRE, "agent");
            asm volatile("s_waitcnt vmcnt(0)" ::: "memory");
        }
    }
    __syncthreads();
}


using pg8::gelu_t;
struct WaveId { int gw, ngw, wave, lane; };
DEV unsigned f2bf_u(float f) { return (unsigned)f2bf(f); }
DEV unsigned pk2(float lo, float hi) { return cvt_pk_bf16(lo, hi); }

DEV void norm_rows(const WaveId& W, const float* x, const float* g, bf16_t* outb, float* outf, int rows) {
    for (int row = W.gw; row < rows; row += W.ngw) {
        const f32x4* xr = (const f32x4*)(x + (size_t)row * D) + W.lane;
        f32x4 v[4]; float s = 0.f;
#pragma unroll
        for (int j = 0; j < 4; ++j) { v[j] = xr[64 * j]; s += (v[j].x * v[j].x + v[j].y * v[j].y) + (v[j].z * v[j].z + v[j].w * v[j].w); }
        const float r = rsqrtf(wave_sum(s) * (1.f / D) + EPS);
#pragma unroll
        for (int j = 0; j < 4; ++j) {
            const f32x4 gg = ((const f32x4*)g)[W.lane + 64 * j];
            const f32x4 o = {v[j].x * r * gg.x, v[j].y * r * gg.y, v[j].z * r * gg.z, v[j].w * r * gg.w};
            if (outb) { u32x2 w; w.x = pk2(o.x, o.y); w.y = pk2(o.z, o.w); ((u32x2*)(outb + (size_t)row * D))[W.lane + 64 * j] = w; }
            else ((f32x4*)(outf + (size_t)row * D))[W.lane + 64 * j] = o;
        }
    }
}
DEV void cvt_piece(const WaveId& W, LAS float* scr, int& base, const float* Wsrc, int ldw, int K, int col0, int ncols, bf16_t* dst, int ldo, int row0, const float* gain = nullptr) {
    const int nblk = ncols / 32, nitems = (K / 64) * nblk;
    int first = (W.gw - base) % W.ngw; if (first < 0) first += W.ngw;
    base = (base + nitems) % W.ngw;
    for (int item = first; item < nitems; item += W.ngw) {
        const int kb = item / nblk, nb = item - kb * nblk, k0 = 64 * kb, n0 = 32 * nb;
        { const int lr = W.lane >> 3, lc = (W.lane & 7) * 4;
          f32x4 v[8]; float g[8];
#pragma unroll
          for (int i = 0; i < 8; ++i) { v[i] = *(const f32x4*)(Wsrc + (size_t)(k0 + lr + 8 * i) * ldw + col0 + n0 + lc); g[i] = gain ? gain[k0 + lr + 8 * i] : 1.f; }
#pragma unroll
          for (int i = 0; i < 8; ++i) { LAS float* d = scr + (lr + 8 * i) * 33 + lc; d[0] = v[i][0] * g[i]; d[1] = v[i][1] * g[i]; d[2] = v[i][2] * g[i]; d[3] = v[i][3] * g[i]; } }
        LDS_WAIT(); asm volatile("" ::: "memory");
        const int c = W.lane & 7;
#pragma unroll
        for (int j = 0; j < 4; ++j) { const int n = (W.lane >> 3) + 8 * j; const LAS float* s = scr + (8 * c) * 33 + n;
            u32x4 o; o.x = pk2(s[0 * 33], s[1 * 33]); o.y = pk2(s[2 * 33], s[3 * 33]); o.z = pk2(s[4 * 33], s[5 * 33]); o.w = pk2(s[6 * 33], s[7 * 33]);
            *(u32x4*)(dst + (size_t)(row0 + n0 + n) * ldo + k0 + 8 * c) = o; }
        LDS_WAIT(); asm volatile("" ::: "memory");
    }
}
DEV void convert_layer_weights(const WaveId& W, LAS float* scr, int& base, unsigned char* ws, const float* const* in, int l, int part = 3) {
    const float* wi = in[3] + (size_t)l * D * DIN;
    if (part & 1) {
    bf16_t* WIN = (bf16_t*)(ws + WS_WIN); const float* gm = in[2] + l * D;
    cvt_piece(W, scr, base, wi, DIN, D, 0, 1536, WIN, D, 0, gm);
    cvt_piece(W, scr, base, wi, DIN, D, 3072, 1536, WIN, D, 1536, gm);
    cvt_piece(W, scr, base, wi, DIN, D, 4608, 512, WIN, D, 3072, gm);
    cvt_piece(W, scr, base, wi, DIN, D, 1536, 512, WIN, D, 3584, gm);
#pragma unroll 1
    for (int j = 0; j < 4; ++j) { cvt_piece(W, scr, base, wi, DIN, D, 2048 + 128 * j, 128, WIN, D, 4096 + 256 * j, gm); cvt_piece(W, scr, base, wi, DIN, D, 2560 + 128 * j, 128, WIN, D, 4096 + 256 * j + 128, gm); }
    cvt_piece(W, scr, base, wi, DIN, D, 5120, 96, WIN, D, 5120, gm);
    cvt_piece(W, scr, base, wi, DIN, D, 5192, 3072, (bf16_t*)(ws + WS_WG), D, 0, gm);
#pragma unroll 1
    for (int i = 0; i < 3; ++i) cvt_piece(W, scr, base, in[5 + i] + (size_t)l * 512 * D, D, 512, 0, D, (bf16_t*)(ws + WS_WBR) + (size_t)i * D * 512, 512, 0);
    cvt_piece(W, scr, base, in[8] + (size_t)l * D * D, D, D, 0, D, (bf16_t*)(ws + WS_WMIX), D, 0);
    }
    if (!(part & 2)) return;
    const float* gf = in[14] + l * D;
    const float* wf = in[15] + (size_t)l * D * 2 * DFF;
#pragma unroll 1
    for (int j = 0; j < 22; ++j) { cvt_piece(W, scr, base, wf, 2 * DFF, D, 128 * j, 128, (bf16_t*)(ws + WS_WUP), D, 256 * j, gf); cvt_piece(W, scr, base, wf, 2 * DFF, D, DFF + 128 * j, 128, (bf16_t*)(ws + WS_WUP), D, 256 * j + 128, gf); }
    cvt_piece(W, scr, base, in[18] + (size_t)l * DFF * D, D, DFF, 0, D, (bf16_t*)(ws + WS_WDOWN), DFF, 0);
}
DEV void prep0_phase(const WaveId& W, LAS float* scr, unsigned char* ws, const float* const* in, bf16_t* XB) {
    int base = 0;
#pragma unroll 1
    for (int l = 0; l < DEPTH; ++l) {
        const float* wq = in[11] + (size_t)l * D * D; bf16_t* WQ = (bf16_t*)(ws + WS_WQ + (size_t)l * 2 * MiB); const float* gx = in[9] + l * D;
        for (size_t i = (size_t)(W.gw * 64 + W.lane) * 4; i < (size_t)D * D; i += (size_t)W.ngw * 256) { const float g = gx[i >> 10]; const f32x4 v = *(const f32x4*)(wq + i); u32x2 o; o.x = pk2(v.x * g, v.y * g); o.y = pk2(v.z * g, v.w * g); *(u32x2*)(WQ + i) = o; }
        cvt_piece(W, scr, base, in[13] + (size_t)l * D * D, D, D, 0, D, (bf16_t*)(ws + WS_WOT + (size_t)l * 2 * MiB), D, 0);
        cvt_piece(W, scr, base, in[12] + (size_t)l * D * 2 * D, 2 * D, D, 0, 2 * D, (bf16_t*)(ws + WS_WKVT + (size_t)l * 4 * MiB), D, 0);
        norm_rows(W, in[1], in[10] + l * D, (bf16_t*)(ws + WS_MEMN + (size_t)l * MiB), nullptr, NB * MEM);
    }
    convert_layer_weights(W, scr, base, ws, in, 0);
    pg8::u64* ss0 = (pg8::u64*)(ws + WS_SS);
    for (int row0 = W.gw; row0 < T; row0 += 4 * W.ngw) {
        f32x4 v[4][4];
#pragma unroll
        for (int u = 0; u < 4; ++u) { const f32x4* xr = (const f32x4*)(in[0] + (size_t)(row0 + u * W.ngw) * D) + W.lane;
#pragma unroll
            for (int j = 0; j < 4; ++j) v[u][j] = xr[64 * j]; }
#pragma unroll
        for (int u = 0; u < 4; ++u) { const int row = row0 + u * W.ngw; float s = 0.f;
#pragma unroll
            for (int j = 0; j < 4; ++j) { const f32x4 x = v[u][j]; s += (x.x * x.x + x.y * x.y) + (x.z * x.z + x.w * x.w);
                u32x2 w; w.x = pk2(x.x, x.y); w.y = pk2(x.z, x.w); ((u32x2*)(XB + (size_t)row * D))[W.lane + 64 * j] = w; }
            s = wave_sum(s); if (W.lane == 0) ss0[row] = (pg8::u64)(s * pg8::SS_SCALE + 0.5f); }
    }
}
DEV void final_norm(const WaveId& W, const bf16_t* x, float* out, const float* g, const pg8::u64* ss) {
    f32x4 gg[4];
#pragma unroll
    for (int j = 0; j < 4; ++j) gg[j] = ((const f32x4*)g)[W.lane + 64 * j];
    for (int row0 = W.gw; row0 < T; row0 += 4 * W.ngw) {
        u32x2 v[4][4]; pg8::u64 sq[4];
#pragma unroll
        for (int u = 0; u < 4; ++u) { const int row = row0 + u * W.ngw; sq[u] = ss[row]; const u32x2* xr = (const u32x2*)(x + (size_t)row * D) + W.lane;
#pragma unroll
            for (int j = 0; j < 4; ++j) v[u][j] = xr[64 * j]; }
#pragma unroll
        for (int u = 0; u < 4; ++u) { const int row = row0 + u * W.ngw; const float r = rsqrtf((float)sq[u] * (1.f / (pg8::SS_SCALE * D)) + EPS); f32x4* orow = (f32x4*)(out + (size_t)row * D) + W.lane;
#pragma unroll
            for (int j = 0; j < 4; ++j) { const u32x2 w = v[u][j];
                const f32x4 o = {bflo(w.x) * r * gg[j].x, bfhi(w.x) * r * gg[j].y, bflo(w.y) * r * gg[j].z, bfhi(w.y) * r * gg[j].w}; orow[64 * j] = o; } }
    }
}
DEV void conv_sc_phase(int gtid, int gthreads, bf16_t* scb, const bf16_t* cx, const float* w, bool dry) {
    for (int i = gtid; i < T * 64; i += gthreads) {
        const int c8 = (i & 63) * 8, t = i >> 6, tl = t & (S - 1);
        const size_t o = (size_t)t * 512 + c8;
        const u32x4 z = {0u, 0u, 0u, 0u};
        const u32x4 x2 = *(const u32x4*)(cx + o), x1 = tl >= 1 ? *(const u32x4*)(cx + o - 512) : z, x0 = tl >= 2 ? *(const u32x4*)(cx + o - 1024) : z, bb = *(const u32x4*)(scb + o);
        const f32x4 w0a = *(const f32x4*)(w + c8), w0b = *(const f32x4*)(w + c8 + 4), w1a = *(const f32x4*)(w + 512 + c8), w1b = *(const f32x4*)(w + 512 + c8 + 4), w2a = *(const f32x4*)(w + 1024 + c8), w2b = *(const f32x4*)(w + 1024 + c8 + 4);
        float r[8];
#define CONV1(k, W0, W1, W2, X0, X1, X2, BBv, F) r[k] = F(BBv) * (W0 * F(X0) + W1 * F(X1) + W2 * F(X2))
        CONV1(0, w0a.x, w1a.x, w2a.x, x0.x, x1.x, x2.x, bb.x, bflo); CONV1(1, w0a.y, w1a.y, w2a.y, x0.x, x1.x, x2.x, bb.x, bfhi);
        CONV1(2, w0a.z, w1a.z, w2a.z, x0.y, x1.y, x2.y, bb.y, bflo); CONV1(3, w0a.w, w1a.w, w2a.w, x0.y, x1.y, x2.y, bb.y, bfhi);
        CONV1(4, w0b.x, w1b.x, w2b.x, x0.z, x1.z, x2.z, bb.z, bflo); CONV1(5, w0b.y, w1b.y, w2b.y, x0.z, x1.z, x2.z, bb.z, bfhi);
        CONV1(6, w0b.z, w1b.z, w2b.z, x0.w, x1.w, x2.w, bb.w, bflo); CONV1(7, w0b.w, w1b.w, w2b.w, x0.w, x1.w, x2.w, bb.w, bfhi);
#undef CONV1
        u32x4 ov; ov.x = pk2(r[0], r[1]); ov.y = pk2(r[2], r[3]); ov.z = pk2(r[4], r[5]); ov.w = pk2(r[6], r[7]);
        if (!dry) *(u32x4*)(scb + o) = ov; else asm volatile("" :: "v"(ov));
    }
}
DEV void ffn_mid_phase(int gtid, int gthreads, const bf16_t* fa, bf16_t* fu, const float* cw, const float* cb, bool dry) {
    constexpr int C8 = DFF / 8;
    for (int i = gtid; i < T * C8; i += gthreads) {
        const int t = i / C8, c8 = (i - t * C8) * 8, tl = t & (S - 1);
        const size_t o = (size_t)t * DFF + c8;
        const u32x4 z = {0u, 0u, 0u, 0u};
        const u32x4 x2 = *(const u32x4*)(fa + o), x1 = tl >= 1 ? *(const u32x4*)(fa + o - DFF) : z, x0 = tl >= 2 ? *(const u32x4*)(fa + o - 2 * DFF) : z, uu = *(const u32x4*)(fu + o);
        const f32x4 w0a = *(const f32x4*)(cw + c8), w0b = *(const f32x4*)(cw + c8 + 4), w1a = *(const f32x4*)(cw + DFF + c8), w1b = *(const f32x4*)(cw + DFF + c8 + 4), w2a = *(const f32x4*)(cw + 2 * DFF + c8), w2b = *(const f32x4*)(cw + 2 * DFF + c8 + 4);
        const f32x4 ba = *(const f32x4*)(cb + c8), bb = *(const f32x4*)(cb + c8 + 4);
        float r[8];
#define FM1(k, B0, W0, W1, W2, X0, X1, X2, Uv, F) r[k] = gelu_t(B0 + W0 * F(X0) + W1 * F(X1) + W2 * F(X2)) * F(Uv)
        FM1(0, ba.x, w0a.x, w1a.x, w2a.x, x0.x, x1.x, x2.x, uu.x, bflo); FM1(1, ba.y, w0a.y, w1a.y, w2a.y, x0.x, x1.x, x2.x, uu.x, bfhi);
        FM1(2, ba.z, w0a.z, w1a.z, w2a.z, x0.y, x1.y, x2.y, uu.y, bflo); FM1(3, ba.w, w0a.w, w1a.w, w2a.w, x0.y, x1.y, x2.y, uu.y, bfhi);
        FM1(4, bb.x, w0b.x, w1b.x, w2b.x, x0.z, x1.z, x2.z, uu.z, bflo); FM1(5, bb.y, w0b.y, w1b.y, w2b.y, x0.z, x1.z, x2.z, uu.z, bfhi);
        FM1(6, bb.z, w0b.z, w1b.z, w2b.z, x0.w, x1.w, x2.w, uu.w, bflo); FM1(7, bb.w, w0b.w, w1b.w, w2b.w, x0.w, x1.w, x2.w, uu.w, bfhi);
#undef FM1
        u32x4 ov; ov.x = pk2(r[0], r[1]); ov.y = pk2(r[2], r[3]); ov.z = pk2(r[4], r[5]); ov.w = pk2(r[6], r[7]);
        if (!dry) *(u32x4*)(fu + o) = ov; else asm volatile("" :: "v"(ov));
    }
}

DEV void ffn_fix_phase(int gtid, int gthreads, const bf16_t* sa, const bf16_t* su, bf16_t* fu, const float* cw, const float* cb, int strip0 = 0, int nstrip = T / 64) {
    constexpr int C8 = DFF / 8;
    for (int i = gtid; i < nstrip * 2 * C8; i += gthreads) {
        const int sr = i / C8, c8 = (i - sr * C8) * 8, strip = strip0 + (sr >> 1), rr = sr & 1, t = strip * 64 + rr;
        const bool first = (strip & (S / 64 - 1)) == 0;
        const u32x4 z = {0u, 0u, 0u, 0u};
        const bf16_t* A = sa + (size_t)strip * 4 * DFF + c8; const bf16_t* Ap = A - 4 * DFF;
        const u32x4 x2 = *(const u32x4*)(A + rr * DFF);
        const u32x4 x1 = rr == 1 ? *(const u32x4*)A : (first ? z : *(const u32x4*)(Ap + 3 * DFF));
        const u32x4 x0 = first ? z : *(const u32x4*)(Ap + (2 + rr) * DFF);
        const u32x4 uu = *(const u32x4*)(su + ((size_t)strip * 2 + rr) * DFF + c8);
        const f32x4 w0a = *(const f32x4*)(cw + c8), w0b = *(const f32x4*)(cw + c8 + 4), w1a = *(const f32x4*)(cw + DFF + c8), w1b = *(const f32x4*)(cw + DFF + c8 + 4), w2a = *(const f32x4*)(cw + 2 * DFF + c8), w2b = *(const f32x4*)(cw + 2 * DFF + c8 + 4);
        const f32x4 ba = *(const f32x4*)(cb + c8), bb = *(const f32x4*)(cb + c8 + 4);
        float r[8];
#define FM1(k, B0, W0, W1, W2, X0, X1, X2, Uv, F) r[k] = gelu_t(B0 + W0 * F(X0) + W1 * F(X1) + W2 * F(X2)) * F(Uv)
        FM1(0, ba.x, w0a.x, w1a.x, w2a.x, x0.x, x1.x, x2.x, uu.x, bflo); FM1(1, ba.y, w0a.y, w1a.y, w2a.y, x0.x, x1.x, x2.x, uu.x, bfhi);
        FM1(2, ba.z, w0a.z, w1a.z, w2a.z, x0.y, x1.y, x2.y, uu.y, bflo); FM1(3, ba.w, w0a.w, w1a.w, w2a.w, x0.y, x1.y, x2.y, uu.y, bfhi);
        FM1(4, bb.x, w0b.x, w1b.x, w2b.x, x0.z, x1.z, x2.z, uu.z, bflo); FM1(5, bb.y, w0b.y, w1b.y, w2b.y, x0.z, x1.z, x2.z, uu.z, bfhi);
        FM1(6, bb.z, w0b.z, w1b.z, w2b.z, x0.w, x1.w, x2.w, uu.w, bflo); FM1(7, bb.w, w0b.w, w1b.w, w2b.w, x0.w, x1.w, x2.w, uu.w, bfhi);
#undef FM1
        u32x4 ov; ov.x = pk2(r[0], r[1]); ov.y = pk2(r[2], r[3]); ov.z = pk2(r[4], r[5]); ov.w = pk2(r[6], r[7]);
        *(u32x4*)(fu + (size_t)t * DFF + c8) = ov;
    }
}

typedef short s16x4 __attribute__((ext_vector_type(4)));
DEV s16x4 vtr(const LAS unsigned char* p) { return __builtin_bit_cast(s16x4, __builtin_amdgcn_ds_read_tr16_b64_v4i16((LAS s16x4*)p)); }
DEV bf16x8 cat8(const s16x4 a, const s16x4 b) { return (bf16x8){a[0], a[1], a[2], a[3], b[0], b[1], b[2], b[3]}; }
DEV bf16x8 pk8(float a0, float a1, float a2, float a3, float a4, float a5, float a6, float a7) {
    u32x4 w; w.x = pk2(a0, a1); w.y = pk2(a2, a3); w.z = pk2(a4, a5); w.w = pk2(a6, a7); return __builtin_bit_cast(bf16x8, w); }
constexpr int VPITCH = 192;
DEV void pv_tile(f32x16& o0, f32x16& o1, const LAS unsigned char* vt, int lane, const bf16x8 (&pk)[4]) {
    const int hi = lane >> 5;
    const LAS unsigned char* vb = vt + (4 * hi + ((lane & 15) >> 2)) * VPITCH + ((lane >> 4) & 1) * 32 + (lane & 3) * 8;
    bf16x8 va[4];
#pragma unroll
    for (int ks = 0; ks < 4; ++ks) va[ks] = cat8(vtr(vb + (16 * ks) * VPITCH), vtr(vb + (16 * ks + 8) * VPITCH));
    asm volatile("" : "+v"(va[0]), "+v"(va[1]), "+v"(va[2]), "+v"(va[3]));
#pragma unroll
    for (int ks = 0; ks < 4; ++ks) o0 = __builtin_amdgcn_mfma_f32_32x32x16_bf16(va[ks], pk[ks], o0, 0, 0, 0);
#pragma unroll
    for (int ks = 0; ks < 4; ++ks) va[ks] = cat8(vtr(vb + (16 * ks) * VPITCH + 64), vtr(vb + (16 * ks + 8) * VPITCH + 64));
    asm volatile("" : "+v"(va[0]), "+v"(va[1]), "+v"(va[2]), "+v"(va[3]));
#pragma unroll
    for (int ks = 0; ks < 4; ++ks) o1 = __builtin_amdgcn_mfma_f32_32x32x16_bf16(va[ks], pk[ks], o1, 0, 0, 0);
}
DEV void store_ot(bf16_t* orow, const f32x16& o0, const f32x16& o1, int hi, float sc) {
#pragma unroll
    for (int g4 = 0; g4 < 4; ++g4) {
        u32x2 a; a.x = pk2(o0[4 * g4] * sc, o0[4 * g4 + 1] * sc); a.y = pk2(o0[4 * g4 + 2] * sc, o0[4 * g4 + 3] * sc);
        u32x2 b; b.x = pk2(o1[4 * g4] * sc, o1[4 * g4 + 1] * sc); b.y = pk2(o1[4 * g4 + 2] * sc, o1[4 * g4 + 3] * sc);
        *(u32x2*)(orow + 8 * g4 + 4 * hi) = a; *(u32x2*)(orow + 32 + 8 * g4 + 4 * hi) = b;
    }
}

DEV void sb_item(LAS unsigned char* vl, const bf16_t* Q, const bf16_t* Kk, const bf16_t* V, bf16_t* O, int b, int h, int qb, int lane, bool dry) {
    const int r32 = lane & 31, hi = lane >> 5, t0 = 32 * qb, t = t0 + r32; const size_t rowb = (size_t)b * S;
    bf16x8 qr[4]; { const bf16_t* qp = Q + (rowb + t0 + r32) * 512 + h * 64 + 8 * hi;
#pragma unroll
        for (int d0 = 0; d0 < 4; ++d0) qr[d0] = *(const bf16x8*)(qp + 16 * d0); }
    f32x16 o0, o1;
#pragma unroll
    for (int r = 0; r < 16; ++r) { o0[r] = 0.f; o1[r] = 0.f; }
    float carry = 1.f;
    const int c_hi = (t0 + 30) >> 6;
#pragma unroll 1
    for (int c = c_hi; c >= 0; --c) {
        const bf16_t* kp = Kk + (rowb + 64 * c + r32) * 512 + h * 64 + 8 * hi;
        bf16x8 k0[4], k1[4];
#pragma unroll
        for (int d0 = 0; d0 < 4; ++d0) { k0[d0] = *(const bf16x8*)(kp + 16 * d0); k1[d0] = *(const bf16x8*)(kp + (size_t)32 * 512 + 16 * d0); }
#pragma unroll
        for (int j = 0; j < 8; ++j) { const int row = (lane >> 3) + 8 * j; *(LAS u32x4*)(vl + row * VPITCH + (lane & 7) * 16) = *(const u32x4*)(V + (rowb + 64 * c + row) * 512 + h * 64 + (lane & 7) * 8); }
        f32x16 p0, p1;
#pragma unroll
        for (int r = 0; r < 16; ++r) { p0[r] = 0.f; p1[r] = 0.f; }
#pragma unroll
        for (int d0 = 0; d0 < 4; ++d0) { p0 = __builtin_amdgcn_mfma_f32_32x32x16_bf16(k0[d0], qr[d0], p0, 0, 0, 0); p1 = __builtin_amdgcn_mfma_f32_32x32x16_bf16(k1[d0], qr[d0], p1, 0, 0, 0); }
        float u[32];
        const bool diag = (c == c_hi);
#pragma unroll
        for (int e = 0; e < 32; ++e) {
            const float z = e < 16 ? p0[e] : p1[e - 16];
            float uu = __builtin_amdgcn_rcpf(1.f + __builtin_amdgcn_exp2f(fminf(z, 126.f)));
            if (diag) { const int kv = 64 * c + 8 * ((e >> 2) & 3) + 4 * hi + (e & 3) + 32 * (e >> 4); if (kv >= t) uu = 1.f; }
            u[e] = uu;
        }
        float gl[8], gh[8];
#pragma unroll
        for (int i = 0; i < 8; ++i) { const float gp = (u[4 * i] * u[4 * i + 1]) * (u[4 * i + 2] * u[4 * i + 3]);
            const auto rr = __builtin_amdgcn_permlane32_swap(__float_as_uint(gp), __float_as_uint(gp), false, false); gl[i] = __uint_as_float(rr[0]); gh[i] = __uint_as_float(rr[1]); }
        float ag[8]; float run = carry;
#pragma unroll
        for (int i = 7; i >= 0; --i) { const float a_hi = run; run *= gh[i]; const float a_lo = run; run *= gl[i]; ag[i] = hi ? a_hi : a_lo; }
        carry = run;
        bf16x8 pk[4];
#pragma unroll
        for (int ks = 0; ks < 4; ++ks) { float w[8];
#pragma unroll
            for (int g = 0; g < 2; ++g) { const int i = 2 * ks + g;
                const float a3 = ag[i], a2 = a3 * u[4 * i + 3], a1 = a2 * u[4 * i + 2], a0 = a1 * u[4 * i + 1];
                w[4 * g] = (1.f - u[4 * i]) * a0; w[4 * g + 1] = (1.f - u[4 * i + 1]) * a1; w[4 * g + 2] = (1.f - u[4 * i + 2]) * a2; w[4 * g + 3] = (1.f - u[4 * i + 3]) * a3; }
            pk[ks] = pk8(w[0], w[1], w[2], w[3], w[4], w[5], w[6], w[7]); }
        pv_tile(o0, o1, vl, lane, pk);
        if (__all(carry < 7.8e-31f)) break;
    }
    if (!dry) store_ot(O + (rowb + t0 + r32) * 512 + h * 64, o0, o1, hi, 1.f); else asm volatile("" :: "v"(o0), "v"(o1));
}
DEV void sb_phase(const WaveId& W, LAS unsigned char* lds, unsigned char* ws, bool dry) {
    LAS unsigned char* vl = lds + W.wave * 12288;
    const bf16_t* Q = (const bf16_t*)(ws + WS_QA); const bf16_t* Kk = (const bf16_t*)(ws + WS_KA); const bf16_t* V = (const bf16_t*)(ws + WS_VA);
    constexpr int NITEM = NB * 8 * (S / 32);
    for (int it = W.gw; it < NITEM; it += W.ngw) {
        const int qb = it & 255, h = (it >> 8) & 7, b = it >> 11;
        sb_item(vl, Q, Kk, V, (bf16_t*)(ws + WS_QA), b, h, qb, W.lane, dry);
    }
}

constexpr int IDX_CTL_OFF = 131072 + 1024;
DEV unsigned fkey2(float v) { const int u = (int)__float_as_uint(v); return (unsigned)(u ^ ((u >> 31) | (int)0x80000000)); }
DEV float relu1(float x) { return __builtin_amdgcn_fmed3f(x, 0.f, 3.0e38f); }
DEV void idx_prefetch(bf16x8 (&afr)[4], float (&w)[16], bf16x8 (&b0)[4], bf16x8 (&b1)[4], const bf16_t* IQ, const bf16_t* IK, const float* IWp, int b, int t0, int wid, int lane) {
    const int r32 = lane & 31, hh = lane >> 5; const size_t rowb = (size_t)b * S;
    { const int qi = 2 * (r32 >> 4) + ((r32 >> 2) & 1), head = (r32 & 3) + 4 * ((r32 >> 3) & 1);
        const bf16_t* ap = IQ + (rowb + t0 + qi) * 512 + head * 64 + 8 * hh;
#pragma unroll
        for (int ks = 0; ks < 4; ++ks) afr[ks] = *(const bf16x8*)(ap + 16 * ks); }
#pragma unroll
    for (int r = 0; r < 16; ++r) w[r] = IWp[(rowb + t0 + 2 * (r >> 3) + hh) * 8 + (r & 7)];
    const int jmax = (t0 + 3) >> 5;
    { const int j0 = wid < jmax ? wid : jmax, j1 = wid + 8 < jmax ? wid + 8 : jmax;
      const bf16_t* p0 = IK + ((rowb >> 5) + j0) * 2048 + (hh * 32 + r32) * 8; const bf16_t* p1 = IK + ((rowb >> 5) + j1) * 2048 + (hh * 32 + r32) * 8;
#pragma unroll
      for (int ks = 0; ks < 4; ++ks) { b0[ks] = *(const bf16x8*)(p0 + ks * 512); b1[ks] = *(const bf16x8*)(p1 + ks * 512); } }
}
DEV void idx_unit(LAS unsigned char* lds, const bf16_t* IQ, const bf16_t* IK, const float* IWp, unsigned* BM, int b, int t0, int nb, int nt0, int wid, int lane,
                  bf16x8 (&afr)[4], float (&w)[16], bf16x8 (&b0)[4], bf16x8 (&b1)[4]) {
    const int r32 = lane & 31, hh = lane >> 5; const size_t rowb = (size_t)b * S;
    const int tmax = t0 + 3, jmax = tmax >> 5;
    LAS unsigned* SCO = (LAS unsigned*)lds;
    bf16x8 b2[4];
#pragma unroll
    for (int ks = 0; ks < 4; ++ks) b2[ks] = afr[ks];
#define IDX_LOADB(dst, jj) do { const int jc_ = (jj) < jmax ? (jj) : jmax; const bf16_t* bp_ = IK + ((rowb >> 5) + jc_) * 2048 + (hh * 32 + r32) * 8; \
        _Pragma("unroll") for (int ks = 0; ks < 4; ++ks) dst[ks] = *(const bf16x8*)(bp_ + ks * 512); } while (0)
#define IDX_COMP(src, jj) do { f32x16 acc; _Pragma("unroll") for (int r = 0; r < 16; ++r) acc[r] = 0.f; \
        _Pragma("unroll") for (int ks = 0; ks < 4; ++ks) acc = __builtin_amdgcn_mfma_f32_32x32x16_bf16(afr[ks], src[ks], acc, 0, 0, 0); \
        float s0 = 0.f, s1 = 0.f; _Pragma("unroll") for (int hd = 0; hd < 8; ++hd) { s0 += w[hd] * relu1(acc[hd]); s1 += w[8 + hd] * relu1(acc[8 + hd]); } \
        unsigned k0_ = fkey2(s0), k1_ = fkey2(s1); const int key = 32 * (jj) + r32; \
        if ((jj) >= jmax) { k0_ = key <= t0 + hh ? k0_ : 0u; k1_ = key <= t0 + 2 + hh ? k1_ : 0u; }     \
        if ((jj) <= jmax) { SCO[hh * 8192 + key] = k0_; SCO[(2 + hh) * 8192 + key] = k1_; } } while (0)
#ifndef IDX_REP_MFMA
#define IDX_REP_MFMA 1
#endif
#ifndef IDX_REP_SEL
#define IDX_REP_SEL 1
#endif
#ifdef IDX_DRY_COMPUTE
#pragma unroll 1
    for (int j = wid; j <= jmax; j += 24) { IDX_COMP(b0, j); asm volatile("" : "+v"(b0[0]), "+v"(b1[0]), "+v"(b2[0])); IDX_COMP(b1, j + 8); IDX_COMP(b2, j + 16); }
#endif
#pragma unroll 1
    for (int rpm = 0; rpm < IDX_REP_MFMA; ++rpm) {
#pragma unroll 1
    for (int j = wid; j <= jmax; j += 24) {
        IDX_LOADB(b2, j + 16); IDX_COMP(b0, j);
        IDX_LOADB(b0, j + 24); IDX_COMP(b1, j + 8);
        IDX_LOADB(b1, j + 32); IDX_COMP(b2, j + 16);
    }
    }
#undef IDX_LOADB
#undef IDX_COMP
    if (nt0 >= 0) idx_prefetch(afr, w, b0, b1, IQ, IK, IWp, nb, nt0, wid, lane);
    LAS unsigned* thr = (LAS unsigned*)(lds + IDX_CTL_OFF);
    if (wid == 0 && lane < 32) ((LAS unsigned*)(lds + IDX_CTL_OFF + 64))[lane] = 0u;
    LDS_WAIT(); __builtin_amdgcn_s_barrier(); asm volatile("" ::: "memory");
    {
        const int q = wid & 3, h = wid >> 2, n = t0 + q + 1;
        volatile LAS unsigned* xme = (volatile LAS unsigned*)(lds + IDX_CTL_OFF + 64) + (q * 2 + h) * 4;
        volatile LAS unsigned* xpa = (volatile LAS unsigned*)(lds + IDX_CTL_OFF + 64) + (q * 2 + (h ^ 1)) * 4;
        unsigned T_ = 1u;
        if (n > 256) {
            LAS unsigned* row = SCO + q * 8192 + lane;
            unsigned r[64];
            const int nil = (jmax >> 1) >= h ? (((jmax >> 1) - h) >> 1) + 1 : 0;
#define IDX_FOR_LIVE(BODY) _Pragma("unroll") for (int g8_ = 0; g8_ < 8; ++g8_) if (8 * g8_ < nil) { _Pragma("unroll") for (int u8_ = 0; u8_ < 8; ++u8_) { const int il = 8 * g8_ + u8_; BODY } }
            IDX_FOR_LIVE( r[il] = (2 * (2 * il + h) + hh <= jmax) ? row[64 * (2 * il + h)] : 0u; )
            unsigned seq = 0u;
#define IDX_XCHG(val, out) do { ++seq; const int pb_ = (seq & 1u) * 2; if (lane == 0) { xme[pb_ + 1] = (val); xme[pb_] = seq; } \
                while (xpa[pb_] != seq) __builtin_amdgcn_s_sleep(0); (out) = xpa[pb_ + 1]; } while (0)
#define IDX_XCHG16(val, out) do { ++seq; const int pb_ = (seq & 1u) * 2; if (lane == 0) xme[pb_] = (seq << 16) | (val); unsigned w_; \
                while (((w_ = xpa[pb_]) >> 16) != (seq & 0xffffu)) __builtin_amdgcn_s_sleep(0); (out) = w_ & 0xffffu; } while (0)
#pragma unroll 1
            for (int rps = 0; rps < IDX_REP_SEL; ++rps) {
            unsigned mx = 0u;
            IDX_FOR_LIVE( mx = max(mx, r[il]); )
#pragma unroll
            for (int o = 1; o < 64; o <<= 1) mx = max(mx, (unsigned)__shfl_xor((int)mx, o));
            { unsigned pm_; IDX_XCHG(mx, pm_); mx = max(mx, pm_); }
            unsigned lo_ = 1u, hi_ = mx + 1u, chi_ = 0u, xgt_ = 1u, xeq_ = 0u, mt_ = 0u; float glo_ = __log2f((float)n) - 8.f, ghi_ = -9.f; int side_ = 0; bool done_ = false;
#pragma unroll 1
            for (int pass = 0; pass < 2 && !done_; ++pass) {
                const unsigned wdt = hi_ - lo_;
                unsigned off;
                if (pass < 2) {
                    const unsigned mkey = hi_ - 1u; const unsigned tgt = pass == 0 ? mkey - (1u << 23) : mkey - (3u << 23);
                    const bool ok = pass == 0 ? (mkey > 0x81000000u) : (mkey > 0x82000000u && tgt > lo_ && tgt < hi_);
                    off = ok ? tgt - lo_ : wdt >> 1;
                } else if ((pass & 3) == 3) off = wdt >> 1;
                else off = (unsigned)(glo_ * __builtin_amdgcn_rcpf(glo_ - ghi_) * (float)wdt);
                off = off < 1u ? 1u : (off > wdt - 1u ? wdt - 1u : off);
                const unsigned cand = (unsigned)__builtin_amdgcn_readfirstlane((int)(lo_ + off));
                unsigned ca_ = 0, cb_ = 0; const unsigned candv = lo_ + off;
#define IDX_CNT4(A, B, C, Dd) asm volatile("v_cmp_ge_u32_e64 s[88:89], %2, %6\n\tv_cmp_ge_u32_e64 s[90:91], %3, %6\n\tv_cmp_ge_u32_e64 s[92:93], %4, %6\n\tv_cmp_ge_u32_e64 s[94:95], %5, %6\n\t" \
                    "v_addc_co_u32_e64 %0, s[88:89], %0, 0, s[88:89]\n\tv_addc_co_u32_e64 %1, s[90:91], %1, 0, s[90:91]\n\tv_addc_co_u32_e64 %0, s[92:93], %0, 0, s[92:93]\n\tv_addc_co_u32_e64 %1, s[94:95], %1, 0, s[94:95]" \
                    : "+v"(ca_), "+v"(cb_) : "v"(A), "v"(B), "v"(C), "v"(Dd), "v"(candv) : "s88", "s89", "s90", "s91", "s92", "s93", "s94", "s95")
#pragma unroll
                for (int g8_ = 0; g8_ < 8; ++g8_) if (8 * g8_ < nil) { IDX_CNT4(r[8 * g8_], r[8 * g8_ + 1], r[8 * g8_ + 2], r[8 * g8_ + 3]); IDX_CNT4(r[8 * g8_ + 4], r[8 * g8_ + 5], r[8 * g8_ + 6], r[8 * g8_ + 7]); }
#undef IDX_CNT4
                int pk = (int)(ca_ + cb_);
                pk += __builtin_amdgcn_update_dpp(0, pk, 0x111, 0xf, 0xf, false);
                pk += __builtin_amdgcn_update_dpp(0, pk, 0x112, 0xf, 0xf, false);
                pk += __builtin_amdgcn_update_dpp(0, pk, 0x114, 0xf, 0xf, false);
                pk += __builtin_amdgcn_update_dpp(0, pk, 0x118, 0xf, 0xf, false);
                pk += __builtin_amdgcn_update_dpp(0, pk, 0x142, 0xa, 0xf, false);
                unsigned tot = (unsigned)__builtin_amdgcn_readlane(pk, 31) + (unsigned)__builtin_amdgcn_readlane(pk, 63);
                { unsigned pt_; IDX_XCHG16(tot, pt_); tot += pt_; }
                const float gc = __log2f(fmaxf((float)tot, 0.5f)) - 8.f;
                if (tot == 256u) { xgt_ = cand; mt_ = 0u; done_ = true; }
                else { if (tot > 256u) { if (side_ == 1) ghi_ *= 0.5f; lo_ = cand; glo_ = gc; side_ = 1; }
                       else { if (side_ == 2) glo_ *= 0.5f; hi_ = cand; ghi_ = gc; chi_ = tot; side_ = 2; }
                       if (hi_ - lo_ == 1u) { xgt_ = hi_; xeq_ = lo_; mt_ = 256u - chi_; done_ = true; } }
            }
            { LAS unsigned* hist = (LAS unsigned*)(lds + IDX_CTL_OFF + 1024) + q * 256;
#pragma unroll 1
              for (int round = 0; round < 6 && !done_; ++round) {
                const unsigned wdt = hi_ - lo_;
                const int sh = wdt <= 256u ? 0 : 24 - (int)__builtin_clz(wdt - 1u);
                hist[128 * h + lane] = 0u; hist[128 * h + 64 + lane] = 0u;
                LDS_WAIT(); { unsigned d_; IDX_XCHG16(0u, d_); (void)d_; }
                const unsigned lov = lo_;
                if (round == 0) {
                    IDX_FOR_LIVE( const unsigned d = r[il] - lov; if (d < wdt) __hip_atomic_fetch_add(hist + (d >> sh), 1u, __ATOMIC_RELAXED, __HIP_MEMORY_SCOPE_WORKGROUP); )
                } else {
#pragma unroll
                    for (int g8_ = 0; g8_ < 8; ++g8_) if (8 * g8_ < nil) {
#pragma unroll
                        for (int u4_ = 0; u4_ < 2; ++u4_) { const int il = 8 * g8_ + 4 * u4_;
                            const unsigned d0 = r[il] - lov, d1 = r[il + 1] - lov, d2 = r[il + 2] - lov, d3 = r[il + 3] - lov;
                            if (min(min(d0, d1), min(d2, d3)) < wdt) {
                                if (d0 < wdt) __hip_atomic_fetch_add(hist + (d0 >> sh), 1u, __ATOMIC_RELAXED, __HIP_MEMORY_SCOPE_WORKGROUP);
                                if (d1 < wdt) __hip_atomic_fetch_add(hist + (d1 >> sh), 1u, __ATOMIC_RELAXED, __HIP_MEMORY_SCOPE_WORKGROUP);
                                if (d2 < wdt) __hip_atomic_fetch_add(hist + (d2 >> sh), 1u, __ATOMIC_RELAXED, __HIP_MEMORY_SCOPE_WORKGROUP);
                                if (d3 < wdt) __hip_atomic_fetch_add(hist + (d3 >> sh), 1u, __ATOMIC_RELAXED, __HIP_MEMORY_SCOPE_WORKGROUP); } } }
                }
                LDS_WAIT(); { unsigned d_; IDX_XCHG16(0u, d_); (void)d_; }
                const u32x4 hb = *(const LAS u32x4*)(hist + 4 * lane);
                const unsigned s4 = (hb.x + hb.y) + (hb.z + hb.w);
                unsigned suf = s4;
#pragma unroll
                for (int o = 1; o < 64; o <<= 1) { const unsigned tv = (unsigned)__shfl_down((int)suf, o); if (lane + o < 64) suf += tv; }
                const unsigned long long okm = __ballot(chi_ + suf >= 256u);
                const int L = 63 - (int)__builtin_clzll(okm);
                const unsigned above = chi_ + (unsigned)__builtin_amdgcn_readlane((int)(suf - s4), L);
                const unsigned h0 = (unsigned)__builtin_amdgcn_readlane((int)hb.x, L), h1 = (unsigned)__builtin_amdgcn_readlane((int)hb.y, L),
                               h2 = (unsigned)__builtin_amdgcn_readlane((int)hb.z, L), h3 = (unsigned)__builtin_amdgcn_readlane((int)hb.w, L);
                unsigned Bsel, cab, cnb;
                if (above + h3 >= 256u) { Bsel = 3u; cab = above; cnb = h3; }
                else if (above + h3 + h2 >= 256u) { Bsel = 2u; cab = above + h3; cnb = h2; }
                else if (above + h3 + h2 + h1 >= 256u) { Bsel = 1u; cab = above + h3 + h2; cnb = h1; }
                else { Bsel = 0u; cab = above + h3 + h2 + h1; cnb = h0; }
                Bsel += 4u * (unsigned)L;
                const unsigned nlo = lo_ + (Bsel << sh); unsigned nhi = nlo + (1u << sh); if (nhi > hi_ || nhi < nlo) nhi = hi_;
                if (cab + cnb == 256u) { xgt_ = nlo; mt_ = 0u; done_ = true; }
                else if (sh == 0) { xgt_ = nlo + 1u; xeq_ = nlo; mt_ = 256u - cab; done_ = true; }
                else { lo_ = nlo; hi_ = nhi; chi_ = cab; }
              } }
#ifdef IDX_XTRA
#pragma unroll 1
            for (int xr = 0; xr < IDX_XTRA; ++xr) { unsigned dsum = 0; const unsigned cv = xgt_ + (unsigned)xr;
                IDX_FOR_LIVE( dsum += r[il] >= cv; )
                int pk = (int)dsum;
                pk += __builtin_amdgcn_update_dpp(0, pk, 0x111, 0xf, 0xf, false); pk += __builtin_amdgcn_update_dpp(0, pk, 0x112, 0xf, 0xf, false); pk += __builtin_amdgcn_update_dpp(0, pk, 0x114, 0xf, 0xf, false);
                pk += __builtin_amdgcn_update_dpp(0, pk, 0x118, 0xf, 0xf, false); pk += __builtin_amdgcn_update_dpp(0, pk, 0x142, 0xa, 0xf, false);
                unsigned tot = (unsigned)__builtin_amdgcn_readlane(pk, 31) + (unsigned)__builtin_amdgcn_readlane(pk, 63);
                { unsigned pt_; IDX_XCHG16(tot, pt_); tot += pt_; } asm volatile("" :: "s"(tot)); }
#endif
            T_ = xgt_;
            if (mt_ != 0u) {
                if (h == 0) { unsigned run = 0u;
#pragma unroll 1
                    for (int i = 0; i <= (jmax >> 1); ++i) { const bool ok_ = 2 * i + hh <= jmax; const unsigned kv = ok_ ? row[64 * i] : 0u; const bool eq = kv == xeq_; const unsigned long long bm = __ballot(eq);
                        const unsigned rank = run + __builtin_amdgcn_mbcnt_hi((unsigned)(bm >> 32), __builtin_amdgcn_mbcnt_lo((unsigned)bm, 0u));
                        if (eq && rank >= mt_) row[64 * i] = 0u;
                        run += (unsigned)__popcll(bm); } }
                T_ = xeq_;
            }
            }
#undef IDX_XCHG
#undef IDX_XCHG16
#undef IDX_FOR_LIVE
        }
        if (lane == 0 && h == 0) thr[q] = T_;
    }
#ifdef PROBE_VALU
    { float a0 = (float)lane, a1 = a0 + 1.f, a2 = a0 + 2.f, a3 = a0 + 3.f, a4 = a0 + 4.f, a5 = a0 + 5.f, a6 = a0 + 6.f, a7 = a0 + 7.f; const float m = 1.0000001f, c = 1e-9f;
#pragma unroll 1
      for (int it = 0; it < 64; ++it) {
#pragma unroll
          for (int u = 0; u < 8; ++u) { a0 = a0 * m + c; a1 = a1 * m + c; a2 = a2 * m + c; a3 = a3 * m + c; a4 = a4 * m + c; a5 = a5 * m + c; a6 = a6 * m + c; a7 = a7 * m + c; } }
      asm volatile("" :: "v"(a0), "v"(a1), "v"(a2), "v"(a3), "v"(a4), "v"(a5), "v"(a6), "v"(a7)); }
#endif
    LDS_WAIT(); __builtin_amdgcn_s_barrier(); asm volatile("" ::: "memory");
    { const unsigned tq0 = thr[hh], tq1 = thr[2 + hh];
#pragma unroll 4
      for (int j = wid; j <= ((t0 | 255) >> 5); j += 8) {
          bool s0 = false, s1 = false;
          if (j <= jmax) { s0 = SCO[hh * 8192 + 32 * j + r32] >= tq0; s1 = SCO[(2 + hh) * 8192 + 32 * j + r32] >= tq1; }
          const unsigned long long b0_ = __ballot(s0), b1_ = __ballot(s1);
          if (lane == 0) { u32x4 o; o.x = (unsigned)b0_; o.y = (unsigned)(b0_ >> 32); o.z = (unsigned)b1_; o.w = (unsigned)(b1_ >> 32); *(u32x4*)(BM + ((size_t)b * 256 + j) * S + t0) = o; }
      } }
    LDS_WAIT(); __builtin_amdgcn_s_barrier();
}
DEV void idx_phase(LAS unsigned char* lds, unsigned char* ws, int vcu, int G, int wid, int lane) {
    constexpr int NUNIT = T / 4;
    const bf16_t* IQ = (const bf16_t*)(ws + WS_IQ); const bf16_t* IK = (const bf16_t*)(ws + WS_IK); const float* IW = (const float*)(ws + WS_IW);
#define IDX_UNIT_OF(k) ((k) * G + (((k) & 1) ? G - 1 - vcu : vcu))
    bf16x8 afr[4], b0[4], b1[4]; float w[16];
    int un = IDX_UNIT_OF(0);
    if (un < NUNIT) { const int b = un / (S / 4); idx_prefetch(afr, w, b0, b1, IQ, IK, IW, b, (un - b * (S / 4)) * 4, wid, lane); }
#pragma unroll 1
    for (int k = 0; un < NUNIT; ++k) {
        const int b = un / (S / 4), t0 = (un - b * (S / 4)) * 4;
        const int nun = IDX_UNIT_OF(k + 1); const int nb = nun / (S / 4), nt0 = nun < NUNIT ? (nun - nb * (S / 4)) * 4 : -1;
        idx_unit(lds, IQ, IK, IW, (unsigned*)(ws + WS_BM), b, t0, nb, nt0, wid, lane, afr, w, b0, b1);
        un = nun;
    }
#undef IDX_UNIT_OF
}

DEV void kn_phase(const WaveId& W, const bf16_t* Kk, float* KN) {
    for (int item = W.gw; item < NB * 8 * (S / 64); item += W.ngw) {
        const int b = item / (8 * (S / 64)), h = (item / (S / 64)) & 7, tile = item % (S / 64);
        const bf16_t* kp = Kk + ((size_t)b * S + tile * 64 + W.lane) * 512 + h * 64;
        float ss = 0.f;
#pragma unroll
        for (int c = 0; c < 8; ++c) { const u32x4 v = *(const u32x4*)(kp + 8 * c);
#pragma unroll
            for (int e = 0; e < 4; ++e) { const float lo = __uint_as_float(v[e] << 16), hi = __uint_as_float(v[e] & 0xffff0000u); ss += lo * lo + hi * hi; } }
        const float m = wave_max(ss);
        if (W.lane == 0) KN[item] = sqrtf(m) * 1.01f;
    }
}

constexpr int DSA_STAGE = 8192 + 64 * VPITCH;
DEV void dsa_unit(LAS unsigned char* lds, const bf16_t* Q, const bf16_t* Kk, const bf16_t* V, const unsigned* BM, const float* KN, bf16_t* O, int b, int h, int qblk, int tid, int wid, int lane) {
    const int r32 = lane & 31, hi = lane >> 5, q0 = 256 * qblk, t0 = q0 + 32 * wid, t = t0 + r32; const size_t rowb = (size_t)b * S;
    bf16x8 qr[4]; { const bf16_t* qp = Q + (rowb + t) * 512 + h * 64 + 8 * hi;
#pragma unroll
        for (int d0 = 0; d0 < 4; ++d0) qr[d0] = *(const bf16x8*)(qp + 16 * d0); }
    f32x16 o0, o1, negm;
#pragma unroll
    for (int r = 0; r < 16; ++r) { o0[r] = 0.f; o1[r] = 0.f; negm[r] = 0.f; }
    float mref = 0.f, lsum = 0.f; bool seen = false;
    float qn; { float qs = 0.f;
#pragma unroll
        for (int d0 = 0; d0 < 4; ++d0)
#pragma unroll
            for (int e = 0; e < 8; ++e) { const float x = __uint_as_float(((unsigned)(unsigned short)qr[d0][e]) << 16); qs += x * x; }
        const auto rr = __builtin_amdgcn_permlane32_swap(__float_as_uint(qs), __float_as_uint(qs), false, false); qn = sqrtf(__uint_as_float(rr[0]) + __uint_as_float(rr[1])) * 1.01f; }
    constexpr float FASTB = 60.f;
    int zlane = 0; asm volatile("" : "+v"(zlane));
    const float* knp = KN + (b * 8 + h) * (S / 64) + zlane;
    float knv = knp[0];
    constexpr float THR = 8.f;
    const int ntile = (q0 + 256) / 64, wlast = (t0 + 31) >> 6;
    const int srow = tid >> 3, sch = tid & 7;
    const bf16_t* kg = Kk + (rowb + srow) * 512 + h * 64 + sch * 8; const bf16_t* vg = V + (rowb + srow) * 512 + h * 64 + sch * 8;
    const int kdst = srow * 128 + ((sch ^ (srow & 7)) * 16), vdst = srow * VPITCH + sch * 16;
    u32x4 kr0 = *(const u32x4*)kg, vr0 = *(const u32x4*)vg;
    *(LAS u32x4*)(lds + kdst) = kr0; *(LAS u32x4*)(lds + 8192 + vdst) = vr0;
    u32x4 kr1 = *(const u32x4*)(kg + (size_t)64 * 512), vr1 = *(const u32x4*)(vg + (size_t)64 * 512);
    const unsigned* bmp = BM + (size_t)b * 256 * S + t;
    unsigned mw0 = bmp[0], mw1 = bmp[(size_t)S];
    const int koff = r32 * 128;
    __syncthreads();
#define DSA_TILE(c, BUF, NBUF, KL, VL, KW, VW) do { \
        const LAS unsigned char* kt = lds + (BUF) * DSA_STAGE; const LAS unsigned char* vt = kt + 8192; \
        if ((c) + 2 < ntile) { KL = *(const u32x4*)(kg + (size_t)((c) + 2) * 64 * 512); VL = *(const u32x4*)(vg + (size_t)((c) + 2) * 64 * 512); } \
        unsigned nw0 = 0u, nw1 = 0u; float nkn = 0.f; \
        if ((c) + 1 <= wlast) { nw0 = bmp[(size_t)(2 * (c) + 2) * S]; nw1 = bmp[(size_t)(2 * (c) + 3) * S]; nkn = knp[(c) + 1]; } \
        if ((c) <= wlast) { \
            bf16x8 kf[8]; \
            _Pragma("unroll") for (int d0 = 0; d0 < 4; ++d0) { const int xo = ((2 * d0 + hi) ^ (r32 & 7)) * 16; \
                kf[2 * d0] = *(const LAS bf16x8*)(kt + koff + xo); kf[2 * d0 + 1] = *(const LAS bf16x8*)(kt + koff + 4096 + xo); } \
            asm volatile("" : "+v"(kf[0]), "+v"(kf[1]), "+v"(kf[2]), "+v"(kf[3]), "+v"(kf[4]), "+v"(kf[5]), "+v"(kf[6]), "+v"(kf[7]));     \
            f32x16 p0 = negm, p1 = negm; \
            _Pragma("unroll") for (int d0 = 0; d0 < 4; ++d0) { p0 = __builtin_amdgcn_mfma_f32_32x32x16_bf16(kf[2 * d0], qr[d0], p0, 0, 0, 0); p1 = __builtin_amdgcn_mfma_f32_32x32x16_bf16(kf[2 * d0 + 1], qr[d0], p1, 0, 0, 0); } \
            const unsigned m0 = mw0 >> (4 * hi), m1 = mw1 >> (4 * hi); \
            _Pragma("unroll") for (int r = 0; r < 16; ++r) { const int bit = (r & 3) + 8 * (r >> 2); \
                const unsigned e0 = (unsigned)__builtin_amdgcn_sbfe((int)m0, bit, 1), e1 = (unsigned)__builtin_amdgcn_sbfe((int)m1, bit, 1); \
                p0[r] = __uint_as_float((__float_as_uint(p0[r]) & e0) | (0xff800000u & ~e0)); p1[r] = __uint_as_float((__float_as_uint(p1[r]) & e1) | (0xff800000u & ~e1)); } \
            if (__any(!(qn * knv + fabsf(mref) <= FASTB))) {     \
                float rm = -INFINITY; \
                _Pragma("unroll") for (int r = 0; r < 16; r += 2) rm = fmaxf(rm, fmaxf(fmaxf(p0[r], p0[r + 1]), fmaxf(p1[r], p1[r + 1]))); \
                { const auto rr = __builtin_amdgcn_permlane32_swap(__float_as_uint(rm), __float_as_uint(rm), false, false); rm = fmaxf(__uint_as_float(rr[0]), __uint_as_float(rr[1])); } \
                const bool shift = rm > THR || (rm < -THR && rm > -INFINITY && !seen);     \
                if (__any(shift)) { \
                    const float dl = shift ? rm : 0.f, f = dl > 0.f ? __builtin_amdgcn_exp2f(-dl) : 1.f; \
                    mref += dl; lsum *= f; \
                    _Pragma("unroll") for (int r = 0; r < 16; ++r) { p0[r] -= dl; p1[r] -= dl; o0[r] *= f; o1[r] *= f; negm[r] = -mref; } \
                } \
            } \
            seen = seen || (mw0 | mw1) != 0u;     \
            float ps = 0.f; \
            _Pragma("unroll") for (int r = 0; r < 16; ++r) { p0[r] = __builtin_amdgcn_exp2f(p0[r]); p1[r] = __builtin_amdgcn_exp2f(p1[r]); ps += p0[r] + p1[r]; } \
            lsum += ps; \
            bf16x8 pk[4]; \
            pk[0] = pk8(p0[0], p0[1], p0[2], p0[3], p0[4], p0[5], p0[6], p0[7]); pk[1] = pk8(p0[8], p0[9], p0[10], p0[11], p0[12], p0[13], p0[14], p0[15]); \
            pk[2] = pk8(p1[0], p1[1], p1[2], p1[3], p1[4], p1[5], p1[6], p1[7]); pk[3] = pk8(p1[8], p1[9], p1[10], p1[11], p1[12], p1[13], p1[14], p1[15]); \
            pv_tile(o0, o1, vt, lane, pk); \
        } \
        mw0 = nw0; mw1 = nw1; knv = nkn; \
        if ((c) + 1 < ntile) { LAS unsigned char* nb = lds + (NBUF) * DSA_STAGE; *(LAS u32x4*)(nb + kdst) = KW; *(LAS u32x4*)(nb + 8192 + vdst) = VW; } \
        asm volatile("s_waitcnt lgkmcnt(0)" ::: "memory"); __builtin_amdgcn_s_barrier(); asm volatile("" ::: "memory"); } while (0)
#pragma unroll 1
    for (int c = 0; c < ntile; c += 2) { DSA_TILE(c, 0, 1, kr0, vr0, kr1, vr1); DSA_TILE(c + 1, 1, 0, kr1, vr1, kr0, vr0); }
#undef DSA_TILE
    { const auto rr = __builtin_amdgcn_permlane32_swap(__float_as_uint(lsum), __float_as_uint(lsum), false, false); lsum = __uint_as_float(rr[0]) + __uint_as_float(rr[1]); }
    store_ot(O + (rowb + t) * 512 + h * 64, o0, o1, hi, 1.f / lsum);
}
DEV void dsa_phase(LAS unsigned char* lds, unsigned char* ws, int vcu, int G, int tid, int wid, int lane, bf16_t* Oout) {
    constexpr int NPAIR = NB * 8 * 16;
    for (int pr = vcu; pr < NPAIR; pr += G) {
        const int bh = pr >> 4, s = pr & 15, b = bh >> 3, h = bh & 7;
#pragma unroll 1
        for (int k = 0; k < 2; ++k) {
            const int qblk = k == 0 ? s : 31 - s;
            dsa_unit(lds, (const bf16_t*)(ws + WS_QC), (const bf16_t*)(ws + WS_KC), (const bf16_t*)(ws + WS_VC), (const unsigned*)(ws + WS_BM), (const float*)(ws + WS_KN), Oout, b, h, qblk, tid, wid, lane);
        }
    }
}
#include <hip/hip_bf16.h>
namespace attn_body {
using bf16=__hip_bfloat16;
using bf16x8=__attribute__((ext_vector_type(8)))short;
using s16x4=__attribute__((ext_vector_type(4)))short;
using f32x16=__attribute__((ext_vector_type(16)))float;
using u32x4=__attribute__((ext_vector_type(4)))unsigned;
constexpr int BATCH=2,NHEAD=8,SEQ=8192,D=64,DM=NHEAD*D;
constexpr int NW=8,QBLK=32,QB=QBLK*NW,KVBLK=64,NQB=SEQ/QB;
constexpr int ATTN_PITCH=DM, ATTN_UNIT_ROWS=QB;
__device__ __forceinline__ int crow(int r,int hi){return (r&3)+8*(r>>2)+4*hi;}
#define SBAR() __builtin_amdgcn_sched_barrier(0)
__device__ __forceinline__ void cmask(f32x16&p0,f32x16&p1,int jb,int qrel,int hi){
  const float NEG=-INFINITY; int kb=64*jb+4*hi;
  #pragma unroll
  for(int r=0;r<16;++r){int kv=kb+(r&3)+8*(r>>2); if(kv>qrel)p0[r]=NEG; if(kv+32>qrel)p1[r]=NEG;}
}

constexpr int NSLOT=3, SLOTB=8192;
constexpr int LDS_K=0, LDS_V=NSLOT*SLOTB, LDS_WS=2*NSLOT*SLOTB, LDS_OST=LDS_WS+NW*64*4, LDS_BYTES=LDS_OST+NW*4096;
constexpr float C2=0.125f*1.4426950408889634f;
__device__ __forceinline__ void glds16(const void*gsrc,unsigned lds_dst){unsigned keep;
  asm volatile("s_mov_b32 %0, m0\n\ts_mov_b32 m0, %2\n\ts_nop 0\n\tglobal_load_lds_dwordx4 %1, off\n\ts_mov_b32 m0, %0":"=&s"(keep):"v"(gsrc),"s"(lds_dst):"memory");}
__device__ __forceinline__ float max3f(float a,float b,float c){float r;asm("v_max3_f32 %0, %1, %2, %3":"=v"(r):"v"(a),"v"(b),"v"(c));return r;}
__device__ __forceinline__ float max2f(float a,float b){float r;asm("v_max_f32_e32 %0, %1, %2":"=v"(r):"v"(a),"v"(b));return r;}
__device__ __forceinline__ float fadd_s(float a,float b){float r;asm("v_add_f32_e32 %0, %1, %2":"=v"(r):"v"(a),"v"(b));return r;}
__device__ __forceinline__ float fsub_s(float a,float b){float r;asm("v_sub_f32_e32 %0, %1, %2":"=v"(r):"v"(a),"v"(b));return r;}
typedef float f32x2_t __attribute__((ext_vector_type(2))); typedef __bf16 bf16x2_t __attribute__((ext_vector_type(2)));
__device__ __forceinline__ unsigned cvtpk_s(float lo,float hi){f32x2_t v={lo,hi};bf16x2_t b=__builtin_convertvector(v,bf16x2_t);return __builtin_bit_cast(unsigned,b);}
#define WAIT_BAR(N) asm volatile("s_waitcnt vmcnt(" #N ") lgkmcnt(0)\n\ts_barrier":::"memory")

__device__ __forceinline__ void qkt(f32x16&p0,f32x16&p1,const char*Kslot,const bf16x8*qr,const f32x16&negm,int r32,int hi){
  const char*kb=Kslot+hi*1024+r32*16;
  #pragma unroll
  for(int d0=0;d0<4;++d0){
    const bf16x8 b0=*reinterpret_cast<const bf16x8*>(kb+d0*2048);
    const bf16x8 b1=*reinterpret_cast<const bf16x8*>(kb+d0*2048+512);
    if(d0==0){p0=__builtin_amdgcn_mfma_f32_32x32x16_bf16(b0,qr[0],negm,0,0,0);p1=__builtin_amdgcn_mfma_f32_32x32x16_bf16(b1,qr[0],negm,0,0,0);}
    else{p0=__builtin_amdgcn_mfma_f32_32x32x16_bf16(b0,qr[d0],p0,0,0,0);p1=__builtin_amdgcn_mfma_f32_32x32x16_bf16(b1,qr[d0],p1,0,0,0);}}
}
typedef __attribute__((address_space(3))) const char* lds_cptr;
typedef short v4i16_t __attribute__((ext_vector_type(4)));
__device__ __forceinline__ void kload8(bf16x8*kf,lds_cptr kp){
  kf[0]=*(const __attribute__((address_space(3))) bf16x8*)(kp);      kf[1]=*(const __attribute__((address_space(3))) bf16x8*)(kp+512);
  kf[2]=*(const __attribute__((address_space(3))) bf16x8*)(kp+2048); kf[3]=*(const __attribute__((address_space(3))) bf16x8*)(kp+2560);
  kf[4]=*(const __attribute__((address_space(3))) bf16x8*)(kp+4096); kf[5]=*(const __attribute__((address_space(3))) bf16x8*)(kp+4608);
  kf[6]=*(const __attribute__((address_space(3))) bf16x8*)(kp+6144); kf[7]=*(const __attribute__((address_space(3))) bf16x8*)(kp+6656);
}
__device__ __forceinline__ void kload2(bf16x8*kf,lds_cptr kp,int j){ kf[2*j]=*(const __attribute__((address_space(3))) bf16x8*)(kp+j*2048); kf[2*j+1]=*(const __attribute__((address_space(3))) bf16x8*)(kp+j*2048+512); }
__device__ __forceinline__ s16x4 vtr(lds_cptr p){ return __builtin_bit_cast(s16x4,__builtin_amdgcn_ds_read_tr16_b64_v4i16((__attribute__((address_space(3))) v4i16_t*)p)); }
__device__ __forceinline__ float rowmax(const f32x16&p0,const f32x16&p1){
  float a=max3f(p0[0],p0[1],p1[0]),b=max3f(p0[2],p0[3],p1[1]);a=max3f(a,p1[2],p1[3]);
  #pragma unroll
  for(int r=4;r<16;r+=4){a=max3f(a,p0[r],p0[r+1]);b=max3f(b,p0[r+2],p0[r+3]);a=max3f(a,p1[r],p1[r+1]);b=max3f(b,p1[r+2],p1[r+3]);}
  const float m=max2f(a,b);
  auto rr=__builtin_amdgcn_permlane32_swap(__float_as_uint(m),__float_as_uint(m),false,false);
  return max2f(__uint_as_float(rr[0]),__uint_as_float(rr[1]));
}
__device__ __forceinline__ void pv(f32x16*o,int vb,bf16x8 pa0,bf16x8 pa1,bf16x8 pa2,bf16x8 pa3){
  #pragma unroll
  for(int d0=0;d0<2;++d0){s16x4 lo[4],hi[4];
    #pragma unroll
    for(int ks=0;ks<4;++ks){
      asm volatile("ds_read_b64_tr_b16 %0,%1 offset:%c2":"=&v"(lo[ks]):"v"(vb),"i"(d0*4096+ks*1024):"memory");
      asm volatile("ds_read_b64_tr_b16 %0,%1 offset:%c2":"=&v"(hi[ks]):"v"(vb),"i"(d0*4096+ks*1024+512):"memory");}
    asm volatile("s_waitcnt lgkmcnt(0)":::"memory");SBAR();
    #define PK(k) (bf16x8){lo[k][0],lo[k][1],lo[k][2],lo[k][3],hi[k][0],hi[k][1],hi[k][2],hi[k][3]}
    o[d0]=__builtin_amdgcn_mfma_f32_32x32x16_bf16(pa0,PK(0),o[d0],0,0,0);
    o[d0]=__builtin_amdgcn_mfma_f32_32x32x16_bf16(pa1,PK(1),o[d0],0,0,0);
    o[d0]=__builtin_amdgcn_mfma_f32_32x32x16_bf16(pa2,PK(2),o[d0],0,0,0);
    o[d0]=__builtin_amdgcn_mfma_f32_32x32x16_bf16(pa3,PK(3),o[d0],0,0,0);
    #undef PK
  }
}

#ifndef ATTN_STORE16
#define ATTN_STORE16(p,v) (*(u32x4*)(p)=(v))
#endif
template<int THRL> __device__ __forceinline__ void attn_unit(int b,int h,int qb,const bf16*Q,const bf16*__restrict__ K,const bf16*__restrict__ V,bf16*O,char*shm,const unsigned*__restrict__ BMb,const float*KNbh,const int tid){
  const int lane=tid&63,r32=lane&31,hi=lane>>5; const int wid=__builtin_amdgcn_readfirstlane(tid>>6);
  const long rowbase=(long)b*SEQ; const int q0=qb*QB;
  const bf16*Qw=Q+(rowbase+q0+wid*QBLK)*DM+h*D;
  const bf16*Kh=K+rowbase*DM+h*D,*Vh=V+rowbase*DM+h*D;
  const unsigned lds0=(unsigned)(uintptr_t)shm;
  float*wsf=(float*)(shm+LDS_WS)+wid*64;
  const bf16*ksrc=Kh+(long)lane*DM+wid*8;
  const bf16*vsrc=Vh+(long)(16*(wid&3)+(lane>>2))*DM+(wid>>2)*32+(lane&3)*8;
  const unsigned kdst=lds0+LDS_K+wid*1024, vdst=lds0+LDS_V+wid*1024;
  #define DMA_K(t,slot) glds16(ksrc+(long)(t)*KVBLK*DM,(unsigned)__builtin_amdgcn_readfirstlane(kdst+(slot)))
  #define DMA_V(t,slot) glds16(vsrc+(long)(t)*KVBLK*DM,(unsigned)__builtin_amdgcn_readfirstlane(vdst+(slot)))
  const int vb0=(int)(lds0+LDS_V)+((lane>>4)&1)*32+(lane&3)*8+(4*hi+((lane&15)>>2))*64;
  const char*Kbase=shm+LDS_K; bf16x8 kf[8];
  const lds_cptr shm3=(lds_cptr)shm; const lds_cptr kp0=shm3+LDS_K+hi*1024+r32*16; const lds_cptr vp0=shm3+LDS_V+((lane>>4)&1)*32+(lane&3)*8+(4*hi+((lane&15)>>2))*64;
  const int NT=(q0+QB)/KVBLK;
  DMA_K(0,0);DMA_V(0,0);DMA_K(1,SLOTB);
  bf16x8 qr[4];
  #pragma unroll
  for(int d0=0;d0<4;++d0)qr[d0]=*reinterpret_cast<const bf16x8*>(&Qw[(long)r32*DM+d0*16+hi*8]);
  const unsigned*bmp=BMb+(q0+wid*QBLK+r32);
  unsigned mwE0=bmp[0],mwE1=bmp[(size_t)SEQ],mwO0=0u,mwO1=0u;
  bool seen=false;
  float qn; { float qs=0.f;
    _Pragma("unroll") for(int d0=0;d0<4;++d0) _Pragma("unroll") for(int e=0;e<8;++e){ const float x=__uint_as_float(((unsigned)(unsigned short)qr[d0][e])<<16); qs+=x*x; }
    auto rr=__builtin_amdgcn_permlane32_swap(__float_as_uint(qs),__float_as_uint(qs),false,false); qn=__builtin_sqrtf(__uint_as_float(rr[0])+__uint_as_float(rr[1]))*1.01f; }
  constexpr float FASTB=60.f;
  int zlane=0; asm volatile("":"+v"(zlane));
  const float*knp=KNbh+zlane;
  float knE=knp[0],knO=0.f;
  bool anysel_=false;
  #define SLOWT(PS) (__any(!(qn*kn##PS<=FASTB)||mhat!=0.f))
  float mhat=0.f,l_reg=0.f;f32x16 o[2];o[0]=f32x16{};o[1]=f32x16{};const f32x16 zero16=f32x16{};
  const int qrel=wid*QBLK+r32;
  #define CMASK(P0,P1,SLOW,PS) do{ const unsigned m0_=mw##PS##0>>(4*hi), m1_=mw##PS##1>>(4*hi); anysel_=(mw##PS##0|mw##PS##1)!=0u; \
    if(SLOW){ _Pragma("unroll") for(int r=0;r<16;++r){ P0[r]-=mhat; P1[r]-=mhat; } } \
    _Pragma("unroll") for(int r=0;r<16;++r){ const int bit_=(r&3)+8*(r>>2); \
      const unsigned e0_=(unsigned)__builtin_amdgcn_sbfe((int)m0_,bit_,1), e1_=(unsigned)__builtin_amdgcn_sbfe((int)m1_,bit_,1); \
      P0[r]=__uint_as_float((__float_as_uint(P0[r])&e0_)|(0xff800000u&~e0_)); P1[r]=__uint_as_float((__float_as_uint(P1[r])&e1_)|(0xff800000u&~e1_)); } \
    }while(0)
  bool resc=false;
  #define START(P0,P1,SLOW) do{ resc=false; seen=anysel_; \
    if(SLOW){ const float rm=rowmax(P0,P1); const float dl=(rm==-INFINITY)?0.f:rm; mhat=fadd_s(mhat,dl); \
      _Pragma("unroll") for(int r=0;r<16;++r){P0[r]=fsub_s(P0[r],dl);P1[r]=fsub_s(P1[r],dl);} \
      } \
    _Pragma("unroll") for(int r=0;r<16;++r)P0[r]=__builtin_amdgcn_exp2f(P0[r]); }while(0)
  #define RESC() do{ if(resc){ asm volatile("s_waitcnt lgkmcnt(0)":::"memory"); \
      _Pragma("unroll") for(int d_=0;d_<2;++d_) _Pragma("unroll") for(int r=0;r<16;++r)o[d_][r]*=wsf[crow(r,hi)]; } }while(0)
  f32x16 pA0,pA1,pB0,pB1;
  int sl_prev=0,sl_cur=0,sl_next=SLOTB;
  #define ROT() do{sl_prev=sl_cur;sl_cur=sl_next;sl_next=(sl_next==(NSLOT-1)*SLOTB)?0:sl_next+SLOTB;}while(0)
  DMA_K(2,2*SLOTB);
  WAIT_BAR(3);
  { mwO0=bmp[(size_t)2*SEQ]; mwO1=bmp[(size_t)3*SEQ]; knO=knp[1];
  const bool slow0_=SLOWT(E);
  qkt(pA0,pA1,Kbase,qr,zero16,r32,hi);asm volatile("s_nop 15\n\ts_nop 7":"+v"(pA0),"+v"(pA1));CMASK(pA0,pA1,slow0_,E);
  START(pA0,pA1,slow0_); }
  _Pragma("unroll") for(int r=0;r<16;++r)pA1[r]=__builtin_amdgcn_exp2f(pA1[r]);
  WAIT_BAR(0);
  DMA_K(3,0);DMA_V(1,SLOTB);
  ROT();
  kload8(kf,kp0+sl_cur);
  WAIT_BAR(2);
  s16x4 vlo[8],vhi[8]; u32x4 pw0,pw1,pw2,pw3;
  #define PKW(P,B) cvtpk_s(P[B],P[B+1])
  #define PAF(k) __builtin_bit_cast(bf16x8,pw##k)
  #define VFR(i) (bf16x8){vlo[i][0],vlo[i][1],vlo[i][2],vlo[i][3],vhi[i][0],vhi[i][1],vhi[i][2],vhi[i][3]}
  #define PIN(x) asm volatile("":"+v"(x))
  #define MX3(a,b,c) __builtin_fmaxf(__builtin_fmaxf((a),(b)),(c))
  #define GAPA(MF,A0,A1,A2,A3,W0,W1,PW) do{ MF; sacc+=A0; sacc+=A1; sacc+=A2; sacc+=A3; PIN(sacc); W0; W1; PIN(PW); SBAR(); }while(0)
  #define EX(v) __builtin_amdgcn_exp2f(v)
  #define GAPB(MF,X,B) do{ MF; X[B]=EX(X[B]); X[B+1]=EX(X[B+1]); X[B+2]=EX(X[B+2]); X[B+3]=EX(X[B+3]); PIN(X); SBAR(); }while(0)
  #define VRD(i) do{ vlo[i]=vtr(vp_+(((i)>>2)*4096+((i)&3)*1024)); vhi[i]=vtr(vp_+(((i)>>2)*4096+((i)&3)*1024+512)); }while(0)
  #define KRD(G,j) do{ if(G){ kload2(kf,kp0+sl_next,j); SBAR(); } }while(0)
  #define STEP(C0,C1,P0,P1,t,GK,GV,GL,PS,NS) do{ SBAR(); \
    if((t)+1<NT){ mw##NS##0=bmp[(size_t)(2*(t)+2)*SEQ]; mw##NS##1=bmp[(size_t)(2*(t)+3)*SEQ]; kn##NS=knp[(t)+1]; }     \
    const lds_cptr vp_=vp0+sl_prev; \
    VRD(0); SBAR(); float sacc=(P0[0]+P0[1]); \
    GAPA(C0=__builtin_amdgcn_mfma_f32_32x32x16_bf16(kf[0],qr[0],zero16,0,0,0), P0[2],P0[3],P0[4],P0[5],     pw0[0]=PKW(P0,0), pw0[1]=PKW(P0,2), pw0); \
    VRD(4); SBAR(); GAPA(C1=__builtin_amdgcn_mfma_f32_32x32x16_bf16(kf[1],qr[0],zero16,0,0,0), P0[6],P0[7],P0[8],P0[9],     pw0[2]=PKW(P0,4), pw0[3]=PKW(P0,6), pw0); \
    VRD(1); SBAR(); GAPA(C0=__builtin_amdgcn_mfma_f32_32x32x16_bf16(kf[2],qr[1],C0,0,0,0),   P0[10],P0[11],P0[12],P0[13], pw1[0]=PKW(P0,8), pw1[1]=PKW(P0,10), pw1); \
    VRD(5); SBAR(); GAPA(C1=__builtin_amdgcn_mfma_f32_32x32x16_bf16(kf[3],qr[1],C1,0,0,0),   P0[14],P0[15],P1[0],P1[1],   pw1[2]=PKW(P0,12),pw1[3]=PKW(P0,14), pw1); \
    VRD(2); SBAR(); GAPA(C0=__builtin_amdgcn_mfma_f32_32x32x16_bf16(kf[4],qr[2],C0,0,0,0),   P1[2],P1[3],P1[4],P1[5],     pw2[0]=PKW(P1,0), pw2[1]=PKW(P1,2), pw2); \
    VRD(6); SBAR(); GAPA(C1=__builtin_amdgcn_mfma_f32_32x32x16_bf16(kf[5],qr[2],C1,0,0,0),   P1[6],P1[7],P1[8],P1[9],     pw2[2]=PKW(P1,4), pw2[3]=PKW(P1,6), pw2); \
    VRD(3); SBAR(); GAPA(C0=__builtin_amdgcn_mfma_f32_32x32x16_bf16(kf[6],qr[3],C0,0,0,0),   P1[10],P1[11],P1[12],P1[13], pw3[0]=PKW(P1,8), pw3[1]=PKW(P1,10), pw3); \
    VRD(7); SBAR(); GAPA(C1=__builtin_amdgcn_mfma_f32_32x32x16_bf16(kf[7],qr[3],C1,0,0,0),   P1[14],P1[15],0.f,0.f,       pw3[2]=PKW(P1,12),pw3[3]=PKW(P1,14), pw3); \
    l_reg+=sacc; \
    if(GK){DMA_K((t)+3,sl_cur);} if(GV){DMA_V((t)+1,sl_next);} \
    const bool slow_=SLOWT(PS); CMASK(C0,C1,slow_,PS); resc=false; \
    if(__builtin_expect(slow_,0)){ float a=MX3(C0[0],C0[1],C1[0]),b=MX3(C0[2],C0[3],C1[1]); a=MX3(a,C1[2],C1[3]); \
      _Pragma("unroll") for(int r=4;r<16;r+=4){a=MX3(a,C0[r],C0[r+1]);b=MX3(b,C0[r+2],C0[r+3]);a=MX3(a,C1[r],C1[r+1]);b=MX3(b,C1[r+2],C1[r+3]);} \
      float rm=__builtin_fmaxf(a,b); { auto rr=__builtin_amdgcn_permlane32_swap(__float_as_uint(rm),__float_as_uint(rm),false,false); rm=__builtin_fmaxf(__uint_as_float(rr[0]),__uint_as_float(rr[1])); } \
      const bool fresh_=!seen&&rm>-INFINITY;     \
      if(__builtin_expect(__any(rm>(float)THRL||(fresh_&&rm<-(float)THRL)),0)){ const float dl=fresh_?rm:__builtin_fmaxf(rm,0.f); mhat+=dl; \
        _Pragma("unroll") for(int r=0;r<16;++r){C0[r]-=dl;C1[r]-=dl;} \
        const float f=dl>0.f?__builtin_amdgcn_exp2f(-dl):1.f; l_reg*=f; if(hi==0)wsf[r32]=f; resc=true; } } \
    seen=seen||anysel_; \
    SBAR(); \
    GAPB(o[0]=__builtin_amdgcn_mfma_f32_32x32x16_bf16(PAF(0),VFR(0),o[0],0,0,0), C0,0); \
    GAPB(o[1]=__builtin_amdgcn_mfma_f32_32x32x16_bf16(PAF(0),VFR(4),o[1],0,0,0), C0,4); \
    KRD(GL,0); GAPB(o[0]=__builtin_amdgcn_mfma_f32_32x32x16_bf16(PAF(1),VFR(1),o[0],0,0,0), C0,8); \
    KRD(GL,1); GAPB(o[1]=__builtin_amdgcn_mfma_f32_32x32x16_bf16(PAF(1),VFR(5),o[1],0,0,0), C0,12); \
    KRD(GL,2); GAPB(o[0]=__builtin_amdgcn_mfma_f32_32x32x16_bf16(PAF(2),VFR(2),o[0],0,0,0), C1,0); \
    KRD(GL,3); GAPB(o[1]=__builtin_amdgcn_mfma_f32_32x32x16_bf16(PAF(2),VFR(6),o[1],0,0,0), C1,4); \
    GAPB(o[0]=__builtin_amdgcn_mfma_f32_32x32x16_bf16(PAF(3),VFR(3),o[0],0,0,0), C1,8); \
    GAPB(o[1]=__builtin_amdgcn_mfma_f32_32x32x16_bf16(PAF(3),VFR(7),o[1],0,0,0), C1,12); \
    }while(0)
  int t=1;
  for(;t+5<NT;t+=2){
    STEP(pB0,pB1,pA0,pA1,t,true,true,true,O,E);     WAIT_BAR(2); RESC(); ROT();
    STEP(pA0,pA1,pB0,pB1,t+1,true,true,true,E,O);   WAIT_BAR(2); RESC(); ROT();
  }
  #define ENDW(tt) do{ if((tt)+3<NT){WAIT_BAR(2);} else if((tt)+2<NT){WAIT_BAR(1);} else {WAIT_BAR(0);} }while(0)
  for(;t+1<NT;t+=2){
    STEP(pB0,pB1,pA0,pA1,t,(t+3<NT),(t+1<NT),(t+1<NT),O,E);       ENDW(t);   RESC(); ROT();
    STEP(pA0,pA1,pB0,pB1,t+1,(t+4<NT),(t+2<NT),(t+2<NT),E,O);     ENDW(t+1); RESC(); ROT();
  }
  STEP(pB0,pB1,pA0,pA1,NT-1,false,false,false,O,E); RESC();
  { float sacc=pB0[0]+pB0[1]; _Pragma("unroll") for(int r=2;r<16;++r)sacc+=pB0[r]; _Pragma("unroll") for(int r=0;r<16;++r)sacc+=pB1[r]; l_reg+=sacc;
    pw0=(u32x4){PKW(pB0,0),PKW(pB0,2),PKW(pB0,4),PKW(pB0,6)};pw1=(u32x4){PKW(pB0,8),PKW(pB0,10),PKW(pB0,12),PKW(pB0,14)};pw2=(u32x4){PKW(pB1,0),PKW(pB1,2),PKW(pB1,4),PKW(pB1,6)};pw3=(u32x4){PKW(pB1,8),PKW(pB1,10),PKW(pB1,12),PKW(pB1,14)};
    SBAR(); pv(o,vb0+sl_cur,PAF(0),PAF(1),PAF(2),PAF(3)); }
  #undef PKW
  #undef PAF
  #undef VFR
  #undef PIN
  #undef MX3
  #undef GAPA
  #undef GAPB
  #undef EX
  #undef VRD
  #undef KRD
  #undef STEP
  #undef ENDW
  {auto rr=__builtin_amdgcn_permlane32_swap(__float_as_uint(l_reg),__float_as_uint(l_reg),false,false);l_reg=__uint_as_float(rr[0])+__uint_as_float(rr[1]);}
  if(hi==0)wsf[32+r32]=l_reg;asm volatile("s_waitcnt lgkmcnt(0)":::"memory");
  float rli[16];
  #pragma unroll
  for(int r=0;r<16;++r)rli[r]=__builtin_amdgcn_rcpf(wsf[32+crow(r,hi)]);
  bf16*Ow=O+(rowbase+q0+wid*QBLK)*DM+h*D;
  { bf16*stg=(bf16*)(shm+LDS_OST)+wid*2048;
    #pragma unroll
    for(int r=0;r<16;++r){const int orow=crow(r,hi);
      #pragma unroll
      for(int d0=0;d0<2;++d0)stg[orow*64+d0*32+r32]=__float2bfloat16(o[d0][r]*rli[r]);}
    asm volatile("s_waitcnt lgkmcnt(0)":::"memory");
    #pragma unroll
    for(int i=0;i<4;++i){const int row=i*8+(lane>>3),ch=lane&7; const u32x4 v=*(const u32x4*)(stg+row*64+ch*8); ATTN_STORE16(Ow+(long)row*DM+ch*8,v);} }
  asm volatile("s_waitcnt lgkmcnt(0)\n\ts_barrier":::"memory");
  #undef DMA_K
  #undef DMA_V
  #undef CMASK
  #undef SLOWT
  #undef START
  #undef RESC
  #undef ROT
}
constexpr int ATTN_LDS_BYTES=LDS_BYTES;
#undef SBAR
#undef WAIT_BAR
}
constexpr int MK_THREADS = 512;
constexpr int RING_BYTES = 131072, MISC_OFF = RING_BYTES + 320, MK_LDS_BYTES = 147456;
constexpr size_t WS_CTL = 0, CTL_ZERO_BYTES = 65536 + 7 * 131072; constexpr int CW_BAR = 4096;
constexpr int PH_PREP0 = 0, PH_L0 = 1, PH_PER_LAYER = 14, NPH = PH_L0 + 2 * PH_PER_LAYER;
enum { Q_INPROJ = 0, Q_SBIDX, Q_DSA, Q_GATES, Q_MERGE, Q_MIX, Q_NORMXA, Q_XALOG, Q_XAOUT, Q_NORMFFN, Q_UP, Q_FFNMID, Q_DOWN, Q_NEXT };

#ifndef QBUILD
#define QBUILD 0xffffu
#endif
#define QON(x) ((QBUILD >> (x)) & 1u)
struct Args { const float* in[20]; float* out; unsigned char* ws; int ph_lo, ph_hi; };

__global__ void __launch_bounds__(MK_THREADS, 2) mk_fwd(Args args) {
    __shared__ __attribute__((aligned(16))) unsigned char lds_raw[MK_LDS_BYTES];
    LAS unsigned char* lds = (LAS unsigned char*)lds_raw;
    volatile LAS unsigned* MISC = (volatile LAS unsigned*)(lds + MISC_OFF);
    const int G = gridDim.x, bx = blockIdx.x;
    unsigned char* ws0 = args.ws;
    const int wave_s = __builtin_amdgcn_readfirstlane((int)threadIdx.x >> 6);
    for (int u = mk_tid(wave_s); u < (MK_LDS_BYTES - RING_BYTES) / 4; u += MK_THREADS) ((LAS unsigned*)(lds + RING_BYTES))[u] = 0u;
    __syncthreads();
    const int lo = args.ph_lo, hi = args.ph_hi;
    XcdBarrier bar; bar.bar = (unsigned*)(ws0 + WS_CTL) + CW_BAR; bar.x = 0; bar.st = nullptr;
    if (hi - lo > 1) bar = xcd_barrier_post((unsigned*)(ws0 + WS_CTL) + CW_BAR, MISC + 8, mk_tid(wave_s));
#define BPW(off) ((bf16_t*)(ws + (off)))
    const int vcu = (G % 8 == 0) ? (bx % 8) * (G / 8) + bx / 8 : bx;
    for (int p = lo; p < hi; ++p) {
#ifdef PROBE_REP
        const int reps = (p >= PH_L0 && ((PROBE_REP >> ((p - PH_L0) % PH_PER_LAYER)) & 1)) ? 2 : 1;
#else
        const int reps = 1;
#endif
#ifdef PROBE_REP
#pragma unroll 1
        for (int rep = 0; rep < reps; ++rep) {
        const bool dry = rep + 1 < reps;
#else
        { constexpr bool dry = false;
#endif
        int oz = 0; asm volatile("" : "+s"(oz));
        int tid = mk_tid(wave_s); asm volatile("" : "+v"(tid));
        const int wave = __builtin_amdgcn_readfirstlane(tid >> 6), lane = tid & 63;
        WaveId W; W.gw = vcu * 8 + wave; W.ngw = G * 8; W.wave = wave; W.lane = lane;
        unsigned char* ws = args.ws + oz; float* X = args.out + oz;
#define INP(k) (args.in[(k) + oz])
        if (p == PH_PREP0) {
            prep0_phase(W, (LAS float*)(lds + wave * 16384), ws, args.in + oz, (bf16_t*)X);
        } else if (p >= PH_L0) {
            const int l = (p - PH_L0) / PH_PER_LAYER, q = (p - PH_L0) % PH_PER_LAYER;
            const float* Xin = l == 0 ? INP(0) : X;
            pg8::u64* SSb = (pg8::u64*)(ws + WS_SS);
#define SSA(i) (SSb + (size_t)(i) * T)
            if (q == Q_SBIDX) {
#ifndef NO_SB
                sb_phase(W, lds, ws, dry);
#endif
                __syncthreads();
#ifndef NO_IDX
#ifdef PROBE_SB_ONLY
                if (!dry)
#endif
                idx_phase(lds, ws, vcu, G, wave, lane);
#endif
                conv_sc_phase(vcu * MK_THREADS + tid, G * MK_THREADS, BPW(WS_SCB), BPW(WS_CX), INP(4) + l * 3 * 512, dry);
                kn_phase(W, BPW(WS_KC), (float*)(ws + WS_KN));
                if (l == 0 && !dry && QON(15)) {
                    __syncthreads();
                    { pg8::Order S; S.init(1, 4, 16, G, bx); pg8::PtrG P{(const char*)(ws + WS_KVM), (const char*)(ws + WS_WQ)}; pg8::EpiPrep E{ws, 1};
                      pg8::gemm_phase<pg8::EpiPrep, pg8::PtrG, true, true>(lds, tid, 2 * D, D, 256, S, P, E); }
                    { pg8::Order S; S.init(4, 1, 16, G, (bx + 64) % G); pg8::PtrH P{(const char*)(ws + WS_KVM), (const char*)(ws + WS_WOT)}; pg8::EpiPrep E{ws, 2};
                      pg8::gemm_phase<pg8::EpiPrep, pg8::PtrH, true, true>(lds, tid, D, 2 * D, 256, S, P, E); }
                }
            } else if (q == Q_DSA) {
#ifndef NO_DSA
                {
                    for (int pr = vcu; pr < NB * 8 * 16; pr += G) { const int bh = pr >> 4, sx = pr & 15, bb = bh >> 3, hh = bh & 7;
#pragma unroll 1
                        for (int k2 = 0; k2 < 2; ++k2)
                            attn_body::attn_unit<8>(bb, hh, k2 == 0 ? sx : 31 - sx, (const attn_body::bf16*)BPW(WS_QC), (const attn_body::bf16*)BPW(WS_KC), (const attn_body::bf16*)BPW(WS_VC),
                                                    (attn_body::bf16*)(dry ? BPW(WS_KA) : BPW(WS_QC)), (char*)lds_raw, (const unsigned*)(ws + WS_BM) + (size_t)bb * 256 * S,
                                                    (const float*)(ws + WS_KN) + bh * (S / 64), tid); }
                }
#endif
            } else if (q == Q_FFNMID) {
            } else if (q == Q_NEXT) {
                if (l + 1 < DEPTH) { int base = 0; convert_layer_weights(W, (LAS float*)(lds + wave * 16384), base, ws, args.in + oz, l + 1); }
                else if (!dry) final_norm(W, BPW(WS_XN), X, INP(19), SSA(6));
            } else if (q == Q_INPROJ && QON(Q_INPROJ)) {
                pg8::Order S; S.init(T / 256, NIN / 256, 1, G, bx);
                pg8::PtrStd P{(const char*)X, (const char*)(ws + WS_WIN), 0, 0, 0, (size_t)256 * D * 2, (size_t)256 * D * 2};
                pg8::EpiInProj E{ws, SSA(3 * l)};
                pg8::gemm_phase<pg8::EpiInProj, pg8::PtrStd, true, true>(lds, tid, D, D, D, S, P, E);
                if (l == 0 && !dry && QON(14)) {
                    pg8::Order S2; S2.init(2, 8, 2, G, (bx + G - 64) % G);
                    pg8::PtrStd P2{(const char*)(ws + WS_MEMN), (const char*)(ws + WS_WKVT), 1 * MiB, 4 * MiB, 0, (size_t)256 * D * 2, (size_t)256 * D * 2};
                    pg8::EpiPrep E2{ws, 0};
                    pg8::gemm_phase<pg8::EpiPrep, pg8::PtrStd, true, true>(lds, tid, D, D, D, S2, P2, E2);
                }
            } else if (q == Q_GATES && QON(Q_GATES)) {
                pg8::Order S; S.init(T / 256, 12, 1, G, bx);
                pg8::PtrStd P{(const char*)X, (const char*)(ws + WS_WG), 0, 0, 0, (size_t)256 * D * 2, (size_t)256 * D * 2};
                pg8::EpiGates E{BPW(WS_GATES), SSA(3 * l)};
                pg8::gemm_phase<pg8::EpiGates, pg8::PtrStd, true, true>(lds, tid, D, D, D, S, P, E);
            } else if (q == Q_MERGE && QON(Q_MERGE)) {
                pg8::Order S; S.init(T / 256, 4, 3, G, bx);
                pg8::PtrStd P{(const char*)(ws + WS_QA), (const char*)(ws + WS_WBR), 16 * MiB, (size_t)D * 512 * 2, 0, (size_t)256 * 512 * 2, (size_t)256 * 512 * 2};
                pg8::EpiMerge E{BPW(WS_XN), BPW(WS_GATES)};
                pg8::gemm_phase<pg8::EpiMerge, pg8::PtrStd, true, true>(lds, tid, 512, 512, 512, S, P, E);
            } else if (q == Q_MIX && QON(Q_MIX)) {
                pg8::Order S; S.init(T / 256, 4, 1, G, bx);
                pg8::PtrStd P{(const char*)(ws + WS_XN), (const char*)(ws + WS_WMIX), 0, 0, 0, (size_t)256 * D * 2, (size_t)256 * D * 2};
                if (l == 0) { pg8::EpiResid<true> E{(const void*)INP(0), dry ? BPW(WS_FU) : BPW(WS_XBXA), dry ? SSA(0) : SSA(1)};
                    pg8::gemm_phase<pg8::EpiResid<true>, pg8::PtrStd, true, true>(lds, tid, D, D, D, S, P, E); }
                else { pg8::EpiResid<false> E{(const void*)X, dry ? BPW(WS_FU) : BPW(WS_XBXA), dry ? SSA(0) : SSA(4)};
                    pg8::gemm_phase<pg8::EpiResid<false>, pg8::PtrStd, true, true>(lds, tid, D, D, D, S, P, E); }

            } else if (q == Q_XALOG && QON(Q_XALOG)) {
                pg8::Order S; S.init(T / 256, 4, 1, G, bx);
                pg8::PtrStd P{(const char*)(ws + WS_XBXA), (const char*)(ws + WS_GT + (size_t)l * 4 * MiB), 0, 0, 2 * MiB, (size_t)256 * D * 2, (size_t)256 * D * 2};
                pg8::EpiSoftmax E{BPW(WS_PXA), SSA(1 + 3 * l)};
                pg8::gemm_phase<pg8::EpiSoftmax, pg8::PtrStd, false, true>(lds, tid, D, D, D, S, P, E);
            } else if (q == Q_XAOUT && QON(Q_XAOUT)) {
                pg8::Order S; S.init(T / 256, 4, 1, G, bx);
                pg8::PtrStd P{(const char*)(ws + WS_PXA), (const char*)(ws + WS_HT + (size_t)l * 4 * MiB), 0, 0, 2 * MiB, (size_t)256 * D * 2, (size_t)256 * D * 2};
                pg8::EpiResid<false> E{(const void*)BPW(WS_XBXA), dry ? BPW(WS_FU) : BPW(WS_XN), dry ? SSA(0) : SSA(2 + 3 * l)};
                pg8::gemm_phase<pg8::EpiResid<false>, pg8::PtrStd, true, true>(lds, tid, D, D, D, S, P, E);
            } else if (q == Q_UP && QON(Q_UP)) {
                pg8::Order S; S.init(T / 256, 22, 1, G, bx);
                pg8::PtrStd P{(const char*)(ws + WS_XN), (const char*)(ws + WS_WUP), 0, 0, 0, (size_t)256 * D * 2, (size_t)256 * D * 2};
                pg8::EpiUpF E{BPW(WS_FU), BPW(WS_SIDEA), BPW(WS_SIDEU), SSA(2 + 3 * l), INP(16) + l * 3 * DFF, INP(17) + l * DFF};
                pg8::gemm_phase<pg8::EpiUpF, pg8::PtrStd, true, true>(lds, tid, D, D, D, S, P, E);
            } else if (q == Q_DOWN && QON(Q_DOWN)) {
                pg8::Order S; S.init(T / 256, 4, 1, G, bx);
                if (!dry) {
#pragma unroll 1
                    for (int i = 0; ; ++i) { pg8::Unit u0; if (!S.next(i, u0)) break; ffn_fix_phase(tid, MK_THREADS, BPW(WS_SIDEA), BPW(WS_SIDEU), BPW(WS_FU), INP(16) + l * 3 * DFF, INP(17) + l * DFF, 4 * u0.pm, 4); }
                    asm volatile("s_waitcnt vmcnt(0)" ::: "memory"); __syncthreads();
                }
                pg8::PtrStd P{(const char*)(ws + WS_FU), (const char*)(ws + WS_WDOWN), 0, 0, 0, (size_t)256 * DFF * 2, (size_t)256 * DFF * 2};
                pg8::EpiResid<false> E{(const void*)BPW(WS_XN), dry ? BPW(WS_QA) : (l + 1 < DEPTH ? (bf16_t*)X : BPW(WS_XN)), dry ? SSA(0) : SSA(3 + 3 * l)};
                pg8::gemm_phase<pg8::EpiResid<false>, pg8::PtrStd, true, true>(lds, tid, DFF, DFF, DFF, S, P, E);
            }
        }
        }
        if (p + 1 < hi && !(p >= PH_L0 && ((p - PH_L0) % PH_PER_LAYER == Q_NORMXA || (p - PH_L0) % PH_PER_LAYER == Q_NORMFFN || (p - PH_L0) % PH_PER_LAYER == Q_FFNMID))) xcd_barrier(bar, mk_tid(wave_s));
    }
}

extern "C" void kernel_launch(void* const* d_in, const int* in_sizes, int n_in, void* d_out, int out_size, void* d_ws, size_t ws_size, hipStream_t st) {
    if (n_in != 20 || ws_size < WS_NEED || out_size != T * D) { fprintf(stderr, "kernel_launch: unexpected sizes n_in %d ws %zu out %d\n", n_in, ws_size, out_size); return; }
    static int grid = 0;
    if (grid == 0) {
        int dev = 0, cus = 0, per_cu = 0;
        (void)hipGetDevice(&dev); (void)hipDeviceGetAttribute(&cus, hipDeviceAttributeMultiprocessorCount, dev);
        if (hipOccupancyMaxActiveBlocksPerMultiprocessor(&per_cu, (const void*)mk_fwd, MK_THREADS, 0) != hipSuccess || per_cu < 1) { fprintf(stderr, "kernel_launch: occupancy query says %d blocks/CU\n", per_cu); grid = -1; return; }
        (void)hipGetLastError();
        if (cus != 256) { fprintf(stderr, "kernel_launch: built for a 256-CU device, found %d\n", cus); grid = -1; return; }
        grid = cus;
    }
    if (grid < 0) return;
    (void)hipMemsetAsync((char*)d_ws + WS_CTL, 0, CTL_ZERO_BYTES, st);
    Args a{};
    for (int i = 0; i < 20; ++i) a.in[i] = (const float*)d_in[i];
    a.out = (float*)d_out; a.ws = (unsigned char*)d_ws; a.ph_lo = 0; a.ph_hi = NPH;
    hipLaunchKernelGGL(mk_fwd, dim3(grid), dim3(MK_THREADS), 0, st, a);
}
```

```cpp
#include <hip/hip_runtime.h>
#include <stdint.h>
#include <stdio.h>

typedef unsigned short bf16_t;
typedef short bf16x8 __attribute__((ext_vector_type(8)));
typedef float f32x16 __attribute__((ext_vector_type(16)));
typedef float f32x4 __attribute__((ext_vector_type(4)));
#define DEV __device__ __forceinline__

constexpr int NB = 2, S = 8192, D = 1024, T = NB * S, DEPTH = 2;
constexpr int DIN = 8264, DFF = 2816, MEM = 256;
constexpr int NIN = 5376;
constexpr float LOG2E = 1.4426950408889634f;
constexpr float QSCALE = 0.125f * LOG2E;
constexpr float WSCALE = 0.125f * 0.35355339059327373f;
constexpr float XSCALE = 0.0625f * LOG2E;
constexpr float EPS = 1e-6f;
#ifndef MK_FUSE
#define MK_FUSE 1
#endif

constexpr size_t MiB = 1u << 20;
constexpr size_t WS_SIDEA = 88 * MiB, WS_SIDEU = 96 * MiB;
constexpr size_t WS_KN = 983040;
constexpr size_t WS_GT = 1 * MiB;
constexpr size_t WS_HT = 9 * MiB;
constexpr size_t WS_WUP = 17 * MiB, WS_WDOWN = 28 * MiB;
constexpr size_t WS_XN = 34 * MiB;
constexpr size_t WS_WMIX = 66 * MiB, WS_WBR = 68 * MiB, WS_WG = 71 * MiB, WS_WIN = 77 * MiB;
constexpr size_t WS_QA = 88 * MiB, WS_SCB = 104 * MiB, WS_QC = 120 * MiB, WS_KA = 136 * MiB, WS_VA = 152 * MiB, WS_KC = 168 * MiB, WS_VC = 184 * MiB,
                 WS_IQ = 200 * MiB, WS_CX = 216 * MiB, WS_IK = 232 * MiB, WS_IW = 234 * MiB, WS_BM = 235 * MiB;
constexpr size_t WS_GATES = 136 * MiB;
constexpr size_t WS_XTMP = 235 * MiB;
constexpr size_t WS_LOG = 88 * MiB, WS_PXA = 168 * MiB;
constexpr size_t WS_XBXA = 136 * MiB;
constexpr size_t WS_SS = 65536;
constexpr size_t WS_FA = 66 * MiB, WS_FU = 154 * MiB;
constexpr size_t WS_WQ = 34 * MiB  , WS_WOT = 38 * MiB  , WS_WKVT = 42 * MiB  , WS_MEMN = 50 * MiB  , WS_KVM = 52 * MiB  ;
constexpr size_t WS_NEED = 256 * MiB;

DEV bf16_t f2bf(float f) { unsigned u = __float_as_uint(f); u += 0x7fffu + ((u >> 16) & 1u); return (bf16_t)(u >> 16); }
DEV float bf2f(bf16_t h) { return __uint_as_float(((unsigned)h) << 16); }
DEV float wave_sum(float v) {
#pragma unroll
    for (int o = 1; o < 64; o <<= 1) v += __shfl_xor(v, o);
    return v;
}
DEV float wave_max(float v) {
#pragma unroll
    for (int o = 1; o < 64; o <<= 1) v = fmaxf(v, __shfl_xor(v, o));
    return v;
}


#define LAS __attribute__((address_space(3)))
#define GAS __attribute__((address_space(1)))
typedef unsigned u32x4 __attribute__((ext_vector_type(4)));
typedef unsigned u32x2 __attribute__((ext_vector_type(2)));
typedef float f32x2 __attribute__((ext_vector_type(2)));
#define LDS_WAIT() asm volatile("s_waitcnt lgkmcnt(0)" ::: "memory")
DEV int mk_tid(int wave_s) { unsigned ones = ~0u; asm volatile("" : "+s"(ones)); return wave_s * 64 + (int)__builtin_amdgcn_mbcnt_hi(ones, __builtin_amdgcn_mbcnt_lo(ones, 0u)); }
#define VM_WAIT() asm volatile("s_waitcnt vmcnt(0)" ::: "memory")
typedef __bf16 bf16x2_t __attribute__((ext_vector_type(2)));
DEV unsigned cvt_pk_bf16(float lo, float hi) { const f32x2 v = {lo, hi}; return __builtin_bit_cast(unsigned, __builtin_convertvector(v, bf16x2_t)); }
DEV float bflo(unsigned w) { return __uint_as_float(w << 16); }
DEV float bfhi(unsigned w) { return __uint_as_float(w & 0xffff0000u); }

namespace pg8 {
constexpr int BM = 256, BK = 64, HALF = 128, HTB = HALF * BK * 2, STAGE_BYTES = 8 * HTB, NXCD = 8, WGM = 8;
__host__ __device__ __forceinline__ int lds_byte(int r, int c) { const int st = (r >> 4) * 2 + (c >> 5), rr = r & 15, cc = c & 31, ob = rr * 64 + cc * 2; return st * 1024 + (ob ^ (((ob >> 9) & 1) << 5)); }
__host__ __device__ __forceinline__ void stage_rc(int b, int& R, int& C) { const int st = b / 1024, sb = b % 1024, swz = sb ^ (((sb >> 9) & 1) << 5); R = (st >> 1) * 16 + swz / 64; C = (st & 1) * 32 + (swz % 64) / 2; }
__host__ __device__ __forceinline__ int perm32(int rho) { const int n = rho >> 4, i = rho & 15; return 8 * (i >> 2) + 4 * n + (i & 3); }

struct Unit { int pm, pn, job; };
struct Order {
    int nM, nN, nwg, ntot, G, c;
    DEV void init(int nM_, int nN_, int njob, int G_, int c_) { nM = nM_; nN = nN_; nwg = nM * nN; ntot = nwg * njob; G = G_; c = c_; }
    DEV bool next(int i, Unit& u) const {
        const int L = i * G + c; if (L >= ntot) return false;
        u.job = L / nwg; int wgid = L - u.job * nwg;
        { const int q = nwg / NXCD, r = nwg % NXCD, xcd = wgid % NXCD, off = wgid / NXCD; wgid = (xcd < r ? xcd * (q + 1) : r * (q + 1) + (xcd - r) * q) + off; }
        const int nig = WGM * nN, gid = wgid / nig, fm = gid * WGM, gsz = (nM - fm) < WGM ? (nM - fm) : WGM;
        u.pm = fm + ((wgid % nig) % gsz); u.pn = (wgid % nig) / gsz; return true;
    }
};
template <class Epi, class Ptr, bool ALIGN_EPI, bool SP2>
DEV void gemm_phase(LAS unsigned char* lds, const int tid_in, const int lda, const int ldb, const int K, const Order& S, const Ptr& P, const Epi& E) {
    int tid_ = tid_in; asm volatile("" : "+v"(tid_));
    const int tid = tid_, wid = __builtin_amdgcn_readfirstlane(tid >> 6), lane = tid & 63, wr = wid >> 2, wc = wid & 3, fr = lane & 15, fq = lane >> 4;
    const int nt = K / BK;
    unsigned voffA[2], voffB[2];
#pragma unroll
    for (int i = 0; i < 2; ++i) { int R, C; stage_rc(tid * 16 + i * 8192, R, C); const int Rb = Epi::PERM ? ((R & ~31) + perm32(R & 31)) : R;
        voffA[i] = (unsigned)(R * lda + C) * 2u; voffB[i] = (unsigned)(Rb * ldb + C) * 2u; }
    const size_t kstep = (size_t)(BK * 2);
    const size_t hstepA = (size_t)HALF * lda * 2, hstepB = (size_t)HALF * ldb * 2;
    const unsigned ldsw = (unsigned)wid * 1024u;
    const int aoff = lds_byte(wr * 64 + fr, fq * 8), boff = lds_byte(wc * 32 + fr, fq * 8);
#define PG8_SA(b, h) (((b) * 2 + (h)) * HTB)
#define PG8_SB(b, h) ((4 + (b) * 2 + (h)) * HTB)
#define PG8_STAGE(bufoff, gbase, voff) do { _Pragma("unroll") for (int _i = 0; _i < 2; ++_i) \
        __builtin_amdgcn_global_load_lds((const unsigned*)((const char*)(gbase) + (voff)[_i]), (LAS unsigned*)(lds + (bufoff) + ldsw + _i * 8192), 16, 0, 0); } while (0)
#define PG8_LDA(dst, b, h) do { _Pragma("unroll") for (int m = 0; m < 4; ++m) _Pragma("unroll") for (int k = 0; k < 2; ++k) dst[m][k] = *(const LAS bf16x8*)(lds + PG8_SA(b, h) + aoff + m * 2048 + k * 1024); } while (0)
#define PG8_LDB(dst, b, h) do { _Pragma("unroll") for (int n = 0; n < 2; ++n) _Pragma("unroll") for (int k = 0; k < 2; ++k) dst[n][k] = *(const LAS bf16x8*)(lds + PG8_SB(b, h) + boff + n * 2048 + k * 1024); } while (0)
#define PG8_MMA(ai, bj, At, Bt) do { __builtin_amdgcn_s_setprio(1); _Pragma("unroll") for (int m = 0; m < 4; ++m) _Pragma("unroll") for (int n = 0; n < 2; ++n) _Pragma("unroll") for (int k = 0; k < 2; ++k) \
        acc[ai][bj][m][n] = __builtin_amdgcn_mfma_f32_16x16x32_bf16(Bt[n][k], At[m][k], acc[ai][bj][m][n], 0, 0, 0); __builtin_amdgcn_s_setprio(0); } while (0)
#define PG8_WAIT_V(n) asm volatile("s_waitcnt vmcnt(" #n ")" ::: "memory")
#define PG8_WAIT_L(n) asm volatile("s_waitcnt lgkmcnt(" #n ")" ::: "memory")
#define PG8_BAR __builtin_amdgcn_s_barrier()
#define PG8_SCHED __builtin_amdgcn_sched_barrier(0)
    Unit cur, nxt; int ui = 0;
    if (!S.next(0, cur)) return;
    f32x4 acc[2][2][4][2];
#pragma unroll
    for (int a = 0; a < 2; ++a)
#pragma unroll
        for (int b = 0; b < 2; ++b)
#pragma unroll
            for (int m = 0; m < 4; ++m)
#pragma unroll
                for (int n = 0; n < 2; ++n) acc[a][b][m][n] = (f32x4){0.f, 0.f, 0.f, 0.f};
    bf16x8 At[4][2], B0[2][2], B1[2][2];
    const char* cA = P.a(cur); const char* cB = P.b(cur);
    typename Epi::Pre pre; E.prefetch(pre, cur, wr, fr);
    if constexpr (SP2) {
        PG8_STAGE(PG8_SB(0, 0), cB, voffB); PG8_STAGE(PG8_SB(0, 1), cB + hstepB, voffB); PG8_STAGE(PG8_SA(0, 0), cA, voffA); PG8_STAGE(PG8_SA(0, 1), cA + hstepA, voffA);
        if (wr == 1) PG8_BAR;
        PG8_WAIT_V(2); PG8_BAR;
        PG8_STAGE(PG8_SB(1, 0), cB + kstep, voffB); PG8_STAGE(PG8_SA(1, 0), cA + kstep, voffA); PG8_STAGE(PG8_SB(1, 1), cB + hstepB + kstep, voffB);
        PG8_WAIT_V(6); PG8_BAR;
    } else {
        PG8_STAGE(PG8_SB(0, 0), cB, voffB); PG8_STAGE(PG8_SA(0, 0), cA, voffA); PG8_STAGE(PG8_SB(0, 1), cB + hstepB, voffB); PG8_STAGE(PG8_SA(0, 1), cA + hstepA, voffA);
        if (wr == 1) PG8_BAR;
        PG8_WAIT_V(4); PG8_BAR;
        PG8_STAGE(PG8_SB(1, 0), cB + kstep, voffB); PG8_STAGE(PG8_SA(1, 0), cA + kstep, voffA); PG8_STAGE(PG8_SB(1, 1), cB + hstepB + kstep, voffB);
        PG8_WAIT_V(6); PG8_BAR;
    }
#pragma unroll 1
    for (;;) {
        const bool has_next = S.next(ui + 1, nxt);
        const char* nA = has_next ? P.a(nxt) : cA; const char* nB = has_next ? P.b(nxt) : cB;
#pragma unroll 1
        for (int t = 0; t < nt; t += 2) {
            const bool last = (t == nt - 2);
            const char* a1 = cA + (size_t)(t + 1) * kstep;
            const char* a2 = last ? nA : cA + (size_t)(t + 2) * kstep; const char* b2 = last ? nB : cB + (size_t)(t + 2) * kstep;
            const char* a3 = a2 + kstep; const char* b3 = b2 + kstep;
            if constexpr (SP2) {
            PG8_LDB(B0, 0, 0); PG8_LDB(B1, 0, 1); PG8_SCHED; PG8_LDA(At, 0, 0); PG8_STAGE(PG8_SA(1, 1), a1 + hstepA, voffA);
            PG8_WAIT_V(8); PG8_WAIT_L(0); PG8_BAR; PG8_MMA(0, 0, At, B0); PG8_MMA(0, 1, At, B1); PG8_BAR; PG8_SCHED;
            PG8_LDA(At, 0, 1); PG8_STAGE(PG8_SB(0, 0), b2, voffB); PG8_STAGE(PG8_SB(0, 1), b2 + hstepB, voffB); PG8_STAGE(PG8_SA(0, 0), a2, voffA);
            PG8_WAIT_V(8); PG8_WAIT_L(0); PG8_BAR; PG8_MMA(1, 0, At, B0); PG8_MMA(1, 1, At, B1); PG8_BAR; PG8_SCHED;
            PG8_LDB(B0, 1, 0); PG8_LDB(B1, 1, 1); PG8_SCHED; PG8_LDA(At, 1, 0); PG8_STAGE(PG8_SA(0, 1), a2 + hstepA, voffA);
            PG8_WAIT_V(8); PG8_WAIT_L(0); PG8_BAR; PG8_MMA(0, 0, At, B0); PG8_MMA(0, 1, At, B1); PG8_BAR; PG8_SCHED;
            PG8_LDA(At, 1, 1); PG8_STAGE(PG8_SB(1, 0), b3, voffB); PG8_STAGE(PG8_SB(1, 1), b3 + hstepB, voffB); PG8_STAGE(PG8_SA(1, 0), a3, voffA);
            PG8_WAIT_V(8); PG8_WAIT_L(0); PG8_BAR; PG8_MMA(1, 0, At, B0); PG8_MMA(1, 1, At, B1); PG8_BAR; PG8_SCHED;
            } else {
            PG8_LDB(B0, 0, 0); PG8_SCHED; PG8_LDA(At, 0, 0); PG8_STAGE(PG8_SA(1, 1), a1 + hstepA, voffA);
            PG8_WAIT_L(8); PG8_BAR; PG8_WAIT_L(0); PG8_MMA(0, 0, At, B0); PG8_BAR; PG8_SCHED;
            PG8_LDB(B1, 0, 1); PG8_STAGE(PG8_SB(0, 0), b2, voffB);
            PG8_BAR; PG8_WAIT_L(0); PG8_MMA(0, 1, At, B1); PG8_BAR;
            PG8_LDA(At, 0, 1); PG8_STAGE(PG8_SA(0, 0), a2, voffA);
            PG8_BAR; PG8_WAIT_L(0); PG8_MMA(1, 0, At, B0); PG8_BAR; PG8_SCHED;
            PG8_STAGE(PG8_SB(0, 1), b2 + hstepB, voffB);
            PG8_WAIT_V(6); PG8_BAR; PG8_MMA(1, 1, At, B1); PG8_BAR;
            PG8_LDB(B0, 1, 0); PG8_SCHED; PG8_LDA(At, 1, 0); PG8_STAGE(PG8_SA(0, 1), a2 + hstepA, voffA);
            PG8_WAIT_L(8); PG8_BAR; PG8_WAIT_L(0); PG8_MMA(0, 0, At, B0); PG8_BAR; PG8_SCHED;
            PG8_LDB(B1, 1, 1); PG8_STAGE(PG8_SB(1, 0), b3, voffB);
            PG8_BAR; PG8_WAIT_L(0); PG8_MMA(0, 1, At, B1); PG8_BAR;
            PG8_LDA(At, 1, 1); PG8_STAGE(PG8_SA(1, 0), a3, voffA);
            PG8_BAR; PG8_WAIT_L(0); PG8_MMA(1, 0, At, B0); PG8_BAR; PG8_SCHED;
            PG8_STAGE(PG8_SB(1, 1), b3 + hstepB, voffB);
            PG8_WAIT_V(6); PG8_BAR; PG8_MMA(1, 1, At, B1); PG8_BAR;
            }
        }
        if constexpr (ALIGN_EPI) { if (wr == 0) PG8_BAR; }
        if constexpr (!Epi::AFTER_DRAIN) { int fr_ = fr, fq_ = fq; asm volatile("" : "+v"(fr_), "+v"(fq_));
            E(acc, cur, wr, wc, fr_, fq_, pre); }
        if (!has_next) break;
#pragma unroll
        for (int a = 0; a < 2; ++a)
#pragma unroll
            for (int b = 0; b < 2; ++b)
#pragma unroll
                for (int m = 0; m < 4; ++m)
#pragma unroll
                    for (int n = 0; n < 2; ++n) acc[a][b][m][n] = (f32x4){0.f, 0.f, 0.f, 0.f};
        cur = nxt; cA = nA; cB = nB; ++ui; E.prefetch(pre, cur, wr, fr);
        if constexpr (ALIGN_EPI) { if (wr == 1) PG8_BAR; }
    }
    PG8_WAIT_V(0);
    if constexpr (!ALIGN_EPI) { if (wr == 0) PG8_BAR; }
    PG8_BAR;
    if constexpr (Epi::AFTER_DRAIN) { int fr_ = fr, fq_ = fq, lane_ = lane; asm volatile("" : "+v"(fr_), "+v"(fq_), "+v"(lane_)); E.fused(acc, cur, wr, wc, fr_, fq_, lds, wid, lane_, pre); }
#undef PG8_SA
#undef PG8_SB
#undef PG8_STAGE
#undef PG8_LDA
#undef PG8_LDB
#undef PG8_MMA
#undef PG8_WAIT_V
#undef PG8_WAIT_L
#undef PG8_BAR
#undef PG8_SCHED
}
typedef f32x4 Acc[2][2][4][2];

struct PtrStd {
    const char* A; const char* B; size_t aj, bj, bb, arow, brow;
    DEV const char* a(const Unit& u) const { return A + (size_t)u.job * aj + (size_t)u.pm * arow; }
    DEV const char* b(const Unit& u) const { return B + (size_t)u.job * bj + (size_t)(u.pm >> 5) * bb + (size_t)u.pn * brow; }
};
struct PtrG {
    const char* KVM; const char* WQ;
    DEV const char* a(const Unit& u) const { return KVM + (size_t)(u.job >> 2) * MiB + (size_t)(u.job & 3) * 512; }
    DEV const char* b(const Unit& u) const { return WQ + (size_t)(u.job >> 3) * 2 * MiB + (size_t)(u.job & 3) * 512 + (size_t)u.pn * 256 * 1024 * 2; }
};
struct PtrH {
    const char* KVM; const char* WOT;
    DEV const char* a(const Unit& u) const { return WOT + (size_t)(u.job >> 3) * 2 * MiB + (size_t)(u.job & 3) * 512 + (size_t)u.pm * 256 * 1024 * 2; }
    DEV const char* b(const Unit& u) const { return KVM + (size_t)(u.job >> 2) * MiB + 2048 + (size_t)(u.job & 3) * 512; }
};

#define EPI_ROWS(u) const int row0 = (u).pm * BM + wr * 64 + fr
DEV u32x4 pack8(const f32x4 v0, const f32x4 v1) { u32x4 w; w.x = cvt_pk_bf16(v0[0], v0[1]); w.y = cvt_pk_bf16(v0[2], v0[3]); w.z = cvt_pk_bf16(v1[0], v1[1]); w.w = cvt_pk_bf16(v1[2], v1[3]); return w; }

struct PreNone {};
typedef unsigned long long u64;
constexpr float SS_SCALE = 65536.f;
struct PreRs { u64 v[2][4]; };
DEV void pre_rs(PreRs& p, const u64* ss, int row0) {
#pragma unroll
    for (int ai = 0; ai < 2; ++ai)
#pragma unroll
        for (int m = 0; m < 4; ++m) p.v[ai][m] = __builtin_nontemporal_load(ss + row0 + ai * HALF + m * 16);
}
DEV void rs_of(float (&rs)[2][4], const PreRs& p) {
#pragma unroll
    for (int ai = 0; ai < 2; ++ai)
#pragma unroll
        for (int m = 0; m < 4; ++m) rs[ai][m] = rsqrtf((float)p.v[ai][m] * (1.f / (SS_SCALE * D)) + EPS);
}
struct EpiInProj {
    typedef PreRs Pre;
    DEV void prefetch(PreRs& p, const Unit& u, int wr, int fr) const { pre_rs(p, ss, u.pm * BM + wr * 64 + fr); }
    static constexpr bool PERM = true, AFTER_DRAIN = false;
    unsigned char* ws; const u64* ss;
    DEV void operator()(const Acc& acc, const Unit& u, int wr, int wc, int fr, int fq, const PreRs& pre) const {
        EPI_ROWS(u); const int pn = u.pn, cb = wc * 32 + 8 * fq;
        float rs[2][4]; rs_of(rs, pre);
        if (pn < 16) {
            const int g = pn >> 1;
            const size_t off = g == 0 ? WS_QA : g == 1 ? WS_KA : g == 2 ? WS_VA : g == 3 ? WS_QC : g == 4 ? WS_KC : g == 5 ? WS_VC : g == 6 ? WS_IQ : WS_SCB;
            const float sc = (g == 0 || g == 3) ? QSCALE : 1.f;
            bf16_t* base = (bf16_t*)(ws + off) + (pn & 1) * 256 + cb;
#pragma unroll
            for (int ai = 0; ai < 2; ++ai)
#pragma unroll
                for (int m = 0; m < 4; ++m) { bf16_t* rowp = base + (size_t)(row0 + ai * HALF + m * 16) * 512;
#pragma unroll
                    for (int bj = 0; bj < 2; ++bj) *(u32x4*)(rowp + bj * HALF) = pack8(acc[ai][bj][m][0] * (sc * rs[ai][m]), acc[ai][bj][m][1] * (sc * rs[ai][m])); }
        } else if (pn < 20) {
            bf16_t* base = (bf16_t*)(ws + WS_CX) + (pn - 16) * 128 + cb;
#pragma unroll
            for (int ai = 0; ai < 2; ++ai)
#pragma unroll
                for (int m = 0; m < 4; ++m) { const float r2 = rs[ai][m] * rs[ai][m]; *(u32x4*)(base + (size_t)(row0 + ai * HALF + m * 16) * 512) = pack8(acc[ai][0][m][0] * acc[ai][1][m][0] * r2, acc[ai][0][m][1] * acc[ai][1][m][1] * r2); }
        } else {
            if (wc < 2) { bf16_t* base = (bf16_t*)(ws + WS_IK);
#pragma unroll
                for (int ai = 0; ai < 2; ++ai)
#pragma unroll
                    for (int m = 0; m < 4; ++m) { const int t = row0 + ai * HALF + m * 16;
                        *(u32x4*)(base + (size_t)(t >> 5) * 2048 + (((cb >> 3) * 32 + (t & 31)) * 8)) = pack8(acc[ai][0][m][0] * rs[ai][m], acc[ai][0][m][1] * rs[ai][m]); }
            } else if (wc == 2 && fq == 0) { float* base = (float*)(ws + WS_IW);
#pragma unroll
                for (int ai = 0; ai < 2; ++ai)
#pragma unroll
                    for (int m = 0; m < 4; ++m) { float* p = base + (size_t)(row0 + ai * HALF + m * 16) * 8; *(f32x4*)p = acc[ai][0][m][0] * (WSCALE * rs[ai][m]); *(f32x4*)(p + 4) = acc[ai][0][m][1] * (WSCALE * rs[ai][m]); }
            }
        }
    }
};
DEV f32x4 sigm4(const f32x4 v) { f32x4 o;
#pragma unroll
    for (int i = 0; i < 4; ++i) o[i] = __builtin_amdgcn_rcpf(1.f + __builtin_amdgcn_exp2f(-LOG2E * v[i])); return o; }
struct EpiGates {
    typedef PreRs Pre;
    DEV void prefetch(PreRs& p, const Unit& u, int wr, int fr) const { pre_rs(p, ss, u.pm * BM + wr * 64 + fr); }
    static constexpr bool PERM = true, AFTER_DRAIN = false;
    bf16_t* G; const u64* ss;
    DEV void operator()(const Acc& acc, const Unit& u, int wr, int wc, int fr, int fq, const PreRs& pre) const {
        EPI_ROWS(u); float rs[2][4]; rs_of(rs, pre); bf16_t* base = G + (size_t)(u.pn >> 2) * T * D + (u.pn & 3) * 256 + wc * 32 + 8 * fq;
#pragma unroll
        for (int ai = 0; ai < 2; ++ai)
#pragma unroll
            for (int m = 0; m < 4; ++m) { bf16_t* rowp = base + (size_t)(row0 + ai * HALF + m * 16) * D;
#pragma unroll
                for (int bj = 0; bj < 2; ++bj) *(u32x4*)(rowp + bj * HALF) = pack8(sigm4(acc[ai][bj][m][0] * rs[ai][m]), sigm4(acc[ai][bj][m][1] * rs[ai][m])); }
    }
};
struct EpiMerge {
    typedef PreNone Pre;
    DEV void prefetch(PreNone&, const Unit&, int, int) const {}
    static constexpr bool PERM = true, AFTER_DRAIN = false;
    bf16_t* M; const bf16_t* G;
    DEV void operator()(const Acc& acc, const Unit& u, int wr, int wc, int fr, int fq, const PreNone&) const {
        EPI_ROWS(u); const size_t cofs = (size_t)u.pn * 256 + wc * 32 + 8 * fq; const bf16_t* gb = G + (size_t)u.job * T * D;
#pragma unroll
        for (int ai = 0; ai < 2; ++ai) {
            u32x4 g[8], p[8];
#pragma unroll
            for (int m = 0; m < 4; ++m)
#pragma unroll
                for (int bj = 0; bj < 2; ++bj) { const size_t o = (size_t)(row0 + ai * HALF + m * 16) * D + cofs + bj * HALF; g[2 * m + bj] = *(const u32x4*)(gb + o);
                    if (u.job > 0) p[2 * m + bj] = __builtin_nontemporal_load((const u32x4*)(M + o)); }
#pragma unroll
            for (int m = 0; m < 4; ++m)
#pragma unroll
                for (int bj = 0; bj < 2; ++bj) { const size_t o = (size_t)(row0 + ai * HALF + m * 16) * D + cofs + bj * HALF; const u32x4 gg = g[2 * m + bj];
                    f32x4 v0 = acc[ai][bj][m][0], v1 = acc[ai][bj][m][1];
                    v0[0] *= bflo(gg.x); v0[1] *= bfhi(gg.x); v0[2] *= bflo(gg.y); v0[3] *= bfhi(gg.y); v1[0] *= bflo(gg.z); v1[1] *= bfhi(gg.z); v1[2] *= bflo(gg.w); v1[3] *= bfhi(gg.w);
                    if (u.job > 0) { const u32x4 pp = p[2 * m + bj];
                        v0[0] += bflo(pp.x); v0[1] += bfhi(pp.x); v0[2] += bflo(pp.y); v0[3] += bfhi(pp.y); v1[0] += bflo(pp.z); v1[1] += bfhi(pp.z); v1[2] += bflo(pp.w); v1[3] += bfhi(pp.w); }
                    *(u32x4*)(M + o) = pack8(v0, v1); }
        }
    }
};
template <bool IN_F32> struct EpiResid {
    typedef PreNone Pre;
    DEV void prefetch(PreNone&, const Unit&, int, int) const {}
    static constexpr bool PERM = true, AFTER_DRAIN = false;
    const void* xin; bf16_t* xb; u64* ss;
    DEV void operator()(const Acc& acc, const Unit& u, int wr, int wc, int fr, int fq, const PreNone&) const {
        EPI_ROWS(u); const size_t cofs = (size_t)u.pn * 256 + wc * 32 + 8 * fq;
#pragma unroll
        for (int ai = 0; ai < 2; ++ai) {
            f32x4 r0[8], r1[8];
#pragma unroll
            for (int m = 0; m < 4; ++m)
#pragma unroll
                for (int bj = 0; bj < 2; ++bj) { const size_t o = (size_t)(row0 + ai * HALF + m * 16) * D + cofs + bj * HALF; const int k = 2 * m + bj;
                    if (IN_F32) { r0[k] = *(const f32x4*)((const float*)xin + o); r1[k] = *(const f32x4*)((const float*)xin + o + 4); }
                    else { const u32x4 p = *(const u32x4*)((const bf16_t*)xin + o); r0[k] = __builtin_bit_cast(f32x4, p); } }
#pragma unroll
            for (int m = 0; m < 4; ++m) { const size_t ro = (size_t)(row0 + ai * HALF + m * 16) * D + cofs; float sq = 0.f;
#pragma unroll
                for (int bj = 0; bj < 2; ++bj) { const size_t o = ro + bj * HALF; const int k = 2 * m + bj; f32x4 v0 = acc[ai][bj][m][0], v1 = acc[ai][bj][m][1];
                    if (IN_F32) { v0 = v0 + r0[k]; v1 = v1 + r1[k]; }
                    else { const u32x4 p = __builtin_bit_cast(u32x4, r0[k]);
                        v0[0] += bflo(p.x); v0[1] += bfhi(p.x); v0[2] += bflo(p.y); v0[3] += bfhi(p.y); v1[0] += bflo(p.z); v1[1] += bfhi(p.z); v1[2] += bflo(p.w); v1[3] += bfhi(p.w); }
                    *(u32x4*)(xb + o) = pack8(v0, v1);
                    sq += ((v0[0] * v0[0] + v0[1] * v0[1]) + (v0[2] * v0[2] + v0[3] * v0[3])) + ((v1[0] * v1[0] + v1[1] * v1[1]) + (v1[2] * v1[2] + v1[3] * v1[3])); }
                sq += __shfl_xor(sq, 16); sq += __shfl_xor(sq, 32);
                if (fq == 0) atomicAdd(ss + row0 + ai * HALF + m * 16, (u64)(sq * SS_SCALE + 0.5f)); }
        }
    }
};
struct EpiUp {
    typedef PreRs Pre;
    DEV void prefetch(PreRs& p, const Unit& u, int wr, int fr) const { pre_rs(p, ss, u.pm * BM + wr * 64 + fr); }
    static constexpr bool PERM = true, AFTER_DRAIN = false;
    bf16_t *fa, *fu; const u64* ss;
    DEV void operator()(const Acc& acc, const Unit& u, int wr, int wc, int fr, int fq, const PreRs& pre) const {
        EPI_ROWS(u); float rs[2][4]; rs_of(rs, pre); const size_t cofs = (size_t)u.pn * 128 + wc * 32 + 8 * fq;
#pragma unroll
        for (int ai = 0; ai < 2; ++ai)
#pragma unroll
            for (int m = 0; m < 4; ++m) { const size_t o = (size_t)(row0 + ai * HALF + m * 16) * DFF + cofs;
                *(u32x4*)(fa + o) = pack8(acc[ai][0][m][0] * rs[ai][m], acc[ai][0][m][1] * rs[ai][m]); *(u32x4*)(fu + o) = pack8(acc[ai][1][m][0] * rs[ai][m], acc[ai][1][m][1] * rs[ai][m]); }
    }
};
DEV float gelu_t(float a) { return a * __builtin_amdgcn_rcpf(1.f + __builtin_amdgcn_exp2f(-1.5957691216057308f * LOG2E * (a + 0.044715f * a * a * a))); }
DEV float row_prev1(float cur, float prevm) { const int r = __builtin_amdgcn_update_dpp(0, (int)__float_as_uint(prevm), 0x121, 0xf, 0xf, false);
    return __uint_as_float((unsigned)__builtin_amdgcn_update_dpp(r, (int)__float_as_uint(cur), 0x111, 0xf, 0xf, false)); }
DEV float row_prev2(float cur, float prevm) { const int r = __builtin_amdgcn_update_dpp(0, (int)__float_as_uint(prevm), 0x122, 0xf, 0xf, false);
    return __uint_as_float((unsigned)__builtin_amdgcn_update_dpp(r, (int)__float_as_uint(cur), 0x112, 0xf, 0xf, false)); }
struct EpiUpF {
    typedef PreRs Pre;
    DEV void prefetch(PreRs& p, const Unit& u, int wr, int fr) const { pre_rs(p, ss, u.pm * BM + wr * 64 + fr); }
    static constexpr bool PERM = true, AFTER_DRAIN = false;
    bf16_t *fu, *sa, *su; const u64* ss; const float *cw, *cb;
    DEV void operator()(const Acc& acc, const Unit& u, int wr, int wc, int fr, int fq, const PreRs& pre) const {
        EPI_ROWS(u); float rs[2][4]; rs_of(rs, pre); const size_t cofs = (size_t)u.pn * 128 + wc * 32 + 8 * fq;
        f32x4 w0[2], w1[2], w2[2], bb[2];
#pragma unroll
        for (int n = 0; n < 2; ++n) { w0[n] = *(const f32x4*)(cw + cofs + 4 * n); w1[n] = *(const f32x4*)(cw + DFF + cofs + 4 * n); w2[n] = *(const f32x4*)(cw + 2 * DFF + cofs + 4 * n); bb[n] = *(const f32x4*)(cb + cofs + 4 * n); }
#pragma unroll
        for (int ai = 0; ai < 2; ++ai) {
            const size_t strip = (size_t)u.pm * 4 + ai * 2 + wr;
            f32x4 ap[2] = {{0.f, 0.f, 0.f, 0.f}, {0.f, 0.f, 0.f, 0.f}};
#pragma unroll
            for (int m = 0; m < 4; ++m) {
                f32x4 a[2], g[2];
#pragma unroll
                for (int n = 0; n < 2; ++n) { a[n] = acc[ai][0][m][n] * rs[ai][m];
#pragma unroll
                    for (int e = 0; e < 4; ++e) { const float a1 = row_prev1(a[n][e], ap[n][e]), a2 = row_prev2(a[n][e], ap[n][e]);
                        g[n][e] = gelu_t(bb[n][e] + w0[n][e] * a2 + w1[n][e] * a1 + w2[n][e] * a[n][e]) * (acc[ai][1][m][n][e] * rs[ai][m]); } }
                if (m == 0) {
                    if (fr < 2) { *(u32x4*)(sa + (strip * 4 + fr) * DFF + cofs) = pack8(a[0], a[1]); *(u32x4*)(su + (strip * 2 + fr) * DFF + cofs) = pack8(acc[ai][1][0][0] * rs[ai][0], acc[ai][1][0][1] * rs[ai][0]); }
                    else *(u32x4*)(fu + (size_t)(row0 + ai * HALF) * DFF + cofs) = pack8(g[0], g[1]);
                } else {
                    *(u32x4*)(fu + (size_t)(row0 + ai * HALF + m * 16) * DFF + cofs) = pack8(g[0], g[1]);
                    if (m == 3 && fr >= 14) *(u32x4*)(sa + (strip * 4 + 2 + (fr - 14)) * DFF + cofs) = pack8(a[0], a[1]);
                }
                ap[0] = a[0]; ap[1] = a[1];
            }
        }
    }
};
struct EpiPrep {
    typedef PreNone Pre;
    DEV void prefetch(PreNone&, const Unit&, int, int) const {}
    static constexpr bool PERM = true, AFTER_DRAIN = false;
    unsigned char* ws; int mode;
    DEV void operator()(const Acc& acc, const Unit& u, int wr, int wc, int fr, int fq, const PreNone&) const {
        EPI_ROWS(u); bf16_t* base; int ldc; float sc = 1.f;
        if (mode == 0) { base = (bf16_t*)(ws + WS_KVM + (size_t)u.job * 2 * MiB); ldc = 2 * D; }
        else if (mode == 1) { base = (bf16_t*)(ws + WS_GT + (size_t)(u.job >> 2) * 2 * MiB) + (size_t)(u.job & 3) * 256 * D; ldc = D; sc = XSCALE; }
        else { base = (bf16_t*)(ws + WS_HT + (size_t)(u.job >> 2) * 2 * MiB) + (u.job & 3) * 256; ldc = D; }
        base += (size_t)u.pn * 256 + wc * 32 + 8 * fq;
#pragma unroll
        for (int ai = 0; ai < 2; ++ai)
#pragma unroll
            for (int m = 0; m < 4; ++m) { bf16_t* rowp = base + (size_t)(row0 + ai * HALF + m * 16) * ldc;
#pragma unroll
                for (int bj = 0; bj < 2; ++bj) *(u32x4*)(rowp + bj * HALF) = pack8(acc[ai][bj][m][0] * sc, acc[ai][bj][m][1] * sc); }
    }
};
struct EpiSoftmax {
    typedef PreRs Pre;
    DEV void prefetch(PreRs& p, const Unit& u, int wr, int fr) const { pre_rs(p, ss, u.pm * BM + wr * 64 + fr); }
    static constexpr bool PERM = true, AFTER_DRAIN = true;
    bf16_t* P; const u64* ss;
    DEV void fused(Acc& acc, const Unit& u, int wr, int wc, int fr, int fq, LAS unsigned char* lds, int wid, int lane, const PreRs& pre) const {
        LAS float* PM = (LAS float*)lds; LAS float* PS = (LAS float*)(lds + 4096);
        { const int row0_ = u.pm * BM + wr * 64 + fr; float rs[2][4]; rs_of(rs, pre);
#pragma unroll
          for (int ai = 0; ai < 2; ++ai)
#pragma unroll
              for (int m = 0; m < 4; ++m)
#pragma unroll
                  for (int bj = 0; bj < 2; ++bj)
#pragma unroll
                      for (int n = 0; n < 2; ++n) acc[ai][bj][m][n] = acc[ai][bj][m][n] * rs[ai][m]; }
#pragma unroll
        for (int ai = 0; ai < 2; ++ai)
#pragma unroll
            for (int m = 0; m < 4; ++m) { float mx = -INFINITY;
#pragma unroll
                for (int bj = 0; bj < 2; ++bj)
#pragma unroll
                    for (int n = 0; n < 2; ++n) { const f32x4 x = acc[ai][bj][m][n]; mx = fmaxf(mx, fmaxf(fmaxf(x[0], x[1]), fmaxf(x[2], x[3]))); }
                mx = fmaxf(mx, __shfl_xor(mx, 16)); mx = fmaxf(mx, __shfl_xor(mx, 32));
                if (fq == 0) PM[(ai * HALF + wr * 64 + m * 16 + fr) * 4 + wc] = mx; }
        LDS_WAIT(); __builtin_amdgcn_s_barrier(); asm volatile("" ::: "memory");
#pragma unroll
        for (int ai = 0; ai < 2; ++ai)
#pragma unroll
            for (int m = 0; m < 4; ++m) { const int r = ai * HALF + wr * 64 + m * 16 + fr; const f32x4 q = *(const LAS f32x4*)(PM + r * 4);
                const float mx = fmaxf(fmaxf(q[0], q[1]), fmaxf(q[2], q[3])); float s = 0.f;
#pragma unroll
                for (int bj = 0; bj < 2; ++bj)
#pragma unroll
                    for (int n = 0; n < 2; ++n) { f32x4 x = acc[ai][bj][m][n];
#pragma unroll
                        for (int i = 0; i < 4; ++i) { x[i] = __builtin_amdgcn_exp2f(x[i] - mx); s += x[i]; } acc[ai][bj][m][n] = x; }
                s += __shfl_xor(s, 16); s += __shfl_xor(s, 32);
                if (fq == 0) PS[r * 4 + wc] = s; }
        LDS_WAIT(); __builtin_amdgcn_s_barrier(); asm volatile("" ::: "memory");
        EPI_ROWS(u); bf16_t* base = P + (size_t)u.pn * 256 + wc * 32 + 8 * fq;
#pragma unroll
        for (int ai = 0; ai < 2; ++ai)
#pragma unroll
            for (int m = 0; m < 4; ++m) { const int r = ai * HALF + wr * 64 + m * 16 + fr; const f32x4 q = *(const LAS f32x4*)(PS + r * 4);
                const float inv = 1.f / ((q[0] + q[1]) + (q[2] + q[3])); bf16_t* rowp = base + (size_t)(row0 + ai * HALF + m * 16) * D;
#pragma unroll
                for (int bj = 0; bj < 2; ++bj) *(u32x4*)(rowp + bj * HALF) = pack8(acc[ai][bj][m][0] * inv, acc[ai][bj][m][1] * inv); }
        LDS_WAIT(); __builtin_amdgcn_s_barrier();
    }
};
}

typedef GAS unsigned gu32;
#define XB_TMO      128
#define XB_XCNT(j)  (256  + 64 * (j))
#define XB_XSUB(j)  (1280 + 64 * (j))
#define XB_XGEN(j)  (2304 + 64 * (j))
#define XB_TOP      3328
#define XB_TOPGEN   3392
#define XCD_BAR_WORDS 3456
#define XB_SPIN_CAP (1u << 22)
DEV unsigned xb_ld(unsigned* p) { return __hip_atomic_load(p, __ATOMIC_RELAXED, __HIP_MEMORY_SCOPE_AGENT); }
DEV unsigned xb_add(unsigned* p, unsigned v) { return __hip_atomic_fetch_add(p, v, __ATOMIC_RELAXED, __HIP_MEMORY_SCOPE_AGENT); }
DEV unsigned xb_xcc_id() { return (unsigned)__builtin_amdgcn_s_getreg((3 << 11) | 20) & 0xFu; }
#define XB_SPIN(cond, bar) do { unsigned _sp = 0; while (cond) { __builtin_amdgcn_s_sleep(1); \
    if ((++_sp & 255u) == 0u) { if (xb_ld(&(bar)[XB_TMO])) break; if (_sp > XB_SPIN_CAP) { atomicAdd(&(bar)[XB_TMO], 1u); break; } } } } while (0)
struct XcdBarrier { unsigned* bar; unsigned x; volatile LAS unsigned* st; };
DEV XcdBarrier xcd_barrier_post(unsigned* bar, volatile LAS unsigned* st, int tid) {
    XcdBarrier b; b.bar = bar; b.x = xb_xcc_id(); b.st = st;
    if (tid == 0) (void)xb_add(&bar[XB_XCNT(b.x)], 1u);
    return b;
}
DEV void xcd_barrier_complete(unsigned* bar, unsigned x, unsigned& nloc, unsigned& nx) {
    const unsigned G = gridDim.x * gridDim.y * gridDim.z;
    unsigned sum, cnt, mine, sp = 0u;
    for (;;) {
        sum = 0u; cnt = 0u; mine = 0u;
#pragma unroll
        for (unsigned j = 0; j < 16; ++j) { const unsigned c = xb_ld(&bar[XB_XCNT(j)]); sum += c; cnt += (c > 0u) ? 1u : 0u; mine = (j == x) ? c : mine; }
        if (sum == G) break;
        __builtin_amdgcn_s_sleep(1);
        if ((++sp & 255u) == 0u) { if (xb_ld(&bar[XB_TMO])) break; if (sp > XB_SPIN_CAP) { atomicAdd(&bar[XB_TMO], 1u); break; } }
    }
    nloc = mine > 0u ? mine : 1u; nx = cnt > 0u ? cnt : 1u;
}
DEV void xcd_barrier(const XcdBarrier& b, int tid) {
    asm volatile("s_waitcnt vmcnt(0)" ::: "memory");
    __syncthreads();
    if (tid == 0) {
        unsigned* bar = b.bar;
        __builtin_amdgcn_s_waitcnt(0);
        unsigned nloc = b.st[0], nx = b.st[1];
        if (nloc == 0u) { xcd_barrier_complete(bar, b.x, nloc, nx); b.st[0] = nloc; b.st[1] = nx; }
        const unsigned old = xb_add(&bar[XB_XSUB(b.x)], 1u);
        const unsigned gen = old / nloc;
        if (old + 1u == (gen + 1u) * nloc) {
            __builtin_amdgcn_fence(__ATOMIC_RELEASE, "agent");
            asm volatile("s_waitcnt vmcnt(0)" ::: "memory");
            const unsigned og = xb_add(&bar[XB_TOP], 1u);
            const unsigned tg = og / nx;
            if (og + 1u == (tg + 1u) * nx) xb_add(&bar[XB_TOPGEN], 1u);
            else XB_SPIN(xb_ld(&bar[XB_TOPGEN]) == tg, bar);
            __builtin_amdgcn_fence(__ATOMIC_ACQUIRE, "agent");
            xb_add(&bar[XB_XGEN(b.x)], 1u);
            asm volatile("s_waitcnt vmcnt(0)" ::: "memory");
        } else {
            XB_SPIN(xb_ld(&bar[XB_XGEN(b.x)]) == gen, bar);
            __builtin_amdgcn_fence(__ATOMIC_ACQUIRE, "agent");
            asm volatile("s_waitcnt vmcnt(0)" ::: "memory");
        }
    }
    __syncthreads();
}


using pg8::gelu_t;
struct WaveId { int gw, ngw, wave, lane; };
DEV unsigned f2bf_u(float f) { return (unsigned)f2bf(f); }
DEV unsigned pk2(float lo, float hi) { return cvt_pk_bf16(lo, hi); }

DEV void norm_rows(const WaveId& W, const float* x, const float* g, bf16_t* outb, float* outf, int rows) {
    for (int row = W.gw; row < rows; row += W.ngw) {
        const f32x4* xr = (const f32x4*)(x + (size_t)row * D) + W.lane;
        f32x4 v[4]; float s = 0.f;
#pragma unroll
        for (int j = 0; j < 4; ++j) { v[j] = xr[64 * j]; s += (v[j].x * v[j].x + v[j].y * v[j].y) + (v[j].z * v[j].z + v[j].w * v[j].w); }
        const float r = rsqrtf(wave_sum(s) * (1.f / D) + EPS);
#pragma unroll
        for (int j = 0; j < 4; ++j) {
            const f32x4 gg = ((const f32x4*)g)[W.lane + 64 * j];
            const f32x4 o = {v[j].x * r * gg.x, v[j].y * r * gg.y, v[j].z * r * gg.z, v[j].w * r * gg.w};
            if (outb) { u32x2 w; w.x = pk2(o.x, o.y); w.y = pk2(o.z, o.w); ((u32x2*)(outb + (size_t)row * D))[W.lane + 64 * j] = w; }
            else ((f32x4*)(outf + (size_t)row * D))[W.lane + 64 * j] = o;
        }
    }
}
DEV void cvt_piece(const WaveId& W, LAS float* scr, int& base, const float* Wsrc, int ldw, int K, int col0, int ncols, bf16_t* dst, int ldo, int row0, const float* gain = nullptr) {
    const int nblk = ncols / 32, nitems = (K / 64) * nblk;
    int first = (W.gw - base) % W.ngw; if (first < 0) first += W.ngw;
    base = (base + nitems) % W.ngw;
    for (int item = first; item < nitems; item += W.ngw) {
        const int kb = item / nblk, nb = item - kb * nblk, k0 = 64 * kb, n0 = 32 * nb;
        { const int lr = W.lane >> 3, lc = (W.lane & 7) * 4;
          f32x4 v[8]; float g[8];
#pragma unroll
          for (int i = 0; i < 8; ++i) { v[i] = *(const f32x4*)(Wsrc + (size_t)(k0 + lr + 8 * i) * ldw + col0 + n0 + lc); g[i] = gain ? gain[k0 + lr + 8 * i] : 1.f; }
#pragma unroll
          for (int i = 0; i < 8; ++i) { LAS float* d = scr + (lr + 8 * i) * 33 + lc; d[0] = v[i][0] * g[i]; d[1] = v[i][1] * g[i]; d[2] = v[i][2] * g[i]; d[3] = v[i][3] * g[i]; } }
        LDS_WAIT(); asm volatile("" ::: "memory");
        const int c = W.lane & 7;
#pragma unroll
        for (int j = 0; j < 4; ++j) { const int n = (W.lane >> 3) + 8 * j; const LAS float* s = scr + (8 * c) * 33 + n;
            u32x4 o; o.x = pk2(s[0 * 33], s[1 * 33]); o.y = pk2(s[2 * 33], s[3 * 33]); o.z = pk2(s[4 * 33], s[5 * 33]); o.w = pk2(s[6 * 33], s[7 * 33]);
            *(u32x4*)(dst + (size_t)(row0 + n0 + n) * ldo + k0 + 8 * c) = o; }
        LDS_WAIT(); asm volatile("" ::: "memory");
    }
}
DEV void convert_layer_weights(const WaveId& W, LAS float* scr, int& base, unsigned char* ws, const float* const* in, int l, int part = 3) {
    const float* wi = in[3] + (size_t)l * D * DIN;
    if (part & 1) {
    bf16_t* WIN = (bf16_t*)(ws + WS_WIN); const float* gm = in[2] + l * D;
    cvt_piece(W, scr, base, wi, DIN, D, 0, 1536, WIN, D, 0, gm);
    cvt_piece(W, scr, base, wi, DIN, D, 3072, 1536, WIN, D, 1536, gm);
    cvt_piece(W, scr, base, wi, DIN, D, 4608, 512, WIN, D, 3072, gm);
    cvt_piece(W, scr, base, wi, DIN, D, 1536, 512, WIN, D, 3584, gm);
#pragma unroll 1
    for (int j = 0; j < 4; ++j) { cvt_piece(W, scr, base, wi, DIN, D, 2048 + 128 * j, 128, WIN, D, 4096 + 256 * j, gm); cvt_piece(W, scr, base, wi, DIN, D, 2560 + 128 * j, 128, WIN, D, 4096 + 256 * j + 128, gm); }
    cvt_piece(W, scr, base, wi, DIN, D, 5120, 96, WIN, D, 5120, gm);
    cvt_piece(W, scr, base, wi, DIN, D, 5192, 3072, (bf16_t*)(ws + WS_WG), D, 0, gm);
#pragma unroll 1
    for (int i = 0; i < 3; ++i) cvt_piece(W, scr, base, in[5 + i] + (size_t)l * 512 * D, D, 512, 0, D, (bf16_t*)(ws + WS_WBR) + (size_t)i * D * 512, 512, 0);
    cvt_piece(W, scr, base, in[8] + (size_t)l * D * D, D, D, 0, D, (bf16_t*)(ws + WS_WMIX), D, 0);
    }
    if (!(part & 2)) return;
    const float* gf = in[14] + l * D;
    const float* wf = in[15] + (size_t)l * D * 2 * DFF;
#pragma unroll 1
    for (int j = 0; j < 22; ++j) { cvt_piece(W, scr, base, wf, 2 * DFF, D, 128 * j, 128, (bf16_t*)(ws + WS_WUP), D, 256 * j, gf); cvt_piece(W, scr, base, wf, 2 * DFF, D, DFF + 128 * j, 128, (bf16_t*)(ws + WS_WUP), D, 256 * j + 128, gf); }
    cvt_piece(W, scr, base, in[18] + (size_t)l * DFF * D, D, DFF, 0, D, (bf16_t*)(ws + WS_WDOWN), DFF, 0);
}
DEV void prep0_phase(const WaveId& W, LAS float* scr, unsigned char* ws, const float* const* in, bf16_t* XB) {
    int base = 0;
#pragma unroll 1
    for (int l = 0; l < DEPTH; ++l) {
        const float* wq = in[11] + (size_t)l * D * D; bf16_t* WQ = (bf16_t*)(ws + WS_WQ + (size_t)l * 2 * MiB); const float* gx = in[9] + l * D;
        for (size_t i = (size_t)(W.gw * 64 + W.lane) * 4; i < (size_t)D * D; i += (size_t)W.ngw * 256) { const float g = gx[i >> 10]; const f32x4 v = *(const f32x4*)(wq + i); u32x2 o; o.x = pk2(v.x * g, v.y * g); o.y = pk2(v.z * g, v.w * g); *(u32x2*)(WQ + i) = o; }
        cvt_piece(W, scr, base, in[13] + (size_t)l * D * D, D, D, 0, D, (bf16_t*)(ws + WS_WOT + (size_t)l * 2 * MiB), D, 0);
        cvt_piece(W, scr, base, in[12] + (size_t)l * D * 2 * D, 2 * D, D, 0, 2 * D, (bf16_t*)(ws + WS_WKVT + (size_t)l * 4 * MiB), D, 0);
        norm_rows(W, in[1], in[10] + l * D, (bf16_t*)(ws + WS_MEMN + (size_t)l * MiB), nullptr, NB * MEM);
    }
    convert_layer_weights(W, scr, base, ws, in, 0);
    pg8::u64* ss0 = (pg8::u64*)(ws + WS_SS);
    for (int row0 = W.gw; row0 < T; row0 += 4 * W.ngw) {
        f32x4 v[4][4];
#pragma unroll
        for (int u = 0; u < 4; ++u) { const f32x4* xr = (const f32x4*)(in[0] + (size_t)(row0 + u * W.ngw) * D) + W.lane;
#pragma unroll
            for (int j = 0; j < 4; ++j) v[u][j] = xr[64 * j]; }
#pragma unroll
        for (int u = 0; u < 4; ++u) { const int row = row0 + u * W.ngw; float s = 0.f;
#pragma unroll
            for (int j = 0; j < 4; ++j) { const f32x4 x = v[u][j]; s += (x.x * x.x + x.y * x.y) + (x.z * x.z + x.w * x.w);
                u32x2 w; w.x = pk2(x.x, x.y); w.y = pk2(x.z, x.w); ((u32x2*)(XB + (size_t)row * D))[W.lane + 64 * j] = w; }
            s = wave_sum(s); if (W.lane == 0) ss0[row] = (pg8::u64)(s * pg8::SS_SCALE + 0.5f); }
    }
}
DEV void final_norm(const WaveId& W, const bf16_t* x, float* out, const float* g, const pg8::u64* ss) {
    f32x4 gg[4];
#pragma unroll
    for (int j = 0; j < 4; ++j) gg[j] = ((const f32x4*)g)[W.lane + 64 * j];
    for (int row0 = W.gw; row0 < T; row0 += 4 * W.ngw) {
        u32x2 v[4][4]; pg8::u64 sq[4];
#pragma unroll
        for (int u = 0; u < 4; ++u) { const int row = row0 + u * W.ngw; sq[u] = ss[row]; const u32x2* xr = (const u32x2*)(x + (size_t)row * D) + W.lane;
#pragma unroll
            for (int j = 0; j < 4; ++j) v[u][j] = xr[64 * j]; }
#pragma unroll
        for (int u = 0; u < 4; ++u) { const int row = row0 + u * W.ngw; const float r = rsqrtf((float)sq[u] * (1.f / (pg8::SS_SCALE * D)) + EPS); f32x4* orow = (f32x4*)(out + (size_t)row * D) + W.lane;
#pragma unroll
            for (int j = 0; j < 4; ++j) { const u32x2 w = v[u][j];
                const f32x4 o = {bflo(w.x) * r * gg[j].x, bfhi(w.x) * r * gg[j].y, bflo(w.y) * r * gg[j].z, bfhi(w.y) * r * gg[j].w}; orow[64 * j] = o; } }
    }
}
DEV void conv_sc_phase(int gtid, int gthreads, bf16_t* scb, const bf16_t* cx, const float* w, bool dry) {
    const int c8 = (gtid & 63) * 8;
    const f32x4 w0a = *(const f32x4*)(w + c8), w0b = *(const f32x4*)(w + c8 + 4), w1a = *(const f32x4*)(w + 512 + c8), w1b = *(const f32x4*)(w + 512 + c8 + 4), w2a = *(const f32x4*)(w + 1024 + c8), w2b = *(const f32x4*)(w + 1024 + c8 + 4);
    const u32x4 z = {0u, 0u, 0u, 0u};
    for (int i0 = gtid; i0 < T * 64; i0 += 4 * gthreads) {
        u32x4 x2[4], x1[4], x0[4], bb[4];
#pragma unroll
        for (int u = 0; u < 4; ++u) { const int i = i0 + u * gthreads; if (i < T * 64) { const int t = i >> 6, tl = t & (S - 1); const size_t o = (size_t)t * 512 + c8;
            x2[u] = *(const u32x4*)(cx + o); x1[u] = tl >= 1 ? *(const u32x4*)(cx + o - 512) : z; x0[u] = tl >= 2 ? *(const u32x4*)(cx + o - 1024) : z; bb[u] = *(const u32x4*)(scb + o); } }
#pragma unroll
        for (int u = 0; u < 4; ++u) { const int i = i0 + u * gthreads; if (i < T * 64) { const size_t o = (size_t)(i >> 6) * 512 + c8;
            float r[8];
#define CONV1(k, W0, W1, W2, X0, X1, X2, BBv, F) r[k] = F(BBv) * (W0 * F(X0) + W1 * F(X1) + W2 * F(X2))
            CONV1(0, w0a.x, w1a.x, w2a.x, x0[u].x, x1[u].x, x2[u].x, bb[u].x, bflo); CONV1(1, w0a.y, w1a.y, w2a.y, x0[u].x, x1[u].x, x2[u].x, bb[u].x, bfhi);
            CONV1(2, w0a.z, w1a.z, w2a.z, x0[u].y, x1[u].y, x2[u].y, bb[u].y, bflo); CONV1(3, w0a.w, w1a.w, w2a.w, x0[u].y, x1[u].y, x2[u].y, bb[u].y, bfhi);
            CONV1(4, w0b.x, w1b.x, w2b.x, x0[u].z, x1[u].z, x2[u].z, bb[u].z, bflo); CONV1(5, w0b.y, w1b.y, w2b.y, x0[u].z, x1[u].z, x2[u].z, bb[u].z, bfhi);
            CONV1(6, w0b.z, w1b.z, w2b.z, x0[u].w, x1[u].w, x2[u].w, bb[u].w, bflo); CONV1(7, w0b.w, w1b.w, w2b.w, x0[u].w, x1[u].w, x2[u].w, bb[u].w, bfhi);
#undef CONV1
            u32x4 ov; ov.x = pk2(r[0], r[1]); ov.y = pk2(r[2], r[3]); ov.z = pk2(r[4], r[5]); ov.w = pk2(r[6], r[7]);
            if (!dry) *(u32x4*)(scb + o) = ov; else asm volatile("" :: "v"(ov)); } }
    }
}
DEV void ffn_mid_phase(int gtid, int gthreads, const bf16_t* fa, bf16_t* fu, const float* cw, const float* cb, bool dry) {
    constexpr int C8 = DFF / 8;
    for (int i = gtid; i < T * C8; i += gthreads) {
        const int t = i / C8, c8 = (i - t * C8) * 8, tl = t & (S - 1);
        const size_t o = (size_t)t * DFF + c8;
        const u32x4 z = {0u, 0u, 0u, 0u};
        const u32x4 x2 = *(const u32x4*)(fa + o), x1 = tl >= 1 ? *(const u32x4*)(fa + o - DFF) : z, x0 = tl >= 2 ? *(const u32x4*)(fa + o - 2 * DFF) : z, uu = *(const u32x4*)(fu + o);
        const f32x4 w0a = *(const f32x4*)(cw + c8), w0b = *(const f32x4*)(cw + c8 + 4), w1a = *(const f32x4*)(cw + DFF + c8), w1b = *(const f32x4*)(cw + DFF + c8 + 4), w2a = *(const f32x4*)(cw + 2 * DFF + c8), w2b = *(const f32x4*)(cw + 2 * DFF + c8 + 4);
        const f32x4 ba = *(const f32x4*)(cb + c8), bb = *(const f32x4*)(cb + c8 + 4);
        float r[8];
#define FM1(k, B0, W0, W1, W2, X0, X1, X2, Uv, F) r[k] = gelu_t(B0 + W0 * F(X0) + W1 * F(X1) + W2 * F(X2)) * F(Uv)
        FM1(0, ba.x, w0a.x, w1a.x, w2a.x, x0.x, x1.x, x2.x, uu.x, bflo); FM1(1, ba.y, w0a.y, w1a.y, w2a.y, x0.x, x1.x, x2.x, uu.x, bfhi);
        FM1(2, ba.z, w0a.z, w1a.z, w2a.z, x0.y, x1.y, x2.y, uu.y, bflo); FM1(3, ba.w, w0a.w, w1a.w, w2a.w, x0.y, x1.y, x2.y, uu.y, bfhi);
        FM1(4, bb.x, w0b.x, w1b.x, w2b.x, x0.z, x1.z, x2.z, uu.z, bflo); FM1(5, bb.y, w0b.y, w1b.y, w2b.y, x0.z, x1.z, x2.z, uu.z, bfhi);
        FM1(6, bb.z, w0b.z, w1b.z, w2b.z, x0.w, x1.w, x2.w, uu.w, bflo); FM1(7, bb.w, w0b.w, w1b.w, w2b.w, x0.w, x1.w, x2.w, uu.w, bfhi);
#undef FM1
        u32x4 ov; ov.x = pk2(r[0], r[1]); ov.y = pk2(r[2], r[3]); ov.z = pk2(r[4], r[5]); ov.w = pk2(r[6], r[7]);
        if (!dry) *(u32x4*)(fu + o) = ov; else asm volatile("" :: "v"(ov));
    }
}

DEV void ffn_fix_phase(int gtid, int gthreads, const bf16_t* sa, const bf16_t* su, bf16_t* fu, const float* cw, const float* cb, int strip0 = 0, int nstrip = T / 64) {
    constexpr int C8 = DFF / 8;
    for (int i = gtid; i < nstrip * 2 * C8; i += gthreads) {
        const int sr = i / C8, c8 = (i - sr * C8) * 8, strip = strip0 + (sr >> 1), rr = sr & 1, t = strip * 64 + rr;
        const bool first = (strip & (S / 64 - 1)) == 0;
        const u32x4 z = {0u, 0u, 0u, 0u};
        const bf16_t* A = sa + (size_t)strip * 4 * DFF + c8; const bf16_t* Ap = A - 4 * DFF;
        const u32x4 x2 = *(const u32x4*)(A + rr * DFF);
        const u32x4 x1 = rr == 1 ? *(const u32x4*)A : (first ? z : *(const u32x4*)(Ap + 3 * DFF));
        const u32x4 x0 = first ? z : *(const u32x4*)(Ap + (2 + rr) * DFF);
        const u32x4 uu = *(const u32x4*)(su + ((size_t)strip * 2 + rr) * DFF + c8);
        const f32x4 w0a = *(const f32x4*)(cw + c8), w0b = *(const f32x4*)(cw + c8 + 4), w1a = *(const f32x4*)(cw + DFF + c8), w1b = *(const f32x4*)(cw + DFF + c8 + 4), w2a = *(const f32x4*)(cw + 2 * DFF + c8), w2b = *(const f32x4*)(cw + 2 * DFF + c8 + 4);
        const f32x4 ba = *(const f32x4*)(cb + c8), bb = *(const f32x4*)(cb + c8 + 4);
        float r[8];
#define FM1(k, B0, W0, W1, W2, X0, X1, X2, Uv, F) r[k] = gelu_t(B0 + W0 * F(X0) + W1 * F(X1) + W2 * F(X2)) * F(Uv)
        FM1(0, ba.x, w0a.x, w1a.x, w2a.x, x0.x, x1.x, x2.x, uu.x, bflo); FM1(1, ba.y, w0a.y, w1a.y, w2a.y, x0.x, x1.x, x2.x, uu.x, bfhi);
        FM1(2, ba.z, w0a.z, w1a.z, w2a.z, x0.y, x1.y, x2.y, uu.y, bflo); FM1(3, ba.w, w0a.w, w1a.w, w2a.w, x0.y, x1.y, x2.y, uu.y, bfhi);
        FM1(4, bb.x, w0b.x, w1b.x, w2b.x, x0.z, x1.z, x2.z, uu.z, bflo); FM1(5, bb.y, w0b.y, w1b.y, w2b.y, x0.z, x1.z, x2.z, uu.z, bfhi);
        FM1(6, bb.z, w0b.z, w1b.z, w2b.z, x0.w, x1.w, x2.w, uu.w, bflo); FM1(7, bb.w, w0b.w, w1b.w, w2b.w, x0.w, x1.w, x2.w, uu.w, bfhi);
#undef FM1
        u32x4 ov; ov.x = pk2(r[0], r[1]); ov.y = pk2(r[2], r[3]); ov.z = pk2(r[4], r[5]); ov.w = pk2(r[6], r[7]);
        *(u32x4*)(fu + (size_t)t * DFF + c8) = ov;
    }
}

typedef short s16x4 __attribute__((ext_vector_type(4)));
DEV s16x4 vtr(const LAS unsigned char* p) { return __builtin_bit_cast(s16x4, __builtin_amdgcn_ds_read_tr16_b64_v4i16((LAS s16x4*)p)); }
DEV bf16x8 cat8(const s16x4 a, const s16x4 b) { return (bf16x8){a[0], a[1], a[2], a[3], b[0], b[1], b[2], b[3]}; }
DEV bf16x8 pk8(float a0, float a1, float a2, float a3, float a4, float a5, float a6, float a7) {
    u32x4 w; w.x = pk2(a0, a1); w.y = pk2(a2, a3); w.z = pk2(a4, a5); w.w = pk2(a6, a7); return __builtin_bit_cast(bf16x8, w); }
constexpr int VPITCH = 192;
DEV void pv_tile(f32x16& o0, f32x16& o1, const LAS unsigned char* vt, int lane, const bf16x8 (&pk)[4]) {
    const int hi = lane >> 5;
    const LAS unsigned char* vb = vt + (4 * hi + ((lane & 15) >> 2)) * VPITCH + ((lane >> 4) & 1) * 32 + (lane & 3) * 8;
    bf16x8 va[4];
#pragma unroll
    for (int ks = 0; ks < 4; ++ks) va[ks] = cat8(vtr(vb + (16 * ks) * VPITCH), vtr(vb + (16 * ks + 8) * VPITCH));
    asm volatile("" : "+v"(va[0]), "+v"(va[1]), "+v"(va[2]), "+v"(va[3]));
#pragma unroll
    for (int ks = 0; ks < 4; ++ks) o0 = __builtin_amdgcn_mfma_f32_32x32x16_bf16(va[ks], pk[ks], o0, 0, 0, 0);
#pragma unroll
    for (int ks = 0; ks < 4; ++ks) va[ks] = cat8(vtr(vb + (16 * ks) * VPITCH + 64), vtr(vb + (16 * ks + 8) * VPITCH + 64));
    asm volatile("" : "+v"(va[0]), "+v"(va[1]), "+v"(va[2]), "+v"(va[3]));
#pragma unroll
    for (int ks = 0; ks < 4; ++ks) o1 = __builtin_amdgcn_mfma_f32_32x32x16_bf16(va[ks], pk[ks], o1, 0, 0, 0);
}
DEV void store_ot(bf16_t* orow, const f32x16& o0, const f32x16& o1, int hi, float sc) {
#pragma unroll
    for (int g4 = 0; g4 < 4; ++g4) {
        u32x2 a; a.x = pk2(o0[4 * g4] * sc, o0[4 * g4 + 1] * sc); a.y = pk2(o0[4 * g4 + 2] * sc, o0[4 * g4 + 3] * sc);
        u32x2 b; b.x = pk2(o1[4 * g4] * sc, o1[4 * g4 + 1] * sc); b.y = pk2(o1[4 * g4 + 2] * sc, o1[4 * g4 + 3] * sc);
        *(u32x2*)(orow + 8 * g4 + 4 * hi) = a; *(u32x2*)(orow + 32 + 8 * g4 + 4 * hi) = b;
    }
}

DEV void sb_item(LAS unsigned char* vl, const bf16_t* Q, const bf16_t* Kk, const bf16_t* V, bf16_t* O, int b, int h, int qb, int lane, bool dry) {
    const int r32 = lane & 31, hi = lane >> 5, t0 = 32 * qb, t = t0 + r32; const size_t rowb = (size_t)b * S;
    bf16x8 qr[4]; { const bf16_t* qp = Q + (rowb + t0 + r32) * 512 + h * 64 + 8 * hi;
#pragma unroll
        for (int d0 = 0; d0 < 4; ++d0) qr[d0] = *(const bf16x8*)(qp + 16 * d0); }
    f32x16 o0, o1;
#pragma unroll
    for (int r = 0; r < 16; ++r) { o0[r] = 0.f; o1[r] = 0.f; }
    float carry = 1.f;
    const int c_hi = (t0 + 30) >> 6;
#pragma unroll 1
    for (int c = c_hi; c >= 0; --c) {
        const bf16_t* kp = Kk + (rowb + 64 * c + r32) * 512 + h * 64 + 8 * hi;
        bf16x8 k0[4], k1[4];
#pragma unroll
        for (int d0 = 0; d0 < 4; ++d0) { k0[d0] = *(const bf16x8*)(kp + 16 * d0); k1[d0] = *(const bf16x8*)(kp + (size_t)32 * 512 + 16 * d0); }
#pragma unroll
        for (int j = 0; j < 8; ++j) { const int row = (lane >> 3) + 8 * j; *(LAS u32x4*)(vl + row * VPITCH + (lane & 7) * 16) = *(const u32x4*)(V + (rowb + 64 * c + row) * 512 + h * 64 + (lane & 7) * 8); }
        f32x16 p0, p1;
#pragma unroll
        for (int r = 0; r < 16; ++r) { p0[r] = 0.f; p1[r] = 0.f; }
#pragma unroll
        for (int d0 = 0; d0 < 4; ++d0) { p0 = __builtin_amdgcn_mfma_f32_32x32x16_bf16(k0[d0], qr[d0], p0, 0, 0, 0); p1 = __builtin_amdgcn_mfma_f32_32x32x16_bf16(k1[d0], qr[d0], p1, 0, 0, 0); }
        float u[32];
        const bool diag = (c == c_hi);
#pragma unroll
        for (int e = 0; e < 32; ++e) {
            const float z = e < 16 ? p0[e] : p1[e - 16];
            float uu = __builtin_amdgcn_rcpf(1.f + __builtin_amdgcn_exp2f(fminf(z, 126.f)));
            if (diag) { const int kv = 64 * c + 8 * ((e >> 2) & 3) + 4 * hi + (e & 3) + 32 * (e >> 4); if (kv >= t) uu = 1.f; }
            u[e] = uu;
        }
        float gl[8], gh[8];
#pragma unroll
        for (int i = 0; i < 8; ++i) { const float gp = (u[4 * i] * u[4 * i + 1]) * (u[4 * i + 2] * u[4 * i + 3]);
            const auto rr = __builtin_amdgcn_permlane32_swap(__float_as_uint(gp), __float_as_uint(gp), false, false); gl[i] = __uint_as_float(rr[0]); gh[i] = __uint_as_float(rr[1]); }
        float ag[8]; float run = carry;
#pragma unroll
        for (int i = 7; i >= 0; --i) { const float a_hi = run; run *= gh[i]; const float a_lo = run; run *= gl[i]; ag[i] = hi ? a_hi : a_lo; }
        carry = run;
        bf16x8 pk[4];
#pragma unroll
        for (int ks = 0; ks < 4; ++ks) { float w[8];
#pragma unroll
            for (int g = 0; g < 2; ++g) { const int i = 2 * ks + g;
                const float a3 = ag[i], a2 = a3 * u[4 * i + 3], a1 = a2 * u[4 * i + 2], a0 = a1 * u[4 * i + 1];
                w[4 * g] = (1.f - u[4 * i]) * a0; w[4 * g + 1] = (1.f - u[4 * i + 1]) * a1; w[4 * g + 2] = (1.f - u[4 * i + 2]) * a2; w[4 * g + 3] = (1.f - u[4 * i + 3]) * a3; }
            pk[ks] = pk8(w[0], w[1], w[2], w[3], w[4], w[5], w[6], w[7]); }
        pv_tile(o0, o1, vl, lane, pk);
        if (__all(carry < 7.8e-31f)) break;
    }
    if (!dry) store_ot(O + (rowb + t0 + r32) * 512 + h * 64, o0, o1, hi, 1.f); else asm volatile("" :: "v"(o0), "v"(o1));
}
DEV void sb_phase(const WaveId& W, LAS unsigned char* lds, unsigned char* ws, bool dry) {
    LAS unsigned char* vl = lds + W.wave * 12288;
    const bf16_t* Q = (const bf16_t*)(ws + WS_QA); const bf16_t* Kk = (const bf16_t*)(ws + WS_KA); const bf16_t* V = (const bf16_t*)(ws + WS_VA);
    constexpr int NITEM = NB * 8 * (S / 32);
    for (int it = W.gw; it < NITEM; it += W.ngw) {
        const int qb = it & 255, h = (it >> 8) & 7, b = it >> 11;
        sb_item(vl, Q, Kk, V, (bf16_t*)(ws + WS_QA), b, h, qb, W.lane, dry);
    }
}

constexpr int IDX_CTL_OFF = 131072 + 1024;
DEV unsigned fkey2(float v) { const int u = (int)__float_as_uint(v); return (unsigned)(u ^ ((u >> 31) | (int)0x80000000)); }
DEV float relu1(float x) { return __builtin_amdgcn_fmed3f(x, 0.f, 3.0e38f); }
DEV void idx_prefetch(bf16x8 (&afr)[4], float (&w)[16], bf16x8 (&b0)[4], bf16x8 (&b1)[4], const bf16_t* IQ, const bf16_t* IK, const float* IWp, int b, int t0, int wid, int lane) {
    const int r32 = lane & 31, hh = lane >> 5; const size_t rowb = (size_t)b * S;
    { const int qi = 2 * (r32 >> 4) + ((r32 >> 2) & 1), head = (r32 & 3) + 4 * ((r32 >> 3) & 1);
        const bf16_t* ap = IQ + (rowb + t0 + qi) * 512 + head * 64 + 8 * hh;
#pragma unroll
        for (int ks = 0; ks < 4; ++ks) afr[ks] = *(const bf16x8*)(ap + 16 * ks); }
#pragma unroll
    for (int r = 0; r < 16; ++r) w[r] = IWp[(rowb + t0 + 2 * (r >> 3) + hh) * 8 + (r & 7)];
    const int jmax = (t0 + 3) >> 5;
    { const int j0 = wid < jmax ? wid : jmax, j1 = wid + 8 < jmax ? wid + 8 : jmax;
      const bf16_t* p0 = IK + ((rowb >> 5) + j0) * 2048 + (hh * 32 + r32) * 8; const bf16_t* p1 = IK + ((rowb >> 5) + j1) * 2048 + (hh * 32 + r32) * 8;
#pragma unroll
      for (int ks = 0; ks < 4; ++ks) { b0[ks] = *(const bf16x8*)(p0 + ks * 512); b1[ks] = *(const bf16x8*)(p1 + ks * 512); } }
}
DEV void idx_unit(LAS unsigned char* lds, const bf16_t* IQ, const bf16_t* IK, const float* IWp, unsigned* BM, int b, int t0, int nb, int nt0, int wid, int lane,
                  bf16x8 (&afr)[4], float (&w)[16], bf16x8 (&b0)[4], bf16x8 (&b1)[4]) {
    const int r32 = lane & 31, hh = lane >> 5; const size_t rowb = (size_t)b * S;
    const int tmax = t0 + 3, jmax = tmax >> 5;
    LAS unsigned* SCO = (LAS unsigned*)lds;
    bf16x8 b2[4];
#pragma unroll
    for (int ks = 0; ks < 4; ++ks) b2[ks] = afr[ks];
#define IDX_LOADB(dst, jj) do { const int jc_ = (jj) < jmax ? (jj) : jmax; const bf16_t* bp_ = IK + ((rowb >> 5) + jc_) * 2048 + (hh * 32 + r32) * 8; \
        _Pragma("unroll") for (int ks = 0; ks < 4; ++ks) dst[ks] = *(const bf16x8*)(bp_ + ks * 512); } while (0)
#define IDX_COMP(src, jj) do { f32x16 acc; _Pragma("unroll") for (int r = 0; r < 16; ++r) acc[r] = 0.f; \
        _Pragma("unroll") for (int ks = 0; ks < 4; ++ks) acc = __builtin_amdgcn_mfma_f32_32x32x16_bf16(afr[ks], src[ks], acc, 0, 0, 0); \
        float s0 = 0.f, s1 = 0.f; _Pragma("unroll") for (int hd = 0; hd < 8; ++hd) { s0 += w[hd] * relu1(acc[hd]); s1 += w[8 + hd] * relu1(acc[8 + hd]); } \
        unsigned k0_ = fkey2(s0), k1_ = fkey2(s1); const int key = 32 * (jj) + r32; \
        if ((jj) >= jmax) { k0_ = key <= t0 + hh ? k0_ : 0u; k1_ = key <= t0 + 2 + hh ? k1_ : 0u; }     \
        if ((jj) <= jmax) { SCO[hh * 8192 + key] = k0_; SCO[(2 + hh) * 8192 + key] = k1_; } } while (0)
#ifndef IDX_REP_MFMA
#define IDX_REP_MFMA 1
#endif
#ifndef IDX_REP_SEL
#define IDX_REP_SEL 1
#endif
#ifdef IDX_DRY_COMPUTE
#pragma unroll 1
    for (int j = wid; j <= jmax; j += 24) { IDX_COMP(b0, j); asm volatile("" : "+v"(b0[0]), "+v"(b1[0]), "+v"(b2[0])); IDX_COMP(b1, j + 8); IDX_COMP(b2, j + 16); }
#endif
#pragma unroll 1
    for (int rpm = 0; rpm < IDX_REP_MFMA; ++rpm) {
#pragma unroll 1
    for (int j = wid; j <= jmax; j += 24) {
        IDX_LOADB(b2, j + 16); IDX_COMP(b0, j);
        IDX_LOADB(b0, j + 24); IDX_COMP(b1, j + 8);
        IDX_LOADB(b1, j + 32); IDX_COMP(b2, j + 16);
    }
    }
#undef IDX_LOADB
#undef IDX_COMP
    if (nt0 >= 0) idx_prefetch(afr, w, b0, b1, IQ, IK, IWp, nb, nt0, wid, lane);
    LAS unsigned* thr = (LAS unsigned*)(lds + IDX_CTL_OFF);
    if (wid == 0 && lane < 32) ((LAS unsigned*)(lds + IDX_CTL_OFF + 64))[lane] = 0u;
    LDS_WAIT(); __builtin_amdgcn_s_barrier(); asm volatile("" ::: "memory");
    {
        const int q = wid & 3, h = wid >> 2, n = t0 + q + 1;
        volatile LAS unsigned* xme = (volatile LAS unsigned*)(lds + IDX_CTL_OFF + 64) + (q * 2 + h) * 4;
        volatile LAS unsigned* xpa = (volatile LAS unsigned*)(lds + IDX_CTL_OFF + 64) + (q * 2 + (h ^ 1)) * 4;
        unsigned T_ = 1u;
        if (n > 256) {
            LAS unsigned* row = SCO + q * 8192 + lane;
            unsigned r[64];
            const int nil = (jmax >> 1) >= h ? (((jmax >> 1) - h) >> 1) + 1 : 0;
#define IDX_FOR_LIVE(BODY) _Pragma("unroll") for (int g8_ = 0; g8_ < 8; ++g8_) if (8 * g8_ < nil) { _Pragma("unroll") for (int u8_ = 0; u8_ < 8; ++u8_) { const int il = 8 * g8_ + u8_; BODY } }
            IDX_FOR_LIVE( r[il] = (2 * (2 * il + h) + hh <= jmax) ? row[64 * (2 * il + h)] : 0u; )
            unsigned seq = 0u;
#define IDX_XCHG(val, out) do { ++seq; const int pb_ = (seq & 1u) * 2; if (lane == 0) { xme[pb_ + 1] = (val); xme[pb_] = seq; } \
                while (xpa[pb_] != seq) __builtin_amdgcn_s_sleep(0); (out) = xpa[pb_ + 1]; } while (0)
#define IDX_XCHG16(val, out) do { ++seq; const int pb_ = (seq & 1u) * 2; if (lane == 0) xme[pb_] = (seq << 16) | (val); unsigned w_; \
                while (((w_ = xpa[pb_]) >> 16) != (seq & 0xffffu)) __builtin_amdgcn_s_sleep(0); (out) = w_ & 0xffffu; } while (0)
#pragma unroll 1
            for (int rps = 0; rps < IDX_REP_SEL; ++rps) {
            unsigned mx = 0u;
            IDX_FOR_LIVE( mx = max(mx, r[il]); )
#pragma unroll
            for (int o = 1; o < 64; o <<= 1) mx = max(mx, (unsigned)__shfl_xor((int)mx, o));
            { unsigned pm_; IDX_XCHG(mx, pm_); mx = max(mx, pm_); }
            unsigned lo_ = 1u, hi_ = mx + 1u, chi_ = 0u, xgt_ = 1u, xeq_ = 0u, mt_ = 0u; float glo_ = __log2f((float)n) - 8.f, ghi_ = -9.f; int side_ = 0; bool done_ = false;
#pragma unroll 1
            for (int pass = 0; pass < 2 && !done_; ++pass) {
                const unsigned wdt = hi_ - lo_;
                unsigned off;
                if (pass < 2) {
                    const unsigned mkey = hi_ - 1u; const unsigned tgt = pass == 0 ? mkey - (1u << 23) : mkey - (3u << 23);
                    const bool ok = pass == 0 ? (mkey > 0x81000000u) : (mkey > 0x82000000u && tgt > lo_ && tgt < hi_);
                    off = ok ? tgt - lo_ : wdt >> 1;
                } else if ((pass & 3) == 3) off = wdt >> 1;
                else off = (unsigned)(glo_ * __builtin_amdgcn_rcpf(glo_ - ghi_) * (float)wdt);
                off = off < 1u ? 1u : (off > wdt - 1u ? wdt - 1u : off);
                const unsigned cand = (unsigned)__builtin_amdgcn_readfirstlane((int)(lo_ + off));
                unsigned ca_ = 0, cb_ = 0; const unsigned candv = lo_ + off;
#define IDX_CNT4(A, B, C, Dd) asm volatile("v_cmp_ge_u32_e64 s[88:89], %2, %6\n\tv_cmp_ge_u32_e64 s[90:91], %3, %6\n\tv_cmp_ge_u32_e64 s[92:93], %4, %6\n\tv_cmp_ge_u32_e64 s[94:95], %5, %6\n\t" \
                    "v_addc_co_u32_e64 %0, s[88:89], %0, 0, s[88:89]\n\tv_addc_co_u32_e64 %1, s[90:91], %1, 0, s[90:91]\n\tv_addc_co_u32_e64 %0, s[92:93], %0, 0, s[92:93]\n\tv_addc_co_u32_e64 %1, s[94:95], %1, 0, s[94:95]" \
                    : "+v"(ca_), "+v"(cb_) : "v"(A), "v"(B), "v"(C), "v"(Dd), "v"(candv) : "s88", "s89", "s90", "s91", "s92", "s93", "s94", "s95")
#pragma unroll
                for (int g8_ = 0; g8_ < 8; ++g8_) if (8 * g8_ < nil) { IDX_CNT4(r[8 * g8_], r[8 * g8_ + 1], r[8 * g8_ + 2], r[8 * g8_ + 3]); IDX_CNT4(r[8 * g8_ + 4], r[8 * g8_ + 5], r[8 * g8_ + 6], r[8 * g8_ + 7]); }
#undef IDX_CNT4
                int pk = (int)(ca_ + cb_);
                pk += __builtin_amdgcn_update_dpp(0, pk, 0x111, 0xf, 0xf, false);
                pk += __builtin_amdgcn_update_dpp(0, pk, 0x112, 0xf, 0xf, false);
                pk += __builtin_amdgcn_update_dpp(0, pk, 0x114, 0xf, 0xf, false);
                pk += __builtin_amdgcn_update_dpp(0, pk, 0x118, 0xf, 0xf, false);
                pk += __builtin_amdgcn_update_dpp(0, pk, 0x142, 0xa, 0xf, false);
                unsigned tot = (unsigned)__builtin_amdgcn_readlane(pk, 31) + (unsigned)__builtin_amdgcn_readlane(pk, 63);
                { unsigned pt_; IDX_XCHG16(tot, pt_); tot += pt_; }
                const float gc = __log2f(fmaxf((float)tot, 0.5f)) - 8.f;
                if (tot == 256u) { xgt_ = cand; mt_ = 0u; done_ = true; }
                else { if (tot > 256u) { if (side_ == 1) ghi_ *= 0.5f; lo_ = cand; glo_ = gc; side_ = 1; }
                       else { if (side_ == 2) glo_ *= 0.5f; hi_ = cand; ghi_ = gc; chi_ = tot; side_ = 2; }
                       if (hi_ - lo_ == 1u) { xgt_ = hi_; xeq_ = lo_; mt_ = 256u - chi_; done_ = true; } }
            }
            { LAS unsigned* hist = (LAS unsigned*)(lds + IDX_CTL_OFF + 1024) + q * 256;
#pragma unroll 1
              for (int round = 0; round < 6 && !done_; ++round) {
                const unsigned wdt = hi_ - lo_;
                const int sh = wdt <= 256u ? 0 : 24 - (int)__builtin_clz(wdt - 1u);
                hist[128 * h + lane] = 0u; hist[128 * h + 64 + lane] = 0u;
                LDS_WAIT(); { unsigned d_; IDX_XCHG16(0u, d_); (void)d_; }
                const unsigned lov = lo_;
                if (round == 0) {
                    IDX_FOR_LIVE( const unsigned d = r[il] - lov; if (d < wdt) __hip_atomic_fetch_add(hist + (d >> sh), 1u, __ATOMIC_RELAXED, __HIP_MEMORY_SCOPE_WORKGROUP); )
                } else {
#pragma unroll
                    for (int g8_ = 0; g8_ < 8; ++g8_) if (8 * g8_ < nil) {
#pragma unroll
                        for (int u4_ = 0; u4_ < 2; ++u4_) { const int il = 8 * g8_ + 4 * u4_;
                            const unsigned d0 = r[il] - lov, d1 = r[il + 1] - lov, d2 = r[il + 2] - lov, d3 = r[il + 3] - lov;
                            if (min(min(d0, d1), min(d2, d3)) < wdt) {
                                if (d0 < wdt) __hip_atomic_fetch_add(hist + (d0 >> sh), 1u, __ATOMIC_RELAXED, __HIP_MEMORY_SCOPE_WORKGROUP);
                                if (d1 < wdt) __hip_atomic_fetch_add(hist + (d1 >> sh), 1u, __ATOMIC_RELAXED, __HIP_MEMORY_SCOPE_WORKGROUP);
                                if (d2 < wdt) __hip_atomic_fetch_add(hist + (d2 >> sh), 1u, __ATOMIC_RELAXED, __HIP_MEMORY_SCOPE_WORKGROUP);
                                if (d3 < wdt) __hip_atomic_fetch_add(hist + (d3 >> sh), 1u, __ATOMIC_RELAXED, __HIP_MEMORY_SCOPE_WORKGROUP); } } }
                }
                LDS_WAIT(); { unsigned d_; IDX_XCHG16(0u, d_); (void)d_; }
                const u32x4 hb = *(const LAS u32x4*)(hist + 4 * lane);
                const unsigned s4 = (hb.x + hb.y) + (hb.z + hb.w);
                unsigned suf = s4;
#pragma unroll
                for (int o = 1; o < 64; o <<= 1) { const unsigned tv = (unsigned)__shfl_down((int)suf, o); if (lane + o < 64) suf += tv; }
                const unsigned long long okm = __ballot(chi_ + suf >= 256u);
                const int L = 63 - (int)__builtin_clzll(okm);
                const unsigned above = chi_ + (unsigned)__builtin_amdgcn_readlane((int)(suf - s4), L);
                const unsigned h0 = (unsigned)__builtin_amdgcn_readlane((int)hb.x, L), h1 = (unsigned)__builtin_amdgcn_readlane((int)hb.y, L),
                               h2 = (unsigned)__builtin_amdgcn_readlane((int)hb.z, L), h3 = (unsigned)__builtin_amdgcn_readlane((int)hb.w, L);
                unsigned Bsel, cab, cnb;
                if (above + h3 >= 256u) { Bsel = 3u; cab = above; cnb = h3; }
                else if (above + h3 + h2 >= 256u) { Bsel = 2u; cab = above + h3; cnb = h2; }
                else if (above + h3 + h2 + h1 >= 256u) { Bsel = 1u; cab = above + h3 + h2; cnb = h1; }
                else { Bsel = 0u; cab = above + h3 + h2 + h1; cnb = h0; }
                Bsel += 4u * (unsigned)L;
                const unsigned nlo = lo_ + (Bsel << sh); unsigned nhi = nlo + (1u << sh); if (nhi > hi_ || nhi < nlo) nhi = hi_;
                if (cab + cnb == 256u) { xgt_ = nlo; mt_ = 0u; done_ = true; }
                else if (sh == 0) { xgt_ = nlo + 1u; xeq_ = nlo; mt_ = 256u - cab; done_ = true; }
                else { lo_ = nlo; hi_ = nhi; chi_ = cab; }
              } }
#ifdef IDX_XTRA
#pragma unroll 1
            for (int xr = 0; xr < IDX_XTRA; ++xr) { unsigned dsum = 0; const unsigned cv = xgt_ + (unsigned)xr;
                IDX_FOR_LIVE( dsum += r[il] >= cv; )
                int pk = (int)dsum;
                pk += __builtin_amdgcn_update_dpp(0, pk, 0x111, 0xf, 0xf, false); pk += __builtin_amdgcn_update_dpp(0, pk, 0x112, 0xf, 0xf, false); pk += __builtin_amdgcn_update_dpp(0, pk, 0x114, 0xf, 0xf, false);
                pk += __builtin_amdgcn_update_dpp(0, pk, 0x118, 0xf, 0xf, false); pk += __builtin_amdgcn_update_dpp(0, pk, 0x142, 0xa, 0xf, false);
                unsigned tot = (unsigned)__builtin_amdgcn_readlane(pk, 31) + (unsigned)__builtin_amdgcn_readlane(pk, 63);
                { unsigned pt_; IDX_XCHG16(tot, pt_); tot += pt_; } asm volatile("" :: "s"(tot)); }
#endif
            T_ = xgt_;
            if (mt_ != 0u) {
                if (h == 0) { unsigned run = 0u;
#pragma unroll 1
                    for (int i = 0; i <= (jmax >> 1); ++i) { const bool ok_ = 2 * i + hh <= jmax; const unsigned kv = ok_ ? row[64 * i] : 0u; const bool eq = kv == xeq_; const unsigned long long bm = __ballot(eq);
                        const unsigned rank = run + __builtin_amdgcn_mbcnt_hi((unsigned)(bm >> 32), __builtin_amdgcn_mbcnt_lo((unsigned)bm, 0u));
                        if (eq && rank >= mt_) row[64 * i] = 0u;
                        run += (unsigned)__popcll(bm); } }
                T_ = xeq_;
            }
            }
#undef IDX_XCHG
#undef IDX_XCHG16
#undef IDX_FOR_LIVE
        }
        if (lane == 0 && h == 0) thr[q] = T_;
    }
#ifdef PROBE_VALU
    { float a0 = (float)lane, a1 = a0 + 1.f, a2 = a0 + 2.f, a3 = a0 + 3.f, a4 = a0 + 4.f, a5 = a0 + 5.f, a6 = a0 + 6.f, a7 = a0 + 7.f; const float m = 1.0000001f, c = 1e-9f;
#pragma unroll 1
      for (int it = 0; it < 64; ++it) {
#pragma unroll
          for (int u = 0; u < 8; ++u) { a0 = a0 * m + c; a1 = a1 * m + c; a2 = a2 * m + c; a3 = a3 * m + c; a4 = a4 * m + c; a5 = a5 * m + c; a6 = a6 * m + c; a7 = a7 * m + c; } }
      asm volatile("" :: "v"(a0), "v"(a1), "v"(a2), "v"(a3), "v"(a4), "v"(a5), "v"(a6), "v"(a7)); }
#endif
    LDS_WAIT(); __builtin_amdgcn_s_barrier(); asm volatile("" ::: "memory");
    { const unsigned tq0 = thr[hh], tq1 = thr[2 + hh];
#pragma unroll 4
      for (int j = wid; j <= ((t0 | 255) >> 5); j += 8) {
          bool s0 = false, s1 = false;
          if (j <= jmax) { s0 = SCO[hh * 8192 + 32 * j + r32] >= tq0; s1 = SCO[(2 + hh) * 8192 + 32 * j + r32] >= tq1; }
          const unsigned long long b0_ = __ballot(s0), b1_ = __ballot(s1);
          if (lane == 0) { u32x4 o; o.x = (unsigned)b0_; o.y = (unsigned)(b0_ >> 32); o.z = (unsigned)b1_; o.w = (unsigned)(b1_ >> 32); *(u32x4*)(BM + ((size_t)b * 256 + j) * S + t0) = o; }
      } }
    LDS_WAIT(); __builtin_amdgcn_s_barrier();
}
DEV void idx_phase(LAS unsigned char* lds, unsigned char* ws, int vcu, int G, int wid, int lane) {
    constexpr int NUNIT = T / 4;
    const bf16_t* IQ = (const bf16_t*)(ws + WS_IQ); const bf16_t* IK = (const bf16_t*)(ws + WS_IK); const float* IW = (const float*)(ws + WS_IW);
#define IDX_UNIT_OF(k) ((k) * G + (((k) & 1) ? G - 1 - vcu : vcu))
    bf16x8 afr[4], b0[4], b1[4]; float w[16];
    int un = IDX_UNIT_OF(0);
    if (un < NUNIT) { const int b = un / (S / 4); idx_prefetch(afr, w, b0, b1, IQ, IK, IW, b, (un - b * (S / 4)) * 4, wid, lane); }
#pragma unroll 1
    for (int k = 0; un < NUNIT; ++k) {
        const int b = un / (S / 4), t0 = (un - b * (S / 4)) * 4;
        const int nun = IDX_UNIT_OF(k + 1); const int nb = nun / (S / 4), nt0 = nun < NUNIT ? (nun - nb * (S / 4)) * 4 : -1;
        idx_unit(lds, IQ, IK, IW, (unsigned*)(ws + WS_BM), b, t0, nb, nt0, wid, lane, afr, w, b0, b1);
        un = nun;
    }
#undef IDX_UNIT_OF
}

DEV void kn_phase(const WaveId& W, const bf16_t* Kk, float* KN) {
    for (int item = W.gw; item < NB * 8 * (S / 64); item += W.ngw) {
        const int b = item / (8 * (S / 64)), h = (item / (S / 64)) & 7, tile = item % (S / 64);
        const bf16_t* kp = Kk + ((size_t)b * S + tile * 64 + W.lane) * 512 + h * 64;
        float ss = 0.f;
#pragma unroll
        for (int c = 0; c < 8; ++c) { const u32x4 v = *(const u32x4*)(kp + 8 * c);
#pragma unroll
            for (int e = 0; e < 4; ++e) { const float lo = __uint_as_float(v[e] << 16), hi = __uint_as_float(v[e] & 0xffff0000u); ss += lo * lo + hi * hi; } }
        const float m = wave_max(ss);
        if (W.lane == 0) KN[item] = sqrtf(m) * 1.01f;
    }
}

constexpr int DSA_STAGE = 8192 + 64 * VPITCH;
DEV void dsa_unit(LAS unsigned char* lds, const bf16_t* Q, const bf16_t* Kk, const bf16_t* V, const unsigned* BM, const float* KN, bf16_t* O, int b, int h, int qblk, int tid, int wid, int lane) {
    const int r32 = lane & 31, hi = lane >> 5, q0 = 256 * qblk, t0 = q0 + 32 * wid, t = t0 + r32; const size_t rowb = (size_t)b * S;
    bf16x8 qr[4]; { const bf16_t* qp = Q + (rowb + t) * 512 + h * 64 + 8 * hi;
#pragma unroll
        for (int d0 = 0; d0 < 4; ++d0) qr[d0] = *(const bf16x8*)(qp + 16 * d0); }
    f32x16 o0, o1, negm;
#pragma unroll
    for (int r = 0; r < 16; ++r) { o0[r] = 0.f; o1[r] = 0.f; negm[r] = 0.f; }
    float mref = 0.f, lsum = 0.f; bool seen = false;
    float qn; { float qs = 0.f;
#pragma unroll
        for (int d0 = 0; d0 < 4; ++d0)
#pragma unroll
            for (int e = 0; e < 8; ++e) { const float x = __uint_as_float(((unsigned)(unsigned short)qr[d0][e]) << 16); qs += x * x; }
        const auto rr = __builtin_amdgcn_permlane32_swap(__float_as_uint(qs), __float_as_uint(qs), false, false); qn = sqrtf(__uint_as_float(rr[0]) + __uint_as_float(rr[1])) * 1.01f; }
    constexpr float FASTB = 60.f;
    int zlane = 0; asm volatile("" : "+v"(zlane));
    const float* knp = KN + (b * 8 + h) * (S / 64) + zlane;
    float knv = knp[0];
    constexpr float THR = 8.f;
    const int ntile = (q0 + 256) / 64, wlast = (t0 + 31) >> 6;
    const int srow = tid >> 3, sch = tid & 7;
    const bf16_t* kg = Kk + (rowb + srow) * 512 + h * 64 + sch * 8; const bf16_t* vg = V + (rowb + srow) * 512 + h * 64 + sch * 8;
    const int kdst = srow * 128 + ((sch ^ (srow & 7)) * 16), vdst = srow * VPITCH + sch * 16;
    u32x4 kr0 = *(const u32x4*)kg, vr0 = *(const u32x4*)vg;
    *(LAS u32x4*)(lds + kdst) = kr0; *(LAS u32x4*)(lds + 8192 + vdst) = vr0;
    u32x4 kr1 = *(const u32x4*)(kg + (size_t)64 * 512), vr1 = *(const u32x4*)(vg + (size_t)64 * 512);
    const unsigned* bmp = BM + (size_t)b * 256 * S + t;
    unsigned mw0 = bmp[0], mw1 = bmp[(size_t)S];
    const int koff = r32 * 128;
    __syncthreads();
#define DSA_TILE(c, BUF, NBUF, KL, VL, KW, VW) do { \
        const LAS unsigned char* kt = lds + (BUF) * DSA_STAGE; const LAS unsigned char* vt = kt + 8192; \
        if ((c) + 2 < ntile) { KL = *(const u32x4*)(kg + (size_t)((c) + 2) * 64 * 512); VL = *(const u32x4*)(vg + (size_t)((c) + 2) * 64 * 512); } \
        unsigned nw0 = 0u, nw1 = 0u; float nkn = 0.f; \
        if ((c) + 1 <= wlast) { nw0 = bmp[(size_t)(2 * (c) + 2) * S]; nw1 = bmp[(size_t)(2 * (c) + 3) * S]; nkn = knp[(c) + 1]; } \
        if ((c) <= wlast) { \
            bf16x8 kf[8]; \
            _Pragma("unroll") for (int d0 = 0; d0 < 4; ++d0) { const int xo = ((2 * d0 + hi) ^ (r32 & 7)) * 16; \
                kf[2 * d0] = *(const LAS bf16x8*)(kt + koff + xo); kf[2 * d0 + 1] = *(const LAS bf16x8*)(kt + koff + 4096 + xo); } \
            asm volatile("" : "+v"(kf[0]), "+v"(kf[1]), "+v"(kf[2]), "+v"(kf[3]), "+v"(kf[4]), "+v"(kf[5]), "+v"(kf[6]), "+v"(kf[7]));     \
            f32x16 p0 = negm, p1 = negm; \
            _Pragma("unroll") for (int d0 = 0; d0 < 4; ++d0) { p0 = __builtin_amdgcn_mfma_f32_32x32x16_bf16(kf[2 * d0], qr[d0], p0, 0, 0, 0); p1 = __builtin_amdgcn_mfma_f32_32x32x16_bf16(kf[2 * d0 + 1], qr[d0], p1, 0, 0, 0); } \
            const unsigned m0 = mw0 >> (4 * hi), m1 = mw1 >> (4 * hi); \
            _Pragma("unroll") for (int r = 0; r < 16; ++r) { const int bit = (r & 3) + 8 * (r >> 2); \
                const unsigned e0 = (unsigned)__builtin_amdgcn_sbfe((int)m0, bit, 1), e1 = (unsigned)__builtin_amdgcn_sbfe((int)m1, bit, 1); \
                p0[r] = __uint_as_float((__float_as_uint(p0[r]) & e0) | (0xff800000u & ~e0)); p1[r] = __uint_as_float((__float_as_uint(p1[r]) & e1) | (0xff800000u & ~e1)); } \
            if (__any(!(qn * knv + fabsf(mref) <= FASTB))) {     \
                float rm = -INFINITY; \
                _Pragma("unroll") for (int r = 0; r < 16; r += 2) rm = fmaxf(rm, fmaxf(fmaxf(p0[r], p0[r + 1]), fmaxf(p1[r], p1[r + 1]))); \
                { const auto rr = __builtin_amdgcn_permlane32_swap(__float_as_uint(rm), __float_as_uint(rm), false, false); rm = fmaxf(__uint_as_float(rr[0]), __uint_as_float(rr[1])); } \
                const bool shift = rm > THR || (rm < -THR && rm > -INFINITY && !seen);     \
                if (__any(shift)) { \
                    const float dl = shift ? rm : 0.f, f = dl > 0.f ? __builtin_amdgcn_exp2f(-dl) : 1.f; \
                    mref += dl; lsum *= f; \
                    _Pragma("unroll") for (int r = 0; r < 16; ++r) { p0[r] -= dl; p1[r] -= dl; o0[r] *= f; o1[r] *= f; negm[r] = -mref; } \
                } \
            } \
            seen = seen || (mw0 | mw1) != 0u;     \
            float ps = 0.f; \
            _Pragma("unroll") for (int r = 0; r < 16; ++r) { p0[r] = __builtin_amdgcn_exp2f(p0[r]); p1[r] = __builtin_amdgcn_exp2f(p1[r]); ps += p0[r] + p1[r]; } \
            lsum += ps; \
            bf16x8 pk[4]; \
            pk[0] = pk8(p0[0], p0[1], p0[2], p0[3], p0[4], p0[5], p0[6], p0[7]); pk[1] = pk8(p0[8], p0[9], p0[10], p0[11], p0[12], p0[13], p0[14], p0[15]); \
            pk[2] = pk8(p1[0], p1[1], p1[2], p1[3], p1[4], p1[5], p1[6], p1[7]); pk[3] = pk8(p1[8], p1[9], p1[10], p1[11], p1[12], p1[13], p1[14], p1[15]); \
            pv_tile(o0, o1, vt, lane, pk); \
        } \
        mw0 = nw0; mw1 = nw1; knv = nkn; \
        if ((c) + 1 < ntile) { LAS unsigned char* nb = lds + (NBUF) * DSA_STAGE; *(LAS u32x4*)(nb + kdst) = KW; *(LAS u32x4*)(nb + 8192 + vdst) = VW; } \
        asm volatile("s_waitcnt lgkmcnt(0)" ::: "memory"); __builtin_amdgcn_s_barrier(); asm volatile("" ::: "memory"); } while (0)
#pragma unroll 1
    for (int c = 0; c < ntile; c += 2) { DSA_TILE(c, 0, 1, kr0, vr0, kr1, vr1); DSA_TILE(c + 1, 1, 0, kr1, vr1, kr0, vr0); }
#undef DSA_TILE
    { const auto rr = __builtin_amdgcn_permlane32_swap(__float_as_uint(lsum), __float_as_uint(lsum), false, false); lsum = __uint_as_float(rr[0]) + __uint_as_float(rr[1]); }
    store_ot(O + (rowb + t) * 512 + h * 64, o0, o1, hi, 1.f / lsum);
}
DEV void dsa_phase(LAS unsigned char* lds, unsigned char* ws, int vcu, int G, int tid, int wid, int lane, bf16_t* Oout) {
    constexpr int NPAIR = NB * 8 * 16;
    for (int pr = vcu; pr < NPAIR; pr += G) {
        const int bh = pr >> 4, s = pr & 15, b = bh >> 3, h = bh & 7;
#pragma unroll 1
        for (int k = 0; k < 2; ++k) {
            const int qblk = k == 0 ? s : 31 - s;
            dsa_unit(lds, (const bf16_t*)(ws + WS_QC), (const bf16_t*)(ws + WS_KC), (const bf16_t*)(ws + WS_VC), (const unsigned*)(ws + WS_BM), (const float*)(ws + WS_KN), Oout, b, h, qblk, tid, wid, lane);
        }
    }
}
#include <hip/hip_bf16.h>
namespace attn_body {
using bf16=__hip_bfloat16;
using bf16x8=__attribute__((ext_vector_type(8)))short;
using s16x4=__attribute__((ext_vector_type(4)))short;
using f32x16=__attribute__((ext_vector_type(16)))float;
using u32x4=__attribute__((ext_vector_type(4)))unsigned;
constexpr int BATCH=2,NHEAD=8,SEQ=8192,D=64,DM=NHEAD*D;
constexpr int NW=8,QBLK=32,QB=QBLK*NW,KVBLK=64,NQB=SEQ/QB;
constexpr int ATTN_PITCH=DM, ATTN_UNIT_ROWS=QB;
__device__ __forceinline__ int crow(int r,int hi){return (r&3)+8*(r>>2)+4*hi;}
#define SBAR() __builtin_amdgcn_sched_barrier(0)
__device__ __forceinline__ void cmask(f32x16&p0,f32x16&p1,int jb,int qrel,int hi){
  const float NEG=-INFINITY; int kb=64*jb+4*hi;
  #pragma unroll
  for(int r=0;r<16;++r){int kv=kb+(r&3)+8*(r>>2); if(kv>qrel)p0[r]=NEG; if(kv+32>qrel)p1[r]=NEG;}
}

constexpr int NSLOT=3, SLOTB=8192;
constexpr int LDS_K=0, LDS_V=NSLOT*SLOTB, LDS_WS=2*NSLOT*SLOTB, LDS_OST=LDS_WS+NW*64*4, LDS_BYTES=LDS_OST+NW*4096;
constexpr float C2=0.125f*1.4426950408889634f;
__device__ __forceinline__ void glds16(const void*gsrc,unsigned lds_dst){unsigned keep;
  asm volatile("s_mov_b32 %0, m0\n\ts_mov_b32 m0, %2\n\ts_nop 0\n\tglobal_load_lds_dwordx4 %1, off\n\ts_mov_b32 m0, %0":"=&s"(keep):"v"(gsrc),"s"(lds_dst):"memory");}
__device__ __forceinline__ float max3f(float a,float b,float c){float r;asm("v_max3_f32 %0, %1, %2, %3":"=v"(r):"v"(a),"v"(b),"v"(c));return r;}
__device__ __forceinline__ float max2f(float a,float b){float r;asm("v_max_f32_e32 %0, %1, %2":"=v"(r):"v"(a),"v"(b));return r;}
__device__ __forceinline__ float fadd_s(float a,float b){float r;asm("v_add_f32_e32 %0, %1, %2":"=v"(r):"v"(a),"v"(b));return r;}
__device__ __forceinline__ float fsub_s(float a,float b){float r;asm("v_sub_f32_e32 %0, %1, %2":"=v"(r):"v"(a),"v"(b));return r;}
typedef float f32x2_t __attribute__((ext_vector_type(2))); typedef __bf16 bf16x2_t __attribute__((ext_vector_type(2)));
__device__ __forceinline__ unsigned cvtpk_s(float lo,float hi){f32x2_t v={lo,hi};bf16x2_t b=__builtin_convertvector(v,bf16x2_t);return __builtin_bit_cast(unsigned,b);}
#define WAIT_BAR(N) asm volatile("s_waitcnt vmcnt(" #N ") lgkmcnt(0)\n\ts_barrier":::"memory")

__device__ __forceinline__ void qkt(f32x16&p0,f32x16&p1,const char*Kslot,const bf16x8*qr,const f32x16&negm,int r32,int hi){
  const char*kb=Kslot+hi*1024+r32*16;
  #pragma unroll
  for(int d0=0;d0<4;++d0){
    const bf16x8 b0=*reinterpret_cast<const bf16x8*>(kb+d0*2048);
    const bf16x8 b1=*reinterpret_cast<const bf16x8*>(kb+d0*2048+512);
    if(d0==0){p0=__builtin_amdgcn_mfma_f32_32x32x16_bf16(b0,qr[0],negm,0,0,0);p1=__builtin_amdgcn_mfma_f32_32x32x16_bf16(b1,qr[0],negm,0,0,0);}
    else{p0=__builtin_amdgcn_mfma_f32_32x32x16_bf16(b0,qr[d0],p0,0,0,0);p1=__builtin_amdgcn_mfma_f32_32x32x16_bf16(b1,qr[d0],p1,0,0,0);}}
}
typedef __attribute__((address_space(3))) const char* lds_cptr;
typedef short v4i16_t __attribute__((ext_vector_type(4)));
__device__ __forceinline__ void kload8(bf16x8*kf,lds_cptr kp){
  kf[0]=*(const __attribute__((address_space(3))) bf16x8*)(kp);      kf[1]=*(const __attribute__((address_space(3))) bf16x8*)(kp+512);
  kf[2]=*(const __attribute__((address_space(3))) bf16x8*)(kp+2048); kf[3]=*(const __attribute__((address_space(3))) bf16x8*)(kp+2560);
  kf[4]=*(const __attribute__((address_space(3))) bf16x8*)(kp+4096); kf[5]=*(const __attribute__((address_space(3))) bf16x8*)(kp+4608);
  kf[6]=*(const __attribute__((address_space(3))) bf16x8*)(kp+6144); kf[7]=*(const __attribute__((address_space(3))) bf16x8*)(kp+6656);
}
__device__ __forceinline__ void kload2(bf16x8*kf,lds_cptr kp,int j){ kf[2*j]=*(const __attribute__((address_space(3))) bf16x8*)(kp+j*2048); kf[2*j+1]=*(const __attribute__((address_space(3))) bf16x8*)(kp+j*2048+512); }
__device__ __forceinline__ s16x4 vtr(lds_cptr p){ return __builtin_bit_cast(s16x4,__builtin_amdgcn_ds_read_tr16_b64_v4i16((__attribute__((address_space(3))) v4i16_t*)p)); }
__device__ __forceinline__ float rowmax(const f32x16&p0,const f32x16&p1){
  float a=max3f(p0[0],p0[1],p1[0]),b=max3f(p0[2],p0[3],p1[1]);a=max3f(a,p1[2],p1[3]);
  #pragma unroll
  for(int r=4;r<16;r+=4){a=max3f(a,p0[r],p0[r+1]);b=max3f(b,p0[r+2],p0[r+3]);a=max3f(a,p1[r],p1[r+1]);b=max3f(b,p1[r+2],p1[r+3]);}
  const float m=max2f(a,b);
  auto rr=__builtin_amdgcn_permlane32_swap(__float_as_uint(m),__float_as_uint(m),false,false);
  return max2f(__uint_as_float(rr[0]),__uint_as_float(rr[1]));
}
__device__ __forceinline__ void pv(f32x16*o,int vb,bf16x8 pa0,bf16x8 pa1,bf16x8 pa2,bf16x8 pa3){
  #pragma unroll
  for(int d0=0;d0<2;++d0){s16x4 lo[4],hi[4];
    #pragma unroll
    for(int ks=0;ks<4;++ks){
      asm volatile("ds_read_b64_tr_b16 %0,%1 offset:%c2":"=&v"(lo[ks]):"v"(vb),"i"(d0*4096+ks*1024):"memory");
      asm volatile("ds_read_b64_tr_b16 %0,%1 offset:%c2":"=&v"(hi[ks]):"v"(vb),"i"(d0*4096+ks*1024+512):"memory");}
    asm volatile("s_waitcnt lgkmcnt(0)":::"memory");SBAR();
    #define PK(k) (bf16x8){lo[k][0],lo[k][1],lo[k][2],lo[k][3],hi[k][0],hi[k][1],hi[k][2],hi[k][3]}
    o[d0]=__builtin_amdgcn_mfma_f32_32x32x16_bf16(pa0,PK(0),o[d0],0,0,0);
    o[d0]=__builtin_amdgcn_mfma_f32_32x32x16_bf16(pa1,PK(1),o[d0],0,0,0);
    o[d0]=__builtin_amdgcn_mfma_f32_32x32x16_bf16(pa2,PK(2),o[d0],0,0,0);
    o[d0]=__builtin_amdgcn_mfma_f32_32x32x16_bf16(pa3,PK(3),o[d0],0,0,0);
    #undef PK
  }
}

#ifndef ATTN_STORE16
#define ATTN_STORE16(p,v) (*(u32x4*)(p)=(v))
#endif
template<int THRL> __device__ __forceinline__ void attn_unit(int b,int h,int qb,const bf16*Q,const bf16*__restrict__ K,const bf16*__restrict__ V,bf16*O,char*shm,const unsigned*__restrict__ BMb,const float*KNbh,const int tid){
  const int lane=tid&63,r32=lane&31,hi=lane>>5; const int wid=__builtin_amdgcn_readfirstlane(tid>>6);
  const long rowbase=(long)b*SEQ; const int q0=qb*QB;
  const bf16*Qw=Q+(rowbase+q0+wid*QBLK)*DM+h*D;
  const bf16*Kh=K+rowbase*DM+h*D,*Vh=V+rowbase*DM+h*D;
  const unsigned lds0=(unsigned)(uintptr_t)shm;
  float*wsf=(float*)(shm+LDS_WS)+wid*64;
  const bf16*ksrc=Kh+(long)lane*DM+wid*8;
  const bf16*vsrc=Vh+(long)(16*(wid&3)+(lane>>2))*DM+(wid>>2)*32+(lane&3)*8;
  const unsigned kdst=lds0+LDS_K+wid*1024, vdst=lds0+LDS_V+wid*1024;
  #define DMA_K(t,slot) glds16(ksrc+(long)(t)*KVBLK*DM,(unsigned)__builtin_amdgcn_readfirstlane(kdst+(slot)))
  #define DMA_V(t,slot) glds16(vsrc+(long)(t)*KVBLK*DM,(unsigned)__builtin_amdgcn_readfirstlane(vdst+(slot)))
  const int vb0=(int)(lds0+LDS_V)+((lane>>4)&1)*32+(lane&3)*8+(4*hi+((lane&15)>>2))*64;
  const char*Kbase=shm+LDS_K; bf16x8 kf[8];
  const lds_cptr shm3=(lds_cptr)shm; const lds_cptr kp0=shm3+LDS_K+hi*1024+r32*16; const lds_cptr vp0=shm3+LDS_V+((lane>>4)&1)*32+(lane&3)*8+(4*hi+((lane&15)>>2))*64;
  const int NT=(q0+QB)/KVBLK;
  DMA_K(0,0);DMA_V(0,0);DMA_K(1,SLOTB);
  bf16x8 qr[4];
  #pragma unroll
  for(int d0=0;d0<4;++d0)qr[d0]=*reinterpret_cast<const bf16x8*>(&Qw[(long)r32*DM+d0*16+hi*8]);
  const unsigned*bmp=BMb+(q0+wid*QBLK+r32);
  unsigned mwE0=bmp[0],mwE1=bmp[(size_t)SEQ],mwO0=0u,mwO1=0u;
  bool seen=false;
  float qn; { float qs=0.f;
    _Pragma("unroll") for(int d0=0;d0<4;++d0) _Pragma("unroll") for(int e=0;e<8;++e){ const float x=__uint_as_float(((unsigned)(unsigned short)qr[d0][e])<<16); qs+=x*x; }
    auto rr=__builtin_amdgcn_permlane32_swap(__float_as_uint(qs),__float_as_uint(qs),false,false); qn=__builtin_sqrtf(__uint_as_float(rr[0])+__uint_as_float(rr[1]))*1.01f; }
  constexpr float FASTB=60.f;
  int zlane=0; asm volatile("":"+v"(zlane));
  const float*knp=KNbh+zlane;
  float knE=knp[0],knO=0.f;
  bool anysel_=false;
  #define SLOWT(PS) (__any(!(qn*kn##PS<=FASTB)||mhat!=0.f))
  float mhat=0.f,l_reg=0.f;f32x16 o[2];o[0]=f32x16{};o[1]=f32x16{};const f32x16 zero16=f32x16{};
  const int qrel=wid*QBLK+r32;
  #define CMASK(P0,P1,SLOW,PS) do{ const unsigned m0_=mw##PS##0>>(4*hi), m1_=mw##PS##1>>(4*hi); anysel_=(mw##PS##0|mw##PS##1)!=0u; \
    if(SLOW){ _Pragma("unroll") for(int r=0;r<16;++r){ P0[r]-=mhat; P1[r]-=mhat; } } \
    _Pragma("unroll") for(int r=0;r<16;++r){ const int bit_=(r&3)+8*(r>>2); \
      const unsigned e0_=(unsigned)__builtin_amdgcn_sbfe((int)m0_,bit_,1), e1_=(unsigned)__builtin_amdgcn_sbfe((int)m1_,bit_,1); \
      P0[r]=__uint_as_float((__float_as_uint(P0[r])&e0_)|(0xff800000u&~e0_)); P1[r]=__uint_as_float((__float_as_uint(P1[r])&e1_)|(0xff800000u&~e1_)); } \
    }while(0)
  bool resc=false;
  #define START(P0,P1,SLOW) do{ resc=false; seen=anysel_; \
    if(SLOW){ const float rm=rowmax(P0,P1); const float dl=(rm==-INFINITY)?0.f:rm; mhat=fadd_s(mhat,dl); \
      _Pragma("unroll") for(int r=0;r<16;++r){P0[r]=fsub_s(P0[r],dl);P1[r]=fsub_s(P1[r],dl);} \
      } \
    _Pragma("unroll") for(int r=0;r<16;++r)P0[r]=__builtin_amdgcn_exp2f(P0[r]); }while(0)
  #define RESC() do{ if(resc){ asm volatile("s_waitcnt lgkmcnt(0)":::"memory"); \
      _Pragma("unroll") for(int d_=0;d_<2;++d_) _Pragma("unroll") for(int r=0;r<16;++r)o[d_][r]*=wsf[crow(r,hi)]; } }while(0)
  f32x16 pA0,pA1,pB0,pB1;
  int sl_prev=0,sl_cur=0,sl_next=SLOTB;
  #define ROT() do{sl_prev=sl_cur;sl_cur=sl_next;sl_next=(sl_next==(NSLOT-1)*SLOTB)?0:sl_next+SLOTB;}while(0)
  DMA_K(2,2*SLOTB);
  WAIT_BAR(3);
  { mwO0=bmp[(size_t)2*SEQ]; mwO1=bmp[(size_t)3*SEQ]; knO=knp[1];
  const bool slow0_=SLOWT(E);
  qkt(pA0,pA1,Kbase,qr,zero16,r32,hi);asm volatile("s_nop 15\n\ts_nop 7":"+v"(pA0),"+v"(pA1));CMASK(pA0,pA1,slow0_,E);
  START(pA0,pA1,slow0_); }
  _Pragma("unroll") for(int r=0;r<16;++r)pA1[r]=__builtin_amdgcn_exp2f(pA1[r]);
  WAIT_BAR(0);
  DMA_K(3,0);DMA_V(1,SLOTB);
  ROT();
  kload8(kf,kp0+sl_cur);
  WAIT_BAR(2);
  s16x4 vlo[8],vhi[8]; u32x4 pw0,pw1,pw2,pw3;
  #define PKW(P,B) cvtpk_s(P[B],P[B+1])
  #define PAF(k) __builtin_bit_cast(bf16x8,pw##k)
  #define VFR(i) (bf16x8){vlo[i][0],vlo[i][1],vlo[i][2],vlo[i][3],vhi[i][0],vhi[i][1],vhi[i][2],vhi[i][3]}
  #define PIN(x) asm volatile("":"+v"(x))
  #define MX3(a,b,c) __builtin_fmaxf(__builtin_fmaxf((a),(b)),(c))
  #define GAPA(MF,A0,A1,A2,A3,W0,W1,PW) do{ MF; sacc+=A0; sacc+=A1; sacc+=A2; sacc+=A3; PIN(sacc); W0; W1; PIN(PW); SBAR(); }while(0)
  #define EX(v) __builtin_amdgcn_exp2f(v)
  #define GAPB(MF,X,B) do{ MF; X[B]=EX(X[B]); X[B+1]=EX(X[B+1]); X[B+2]=EX(X[B+2]); X[B+3]=EX(X[B+3]); PIN(X); SBAR(); }while(0)
  #define VRD(i) do{ vlo[i]=vtr(vp_+(((i)>>2)*4096+((i)&3)*1024)); vhi[i]=vtr(vp_+(((i)>>2)*4096+((i)&3)*1024+512)); }while(0)
  #define KRD(G,j) do{ if(G){ kload2(kf,kp0+sl_next,j); SBAR(); } }while(0)
  #define STEP(C0,C1,P0,P1,t,GK,GV,GL,PS,NS) do{ SBAR(); \
    if((t)+1<NT){ mw##NS##0=bmp[(size_t)(2*(t)+2)*SEQ]; mw##NS##1=bmp[(size_t)(2*(t)+3)*SEQ]; kn##NS=knp[(t)+1]; }     \
    const lds_cptr vp_=vp0+sl_prev; \
    VRD(0); SBAR(); float sacc=(P0[0]+P0[1]); \
    GAPA(C0=__builtin_amdgcn_mfma_f32_32x32x16_bf16(kf[0],qr[0],zero16,0,0,0), P0[2],P0[3],P0[4],P0[5],     pw0[0]=PKW(P0,0), pw0[1]=PKW(P0,2), pw0); \
    VRD(4); SBAR(); GAPA(C1=__builtin_amdgcn_mfma_f32_32x32x16_bf16(kf[1],qr[0],zero16,0,0,0), P0[6],P0[7],P0[8],P0[9],     pw0[2]=PKW(P0,4), pw0[3]=PKW(P0,6), pw0); \
    VRD(1); SBAR(); GAPA(C0=__builtin_amdgcn_mfma_f32_32x32x16_bf16(kf[2],qr[1],C0,0,0,0),   P0[10],P0[11],P0[12],P0[13], pw1[0]=PKW(P0,8), pw1[1]=PKW(P0,10), pw1); \
    VRD(5); SBAR(); GAPA(C1=__builtin_amdgcn_mfma_f32_32x32x16_bf16(kf[3],qr[1],C1,0,0,0),   P0[14],P0[15],P1[0],P1[1],   pw1[2]=PKW(P0,12),pw1[3]=PKW(P0,14), pw1); \
    VRD(2); SBAR(); GAPA(C0=__builtin_amdgcn_mfma_f32_32x32x16_bf16(kf[4],qr[2],C0,0,0,0),   P1[2],P1[3],P1[4],P1[5],     pw2[0]=PKW(P1,0), pw2[1]=PKW(P1,2), pw2); \
    VRD(6); SBAR(); GAPA(C1=__builtin_amdgcn_mfma_f32_32x32x16_bf16(kf[5],qr[2],C1,0,0,0),   P1[6],P1[7],P1[8],P1[9],     pw2[2]=PKW(P1,4), pw2[3]=PKW(P1,6), pw2); \
    VRD(3); SBAR(); GAPA(C0=__builtin_amdgcn_mfma_f32_32x32x16_bf16(kf[6],qr[3],C0,0,0,0),   P1[10],P1[11],P1[12],P1[13], pw3[0]=PKW(P1,8), pw3[1]=PKW(P1,10), pw3); \
    VRD(7); SBAR(); GAPA(C1=__builtin_amdgcn_mfma_f32_32x32x16_bf16(kf[7],qr[3],C1,0,0,0),   P1[14],P1[15],0.f,0.f,       pw3[2]=PKW(P1,12),pw3[3]=PKW(P1,14), pw3); \
    l_reg+=sacc; \
    if(GK){DMA_K((t)+3,sl_cur);} if(GV){DMA_V((t)+1,sl_next);} \
    const bool slow_=SLOWT(PS); CMASK(C0,C1,slow_,PS); resc=false; \
    if(__builtin_expect(slow_,0)){ float a=MX3(C0[0],C0[1],C1[0]),b=MX3(C0[2],C0[3],C1[1]); a=MX3(a,C1[2],C1[3]); \
      _Pragma("unroll") for(int r=4;r<16;r+=4){a=MX3(a,C0[r],C0[r+1]);b=MX3(b,C0[r+2],C0[r+3]);a=MX3(a,C1[r],C1[r+1]);b=MX3(b,C1[r+2],C1[r+3]);} \
      float rm=__builtin_fmaxf(a,b); { auto rr=__builtin_amdgcn_permlane32_swap(__float_as_uint(rm),__float_as_uint(rm),false,false); rm=__builtin_fmaxf(__uint_as_float(rr[0]),__uint_as_float(rr[1])); } \
      const bool fresh_=!seen&&rm>-INFINITY;     \
      if(__builtin_expect(__any(rm>(float)THRL||(fresh_&&rm<-(float)THRL)),0)){ const float dl=fresh_?rm:__builtin_fmaxf(rm,0.f); mhat+=dl; \
        _Pragma("unroll") for(int r=0;r<16;++r){C0[r]-=dl;C1[r]-=dl;} \
        const float f=dl>0.f?__builtin_amdgcn_exp2f(-dl):1.f; l_reg*=f; if(hi==0)wsf[r32]=f; resc=true; } } \
    seen=seen||anysel_; \
    SBAR(); \
    GAPB(o[0]=__builtin_amdgcn_mfma_f32_32x32x16_bf16(PAF(0),VFR(0),o[0],0,0,0), C0,0); \
    GAPB(o[1]=__builtin_amdgcn_mfma_f32_32x32x16_bf16(PAF(0),VFR(4),o[1],0,0,0), C0,4); \
    KRD(GL,0); GAPB(o[0]=__builtin_amdgcn_mfma_f32_32x32x16_bf16(PAF(1),VFR(1),o[0],0,0,0), C0,8); \
    KRD(GL,1); GAPB(o[1]=__builtin_amdgcn_mfma_f32_32x32x16_bf16(PAF(1),VFR(5),o[1],0,0,0), C0,12); \
    KRD(GL,2); GAPB(o[0]=__builtin_amdgcn_mfma_f32_32x32x16_bf16(PAF(2),VFR(2),o[0],0,0,0), C1,0); \
    KRD(GL,3); GAPB(o[1]=__builtin_amdgcn_mfma_f32_32x32x16_bf16(PAF(2),VFR(6),o[1],0,0,0), C1,4); \
    GAPB(o[0]=__builtin_amdgcn_mfma_f32_32x32x16_bf16(PAF(3),VFR(3),o[0],0,0,0), C1,8); \
    GAPB(o[1]=__builtin_amdgcn_mfma_f32_32x32x16_bf16(PAF(3),VFR(7),o[1],0,0,0), C1,12); \
    }while(0)
  int t=1;
  for(;t+5<NT;t+=2){
    STEP(pB0,pB1,pA0,pA1,t,true,true,true,O,E);     WAIT_BAR(2); RESC(); ROT();
    STEP(pA0,pA1,pB0,pB1,t+1,true,true,true,E,O);   WAIT_BAR(2); RESC(); ROT();
  }
  #define ENDW(tt) do{ if((tt)+3<NT){WAIT_BAR(2);} else if((tt)+2<NT){WAIT_BAR(1);} else {WAIT_BAR(0);} }while(0)
  for(;t+1<NT;t+=2){
    STEP(pB0,pB1,pA0,pA1,t,(t+3<NT),(t+1<NT),(t+1<NT),O,E);       ENDW(t);   RESC(); ROT();
    STEP(pA0,pA1,pB0,pB1,t+1,(t+4<NT),(t+2<NT),(t+2<NT),E,O);     ENDW(t+1); RESC(); ROT();
  }
  STEP(pB0,pB1,pA0,pA1,NT-1,false,false,false,O,E); RESC();
  { float sacc=pB0[0]+pB0[1]; _Pragma("unroll") for(int r=2;r<16;++r)sacc+=pB0[r]; _Pragma("unroll") for(int r=0;r<16;++r)sacc+=pB1[r]; l_reg+=sacc;
    pw0=(u32x4){PKW(pB0,0),PKW(pB0,2),PKW(pB0,4),PKW(pB0,6)};pw1=(u32x4){PKW(pB0,8),PKW(pB0,10),PKW(pB0,12),PKW(pB0,14)};pw2=(u32x4){PKW(pB1,0),PKW(pB1,2),PKW(pB1,4),PKW(pB1,6)};pw3=(u32x4){PKW(pB1,8),PKW(pB1,10),PKW(pB1,12),PKW(pB1,14)};
    SBAR(); pv(o,vb0+sl_cur,PAF(0),PAF(1),PAF(2),PAF(3)); }
  #undef PKW
  #undef PAF
  #undef VFR
  #undef PIN
  #undef MX3
  #undef GAPA
  #undef GAPB
  #undef EX
  #undef VRD
  #undef KRD
  #undef STEP
  #undef ENDW
  {auto rr=__builtin_amdgcn_permlane32_swap(__float_as_uint(l_reg),__float_as_uint(l_reg),false,false);l_reg=__uint_as_float(rr[0])+__uint_as_float(rr[1]);}
  if(hi==0)wsf[32+r32]=l_reg;asm volatile("s_waitcnt lgkmcnt(0)":::"memory");
  float rli[16];
  #pragma unroll
  for(int r=0;r<16;++r)rli[r]=__builtin_amdgcn_rcpf(wsf[32+crow(r,hi)]);
  bf16*Ow=O+(rowbase+q0+wid*QBLK)*DM+h*D;
  { bf16*stg=(bf16*)(shm+LDS_OST)+wid*2048;
    #pragma unroll
    for(int r=0;r<16;++r){const int orow=crow(r,hi);
      #pragma unroll
      for(int d0=0;d0<2;++d0)stg[orow*64+d0*32+r32]=__float2bfloat16(o[d0][r]*rli[r]);}
    asm volatile("s_waitcnt lgkmcnt(0)":::"memory");
    #pragma unroll
    for(int i=0;i<4;++i){const int row=i*8+(lane>>3),ch=lane&7; const u32x4 v=*(const u32x4*)(stg+row*64+ch*8); ATTN_STORE16(Ow+(long)row*DM+ch*8,v);} }
  asm volatile("s_waitcnt lgkmcnt(0)\n\ts_barrier":::"memory");
  #undef DMA_K
  #undef DMA_V
  #undef CMASK
  #undef SLOWT
  #undef START
  #undef RESC
  #undef ROT
}
constexpr int ATTN_LDS_BYTES=LDS_BYTES;
#undef SBAR
#undef WAIT_BAR
}
constexpr int MK_THREADS = 512;
constexpr int RING_BYTES = 131072, MISC_OFF = RING_BYTES + 320, MK_LDS_BYTES = 147456;
constexpr size_t WS_CTL = 0, CTL_ZERO_BYTES = 65536 + 7 * 131072; constexpr int CW_BAR = 4096;
constexpr int PH_PREP0 = 0, PH_L0 = 1, PH_PER_LAYER = 14, NPH = PH_L0 + 2 * PH_PER_LAYER;
enum { Q_INPROJ = 0, Q_SBIDX, Q_DSA, Q_GATES, Q_MERGE, Q_MIX, Q_NORMXA, Q_XALOG, Q_XAOUT, Q_NORMFFN, Q_UP, Q_FFNMID, Q_DOWN, Q_NEXT };

#ifndef QBUILD
#define QBUILD 0xffffu
#endif
#define QON(x) ((QBUILD >> (x)) & 1u)
struct Args { const float* in[20]; float* out; unsigned char* ws; int ph_lo, ph_hi; };

__global__ void __launch_bounds__(MK_THREADS, 2) mk_fwd(Args args) {
    __shared__ __attribute__((aligned(16))) unsigned char lds_raw[MK_LDS_BYTES];
    LAS unsigned char* lds = (LAS unsigned char*)lds_raw;
    volatile LAS unsigned* MISC = (volatile LAS unsigned*)(lds + MISC_OFF);
    const int G = gridDim.x, bx = blockIdx.x;
    unsigned char* ws0 = args.ws;
    const int wave_s = __builtin_amdgcn_readfirstlane((int)threadIdx.x >> 6);
    for (int u = mk_tid(wave_s); u < (MK_LDS_BYTES - RING_BYTES) / 4; u += MK_THREADS) ((LAS unsigned*)(lds + RING_BYTES))[u] = 0u;
    __syncthreads();
    const int lo = args.ph_lo, hi = args.ph_hi;
    XcdBarrier bar; bar.bar = (unsigned*)(ws0 + WS_CTL) + CW_BAR; bar.x = 0; bar.st = nullptr;
    if (hi - lo > 1) bar = xcd_barrier_post((unsigned*)(ws0 + WS_CTL) + CW_BAR, MISC + 8, mk_tid(wave_s));
#define BPW(off) ((bf16_t*)(ws + (off)))
    const int vcu = (G % 8 == 0) ? (bx % 8) * (G / 8) + bx / 8 : bx;
    for (int p = lo; p < hi; ++p) {
#ifdef PROBE_REP
        const int reps = (p >= PH_L0 && ((PROBE_REP >> ((p - PH_L0) % PH_PER_LAYER)) & 1)) ? 2 : 1;
#else
        const int reps = 1;
#endif
#ifdef PROBE_REP
#pragma unroll 1
        for (int rep = 0; rep < reps; ++rep) {
        const bool dry = rep + 1 < reps;
#else
        { constexpr bool dry = false;
#endif
        int oz = 0; asm volatile("" : "+s"(oz));
        int tid = mk_tid(wave_s); asm volatile("" : "+v"(tid));
        const int wave = __builtin_amdgcn_readfirstlane(tid >> 6), lane = tid & 63;
        WaveId W; W.gw = vcu * 8 + wave; W.ngw = G * 8; W.wave = wave; W.lane = lane;
        unsigned char* ws = args.ws + oz; float* X = args.out + oz;
#define INP(k) (args.in[(k) + oz])
        if (p == PH_PREP0) {
            prep0_phase(W, (LAS float*)(lds + wave * 16384), ws, args.in + oz, (bf16_t*)X);
        } else if (p >= PH_L0) {
            const int l = (p - PH_L0) / PH_PER_LAYER, q = (p - PH_L0) % PH_PER_LAYER;
            const float* Xin = l == 0 ? INP(0) : X;
            pg8::u64* SSb = (pg8::u64*)(ws + WS_SS);
#define SSA(i) (SSb + (size_t)(i) * T)
            if (q == Q_SBIDX) {
#ifndef NO_SB
                sb_phase(W, lds, ws, dry);
#endif
                __syncthreads();
#ifndef NO_IDX
#ifdef PROBE_SB_ONLY
                if (!dry)
#endif
                idx_phase(lds, ws, vcu, G, wave, lane);
#endif
                conv_sc_phase(vcu * MK_THREADS + tid, G * MK_THREADS, BPW(WS_SCB), BPW(WS_CX), INP(4) + l * 3 * 512, dry);
                kn_phase(W, BPW(WS_KC), (float*)(ws + WS_KN));
                if (l == 0 && !dry && QON(15)) {
                    __syncthreads();
                    { pg8::Order S; S.init(1, 4, 16, G, bx); pg8::PtrG P{(const char*)(ws + WS_KVM), (const char*)(ws + WS_WQ)}; pg8::EpiPrep E{ws, 1};
                      pg8::gemm_phase<pg8::EpiPrep, pg8::PtrG, true, true>(lds, tid, 2 * D, D, 256, S, P, E); }
                    { pg8::Order S; S.init(4, 1, 16, G, (bx + 64) % G); pg8::PtrH P{(const char*)(ws + WS_KVM), (const char*)(ws + WS_WOT)}; pg8::EpiPrep E{ws, 2};
                      pg8::gemm_phase<pg8::EpiPrep, pg8::PtrH, true, true>(lds, tid, D, 2 * D, 256, S, P, E); }
                }
            } else if (q == Q_DSA) {
#ifndef NO_DSA
                {
                    for (int pr = vcu; pr < NB * 8 * 16; pr += G) { const int bh = pr >> 4, sx = pr & 15, bb = bh >> 3, hh = bh & 7;
#pragma unroll 1
                        for (int k2 = 0; k2 < 2; ++k2)
                            attn_body::attn_unit<8>(bb, hh, k2 == 0 ? sx : 31 - sx, (const attn_body::bf16*)BPW(WS_QC), (const attn_body::bf16*)BPW(WS_KC), (const attn_body::bf16*)BPW(WS_VC),
                                                    (attn_body::bf16*)(dry ? BPW(WS_KA) : BPW(WS_QC)), (char*)lds_raw, (const unsigned*)(ws + WS_BM) + (size_t)bb * 256 * S,
                                                    (const float*)(ws + WS_KN) + bh * (S / 64), tid); }
                }
#endif
            } else if (q == Q_FFNMID) {
            } else if (q == Q_NEXT) {
                if (l + 1 < DEPTH) { int base = 0; convert_layer_weights(W, (LAS float*)(lds + wave * 16384), base, ws, args.in + oz, l + 1); }
                else if (!dry) final_norm(W, BPW(WS_XN), X, INP(19), SSA(6));
            } else if (q == Q_INPROJ && QON(Q_INPROJ)) {
                pg8::Order S; S.init(T / 256, NIN / 256, 1, G, bx);
                pg8::PtrStd P{(const char*)X, (const char*)(ws + WS_WIN), 0, 0, 0, (size_t)256 * D * 2, (size_t)256 * D * 2};
                pg8::EpiInProj E{ws, SSA(3 * l)};
                pg8::gemm_phase<pg8::EpiInProj, pg8::PtrStd, true, true>(lds, tid, D, D, D, S, P, E);
                if (l == 0 && !dry && QON(14)) {
                    pg8::Order S2; S2.init(2, 8, 2, G, (bx + G - 64) % G);
                    pg8::PtrStd P2{(const char*)(ws + WS_MEMN), (const char*)(ws + WS_WKVT), 1 * MiB, 4 * MiB, 0, (size_t)256 * D * 2, (size_t)256 * D * 2};
                    pg8::EpiPrep E2{ws, 0};
                    pg8::gemm_phase<pg8::EpiPrep, pg8::PtrStd, true, true>(lds, tid, D, D, D, S2, P2, E2);
                }
            } else if (q == Q_GATES && QON(Q_GATES)) {
                pg8::Order S; S.init(T / 256, 12, 1, G, bx);
                pg8::PtrStd P{(const char*)X, (const char*)(ws + WS_WG), 0, 0, 0, (size_t)256 * D * 2, (size_t)256 * D * 2};
                pg8::EpiGates E{BPW(WS_GATES), SSA(3 * l)};
                pg8::gemm_phase<pg8::EpiGates, pg8::PtrStd, true, true>(lds, tid, D, D, D, S, P, E);
            } else if (q == Q_MERGE && QON(Q_MERGE)) {
                pg8::Order S; S.init(T / 256, 4, 3, G, bx);
                pg8::PtrStd P{(const char*)(ws + WS_QA), (const char*)(ws + WS_WBR), 16 * MiB, (size_t)D * 512 * 2, 0, (size_t)256 * 512 * 2, (size_t)256 * 512 * 2};
                pg8::EpiMerge E{BPW(WS_XN), BPW(WS_GATES)};
                pg8::gemm_phase<pg8::EpiMerge, pg8::PtrStd, true, true>(lds, tid, 512, 512, 512, S, P, E);
            } else if (q == Q_MIX && QON(Q_MIX)) {
                pg8::Order S; S.init(T / 256, 4, 1, G, bx);
                pg8::PtrStd P{(const char*)(ws + WS_XN), (const char*)(ws + WS_WMIX), 0, 0, 0, (size_t)256 * D * 2, (size_t)256 * D * 2};
                if (l == 0) { pg8::EpiResid<true> E{(const void*)INP(0), dry ? BPW(WS_FU) : BPW(WS_XBXA), dry ? SSA(0) : SSA(1)};
                    pg8::gemm_phase<pg8::EpiResid<true>, pg8::PtrStd, true, true>(lds, tid, D, D, D, S, P, E); }
                else { pg8::EpiResid<false> E{(const void*)X, dry ? BPW(WS_FU) : BPW(WS_XBXA), dry ? SSA(0) : SSA(4)};
                    pg8::gemm_phase<pg8::EpiResid<false>, pg8::PtrStd, true, true>(lds, tid, D, D, D, S, P, E); }

            } else if (q == Q_XALOG && QON(Q_XALOG)) {
                pg8::Order S; S.init(T / 256, 4, 1, G, bx);
                pg8::PtrStd P{(const char*)(ws + WS_XBXA), (const char*)(ws + WS_GT + (size_t)l * 4 * MiB), 0, 0, 2 * MiB, (size_t)256 * D * 2, (size_t)256 * D * 2};
                pg8::EpiSoftmax E{BPW(WS_PXA), SSA(1 + 3 * l)};
                pg8::gemm_phase<pg8::EpiSoftmax, pg8::PtrStd, false, true>(lds, tid, D, D, D, S, P, E);
            } else if (q == Q_XAOUT && QON(Q_XAOUT)) {
                pg8::Order S; S.init(T / 256, 4, 1, G, bx);
                pg8::PtrStd P{(const char*)(ws + WS_PXA), (const char*)(ws + WS_HT + (size_t)l * 4 * MiB), 0, 0, 2 * MiB, (size_t)256 * D * 2, (size_t)256 * D * 2};
                pg8::EpiResid<false> E{(const void*)BPW(WS_XBXA), dry ? BPW(WS_FU) : BPW(WS_XN), dry ? SSA(0) : SSA(2 + 3 * l)};
                pg8::gemm_phase<pg8::EpiResid<false>, pg8::PtrStd, true, true>(lds, tid, D, D, D, S, P, E);
            } else if (q == Q_UP && QON(Q_UP)) {
                pg8::Order S; S.init(T / 256, 22, 1, G, bx);
                pg8::PtrStd P{(const char*)(ws + WS_XN), (const char*)(ws + WS_WUP), 0, 0, 0, (size_t)256 * D * 2, (size_t)256 * D * 2};
                pg8::EpiUpF E{BPW(WS_FU), BPW(WS_SIDEA), BPW(WS_SIDEU), SSA(2 + 3 * l), INP(16) + l * 3 * DFF, INP(17) + l * DFF};
                pg8::gemm_phase<pg8::EpiUpF, pg8::PtrStd, true, true>(lds, tid, D, D, D, S, P, E);
            } else if (q == Q_DOWN && QON(Q_DOWN)) {
                pg8::Order S; S.init(T / 256, 4, 1, G, bx);
                if (!dry) {
#pragma unroll 1
                    for (int i = 0; ; ++i) { pg8::Unit u0; if (!S.next(i, u0)) break; ffn_fix_phase(tid, MK_THREADS, BPW(WS_SIDEA), BPW(WS_SIDEU), BPW(WS_FU), INP(16) + l * 3 * DFF, INP(17) + l * DFF, 4 * u0.pm, 4); }
                    asm volatile("s_waitcnt vmcnt(0)" ::: "memory"); __syncthreads();
                }
                pg8::PtrStd P{(const char*)(ws + WS_FU), (const char*)(ws + WS_WDOWN), 0, 0, 0, (size_t)256 * DFF * 2, (size_t)256 * DFF * 2};
                pg8::EpiResid<false> E{(const void*)BPW(WS_XN), dry ? BPW(WS_QA) : (l + 1 < DEPTH ? (bf16_t*)X : BPW(WS_XN)), dry ? SSA(0) : SSA(3 + 3 * l)};
                pg8::gemm_phase<pg8::EpiResid<false>, pg8::PtrStd, true, true>(lds, tid, DFF, DFF, DFF, S, P, E);
            }
        }
        }
        if (p + 1 < hi && !(p >= PH_L0 && ((p - PH_L0) % PH_PER_LAYER == Q_NORMXA || (p - PH_L0) % PH_PER_LAYER == Q_NORMFFN || (p - PH_L0) % PH_PER_LAYER == Q_FFNMID))) xcd_barrier(bar, mk_tid(wave_s));
    }
}

extern "C" void kernel_launch(void* const* d_in, const int* in_sizes, int n_in, void* d_out, int out_size, void* d_ws, size_t ws_size, hipStream_t st) {
    if (n_in != 20 || ws_size < WS_NEED || out_size != T * D) { fprintf(stderr, "kernel_launch: unexpected sizes n_in %d ws %zu out %d\n", n_in, ws_size, out_size); return; }
    static int grid = 0;
    if (grid == 0) {
        int dev = 0, cus = 0, per_cu = 0;
        (void)hipGetDevice(&dev); (void)hipDeviceGetAttribute(&cus, hipDeviceAttributeMultiprocessorCount, dev);
        if (hipOccupancyMaxActiveBlocksPerMultiprocessor(&per_cu, (const void*)mk_fwd, MK_THREADS, 0) != hipSuccess || per_cu < 1) { fprintf(stderr, "kernel_launch: occupancy query says %d blocks/CU\n", per_cu); grid = -1; return; }
        (void)hipGetLastError();
        if (cus != 256) { fprintf(stderr, "kernel_launch: built for a 256-CU device, found %d\n", cus); grid = -1; return; }
        grid = cus;
    }
    if (grid < 0) return;
    (void)hipMemsetAsync((char*)d_ws + WS_CTL, 0, CTL_ZERO_BYTES, st);
    Args a{};
    for (int i = 0; i < 20; ++i) a.in[i] = (const float*)d_in[i];
    a.out = (float*)d_out; a.ws = (unsigned char*)d_ws; a.ph_lo = 0; a.ph_hi = NPH;
    hipLaunchKernelGGL(mk_fwd, dim3(grid), dim3(MK_THREADS), 0, st, a);
}
```

```cpp
#include <hip/hip_runtime.h>
#include <stdint.h>
#include <stdio.h>

typedef unsigned short bf16_t;
typedef short bf16x8 __attribute__((ext_vector_type(8)));
typedef float f32x16 __attribute__((ext_vector_type(16)));
typedef float f32x4 __attribute__((ext_vector_type(4)));
#define DEV __device__ __forceinline__

constexpr int NB = 2, S = 8192, D = 1024, T = NB * S, DEPTH = 2;
constexpr int DIN = 8264, DFF = 2816, MEM = 256;
constexpr int NIN = 5376;
constexpr float LOG2E = 1.4426950408889634f;
constexpr float QSCALE = 0.125f * LOG2E;
constexpr float WSCALE = 0.125f * 0.35355339059327373f;
constexpr float XSCALE = 0.0625f * LOG2E;
constexpr float EPS = 1e-6f;
#ifndef MK_FUSE
#define MK_FUSE 1
#endif

constexpr size_t MiB = 1u << 20;
constexpr size_t WS_SIDEA = 88 * MiB, WS_SIDEU = 96 * MiB;
constexpr size_t WS_KN = 983040;
constexpr size_t WS_GT = 1 * MiB;
constexpr size_t WS_HT = 9 * MiB;
constexpr size_t WS_WUP = 17 * MiB, WS_WDOWN = 28 * MiB;
constexpr size_t WS_XN = 34 * MiB;
constexpr size_t WS_WMIX = 66 * MiB, WS_WBR = 68 * MiB, WS_WG = 71 * MiB, WS_WIN = 77 * MiB;
constexpr size_t WS_QA = 88 * MiB, WS_SCB = 104 * MiB, WS_QC = 120 * MiB, WS_KA = 136 * MiB, WS_VA = 152 * MiB, WS_KC = 168 * MiB, WS_VC = 184 * MiB,
                 WS_IQ = 200 * MiB, WS_CX = 216 * MiB, WS_IK = 232 * MiB, WS_IW = 234 * MiB, WS_BM = 235 * MiB;
constexpr size_t WS_GATES = 136 * MiB;
constexpr size_t WS_XTMP = 235 * MiB;
constexpr size_t WS_LOG = 88 * MiB, WS_PXA = 168 * MiB;
constexpr size_t WS_XBXA = 136 * MiB;
constexpr size_t WS_SS = 65536;
constexpr size_t WS_FA = 66 * MiB, WS_FU = 154 * MiB;
constexpr size_t WS_WQ = 34 * MiB  , WS_WOT = 38 * MiB  , WS_WKVT = 42 * MiB  , WS_MEMN = 50 * MiB  , WS_KVM = 52 * MiB  ;
constexpr size_t WS_NEED = 256 * MiB;

DEV bf16_t f2bf(float f) { unsigned u = __float_as_uint(f); u += 0x7fffu + ((u >> 16) & 1u); return (bf16_t)(u >> 16); }
DEV float bf2f(bf16_t h) { return __uint_as_float(((unsigned)h) << 16); }
DEV float wave_sum(float v) {
#pragma unroll
    for (int o = 1; o < 64; o <<= 1) v += __shfl_xor(v, o);
    return v;
}
DEV float wave_max(float v) {
#pragma unroll
    for (int o = 1; o < 64; o <<= 1) v = fmaxf(v, __shfl_xor(v, o));
    return v;
}


#define LAS __attribute__((address_space(3)))
#define GAS __attribute__((address_space(1)))
typedef unsigned u32x4 __attribute__((ext_vector_type(4)));
typedef unsigned u32x2 __attribute__((ext_vector_type(2)));
typedef float f32x2 __attribute__((ext_vector_type(2)));
#define LDS_WAIT() asm volatile("s_waitcnt lgkmcnt(0)" ::: "memory")
DEV int mk_tid(int wave_s) { unsigned ones = ~0u; asm volatile("" : "+s"(ones)); return wave_s * 64 + (int)__builtin_amdgcn_mbcnt_hi(ones, __builtin_amdgcn_mbcnt_lo(ones, 0u)); }
#define VM_WAIT() asm volatile("s_waitcnt vmcnt(0)" ::: "memory")
typedef __bf16 bf16x2_t __attribute__((ext_vector_type(2)));
DEV unsigned cvt_pk_bf16(float lo, float hi) { const f32x2 v = {lo, hi}; return __builtin_bit_cast(unsigned, __builtin_convertvector(v, bf16x2_t)); }
DEV float bflo(unsigned w) { return __uint_as_float(w << 16); }
DEV float bfhi(unsigned w) { return __uint_as_float(w & 0xffff0000u); }

namespace pg8 {
constexpr int BM = 256, BK = 64, HALF = 128, HTB = HALF * BK * 2, STAGE_BYTES = 8 * HTB, NXCD = 8, WGM = 8;
__host__ __device__ __forceinline__ int lds_byte(int r, int c) { const int st = (r >> 4) * 2 + (c >> 5), rr = r & 15, cc = c & 31, ob = rr * 64 + cc * 2; return st * 1024 + (ob ^ (((ob >> 9) & 1) << 5)); }
__host__ __device__ __forceinline__ void stage_rc(int b, int& R, int& C) { const int st = b / 1024, sb = b % 1024, swz = sb ^ (((sb >> 9) & 1) << 5); R = (st >> 1) * 16 + swz / 64; C = (st & 1) * 32 + (swz % 64) / 2; }
__host__ __device__ __forceinline__ int perm32(int rho) { const int n = rho >> 4, i = rho & 15; return 8 * (i >> 2) + 4 * n + (i & 3); }

struct Unit { int pm, pn, job; };
struct Order {
    int nM, nN, nwg, ntot, G, c;
    DEV void init(int nM_, int nN_, int njob, int G_, int c_) { nM = nM_; nN = nN_; nwg = nM * nN; ntot = nwg * njob; G = G_; c = c_; }
    DEV bool next(int i, Unit& u) const {
        const int L = i * G + c; if (L >= ntot) return false;
        u.job = L / nwg; int wgid = L - u.job * nwg;
        { const int q = nwg / NXCD, r = nwg % NXCD, xcd = wgid % NXCD, off = wgid / NXCD; wgid = (xcd < r ? xcd * (q + 1) : r * (q + 1) + (xcd - r) * q) + off; }
        const int nig = WGM * nN, gid = wgid / nig, fm = gid * WGM, gsz = (nM - fm) < WGM ? (nM - fm) : WGM;
        u.pm = fm + ((wgid % nig) % gsz); u.pn = (wgid % nig) / gsz; return true;
    }
};
template <class Epi, class Ptr, bool ALIGN_EPI, bool SP2>
DEV void gemm_phase(LAS unsigned char* lds, const int tid_in, const int lda, const int ldb, const int K, const Order& S, const Ptr& P, const Epi& E) {
    int tid_ = tid_in; asm volatile("" : "+v"(tid_));
    const int tid = tid_, wid = __builtin_amdgcn_readfirstlane(tid >> 6), lane = tid & 63, wr = wid >> 2, wc = wid & 3, fr = lane & 15, fq = lane >> 4;
    const int nt = K / BK;
    unsigned voffA[2], voffB[2];
#pragma unroll
    for (int i = 0; i < 2; ++i) { int R, C; stage_rc(tid * 16 + i * 8192, R, C); const int Rb = Epi::PERM ? ((R & ~31) + perm32(R & 31)) : R;
        voffA[i] = (unsigned)(R * lda + C) * 2u; voffB[i] = (unsigned)(Rb * ldb + C) * 2u; }
    const size_t kstep = (size_t)(BK * 2);
    const size_t hstepA = (size_t)HALF * lda * 2, hstepB = (size_t)HALF * ldb * 2;
    const unsigned ldsw = (unsigned)wid * 1024u;
    const int aoff = lds_byte(wr * 64 + fr, fq * 8), boff = lds_byte(wc * 32 + fr, fq * 8);
#define PG8_SA(b, h) (((b) * 2 + (h)) * HTB)
#define PG8_SB(b, h) ((4 + (b) * 2 + (h)) * HTB)
#define PG8_STAGE(bufoff, gbase, voff) do { _Pragma("unroll") for (int _i = 0; _i < 2; ++_i) \
        __builtin_amdgcn_global_load_lds((const unsigned*)((const char*)(gbase) + (voff)[_i]), (LAS unsigned*)(lds + (bufoff) + ldsw + _i * 8192), 16, 0, 0); } while (0)
#define PG8_LDA(dst, b, h) do { _Pragma("unroll") for (int m = 0; m < 4; ++m) _Pragma("unroll") for (int k = 0; k < 2; ++k) dst[m][k] = *(const LAS bf16x8*)(lds + PG8_SA(b, h) + aoff + m * 2048 + k * 1024); } while (0)
#define PG8_LDB(dst, b, h) do { _Pragma("unroll") for (int n = 0; n < 2; ++n) _Pragma("unroll") for (int k = 0; k < 2; ++k) dst[n][k] = *(const LAS bf16x8*)(lds + PG8_SB(b, h) + boff + n * 2048 + k * 1024); } while (0)
#define PG8_MMA(ai, bj, At, Bt) do { __builtin_amdgcn_s_setprio(1); _Pragma("unroll") for (int m = 0; m < 4; ++m) _Pragma("unroll") for (int n = 0; n < 2; ++n) _Pragma("unroll") for (int k = 0; k < 2; ++k) \
        acc[ai][bj][m][n] = __builtin_amdgcn_mfma_f32_16x16x32_bf16(Bt[n][k], At[m][k], acc[ai][bj][m][n], 0, 0, 0); __builtin_amdgcn_s_setprio(0); } while (0)
#define PG8_WAIT_V(n) asm volatile("s_waitcnt vmcnt(" #n ")" ::: "memory")
#define PG8_WAIT_L(n) asm volatile("s_waitcnt lgkmcnt(" #n ")" ::: "memory")
#define PG8_BAR __builtin_amdgcn_s_barrier()
#define PG8_SCHED __builtin_amdgcn_sched_barrier(0)
    Unit cur, nxt; int ui = 0;
    if (!S.next(0, cur)) return;
    f32x4 acc[2][2][4][2];
#pragma unroll
    for (int a = 0; a < 2; ++a)
#pragma unroll
        for (int b = 0; b < 2; ++b)
#pragma unroll
            for (int m = 0; m < 4; ++m)
#pragma unroll
                for (int n = 0; n < 2; ++n) acc[a][b][m][n] = (f32x4){0.f, 0.f, 0.f, 0.f};
    bf16x8 At[4][2], B0[2][2], B1[2][2];
    const char* cA = P.a(cur); const char* cB = P.b(cur);
    typename Epi::Pre pre; E.prefetch(pre, cur, wr, fr);
    if constexpr (SP2) {
        PG8_STAGE(PG8_SB(0, 0), cB, voffB); PG8_STAGE(PG8_SB(0, 1), cB + hstepB, voffB); PG8_STAGE(PG8_SA(0, 0), cA, voffA); PG8_STAGE(PG8_SA(0, 1), cA + hstepA, voffA);
        if (wr == 1) PG8_BAR;
        PG8_WAIT_V(2); PG8_BAR;
        PG8_STAGE(PG8_SB(1, 0), cB + kstep, voffB); PG8_STAGE(PG8_SA(1, 0), cA + kstep, voffA); PG8_STAGE(PG8_SB(1, 1), cB + hstepB + kstep, voffB);
        PG8_WAIT_V(6); PG8_BAR;
    } else {
        PG8_STAGE(PG8_SB(0, 0), cB, voffB); PG8_STAGE(PG8_SA(0, 0), cA, voffA); PG8_STAGE(PG8_SB(0, 1), cB + hstepB, voffB); PG8_STAGE(PG8_SA(0, 1), cA + hstepA, voffA);
        if (wr == 1) PG8_BAR;
        PG8_WAIT_V(4); PG8_BAR;
        PG8_STAGE(PG8_SB(1, 0), cB + kstep, voffB); PG8_STAGE(PG8_SA(1, 0), cA + kstep, voffA); PG8_STAGE(PG8_SB(1, 1), cB + hstepB + kstep, voffB);
        PG8_WAIT_V(6); PG8_BAR;
    }
#pragma unroll 1
    for (;;) {
        const bool has_next = S.next(ui + 1, nxt);
        const char* nA = has_next ? P.a(nxt) : cA; const char* nB = has_next ? P.b(nxt) : cB;
#pragma unroll 1
        for (int t = 0; t < nt; t += 2) {
            const bool last = (t == nt - 2);
            const char* a1 = cA + (size_t)(t + 1) * kstep;
            const char* a2 = last ? nA : cA + (size_t)(t + 2) * kstep; const char* b2 = last ? nB : cB + (size_t)(t + 2) * kstep;
            const char* a3 = a2 + kstep; const char* b3 = b2 + kstep;
            if constexpr (SP2) {
            PG8_LDB(B0, 0, 0); PG8_LDB(B1, 0, 1); PG8_SCHED; PG8_LDA(At, 0, 0); PG8_STAGE(PG8_SA(1, 1), a1 + hstepA, voffA);
            PG8_WAIT_V(8); PG8_WAIT_L(0); PG8_BAR; PG8_MMA(0, 0, At, B0); PG8_MMA(0, 1, At, B1); PG8_BAR; PG8_SCHED;
            PG8_LDA(At, 0, 1); PG8_STAGE(PG8_SB(0, 0), b2, voffB); PG8_STAGE(PG8_SB(0, 1), b2 + hstepB, voffB); PG8_STAGE(PG8_SA(0, 0), a2, voffA);
            PG8_WAIT_V(8); PG8_WAIT_L(0); PG8_BAR; PG8_MMA(1, 0, At, B0); PG8_MMA(1, 1, At, B1); PG8_BAR; PG8_SCHED;
            PG8_LDB(B0, 1, 0); PG8_LDB(B1, 1, 1); PG8_SCHED; PG8_LDA(At, 1, 0); PG8_STAGE(PG8_SA(0, 1), a2 + hstepA, voffA);
            PG8_WAIT_V(8); PG8_WAIT_L(0); PG8_BAR; PG8_MMA(0, 0, At, B0); PG8_MMA(0, 1, At, B1); PG8_BAR; PG8_SCHED;
            PG8_LDA(At, 1, 1); PG8_STAGE(PG8_SB(1, 0), b3, voffB); PG8_STAGE(PG8_SB(1, 1), b3 + hstepB, voffB); PG8_STAGE(PG8_SA(1, 0), a3, voffA);
            PG8_WAIT_V(8); PG8_WAIT_L(0); PG8_BAR; PG8_MMA(1, 0, At, B0); PG8_MMA(1, 1, At, B1); PG8_BAR; PG8_SCHED;
            } else {
            PG8_LDB(B0, 0, 0); PG8_SCHED; PG8_LDA(At, 0, 0); PG8_STAGE(PG8_SA(1, 1), a1 + hstepA, voffA);
            PG8_WAIT_L(8); PG8_BAR; PG8_WAIT_L(0); PG8_MMA(0, 0, At, B0); PG8_BAR; PG8_SCHED;
            PG8_LDB(B1, 0, 1); PG8_STAGE(PG8_SB(0, 0), b2, voffB);
            PG8_BAR; PG8_WAIT_L(0); PG8_MMA(0, 1, At, B1); PG8_BAR;
            PG8_LDA(At, 0, 1); PG8_STAGE(PG8_SA(0, 0), a2, voffA);
            PG8_BAR; PG8_WAIT_L(0); PG8_MMA(1, 0, At, B0); PG8_BAR; PG8_SCHED;
            PG8_STAGE(PG8_SB(0, 1), b2 + hstepB, voffB);
            PG8_WAIT_V(6); PG8_BAR; PG8_MMA(1, 1, At, B1); PG8_BAR;
            PG8_LDB(B0, 1, 0); PG8_SCHED; PG8_LDA(At, 1, 0); PG8_STAGE(PG8_SA(0, 1), a2 + hstepA, voffA);
            PG8_WAIT_L(8); PG8_BAR; PG8_WAIT_L(0); PG8_MMA(0, 0, At, B0); PG8_BAR; PG8_SCHED;
            PG8_LDB(B1, 1, 1); PG8_STAGE(PG8_SB(1, 0), b3, voffB);
            PG8_BAR; PG8_WAIT_L(0); PG8_MMA(0, 1, At, B1); PG8_BAR;
            PG8_LDA(At, 1, 1); PG8_STAGE(PG8_SA(1, 0), a3, voffA);
            PG8_BAR; PG8_WAIT_L(0); PG8_MMA(1, 0, At, B0); PG8_BAR; PG8_SCHED;
            PG8_STAGE(PG8_SB(1, 1), b3 + hstepB, voffB);
            PG8_WAIT_V(6); PG8_BAR; PG8_MMA(1, 1, At, B1); PG8_BAR;
            }
        }
        if constexpr (ALIGN_EPI) { if (wr == 0) PG8_BAR; }
        if constexpr (!Epi::AFTER_DRAIN) { int fr_ = fr, fq_ = fq; asm volatile("" : "+v"(fr_), "+v"(fq_));
            E(acc, cur, wr, wc, fr_, fq_, pre); }
        if (!has_next) break;
#pragma unroll
        for (int a = 0; a < 2; ++a)
#pragma unroll
            for (int b = 0; b < 2; ++b)
#pragma unroll
                for (int m = 0; m < 4; ++m)
#pragma unroll
                    for (int n = 0; n < 2; ++n) acc[a][b][m][n] = (f32x4){0.f, 0.f, 0.f, 0.f};
        cur = nxt; cA = nA; cB = nB; ++ui; E.prefetch(pre, cur, wr, fr);
        if constexpr (ALIGN_EPI) { if (wr == 1) PG8_BAR; }
    }
    PG8_WAIT_V(0);
    if constexpr (!ALIGN_EPI) { if (wr == 0) PG8_BAR; }
    PG8_BAR;
    if constexpr (Epi::AFTER_DRAIN) { int fr_ = fr, fq_ = fq, lane_ = lane; asm volatile("" : "+v"(fr_), "+v"(fq_), "+v"(lane_)); E.fused(acc, cur, wr, wc, fr_, fq_, lds, wid, lane_, pre); }
#undef PG8_SA
#undef PG8_SB
#undef PG8_STAGE
#undef PG8_LDA
#undef PG8_LDB
#undef PG8_MMA
#undef PG8_WAIT_V
#undef PG8_WAIT_L
#undef PG8_BAR
#undef PG8_SCHED
}
typedef f32x4 Acc[2][2][4][2];

struct PtrStd {
    const char* A; const char* B; size_t aj, bj, bb, arow, brow;
    DEV const char* a(const Unit& u) const { return A + (size_t)u.job * aj + (size_t)u.pm * arow; }
    DEV const char* b(const Unit& u) const { return B + (size_t)u.job * bj + (size_t)(u.pm >> 5) * bb + (size_t)u.pn * brow; }
};
struct PtrG {
    const char* KVM; const char* WQ;
    DEV const char* a(const Unit& u) const { return KVM + (size_t)(u.job >> 2) * MiB + (size_t)(u.job & 3) * 512; }
    DEV const char* b(const Unit& u) const { return WQ + (size_t)(u.job >> 3) * 2 * MiB + (size_t)(u.job & 3) * 512 + (size_t)u.pn * 256 * 1024 * 2; }
};
struct PtrH {
    const char* KVM; const char* WOT;
    DEV const char* a(const Unit& u) const { return WOT + (size_t)(u.job >> 3) * 2 * MiB + (size_t)(u.job & 3) * 512 + (size_t)u.pm * 256 * 1024 * 2; }
    DEV const char* b(const Unit& u) const { return KVM + (size_t)(u.job >> 2) * MiB + 2048 + (size_t)(u.job & 3) * 512; }
};

#define EPI_ROWS(u) const int row0 = (u).pm * BM + wr * 64 + fr
DEV u32x4 pack8(const f32x4 v0, const f32x4 v1) { u32x4 w; w.x = cvt_pk_bf16(v0[0], v0[1]); w.y = cvt_pk_bf16(v0[2], v0[3]); w.z = cvt_pk_bf16(v1[0], v1[1]); w.w = cvt_pk_bf16(v1[2], v1[3]); return w; }

struct PreNone {};
typedef unsigned long long u64;
constexpr float SS_SCALE = 65536.f;
struct PreRs { u64 v[2][4]; };
DEV void pre_rs(PreRs& p, const u64* ss, int row0) {
#pragma unroll
    for (int ai = 0; ai < 2; ++ai)
#pragma unroll
        for (int m = 0; m < 4; ++m) p.v[ai][m] = __builtin_nontemporal_load(ss + row0 + ai * HALF + m * 16);
}
DEV void rs_of(float (&rs)[2][4], const PreRs& p) {
#pragma unroll
    for (int ai = 0; ai < 2; ++ai)
#pragma unroll
        for (int m = 0; m < 4; ++m) rs[ai][m] = rsqrtf((float)p.v[ai][m] * (1.f / (SS_SCALE * D)) + EPS);
}
struct EpiInProj {
    typedef PreRs Pre;
    DEV void prefetch(PreRs& p, const Unit& u, int wr, int fr) const { pre_rs(p, ss, u.pm * BM + wr * 64 + fr); }
    static constexpr bool PERM = true, AFTER_DRAIN = false;
    unsigned char* ws; const u64* ss;
    DEV void operator()(const Acc& acc, const Unit& u, int wr, int wc, int fr, int fq, const PreRs& pre) const {
        EPI_ROWS(u); const int pn = u.pn, cb = wc * 32 + 8 * fq;
        float rs[2][4]; rs_of(rs, pre);
        if (pn < 16) {
            const int g = pn >> 1;
            const size_t off = g == 0 ? WS_QA : g == 1 ? WS_KA : g == 2 ? WS_VA : g == 3 ? WS_QC : g == 4 ? WS_KC : g == 5 ? WS_VC : g == 6 ? WS_IQ : WS_SCB;
            const float sc = (g == 0 || g == 3) ? QSCALE : 1.f;
            bf16_t* base = (bf16_t*)(ws + off) + (pn & 1) * 256 + cb;
#pragma unroll
            for (int ai = 0; ai < 2; ++ai)
#pragma unroll
                for (int m = 0; m < 4; ++m) { bf16_t* rowp = base + (size_t)(row0 + ai * HALF + m * 16) * 512;
#pragma unroll
                    for (int bj = 0; bj < 2; ++bj) *(u32x4*)(rowp + bj * HALF) = pack8(acc[ai][bj][m][0] * (sc * rs[ai][m]), acc[ai][bj][m][1] * (sc * rs[ai][m])); }
        } else if (pn < 20) {
            bf16_t* base = (bf16_t*)(ws + WS_CX) + (pn - 16) * 128 + cb;
#pragma unroll
            for (int ai = 0; ai < 2; ++ai)
#pragma unroll
                for (int m = 0; m < 4; ++m) { const float r2 = rs[ai][m] * rs[ai][m]; *(u32x4*)(base + (size_t)(row0 + ai * HALF + m * 16) * 512) = pack8(acc[ai][0][m][0] * acc[ai][1][m][0] * r2, acc[ai][0][m][1] * acc[ai][1][m][1] * r2); }
        } else {
            if (wc < 2) { bf16_t* base = (bf16_t*)(ws + WS_IK);
#pragma unroll
                for (int ai = 0; ai < 2; ++ai)
#pragma unroll
                    for (int m = 0; m < 4; ++m) { const int t = row0 + ai * HALF + m * 16;
                        *(u32x4*)(base + (size_t)(t >> 5) * 2048 + (((cb >> 3) * 32 + (t & 31)) * 8)) = pack8(acc[ai][0][m][0] * rs[ai][m], acc[ai][0][m][1] * rs[ai][m]); }
            } else if (wc == 2 && fq == 0) { float* base = (float*)(ws + WS_IW);
#pragma unroll
                for (int ai = 0; ai < 2; ++ai)
#pragma unroll
                    for (int m = 0; m < 4; ++m) { float* p = base + (size_t)(row0 + ai * HALF + m * 16) * 8; *(f32x4*)p = acc[ai][0][m][0] * (WSCALE * rs[ai][m]); *(f32x4*)(p + 4) = acc[ai][0][m][1] * (WSCALE * rs[ai][m]); }
            }
        }
    }
};
DEV f32x4 sigm4(const f32x4 v) { f32x4 o;
#pragma unroll
    for (int i = 0; i < 4; ++i) o[i] = __builtin_amdgcn_rcpf(1.f + __builtin_amdgcn_exp2f(-LOG2E * v[i])); return o; }
struct EpiGates {
    typedef PreRs Pre;
    DEV void prefetch(PreRs& p, const Unit& u, int wr, int fr) const { pre_rs(p, ss, u.pm * BM + wr * 64 + fr); }
    static constexpr bool PERM = true, AFTER_DRAIN = false;
    bf16_t* G; const u64* ss;
    DEV void operator()(const Acc& acc, const Unit& u, int wr, int wc, int fr, int fq, const PreRs& pre) const {
        EPI_ROWS(u); float rs[2][4]; rs_of(rs, pre); bf16_t* base = G + (size_t)(u.pn >> 2) * T * D + (u.pn & 3) * 256 + wc * 32 + 8 * fq;
#pragma unroll
        for (int ai = 0; ai < 2; ++ai)
#pragma unroll
            for (int m = 0; m < 4; ++m) { bf16_t* rowp = base + (size_t)(row0 + ai * HALF + m * 16) * D;
#pragma unroll
                for (int bj = 0; bj < 2; ++bj) *(u32x4*)(rowp + bj * HALF) = pack8(sigm4(acc[ai][bj][m][0] * rs[ai][m]), sigm4(acc[ai][bj][m][1] * rs[ai][m])); }
    }
};
struct EpiMerge {
    typedef PreNone Pre;
    DEV void prefetch(PreNone&, const Unit&, int, int) const {}
    static constexpr bool PERM = true, AFTER_DRAIN = false;
    bf16_t* M; const bf16_t* G;
    DEV void operator()(const Acc& acc, const Unit& u, int wr, int wc, int fr, int fq, const PreNone&) const {
        EPI_ROWS(u); const size_t cofs = (size_t)u.pn * 256 + wc * 32 + 8 * fq; const bf16_t* gb = G + (size_t)u.job * T * D;
#pragma unroll
        for (int ai = 0; ai < 2; ++ai) {
            u32x4 g[8], p[8];
#pragma unroll
            for (int m = 0; m < 4; ++m)
#pragma unroll
                for (int bj = 0; bj < 2; ++bj) { const size_t o = (size_t)(row0 + ai * HALF + m * 16) * D + cofs + bj * HALF; g[2 * m + bj] = *(const u32x4*)(gb + o);
                    if (u.job > 0) p[2 * m + bj] = __builtin_nontemporal_load((const u32x4*)(M + o)); }
#pragma unroll
            for (int m = 0; m < 4; ++m)
#pragma unroll
                for (int bj = 0; bj < 2; ++bj) { const size_t o = (size_t)(row0 + ai * HALF + m * 16) * D + cofs + bj * HALF; const u32x4 gg = g[2 * m + bj];
                    f32x4 v0 = acc[ai][bj][m][0], v1 = acc[ai][bj][m][1];
                    v0[0] *= bflo(gg.x); v0[1] *= bfhi(gg.x); v0[2] *= bflo(gg.y); v0[3] *= bfhi(gg.y); v1[0] *= bflo(gg.z); v1[1] *= bfhi(gg.z); v1[2] *= bflo(gg.w); v1[3] *= bfhi(gg.w);
                    if (u.job > 0) { const u32x4 pp = p[2 * m + bj];
                        v0[0] += bflo(pp.x); v0[1] += bfhi(pp.x); v0[2] += bflo(pp.y); v0[3] += bfhi(pp.y); v1[0] += bflo(pp.z); v1[1] += bfhi(pp.z); v1[2] += bflo(pp.w); v1[3] += bfhi(pp.w); }
                    *(u32x4*)(M + o) = pack8(v0, v1); }
        }
    }
};
template <bool IN_F32> struct EpiResid {
    typedef PreNone Pre;
    DEV void prefetch(PreNone&, const Unit&, int, int) const {}
    static constexpr bool PERM = true, AFTER_DRAIN = false;
    const void* xin; bf16_t* xb; u64* ss;
    DEV void operator()(const Acc& acc, const Unit& u, int wr, int wc, int fr, int fq, const PreNone&) const {
        EPI_ROWS(u); const size_t cofs = (size_t)u.pn * 256 + wc * 32 + 8 * fq;
#pragma unroll
        for (int ai = 0; ai < 2; ++ai) {
            f32x4 r0[8], r1[8];
#pragma unroll
            for (int m = 0; m < 4; ++m)
#pragma unroll
                for (int bj = 0; bj < 2; ++bj) { const size_t o = (size_t)(row0 + ai * HALF + m * 16) * D + cofs + bj * HALF; const int k = 2 * m + bj;
                    if (IN_F32) { r0[k] = *(const f32x4*)((const float*)xin + o); r1[k] = *(const f32x4*)((const float*)xin + o + 4); }
                    else { const u32x4 p = *(const u32x4*)((const bf16_t*)xin + o); r0[k] = __builtin_bit_cast(f32x4, p); } }
#pragma unroll
            for (int m = 0; m < 4; ++m) { const size_t ro = (size_t)(row0 + ai * HALF + m * 16) * D + cofs; float sq = 0.f;
#pragma unroll
                for (int bj = 0; bj < 2; ++bj) { const size_t o = ro + bj * HALF; const int k = 2 * m + bj; f32x4 v0 = acc[ai][bj][m][0], v1 = acc[ai][bj][m][1];
                    if (IN_F32) { v0 = v0 + r0[k]; v1 = v1 + r1[k]; }
                    else { const u32x4 p = __builtin_bit_cast(u32x4, r0[k]);
                        v0[0] += bflo(p.x); v0[1] += bfhi(p.x); v0[2] += bflo(p.y); v0[3] += bfhi(p.y); v1[0] += bflo(p.z); v1[1] += bfhi(p.z); v1[2] += bflo(p.w); v1[3] += bfhi(p.w); }
                    *(u32x4*)(xb + o) = pack8(v0, v1);
                    sq += ((v0[0] * v0[0] + v0[1] * v0[1]) + (v0[2] * v0[2] + v0[3] * v0[3])) + ((v1[0] * v1[0] + v1[1] * v1[1]) + (v1[2] * v1[2] + v1[3] * v1[3])); }
                sq += __shfl_xor(sq, 16); sq += __shfl_xor(sq, 32);
                if (fq == 0) atomicAdd(ss + row0 + ai * HALF + m * 16, (u64)(sq * SS_SCALE + 0.5f)); }
        }
    }
};
DEV float gelu_t(float a) { return a * __builtin_amdgcn_rcpf(1.f + __builtin_amdgcn_exp2f(-1.5957691216057308f * LOG2E * (a + 0.044715f * a * a * a))); }
DEV float row_prev1(float cur, float prevm) { const int r = __builtin_amdgcn_update_dpp(0, (int)__float_as_uint(prevm), 0x121, 0xf, 0xf, false);
    return __uint_as_float((unsigned)__builtin_amdgcn_update_dpp(r, (int)__float_as_uint(cur), 0x111, 0xf, 0xf, false)); }
DEV float row_prev2(float cur, float prevm) { const int r = __builtin_amdgcn_update_dpp(0, (int)__float_as_uint(prevm), 0x122, 0xf, 0xf, false);
    return __uint_as_float((unsigned)__builtin_amdgcn_update_dpp(r, (int)__float_as_uint(cur), 0x112, 0xf, 0xf, false)); }
struct EpiUpF {
    typedef PreRs Pre;
    DEV void prefetch(PreRs& p, const Unit& u, int wr, int fr) const { pre_rs(p, ss, u.pm * BM + wr * 64 + fr); }
    static constexpr bool PERM = true, AFTER_DRAIN = false;
    bf16_t *fu, *sa, *su; const u64* ss; const float *cw, *cb;
    DEV void operator()(const Acc& acc, const Unit& u, int wr, int wc, int fr, int fq, const PreRs& pre) const {
        EPI_ROWS(u); float rs[2][4]; rs_of(rs, pre); const size_t cofs = (size_t)u.pn * 128 + wc * 32 + 8 * fq;
        f32x4 w0[2], w1[2], w2[2], bb[2];
#pragma unroll
        for (int n = 0; n < 2; ++n) { w0[n] = *(const f32x4*)(cw + cofs + 4 * n); w1[n] = *(const f32x4*)(cw + DFF + cofs + 4 * n); w2[n] = *(const f32x4*)(cw + 2 * DFF + cofs + 4 * n); bb[n] = *(const f32x4*)(cb + cofs + 4 * n); }
#pragma unroll
        for (int ai = 0; ai < 2; ++ai) {
            const size_t strip = (size_t)u.pm * 4 + ai * 2 + wr;
            f32x4 ap[2] = {{0.f, 0.f, 0.f, 0.f}, {0.f, 0.f, 0.f, 0.f}};
#pragma unroll
            for (int m = 0; m < 4; ++m) {
                f32x4 a[2], g[2];
#pragma unroll
                for (int n = 0; n < 2; ++n) { a[n] = acc[ai][0][m][n] * rs[ai][m];
#pragma unroll
                    for (int e = 0; e < 4; ++e) { const float a1 = row_prev1(a[n][e], ap[n][e]), a2 = row_prev2(a[n][e], ap[n][e]);
                        g[n][e] = gelu_t(bb[n][e] + w0[n][e] * a2 + w1[n][e] * a1 + w2[n][e] * a[n][e]) * (acc[ai][1][m][n][e] * rs[ai][m]); } }
                if (m == 0) {
                    if (fr < 2) { *(u32x4*)(sa + (strip * 4 + fr) * DFF + cofs) = pack8(a[0], a[1]); *(u32x4*)(su + (strip * 2 + fr) * DFF + cofs) = pack8(acc[ai][1][0][0] * rs[ai][0], acc[ai][1][0][1] * rs[ai][0]); }
                    else *(u32x4*)(fu + (size_t)(row0 + ai * HALF) * DFF + cofs) = pack8(g[0], g[1]);
                } else {
                    *(u32x4*)(fu + (size_t)(row0 + ai * HALF + m * 16) * DFF + cofs) = pack8(g[0], g[1]);
                    if (m == 3 && fr >= 14) *(u32x4*)(sa + (strip * 4 + 2 + (fr - 14)) * DFF + cofs) = pack8(a[0], a[1]);
                }
                ap[0] = a[0]; ap[1] = a[1];
            }
        }
    }
};
struct EpiPrep {
    typedef PreNone Pre;
    DEV void prefetch(PreNone&, const Unit&, int, int) const {}
    static constexpr bool PERM = true, AFTER_DRAIN = false;
    unsigned char* ws; int mode;
    DEV void operator()(const Acc& acc, const Unit& u, int wr, int wc, int fr, int fq, const PreNone&) const {
        EPI_ROWS(u); bf16_t* base; int ldc; float sc = 1.f;
        if (mode == 0) { base = (bf16_t*)(ws + WS_KVM + (size_t)u.job * 2 * MiB); ldc = 2 * D; }
        else if (mode == 1) { base = (bf16_t*)(ws + WS_GT + (size_t)(u.job >> 2) * 2 * MiB) + (size_t)(u.job & 3) * 256 * D; ldc = D; sc = XSCALE; }
        else { base = (bf16_t*)(ws + WS_HT + (size_t)(u.job >> 2) * 2 * MiB) + (u.job & 3) * 256; ldc = D; }
        base += (size_t)u.pn * 256 + wc * 32 + 8 * fq;
#pragma unroll
        for (int ai = 0; ai < 2; ++ai)
#pragma unroll
            for (int m = 0; m < 4; ++m) { bf16_t* rowp = base + (size_t)(row0 + ai * HALF + m * 16) * ldc;
#pragma unroll
                for (int bj = 0; bj < 2; ++bj) *(u32x4*)(rowp + bj * HALF) = pack8(acc[ai][bj][m][0] * sc, acc[ai][bj][m][1] * sc); }
    }
};
struct EpiSoftmax {
    typedef PreRs Pre;
    DEV void prefetch(PreRs& p, const Unit& u, int wr, int fr) const { pre_rs(p, ss, u.pm * BM + wr * 64 + fr); }
    static constexpr bool PERM = true, AFTER_DRAIN = true;
    bf16_t* P; const u64* ss;
    DEV void fused(Acc& acc, const Unit& u, int wr, int wc, int fr, int fq, LAS unsigned char* lds, int wid, int lane, const PreRs& pre) const {
        LAS float* PM = (LAS float*)lds; LAS float* PS = (LAS float*)(lds + 4096);
        { const int row0_ = u.pm * BM + wr * 64 + fr; float rs[2][4]; rs_of(rs, pre);
#pragma unroll
          for (int ai = 0; ai < 2; ++ai)
#pragma unroll
              for (int m = 0; m < 4; ++m)
#pragma unroll
                  for (int bj = 0; bj < 2; ++bj)
#pragma unroll
                      for (int n = 0; n < 2; ++n) acc[ai][bj][m][n] = acc[ai][bj][m][n] * rs[ai][m]; }
#pragma unroll
        for (int ai = 0; ai < 2; ++ai)
#pragma unroll
            for (int m = 0; m < 4; ++m) { float mx = -INFINITY;
#pragma unroll
                for (int bj = 0; bj < 2; ++bj)
#pragma unroll
                    for (int n = 0; n < 2; ++n) { const f32x4 x = acc[ai][bj][m][n]; mx = fmaxf(mx, fmaxf(fmaxf(x[0], x[1]), fmaxf(x[2], x[3]))); }
                mx = fmaxf(mx, __shfl_xor(mx, 16)); mx = fmaxf(mx, __shfl_xor(mx, 32));
                if (fq == 0) PM[(ai * HALF + wr * 64 + m * 16 + fr) * 4 + wc] = mx; }
        LDS_WAIT(); __builtin_amdgcn_s_barrier(); asm volatile("" ::: "memory");
#pragma unroll
        for (int ai = 0; ai < 2; ++ai)
#pragma unroll
            for (int m = 0; m < 4; ++m) { const int r = ai * HALF + wr * 64 + m * 16 + fr; const f32x4 q = *(const LAS f32x4*)(PM + r * 4);
                const float mx = fmaxf(fmaxf(q[0], q[1]), fmaxf(q[2], q[3])); float s = 0.f;
#pragma unroll
                for (int bj = 0; bj < 2; ++bj)
#pragma unroll
                    for (int n = 0; n < 2; ++n) { f32x4 x = acc[ai][bj][m][n];
#pragma unroll
                        for (int i = 0; i < 4; ++i) { x[i] = __builtin_amdgcn_exp2f(x[i] - mx); s += x[i]; } acc[ai][bj][m][n] = x; }
                s += __shfl_xor(s, 16); s += __shfl_xor(s, 32);
                if (fq == 0) PS[r * 4 + wc] = s; }
        LDS_WAIT(); __builtin_amdgcn_s_barrier(); asm volatile("" ::: "memory");
        EPI_ROWS(u); bf16_t* base = P + (size_t)u.pn * 256 + wc * 32 + 8 * fq;
#pragma unroll
        for (int ai = 0; ai < 2; ++ai)
#pragma unroll
            for (int m = 0; m < 4; ++m) { const int r = ai * HALF + wr * 64 + m * 16 + fr; const f32x4 q = *(const LAS f32x4*)(PS + r * 4);
                const float inv = 1.f / ((q[0] + q[1]) + (q[2] + q[3])); bf16_t* rowp = base + (size_t)(row0 + ai * HALF + m * 16) * D;
#pragma unroll
                for (int bj = 0; bj < 2; ++bj) *(u32x4*)(rowp + bj * HALF) = pack8(acc[ai][bj][m][0] * inv, acc[ai][bj][m][1] * inv); }
        LDS_WAIT(); __builtin_amdgcn_s_barrier();
    }
};
}

typedef GAS unsigned gu32;
#define XB_TMO      128
#define XB_XCNT(j)  (256  + 64 * (j))
#define XB_XSUB(j)  (1280 + 64 * (j))
#define XB_XGEN(j)  (2304 + 64 * (j))
#define XB_TOP      3328
#define XB_TOPGEN   3392
#define XCD_BAR_WORDS 3456
#define XB_SPIN_CAP (1u << 22)
DEV unsigned xb_ld(unsigned* p) { return __hip_atomic_load(p, __ATOMIC_RELAXED, __HIP_MEMORY_SCOPE_AGENT); }
DEV unsigned xb_add(unsigned* p, unsigned v) { return __hip_atomic_fetch_add(p, v, __ATOMIC_RELAXED, __HIP_MEMORY_SCOPE_AGENT); }
DEV unsigned xb_xcc_id() { return (unsigned)__builtin_amdgcn_s_getreg((3 << 11) | 20) & 0xFu; }
#define XB_SPIN(cond, bar) do { unsigned _sp = 0; while (cond) { __builtin_amdgcn_s_sleep(1); \
    if ((++_sp & 255u) == 0u) { if (xb_ld(&(bar)[XB_TMO])) break; if (_sp > XB_SPIN_CAP) { atomicAdd(&(bar)[XB_TMO], 1u); break; } } } } while (0)
struct XcdBarrier { unsigned* bar; unsigned x; volatile LAS unsigned* st; };
DEV XcdBarrier xcd_barrier_post(unsigned* bar, volatile LAS unsigned* st, int tid) {
    XcdBarrier b; b.bar = bar; b.x = xb_xcc_id(); b.st = st;
    if (tid == 0) (void)xb_add(&bar[XB_XCNT(b.x)], 1u);
    return b;
}
DEV void xcd_barrier_complete(unsigned* bar, unsigned x, unsigned& nloc, unsigned& nx) {
    const unsigned G = gridDim.x * gridDim.y * gridDim.z;
    unsigned sum, cnt, mine, sp = 0u;
    for (;;) {
        sum = 0u; cnt = 0u; mine = 0u;
#pragma unroll
        for (unsigned j = 0; j < 16; ++j) { const unsigned c = xb_ld(&bar[XB_XCNT(j)]); sum += c; cnt += (c > 0u) ? 1u : 0u; mine = (j == x) ? c : mine; }
        if (sum == G) break;
        __builtin_amdgcn_s_sleep(1);
        if ((++sp & 255u) == 0u) { if (xb_ld(&bar[XB_TMO])) break; if (sp > XB_SPIN_CAP) { atomicAdd(&bar[XB_TMO], 1u); break; } }
    }
    nloc = mine > 0u ? mine : 1u; nx = cnt > 0u ? cnt : 1u;
}
DEV void xcd_barrier(const XcdBarrier& b, int tid) {
    asm volatile("s_waitcnt vmcnt(0)" ::: "memory");
    __syncthreads();
    if (tid == 0) {
        unsigned* bar = b.bar;
        __builtin_amdgcn_s_waitcnt(0);
        unsigned nloc = b.st[0], nx = b.st[1];
        if (nloc == 0u) { xcd_barrier_complete(bar, b.x, nloc, nx); b.st[0] = nloc; b.st[1] = nx; }
        const unsigned old = xb_add(&bar[XB_XSUB(b.x)], 1u);
        const unsigned gen = old / nloc;
        if (old + 1u == (gen + 1u) * nloc) {
            __builtin_amdgcn_fence(__ATOMIC_RELEASE, "agent");
            asm volatile("s_waitcnt vmcnt(0)" ::: "memory");
            const unsigned og = xb_add(&bar[XB_TOP], 1u);
            const unsigned tg = og / nx;
            if (og + 1u == (tg + 1u) * nx) xb_add(&bar[XB_TOPGEN], 1u);
            else XB_SPIN(xb_ld(&bar[XB_TOPGEN]) == tg, bar);
            __builtin_amdgcn_fence(__ATOMIC_ACQUIRE, "agent");
            xb_add(&bar[XB_XGEN(b.x)], 1u);
            asm volatile("s_waitcnt vmcnt(0)" ::: "memory");
        } else {
            XB_SPIN(xb_ld(&bar[XB_XGEN(b.x)]) == gen, bar);
            __builtin_amdgcn_fence(__ATOMIC_ACQUIRE, "agent");
            asm volatile("s_waitcnt vmcnt(0)" ::: "memory");
        }
    }
    __syncthreads();
}


using pg8::gelu_t;
struct WaveId { int gw, ngw, wave, lane; };
DEV unsigned f2bf_u(float f) { return (unsigned)f2bf(f); }
DEV unsigned pk2(float lo, float hi) { return cvt_pk_bf16(lo, hi); }

DEV void norm_rows(const WaveId& W, const float* x, const float* g, bf16_t* outb, float* outf, int rows) {
    for (int row = W.gw; row < rows; row += W.ngw) {
        const f32x4* xr = (const f32x4*)(x + (size_t)row * D) + W.lane;
        f32x4 v[4]; float s = 0.f;
#pragma unroll
        for (int j = 0; j < 4; ++j) { v[j] = xr[64 * j]; s += (v[j].x * v[j].x + v[j].y * v[j].y) + (v[j].z * v[j].z + v[j].w * v[j].w); }
        const float r = rsqrtf(wave_sum(s) * (1.f / D) + EPS);
#pragma unroll
        for (int j = 0; j < 4; ++j) {
            const f32x4 gg = ((const f32x4*)g)[W.lane + 64 * j];
            const f32x4 o = {v[j].x * r * gg.x, v[j].y * r * gg.y, v[j].z * r * gg.z, v[j].w * r * gg.w};
            if (outb) { u32x2 w; w.x = pk2(o.x, o.y); w.y = pk2(o.z, o.w); ((u32x2*)(outb + (size_t)row * D))[W.lane + 64 * j] = w; }
            else ((f32x4*)(outf + (size_t)row * D))[W.lane + 64 * j] = o;
        }
    }
}
DEV void cvt_piece(const WaveId& W, LAS float* scr, int& base, const float* Wsrc, int ldw, int K, int col0, int ncols, bf16_t* dst, int ldo, int row0, const float* gain = nullptr) {
    const int nblk = ncols / 32, nitems = (K / 64) * nblk;
    int first = (W.gw - base) % W.ngw; if (first < 0) first += W.ngw;
    base = (base + nitems) % W.ngw;
    for (int item = first; item < nitems; item += W.ngw) {
        const int kb = item / nblk, nb = item - kb * nblk, k0 = 64 * kb, n0 = 32 * nb;
        { const int lr = W.lane >> 3, lc = (W.lane & 7) * 4;
          f32x4 v[8]; float g[8];
#pragma unroll
          for (int i = 0; i < 8; ++i) { v[i] = *(const f32x4*)(Wsrc + (size_t)(k0 + lr + 8 * i) * ldw + col0 + n0 + lc); g[i] = gain ? gain[k0 + lr + 8 * i] : 1.f; }
#pragma unroll
          for (int i = 0; i < 8; ++i) { LAS float* d = scr + (lr + 8 * i) * 33 + lc; d[0] = v[i][0] * g[i]; d[1] = v[i][1] * g[i]; d[2] = v[i][2] * g[i]; d[3] = v[i][3] * g[i]; } }
        LDS_WAIT(); asm volatile("" ::: "memory");
        const int c = W.lane & 7;
#pragma unroll
        for (int j = 0; j < 4; ++j) { const int n = (W.lane >> 3) + 8 * j; const LAS float* s = scr + (8 * c) * 33 + n;
            u32x4 o; o.x = pk2(s[0 * 33], s[1 * 33]); o.y = pk2(s[2 * 33], s[3 * 33]); o.z = pk2(s[4 * 33], s[5 * 33]); o.w = pk2(s[6 * 33], s[7 * 33]);
            *(u32x4*)(dst + (size_t)(row0 + n0 + n) * ldo + k0 + 8 * c) = o; }
        LDS_WAIT(); asm volatile("" ::: "memory");
    }
}
DEV void convert_layer_weights(const WaveId& W, LAS float* scr, int& base, unsigned char* ws, const float* const* in, int l, int part = 3) {
    const float* wi = in[3] + (size_t)l * D * DIN;
    if (part & 1) {
    bf16_t* WIN = (bf16_t*)(ws + WS_WIN); const float* gm = in[2] + l * D;
    cvt_piece(W, scr, base, wi, DIN, D, 0, 1536, WIN, D, 0, gm);
    cvt_piece(W, scr, base, wi, DIN, D, 3072, 1536, WIN, D, 1536, gm);
    cvt_piece(W, scr, base, wi, DIN, D, 4608, 512, WIN, D, 3072, gm);
    cvt_piece(W, scr, base, wi, DIN, D, 1536, 512, WIN, D, 3584, gm);
#pragma unroll 1
    for (int j = 0; j < 4; ++j) { cvt_piece(W, scr, base, wi, DIN, D, 2048 + 128 * j, 128, WIN, D, 4096 + 256 * j, gm); cvt_piece(W, scr, base, wi, DIN, D, 2560 + 128 * j, 128, WIN, D, 4096 + 256 * j + 128, gm); }
    cvt_piece(W, scr, base, wi, DIN, D, 5120, 96, WIN, D, 5120, gm);
    cvt_piece(W, scr, base, wi, DIN, D, 5192, 3072, (bf16_t*)(ws + WS_WG), D, 0, gm);
#pragma unroll 1
    for (int i = 0; i < 3; ++i) cvt_piece(W, scr, base, in[5 + i] + (size_t)l * 512 * D, D, 512, 0, D, (bf16_t*)(ws + WS_WBR) + (size_t)i * D * 512, 512, 0);
    cvt_piece(W, scr, base, in[8] + (size_t)l * D * D, D, D, 0, D, (bf16_t*)(ws + WS_WMIX), D, 0);
    }
    if (!(part & 2)) return;
    const float* gf = in[14] + l * D;
    const float* wf = in[15] + (size_t)l * D * 2 * DFF;
#pragma unroll 1
    for (int j = 0; j < 22; ++j) { cvt_piece(W, scr, base, wf, 2 * DFF, D, 128 * j, 128, (bf16_t*)(ws + WS_WUP), D, 256 * j, gf); cvt_piece(W, scr, base, wf, 2 * DFF, D, DFF + 128 * j, 128, (bf16_t*)(ws + WS_WUP), D, 256 * j + 128, gf); }
    cvt_piece(W, scr, base, in[18] + (size_t)l * DFF * D, D, DFF, 0, D, (bf16_t*)(ws + WS_WDOWN), DFF, 0);
}
DEV void prep0_phase(const WaveId& W, LAS float* scr, unsigned char* ws, const float* const* in, bf16_t* XB) {
    int base = 0;
#pragma unroll 1
    for (int l = 0; l < DEPTH; ++l) {
        const float* wq = in[11] + (size_t)l * D * D; bf16_t* WQ = (bf16_t*)(ws + WS_WQ + (size_t)l * 2 * MiB); const float* gx = in[9] + l * D;
        for (size_t i = (size_t)(W.gw * 64 + W.lane) * 4; i < (size_t)D * D; i += (size_t)W.ngw * 256) { const float g = gx[i >> 10]; const f32x4 v = *(const f32x4*)(wq + i); u32x2 o; o.x = pk2(v.x * g, v.y * g); o.y = pk2(v.z * g, v.w * g); *(u32x2*)(WQ + i) = o; }
        cvt_piece(W, scr, base, in[13] + (size_t)l * D * D, D, D, 0, D, (bf16_t*)(ws + WS_WOT + (size_t)l * 2 * MiB), D, 0);
        cvt_piece(W, scr, base, in[12] + (size_t)l * D * 2 * D, 2 * D, D, 0, 2 * D, (bf16_t*)(ws + WS_WKVT + (size_t)l * 4 * MiB), D, 0);
        norm_rows(W, in[1], in[10] + l * D, (bf16_t*)(ws + WS_MEMN + (size_t)l * MiB), nullptr, NB * MEM);
    }
    convert_layer_weights(W, scr, base, ws, in, 0);
    pg8::u64* ss0 = (pg8::u64*)(ws + WS_SS);
    for (int row0 = W.gw; row0 < T; row0 += 4 * W.ngw) {
        f32x4 v[4][4];
#pragma unroll
        for (int u = 0; u < 4; ++u) { const f32x4* xr = (const f32x4*)(in[0] + (size_t)(row0 + u * W.ngw) * D) + W.lane;
#pragma unroll
            for (int j = 0; j < 4; ++j) v[u][j] = xr[64 * j]; }
#pragma unroll
        for (int u = 0; u < 4; ++u) { const int row = row0 + u * W.ngw; float s = 0.f;
#pragma unroll
            for (int j = 0; j < 4; ++j) { const f32x4 x = v[u][j]; s += (x.x * x.x + x.y * x.y) + (x.z * x.z + x.w * x.w);
                u32x2 w; w.x = pk2(x.x, x.y); w.y = pk2(x.z, x.w); ((u32x2*)(XB + (size_t)row * D))[W.lane + 64 * j] = w; }
            s = wave_sum(s); if (W.lane == 0) ss0[row] = (pg8::u64)(s * pg8::SS_SCALE + 0.5f); }
    }
}
DEV void final_norm(const WaveId& W, const bf16_t* x, float* out, const float* g, const pg8::u64* ss) {
    f32x4 gg[4];
#pragma unroll
    for (int j = 0; j < 4; ++j) gg[j] = ((const f32x4*)g)[W.lane + 64 * j];
    for (int row0 = W.gw; row0 < T; row0 += 4 * W.ngw) {
        u32x2 v[4][4]; pg8::u64 sq[4];
#pragma unroll
        for (int u = 0; u < 4; ++u) { const int row = row0 + u * W.ngw; sq[u] = ss[row]; const u32x2* xr = (const u32x2*)(x + (size_t)row * D) + W.lane;
#pragma unroll
            for (int j = 0; j < 4; ++j) v[u][j] = xr[64 * j]; }
#pragma unroll
        for (int u = 0; u < 4; ++u) { const int row = row0 + u * W.ngw; const float r = rsqrtf((float)sq[u] * (1.f / (pg8::SS_SCALE * D)) + EPS); f32x4* orow = (f32x4*)(out + (size_t)row * D) + W.lane;
#pragma unroll
            for (int j = 0; j < 4; ++j) { const u32x2 w = v[u][j];
                const f32x4 o = {bflo(w.x) * r * gg[j].x, bfhi(w.x) * r * gg[j].y, bflo(w.y) * r * gg[j].z, bfhi(w.y) * r * gg[j].w}; orow[64 * j] = o; } }
    }
}
DEV void conv_sc_phase(int gtid, int gthreads, bf16_t* scb, const bf16_t* cx, const float* w, bool dry) {
    const int c8 = (gtid & 63) * 8;
    const f32x4 w0a = *(const f32x4*)(w + c8), w0b = *(const f32x4*)(w + c8 + 4), w1a = *(const f32x4*)(w + 512 + c8), w1b = *(const f32x4*)(w + 512 + c8 + 4), w2a = *(const f32x4*)(w + 1024 + c8), w2b = *(const f32x4*)(w + 1024 + c8 + 4);
    const u32x4 z = {0u, 0u, 0u, 0u};
    for (int i0 = gtid; i0 < T * 64; i0 += 4 * gthreads) {
        u32x4 x2[4], x1[4], x0[4], bb[4];
#pragma unroll
        for (int u = 0; u < 4; ++u) { const int i = i0 + u * gthreads; if (i < T * 64) { const int t = i >> 6, tl = t & (S - 1); const size_t o = (size_t)t * 512 + c8;
            x2[u] = *(const u32x4*)(cx + o); x1[u] = tl >= 1 ? *(const u32x4*)(cx + o - 512) : z; x0[u] = tl >= 2 ? *(const u32x4*)(cx + o - 1024) : z; bb[u] = *(const u32x4*)(scb + o); } }
#pragma unroll
        for (int u = 0; u < 4; ++u) { const int i = i0 + u * gthreads; if (i < T * 64) { const size_t o = (size_t)(i >> 6) * 512 + c8;
            float r[8];
#define CONV1(k, W0, W1, W2, X0, X1, X2, BBv, F) r[k] = F(BBv) * (W0 * F(X0) + W1 * F(X1) + W2 * F(X2))
            CONV1(0, w0a.x, w1a.x, w2a.x, x0[u].x, x1[u].x, x2[u].x, bb[u].x, bflo); CONV1(1, w0a.y, w1a.y, w2a.y, x0[u].x, x1[u].x, x2[u].x, bb[u].x, bfhi);
            CONV1(2, w0a.z, w1a.z, w2a.z, x0[u].y, x1[u].y, x2[u].y, bb[u].y, bflo); CONV1(3, w0a.w, w1a.w, w2a.w, x0[u].y, x1[u].y, x2[u].y, bb[u].y, bfhi);
            CONV1(4, w0b.x, w1b.x, w2b.x, x0[u].z, x1[u].z, x2[u].z, bb[u].z, bflo); CONV1(5, w0b.y, w1b.y, w2b.y, x0[u].z, x1[u].z, x2[u].z, bb[u].z, bfhi);
            CONV1(6, w0b.z, w1b.z, w2b.z, x0[u].w, x1[u].w, x2[u].w, bb[u].w, bflo); CONV1(7, w0b.w, w1b.w, w2b.w, x0[u].w, x1[u].w, x2[u].w, bb[u].w, bfhi);
#undef CONV1
            u32x4 ov; ov.x = pk2(r[0], r[1]); ov.y = pk2(r[2], r[3]); ov.z = pk2(r[4], r[5]); ov.w = pk2(r[6], r[7]);
            if (!dry) *(u32x4*)(scb + o) = ov; else asm volatile("" :: "v"(ov)); } }
    }
}
DEV void ffn_fix_phase(int gtid, int gthreads, const bf16_t* sa, const bf16_t* su, bf16_t* fu, const float* cw, const float* cb, int strip0 = 0, int nstrip = T / 64) {
    constexpr int C8 = DFF / 8; const u32x4 z = {0u, 0u, 0u, 0u};
    for (int i0 = gtid; i0 < nstrip * 2 * C8; i0 += 3 * gthreads) {
        u32x4 x2[3], x1[3], x0[3], uu[3];
#pragma unroll
        for (int q = 0; q < 3; ++q) { const int i = i0 + q * gthreads; if (i < nstrip * 2 * C8) {
            const int sr = i / C8, c8 = (i - sr * C8) * 8, strip = strip0 + (sr >> 1), rr = sr & 1;
            const bool first = (strip & (S / 64 - 1)) == 0;
            const bf16_t* A = sa + (size_t)strip * 4 * DFF + c8; const bf16_t* Ap = A - 4 * DFF;
            x2[q] = *(const u32x4*)(A + rr * DFF);
            x1[q] = rr == 1 ? *(const u32x4*)A : (first ? z : *(const u32x4*)(Ap + 3 * DFF));
            x0[q] = first ? z : *(const u32x4*)(Ap + (2 + rr) * DFF);
            uu[q] = *(const u32x4*)(su + ((size_t)strip * 2 + rr) * DFF + c8); } }
#pragma unroll
        for (int q = 0; q < 3; ++q) { const int i = i0 + q * gthreads; if (i < nstrip * 2 * C8) {
            const int sr = i / C8, c8 = (i - sr * C8) * 8, strip = strip0 + (sr >> 1), rr = sr & 1, t = strip * 64 + rr;
            const f32x4 w0a = *(const f32x4*)(cw + c8), w0b = *(const f32x4*)(cw + c8 + 4), w1a = *(const f32x4*)(cw + DFF + c8), w1b = *(const f32x4*)(cw + DFF + c8 + 4), w2a = *(const f32x4*)(cw + 2 * DFF + c8), w2b = *(const f32x4*)(cw + 2 * DFF + c8 + 4);
            const f32x4 ba = *(const f32x4*)(cb + c8), bb = *(const f32x4*)(cb + c8 + 4);
            float r[8];
#define FM1(k, B0, W0, W1, W2, X0, X1, X2, Uv, F) r[k] = gelu_t(B0 + W0 * F(X0) + W1 * F(X1) + W2 * F(X2)) * F(Uv)
            FM1(0, ba.x, w0a.x, w1a.x, w2a.x, x0[q].x, x1[q].x, x2[q].x, uu[q].x, bflo); FM1(1, ba.y, w0a.y, w1a.y, w2a.y, x0[q].x, x1[q].x, x2[q].x, uu[q].x, bfhi);
            FM1(2, ba.z, w0a.z, w1a.z, w2a.z, x0[q].y, x1[q].y, x2[q].y, uu[q].y, bflo); FM1(3, ba.w, w0a.w, w1a.w, w2a.w, x0[q].y, x1[q].y, x2[q].y, uu[q].y, bfhi);
            FM1(4, bb.x, w0b.x, w1b.x, w2b.x, x0[q].z, x1[q].z, x2[q].z, uu[q].z, bflo); FM1(5, bb.y, w0b.y, w1b.y, w2b.y, x0[q].z, x1[q].z, x2[q].z, uu[q].z, bfhi);
            FM1(6, bb.z, w0b.z, w1b.z, w2b.z, x0[q].w, x1[q].w, x2[q].w, uu[q].w, bflo); FM1(7, bb.w, w0b.w, w1b.w, w2b.w, x0[q].w, x1[q].w, x2[q].w, uu[q].w, bfhi);
#undef FM1
            u32x4 ov; ov.x = pk2(r[0], r[1]); ov.y = pk2(r[2], r[3]); ov.z = pk2(r[4], r[5]); ov.w = pk2(r[6], r[7]);
            *(u32x4*)(fu + (size_t)t * DFF + c8) = ov; } }
    }
}

typedef short s16x4 __attribute__((ext_vector_type(4)));
DEV s16x4 vtr(const LAS unsigned char* p) { return __builtin_bit_cast(s16x4, __builtin_amdgcn_ds_read_tr16_b64_v4i16((LAS s16x4*)p)); }
DEV bf16x8 cat8(const s16x4 a, const s16x4 b) { return (bf16x8){a[0], a[1], a[2], a[3], b[0], b[1], b[2], b[3]}; }
DEV bf16x8 pk8(float a0, float a1, float a2, float a3, float a4, float a5, float a6, float a7) {
    u32x4 w; w.x = pk2(a0, a1); w.y = pk2(a2, a3); w.z = pk2(a4, a5); w.w = pk2(a6, a7); return __builtin_bit_cast(bf16x8, w); }
constexpr int VPITCH = 192;
DEV void pv_tile(f32x16& o0, f32x16& o1, const LAS unsigned char* vt, int lane, const bf16x8 (&pk)[4]) {
    const int hi = lane >> 5;
    const LAS unsigned char* vb = vt + (4 * hi + ((lane & 15) >> 2)) * VPITCH + ((lane >> 4) & 1) * 32 + (lane & 3) * 8;
    bf16x8 va[4];
#pragma unroll
    for (int ks = 0; ks < 4; ++ks) va[ks] = cat8(vtr(vb + (16 * ks) * VPITCH), vtr(vb + (16 * ks + 8) * VPITCH));
    asm volatile("" : "+v"(va[0]), "+v"(va[1]), "+v"(va[2]), "+v"(va[3]));
#pragma unroll
    for (int ks = 0; ks < 4; ++ks) o0 = __builtin_amdgcn_mfma_f32_32x32x16_bf16(va[ks], pk[ks], o0, 0, 0, 0);
#pragma unroll
    for (int ks = 0; ks < 4; ++ks) va[ks] = cat8(vtr(vb + (16 * ks) * VPITCH + 64), vtr(vb + (16 * ks + 8) * VPITCH + 64));
    asm volatile("" : "+v"(va[0]), "+v"(va[1]), "+v"(va[2]), "+v"(va[3]));
#pragma unroll
    for (int ks = 0; ks < 4; ++ks) o1 = __builtin_amdgcn_mfma_f32_32x32x16_bf16(va[ks], pk[ks], o1, 0, 0, 0);
}
DEV void store_ot(bf16_t* orow, const f32x16& o0, const f32x16& o1, int hi, float sc) {
#pragma unroll
    for (int g4 = 0; g4 < 4; ++g4) {
        u32x2 a; a.x = pk2(o0[4 * g4] * sc, o0[4 * g4 + 1] * sc); a.y = pk2(o0[4 * g4 + 2] * sc, o0[4 * g4 + 3] * sc);
        u32x2 b; b.x = pk2(o1[4 * g4] * sc, o1[4 * g4 + 1] * sc); b.y = pk2(o1[4 * g4 + 2] * sc, o1[4 * g4 + 3] * sc);
        *(u32x2*)(orow + 8 * g4 + 4 * hi) = a; *(u32x2*)(orow + 32 + 8 * g4 + 4 * hi) = b;
    }
}

DEV void sb_item(LAS unsigned char* vl, const bf16_t* Q, const bf16_t* Kk, const bf16_t* V, bf16_t* O, int b, int h, int qb, int lane, bool dry) {
    const int r32 = lane & 31, hi = lane >> 5, t0 = 32 * qb, t = t0 + r32; const size_t rowb = (size_t)b * S;
    bf16x8 qr[4]; { const bf16_t* qp = Q + (rowb + t0 + r32) * 512 + h * 64 + 8 * hi;
#pragma unroll
        for (int d0 = 0; d0 < 4; ++d0) qr[d0] = *(const bf16x8*)(qp + 16 * d0); }
    f32x16 o0, o1;
#pragma unroll
    for (int r = 0; r < 16; ++r) { o0[r] = 0.f; o1[r] = 0.f; }
    float carry = 1.f;
    const int c_hi = (t0 + 30) >> 6;
#pragma unroll 1
    for (int c = c_hi; c >= 0; --c) {
        const bf16_t* kp = Kk + (rowb + 64 * c + r32) * 512 + h * 64 + 8 * hi;
        bf16x8 k0[4], k1[4];
#pragma unroll
        for (int d0 = 0; d0 < 4; ++d0) { k0[d0] = *(const bf16x8*)(kp + 16 * d0); k1[d0] = *(const bf16x8*)(kp + (size_t)32 * 512 + 16 * d0); }
#pragma unroll
        for (int j = 0; j < 8; ++j) { const int row = (lane >> 3) + 8 * j; *(LAS u32x4*)(vl + row * VPITCH + (lane & 7) * 16) = *(const u32x4*)(V + (rowb + 64 * c + row) * 512 + h * 64 + (lane & 7) * 8); }
        f32x16 p0, p1;
#pragma unroll
        for (int r = 0; r < 16; ++r) { p0[r] = 0.f; p1[r] = 0.f; }
#pragma unroll
        for (int d0 = 0; d0 < 4; ++d0) { p0 = __builtin_amdgcn_mfma_f32_32x32x16_bf16(k0[d0], qr[d0], p0, 0, 0, 0); p1 = __builtin_amdgcn_mfma_f32_32x32x16_bf16(k1[d0], qr[d0], p1, 0, 0, 0); }
        float u[32];
        const bool diag = (c == c_hi);
#pragma unroll
        for (int e = 0; e < 32; ++e) {
            const float z = e < 16 ? p0[e] : p1[e - 16];
            float uu = __builtin_amdgcn_rcpf(1.f + __builtin_amdgcn_exp2f(fminf(z, 126.f)));
            if (diag) { const int kv = 64 * c + 8 * ((e >> 2) & 3) + 4 * hi + (e & 3) + 32 * (e >> 4); if (kv >= t) uu = 1.f; }
            u[e] = uu;
        }
        float gl[8], gh[8];
#pragma unroll
        for (int i = 0; i < 8; ++i) { const float gp = (u[4 * i] * u[4 * i + 1]) * (u[4 * i + 2] * u[4 * i + 3]);
            const auto rr = __builtin_amdgcn_permlane32_swap(__float_as_uint(gp), __float_as_uint(gp), false, false); gl[i] = __uint_as_float(rr[0]); gh[i] = __uint_as_float(rr[1]); }
        float ag[8]; float run = carry;
#pragma unroll
        for (int i = 7; i >= 0; --i) { const float a_hi = run; run *= gh[i]; const float a_lo = run; run *= gl[i]; ag[i] = hi ? a_hi : a_lo; }
        carry = run;
        bf16x8 pk[4];
#pragma unroll
        for (int ks = 0; ks < 4; ++ks) { float w[8];
#pragma unroll
            for (int g = 0; g < 2; ++g) { const int i = 2 * ks + g;
                const float a3 = ag[i], a2 = a3 * u[4 * i + 3], a1 = a2 * u[4 * i + 2], a0 = a1 * u[4 * i + 1];
                w[4 * g] = (1.f - u[4 * i]) * a0; w[4 * g + 1] = (1.f - u[4 * i + 1]) * a1; w[4 * g + 2] = (1.f - u[4 * i + 2]) * a2; w[4 * g + 3] = (1.f - u[4 * i + 3]) * a3; }
            pk[ks] = pk8(w[0], w[1], w[2], w[3], w[4], w[5], w[6], w[7]); }
        pv_tile(o0, o1, vl, lane, pk);
        if (__all(carry < 7.8e-31f)) break;
    }
    if (!dry) store_ot(O + (rowb + t0 + r32) * 512 + h * 64, o0, o1, hi, 1.f); else asm volatile("" :: "v"(o0), "v"(o1));
}
DEV void sb_phase(const WaveId& W, LAS unsigned char* lds, unsigned char* ws, bool dry) {
    LAS unsigned char* vl = lds + W.wave * 12288;
    const bf16_t* Q = (const bf16_t*)(ws + WS_QA); const bf16_t* Kk = (const bf16_t*)(ws + WS_KA); const bf16_t* V = (const bf16_t*)(ws + WS_VA);
    constexpr int NITEM = NB * 8 * (S / 32);
    for (int it = W.gw; it < NITEM; it += W.ngw) {
        const int qb = it & 255, h = (it >> 8) & 7, b = it >> 11;
        sb_item(vl, Q, Kk, V, (bf16_t*)(ws + WS_QA), b, h, qb, W.lane, dry);
    }
}

constexpr int IDX_CTL_OFF = 131072 + 1024;
DEV unsigned fkey2(float v) { const int u = (int)__float_as_uint(v); return (unsigned)(u ^ ((u >> 31) | (int)0x80000000)); }
DEV float relu1(float x) { return __builtin_amdgcn_fmed3f(x, 0.f, 3.0e38f); }
DEV void idx_prefetch(bf16x8 (&afr)[4], float (&w)[16], bf16x8 (&b0)[4], bf16x8 (&b1)[4], const bf16_t* IQ, const bf16_t* IK, const float* IWp, int b, int t0, int wid, int lane) {
    const int r32 = lane & 31, hh = lane >> 5; const size_t rowb = (size_t)b * S;
    { const int qi = 2 * (r32 >> 4) + ((r32 >> 2) & 1), head = (r32 & 3) + 4 * ((r32 >> 3) & 1);
        const bf16_t* ap = IQ + (rowb + t0 + qi) * 512 + head * 64 + 8 * hh;
#pragma unroll
        for (int ks = 0; ks < 4; ++ks) afr[ks] = *(const bf16x8*)(ap + 16 * ks); }
#pragma unroll
    for (int r = 0; r < 16; ++r) w[r] = IWp[(rowb + t0 + 2 * (r >> 3) + hh) * 8 + (r & 7)];
    const int jmax = (t0 + 3) >> 5;
    { const int j0 = wid < jmax ? wid : jmax, j1 = wid + 8 < jmax ? wid + 8 : jmax;
      const bf16_t* p0 = IK + ((rowb >> 5) + j0) * 2048 + (hh * 32 + r32) * 8; const bf16_t* p1 = IK + ((rowb >> 5) + j1) * 2048 + (hh * 32 + r32) * 8;
#pragma unroll
      for (int ks = 0; ks < 4; ++ks) { b0[ks] = *(const bf16x8*)(p0 + ks * 512); b1[ks] = *(const bf16x8*)(p1 + ks * 512); } }
}
DEV void idx_unit(LAS unsigned char* lds, const bf16_t* IQ, const bf16_t* IK, const float* IWp, unsigned* BM, int b, int t0, int nb, int nt0, int wid, int lane,
                  bf16x8 (&afr)[4], float (&w)[16], bf16x8 (&b0)[4], bf16x8 (&b1)[4]) {
    const int r32 = lane & 31, hh = lane >> 5; const size_t rowb = (size_t)b * S;
    const int tmax = t0 + 3, jmax = tmax >> 5;
    LAS unsigned* SCO = (LAS unsigned*)lds;
    bf16x8 b2[4];
#pragma unroll
    for (int ks = 0; ks < 4; ++ks) b2[ks] = afr[ks];
#define IDX_LOADB(dst, jj) do { const int jc_ = (jj) < jmax ? (jj) : jmax; const bf16_t* bp_ = IK + ((rowb >> 5) + jc_) * 2048 + (hh * 32 + r32) * 8; \
        _Pragma("unroll") for (int ks = 0; ks < 4; ++ks) dst[ks] = *(const bf16x8*)(bp_ + ks * 512); } while (0)
#define IDX_COMP(src, jj) do { f32x16 acc; _Pragma("unroll") for (int r = 0; r < 16; ++r) acc[r] = 0.f; \
        _Pragma("unroll") for (int ks = 0; ks < 4; ++ks) acc = __builtin_amdgcn_mfma_f32_32x32x16_bf16(afr[ks], src[ks], acc, 0, 0, 0); \
        float s0 = 0.f, s1 = 0.f; _Pragma("unroll") for (int hd = 0; hd < 8; ++hd) { s0 += w[hd] * relu1(acc[hd]); s1 += w[8 + hd] * relu1(acc[8 + hd]); } \
        unsigned k0_ = fkey2(s0), k1_ = fkey2(s1); const int key = 32 * (jj) + r32; \
        if ((jj) >= jmax) { k0_ = key <= t0 + hh ? k0_ : 0u; k1_ = key <= t0 + 2 + hh ? k1_ : 0u; }     \
        if ((jj) <= jmax) { SCO[hh * 8192 + key] = k0_; SCO[(2 + hh) * 8192 + key] = k1_; } } while (0)
#ifndef IDX_REP_MFMA
#define IDX_REP_MFMA 1
#endif
#ifndef IDX_REP_SEL
#define IDX_REP_SEL 1
#endif
#ifdef IDX_DRY_COMPUTE
#pragma unroll 1
    for (int j = wid; j <= jmax; j += 24) { IDX_COMP(b0, j); asm volatile("" : "+v"(b0[0]), "+v"(b1[0]), "+v"(b2[0])); IDX_COMP(b1, j + 8); IDX_COMP(b2, j + 16); }
#endif
#pragma unroll 1
    for (int rpm = 0; rpm < IDX_REP_MFMA; ++rpm) {
#pragma unroll 1
    for (int j = wid; j <= jmax; j += 24) {
        IDX_LOADB(b2, j + 16); IDX_COMP(b0, j);
        IDX_LOADB(b0, j + 24); IDX_COMP(b1, j + 8);
        IDX_LOADB(b1, j + 32); IDX_COMP(b2, j + 16);
    }
    }
#undef IDX_LOADB
#undef IDX_COMP
    if (nt0 >= 0) idx_prefetch(afr, w, b0, b1, IQ, IK, IWp, nb, nt0, wid, lane);
    LAS unsigned* thr = (LAS unsigned*)(lds + IDX_CTL_OFF);
    if (wid == 0 && lane < 32) ((LAS unsigned*)(lds + IDX_CTL_OFF + 64))[lane] = 0u;
    LDS_WAIT(); __builtin_amdgcn_s_barrier(); asm volatile("" ::: "memory");
    {
        const int q = wid & 3, h = wid >> 2, n = t0 + q + 1;
        volatile LAS unsigned* xme = (volatile LAS unsigned*)(lds + IDX_CTL_OFF + 64) + (q * 2 + h) * 4;
        volatile LAS unsigned* xpa = (volatile LAS unsigned*)(lds + IDX_CTL_OFF + 64) + (q * 2 + (h ^ 1)) * 4;
        unsigned T_ = 1u;
        if (n > 256) {
            LAS unsigned* row = SCO + q * 8192 + lane;
            unsigned r[64];
            const int nil = (jmax >> 1) >= h ? (((jmax >> 1) - h) >> 1) + 1 : 0;
#define IDX_FOR_LIVE(BODY) _Pragma("unroll") for (int g8_ = 0; g8_ < 8; ++g8_) if (8 * g8_ < nil) { _Pragma("unroll") for (int u8_ = 0; u8_ < 8; ++u8_) { const int il = 8 * g8_ + u8_; BODY } }
            IDX_FOR_LIVE( r[il] = (2 * (2 * il + h) + hh <= jmax) ? row[64 * (2 * il + h)] : 0u; )
            unsigned seq = 0u;
#define IDX_XCHG(val, out) do { ++seq; const int pb_ = (seq & 1u) * 2; if (lane == 0) { xme[pb_ + 1] = (val); xme[pb_] = seq; } \
                while (xpa[pb_] != seq) __builtin_amdgcn_s_sleep(0); (out) = xpa[pb_ + 1]; } while (0)
#define IDX_XCHG16(val, out) do { ++seq; const int pb_ = (seq & 1u) * 2; if (lane == 0) xme[pb_] = (seq << 16) | (val); unsigned w_; \
                while (((w_ = xpa[pb_]) >> 16) != (seq & 0xffffu)) __builtin_amdgcn_s_sleep(0); (out) = w_ & 0xffffu; } while (0)
#pragma unroll 1
            for (int rps = 0; rps < IDX_REP_SEL; ++rps) {
            unsigned mx = 0u;
            IDX_FOR_LIVE( mx = max(mx, r[il]); )
#pragma unroll
            for (int o = 1; o < 64; o <<= 1) mx = max(mx, (unsigned)__shfl_xor((int)mx, o));
            { unsigned pm_; IDX_XCHG(mx, pm_); mx = max(mx, pm_); }
            unsigned lo_ = 1u, hi_ = mx + 1u, chi_ = 0u, xgt_ = 1u, xeq_ = 0u, mt_ = 0u; bool done_ = false;
            if (mx > 0x82000000u) {
                const unsigned c1 = mx - (1u << 23), c2 = mx - (3u << 23);
                unsigned ca_ = 0, cb_ = 0, cc_ = 0, cd_ = 0; const unsigned c1v = c1, c2v = c2;
#define IDX_CNT4B(A, B, C, Dd) asm volatile("v_cmp_ge_u32_e64 s[88:89], %4, %8\n\tv_cmp_ge_u32_e64 s[90:91], %5, %8\n\tv_cmp_ge_u32_e64 s[92:93], %6, %8\n\tv_cmp_ge_u32_e64 s[94:95], %7, %8\n\t" \
                    "v_addc_co_u32_e64 %0, s[88:89], %0, 0, s[88:89]\n\tv_addc_co_u32_e64 %1, s[90:91], %1, 0, s[90:91]\n\tv_addc_co_u32_e64 %0, s[92:93], %0, 0, s[92:93]\n\tv_addc_co_u32_e64 %1, s[94:95], %1, 0, s[94:95]\n\t" \
                    "v_cmp_ge_u32_e64 s[88:89], %4, %9\n\tv_cmp_ge_u32_e64 s[90:91], %5, %9\n\tv_cmp_ge_u32_e64 s[92:93], %6, %9\n\tv_cmp_ge_u32_e64 s[94:95], %7, %9\n\t" \
                    "v_addc_co_u32_e64 %2, s[88:89], %2, 0, s[88:89]\n\tv_addc_co_u32_e64 %3, s[90:91], %3, 0, s[90:91]\n\tv_addc_co_u32_e64 %2, s[92:93], %2, 0, s[92:93]\n\tv_addc_co_u32_e64 %3, s[94:95], %3, 0, s[94:95]" \
                    : "+v"(ca_), "+v"(cb_), "+v"(cc_), "+v"(cd_) : "v"(A), "v"(B), "v"(C), "v"(Dd), "v"(c1v), "v"(c2v) : "s88", "s89", "s90", "s91", "s92", "s93", "s94", "s95")
#pragma unroll
                for (int g8_ = 0; g8_ < 8; ++g8_) if (8 * g8_ < nil) { IDX_CNT4B(r[8 * g8_], r[8 * g8_ + 1], r[8 * g8_ + 2], r[8 * g8_ + 3]); IDX_CNT4B(r[8 * g8_ + 4], r[8 * g8_ + 5], r[8 * g8_ + 6], r[8 * g8_ + 7]); }
#undef IDX_CNT4B
                int pk = (int)((ca_ + cb_) | ((cc_ + cd_) << 16));
                pk += __builtin_amdgcn_update_dpp(0, pk, 0x111, 0xf, 0xf, false);
                pk += __builtin_amdgcn_update_dpp(0, pk, 0x112, 0xf, 0xf, false);
                pk += __builtin_amdgcn_update_dpp(0, pk, 0x114, 0xf, 0xf, false);
                pk += __builtin_amdgcn_update_dpp(0, pk, 0x118, 0xf, 0xf, false);
                pk += __builtin_amdgcn_update_dpp(0, pk, 0x142, 0xa, 0xf, false);
                unsigned tot = (unsigned)__builtin_amdgcn_readlane(pk, 31) + (unsigned)__builtin_amdgcn_readlane(pk, 63);
                { unsigned pt_; IDX_XCHG(tot, pt_); tot += pt_; }
                const unsigned t1 = tot & 0xffffu, t2 = tot >> 16;
                if (t1 == 256u) { xgt_ = c1; mt_ = 0u; done_ = true; }
                else if (t1 > 256u) lo_ = c1;
                else { hi_ = c1; chi_ = t1;
                       if (t2 == 256u) { xgt_ = c2; mt_ = 0u; done_ = true; }
                       else if (t2 > 256u) lo_ = c2;
                       else { hi_ = c2; chi_ = t2; } }
                if (!done_ && hi_ - lo_ == 1u) { xgt_ = hi_; xeq_ = lo_; mt_ = 256u - chi_; done_ = true; }
            }
            { LAS unsigned* hist = (LAS unsigned*)(lds + IDX_CTL_OFF + 1024) + q * 256;
#pragma unroll 1
              for (int round = 0; round < 6 && !done_; ++round) {
                const unsigned wdt = hi_ - lo_;
                const int sh = wdt <= 256u ? 0 : 24 - (int)__builtin_clz(wdt - 1u);
                hist[128 * h + lane] = 0u; hist[128 * h + 64 + lane] = 0u;
                LDS_WAIT(); { unsigned d_; IDX_XCHG16(0u, d_); (void)d_; }
                const unsigned lov = lo_;
                if (round == 0) {
                    IDX_FOR_LIVE( const unsigned d = r[il] - lov; if (d < wdt) __hip_atomic_fetch_add(hist + (d >> sh), 1u, __ATOMIC_RELAXED, __HIP_MEMORY_SCOPE_WORKGROUP); )
                } else {
#pragma unroll
                    for (int g8_ = 0; g8_ < 8; ++g8_) if (8 * g8_ < nil) {
#pragma unroll
                        for (int u4_ = 0; u4_ < 2; ++u4_) { const int il = 8 * g8_ + 4 * u4_;
                            const unsigned d0 = r[il] - lov, d1 = r[il + 1] - lov, d2 = r[il + 2] - lov, d3 = r[il + 3] - lov;
                            if (min(min(d0, d1), min(d2, d3)) < wdt) {
                                if (d0 < wdt) __hip_atomic_fetch_add(hist + (d0 >> sh), 1u, __ATOMIC_RELAXED, __HIP_MEMORY_SCOPE_WORKGROUP);
                                if (d1 < wdt) __hip_atomic_fetch_add(hist + (d1 >> sh), 1u, __ATOMIC_RELAXED, __HIP_MEMORY_SCOPE_WORKGROUP);
                                if (d2 < wdt) __hip_atomic_fetch_add(hist + (d2 >> sh), 1u, __ATOMIC_RELAXED, __HIP_MEMORY_SCOPE_WORKGROUP);
                                if (d3 < wdt) __hip_atomic_fetch_add(hist + (d3 >> sh), 1u, __ATOMIC_RELAXED, __HIP_MEMORY_SCOPE_WORKGROUP); } } }
                }
                LDS_WAIT(); { unsigned d_; IDX_XCHG16(0u, d_); (void)d_; }
                const u32x4 hb = *(const LAS u32x4*)(hist + 4 * lane);
                const unsigned s4 = (hb.x + hb.y) + (hb.z + hb.w);
                unsigned suf = s4;
#pragma unroll
                for (int o = 1; o < 64; o <<= 1) { const unsigned tv = (unsigned)__shfl_down((int)suf, o); if (lane + o < 64) suf += tv; }
                const unsigned long long okm = __ballot(chi_ + suf >= 256u);
                const int L = 63 - (int)__builtin_clzll(okm);
                const unsigned above = chi_ + (unsigned)__builtin_amdgcn_readlane((int)(suf - s4), L);
                const unsigned h0 = (unsigned)__builtin_amdgcn_readlane((int)hb.x, L), h1 = (unsigned)__builtin_amdgcn_readlane((int)hb.y, L),
                               h2 = (unsigned)__builtin_amdgcn_readlane((int)hb.z, L), h3 = (unsigned)__builtin_amdgcn_readlane((int)hb.w, L);
                unsigned Bsel, cab, cnb;
                if (above + h3 >= 256u) { Bsel = 3u; cab = above; cnb = h3; }
                else if (above + h3 + h2 >= 256u) { Bsel = 2u; cab = above + h3; cnb = h2; }
                else if (above + h3 + h2 + h1 >= 256u) { Bsel = 1u; cab = above + h3 + h2; cnb = h1; }
                else { Bsel = 0u; cab = above + h3 + h2 + h1; cnb = h0; }
                Bsel += 4u * (unsigned)L;
                const unsigned nlo = lo_ + (Bsel << sh); unsigned nhi = nlo + (1u << sh); if (nhi > hi_ || nhi < nlo) nhi = hi_;
                if (cab + cnb == 256u) { xgt_ = nlo; mt_ = 0u; done_ = true; }
                else if (sh == 0) { xgt_ = nlo + 1u; xeq_ = nlo; mt_ = 256u - cab; done_ = true; }
                else { lo_ = nlo; hi_ = nhi; chi_ = cab; }
              } }
#ifdef IDX_XTRA
#pragma unroll 1
            for (int xr = 0; xr < IDX_XTRA; ++xr) { unsigned dsum = 0; const unsigned cv = xgt_ + (unsigned)xr;
                IDX_FOR_LIVE( dsum += r[il] >= cv; )
                int pk = (int)dsum;
                pk += __builtin_amdgcn_update_dpp(0, pk, 0x111, 0xf, 0xf, false); pk += __builtin_amdgcn_update_dpp(0, pk, 0x112, 0xf, 0xf, false); pk += __builtin_amdgcn_update_dpp(0, pk, 0x114, 0xf, 0xf, false);
                pk += __builtin_amdgcn_update_dpp(0, pk, 0x118, 0xf, 0xf, false); pk += __builtin_amdgcn_update_dpp(0, pk, 0x142, 0xa, 0xf, false);
                unsigned tot = (unsigned)__builtin_amdgcn_readlane(pk, 31) + (unsigned)__builtin_amdgcn_readlane(pk, 63);
                { unsigned pt_; IDX_XCHG16(tot, pt_); tot += pt_; } asm volatile("" :: "s"(tot)); }
#endif
            T_ = xgt_;
            if (mt_ != 0u) {
                if (h == 0) { unsigned run = 0u;
#pragma unroll 1
                    for (int i = 0; i <= (jmax >> 1); ++i) { const bool ok_ = 2 * i + hh <= jmax; const unsigned kv = ok_ ? row[64 * i] : 0u; const bool eq = kv == xeq_; const unsigned long long bm = __ballot(eq);
                        const unsigned rank = run + __builtin_amdgcn_mbcnt_hi((unsigned)(bm >> 32), __builtin_amdgcn_mbcnt_lo((unsigned)bm, 0u));
                        if (eq && rank >= mt_) row[64 * i] = 0u;
                        run += (unsigned)__popcll(bm); } }
                T_ = xeq_;
            }
            }
#undef IDX_XCHG
#undef IDX_XCHG16
#undef IDX_FOR_LIVE
        }
        if (lane == 0 && h == 0) thr[q] = T_;
    }
#ifdef PROBE_VALU
    { float a0 = (float)lane, a1 = a0 + 1.f, a2 = a0 + 2.f, a3 = a0 + 3.f, a4 = a0 + 4.f, a5 = a0 + 5.f, a6 = a0 + 6.f, a7 = a0 + 7.f; const float m = 1.0000001f, c = 1e-9f;
#pragma unroll 1
      for (int it = 0; it < 64; ++it) {
#pragma unroll
          for (int u = 0; u < 8; ++u) { a0 = a0 * m + c; a1 = a1 * m + c; a2 = a2 * m + c; a3 = a3 * m + c; a4 = a4 * m + c; a5 = a5 * m + c; a6 = a6 * m + c; a7 = a7 * m + c; } }
      asm volatile("" :: "v"(a0), "v"(a1), "v"(a2), "v"(a3), "v"(a4), "v"(a5), "v"(a6), "v"(a7)); }
#endif
    LDS_WAIT(); __builtin_amdgcn_s_barrier(); asm volatile("" ::: "memory");
    { const unsigned tq0 = thr[hh], tq1 = thr[2 + hh];
#pragma unroll 4
      for (int j = wid; j <= ((t0 | 255) >> 5); j += 8) {
          bool s0 = false, s1 = false;
          if (j <= jmax) { s0 = SCO[hh * 8192 + 32 * j + r32] >= tq0; s1 = SCO[(2 + hh) * 8192 + 32 * j + r32] >= tq1; }
          const unsigned long long b0_ = __ballot(s0), b1_ = __ballot(s1);
          if (lane == 0) { u32x4 o; o.x = (unsigned)b0_; o.y = (unsigned)(b0_ >> 32); o.z = (unsigned)b1_; o.w = (unsigned)(b1_ >> 32); *(u32x4*)(BM + ((size_t)b * 256 + j) * S + t0) = o; }
      } }
    LDS_WAIT(); __builtin_amdgcn_s_barrier();
}
DEV void idx_phase(LAS unsigned char* lds, unsigned char* ws, int vcu, int G, int wid, int lane) {
    constexpr int NUNIT = T / 4;
    const bf16_t* IQ = (const bf16_t*)(ws + WS_IQ); const bf16_t* IK = (const bf16_t*)(ws + WS_IK); const float* IW = (const float*)(ws + WS_IW);
#define IDX_UNIT_OF(k) ((k) * G + (((k) & 1) ? G - 1 - vcu : vcu))
    bf16x8 afr[4], b0[4], b1[4]; float w[16];
    int un = IDX_UNIT_OF(0);
    if (un < NUNIT) { const int b = un / (S / 4); idx_prefetch(afr, w, b0, b1, IQ, IK, IW, b, (un - b * (S / 4)) * 4, wid, lane); }
#pragma unroll 1
    for (int k = 0; un < NUNIT; ++k) {
        const int b = un / (S / 4), t0 = (un - b * (S / 4)) * 4;
        const int nun = IDX_UNIT_OF(k + 1); const int nb = nun / (S / 4), nt0 = nun < NUNIT ? (nun - nb * (S / 4)) * 4 : -1;
        idx_unit(lds, IQ, IK, IW, (unsigned*)(ws + WS_BM), b, t0, nb, nt0, wid, lane, afr, w, b0, b1);
        un = nun;
    }
#undef IDX_UNIT_OF
}

DEV void kn_phase(const WaveId& W, const bf16_t* Kk, float* KN) {
    for (int item = W.gw; item < NB * 8 * (S / 64); item += W.ngw) {
        const int b = item / (8 * (S / 64)), h = (item / (S / 64)) & 7, tile = item % (S / 64);
        const bf16_t* kp = Kk + ((size_t)b * S + tile * 64 + W.lane) * 512 + h * 64;
        float ss = 0.f;
#pragma unroll
        for (int c = 0; c < 8; ++c) { const u32x4 v = *(const u32x4*)(kp + 8 * c);
#pragma unroll
            for (int e = 0; e < 4; ++e) { const float lo = __uint_as_float(v[e] << 16), hi = __uint_as_float(v[e] & 0xffff0000u); ss += lo * lo + hi * hi; } }
        const float m = wave_max(ss);
        if (W.lane == 0) KN[item] = sqrtf(m) * 1.01f;
    }
}
#include <hip/hip_bf16.h>
namespace attn_body {
using bf16=__hip_bfloat16;
using bf16x8=__attribute__((ext_vector_type(8)))short;
using s16x4=__attribute__((ext_vector_type(4)))short;
using f32x16=__attribute__((ext_vector_type(16)))float;
using u32x4=__attribute__((ext_vector_type(4)))unsigned;
constexpr int BATCH=2,NHEAD=8,SEQ=8192,D=64,DM=NHEAD*D;
constexpr int NW=8,QBLK=32,QB=QBLK*NW,KVBLK=64,NQB=SEQ/QB;
constexpr int ATTN_PITCH=DM, ATTN_UNIT_ROWS=QB;
__device__ __forceinline__ int crow(int r,int hi){return (r&3)+8*(r>>2)+4*hi;}
#define SBAR() __builtin_amdgcn_sched_barrier(0)
__device__ __forceinline__ void cmask(f32x16&p0,f32x16&p1,int jb,int qrel,int hi){
  const float NEG=-INFINITY; int kb=64*jb+4*hi;
  #pragma unroll
  for(int r=0;r<16;++r){int kv=kb+(r&3)+8*(r>>2); if(kv>qrel)p0[r]=NEG; if(kv+32>qrel)p1[r]=NEG;}
}

constexpr int NSLOT=3, SLOTB=8192;
constexpr int LDS_K=0, LDS_V=NSLOT*SLOTB, LDS_WS=2*NSLOT*SLOTB, LDS_OST=LDS_WS+NW*64*4, LDS_BYTES=LDS_OST+NW*4096;
constexpr float C2=0.125f*1.4426950408889634f;
__device__ __forceinline__ void glds16(const void*gsrc,unsigned lds_dst){unsigned keep;
  asm volatile("s_mov_b32 %0, m0\n\ts_mov_b32 m0, %2\n\ts_nop 0\n\tglobal_load_lds_dwordx4 %1, off\n\ts_mov_b32 m0, %0":"=&s"(keep):"v"(gsrc),"s"(lds_dst):"memory");}
__device__ __forceinline__ float max3f(float a,float b,float c){float r;asm("v_max3_f32 %0, %1, %2, %3":"=v"(r):"v"(a),"v"(b),"v"(c));return r;}
__device__ __forceinline__ float max2f(float a,float b){float r;asm("v_max_f32_e32 %0, %1, %2":"=v"(r):"v"(a),"v"(b));return r;}
__device__ __forceinline__ float fadd_s(float a,float b){float r;asm("v_add_f32_e32 %0, %1, %2":"=v"(r):"v"(a),"v"(b));return r;}
__device__ __forceinline__ float fsub_s(float a,float b){float r;asm("v_sub_f32_e32 %0, %1, %2":"=v"(r):"v"(a),"v"(b));return r;}
typedef float f32x2_t __attribute__((ext_vector_type(2))); typedef __bf16 bf16x2_t __attribute__((ext_vector_type(2)));
__device__ __forceinline__ unsigned cvtpk_s(float lo,float hi){f32x2_t v={lo,hi};bf16x2_t b=__builtin_convertvector(v,bf16x2_t);return __builtin_bit_cast(unsigned,b);}
#define WAIT_BAR(N) asm volatile("s_waitcnt vmcnt(" #N ") lgkmcnt(0)\n\ts_barrier":::"memory")

__device__ __forceinline__ void qkt(f32x16&p0,f32x16&p1,const char*Kslot,const bf16x8*qr,const f32x16&negm,int r32,int hi){
  const char*kb=Kslot+hi*1024+r32*16;
  #pragma unroll
  for(int d0=0;d0<4;++d0){
    const bf16x8 b0=*reinterpret_cast<const bf16x8*>(kb+d0*2048);
    const bf16x8 b1=*reinterpret_cast<const bf16x8*>(kb+d0*2048+512);
    if(d0==0){p0=__builtin_amdgcn_mfma_f32_32x32x16_bf16(b0,qr[0],negm,0,0,0);p1=__builtin_amdgcn_mfma_f32_32x32x16_bf16(b1,qr[0],negm,0,0,0);}
    else{p0=__builtin_amdgcn_mfma_f32_32x32x16_bf16(b0,qr[d0],p0,0,0,0);p1=__builtin_amdgcn_mfma_f32_32x32x16_bf16(b1,qr[d0],p1,0,0,0);}}
}
typedef __attribute__((address_space(3))) const char* lds_cptr;
typedef short v4i16_t __attribute__((ext_vector_type(4)));
__device__ __forceinline__ void kload8(bf16x8*kf,lds_cptr kp){
  kf[0]=*(const __attribute__((address_space(3))) bf16x8*)(kp);      kf[1]=*(const __attribute__((address_space(3))) bf16x8*)(kp+512);
  kf[2]=*(const __attribute__((address_space(3))) bf16x8*)(kp+2048); kf[3]=*(const __attribute__((address_space(3))) bf16x8*)(kp+2560);
  kf[4]=*(const __attribute__((address_space(3))) bf16x8*)(kp+4096); kf[5]=*(const __attribute__((address_space(3))) bf16x8*)(kp+4608);
  kf[6]=*(const __attribute__((address_space(3))) bf16x8*)(kp+6144); kf[7]=*(const __attribute__((address_space(3))) bf16x8*)(kp+6656);
}
__device__ __forceinline__ void kload2(bf16x8*kf,lds_cptr kp,int j){ kf[2*j]=*(const __attribute__((address_space(3))) bf16x8*)(kp+j*2048); kf[2*j+1]=*(const __attribute__((address_space(3))) bf16x8*)(kp+j*2048+512); }
__device__ __forceinline__ s16x4 vtr(lds_cptr p){ return __builtin_bit_cast(s16x4,__builtin_amdgcn_ds_read_tr16_b64_v4i16((__attribute__((address_space(3))) v4i16_t*)p)); }
__device__ __forceinline__ float rowmax(const f32x16&p0,const f32x16&p1){
  float a=max3f(p0[0],p0[1],p1[0]),b=max3f(p0[2],p0[3],p1[1]);a=max3f(a,p1[2],p1[3]);
  #pragma unroll
  for(int r=4;r<16;r+=4){a=max3f(a,p0[r],p0[r+1]);b=max3f(b,p0[r+2],p0[r+3]);a=max3f(a,p1[r],p1[r+1]);b=max3f(b,p1[r+2],p1[r+3]);}
  const float m=max2f(a,b);
  auto rr=__builtin_amdgcn_permlane32_swap(__float_as_uint(m),__float_as_uint(m),false,false);
  return max2f(__uint_as_float(rr[0]),__uint_as_float(rr[1]));
}
__device__ __forceinline__ void pv(f32x16*o,int vb,bf16x8 pa0,bf16x8 pa1,bf16x8 pa2,bf16x8 pa3){
  #pragma unroll
  for(int d0=0;d0<2;++d0){s16x4 lo[4],hi[4];
    #pragma unroll
    for(int ks=0;ks<4;++ks){
      asm volatile("ds_read_b64_tr_b16 %0,%1 offset:%c2":"=&v"(lo[ks]):"v"(vb),"i"(d0*4096+ks*1024):"memory");
      asm volatile("ds_read_b64_tr_b16 %0,%1 offset:%c2":"=&v"(hi[ks]):"v"(vb),"i"(d0*4096+ks*1024+512):"memory");}
    asm volatile("s_waitcnt lgkmcnt(0)":::"memory");SBAR();
    #define PK(k) (bf16x8){lo[k][0],lo[k][1],lo[k][2],lo[k][3],hi[k][0],hi[k][1],hi[k][2],hi[k][3]}
    o[d0]=__builtin_amdgcn_mfma_f32_32x32x16_bf16(pa0,PK(0),o[d0],0,0,0);
    o[d0]=__builtin_amdgcn_mfma_f32_32x32x16_bf16(pa1,PK(1),o[d0],0,0,0);
    o[d0]=__builtin_amdgcn_mfma_f32_32x32x16_bf16(pa2,PK(2),o[d0],0,0,0);
    o[d0]=__builtin_amdgcn_mfma_f32_32x32x16_bf16(pa3,PK(3),o[d0],0,0,0);
    #undef PK
  }
}

#ifndef ATTN_STORE16
#define ATTN_STORE16(p,v) (*(u32x4*)(p)=(v))
#endif
template<int THRL> __device__ __forceinline__ void attn_unit(int b,int h,int qb,const bf16*Q,const bf16*__restrict__ K,const bf16*__restrict__ V,bf16*O,char*shm,const unsigned*__restrict__ BMb,const float*KNbh,const int tid){
  const int lane=tid&63,r32=lane&31,hi=lane>>5; const int wid=__builtin_amdgcn_readfirstlane(tid>>6);
  const long rowbase=(long)b*SEQ; const int q0=qb*QB;
  const bf16*Qw=Q+(rowbase+q0+wid*QBLK)*DM+h*D;
  const bf16*Kh=K+rowbase*DM+h*D,*Vh=V+rowbase*DM+h*D;
  const unsigned lds0=(unsigned)(uintptr_t)shm;
  float*wsf=(float*)(shm+LDS_WS)+wid*64;
  const bf16*ksrc=Kh+(long)lane*DM+wid*8;
  const bf16*vsrc=Vh+(long)(16*(wid&3)+(lane>>2))*DM+(wid>>2)*32+(lane&3)*8;
  const unsigned kdst=lds0+LDS_K+wid*1024, vdst=lds0+LDS_V+wid*1024;
  #define DMA_K(t,slot) glds16(ksrc+(long)(t)*KVBLK*DM,(unsigned)__builtin_amdgcn_readfirstlane(kdst+(slot)))
  #define DMA_V(t,slot) glds16(vsrc+(long)(t)*KVBLK*DM,(unsigned)__builtin_amdgcn_readfirstlane(vdst+(slot)))
  const int vb0=(int)(lds0+LDS_V)+((lane>>4)&1)*32+(lane&3)*8+(4*hi+((lane&15)>>2))*64;
  const char*Kbase=shm+LDS_K; bf16x8 kf[8];
  const lds_cptr shm3=(lds_cptr)shm; const lds_cptr kp0=shm3+LDS_K+hi*1024+r32*16; const lds_cptr vp0=shm3+LDS_V+((lane>>4)&1)*32+(lane&3)*8+(4*hi+((lane&15)>>2))*64;
  const int NT=(q0+QB)/KVBLK;
  DMA_K(0,0);DMA_V(0,0);DMA_K(1,SLOTB);
  bf16x8 qr[4];
  #pragma unroll
  for(int d0=0;d0<4;++d0)qr[d0]=*reinterpret_cast<const bf16x8*>(&Qw[(long)r32*DM+d0*16+hi*8]);
  const unsigned*bmp=BMb+(q0+wid*QBLK+r32);
  unsigned mwE0=bmp[0],mwE1=bmp[(size_t)SEQ],mwO0=0u,mwO1=0u;
  bool seen=false;
  float qn; { float qs=0.f;
    _Pragma("unroll") for(int d0=0;d0<4;++d0) _Pragma("unroll") for(int e=0;e<8;++e){ const float x=__uint_as_float(((unsigned)(unsigned short)qr[d0][e])<<16); qs+=x*x; }
    auto rr=__builtin_amdgcn_permlane32_swap(__float_as_uint(qs),__float_as_uint(qs),false,false); qn=__builtin_sqrtf(__uint_as_float(rr[0])+__uint_as_float(rr[1]))*1.01f; }
  constexpr float FASTB=60.f;
  int zlane=0; asm volatile("":"+v"(zlane));
  const float*knp=KNbh+zlane;
  float knE=knp[0],knO=0.f;
  bool anysel_=false;
  #define SLOWT(PS) (__any(!(qn*kn##PS<=FASTB)||mhat!=0.f))
  float mhat=0.f,l_reg=0.f;f32x16 o[2];o[0]=f32x16{};o[1]=f32x16{};const f32x16 zero16=f32x16{};
  const int qrel=wid*QBLK+r32;
  #define CMASK(P0,P1,SLOW,PS) do{ const unsigned m0_=mw##PS##0>>(4*hi), m1_=mw##PS##1>>(4*hi); anysel_=(mw##PS##0|mw##PS##1)!=0u; \
    if(SLOW){ _Pragma("unroll") for(int r=0;r<16;++r){ P0[r]-=mhat; P1[r]-=mhat; } } \
    _Pragma("unroll") for(int r=0;r<16;++r){ const int bit_=(r&3)+8*(r>>2); \
      const unsigned e0_=(unsigned)__builtin_amdgcn_sbfe((int)m0_,bit_,1), e1_=(unsigned)__builtin_amdgcn_sbfe((int)m1_,bit_,1); \
      P0[r]=__uint_as_float((__float_as_uint(P0[r])&e0_)|(0xff800000u&~e0_)); P1[r]=__uint_as_float((__float_as_uint(P1[r])&e1_)|(0xff800000u&~e1_)); } \
    }while(0)
  bool resc=false;
  #define START(P0,P1,SLOW) do{ resc=false; seen=anysel_; \
    if(SLOW){ const float rm=rowmax(P0,P1); const float dl=(rm==-INFINITY)?0.f:rm; mhat=fadd_s(mhat,dl); \
      _Pragma("unroll") for(int r=0;r<16;++r){P0[r]=fsub_s(P0[r],dl);P1[r]=fsub_s(P1[r],dl);} \
      } \
    _Pragma("unroll") for(int r=0;r<16;++r)P0[r]=__builtin_amdgcn_exp2f(P0[r]); }while(0)
  #define RESC() do{ if(resc){ asm volatile("s_waitcnt lgkmcnt(0)":::"memory"); \
      _Pragma("unroll") for(int d_=0;d_<2;++d_) _Pragma("unroll") for(int r=0;r<16;++r)o[d_][r]*=wsf[crow(r,hi)]; } }while(0)
  f32x16 pA0,pA1,pB0,pB1;
  int sl_prev=0,sl_cur=0,sl_next=SLOTB;
  #define ROT() do{sl_prev=sl_cur;sl_cur=sl_next;sl_next=(sl_next==(NSLOT-1)*SLOTB)?0:sl_next+SLOTB;}while(0)
  DMA_K(2,2*SLOTB);
  WAIT_BAR(3);
  { mwO0=bmp[(size_t)2*SEQ]; mwO1=bmp[(size_t)3*SEQ]; knO=knp[1];
  const bool slow0_=SLOWT(E);
  qkt(pA0,pA1,Kbase,qr,zero16,r32,hi);asm volatile("s_nop 15\n\ts_nop 7":"+v"(pA0),"+v"(pA1));CMASK(pA0,pA1,slow0_,E);
  START(pA0,pA1,slow0_); }
  _Pragma("unroll") for(int r=0;r<16;++r)pA1[r]=__builtin_amdgcn_exp2f(pA1[r]);
  WAIT_BAR(0);
  DMA_K(3,0);DMA_V(1,SLOTB);
  ROT();
  kload8(kf,kp0+sl_cur);
  WAIT_BAR(2);
  s16x4 vlo[8],vhi[8]; u32x4 pw0,pw1,pw2,pw3;
  #define PKW(P,B) cvtpk_s(P[B],P[B+1])
  #define PAF(k) __builtin_bit_cast(bf16x8,pw##k)
  #define VFR(i) (bf16x8){vlo[i][0],vlo[i][1],vlo[i][2],vlo[i][3],vhi[i][0],vhi[i][1],vhi[i][2],vhi[i][3]}
  #define PIN(x) asm volatile("":"+v"(x))
  #define MX3(a,b,c) __builtin_fmaxf(__builtin_fmaxf((a),(b)),(c))
  #define GAPA(MF,A0,A1,A2,A3,W0,W1,PW) do{ MF; sacc+=A0; sacc+=A1; sacc+=A2; sacc+=A3; PIN(sacc); W0; W1; PIN(PW); SBAR(); }while(0)
  #define EX(v) __builtin_amdgcn_exp2f(v)
  #define GAPB(MF,X,B) do{ MF; X[B]=EX(X[B]); X[B+1]=EX(X[B+1]); X[B+2]=EX(X[B+2]); X[B+3]=EX(X[B+3]); PIN(X); SBAR(); }while(0)
  #define VRD(i) do{ vlo[i]=vtr(vp_+(((i)>>2)*4096+((i)&3)*1024)); vhi[i]=vtr(vp_+(((i)>>2)*4096+((i)&3)*1024+512)); }while(0)
  #define KRD(G,j) do{ if(G){ kload2(kf,kp0+sl_next,j); SBAR(); } }while(0)
  #define STEP(C0,C1,P0,P1,t,GK,GV,GL,PS,NS) do{ SBAR(); \
    if((t)+1<NT){ mw##NS##0=bmp[(size_t)(2*(t)+2)*SEQ]; mw##NS##1=bmp[(size_t)(2*(t)+3)*SEQ]; kn##NS=knp[(t)+1]; }     \
    const lds_cptr vp_=vp0+sl_prev; \
    VRD(0); SBAR(); float sacc=(P0[0]+P0[1]); \
    GAPA(C0=__builtin_amdgcn_mfma_f32_32x32x16_bf16(kf[0],qr[0],zero16,0,0,0), P0[2],P0[3],P0[4],P0[5],     pw0[0]=PKW(P0,0), pw0[1]=PKW(P0,2), pw0); \
    VRD(4); SBAR(); GAPA(C1=__builtin_amdgcn_mfma_f32_32x32x16_bf16(kf[1],qr[0],zero16,0,0,0), P0[6],P0[7],P0[8],P0[9],     pw0[2]=PKW(P0,4), pw0[3]=PKW(P0,6), pw0); \
    VRD(1); SBAR(); GAPA(C0=__builtin_amdgcn_mfma_f32_32x32x16_bf16(kf[2],qr[1],C0,0,0,0),   P0[10],P0[11],P0[12],P0[13], pw1[0]=PKW(P0,8), pw1[1]=PKW(P0,10), pw1); \
    VRD(5); SBAR(); GAPA(C1=__builtin_amdgcn_mfma_f32_32x32x16_bf16(kf[3],qr[1],C1,0,0,0),   P0[14],P0[15],P1[0],P1[1],   pw1[2]=PKW(P0,12),pw1[3]=PKW(P0,14), pw1); \
    VRD(2); SBAR(); GAPA(C0=__builtin_amdgcn_mfma_f32_32x32x16_bf16(kf[4],qr[2],C0,0,0,0),   P1[2],P1[3],P1[4],P1[5],     pw2[0]=PKW(P1,0), pw2[1]=PKW(P1,2), pw2); \
    VRD(6); SBAR(); GAPA(C1=__builtin_amdgcn_mfma_f32_32x32x16_bf16(kf[5],qr[2],C1,0,0,0),   P1[6],P1[7],P1[8],P1[9],     pw2[2]=PKW(P1,4), pw2[3]=PKW(P1,6), pw2); \
    VRD(3); SBAR(); GAPA(C0=__builtin_amdgcn_mfma_f32_32x32x16_bf16(kf[6],qr[3],C0,0,0,0),   P1[10],P1[11],P1[12],P1[13], pw3[0]=PKW(P1,8), pw3[1]=PKW(P1,10), pw3); \
    VRD(7); SBAR(); GAPA(C1=__builtin_amdgcn_mfma_f32_32x32x16_bf16(kf[7],qr[3],C1,0,0,0),   P1[14],P1[15],0.f,0.f,       pw3[2]=PKW(P1,12),pw3[3]=PKW(P1,14), pw3); \
    l_reg+=sacc; \
    if(GK){DMA_K((t)+3,sl_cur);} if(GV){DMA_V((t)+1,sl_next);} \
    const bool slow_=SLOWT(PS); CMASK(C0,C1,slow_,PS); resc=false; \
    if(__builtin_expect(slow_,0)){ float a=MX3(C0[0],C0[1],C1[0]),b=MX3(C0[2],C0[3],C1[1]); a=MX3(a,C1[2],C1[3]); \
      _Pragma("unroll") for(int r=4;r<16;r+=4){a=MX3(a,C0[r],C0[r+1]);b=MX3(b,C0[r+2],C0[r+3]);a=MX3(a,C1[r],C1[r+1]);b=MX3(b,C1[r+2],C1[r+3]);} \
      float rm=__builtin_fmaxf(a,b); { auto rr=__builtin_amdgcn_permlane32_swap(__float_as_uint(rm),__float_as_uint(rm),false,false); rm=__builtin_fmaxf(__uint_as_float(rr[0]),__uint_as_float(rr[1])); } \
      const bool fresh_=!seen&&rm>-INFINITY;     \
      if(__builtin_expect(__any(rm>(float)THRL||(fresh_&&rm<-(float)THRL)),0)){ const float dl=fresh_?rm:__builtin_fmaxf(rm,0.f); mhat+=dl; \
        _Pragma("unroll") for(int r=0;r<16;++r){C0[r]-=dl;C1[r]-=dl;} \
        const float f=dl>0.f?__builtin_amdgcn_exp2f(-dl):1.f; l_reg*=f; if(hi==0)wsf[r32]=f; resc=true; } } \
    seen=seen||anysel_; \
    SBAR(); \
    GAPB(o[0]=__builtin_amdgcn_mfma_f32_32x32x16_bf16(PAF(0),VFR(0),o[0],0,0,0), C0,0); \
    GAPB(o[1]=__builtin_amdgcn_mfma_f32_32x32x16_bf16(PAF(0),VFR(4),o[1],0,0,0), C0,4); \
    KRD(GL,0); GAPB(o[0]=__builtin_amdgcn_mfma_f32_32x32x16_bf16(PAF(1),VFR(1),o[0],0,0,0), C0,8); \
    KRD(GL,1); GAPB(o[1]=__builtin_amdgcn_mfma_f32_32x32x16_bf16(PAF(1),VFR(5),o[1],0,0,0), C0,12); \
    KRD(GL,2); GAPB(o[0]=__builtin_amdgcn_mfma_f32_32x32x16_bf16(PAF(2),VFR(2),o[0],0,0,0), C1,0); \
    KRD(GL,3); GAPB(o[1]=__builtin_amdgcn_mfma_f32_32x32x16_bf16(PAF(2),VFR(6),o[1],0,0,0), C1,4); \
    GAPB(o[0]=__builtin_amdgcn_mfma_f32_32x32x16_bf16(PAF(3),VFR(3),o[0],0,0,0), C1,8); \
    GAPB(o[1]=__builtin_amdgcn_mfma_f32_32x32x16_bf16(PAF(3),VFR(7),o[1],0,0,0), C1,12); \
    }while(0)
  int t=1;
  for(;t+5<NT;t+=2){
    STEP(pB0,pB1,pA0,pA1,t,true,true,true,O,E);     WAIT_BAR(2); RESC(); ROT();
    STEP(pA0,pA1,pB0,pB1,t+1,true,true,true,E,O);   WAIT_BAR(2); RESC(); ROT();
  }
  #define ENDW(tt) do{ if((tt)+3<NT){WAIT_BAR(2);} else if((tt)+2<NT){WAIT_BAR(1);} else {WAIT_BAR(0);} }while(0)
  for(;t+1<NT;t+=2){
    STEP(pB0,pB1,pA0,pA1,t,(t+3<NT),(t+1<NT),(t+1<NT),O,E);       ENDW(t);   RESC(); ROT();
    STEP(pA0,pA1,pB0,pB1,t+1,(t+4<NT),(t+2<NT),(t+2<NT),E,O);     ENDW(t+1); RESC(); ROT();
  }
  STEP(pB0,pB1,pA0,pA1,NT-1,false,false,false,O,E); RESC();
  { float sacc=pB0[0]+pB0[1]; _Pragma("unroll") for(int r=2;r<16;++r)sacc+=pB0[r]; _Pragma("unroll") for(int r=0;r<16;++r)sacc+=pB1[r]; l_reg+=sacc;
    pw0=(u32x4){PKW(pB0,0),PKW(pB0,2),PKW(pB0,4),PKW(pB0,6)};pw1=(u32x4){PKW(pB0,8),PKW(pB0,10),PKW(pB0,12),PKW(pB0,14)};pw2=(u32x4){PKW(pB1,0),PKW(pB1,2),PKW(pB1,4),PKW(pB1,6)};pw3=(u32x4){PKW(pB1,8),PKW(pB1,10),PKW(pB1,12),PKW(pB1,14)};
    SBAR(); pv(o,vb0+sl_cur,PAF(0),PAF(1),PAF(2),PAF(3)); }
  #undef PKW
  #undef PAF
  #undef VFR
  #undef PIN
  #undef MX3
  #undef GAPA
  #undef GAPB
  #undef EX
  #undef VRD
  #undef KRD
  #undef STEP
  #undef ENDW
  {auto rr=__builtin_amdgcn_permlane32_swap(__float_as_uint(l_reg),__float_as_uint(l_reg),false,false);l_reg=__uint_as_float(rr[0])+__uint_as_float(rr[1]);}
  if(hi==0)wsf[32+r32]=l_reg;asm volatile("s_waitcnt lgkmcnt(0)":::"memory");
  float rli[16];
  #pragma unroll
  for(int r=0;r<16;++r)rli[r]=__builtin_amdgcn_rcpf(wsf[32+crow(r,hi)]);
  bf16*Ow=O+(rowbase+q0+wid*QBLK)*DM+h*D;
  { bf16*stg=(bf16*)(shm+LDS_OST)+wid*2048;
    #pragma unroll
    for(int r=0;r<16;++r){const int orow=crow(r,hi);
      #pragma unroll
      for(int d0=0;d0<2;++d0)stg[orow*64+d0*32+r32]=__float2bfloat16(o[d0][r]*rli[r]);}
    asm volatile("s_waitcnt lgkmcnt(0)":::"memory");
    #pragma unroll
    for(int i=0;i<4;++i){const int row=i*8+(lane>>3),ch=lane&7; const u32x4 v=*(const u32x4*)(stg+row*64+ch*8); ATTN_STORE16(Ow+(long)row*DM+ch*8,v);} }
  asm volatile("s_waitcnt lgkmcnt(0)\n\ts_barrier":::"memory");
  #undef DMA_K
  #undef DMA_V
  #undef CMASK
  #undef SLOWT
  #undef START
  #undef RESC
  #undef ROT
}
constexpr int ATTN_LDS_BYTES=LDS_BYTES;
#undef SBAR
#undef WAIT_BAR
}
constexpr int MK_THREADS = 512;
constexpr int RING_BYTES = 131072, MISC_OFF = RING_BYTES + 320, MK_LDS_BYTES = 147456;
constexpr size_t WS_CTL = 0, CTL_ZERO_BYTES = 65536 + 7 * 131072; constexpr int CW_BAR = 4096;
constexpr int PH_PREP0 = 0, PH_L0 = 1, PH_PER_LAYER = 14, NPH = PH_L0 + 2 * PH_PER_LAYER;
enum { Q_INPROJ = 0, Q_SBIDX, Q_DSA, Q_GATES, Q_MERGE, Q_MIX, Q_NORMXA, Q_XALOG, Q_XAOUT, Q_NORMFFN, Q_UP, Q_FFNMID, Q_DOWN, Q_NEXT };

#ifndef QBUILD
#define QBUILD 0xffffu
#endif
#define QON(x) ((QBUILD >> (x)) & 1u)
struct Args { const float* in[20]; float* out; unsigned char* ws; int ph_lo, ph_hi; };

__global__ void __launch_bounds__(MK_THREADS, 2) mk_fwd(Args args) {
    __shared__ __attribute__((aligned(16))) unsigned char lds_raw[MK_LDS_BYTES];
    LAS unsigned char* lds = (LAS unsigned char*)lds_raw;
    volatile LAS unsigned* MISC = (volatile LAS unsigned*)(lds + MISC_OFF);
    const int G = gridDim.x, bx = blockIdx.x;
    unsigned char* ws0 = args.ws;
    const int wave_s = __builtin_amdgcn_readfirstlane((int)threadIdx.x >> 6);
    for (int u = mk_tid(wave_s); u < (MK_LDS_BYTES - RING_BYTES) / 4; u += MK_THREADS) ((LAS unsigned*)(lds + RING_BYTES))[u] = 0u;
    __syncthreads();
    const int lo = args.ph_lo, hi = args.ph_hi;
    XcdBarrier bar; bar.bar = (unsigned*)(ws0 + WS_CTL) + CW_BAR; bar.x = 0; bar.st = nullptr;
    if (hi - lo > 1) bar = xcd_barrier_post((unsigned*)(ws0 + WS_CTL) + CW_BAR, MISC + 8, mk_tid(wave_s));
#define BPW(off) ((bf16_t*)(ws + (off)))
    const int vcu = (G % 8 == 0) ? (bx % 8) * (G / 8) + bx / 8 : bx;
    for (int p = lo; p < hi; ++p) {
#ifdef PROBE_REP
        const int reps = (p >= PH_L0 && ((PROBE_REP >> ((p - PH_L0) % PH_PER_LAYER)) & 1)) ? 2 : 1;
#else
        const int reps = 1;
#endif
#ifdef PROBE_REP
#pragma unroll 1
        for (int rep = 0; rep < reps; ++rep) {
        const bool dry = rep + 1 < reps;
#else
        { constexpr bool dry = false;
#endif
        int oz = 0; asm volatile("" : "+s"(oz));
        int tid = mk_tid(wave_s); asm volatile("" : "+v"(tid));
        const int wave = __builtin_amdgcn_readfirstlane(tid >> 6), lane = tid & 63;
        WaveId W; W.gw = vcu * 8 + wave; W.ngw = G * 8; W.wave = wave; W.lane = lane;
        unsigned char* ws = args.ws + oz; float* X = args.out + oz;
#define INP(k) (args.in[(k) + oz])
        if (p == PH_PREP0) {
            prep0_phase(W, (LAS float*)(lds + wave * 16384), ws, args.in + oz, (bf16_t*)X);
        } else if (p >= PH_L0) {
            const int l = (p - PH_L0) / PH_PER_LAYER, q = (p - PH_L0) % PH_PER_LAYER;
            const float* Xin = l == 0 ? INP(0) : X;
            pg8::u64* SSb = (pg8::u64*)(ws + WS_SS);
#define SSA(i) (SSb + (size_t)(i) * T)
            if (q == Q_SBIDX) {
#ifndef NO_SB
                sb_phase(W, lds, ws, dry);
#endif
                __syncthreads();
#ifndef NO_IDX
#ifdef PROBE_SB_ONLY
                if (!dry)
#endif
                idx_phase(lds, ws, vcu, G, wave, lane);
#endif
                conv_sc_phase(vcu * MK_THREADS + tid, G * MK_THREADS, BPW(WS_SCB), BPW(WS_CX), INP(4) + l * 3 * 512, dry);
                kn_phase(W, BPW(WS_KC), (float*)(ws + WS_KN));
                if (l == 0 && !dry && QON(15)) {
                    __syncthreads();
                    { pg8::Order S; S.init(1, 4, 16, G, bx); pg8::PtrG P{(const char*)(ws + WS_KVM), (const char*)(ws + WS_WQ)}; pg8::EpiPrep E{ws, 1};
                      pg8::gemm_phase<pg8::EpiPrep, pg8::PtrG, true, true>(lds, tid, 2 * D, D, 256, S, P, E); }
                    { pg8::Order S; S.init(4, 1, 16, G, (bx + 64) % G); pg8::PtrH P{(const char*)(ws + WS_KVM), (const char*)(ws + WS_WOT)}; pg8::EpiPrep E{ws, 2};
                      pg8::gemm_phase<pg8::EpiPrep, pg8::PtrH, true, true>(lds, tid, D, 2 * D, 256, S, P, E); }
                }
            } else if (q == Q_DSA) {
#ifndef NO_DSA
                {
                    for (int pr = vcu; pr < NB * 8 * 16; pr += G) { const int bh = pr >> 4, sx = pr & 15, bb = bh >> 3, hh = bh & 7;
#pragma unroll 1
                        for (int k2 = 0; k2 < 2; ++k2)
                            attn_body::attn_unit<8>(bb, hh, k2 == 0 ? sx : 31 - sx, (const attn_body::bf16*)BPW(WS_QC), (const attn_body::bf16*)BPW(WS_KC), (const attn_body::bf16*)BPW(WS_VC),
                                                    (attn_body::bf16*)(dry ? BPW(WS_KA) : BPW(WS_QC)), (char*)lds_raw, (const unsigned*)(ws + WS_BM) + (size_t)bb * 256 * S,
                                                    (const float*)(ws + WS_KN) + bh * (S / 64), tid); }
                }
#endif
            } else if (q == Q_FFNMID) {
            } else if (q == Q_NEXT) {
                if (l + 1 < DEPTH) { int base = 0; convert_layer_weights(W, (LAS float*)(lds + wave * 16384), base, ws, args.in + oz, l + 1); }
                else if (!dry) final_norm(W, BPW(WS_XN), X, INP(19), SSA(6));
            } else if (q == Q_INPROJ && QON(Q_INPROJ)) {
                pg8::Order S; S.init(T / 256, NIN / 256, 1, G, bx);
                pg8::PtrStd P{(const char*)X, (const char*)(ws + WS_WIN), 0, 0, 0, (size_t)256 * D * 2, (size_t)256 * D * 2};
                pg8::EpiInProj E{ws, SSA(3 * l)};
                pg8::gemm_phase<pg8::EpiInProj, pg8::PtrStd, true, true>(lds, tid, D, D, D, S, P, E);
                if (l == 0 && !dry && QON(14)) {
                    pg8::Order S2; S2.init(2, 8, 2, G, (bx + G - 64) % G);
                    pg8::PtrStd P2{(const char*)(ws + WS_MEMN), (const char*)(ws + WS_WKVT), 1 * MiB, 4 * MiB, 0, (size_t)256 * D * 2, (size_t)256 * D * 2};
                    pg8::EpiPrep E2{ws, 0};
                    pg8::gemm_phase<pg8::EpiPrep, pg8::PtrStd, true, true>(lds, tid, D, D, D, S2, P2, E2);
                }
            } else if (q == Q_GATES && QON(Q_GATES)) {
                pg8::Order S; S.init(T / 256, 12, 1, G, bx);
                pg8::PtrStd P{(const char*)X, (const char*)(ws + WS_WG), 0, 0, 0, (size_t)256 * D * 2, (size_t)256 * D * 2};
                pg8::EpiGates E{BPW(WS_GATES), SSA(3 * l)};
                pg8::gemm_phase<pg8::EpiGates, pg8::PtrStd, true, true>(lds, tid, D, D, D, S, P, E);
            } else if (q == Q_MERGE && QON(Q_MERGE)) {
                pg8::Order S; S.init(T / 256, 4, 3, G, bx);
                pg8::PtrStd P{(const char*)(ws + WS_QA), (const char*)(ws + WS_WBR), 16 * MiB, (size_t)D * 512 * 2, 0, (size_t)256 * 512 * 2, (size_t)256 * 512 * 2};
                pg8::EpiMerge E{BPW(WS_XN), BPW(WS_GATES)};
                pg8::gemm_phase<pg8::EpiMerge, pg8::PtrStd, true, true>(lds, tid, 512, 512, 512, S, P, E);
            } else if (q == Q_MIX && QON(Q_MIX)) {
                pg8::Order S; S.init(T / 256, 4, 1, G, bx);
                pg8::PtrStd P{(const char*)(ws + WS_XN), (const char*)(ws + WS_WMIX), 0, 0, 0, (size_t)256 * D * 2, (size_t)256 * D * 2};
                if (l == 0) { pg8::EpiResid<true> E{(const void*)INP(0), dry ? BPW(WS_FU) : BPW(WS_XBXA), dry ? SSA(0) : SSA(1)};
                    pg8::gemm_phase<pg8::EpiResid<true>, pg8::PtrStd, true, true>(lds, tid, D, D, D, S, P, E); }
                else { pg8::EpiResid<false> E{(const void*)X, dry ? BPW(WS_FU) : BPW(WS_XBXA), dry ? SSA(0) : SSA(4)};
                    pg8::gemm_phase<pg8::EpiResid<false>, pg8::PtrStd, true, true>(lds, tid, D, D, D, S, P, E); }

            } else if (q == Q_XALOG && QON(Q_XALOG)) {
                pg8::Order S; S.init(T / 256, 4, 1, G, bx);
                pg8::PtrStd P{(const char*)(ws + WS_XBXA), (const char*)(ws + WS_GT + (size_t)l * 4 * MiB), 0, 0, 2 * MiB, (size_t)256 * D * 2, (size_t)256 * D * 2};
                pg8::EpiSoftmax E{BPW(WS_PXA), SSA(1 + 3 * l)};
                pg8::gemm_phase<pg8::EpiSoftmax, pg8::PtrStd, false, true>(lds, tid, D, D, D, S, P, E);
            } else if (q == Q_XAOUT && QON(Q_XAOUT)) {
                pg8::Order S; S.init(T / 256, 4, 1, G, bx);
                pg8::PtrStd P{(const char*)(ws + WS_PXA), (const char*)(ws + WS_HT + (size_t)l * 4 * MiB), 0, 0, 2 * MiB, (size_t)256 * D * 2, (size_t)256 * D * 2};
                pg8::EpiResid<false> E{(const void*)BPW(WS_XBXA), dry ? BPW(WS_FU) : BPW(WS_XN), dry ? SSA(0) : SSA(2 + 3 * l)};
                pg8::gemm_phase<pg8::EpiResid<false>, pg8::PtrStd, true, true>(lds, tid, D, D, D, S, P, E);
            } else if (q == Q_UP && QON(Q_UP)) {
                pg8::Order S; S.init(T / 256, 22, 1, G, bx);
                pg8::PtrStd P{(const char*)(ws + WS_XN), (const char*)(ws + WS_WUP), 0, 0, 0, (size_t)256 * D * 2, (size_t)256 * D * 2};
                pg8::EpiUpF E{BPW(WS_FU), BPW(WS_SIDEA), BPW(WS_SIDEU), SSA(2 + 3 * l), INP(16) + l * 3 * DFF, INP(17) + l * DFF};
                pg8::gemm_phase<pg8::EpiUpF, pg8::PtrStd, true, true>(lds, tid, D, D, D, S, P, E);
            } else if (q == Q_DOWN && QON(Q_DOWN)) {
                pg8::Order S; S.init(T / 256, 4, 1, G, bx);
                if (!dry) {
#pragma unroll 1
                    for (int i = 0; ; ++i) { pg8::Unit u0; if (!S.next(i, u0)) break; ffn_fix_phase(tid, MK_THREADS, BPW(WS_SIDEA), BPW(WS_SIDEU), BPW(WS_FU), INP(16) + l * 3 * DFF, INP(17) + l * DFF, 4 * u0.pm, 4); }
                    asm volatile("s_waitcnt vmcnt(0)" ::: "memory"); __syncthreads();
                }
                pg8::PtrStd P{(const char*)(ws + WS_FU), (const char*)(ws + WS_WDOWN), 0, 0, 0, (size_t)256 * DFF * 2, (size_t)256 * DFF * 2};
                pg8::EpiResid<false> E{(const void*)BPW(WS_XN), dry ? BPW(WS_QA) : (l + 1 < DEPTH ? (bf16_t*)X : BPW(WS_XN)), dry ? SSA(0) : SSA(3 + 3 * l)};
                pg8::gemm_phase<pg8::EpiResid<false>, pg8::PtrStd, true, true>(lds, tid, DFF, DFF, DFF, S, P, E);
            }
        }
        }
        if (p + 1 < hi && !(p >= PH_L0 && ((p - PH_L0) % PH_PER_LAYER == Q_NORMXA || (p - PH_L0) % PH_PER_LAYER == Q_NORMFFN || (p - PH_L0) % PH_PER_LAYER == Q_FFNMID))) xcd_barrier(bar, mk_tid(wave_s));
    }
}

extern "C" void kernel_launch(void* const* d_in, const int* in_sizes, int n_in, void* d_out, int out_size, void* d_ws, size_t ws_size, hipStream_t st) {
    if (n_in != 20 || ws_size < WS_NEED || out_size != T * D) { fprintf(stderr, "kernel_launch: unexpected sizes n_in %d ws %zu out %d\n", n_in, ws_size, out_size); return; }
    static int grid = 0;
    if (grid == 0) {
        int dev = 0, cus = 0, per_cu = 0;
        (void)hipGetDevice(&dev); (void)hipDeviceGetAttribute(&cus, hipDeviceAttributeMultiprocessorCount, dev);
        if (hipOccupancyMaxActiveBlocksPerMultiprocessor(&per_cu, (const void*)mk_fwd, MK_THREADS, 0) != hipSuccess || per_cu < 1) { fprintf(stderr, "kernel_launch: occupancy query says %d blocks/CU\n", per_cu); grid = -1; return; }
        (void)hipGetLastError();
        if (cus != 256) { fprintf(stderr, "kernel_launch: built for a 256-CU device, found %d\n", cus); grid = -1; return; }
        grid = cus;
    }
    if (grid < 0) return;
    (void)hipMemsetAsync((char*)d_ws + WS_CTL, 0, CTL_ZERO_BYTES, st);
    Args a{};
    for (int i = 0; i < 20; ++i) a.in[i] = (const float*)d_in[i];
    a.out = (float*)d_out; a.ws = (unsigned char*)d_ws; a.ph_lo = 0; a.ph_hi = NPH;
    hipLaunchKernelGGL(mk_fwd, dim3(grid), dim3(MK_THREADS), 0, st, a);
}
```

```cpp
#include <hip/hip_runtime.h>
#include <stdint.h>
#include <stdio.h>

typedef unsigned short bf16_t;
typedef short bf16x8 __attribute__((ext_vector_type(8)));
typedef float f32x16 __attribute__((ext_vector_type(16)));
typedef float f32x4 __attribute__((ext_vector_type(4)));
#define DEV __device__ __forceinline__

constexpr int NB = 2, S = 8192, D = 1024, T = NB * S, DEPTH = 2;
constexpr int DIN = 8264, DFF = 2816, MEM = 256;
constexpr int NIN = 5376;
constexpr float LOG2E = 1.4426950408889634f;
constexpr float QSCALE = 0.125f * LOG2E;
constexpr float WSCALE = 0.125f * 0.35355339059327373f;
constexpr float XSCALE = 0.0625f * LOG2E;
constexpr float EPS = 1e-6f;
#ifndef MK_FUSE
#define MK_FUSE 1
#endif

constexpr size_t MiB = 1u << 20;
constexpr size_t WS_SIDEA = 88 * MiB, WS_SIDEU = 96 * MiB;
constexpr size_t WS_KN = 983040;
constexpr size_t WS_GT = 1 * MiB;
constexpr size_t WS_HT = 9 * MiB;
constexpr size_t WS_WUP = 17 * MiB, WS_WDOWN = 28 * MiB;
constexpr size_t WS_XN = 34 * MiB;
constexpr size_t WS_WMIX = 66 * MiB, WS_WBR = 68 * MiB, WS_WG = 71 * MiB, WS_WIN = 77 * MiB;
constexpr size_t WS_QA = 88 * MiB, WS_SCB = 104 * MiB, WS_QC = 120 * MiB, WS_KA = 136 * MiB, WS_VA = 152 * MiB, WS_KC = 168 * MiB, WS_VC = 184 * MiB,
                 WS_IQ = 200 * MiB, WS_CX = 216 * MiB, WS_IK = 232 * MiB, WS_IW = 234 * MiB, WS_BM = 235 * MiB;
constexpr size_t WS_GATES = 136 * MiB;
constexpr size_t WS_XTMP = 235 * MiB;
constexpr size_t WS_LOG = 88 * MiB, WS_PXA = 168 * MiB;
constexpr size_t WS_XBXA = 136 * MiB;
constexpr size_t WS_SS = 65536;
constexpr size_t WS_FA = 66 * MiB, WS_FU = 154 * MiB;
constexpr size_t WS_WQ = 34 * MiB  , WS_WOT = 38 * MiB  , WS_WKVT = 42 * MiB  , WS_MEMN = 50 * MiB  , WS_KVM = 52 * MiB  ;
constexpr size_t WS_NEED = 256 * MiB;

DEV bf16_t f2bf(float f) { unsigned u = __float_as_uint(f); u += 0x7fffu + ((u >> 16) & 1u); return (bf16_t)(u >> 16); }
DEV float bf2f(bf16_t h) { return __uint_as_float(((unsigned)h) << 16); }
DEV float wave_sum(float v) {
#pragma unroll
    for (int o = 1; o < 64; o <<= 1) v += __shfl_xor(v, o);
    return v;
}
DEV float wave_max(float v) {
#pragma unroll
    for (int o = 1; o < 64; o <<= 1) v = fmaxf(v, __shfl_xor(v, o));
    return v;
}


#define LAS __attribute__((address_space(3)))
#define GAS __attribute__((address_space(1)))
typedef unsigned u32x4 __attribute__((ext_vector_type(4)));
typedef unsigned u32x2 __attribute__((ext_vector_type(2)));
typedef float f32x2 __attribute__((ext_vector_type(2)));
#define LDS_WAIT() asm volatile("s_waitcnt lgkmcnt(0)" ::: "memory")
DEV int mk_tid(int wave_s) { unsigned ones = ~0u; asm volatile("" : "+s"(ones)); return wave_s * 64 + (int)__builtin_amdgcn_mbcnt_hi(ones, __builtin_amdgcn_mbcnt_lo(ones, 0u)); }
#define VM_WAIT() asm volatile("s_waitcnt vmcnt(0)" ::: "memory")
typedef __bf16 bf16x2_t __attribute__((ext_vector_type(2)));
DEV unsigned cvt_pk_bf16(float lo, float hi) { const f32x2 v = {lo, hi}; return __builtin_bit_cast(unsigned, __builtin_convertvector(v, bf16x2_t)); }
DEV float bflo(unsigned w) { return __uint_as_float(w << 16); }
DEV float bfhi(unsigned w) { return __uint_as_float(w & 0xffff0000u); }

namespace pg8 {
constexpr int BM = 256, BK = 64, HALF = 128, HTB = HALF * BK * 2, STAGE_BYTES = 8 * HTB, NXCD = 8, WGM = 8;
__host__ __device__ __forceinline__ int lds_byte(int r, int c) { const int st = (r >> 4) * 2 + (c >> 5), rr = r & 15, cc = c & 31, ob = rr * 64 + cc * 2; return st * 1024 + (ob ^ (((ob >> 9) & 1) << 5)); }
__host__ __device__ __forceinline__ void stage_rc(int b, int& R, int& C) { const int st = b / 1024, sb = b % 1024, swz = sb ^ (((sb >> 9) & 1) << 5); R = (st >> 1) * 16 + swz / 64; C = (st & 1) * 32 + (swz % 64) / 2; }
__host__ __device__ __forceinline__ int perm32(int rho) { const int n = rho >> 4, i = rho & 15; return 8 * (i >> 2) + 4 * n + (i & 3); }

struct Unit { int pm, pn, job; };
struct Order {
    int nM, nN, nwg, ntot, G, c;
    DEV void init(int nM_, int nN_, int njob, int G_, int c_) { nM = nM_; nN = nN_; nwg = nM * nN; ntot = nwg * njob; G = G_; c = c_; }
    DEV bool next(int i, Unit& u) const {
        const int L = i * G + c; if (L >= ntot) return false;
        u.job = L / nwg; int wgid = L - u.job * nwg;
        { const int q = nwg / NXCD, r = nwg % NXCD, xcd = wgid % NXCD, off = wgid / NXCD; wgid = (xcd < r ? xcd * (q + 1) : r * (q + 1) + (xcd - r) * q) + off; }
        const int nig = WGM * nN, gid = wgid / nig, fm = gid * WGM, gsz = (nM - fm) < WGM ? (nM - fm) : WGM;
        u.pm = fm + ((wgid % nig) % gsz); u.pn = (wgid % nig) / gsz; return true;
    }
};
template <class T, class = void> struct epi_chain { static constexpr bool value = false; };
template <class T> struct epi_chain<T, decltype((void)T::CHAIN)> { static constexpr bool value = T::CHAIN; };
template <class Epi, class Ptr, bool ALIGN_EPI, bool SP2>
DEV void gemm_phase(LAS unsigned char* lds, const int tid_in, const int lda, const int ldb, const int K, const Order& S, const Ptr& P, const Epi& E) {
    int tid_ = tid_in; asm volatile("" : "+v"(tid_));
    const int tid = tid_, wid = __builtin_amdgcn_readfirstlane(tid >> 6), lane = tid & 63, wr = wid >> 2, wc = wid & 3, fr = lane & 15, fq = lane >> 4;
    const int nt = K / BK;
    unsigned voffA[2], voffB[2];
#pragma unroll
    for (int i = 0; i < 2; ++i) { int R, C; stage_rc(tid * 16 + i * 8192, R, C); const int Rb = Epi::PERM ? ((R & ~31) + perm32(R & 31)) : R;
        voffA[i] = (unsigned)(R * lda + C) * 2u; voffB[i] = (unsigned)(Rb * ldb + C) * 2u; }
    const size_t kstep = (size_t)(BK * 2);
    const size_t hstepA = (size_t)HALF * lda * 2, hstepB = (size_t)HALF * ldb * 2;
    const unsigned ldsw = (unsigned)wid * 1024u;
    const int aoff = lds_byte(wr * 64 + fr, fq * 8), boff = lds_byte(wc * 32 + fr, fq * 8);
#define PG8_SA(b, h) (((b) * 2 + (h)) * HTB)
#define PG8_SB(b, h) ((4 + (b) * 2 + (h)) * HTB)
#define PG8_STAGE(bufoff, gbase, voff) do { _Pragma("unroll") for (int _i = 0; _i < 2; ++_i) \
        __builtin_amdgcn_global_load_lds((const unsigned*)((const char*)(gbase) + (voff)[_i]), (LAS unsigned*)(lds + (bufoff) + ldsw + _i * 8192), 16, 0, 0); } while (0)
#define PG8_LDA(dst, b, h) do { _Pragma("unroll") for (int m = 0; m < 4; ++m) _Pragma("unroll") for (int k = 0; k < 2; ++k) dst[m][k] = *(const LAS bf16x8*)(lds + PG8_SA(b, h) + aoff + m * 2048 + k * 1024); } while (0)
#define PG8_LDB(dst, b, h) do { _Pragma("unroll") for (int n = 0; n < 2; ++n) _Pragma("unroll") for (int k = 0; k < 2; ++k) dst[n][k] = *(const LAS bf16x8*)(lds + PG8_SB(b, h) + boff + n * 2048 + k * 1024); } while (0)
#define PG8_MMA(ai, bj, At, Bt) do { __builtin_amdgcn_s_setprio(1); _Pragma("unroll") for (int m = 0; m < 4; ++m) _Pragma("unroll") for (int n = 0; n < 2; ++n) _Pragma("unroll") for (int k = 0; k < 2; ++k) \
        acc[ai][bj][m][n] = __builtin_amdgcn_mfma_f32_16x16x32_bf16(Bt[n][k], At[m][k], acc[ai][bj][m][n], 0, 0, 0); __builtin_amdgcn_s_setprio(0); } while (0)
#define PG8_WAIT_V(n) asm volatile("s_waitcnt vmcnt(" #n ")" ::: "memory")
#define PG8_WAIT_L(n) asm volatile("s_waitcnt lgkmcnt(" #n ")" ::: "memory")
#define PG8_BAR __builtin_amdgcn_s_barrier()
#define PG8_SCHED __builtin_amdgcn_sched_barrier(0)
    Unit cur, nxt; int ui = 0;
    if (!S.next(0, cur)) return;
    f32x4 acc[2][2][4][2];
#pragma unroll
    for (int a = 0; a < 2; ++a)
#pragma unroll
        for (int b = 0; b < 2; ++b)
#pragma unroll
            for (int m = 0; m < 4; ++m)
#pragma unroll
                for (int n = 0; n < 2; ++n) acc[a][b][m][n] = (f32x4){0.f, 0.f, 0.f, 0.f};
    bf16x8 At[4][2], B0[2][2], B1[2][2];
    const char* cA = P.a(cur); const char* cB = P.b(cur);
    typename Epi::Pre pre; E.prefetch(pre, cur, wr, fr);
    if constexpr (SP2) {
        PG8_STAGE(PG8_SB(0, 0), cB, voffB); PG8_STAGE(PG8_SB(0, 1), cB + hstepB, voffB); PG8_STAGE(PG8_SA(0, 0), cA, voffA); PG8_STAGE(PG8_SA(0, 1), cA + hstepA, voffA);
        if (wr == 1) PG8_BAR;
        PG8_WAIT_V(2); PG8_BAR;
        PG8_STAGE(PG8_SB(1, 0), cB + kstep, voffB); PG8_STAGE(PG8_SA(1, 0), cA + kstep, voffA); PG8_STAGE(PG8_SB(1, 1), cB + hstepB + kstep, voffB);
        PG8_WAIT_V(6); PG8_BAR;
    } else {
        PG8_STAGE(PG8_SB(0, 0), cB, voffB); PG8_STAGE(PG8_SA(0, 0), cA, voffA); PG8_STAGE(PG8_SB(0, 1), cB + hstepB, voffB); PG8_STAGE(PG8_SA(0, 1), cA + hstepA, voffA);
        if (wr == 1) PG8_BAR;
        PG8_WAIT_V(4); PG8_BAR;
        PG8_STAGE(PG8_SB(1, 0), cB + kstep, voffB); PG8_STAGE(PG8_SA(1, 0), cA + kstep, voffA); PG8_STAGE(PG8_SB(1, 1), cB + hstepB + kstep, voffB);
        PG8_WAIT_V(6); PG8_BAR;
    }
#pragma unroll 1
    for (;;) {
        const bool has_next = S.next(ui + 1, nxt);
        const char* nA = has_next ? P.a(nxt) : cA; const char* nB = has_next ? P.b(nxt) : cB;
#pragma unroll 1
        for (int t = 0; t < nt; t += 2) {
            const bool last = (t == nt - 2);
            const char* a1 = cA + (size_t)(t + 1) * kstep;
            const char* a2 = last ? nA : cA + (size_t)(t + 2) * kstep; const char* b2 = last ? nB : cB + (size_t)(t + 2) * kstep;
            const char* a3 = a2 + kstep; const char* b3 = b2 + kstep;
            if constexpr (SP2) {
            PG8_LDB(B0, 0, 0); PG8_LDB(B1, 0, 1); PG8_SCHED; PG8_LDA(At, 0, 0); PG8_STAGE(PG8_SA(1, 1), a1 + hstepA, voffA);
            PG8_WAIT_V(8); PG8_WAIT_L(0); PG8_BAR; PG8_MMA(0, 0, At, B0); PG8_MMA(0, 1, At, B1); PG8_BAR; PG8_SCHED;
            PG8_LDA(At, 0, 1); PG8_STAGE(PG8_SB(0, 0), b2, voffB); PG8_STAGE(PG8_SB(0, 1), b2 + hstepB, voffB); PG8_STAGE(PG8_SA(0, 0), a2, voffA);
            PG8_WAIT_V(8); PG8_WAIT_L(0); PG8_BAR; PG8_MMA(1, 0, At, B0); PG8_MMA(1, 1, At, B1); PG8_BAR; PG8_SCHED;
            PG8_LDB(B0, 1, 0); PG8_LDB(B1, 1, 1); PG8_SCHED; PG8_LDA(At, 1, 0); PG8_STAGE(PG8_SA(0, 1), a2 + hstepA, voffA);
            PG8_WAIT_V(8); PG8_WAIT_L(0); PG8_BAR; PG8_MMA(0, 0, At, B0); PG8_MMA(0, 1, At, B1); PG8_BAR; PG8_SCHED;
            PG8_LDA(At, 1, 1); PG8_STAGE(PG8_SB(1, 0), b3, voffB); PG8_STAGE(PG8_SB(1, 1), b3 + hstepB, voffB); PG8_STAGE(PG8_SA(1, 0), a3, voffA);
            PG8_WAIT_V(8); PG8_WAIT_L(0); PG8_BAR; PG8_MMA(1, 0, At, B0); PG8_MMA(1, 1, At, B1); PG8_BAR; PG8_SCHED;
            } else {
            PG8_LDB(B0, 0, 0); PG8_SCHED; PG8_LDA(At, 0, 0); PG8_STAGE(PG8_SA(1, 1), a1 + hstepA, voffA);
            PG8_WAIT_L(8); PG8_BAR; PG8_WAIT_L(0); PG8_MMA(0, 0, At, B0); PG8_BAR; PG8_SCHED;
            PG8_LDB(B1, 0, 1); PG8_STAGE(PG8_SB(0, 0), b2, voffB);
            PG8_BAR; PG8_WAIT_L(0); PG8_MMA(0, 1, At, B1); PG8_BAR;
            PG8_LDA(At, 0, 1); PG8_STAGE(PG8_SA(0, 0), a2, voffA);
            PG8_BAR; PG8_WAIT_L(0); PG8_MMA(1, 0, At, B0); PG8_BAR; PG8_SCHED;
            PG8_STAGE(PG8_SB(0, 1), b2 + hstepB, voffB);
            PG8_WAIT_V(6); PG8_BAR; PG8_MMA(1, 1, At, B1); PG8_BAR;
            PG8_LDB(B0, 1, 0); PG8_SCHED; PG8_LDA(At, 1, 0); PG8_STAGE(PG8_SA(0, 1), a2 + hstepA, voffA);
            PG8_WAIT_L(8); PG8_BAR; PG8_WAIT_L(0); PG8_MMA(0, 0, At, B0); PG8_BAR; PG8_SCHED;
            PG8_LDB(B1, 1, 1); PG8_STAGE(PG8_SB(1, 0), b3, voffB);
            PG8_BAR; PG8_WAIT_L(0); PG8_MMA(0, 1, At, B1); PG8_BAR;
            PG8_LDA(At, 1, 1); PG8_STAGE(PG8_SA(1, 0), a3, voffA);
            PG8_BAR; PG8_WAIT_L(0); PG8_MMA(1, 0, At, B0); PG8_BAR; PG8_SCHED;
            PG8_STAGE(PG8_SB(1, 1), b3 + hstepB, voffB);
            PG8_WAIT_V(6); PG8_BAR; PG8_MMA(1, 1, At, B1); PG8_BAR;
            }
        }
        if constexpr (ALIGN_EPI) { if (wr == 0) PG8_BAR; }
        if constexpr (!Epi::AFTER_DRAIN) { int fr_ = fr, fq_ = fq; asm volatile("" : "+v"(fr_), "+v"(fq_));
            E(acc, cur, wr, wc, fr_, fq_, pre); }
        if (!has_next) break;
        if (!epi_chain<Epi>::value || nxt.job == 0) {
#pragma unroll
        for (int a = 0; a < 2; ++a)
#pragma unroll
            for (int b = 0; b < 2; ++b)
#pragma unroll
                for (int m = 0; m < 4; ++m)
#pragma unroll
                    for (int n = 0; n < 2; ++n) acc[a][b][m][n] = (f32x4){0.f, 0.f, 0.f, 0.f};
        }
        cur = nxt; cA = nA; cB = nB; ++ui; E.prefetch(pre, cur, wr, fr);
        if constexpr (ALIGN_EPI) { if (wr == 1) PG8_BAR; }
    }
    PG8_WAIT_V(0);
    if constexpr (!ALIGN_EPI) { if (wr == 0) PG8_BAR; }
    PG8_BAR;
    if constexpr (Epi::AFTER_DRAIN) { int fr_ = fr, fq_ = fq, lane_ = lane; asm volatile("" : "+v"(fr_), "+v"(fq_), "+v"(lane_)); E.fused(acc, cur, wr, wc, fr_, fq_, lds, wid, lane_, pre); }
#undef PG8_SA
#undef PG8_SB
#undef PG8_STAGE
#undef PG8_LDA
#undef PG8_LDB
#undef PG8_MMA
#undef PG8_WAIT_V
#undef PG8_WAIT_L
#undef PG8_BAR
#undef PG8_SCHED
}
typedef f32x4 Acc[2][2][4][2];

struct PtrStd {
    const char* A; const char* B; size_t aj, bj, bb, arow, brow;
    DEV const char* a(const Unit& u) const { return A + (size_t)u.job * aj + (size_t)u.pm * arow; }
    DEV const char* b(const Unit& u) const { return B + (size_t)u.job * bj + (size_t)(u.pm >> 5) * bb + (size_t)u.pn * brow; }
};
struct PtrG {
    const char* KVM; const char* WQ;
    DEV const char* a(const Unit& u) const { return KVM + (size_t)(u.job >> 2) * MiB + (size_t)(u.job & 3) * 512; }
    DEV const char* b(const Unit& u) const { return WQ + (size_t)(u.job >> 3) * 2 * MiB + (size_t)(u.job & 3) * 512 + (size_t)u.pn * 256 * 1024 * 2; }
};
struct PtrH {
    const char* KVM; const char* WOT;
    DEV const char* a(const Unit& u) const { return WOT + (size_t)(u.job >> 3) * 2 * MiB + (size_t)(u.job & 3) * 512 + (size_t)u.pm * 256 * 1024 * 2; }
    DEV const char* b(const Unit& u) const { return KVM + (size_t)(u.job >> 2) * MiB + 2048 + (size_t)(u.job & 3) * 512; }
};

#define EPI_ROWS(u) const int row0 = (u).pm * BM + wr * 64 + fr
DEV u32x4 pack8(const f32x4 v0, const f32x4 v1) { u32x4 w; w.x = cvt_pk_bf16(v0[0], v0[1]); w.y = cvt_pk_bf16(v0[2], v0[3]); w.z = cvt_pk_bf16(v1[0], v1[1]); w.w = cvt_pk_bf16(v1[2], v1[3]); return w; }

struct PreNone {};
typedef unsigned long long u64;
constexpr float SS_SCALE = 65536.f;
struct PreRs { u64 v[2][4]; };
DEV void pre_rs(PreRs& p, const u64* ss, int row0) {
#pragma unroll
    for (int ai = 0; ai < 2; ++ai)
#pragma unroll
        for (int m = 0; m < 4; ++m) p.v[ai][m] = __builtin_nontemporal_load(ss + row0 + ai * HALF + m * 16);
}
DEV void rs_of(float (&rs)[2][4], const PreRs& p) {
#pragma unroll
    for (int ai = 0; ai < 2; ++ai)
#pragma unroll
        for (int m = 0; m < 4; ++m) rs[ai][m] = rsqrtf((float)p.v[ai][m] * (1.f / (SS_SCALE * D)) + EPS);
}
struct EpiInProj {
    typedef PreRs Pre;
    DEV void prefetch(PreRs& p, const Unit& u, int wr, int fr) const { pre_rs(p, ss, u.pm * BM + wr * 64 + fr); }
    static constexpr bool PERM = true, AFTER_DRAIN = false;
    unsigned char* ws; const u64* ss;
    DEV void operator()(const Acc& acc, const Unit& u, int wr, int wc, int fr, int fq, const PreRs& pre) const {
        EPI_ROWS(u); const int pn = u.pn, cb = wc * 32 + 8 * fq;
        float rs[2][4]; rs_of(rs, pre);
        if (pn < 16) {
            const int g = pn >> 1;
            const size_t off = g == 0 ? WS_QA : g == 1 ? WS_KA : g == 2 ? WS_VA : g == 3 ? WS_QC : g == 4 ? WS_KC : g == 5 ? WS_VC : g == 6 ? WS_IQ : WS_SCB;
            const float sc = (g == 0 || g == 3) ? QSCALE : 1.f;
            bf16_t* base = (bf16_t*)(ws + off) + (pn & 1) * 256 + cb;
#pragma unroll
            for (int ai = 0; ai < 2; ++ai)
#pragma unroll
                for (int m = 0; m < 4; ++m) { bf16_t* rowp = base + (size_t)(row0 + ai * HALF + m * 16) * 512;
#pragma unroll
                    for (int bj = 0; bj < 2; ++bj) *(u32x4*)(rowp + bj * HALF) = pack8(acc[ai][bj][m][0] * (sc * rs[ai][m]), acc[ai][bj][m][1] * (sc * rs[ai][m])); }
        } else if (pn < 20) {
            bf16_t* base = (bf16_t*)(ws + WS_CX) + (pn - 16) * 128 + cb;
#pragma unroll
            for (int ai = 0; ai < 2; ++ai)
#pragma unroll
                for (int m = 0; m < 4; ++m) { const float r2 = rs[ai][m] * rs[ai][m]; *(u32x4*)(base + (size_t)(row0 + ai * HALF + m * 16) * 512) = pack8(acc[ai][0][m][0] * acc[ai][1][m][0] * r2, acc[ai][0][m][1] * acc[ai][1][m][1] * r2); }
        } else {
            if (wc < 2) { bf16_t* base = (bf16_t*)(ws + WS_IK);
#pragma unroll
                for (int ai = 0; ai < 2; ++ai)
#pragma unroll
                    for (int m = 0; m < 4; ++m) { const int t = row0 + ai * HALF + m * 16;
                        *(u32x4*)(base + (size_t)(t >> 5) * 2048 + (((cb >> 3) * 32 + (t & 31)) * 8)) = pack8(acc[ai][0][m][0] * rs[ai][m], acc[ai][0][m][1] * rs[ai][m]); }
            } else if (wc == 2 && fq == 0) { float* base = (float*)(ws + WS_IW);
#pragma unroll
                for (int ai = 0; ai < 2; ++ai)
#pragma unroll
                    for (int m = 0; m < 4; ++m) { float* p = base + (size_t)(row0 + ai * HALF + m * 16) * 8; *(f32x4*)p = acc[ai][0][m][0] * (WSCALE * rs[ai][m]); *(f32x4*)(p + 4) = acc[ai][0][m][1] * (WSCALE * rs[ai][m]); }
            }
        }
    }
};
DEV f32x4 sigm4(const f32x4 v) { f32x4 o;
#pragma unroll
    for (int i = 0; i < 4; ++i) o[i] = __builtin_amdgcn_rcpf(1.f + __builtin_amdgcn_exp2f(-LOG2E * v[i])); return o; }
struct EpiGates {
    typedef PreRs Pre;
    DEV void prefetch(PreRs& p, const Unit& u, int wr, int fr) const { pre_rs(p, ss, u.pm * BM + wr * 64 + fr); }
    static constexpr bool PERM = true, AFTER_DRAIN = false;
    bf16_t* G; const u64* ss;
    DEV void operator()(const Acc& acc, const Unit& u, int wr, int wc, int fr, int fq, const PreRs& pre) const {
        EPI_ROWS(u); float rs[2][4]; rs_of(rs, pre); bf16_t* base = G + (size_t)(u.pn >> 2) * T * D + (u.pn & 3) * 256 + wc * 32 + 8 * fq;
#pragma unroll
        for (int ai = 0; ai < 2; ++ai)
#pragma unroll
            for (int m = 0; m < 4; ++m) { bf16_t* rowp = base + (size_t)(row0 + ai * HALF + m * 16) * D;
#pragma unroll
                for (int bj = 0; bj < 2; ++bj) *(u32x4*)(rowp + bj * HALF) = pack8(sigm4(acc[ai][bj][m][0] * rs[ai][m]), sigm4(acc[ai][bj][m][1] * rs[ai][m])); }
    }
};
struct EpiMerge {
    typedef PreNone Pre;
    DEV void prefetch(PreNone&, const Unit&, int, int) const {}
    static constexpr bool PERM = true, AFTER_DRAIN = false;
    bf16_t* M; const bf16_t* G;
    DEV void operator()(const Acc& acc, const Unit& u, int wr, int wc, int fr, int fq, const PreNone&) const {
        EPI_ROWS(u); const size_t cofs = (size_t)u.pn * 256 + wc * 32 + 8 * fq; const bf16_t* gb = G + (size_t)u.job * T * D;
#pragma unroll
        for (int ai = 0; ai < 2; ++ai) {
            u32x4 g[8], p[8];
#pragma unroll
            for (int m = 0; m < 4; ++m)
#pragma unroll
                for (int bj = 0; bj < 2; ++bj) { const size_t o = (size_t)(row0 + ai * HALF + m * 16) * D + cofs + bj * HALF; g[2 * m + bj] = *(const u32x4*)(gb + o);
                    if (u.job > 0) p[2 * m + bj] = __builtin_nontemporal_load((const u32x4*)(M + o)); }
#pragma unroll
            for (int m = 0; m < 4; ++m)
#pragma unroll
                for (int bj = 0; bj < 2; ++bj) { const size_t o = (size_t)(row0 + ai * HALF + m * 16) * D + cofs + bj * HALF; const u32x4 gg = g[2 * m + bj];
                    f32x4 v0 = acc[ai][bj][m][0], v1 = acc[ai][bj][m][1];
                    v0[0] *= bflo(gg.x); v0[1] *= bfhi(gg.x); v0[2] *= bflo(gg.y); v0[3] *= bfhi(gg.y); v1[0] *= bflo(gg.z); v1[1] *= bfhi(gg.z); v1[2] *= bflo(gg.w); v1[3] *= bfhi(gg.w);
                    if (u.job > 0) { const u32x4 pp = p[2 * m + bj];
                        v0[0] += bflo(pp.x); v0[1] += bfhi(pp.x); v0[2] += bflo(pp.y); v0[3] += bfhi(pp.y); v1[0] += bflo(pp.z); v1[1] += bfhi(pp.z); v1[2] += bflo(pp.w); v1[3] += bfhi(pp.w); }
                    *(u32x4*)(M + o) = pack8(v0, v1); }
        }
    }
};
struct EpiMergeC {
    typedef PreNone Pre;
    DEV void prefetch(PreNone&, const Unit&, int, int) const {}
    static constexpr bool PERM = true, AFTER_DRAIN = false, CHAIN = true;
    bf16_t* M; const bf16_t* G;
    static DEV float gl(unsigned w) { return fmaxf(bflo(w), 9.094947e-13f); }
    static DEV float gh(unsigned w) { return fmaxf(bfhi(w), 9.094947e-13f); }
    DEV void operator()(Acc& acc, const Unit& u, int wr, int wc, int fr, int fq, const PreNone&) const {
        EPI_ROWS(u); const size_t cofs = (size_t)u.pn * 256 + wc * 32 + 8 * fq; const bf16_t* gb = G + (size_t)u.job * T * D; const bool lastj = u.job == 2;
#pragma unroll
        for (int ai = 0; ai < 2; ++ai) {
            u32x4 g[8], gn[8];
#pragma unroll
            for (int m = 0; m < 4; ++m)
#pragma unroll
                for (int bj = 0; bj < 2; ++bj) { const size_t o = (size_t)(row0 + ai * HALF + m * 16) * D + cofs + bj * HALF; g[2 * m + bj] = *(const u32x4*)(gb + o);
                    if (!lastj) gn[2 * m + bj] = *(const u32x4*)(gb + (size_t)T * D + o); }
#pragma unroll
            for (int m = 0; m < 4; ++m)
#pragma unroll
                for (int bj = 0; bj < 2; ++bj) { const u32x4 a = g[2 * m + bj]; f32x4 s0 = {gl(a.x), gh(a.x), gl(a.y), gh(a.y)}, s1 = {gl(a.z), gh(a.z), gl(a.w), gh(a.w)};
                    if (!lastj) { const u32x4 b = gn[2 * m + bj];
                        s0[0] *= __builtin_amdgcn_rcpf(gl(b.x)); s0[1] *= __builtin_amdgcn_rcpf(gh(b.x)); s0[2] *= __builtin_amdgcn_rcpf(gl(b.y)); s0[3] *= __builtin_amdgcn_rcpf(gh(b.y));
                        s1[0] *= __builtin_amdgcn_rcpf(gl(b.z)); s1[1] *= __builtin_amdgcn_rcpf(gh(b.z)); s1[2] *= __builtin_amdgcn_rcpf(gl(b.w)); s1[3] *= __builtin_amdgcn_rcpf(gh(b.w)); }
                    acc[ai][bj][m][0] = acc[ai][bj][m][0] * s0; acc[ai][bj][m][1] = acc[ai][bj][m][1] * s1;
                    if (lastj) { const size_t o = (size_t)(row0 + ai * HALF + m * 16) * D + cofs + bj * HALF; *(u32x4*)(M + o) = pack8(acc[ai][bj][m][0], acc[ai][bj][m][1]); } }
        }
    }
};
template <bool IN_F32> struct EpiResid {
    typedef PreNone Pre;
    DEV void prefetch(PreNone&, const Unit&, int, int) const {}
    static constexpr bool PERM = true, AFTER_DRAIN = false;
    const void* xin; bf16_t* xb; u64* ss;
    DEV void operator()(const Acc& acc, const Unit& u, int wr, int wc, int fr, int fq, const PreNone&) const {
        EPI_ROWS(u); const size_t cofs = (size_t)u.pn * 256 + wc * 32 + 8 * fq;
#pragma unroll
        for (int ai = 0; ai < 2; ++ai) {
            f32x4 r0[8], r1[8];
#pragma unroll
            for (int m = 0; m < 4; ++m)
#pragma unroll
                for (int bj = 0; bj < 2; ++bj) { const size_t o = (size_t)(row0 + ai * HALF + m * 16) * D + cofs + bj * HALF; const int k = 2 * m + bj;
                    if (IN_F32) { r0[k] = *(const f32x4*)((const float*)xin + o); r1[k] = *(const f32x4*)((const float*)xin + o + 4); }
                    else { const u32x4 p = *(const u32x4*)((const bf16_t*)xin + o); r0[k] = __builtin_bit_cast(f32x4, p); } }
#pragma unroll
            for (int m = 0; m < 4; ++m) { const size_t ro = (size_t)(row0 + ai * HALF + m * 16) * D + cofs; float sq = 0.f;
#pragma unroll
                for (int bj = 0; bj < 2; ++bj) { const size_t o = ro + bj * HALF; const int k = 2 * m + bj; f32x4 v0 = acc[ai][bj][m][0], v1 = acc[ai][bj][m][1];
                    if (IN_F32) { v0 = v0 + r0[k]; v1 = v1 + r1[k]; }
                    else { const u32x4 p = __builtin_bit_cast(u32x4, r0[k]);
                        v0[0] += bflo(p.x); v0[1] += bfhi(p.x); v0[2] += bflo(p.y); v0[3] += bfhi(p.y); v1[0] += bflo(p.z); v1[1] += bfhi(p.z); v1[2] += bflo(p.w); v1[3] += bfhi(p.w); }
                    *(u32x4*)(xb + o) = pack8(v0, v1);
                    sq += ((v0[0] * v0[0] + v0[1] * v0[1]) + (v0[2] * v0[2] + v0[3] * v0[3])) + ((v1[0] * v1[0] + v1[1] * v1[1]) + (v1[2] * v1[2] + v1[3] * v1[3])); }
                sq += __shfl_xor(sq, 16); sq += __shfl_xor(sq, 32);
                if (fq == 0) atomicAdd(ss + row0 + ai * HALF + m * 16, (u64)(sq * SS_SCALE + 0.5f)); }
        }
    }
};
DEV float gelu_t(float a) { return a * __builtin_amdgcn_rcpf(1.f + __builtin_amdgcn_exp2f(-1.5957691216057308f * LOG2E * (a + 0.044715f * a * a * a))); }
DEV float row_prev1(float cur, float prevm) { const int r = __builtin_amdgcn_update_dpp(0, (int)__float_as_uint(prevm), 0x121, 0xf, 0xf, false);
    return __uint_as_float((unsigned)__builtin_amdgcn_update_dpp(r, (int)__float_as_uint(cur), 0x111, 0xf, 0xf, false)); }
DEV float row_prev2(float cur, float prevm) { const int r = __builtin_amdgcn_update_dpp(0, (int)__float_as_uint(prevm), 0x122, 0xf, 0xf, false);
    return __uint_as_float((unsigned)__builtin_amdgcn_update_dpp(r, (int)__float_as_uint(cur), 0x112, 0xf, 0xf, false)); }
struct EpiUpF {
    typedef PreRs Pre;
    DEV void prefetch(PreRs& p, const Unit& u, int wr, int fr) const { pre_rs(p, ss, u.pm * BM + wr * 64 + fr); }
    static constexpr bool PERM = true, AFTER_DRAIN = false;
    bf16_t *fu, *sa, *su; const u64* ss; const float *cw, *cb;
    DEV void operator()(const Acc& acc, const Unit& u, int wr, int wc, int fr, int fq, const PreRs& pre) const {
        EPI_ROWS(u); float rs[2][4]; rs_of(rs, pre); const size_t cofs = (size_t)u.pn * 128 + wc * 32 + 8 * fq;
        f32x4 w0[2], w1[2], w2[2], bb[2];
#pragma unroll
        for (int n = 0; n < 2; ++n) { w0[n] = *(const f32x4*)(cw + cofs + 4 * n); w1[n] = *(const f32x4*)(cw + DFF + cofs + 4 * n); w2[n] = *(const f32x4*)(cw + 2 * DFF + cofs + 4 * n); bb[n] = *(const f32x4*)(cb + cofs + 4 * n); }
#pragma unroll
        for (int ai = 0; ai < 2; ++ai) {
            const size_t strip = (size_t)u.pm * 4 + ai * 2 + wr;
            f32x4 ap[2] = {{0.f, 0.f, 0.f, 0.f}, {0.f, 0.f, 0.f, 0.f}};
#pragma unroll
            for (int m = 0; m < 4; ++m) {
                f32x4 a[2], g[2];
#pragma unroll
                for (int n = 0; n < 2; ++n) { a[n] = acc[ai][0][m][n] * rs[ai][m];
#pragma unroll
                    for (int e = 0; e < 4; ++e) { const float a1 = row_prev1(a[n][e], ap[n][e]), a2 = row_prev2(a[n][e], ap[n][e]);
                        g[n][e] = gelu_t(bb[n][e] + w0[n][e] * a2 + w1[n][e] * a1 + w2[n][e] * a[n][e]) * (acc[ai][1][m][n][e] * rs[ai][m]); } }
                if (m == 0) {
                    if (fr < 2) { *(u32x4*)(sa + (strip * 4 + fr) * DFF + cofs) = pack8(a[0], a[1]); *(u32x4*)(su + (strip * 2 + fr) * DFF + cofs) = pack8(acc[ai][1][0][0] * rs[ai][0], acc[ai][1][0][1] * rs[ai][0]); }
                    else *(u32x4*)(fu + (size_t)(row0 + ai * HALF) * DFF + cofs) = pack8(g[0], g[1]);
                } else {
                    *(u32x4*)(fu + (size_t)(row0 + ai * HALF + m * 16) * DFF + cofs) = pack8(g[0], g[1]);
                    if (m == 3 && fr >= 14) *(u32x4*)(sa + (strip * 4 + 2 + (fr - 14)) * DFF + cofs) = pack8(a[0], a[1]);
                }
                ap[0] = a[0]; ap[1] = a[1];
            }
        }
    }
};
struct EpiPrep {
    typedef PreNone Pre;
    DEV void prefetch(PreNone&, const Unit&, int, int) const {}
    static constexpr bool PERM = true, AFTER_DRAIN = false;
    unsigned char* ws; int mode;
    DEV void operator()(const Acc& acc, const Unit& u, int wr, int wc, int fr, int fq, const PreNone&) const {
        EPI_ROWS(u); bf16_t* base; int ldc; float sc = 1.f;
        if (mode == 0) { base = (bf16_t*)(ws + WS_KVM + (size_t)u.job * 2 * MiB); ldc = 2 * D; }
        else if (mode == 1) { base = (bf16_t*)(ws + WS_GT + (size_t)(u.job >> 2) * 2 * MiB) + (size_t)(u.job & 3) * 256 * D; ldc = D; sc = XSCALE; }
        else { base = (bf16_t*)(ws + WS_HT + (size_t)(u.job >> 2) * 2 * MiB) + (u.job & 3) * 256; ldc = D; }
        base += (size_t)u.pn * 256 + wc * 32 + 8 * fq;
#pragma unroll
        for (int ai = 0; ai < 2; ++ai)
#pragma unroll
            for (int m = 0; m < 4; ++m) { bf16_t* rowp = base + (size_t)(row0 + ai * HALF + m * 16) * ldc;
#pragma unroll
                for (int bj = 0; bj < 2; ++bj) *(u32x4*)(rowp + bj * HALF) = pack8(acc[ai][bj][m][0] * sc, acc[ai][bj][m][1] * sc); }
    }
};
struct EpiSoftmax {
    typedef PreRs Pre;
    DEV void prefetch(PreRs& p, const Unit& u, int wr, int fr) const { pre_rs(p, ss, u.pm * BM + wr * 64 + fr); }
    static constexpr bool PERM = true, AFTER_DRAIN = true;
    bf16_t* P; const u64* ss;
    DEV void fused(Acc& acc, const Unit& u, int wr, int wc, int fr, int fq, LAS unsigned char* lds, int wid, int lane, const PreRs& pre) const {
        LAS float* PM = (LAS float*)lds; LAS float* PS = (LAS float*)(lds + 4096);
        { const int row0_ = u.pm * BM + wr * 64 + fr; float rs[2][4]; rs_of(rs, pre);
#pragma unroll
          for (int ai = 0; ai < 2; ++ai)
#pragma unroll
              for (int m = 0; m < 4; ++m)
#pragma unroll
                  for (int bj = 0; bj < 2; ++bj)
#pragma unroll
                      for (int n = 0; n < 2; ++n) acc[ai][bj][m][n] = acc[ai][bj][m][n] * rs[ai][m]; }
#pragma unroll
        for (int ai = 0; ai < 2; ++ai)
#pragma unroll
            for (int m = 0; m < 4; ++m) { float mx = -INFINITY;
#pragma unroll
                for (int bj = 0; bj < 2; ++bj)
#pragma unroll
                    for (int n = 0; n < 2; ++n) { const f32x4 x = acc[ai][bj][m][n]; mx = fmaxf(mx, fmaxf(fmaxf(x[0], x[1]), fmaxf(x[2], x[3]))); }
                mx = fmaxf(mx, __shfl_xor(mx, 16)); mx = fmaxf(mx, __shfl_xor(mx, 32));
                if (fq == 0) PM[(ai * HALF + wr * 64 + m * 16 + fr) * 4 + wc] = mx; }
        LDS_WAIT(); __builtin_amdgcn_s_barrier(); asm volatile("" ::: "memory");
#pragma unroll
        for (int ai = 0; ai < 2; ++ai)
#pragma unroll
            for (int m = 0; m < 4; ++m) { const int r = ai * HALF + wr * 64 + m * 16 + fr; const f32x4 q = *(const LAS f32x4*)(PM + r * 4);
                const float mx = fmaxf(fmaxf(q[0], q[1]), fmaxf(q[2], q[3])); float s = 0.f;
#pragma unroll
                for (int bj = 0; bj < 2; ++bj)
#pragma unroll
                    for (int n = 0; n < 2; ++n) { f32x4 x = acc[ai][bj][m][n];
#pragma unroll
                        for (int i = 0; i < 4; ++i) { x[i] = __builtin_amdgcn_exp2f(x[i] - mx); s += x[i]; } acc[ai][bj][m][n] = x; }
                s += __shfl_xor(s, 16); s += __shfl_xor(s, 32);
                if (fq == 0) PS[r * 4 + wc] = s; }
        LDS_WAIT(); __builtin_amdgcn_s_barrier(); asm volatile("" ::: "memory");
        EPI_ROWS(u); bf16_t* base = P + (size_t)u.pn * 256 + wc * 32 + 8 * fq;
#pragma unroll
        for (int ai = 0; ai < 2; ++ai)
#pragma unroll
            for (int m = 0; m < 4; ++m) { const int r = ai * HALF + wr * 64 + m * 16 + fr; const f32x4 q = *(const LAS f32x4*)(PS + r * 4);
                const float inv = 1.f / ((q[0] + q[1]) + (q[2] + q[3])); bf16_t* rowp = base + (size_t)(row0 + ai * HALF + m * 16) * D;
#pragma unroll
                for (int bj = 0; bj < 2; ++bj) *(u32x4*)(rowp + bj * HALF) = pack8(acc[ai][bj][m][0] * inv, acc[ai][bj][m][1] * inv); }
        LDS_WAIT(); __builtin_amdgcn_s_barrier();
    }
};
}

typedef GAS unsigned gu32;
#define XB_TMO      128
#define XB_XCNT(j)  (256  + 64 * (j))
#define XB_XSUB(j)  (1280 + 64 * (j))
#define XB_XGEN(j)  (2304 + 64 * (j))
#define XB_TOP      3328
#define XB_TOPGEN   3392
#define XCD_BAR_WORDS 3456
#define XB_SPIN_CAP (1u << 22)
DEV unsigned xb_ld(unsigned* p) { return __hip_atomic_load(p, __ATOMIC_RELAXED, __HIP_MEMORY_SCOPE_AGENT); }
DEV unsigned xb_add(unsigned* p, unsigned v) { return __hip_atomic_fetch_add(p, v, __ATOMIC_RELAXED, __HIP_MEMORY_SCOPE_AGENT); }
DEV unsigned xb_xcc_id() { return (unsigned)__builtin_amdgcn_s_getreg((3 << 11) | 20) & 0xFu; }
#define XB_SPIN(cond, bar) do { unsigned _sp = 0; while (cond) { __builtin_amdgcn_s_sleep(1); \
    if ((++_sp & 255u) == 0u) { if (xb_ld(&(bar)[XB_TMO])) break; if (_sp > XB_SPIN_CAP) { atomicAdd(&(bar)[XB_TMO], 1u); break; } } } } while (0)
struct XcdBarrier { unsigned* bar; unsigned x; volatile LAS unsigned* st; };
DEV XcdBarrier xcd_barrier_post(unsigned* bar, volatile LAS unsigned* st, int tid) {
    XcdBarrier b; b.bar = bar; b.x = xb_xcc_id(); b.st = st;
    if (tid == 0) (void)xb_add(&bar[XB_XCNT(b.x)], 1u);
    return b;
}
DEV void xcd_barrier_complete(unsigned* bar, unsigned x, unsigned& nloc, unsigned& nx) {
    const unsigned G = gridDim.x * gridDim.y * gridDim.z;
    unsigned sum, cnt, mine, sp = 0u;
    for (;;) {
        sum = 0u; cnt = 0u; mine = 0u;
#pragma unroll
        for (unsigned j = 0; j < 16; ++j) { const unsigned c = xb_ld(&bar[XB_XCNT(j)]); sum += c; cnt += (c > 0u) ? 1u : 0u; mine = (j == x) ? c : mine; }
        if (sum == G) break;
        __builtin_amdgcn_s_sleep(1);
        if ((++sp & 255u) == 0u) { if (xb_ld(&bar[XB_TMO])) break; if (sp > XB_SPIN_CAP) { atomicAdd(&bar[XB_TMO], 1u); break; } }
    }
    nloc = mine > 0u ? mine : 1u; nx = cnt > 0u ? cnt : 1u;
}
DEV void xcd_barrier(const XcdBarrier& b, int tid) {
    asm volatile("s_waitcnt vmcnt(0)" ::: "memory");
    __syncthreads();
    if (tid == 0) {
        unsigned* bar = b.bar;
        __builtin_amdgcn_s_waitcnt(0);
        unsigned nloc = b.st[0], nx = b.st[1];
        if (nloc == 0u) { xcd_barrier_complete(bar, b.x, nloc, nx); b.st[0] = nloc; b.st[1] = nx; }
        const unsigned old = xb_add(&bar[XB_XSUB(b.x)], 1u);
        const unsigned gen = old / nloc;
        if (old + 1u == (gen + 1u) * nloc) {
            __builtin_amdgcn_fence(__ATOMIC_RELEASE, "agent");
            asm volatile("s_waitcnt vmcnt(0)" ::: "memory");
            const unsigned og = xb_add(&bar[XB_TOP], 1u);
            const unsigned tg = og / nx;
            if (og + 1u == (tg + 1u) * nx) xb_add(&bar[XB_TOPGEN], 1u);
            else XB_SPIN(xb_ld(&bar[XB_TOPGEN]) == tg, bar);
            __builtin_amdgcn_fence(__ATOMIC_ACQUIRE, "agent");
            xb_add(&bar[XB_XGEN(b.x)], 1u);
            asm volatile("s_waitcnt vmcnt(0)" ::: "memory");
        } else {
            XB_SPIN(xb_ld(&bar[XB_XGEN(b.x)]) == gen, bar);
            __builtin_amdgcn_fence(__ATOMIC_ACQUIRE, "agent");
            asm volatile("s_waitcnt vmcnt(0)" ::: "memory");
        }
    }
    __syncthreads();
}


using pg8::gelu_t;
struct WaveId { int gw, ngw, wave, lane; };
DEV unsigned f2bf_u(float f) { return (unsigned)f2bf(f); }
DEV unsigned pk2(float lo, float hi) { return cvt_pk_bf16(lo, hi); }

DEV void norm_rows(const WaveId& W, const float* x, const float* g, bf16_t* outb, float* outf, int rows) {
    for (int row = W.gw; row < rows; row += W.ngw) {
        const f32x4* xr = (const f32x4*)(x + (size_t)row * D) + W.lane;
        f32x4 v[4]; float s = 0.f;
#pragma unroll
        for (int j = 0; j < 4; ++j) { v[j] = xr[64 * j]; s += (v[j].x * v[j].x + v[j].y * v[j].y) + (v[j].z * v[j].z + v[j].w * v[j].w); }
        const float r = rsqrtf(wave_sum(s) * (1.f / D) + EPS);
#pragma unroll
        for (int j = 0; j < 4; ++j) {
            const f32x4 gg = ((const f32x4*)g)[W.lane + 64 * j];
            const f32x4 o = {v[j].x * r * gg.x, v[j].y * r * gg.y, v[j].z * r * gg.z, v[j].w * r * gg.w};
            if (outb) { u32x2 w; w.x = pk2(o.x, o.y); w.y = pk2(o.z, o.w); ((u32x2*)(outb + (size_t)row * D))[W.lane + 64 * j] = w; }
            else ((f32x4*)(outf + (size_t)row * D))[W.lane + 64 * j] = o;
        }
    }
}
DEV void cvt_piece(const WaveId& W, LAS float* scr, int& base, const float* Wsrc, int ldw, int K, int col0, int ncols, bf16_t* dst, int ldo, int row0, const float* gain = nullptr) {
    const int nblk = ncols / 32, nitems = (K / 64) * nblk;
    int first = (W.gw - base) % W.ngw; if (first < 0) first += W.ngw;
    base = (base + nitems) % W.ngw;
    for (int item = first; item < nitems; item += W.ngw) {
        const int kb = item / nblk, nb = item - kb * nblk, k0 = 64 * kb, n0 = 32 * nb;
        { const int lr = W.lane >> 3, lc = (W.lane & 7) * 4;
          f32x4 v[8]; float g[8];
#pragma unroll
          for (int i = 0; i < 8; ++i) { v[i] = *(const f32x4*)(Wsrc + (size_t)(k0 + lr + 8 * i) * ldw + col0 + n0 + lc); g[i] = gain ? gain[k0 + lr + 8 * i] : 1.f; }
#pragma unroll
          for (int i = 0; i < 8; ++i) { LAS float* d = scr + (lr + 8 * i) * 33 + lc; d[0] = v[i][0] * g[i]; d[1] = v[i][1] * g[i]; d[2] = v[i][2] * g[i]; d[3] = v[i][3] * g[i]; } }
        LDS_WAIT(); asm volatile("" ::: "memory");
        const int c = W.lane & 7;
#pragma unroll
        for (int j = 0; j < 4; ++j) { const int n = (W.lane >> 3) + 8 * j; const LAS float* s = scr + (8 * c) * 33 + n;
            u32x4 o; o.x = pk2(s[0 * 33], s[1 * 33]); o.y = pk2(s[2 * 33], s[3 * 33]); o.z = pk2(s[4 * 33], s[5 * 33]); o.w = pk2(s[6 * 33], s[7 * 33]);
            *(u32x4*)(dst + (size_t)(row0 + n0 + n) * ldo + k0 + 8 * c) = o; }
        LDS_WAIT(); asm volatile("" ::: "memory");
    }
}
DEV void convert_layer_weights(const WaveId& W, LAS float* scr, int& base, unsigned char* ws, const float* const* in, int l, int part = 3) {
    const float* wi = in[3] + (size_t)l * D * DIN;
    if (part & 1) {
    bf16_t* WIN = (bf16_t*)(ws + WS_WIN); const float* gm = in[2] + l * D;
    cvt_piece(W, scr, base, wi, DIN, D, 0, 1536, WIN, D, 0, gm);
    cvt_piece(W, scr, base, wi, DIN, D, 3072, 1536, WIN, D, 1536, gm);
    cvt_piece(W, scr, base, wi, DIN, D, 4608, 512, WIN, D, 3072, gm);
    cvt_piece(W, scr, base, wi, DIN, D, 1536, 512, WIN, D, 3584, gm);
#pragma unroll 1
    for (int j = 0; j < 4; ++j) { cvt_piece(W, scr, base, wi, DIN, D, 2048 + 128 * j, 128, WIN, D, 4096 + 256 * j, gm); cvt_piece(W, scr, base, wi, DIN, D, 2560 + 128 * j, 128, WIN, D, 4096 + 256 * j + 128, gm); }
    cvt_piece(W, scr, base, wi, DIN, D, 5120, 96, WIN, D, 5120, gm);
    cvt_piece(W, scr, base, wi, DIN, D, 5192, 3072, (bf16_t*)(ws + WS_WG), D, 0, gm);
#pragma unroll 1
    for (int i = 0; i < 3; ++i) cvt_piece(W, scr, base, in[5 + i] + (size_t)l * 512 * D, D, 512, 0, D, (bf16_t*)(ws + WS_WBR) + (size_t)i * D * 512, 512, 0);
    cvt_piece(W, scr, base, in[8] + (size_t)l * D * D, D, D, 0, D, (bf16_t*)(ws + WS_WMIX), D, 0);
    }
    if (!(part & 2)) return;
    const float* gf = in[14] + l * D;
    const float* wf = in[15] + (size_t)l * D * 2 * DFF;
#pragma unroll 1
    for (int j = 0; j < 22; ++j) { cvt_piece(W, scr, base, wf, 2 * DFF, D, 128 * j, 128, (bf16_t*)(ws + WS_WUP), D, 256 * j, gf); cvt_piece(W, scr, base, wf, 2 * DFF, D, DFF + 128 * j, 128, (bf16_t*)(ws + WS_WUP), D, 256 * j + 128, gf); }
    cvt_piece(W, scr, base, in[18] + (size_t)l * DFF * D, D, DFF, 0, D, (bf16_t*)(ws + WS_WDOWN), DFF, 0);
}
DEV void prep0_phase(const WaveId& W, LAS float* scr, unsigned char* ws, const float* const* in, bf16_t* XB) {
    int base = 0;
#pragma unroll 1
    for (int l = 0; l < DEPTH; ++l) {
        const float* wq = in[11] + (size_t)l * D * D; bf16_t* WQ = (bf16_t*)(ws + WS_WQ + (size_t)l * 2 * MiB); const float* gx = in[9] + l * D;
        for (size_t i = (size_t)(W.gw * 64 + W.lane) * 4; i < (size_t)D * D; i += (size_t)W.ngw * 256) { const float g = gx[i >> 10]; const f32x4 v = *(const f32x4*)(wq + i); u32x2 o; o.x = pk2(v.x * g, v.y * g); o.y = pk2(v.z * g, v.w * g); *(u32x2*)(WQ + i) = o; }
        cvt_piece(W, scr, base, in[13] + (size_t)l * D * D, D, D, 0, D, (bf16_t*)(ws + WS_WOT + (size_t)l * 2 * MiB), D, 0);
        cvt_piece(W, scr, base, in[12] + (size_t)l * D * 2 * D, 2 * D, D, 0, 2 * D, (bf16_t*)(ws + WS_WKVT + (size_t)l * 4 * MiB), D, 0);
        norm_rows(W, in[1], in[10] + l * D, (bf16_t*)(ws + WS_MEMN + (size_t)l * MiB), nullptr, NB * MEM);
    }
    convert_layer_weights(W, scr, base, ws, in, 0);
    pg8::u64* ss0 = (pg8::u64*)(ws + WS_SS);
    for (int row0 = W.gw; row0 < T; row0 += 4 * W.ngw) {
        f32x4 v[4][4];
#pragma unroll
        for (int u = 0; u < 4; ++u) { const f32x4* xr = (const f32x4*)(in[0] + (size_t)(row0 + u * W.ngw) * D) + W.lane;
#pragma unroll
            for (int j = 0; j < 4; ++j) v[u][j] = xr[64 * j]; }
#pragma unroll
        for (int u = 0; u < 4; ++u) { const int row = row0 + u * W.ngw; float s = 0.f;
#pragma unroll
            for (int j = 0; j < 4; ++j) { const f32x4 x = v[u][j]; s += (x.x * x.x + x.y * x.y) + (x.z * x.z + x.w * x.w);
                u32x2 w; w.x = pk2(x.x, x.y); w.y = pk2(x.z, x.w); ((u32x2*)(XB + (size_t)row * D))[W.lane + 64 * j] = w; }
            s = wave_sum(s); if (W.lane == 0) ss0[row] = (pg8::u64)(s * pg8::SS_SCALE + 0.5f); }
    }
}
DEV void final_norm(const WaveId& W, const bf16_t* x, float* out, const float* g, const pg8::u64* ss) {
    f32x4 gg[4];
#pragma unroll
    for (int j = 0; j < 4; ++j) gg[j] = ((const f32x4*)g)[W.lane + 64 * j];
    for (int row0 = W.gw; row0 < T; row0 += 4 * W.ngw) {
        u32x2 v[4][4]; pg8::u64 sq[4];
#pragma unroll
        for (int u = 0; u < 4; ++u) { const int row = row0 + u * W.ngw; sq[u] = ss[row]; const u32x2* xr = (const u32x2*)(x + (size_t)row * D) + W.lane;
#pragma unroll
            for (int j = 0; j < 4; ++j) v[u][j] = xr[64 * j]; }
#pragma unroll
        for (int u = 0; u < 4; ++u) { const int row = row0 + u * W.ngw; const float r = rsqrtf((float)sq[u] * (1.f / (pg8::SS_SCALE * D)) + EPS); f32x4* orow = (f32x4*)(out + (size_t)row * D) + W.lane;
#pragma unroll
            for (int j = 0; j < 4; ++j) { const u32x2 w = v[u][j];
                const f32x4 o = {bflo(w.x) * r * gg[j].x, bfhi(w.x) * r * gg[j].y, bflo(w.y) * r * gg[j].z, bfhi(w.y) * r * gg[j].w}; orow[64 * j] = o; } }
    }
}
DEV void conv_sc_phase(int gtid, int gthreads, bf16_t* scb, const bf16_t* cx, const float* w, bool dry) {
    const int c8 = (gtid & 63) * 8;
    const f32x4 w0a = *(const f32x4*)(w + c8), w0b = *(const f32x4*)(w + c8 + 4), w1a = *(const f32x4*)(w + 512 + c8), w1b = *(const f32x4*)(w + 512 + c8 + 4), w2a = *(const f32x4*)(w + 1024 + c8), w2b = *(const f32x4*)(w + 1024 + c8 + 4);
    const u32x4 z = {0u, 0u, 0u, 0u};
    for (int i0 = gtid; i0 < T * 64; i0 += 4 * gthreads) {
        u32x4 x2[4], x1[4], x0[4], bb[4];
#pragma unroll
        for (int u = 0; u < 4; ++u) { const int i = i0 + u * gthreads; if (i < T * 64) { const int t = i >> 6, tl = t & (S - 1); const size_t o = (size_t)t * 512 + c8;
            x2[u] = *(const u32x4*)(cx + o); x1[u] = tl >= 1 ? *(const u32x4*)(cx + o - 512) : z; x0[u] = tl >= 2 ? *(const u32x4*)(cx + o - 1024) : z; bb[u] = *(const u32x4*)(scb + o); } }
#pragma unroll
        for (int u = 0; u < 4; ++u) { const int i = i0 + u * gthreads; if (i < T * 64) { const size_t o = (size_t)(i >> 6) * 512 + c8;
            float r[8];
#define CONV1(k, W0, W1, W2, X0, X1, X2, BBv, F) r[k] = F(BBv) * (W0 * F(X0) + W1 * F(X1) + W2 * F(X2))
            CONV1(0, w0a.x, w1a.x, w2a.x, x0[u].x, x1[u].x, x2[u].x, bb[u].x, bflo); CONV1(1, w0a.y, w1a.y, w2a.y, x0[u].x, x1[u].x, x2[u].x, bb[u].x, bfhi);
            CONV1(2, w0a.z, w1a.z, w2a.z, x0[u].y, x1[u].y, x2[u].y, bb[u].y, bflo); CONV1(3, w0a.w, w1a.w, w2a.w, x0[u].y, x1[u].y, x2[u].y, bb[u].y, bfhi);
            CONV1(4, w0b.x, w1b.x, w2b.x, x0[u].z, x1[u].z, x2[u].z, bb[u].z, bflo); CONV1(5, w0b.y, w1b.y, w2b.y, x0[u].z, x1[u].z, x2[u].z, bb[u].z, bfhi);
            CONV1(6, w0b.z, w1b.z, w2b.z, x0[u].w, x1[u].w, x2[u].w, bb[u].w, bflo); CONV1(7, w0b.w, w1b.w, w2b.w, x0[u].w, x1[u].w, x2[u].w, bb[u].w, bfhi);
#undef CONV1
            u32x4 ov; ov.x = pk2(r[0], r[1]); ov.y = pk2(r[2], r[3]); ov.z = pk2(r[4], r[5]); ov.w = pk2(r[6], r[7]);
            if (!dry) *(u32x4*)(scb + o) = ov; else asm volatile("" :: "v"(ov)); } }
    }
}
DEV void ffn_fix_phase(int gtid, int gthreads, const bf16_t* sa, const bf16_t* su, bf16_t* fu, const float* cw, const float* cb, int strip0 = 0, int nstrip = T / 64) {
    constexpr int C8 = DFF / 8; const u32x4 z = {0u, 0u, 0u, 0u};
    for (int i0 = gtid; i0 < nstrip * 2 * C8; i0 += 3 * gthreads) {
        u32x4 x2[3], x1[3], x0[3], uu[3];
#pragma unroll
        for (int q = 0; q < 3; ++q) { const int i = i0 + q * gthreads; if (i < nstrip * 2 * C8) {
            const int sr = i / C8, c8 = (i - sr * C8) * 8, strip = strip0 + (sr >> 1), rr = sr & 1;
            const bool first = (strip & (S / 64 - 1)) == 0;
            const bf16_t* A = sa + (size_t)strip * 4 * DFF + c8; const bf16_t* Ap = A - 4 * DFF;
            x2[q] = *(const u32x4*)(A + rr * DFF);
            x1[q] = rr == 1 ? *(const u32x4*)A : (first ? z : *(const u32x4*)(Ap + 3 * DFF));
            x0[q] = first ? z : *(const u32x4*)(Ap + (2 + rr) * DFF);
            uu[q] = *(const u32x4*)(su + ((size_t)strip * 2 + rr) * DFF + c8); } }
#pragma unroll
        for (int q = 0; q < 3; ++q) { const int i = i0 + q * gthreads; if (i < nstrip * 2 * C8) {
            const int sr = i / C8, c8 = (i - sr * C8) * 8, strip = strip0 + (sr >> 1), rr = sr & 1, t = strip * 64 + rr;
            const f32x4 w0a = *(const f32x4*)(cw + c8), w0b = *(const f32x4*)(cw + c8 + 4), w1a = *(const f32x4*)(cw + DFF + c8), w1b = *(const f32x4*)(cw + DFF + c8 + 4), w2a = *(const f32x4*)(cw + 2 * DFF + c8), w2b = *(const f32x4*)(cw + 2 * DFF + c8 + 4);
            const f32x4 ba = *(const f32x4*)(cb + c8), bb = *(const f32x4*)(cb + c8 + 4);
            float r[8];
#define FM1(k, B0, W0, W1, W2, X0, X1, X2, Uv, F) r[k] = gelu_t(B0 + W0 * F(X0) + W1 * F(X1) + W2 * F(X2)) * F(Uv)
            FM1(0, ba.x, w0a.x, w1a.x, w2a.x, x0[q].x, x1[q].x, x2[q].x, uu[q].x, bflo); FM1(1, ba.y, w0a.y, w1a.y, w2a.y, x0[q].x, x1[q].x, x2[q].x, uu[q].x, bfhi);
            FM1(2, ba.z, w0a.z, w1a.z, w2a.z, x0[q].y, x1[q].y, x2[q].y, uu[q].y, bflo); FM1(3, ba.w, w0a.w, w1a.w, w2a.w, x0[q].y, x1[q].y, x2[q].y, uu[q].y, bfhi);
            FM1(4, bb.x, w0b.x, w1b.x, w2b.x, x0[q].z, x1[q].z, x2[q].z, uu[q].z, bflo); FM1(5, bb.y, w0b.y, w1b.y, w2b.y, x0[q].z, x1[q].z, x2[q].z, uu[q].z, bfhi);
            FM1(6, bb.z, w0b.z, w1b.z, w2b.z, x0[q].w, x1[q].w, x2[q].w, uu[q].w, bflo); FM1(7, bb.w, w0b.w, w1b.w, w2b.w, x0[q].w, x1[q].w, x2[q].w, uu[q].w, bfhi);
#undef FM1
            u32x4 ov; ov.x = pk2(r[0], r[1]); ov.y = pk2(r[2], r[3]); ov.z = pk2(r[4], r[5]); ov.w = pk2(r[6], r[7]);
            *(u32x4*)(fu + (size_t)t * DFF + c8) = ov; } }
    }
}

typedef short s16x4 __attribute__((ext_vector_type(4)));
DEV s16x4 vtr(const LAS unsigned char* p) { return __builtin_bit_cast(s16x4, __builtin_amdgcn_ds_read_tr16_b64_v4i16((LAS s16x4*)p)); }
DEV bf16x8 cat8(const s16x4 a, const s16x4 b) { return (bf16x8){a[0], a[1], a[2], a[3], b[0], b[1], b[2], b[3]}; }
DEV bf16x8 pk8(float a0, float a1, float a2, float a3, float a4, float a5, float a6, float a7) {
    u32x4 w; w.x = pk2(a0, a1); w.y = pk2(a2, a3); w.z = pk2(a4, a5); w.w = pk2(a6, a7); return __builtin_bit_cast(bf16x8, w); }
constexpr int VPITCH = 192;
DEV void pv_tile(f32x16& o0, f32x16& o1, const LAS unsigned char* vt, int lane, const bf16x8 (&pk)[4]) {
    const int hi = lane >> 5;
    const LAS unsigned char* vb = vt + (4 * hi + ((lane & 15) >> 2)) * VPITCH + ((lane >> 4) & 1) * 32 + (lane & 3) * 8;
    bf16x8 va[4];
#pragma unroll
    for (int ks = 0; ks < 4; ++ks) va[ks] = cat8(vtr(vb + (16 * ks) * VPITCH), vtr(vb + (16 * ks + 8) * VPITCH));
    asm volatile("" : "+v"(va[0]), "+v"(va[1]), "+v"(va[2]), "+v"(va[3]));
#pragma unroll
    for (int ks = 0; ks < 4; ++ks) o0 = __builtin_amdgcn_mfma_f32_32x32x16_bf16(va[ks], pk[ks], o0, 0, 0, 0);
#pragma unroll
    for (int ks = 0; ks < 4; ++ks) va[ks] = cat8(vtr(vb + (16 * ks) * VPITCH + 64), vtr(vb + (16 * ks + 8) * VPITCH + 64));
    asm volatile("" : "+v"(va[0]), "+v"(va[1]), "+v"(va[2]), "+v"(va[3]));
#pragma unroll
    for (int ks = 0; ks < 4; ++ks) o1 = __builtin_amdgcn_mfma_f32_32x32x16_bf16(va[ks], pk[ks], o1, 0, 0, 0);
}
DEV void store_ot(bf16_t* orow, const f32x16& o0, const f32x16& o1, int hi, float sc) {
#pragma unroll
    for (int g4 = 0; g4 < 4; ++g4) {
        u32x2 a; a.x = pk2(o0[4 * g4] * sc, o0[4 * g4 + 1] * sc); a.y = pk2(o0[4 * g4 + 2] * sc, o0[4 * g4 + 3] * sc);
        u32x2 b; b.x = pk2(o1[4 * g4] * sc, o1[4 * g4 + 1] * sc); b.y = pk2(o1[4 * g4 + 2] * sc, o1[4 * g4 + 3] * sc);
        *(u32x2*)(orow + 8 * g4 + 4 * hi) = a; *(u32x2*)(orow + 32 + 8 * g4 + 4 * hi) = b;
    }
}

DEV void sb_item(LAS unsigned char* vl, const bf16_t* Q, const bf16_t* Kk, const bf16_t* V, bf16_t* O, int b, int h, int qb, int lane, bool dry) {
    const int r32 = lane & 31, hi = lane >> 5, t0 = 32 * qb, t = t0 + r32; const size_t rowb = (size_t)b * S;
    bf16x8 qr[4]; { const bf16_t* qp = Q + (rowb + t0 + r32) * 512 + h * 64 + 8 * hi;
#pragma unroll
        for (int d0 = 0; d0 < 4; ++d0) qr[d0] = *(const bf16x8*)(qp + 16 * d0); }
    f32x16 o0, o1;
#pragma unroll
    for (int r = 0; r < 16; ++r) { o0[r] = 0.f; o1[r] = 0.f; }
    float carry = 1.f;
    const int c_hi = (t0 + 30) >> 6;
#pragma unroll 1
    for (int c = c_hi; c >= 0; --c) {
        const bf16_t* kp = Kk + (rowb + 64 * c + r32) * 512 + h * 64 + 8 * hi;
        bf16x8 k0[4], k1[4];
#pragma unroll
        for (int d0 = 0; d0 < 4; ++d0) { k0[d0] = *(const bf16x8*)(kp + 16 * d0); k1[d0] = *(const bf16x8*)(kp + (size_t)32 * 512 + 16 * d0); }
#pragma unroll
        for (int j = 0; j < 8; ++j) { const int row = (lane >> 3) + 8 * j; *(LAS u32x4*)(vl + row * VPITCH + (lane & 7) * 16) = *(const u32x4*)(V + (rowb + 64 * c + row) * 512 + h * 64 + (lane & 7) * 8); }
        f32x16 p0, p1;
#pragma unroll
        for (int r = 0; r < 16; ++r) { p0[r] = 0.f; p1[r] = 0.f; }
#pragma unroll
        for (int d0 = 0; d0 < 4; ++d0) { p0 = __builtin_amdgcn_mfma_f32_32x32x16_bf16(k0[d0], qr[d0], p0, 0, 0, 0); p1 = __builtin_amdgcn_mfma_f32_32x32x16_bf16(k1[d0], qr[d0], p1, 0, 0, 0); }
        float u[32];
        const bool diag = (c == c_hi);
#pragma unroll
        for (int e = 0; e < 32; ++e) {
            const float z = e < 16 ? p0[e] : p1[e - 16];
            float uu = __builtin_amdgcn_rcpf(1.f + __builtin_amdgcn_exp2f(fminf(z, 126.f)));
            if (diag) { const int kv = 64 * c + 8 * ((e >> 2) & 3) + 4 * hi + (e & 3) + 32 * (e >> 4); if (kv >= t) uu = 1.f; }
            u[e] = uu;
        }
        float gl[8], gh[8];
#pragma unroll
        for (int i = 0; i < 8; ++i) { const float gp = (u[4 * i] * u[4 * i + 1]) * (u[4 * i + 2] * u[4 * i + 3]);
            const auto rr = __builtin_amdgcn_permlane32_swap(__float_as_uint(gp), __float_as_uint(gp), false, false); gl[i] = __uint_as_float(rr[0]); gh[i] = __uint_as_float(rr[1]); }
        float ag[8]; float run = carry;
#pragma unroll
        for (int i = 7; i >= 0; --i) { const float a_hi = run; run *= gh[i]; const float a_lo = run; run *= gl[i]; ag[i] = hi ? a_hi : a_lo; }
        carry = run;
        bf16x8 pk[4];
#pragma unroll
        for (int ks = 0; ks < 4; ++ks) { float w[8];
#pragma unroll
            for (int g = 0; g < 2; ++g) { const int i = 2 * ks + g;
                const float a3 = ag[i], a2 = a3 * u[4 * i + 3], a1 = a2 * u[4 * i + 2], a0 = a1 * u[4 * i + 1];
                w[4 * g] = (1.f - u[4 * i]) * a0; w[4 * g + 1] = (1.f - u[4 * i + 1]) * a1; w[4 * g + 2] = (1.f - u[4 * i + 2]) * a2; w[4 * g + 3] = (1.f - u[4 * i + 3]) * a3; }
            pk[ks] = pk8(w[0], w[1], w[2], w[3], w[4], w[5], w[6], w[7]); }
        pv_tile(o0, o1, vl, lane, pk);
        if (__all(carry < 7.8e-31f)) break;
    }
    if (!dry) store_ot(O + (rowb + t0 + r32) * 512 + h * 64, o0, o1, hi, 1.f); else asm volatile("" :: "v"(o0), "v"(o1));
}
DEV void sb_phase(const WaveId& W, LAS unsigned char* lds, unsigned char* ws, bool dry) {
    LAS unsigned char* vl = lds + W.wave * 12288;
    const bf16_t* Q = (const bf16_t*)(ws + WS_QA); const bf16_t* Kk = (const bf16_t*)(ws + WS_KA); const bf16_t* V = (const bf16_t*)(ws + WS_VA);
    constexpr int NITEM = NB * 8 * (S / 32);
    for (int it = W.gw; it < NITEM; it += W.ngw) {
        const int qb = it & 255, h = (it >> 8) & 7, b = it >> 11;
        sb_item(vl, Q, Kk, V, (bf16_t*)(ws + WS_QA), b, h, qb, W.lane, dry);
    }
}

constexpr int IDX_CTL_OFF = 131072 + 1024;
DEV unsigned fkey2(float v) { const int u = (int)__float_as_uint(v); return (unsigned)(u ^ ((u >> 31) | (int)0x80000000)); }
DEV float relu1(float x) { return __builtin_amdgcn_fmed3f(x, 0.f, 3.0e38f); }
DEV void idx_prefetch(bf16x8 (&afr)[4], float (&w)[16], bf16x8 (&b0)[4], bf16x8 (&b1)[4], const bf16_t* IQ, const bf16_t* IK, const float* IWp, int b, int t0, int wid, int lane) {
    const int r32 = lane & 31, hh = lane >> 5; const size_t rowb = (size_t)b * S;
    { const int qi = 2 * (r32 >> 4) + ((r32 >> 2) & 1), head = (r32 & 3) + 4 * ((r32 >> 3) & 1);
        const bf16_t* ap = IQ + (rowb + t0 + qi) * 512 + head * 64 + 8 * hh;
#pragma unroll
        for (int ks = 0; ks < 4; ++ks) afr[ks] = *(const bf16x8*)(ap + 16 * ks); }
#pragma unroll
    for (int r = 0; r < 16; ++r) w[r] = IWp[(rowb + t0 + 2 * (r >> 3) + hh) * 8 + (r & 7)];
    const int jmax = (t0 + 3) >> 5;
    { const int j0 = wid < jmax ? wid : jmax, j1 = wid + 8 < jmax ? wid + 8 : jmax;
      const bf16_t* p0 = IK + ((rowb >> 5) + j0) * 2048 + (hh * 32 + r32) * 8; const bf16_t* p1 = IK + ((rowb >> 5) + j1) * 2048 + (hh * 32 + r32) * 8;
#pragma unroll
      for (int ks = 0; ks < 4; ++ks) { b0[ks] = *(const bf16x8*)(p0 + ks * 512); b1[ks] = *(const bf16x8*)(p1 + ks * 512); } }
}
DEV void idx_unit(LAS unsigned char* lds, const bf16_t* IQ, const bf16_t* IK, const float* IWp, unsigned* BM, int b, int t0, int nb, int nt0, int wid, int lane,
                  bf16x8 (&afr)[4], float (&w)[16], bf16x8 (&b0)[4], bf16x8 (&b1)[4]) {
    const int r32 = lane & 31, hh = lane >> 5; const size_t rowb = (size_t)b * S;
    const int tmax = t0 + 3, jmax = tmax >> 5;
    LAS unsigned* SCO = (LAS unsigned*)lds;
    bf16x8 b2[4];
#pragma unroll
    for (int ks = 0; ks < 4; ++ks) b2[ks] = afr[ks];
#define IDX_LOADB(dst, jj) do { const int jc_ = (jj) < jmax ? (jj) : jmax; const bf16_t* bp_ = IK + ((rowb >> 5) + jc_) * 2048 + (hh * 32 + r32) * 8; \
        _Pragma("unroll") for (int ks = 0; ks < 4; ++ks) dst[ks] = *(const bf16x8*)(bp_ + ks * 512); } while (0)
#define IDX_COMP(src, jj) do { f32x16 acc; _Pragma("unroll") for (int r = 0; r < 16; ++r) acc[r] = 0.f; \
        _Pragma("unroll") for (int ks = 0; ks < 4; ++ks) acc = __builtin_amdgcn_mfma_f32_32x32x16_bf16(afr[ks], src[ks], acc, 0, 0, 0); \
        float s0 = 0.f, s1 = 0.f; _Pragma("unroll") for (int hd = 0; hd < 8; ++hd) { s0 += w[hd] * relu1(acc[hd]); s1 += w[8 + hd] * relu1(acc[8 + hd]); } \
        unsigned k0_ = fkey2(s0), k1_ = fkey2(s1); const int key = 32 * (jj) + r32; \
        if ((jj) >= jmax) { k0_ = key <= t0 + hh ? k0_ : 0u; k1_ = key <= t0 + 2 + hh ? k1_ : 0u; }     \
        if ((jj) <= jmax) { SCO[hh * 8192 + key] = k0_; SCO[(2 + hh) * 8192 + key] = k1_; } } while (0)
#ifndef IDX_REP_MFMA
#define IDX_REP_MFMA 1
#endif
#ifndef IDX_REP_SEL
#define IDX_REP_SEL 1
#endif
#ifdef IDX_DRY_COMPUTE
#pragma unroll 1
    for (int j = wid; j <= jmax; j += 24) { IDX_COMP(b0, j); asm volatile("" : "+v"(b0[0]), "+v"(b1[0]), "+v"(b2[0])); IDX_COMP(b1, j + 8); IDX_COMP(b2, j + 16); }
#endif
#pragma unroll 1
    for (int rpm = 0; rpm < IDX_REP_MFMA; ++rpm) {
#pragma unroll 1
    for (int j = wid; j <= jmax; j += 24) {
        IDX_LOADB(b2, j + 16); IDX_COMP(b0, j);
        IDX_LOADB(b0, j + 24); IDX_COMP(b1, j + 8);
        IDX_LOADB(b1, j + 32); IDX_COMP(b2, j + 16);
    }
    }
#undef IDX_LOADB
#undef IDX_COMP
    if (nt0 >= 0) idx_prefetch(afr, w, b0, b1, IQ, IK, IWp, nb, nt0, wid, lane);
    LAS unsigned* thr = (LAS unsigned*)(lds + IDX_CTL_OFF);
    if (wid == 0 && lane < 32) ((LAS unsigned*)(lds + IDX_CTL_OFF + 64))[lane] = 0u;
    LDS_WAIT(); __builtin_amdgcn_s_barrier(); asm volatile("" ::: "memory");
    {
        const int q = wid & 3, h = wid >> 2, n = t0 + q + 1;
        volatile LAS unsigned* xme = (volatile LAS unsigned*)(lds + IDX_CTL_OFF + 64) + (q * 2 + h) * 4;
        volatile LAS unsigned* xpa = (volatile LAS unsigned*)(lds + IDX_CTL_OFF + 64) + (q * 2 + (h ^ 1)) * 4;
        unsigned T_ = 1u;
        if (n > 256) {
            LAS unsigned* row = SCO + q * 8192 + lane;
            unsigned r[64];
            const int nil = (jmax >> 1) >= h ? (((jmax >> 1) - h) >> 1) + 1 : 0;
#define IDX_FOR_LIVE(BODY) _Pragma("unroll") for (int g8_ = 0; g8_ < 8; ++g8_) if (8 * g8_ < nil) { _Pragma("unroll") for (int u8_ = 0; u8_ < 8; ++u8_) { const int il = 8 * g8_ + u8_; BODY } }
            IDX_FOR_LIVE( r[il] = (2 * (2 * il + h) + hh <= jmax) ? row[64 * (2 * il + h)] : 0u; )
            unsigned seq = 0u;
#define IDX_XCHG(val, out) do { ++seq; const int pb_ = (seq & 1u) * 2; if (lane == 0) { xme[pb_ + 1] = (val); xme[pb_] = seq; } \
                while (xpa[pb_] != seq) __builtin_amdgcn_s_sleep(0); (out) = xpa[pb_ + 1]; } while (0)
#define IDX_XCHG16(val, out) do { ++seq; const int pb_ = (seq & 1u) * 2; if (lane == 0) xme[pb_] = (seq << 16) | (val); unsigned w_; \
                while (((w_ = xpa[pb_]) >> 16) != (seq & 0xffffu)) __builtin_amdgcn_s_sleep(0); (out) = w_ & 0xffffu; } while (0)
#pragma unroll 1
            for (int rps = 0; rps < IDX_REP_SEL; ++rps) {
            unsigned mx = 0u;
            IDX_FOR_LIVE( mx = max(mx, r[il]); )
#pragma unroll
            for (int o = 1; o < 64; o <<= 1) mx = max(mx, (unsigned)__shfl_xor((int)mx, o));
            { unsigned pm_; IDX_XCHG(mx, pm_); mx = max(mx, pm_); }
            unsigned lo_ = 1u, hi_ = mx + 1u, chi_ = 0u, xgt_ = 1u, xeq_ = 0u, mt_ = 0u; bool done_ = false;
            if (mx > 0x82000000u) {
                const unsigned c1 = mx - (1u << 23), c2 = mx - (3u << 23);
                unsigned ca_ = 0, cb_ = 0, cc_ = 0, cd_ = 0; const unsigned c1v = c1, c2v = c2;
#define IDX_CNT4B(A, B, C, Dd) asm volatile("v_cmp_ge_u32_e64 s[88:89], %4, %8\n\tv_cmp_ge_u32_e64 s[90:91], %5, %8\n\tv_cmp_ge_u32_e64 s[92:93], %6, %8\n\tv_cmp_ge_u32_e64 s[94:95], %7, %8\n\t" \
                    "v_addc_co_u32_e64 %0, s[88:89], %0, 0, s[88:89]\n\tv_addc_co_u32_e64 %1, s[90:91], %1, 0, s[90:91]\n\tv_addc_co_u32_e64 %0, s[92:93], %0, 0, s[92:93]\n\tv_addc_co_u32_e64 %1, s[94:95], %1, 0, s[94:95]\n\t" \
                    "v_cmp_ge_u32_e64 s[88:89], %4, %9\n\tv_cmp_ge_u32_e64 s[90:91], %5, %9\n\tv_cmp_ge_u32_e64 s[92:93], %6, %9\n\tv_cmp_ge_u32_e64 s[94:95], %7, %9\n\t" \
                    "v_addc_co_u32_e64 %2, s[88:89], %2, 0, s[88:89]\n\tv_addc_co_u32_e64 %3, s[90:91], %3, 0, s[90:91]\n\tv_addc_co_u32_e64 %2, s[92:93], %2, 0, s[92:93]\n\tv_addc_co_u32_e64 %3, s[94:95], %3, 0, s[94:95]" \
                    : "+v"(ca_), "+v"(cb_), "+v"(cc_), "+v"(cd_) : "v"(A), "v"(B), "v"(C), "v"(Dd), "v"(c1v), "v"(c2v) : "s88", "s89", "s90", "s91", "s92", "s93", "s94", "s95")
#pragma unroll
                for (int g8_ = 0; g8_ < 8; ++g8_) if (8 * g8_ < nil) { IDX_CNT4B(r[8 * g8_], r[8 * g8_ + 1], r[8 * g8_ + 2], r[8 * g8_ + 3]); IDX_CNT4B(r[8 * g8_ + 4], r[8 * g8_ + 5], r[8 * g8_ + 6], r[8 * g8_ + 7]); }
#undef IDX_CNT4B
                int pk = (int)((ca_ + cb_) | ((cc_ + cd_) << 16));
                pk += __builtin_amdgcn_update_dpp(0, pk, 0x111, 0xf, 0xf, false);
                pk += __builtin_amdgcn_update_dpp(0, pk, 0x112, 0xf, 0xf, false);
                pk += __builtin_amdgcn_update_dpp(0, pk, 0x114, 0xf, 0xf, false);
                pk += __builtin_amdgcn_update_dpp(0, pk, 0x118, 0xf, 0xf, false);
                pk += __builtin_amdgcn_update_dpp(0, pk, 0x142, 0xa, 0xf, false);
                unsigned tot = (unsigned)__builtin_amdgcn_readlane(pk, 31) + (unsigned)__builtin_amdgcn_readlane(pk, 63);
                { unsigned pt_; IDX_XCHG(tot, pt_); tot += pt_; }
                const unsigned t1 = tot & 0xffffu, t2 = tot >> 16;
                if (t1 == 256u) { xgt_ = c1; mt_ = 0u; done_ = true; }
                else if (t1 > 256u) lo_ = c1;
                else { hi_ = c1; chi_ = t1;
                       if (t2 == 256u) { xgt_ = c2; mt_ = 0u; done_ = true; }
                       else if (t2 > 256u) lo_ = c2;
                       else { hi_ = c2; chi_ = t2; } }
                if (!done_ && hi_ - lo_ == 1u) { xgt_ = hi_; xeq_ = lo_; mt_ = 256u - chi_; done_ = true; }
            }
            { LAS unsigned* hist = (LAS unsigned*)(lds + IDX_CTL_OFF + 1024) + q * 256;
#pragma unroll 1
              for (int round = 0; round < 6 && !done_; ++round) {
                const unsigned wdt = hi_ - lo_;
                const int sh = wdt <= 256u ? 0 : 24 - (int)__builtin_clz(wdt - 1u);
                hist[128 * h + lane] = 0u; hist[128 * h + 64 + lane] = 0u;
                LDS_WAIT(); { unsigned d_; IDX_XCHG16(0u, d_); (void)d_; }
                const unsigned lov = lo_;
                if (round == 0) {
                    IDX_FOR_LIVE( const unsigned d = r[il] - lov; if (d < wdt) __hip_atomic_fetch_add(hist + (d >> sh), 1u, __ATOMIC_RELAXED, __HIP_MEMORY_SCOPE_WORKGROUP); )
                } else {
#pragma unroll
                    for (int g8_ = 0; g8_ < 8; ++g8_) if (8 * g8_ < nil) {
#pragma unroll
                        for (int u4_ = 0; u4_ < 2; ++u4_) { const int il = 8 * g8_ + 4 * u4_;
                            const unsigned d0 = r[il] - lov, d1 = r[il + 1] - lov, d2 = r[il + 2] - lov, d3 = r[il + 3] - lov;
                            if (min(min(d0, d1), min(d2, d3)) < wdt) {
                                if (d0 < wdt) __hip_atomic_fetch_add(hist + (d0 >> sh), 1u, __ATOMIC_RELAXED, __HIP_MEMORY_SCOPE_WORKGROUP);
                                if (d1 < wdt) __hip_atomic_fetch_add(hist + (d1 >> sh), 1u, __ATOMIC_RELAXED, __HIP_MEMORY_SCOPE_WORKGROUP);
                                if (d2 < wdt) __hip_atomic_fetch_add(hist + (d2 >> sh), 1u, __ATOMIC_RELAXED, __HIP_MEMORY_SCOPE_WORKGROUP);
                                if (d3 < wdt) __hip_atomic_fetch_add(hist + (d3 >> sh), 1u, __ATOMIC_RELAXED, __HIP_MEMORY_SCOPE_WORKGROUP); } } }
                }
                LDS_WAIT(); { unsigned d_; IDX_XCHG16(0u, d_); (void)d_; }
                const u32x4 hb = *(const LAS u32x4*)(hist + 4 * lane);
                const unsigned s4 = (hb.x + hb.y) + (hb.z + hb.w);
                unsigned suf = s4;
#pragma unroll
                for (int o = 1; o < 64; o <<= 1) { const unsigned tv = (unsigned)__shfl_down((int)suf, o); if (lane + o < 64) suf += tv; }
                const unsigned long long okm = __ballot(chi_ + suf >= 256u);
                const int L = 63 - (int)__builtin_clzll(okm);
                const unsigned above = chi_ + (unsigned)__builtin_amdgcn_readlane((int)(suf - s4), L);
                const unsigned h0 = (unsigned)__builtin_amdgcn_readlane((int)hb.x, L), h1 = (unsigned)__builtin_amdgcn_readlane((int)hb.y, L),
                               h2 = (unsigned)__builtin_amdgcn_readlane((int)hb.z, L), h3 = (unsigned)__builtin_amdgcn_readlane((int)hb.w, L);
                unsigned Bsel, cab, cnb;
                if (above + h3 >= 256u) { Bsel = 3u; cab = above; cnb = h3; }
                else if (above + h3 + h2 >= 256u) { Bsel = 2u; cab = above + h3; cnb = h2; }
                else if (above + h3 + h2 + h1 >= 256u) { Bsel = 1u; cab = above + h3 + h2; cnb = h1; }
                else { Bsel = 0u; cab = above + h3 + h2 + h1; cnb = h0; }
                Bsel += 4u * (unsigned)L;
                const unsigned nlo = lo_ + (Bsel << sh); unsigned nhi = nlo + (1u << sh); if (nhi > hi_ || nhi < nlo) nhi = hi_;
                if (cab + cnb == 256u) { xgt_ = nlo; mt_ = 0u; done_ = true; }
                else if (sh == 0) { xgt_ = nlo + 1u; xeq_ = nlo; mt_ = 256u - cab; done_ = true; }
                else { lo_ = nlo; hi_ = nhi; chi_ = cab; }
              } }
#ifdef IDX_XTRA
#pragma unroll 1
            for (int xr = 0; xr < IDX_XTRA; ++xr) { unsigned dsum = 0; const unsigned cv = xgt_ + (unsigned)xr;
                IDX_FOR_LIVE( dsum += r[il] >= cv; )
                int pk = (int)dsum;
                pk += __builtin_amdgcn_update_dpp(0, pk, 0x111, 0xf, 0xf, false); pk += __builtin_amdgcn_update_dpp(0, pk, 0x112, 0xf, 0xf, false); pk += __builtin_amdgcn_update_dpp(0, pk, 0x114, 0xf, 0xf, false);
                pk += __builtin_amdgcn_update_dpp(0, pk, 0x118, 0xf, 0xf, false); pk += __builtin_amdgcn_update_dpp(0, pk, 0x142, 0xa, 0xf, false);
                unsigned tot = (unsigned)__builtin_amdgcn_readlane(pk, 31) + (unsigned)__builtin_amdgcn_readlane(pk, 63);
                { unsigned pt_; IDX_XCHG16(tot, pt_); tot += pt_; } asm volatile("" :: "s"(tot)); }
#endif
            T_ = xgt_;
            if (mt_ != 0u) {
                if (h == 0) { unsigned run = 0u;
#pragma unroll 1
                    for (int i = 0; i <= (jmax >> 1); ++i) { const bool ok_ = 2 * i + hh <= jmax; const unsigned kv = ok_ ? row[64 * i] : 0u; const bool eq = kv == xeq_; const unsigned long long bm = __ballot(eq);
                        const unsigned rank = run + __builtin_amdgcn_mbcnt_hi((unsigned)(bm >> 32), __builtin_amdgcn_mbcnt_lo((unsigned)bm, 0u));
                        if (eq && rank >= mt_) row[64 * i] = 0u;
                        run += (unsigned)__popcll(bm); } }
                T_ = xeq_;
            }
            }
#undef IDX_XCHG
#undef IDX_XCHG16
#undef IDX_FOR_LIVE
        }
        if (lane == 0 && h == 0) thr[q] = T_;
    }
#ifdef PROBE_VALU
    { float a0 = (float)lane, a1 = a0 + 1.f, a2 = a0 + 2.f, a3 = a0 + 3.f, a4 = a0 + 4.f, a5 = a0 + 5.f, a6 = a0 + 6.f, a7 = a0 + 7.f; const float m = 1.0000001f, c = 1e-9f;
#pragma unroll 1
      for (int it = 0; it < 64; ++it) {
#pragma unroll
          for (int u = 0; u < 8; ++u) { a0 = a0 * m + c; a1 = a1 * m + c; a2 = a2 * m + c; a3 = a3 * m + c; a4 = a4 * m + c; a5 = a5 * m + c; a6 = a6 * m + c; a7 = a7 * m + c; } }
      asm volatile("" :: "v"(a0), "v"(a1), "v"(a2), "v"(a3), "v"(a4), "v"(a5), "v"(a6), "v"(a7)); }
#endif
    LDS_WAIT(); __builtin_amdgcn_s_barrier(); asm volatile("" ::: "memory");
    { const unsigned tq0 = thr[hh], tq1 = thr[2 + hh];
#pragma unroll 4
      for (int j = wid; j <= ((t0 | 255) >> 5); j += 8) {
          bool s0 = false, s1 = false;
          if (j <= jmax) { s0 = SCO[hh * 8192 + 32 * j + r32] >= tq0; s1 = SCO[(2 + hh) * 8192 + 32 * j + r32] >= tq1; }
          const unsigned long long b0_ = __ballot(s0), b1_ = __ballot(s1);
          if (lane == 0) { u32x4 o; o.x = (unsigned)b0_; o.y = (unsigned)(b0_ >> 32); o.z = (unsigned)b1_; o.w = (unsigned)(b1_ >> 32); *(u32x4*)(BM + ((size_t)b * 256 + j) * S + t0) = o; }
      } }
    LDS_WAIT(); __builtin_amdgcn_s_barrier();
}
DEV void idx_phase(LAS unsigned char* lds, unsigned char* ws, int vcu, int G, int wid, int lane) {
    constexpr int NUNIT = T / 4;
    const bf16_t* IQ = (const bf16_t*)(ws + WS_IQ); const bf16_t* IK = (const bf16_t*)(ws + WS_IK); const float* IW = (const float*)(ws + WS_IW);
#define IDX_UNIT_OF(k) ((k) * G + (((k) & 1) ? G - 1 - vcu : vcu))
    bf16x8 afr[4], b0[4], b1[4]; float w[16];
    int un = IDX_UNIT_OF(0);
    if (un < NUNIT) { const int b = un / (S / 4); idx_prefetch(afr, w, b0, b1, IQ, IK, IW, b, (un - b * (S / 4)) * 4, wid, lane); }
#pragma unroll 1
    for (int k = 0; un < NUNIT; ++k) {
        const int b = un / (S / 4), t0 = (un - b * (S / 4)) * 4;
        const int nun = IDX_UNIT_OF(k + 1); const int nb = nun / (S / 4), nt0 = nun < NUNIT ? (nun - nb * (S / 4)) * 4 : -1;
        idx_unit(lds, IQ, IK, IW, (unsigned*)(ws + WS_BM), b, t0, nb, nt0, wid, lane, afr, w, b0, b1);
        un = nun;
    }
#undef IDX_UNIT_OF
}

DEV void kn_phase(const WaveId& W, const bf16_t* Kk, float* KN) {
    for (int item = W.gw; item < NB * 8 * (S / 64); item += W.ngw) {
        const int b = item / (8 * (S / 64)), h = (item / (S / 64)) & 7, tile = item % (S / 64);
        const bf16_t* kp = Kk + ((size_t)b * S + tile * 64 + W.lane) * 512 + h * 64;
        float ss = 0.f;
#pragma unroll
        for (int c = 0; c < 8; ++c) { const u32x4 v = *(const u32x4*)(kp + 8 * c);
#pragma unroll
            for (int e = 0; e < 4; ++e) { const float lo = __uint_as_float(v[e] << 16), hi = __uint_as_float(v[e] & 0xffff0000u); ss += lo * lo + hi * hi; } }
        const float m = wave_max(ss);
        if (W.lane == 0) KN[item] = sqrtf(m) * 1.01f;
    }
}
#include <hip/hip_bf16.h>
namespace attn_body {
using bf16=__hip_bfloat16;
using bf16x8=__attribute__((ext_vector_type(8)))short;
using s16x4=__attribute__((ext_vector_type(4)))short;
using f32x16=__attribute__((ext_vector_type(16)))float;
using u32x4=__attribute__((ext_vector_type(4)))unsigned;
constexpr int BATCH=2,NHEAD=8,SEQ=8192,D=64,DM=NHEAD*D;
constexpr int NW=8,QBLK=32,QB=QBLK*NW,KVBLK=64,NQB=SEQ/QB;
constexpr int ATTN_PITCH=DM, ATTN_UNIT_ROWS=QB;
__device__ __forceinline__ int crow(int r,int hi){return (r&3)+8*(r>>2)+4*hi;}
#define SBAR() __builtin_amdgcn_sched_barrier(0)
__device__ __forceinline__ void cmask(f32x16&p0,f32x16&p1,int jb,int qrel,int hi){
  const float NEG=-INFINITY; int kb=64*jb+4*hi;
  #pragma unroll
  for(int r=0;r<16;++r){int kv=kb+(r&3)+8*(r>>2); if(kv>qrel)p0[r]=NEG; if(kv+32>qrel)p1[r]=NEG;}
}

constexpr int NSLOT=3, SLOTB=8192;
constexpr int LDS_K=0, LDS_V=NSLOT*SLOTB, LDS_WS=2*NSLOT*SLOTB, LDS_OST=LDS_WS+NW*64*4, LDS_BYTES=LDS_OST+NW*4096;
constexpr float C2=0.125f*1.4426950408889634f;
__device__ __forceinline__ void glds16(const void*gsrc,unsigned lds_dst){unsigned keep;
  asm volatile("s_mov_b32 %0, m0\n\ts_mov_b32 m0, %2\n\ts_nop 0\n\tglobal_load_lds_dwordx4 %1, off\n\ts_mov_b32 m0, %0":"=&s"(keep):"v"(gsrc),"s"(lds_dst):"memory");}
__device__ __forceinline__ float max3f(float a,float b,float c){float r;asm("v_max3_f32 %0, %1, %2, %3":"=v"(r):"v"(a),"v"(b),"v"(c));return r;}
__device__ __forceinline__ float max2f(float a,float b){float r;asm("v_max_f32_e32 %0, %1, %2":"=v"(r):"v"(a),"v"(b));return r;}
__device__ __forceinline__ float fadd_s(float a,float b){float r;asm("v_add_f32_e32 %0, %1, %2":"=v"(r):"v"(a),"v"(b));return r;}
__device__ __forceinline__ float fsub_s(float a,float b){float r;asm("v_sub_f32_e32 %0, %1, %2":"=v"(r):"v"(a),"v"(b));return r;}
typedef float f32x2_t __attribute__((ext_vector_type(2))); typedef __bf16 bf16x2_t __attribute__((ext_vector_type(2)));
__device__ __forceinline__ unsigned cvtpk_s(float lo,float hi){f32x2_t v={lo,hi};bf16x2_t b=__builtin_convertvector(v,bf16x2_t);return __builtin_bit_cast(unsigned,b);}
#define WAIT_BAR(N) asm volatile("s_waitcnt vmcnt(" #N ") lgkmcnt(0)\n\ts_barrier":::"memory")

__device__ __forceinline__ void qkt(f32x16&p0,f32x16&p1,const char*Kslot,const bf16x8*qr,const f32x16&negm,int r32,int hi){
  const char*kb=Kslot+hi*1024+r32*16;
  #pragma unroll
  for(int d0=0;d0<4;++d0){
    const bf16x8 b0=*reinterpret_cast<const bf16x8*>(kb+d0*2048);
    const bf16x8 b1=*reinterpret_cast<const bf16x8*>(kb+d0*2048+512);
    if(d0==0){p0=__builtin_amdgcn_mfma_f32_32x32x16_bf16(b0,qr[0],negm,0,0,0);p1=__builtin_amdgcn_mfma_f32_32x32x16_bf16(b1,qr[0],negm,0,0,0);}
    else{p0=__builtin_amdgcn_mfma_f32_32x32x16_bf16(b0,qr[d0],p0,0,0,0);p1=__builtin_amdgcn_mfma_f32_32x32x16_bf16(b1,qr[d0],p1,0,0,0);}}
}
typedef __attribute__((address_space(3))) const char* lds_cptr;
typedef short v4i16_t __attribute__((ext_vector_type(4)));
__device__ __forceinline__ void kload8(bf16x8*kf,lds_cptr kp){
  kf[0]=*(const __attribute__((address_space(3))) bf16x8*)(kp);      kf[1]=*(const __attribute__((address_space(3))) bf16x8*)(kp+512);
  kf[2]=*(const __attribute__((address_space(3))) bf16x8*)(kp+2048); kf[3]=*(const __attribute__((address_space(3))) bf16x8*)(kp+2560);
  kf[4]=*(const __attribute__((address_space(3))) bf16x8*)(kp+4096); kf[5]=*(const __attribute__((address_space(3))) bf16x8*)(kp+4608);
  kf[6]=*(const __attribute__((address_space(3))) bf16x8*)(kp+6144); kf[7]=*(const __attribute__((address_space(3))) bf16x8*)(kp+6656);
}
__device__ __forceinline__ void kload2(bf16x8*kf,lds_cptr kp,int j){ kf[2*j]=*(const __attribute__((address_space(3))) bf16x8*)(kp+j*2048); kf[2*j+1]=*(const __attribute__((address_space(3))) bf16x8*)(kp+j*2048+512); }
__device__ __forceinline__ s16x4 vtr(lds_cptr p){ return __builtin_bit_cast(s16x4,__builtin_amdgcn_ds_read_tr16_b64_v4i16((__attribute__((address_space(3))) v4i16_t*)p)); }
__device__ __forceinline__ float rowmax(const f32x16&p0,const f32x16&p1){
  float a=max3f(p0[0],p0[1],p1[0]),b=max3f(p0[2],p0[3],p1[1]);a=max3f(a,p1[2],p1[3]);
  #pragma unroll
  for(int r=4;r<16;r+=4){a=max3f(a,p0[r],p0[r+1]);b=max3f(b,p0[r+2],p0[r+3]);a=max3f(a,p1[r],p1[r+1]);b=max3f(b,p1[r+2],p1[r+3]);}
  const float m=max2f(a,b);
  auto rr=__builtin_amdgcn_permlane32_swap(__float_as_uint(m),__float_as_uint(m),false,false);
  return max2f(__uint_as_float(rr[0]),__uint_as_float(rr[1]));
}
__device__ __forceinline__ void pv(f32x16*o,int vb,bf16x8 pa0,bf16x8 pa1,bf16x8 pa2,bf16x8 pa3){
  #pragma unroll
  for(int d0=0;d0<2;++d0){s16x4 lo[4],hi[4];
    #pragma unroll
    for(int ks=0;ks<4;++ks){
      asm volatile("ds_read_b64_tr_b16 %0,%1 offset:%c2":"=&v"(lo[ks]):"v"(vb),"i"(d0*4096+ks*1024):"memory");
      asm volatile("ds_read_b64_tr_b16 %0,%1 offset:%c2":"=&v"(hi[ks]):"v"(vb),"i"(d0*4096+ks*1024+512):"memory");}
    asm volatile("s_waitcnt lgkmcnt(0)":::"memory");SBAR();
    #define PK(k) (bf16x8){lo[k][0],lo[k][1],lo[k][2],lo[k][3],hi[k][0],hi[k][1],hi[k][2],hi[k][3]}
    o[d0]=__builtin_amdgcn_mfma_f32_32x32x16_bf16(pa0,PK(0),o[d0],0,0,0);
    o[d0]=__builtin_amdgcn_mfma_f32_32x32x16_bf16(pa1,PK(1),o[d0],0,0,0);
    o[d0]=__builtin_amdgcn_mfma_f32_32x32x16_bf16(pa2,PK(2),o[d0],0,0,0);
    o[d0]=__builtin_amdgcn_mfma_f32_32x32x16_bf16(pa3,PK(3),o[d0],0,0,0);
    #undef PK
  }
}

#ifndef ATTN_STORE16
#define ATTN_STORE16(p,v) (*(u32x4*)(p)=(v))
#endif
template<int THRL> __device__ __forceinline__ void attn_unit(int b,int h,int qb,const bf16*Q,const bf16*__restrict__ K,const bf16*__restrict__ V,bf16*O,char*shm,const unsigned*__restrict__ BMb,const float*KNbh,const int tid){
  const int lane=tid&63,r32=lane&31,hi=lane>>5; const int wid=__builtin_amdgcn_readfirstlane(tid>>6);
  const long rowbase=(long)b*SEQ; const int q0=qb*QB;
  const bf16*Qw=Q+(rowbase+q0+wid*QBLK)*DM+h*D;
  const bf16*Kh=K+rowbase*DM+h*D,*Vh=V+rowbase*DM+h*D;
  const unsigned lds0=(unsigned)(uintptr_t)shm;
  float*wsf=(float*)(shm+LDS_WS)+wid*64;
  const bf16*ksrc=Kh+(long)lane*DM+wid*8;
  const bf16*vsrc=Vh+(long)(16*(wid&3)+(lane>>2))*DM+(wid>>2)*32+(lane&3)*8;
  const unsigned kdst=lds0+LDS_K+wid*1024, vdst=lds0+LDS_V+wid*1024;
  #define DMA_K(t,slot) glds16(ksrc+(long)(t)*KVBLK*DM,(unsigned)__builtin_amdgcn_readfirstlane(kdst+(slot)))
  #define DMA_V(t,slot) glds16(vsrc+(long)(t)*KVBLK*DM,(unsigned)__builtin_amdgcn_readfirstlane(vdst+(slot)))
  const int vb0=(int)(lds0+LDS_V)+((lane>>4)&1)*32+(lane&3)*8+(4*hi+((lane&15)>>2))*64;
  const char*Kbase=shm+LDS_K; bf16x8 kf[8];
  const lds_cptr shm3=(lds_cptr)shm; const lds_cptr kp0=shm3+LDS_K+hi*1024+r32*16; const lds_cptr vp0=shm3+LDS_V+((lane>>4)&1)*32+(lane&3)*8+(4*hi+((lane&15)>>2))*64;
  const int NT=(q0+QB)/KVBLK;
  DMA_K(0,0);DMA_V(0,0);DMA_K(1,SLOTB);
  bf16x8 qr[4];
  #pragma unroll
  for(int d0=0;d0<4;++d0)qr[d0]=*reinterpret_cast<const bf16x8*>(&Qw[(long)r32*DM+d0*16+hi*8]);
  const unsigned*bmp=BMb+(q0+wid*QBLK+r32);
  unsigned mwE0=bmp[0],mwE1=bmp[(size_t)SEQ],mwO0=0u,mwO1=0u;
  bool seen=false;
  float qn; { float qs=0.f;
    _Pragma("unroll") for(int d0=0;d0<4;++d0) _Pragma("unroll") for(int e=0;e<8;++e){ const float x=__uint_as_float(((unsigned)(unsigned short)qr[d0][e])<<16); qs+=x*x; }
    auto rr=__builtin_amdgcn_permlane32_swap(__float_as_uint(qs),__float_as_uint(qs),false,false); qn=__builtin_sqrtf(__uint_as_float(rr[0])+__uint_as_float(rr[1]))*1.01f; }
  constexpr float FASTB=60.f;
  int zlane=0; asm volatile("":"+v"(zlane));
  const float*knp=KNbh+zlane;
  float knE=knp[0],knO=0.f;
  bool anysel_=false;
  #define SLOWT(PS) (__any(!(qn*kn##PS<=FASTB)||mhat!=0.f))
  float mhat=0.f,l_reg=0.f;f32x16 o[2];o[0]=f32x16{};o[1]=f32x16{};const f32x16 zero16=f32x16{};
  const int qrel=wid*QBLK+r32;
  #define CMASK(P0,P1,SLOW,PS) do{ const unsigned m0_=mw##PS##0>>(4*hi), m1_=mw##PS##1>>(4*hi); anysel_=(mw##PS##0|mw##PS##1)!=0u; \
    if(SLOW){ _Pragma("unroll") for(int r=0;r<16;++r){ P0[r]-=mhat; P1[r]-=mhat; } } \
    _Pragma("unroll") for(int r=0;r<16;++r){ const int bit_=(r&3)+8*(r>>2); \
      const unsigned e0_=(unsigned)__builtin_amdgcn_sbfe((int)m0_,bit_,1), e1_=(unsigned)__builtin_amdgcn_sbfe((int)m1_,bit_,1); \
      P0[r]=__uint_as_float((__float_as_uint(P0[r])&e0_)|(0xff800000u&~e0_)); P1[r]=__uint_as_float((__float_as_uint(P1[r])&e1_)|(0xff800000u&~e1_)); } \
    }while(0)
  bool resc=false;
  #define START(P0,P1,SLOW) do{ resc=false; seen=anysel_; \
    if(SLOW){ const float rm=rowmax(P0,P1); const float dl=(rm==-INFINITY)?0.f:rm; mhat=fadd_s(mhat,dl); \
      _Pragma("unroll") for(int r=0;r<16;++r){P0[r]=fsub_s(P0[r],dl);P1[r]=fsub_s(P1[r],dl);} \
      } \
    _Pragma("unroll") for(int r=0;r<16;++r)P0[r]=__builtin_amdgcn_exp2f(P0[r]); }while(0)
  #define RESC() do{ if(resc){ asm volatile("s_waitcnt lgkmcnt(0)":::"memory"); \
      _Pragma("unroll") for(int d_=0;d_<2;++d_) _Pragma("unroll") for(int r=0;r<16;++r)o[d_][r]*=wsf[crow(r,hi)]; } }while(0)
  f32x16 pA0,pA1,pB0,pB1;
  int sl_prev=0,sl_cur=0,sl_next=SLOTB;
  #define ROT() do{sl_prev=sl_cur;sl_cur=sl_next;sl_next=(sl_next==(NSLOT-1)*SLOTB)?0:sl_next+SLOTB;}while(0)
  DMA_K(2,2*SLOTB);
  WAIT_BAR(3);
  { mwO0=bmp[(size_t)2*SEQ]; mwO1=bmp[(size_t)3*SEQ]; knO=knp[1];
  const bool slow0_=SLOWT(E);
  qkt(pA0,pA1,Kbase,qr,zero16,r32,hi);asm volatile("s_nop 15\n\ts_nop 7":"+v"(pA0),"+v"(pA1));CMASK(pA0,pA1,slow0_,E);
  START(pA0,pA1,slow0_); }
  _Pragma("unroll") for(int r=0;r<16;++r)pA1[r]=__builtin_amdgcn_exp2f(pA1[r]);
  WAIT_BAR(0);
  DMA_K(3,0);DMA_V(1,SLOTB);
  ROT();
  kload8(kf,kp0+sl_cur);
  WAIT_BAR(2);
  s16x4 vlo[8],vhi[8]; u32x4 pw0,pw1,pw2,pw3;
  #define PKW(P,B) cvtpk_s(P[B],P[B+1])
  #define PAF(k) __builtin_bit_cast(bf16x8,pw##k)
  #define VFR(i) (bf16x8){vlo[i][0],vlo[i][1],vlo[i][2],vlo[i][3],vhi[i][0],vhi[i][1],vhi[i][2],vhi[i][3]}
  #define PIN(x) asm volatile("":"+v"(x))
  #define MX3(a,b,c) __builtin_fmaxf(__builtin_fmaxf((a),(b)),(c))
  #define GAPA(MF,A0,A1,A2,A3,W0,W1,PW) do{ MF; sacc+=A0; sacc+=A1; sacc+=A2; sacc+=A3; PIN(sacc); W0; W1; PIN(PW); SBAR(); }while(0)
  #define EX(v) __builtin_amdgcn_exp2f(v)
  #define GAPB(MF,X,B) do{ MF; X[B]=EX(X[B]); X[B+1]=EX(X[B+1]); X[B+2]=EX(X[B+2]); X[B+3]=EX(X[B+3]); PIN(X); SBAR(); }while(0)
  #define VRD(i) do{ vlo[i]=vtr(vp_+(((i)>>2)*4096+((i)&3)*1024)); vhi[i]=vtr(vp_+(((i)>>2)*4096+((i)&3)*1024+512)); }while(0)
  #define KRD(G,j) do{ if(G){ kload2(kf,kp0+sl_next,j); SBAR(); } }while(0)
  #define STEP(C0,C1,P0,P1,t,GK,GV,GL,PS,NS) do{ SBAR(); \
    if((t)+1<NT){ mw##NS##0=bmp[(size_t)(2*(t)+2)*SEQ]; mw##NS##1=bmp[(size_t)(2*(t)+3)*SEQ]; kn##NS=knp[(t)+1]; }     \
    const lds_cptr vp_=vp0+sl_prev; \
    VRD(0); SBAR(); float sacc=(P0[0]+P0[1]); \
    GAPA(C0=__builtin_amdgcn_mfma_f32_32x32x16_bf16(kf[0],qr[0],zero16,0,0,0), P0[2],P0[3],P0[4],P0[5],     pw0[0]=PKW(P0,0), pw0[1]=PKW(P0,2), pw0); \
    VRD(4); SBAR(); GAPA(C1=__builtin_amdgcn_mfma_f32_32x32x16_bf16(kf[1],qr[0],zero16,0,0,0), P0[6],P0[7],P0[8],P0[9],     pw0[2]=PKW(P0,4), pw0[3]=PKW(P0,6), pw0); \
    VRD(1); SBAR(); GAPA(C0=__builtin_amdgcn_mfma_f32_32x32x16_bf16(kf[2],qr[1],C0,0,0,0),   P0[10],P0[11],P0[12],P0[13], pw1[0]=PKW(P0,8), pw1[1]=PKW(P0,10), pw1); \
    VRD(5); SBAR(); GAPA(C1=__builtin_amdgcn_mfma_f32_32x32x16_bf16(kf[3],qr[1],C1,0,0,0),   P0[14],P0[15],P1[0],P1[1],   pw1[2]=PKW(P0,12),pw1[3]=PKW(P0,14), pw1); \
    VRD(2); SBAR(); GAPA(C0=__builtin_amdgcn_mfma_f32_32x32x16_bf16(kf[4],qr[2],C0,0,0,0),   P1[2],P1[3],P1[4],P1[5],     pw2[0]=PKW(P1,0), pw2[1]=PKW(P1,2), pw2); \
    VRD(6); SBAR(); GAPA(C1=__builtin_amdgcn_mfma_f32_32x32x16_bf16(kf[5],qr[2],C1,0,0,0),   P1[6],P1[7],P1[8],P1[9],     pw2[2]=PKW(P1,4), pw2[3]=PKW(P1,6), pw2); \
    VRD(3); SBAR(); GAPA(C0=__builtin_amdgcn_mfma_f32_32x32x16_bf16(kf[6],qr[3],C0,0,0,0),   P1[10],P1[11],P1[12],P1[13], pw3[0]=PKW(P1,8), pw3[1]=PKW(P1,10), pw3); \
    VRD(7); SBAR(); GAPA(C1=__builtin_amdgcn_mfma_f32_32x32x16_bf16(kf[7],qr[3],C1,0,0,0),   P1[14],P1[15],0.f,0.f,       pw3[2]=PKW(P1,12),pw3[3]=PKW(P1,14), pw3); \
    l_reg+=sacc; \
    if(GK){DMA_K((t)+3,sl_cur);} if(GV){DMA_V((t)+1,sl_next);} \
    const bool slow_=SLOWT(PS); CMASK(C0,C1,slow_,PS); resc=false; \
    if(__builtin_expect(slow_,0)){ float a=MX3(C0[0],C0[1],C1[0]),b=MX3(C0[2],C0[3],C1[1]); a=MX3(a,C1[2],C1[3]); \
      _Pragma("unroll") for(int r=4;r<16;r+=4){a=MX3(a,C0[r],C0[r+1]);b=MX3(b,C0[r+2],C0[r+3]);a=MX3(a,C1[r],C1[r+1]);b=MX3(b,C1[r+2],C1[r+3]);} \
      float rm=__builtin_fmaxf(a,b); { auto rr=__builtin_amdgcn_permlane32_swap(__float_as_uint(rm),__float_as_uint(rm),false,false); rm=__builtin_fmaxf(__uint_as_float(rr[0]),__uint_as_float(rr[1])); } \
      const bool fresh_=!seen&&rm>-INFINITY;     \
      if(__builtin_expect(__any(rm>(float)THRL||(fresh_&&rm<-(float)THRL)),0)){ const float dl=fresh_?rm:__builtin_fmaxf(rm,0.f); mhat+=dl; \
        _Pragma("unroll") for(int r=0;r<16;++r){C0[r]-=dl;C1[r]-=dl;} \
        const float f=dl>0.f?__builtin_amdgcn_exp2f(-dl):1.f; l_reg*=f; if(hi==0)wsf[r32]=f; resc=true; } } \
    seen=seen||anysel_; \
    SBAR(); \
    GAPB(o[0]=__builtin_amdgcn_mfma_f32_32x32x16_bf16(PAF(0),VFR(0),o[0],0,0,0), C0,0); \
    GAPB(o[1]=__builtin_amdgcn_mfma_f32_32x32x16_bf16(PAF(0),VFR(4),o[1],0,0,0), C0,4); \
    KRD(GL,0); GAPB(o[0]=__builtin_amdgcn_mfma_f32_32x32x16_bf16(PAF(1),VFR(1),o[0],0,0,0), C0,8); \
    KRD(GL,1); GAPB(o[1]=__builtin_amdgcn_mfma_f32_32x32x16_bf16(PAF(1),VFR(5),o[1],0,0,0), C0,12); \
    KRD(GL,2); GAPB(o[0]=__builtin_amdgcn_mfma_f32_32x32x16_bf16(PAF(2),VFR(2),o[0],0,0,0), C1,0); \
    KRD(GL,3); GAPB(o[1]=__builtin_amdgcn_mfma_f32_32x32x16_bf16(PAF(2),VFR(6),o[1],0,0,0), C1,4); \
    GAPB(o[0]=__builtin_amdgcn_mfma_f32_32x32x16_bf16(PAF(3),VFR(3),o[0],0,0,0), C1,8); \
    GAPB(o[1]=__builtin_amdgcn_mfma_f32_32x32x16_bf16(PAF(3),VFR(7),o[1],0,0,0), C1,12); \
    }while(0)
  int t=1;
  for(;t+5<NT;t+=2){
    STEP(pB0,pB1,pA0,pA1,t,true,true,true,O,E);     WAIT_BAR(2); RESC(); ROT();
    STEP(pA0,pA1,pB0,pB1,t+1,true,true,true,E,O);   WAIT_BAR(2); RESC(); ROT();
  }
  #define ENDW(tt) do{ if((tt)+3<NT){WAIT_BAR(2);} else if((tt)+2<NT){WAIT_BAR(1);} else {WAIT_BAR(0);} }while(0)
  for(;t+1<NT;t+=2){
    STEP(pB0,pB1,pA0,pA1,t,(t+3<NT),(t+1<NT),(t+1<NT),O,E);       ENDW(t);   RESC(); ROT();
    STEP(pA0,pA1,pB0,pB1,t+1,(t+4<NT),(t+2<NT),(t+2<NT),E,O);     ENDW(t+1); RESC(); ROT();
  }
  STEP(pB0,pB1,pA0,pA1,NT-1,false,false,false,O,E); RESC();
  { float sacc=pB0[0]+pB0[1]; _Pragma("unroll") for(int r=2;r<16;++r)sacc+=pB0[r]; _Pragma("unroll") for(int r=0;r<16;++r)sacc+=pB1[r]; l_reg+=sacc;
    pw0=(u32x4){PKW(pB0,0),PKW(pB0,2),PKW(pB0,4),PKW(pB0,6)};pw1=(u32x4){PKW(pB0,8),PKW(pB0,10),PKW(pB0,12),PKW(pB0,14)};pw2=(u32x4){PKW(pB1,0),PKW(pB1,2),PKW(pB1,4),PKW(pB1,6)};pw3=(u32x4){PKW(pB1,8),PKW(pB1,10),PKW(pB1,12),PKW(pB1,14)};
    SBAR(); pv(o,vb0+sl_cur,PAF(0),PAF(1),PAF(2),PAF(3)); }
  #undef PKW
  #undef PAF
  #undef VFR
  #undef PIN
  #undef MX3
  #undef GAPA
  #undef GAPB
  #undef EX
  #undef VRD
  #undef KRD
  #undef STEP
  #undef ENDW
  {auto rr=__builtin_amdgcn_permlane32_swap(__float_as_uint(l_reg),__float_as_uint(l_reg),false,false);l_reg=__uint_as_float(rr[0])+__uint_as_float(rr[1]);}
  if(hi==0)wsf[32+r32]=l_reg;asm volatile("s_waitcnt lgkmcnt(0)":::"memory");
  float rli[16];
  #pragma unroll
  for(int r=0;r<16;++r)rli[r]=__builtin_amdgcn_rcpf(wsf[32+crow(r,hi)]);
  bf16*Ow=O+(rowbase+q0+wid*QBLK)*DM+h*D;
  { bf16*stg=(bf16*)(shm+LDS_OST)+wid*2048;
    #pragma unroll
    for(int r=0;r<16;++r){const int orow=crow(r,hi);
      #pragma unroll
      for(int d0=0;d0<2;++d0)stg[orow*64+d0*32+r32]=__float2bfloat16(o[d0][r]*rli[r]);}
    asm volatile("s_waitcnt lgkmcnt(0)":::"memory");
    #pragma unroll
    for(int i=0;i<4;++i){const int row=i*8+(lane>>3),ch=lane&7; const u32x4 v=*(const u32x4*)(stg+row*64+ch*8); ATTN_STORE16(Ow+(long)row*DM+ch*8,v);} }
  asm volatile("s_waitcnt lgkmcnt(0)\n\ts_barrier":::"memory");
  #undef DMA_K
  #undef DMA_V
  #undef CMASK
  #undef SLOWT
  #undef START
  #undef RESC
  #undef ROT
}
constexpr int ATTN_LDS_BYTES=LDS_BYTES;
#undef SBAR
#undef WAIT_BAR
}
constexpr int MK_THREADS = 512;
constexpr int RING_BYTES = 131072, MISC_OFF = RING_BYTES + 320, MK_LDS_BYTES = 147456;
constexpr size_t WS_CTL = 0, CTL_ZERO_BYTES = 65536 + 7 * 131072; constexpr int CW_BAR = 4096;
constexpr int PH_PREP0 = 0, PH_L0 = 1, PH_PER_LAYER = 14, NPH = PH_L0 + 2 * PH_PER_LAYER;
enum { Q_INPROJ = 0, Q_SBIDX, Q_DSA, Q_GATES, Q_MERGE, Q_MIX, Q_NORMXA, Q_XALOG, Q_XAOUT, Q_NORMFFN, Q_UP, Q_FFNMID, Q_DOWN, Q_NEXT };

#ifndef QBUILD
#define QBUILD 0xffffu
#endif
#define QON(x) ((QBUILD >> (x)) & 1u)
struct Args { const float* in[20]; float* out; unsigned char* ws; int ph_lo, ph_hi; };

__global__ void __launch_bounds__(MK_THREADS, 2) mk_fwd(Args args) {
    __shared__ __attribute__((aligned(16))) unsigned char lds_raw[MK_LDS_BYTES];
    LAS unsigned char* lds = (LAS unsigned char*)lds_raw;
    volatile LAS unsigned* MISC = (volatile LAS unsigned*)(lds + MISC_OFF);
    const int G = gridDim.x, bx = blockIdx.x;
    unsigned char* ws0 = args.ws;
    const int wave_s = __builtin_amdgcn_readfirstlane((int)threadIdx.x >> 6);
    for (int u = mk_tid(wave_s); u < (MK_LDS_BYTES - RING_BYTES) / 4; u += MK_THREADS) ((LAS unsigned*)(lds + RING_BYTES))[u] = 0u;
    __syncthreads();
    const int lo = args.ph_lo, hi = args.ph_hi;
    XcdBarrier bar; bar.bar = (unsigned*)(ws0 + WS_CTL) + CW_BAR; bar.x = 0; bar.st = nullptr;
    if (hi - lo > 1) bar = xcd_barrier_post((unsigned*)(ws0 + WS_CTL) + CW_BAR, MISC + 8, mk_tid(wave_s));
#define BPW(off) ((bf16_t*)(ws + (off)))
    const int vcu = (G % 8 == 0) ? (bx % 8) * (G / 8) + bx / 8 : bx;
    for (int p = lo; p < hi; ++p) {
#ifdef PROBE_REP
        const int reps = (p >= PH_L0 && ((PROBE_REP >> ((p - PH_L0) % PH_PER_LAYER)) & 1)) ? 2 : 1;
#else
        const int reps = 1;
#endif
#ifdef PROBE_REP
#pragma unroll 1
        for (int rep = 0; rep < reps; ++rep) {
        const bool dry = rep + 1 < reps;
#else
        { constexpr bool dry = false;
#endif
        int oz = 0; asm volatile("" : "+s"(oz));
        int tid = mk_tid(wave_s); asm volatile("" : "+v"(tid));
        const int wave = __builtin_amdgcn_readfirstlane(tid >> 6), lane = tid & 63;
        WaveId W; W.gw = vcu * 8 + wave; W.ngw = G * 8; W.wave = wave; W.lane = lane;
        unsigned char* ws = args.ws + oz; float* X = args.out + oz;
#define INP(k) (args.in[(k) + oz])
        if (p == PH_PREP0) {
            prep0_phase(W, (LAS float*)(lds + wave * 16384), ws, args.in + oz, (bf16_t*)X);
        } else if (p >= PH_L0) {
            const int l = (p - PH_L0) / PH_PER_LAYER, q = (p - PH_L0) % PH_PER_LAYER;
            const float* Xin = l == 0 ? INP(0) : X;
            pg8::u64* SSb = (pg8::u64*)(ws + WS_SS);
#define SSA(i) (SSb + (size_t)(i) * T)
            if (q == Q_SBIDX) {
#ifndef NO_SB
                sb_phase(W, lds, ws, dry);
#endif
                __syncthreads();
#ifndef NO_IDX
#ifdef PROBE_SB_ONLY
                if (!dry)
#endif
                idx_phase(lds, ws, vcu, G, wave, lane);
#endif
                conv_sc_phase(vcu * MK_THREADS + tid, G * MK_THREADS, BPW(WS_SCB), BPW(WS_CX), INP(4) + l * 3 * 512, dry);
                kn_phase(W, BPW(WS_KC), (float*)(ws + WS_KN));
                if (l == 0 && !dry && QON(15)) {
                    __syncthreads();
                    { pg8::Order S; S.init(1, 4, 16, G, bx); pg8::PtrG P{(const char*)(ws + WS_KVM), (const char*)(ws + WS_WQ)}; pg8::EpiPrep E{ws, 1};
                      pg8::gemm_phase<pg8::EpiPrep, pg8::PtrG, true, true>(lds, tid, 2 * D, D, 256, S, P, E); }
                    { pg8::Order S; S.init(4, 1, 16, G, (bx + 64) % G); pg8::PtrH P{(const char*)(ws + WS_KVM), (const char*)(ws + WS_WOT)}; pg8::EpiPrep E{ws, 2};
                      pg8::gemm_phase<pg8::EpiPrep, pg8::PtrH, true, true>(lds, tid, D, 2 * D, 256, S, P, E); }
                }
            } else if (q == Q_DSA) {
#ifndef NO_DSA
                {
                    for (int pr = vcu; pr < NB * 8 * 16; pr += G) { const int bh = pr >> 4, sx = pr & 15, bb = bh >> 3, hh = bh & 7;
#pragma unroll 1
                        for (int k2 = 0; k2 < 2; ++k2)
                            attn_body::attn_unit<8>(bb, hh, k2 == 0 ? sx : 31 - sx, (const attn_body::bf16*)BPW(WS_QC), (const attn_body::bf16*)BPW(WS_KC), (const attn_body::bf16*)BPW(WS_VC),
                                                    (attn_body::bf16*)(dry ? BPW(WS_KA) : BPW(WS_QC)), (char*)lds_raw, (const unsigned*)(ws + WS_BM) + (size_t)bb * 256 * S,
                                                    (const float*)(ws + WS_KN) + bh * (S / 64), tid); }
                }
#endif
            } else if (q == Q_FFNMID) {
            } else if (q == Q_NEXT) {
                if (l + 1 < DEPTH) { int base = 0; convert_layer_weights(W, (LAS float*)(lds + wave * 16384), base, ws, args.in + oz, l + 1); }
                else if (!dry) final_norm(W, BPW(WS_XN), X, INP(19), SSA(6));
            } else if (q == Q_INPROJ && QON(Q_INPROJ)) {
                pg8::Order S; S.init(T / 256, NIN / 256, 1, G, bx);
                pg8::PtrStd P{(const char*)X, (const char*)(ws + WS_WIN), 0, 0, 0, (size_t)256 * D * 2, (size_t)256 * D * 2};
                pg8::EpiInProj E{ws, SSA(3 * l)};
                pg8::gemm_phase<pg8::EpiInProj, pg8::PtrStd, true, true>(lds, tid, D, D, D, S, P, E);
                if (l == 0 && !dry && QON(14)) {
                    pg8::Order S2; S2.init(2, 8, 2, G, (bx + G - 64) % G);
                    pg8::PtrStd P2{(const char*)(ws + WS_MEMN), (const char*)(ws + WS_WKVT), 1 * MiB, 4 * MiB, 0, (size_t)256 * D * 2, (size_t)256 * D * 2};
                    pg8::EpiPrep E2{ws, 0};
                    pg8::gemm_phase<pg8::EpiPrep, pg8::PtrStd, true, true>(lds, tid, D, D, D, S2, P2, E2);
                }
            } else if (q == Q_GATES && QON(Q_GATES)) {
                pg8::Order S; S.init(T / 256, 12, 1, G, bx);
                pg8::PtrStd P{(const char*)X, (const char*)(ws + WS_WG), 0, 0, 0, (size_t)256 * D * 2, (size_t)256 * D * 2};
                pg8::EpiGates E{BPW(WS_GATES), SSA(3 * l)};
                pg8::gemm_phase<pg8::EpiGates, pg8::PtrStd, true, true>(lds, tid, D, D, D, S, P, E);
            } else if (q == Q_MERGE && QON(Q_MERGE)) {
                pg8::Order S; S.init(T / 256, 4, 3, G, bx);
                pg8::PtrStd P{(const char*)(ws + WS_QA), (const char*)(ws + WS_WBR), 16 * MiB, (size_t)D * 512 * 2, 0, (size_t)256 * 512 * 2, (size_t)256 * 512 * 2};
                pg8::EpiMergeC E{BPW(WS_XN), BPW(WS_GATES)};
                pg8::gemm_phase<pg8::EpiMergeC, pg8::PtrStd, true, true>(lds, tid, 512, 512, 512, S, P, E);
            } else if (q == Q_MIX && QON(Q_MIX)) {
                pg8::Order S; S.init(T / 256, 4, 1, G, bx);
                pg8::PtrStd P{(const char*)(ws + WS_XN), (const char*)(ws + WS_WMIX), 0, 0, 0, (size_t)256 * D * 2, (size_t)256 * D * 2};
                if (l == 0) { pg8::EpiResid<true> E{(const void*)INP(0), dry ? BPW(WS_FU) : BPW(WS_XBXA), dry ? SSA(0) : SSA(1)};
                    pg8::gemm_phase<pg8::EpiResid<true>, pg8::PtrStd, true, true>(lds, tid, D, D, D, S, P, E); }
                else { pg8::EpiResid<false> E{(const void*)X, dry ? BPW(WS_FU) : BPW(WS_XBXA), dry ? SSA(0) : SSA(4)};
                    pg8::gemm_phase<pg8::EpiResid<false>, pg8::PtrStd, true, true>(lds, tid, D, D, D, S, P, E); }

            } else if (q == Q_XALOG && QON(Q_XALOG)) {
                pg8::Order S; S.init(T / 256, 4, 1, G, bx);
                pg8::PtrStd P{(const char*)(ws + WS_XBXA), (const char*)(ws + WS_GT + (size_t)l * 4 * MiB), 0, 0, 2 * MiB, (size_t)256 * D * 2, (size_t)256 * D * 2};
                pg8::EpiSoftmax E{BPW(WS_PXA), SSA(1 + 3 * l)};
                pg8::gemm_phase<pg8::EpiSoftmax, pg8::PtrStd, false, true>(lds, tid, D, D, D, S, P, E);
            } else if (q == Q_XAOUT && QON(Q_XAOUT)) {
                pg8::Order S; S.init(T / 256, 4, 1, G, bx);
                pg8::PtrStd P{(const char*)(ws + WS_PXA), (const char*)(ws + WS_HT + (size_t)l * 4 * MiB), 0, 0, 2 * MiB, (size_t)256 * D * 2, (size_t)256 * D * 2};
                pg8::EpiResid<false> E{(const void*)BPW(WS_XBXA), dry ? BPW(WS_FU) : BPW(WS_XN), dry ? SSA(0) : SSA(2 + 3 * l)};
                pg8::gemm_phase<pg8::EpiResid<false>, pg8::PtrStd, true, true>(lds, tid, D, D, D, S, P, E);
            } else if (q == Q_UP && QON(Q_UP)) {
                pg8::Order S; S.init(T / 256, 22, 1, G, bx);
                pg8::PtrStd P{(const char*)(ws + WS_XN), (const char*)(ws + WS_WUP), 0, 0, 0, (size_t)256 * D * 2, (size_t)256 * D * 2};
                pg8::EpiUpF E{BPW(WS_FU), BPW(WS_SIDEA), BPW(WS_SIDEU), SSA(2 + 3 * l), INP(16) + l * 3 * DFF, INP(17) + l * DFF};
                pg8::gemm_phase<pg8::EpiUpF, pg8::PtrStd, true, true>(lds, tid, D, D, D, S, P, E);
            } else if (q == Q_DOWN && QON(Q_DOWN)) {
                pg8::Order S; S.init(T / 256, 4, 1, G, bx);
                if (!dry) {
#pragma unroll 1
                    for (int i = 0; ; ++i) { pg8::Unit u0; if (!S.next(i, u0)) break; ffn_fix_phase(tid, MK_THREADS, BPW(WS_SIDEA), BPW(WS_SIDEU), BPW(WS_FU), INP(16) + l * 3 * DFF, INP(17) + l * DFF, 4 * u0.pm, 4); }
                    asm volatile("s_waitcnt vmcnt(0)" ::: "memory"); __syncthreads();
                }
                pg8::PtrStd P{(const char*)(ws + WS_FU), (const char*)(ws + WS_WDOWN), 0, 0, 0, (size_t)256 * DFF * 2, (size_t)256 * DFF * 2};
                pg8::EpiResid<false> E{(const void*)BPW(WS_XN), dry ? BPW(WS_QA) : (l + 1 < DEPTH ? (bf16_t*)X : BPW(WS_XN)), dry ? SSA(0) : SSA(3 + 3 * l)};
                pg8::gemm_phase<pg8::EpiResid<false>, pg8::PtrStd, true, true>(lds, tid, DFF, DFF, DFF, S, P, E);
            }
        }
        }
        if (p + 1 < hi && !(p >= PH_L0 && ((p - PH_L0) % PH_PER_LAYER == Q_NORMXA || (p - PH_L0) % PH_PER_LAYER == Q_NORMFFN || (p - PH_L0) % PH_PER_LAYER == Q_FFNMID))) xcd_barrier(bar, mk_tid(wave_s));
    }
}

extern "C" void kernel_launch(void* const* d_in, const int* in_sizes, int n_in, void* d_out, int out_size, void* d_ws, size_t ws_size, hipStream_t st) {
    if (n_in != 20 || ws_size < WS_NEED || out_size != T * D) { fprintf(stderr, "kernel_launch: unexpected sizes n_in %d ws %zu out %d\n", n_in, ws_size, out_size); return; }
    static int grid = 0;
    if (grid == 0) {
        int dev = 0, cus = 0, per_cu = 0;
        (void)hipGetDevice(&dev); (void)hipDeviceGetAttribute(&cus, hipDeviceAttributeMultiprocessorCount, dev);
        if (hipOccupancyMaxActiveBlocksPerMultiprocessor(&per_cu, (const void*)mk_fwd, MK_THREADS, 0) != hipSuccess || per_cu < 1) { fprintf(stderr, "kernel_launch: occupancy query says %d blocks/CU\n", per_cu); grid = -1; return; }
        (void)hipGetLastError();
        if (cus != 256) { fprintf(stderr, "kernel_launch: built for a 256-CU device, found %d\n", cus); grid = -1; return; }
        grid = cus;
    }
    if (grid < 0) return;
    (void)hipMemsetAsync((char*)d_ws + WS_CTL, 0, CTL_ZERO_BYTES, st);
    Args a{};
    for (int i = 0; i < 20; ++i) a.in[i] = (const float*)d_in[i];
    a.out = (float*)d_out; a.ws = (unsigned char*)d_ws; a.ph_lo = 0; a.ph_hi = NPH;
    hipLaunchKernelGGL(mk_fwd, dim3(grid), dim3(MK_THREADS), 0, st, a);
}
```

```cpp
#include <hip/hip_runtime.h>
#include <stdint.h>
#include <stdio.h>

typedef unsigned short bf16_t;
typedef short bf16x8 __attribute__((ext_vector_type(8)));
typedef float f32x16 __attribute__((ext_vector_type(16)));
typedef float f32x4 __attribute__((ext_vector_type(4)));
#define DEV __device__ __forceinline__

constexpr int NB = 2, S = 8192, D = 1024, T = NB * S, DEPTH = 2;
constexpr int DIN = 8264, DFF = 2816, MEM = 256;
constexpr int NIN = 5376;
constexpr float LOG2E = 1.4426950408889634f;
constexpr float QSCALE = 0.125f * LOG2E;
constexpr float WSCALE = 0.125f * 0.35355339059327373f;
constexpr float XSCALE = 0.0625f * LOG2E;
constexpr float EPS = 1e-6f;
#ifndef MK_FUSE
#define MK_FUSE 1
#endif

constexpr size_t MiB = 1u << 20;
constexpr size_t WS_SIDEA = 88 * MiB, WS_SIDEU = 96 * MiB;
constexpr size_t WS_KN = 983040;
constexpr size_t WS_GT = 1 * MiB;
constexpr size_t WS_HT = 9 * MiB;
constexpr size_t WS_WUP = 17 * MiB, WS_WDOWN = 28 * MiB;
constexpr size_t WS_XN = 34 * MiB;
constexpr size_t WS_WMIX = 66 * MiB, WS_WBR = 68 * MiB, WS_WG = 71 * MiB, WS_WIN = 77 * MiB;
constexpr size_t WS_QA = 88 * MiB, WS_SCB = 104 * MiB, WS_QC = 120 * MiB, WS_KA = 136 * MiB, WS_VA = 152 * MiB, WS_KC = 168 * MiB, WS_VC = 184 * MiB,
                 WS_IQ = 200 * MiB, WS_CX = 216 * MiB, WS_IK = 232 * MiB, WS_IW = 234 * MiB, WS_BM = 235 * MiB;
constexpr size_t WS_GATES = 136 * MiB;
constexpr size_t WS_XTMP = 235 * MiB;
constexpr size_t WS_LOG = 88 * MiB, WS_PXA = 168 * MiB;
constexpr size_t WS_XBXA = 136 * MiB;
constexpr size_t WS_SS = 65536;
constexpr size_t WS_FA = 66 * MiB, WS_FU = 154 * MiB;
constexpr size_t WS_WQ = 34 * MiB  , WS_WOT = 38 * MiB  , WS_WKVT = 42 * MiB  , WS_MEMN = 50 * MiB  , WS_KVM = 52 * MiB  ;
constexpr size_t WS_NEED = 256 * MiB;

DEV bf16_t f2bf(float f) { unsigned u = __float_as_uint(f); u += 0x7fffu + ((u >> 16) & 1u); return (bf16_t)(u >> 16); }
DEV float bf2f(bf16_t h) { return __uint_as_float(((unsigned)h) << 16); }
DEV float wave_sum(float v) {
#pragma unroll
    for (int o = 1; o < 64; o <<= 1) v += __shfl_xor(v, o);
    return v;
}
DEV float wave_max(float v) {
#pragma unroll
    for (int o = 1; o < 64; o <<= 1) v = fmaxf(v, __shfl_xor(v, o));
    return v;
}


#define LAS __attribute__((address_space(3)))
#define GAS __attribute__((address_space(1)))
typedef unsigned u32x4 __attribute__((ext_vector_type(4)));
typedef unsigned u32x2 __attribute__((ext_vector_type(2)));
typedef float f32x2 __attribute__((ext_vector_type(2)));
#define LDS_WAIT() asm volatile("s_waitcnt lgkmcnt(0)" ::: "memory")
DEV int mk_tid(int wave_s) { unsigned ones = ~0u; asm volatile("" : "+s"(ones)); return wave_s * 64 + (int)__builtin_amdgcn_mbcnt_hi(ones, __builtin_amdgcn_mbcnt_lo(ones, 0u)); }
#define VM_WAIT() asm volatile("s_waitcnt vmcnt(0)" ::: "memory")
typedef __bf16 bf16x2_t __attribute__((ext_vector_type(2)));
DEV unsigned cvt_pk_bf16(float lo, float hi) { const f32x2 v = {lo, hi}; return __builtin_bit_cast(unsigned, __builtin_convertvector(v, bf16x2_t)); }
DEV float bflo(unsigned w) { return __uint_as_float(w << 16); }
DEV float bfhi(unsigned w) { return __uint_as_float(w & 0xffff0000u); }

namespace pg8 {
constexpr int BM = 256, BK = 64, HALF = 128, HTB = HALF * BK * 2, STAGE_BYTES = 8 * HTB, NXCD = 8, WGM = 4;
__host__ __device__ __forceinline__ int lds_byte(int r, int c) { const int st = (r >> 4) * 2 + (c >> 5), rr = r & 15, cc = c & 31, ob = rr * 64 + cc * 2; return st * 1024 + (ob ^ (((ob >> 9) & 1) << 5)); }
__host__ __device__ __forceinline__ void stage_rc(int b, int& R, int& C) { const int st = b / 1024, sb = b % 1024, swz = sb ^ (((sb >> 9) & 1) << 5); R = (st >> 1) * 16 + swz / 64; C = (st & 1) * 32 + (swz % 64) / 2; }
__host__ __device__ __forceinline__ int perm32(int rho) { const int n = rho >> 4, i = rho & 15; return 8 * (i >> 2) + 4 * n + (i & 3); }

struct Unit { int pm, pn, job; };
struct Order {
    int nM, nN, nwg, ntot, G, c;
    DEV void init(int nM_, int nN_, int njob, int G_, int c_) { nM = nM_; nN = nN_; nwg = nM * nN; ntot = nwg * njob; G = G_; c = c_; }
    DEV bool next(int i, Unit& u) const {
        const int L = i * G + c; if (L >= ntot) return false;
        u.job = L / nwg; int wgid = L - u.job * nwg;
        { const int q = nwg / NXCD, r = nwg % NXCD, xcd = wgid % NXCD, off = wgid / NXCD; wgid = (xcd < r ? xcd * (q + 1) : r * (q + 1) + (xcd - r) * q) + off; }
        const int nig = WGM * nN, gid = wgid / nig, fm = gid * WGM, gsz = (nM - fm) < WGM ? (nM - fm) : WGM;
        u.pm = fm + ((wgid % nig) % gsz); u.pn = (wgid % nig) / gsz; return true;
    }
};
template <class T, class = void> struct epi_chain { static constexpr bool value = false; };
template <class T> struct epi_chain<T, decltype((void)T::CHAIN)> { static constexpr bool value = T::CHAIN; };
template <class Epi, class Ptr, bool ALIGN_EPI, bool SP2>
DEV void gemm_phase(LAS unsigned char* lds, const int tid_in, const int lda, const int ldb, const int K, const Order& S, const Ptr& P, const Epi& E) {
    int tid_ = tid_in; asm volatile("" : "+v"(tid_));
    const int tid = tid_, wid = __builtin_amdgcn_readfirstlane(tid >> 6), lane = tid & 63, wr = wid >> 2, wc = wid & 3, fr = lane & 15, fq = lane >> 4;
    const int nt = K / BK;
    unsigned voffA[2], voffB[2];
#pragma unroll
    for (int i = 0; i < 2; ++i) { int R, C; stage_rc(tid * 16 + i * 8192, R, C); const int Rb = Epi::PERM ? ((R & ~31) + perm32(R & 31)) : R;
        voffA[i] = (unsigned)(R * lda + C) * 2u; voffB[i] = (unsigned)(Rb * ldb + C) * 2u; }
    const size_t kstep = (size_t)(BK * 2);
    const size_t hstepA = (size_t)HALF * lda * 2, hstepB = (size_t)HALF * ldb * 2;
    const unsigned ldsw = (unsigned)wid * 1024u;
    const int aoff = lds_byte(wr * 64 + fr, fq * 8), boff = lds_byte(wc * 32 + fr, fq * 8);
#define PG8_SA(b, h) (((b) * 2 + (h)) * HTB)
#define PG8_SB(b, h) ((4 + (b) * 2 + (h)) * HTB)
#define PG8_STAGE(bufoff, gbase, voff) do { _Pragma("unroll") for (int _i = 0; _i < 2; ++_i) \
        __builtin_amdgcn_global_load_lds((const unsigned*)((const char*)(gbase) + (voff)[_i]), (LAS unsigned*)(lds + (bufoff) + ldsw + _i * 8192), 16, 0, 0); } while (0)
#define PG8_LDA(dst, b, h) do { _Pragma("unroll") for (int m = 0; m < 4; ++m) _Pragma("unroll") for (int k = 0; k < 2; ++k) dst[m][k] = *(const LAS bf16x8*)(lds + PG8_SA(b, h) + aoff + m * 2048 + k * 1024); } while (0)
#define PG8_LDB(dst, b, h) do { _Pragma("unroll") for (int n = 0; n < 2; ++n) _Pragma("unroll") for (int k = 0; k < 2; ++k) dst[n][k] = *(const LAS bf16x8*)(lds + PG8_SB(b, h) + boff + n * 2048 + k * 1024); } while (0)
#define PG8_MMA(ai, bj, At, Bt) do { __builtin_amdgcn_s_setprio(1); _Pragma("unroll") for (int m = 0; m < 4; ++m) _Pragma("unroll") for (int n = 0; n < 2; ++n) _Pragma("unroll") for (int k = 0; k < 2; ++k) \
        acc[ai][bj][m][n] = __builtin_amdgcn_mfma_f32_16x16x32_bf16(Bt[n][k], At[m][k], acc[ai][bj][m][n], 0, 0, 0); __builtin_amdgcn_s_setprio(0); } while (0)
#define PG8_WAIT_V(n) asm volatile("s_waitcnt vmcnt(" #n ")" ::: "memory")
#define PG8_WAIT_L(n) asm volatile("s_waitcnt lgkmcnt(" #n ")" ::: "memory")
#define PG8_BAR __builtin_amdgcn_s_barrier()
#define PG8_SCHED __builtin_amdgcn_sched_barrier(0)
    Unit cur, nxt; int ui = 0;
    if (!S.next(0, cur)) return;
    f32x4 acc[2][2][4][2];
#pragma unroll
    for (int a = 0; a < 2; ++a)
#pragma unroll
        for (int b = 0; b < 2; ++b)
#pragma unroll
            for (int m = 0; m < 4; ++m)
#pragma unroll
                for (int n = 0; n < 2; ++n) acc[a][b][m][n] = (f32x4){0.f, 0.f, 0.f, 0.f};
    bf16x8 At[4][2], B0[2][2], B1[2][2];
    const char* cA = P.a(cur); const char* cB = P.b(cur);
    typename Epi::Pre pre; E.prefetch(pre, cur, wr, fr);
    if constexpr (SP2) {
        PG8_STAGE(PG8_SB(0, 0), cB, voffB); PG8_STAGE(PG8_SB(0, 1), cB + hstepB, voffB); PG8_STAGE(PG8_SA(0, 0), cA, voffA); PG8_STAGE(PG8_SA(0, 1), cA + hstepA, voffA);
        if (wr == 1) PG8_BAR;
        PG8_WAIT_V(2); PG8_BAR;
        PG8_STAGE(PG8_SB(1, 0), cB + kstep, voffB); PG8_STAGE(PG8_SA(1, 0), cA + kstep, voffA); PG8_STAGE(PG8_SB(1, 1), cB + hstepB + kstep, voffB);
        PG8_WAIT_V(6); PG8_BAR;
    } else {
        PG8_STAGE(PG8_SB(0, 0), cB, voffB); PG8_STAGE(PG8_SA(0, 0), cA, voffA); PG8_STAGE(PG8_SB(0, 1), cB + hstepB, voffB); PG8_STAGE(PG8_SA(0, 1), cA + hstepA, voffA);
        if (wr == 1) PG8_BAR;
        PG8_WAIT_V(4); PG8_BAR;
        PG8_STAGE(PG8_SB(1, 0), cB + kstep, voffB); PG8_STAGE(PG8_SA(1, 0), cA + kstep, voffA); PG8_STAGE(PG8_SB(1, 1), cB + hstepB + kstep, voffB);
        PG8_WAIT_V(6); PG8_BAR;
    }
#pragma unroll 1
    for (;;) {
        const bool has_next = S.next(ui + 1, nxt);
        const char* nA = has_next ? P.a(nxt) : cA; const char* nB = has_next ? P.b(nxt) : cB;
#pragma unroll 1
        for (int t = 0; t < nt; t += 2) {
            const bool last = (t == nt - 2);
            const char* a1 = cA + (size_t)(t + 1) * kstep;
            const char* a2 = last ? nA : cA + (size_t)(t + 2) * kstep; const char* b2 = last ? nB : cB + (size_t)(t + 2) * kstep;
            const char* a3 = a2 + kstep; const char* b3 = b2 + kstep;
            if constexpr (SP2) {
            PG8_LDB(B0, 0, 0); PG8_LDB(B1, 0, 1); PG8_SCHED; PG8_LDA(At, 0, 0); PG8_STAGE(PG8_SA(1, 1), a1 + hstepA, voffA);
            PG8_WAIT_V(8); PG8_WAIT_L(0); PG8_BAR; PG8_MMA(0, 0, At, B0); PG8_MMA(0, 1, At, B1); PG8_BAR; PG8_SCHED;
            PG8_LDA(At, 0, 1); PG8_STAGE(PG8_SB(0, 0), b2, voffB); PG8_STAGE(PG8_SB(0, 1), b2 + hstepB, voffB); PG8_STAGE(PG8_SA(0, 0), a2, voffA);
            PG8_WAIT_V(8); PG8_WAIT_L(0); PG8_BAR; PG8_MMA(1, 0, At, B0); PG8_MMA(1, 1, At, B1); PG8_BAR; PG8_SCHED;
            PG8_LDB(B0, 1, 0); PG8_LDB(B1, 1, 1); PG8_SCHED; PG8_LDA(At, 1, 0); PG8_STAGE(PG8_SA(0, 1), a2 + hstepA, voffA);
            PG8_WAIT_V(8); PG8_WAIT_L(0); PG8_BAR; PG8_MMA(0, 0, At, B0); PG8_MMA(0, 1, At, B1); PG8_BAR; PG8_SCHED;
            PG8_LDA(At, 1, 1); PG8_STAGE(PG8_SB(1, 0), b3, voffB); PG8_STAGE(PG8_SB(1, 1), b3 + hstepB, voffB); PG8_STAGE(PG8_SA(1, 0), a3, voffA);
            PG8_WAIT_V(8); PG8_WAIT_L(0); PG8_BAR; PG8_MMA(1, 0, At, B0); PG8_MMA(1, 1, At, B1); PG8_BAR; PG8_SCHED;
            } else {
            PG8_LDB(B0, 0, 0); PG8_SCHED; PG8_LDA(At, 0, 0); PG8_STAGE(PG8_SA(1, 1), a1 + hstepA, voffA);
            PG8_WAIT_L(8); PG8_BAR; PG8_WAIT_L(0); PG8_MMA(0, 0, At, B0); PG8_BAR; PG8_SCHED;
            PG8_LDB(B1, 0, 1); PG8_STAGE(PG8_SB(0, 0), b2, voffB);
            PG8_BAR; PG8_WAIT_L(0); PG8_MMA(0, 1, At, B1); PG8_BAR;
            PG8_LDA(At, 0, 1); PG8_STAGE(PG8_SA(0, 0), a2, voffA);
            PG8_BAR; PG8_WAIT_L(0); PG8_MMA(1, 0, At, B0); PG8_BAR; PG8_SCHED;
            PG8_STAGE(PG8_SB(0, 1), b2 + hstepB, voffB);
            PG8_WAIT_V(6); PG8_BAR; PG8_MMA(1, 1, At, B1); PG8_BAR;
            PG8_LDB(B0, 1, 0); PG8_SCHED; PG8_LDA(At, 1, 0); PG8_STAGE(PG8_SA(0, 1), a2 + hstepA, voffA);
            PG8_WAIT_L(8); PG8_BAR; PG8_WAIT_L(0); PG8_MMA(0, 0, At, B0); PG8_BAR; PG8_SCHED;
            PG8_LDB(B1, 1, 1); PG8_STAGE(PG8_SB(1, 0), b3, voffB);
            PG8_BAR; PG8_WAIT_L(0); PG8_MMA(0, 1, At, B1); PG8_BAR;
            PG8_LDA(At, 1, 1); PG8_STAGE(PG8_SA(1, 0), a3, voffA);
            PG8_BAR; PG8_WAIT_L(0); PG8_MMA(1, 0, At, B0); PG8_BAR; PG8_SCHED;
            PG8_STAGE(PG8_SB(1, 1), b3 + hstepB, voffB);
            PG8_WAIT_V(6); PG8_BAR; PG8_MMA(1, 1, At, B1); PG8_BAR;
            }
        }
        if constexpr (ALIGN_EPI) { if (wr == 0) PG8_BAR; }
        if constexpr (!Epi::AFTER_DRAIN) { int fr_ = fr, fq_ = fq; asm volatile("" : "+v"(fr_), "+v"(fq_));
            E(acc, cur, wr, wc, fr_, fq_, pre); }
        if (!has_next) break;
        if (!epi_chain<Epi>::value || nxt.job == 0) {
#pragma unroll
        for (int a = 0; a < 2; ++a)
#pragma unroll
            for (int b = 0; b < 2; ++b)
#pragma unroll
                for (int m = 0; m < 4; ++m)
#pragma unroll
                    for (int n = 0; n < 2; ++n) acc[a][b][m][n] = (f32x4){0.f, 0.f, 0.f, 0.f};
        }
        cur = nxt; cA = nA; cB = nB; ++ui; E.prefetch(pre, cur, wr, fr);
        if constexpr (ALIGN_EPI) { if (wr == 1) PG8_BAR; }
    }
    PG8_WAIT_V(0);
    if constexpr (!ALIGN_EPI) { if (wr == 0) PG8_BAR; }
    PG8_BAR;
    if constexpr (Epi::AFTER_DRAIN) { int fr_ = fr, fq_ = fq, lane_ = lane; asm volatile("" : "+v"(fr_), "+v"(fq_), "+v"(lane_)); E.fused(acc, cur, wr, wc, fr_, fq_, lds, wid, lane_, pre); }
#undef PG8_SA
#undef PG8_SB
#undef PG8_STAGE
#undef PG8_LDA
#undef PG8_LDB
#undef PG8_MMA
#undef PG8_WAIT_V
#undef PG8_WAIT_L
#undef PG8_BAR
#undef PG8_SCHED
}
typedef f32x4 Acc[2][2][4][2];

struct PtrStd {
    const char* A; const char* B; size_t aj, bj, bb, arow, brow;
    DEV const char* a(const Unit& u) const { return A + (size_t)u.job * aj + (size_t)u.pm * arow; }
    DEV const char* b(const Unit& u) const { return B + (size_t)u.job * bj + (size_t)(u.pm >> 5) * bb + (size_t)u.pn * brow; }
};
struct PtrG {
    const char* KVM; const char* WQ;
    DEV const char* a(const Unit& u) const { return KVM + (size_t)(u.job >> 2) * MiB + (size_t)(u.job & 3) * 512; }
    DEV const char* b(const Unit& u) const { return WQ + (size_t)(u.job >> 3) * 2 * MiB + (size_t)(u.job & 3) * 512 + (size_t)u.pn * 256 * 1024 * 2; }
};
struct PtrH {
    const char* KVM; const char* WOT;
    DEV const char* a(const Unit& u) const { return WOT + (size_t)(u.job >> 3) * 2 * MiB + (size_t)(u.job & 3) * 512 + (size_t)u.pm * 256 * 1024 * 2; }
    DEV const char* b(const Unit& u) const { return KVM + (size_t)(u.job >> 2) * MiB + 2048 + (size_t)(u.job & 3) * 512; }
};

#define EPI_ROWS(u) const int row0 = (u).pm * BM + wr * 64 + fr
DEV u32x4 pack8(const f32x4 v0, const f32x4 v1) { u32x4 w; w.x = cvt_pk_bf16(v0[0], v0[1]); w.y = cvt_pk_bf16(v0[2], v0[3]); w.z = cvt_pk_bf16(v1[0], v1[1]); w.w = cvt_pk_bf16(v1[2], v1[3]); return w; }

struct PreNone {};
typedef unsigned long long u64;
constexpr float SS_SCALE = 65536.f;
struct PreRs { u64 v[2][4]; };
DEV void pre_rs(PreRs& p, const u64* ss, int row0) {
#pragma unroll
    for (int ai = 0; ai < 2; ++ai)
#pragma unroll
        for (int m = 0; m < 4; ++m) p.v[ai][m] = __builtin_nontemporal_load(ss + row0 + ai * HALF + m * 16);
}
DEV void rs_of(float (&rs)[2][4], const PreRs& p) {
#pragma unroll
    for (int ai = 0; ai < 2; ++ai)
#pragma unroll
        for (int m = 0; m < 4; ++m) rs[ai][m] = rsqrtf((float)p.v[ai][m] * (1.f / (SS_SCALE * D)) + EPS);
}
struct EpiInProj {
    typedef PreRs Pre;
    DEV void prefetch(PreRs& p, const Unit& u, int wr, int fr) const { pre_rs(p, ss, u.pm * BM + wr * 64 + fr); }
    static constexpr bool PERM = true, AFTER_DRAIN = false;
    unsigned char* ws; const u64* ss;
    DEV void operator()(const Acc& acc, const Unit& u, int wr, int wc, int fr, int fq, const PreRs& pre) const {
        EPI_ROWS(u); const int pn = u.pn, cb = wc * 32 + 8 * fq;
        float rs[2][4]; rs_of(rs, pre);
        if (pn < 16) {
            const int g = pn >> 1;
            const size_t off = g == 0 ? WS_QA : g == 1 ? WS_KA : g == 2 ? WS_VA : g == 3 ? WS_QC : g == 4 ? WS_KC : g == 5 ? WS_VC : g == 6 ? WS_IQ : WS_SCB;
            const float sc = (g == 0 || g == 3) ? QSCALE : 1.f;
            bf16_t* base = (bf16_t*)(ws + off) + (pn & 1) * 256 + cb;
#pragma unroll
            for (int ai = 0; ai < 2; ++ai)
#pragma unroll
                for (int m = 0; m < 4; ++m) { bf16_t* rowp = base + (size_t)(row0 + ai * HALF + m * 16) * 512;
#pragma unroll
                    for (int bj = 0; bj < 2; ++bj) *(u32x4*)(rowp + bj * HALF) = pack8(acc[ai][bj][m][0] * (sc * rs[ai][m]), acc[ai][bj][m][1] * (sc * rs[ai][m])); }
        } else if (pn < 20) {
            bf16_t* base = (bf16_t*)(ws + WS_CX) + (pn - 16) * 128 + cb;
#pragma unroll
            for (int ai = 0; ai < 2; ++ai)
#pragma unroll
                for (int m = 0; m < 4; ++m) { const float r2 = rs[ai][m] * rs[ai][m]; *(u32x4*)(base + (size_t)(row0 + ai * HALF + m * 16) * 512) = pack8(acc[ai][0][m][0] * acc[ai][1][m][0] * r2, acc[ai][0][m][1] * acc[ai][1][m][1] * r2); }
        } else {
            if (wc < 2) { bf16_t* base = (bf16_t*)(ws + WS_IK);
#pragma unroll
                for (int ai = 0; ai < 2; ++ai)
#pragma unroll
                    for (int m = 0; m < 4; ++m) { const int t = row0 + ai * HALF + m * 16;
                        *(u32x4*)(base + (size_t)(t >> 5) * 2048 + (((cb >> 3) * 32 + (t & 31)) * 8)) = pack8(acc[ai][0][m][0] * rs[ai][m], acc[ai][0][m][1] * rs[ai][m]); }
            } else if (wc == 2 && fq == 0) { float* base = (float*)(ws + WS_IW);
#pragma unroll
                for (int ai = 0; ai < 2; ++ai)
#pragma unroll
                    for (int m = 0; m < 4; ++m) { float* p = base + (size_t)(row0 + ai * HALF + m * 16) * 8; *(f32x4*)p = acc[ai][0][m][0] * (WSCALE * rs[ai][m]); *(f32x4*)(p + 4) = acc[ai][0][m][1] * (WSCALE * rs[ai][m]); }
            }
        }
    }
};
DEV f32x4 sigm4(const f32x4 v) { f32x4 o;
#pragma unroll
    for (int i = 0; i < 4; ++i) o[i] = __builtin_amdgcn_rcpf(1.f + __builtin_amdgcn_exp2f(-LOG2E * v[i])); return o; }
struct EpiGates {
    typedef PreRs Pre;
    DEV void prefetch(PreRs& p, const Unit& u, int wr, int fr) const { pre_rs(p, ss, u.pm * BM + wr * 64 + fr); }
    static constexpr bool PERM = true, AFTER_DRAIN = false;
    bf16_t* G; const u64* ss;
    DEV void operator()(const Acc& acc, const Unit& u, int wr, int wc, int fr, int fq, const PreRs& pre) const {
        EPI_ROWS(u); float rs[2][4]; rs_of(rs, pre); bf16_t* base = G + (size_t)(u.pn >> 2) * T * D + (u.pn & 3) * 256 + wc * 32 + 8 * fq;
#pragma unroll
        for (int ai = 0; ai < 2; ++ai)
#pragma unroll
            for (int m = 0; m < 4; ++m) { bf16_t* rowp = base + (size_t)(row0 + ai * HALF + m * 16) * D;
#pragma unroll
                for (int bj = 0; bj < 2; ++bj) *(u32x4*)(rowp + bj * HALF) = pack8(sigm4(acc[ai][bj][m][0] * rs[ai][m]), sigm4(acc[ai][bj][m][1] * rs[ai][m])); }
    }
};
struct EpiMerge {
    typedef PreNone Pre;
    DEV void prefetch(PreNone&, const Unit&, int, int) const {}
    static constexpr bool PERM = true, AFTER_DRAIN = false;
    bf16_t* M; const bf16_t* G;
    DEV void operator()(const Acc& acc, const Unit& u, int wr, int wc, int fr, int fq, const PreNone&) const {
        EPI_ROWS(u); const size_t cofs = (size_t)u.pn * 256 + wc * 32 + 8 * fq; const bf16_t* gb = G + (size_t)u.job * T * D;
#pragma unroll
        for (int ai = 0; ai < 2; ++ai) {
            u32x4 g[8], p[8];
#pragma unroll
            for (int m = 0; m < 4; ++m)
#pragma unroll
                for (int bj = 0; bj < 2; ++bj) { const size_t o = (size_t)(row0 + ai * HALF + m * 16) * D + cofs + bj * HALF; g[2 * m + bj] = *(const u32x4*)(gb + o);
                    if (u.job > 0) p[2 * m + bj] = __builtin_nontemporal_load((const u32x4*)(M + o)); }
#pragma unroll
            for (int m = 0; m < 4; ++m)
#pragma unroll
                for (int bj = 0; bj < 2; ++bj) { const size_t o = (size_t)(row0 + ai * HALF + m * 16) * D + cofs + bj * HALF; const u32x4 gg = g[2 * m + bj];
                    f32x4 v0 = acc[ai][bj][m][0], v1 = acc[ai][bj][m][1];
                    v0[0] *= bflo(gg.x); v0[1] *= bfhi(gg.x); v0[2] *= bflo(gg.y); v0[3] *= bfhi(gg.y); v1[0] *= bflo(gg.z); v1[1] *= bfhi(gg.z); v1[2] *= bflo(gg.w); v1[3] *= bfhi(gg.w);
                    if (u.job > 0) { const u32x4 pp = p[2 * m + bj];
                        v0[0] += bflo(pp.x); v0[1] += bfhi(pp.x); v0[2] += bflo(pp.y); v0[3] += bfhi(pp.y); v1[0] += bflo(pp.z); v1[1] += bfhi(pp.z); v1[2] += bflo(pp.w); v1[3] += bfhi(pp.w); }
                    *(u32x4*)(M + o) = pack8(v0, v1); }
        }
    }
};
struct EpiMergeC {
    typedef PreNone Pre;
    DEV void prefetch(PreNone&, const Unit&, int, int) const {}
    static constexpr bool PERM = true, AFTER_DRAIN = false, CHAIN = true;
    bf16_t* M; const bf16_t* G;
    static DEV float gl(unsigned w) { return fmaxf(bflo(w), 9.094947e-13f); }
    static DEV float gh(unsigned w) { return fmaxf(bfhi(w), 9.094947e-13f); }
    DEV void operator()(Acc& acc, const Unit& u, int wr, int wc, int fr, int fq, const PreNone&) const {
        EPI_ROWS(u); const size_t cofs = (size_t)u.pn * 256 + wc * 32 + 8 * fq; const bf16_t* gb = G + (size_t)u.job * T * D; const bool lastj = u.job == 2;
#pragma unroll
        for (int ai = 0; ai < 2; ++ai) {
            u32x4 g[8], gn[8];
#pragma unroll
            for (int m = 0; m < 4; ++m)
#pragma unroll
                for (int bj = 0; bj < 2; ++bj) { const size_t o = (size_t)(row0 + ai * HALF + m * 16) * D + cofs + bj * HALF; g[2 * m + bj] = *(const u32x4*)(gb + o);
                    if (!lastj) gn[2 * m + bj] = *(const u32x4*)(gb + (size_t)T * D + o); }
#pragma unroll
            for (int m = 0; m < 4; ++m)
#pragma unroll
                for (int bj = 0; bj < 2; ++bj) { const u32x4 a = g[2 * m + bj]; f32x4 s0 = {gl(a.x), gh(a.x), gl(a.y), gh(a.y)}, s1 = {gl(a.z), gh(a.z), gl(a.w), gh(a.w)};
                    if (!lastj) { const u32x4 b = gn[2 * m + bj];
                        s0[0] *= __builtin_amdgcn_rcpf(gl(b.x)); s0[1] *= __builtin_amdgcn_rcpf(gh(b.x)); s0[2] *= __builtin_amdgcn_rcpf(gl(b.y)); s0[3] *= __builtin_amdgcn_rcpf(gh(b.y));
                        s1[0] *= __builtin_amdgcn_rcpf(gl(b.z)); s1[1] *= __builtin_amdgcn_rcpf(gh(b.z)); s1[2] *= __builtin_amdgcn_rcpf(gl(b.w)); s1[3] *= __builtin_amdgcn_rcpf(gh(b.w)); }
                    acc[ai][bj][m][0] = acc[ai][bj][m][0] * s0; acc[ai][bj][m][1] = acc[ai][bj][m][1] * s1;
                    if (lastj) { const size_t o = (size_t)(row0 + ai * HALF + m * 16) * D + cofs + bj * HALF; *(u32x4*)(M + o) = pack8(acc[ai][bj][m][0], acc[ai][bj][m][1]); } }
        }
    }
};
template <bool IN_F32> struct EpiResid {
    typedef PreNone Pre;
    DEV void prefetch(PreNone&, const Unit&, int, int) const {}
    static constexpr bool PERM = true, AFTER_DRAIN = false;
    const void* xin; bf16_t* xb; u64* ss;
    DEV void operator()(const Acc& acc, const Unit& u, int wr, int wc, int fr, int fq, const PreNone&) const {
        EPI_ROWS(u); const size_t cofs = (size_t)u.pn * 256 + wc * 32 + 8 * fq;
#pragma unroll
        for (int ai = 0; ai < 2; ++ai) {
            f32x4 r0[8], r1[8];
#pragma unroll
            for (int m = 0; m < 4; ++m)
#pragma unroll
                for (int bj = 0; bj < 2; ++bj) { const size_t o = (size_t)(row0 + ai * HALF + m * 16) * D + cofs + bj * HALF; const int k = 2 * m + bj;
                    if (IN_F32) { r0[k] = *(const f32x4*)((const float*)xin + o); r1[k] = *(const f32x4*)((const float*)xin + o + 4); }
                    else { const u32x4 p = *(const u32x4*)((const bf16_t*)xin + o); r0[k] = __builtin_bit_cast(f32x4, p); } }
#pragma unroll
            for (int m = 0; m < 4; ++m) { const size_t ro = (size_t)(row0 + ai * HALF + m * 16) * D + cofs; float sq = 0.f;
#pragma unroll
                for (int bj = 0; bj < 2; ++bj) { const size_t o = ro + bj * HALF; const int k = 2 * m + bj; f32x4 v0 = acc[ai][bj][m][0], v1 = acc[ai][bj][m][1];
                    if (IN_F32) { v0 = v0 + r0[k]; v1 = v1 + r1[k]; }
                    else { const u32x4 p = __builtin_bit_cast(u32x4, r0[k]);
                        v0[0] += bflo(p.x); v0[1] += bfhi(p.x); v0[2] += bflo(p.y); v0[3] += bfhi(p.y); v1[0] += bflo(p.z); v1[1] += bfhi(p.z); v1[2] += bflo(p.w); v1[3] += bfhi(p.w); }
                    *(u32x4*)(xb + o) = pack8(v0, v1);
                    sq += ((v0[0] * v0[0] + v0[1] * v0[1]) + (v0[2] * v0[2] + v0[3] * v0[3])) + ((v1[0] * v1[0] + v1[1] * v1[1]) + (v1[2] * v1[2] + v1[3] * v1[3])); }
                sq += __shfl_xor(sq, 16); sq += __shfl_xor(sq, 32);
                if (fq == 0) atomicAdd(ss + row0 + ai * HALF + m * 16, (u64)(sq * SS_SCALE + 0.5f)); }
        }
    }
};
DEV float gelu_t(float a) { return a * __builtin_amdgcn_rcpf(1.f + __builtin_amdgcn_exp2f(-1.5957691216057308f * LOG2E * (a + 0.044715f * a * a * a))); }
DEV float row_prev1(float cur, float prevm) { const int r = __builtin_amdgcn_update_dpp(0, (int)__float_as_uint(prevm), 0x121, 0xf, 0xf, false);
    return __uint_as_float((unsigned)__builtin_amdgcn_update_dpp(r, (int)__float_as_uint(cur), 0x111, 0xf, 0xf, false)); }
DEV float row_prev2(float cur, float prevm) { const int r = __builtin_amdgcn_update_dpp(0, (int)__float_as_uint(prevm), 0x122, 0xf, 0xf, false);
    return __uint_as_float((unsigned)__builtin_amdgcn_update_dpp(r, (int)__float_as_uint(cur), 0x112, 0xf, 0xf, false)); }
struct EpiUpF {
    typedef PreRs Pre;
    DEV void prefetch(PreRs& p, const Unit& u, int wr, int fr) const { pre_rs(p, ss, u.pm * BM + wr * 64 + fr); }
    static constexpr bool PERM = true, AFTER_DRAIN = false;
    bf16_t *fu, *sa, *su; const u64* ss; const float *cw, *cb;
    DEV void operator()(const Acc& acc, const Unit& u, int wr, int wc, int fr, int fq, const PreRs& pre) const {
        EPI_ROWS(u); float rs[2][4]; rs_of(rs, pre); const size_t cofs = (size_t)u.pn * 128 + wc * 32 + 8 * fq;
        f32x4 w0[2], w1[2], w2[2], bb[2];
#pragma unroll
        for (int n = 0; n < 2; ++n) { w0[n] = *(const f32x4*)(cw + cofs + 4 * n); w1[n] = *(const f32x4*)(cw + DFF + cofs + 4 * n); w2[n] = *(const f32x4*)(cw + 2 * DFF + cofs + 4 * n); bb[n] = *(const f32x4*)(cb + cofs + 4 * n); }
#pragma unroll
        for (int ai = 0; ai < 2; ++ai) {
            const size_t strip = (size_t)u.pm * 4 + ai * 2 + wr;
            f32x4 ap[2] = {{0.f, 0.f, 0.f, 0.f}, {0.f, 0.f, 0.f, 0.f}};
#pragma unroll
            for (int m = 0; m < 4; ++m) {
                f32x4 a[2], g[2];
#pragma unroll
                for (int n = 0; n < 2; ++n) { a[n] = acc[ai][0][m][n] * rs[ai][m];
#pragma unroll
                    for (int e = 0; e < 4; ++e) { const float a1 = row_prev1(a[n][e], ap[n][e]), a2 = row_prev2(a[n][e], ap[n][e]);
                        g[n][e] = gelu_t(bb[n][e] + w0[n][e] * a2 + w1[n][e] * a1 + w2[n][e] * a[n][e]) * (acc[ai][1][m][n][e] * rs[ai][m]); } }
                if (m == 0) {
                    if (fr < 2) { *(u32x4*)(sa + (strip * 4 + fr) * DFF + cofs) = pack8(a[0], a[1]); *(u32x4*)(su + (strip * 2 + fr) * DFF + cofs) = pack8(acc[ai][1][0][0] * rs[ai][0], acc[ai][1][0][1] * rs[ai][0]); }
                    else *(u32x4*)(fu + (size_t)(row0 + ai * HALF) * DFF + cofs) = pack8(g[0], g[1]);
                } else {
                    *(u32x4*)(fu + (size_t)(row0 + ai * HALF + m * 16) * DFF + cofs) = pack8(g[0], g[1]);
                    if (m == 3 && fr >= 14) *(u32x4*)(sa + (strip * 4 + 2 + (fr - 14)) * DFF + cofs) = pack8(a[0], a[1]);
                }
                ap[0] = a[0]; ap[1] = a[1];
            }
        }
    }
};
struct EpiPrep {
    typedef PreNone Pre;
    DEV void prefetch(PreNone&, const Unit&, int, int) const {}
    static constexpr bool PERM = true, AFTER_DRAIN = false;
    unsigned char* ws; int mode;
    DEV void operator()(const Acc& acc, const Unit& u, int wr, int wc, int fr, int fq, const PreNone&) const {
        EPI_ROWS(u); bf16_t* base; int ldc; float sc = 1.f;
        if (mode == 0) { base = (bf16_t*)(ws + WS_KVM + (size_t)u.job * 2 * MiB); ldc = 2 * D; }
        else if (mode == 1) { base = (bf16_t*)(ws + WS_GT + (size_t)(u.job >> 2) * 2 * MiB) + (size_t)(u.job & 3) * 256 * D; ldc = D; sc = XSCALE; }
        else { base = (bf16_t*)(ws + WS_HT + (size_t)(u.job >> 2) * 2 * MiB) + (u.job & 3) * 256; ldc = D; }
        base += (size_t)u.pn * 256 + wc * 32 + 8 * fq;
#pragma unroll
        for (int ai = 0; ai < 2; ++ai)
#pragma unroll
            for (int m = 0; m < 4; ++m) { bf16_t* rowp = base + (size_t)(row0 + ai * HALF + m * 16) * ldc;
#pragma unroll
                for (int bj = 0; bj < 2; ++bj) *(u32x4*)(rowp + bj * HALF) = pack8(acc[ai][bj][m][0] * sc, acc[ai][bj][m][1] * sc); }
    }
};
struct EpiSoftmax {
    typedef PreRs Pre;
    DEV void prefetch(PreRs& p, const Unit& u, int wr, int fr) const { pre_rs(p, ss, u.pm * BM + wr * 64 + fr); }
    static constexpr bool PERM = true, AFTER_DRAIN = true;
    bf16_t* P; const u64* ss;
    DEV void fused(Acc& acc, const Unit& u, int wr, int wc, int fr, int fq, LAS unsigned char* lds, int wid, int lane, const PreRs& pre) const {
        LAS float* PM = (LAS float*)lds; LAS float* PS = (LAS float*)(lds + 4096);
        { const int row0_ = u.pm * BM + wr * 64 + fr; float rs[2][4]; rs_of(rs, pre);
#pragma unroll
          for (int ai = 0; ai < 2; ++ai)
#pragma unroll
              for (int m = 0; m < 4; ++m)
#pragma unroll
                  for (int bj = 0; bj < 2; ++bj)
#pragma unroll
                      for (int n = 0; n < 2; ++n) acc[ai][bj][m][n] = acc[ai][bj][m][n] * rs[ai][m]; }
#pragma unroll
        for (int ai = 0; ai < 2; ++ai)
#pragma unroll
            for (int m = 0; m < 4; ++m) { float mx = -INFINITY;
#pragma unroll
                for (int bj = 0; bj < 2; ++bj)
#pragma unroll
                    for (int n = 0; n < 2; ++n) { const f32x4 x = acc[ai][bj][m][n]; mx = fmaxf(mx, fmaxf(fmaxf(x[0], x[1]), fmaxf(x[2], x[3]))); }
                mx = fmaxf(mx, __shfl_xor(mx, 16)); mx = fmaxf(mx, __shfl_xor(mx, 32));
                if (fq == 0) PM[(ai * HALF + wr * 64 + m * 16 + fr) * 4 + wc] = mx; }
        LDS_WAIT(); __builtin_amdgcn_s_barrier(); asm volatile("" ::: "memory");
#pragma unroll
        for (int ai = 0; ai < 2; ++ai)
#pragma unroll
            for (int m = 0; m < 4; ++m) { const int r = ai * HALF + wr * 64 + m * 16 + fr; const f32x4 q = *(const LAS f32x4*)(PM + r * 4);
                const float mx = fmaxf(fmaxf(q[0], q[1]), fmaxf(q[2], q[3])); float s = 0.f;
#pragma unroll
                for (int bj = 0; bj < 2; ++bj)
#pragma unroll
                    for (int n = 0; n < 2; ++n) { f32x4 x = acc[ai][bj][m][n];
#pragma unroll
                        for (int i = 0; i < 4; ++i) { x[i] = __builtin_amdgcn_exp2f(x[i] - mx); s += x[i]; } acc[ai][bj][m][n] = x; }
                s += __shfl_xor(s, 16); s += __shfl_xor(s, 32);
                if (fq == 0) PS[r * 4 + wc] = s; }
        LDS_WAIT(); __builtin_amdgcn_s_barrier(); asm volatile("" ::: "memory");
        EPI_ROWS(u); bf16_t* base = P + (size_t)u.pn * 256 + wc * 32 + 8 * fq;
#pragma unroll
        for (int ai = 0; ai < 2; ++ai)
#pragma unroll
            for (int m = 0; m < 4; ++m) { const int r = ai * HALF + wr * 64 + m * 16 + fr; const f32x4 q = *(const LAS f32x4*)(PS + r * 4);
                const float inv = 1.f / ((q[0] + q[1]) + (q[2] + q[3])); bf16_t* rowp = base + (size_t)(row0 + ai * HALF + m * 16) * D;
#pragma unroll
                for (int bj = 0; bj < 2; ++bj) *(u32x4*)(rowp + bj * HALF) = pack8(acc[ai][bj][m][0] * inv, acc[ai][bj][m][1] * inv); }
        LDS_WAIT(); __builtin_amdgcn_s_barrier();
    }
};
}

typedef GAS unsigned gu32;
#define XB_TMO      128
#define XB_XCNT(j)  (256  + 64 * (j))
#define XB_XSUB(j)  (1280 + 64 * (j))
#define XB_XGEN(j)  (2304 + 64 * (j))
#define XB_TOP      3328
#define XB_TOPGEN   3392
#define XCD_BAR_WORDS 3456
#define XB_SPIN_CAP (1u << 22)
DEV unsigned xb_ld(unsigned* p) { return __hip_atomic_load(p, __ATOMIC_RELAXED, __HIP_MEMORY_SCOPE_AGENT); }
DEV unsigned xb_add(unsigned* p, unsigned v) { return __hip_atomic_fetch_add(p, v, __ATOMIC_RELAXED, __HIP_MEMORY_SCOPE_AGENT); }
DEV unsigned xb_xcc_id() { return (unsigned)__builtin_amdgcn_s_getreg((3 << 11) | 20) & 0xFu; }
#define XB_SPIN(cond, bar) do { unsigned _sp = 0; while (cond) { __builtin_amdgcn_s_sleep(1); \
    if ((++_sp & 255u) == 0u) { if (xb_ld(&(bar)[XB_TMO])) break; if (_sp > XB_SPIN_CAP) { atomicAdd(&(bar)[XB_TMO], 1u); break; } } } } while (0)
struct XcdBarrier { unsigned* bar; unsigned x; volatile LAS unsigned* st; };
DEV XcdBarrier xcd_barrier_post(unsigned* bar, volatile LAS unsigned* st, int tid) {
    XcdBarrier b; b.bar = bar; b.x = xb_xcc_id(); b.st = st;
    if (tid == 0) (void)xb_add(&bar[XB_XCNT(b.x)], 1u);
    return b;
}
DEV void xcd_barrier_complete(unsigned* bar, unsigned x, unsigned& nloc, unsigned& nx) {
    const unsigned G = gridDim.x * gridDim.y * gridDim.z;
    unsigned sum, cnt, mine, sp = 0u;
    for (;;) {
        sum = 0u; cnt = 0u; mine = 0u;
#pragma unroll
        for (unsigned j = 0; j < 16; ++j) { const unsigned c = xb_ld(&bar[XB_XCNT(j)]); sum += c; cnt += (c > 0u) ? 1u : 0u; mine = (j == x) ? c : mine; }
        if (sum == G) break;
        __builtin_amdgcn_s_sleep(1);
        if ((++sp & 255u) == 0u) { if (xb_ld(&bar[XB_TMO])) break; if (sp > XB_SPIN_CAP) { atomicAdd(&bar[XB_TMO], 1u); break; } }
    }
    nloc = mine > 0u ? mine : 1u; nx = cnt > 0u ? cnt : 1u;
}
DEV void xcd_barrier(const XcdBarrier& b, int tid) {
    asm volatile("s_waitcnt vmcnt(0)" ::: "memory");
    __syncthreads();
    if (tid == 0) {
        unsigned* bar = b.bar;
        __builtin_amdgcn_s_waitcnt(0);
        unsigned nloc = b.st[0], nx = b.st[1];
        if (nloc == 0u) { xcd_barrier_complete(bar, b.x, nloc, nx); b.st[0] = nloc; b.st[1] = nx; }
        const unsigned old = xb_add(&bar[XB_XSUB(b.x)], 1u);
        const unsigned gen = old / nloc;
        if (old + 1u == (gen + 1u) * nloc) {
            __builtin_amdgcn_fence(__ATOMIC_RELEASE, "agent");
            asm volatile("s_waitcnt vmcnt(0)" ::: "memory");
            const unsigned og = xb_add(&bar[XB_TOP], 1u);
            const unsigned tg = og / nx;
            if (og + 1u == (tg + 1u) * nx) xb_add(&bar[XB_TOPGEN], 1u);
            else XB_SPIN(xb_ld(&bar[XB_TOPGEN]) == tg, bar);
            __builtin_amdgcn_fence(__ATOMIC_ACQUIRE, "agent");
            xb_add(&bar[XB_XGEN(b.x)], 1u);
            asm volatile("s_waitcnt vmcnt(0)" ::: "memory");
        } else {
            XB_SPIN(xb_ld(&bar[XB_XGEN(b.x)]) == gen, bar);
            __builtin_amdgcn_fence(__ATOMIC_ACQUIRE, "agent");
            asm volatile("s_waitcnt vmcnt(0)" ::: "memory");
        }
    }
    __syncthreads();
}


using pg8::gelu_t;
struct WaveId { int gw, ngw, wave, lane; };
DEV unsigned f2bf_u(float f) { return (unsigned)f2bf(f); }
DEV unsigned pk2(float lo, float hi) { return cvt_pk_bf16(lo, hi); }

DEV void norm_rows(const WaveId& W, const float* x, const float* g, bf16_t* outb, float* outf, int rows) {
    for (int row = W.gw; row < rows; row += W.ngw) {
        const f32x4* xr = (const f32x4*)(x + (size_t)row * D) + W.lane;
        f32x4 v[4]; float s = 0.f;
#pragma unroll
        for (int j = 0; j < 4; ++j) { v[j] = xr[64 * j]; s += (v[j].x * v[j].x + v[j].y * v[j].y) + (v[j].z * v[j].z + v[j].w * v[j].w); }
        const float r = rsqrtf(wave_sum(s) * (1.f / D) + EPS);
#pragma unroll
        for (int j = 0; j < 4; ++j) {
            const f32x4 gg = ((const f32x4*)g)[W.lane + 64 * j];
            const f32x4 o = {v[j].x * r * gg.x, v[j].y * r * gg.y, v[j].z * r * gg.z, v[j].w * r * gg.w};
            if (outb) { u32x2 w; w.x = pk2(o.x, o.y); w.y = pk2(o.z, o.w); ((u32x2*)(outb + (size_t)row * D))[W.lane + 64 * j] = w; }
            else ((f32x4*)(outf + (size_t)row * D))[W.lane + 64 * j] = o;
        }
    }
}
DEV void cvt_piece(const WaveId& W, LAS float* scr, int& base, const float* Wsrc, int ldw, int K, int col0, int ncols, bf16_t* dst, int ldo, int row0, const float* gain = nullptr) {
    const int nblk = ncols / 32, nitems = (K / 64) * nblk;
    int first = (W.gw - base) % W.ngw; if (first < 0) first += W.ngw;
    base = (base + nitems) % W.ngw;
    for (int item = first; item < nitems; item += W.ngw) {
        const int kb = item / nblk, nb = item - kb * nblk, k0 = 64 * kb, n0 = 32 * nb;
        { const int lr = W.lane >> 3, lc = (W.lane & 7) * 4;
          f32x4 v[8]; float g[8];
#pragma unroll
          for (int i = 0; i < 8; ++i) { v[i] = *(const f32x4*)(Wsrc + (size_t)(k0 + lr + 8 * i) * ldw + col0 + n0 + lc); g[i] = gain ? gain[k0 + lr + 8 * i] : 1.f; }
#pragma unroll
          for (int i = 0; i < 8; ++i) { LAS float* d = scr + (lr + 8 * i) * 33 + lc; d[0] = v[i][0] * g[i]; d[1] = v[i][1] * g[i]; d[2] = v[i][2] * g[i]; d[3] = v[i][3] * g[i]; } }
        LDS_WAIT(); asm volatile("" ::: "memory");
        const int c = W.lane & 7;
#pragma unroll
        for (int j = 0; j < 4; ++j) { const int n = (W.lane >> 3) + 8 * j; const LAS float* s = scr + (8 * c) * 33 + n;
            u32x4 o; o.x = pk2(s[0 * 33], s[1 * 33]); o.y = pk2(s[2 * 33], s[3 * 33]); o.z = pk2(s[4 * 33], s[5 * 33]); o.w = pk2(s[6 * 33], s[7 * 33]);
            *(u32x4*)(dst + (size_t)(row0 + n0 + n) * ldo + k0 + 8 * c) = o; }
        LDS_WAIT(); asm volatile("" ::: "memory");
    }
}
DEV void convert_layer_weights(const WaveId& W, LAS float* scr, int& base, unsigned char* ws, const float* const* in, int l, int part = 3) {
    const float* wi = in[3] + (size_t)l * D * DIN;
    if (part & 1) {
    bf16_t* WIN = (bf16_t*)(ws + WS_WIN); const float* gm = in[2] + l * D;
    cvt_piece(W, scr, base, wi, DIN, D, 0, 1536, WIN, D, 0, gm);
    cvt_piece(W, scr, base, wi, DIN, D, 3072, 1536, WIN, D, 1536, gm);
    cvt_piece(W, scr, base, wi, DIN, D, 4608, 512, WIN, D, 3072, gm);
    cvt_piece(W, scr, base, wi, DIN, D, 1536, 512, WIN, D, 3584, gm);
#pragma unroll 1
    for (int j = 0; j < 4; ++j) { cvt_piece(W, scr, base, wi, DIN, D, 2048 + 128 * j, 128, WIN, D, 4096 + 256 * j, gm); cvt_piece(W, scr, base, wi, DIN, D, 2560 + 128 * j, 128, WIN, D, 4096 + 256 * j + 128, gm); }
    cvt_piece(W, scr, base, wi, DIN, D, 5120, 96, WIN, D, 5120, gm);
    cvt_piece(W, scr, base, wi, DIN, D, 5192, 3072, (bf16_t*)(ws + WS_WG), D, 0, gm);
#pragma unroll 1
    for (int i = 0; i < 3; ++i) cvt_piece(W, scr, base, in[5 + i] + (size_t)l * 512 * D, D, 512, 0, D, (bf16_t*)(ws + WS_WBR) + (size_t)i * D * 512, 512, 0);
    cvt_piece(W, scr, base, in[8] + (size_t)l * D * D, D, D, 0, D, (bf16_t*)(ws + WS_WMIX), D, 0);
    }
    if (!(part & 2)) return;
    const float* gf = in[14] + l * D;
    const float* wf = in[15] + (size_t)l * D * 2 * DFF;
#pragma unroll 1
    for (int j = 0; j < 22; ++j) { cvt_piece(W, scr, base, wf, 2 * DFF, D, 128 * j, 128, (bf16_t*)(ws + WS_WUP), D, 256 * j, gf); cvt_piece(W, scr, base, wf, 2 * DFF, D, DFF + 128 * j, 128, (bf16_t*)(ws + WS_WUP), D, 256 * j + 128, gf); }
    cvt_piece(W, scr, base, in[18] + (size_t)l * DFF * D, D, DFF, 0, D, (bf16_t*)(ws + WS_WDOWN), DFF, 0);
}
DEV void prep0_phase(const WaveId& W, LAS float* scr, unsigned char* ws, const float* const* in, bf16_t* XB) {
    int base = 0;
#pragma unroll 1
    for (int l = 0; l < DEPTH; ++l) {
        const float* wq = in[11] + (size_t)l * D * D; bf16_t* WQ = (bf16_t*)(ws + WS_WQ + (size_t)l * 2 * MiB); const float* gx = in[9] + l * D;
        for (size_t i = (size_t)(W.gw * 64 + W.lane) * 4; i < (size_t)D * D; i += (size_t)W.ngw * 256) { const float g = gx[i >> 10]; const f32x4 v = *(const f32x4*)(wq + i); u32x2 o; o.x = pk2(v.x * g, v.y * g); o.y = pk2(v.z * g, v.w * g); *(u32x2*)(WQ + i) = o; }
        cvt_piece(W, scr, base, in[13] + (size_t)l * D * D, D, D, 0, D, (bf16_t*)(ws + WS_WOT + (size_t)l * 2 * MiB), D, 0);
        cvt_piece(W, scr, base, in[12] + (size_t)l * D * 2 * D, 2 * D, D, 0, 2 * D, (bf16_t*)(ws + WS_WKVT + (size_t)l * 4 * MiB), D, 0);
        norm_rows(W, in[1], in[10] + l * D, (bf16_t*)(ws + WS_MEMN + (size_t)l * MiB), nullptr, NB * MEM);
    }
    convert_layer_weights(W, scr, base, ws, in, 0);
    pg8::u64* ss0 = (pg8::u64*)(ws + WS_SS);
    for (int row0 = W.gw; row0 < T; row0 += 4 * W.ngw) {
        f32x4 v[4][4];
#pragma unroll
        for (int u = 0; u < 4; ++u) { const f32x4* xr = (const f32x4*)(in[0] + (size_t)(row0 + u * W.ngw) * D) + W.lane;
#pragma unroll
            for (int j = 0; j < 4; ++j) v[u][j] = xr[64 * j]; }
#pragma unroll
        for (int u = 0; u < 4; ++u) { const int row = row0 + u * W.ngw; float s = 0.f;
#pragma unroll
            for (int j = 0; j < 4; ++j) { const f32x4 x = v[u][j]; s += (x.x * x.x + x.y * x.y) + (x.z * x.z + x.w * x.w);
                u32x2 w; w.x = pk2(x.x, x.y); w.y = pk2(x.z, x.w); ((u32x2*)(XB + (size_t)row * D))[W.lane + 64 * j] = w; }
            s = wave_sum(s); if (W.lane == 0) ss0[row] = (pg8::u64)(s * pg8::SS_SCALE + 0.5f); }
    }
}
DEV void final_norm(const WaveId& W, const bf16_t* x, float* out, const float* g, const pg8::u64* ss) {
    f32x4 gg[4];
#pragma unroll
    for (int j = 0; j < 4; ++j) gg[j] = ((const f32x4*)g)[W.lane + 64 * j];
    for (int row0 = W.gw; row0 < T; row0 += 4 * W.ngw) {
        u32x2 v[4][4]; pg8::u64 sq[4];
#pragma unroll
        for (int u = 0; u < 4; ++u) { const int row = row0 + u * W.ngw; sq[u] = ss[row]; const u32x2* xr = (const u32x2*)(x + (size_t)row * D) + W.lane;
#pragma unroll
            for (int j = 0; j < 4; ++j) v[u][j] = xr[64 * j]; }
#pragma unroll
        for (int u = 0; u < 4; ++u) { const int row = row0 + u * W.ngw; const float r = rsqrtf((float)sq[u] * (1.f / (pg8::SS_SCALE * D)) + EPS); f32x4* orow = (f32x4*)(out + (size_t)row * D) + W.lane;
#pragma unroll
            for (int j = 0; j < 4; ++j) { const u32x2 w = v[u][j];
                const f32x4 o = {bflo(w.x) * r * gg[j].x, bfhi(w.x) * r * gg[j].y, bflo(w.y) * r * gg[j].z, bfhi(w.y) * r * gg[j].w}; orow[64 * j] = o; } }
    }
}
DEV void conv_sc_phase(int gtid, int gthreads, bf16_t* scb, const bf16_t* cx, const float* w, bool dry) {
    const int c8 = (gtid & 63) * 8;
    const f32x4 w0a = *(const f32x4*)(w + c8), w0b = *(const f32x4*)(w + c8 + 4), w1a = *(const f32x4*)(w + 512 + c8), w1b = *(const f32x4*)(w + 512 + c8 + 4), w2a = *(const f32x4*)(w + 1024 + c8), w2b = *(const f32x4*)(w + 1024 + c8 + 4);
    const u32x4 z = {0u, 0u, 0u, 0u};
    for (int i0 = gtid; i0 < T * 64; i0 += 4 * gthreads) {
        u32x4 x2[4], x1[4], x0[4], bb[4];
#pragma unroll
        for (int u = 0; u < 4; ++u) { const int i = i0 + u * gthreads; if (i < T * 64) { const int t = i >> 6, tl = t & (S - 1); const size_t o = (size_t)t * 512 + c8;
            x2[u] = *(const u32x4*)(cx + o); x1[u] = tl >= 1 ? *(const u32x4*)(cx + o - 512) : z; x0[u] = tl >= 2 ? *(const u32x4*)(cx + o - 1024) : z; bb[u] = *(const u32x4*)(scb + o); } }
#pragma unroll
        for (int u = 0; u < 4; ++u) { const int i = i0 + u * gthreads; if (i < T * 64) { const size_t o = (size_t)(i >> 6) * 512 + c8;
            float r[8];
#define CONV1(k, W0, W1, W2, X0, X1, X2, BBv, F) r[k] = F(BBv) * (W0 * F(X0) + W1 * F(X1) + W2 * F(X2))
            CONV1(0, w0a.x, w1a.x, w2a.x, x0[u].x, x1[u].x, x2[u].x, bb[u].x, bflo); CONV1(1, w0a.y, w1a.y, w2a.y, x0[u].x, x1[u].x, x2[u].x, bb[u].x, bfhi);
            CONV1(2, w0a.z, w1a.z, w2a.z, x0[u].y, x1[u].y, x2[u].y, bb[u].y, bflo); CONV1(3, w0a.w, w1a.w, w2a.w, x0[u].y, x1[u].y, x2[u].y, bb[u].y, bfhi);
            CONV1(4, w0b.x, w1b.x, w2b.x, x0[u].z, x1[u].z, x2[u].z, bb[u].z, bflo); CONV1(5, w0b.y, w1b.y, w2b.y, x0[u].z, x1[u].z, x2[u].z, bb[u].z, bfhi);
            CONV1(6, w0b.z, w1b.z, w2b.z, x0[u].w, x1[u].w, x2[u].w, bb[u].w, bflo); CONV1(7, w0b.w, w1b.w, w2b.w, x0[u].w, x1[u].w, x2[u].w, bb[u].w, bfhi);
#undef CONV1
            u32x4 ov; ov.x = pk2(r[0], r[1]); ov.y = pk2(r[2], r[3]); ov.z = pk2(r[4], r[5]); ov.w = pk2(r[6], r[7]);
            if (!dry) *(u32x4*)(scb + o) = ov; else asm volatile("" :: "v"(ov)); } }
    }
}
DEV void ffn_fix_phase(int gtid, int gthreads, const bf16_t* sa, const bf16_t* su, bf16_t* fu, const float* cw, const float* cb, int strip0 = 0, int nstrip = T / 64) {
    constexpr int C8 = DFF / 8; const u32x4 z = {0u, 0u, 0u, 0u};
    for (int i0 = gtid; i0 < nstrip * 2 * C8; i0 += 3 * gthreads) {
        u32x4 x2[3], x1[3], x0[3], uu[3];
#pragma unroll
        for (int q = 0; q < 3; ++q) { const int i = i0 + q * gthreads; if (i < nstrip * 2 * C8) {
            const int sr = i / C8, c8 = (i - sr * C8) * 8, strip = strip0 + (sr >> 1), rr = sr & 1;
            const bool first = (strip & (S / 64 - 1)) == 0;
            const bf16_t* A = sa + (size_t)strip * 4 * DFF + c8; const bf16_t* Ap = A - 4 * DFF;
            x2[q] = *(const u32x4*)(A + rr * DFF);
            x1[q] = rr == 1 ? *(const u32x4*)A : (first ? z : *(const u32x4*)(Ap + 3 * DFF));
            x0[q] = first ? z : *(const u32x4*)(Ap + (2 + rr) * DFF);
            uu[q] = *(const u32x4*)(su + ((size_t)strip * 2 + rr) * DFF + c8); } }
#pragma unroll
        for (int q = 0; q < 3; ++q) { const int i = i0 + q * gthreads; if (i < nstrip * 2 * C8) {
            const int sr = i / C8, c8 = (i - sr * C8) * 8, strip = strip0 + (sr >> 1), rr = sr & 1, t = strip * 64 + rr;
            const f32x4 w0a = *(const f32x4*)(cw + c8), w0b = *(const f32x4*)(cw + c8 + 4), w1a = *(const f32x4*)(cw + DFF + c8), w1b = *(const f32x4*)(cw + DFF + c8 + 4), w2a = *(const f32x4*)(cw + 2 * DFF + c8), w2b = *(const f32x4*)(cw + 2 * DFF + c8 + 4);
            const f32x4 ba = *(const f32x4*)(cb + c8), bb = *(const f32x4*)(cb + c8 + 4);
            float r[8];
#define FM1(k, B0, W0, W1, W2, X0, X1, X2, Uv, F) r[k] = gelu_t(B0 + W0 * F(X0) + W1 * F(X1) + W2 * F(X2)) * F(Uv)
            FM1(0, ba.x, w0a.x, w1a.x, w2a.x, x0[q].x, x1[q].x, x2[q].x, uu[q].x, bflo); FM1(1, ba.y, w0a.y, w1a.y, w2a.y, x0[q].x, x1[q].x, x2[q].x, uu[q].x, bfhi);
            FM1(2, ba.z, w0a.z, w1a.z, w2a.z, x0[q].y, x1[q].y, x2[q].y, uu[q].y, bflo); FM1(3, ba.w, w0a.w, w1a.w, w2a.w, x0[q].y, x1[q].y, x2[q].y, uu[q].y, bfhi);
            FM1(4, bb.x, w0b.x, w1b.x, w2b.x, x0[q].z, x1[q].z, x2[q].z, uu[q].z, bflo); FM1(5, bb.y, w0b.y, w1b.y, w2b.y, x0[q].z, x1[q].z, x2[q].z, uu[q].z, bfhi);
            FM1(6, bb.z, w0b.z, w1b.z, w2b.z, x0[q].w, x1[q].w, x2[q].w, uu[q].w, bflo); FM1(7, bb.w, w0b.w, w1b.w, w2b.w, x0[q].w, x1[q].w, x2[q].w, uu[q].w, bfhi);
#undef FM1
            u32x4 ov; ov.x = pk2(r[0], r[1]); ov.y = pk2(r[2], r[3]); ov.z = pk2(r[4], r[5]); ov.w = pk2(r[6], r[7]);
            *(u32x4*)(fu + (size_t)t * DFF + c8) = ov; } }
    }
}

typedef short s16x4 __attribute__((ext_vector_type(4)));
DEV s16x4 vtr(const LAS unsigned char* p) { return __builtin_bit_cast(s16x4, __builtin_amdgcn_ds_read_tr16_b64_v4i16((LAS s16x4*)p)); }
DEV bf16x8 cat8(const s16x4 a, const s16x4 b) { return (bf16x8){a[0], a[1], a[2], a[3], b[0], b[1], b[2], b[3]}; }
DEV bf16x8 pk8(float a0, float a1, float a2, float a3, float a4, float a5, float a6, float a7) {
    u32x4 w; w.x = pk2(a0, a1); w.y = pk2(a2, a3); w.z = pk2(a4, a5); w.w = pk2(a6, a7); return __builtin_bit_cast(bf16x8, w); }
constexpr int VPITCH = 192;
DEV void pv_tile(f32x16& o0, f32x16& o1, const LAS unsigned char* vt, int lane, const bf16x8 (&pk)[4]) {
    const int hi = lane >> 5;
    const LAS unsigned char* vb = vt + (4 * hi + ((lane & 15) >> 2)) * VPITCH + ((lane >> 4) & 1) * 32 + (lane & 3) * 8;
    bf16x8 va[4];
#pragma unroll
    for (int ks = 0; ks < 4; ++ks) va[ks] = cat8(vtr(vb + (16 * ks) * VPITCH), vtr(vb + (16 * ks + 8) * VPITCH));
    asm volatile("" : "+v"(va[0]), "+v"(va[1]), "+v"(va[2]), "+v"(va[3]));
#pragma unroll
    for (int ks = 0; ks < 4; ++ks) o0 = __builtin_amdgcn_mfma_f32_32x32x16_bf16(va[ks], pk[ks], o0, 0, 0, 0);
#pragma unroll
    for (int ks = 0; ks < 4; ++ks) va[ks] = cat8(vtr(vb + (16 * ks) * VPITCH + 64), vtr(vb + (16 * ks + 8) * VPITCH + 64));
    asm volatile("" : "+v"(va[0]), "+v"(va[1]), "+v"(va[2]), "+v"(va[3]));
#pragma unroll
    for (int ks = 0; ks < 4; ++ks) o1 = __builtin_amdgcn_mfma_f32_32x32x16_bf16(va[ks], pk[ks], o1, 0, 0, 0);
}
DEV void store_ot(bf16_t* orow, const f32x16& o0, const f32x16& o1, int hi, float sc) {
#pragma unroll
    for (int g4 = 0; g4 < 4; ++g4) {
        u32x2 a; a.x = pk2(o0[4 * g4] * sc, o0[4 * g4 + 1] * sc); a.y = pk2(o0[4 * g4 + 2] * sc, o0[4 * g4 + 3] * sc);
        u32x2 b; b.x = pk2(o1[4 * g4] * sc, o1[4 * g4 + 1] * sc); b.y = pk2(o1[4 * g4 + 2] * sc, o1[4 * g4 + 3] * sc);
        *(u32x2*)(orow + 8 * g4 + 4 * hi) = a; *(u32x2*)(orow + 32 + 8 * g4 + 4 * hi) = b;
    }
}

DEV void sb_item(LAS unsigned char* vl, const bf16_t* Q, const bf16_t* Kk, const bf16_t* V, bf16_t* O, int b, int h, int qb, int lane, bool dry) {
    const int r32 = lane & 31, hi = lane >> 5, t0 = 32 * qb, t = t0 + r32; const size_t rowb = (size_t)b * S;
    bf16x8 qr[4]; { const bf16_t* qp = Q + (rowb + t0 + r32) * 512 + h * 64 + 8 * hi;
#pragma unroll
        for (int d0 = 0; d0 < 4; ++d0) qr[d0] = *(const bf16x8*)(qp + 16 * d0); }
    f32x16 o0, o1;
#pragma unroll
    for (int r = 0; r < 16; ++r) { o0[r] = 0.f; o1[r] = 0.f; }
    float carry = 1.f;
    const int c_hi = (t0 + 30) >> 6;
#pragma unroll 1
    for (int c = c_hi; c >= 0; --c) {
        const bf16_t* kp = Kk + (rowb + 64 * c + r32) * 512 + h * 64 + 8 * hi;
        bf16x8 k0[4], k1[4];
#pragma unroll
        for (int d0 = 0; d0 < 4; ++d0) { k0[d0] = *(const bf16x8*)(kp + 16 * d0); k1[d0] = *(const bf16x8*)(kp + (size_t)32 * 512 + 16 * d0); }
#pragma unroll
        for (int j = 0; j < 8; ++j) { const int row = (lane >> 3) + 8 * j; *(LAS u32x4*)(vl + row * VPITCH + (lane & 7) * 16) = *(const u32x4*)(V + (rowb + 64 * c + row) * 512 + h * 64 + (lane & 7) * 8); }
        f32x16 p0, p1;
#pragma unroll
        for (int r = 0; r < 16; ++r) { p0[r] = 0.f; p1[r] = 0.f; }
#pragma unroll
        for (int d0 = 0; d0 < 4; ++d0) { p0 = __builtin_amdgcn_mfma_f32_32x32x16_bf16(k0[d0], qr[d0], p0, 0, 0, 0); p1 = __builtin_amdgcn_mfma_f32_32x32x16_bf16(k1[d0], qr[d0], p1, 0, 0, 0); }
        float u[32];
        const bool diag = (c == c_hi);
#pragma unroll
        for (int e = 0; e < 32; ++e) {
            const float z = e < 16 ? p0[e] : p1[e - 16];
            float uu = __builtin_amdgcn_rcpf(1.f + __builtin_amdgcn_exp2f(fminf(z, 126.f)));
            if (diag) { const int kv = 64 * c + 8 * ((e >> 2) & 3) + 4 * hi + (e & 3) + 32 * (e >> 4); if (kv >= t) uu = 1.f; }
            u[e] = uu;
        }
        float gl[8], gh[8];
#pragma unroll
        for (int i = 0; i < 8; ++i) { const float gp = (u[4 * i] * u[4 * i + 1]) * (u[4 * i + 2] * u[4 * i + 3]);
            const auto rr = __builtin_amdgcn_permlane32_swap(__float_as_uint(gp), __float_as_uint(gp), false, false); gl[i] = __uint_as_float(rr[0]); gh[i] = __uint_as_float(rr[1]); }
        float ag[8]; float run = carry;
#pragma unroll
        for (int i = 7; i >= 0; --i) { const float a_hi = run; run *= gh[i]; const float a_lo = run; run *= gl[i]; ag[i] = hi ? a_hi : a_lo; }
        carry = run;
        bf16x8 pk[4];
#pragma unroll
        for (int ks = 0; ks < 4; ++ks) { float w[8];
#pragma unroll
            for (int g = 0; g < 2; ++g) { const int i = 2 * ks + g;
                const float a3 = ag[i], a2 = a3 * u[4 * i + 3], a1 = a2 * u[4 * i + 2], a0 = a1 * u[4 * i + 1];
                w[4 * g] = (1.f - u[4 * i]) * a0; w[4 * g + 1] = (1.f - u[4 * i + 1]) * a1; w[4 * g + 2] = (1.f - u[4 * i + 2]) * a2; w[4 * g + 3] = (1.f - u[4 * i + 3]) * a3; }
            pk[ks] = pk8(w[0], w[1], w[2], w[3], w[4], w[5], w[6], w[7]); }
        pv_tile(o0, o1, vl, lane, pk);
        if (__all(carry < 7.8e-31f)) break;
    }
    if (!dry) store_ot(O + (rowb + t0 + r32) * 512 + h * 64, o0, o1, hi, 1.f); else asm volatile("" :: "v"(o0), "v"(o1));
}
DEV void sb_phase(const WaveId& W, LAS unsigned char* lds, unsigned char* ws, bool dry) {
    LAS unsigned char* vl = lds + W.wave * 12288;
    const bf16_t* Q = (const bf16_t*)(ws + WS_QA); const bf16_t* Kk = (const bf16_t*)(ws + WS_KA); const bf16_t* V = (const bf16_t*)(ws + WS_VA);
    constexpr int NITEM = NB * 8 * (S / 32);
    for (int it = W.gw; it < NITEM; it += W.ngw) {
        const int qb = it & 255, h = (it >> 8) & 7, b = it >> 11;
        sb_item(vl, Q, Kk, V, (bf16_t*)(ws + WS_QA), b, h, qb, W.lane, dry);
    }
}

constexpr int IDX_CTL_OFF = 131072 + 1024;
DEV unsigned fkey2(float v) { const int u = (int)__float_as_uint(v); return (unsigned)(u ^ ((u >> 31) | (int)0x80000000)); }
DEV float relu1(float x) { return __builtin_amdgcn_fmed3f(x, 0.f, 3.0e38f); }
DEV void idx_prefetch(bf16x8 (&afr)[4], float (&w)[16], bf16x8 (&b0)[4], bf16x8 (&b1)[4], const bf16_t* IQ, const bf16_t* IK, const float* IWp, int b, int t0, int wid, int lane) {
    const int r32 = lane & 31, hh = lane >> 5; const size_t rowb = (size_t)b * S;
    { const int qi = 2 * (r32 >> 4) + ((r32 >> 2) & 1), head = (r32 & 3) + 4 * ((r32 >> 3) & 1);
        const bf16_t* ap = IQ + (rowb + t0 + qi) * 512 + head * 64 + 8 * hh;
#pragma unroll
        for (int ks = 0; ks < 4; ++ks) afr[ks] = *(const bf16x8*)(ap + 16 * ks); }
#pragma unroll
    for (int r = 0; r < 16; ++r) w[r] = IWp[(rowb + t0 + 2 * (r >> 3) + hh) * 8 + (r & 7)];
    const int jmax = (t0 + 3) >> 5;
    { const int j0 = wid < jmax ? wid : jmax, j1 = wid + 8 < jmax ? wid + 8 : jmax;
      const bf16_t* p0 = IK + ((rowb >> 5) + j0) * 2048 + (hh * 32 + r32) * 8; const bf16_t* p1 = IK + ((rowb >> 5) + j1) * 2048 + (hh * 32 + r32) * 8;
#pragma unroll
      for (int ks = 0; ks < 4; ++ks) { b0[ks] = *(const bf16x8*)(p0 + ks * 512); b1[ks] = *(const bf16x8*)(p1 + ks * 512); } }
}
DEV void idx_unit(LAS unsigned char* lds, const bf16_t* IQ, const bf16_t* IK, const float* IWp, unsigned* BM, int b, int t0, int nb, int nt0, int wid, int lane,
                  bf16x8 (&afr)[4], float (&w)[16], bf16x8 (&b0)[4], bf16x8 (&b1)[4]) {
    const int r32 = lane & 31, hh = lane >> 5; const size_t rowb = (size_t)b * S;
    const int tmax = t0 + 3, jmax = tmax >> 5;
    LAS unsigned* SCO = (LAS unsigned*)lds;
    bf16x8 b2[4];
#pragma unroll
    for (int ks = 0; ks < 4; ++ks) b2[ks] = afr[ks];
#define IDX_LOADB(dst, jj) do { const int jc_ = (jj) < jmax ? (jj) : jmax; const bf16_t* bp_ = IK + ((rowb >> 5) + jc_) * 2048 + (hh * 32 + r32) * 8; \
        _Pragma("unroll") for (int ks = 0; ks < 4; ++ks) dst[ks] = *(const bf16x8*)(bp_ + ks * 512); } while (0)
#define IDX_COMP(src, jj) do { f32x16 acc; _Pragma("unroll") for (int r = 0; r < 16; ++r) acc[r] = 0.f; \
        _Pragma("unroll") for (int ks = 0; ks < 4; ++ks) acc = __builtin_amdgcn_mfma_f32_32x32x16_bf16(afr[ks], src[ks], acc, 0, 0, 0); \
        float s0 = 0.f, s1 = 0.f; _Pragma("unroll") for (int hd = 0; hd < 8; ++hd) { s0 += w[hd] * relu1(acc[hd]); s1 += w[8 + hd] * relu1(acc[8 + hd]); } \
        unsigned k0_ = fkey2(s0), k1_ = fkey2(s1); const int key = 32 * (jj) + r32; \
        if ((jj) >= jmax) { k0_ = key <= t0 + hh ? k0_ : 0u; k1_ = key <= t0 + 2 + hh ? k1_ : 0u; }     \
        if ((jj) <= jmax) { SCO[hh * 8192 + key] = k0_; SCO[(2 + hh) * 8192 + key] = k1_; } } while (0)
#ifndef IDX_REP_MFMA
#define IDX_REP_MFMA 1
#endif
#ifndef IDX_REP_SEL
#define IDX_REP_SEL 1
#endif
#ifdef IDX_DRY_COMPUTE
#pragma unroll 1
    for (int j = wid; j <= jmax; j += 24) { IDX_COMP(b0, j); asm volatile("" : "+v"(b0[0]), "+v"(b1[0]), "+v"(b2[0])); IDX_COMP(b1, j + 8); IDX_COMP(b2, j + 16); }
#endif
#pragma unroll 1
    for (int rpm = 0; rpm < IDX_REP_MFMA; ++rpm) {
#pragma unroll 1
    for (int j = wid; j <= jmax; j += 24) {
        IDX_LOADB(b2, j + 16); IDX_COMP(b0, j);
        IDX_LOADB(b0, j + 24); IDX_COMP(b1, j + 8);
        IDX_LOADB(b1, j + 32); IDX_COMP(b2, j + 16);
    }
    }
#undef IDX_LOADB
#undef IDX_COMP
    if (nt0 >= 0) idx_prefetch(afr, w, b0, b1, IQ, IK, IWp, nb, nt0, wid, lane);
    LAS unsigned* thr = (LAS unsigned*)(lds + IDX_CTL_OFF);
    if (wid == 0 && lane < 32) ((LAS unsigned*)(lds + IDX_CTL_OFF + 64))[lane] = 0u;
    LDS_WAIT(); __builtin_amdgcn_s_barrier(); asm volatile("" ::: "memory");
    {
        const int q = wid & 3, h = wid >> 2, n = t0 + q + 1;
        volatile LAS unsigned* xme = (volatile LAS unsigned*)(lds + IDX_CTL_OFF + 64) + (q * 2 + h) * 4;
        volatile LAS unsigned* xpa = (volatile LAS unsigned*)(lds + IDX_CTL_OFF + 64) + (q * 2 + (h ^ 1)) * 4;
        unsigned T_ = 1u;
        if (n > 256) {
            LAS unsigned* row = SCO + q * 8192 + lane;
            unsigned r[64];
            const int nil = (jmax >> 1) >= h ? (((jmax >> 1) - h) >> 1) + 1 : 0;
#define IDX_FOR_LIVE(BODY) _Pragma("unroll") for (int g8_ = 0; g8_ < 8; ++g8_) if (8 * g8_ < nil) { _Pragma("unroll") for (int u8_ = 0; u8_ < 8; ++u8_) { const int il = 8 * g8_ + u8_; BODY } }
            IDX_FOR_LIVE( r[il] = (2 * (2 * il + h) + hh <= jmax) ? row[64 * (2 * il + h)] : 0u; )
            unsigned seq = 0u;
#define IDX_XCHG(val, out) do { ++seq; const int pb_ = (seq & 1u) * 2; if (lane == 0) { xme[pb_ + 1] = (val); xme[pb_] = seq; } \
                while (xpa[pb_] != seq) __builtin_amdgcn_s_sleep(0); (out) = xpa[pb_ + 1]; } while (0)
#define IDX_XCHG16(val, out) do { ++seq; const int pb_ = (seq & 1u) * 2; if (lane == 0) xme[pb_] = (seq << 16) | (val); unsigned w_; \
                while (((w_ = xpa[pb_]) >> 16) != (seq & 0xffffu)) __builtin_amdgcn_s_sleep(0); (out) = w_ & 0xffffu; } while (0)
#pragma unroll 1
            for (int rps = 0; rps < IDX_REP_SEL; ++rps) {
            unsigned mx = 0u;
            IDX_FOR_LIVE( mx = max(mx, r[il]); )
#pragma unroll
            for (int o = 1; o < 64; o <<= 1) mx = max(mx, (unsigned)__shfl_xor((int)mx, o));
            { unsigned pm_; IDX_XCHG(mx, pm_); mx = max(mx, pm_); }
            unsigned lo_ = 1u, hi_ = mx + 1u, chi_ = 0u, xgt_ = 1u, xeq_ = 0u, mt_ = 0u; bool done_ = false;
            if (mx > 0x82000000u) {
                const unsigned c1 = mx - (1u << 23), c2 = mx - (3u << 23);
                unsigned ca_ = 0, cb_ = 0, cc_ = 0, cd_ = 0; const unsigned c1v = c1, c2v = c2;
#define IDX_CNT4B(A, B, C, Dd) asm volatile("v_cmp_ge_u32_e64 s[88:89], %4, %8\n\tv_cmp_ge_u32_e64 s[90:91], %5, %8\n\tv_cmp_ge_u32_e64 s[92:93], %6, %8\n\tv_cmp_ge_u32_e64 s[94:95], %7, %8\n\t" \
                    "v_addc_co_u32_e64 %0, s[88:89], %0, 0, s[88:89]\n\tv_addc_co_u32_e64 %1, s[90:91], %1, 0, s[90:91]\n\tv_addc_co_u32_e64 %0, s[92:93], %0, 0, s[92:93]\n\tv_addc_co_u32_e64 %1, s[94:95], %1, 0, s[94:95]\n\t" \
                    "v_cmp_ge_u32_e64 s[88:89], %4, %9\n\tv_cmp_ge_u32_e64 s[90:91], %5, %9\n\tv_cmp_ge_u32_e64 s[92:93], %6, %9\n\tv_cmp_ge_u32_e64 s[94:95], %7, %9\n\t" \
                    "v_addc_co_u32_e64 %2, s[88:89], %2, 0, s[88:89]\n\tv_addc_co_u32_e64 %3, s[90:91], %3, 0, s[90:91]\n\tv_addc_co_u32_e64 %2, s[92:93], %2, 0, s[92:93]\n\tv_addc_co_u32_e64 %3, s[94:95], %3, 0, s[94:95]" \
                    : "+v"(ca_), "+v"(cb_), "+v"(cc_), "+v"(cd_) : "v"(A), "v"(B), "v"(C), "v"(Dd), "v"(c1v), "v"(c2v) : "s88", "s89", "s90", "s91", "s92", "s93", "s94", "s95")
#pragma unroll
                for (int g8_ = 0; g8_ < 8; ++g8_) if (8 * g8_ < nil) { IDX_CNT4B(r[8 * g8_], r[8 * g8_ + 1], r[8 * g8_ + 2], r[8 * g8_ + 3]); IDX_CNT4B(r[8 * g8_ + 4], r[8 * g8_ + 5], r[8 * g8_ + 6], r[8 * g8_ + 7]); }
#undef IDX_CNT4B
                int pk = (int)((ca_ + cb_) | ((cc_ + cd_) << 16));
                pk += __builtin_amdgcn_update_dpp(0, pk, 0x111, 0xf, 0xf, false);
                pk += __builtin_amdgcn_update_dpp(0, pk, 0x112, 0xf, 0xf, false);
                pk += __builtin_amdgcn_update_dpp(0, pk, 0x114, 0xf, 0xf, false);
                pk += __builtin_amdgcn_update_dpp(0, pk, 0x118, 0xf, 0xf, false);
                pk += __builtin_amdgcn_update_dpp(0, pk, 0x142, 0xa, 0xf, false);
                unsigned tot = (unsigned)__builtin_amdgcn_readlane(pk, 31) + (unsigned)__builtin_amdgcn_readlane(pk, 63);
                { unsigned pt_; IDX_XCHG(tot, pt_); tot += pt_; }
                const unsigned t1 = tot & 0xffffu, t2 = tot >> 16;
                if (t1 == 256u) { xgt_ = c1; mt_ = 0u; done_ = true; }
                else if (t1 > 256u) lo_ = c1;
                else { hi_ = c1; chi_ = t1;
                       if (t2 == 256u) { xgt_ = c2; mt_ = 0u; done_ = true; }
                       else if (t2 > 256u) lo_ = c2;
                       else { hi_ = c2; chi_ = t2; } }
                if (!done_ && hi_ - lo_ == 1u) { xgt_ = hi_; xeq_ = lo_; mt_ = 256u - chi_; done_ = true; }
            }
            { LAS unsigned* hist = (LAS unsigned*)(lds + IDX_CTL_OFF + 1024) + q * 256;
#pragma unroll 1
              for (int round = 0; round < 6 && !done_; ++round) {
                const unsigned wdt = hi_ - lo_;
                const int sh = wdt <= 256u ? 0 : 24 - (int)__builtin_clz(wdt - 1u);
                hist[128 * h + lane] = 0u; hist[128 * h + 64 + lane] = 0u;
                LDS_WAIT(); { unsigned d_; IDX_XCHG16(0u, d_); (void)d_; }
                const unsigned lov = lo_;
                if (round == 0) {
                    IDX_FOR_LIVE( const unsigned d = r[il] - lov; if (d < wdt) __hip_atomic_fetch_add(hist + (d >> sh), 1u, __ATOMIC_RELAXED, __HIP_MEMORY_SCOPE_WORKGROUP); )
                } else {
#pragma unroll
                    for (int g8_ = 0; g8_ < 8; ++g8_) if (8 * g8_ < nil) {
#pragma unroll
                        for (int u4_ = 0; u4_ < 2; ++u4_) { const int il = 8 * g8_ + 4 * u4_;
                            const unsigned d0 = r[il] - lov, d1 = r[il + 1] - lov, d2 = r[il + 2] - lov, d3 = r[il + 3] - lov;
                            if (min(min(d0, d1), min(d2, d3)) < wdt) {
                                if (d0 < wdt) __hip_atomic_fetch_add(hist + (d0 >> sh), 1u, __ATOMIC_RELAXED, __HIP_MEMORY_SCOPE_WORKGROUP);
                                if (d1 < wdt) __hip_atomic_fetch_add(hist + (d1 >> sh), 1u, __ATOMIC_RELAXED, __HIP_MEMORY_SCOPE_WORKGROUP);
                                if (d2 < wdt) __hip_atomic_fetch_add(hist + (d2 >> sh), 1u, __ATOMIC_RELAXED, __HIP_MEMORY_SCOPE_WORKGROUP);
                                if (d3 < wdt) __hip_atomic_fetch_add(hist + (d3 >> sh), 1u, __ATOMIC_RELAXED, __HIP_MEMORY_SCOPE_WORKGROUP); } } }
                }
                LDS_WAIT(); { unsigned d_; IDX_XCHG16(0u, d_); (void)d_; }
                const u32x4 hb = *(const LAS u32x4*)(hist + 4 * lane);
                const unsigned s4 = (hb.x + hb.y) + (hb.z + hb.w);
                unsigned suf = s4;
#pragma unroll
                for (int o = 1; o < 64; o <<= 1) { const unsigned tv = (unsigned)__shfl_down((int)suf, o); if (lane + o < 64) suf += tv; }
                const unsigned long long okm = __ballot(chi_ + suf >= 256u);
                const int L = 63 - (int)__builtin_clzll(okm);
                const unsigned above = chi_ + (unsigned)__builtin_amdgcn_readlane((int)(suf - s4), L);
                const unsigned h0 = (unsigned)__builtin_amdgcn_readlane((int)hb.x, L), h1 = (unsigned)__builtin_amdgcn_readlane((int)hb.y, L),
                               h2 = (unsigned)__builtin_amdgcn_readlane((int)hb.z, L), h3 = (unsigned)__builtin_amdgcn_readlane((int)hb.w, L);
                unsigned Bsel, cab, cnb;
                if (above + h3 >= 256u) { Bsel = 3u; cab = above; cnb = h3; }
                else if (above + h3 + h2 >= 256u) { Bsel = 2u; cab = above + h3; cnb = h2; }
                else if (above + h3 + h2 + h1 >= 256u) { Bsel = 1u; cab = above + h3 + h2; cnb = h1; }
                else { Bsel = 0u; cab = above + h3 + h2 + h1; cnb = h0; }
                Bsel += 4u * (unsigned)L;
                const unsigned nlo = lo_ + (Bsel << sh); unsigned nhi = nlo + (1u << sh); if (nhi > hi_ || nhi < nlo) nhi = hi_;
                if (cab + cnb == 256u) { xgt_ = nlo; mt_ = 0u; done_ = true; }
                else if (sh == 0) { xgt_ = nlo + 1u; xeq_ = nlo; mt_ = 256u - cab; done_ = true; }
                else { lo_ = nlo; hi_ = nhi; chi_ = cab; }
              } }
#ifdef IDX_XTRA
#pragma unroll 1
            for (int xr = 0; xr < IDX_XTRA; ++xr) { unsigned dsum = 0; const unsigned cv = xgt_ + (unsigned)xr;
                IDX_FOR_LIVE( dsum += r[il] >= cv; )
                int pk = (int)dsum;
                pk += __builtin_amdgcn_update_dpp(0, pk, 0x111, 0xf, 0xf, false); pk += __builtin_amdgcn_update_dpp(0, pk, 0x112, 0xf, 0xf, false); pk += __builtin_amdgcn_update_dpp(0, pk, 0x114, 0xf, 0xf, false);
                pk += __builtin_amdgcn_update_dpp(0, pk, 0x118, 0xf, 0xf, false); pk += __builtin_amdgcn_update_dpp(0, pk, 0x142, 0xa, 0xf, false);
                unsigned tot = (unsigned)__builtin_amdgcn_readlane(pk, 31) + (unsigned)__builtin_amdgcn_readlane(pk, 63);
                { unsigned pt_; IDX_XCHG16(tot, pt_); tot += pt_; } asm volatile("" :: "s"(tot)); }
#endif
            T_ = xgt_;
            if (mt_ != 0u) {
                if (h == 0) { unsigned run = 0u;
#pragma unroll 1
                    for (int i = 0; i <= (jmax >> 1); ++i) { const bool ok_ = 2 * i + hh <= jmax; const unsigned kv = ok_ ? row[64 * i] : 0u; const bool eq = kv == xeq_; const unsigned long long bm = __ballot(eq);
                        const unsigned rank = run + __builtin_amdgcn_mbcnt_hi((unsigned)(bm >> 32), __builtin_amdgcn_mbcnt_lo((unsigned)bm, 0u));
                        if (eq && rank >= mt_) row[64 * i] = 0u;
                        run += (unsigned)__popcll(bm); } }
                T_ = xeq_;
            }
            }
#undef IDX_XCHG
#undef IDX_XCHG16
#undef IDX_FOR_LIVE
        }
        if (lane == 0 && h == 0) thr[q] = T_;
    }
#ifdef PROBE_VALU
    { float a0 = (float)lane, a1 = a0 + 1.f, a2 = a0 + 2.f, a3 = a0 + 3.f, a4 = a0 + 4.f, a5 = a0 + 5.f, a6 = a0 + 6.f, a7 = a0 + 7.f; const float m = 1.0000001f, c = 1e-9f;
#pragma unroll 1
      for (int it = 0; it < 64; ++it) {
#pragma unroll
          for (int u = 0; u < 8; ++u) { a0 = a0 * m + c; a1 = a1 * m + c; a2 = a2 * m + c; a3 = a3 * m + c; a4 = a4 * m + c; a5 = a5 * m + c; a6 = a6 * m + c; a7 = a7 * m + c; } }
      asm volatile("" :: "v"(a0), "v"(a1), "v"(a2), "v"(a3), "v"(a4), "v"(a5), "v"(a6), "v"(a7)); }
#endif
    LDS_WAIT(); __builtin_amdgcn_s_barrier(); asm volatile("" ::: "memory");
    { const unsigned tq0 = thr[hh], tq1 = thr[2 + hh];
#pragma unroll 4
      for (int j = wid; j <= ((t0 | 255) >> 5); j += 8) {
          bool s0 = false, s1 = false;
          if (j <= jmax) { s0 = SCO[hh * 8192 + 32 * j + r32] >= tq0; s1 = SCO[(2 + hh) * 8192 + 32 * j + r32] >= tq1; }
          const unsigned long long b0_ = __ballot(s0), b1_ = __ballot(s1);
          if (lane == 0) { u32x4 o; o.x = (unsigned)b0_; o.y = (unsigned)(b0_ >> 32); o.z = (unsigned)b1_; o.w = (unsigned)(b1_ >> 32); *(u32x4*)(BM + ((size_t)b * 256 + j) * S + t0) = o; }
      } }
    LDS_WAIT(); __builtin_amdgcn_s_barrier();
}
DEV void idx_phase(LAS unsigned char* lds, unsigned char* ws, int vcu, int G, int wid, int lane) {
    constexpr int NUNIT = T / 4;
    const bf16_t* IQ = (const bf16_t*)(ws + WS_IQ); const bf16_t* IK = (const bf16_t*)(ws + WS_IK); const float* IW = (const float*)(ws + WS_IW);
#define IDX_UNIT_OF(k) ((k) * G + (((k) & 1) ? G - 1 - vcu : vcu))
    bf16x8 afr[4], b0[4], b1[4]; float w[16];
    int un = IDX_UNIT_OF(0);
    if (un < NUNIT) { const int b = un / (S / 4); idx_prefetch(afr, w, b0, b1, IQ, IK, IW, b, (un - b * (S / 4)) * 4, wid, lane); }
#pragma unroll 1
    for (int k = 0; un < NUNIT; ++k) {
        const int b = un / (S / 4), t0 = (un - b * (S / 4)) * 4;
        const int nun = IDX_UNIT_OF(k + 1); const int nb = nun / (S / 4), nt0 = nun < NUNIT ? (nun - nb * (S / 4)) * 4 : -1;
        idx_unit(lds, IQ, IK, IW, (unsigned*)(ws + WS_BM), b, t0, nb, nt0, wid, lane, afr, w, b0, b1);
        un = nun;
    }
#undef IDX_UNIT_OF
}

DEV void kn_phase(const WaveId& W, const bf16_t* Kk, float* KN) {
    for (int item = W.gw; item < NB * 8 * (S / 64); item += W.ngw) {
        const int b = item / (8 * (S / 64)), h = (item / (S / 64)) & 7, tile = item % (S / 64);
        const bf16_t* kp = Kk + ((size_t)b * S + tile * 64 + W.lane) * 512 + h * 64;
        float ss = 0.f;
#pragma unroll
        for (int c = 0; c < 8; ++c) { const u32x4 v = *(const u32x4*)(kp + 8 * c);
#pragma unroll
            for (int e = 0; e < 4; ++e) { const float lo = __uint_as_float(v[e] << 16), hi = __uint_as_float(v[e] & 0xffff0000u); ss += lo * lo + hi * hi; } }
        const float m = wave_max(ss);
        if (W.lane == 0) KN[item] = sqrtf(m) * 1.01f;
    }
}
#include <hip/hip_bf16.h>
namespace attn_body {
using bf16=__hip_bfloat16;
using bf16x8=__attribute__((ext_vector_type(8)))short;
using s16x4=__attribute__((ext_vector_type(4)))short;
using f32x16=__attribute__((ext_vector_type(16)))float;
using u32x4=__attribute__((ext_vector_type(4)))unsigned;
constexpr int BATCH=2,NHEAD=8,SEQ=8192,D=64,DM=NHEAD*D;
constexpr int NW=8,QBLK=32,QB=QBLK*NW,KVBLK=64,NQB=SEQ/QB;
constexpr int ATTN_PITCH=DM, ATTN_UNIT_ROWS=QB;
__device__ __forceinline__ int crow(int r,int hi){return (r&3)+8*(r>>2)+4*hi;}
#define SBAR() __builtin_amdgcn_sched_barrier(0)
__device__ __forceinline__ void cmask(f32x16&p0,f32x16&p1,int jb,int qrel,int hi){
  const float NEG=-INFINITY; int kb=64*jb+4*hi;
  #pragma unroll
  for(int r=0;r<16;++r){int kv=kb+(r&3)+8*(r>>2); if(kv>qrel)p0[r]=NEG; if(kv+32>qrel)p1[r]=NEG;}
}

constexpr int NSLOT=3, SLOTB=8192;
constexpr int LDS_K=0, LDS_V=NSLOT*SLOTB, LDS_WS=2*NSLOT*SLOTB, LDS_OST=LDS_WS+NW*64*4, LDS_BYTES=LDS_OST+NW*4096;
constexpr float C2=0.125f*1.4426950408889634f;
__device__ __forceinline__ void glds16(const void*gsrc,unsigned lds_dst){unsigned keep;
  asm volatile("s_mov_b32 %0, m0\n\ts_mov_b32 m0, %2\n\ts_nop 0\n\tglobal_load_lds_dwordx4 %1, off\n\ts_mov_b32 m0, %0":"=&s"(keep):"v"(gsrc),"s"(lds_dst):"memory");}
__device__ __forceinline__ float max3f(float a,float b,float c){float r;asm("v_max3_f32 %0, %1, %2, %3":"=v"(r):"v"(a),"v"(b),"v"(c));return r;}
__device__ __forceinline__ float max2f(float a,float b){float r;asm("v_max_f32_e32 %0, %1, %2":"=v"(r):"v"(a),"v"(b));return r;}
__device__ __forceinline__ float fadd_s(float a,float b){float r;asm("v_add_f32_e32 %0, %1, %2":"=v"(r):"v"(a),"v"(b));return r;}
__device__ __forceinline__ float fsub_s(float a,float b){float r;asm("v_sub_f32_e32 %0, %1, %2":"=v"(r):"v"(a),"v"(b));return r;}
typedef float f32x2_t __attribute__((ext_vector_type(2))); typedef __bf16 bf16x2_t __attribute__((ext_vector_type(2)));
__device__ __forceinline__ unsigned cvtpk_s(float lo,float hi){f32x2_t v={lo,hi};bf16x2_t b=__builtin_convertvector(v,bf16x2_t);return __builtin_bit_cast(unsigned,b);}
#define WAIT_BAR(N) asm volatile("s_waitcnt vmcnt(" #N ") lgkmcnt(0)\n\ts_barrier":::"memory")

__device__ __forceinline__ void qkt(f32x16&p0,f32x16&p1,const char*Kslot,const bf16x8*qr,const f32x16&negm,int r32,int hi){
  const char*kb=Kslot+hi*1024+r32*16;
  #pragma unroll
  for(int d0=0;d0<4;++d0){
    const bf16x8 b0=*reinterpret_cast<const bf16x8*>(kb+d0*2048);
    const bf16x8 b1=*reinterpret_cast<const bf16x8*>(kb+d0*2048+512);
    if(d0==0){p0=__builtin_amdgcn_mfma_f32_32x32x16_bf16(b0,qr[0],negm,0,0,0);p1=__builtin_amdgcn_mfma_f32_32x32x16_bf16(b1,qr[0],negm,0,0,0);}
    else{p0=__builtin_amdgcn_mfma_f32_32x32x16_bf16(b0,qr[d0],p0,0,0,0);p1=__builtin_amdgcn_mfma_f32_32x32x16_bf16(b1,qr[d0],p1,0,0,0);}}
}
typedef __attribute__((address_space(3))) const char* lds_cptr;
typedef short v4i16_t __attribute__((ext_vector_type(4)));
__device__ __forceinline__ void kload8(bf16x8*kf,lds_cptr kp){
  kf[0]=*(const __attribute__((address_space(3))) bf16x8*)(kp);      kf[1]=*(const __attribute__((address_space(3))) bf16x8*)(kp+512);
  kf[2]=*(const __attribute__((address_space(3))) bf16x8*)(kp+2048); kf[3]=*(const __attribute__((address_space(3))) bf16x8*)(kp+2560);
  kf[4]=*(const __attribute__((address_space(3))) bf16x8*)(kp+4096); kf[5]=*(const __attribute__((address_space(3))) bf16x8*)(kp+4608);
  kf[6]=*(const __attribute__((address_space(3))) bf16x8*)(kp+6144); kf[7]=*(const __attribute__((address_space(3))) bf16x8*)(kp+6656);
}
__device__ __forceinline__ void kload2(bf16x8*kf,lds_cptr kp,int j){ kf[2*j]=*(const __attribute__((address_space(3))) bf16x8*)(kp+j*2048); kf[2*j+1]=*(const __attribute__((address_space(3))) bf16x8*)(kp+j*2048+512); }
__device__ __forceinline__ s16x4 vtr(lds_cptr p){ return __builtin_bit_cast(s16x4,__builtin_amdgcn_ds_read_tr16_b64_v4i16((__attribute__((address_space(3))) v4i16_t*)p)); }
__device__ __forceinline__ float rowmax(const f32x16&p0,const f32x16&p1){
  float a=max3f(p0[0],p0[1],p1[0]),b=max3f(p0[2],p0[3],p1[1]);a=max3f(a,p1[2],p1[3]);
  #pragma unroll
  for(int r=4;r<16;r+=4){a=max3f(a,p0[r],p0[r+1]);b=max3f(b,p0[r+2],p0[r+3]);a=max3f(a,p1[r],p1[r+1]);b=max3f(b,p1[r+2],p1[r+3]);}
  const float m=max2f(a,b);
  auto rr=__builtin_amdgcn_permlane32_swap(__float_as_uint(m),__float_as_uint(m),false,false);
  return max2f(__uint_as_float(rr[0]),__uint_as_float(rr[1]));
}
__device__ __forceinline__ void pv(f32x16*o,int vb,bf16x8 pa0,bf16x8 pa1,bf16x8 pa2,bf16x8 pa3){
  #pragma unroll
  for(int d0=0;d0<2;++d0){s16x4 lo[4],hi[4];
    #pragma unroll
    for(int ks=0;ks<4;++ks){
      asm volatile("ds_read_b64_tr_b16 %0,%1 offset:%c2":"=&v"(lo[ks]):"v"(vb),"i"(d0*4096+ks*1024):"memory");
      asm volatile("ds_read_b64_tr_b16 %0,%1 offset:%c2":"=&v"(hi[ks]):"v"(vb),"i"(d0*4096+ks*1024+512):"memory");}
    asm volatile("s_waitcnt lgkmcnt(0)":::"memory");SBAR();
    #define PK(k) (bf16x8){lo[k][0],lo[k][1],lo[k][2],lo[k][3],hi[k][0],hi[k][1],hi[k][2],hi[k][3]}
    o[d0]=__builtin_amdgcn_mfma_f32_32x32x16_bf16(pa0,PK(0),o[d0],0,0,0);
    o[d0]=__builtin_amdgcn_mfma_f32_32x32x16_bf16(pa1,PK(1),o[d0],0,0,0);
    o[d0]=__builtin_amdgcn_mfma_f32_32x32x16_bf16(pa2,PK(2),o[d0],0,0,0);
    o[d0]=__builtin_amdgcn_mfma_f32_32x32x16_bf16(pa3,PK(3),o[d0],0,0,0);
    #undef PK
  }
}

#ifndef ATTN_STORE16
#define ATTN_STORE16(p,v) (*(u32x4*)(p)=(v))
#endif
template<int THRL> __device__ __forceinline__ void attn_unit(int b,int h,int qb,const bf16*Q,const bf16*__restrict__ K,const bf16*__restrict__ V,bf16*O,char*shm,const unsigned*__restrict__ BMb,const float*KNbh,const int tid){
  const int lane=tid&63,r32=lane&31,hi=lane>>5; const int wid=__builtin_amdgcn_readfirstlane(tid>>6);
  const long rowbase=(long)b*SEQ; const int q0=qb*QB;
  const bf16*Qw=Q+(rowbase+q0+wid*QBLK)*DM+h*D;
  const bf16*Kh=K+rowbase*DM+h*D,*Vh=V+rowbase*DM+h*D;
  const unsigned lds0=(unsigned)(uintptr_t)shm;
  float*wsf=(float*)(shm+LDS_WS)+wid*64;
  const bf16*ksrc=Kh+(long)lane*DM+wid*8;
  const bf16*vsrc=Vh+(long)(16*(wid&3)+(lane>>2))*DM+(wid>>2)*32+(lane&3)*8;
  const unsigned kdst=lds0+LDS_K+wid*1024, vdst=lds0+LDS_V+wid*1024;
  #define DMA_K(t,slot) glds16(ksrc+(long)(t)*KVBLK*DM,(unsigned)__builtin_amdgcn_readfirstlane(kdst+(slot)))
  #define DMA_V(t,slot) glds16(vsrc+(long)(t)*KVBLK*DM,(unsigned)__builtin_amdgcn_readfirstlane(vdst+(slot)))
  const int vb0=(int)(lds0+LDS_V)+((lane>>4)&1)*32+(lane&3)*8+(4*hi+((lane&15)>>2))*64;
  const char*Kbase=shm+LDS_K; bf16x8 kf[8];
  const lds_cptr shm3=(lds_cptr)shm; const lds_cptr kp0=shm3+LDS_K+hi*1024+r32*16; const lds_cptr vp0=shm3+LDS_V+((lane>>4)&1)*32+(lane&3)*8+(4*hi+((lane&15)>>2))*64;
  const int NT=(q0+QB)/KVBLK;
  DMA_K(0,0);DMA_V(0,0);DMA_K(1,SLOTB);
  bf16x8 qr[4];
  #pragma unroll
  for(int d0=0;d0<4;++d0)qr[d0]=*reinterpret_cast<const bf16x8*>(&Qw[(long)r32*DM+d0*16+hi*8]);
  const unsigned*bmp=BMb+(q0+wid*QBLK+r32);
  unsigned mwE0=bmp[0],mwE1=bmp[(size_t)SEQ],mwO0=0u,mwO1=0u;
  bool seen=false;
  float qn; { float qs=0.f;
    _Pragma("unroll") for(int d0=0;d0<4;++d0) _Pragma("unroll") for(int e=0;e<8;++e){ const float x=__uint_as_float(((unsigned)(unsigned short)qr[d0][e])<<16); qs+=x*x; }
    auto rr=__builtin_amdgcn_permlane32_swap(__float_as_uint(qs),__float_as_uint(qs),false,false); qn=__builtin_sqrtf(__uint_as_float(rr[0])+__uint_as_float(rr[1]))*1.01f; }
  constexpr float FASTB=60.f;
  int zlane=0; asm volatile("":"+v"(zlane));
  const float*knp=KNbh+zlane;
  float knE=knp[0],knO=0.f;
  bool anysel_=false;
  #define SLOWT(PS) (__any(!(qn*kn##PS<=FASTB)||mhat!=0.f))
  float mhat=0.f,l_reg=0.f;f32x16 o[2];o[0]=f32x16{};o[1]=f32x16{};const f32x16 zero16=f32x16{};
  const int qrel=wid*QBLK+r32;
  #define CMASK(P0,P1,SLOW,PS) do{ const unsigned m0_=mw##PS##0>>(4*hi), m1_=mw##PS##1>>(4*hi); anysel_=(mw##PS##0|mw##PS##1)!=0u; \
    if(SLOW){ _Pragma("unroll") for(int r=0;r<16;++r){ P0[r]-=mhat; P1[r]-=mhat; } } \
    _Pragma("unroll") for(int r=0;r<16;++r){ const int bit_=(r&3)+8*(r>>2); \
      const unsigned e0_=(unsigned)__builtin_amdgcn_sbfe((int)m0_,bit_,1), e1_=(unsigned)__builtin_amdgcn_sbfe((int)m1_,bit_,1); \
      P0[r]=__uint_as_float((__float_as_uint(P0[r])&e0_)|(0xff800000u&~e0_)); P1[r]=__uint_as_float((__float_as_uint(P1[r])&e1_)|(0xff800000u&~e1_)); } \
    }while(0)
  bool resc=false;
  #define START(P0,P1,SLOW) do{ resc=false; seen=anysel_; \
    if(SLOW){ const float rm=rowmax(P0,P1); const float dl=(rm==-INFINITY)?0.f:rm; mhat=fadd_s(mhat,dl); \
      _Pragma("unroll") for(int r=0;r<16;++r){P0[r]=fsub_s(P0[r],dl);P1[r]=fsub_s(P1[r],dl);} \
      } \
    _Pragma("unroll") for(int r=0;r<16;++r)P0[r]=__builtin_amdgcn_exp2f(P0[r]); }while(0)
  #define RESC() do{ if(resc){ asm volatile("s_waitcnt lgkmcnt(0)":::"memory"); \
      _Pragma("unroll") for(int d_=0;d_<2;++d_) _Pragma("unroll") for(int r=0;r<16;++r)o[d_][r]*=wsf[crow(r,hi)]; } }while(0)
  f32x16 pA0,pA1,pB0,pB1;
  int sl_prev=0,sl_cur=0,sl_next=SLOTB;
  #define ROT() do{sl_prev=sl_cur;sl_cur=sl_next;sl_next=(sl_next==(NSLOT-1)*SLOTB)?0:sl_next+SLOTB;}while(0)
  DMA_K(2,2*SLOTB);
  WAIT_BAR(3);
  { mwO0=bmp[(size_t)2*SEQ]; mwO1=bmp[(size_t)3*SEQ]; knO=knp[1];
  const bool slow0_=SLOWT(E);
  qkt(pA0,pA1,Kbase,qr,zero16,r32,hi);asm volatile("s_nop 15\n\ts_nop 7":"+v"(pA0),"+v"(pA1));CMASK(pA0,pA1,slow0_,E);
  START(pA0,pA1,slow0_); }
  _Pragma("unroll") for(int r=0;r<16;++r)pA1[r]=__builtin_amdgcn_exp2f(pA1[r]);
  WAIT_BAR(0);
  DMA_K(3,0);DMA_V(1,SLOTB);
  ROT();
  kload8(kf,kp0+sl_cur);
  WAIT_BAR(2);
  s16x4 vlo[8],vhi[8]; u32x4 pw0,pw1,pw2,pw3;
  #define PKW(P,B) cvtpk_s(P[B],P[B+1])
  #define PAF(k) __builtin_bit_cast(bf16x8,pw##k)
  #define VFR(i) (bf16x8){vlo[i][0],vlo[i][1],vlo[i][2],vlo[i][3],vhi[i][0],vhi[i][1],vhi[i][2],vhi[i][3]}
  #define PIN(x) asm volatile("":"+v"(x))
  #define MX3(a,b,c) __builtin_fmaxf(__builtin_fmaxf((a),(b)),(c))
  #define GAPA(MF,A0,A1,A2,A3,W0,W1,PW) do{ MF; sacc+=A0; sacc+=A1; sacc+=A2; sacc+=A3; PIN(sacc); W0; W1; PIN(PW); SBAR(); }while(0)
  #define EX(v) __builtin_amdgcn_exp2f(v)
  #define GAPB(MF,X,B) do{ MF; X[B]=EX(X[B]); X[B+1]=EX(X[B+1]); X[B+2]=EX(X[B+2]); X[B+3]=EX(X[B+3]); PIN(X); SBAR(); }while(0)
  #define VRD(i) do{ vlo[i]=vtr(vp_+(((i)>>2)*4096+((i)&3)*1024)); vhi[i]=vtr(vp_+(((i)>>2)*4096+((i)&3)*1024+512)); }while(0)
  #define KRD(G,j) do{ if(G){ kload2(kf,kp0+sl_next,j); SBAR(); } }while(0)
  #define STEP(C0,C1,P0,P1,t,GK,GV,GL,PS,NS) do{ SBAR(); \
    if((t)+1<NT){ mw##NS##0=bmp[(size_t)(2*(t)+2)*SEQ]; mw##NS##1=bmp[(size_t)(2*(t)+3)*SEQ]; kn##NS=knp[(t)+1]; }     \
    const lds_cptr vp_=vp0+sl_prev; \
    VRD(0); SBAR(); float sacc=(P0[0]+P0[1]); \
    GAPA(C0=__builtin_amdgcn_mfma_f32_32x32x16_bf16(kf[0],qr[0],zero16,0,0,0), P0[2],P0[3],P0[4],P0[5],     pw0[0]=PKW(P0,0), pw0[1]=PKW(P0,2), pw0); \
    VRD(4); SBAR(); GAPA(C1=__builtin_amdgcn_mfma_f32_32x32x16_bf16(kf[1],qr[0],zero16,0,0,0), P0[6],P0[7],P0[8],P0[9],     pw0[2]=PKW(P0,4), pw0[3]=PKW(P0,6), pw0); \
    VRD(1); SBAR(); GAPA(C0=__builtin_amdgcn_mfma_f32_32x32x16_bf16(kf[2],qr[1],C0,0,0,0),   P0[10],P0[11],P0[12],P0[13], pw1[0]=PKW(P0,8), pw1[1]=PKW(P0,10), pw1); \
    VRD(5); SBAR(); GAPA(C1=__builtin_amdgcn_mfma_f32_32x32x16_bf16(kf[3],qr[1],C1,0,0,0),   P0[14],P0[15],P1[0],P1[1],   pw1[2]=PKW(P0,12),pw1[3]=PKW(P0,14), pw1); \
    VRD(2); SBAR(); GAPA(C0=__builtin_amdgcn_mfma_f32_32x32x16_bf16(kf[4],qr[2],C0,0,0,0),   P1[2],P1[3],P1[4],P1[5],     pw2[0]=PKW(P1,0), pw2[1]=PKW(P1,2), pw2); \
    VRD(6); SBAR(); GAPA(C1=__builtin_amdgcn_mfma_f32_32x32x16_bf16(kf[5],qr[2],C1,0,0,0),   P1[6],P1[7],P1[8],P1[9],     pw2[2]=PKW(P1,4), pw2[3]=PKW(P1,6), pw2); \
    VRD(3); SBAR(); GAPA(C0=__builtin_amdgcn_mfma_f32_32x32x16_bf16(kf[6],qr[3],C0,0,0,0),   P1[10],P1[11],P1[12],P1[13], pw3[0]=PKW(P1,8), pw3[1]=PKW(P1,10), pw3); \
    VRD(7); SBAR(); GAPA(C1=__builtin_amdgcn_mfma_f32_32x32x16_bf16(kf[7],qr[3],C1,0,0,0),   P1[14],P1[15],0.f,0.f,       pw3[2]=PKW(P1,12),pw3[3]=PKW(P1,14), pw3); \
    l_reg+=sacc; \
    if(GK){DMA_K((t)+3,sl_cur);} if(GV){DMA_V((t)+1,sl_next);} \
    const bool slow_=SLOWT(PS); CMASK(C0,C1,slow_,PS); resc=false; \
    if(__builtin_expect(slow_,0)){ float a=MX3(C0[0],C0[1],C1[0]),b=MX3(C0[2],C0[3],C1[1]); a=MX3(a,C1[2],C1[3]); \
      _Pragma("unroll") for(int r=4;r<16;r+=4){a=MX3(a,C0[r],C0[r+1]);b=MX3(b,C0[r+2],C0[r+3]);a=MX3(a,C1[r],C1[r+1]);b=MX3(b,C1[r+2],C1[r+3]);} \
      float rm=__builtin_fmaxf(a,b); { auto rr=__builtin_amdgcn_permlane32_swap(__float_as_uint(rm),__float_as_uint(rm),false,false); rm=__builtin_fmaxf(__uint_as_float(rr[0]),__uint_as_float(rr[1])); } \
      const bool fresh_=!seen&&rm>-INFINITY;     \
      if(__builtin_expect(__any(rm>(float)THRL||(fresh_&&rm<-(float)THRL)),0)){ const float dl=fresh_?rm:__builtin_fmaxf(rm,0.f); mhat+=dl; \
        _Pragma("unroll") for(int r=0;r<16;++r){C0[r]-=dl;C1[r]-=dl;} \
        const float f=dl>0.f?__builtin_amdgcn_exp2f(-dl):1.f; l_reg*=f; if(hi==0)wsf[r32]=f; resc=true; } } \
    seen=seen||anysel_; \
    SBAR(); \
    GAPB(o[0]=__builtin_amdgcn_mfma_f32_32x32x16_bf16(PAF(0),VFR(0),o[0],0,0,0), C0,0); \
    GAPB(o[1]=__builtin_amdgcn_mfma_f32_32x32x16_bf16(PAF(0),VFR(4),o[1],0,0,0), C0,4); \
    KRD(GL,0); GAPB(o[0]=__builtin_amdgcn_mfma_f32_32x32x16_bf16(PAF(1),VFR(1),o[0],0,0,0), C0,8); \
    KRD(GL,1); GAPB(o[1]=__builtin_amdgcn_mfma_f32_32x32x16_bf16(PAF(1),VFR(5),o[1],0,0,0), C0,12); \
    KRD(GL,2); GAPB(o[0]=__builtin_amdgcn_mfma_f32_32x32x16_bf16(PAF(2),VFR(2),o[0],0,0,0), C1,0); \
    KRD(GL,3); GAPB(o[1]=__builtin_amdgcn_mfma_f32_32x32x16_bf16(PAF(2),VFR(6),o[1],0,0,0), C1,4); \
    GAPB(o[0]=__builtin_amdgcn_mfma_f32_32x32x16_bf16(PAF(3),VFR(3),o[0],0,0,0), C1,8); \
    GAPB(o[1]=__builtin_amdgcn_mfma_f32_32x32x16_bf16(PAF(3),VFR(7),o[1],0,0,0), C1,12); \
    }while(0)
  int t=1;
  for(;t+5<NT;t+=2){
    STEP(pB0,pB1,pA0,pA1,t,true,true,true,O,E);     WAIT_BAR(2); RESC(); ROT();
    STEP(pA0,pA1,pB0,pB1,t+1,true,true,true,E,O);   WAIT_BAR(2); RESC(); ROT();
  }
  #define ENDW(tt) do{ if((tt)+3<NT){WAIT_BAR(2);} else if((tt)+2<NT){WAIT_BAR(1);} else {WAIT_BAR(0);} }while(0)
  for(;t+1<NT;t+=2){
    STEP(pB0,pB1,pA0,pA1,t,(t+3<NT),(t+1<NT),(t+1<NT),O,E);       ENDW(t);   RESC(); ROT();
    STEP(pA0,pA1,pB0,pB1,t+1,(t+4<NT),(t+2<NT),(t+2<NT),E,O);     ENDW(t+1); RESC(); ROT();
  }
  STEP(pB0,pB1,pA0,pA1,NT-1,false,false,false,O,E); RESC();
  { float sacc=pB0[0]+pB0[1]; _Pragma("unroll") for(int r=2;r<16;++r)sacc+=pB0[r]; _Pragma("unroll") for(int r=0;r<16;++r)sacc+=pB1[r]; l_reg+=sacc;
    pw0=(u32x4){PKW(pB0,0),PKW(pB0,2),PKW(pB0,4),PKW(pB0,6)};pw1=(u32x4){PKW(pB0,8),PKW(pB0,10),PKW(pB0,12),PKW(pB0,14)};pw2=(u32x4){PKW(pB1,0),PKW(pB1,2),PKW(pB1,4),PKW(pB1,6)};pw3=(u32x4){PKW(pB1,8),PKW(pB1,10),PKW(pB1,12),PKW(pB1,14)};
    SBAR(); pv(o,vb0+sl_cur,PAF(0),PAF(1),PAF(2),PAF(3)); }
  #undef PKW
  #undef PAF
  #undef VFR
  #undef PIN
  #undef MX3
  #undef GAPA
  #undef GAPB
  #undef EX
  #undef VRD
  #undef KRD
  #undef STEP
  #undef ENDW
  {auto rr=__builtin_amdgcn_permlane32_swap(__float_as_uint(l_reg),__float_as_uint(l_reg),false,false);l_reg=__uint_as_float(rr[0])+__uint_as_float(rr[1]);}
  if(hi==0)wsf[32+r32]=l_reg;asm volatile("s_waitcnt lgkmcnt(0)":::"memory");
  float rli[16];
  #pragma unroll
  for(int r=0;r<16;++r)rli[r]=__builtin_amdgcn_rcpf(wsf[32+crow(r,hi)]);
  bf16*Ow=O+(rowbase+q0+wid*QBLK)*DM+h*D;
  { bf16*stg=(bf16*)(shm+LDS_OST)+wid*2048;
    #pragma unroll
    for(int r=0;r<16;++r){const int orow=crow(r,hi);
      #pragma unroll
      for(int d0=0;d0<2;++d0)stg[orow*64+d0*32+r32]=__float2bfloat16(o[d0][r]*rli[r]);}
    asm volatile("s_waitcnt lgkmcnt(0)":::"memory");
    #pragma unroll
    for(int i=0;i<4;++i){const int row=i*8+(lane>>3),ch=lane&7; const u32x4 v=*(const u32x4*)(stg+row*64+ch*8); ATTN_STORE16(Ow+(long)row*DM+ch*8,v);} }
  asm volatile("s_waitcnt lgkmcnt(0)\n\ts_barrier":::"memory");
  #undef DMA_K
  #undef DMA_V
  #undef CMASK
  #undef SLOWT
  #undef START
  #undef RESC
  #undef ROT
}
constexpr int ATTN_LDS_BYTES=LDS_BYTES;
#undef SBAR
#undef WAIT_BAR
}
constexpr int MK_THREADS = 512;
constexpr int RING_BYTES = 131072, MISC_OFF = RING_BYTES + 320, MK_LDS_BYTES = 147456;
constexpr size_t WS_CTL = 0, CTL_ZERO_BYTES = 65536 + 7 * 131072; constexpr int CW_BAR = 4096;
constexpr int PH_PREP0 = 0, PH_L0 = 1, PH_PER_LAYER = 14, NPH = PH_L0 + 2 * PH_PER_LAYER;
enum { Q_INPROJ = 0, Q_SBIDX, Q_DSA, Q_GATES, Q_MERGE, Q_MIX, Q_NORMXA, Q_XALOG, Q_XAOUT, Q_NORMFFN, Q_UP, Q_FFNMID, Q_DOWN, Q_NEXT };

#ifndef QBUILD
#define QBUILD 0xffffu
#endif
#define QON(x) ((QBUILD >> (x)) & 1u)
struct Args { const float* in[20]; float* out; unsigned char* ws; int ph_lo, ph_hi; };

__global__ void __launch_bounds__(MK_THREADS, 2) mk_fwd(Args args) {
    __shared__ __attribute__((aligned(16))) unsigned char lds_raw[MK_LDS_BYTES];
    LAS unsigned char* lds = (LAS unsigned char*)lds_raw;
    volatile LAS unsigned* MISC = (volatile LAS unsigned*)(lds + MISC_OFF);
    const int G = gridDim.x, bx = blockIdx.x;
    unsigned char* ws0 = args.ws;
    const int wave_s = __builtin_amdgcn_readfirstlane((int)threadIdx.x >> 6);
    for (int u = mk_tid(wave_s); u < (MK_LDS_BYTES - RING_BYTES) / 4; u += MK_THREADS) ((LAS unsigned*)(lds + RING_BYTES))[u] = 0u;
    __syncthreads();
    const int lo = args.ph_lo, hi = args.ph_hi;
    XcdBarrier bar; bar.bar = (unsigned*)(ws0 + WS_CTL) + CW_BAR; bar.x = 0; bar.st = nullptr;
    if (hi - lo > 1) bar = xcd_barrier_post((unsigned*)(ws0 + WS_CTL) + CW_BAR, MISC + 8, mk_tid(wave_s));
#define BPW(off) ((bf16_t*)(ws + (off)))
    const int vcu = (G % 8 == 0) ? (bx % 8) * (G / 8) + bx / 8 : bx;
    for (int p = lo; p < hi; ++p) {
#ifdef PROBE_REP
        const int reps = (p >= PH_L0 && ((PROBE_REP >> ((p - PH_L0) % PH_PER_LAYER)) & 1)) ? 2 : 1;
#else
        const int reps = 1;
#endif
#ifdef PROBE_REP
#pragma unroll 1
        for (int rep = 0; rep < reps; ++rep) {
        const bool dry = rep + 1 < reps;
#else
        { constexpr bool dry = false;
#endif
        int oz = 0; asm volatile("" : "+s"(oz));
        int tid = mk_tid(wave_s); asm volatile("" : "+v"(tid));
        const int wave = __builtin_amdgcn_readfirstlane(tid >> 6), lane = tid & 63;
        WaveId W; W.gw = vcu * 8 + wave; W.ngw = G * 8; W.wave = wave; W.lane = lane;
        unsigned char* ws = args.ws + oz; float* X = args.out + oz;
#define INP(k) (args.in[(k) + oz])
        if (p == PH_PREP0) {
            prep0_phase(W, (LAS float*)(lds + wave * 16384), ws, args.in + oz, (bf16_t*)X);
        } else if (p >= PH_L0) {
            const int l = (p - PH_L0) / PH_PER_LAYER, q = (p - PH_L0) % PH_PER_LAYER;
            const float* Xin = l == 0 ? INP(0) : X;
            pg8::u64* SSb = (pg8::u64*)(ws + WS_SS);
#define SSA(i) (SSb + (size_t)(i) * T)
            if (q == Q_SBIDX) {
#ifndef NO_SB
                sb_phase(W, lds, ws, dry);
#endif
                __syncthreads();
#ifndef NO_IDX
#ifdef PROBE_SB_ONLY
                if (!dry)
#endif
                idx_phase(lds, ws, vcu, G, wave, lane);
#endif
                conv_sc_phase(vcu * MK_THREADS + tid, G * MK_THREADS, BPW(WS_SCB), BPW(WS_CX), INP(4) + l * 3 * 512, dry);
                kn_phase(W, BPW(WS_KC), (float*)(ws + WS_KN));
                if (l == 0 && !dry && QON(15)) {
                    __syncthreads();
                    { pg8::Order S; S.init(1, 4, 16, G, bx); pg8::PtrG P{(const char*)(ws + WS_KVM), (const char*)(ws + WS_WQ)}; pg8::EpiPrep E{ws, 1};
                      pg8::gemm_phase<pg8::EpiPrep, pg8::PtrG, true, true>(lds, tid, 2 * D, D, 256, S, P, E); }
                    { pg8::Order S; S.init(4, 1, 16, G, (bx + 64) % G); pg8::PtrH P{(const char*)(ws + WS_KVM), (const char*)(ws + WS_WOT)}; pg8::EpiPrep E{ws, 2};
                      pg8::gemm_phase<pg8::EpiPrep, pg8::PtrH, true, true>(lds, tid, D, 2 * D, 256, S, P, E); }
                }
            } else if (q == Q_DSA) {
#ifndef NO_DSA
                {
                    for (int pr = vcu; pr < NB * 8 * 16; pr += G) { const int bh = pr >> 4, sx = pr & 15, bb = bh >> 3, hh = bh & 7;
#pragma unroll 1
                        for (int k2 = 0; k2 < 2; ++k2)
                            attn_body::attn_unit<8>(bb, hh, k2 == 0 ? sx : 31 - sx, (const attn_body::bf16*)BPW(WS_QC), (const attn_body::bf16*)BPW(WS_KC), (const attn_body::bf16*)BPW(WS_VC),
                                                    (attn_body::bf16*)(dry ? BPW(WS_KA) : BPW(WS_QC)), (char*)lds_raw, (const unsigned*)(ws + WS_BM) + (size_t)bb * 256 * S,
                                                    (const float*)(ws + WS_KN) + bh * (S / 64), tid); }
                }
#endif
            } else if (q == Q_FFNMID) {
            } else if (q == Q_NEXT) {
                if (l + 1 < DEPTH) { int base = 0; convert_layer_weights(W, (LAS float*)(lds + wave * 16384), base, ws, args.in + oz, l + 1); }
                else if (!dry) final_norm(W, BPW(WS_XN), X, INP(19), SSA(6));
            } else if (q == Q_INPROJ && QON(Q_INPROJ)) {
                pg8::Order S; S.init(T / 256, NIN / 256, 1, G, bx);
                pg8::PtrStd P{(const char*)X, (const char*)(ws + WS_WIN), 0, 0, 0, (size_t)256 * D * 2, (size_t)256 * D * 2};
                pg8::EpiInProj E{ws, SSA(3 * l)};
                pg8::gemm_phase<pg8::EpiInProj, pg8::PtrStd, true, true>(lds, tid, D, D, D, S, P, E);
                if (l == 0 && !dry && QON(14)) {
                    pg8::Order S2; S2.init(2, 8, 2, G, (bx + G - 64) % G);
                    pg8::PtrStd P2{(const char*)(ws + WS_MEMN), (const char*)(ws + WS_WKVT), 1 * MiB, 4 * MiB, 0, (size_t)256 * D * 2, (size_t)256 * D * 2};
                    pg8::EpiPrep E2{ws, 0};
                    pg8::gemm_phase<pg8::EpiPrep, pg8::PtrStd, true, true>(lds, tid, D, D, D, S2, P2, E2);
                }
            } else if (q == Q_GATES && QON(Q_GATES)) {
                pg8::Order S; S.init(T / 256, 12, 1, G, bx);
                pg8::PtrStd P{(const char*)X, (const char*)(ws + WS_WG), 0, 0, 0, (size_t)256 * D * 2, (size_t)256 * D * 2};
                pg8::EpiGates E{BPW(WS_GATES), SSA(3 * l)};
                pg8::gemm_phase<pg8::EpiGates, pg8::PtrStd, true, true>(lds, tid, D, D, D, S, P, E);
            } else if (q == Q_MERGE && QON(Q_MERGE)) {
                pg8::Order S; S.init(T / 256, 4, 3, G, bx);
                pg8::PtrStd P{(const char*)(ws + WS_QA), (const char*)(ws + WS_WBR), 16 * MiB, (size_t)D * 512 * 2, 0, (size_t)256 * 512 * 2, (size_t)256 * 512 * 2};
                pg8::EpiMergeC E{BPW(WS_XN), BPW(WS_GATES)};
                pg8::gemm_phase<pg8::EpiMergeC, pg8::PtrStd, true, true>(lds, tid, 512, 512, 512, S, P, E);
            } else if (q == Q_MIX && QON(Q_MIX)) {
                pg8::Order S; S.init(T / 256, 4, 1, G, bx);
                pg8::PtrStd P{(const char*)(ws + WS_XN), (const char*)(ws + WS_WMIX), 0, 0, 0, (size_t)256 * D * 2, (size_t)256 * D * 2};
                if (l == 0) { pg8::EpiResid<true> E{(const void*)INP(0), dry ? BPW(WS_FU) : BPW(WS_XBXA), dry ? SSA(0) : SSA(1)};
                    pg8::gemm_phase<pg8::EpiResid<true>, pg8::PtrStd, true, true>(lds, tid, D, D, D, S, P, E); }
                else { pg8::EpiResid<false> E{(const void*)X, dry ? BPW(WS_FU) : BPW(WS_XBXA), dry ? SSA(0) : SSA(4)};
                    pg8::gemm_phase<pg8::EpiResid<false>, pg8::PtrStd, true, true>(lds, tid, D, D, D, S, P, E); }

            } else if (q == Q_XALOG && QON(Q_XALOG)) {
                pg8::Order S; S.init(T / 256, 4, 1, G, bx);
                pg8::PtrStd P{(const char*)(ws + WS_XBXA), (const char*)(ws + WS_GT + (size_t)l * 4 * MiB), 0, 0, 2 * MiB, (size_t)256 * D * 2, (size_t)256 * D * 2};
                pg8::EpiSoftmax E{BPW(WS_PXA), SSA(1 + 3 * l)};
                pg8::gemm_phase<pg8::EpiSoftmax, pg8::PtrStd, false, true>(lds, tid, D, D, D, S, P, E);
            } else if (q == Q_XAOUT && QON(Q_XAOUT)) {
                pg8::Order S; S.init(T / 256, 4, 1, G, bx);
                pg8::PtrStd P{(const char*)(ws + WS_PXA), (const char*)(ws + WS_HT + (size_t)l * 4 * MiB), 0, 0, 2 * MiB, (size_t)256 * D * 2, (size_t)256 * D * 2};
                pg8::EpiResid<false> E{(const void*)BPW(WS_XBXA), dry ? BPW(WS_FU) : BPW(WS_XN), dry ? SSA(0) : SSA(2 + 3 * l)};
                pg8::gemm_phase<pg8::EpiResid<false>, pg8::PtrStd, true, true>(lds, tid, D, D, D, S, P, E);
            } else if (q == Q_UP && QON(Q_UP)) {
                pg8::Order S; S.init(T / 256, 22, 1, G, bx);
                pg8::PtrStd P{(const char*)(ws + WS_XN), (const char*)(ws + WS_WUP), 0, 0, 0, (size_t)256 * D * 2, (size_t)256 * D * 2};
                pg8::EpiUpF E{BPW(WS_FU), BPW(WS_SIDEA), BPW(WS_SIDEU), SSA(2 + 3 * l), INP(16) + l * 3 * DFF, INP(17) + l * DFF};
                pg8::gemm_phase<pg8::EpiUpF, pg8::PtrStd, true, true>(lds, tid, D, D, D, S, P, E);
            } else if (q == Q_DOWN && QON(Q_DOWN)) {
                pg8::Order S; S.init(T / 256, 4, 1, G, bx);
                if (!dry) {
#pragma unroll 1
                    for (int i = 0; ; ++i) { pg8::Unit u0; if (!S.next(i, u0)) break; ffn_fix_phase(tid, MK_THREADS, BPW(WS_SIDEA), BPW(WS_SIDEU), BPW(WS_FU), INP(16) + l * 3 * DFF, INP(17) + l * DFF, 4 * u0.pm, 4); }
                    asm volatile("s_waitcnt vmcnt(0)" ::: "memory"); __syncthreads();
                }
                pg8::PtrStd P{(const char*)(ws + WS_FU), (const char*)(ws + WS_WDOWN), 0, 0, 0, (size_t)256 * DFF * 2, (size_t)256 * DFF * 2};
                pg8::EpiResid<false> E{(const void*)BPW(WS_XN), dry ? BPW(WS_QA) : (l + 1 < DEPTH ? (bf16_t*)X : BPW(WS_XN)), dry ? SSA(0) : SSA(3 + 3 * l)};
                pg8::gemm_phase<pg8::EpiResid<false>, pg8::PtrStd, true, true>(lds, tid, DFF, DFF, DFF, S, P, E);
            }
        }
        }
        if (p + 1 < hi && !(p >= PH_L0 && ((p - PH_L0) % PH_PER_LAYER == Q_NORMXA || (p - PH_L0) % PH_PER_LAYER == Q_NORMFFN || (p - PH_L0) % PH_PER_LAYER == Q_FFNMID))) xcd_barrier(bar, mk_tid(wave_s));
    }
}

extern "C" void kernel_launch(void* const* d_in, const int* in_sizes, int n_in, void* d_out, int out_size, void* d_ws, size_t ws_size, hipStream_t st) {
    if (n_in != 20 || ws_size < WS_NEED || out_size != T * D) { fprintf(stderr, "kernel_launch: unexpected sizes n_in %d ws %zu out %d\n", n_in, ws_size, out_size); return; }
    static int grid = 0;
    if (grid == 0) {
        int dev = 0, cus = 0, per_cu = 0;
        (void)hipGetDevice(&dev); (void)hipDeviceGetAttribute(&cus, hipDeviceAttributeMultiprocessorCount, dev);
        if (hipOccupancyMaxActiveBlocksPerMultiprocessor(&per_cu, (const void*)mk_fwd, MK_THREADS, 0) != hipSuccess || per_cu < 1) { fprintf(stderr, "kernel_launch: occupancy query says %d blocks/CU\n", per_cu); grid = -1; return; }
        (void)hipGetLastError();
        if (cus != 256) { fprintf(stderr, "kernel_launch: built for a 256-CU device, found %d\n", cus); grid = -1; return; }
        grid = cus;
    }
    if (grid < 0) return;
    (void)hipMemsetAsync((char*)d_ws + WS_CTL, 0, CTL_ZERO_BYTES, st);
    Args a{};
    for (int i = 0; i < 20; ++i) a.in[i] = (const float*)d_in[i];
    a.out = (float*)d_out; a.ws = (unsigned char*)d_ws; a.ph_lo = 0; a.ph_hi = NPH;
    hipLaunchKernelGGL(mk_fwd, dim3(grid), dim3(MK_THREADS), 0, st, a);
}
```

```cpp
#include <hip/hip_runtime.h>
#include <stdint.h>
#include <stdio.h>

typedef unsigned short bf16_t;
typedef short bf16x8 __attribute__((ext_vector_type(8)));
typedef float f32x16 __attribute__((ext_vector_type(16)));
typedef float f32x4 __attribute__((ext_vector_type(4)));
#define DEV __device__ __forceinline__

constexpr int NB = 2, S = 8192, D = 1024, T = NB * S, DEPTH = 2;
constexpr int DIN = 8264, DFF = 2816, MEM = 256;
constexpr int NIN = 5376;
constexpr float LOG2E = 1.4426950408889634f;
constexpr float QSCALE = 0.125f * LOG2E;
constexpr float WSCALE = 0.125f * 0.35355339059327373f;
constexpr float XSCALE = 0.0625f * LOG2E;
constexpr float EPS = 1e-6f;
#ifndef MK_FUSE
#define MK_FUSE 1
#endif

constexpr size_t MiB = 1u << 20;
constexpr size_t WS_SIDEA = 88 * MiB, WS_SIDEU = 96 * MiB;
constexpr size_t WS_KN = 983040;
constexpr size_t WS_GT = 1 * MiB;
constexpr size_t WS_HT = 9 * MiB;
constexpr size_t WS_WUP = 17 * MiB, WS_WDOWN = 28 * MiB;
constexpr size_t WS_XN = 34 * MiB;
constexpr size_t WS_WMIX = 66 * MiB, WS_WBR = 68 * MiB, WS_WG = 71 * MiB, WS_WIN = 77 * MiB;
constexpr size_t WS_QA = 88 * MiB, WS_SCB = 104 * MiB, WS_QC = 120 * MiB, WS_KA = 136 * MiB, WS_VA = 152 * MiB, WS_KC = 168 * MiB, WS_VC = 184 * MiB,
                 WS_IQ = 200 * MiB, WS_CX = 216 * MiB, WS_IK = 232 * MiB, WS_IW = 234 * MiB, WS_BM = 235 * MiB;
constexpr size_t WS_GATES = 136 * MiB;
constexpr size_t WS_XTMP = 235 * MiB;
constexpr size_t WS_LOG = 88 * MiB, WS_PXA = 168 * MiB;
constexpr size_t WS_XBXA = 136 * MiB;
constexpr size_t WS_SS = 65536;
constexpr size_t WS_FA = 66 * MiB, WS_FU = 154 * MiB;
constexpr size_t WS_WQ = 34 * MiB  , WS_WOT = 38 * MiB  , WS_WKVT = 42 * MiB  , WS_MEMN = 50 * MiB  , WS_KVM = 52 * MiB  ;
constexpr size_t WS_NEED = 256 * MiB;

DEV bf16_t f2bf(float f) { unsigned u = __float_as_uint(f); u += 0x7fffu + ((u >> 16) & 1u); return (bf16_t)(u >> 16); }
DEV float bf2f(bf16_t h) { return __uint_as_float(((unsigned)h) << 16); }
DEV float wave_sum(float v) {
#pragma unroll
    for (int o = 1; o < 64; o <<= 1) v += __shfl_xor(v, o);
    return v;
}
DEV float wave_max(float v) {
#pragma unroll
    for (int o = 1; o < 64; o <<= 1) v = fmaxf(v, __shfl_xor(v, o));
    return v;
}


#define LAS __attribute__((address_space(3)))
#define GAS __attribute__((address_space(1)))
typedef unsigned u32x4 __attribute__((ext_vector_type(4)));
typedef unsigned u32x2 __attribute__((ext_vector_type(2)));
typedef float f32x2 __attribute__((ext_vector_type(2)));
#define LDS_WAIT() asm volatile("s_waitcnt lgkmcnt(0)" ::: "memory")
DEV int mk_tid(int wave_s) { unsigned ones = ~0u; asm volatile("" : "+s"(ones)); return wave_s * 64 + (int)__builtin_amdgcn_mbcnt_hi(ones, __builtin_amdgcn_mbcnt_lo(ones, 0u)); }
#define VM_WAIT() asm volatile("s_waitcnt vmcnt(0)" ::: "memory")
typedef __bf16 bf16x2_t __attribute__((ext_vector_type(2)));
DEV unsigned cvt_pk_bf16(float lo, float hi) { const f32x2 v = {lo, hi}; return __builtin_bit_cast(unsigned, __builtin_convertvector(v, bf16x2_t)); }
DEV float bflo(unsigned w) { return __uint_as_float(w << 16); }
DEV float bfhi(unsigned w) { return __uint_as_float(w & 0xffff0000u); }

namespace pg8 {
constexpr int BM = 256, BK = 64, HALF = 128, HTB = HALF * BK * 2, STAGE_BYTES = 8 * HTB, NXCD = 8, WGM = 4;
__host__ __device__ __forceinline__ int lds_byte(int r, int c) { const int st = (r >> 4) * 2 + (c >> 5), rr = r & 15, cc = c & 31, ob = rr * 64 + cc * 2; return st * 1024 + (ob ^ (((ob >> 9) & 1) << 5)); }
__host__ __device__ __forceinline__ void stage_rc(int b, int& R, int& C) { const int st = b / 1024, sb = b % 1024, swz = sb ^ (((sb >> 9) & 1) << 5); R = (st >> 1) * 16 + swz / 64; C = (st & 1) * 32 + (swz % 64) / 2; }
__host__ __device__ __forceinline__ int perm32(int rho) { const int n = rho >> 4, i = rho & 15; return 8 * (i >> 2) + 4 * n + (i & 3); }

struct Unit { int pm, pn, job; };
struct Order {
    int nM, nN, nwg, ntot, G, c;
    DEV void init(int nM_, int nN_, int njob, int G_, int c_) { nM = nM_; nN = nN_; nwg = nM * nN; ntot = nwg * njob; G = G_; c = c_; }
    DEV bool next(int i, Unit& u) const {
        const int L = i * G + c; if (L >= ntot) return false;
        u.job = L / nwg; int wgid = L - u.job * nwg;
        { const int q = nwg / NXCD, r = nwg % NXCD, xcd = wgid % NXCD, off = wgid / NXCD; wgid = (xcd < r ? xcd * (q + 1) : r * (q + 1) + (xcd - r) * q) + off; }
        const int nig = WGM * nN, gid = wgid / nig, fm = gid * WGM, gsz = (nM - fm) < WGM ? (nM - fm) : WGM;
        u.pm = fm + ((wgid % nig) % gsz); u.pn = (wgid % nig) / gsz; return true;
    }
};
template <class T, class = void> struct epi_chain { static constexpr bool value = false; };
template <class T> struct epi_chain<T, decltype((void)T::CHAIN)> { static constexpr bool value = T::CHAIN; };
template <class Epi, class Ptr, bool ALIGN_EPI, bool SP2>
DEV void gemm_phase(LAS unsigned char* lds, const int tid_in, const int lda, const int ldb, const int K, const Order& S, const Ptr& P, const Epi& E) {
    int tid_ = tid_in; asm volatile("" : "+v"(tid_));
    const int tid = tid_, wid = __builtin_amdgcn_readfirstlane(tid >> 6), lane = tid & 63, wr = wid >> 2, wc = wid & 3, fr = lane & 15, fq = lane >> 4;
    const int nt = K / BK;
    unsigned voffA[2], voffB[2];
#pragma unroll
    for (int i = 0; i < 2; ++i) { int R, C; stage_rc(tid * 16 + i * 8192, R, C); const int Rb = Epi::PERM ? ((R & ~31) + perm32(R & 31)) : R;
        voffA[i] = (unsigned)(R * lda + C) * 2u; voffB[i] = (unsigned)(Rb * ldb + C) * 2u; }
    const size_t kstep = (size_t)(BK * 2);
    const size_t hstepA = (size_t)HALF * lda * 2, hstepB = (size_t)HALF * ldb * 2;
    const unsigned ldsw = (unsigned)wid * 1024u;
    const int aoff = lds_byte(wr * 64 + fr, fq * 8), boff = lds_byte(wc * 32 + fr, fq * 8);
#define PG8_SA(b, h) (((b) * 2 + (h)) * HTB)
#define PG8_SB(b, h) ((4 + (b) * 2 + (h)) * HTB)
#define PG8_STAGE(bufoff, gbase, voff) do { _Pragma("unroll") for (int _i = 0; _i < 2; ++_i) \
        __builtin_amdgcn_global_load_lds((const unsigned*)((const char*)(gbase) + (voff)[_i]), (LAS unsigned*)(lds + (bufoff) + ldsw + _i * 8192), 16, 0, 0); } while (0)
#define PG8_LDA(dst, b, h) do { _Pragma("unroll") for (int m = 0; m < 4; ++m) _Pragma("unroll") for (int k = 0; k < 2; ++k) dst[m][k] = *(const LAS bf16x8*)(lds + PG8_SA(b, h) + aoff + m * 2048 + k * 1024); } while (0)
#define PG8_LDB(dst, b, h) do { _Pragma("unroll") for (int n = 0; n < 2; ++n) _Pragma("unroll") for (int k = 0; k < 2; ++k) dst[n][k] = *(const LAS bf16x8*)(lds + PG8_SB(b, h) + boff + n * 2048 + k * 1024); } while (0)
#define PG8_MMA(ai, bj, At, Bt) do { __builtin_amdgcn_s_setprio(1); _Pragma("unroll") for (int m = 0; m < 4; ++m) _Pragma("unroll") for (int n = 0; n < 2; ++n) _Pragma("unroll") for (int k = 0; k < 2; ++k) \
        acc[ai][bj][m][n] = __builtin_amdgcn_mfma_f32_16x16x32_bf16(Bt[n][k], At[m][k], acc[ai][bj][m][n], 0, 0, 0); __builtin_amdgcn_s_setprio(0); } while (0)
#define PG8_WAIT_V(n) asm volatile("s_waitcnt vmcnt(" #n ")" ::: "memory")
#define PG8_WAIT_L(n) asm volatile("s_waitcnt lgkmcnt(" #n ")" ::: "memory")
#define PG8_BAR __builtin_amdgcn_s_barrier()
#define PG8_SCHED __builtin_amdgcn_sched_barrier(0)
    Unit cur, nxt; int ui = 0;
    if (!S.next(0, cur)) return;
    f32x4 acc[2][2][4][2];
#pragma unroll
    for (int a = 0; a < 2; ++a)
#pragma unroll
        for (int b = 0; b < 2; ++b)
#pragma unroll
            for (int m = 0; m < 4; ++m)
#pragma unroll
                for (int n = 0; n < 2; ++n) acc[a][b][m][n] = (f32x4){0.f, 0.f, 0.f, 0.f};
    bf16x8 At[4][2], B0[2][2], B1[2][2];
    const char* cA = P.a(cur); const char* cB = P.b(cur);
    typename Epi::Pre pre; E.prefetch(pre, cur, wr, fr);
    if constexpr (SP2) {
        PG8_STAGE(PG8_SB(0, 0), cB, voffB); PG8_STAGE(PG8_SB(0, 1), cB + hstepB, voffB); PG8_STAGE(PG8_SA(0, 0), cA, voffA); PG8_STAGE(PG8_SA(0, 1), cA + hstepA, voffA);
        if (wr == 1) PG8_BAR;
        PG8_WAIT_V(2); PG8_BAR;
        PG8_STAGE(PG8_SB(1, 0), cB + kstep, voffB); PG8_STAGE(PG8_SA(1, 0), cA + kstep, voffA); PG8_STAGE(PG8_SB(1, 1), cB + hstepB + kstep, voffB);
        PG8_WAIT_V(6); PG8_BAR;
    } else {
        PG8_STAGE(PG8_SB(0, 0), cB, voffB); PG8_STAGE(PG8_SA(0, 0), cA, voffA); PG8_STAGE(PG8_SB(0, 1), cB + hstepB, voffB); PG8_STAGE(PG8_SA(0, 1), cA + hstepA, voffA);
        if (wr == 1) PG8_BAR;
        PG8_WAIT_V(4); PG8_BAR;
        PG8_STAGE(PG8_SB(1, 0), cB + kstep, voffB); PG8_STAGE(PG8_SA(1, 0), cA + kstep, voffA); PG8_STAGE(PG8_SB(1, 1), cB + hstepB + kstep, voffB);
        PG8_WAIT_V(6); PG8_BAR;
    }
#pragma unroll 1
    for (;;) {
        const bool has_next = S.next(ui + 1, nxt);
        const char* nA = has_next ? P.a(nxt) : cA; const char* nB = has_next ? P.b(nxt) : cB;
#pragma unroll 1
        for (int t = 0; t < nt; t += 2) {
            const bool last = (t == nt - 2);
            const char* a1 = cA + (size_t)(t + 1) * kstep;
            const char* a2 = last ? nA : cA + (size_t)(t + 2) * kstep; const char* b2 = last ? nB : cB + (size_t)(t + 2) * kstep;
            const char* a3 = a2 + kstep; const char* b3 = b2 + kstep;
            if constexpr (SP2) {
            PG8_LDB(B0, 0, 0); PG8_LDB(B1, 0, 1); PG8_SCHED; PG8_LDA(At, 0, 0); PG8_STAGE(PG8_SA(1, 1), a1 + hstepA, voffA);
            PG8_WAIT_V(8); PG8_WAIT_L(0); PG8_BAR; PG8_MMA(0, 0, At, B0); PG8_MMA(0, 1, At, B1); PG8_BAR; PG8_SCHED;
            PG8_LDA(At, 0, 1); PG8_STAGE(PG8_SB(0, 0), b2, voffB); PG8_STAGE(PG8_SB(0, 1), b2 + hstepB, voffB); PG8_STAGE(PG8_SA(0, 0), a2, voffA);
            PG8_WAIT_V(8); PG8_WAIT_L(0); PG8_BAR; PG8_MMA(1, 0, At, B0); PG8_MMA(1, 1, At, B1); PG8_BAR; PG8_SCHED;
            PG8_LDB(B0, 1, 0); PG8_LDB(B1, 1, 1); PG8_SCHED; PG8_LDA(At, 1, 0); PG8_STAGE(PG8_SA(0, 1), a2 + hstepA, voffA);
            PG8_WAIT_V(8); PG8_WAIT_L(0); PG8_BAR; PG8_MMA(0, 0, At, B0); PG8_MMA(0, 1, At, B1); PG8_BAR; PG8_SCHED;
            PG8_LDA(At, 1, 1); PG8_STAGE(PG8_SB(1, 0), b3, voffB); PG8_STAGE(PG8_SB(1, 1), b3 + hstepB, voffB); PG8_STAGE(PG8_SA(1, 0), a3, voffA);
            PG8_WAIT_V(8); PG8_WAIT_L(0); PG8_BAR; PG8_MMA(1, 0, At, B0); PG8_MMA(1, 1, At, B1); PG8_BAR; PG8_SCHED;
            } else {
            PG8_LDB(B0, 0, 0); PG8_SCHED; PG8_LDA(At, 0, 0); PG8_STAGE(PG8_SA(1, 1), a1 + hstepA, voffA);
            PG8_WAIT_L(8); PG8_BAR; PG8_WAIT_L(0); PG8_MMA(0, 0, At, B0); PG8_BAR; PG8_SCHED;
            PG8_LDB(B1, 0, 1); PG8_STAGE(PG8_SB(0, 0), b2, voffB);
            PG8_BAR; PG8_WAIT_L(0); PG8_MMA(0, 1, At, B1); PG8_BAR;
            PG8_LDA(At, 0, 1); PG8_STAGE(PG8_SA(0, 0), a2, voffA);
            PG8_BAR; PG8_WAIT_L(0); PG8_MMA(1, 0, At, B0); PG8_BAR; PG8_SCHED;
            PG8_STAGE(PG8_SB(0, 1), b2 + hstepB, voffB);
            PG8_WAIT_V(6); PG8_BAR; PG8_MMA(1, 1, At, B1); PG8_BAR;
            PG8_LDB(B0, 1, 0); PG8_SCHED; PG8_LDA(At, 1, 0); PG8_STAGE(PG8_SA(0, 1), a2 + hstepA, voffA);
            PG8_WAIT_L(8); PG8_BAR; PG8_WAIT_L(0); PG8_MMA(0, 0, At, B0); PG8_BAR; PG8_SCHED;
            PG8_LDB(B1, 1, 1); PG8_STAGE(PG8_SB(1, 0), b3, voffB);
            PG8_BAR; PG8_WAIT_L(0); PG8_MMA(0, 1, At, B1); PG8_BAR;
            PG8_LDA(At, 1, 1); PG8_STAGE(PG8_SA(1, 0), a3, voffA);
            PG8_BAR; PG8_WAIT_L(0); PG8_MMA(1, 0, At, B0); PG8_BAR; PG8_SCHED;
            PG8_STAGE(PG8_SB(1, 1), b3 + hstepB, voffB);
            PG8_WAIT_V(6); PG8_BAR; PG8_MMA(1, 1, At, B1); PG8_BAR;
            }
        }
        if constexpr (ALIGN_EPI) { if (wr == 0) PG8_BAR; }
        if constexpr (!Epi::AFTER_DRAIN) { const int le_ = mk_tid(0);
            E(acc, cur, wr, wc, le_ & 15, le_ >> 4, pre); }
        if (!has_next) break;
        if (!epi_chain<Epi>::value || nxt.job == 0) {
#pragma unroll
        for (int a = 0; a < 2; ++a)
#pragma unroll
            for (int b = 0; b < 2; ++b)
#pragma unroll
                for (int m = 0; m < 4; ++m)
#pragma unroll
                    for (int n = 0; n < 2; ++n) acc[a][b][m][n] = (f32x4){0.f, 0.f, 0.f, 0.f};
        }
        cur = nxt; cA = nA; cB = nB; ++ui; E.prefetch(pre, cur, wr, fr);
        if constexpr (ALIGN_EPI) { if (wr == 1) PG8_BAR; }
    }
    PG8_WAIT_V(0);
    if constexpr (!ALIGN_EPI) { if (wr == 0) PG8_BAR; }
    PG8_BAR;
    if constexpr (Epi::AFTER_DRAIN) { const int le_ = mk_tid(0); E.fused(acc, cur, wr, wc, le_ & 15, le_ >> 4, lds, wid, le_, pre); }
#undef PG8_SA
#undef PG8_SB
#undef PG8_STAGE
#undef PG8_LDA
#undef PG8_LDB
#undef PG8_MMA
#undef PG8_WAIT_V
#undef PG8_WAIT_L
#undef PG8_BAR
#undef PG8_SCHED
}
typedef f32x4 Acc[2][2][4][2];

struct PtrStd {
    const char* A; const char* B; size_t aj, bj, bb, arow, brow;
    DEV const char* a(const Unit& u) const { return A + (size_t)u.job * aj + (size_t)u.pm * arow; }
    DEV const char* b(const Unit& u) const { return B + (size_t)u.job * bj + (size_t)(u.pm >> 5) * bb + (size_t)u.pn * brow; }
};
struct PtrG {
    const char* KVM; const char* WQ;
    DEV const char* a(const Unit& u) const { return KVM + (size_t)(u.job >> 2) * MiB + (size_t)(u.job & 3) * 512; }
    DEV const char* b(const Unit& u) const { return WQ + (size_t)(u.job >> 3) * 2 * MiB + (size_t)(u.job & 3) * 512 + (size_t)u.pn * 256 * 1024 * 2; }
};
struct PtrH {
    const char* KVM; const char* WOT;
    DEV const char* a(const Unit& u) const { return WOT + (size_t)(u.job >> 3) * 2 * MiB + (size_t)(u.job & 3) * 512 + (size_t)u.pm * 256 * 1024 * 2; }
    DEV const char* b(const Unit& u) const { return KVM + (size_t)(u.job >> 2) * MiB + 2048 + (size_t)(u.job & 3) * 512; }
};

#define EPI_ROWS(u) const int row0 = (u).pm * BM + wr * 64 + fr
DEV u32x4 pack8(const f32x4 v0, const f32x4 v1) { u32x4 w; w.x = cvt_pk_bf16(v0[0], v0[1]); w.y = cvt_pk_bf16(v0[2], v0[3]); w.z = cvt_pk_bf16(v1[0], v1[1]); w.w = cvt_pk_bf16(v1[2], v1[3]); return w; }

struct PreNone {};
typedef unsigned long long u64;
constexpr float SS_SCALE = 65536.f;
struct PreRs { u64 v[2][4]; };
DEV void pre_rs(PreRs& p, const u64* ss, int row0) {
#pragma unroll
    for (int ai = 0; ai < 2; ++ai)
#pragma unroll
        for (int m = 0; m < 4; ++m) p.v[ai][m] = __builtin_nontemporal_load(ss + row0 + ai * HALF + m * 16);
}
DEV void rs_of(float (&rs)[2][4], const PreRs& p) {
#pragma unroll
    for (int ai = 0; ai < 2; ++ai)
#pragma unroll
        for (int m = 0; m < 4; ++m) rs[ai][m] = rsqrtf((float)p.v[ai][m] * (1.f / (SS_SCALE * D)) + EPS);
}
struct EpiInProj {
    typedef PreRs Pre;
    DEV void prefetch(PreRs& p, const Unit& u, int wr, int fr) const { pre_rs(p, ss, u.pm * BM + wr * 64 + fr); }
    static constexpr bool PERM = true, AFTER_DRAIN = false;
    unsigned char* ws; const u64* ss;
    DEV void operator()(const Acc& acc, const Unit& u, int wr, int wc, int fr, int fq, const PreRs& pre) const {
        EPI_ROWS(u); const int pn = u.pn, cb = wc * 32 + 8 * fq;
        float rs[2][4]; rs_of(rs, pre);
        if (pn < 16) {
            const int g = pn >> 1;
            const size_t off = g == 0 ? WS_QA : g == 1 ? WS_KA : g == 2 ? WS_VA : g == 3 ? WS_QC : g == 4 ? WS_KC : g == 5 ? WS_VC : g == 6 ? WS_IQ : WS_SCB;
            const float sc = (g == 0 || g == 3) ? QSCALE : 1.f;
            bf16_t* base = (bf16_t*)(ws + off) + (pn & 1) * 256 + cb;
#pragma unroll
            for (int ai = 0; ai < 2; ++ai)
#pragma unroll
                for (int m = 0; m < 4; ++m) { bf16_t* rowp = base + (size_t)(row0 + ai * HALF + m * 16) * 512;
#pragma unroll
                    for (int bj = 0; bj < 2; ++bj) *(u32x4*)(rowp + bj * HALF) = pack8(acc[ai][bj][m][0] * (sc * rs[ai][m]), acc[ai][bj][m][1] * (sc * rs[ai][m])); }
        } else if (pn < 20) {
            bf16_t* base = (bf16_t*)(ws + WS_CX) + (pn - 16) * 128 + cb;
#pragma unroll
            for (int ai = 0; ai < 2; ++ai)
#pragma unroll
                for (int m = 0; m < 4; ++m) { const float r2 = rs[ai][m] * rs[ai][m]; *(u32x4*)(base + (size_t)(row0 + ai * HALF + m * 16) * 512) = pack8(acc[ai][0][m][0] * acc[ai][1][m][0] * r2, acc[ai][0][m][1] * acc[ai][1][m][1] * r2); }
        } else {
            if (wc < 2) { bf16_t* base = (bf16_t*)(ws + WS_IK);
#pragma unroll
                for (int ai = 0; ai < 2; ++ai)
#pragma unroll
                    for (int m = 0; m < 4; ++m) { const int t = row0 + ai * HALF + m * 16;
                        *(u32x4*)(base + (size_t)(t >> 5) * 2048 + (((cb >> 3) * 32 + (t & 31)) * 8)) = pack8(acc[ai][0][m][0] * rs[ai][m], acc[ai][0][m][1] * rs[ai][m]); }
            } else if (wc == 2 && fq == 0) { float* base = (float*)(ws + WS_IW);
#pragma unroll
                for (int ai = 0; ai < 2; ++ai)
#pragma unroll
                    for (int m = 0; m < 4; ++m) { float* p = base + (size_t)(row0 + ai * HALF + m * 16) * 8; *(f32x4*)p = acc[ai][0][m][0] * (WSCALE * rs[ai][m]); *(f32x4*)(p + 4) = acc[ai][0][m][1] * (WSCALE * rs[ai][m]); }
            }
        }
    }
};
DEV f32x4 sigm4(const f32x4 v) { f32x4 o;
#pragma unroll
    for (int i = 0; i < 4; ++i) o[i] = __builtin_amdgcn_rcpf(1.f + __builtin_amdgcn_exp2f(-LOG2E * v[i])); return o; }
struct EpiGates {
    typedef PreRs Pre;
    DEV void prefetch(PreRs& p, const Unit& u, int wr, int fr) const { pre_rs(p, ss, u.pm * BM + wr * 64 + fr); }
    static constexpr bool PERM = true, AFTER_DRAIN = false;
    bf16_t* G; const u64* ss;
    DEV void operator()(const Acc& acc, const Unit& u, int wr, int wc, int fr, int fq, const PreRs& pre) const {
        EPI_ROWS(u); float rs[2][4]; rs_of(rs, pre); bf16_t* base = G + (size_t)(u.pn >> 2) * T * D + (u.pn & 3) * 256 + wc * 32 + 8 * fq;
#pragma unroll
        for (int ai = 0; ai < 2; ++ai)
#pragma unroll
            for (int m = 0; m < 4; ++m) { bf16_t* rowp = base + (size_t)(row0 + ai * HALF + m * 16) * D;
#pragma unroll
                for (int bj = 0; bj < 2; ++bj) *(u32x4*)(rowp + bj * HALF) = pack8(sigm4(acc[ai][bj][m][0] * rs[ai][m]), sigm4(acc[ai][bj][m][1] * rs[ai][m])); }
    }
};
struct EpiMerge {
    typedef PreNone Pre;
    DEV void prefetch(PreNone&, const Unit&, int, int) const {}
    static constexpr bool PERM = true, AFTER_DRAIN = false;
    bf16_t* M; const bf16_t* G;
    DEV void operator()(const Acc& acc, const Unit& u, int wr, int wc, int fr, int fq, const PreNone&) const {
        EPI_ROWS(u); const size_t cofs = (size_t)u.pn * 256 + wc * 32 + 8 * fq; const bf16_t* gb = G + (size_t)u.job * T * D;
#pragma unroll
        for (int ai = 0; ai < 2; ++ai) {
            u32x4 g[8], p[8];
#pragma unroll
            for (int m = 0; m < 4; ++m)
#pragma unroll
                for (int bj = 0; bj < 2; ++bj) { const size_t o = (size_t)(row0 + ai * HALF + m * 16) * D + cofs + bj * HALF; g[2 * m + bj] = *(const u32x4*)(gb + o);
                    if (u.job > 0) p[2 * m + bj] = __builtin_nontemporal_load((const u32x4*)(M + o)); }
#pragma unroll
            for (int m = 0; m < 4; ++m)
#pragma unroll
                for (int bj = 0; bj < 2; ++bj) { const size_t o = (size_t)(row0 + ai * HALF + m * 16) * D + cofs + bj * HALF; const u32x4 gg = g[2 * m + bj];
                    f32x4 v0 = acc[ai][bj][m][0], v1 = acc[ai][bj][m][1];
                    v0[0] *= bflo(gg.x); v0[1] *= bfhi(gg.x); v0[2] *= bflo(gg.y); v0[3] *= bfhi(gg.y); v1[0] *= bflo(gg.z); v1[1] *= bfhi(gg.z); v1[2] *= bflo(gg.w); v1[3] *= bfhi(gg.w);
                    if (u.job > 0) { const u32x4 pp = p[2 * m + bj];
                        v0[0] += bflo(pp.x); v0[1] += bfhi(pp.x); v0[2] += bflo(pp.y); v0[3] += bfhi(pp.y); v1[0] += bflo(pp.z); v1[1] += bfhi(pp.z); v1[2] += bflo(pp.w); v1[3] += bfhi(pp.w); }
                    *(u32x4*)(M + o) = pack8(v0, v1); }
        }
    }
};
struct EpiMergeC {
    typedef PreNone Pre;
    DEV void prefetch(PreNone&, const Unit&, int, int) const {}
    static constexpr bool PERM = true, AFTER_DRAIN = false, CHAIN = true;
    bf16_t* M; const bf16_t* G;
    static DEV float gl(unsigned w) { return fmaxf(bflo(w), 9.094947e-13f); }
    static DEV float gh(unsigned w) { return fmaxf(bfhi(w), 9.094947e-13f); }
    DEV void operator()(Acc& acc, const Unit& u, int wr, int wc, int fr, int fq, const PreNone&) const {
        EPI_ROWS(u); const size_t cofs = (size_t)u.pn * 256 + wc * 32 + 8 * fq; const bf16_t* gb = G + (size_t)u.job * T * D; const bool lastj = u.job == 2;
#pragma unroll
        for (int ai = 0; ai < 2; ++ai) {
            u32x4 g[8], gn[8];
#pragma unroll
            for (int m = 0; m < 4; ++m)
#pragma unroll
                for (int bj = 0; bj < 2; ++bj) { const size_t o = (size_t)(row0 + ai * HALF + m * 16) * D + cofs + bj * HALF; g[2 * m + bj] = *(const u32x4*)(gb + o);
                    if (!lastj) gn[2 * m + bj] = *(const u32x4*)(gb + (size_t)T * D + o); }
#pragma unroll
            for (int m = 0; m < 4; ++m)
#pragma unroll
                for (int bj = 0; bj < 2; ++bj) { const u32x4 a = g[2 * m + bj]; f32x4 s0 = {gl(a.x), gh(a.x), gl(a.y), gh(a.y)}, s1 = {gl(a.z), gh(a.z), gl(a.w), gh(a.w)};
                    if (!lastj) { const u32x4 b = gn[2 * m + bj];
                        s0[0] *= __builtin_amdgcn_rcpf(gl(b.x)); s0[1] *= __builtin_amdgcn_rcpf(gh(b.x)); s0[2] *= __builtin_amdgcn_rcpf(gl(b.y)); s0[3] *= __builtin_amdgcn_rcpf(gh(b.y));
                        s1[0] *= __builtin_amdgcn_rcpf(gl(b.z)); s1[1] *= __builtin_amdgcn_rcpf(gh(b.z)); s1[2] *= __builtin_amdgcn_rcpf(gl(b.w)); s1[3] *= __builtin_amdgcn_rcpf(gh(b.w)); }
                    acc[ai][bj][m][0] = acc[ai][bj][m][0] * s0; acc[ai][bj][m][1] = acc[ai][bj][m][1] * s1;
                    if (lastj) { const size_t o = (size_t)(row0 + ai * HALF + m * 16) * D + cofs + bj * HALF; *(u32x4*)(M + o) = pack8(acc[ai][bj][m][0], acc[ai][bj][m][1]); } }
        }
    }
};
template <bool IN_F32> struct EpiResid {
    typedef PreNone Pre;
    DEV void prefetch(PreNone&, const Unit&, int, int) const {}
    static constexpr bool PERM = true, AFTER_DRAIN = false;
    const void* xin; bf16_t* xb; u64* ss;
    DEV void operator()(const Acc& acc, const Unit& u, int wr, int wc, int fr, int fq, const PreNone&) const {
        EPI_ROWS(u); const size_t cofs = (size_t)u.pn * 256 + wc * 32 + 8 * fq;
#pragma unroll
        for (int ai = 0; ai < 2; ++ai) {
            f32x4 r0[8], r1[8];
#pragma unroll
            for (int m = 0; m < 4; ++m)
#pragma unroll
                for (int bj = 0; bj < 2; ++bj) { const size_t o = (size_t)(row0 + ai * HALF + m * 16) * D + cofs + bj * HALF; const int k = 2 * m + bj;
                    if (IN_F32) { r0[k] = *(const f32x4*)((const float*)xin + o); r1[k] = *(const f32x4*)((const float*)xin + o + 4); }
                    else { const u32x4 p = *(const u32x4*)((const bf16_t*)xin + o); r0[k] = __builtin_bit_cast(f32x4, p); } }
#pragma unroll
            for (int m = 0; m < 4; ++m) { const size_t ro = (size_t)(row0 + ai * HALF + m * 16) * D + cofs; float sq = 0.f;
#pragma unroll
                for (int bj = 0; bj < 2; ++bj) { const size_t o = ro + bj * HALF; const int k = 2 * m + bj; f32x4 v0 = acc[ai][bj][m][0], v1 = acc[ai][bj][m][1];
                    if (IN_F32) { v0 = v0 + r0[k]; v1 = v1 + r1[k]; }
                    else { const u32x4 p = __builtin_bit_cast(u32x4, r0[k]);
                        v0[0] += bflo(p.x); v0[1] += bfhi(p.x); v0[2] += bflo(p.y); v0[3] += bfhi(p.y); v1[0] += bflo(p.z); v1[1] += bfhi(p.z); v1[2] += bflo(p.w); v1[3] += bfhi(p.w); }
                    *(u32x4*)(xb + o) = pack8(v0, v1);
                    sq += ((v0[0] * v0[0] + v0[1] * v0[1]) + (v0[2] * v0[2] + v0[3] * v0[3])) + ((v1[0] * v1[0] + v1[1] * v1[1]) + (v1[2] * v1[2] + v1[3] * v1[3])); }
                sq += __shfl_xor(sq, 16); sq += __shfl_xor(sq, 32);
                if (fq == 0) atomicAdd(ss + row0 + ai * HALF + m * 16, (u64)(sq * SS_SCALE + 0.5f)); }
        }
    }
};
DEV float gelu_t(float a) { return a * __builtin_amdgcn_rcpf(1.f + __builtin_amdgcn_exp2f(-1.5957691216057308f * LOG2E * (a + 0.044715f * a * a * a))); }
DEV float row_prev1(float cur, float prevm) { const int r = __builtin_amdgcn_update_dpp(0, (int)__float_as_uint(prevm), 0x121, 0xf, 0xf, false);
    return __uint_as_float((unsigned)__builtin_amdgcn_update_dpp(r, (int)__float_as_uint(cur), 0x111, 0xf, 0xf, false)); }
DEV float row_prev2(float cur, float prevm) { const int r = __builtin_amdgcn_update_dpp(0, (int)__float_as_uint(prevm), 0x122, 0xf, 0xf, false);
    return __uint_as_float((unsigned)__builtin_amdgcn_update_dpp(r, (int)__float_as_uint(cur), 0x112, 0xf, 0xf, false)); }
struct EpiUpF {
    typedef PreRs Pre;
    DEV void prefetch(PreRs& p, const Unit& u, int wr, int fr) const { pre_rs(p, ss, u.pm * BM + wr * 64 + fr); }
    static constexpr bool PERM = true, AFTER_DRAIN = false;
    bf16_t *fu, *sa, *su; const u64* ss; const float *cw, *cb;
    DEV void operator()(const Acc& acc, const Unit& u, int wr, int wc, int fr, int fq, const PreRs& pre) const {
        EPI_ROWS(u); float rs[2][4]; rs_of(rs, pre); const size_t cofs = (size_t)u.pn * 128 + wc * 32 + 8 * fq;
        f32x4 w0[2], w1[2], w2[2], bb[2];
#pragma unroll
        for (int n = 0; n < 2; ++n) { w0[n] = *(const f32x4*)(cw + cofs + 4 * n); w1[n] = *(const f32x4*)(cw + DFF + cofs + 4 * n); w2[n] = *(const f32x4*)(cw + 2 * DFF + cofs + 4 * n); bb[n] = *(const f32x4*)(cb + cofs + 4 * n); }
#pragma unroll
        for (int ai = 0; ai < 2; ++ai) {
            const size_t strip = (size_t)u.pm * 4 + ai * 2 + wr;
            f32x4 ap[2] = {{0.f, 0.f, 0.f, 0.f}, {0.f, 0.f, 0.f, 0.f}};
#pragma unroll
            for (int m = 0; m < 4; ++m) {
                f32x4 a[2], g[2];
#pragma unroll
                for (int n = 0; n < 2; ++n) { a[n] = acc[ai][0][m][n] * rs[ai][m];
#pragma unroll
                    for (int e = 0; e < 4; ++e) { const float a1 = row_prev1(a[n][e], ap[n][e]), a2 = row_prev2(a[n][e], ap[n][e]);
                        g[n][e] = gelu_t(bb[n][e] + w0[n][e] * a2 + w1[n][e] * a1 + w2[n][e] * a[n][e]) * (acc[ai][1][m][n][e] * rs[ai][m]); } }
                if (m == 0) {
                    if (fr < 2) { *(u32x4*)(sa + (strip * 4 + fr) * DFF + cofs) = pack8(a[0], a[1]); *(u32x4*)(su + (strip * 2 + fr) * DFF + cofs) = pack8(acc[ai][1][0][0] * rs[ai][0], acc[ai][1][0][1] * rs[ai][0]); }
                    else *(u32x4*)(fu + (size_t)(row0 + ai * HALF) * DFF + cofs) = pack8(g[0], g[1]);
                } else {
                    *(u32x4*)(fu + (size_t)(row0 + ai * HALF + m * 16) * DFF + cofs) = pack8(g[0], g[1]);
                    if (m == 3 && fr >= 14) *(u32x4*)(sa + (strip * 4 + 2 + (fr - 14)) * DFF + cofs) = pack8(a[0], a[1]);
                }
                ap[0] = a[0]; ap[1] = a[1];
            }
        }
    }
};
struct EpiPrep {
    typedef PreNone Pre;
    DEV void prefetch(PreNone&, const Unit&, int, int) const {}
    static constexpr bool PERM = true, AFTER_DRAIN = false;
    unsigned char* ws; int mode;
    DEV void operator()(const Acc& acc, const Unit& u, int wr, int wc, int fr, int fq, const PreNone&) const {
        EPI_ROWS(u); bf16_t* base; int ldc; float sc = 1.f;
        if (mode == 0) { base = (bf16_t*)(ws + WS_KVM + (size_t)u.job * 2 * MiB); ldc = 2 * D; }
        else if (mode == 1) { base = (bf16_t*)(ws + WS_GT + (size_t)(u.job >> 2) * 2 * MiB) + (size_t)(u.job & 3) * 256 * D; ldc = D; sc = XSCALE; }
        else { base = (bf16_t*)(ws + WS_HT + (size_t)(u.job >> 2) * 2 * MiB) + (u.job & 3) * 256; ldc = D; }
        base += (size_t)u.pn * 256 + wc * 32 + 8 * fq;
#pragma unroll
        for (int ai = 0; ai < 2; ++ai)
#pragma unroll
            for (int m = 0; m < 4; ++m) { bf16_t* rowp = base + (size_t)(row0 + ai * HALF + m * 16) * ldc;
#pragma unroll
                for (int bj = 0; bj < 2; ++bj) *(u32x4*)(rowp + bj * HALF) = pack8(acc[ai][bj][m][0] * sc, acc[ai][bj][m][1] * sc); }
    }
};
struct EpiSoftmax {
    typedef PreRs Pre;
    DEV void prefetch(PreRs& p, const Unit& u, int wr, int fr) const { pre_rs(p, ss, u.pm * BM + wr * 64 + fr); }
    static constexpr bool PERM = true, AFTER_DRAIN = true;
    bf16_t* P; const u64* ss;
    DEV void fused(Acc& acc, const Unit& u, int wr, int wc, int fr, int fq, LAS unsigned char* lds, int wid, int lane, const PreRs& pre) const {
        LAS float* PM = (LAS float*)lds; LAS float* PS = (LAS float*)(lds + 4096);
        { const int row0_ = u.pm * BM + wr * 64 + fr; float rs[2][4]; rs_of(rs, pre);
#pragma unroll
          for (int ai = 0; ai < 2; ++ai)
#pragma unroll
              for (int m = 0; m < 4; ++m)
#pragma unroll
                  for (int bj = 0; bj < 2; ++bj)
#pragma unroll
                      for (int n = 0; n < 2; ++n) acc[ai][bj][m][n] = acc[ai][bj][m][n] * rs[ai][m]; }
#pragma unroll
        for (int ai = 0; ai < 2; ++ai)
#pragma unroll
            for (int m = 0; m < 4; ++m) { float mx = -INFINITY;
#pragma unroll
                for (int bj = 0; bj < 2; ++bj)
#pragma unroll
                    for (int n = 0; n < 2; ++n) { const f32x4 x = acc[ai][bj][m][n]; mx = fmaxf(mx, fmaxf(fmaxf(x[0], x[1]), fmaxf(x[2], x[3]))); }
                mx = fmaxf(mx, __shfl_xor(mx, 16)); mx = fmaxf(mx, __shfl_xor(mx, 32));
                if (fq == 0) PM[(ai * HALF + wr * 64 + m * 16 + fr) * 4 + wc] = mx; }
        LDS_WAIT(); __builtin_amdgcn_s_barrier(); asm volatile("" ::: "memory");
#pragma unroll
        for (int ai = 0; ai < 2; ++ai)
#pragma unroll
            for (int m = 0; m < 4; ++m) { const int r = ai * HALF + wr * 64 + m * 16 + fr; const f32x4 q = *(const LAS f32x4*)(PM + r * 4);
                const float mx = fmaxf(fmaxf(q[0], q[1]), fmaxf(q[2], q[3])); float s = 0.f;
#pragma unroll
                for (int bj = 0; bj < 2; ++bj)
#pragma unroll
                    for (int n = 0; n < 2; ++n) { f32x4 x = acc[ai][bj][m][n];
#pragma unroll
                        for (int i = 0; i < 4; ++i) { x[i] = __builtin_amdgcn_exp2f(x[i] - mx); s += x[i]; } acc[ai][bj][m][n] = x; }
                s += __shfl_xor(s, 16); s += __shfl_xor(s, 32);
                if (fq == 0) PS[r * 4 + wc] = s; }
        LDS_WAIT(); __builtin_amdgcn_s_barrier(); asm volatile("" ::: "memory");
        EPI_ROWS(u); bf16_t* base = P + (size_t)u.pn * 256 + wc * 32 + 8 * fq;
#pragma unroll
        for (int ai = 0; ai < 2; ++ai)
#pragma unroll
            for (int m = 0; m < 4; ++m) { const int r = ai * HALF + wr * 64 + m * 16 + fr; const f32x4 q = *(const LAS f32x4*)(PS + r * 4);
                const float inv = 1.f / ((q[0] + q[1]) + (q[2] + q[3])); bf16_t* rowp = base + (size_t)(row0 + ai * HALF + m * 16) * D;
#pragma unroll
                for (int bj = 0; bj < 2; ++bj) *(u32x4*)(rowp + bj * HALF) = pack8(acc[ai][bj][m][0] * inv, acc[ai][bj][m][1] * inv); }
        LDS_WAIT(); __builtin_amdgcn_s_barrier();
    }
};
}

typedef GAS unsigned gu32;
#define XB_TMO      128
#define XB_XCNT(j)  (256  + 64 * (j))
#define XB_XSUB(j)  (1280 + 64 * (j))
#define XB_XGEN(j)  (2304 + 64 * (j))
#define XB_TOP      3328
#define XB_TOPGEN   3392
#define XCD_BAR_WORDS 3456
#define XB_SPIN_CAP (1u << 22)
DEV unsigned xb_ld(unsigned* p) { return __hip_atomic_load(p, __ATOMIC_RELAXED, __HIP_MEMORY_SCOPE_AGENT); }
DEV unsigned xb_add(unsigned* p, unsigned v) { return __hip_atomic_fetch_add(p, v, __ATOMIC_RELAXED, __HIP_MEMORY_SCOPE_AGENT); }
DEV unsigned xb_xcc_id() { return (unsigned)__builtin_amdgcn_s_getreg((3 << 11) | 20) & 0xFu; }
#define XB_SPIN(cond, bar) do { unsigned _sp = 0; while (cond) { __builtin_amdgcn_s_sleep(1); \
    if ((++_sp & 255u) == 0u) { if (xb_ld(&(bar)[XB_TMO])) break; if (_sp > XB_SPIN_CAP) { atomicAdd(&(bar)[XB_TMO], 1u); break; } } } } while (0)
struct XcdBarrier { unsigned* bar; unsigned x; volatile LAS unsigned* st; };
DEV XcdBarrier xcd_barrier_post(unsigned* bar, volatile LAS unsigned* st, int tid) {
    XcdBarrier b; b.bar = bar; b.x = xb_xcc_id(); b.st = st;
    if (tid == 0) (void)xb_add(&bar[XB_XCNT(b.x)], 1u);
    return b;
}
DEV void xcd_barrier_complete(unsigned* bar, unsigned x, unsigned& nloc, unsigned& nx) {
    const unsigned G = gridDim.x * gridDim.y * gridDim.z;
    unsigned sum, cnt, mine, sp = 0u;
    for (;;) {
        sum = 0u; cnt = 0u; mine = 0u;
#pragma unroll
        for (unsigned j = 0; j < 16; ++j) { const unsigned c = xb_ld(&bar[XB_XCNT(j)]); sum += c; cnt += (c > 0u) ? 1u : 0u; mine = (j == x) ? c : mine; }
        if (sum == G) break;
        __builtin_amdgcn_s_sleep(1);
        if ((++sp & 255u) == 0u) { if (xb_ld(&bar[XB_TMO])) break; if (sp > XB_SPIN_CAP) { atomicAdd(&bar[XB_TMO], 1u); break; } }
    }
    nloc = mine > 0u ? mine : 1u; nx = cnt > 0u ? cnt : 1u;
}
#define XB_BADMAP 192
DEV void xcd_barrier_local(const XcdBarrier& b, int tid) {
    asm volatile("s_waitcnt vmcnt(0)" ::: "memory");
    __syncthreads();
    if (tid == 0) {
        unsigned* bar = b.bar;
        __builtin_amdgcn_s_waitcnt(0);
        const unsigned nloc = b.st[0];
        const unsigned old = xb_add(&bar[XB_XSUB(b.x)], 1u);
        const unsigned gen = old / nloc;
        if (old + 1u == (gen + 1u) * nloc) xb_add(&bar[XB_XGEN(b.x)], 1u);
        else XB_SPIN(xb_ld(&bar[XB_XGEN(b.x)]) == gen, bar);
        __builtin_amdgcn_fence(__ATOMIC_ACQUIRE, "agent");
        asm volatile("s_waitcnt vmcnt(0)" ::: "memory");
    }
    __syncthreads();
}
DEV void xcd_barrier(const XcdBarrier& b, int tid) {
    asm volatile("s_waitcnt vmcnt(0)" ::: "memory");
    __syncthreads();
    if (tid == 0) {
        unsigned* bar = b.bar;
        __builtin_amdgcn_s_waitcnt(0);
        unsigned nloc = b.st[0], nx = b.st[1];
        if (nloc == 0u) { xcd_barrier_complete(bar, b.x, nloc, nx); b.st[0] = nloc; b.st[1] = nx; }
        const unsigned old = xb_add(&bar[XB_XSUB(b.x)], 1u);
        const unsigned gen = old / nloc;
        if (old + 1u == (gen + 1u) * nloc) {
            __builtin_amdgcn_fence(__ATOMIC_RELEASE, "agent");
            asm volatile("s_waitcnt vmcnt(0)" ::: "memory");
            const unsigned og = xb_add(&bar[XB_TOP], 1u);
            const unsigned tg = og / nx;
            if (og + 1u == (tg + 1u) * nx) xb_add(&bar[XB_TOPGEN], 1u);
            else XB_SPIN(xb_ld(&bar[XB_TOPGEN]) == tg, bar);
            __builtin_amdgcn_fence(__ATOMIC_ACQUIRE, "agent");
            xb_add(&bar[XB_XGEN(b.x)], 1u);
            asm volatile("s_waitcnt vmcnt(0)" ::: "memory");
        } else {
            XB_SPIN(xb_ld(&bar[XB_XGEN(b.x)]) == gen, bar);
            __builtin_amdgcn_fence(__ATOMIC_ACQUIRE, "agent");
            asm volatile("s_waitcnt vmcnt(0)" ::: "memory");
        }
    }
    __syncthreads();
}


using pg8::gelu_t;
struct WaveId { int gw, ngw, wave, lane; };
DEV unsigned f2bf_u(float f) { return (unsigned)f2bf(f); }
DEV unsigned pk2(float lo, float hi) { return cvt_pk_bf16(lo, hi); }

DEV void norm_rows(const WaveId& W, const float* x, const float* g, bf16_t* outb, float* outf, int rows) {
    for (int row = W.gw; row < rows; row += W.ngw) {
        const f32x4* xr = (const f32x4*)(x + (size_t)row * D) + W.lane;
        f32x4 v[4]; float s = 0.f;
#pragma unroll
        for (int j = 0; j < 4; ++j) { v[j] = xr[64 * j]; s += (v[j].x * v[j].x + v[j].y * v[j].y) + (v[j].z * v[j].z + v[j].w * v[j].w); }
        const float r = rsqrtf(wave_sum(s) * (1.f / D) + EPS);
#pragma unroll
        for (int j = 0; j < 4; ++j) {
            const f32x4 gg = ((const f32x4*)g)[W.lane + 64 * j];
            const f32x4 o = {v[j].x * r * gg.x, v[j].y * r * gg.y, v[j].z * r * gg.z, v[j].w * r * gg.w};
            if (outb) { u32x2 w; w.x = pk2(o.x, o.y); w.y = pk2(o.z, o.w); ((u32x2*)(outb + (size_t)row * D))[W.lane + 64 * j] = w; }
            else ((f32x4*)(outf + (size_t)row * D))[W.lane + 64 * j] = o;
        }
    }
}
DEV void cvt_piece(const WaveId& W, LAS float* scr, int& base, const float* Wsrc, int ldw, int K, int col0, int ncols, bf16_t* dst, int ldo, int row0, const float* gain = nullptr) {
    const int nblk = ncols / 32, nitems = (K / 64) * nblk;
    int first = (W.gw - base) % W.ngw; if (first < 0) first += W.ngw;
    base = (base + nitems) % W.ngw;
    for (int item = first; item < nitems; item += W.ngw) {
        const int kb = item / nblk, nb = item - kb * nblk, k0 = 64 * kb, n0 = 32 * nb;
        { const int lr = W.lane >> 3, lc = (W.lane & 7) * 4;
          f32x4 v[8]; float g[8];
#pragma unroll
          for (int i = 0; i < 8; ++i) { v[i] = *(const f32x4*)(Wsrc + (size_t)(k0 + lr + 8 * i) * ldw + col0 + n0 + lc); g[i] = gain ? gain[k0 + lr + 8 * i] : 1.f; }
#pragma unroll
          for (int i = 0; i < 8; ++i) { LAS float* d = scr + (lr + 8 * i) * 33 + lc; d[0] = v[i][0] * g[i]; d[1] = v[i][1] * g[i]; d[2] = v[i][2] * g[i]; d[3] = v[i][3] * g[i]; } }
        LDS_WAIT(); asm volatile("" ::: "memory");
        const int c = W.lane & 7;
#pragma unroll
        for (int j = 0; j < 4; ++j) { const int n = (W.lane >> 3) + 8 * j; const LAS float* s = scr + (8 * c) * 33 + n;
            u32x4 o; o.x = pk2(s[0 * 33], s[1 * 33]); o.y = pk2(s[2 * 33], s[3 * 33]); o.z = pk2(s[4 * 33], s[5 * 33]); o.w = pk2(s[6 * 33], s[7 * 33]);
            *(u32x4*)(dst + (size_t)(row0 + n0 + n) * ldo + k0 + 8 * c) = o; }
        LDS_WAIT(); asm volatile("" ::: "memory");
    }
}
DEV void convert_layer_weights(const WaveId& W, LAS float* scr, int& base, unsigned char* ws, const float* const* in, int l, int part = 7) {
    const float* wi = in[3] + (size_t)l * D * DIN;
    if (part & 1) {
    bf16_t* WIN = (bf16_t*)(ws + WS_WIN); const float* gm = in[2] + l * D;
    cvt_piece(W, scr, base, wi, DIN, D, 0, 1536, WIN, D, 0, gm);
    cvt_piece(W, scr, base, wi, DIN, D, 3072, 1536, WIN, D, 1536, gm);
    cvt_piece(W, scr, base, wi, DIN, D, 4608, 512, WIN, D, 3072, gm);
    cvt_piece(W, scr, base, wi, DIN, D, 1536, 512, WIN, D, 3584, gm);
#pragma unroll 1
    for (int j = 0; j < 4; ++j) { cvt_piece(W, scr, base, wi, DIN, D, 2048 + 128 * j, 128, WIN, D, 4096 + 256 * j, gm); cvt_piece(W, scr, base, wi, DIN, D, 2560 + 128 * j, 128, WIN, D, 4096 + 256 * j + 128, gm); }
    cvt_piece(W, scr, base, wi, DIN, D, 5120, 96, WIN, D, 5120, gm);
    cvt_piece(W, scr, base, wi, DIN, D, 5192, 3072, (bf16_t*)(ws + WS_WG), D, 0, gm);
#pragma unroll 1
    for (int i = 0; i < 3; ++i) cvt_piece(W, scr, base, in[5 + i] + (size_t)l * 512 * D, D, 512, 0, D, (bf16_t*)(ws + WS_WBR) + (size_t)i * D * 512, 512, 0);
    cvt_piece(W, scr, base, in[8] + (size_t)l * D * D, D, D, 0, D, (bf16_t*)(ws + WS_WMIX), D, 0);
    }
    if (part & 2) {
    const float* gf = in[14] + l * D;
    const float* wf = in[15] + (size_t)l * D * 2 * DFF;
#pragma unroll 1
    for (int j = 0; j < 22; ++j) { cvt_piece(W, scr, base, wf, 2 * DFF, D, 128 * j, 128, (bf16_t*)(ws + WS_WUP), D, 256 * j, gf); cvt_piece(W, scr, base, wf, 2 * DFF, D, DFF + 128 * j, 128, (bf16_t*)(ws + WS_WUP), D, 256 * j + 128, gf); }
    }
    if (part & 4) cvt_piece(W, scr, base, in[18] + (size_t)l * DFF * D, D, DFF, 0, D, (bf16_t*)(ws + WS_WDOWN), DFF, 0);
}
DEV void prep0_phase(const WaveId& W, LAS float* scr, unsigned char* ws, const float* const* in, bf16_t* XB) {
    int base = 0;
#pragma unroll 1
    for (int l = 0; l < DEPTH; ++l) {
        const float* wq = in[11] + (size_t)l * D * D; bf16_t* WQ = (bf16_t*)(ws + WS_WQ + (size_t)l * 2 * MiB); const float* gx = in[9] + l * D;
        for (size_t i = (size_t)(W.gw * 64 + W.lane) * 4; i < (size_t)D * D; i += (size_t)W.ngw * 256) { const float g = gx[i >> 10]; const f32x4 v = *(const f32x4*)(wq + i); u32x2 o; o.x = pk2(v.x * g, v.y * g); o.y = pk2(v.z * g, v.w * g); *(u32x2*)(WQ + i) = o; }
        cvt_piece(W, scr, base, in[13] + (size_t)l * D * D, D, D, 0, D, (bf16_t*)(ws + WS_WOT + (size_t)l * 2 * MiB), D, 0);
        cvt_piece(W, scr, base, in[12] + (size_t)l * D * 2 * D, 2 * D, D, 0, 2 * D, (bf16_t*)(ws + WS_WKVT + (size_t)l * 4 * MiB), D, 0);
        norm_rows(W, in[1], in[10] + l * D, (bf16_t*)(ws + WS_MEMN + (size_t)l * MiB), nullptr, NB * MEM);
    }
    convert_layer_weights(W, scr, base, ws, in, 0);
    pg8::u64* ss0 = (pg8::u64*)(ws + WS_SS);
    { unsigned zz = 0u; asm volatile("" : "+v"(zz)); const u32x4 z = {zz, zz, zz, zz};
      for (int i = W.gw * 64 + W.lane; i < 6 * T * 8 / 16; i += W.ngw * 64) ((u32x4*)(ss0 + T))[i] = z; }
    for (int row0 = W.gw; row0 < T; row0 += 4 * W.ngw) {
        f32x4 v[4][4];
#pragma unroll
        for (int u = 0; u < 4; ++u) { const f32x4* xr = (const f32x4*)(in[0] + (size_t)(row0 + u * W.ngw) * D) + W.lane;
#pragma unroll
            for (int j = 0; j < 4; ++j) v[u][j] = xr[64 * j]; }
#pragma unroll
        for (int u = 0; u < 4; ++u) { const int row = row0 + u * W.ngw; float s = 0.f;
#pragma unroll
            for (int j = 0; j < 4; ++j) { const f32x4 x = v[u][j]; s += (x.x * x.x + x.y * x.y) + (x.z * x.z + x.w * x.w);
                u32x2 w; w.x = pk2(x.x, x.y); w.y = pk2(x.z, x.w); ((u32x2*)(XB + (size_t)row * D))[W.lane + 64 * j] = w; }
            s = wave_sum(s); if (W.lane == 0) ss0[row] = (pg8::u64)(s * pg8::SS_SCALE + 0.5f); }
    }
}
DEV void final_norm(const WaveId& W, const bf16_t* x, float* out, const float* g, const pg8::u64* ss) {
    f32x4 gg[4];
#pragma unroll
    for (int j = 0; j < 4; ++j) gg[j] = ((const f32x4*)g)[W.lane + 64 * j];
    for (int row0 = W.gw; row0 < T; row0 += 4 * W.ngw) {
        u32x2 v[4][4]; pg8::u64 sq[4];
#pragma unroll
        for (int u = 0; u < 4; ++u) { const int row = row0 + u * W.ngw; sq[u] = ss[row]; const u32x2* xr = (const u32x2*)(x + (size_t)row * D) + W.lane;
#pragma unroll
            for (int j = 0; j < 4; ++j) v[u][j] = xr[64 * j]; }
#pragma unroll
        for (int u = 0; u < 4; ++u) { const int row = row0 + u * W.ngw; const float r = rsqrtf((float)sq[u] * (1.f / (pg8::SS_SCALE * D)) + EPS); f32x4* orow = (f32x4*)(out + (size_t)row * D) + W.lane;
#pragma unroll
            for (int j = 0; j < 4; ++j) { const u32x2 w = v[u][j];
                const f32x4 o = {bflo(w.x) * r * gg[j].x, bfhi(w.x) * r * gg[j].y, bflo(w.y) * r * gg[j].z, bfhi(w.y) * r * gg[j].w}; orow[64 * j] = o; } }
    }
}
DEV void conv_sc_phase(int gtid, int gthreads, bf16_t* scb, const bf16_t* cx, const float* w, bool dry) {
    const int c8 = (gtid & 63) * 8;
    const f32x4 w0a = *(const f32x4*)(w + c8), w0b = *(const f32x4*)(w + c8 + 4), w1a = *(const f32x4*)(w + 512 + c8), w1b = *(const f32x4*)(w + 512 + c8 + 4), w2a = *(const f32x4*)(w + 1024 + c8), w2b = *(const f32x4*)(w + 1024 + c8 + 4);
    const u32x4 z = {0u, 0u, 0u, 0u};
    for (int i0 = gtid; i0 < T * 64; i0 += 4 * gthreads) {
        u32x4 x2[4], x1[4], x0[4], bb[4];
#pragma unroll
        for (int u = 0; u < 4; ++u) { const int i = i0 + u * gthreads; if (i < T * 64) { const int t = i >> 6, tl = t & (S - 1); const size_t o = (size_t)t * 512 + c8;
            x2[u] = *(const u32x4*)(cx + o); x1[u] = tl >= 1 ? *(const u32x4*)(cx + o - 512) : z; x0[u] = tl >= 2 ? *(const u32x4*)(cx + o - 1024) : z; bb[u] = *(const u32x4*)(scb + o); } }
#pragma unroll
        for (int u = 0; u < 4; ++u) { const int i = i0 + u * gthreads; if (i < T * 64) { const size_t o = (size_t)(i >> 6) * 512 + c8;
            float r[8];
#define CONV1(k, W0, W1, W2, X0, X1, X2, BBv, F) r[k] = F(BBv) * (W0 * F(X0) + W1 * F(X1) + W2 * F(X2))
            CONV1(0, w0a.x, w1a.x, w2a.x, x0[u].x, x1[u].x, x2[u].x, bb[u].x, bflo); CONV1(1, w0a.y, w1a.y, w2a.y, x0[u].x, x1[u].x, x2[u].x, bb[u].x, bfhi);
            CONV1(2, w0a.z, w1a.z, w2a.z, x0[u].y, x1[u].y, x2[u].y, bb[u].y, bflo); CONV1(3, w0a.w, w1a.w, w2a.w, x0[u].y, x1[u].y, x2[u].y, bb[u].y, bfhi);
            CONV1(4, w0b.x, w1b.x, w2b.x, x0[u].z, x1[u].z, x2[u].z, bb[u].z, bflo); CONV1(5, w0b.y, w1b.y, w2b.y, x0[u].z, x1[u].z, x2[u].z, bb[u].z, bfhi);
            CONV1(6, w0b.z, w1b.z, w2b.z, x0[u].w, x1[u].w, x2[u].w, bb[u].w, bflo); CONV1(7, w0b.w, w1b.w, w2b.w, x0[u].w, x1[u].w, x2[u].w, bb[u].w, bfhi);
#undef CONV1
            u32x4 ov; ov.x = pk2(r[0], r[1]); ov.y = pk2(r[2], r[3]); ov.z = pk2(r[4], r[5]); ov.w = pk2(r[6], r[7]);
            if (!dry) *(u32x4*)(scb + o) = ov; else asm volatile("" :: "v"(ov)); } }
    }
}
DEV void ffn_fix_phase(int gtid, int gthreads, const bf16_t* sa, const bf16_t* su, bf16_t* fu, const float* cw, const float* cb, int strip0 = 0, int nstrip = T / 64) {
    constexpr int C8 = DFF / 8; const u32x4 z = {0u, 0u, 0u, 0u};
    for (int i0 = gtid; i0 < nstrip * 2 * C8; i0 += 3 * gthreads) {
        u32x4 x2[3], x1[3], x0[3], uu[3];
#pragma unroll
        for (int q = 0; q < 3; ++q) { const int i = i0 + q * gthreads; if (i < nstrip * 2 * C8) {
            const int sr = i / C8, c8 = (i - sr * C8) * 8, strip = strip0 + (sr >> 1), rr = sr & 1;
            const bool first = (strip & (S / 64 - 1)) == 0;
            const bf16_t* A = sa + (size_t)strip * 4 * DFF + c8; const bf16_t* Ap = A - 4 * DFF;
            x2[q] = *(const u32x4*)(A + rr * DFF);
            x1[q] = rr == 1 ? *(const u32x4*)A : (first ? z : *(const u32x4*)(Ap + 3 * DFF));
            x0[q] = first ? z : *(const u32x4*)(Ap + (2 + rr) * DFF);
            uu[q] = *(const u32x4*)(su + ((size_t)strip * 2 + rr) * DFF + c8); } }
#pragma unroll
        for (int q = 0; q < 3; ++q) { const int i = i0 + q * gthreads; if (i < nstrip * 2 * C8) {
            const int sr = i / C8, c8 = (i - sr * C8) * 8, strip = strip0 + (sr >> 1), rr = sr & 1, t = strip * 64 + rr;
            const f32x4 w0a = *(const f32x4*)(cw + c8), w0b = *(const f32x4*)(cw + c8 + 4), w1a = *(const f32x4*)(cw + DFF + c8), w1b = *(const f32x4*)(cw + DFF + c8 + 4), w2a = *(const f32x4*)(cw + 2 * DFF + c8), w2b = *(const f32x4*)(cw + 2 * DFF + c8 + 4);
            const f32x4 ba = *(const f32x4*)(cb + c8), bb = *(const f32x4*)(cb + c8 + 4);
            float r[8];
#define FM1(k, B0, W0, W1, W2, X0, X1, X2, Uv, F) r[k] = gelu_t(B0 + W0 * F(X0) + W1 * F(X1) + W2 * F(X2)) * F(Uv)
            FM1(0, ba.x, w0a.x, w1a.x, w2a.x, x0[q].x, x1[q].x, x2[q].x, uu[q].x, bflo); FM1(1, ba.y, w0a.y, w1a.y, w2a.y, x0[q].x, x1[q].x, x2[q].x, uu[q].x, bfhi);
            FM1(2, ba.z, w0a.z, w1a.z, w2a.z, x0[q].y, x1[q].y, x2[q].y, uu[q].y, bflo); FM1(3, ba.w, w0a.w, w1a.w, w2a.w, x0[q].y, x1[q].y, x2[q].y, uu[q].y, bfhi);
            FM1(4, bb.x, w0b.x, w1b.x, w2b.x, x0[q].z, x1[q].z, x2[q].z, uu[q].z, bflo); FM1(5, bb.y, w0b.y, w1b.y, w2b.y, x0[q].z, x1[q].z, x2[q].z, uu[q].z, bfhi);
            FM1(6, bb.z, w0b.z, w1b.z, w2b.z, x0[q].w, x1[q].w, x2[q].w, uu[q].w, bflo); FM1(7, bb.w, w0b.w, w1b.w, w2b.w, x0[q].w, x1[q].w, x2[q].w, uu[q].w, bfhi);
#undef FM1
            u32x4 ov; ov.x = pk2(r[0], r[1]); ov.y = pk2(r[2], r[3]); ov.z = pk2(r[4], r[5]); ov.w = pk2(r[6], r[7]);
            *(u32x4*)(fu + (size_t)t * DFF + c8) = ov; } }
    }
}

typedef short s16x4 __attribute__((ext_vector_type(4)));
DEV s16x4 vtr(const LAS unsigned char* p) { return __builtin_bit_cast(s16x4, __builtin_amdgcn_ds_read_tr16_b64_v4i16((LAS s16x4*)p)); }
DEV bf16x8 cat8(const s16x4 a, const s16x4 b) { return (bf16x8){a[0], a[1], a[2], a[3], b[0], b[1], b[2], b[3]}; }
DEV bf16x8 pk8(float a0, float a1, float a2, float a3, float a4, float a5, float a6, float a7) {
    u32x4 w; w.x = pk2(a0, a1); w.y = pk2(a2, a3); w.z = pk2(a4, a5); w.w = pk2(a6, a7); return __builtin_bit_cast(bf16x8, w); }
constexpr int VPITCH = 192;
DEV void pv_tile(f32x16& o0, f32x16& o1, const LAS unsigned char* vt, int lane, const bf16x8 (&pk)[4]) {
    const int hi = lane >> 5;
    const LAS unsigned char* vb = vt + (4 * hi + ((lane & 15) >> 2)) * VPITCH + ((lane >> 4) & 1) * 32 + (lane & 3) * 8;
    bf16x8 va[4];
#pragma unroll
    for (int ks = 0; ks < 4; ++ks) va[ks] = cat8(vtr(vb + (16 * ks) * VPITCH), vtr(vb + (16 * ks + 8) * VPITCH));
    asm volatile("" : "+v"(va[0]), "+v"(va[1]), "+v"(va[2]), "+v"(va[3]));
#pragma unroll
    for (int ks = 0; ks < 4; ++ks) o0 = __builtin_amdgcn_mfma_f32_32x32x16_bf16(va[ks], pk[ks], o0, 0, 0, 0);
#pragma unroll
    for (int ks = 0; ks < 4; ++ks) va[ks] = cat8(vtr(vb + (16 * ks) * VPITCH + 64), vtr(vb + (16 * ks + 8) * VPITCH + 64));
    asm volatile("" : "+v"(va[0]), "+v"(va[1]), "+v"(va[2]), "+v"(va[3]));
#pragma unroll
    for (int ks = 0; ks < 4; ++ks) o1 = __builtin_amdgcn_mfma_f32_32x32x16_bf16(va[ks], pk[ks], o1, 0, 0, 0);
}
DEV void store_ot(bf16_t* orow, const f32x16& o0, const f32x16& o1, int hi, float sc) {
#pragma unroll
    for (int g4 = 0; g4 < 4; ++g4) {
        u32x2 a; a.x = pk2(o0[4 * g4] * sc, o0[4 * g4 + 1] * sc); a.y = pk2(o0[4 * g4 + 2] * sc, o0[4 * g4 + 3] * sc);
        u32x2 b; b.x = pk2(o1[4 * g4] * sc, o1[4 * g4 + 1] * sc); b.y = pk2(o1[4 * g4 + 2] * sc, o1[4 * g4 + 3] * sc);
        *(u32x2*)(orow + 8 * g4 + 4 * hi) = a; *(u32x2*)(orow + 32 + 8 * g4 + 4 * hi) = b;
    }
}

DEV void sb_item(LAS unsigned char* vl, const bf16_t* Q, const bf16_t* Kk, const bf16_t* V, bf16_t* O, int b, int h, int qb, int lane, bool dry) {
    const int r32 = lane & 31, hi = lane >> 5, t0 = 32 * qb, t = t0 + r32; const size_t rowb = (size_t)b * S;
    bf16x8 qr[4]; { const bf16_t* qp = Q + (rowb + t0 + r32) * 512 + h * 64 + 8 * hi;
#pragma unroll
        for (int d0 = 0; d0 < 4; ++d0) qr[d0] = *(const bf16x8*)(qp + 16 * d0); }
    f32x16 o0, o1;
#pragma unroll
    for (int r = 0; r < 16; ++r) { o0[r] = 0.f; o1[r] = 0.f; }
    float carry = 1.f;
    const int c_hi = (t0 + 30) >> 6;
#pragma unroll 1
    for (int c = c_hi; c >= 0; --c) {
        const bf16_t* kp = Kk + (rowb + 64 * c + r32) * 512 + h * 64 + 8 * hi;
        bf16x8 k0[4], k1[4];
#pragma unroll
        for (int d0 = 0; d0 < 4; ++d0) { k0[d0] = *(const bf16x8*)(kp + 16 * d0); k1[d0] = *(const bf16x8*)(kp + (size_t)32 * 512 + 16 * d0); }
        u32x4 vreg[8];
#pragma unroll
        for (int j = 0; j < 8; ++j) { const int row = (lane >> 3) + 8 * j; vreg[j] = *(const u32x4*)(V + (rowb + 64 * c + row) * 512 + h * 64 + (lane & 7) * 8); }
        f32x16 p0, p1;
#pragma unroll
        for (int r = 0; r < 16; ++r) { p0[r] = 0.f; p1[r] = 0.f; }
#pragma unroll
        for (int d0 = 0; d0 < 4; ++d0) { p0 = __builtin_amdgcn_mfma_f32_32x32x16_bf16(k0[d0], qr[d0], p0, 0, 0, 0); p1 = __builtin_amdgcn_mfma_f32_32x32x16_bf16(k1[d0], qr[d0], p1, 0, 0, 0); }
        float u[32];
        const bool diag = (c == c_hi);
#pragma unroll
        for (int e = 0; e < 32; ++e) {
            const float z = e < 16 ? p0[e] : p1[e - 16];
            float uu = __builtin_amdgcn_rcpf(1.f + __builtin_amdgcn_exp2f(fminf(z, 126.f)));
            if (diag) { const int kv = 64 * c + 8 * ((e >> 2) & 3) + 4 * hi + (e & 3) + 32 * (e >> 4); if (kv >= t) uu = 1.f; }
            u[e] = uu;
        }
        float gl[8], gh[8];
#pragma unroll
        for (int i = 0; i < 8; ++i) { const float gp = (u[4 * i] * u[4 * i + 1]) * (u[4 * i + 2] * u[4 * i + 3]);
            const auto rr = __builtin_amdgcn_permlane32_swap(__float_as_uint(gp), __float_as_uint(gp), false, false); gl[i] = __uint_as_float(rr[0]); gh[i] = __uint_as_float(rr[1]); }
        float ag[8]; float run = carry;
#pragma unroll
        for (int i = 7; i >= 0; --i) { const float a_hi = run; run *= gh[i]; const float a_lo = run; run *= gl[i]; ag[i] = hi ? a_hi : a_lo; }
        carry = run;
        bf16x8 pk[4];
#pragma unroll
        for (int ks = 0; ks < 4; ++ks) { float w[8];
#pragma unroll
            for (int g = 0; g < 2; ++g) { const int i = 2 * ks + g;
                const float a3 = ag[i], a2 = a3 * u[4 * i + 3], a1 = a2 * u[4 * i + 2], a0 = a1 * u[4 * i + 1];
                w[4 * g] = (1.f - u[4 * i]) * a0; w[4 * g + 1] = (1.f - u[4 * i + 1]) * a1; w[4 * g + 2] = (1.f - u[4 * i + 2]) * a2; w[4 * g + 3] = (1.f - u[4 * i + 3]) * a3; }
            pk[ks] = pk8(w[0], w[1], w[2], w[3], w[4], w[5], w[6], w[7]); }
#pragma unroll
        for (int j = 0; j < 8; ++j) { const int row = (lane >> 3) + 8 * j; *(LAS u32x4*)(vl + row * VPITCH + (lane & 7) * 16) = vreg[j]; }
        pv_tile(o0, o1, vl, lane, pk);
        if (__all(carry < 7.8e-31f)) break;
    }
    if (!dry) store_ot(O + (rowb + t0 + r32) * 512 + h * 64, o0, o1, hi, 1.f); else asm volatile("" :: "v"(o0), "v"(o1));
}
DEV void sb_phase(const WaveId& W, LAS unsigned char* lds, unsigned char* ws, bool dry) {
    LAS unsigned char* vl = lds + W.wave * 12288;
    const bf16_t* Q = (const bf16_t*)(ws + WS_QA); const bf16_t* Kk = (const bf16_t*)(ws + WS_KA); const bf16_t* V = (const bf16_t*)(ws + WS_VA);
    constexpr int NITEM = NB * 8 * (S / 32);
    for (int it = W.gw; it < NITEM; it += W.ngw) {
        const int qb = it & 255, h = (it >> 8) & 7, b = it >> 11;
        sb_item(vl, Q, Kk, V, (bf16_t*)(ws + WS_QA), b, h, qb, W.lane, dry);
    }
}

constexpr int IDX_CTL_OFF = 131072 + 1024;
DEV unsigned fkey2(float v) { const int u = (int)__float_as_uint(v); return (unsigned)(u ^ ((u >> 31) | (int)0x80000000)); }
DEV float relu1(float x) { return __builtin_amdgcn_fmed3f(x, 0.f, 3.0e38f); }
DEV void idx_prefetch(bf16x8 (&afr)[4], float (&w)[16], bf16x8 (&b0)[4], bf16x8 (&b1)[4], const bf16_t* IQ, const bf16_t* IK, const float* IWp, int b, int t0, int wid, int lane) {
    const int r32 = lane & 31, hh = lane >> 5; const size_t rowb = (size_t)b * S;
    { const int qi = 2 * (r32 >> 4) + ((r32 >> 2) & 1), head = (r32 & 3) + 4 * ((r32 >> 3) & 1);
        const bf16_t* ap = IQ + (rowb + t0 + qi) * 512 + head * 64 + 8 * hh;
#pragma unroll
        for (int ks = 0; ks < 4; ++ks) afr[ks] = *(const bf16x8*)(ap + 16 * ks); }
#pragma unroll
    for (int r = 0; r < 16; ++r) w[r] = IWp[(rowb + t0 + 2 * (r >> 3) + hh) * 8 + (r & 7)];
    const int jmax = (t0 + 3) >> 5;
    { const int j0 = wid < jmax ? wid : jmax, j1 = wid + 8 < jmax ? wid + 8 : jmax;
      const bf16_t* p0 = IK + ((rowb >> 5) + j0) * 2048 + (hh * 32 + r32) * 8; const bf16_t* p1 = IK + ((rowb >> 5) + j1) * 2048 + (hh * 32 + r32) * 8;
#pragma unroll
      for (int ks = 0; ks < 4; ++ks) { b0[ks] = *(const bf16x8*)(p0 + ks * 512); b1[ks] = *(const bf16x8*)(p1 + ks * 512); } }
}
DEV void idx_ticket(unsigned tk, int& b, int& t0) { b = (int)(tk & 1u); t0 = (int)(S / 4 - 1 - (tk >> 1)) * 4; }
DEV void idx_unit(LAS unsigned char* lds, const bf16_t* IQ, const bf16_t* IK, const float* IWp, unsigned* BM, int b, int t0, unsigned* qhead, int par, unsigned& next_tk, int wid, int lane,
                  bf16x8 (&afr)[4], float (&w)[16], bf16x8 (&b0)[4], bf16x8 (&b1)[4]) {
    const int r32 = lane & 31, hh = lane >> 5; const size_t rowb = (size_t)b * S;
    LAS unsigned* QW = (LAS unsigned*)(lds + IDX_CTL_OFF + 32);
    unsigned tk_reg = 0u; if (wid == 0 && lane == 0) tk_reg = __hip_atomic_fetch_add(qhead, 1u, __ATOMIC_RELAXED, __HIP_MEMORY_SCOPE_AGENT);
    const int tmax = t0 + 3, jmax = tmax >> 5;
    LAS unsigned* SCO = (LAS unsigned*)lds;
    bf16x8 b2[4];
#pragma unroll
    for (int ks = 0; ks < 4; ++ks) b2[ks] = afr[ks];
#define IDX_LOADB(dst, jj) do { const int jc_ = (jj) < jmax ? (jj) : jmax; const bf16_t* bp_ = IK + ((rowb >> 5) + jc_) * 2048 + (hh * 32 + r32) * 8; \
        _Pragma("unroll") for (int ks = 0; ks < 4; ++ks) dst[ks] = *(const bf16x8*)(bp_ + ks * 512); } while (0)
#define IDX_COMP(src, jj) do { f32x16 acc; _Pragma("unroll") for (int r = 0; r < 16; ++r) acc[r] = 0.f; \
        _Pragma("unroll") for (int ks = 0; ks < 4; ++ks) acc = __builtin_amdgcn_mfma_f32_32x32x16_bf16(afr[ks], src[ks], acc, 0, 0, 0); \
        float s0 = 0.f, s1 = 0.f; _Pragma("unroll") for (int hd = 0; hd < 8; ++hd) { s0 += w[hd] * relu1(acc[hd]); s1 += w[8 + hd] * relu1(acc[8 + hd]); } \
        unsigned k0_ = fkey2(s0), k1_ = fkey2(s1); const int key = 32 * (jj) + r32; \
        if ((jj) >= jmax) { k0_ = key <= t0 + hh ? k0_ : 0u; k1_ = key <= t0 + 2 + hh ? k1_ : 0u; }     \
        if ((jj) <= jmax) { SCO[hh * 8192 + key] = k0_; SCO[(2 + hh) * 8192 + key] = k1_; } } while (0)
#ifndef IDX_REP_MFMA
#define IDX_REP_MFMA 1
#endif
#ifndef IDX_REP_SEL
#define IDX_REP_SEL 1
#endif
#ifdef IDX_DRY_COMPUTE
#pragma unroll 1
    for (int j = wid; j <= jmax; j += 24) { IDX_COMP(b0, j); asm volatile("" : "+v"(b0[0]), "+v"(b1[0]), "+v"(b2[0])); IDX_COMP(b1, j + 8); IDX_COMP(b2, j + 16); }
#endif
#pragma unroll 1
    for (int rpm = 0; rpm < IDX_REP_MFMA; ++rpm) {
#pragma unroll 1
    for (int j = wid; j <= jmax; j += 24) {
        IDX_LOADB(b2, j + 16); IDX_COMP(b0, j);
        IDX_LOADB(b0, j + 24); IDX_COMP(b1, j + 8);
        IDX_LOADB(b1, j + 32); IDX_COMP(b2, j + 16);
    }
    }
#undef IDX_LOADB
#undef IDX_COMP
    LAS unsigned* thr = (LAS unsigned*)(lds + IDX_CTL_OFF);
    if (wid == 0 && lane < 32) ((LAS unsigned*)(lds + IDX_CTL_OFF + 64))[lane] = 0u;
    if (wid == 0 && lane == 0) QW[par ^ 1] = tk_reg;
    LDS_WAIT(); __builtin_amdgcn_s_barrier(); asm volatile("" ::: "memory");
    next_tk = QW[par ^ 1];
    if (next_tk < (unsigned)(T / 4)) { int nb, nt0; idx_ticket(next_tk, nb, nt0); idx_prefetch(afr, w, b0, b1, IQ, IK, IWp, nb, nt0, wid, lane); }
    {
        const int q = wid & 3, h = wid >> 2, n = t0 + q + 1;
        volatile LAS unsigned* xme = (volatile LAS unsigned*)(lds + IDX_CTL_OFF + 64) + (q * 2 + h) * 4;
        volatile LAS unsigned* xpa = (volatile LAS unsigned*)(lds + IDX_CTL_OFF + 64) + (q * 2 + (h ^ 1)) * 4;
        unsigned T_ = 1u;
        if (n > 256) {
            LAS unsigned* row = SCO + q * 8192 + lane;
            unsigned r[64];
            const int nil = (jmax >> 1) >= h ? (((jmax >> 1) - h) >> 1) + 1 : 0;
#define IDX_FOR_LIVE(BODY) _Pragma("unroll") for (int g8_ = 0; g8_ < 8; ++g8_) if (8 * g8_ < nil) { _Pragma("unroll") for (int u8_ = 0; u8_ < 8; ++u8_) { const int il = 8 * g8_ + u8_; BODY } }
            IDX_FOR_LIVE( r[il] = (2 * (2 * il + h) + hh <= jmax) ? row[64 * (2 * il + h)] : 0u; )
            unsigned seq = 0u;
#define IDX_XCHG(val, out) do { ++seq; const int pb_ = (seq & 1u) * 2; if (lane == 0) { xme[pb_ + 1] = (val); xme[pb_] = seq; } \
                while (xpa[pb_] != seq) __builtin_amdgcn_s_sleep(0); (out) = xpa[pb_ + 1]; } while (0)
#define IDX_XCHG16(val, out) do { ++seq; const int pb_ = (seq & 1u) * 2; if (lane == 0) xme[pb_] = (seq << 16) | (val); unsigned w_; \
                while (((w_ = xpa[pb_]) >> 16) != (seq & 0xffffu)) __builtin_amdgcn_s_sleep(0); (out) = w_ & 0xffffu; } while (0)
#pragma unroll 1
            for (int rps = 0; rps < IDX_REP_SEL; ++rps) {
            unsigned mx = 0u;
            IDX_FOR_LIVE( mx = max(mx, r[il]); )
#pragma unroll
            for (int o = 1; o < 64; o <<= 1) mx = max(mx, (unsigned)__shfl_xor((int)mx, o));
            { unsigned pm_; IDX_XCHG(mx, pm_); mx = max(mx, pm_); }
            unsigned lo_ = 1u, hi_ = mx + 1u, chi_ = 0u, xgt_ = 1u, xeq_ = 0u, mt_ = 0u; bool done_ = false;
            if (mx > 0x82000000u) {
                const unsigned c1 = mx - (1u << 23), c2 = mx - (3u << 23);
                unsigned ca_ = 0, cb_ = 0, cc_ = 0, cd_ = 0; const unsigned c1v = c1, c2v = c2;
#define IDX_CNT4B(A, B, C, Dd) asm volatile("v_cmp_ge_u32_e64 s[88:89], %4, %8\n\tv_cmp_ge_u32_e64 s[90:91], %5, %8\n\tv_cmp_ge_u32_e64 s[92:93], %6, %8\n\tv_cmp_ge_u32_e64 s[94:95], %7, %8\n\t" \
                    "v_addc_co_u32_e64 %0, s[88:89], %0, 0, s[88:89]\n\tv_addc_co_u32_e64 %1, s[90:91], %1, 0, s[90:91]\n\tv_addc_co_u32_e64 %0, s[92:93], %0, 0, s[92:93]\n\tv_addc_co_u32_e64 %1, s[94:95], %1, 0, s[94:95]\n\t" \
                    "v_cmp_ge_u32_e64 s[88:89], %4, %9\n\tv_cmp_ge_u32_e64 s[90:91], %5, %9\n\tv_cmp_ge_u32_e64 s[92:93], %6, %9\n\tv_cmp_ge_u32_e64 s[94:95], %7, %9\n\t" \
                    "v_addc_co_u32_e64 %2, s[88:89], %2, 0, s[88:89]\n\tv_addc_co_u32_e64 %3, s[90:91], %3, 0, s[90:91]\n\tv_addc_co_u32_e64 %2, s[92:93], %2, 0, s[92:93]\n\tv_addc_co_u32_e64 %3, s[94:95], %3, 0, s[94:95]" \
                    : "+v"(ca_), "+v"(cb_), "+v"(cc_), "+v"(cd_) : "v"(A), "v"(B), "v"(C), "v"(Dd), "v"(c1v), "v"(c2v) : "s88", "s89", "s90", "s91", "s92", "s93", "s94", "s95")
#pragma unroll
                for (int g8_ = 0; g8_ < 8; ++g8_) if (8 * g8_ < nil) { IDX_CNT4B(r[8 * g8_], r[8 * g8_ + 1], r[8 * g8_ + 2], r[8 * g8_ + 3]); IDX_CNT4B(r[8 * g8_ + 4], r[8 * g8_ + 5], r[8 * g8_ + 6], r[8 * g8_ + 7]); }
#undef IDX_CNT4B
                int pk = (int)((ca_ + cb_) | ((cc_ + cd_) << 16));
                pk += __builtin_amdgcn_update_dpp(0, pk, 0x111, 0xf, 0xf, false);
                pk += __builtin_amdgcn_update_dpp(0, pk, 0x112, 0xf, 0xf, false);
                pk += __builtin_amdgcn_update_dpp(0, pk, 0x114, 0xf, 0xf, false);
                pk += __builtin_amdgcn_update_dpp(0, pk, 0x118, 0xf, 0xf, false);
                pk += __builtin_amdgcn_update_dpp(0, pk, 0x142, 0xa, 0xf, false);
                unsigned tot = (unsigned)__builtin_amdgcn_readlane(pk, 31) + (unsigned)__builtin_amdgcn_readlane(pk, 63);
                { unsigned pt_; IDX_XCHG(tot, pt_); tot += pt_; }
                const unsigned t1 = tot & 0xffffu, t2 = tot >> 16;
                if (t1 == 256u) { xgt_ = c1; mt_ = 0u; done_ = true; }
                else if (t1 > 256u) lo_ = c1;
                else { hi_ = c1; chi_ = t1;
                       if (t2 == 256u) { xgt_ = c2; mt_ = 0u; done_ = true; }
                       else if (t2 > 256u) lo_ = c2;
                       else { hi_ = c2; chi_ = t2; } }
                if (!done_ && hi_ - lo_ == 1u) { xgt_ = hi_; xeq_ = lo_; mt_ = 256u - chi_; done_ = true; }
            }
            { LAS unsigned* hist = (LAS unsigned*)(lds + IDX_CTL_OFF + 1024) + q * 256;
#pragma unroll 1
              for (int round = 0; round < 6 && !done_; ++round) {
                const unsigned wdt = hi_ - lo_;
                const int sh = wdt <= 256u ? 0 : 24 - (int)__builtin_clz(wdt - 1u);
                hist[128 * h + lane] = 0u; hist[128 * h + 64 + lane] = 0u;
                LDS_WAIT(); { unsigned d_; IDX_XCHG16(0u, d_); (void)d_; }
                const unsigned lov = lo_;
                if (round == 0) {
                    IDX_FOR_LIVE( const unsigned d = r[il] - lov; if (d < wdt) __hip_atomic_fetch_add(hist + (d >> sh), 1u, __ATOMIC_RELAXED, __HIP_MEMORY_SCOPE_WORKGROUP); )
                } else {
#pragma unroll
                    for (int g8_ = 0; g8_ < 8; ++g8_) if (8 * g8_ < nil) {
#pragma unroll
                        for (int u4_ = 0; u4_ < 2; ++u4_) { const int il = 8 * g8_ + 4 * u4_;
                            const unsigned d0 = r[il] - lov, d1 = r[il + 1] - lov, d2 = r[il + 2] - lov, d3 = r[il + 3] - lov;
                            if (min(min(d0, d1), min(d2, d3)) < wdt) {
                                if (d0 < wdt) __hip_atomic_fetch_add(hist + (d0 >> sh), 1u, __ATOMIC_RELAXED, __HIP_MEMORY_SCOPE_WORKGROUP);
                                if (d1 < wdt) __hip_atomic_fetch_add(hist + (d1 >> sh), 1u, __ATOMIC_RELAXED, __HIP_MEMORY_SCOPE_WORKGROUP);
                                if (d2 < wdt) __hip_atomic_fetch_add(hist + (d2 >> sh), 1u, __ATOMIC_RELAXED, __HIP_MEMORY_SCOPE_WORKGROUP);
                                if (d3 < wdt) __hip_atomic_fetch_add(hist + (d3 >> sh), 1u, __ATOMIC_RELAXED, __HIP_MEMORY_SCOPE_WORKGROUP); } } }
                }
                LDS_WAIT(); { unsigned d_; IDX_XCHG16(0u, d_); (void)d_; }
                const u32x4 hb = *(const LAS u32x4*)(hist + 4 * lane);
                const unsigned s4 = (hb.x + hb.y) + (hb.z + hb.w);
                unsigned suf = s4;
#pragma unroll
                for (int o = 1; o < 64; o <<= 1) { const unsigned tv = (unsigned)__shfl_down((int)suf, o); if (lane + o < 64) suf += tv; }
                const unsigned long long okm = __ballot(chi_ + suf >= 256u);
                const int L = 63 - (int)__builtin_clzll(okm);
                const unsigned above = chi_ + (unsigned)__builtin_amdgcn_readlane((int)(suf - s4), L);
                const unsigned h0 = (unsigned)__builtin_amdgcn_readlane((int)hb.x, L), h1 = (unsigned)__builtin_amdgcn_readlane((int)hb.y, L),
                               h2 = (unsigned)__builtin_amdgcn_readlane((int)hb.z, L), h3 = (unsigned)__builtin_amdgcn_readlane((int)hb.w, L);
                unsigned Bsel, cab, cnb;
                if (above + h3 >= 256u) { Bsel = 3u; cab = above; cnb = h3; }
                else if (above + h3 + h2 >= 256u) { Bsel = 2u; cab = above + h3; cnb = h2; }
                else if (above + h3 + h2 + h1 >= 256u) { Bsel = 1u; cab = above + h3 + h2; cnb = h1; }
                else { Bsel = 0u; cab = above + h3 + h2 + h1; cnb = h0; }
                Bsel += 4u * (unsigned)L;
                const unsigned nlo = lo_ + (Bsel << sh); unsigned nhi = nlo + (1u << sh); if (nhi > hi_ || nhi < nlo) nhi = hi_;
                if (cab + cnb == 256u) { xgt_ = nlo; mt_ = 0u; done_ = true; }
                else if (sh == 0) { xgt_ = nlo + 1u; xeq_ = nlo; mt_ = 256u - cab; done_ = true; }
                else { lo_ = nlo; hi_ = nhi; chi_ = cab; }
              } }
#ifdef IDX_XTRA
#pragma unroll 1
            for (int xr = 0; xr < IDX_XTRA; ++xr) { unsigned dsum = 0; const unsigned cv = xgt_ + (unsigned)xr;
                IDX_FOR_LIVE( dsum += r[il] >= cv; )
                int pk = (int)dsum;
                pk += __builtin_amdgcn_update_dpp(0, pk, 0x111, 0xf, 0xf, false); pk += __builtin_amdgcn_update_dpp(0, pk, 0x112, 0xf, 0xf, false); pk += __builtin_amdgcn_update_dpp(0, pk, 0x114, 0xf, 0xf, false);
                pk += __builtin_amdgcn_update_dpp(0, pk, 0x118, 0xf, 0xf, false); pk += __builtin_amdgcn_update_dpp(0, pk, 0x142, 0xa, 0xf, false);
                unsigned tot = (unsigned)__builtin_amdgcn_readlane(pk, 31) + (unsigned)__builtin_amdgcn_readlane(pk, 63);
                { unsigned pt_; IDX_XCHG16(tot, pt_); tot += pt_; } asm volatile("" :: "s"(tot)); }
#endif
            T_ = xgt_;
            if (mt_ != 0u) {
                if (h == 0) { unsigned run = 0u;
#pragma unroll 1
                    for (int i = 0; i <= (jmax >> 1); ++i) { const bool ok_ = 2 * i + hh <= jmax; const unsigned kv = ok_ ? row[64 * i] : 0u; const bool eq = kv == xeq_; const unsigned long long bm = __ballot(eq);
                        const unsigned rank = run + __builtin_amdgcn_mbcnt_hi((unsigned)(bm >> 32), __builtin_amdgcn_mbcnt_lo((unsigned)bm, 0u));
                        if (eq && rank >= mt_) row[64 * i] = 0u;
                        run += (unsigned)__popcll(bm); } }
                T_ = xeq_;
            }
            }
#undef IDX_XCHG
#undef IDX_XCHG16
#undef IDX_FOR_LIVE
        }
        if (lane == 0 && h == 0) thr[q] = T_;
    }
#ifdef PROBE_VALU
    { float a0 = (float)lane, a1 = a0 + 1.f, a2 = a0 + 2.f, a3 = a0 + 3.f, a4 = a0 + 4.f, a5 = a0 + 5.f, a6 = a0 + 6.f, a7 = a0 + 7.f; const float m = 1.0000001f, c = 1e-9f;
#pragma unroll 1
      for (int it = 0; it < 64; ++it) {
#pragma unroll
          for (int u = 0; u < 8; ++u) { a0 = a0 * m + c; a1 = a1 * m + c; a2 = a2 * m + c; a3 = a3 * m + c; a4 = a4 * m + c; a5 = a5 * m + c; a6 = a6 * m + c; a7 = a7 * m + c; } }
      asm volatile("" :: "v"(a0), "v"(a1), "v"(a2), "v"(a3), "v"(a4), "v"(a5), "v"(a6), "v"(a7)); }
#endif
    LDS_WAIT(); __builtin_amdgcn_s_barrier(); asm volatile("" ::: "memory");
    { const unsigned tq0 = thr[hh], tq1 = thr[2 + hh];
#pragma unroll 4
      for (int j = wid; j <= ((t0 | 255) >> 5); j += 8) {
          bool s0 = false, s1 = false;
          if (j <= jmax) { s0 = SCO[hh * 8192 + 32 * j + r32] >= tq0; s1 = SCO[(2 + hh) * 8192 + 32 * j + r32] >= tq1; }
          const unsigned long long b0_ = __ballot(s0), b1_ = __ballot(s1);
          if (lane == 0) { u32x4 o; o.x = (unsigned)b0_; o.y = (unsigned)(b0_ >> 32); o.z = (unsigned)b1_; o.w = (unsigned)(b1_ >> 32); *(u32x4*)(BM + ((size_t)b * 256 + j) * S + t0) = o; }
      } }
    LDS_WAIT(); __builtin_amdgcn_s_barrier();
}
DEV void idx_phase(LAS unsigned char* lds, unsigned char* ws, unsigned* qhead, int wid, int lane) {
    constexpr unsigned NUNIT = T / 4;
    const bf16_t* IQ = (const bf16_t*)(ws + WS_IQ); const bf16_t* IK = (const bf16_t*)(ws + WS_IK); const float* IW = (const float*)(ws + WS_IW);
    LAS unsigned* QW = (LAS unsigned*)(lds + IDX_CTL_OFF + 32);
    if (wid == 0 && lane == 0) QW[0] = __hip_atomic_fetch_add(qhead, 1u, __ATOMIC_RELAXED, __HIP_MEMORY_SCOPE_AGENT);
    LDS_WAIT(); __builtin_amdgcn_s_barrier(); asm volatile("" ::: "memory");
    unsigned tk = QW[0];
    bf16x8 afr[4], b0[4], b1[4]; float w[16];
    if (tk < NUNIT) { int b, t0; idx_ticket(tk, b, t0); idx_prefetch(afr, w, b0, b1, IQ, IK, IW, b, t0, wid, lane); }
#pragma unroll 1
    for (int k = 0; tk < NUNIT; ++k) {
        int b, t0; idx_ticket(tk, b, t0); unsigned ntk = NUNIT;
        idx_unit(lds, IQ, IK, IW, (unsigned*)(ws + WS_BM), b, t0, qhead, k & 1, ntk, wid, lane, afr, w, b0, b1);
        tk = ntk;
    }
}

DEV void kn_phase(const WaveId& W, const bf16_t* Kk, float* KN) {
    for (int item = W.gw; item < NB * 8 * (S / 64); item += W.ngw) {
        const int b = item / (8 * (S / 64)), h = (item / (S / 64)) & 7, tile = item % (S / 64);
        const bf16_t* kp = Kk + ((size_t)b * S + tile * 64 + W.lane) * 512 + h * 64;
        float ss = 0.f;
#pragma unroll
        for (int c = 0; c < 8; ++c) { const u32x4 v = *(const u32x4*)(kp + 8 * c);
#pragma unroll
            for (int e = 0; e < 4; ++e) { const float lo = __uint_as_float(v[e] << 16), hi = __uint_as_float(v[e] & 0xffff0000u); ss += lo * lo + hi * hi; } }
        const float m = wave_max(ss);
        if (W.lane == 0) KN[item] = sqrtf(m) * 1.01f;
    }
}
#include <hip/hip_bf16.h>
namespace attn_body {
using bf16=__hip_bfloat16;
using bf16x8=__attribute__((ext_vector_type(8)))short;
using s16x4=__attribute__((ext_vector_type(4)))short;
using f32x16=__attribute__((ext_vector_type(16)))float;
using u32x4=__attribute__((ext_vector_type(4)))unsigned;
constexpr int BATCH=2,NHEAD=8,SEQ=8192,D=64,DM=NHEAD*D;
constexpr int NW=8,QBLK=32,QB=QBLK*NW,KVBLK=64,NQB=SEQ/QB;
constexpr int ATTN_PITCH=DM, ATTN_UNIT_ROWS=QB;
__device__ __forceinline__ int crow(int r,int hi){return (r&3)+8*(r>>2)+4*hi;}
#define SBAR() __builtin_amdgcn_sched_barrier(0)
__device__ __forceinline__ void cmask(f32x16&p0,f32x16&p1,int jb,int qrel,int hi){
  const float NEG=-INFINITY; int kb=64*jb+4*hi;
  #pragma unroll
  for(int r=0;r<16;++r){int kv=kb+(r&3)+8*(r>>2); if(kv>qrel)p0[r]=NEG; if(kv+32>qrel)p1[r]=NEG;}
}

constexpr int NSLOT=3, SLOTB=8192;
constexpr int LDS_K=0, LDS_V=NSLOT*SLOTB, LDS_WS=2*NSLOT*SLOTB, LDS_OST=LDS_WS+NW*64*4, LDS_BYTES=LDS_OST+NW*4096;
constexpr float C2=0.125f*1.4426950408889634f;
__device__ __forceinline__ void glds16(const void*gsrc,unsigned lds_dst){unsigned keep;
  asm volatile("s_mov_b32 %0, m0\n\ts_mov_b32 m0, %2\n\ts_nop 0\n\tglobal_load_lds_dwordx4 %1, off\n\ts_mov_b32 m0, %0":"=&s"(keep):"v"(gsrc),"s"(lds_dst):"memory");}
__device__ __forceinline__ float max3f(float a,float b,float c){float r;asm("v_max3_f32 %0, %1, %2, %3":"=v"(r):"v"(a),"v"(b),"v"(c));return r;}
__device__ __forceinline__ float max2f(float a,float b){float r;asm("v_max_f32_e32 %0, %1, %2":"=v"(r):"v"(a),"v"(b));return r;}
__device__ __forceinline__ float fadd_s(float a,float b){float r;asm("v_add_f32_e32 %0, %1, %2":"=v"(r):"v"(a),"v"(b));return r;}
__device__ __forceinline__ float fsub_s(float a,float b){float r;asm("v_sub_f32_e32 %0, %1, %2":"=v"(r):"v"(a),"v"(b));return r;}
typedef float f32x2_t __attribute__((ext_vector_type(2))); typedef __bf16 bf16x2_t __attribute__((ext_vector_type(2)));
__device__ __forceinline__ unsigned cvtpk_s(float lo,float hi){f32x2_t v={lo,hi};bf16x2_t b=__builtin_convertvector(v,bf16x2_t);return __builtin_bit_cast(unsigned,b);}
#define WAIT_BAR(N) asm volatile("s_waitcnt vmcnt(" #N ") lgkmcnt(0)\n\ts_barrier":::"memory")

__device__ __forceinline__ void qkt(f32x16&p0,f32x16&p1,const char*Kslot,const bf16x8*qr,const f32x16&negm,int r32,int hi){
  const char*kb=Kslot+hi*1024+r32*16;
  #pragma unroll
  for(int d0=0;d0<4;++d0){
    const bf16x8 b0=*reinterpret_cast<const bf16x8*>(kb+d0*2048);
    const bf16x8 b1=*reinterpret_cast<const bf16x8*>(kb+d0*2048+512);
    if(d0==0){p0=__builtin_amdgcn_mfma_f32_32x32x16_bf16(b0,qr[0],negm,0,0,0);p1=__builtin_amdgcn_mfma_f32_32x32x16_bf16(b1,qr[0],negm,0,0,0);}
    else{p0=__builtin_amdgcn_mfma_f32_32x32x16_bf16(b0,qr[d0],p0,0,0,0);p1=__builtin_amdgcn_mfma_f32_32x32x16_bf16(b1,qr[d0],p1,0,0,0);}}
}
typedef __attribute__((address_space(3))) const char* lds_cptr;
typedef short v4i16_t __attribute__((ext_vector_type(4)));
__device__ __forceinline__ void kload8(bf16x8*kf,lds_cptr kp){
  kf[0]=*(const __attribute__((address_space(3))) bf16x8*)(kp);      kf[1]=*(const __attribute__((address_space(3))) bf16x8*)(kp+512);
  kf[2]=*(const __attribute__((address_space(3))) bf16x8*)(kp+2048); kf[3]=*(const __attribute__((address_space(3))) bf16x8*)(kp+2560);
  kf[4]=*(const __attribute__((address_space(3))) bf16x8*)(kp+4096); kf[5]=*(const __attribute__((address_space(3))) bf16x8*)(kp+4608);
  kf[6]=*(const __attribute__((address_space(3))) bf16x8*)(kp+6144); kf[7]=*(const __attribute__((address_space(3))) bf16x8*)(kp+6656);
}
__device__ __forceinline__ void kload2(bf16x8*kf,lds_cptr kp,int j){ kf[2*j]=*(const __attribute__((address_space(3))) bf16x8*)(kp+j*2048); kf[2*j+1]=*(const __attribute__((address_space(3))) bf16x8*)(kp+j*2048+512); }
__device__ __forceinline__ s16x4 vtr(lds_cptr p){ return __builtin_bit_cast(s16x4,__builtin_amdgcn_ds_read_tr16_b64_v4i16((__attribute__((address_space(3))) v4i16_t*)p)); }
__device__ __forceinline__ float rowmax(const f32x16&p0,const f32x16&p1){
  float a=max3f(p0[0],p0[1],p1[0]),b=max3f(p0[2],p0[3],p1[1]);a=max3f(a,p1[2],p1[3]);
  #pragma unroll
  for(int r=4;r<16;r+=4){a=max3f(a,p0[r],p0[r+1]);b=max3f(b,p0[r+2],p0[r+3]);a=max3f(a,p1[r],p1[r+1]);b=max3f(b,p1[r+2],p1[r+3]);}
  const float m=max2f(a,b);
  auto rr=__builtin_amdgcn_permlane32_swap(__float_as_uint(m),__float_as_uint(m),false,false);
  return max2f(__uint_as_float(rr[0]),__uint_as_float(rr[1]));
}
__device__ __forceinline__ void pv(f32x16*o,int vb,bf16x8 pa0,bf16x8 pa1,bf16x8 pa2,bf16x8 pa3){
  #pragma unroll
  for(int d0=0;d0<2;++d0){s16x4 lo[4],hi[4];
    #pragma unroll
    for(int ks=0;ks<4;++ks){
      asm volatile("ds_read_b64_tr_b16 %0,%1 offset:%c2":"=&v"(lo[ks]):"v"(vb),"i"(d0*4096+ks*1024):"memory");
      asm volatile("ds_read_b64_tr_b16 %0,%1 offset:%c2":"=&v"(hi[ks]):"v"(vb),"i"(d0*4096+ks*1024+512):"memory");}
    asm volatile("s_waitcnt lgkmcnt(0)":::"memory");SBAR();
    #define PK(k) (bf16x8){lo[k][0],lo[k][1],lo[k][2],lo[k][3],hi[k][0],hi[k][1],hi[k][2],hi[k][3]}
    o[d0]=__builtin_amdgcn_mfma_f32_32x32x16_bf16(pa0,PK(0),o[d0],0,0,0);
    o[d0]=__builtin_amdgcn_mfma_f32_32x32x16_bf16(pa1,PK(1),o[d0],0,0,0);
    o[d0]=__builtin_amdgcn_mfma_f32_32x32x16_bf16(pa2,PK(2),o[d0],0,0,0);
    o[d0]=__builtin_amdgcn_mfma_f32_32x32x16_bf16(pa3,PK(3),o[d0],0,0,0);
    #undef PK
  }
}

#ifndef ATTN_STORE16
#define ATTN_STORE16(p,v) (*(u32x4*)(p)=(v))
#endif
template<int THRL> __device__ __forceinline__ void attn_unit(int b,int h,int qb,const bf16*Q,const bf16*__restrict__ K,const bf16*__restrict__ V,bf16*O,char*shm,const unsigned*__restrict__ BMb,const float*KNbh,const int tid){
  const int lane=tid&63,r32=lane&31,hi=lane>>5; const int wid=__builtin_amdgcn_readfirstlane(tid>>6);
  const long rowbase=(long)b*SEQ; const int q0=qb*QB;
  const bf16*Qw=Q+(rowbase+q0+wid*QBLK)*DM+h*D;
  const bf16*Kh=K+rowbase*DM+h*D,*Vh=V+rowbase*DM+h*D;
  const unsigned lds0=(unsigned)(uintptr_t)shm;
  float*wsf=(float*)(shm+LDS_WS)+wid*64;
  const bf16*ksrc=Kh+(long)lane*DM+wid*8;
  const bf16*vsrc=Vh+(long)(16*(wid&3)+(lane>>2))*DM+(wid>>2)*32+(lane&3)*8;
  const unsigned kdst=lds0+LDS_K+wid*1024, vdst=lds0+LDS_V+wid*1024;
  #define DMA_K(t,slot) glds16(ksrc+(long)(t)*KVBLK*DM,(unsigned)__builtin_amdgcn_readfirstlane(kdst+(slot)))
  #define DMA_V(t,slot) glds16(vsrc+(long)(t)*KVBLK*DM,(unsigned)__builtin_amdgcn_readfirstlane(vdst+(slot)))
  const int vb0=(int)(lds0+LDS_V)+((lane>>4)&1)*32+(lane&3)*8+(4*hi+((lane&15)>>2))*64;
  const char*Kbase=shm+LDS_K; bf16x8 kf[8];
  const lds_cptr shm3=(lds_cptr)shm; const lds_cptr kp0=shm3+LDS_K+hi*1024+r32*16; const lds_cptr vp0=shm3+LDS_V+((lane>>4)&1)*32+(lane&3)*8+(4*hi+((lane&15)>>2))*64;
  const int NT=(q0+QB)/KVBLK;
  DMA_K(0,0);DMA_V(0,0);DMA_K(1,SLOTB);
  bf16x8 qr[4];
  #pragma unroll
  for(int d0=0;d0<4;++d0)qr[d0]=*reinterpret_cast<const bf16x8*>(&Qw[(long)r32*DM+d0*16+hi*8]);
  const unsigned*bmp=BMb+(q0+wid*QBLK+r32);
  unsigned mwE0=bmp[0],mwE1=bmp[(size_t)SEQ],mwO0=0u,mwO1=0u;
  bool seen=false;
  float qn; { float qs=0.f;
    _Pragma("unroll") for(int d0=0;d0<4;++d0) _Pragma("unroll") for(int e=0;e<8;++e){ const float x=__uint_as_float(((unsigned)(unsigned short)qr[d0][e])<<16); qs+=x*x; }
    auto rr=__builtin_amdgcn_permlane32_swap(__float_as_uint(qs),__float_as_uint(qs),false,false); qn=__builtin_sqrtf(__uint_as_float(rr[0])+__uint_as_float(rr[1]))*1.01f; }
  constexpr float FASTB=60.f;
  int zlane=0; asm volatile("":"+v"(zlane));
  const float*knp=KNbh+zlane;
  float knE=knp[0],knO=0.f;
  bool anysel_=false;
  #define SLOWT(PS) (__any(!(qn*kn##PS<=FASTB)||mhat!=0.f))
  float mhat=0.f,l_reg=0.f;f32x16 o[2];o[0]=f32x16{};o[1]=f32x16{};const f32x16 zero16=f32x16{};
  const int qrel=wid*QBLK+r32;
  #define CMASK(P0,P1,SLOW,PS) do{ const unsigned m0_=mw##PS##0>>(4*hi), m1_=mw##PS##1>>(4*hi); anysel_=(mw##PS##0|mw##PS##1)!=0u; \
    if(SLOW){ _Pragma("unroll") for(int r=0;r<16;++r){ P0[r]-=mhat; P1[r]-=mhat; } } \
    _Pragma("unroll") for(int r=0;r<16;++r){ const int bit_=(r&3)+8*(r>>2); \
      const unsigned e0_=(unsigned)__builtin_amdgcn_sbfe((int)m0_,bit_,1), e1_=(unsigned)__builtin_amdgcn_sbfe((int)m1_,bit_,1); \
      P0[r]=__uint_as_float((__float_as_uint(P0[r])&e0_)|(0xff800000u&~e0_)); P1[r]=__uint_as_float((__float_as_uint(P1[r])&e1_)|(0xff800000u&~e1_)); } \
    }while(0)
  bool resc=false;
  #define START(P0,P1,SLOW) do{ resc=false; seen=anysel_; \
    if(SLOW){ const float rm=rowmax(P0,P1); const float dl=(rm==-INFINITY)?0.f:rm; mhat=fadd_s(mhat,dl); \
      _Pragma("unroll") for(int r=0;r<16;++r){P0[r]=fsub_s(P0[r],dl);P1[r]=fsub_s(P1[r],dl);} \
      } \
    _Pragma("unroll") for(int r=0;r<16;++r)P0[r]=__builtin_amdgcn_exp2f(P0[r]); }while(0)
  #define RESC() do{ if(resc){ asm volatile("s_waitcnt lgkmcnt(0)":::"memory"); \
      _Pragma("unroll") for(int d_=0;d_<2;++d_) _Pragma("unroll") for(int r=0;r<16;++r)o[d_][r]*=wsf[crow(r,hi)]; } }while(0)
  f32x16 pA0,pA1,pB0,pB1;
  int sl_prev=0,sl_cur=0,sl_next=SLOTB;
  #define ROT() do{sl_prev=sl_cur;sl_cur=sl_next;sl_next=(sl_next==(NSLOT-1)*SLOTB)?0:sl_next+SLOTB;}while(0)
  DMA_K(2,2*SLOTB);
  WAIT_BAR(3);
  { mwO0=bmp[(size_t)2*SEQ]; mwO1=bmp[(size_t)3*SEQ]; knO=knp[1];
  const bool slow0_=SLOWT(E);
  qkt(pA0,pA1,Kbase,qr,zero16,r32,hi);asm volatile("s_nop 15\n\ts_nop 7":"+v"(pA0),"+v"(pA1));CMASK(pA0,pA1,slow0_,E);
  START(pA0,pA1,slow0_); }
  _Pragma("unroll") for(int r=0;r<16;++r)pA1[r]=__builtin_amdgcn_exp2f(pA1[r]);
  WAIT_BAR(0);
  DMA_K(3,0);DMA_V(1,SLOTB);
  ROT();
  kload8(kf,kp0+sl_cur);
  WAIT_BAR(2);
  s16x4 vlo[8],vhi[8]; u32x4 pw0,pw1,pw2,pw3;
  #define PKW(P,B) cvtpk_s(P[B],P[B+1])
  #define PAF(k) __builtin_bit_cast(bf16x8,pw##k)
  #define VFR(i) (bf16x8){vlo[i][0],vlo[i][1],vlo[i][2],vlo[i][3],vhi[i][0],vhi[i][1],vhi[i][2],vhi[i][3]}
  #define PIN(x) asm volatile("":"+v"(x))
  #define MX3(a,b,c) __builtin_fmaxf(__builtin_fmaxf((a),(b)),(c))
  #define GAPA(MF,A0,A1,A2,A3,W0,W1,PW) do{ MF; sacc+=A0; sacc+=A1; sacc+=A2; sacc+=A3; PIN(sacc); W0; W1; PIN(PW); SBAR(); }while(0)
  #define EX(v) __builtin_amdgcn_exp2f(v)
  #define GAPB(MF,X,B) do{ MF; X[B]=EX(X[B]); X[B+1]=EX(X[B+1]); X[B+2]=EX(X[B+2]); X[B+3]=EX(X[B+3]); PIN(X); SBAR(); }while(0)
  #define VRD(i) do{ vlo[i]=vtr(vp_+(((i)>>2)*4096+((i)&3)*1024)); vhi[i]=vtr(vp_+(((i)>>2)*4096+((i)&3)*1024+512)); }while(0)
  #define KRD(G,j) do{ if(G){ kload2(kf,kp0+sl_next,j); SBAR(); } }while(0)
  #define STEP(C0,C1,P0,P1,t,GK,GV,GL,PS,NS) do{ SBAR(); \
    if((t)+1<NT){ mw##NS##0=bmp[(size_t)(2*(t)+2)*SEQ]; mw##NS##1=bmp[(size_t)(2*(t)+3)*SEQ]; kn##NS=knp[(t)+1]; }     \
    const lds_cptr vp_=vp0+sl_prev; \
    VRD(0); SBAR(); float sacc=(P0[0]+P0[1]); \
    GAPA(C0=__builtin_amdgcn_mfma_f32_32x32x16_bf16(kf[0],qr[0],zero16,0,0,0), P0[2],P0[3],P0[4],P0[5],     pw0[0]=PKW(P0,0), pw0[1]=PKW(P0,2), pw0); \
    VRD(4); SBAR(); GAPA(C1=__builtin_amdgcn_mfma_f32_32x32x16_bf16(kf[1],qr[0],zero16,0,0,0), P0[6],P0[7],P0[8],P0[9],     pw0[2]=PKW(P0,4), pw0[3]=PKW(P0,6), pw0); \
    VRD(1); SBAR(); GAPA(C0=__builtin_amdgcn_mfma_f32_32x32x16_bf16(kf[2],qr[1],C0,0,0,0),   P0[10],P0[11],P0[12],P0[13], pw1[0]=PKW(P0,8), pw1[1]=PKW(P0,10), pw1); \
    VRD(5); SBAR(); GAPA(C1=__builtin_amdgcn_mfma_f32_32x32x16_bf16(kf[3],qr[1],C1,0,0,0),   P0[14],P0[15],P1[0],P1[1],   pw1[2]=PKW(P0,12),pw1[3]=PKW(P0,14), pw1); \
    VRD(2); SBAR(); GAPA(C0=__builtin_amdgcn_mfma_f32_32x32x16_bf16(kf[4],qr[2],C0,0,0,0),   P1[2],P1[3],P1[4],P1[5],     pw2[0]=PKW(P1,0), pw2[1]=PKW(P1,2), pw2); \
    VRD(6); SBAR(); GAPA(C1=__builtin_amdgcn_mfma_f32_32x32x16_bf16(kf[5],qr[2],C1,0,0,0),   P1[6],P1[7],P1[8],P1[9],     pw2[2]=PKW(P1,4), pw2[3]=PKW(P1,6), pw2); \
    VRD(3); SBAR(); GAPA(C0=__builtin_amdgcn_mfma_f32_32x32x16_bf16(kf[6],qr[3],C0,0,0,0),   P1[10],P1[11],P1[12],P1[13], pw3[0]=PKW(P1,8), pw3[1]=PKW(P1,10), pw3); \
    VRD(7); SBAR(); GAPA(C1=__builtin_amdgcn_mfma_f32_32x32x16_bf16(kf[7],qr[3],C1,0,0,0),   P1[14],P1[15],0.f,0.f,       pw3[2]=PKW(P1,12),pw3[3]=PKW(P1,14), pw3); \
    l_reg+=sacc; \
    if(GK){DMA_K((t)+3,sl_cur);} if(GV){DMA_V((t)+1,sl_next);} \
    const bool slow_=SLOWT(PS); CMASK(C0,C1,slow_,PS); resc=false; \
    if(__builtin_expect(slow_,0)){ float a=MX3(C0[0],C0[1],C1[0]),b=MX3(C0[2],C0[3],C1[1]); a=MX3(a,C1[2],C1[3]); \
      _Pragma("unroll") for(int r=4;r<16;r+=4){a=MX3(a,C0[r],C0[r+1]);b=MX3(b,C0[r+2],C0[r+3]);a=MX3(a,C1[r],C1[r+1]);b=MX3(b,C1[r+2],C1[r+3]);} \
      float rm=__builtin_fmaxf(a,b); { auto rr=__builtin_amdgcn_permlane32_swap(__float_as_uint(rm),__float_as_uint(rm),false,false); rm=__builtin_fmaxf(__uint_as_float(rr[0]),__uint_as_float(rr[1])); } \
      const bool fresh_=!seen&&rm>-INFINITY;     \
      if(__builtin_expect(__any(rm>(float)THRL||(fresh_&&rm<-(float)THRL)),0)){ const float dl=fresh_?rm:__builtin_fmaxf(rm,0.f); mhat+=dl; \
        _Pragma("unroll") for(int r=0;r<16;++r){C0[r]-=dl;C1[r]-=dl;} \
        const float f=dl>0.f?__builtin_amdgcn_exp2f(-dl):1.f; l_reg*=f; if(hi==0)wsf[r32]=f; resc=true; } } \
    seen=seen||anysel_; \
    SBAR(); \
    GAPB(o[0]=__builtin_amdgcn_mfma_f32_32x32x16_bf16(PAF(0),VFR(0),o[0],0,0,0), C0,0); \
    GAPB(o[1]=__builtin_amdgcn_mfma_f32_32x32x16_bf16(PAF(0),VFR(4),o[1],0,0,0), C0,4); \
    KRD(GL,0); GAPB(o[0]=__builtin_amdgcn_mfma_f32_32x32x16_bf16(PAF(1),VFR(1),o[0],0,0,0), C0,8); \
    KRD(GL,1); GAPB(o[1]=__builtin_amdgcn_mfma_f32_32x32x16_bf16(PAF(1),VFR(5),o[1],0,0,0), C0,12); \
    KRD(GL,2); GAPB(o[0]=__builtin_amdgcn_mfma_f32_32x32x16_bf16(PAF(2),VFR(2),o[0],0,0,0), C1,0); \
    KRD(GL,3); GAPB(o[1]=__builtin_amdgcn_mfma_f32_32x32x16_bf16(PAF(2),VFR(6),o[1],0,0,0), C1,4); \
    GAPB(o[0]=__builtin_amdgcn_mfma_f32_32x32x16_bf16(PAF(3),VFR(3),o[0],0,0,0), C1,8); \
    GAPB(o[1]=__builtin_amdgcn_mfma_f32_32x32x16_bf16(PAF(3),VFR(7),o[1],0,0,0), C1,12); \
    }while(0)
  int t=1;
  for(;t+5<NT;t+=2){
    STEP(pB0,pB1,pA0,pA1,t,true,true,true,O,E);     WAIT_BAR(2); RESC(); ROT();
    STEP(pA0,pA1,pB0,pB1,t+1,true,true,true,E,O);   WAIT_BAR(2); RESC(); ROT();
  }
  #define ENDW(tt) do{ if((tt)+3<NT){WAIT_BAR(2);} else if((tt)+2<NT){WAIT_BAR(1);} else {WAIT_BAR(0);} }while(0)
  for(;t+1<NT;t+=2){
    STEP(pB0,pB1,pA0,pA1,t,(t+3<NT),(t+1<NT),(t+1<NT),O,E);       ENDW(t);   RESC(); ROT();
    STEP(pA0,pA1,pB0,pB1,t+1,(t+4<NT),(t+2<NT),(t+2<NT),E,O);     ENDW(t+1); RESC(); ROT();
  }
  STEP(pB0,pB1,pA0,pA1,NT-1,false,false,false,O,E); RESC();
  { float sacc=pB0[0]+pB0[1]; _Pragma("unroll") for(int r=2;r<16;++r)sacc+=pB0[r]; _Pragma("unroll") for(int r=0;r<16;++r)sacc+=pB1[r]; l_reg+=sacc;
    pw0=(u32x4){PKW(pB0,0),PKW(pB0,2),PKW(pB0,4),PKW(pB0,6)};pw1=(u32x4){PKW(pB0,8),PKW(pB0,10),PKW(pB0,12),PKW(pB0,14)};pw2=(u32x4){PKW(pB1,0),PKW(pB1,2),PKW(pB1,4),PKW(pB1,6)};pw3=(u32x4){PKW(pB1,8),PKW(pB1,10),PKW(pB1,12),PKW(pB1,14)};
    SBAR(); pv(o,vb0+sl_cur,PAF(0),PAF(1),PAF(2),PAF(3)); }
  #undef PKW
  #undef PAF
  #undef VFR
  #undef PIN
  #undef MX3
  #undef GAPA
  #undef GAPB
  #undef EX
  #undef VRD
  #undef KRD
  #undef STEP
  #undef ENDW
  {auto rr=__builtin_amdgcn_permlane32_swap(__float_as_uint(l_reg),__float_as_uint(l_reg),false,false);l_reg=__uint_as_float(rr[0])+__uint_as_float(rr[1]);}
  if(hi==0)wsf[32+r32]=l_reg;asm volatile("s_waitcnt lgkmcnt(0)":::"memory");
  float rli[16];
  #pragma unroll
  for(int r=0;r<16;++r)rli[r]=__builtin_amdgcn_rcpf(wsf[32+crow(r,hi)]);
  bf16*Ow=O+(rowbase+q0+wid*QBLK)*DM+h*D;
  { bf16*stg=(bf16*)(shm+LDS_OST)+wid*2048;
    #pragma unroll
    for(int r=0;r<16;++r){const int orow=crow(r,hi);
      #pragma unroll
      for(int d0=0;d0<2;++d0)stg[orow*64+d0*32+r32]=__float2bfloat16(o[d0][r]*rli[r]);}
    asm volatile("s_waitcnt lgkmcnt(0)":::"memory");
    #pragma unroll
    for(int i=0;i<4;++i){const int row=i*8+(lane>>3),ch=lane&7; const u32x4 v=*(const u32x4*)(stg+row*64+ch*8); ATTN_STORE16(Ow+(long)row*DM+ch*8,v);} }
  asm volatile("s_waitcnt lgkmcnt(0)\n\ts_barrier":::"memory");
  #undef DMA_K
  #undef DMA_V
  #undef CMASK
  #undef SLOWT
  #undef START
  #undef RESC
  #undef ROT
}
constexpr int ATTN_LDS_BYTES=LDS_BYTES;
#undef SBAR
#undef WAIT_BAR
}
constexpr int MK_THREADS = 512;
constexpr int RING_BYTES = 131072, MISC_OFF = RING_BYTES + 320, MK_LDS_BYTES = 147456;
constexpr size_t WS_CTL = 0, CTL_ZERO_BYTES = 65536; constexpr int CW_BAR = 4096;
constexpr int PH_PREP0 = 0, PH_L0 = 1, PH_PER_LAYER = 14, NPH = PH_L0 + 2 * PH_PER_LAYER;
enum { Q_INPROJ = 0, Q_SBIDX, Q_DSA, Q_GATES, Q_MERGE, Q_MIX, Q_NORMXA, Q_XALOG, Q_XAOUT, Q_NORMFFN, Q_UP, Q_FFNMID, Q_DOWN, Q_NEXT };

#ifndef QBUILD
#define QBUILD 0xffffu
#endif
#define QON(x) ((QBUILD >> (x)) & 1u)
struct Args { const float* in[20]; float* out; unsigned char* ws; int ph_lo, ph_hi; };

__global__ void __launch_bounds__(MK_THREADS, 2) mk_fwd(Args args) {
    __shared__ __attribute__((aligned(16))) unsigned char lds_raw[MK_LDS_BYTES];
    LAS unsigned char* lds = (LAS unsigned char*)lds_raw;
    volatile LAS unsigned* MISC = (volatile LAS unsigned*)(lds + MISC_OFF);
    const int G = gridDim.x, bx = blockIdx.x;
    unsigned char* ws0 = args.ws;
    const int wave_s = __builtin_amdgcn_readfirstlane((int)threadIdx.x >> 6);
    for (int u = mk_tid(wave_s); u < (MK_LDS_BYTES - RING_BYTES) / 4; u += MK_THREADS) ((LAS unsigned*)(lds + RING_BYTES))[u] = 0u;
    __syncthreads();
    const int lo = args.ph_lo, hi = args.ph_hi;
    XcdBarrier bar; bar.bar = (unsigned*)(ws0 + WS_CTL) + CW_BAR; bar.x = 0; bar.st = nullptr;
    if (hi - lo > 1) bar = xcd_barrier_post((unsigned*)(ws0 + WS_CTL) + CW_BAR, MISC + 8, mk_tid(wave_s));
#define BPW(off) ((bf16_t*)(ws + (off)))
    const int vcu = (G % 8 == 0) ? (bx % 8) * (G / 8) + bx / 8 : bx;
    bool use_local = false;
    for (int p = lo; p < hi; ++p) {
#ifdef PROBE_REP
        const int reps = (p >= PH_L0 && ((PROBE_REP >> ((p - PH_L0) % PH_PER_LAYER)) & 1)) ? 2 : 1;
#else
        const int reps = 1;
#endif
#ifdef PROBE_REP
#pragma unroll 1
        for (int rep = 0; rep < reps; ++rep) {
        const bool dry = rep + 1 < reps;
#else
        { constexpr bool dry = false;
#endif
        int oz = 0; asm volatile("" : "+s"(oz));
        int tid = mk_tid(wave_s); asm volatile("" : "+v"(tid));
        const int wave = __builtin_amdgcn_readfirstlane(tid >> 6), lane = tid & 63;
        WaveId W; W.gw = vcu * 8 + wave; W.ngw = G * 8; W.wave = wave; W.lane = lane;
        unsigned char* ws = args.ws + oz; float* X = args.out + oz;
#define INP(k) (args.in[(k) + oz])
        if (p == PH_PREP0) {
            prep0_phase(W, (LAS float*)(lds + wave * 16384), ws, args.in + oz, (bf16_t*)X);
        } else if (p >= PH_L0) {
            const int l = (p - PH_L0) / PH_PER_LAYER, q = (p - PH_L0) % PH_PER_LAYER;
            const float* Xin = l == 0 ? INP(0) : X;
            pg8::u64* SSb = (pg8::u64*)(ws + WS_SS);
#define SSA(i) (SSb + (size_t)(i) * T)
            if (q == Q_SBIDX) {
#ifndef NO_SB
                sb_phase(W, lds, ws, dry);
#endif
                __syncthreads();
#ifndef NO_IDX
#ifdef PROBE_SB_ONLY
                if (!dry)
#endif
                idx_phase(lds, ws, (unsigned*)(ws + WS_CTL) + 1024 + 64 * l, wave, lane);
#endif
                conv_sc_phase(vcu * MK_THREADS + tid, G * MK_THREADS, BPW(WS_SCB), BPW(WS_CX), INP(4) + l * 3 * 512, dry);
                kn_phase(W, BPW(WS_KC), (float*)(ws + WS_KN));
                if (l == 0 && !dry && QON(15)) {
                    __syncthreads();
                    { pg8::Order S; S.init(1, 4, 16, G, bx); pg8::PtrG P{(const char*)(ws + WS_KVM), (const char*)(ws + WS_WQ)}; pg8::EpiPrep E{ws, 1};
                      pg8::gemm_phase<pg8::EpiPrep, pg8::PtrG, true, true>(lds, tid, 2 * D, D, 256, S, P, E); }
                    { pg8::Order S; S.init(4, 1, 16, G, (bx + 64) % G); pg8::PtrH P{(const char*)(ws + WS_KVM), (const char*)(ws + WS_WOT)}; pg8::EpiPrep E{ws, 2};
                      pg8::gemm_phase<pg8::EpiPrep, pg8::PtrH, true, true>(lds, tid, D, 2 * D, 256, S, P, E); }
                }
            } else if (q == Q_DSA) {
#ifndef NO_DSA
                {
                    for (int pr = vcu; pr < NB * 8 * 16; pr += G) { const int bh = pr >> 4, sx = pr & 15, bb = bh >> 3, hh = bh & 7;
#pragma unroll 1
                        for (int k2 = 0; k2 < 2; ++k2)
                            attn_body::attn_unit<8>(bb, hh, k2 == 0 ? sx : 31 - sx, (const attn_body::bf16*)BPW(WS_QC), (const attn_body::bf16*)BPW(WS_KC), (const attn_body::bf16*)BPW(WS_VC),
                                                    (attn_body::bf16*)(dry ? BPW(WS_KA) : BPW(WS_QC)), (char*)lds_raw, (const unsigned*)(ws + WS_BM) + (size_t)bb * 256 * S,
                                                    (const float*)(ws + WS_KN) + bh * (S / 64), tid); }
                }
#endif
            } else if (q == Q_FFNMID) {
            } else if (q == Q_NEXT) {
                if (l + 1 == DEPTH && !dry) final_norm(W, BPW(WS_XN), X, INP(19), SSA(6));
            } else if (q == Q_INPROJ && QON(Q_INPROJ)) {
                pg8::Order S; S.init(T / 256, NIN / 256, 1, G, bx);
                pg8::PtrStd P{(const char*)X, (const char*)(ws + WS_WIN), 0, 0, 0, (size_t)256 * D * 2, (size_t)256 * D * 2};
                if (l > 0 && !dry) { int base = 0; convert_layer_weights(W, (LAS float*)(lds + wave * 16384), base, ws, args.in + oz, l, 4); __syncthreads(); }
                pg8::EpiInProj E{ws, SSA(3 * l)};
                pg8::gemm_phase<pg8::EpiInProj, pg8::PtrStd, true, true>(lds, tid, D, D, D, S, P, E);
                if (l == 0 && !dry && QON(14)) {
                    pg8::Order S2; S2.init(2, 8, 2, G, (bx + G - 64) % G);
                    pg8::PtrStd P2{(const char*)(ws + WS_MEMN), (const char*)(ws + WS_WKVT), 1 * MiB, 4 * MiB, 0, (size_t)256 * D * 2, (size_t)256 * D * 2};
                    pg8::EpiPrep E2{ws, 0};
                    pg8::gemm_phase<pg8::EpiPrep, pg8::PtrStd, true, true>(lds, tid, D, D, D, S2, P2, E2);
                }
            } else if (q == Q_GATES && QON(Q_GATES)) {
                pg8::Order S; S.init(T / 256, 12, 1, G, bx);
                pg8::PtrStd P{(const char*)X, (const char*)(ws + WS_WG), 0, 0, 0, (size_t)256 * D * 2, (size_t)256 * D * 2};
                pg8::EpiGates E{BPW(WS_GATES), SSA(3 * l)};
                pg8::gemm_phase<pg8::EpiGates, pg8::PtrStd, true, true>(lds, tid, D, D, D, S, P, E);
            } else if (q == Q_MERGE && QON(Q_MERGE)) {
                pg8::Order S; S.init(T / 256, 4, 3, G, bx);
                pg8::PtrStd P{(const char*)(ws + WS_QA), (const char*)(ws + WS_WBR), 16 * MiB, (size_t)D * 512 * 2, 0, (size_t)256 * 512 * 2, (size_t)256 * 512 * 2};
                pg8::EpiMergeC E{BPW(WS_XN), BPW(WS_GATES)};
                pg8::gemm_phase<pg8::EpiMergeC, pg8::PtrStd, true, true>(lds, tid, 512, 512, 512, S, P, E);
            } else if (q == Q_MIX && QON(Q_MIX)) {
                pg8::Order S; S.init(T / 256, 4, 1, G, bx);
                pg8::PtrStd P{(const char*)(ws + WS_XN), (const char*)(ws + WS_WMIX), 0, 0, 0, (size_t)256 * D * 2, (size_t)256 * D * 2};
                if (l == 0) { pg8::EpiResid<true> E{(const void*)INP(0), dry ? BPW(WS_FU) : BPW(WS_XBXA), dry ? SSA(0) : SSA(1)};
                    pg8::gemm_phase<pg8::EpiResid<true>, pg8::PtrStd, true, true>(lds, tid, D, D, D, S, P, E); }
                else { pg8::EpiResid<false> E{(const void*)X, dry ? BPW(WS_FU) : BPW(WS_XBXA), dry ? SSA(0) : SSA(4)};
                    pg8::gemm_phase<pg8::EpiResid<false>, pg8::PtrStd, true, true>(lds, tid, D, D, D, S, P, E); }

            } else if (q == Q_XALOG && QON(Q_XALOG)) {
                pg8::Order S; S.init(T / 256, 4, 1, G, bx);
                pg8::PtrStd P{(const char*)(ws + WS_XBXA), (const char*)(ws + WS_GT + (size_t)l * 4 * MiB), 0, 0, 2 * MiB, (size_t)256 * D * 2, (size_t)256 * D * 2};
                pg8::EpiSoftmax E{BPW(WS_PXA), SSA(1 + 3 * l)};
                pg8::gemm_phase<pg8::EpiSoftmax, pg8::PtrStd, false, true>(lds, tid, D, D, D, S, P, E);
            } else if (q == Q_XAOUT && QON(Q_XAOUT)) {
                pg8::Order S; S.init(T / 256, 4, 1, G, bx);
                pg8::PtrStd P{(const char*)(ws + WS_PXA), (const char*)(ws + WS_HT + (size_t)l * 4 * MiB), 0, 0, 2 * MiB, (size_t)256 * D * 2, (size_t)256 * D * 2};
                pg8::EpiResid<false> E{(const void*)BPW(WS_XBXA), dry ? BPW(WS_FU) : BPW(WS_XN), dry ? SSA(0) : SSA(2 + 3 * l)};
                pg8::gemm_phase<pg8::EpiResid<false>, pg8::PtrStd, true, true>(lds, tid, D, D, D, S, P, E);
            } else if (q == Q_UP && QON(Q_UP)) {
                pg8::Order S; S.init(T / 256, 22, 1, G, bx);
                pg8::PtrStd P{(const char*)(ws + WS_XN), (const char*)(ws + WS_WUP), 0, 0, 0, (size_t)256 * D * 2, (size_t)256 * D * 2};
                pg8::EpiUpF E{BPW(WS_FU), BPW(WS_SIDEA), BPW(WS_SIDEU), SSA(2 + 3 * l), INP(16) + l * 3 * DFF, INP(17) + l * DFF};
                pg8::gemm_phase<pg8::EpiUpF, pg8::PtrStd, true, true>(lds, tid, D, D, D, S, P, E);
            } else if (q == Q_DOWN && QON(Q_DOWN)) {
                pg8::Order S; S.init(T / 256, 4, 1, G, bx);
                if (!dry) {
#pragma unroll 1
                    for (int i = 0; ; ++i) { pg8::Unit u0; if (!S.next(i, u0)) break; ffn_fix_phase(tid, MK_THREADS, BPW(WS_SIDEA), BPW(WS_SIDEU), BPW(WS_FU), INP(16) + l * 3 * DFF, INP(17) + l * DFF, 4 * u0.pm, 4); }
                    asm volatile("s_waitcnt vmcnt(0)" ::: "memory"); __syncthreads();
                }
                pg8::PtrStd P{(const char*)(ws + WS_FU), (const char*)(ws + WS_WDOWN), 0, 0, 0, (size_t)256 * DFF * 2, (size_t)256 * DFF * 2};
                pg8::EpiResid<false> E{(const void*)BPW(WS_XN), dry ? BPW(WS_QA) : (l + 1 < DEPTH ? (bf16_t*)X : BPW(WS_XN)), dry ? SSA(0) : SSA(3 + 3 * l)};
                pg8::gemm_phase<pg8::EpiResid<false>, pg8::PtrStd, true, true>(lds, tid, DFF, DFF, DFF, S, P, E);
                if (l + 1 < DEPTH && !dry) {
                    __syncthreads(); int base = 0; convert_layer_weights(W, (LAS float*)(lds + wave * 16384), base, ws, args.in + oz, l + 1, 3); }
            }
        }
        }
        if (p + 1 < hi && !(p >= PH_L0 && ((p - PH_L0) % PH_PER_LAYER == Q_NORMXA || (p - PH_L0) % PH_PER_LAYER == Q_NORMFFN || (p - PH_L0) % PH_PER_LAYER == Q_FFNMID || ((p - PH_L0) % PH_PER_LAYER == Q_NEXT && (p - PH_L0) / PH_PER_LAYER + 1 < DEPTH)))) {
            const int qq = p >= PH_L0 ? (p - PH_L0) % PH_PER_LAYER : -1;
            const bool chain = qq == Q_GATES || qq == Q_MERGE || qq == Q_MIX || qq == Q_XALOG || qq == Q_XAOUT;
            if (chain && use_local) xcd_barrier_local(bar, mk_tid(wave_s)); else xcd_barrier(bar, mk_tid(wave_s));
            if (p == lo) {
                if (mk_tid(wave_s) == 0 && (bar.x != (unsigned)(bx & 7) || bar.st[0] != (unsigned)(G >> 3) || bar.st[1] != 8u || (G & 7))) (void)xb_add(&bar.bar[XB_BADMAP], 1u);
            } else if (p == lo + 1) {
                if (mk_tid(wave_s) == 0) MISC[12] = xb_ld(&bar.bar[XB_BADMAP]);
                __syncthreads(); use_local = MISC[12] == 0u;
            }
        }
    }
}

extern "C" void kernel_launch(void* const* d_in, const int* in_sizes, int n_in, void* d_out, int out_size, void* d_ws, size_t ws_size, hipStream_t st) {
    if (n_in != 20 || ws_size < WS_NEED || out_size != T * D) { fprintf(stderr, "kernel_launch: unexpected sizes n_in %d ws %zu out %d\n", n_in, ws_size, out_size); return; }
    static int grid = 0;
    if (grid == 0) {
        int dev = 0, cus = 0, per_cu = 0;
        (void)hipGetDevice(&dev); (void)hipDeviceGetAttribute(&cus, hipDeviceAttributeMultiprocessorCount, dev);
        if (hipOccupancyMaxActiveBlocksPerMultiprocessor(&per_cu, (const void*)mk_fwd, MK_THREADS, 0) != hipSuccess || per_cu < 1) { fprintf(stderr, "kernel_launch: occupancy query says %d blocks/CU\n", per_cu); grid = -1; return; }
        (void)hipGetLastError();
        if (cus != 256) { fprintf(stderr, "kernel_launch: built for a 256-CU device, found %d\n", cus); grid = -1; return; }
        grid = cus;
    }
    if (grid < 0) return;
    (void)hipMemsetAsync((char*)d_ws + WS_CTL, 0, CTL_ZERO_BYTES, st);
    Args a{};
    for (int i = 0; i < 20; ++i) a.in[i] = (const float*)d_in[i];
    a.out = (float*)d_out; a.ws = (unsigned char*)d_ws; a.ph_lo = 0; a.ph_hi = NPH;
    hipLaunchKernelGGL(mk_fwd, dim3(grid), dim3(MK_THREADS), 0, st, a);
}
```

```cpp
#include <hip/hip_runtime.h>
#include <stdint.h>
#include <stdio.h>

typedef unsigned short bf16_t;
typedef short bf16x8 __attribute__((ext_vector_type(8)));
typedef float f32x16 __attribute__((ext_vector_type(16)));
typedef float f32x4 __attribute__((ext_vector_type(4)));
#define DEV __device__ __forceinline__

constexpr int NB = 2, S = 8192, D = 1024, T = NB * S, DEPTH = 2;
constexpr int DIN = 8264, DFF = 2816, MEM = 256;
constexpr int NIN = 5376;
constexpr float LOG2E = 1.4426950408889634f;
constexpr float QSCALE = 0.125f * LOG2E;
constexpr float WSCALE = 0.125f * 0.35355339059327373f;
constexpr float XSCALE = 0.0625f * LOG2E;
constexpr float EPS = 1e-6f;
#ifndef MK_FUSE
#define MK_FUSE 1
#endif

constexpr size_t MiB = 1u << 20;
constexpr size_t WS_SIDEA = 88 * MiB, WS_SIDEU = 96 * MiB;
constexpr size_t WS_KN = 983040;
constexpr size_t WS_GT = 1 * MiB;
constexpr size_t WS_HT = 9 * MiB;
constexpr size_t WS_WUP = 17 * MiB, WS_WDOWN = 28 * MiB;
constexpr size_t WS_XN = 34 * MiB;
constexpr size_t WS_WMIX = 66 * MiB, WS_WBR = 68 * MiB, WS_WG = 71 * MiB, WS_WIN = 77 * MiB;
constexpr size_t WS_QA = 88 * MiB, WS_SCB = 104 * MiB, WS_QC = 120 * MiB, WS_KA = 136 * MiB, WS_VA = 152 * MiB, WS_KC = 168 * MiB, WS_VC = 184 * MiB,
                 WS_IQ = 200 * MiB, WS_CX = 216 * MiB, WS_IK = 232 * MiB, WS_IW = 234 * MiB, WS_BM = 235 * MiB;
constexpr size_t WS_GATES = 136 * MiB;
constexpr size_t WS_XTMP = 235 * MiB;
constexpr size_t WS_LOG = 88 * MiB, WS_PXA = 168 * MiB;
constexpr size_t WS_XBXA = 136 * MiB;
constexpr size_t WS_SS = 65536;
constexpr size_t WS_FA = 66 * MiB, WS_FU = 154 * MiB;
constexpr size_t WS_WQ = 34 * MiB  , WS_WOT = 38 * MiB  , WS_WKVT = 42 * MiB  , WS_MEMN = 50 * MiB  , WS_KVM = 52 * MiB  ;
constexpr size_t WS_NEED = 256 * MiB;

DEV bf16_t f2bf(float f) { unsigned u = __float_as_uint(f); u += 0x7fffu + ((u >> 16) & 1u); return (bf16_t)(u >> 16); }
DEV float bf2f(bf16_t h) { return __uint_as_float(((unsigned)h) << 16); }
DEV float wave_sum(float v) {
#pragma unroll
    for (int o = 1; o < 64; o <<= 1) v += __shfl_xor(v, o);
    return v;
}
DEV float wave_max(float v) {
#pragma unroll
    for (int o = 1; o < 64; o <<= 1) v = fmaxf(v, __shfl_xor(v, o));
    return v;
}


#define LAS __attribute__((address_space(3)))
#define GAS __attribute__((address_space(1)))
typedef unsigned u32x4 __attribute__((ext_vector_type(4)));
typedef unsigned u32x2 __attribute__((ext_vector_type(2)));
typedef float f32x2 __attribute__((ext_vector_type(2)));
#define LDS_WAIT() asm volatile("s_waitcnt lgkmcnt(0)" ::: "memory")
DEV int mk_tid(int wave_s) { unsigned ones = ~0u; asm volatile("" : "+s"(ones)); return wave_s * 64 + (int)__builtin_amdgcn_mbcnt_hi(ones, __builtin_amdgcn_mbcnt_lo(ones, 0u)); }
#define VM_WAIT() asm volatile("s_waitcnt vmcnt(0)" ::: "memory")
typedef __bf16 bf16x2_t __attribute__((ext_vector_type(2)));
DEV unsigned cvt_pk_bf16(float lo, float hi) { const f32x2 v = {lo, hi}; return __builtin_bit_cast(unsigned, __builtin_convertvector(v, bf16x2_t)); }
DEV float bflo(unsigned w) { return __uint_as_float(w << 16); }
DEV float bfhi(unsigned w) { return __uint_as_float(w & 0xffff0000u); }

namespace pg8 {
constexpr int BM = 256, BK = 64, HALF = 128, HTB = HALF * BK * 2, STAGE_BYTES = 8 * HTB, NXCD = 8, WGM = 4;
__host__ __device__ __forceinline__ int lds_byte(int r, int c) { const int st = (r >> 4) * 2 + (c >> 5), rr = r & 15, cc = c & 31, ob = rr * 64 + cc * 2; return st * 1024 + (ob ^ (((ob >> 9) & 1) << 5)); }
__host__ __device__ __forceinline__ void stage_rc(int b, int& R, int& C) { const int st = b / 1024, sb = b % 1024, swz = sb ^ (((sb >> 9) & 1) << 5); R = (st >> 1) * 16 + swz / 64; C = (st & 1) * 32 + (swz % 64) / 2; }
__host__ __device__ __forceinline__ int perm32(int rho) { const int n = rho >> 4, i = rho & 15; return 8 * (i >> 2) + 4 * n + (i & 3); }

struct Unit { int pm, pn, job; };
struct Order {
    int nM, nN, nwg, ntot, G, c;
    DEV void init(int nM_, int nN_, int njob, int G_, int c_) { nM = nM_; nN = nN_; nwg = nM * nN; ntot = nwg * njob; G = G_; c = c_; }
    DEV bool next(int i, Unit& u) const {
        const int L = i * G + c; if (L >= ntot) return false;
        u.job = L / nwg; int wgid = L - u.job * nwg;
        { const int q = nwg / NXCD, r = nwg % NXCD, xcd = wgid % NXCD, off = wgid / NXCD; wgid = (xcd < r ? xcd * (q + 1) : r * (q + 1) + (xcd - r) * q) + off; }
        const int nig = WGM * nN, gid = wgid / nig, fm = gid * WGM, gsz = (nM - fm) < WGM ? (nM - fm) : WGM;
        u.pm = fm + ((wgid % nig) % gsz); u.pn = (wgid % nig) / gsz; return true;
    }
};
template <class T, class = void> struct epi_chain { static constexpr bool value = false; };
template <class T> struct epi_chain<T, decltype((void)T::CHAIN)> { static constexpr bool value = T::CHAIN; };
template <class Epi, class Ptr, bool ALIGN_EPI, bool SP2>
DEV void gemm_phase(LAS unsigned char* lds, const int tid_in, const int lda, const int ldb, const int K, const Order& S, const Ptr& P, const Epi& E) {
    int tid_ = tid_in; asm volatile("" : "+v"(tid_));
    const int tid = tid_, wid = __builtin_amdgcn_readfirstlane(tid >> 6), lane = tid & 63, wr = wid >> 2, wc = wid & 3, fr = lane & 15, fq = lane >> 4;
    const int nt = K / BK;
    unsigned voffA[2], voffB[2];
#pragma unroll
    for (int i = 0; i < 2; ++i) { int R, C; stage_rc(tid * 16 + i * 8192, R, C); const int Rb = Epi::PERM ? ((R & ~31) + perm32(R & 31)) : R;
        voffA[i] = (unsigned)(R * lda + C) * 2u; voffB[i] = (unsigned)(Rb * ldb + C) * 2u; }
    const size_t kstep = (size_t)(BK * 2);
    const size_t hstepA = (size_t)HALF * lda * 2, hstepB = (size_t)HALF * ldb * 2;
    const unsigned ldsw = (unsigned)wid * 1024u;
    const int aoff = lds_byte(wr * 64 + fr, fq * 8), boff = lds_byte(wc * 32 + fr, fq * 8);
#define PG8_SA(b, h) (((b) * 2 + (h)) * HTB)
#define PG8_SB(b, h) ((4 + (b) * 2 + (h)) * HTB)
#define PG8_STAGE(bufoff, gbase, voff) do { _Pragma("unroll") for (int _i = 0; _i < 2; ++_i) \
        __builtin_amdgcn_global_load_lds((const unsigned*)((const char*)(gbase) + (voff)[_i]), (LAS unsigned*)(lds + (bufoff) + ldsw + _i * 8192), 16, 0, 0); } while (0)
#define PG8_LDA(dst, b, h) do { _Pragma("unroll") for (int m = 0; m < 4; ++m) _Pragma("unroll") for (int k = 0; k < 2; ++k) dst[m][k] = *(const LAS bf16x8*)(lds + PG8_SA(b, h) + aoff + m * 2048 + k * 1024); } while (0)
#define PG8_LDB(dst, b, h) do { _Pragma("unroll") for (int n = 0; n < 2; ++n) _Pragma("unroll") for (int k = 0; k < 2; ++k) dst[n][k] = *(const LAS bf16x8*)(lds + PG8_SB(b, h) + boff + n * 2048 + k * 1024); } while (0)
#define PG8_MMA(ai, bj, At, Bt) do { __builtin_amdgcn_s_setprio(1); _Pragma("unroll") for (int m = 0; m < 4; ++m) _Pragma("unroll") for (int n = 0; n < 2; ++n) _Pragma("unroll") for (int k = 0; k < 2; ++k) \
        acc[ai][bj][m][n] = __builtin_amdgcn_mfma_f32_16x16x32_bf16(Bt[n][k], At[m][k], acc[ai][bj][m][n], 0, 0, 0); __builtin_amdgcn_s_setprio(0); } while (0)
#define PG8_WAIT_V(n) asm volatile("s_waitcnt vmcnt(" #n ")" ::: "memory")
#define PG8_WAIT_L(n) asm volatile("s_waitcnt lgkmcnt(" #n ")" ::: "memory")
#define PG8_BAR __builtin_amdgcn_s_barrier()
#define PG8_SCHED __builtin_amdgcn_sched_barrier(0)
    Unit cur, nxt; int ui = 0;
    if (!S.next(0, cur)) return;
    f32x4 acc[2][2][4][2];
#pragma unroll
    for (int a = 0; a < 2; ++a)
#pragma unroll
        for (int b = 0; b < 2; ++b)
#pragma unroll
            for (int m = 0; m < 4; ++m)
#pragma unroll
                for (int n = 0; n < 2; ++n) acc[a][b][m][n] = (f32x4){0.f, 0.f, 0.f, 0.f};
    bf16x8 At[4][2], B0[2][2], B1[2][2];
    const char* cA = P.a(cur); const char* cB = P.b(cur);
    typename Epi::Pre pre; E.prefetch(pre, cur, wr, fr);
    if constexpr (SP2) {
        PG8_STAGE(PG8_SB(0, 0), cB, voffB); PG8_STAGE(PG8_SB(0, 1), cB + hstepB, voffB); PG8_STAGE(PG8_SA(0, 0), cA, voffA); PG8_STAGE(PG8_SA(0, 1), cA + hstepA, voffA);
        if (wr == 1) PG8_BAR;
        PG8_WAIT_V(2); PG8_BAR;
        PG8_STAGE(PG8_SB(1, 0), cB + kstep, voffB); PG8_STAGE(PG8_SA(1, 0), cA + kstep, voffA); PG8_STAGE(PG8_SB(1, 1), cB + hstepB + kstep, voffB);
        PG8_WAIT_V(6); PG8_BAR;
    } else {
        PG8_STAGE(PG8_SB(0, 0), cB, voffB); PG8_STAGE(PG8_SA(0, 0), cA, voffA); PG8_STAGE(PG8_SB(0, 1), cB + hstepB, voffB); PG8_STAGE(PG8_SA(0, 1), cA + hstepA, voffA);
        if (wr == 1) PG8_BAR;
        PG8_WAIT_V(4); PG8_BAR;
        PG8_STAGE(PG8_SB(1, 0), cB + kstep, voffB); PG8_STAGE(PG8_SA(1, 0), cA + kstep, voffA); PG8_STAGE(PG8_SB(1, 1), cB + hstepB + kstep, voffB);
        PG8_WAIT_V(6); PG8_BAR;
    }
#pragma unroll 1
    for (;;) {
        const bool has_next = S.next(ui + 1, nxt);
        const char* nA = has_next ? P.a(nxt) : cA; const char* nB = has_next ? P.b(nxt) : cB;
#pragma unroll 1
        for (int t = 0; t < nt; t += 2) {
            const bool last = (t == nt - 2);
            const char* a1 = cA + (size_t)(t + 1) * kstep;
            const char* a2 = last ? nA : cA + (size_t)(t + 2) * kstep; const char* b2 = last ? nB : cB + (size_t)(t + 2) * kstep;
            const char* a3 = a2 + kstep; const char* b3 = b2 + kstep;
            if constexpr (SP2) {
            PG8_LDB(B0, 0, 0); PG8_LDB(B1, 0, 1); PG8_SCHED; PG8_LDA(At, 0, 0); PG8_STAGE(PG8_SA(1, 1), a1 + hstepA, voffA);
            PG8_WAIT_V(8); PG8_WAIT_L(0); PG8_BAR; PG8_MMA(0, 0, At, B0); PG8_MMA(0, 1, At, B1); PG8_BAR; PG8_SCHED;
            PG8_LDA(At, 0, 1); PG8_STAGE(PG8_SB(0, 0), b2, voffB); PG8_STAGE(PG8_SB(0, 1), b2 + hstepB, voffB); PG8_STAGE(PG8_SA(0, 0), a2, voffA);
            PG8_WAIT_V(8); PG8_WAIT_L(0); PG8_BAR; PG8_MMA(1, 0, At, B0); PG8_MMA(1, 1, At, B1); PG8_BAR; PG8_SCHED;
            PG8_LDB(B0, 1, 0); PG8_LDB(B1, 1, 1); PG8_SCHED; PG8_LDA(At, 1, 0); PG8_STAGE(PG8_SA(0, 1), a2 + hstepA, voffA);
            PG8_WAIT_V(8); PG8_WAIT_L(0); PG8_BAR; PG8_MMA(0, 0, At, B0); PG8_MMA(0, 1, At, B1); PG8_BAR; PG8_SCHED;
            PG8_LDA(At, 1, 1); PG8_STAGE(PG8_SB(1, 0), b3, voffB); PG8_STAGE(PG8_SB(1, 1), b3 + hstepB, voffB); PG8_STAGE(PG8_SA(1, 0), a3, voffA);
            PG8_WAIT_V(8); PG8_WAIT_L(0); PG8_BAR; PG8_MMA(1, 0, At, B0); PG8_MMA(1, 1, At, B1); PG8_BAR; PG8_SCHED;
            } else {
            PG8_LDB(B0, 0, 0); PG8_SCHED; PG8_LDA(At, 0, 0); PG8_STAGE(PG8_SA(1, 1), a1 + hstepA, voffA);
            PG8_WAIT_L(8); PG8_BAR; PG8_WAIT_L(0); PG8_MMA(0, 0, At, B0); PG8_BAR; PG8_SCHED;
            PG8_LDB(B1, 0, 1); PG8_STAGE(PG8_SB(0, 0), b2, voffB);
            PG8_BAR; PG8_WAIT_L(0); PG8_MMA(0, 1, At, B1); PG8_BAR;
            PG8_LDA(At, 0, 1); PG8_STAGE(PG8_SA(0, 0), a2, voffA);
            PG8_BAR; PG8_WAIT_L(0); PG8_MMA(1, 0, At, B0); PG8_BAR; PG8_SCHED;
            PG8_STAGE(PG8_SB(0, 1), b2 + hstepB, voffB);
            PG8_WAIT_V(6); PG8_BAR; PG8_MMA(1, 1, At, B1); PG8_BAR;
            PG8_LDB(B0, 1, 0); PG8_SCHED; PG8_LDA(At, 1, 0); PG8_STAGE(PG8_SA(0, 1), a2 + hstepA, voffA);
            PG8_WAIT_L(8); PG8_BAR; PG8_WAIT_L(0); PG8_MMA(0, 0, At, B0); PG8_BAR; PG8_SCHED;
            PG8_LDB(B1, 1, 1); PG8_STAGE(PG8_SB(1, 0), b3, voffB);
            PG8_BAR; PG8_WAIT_L(0); PG8_MMA(0, 1, At, B1); PG8_BAR;
            PG8_LDA(At, 1, 1); PG8_STAGE(PG8_SA(1, 0), a3, voffA);
            PG8_BAR; PG8_WAIT_L(0); PG8_MMA(1, 0, At, B0); PG8_BAR; PG8_SCHED;
            PG8_STAGE(PG8_SB(1, 1), b3 + hstepB, voffB);
            PG8_WAIT_V(6); PG8_BAR; PG8_MMA(1, 1, At, B1); PG8_BAR;
            }
        }
        if constexpr (ALIGN_EPI) { if (wr == 0) PG8_BAR; }
        if constexpr (!Epi::AFTER_DRAIN) { const int le_ = mk_tid(0);
            E(acc, cur, wr, wc, le_ & 15, le_ >> 4, pre); }
        if (!has_next) break;
        if (!epi_chain<Epi>::value || nxt.job == 0) {
#pragma unroll
        for (int a = 0; a < 2; ++a)
#pragma unroll
            for (int b = 0; b < 2; ++b)
#pragma unroll
                for (int m = 0; m < 4; ++m)
#pragma unroll
                    for (int n = 0; n < 2; ++n) acc[a][b][m][n] = (f32x4){0.f, 0.f, 0.f, 0.f};
        }
        cur = nxt; cA = nA; cB = nB; ++ui; E.prefetch(pre, cur, wr, fr);
        if constexpr (ALIGN_EPI) { if (wr == 1) PG8_BAR; }
    }
    PG8_WAIT_V(0);
    if constexpr (!ALIGN_EPI) { if (wr == 0) PG8_BAR; }
    PG8_BAR;
    if constexpr (Epi::AFTER_DRAIN) { const int le_ = mk_tid(0); E.fused(acc, cur, wr, wc, le_ & 15, le_ >> 4, lds, wid, le_, pre); }
#undef PG8_SA
#undef PG8_SB
#undef PG8_STAGE
#undef PG8_LDA
#undef PG8_LDB
#undef PG8_MMA
#undef PG8_WAIT_V
#undef PG8_WAIT_L
#undef PG8_BAR
#undef PG8_SCHED
}
typedef f32x4 Acc[2][2][4][2];

struct PtrStd {
    const char* A; const char* B; size_t aj, bj, bb, arow, brow;
    DEV const char* a(const Unit& u) const { return A + (size_t)u.job * aj + (size_t)u.pm * arow; }
    DEV const char* b(const Unit& u) const { return B + (size_t)u.job * bj + (size_t)(u.pm >> 5) * bb + (size_t)u.pn * brow; }
};
struct PtrG {
    const char* KVM; const char* WQ;
    DEV const char* a(const Unit& u) const { return KVM + (size_t)(u.job >> 2) * MiB + (size_t)(u.job & 3) * 512; }
    DEV const char* b(const Unit& u) const { return WQ + (size_t)(u.job >> 3) * 2 * MiB + (size_t)(u.job & 3) * 512 + (size_t)u.pn * 256 * 1024 * 2; }
};
struct PtrH {
    const char* KVM; const char* WOT;
    DEV const char* a(const Unit& u) const { return WOT + (size_t)(u.job >> 3) * 2 * MiB + (size_t)(u.job & 3) * 512 + (size_t)u.pm * 256 * 1024 * 2; }
    DEV const char* b(const Unit& u) const { return KVM + (size_t)(u.job >> 2) * MiB + 2048 + (size_t)(u.job & 3) * 512; }
};

#define EPI_ROWS(u) const int row0 = (u).pm * BM + wr * 64 + fr
DEV u32x4 pack8(const f32x4 v0, const f32x4 v1) { u32x4 w; w.x = cvt_pk_bf16(v0[0], v0[1]); w.y = cvt_pk_bf16(v0[2], v0[3]); w.z = cvt_pk_bf16(v1[0], v1[1]); w.w = cvt_pk_bf16(v1[2], v1[3]); return w; }

struct PreNone {};
typedef unsigned long long u64;
constexpr float SS_SCALE = 65536.f;
struct PreRs { u64 v[2][4]; };
DEV void pre_rs(PreRs& p, const u64* ss, int row0) {
#pragma unroll
    for (int ai = 0; ai < 2; ++ai)
#pragma unroll
        for (int m = 0; m < 4; ++m) p.v[ai][m] = __builtin_nontemporal_load(ss + row0 + ai * HALF + m * 16);
}
DEV void rs_of(float (&rs)[2][4], const PreRs& p) {
#pragma unroll
    for (int ai = 0; ai < 2; ++ai)
#pragma unroll
        for (int m = 0; m < 4; ++m) rs[ai][m] = rsqrtf((float)p.v[ai][m] * (1.f / (SS_SCALE * D)) + EPS);
}
struct EpiInProj {
    typedef PreRs Pre;
    DEV void prefetch(PreRs& p, const Unit& u, int wr, int fr) const { pre_rs(p, ss, u.pm * BM + wr * 64 + fr); }
    static constexpr bool PERM = true, AFTER_DRAIN = false;
    unsigned char* ws; const u64* ss;
    DEV void operator()(const Acc& acc, const Unit& u, int wr, int wc, int fr, int fq, const PreRs& pre) const {
        EPI_ROWS(u); const int pn = u.pn, cb = wc * 32 + 8 * fq;
        float rs[2][4]; rs_of(rs, pre);
        if (pn < 16) {
            const int g = pn >> 1;
            const size_t off = g == 0 ? WS_QA : g == 1 ? WS_KA : g == 2 ? WS_VA : g == 3 ? WS_QC : g == 4 ? WS_KC : g == 5 ? WS_VC : g == 6 ? WS_IQ : WS_SCB;
            const float sc = (g == 0 || g == 3) ? QSCALE : 1.f;
            bf16_t* base = (bf16_t*)(ws + off) + (pn & 1) * 256 + cb;
#pragma unroll
            for (int ai = 0; ai < 2; ++ai)
#pragma unroll
                for (int m = 0; m < 4; ++m) { bf16_t* rowp = base + (size_t)(row0 + ai * HALF + m * 16) * 512;
#pragma unroll
                    for (int bj = 0; bj < 2; ++bj) *(u32x4*)(rowp + bj * HALF) = pack8(acc[ai][bj][m][0] * (sc * rs[ai][m]), acc[ai][bj][m][1] * (sc * rs[ai][m])); }
        } else if (pn < 20) {
            bf16_t* base = (bf16_t*)(ws + WS_CX) + (pn - 16) * 128 + cb;
#pragma unroll
            for (int ai = 0; ai < 2; ++ai)
#pragma unroll
                for (int m = 0; m < 4; ++m) { const float r2 = rs[ai][m] * rs[ai][m]; *(u32x4*)(base + (size_t)(row0 + ai * HALF + m * 16) * 512) = pack8(acc[ai][0][m][0] * acc[ai][1][m][0] * r2, acc[ai][0][m][1] * acc[ai][1][m][1] * r2); }
        } else {
            if (wc < 2) { bf16_t* base = (bf16_t*)(ws + WS_IK);
#pragma unroll
                for (int ai = 0; ai < 2; ++ai)
#pragma unroll
                    for (int m = 0; m < 4; ++m) { const int t = row0 + ai * HALF + m * 16;
                        *(u32x4*)(base + (size_t)(t >> 5) * 2048 + (((cb >> 3) * 32 + (t & 31)) * 8)) = pack8(acc[ai][0][m][0] * rs[ai][m], acc[ai][0][m][1] * rs[ai][m]); }
            } else if (wc == 2 && fq == 0) { float* base = (float*)(ws + WS_IW);
#pragma unroll
                for (int ai = 0; ai < 2; ++ai)
#pragma unroll
                    for (int m = 0; m < 4; ++m) { float* p = base + (size_t)(row0 + ai * HALF + m * 16) * 8; *(f32x4*)p = acc[ai][0][m][0] * (WSCALE * rs[ai][m]); *(f32x4*)(p + 4) = acc[ai][0][m][1] * (WSCALE * rs[ai][m]); }
            }
        }
    }
};
DEV f32x4 sigm4(const f32x4 v) { f32x4 o;
#pragma unroll
    for (int i = 0; i < 4; ++i) o[i] = __builtin_amdgcn_rcpf(1.f + __builtin_amdgcn_exp2f(-LOG2E * v[i])); return o; }
struct EpiGates {
    typedef PreRs Pre;
    DEV void prefetch(PreRs& p, const Unit& u, int wr, int fr) const { pre_rs(p, ss, u.pm * BM + wr * 64 + fr); }
    static constexpr bool PERM = true, AFTER_DRAIN = false;
    bf16_t* G; const u64* ss;
    DEV void operator()(const Acc& acc, const Unit& u, int wr, int wc, int fr, int fq, const PreRs& pre) const {
        EPI_ROWS(u); float rs[2][4]; rs_of(rs, pre); bf16_t* base = G + (size_t)(u.pn >> 2) * T * D + (u.pn & 3) * 256 + wc * 32 + 8 * fq;
#pragma unroll
        for (int ai = 0; ai < 2; ++ai)
#pragma unroll
            for (int m = 0; m < 4; ++m) { bf16_t* rowp = base + (size_t)(row0 + ai * HALF + m * 16) * D;
#pragma unroll
                for (int bj = 0; bj < 2; ++bj) *(u32x4*)(rowp + bj * HALF) = pack8(sigm4(acc[ai][bj][m][0] * rs[ai][m]), sigm4(acc[ai][bj][m][1] * rs[ai][m])); }
    }
};
struct EpiMerge {
    typedef PreNone Pre;
    DEV void prefetch(PreNone&, const Unit&, int, int) const {}
    static constexpr bool PERM = true, AFTER_DRAIN = false;
    bf16_t* M; const bf16_t* G;
    DEV void operator()(const Acc& acc, const Unit& u, int wr, int wc, int fr, int fq, const PreNone&) const {
        EPI_ROWS(u); const size_t cofs = (size_t)u.pn * 256 + wc * 32 + 8 * fq; const bf16_t* gb = G + (size_t)u.job * T * D;
#pragma unroll
        for (int ai = 0; ai < 2; ++ai) {
            u32x4 g[8], p[8];
#pragma unroll
            for (int m = 0; m < 4; ++m)
#pragma unroll
                for (int bj = 0; bj < 2; ++bj) { const size_t o = (size_t)(row0 + ai * HALF + m * 16) * D + cofs + bj * HALF; g[2 * m + bj] = *(const u32x4*)(gb + o);
                    if (u.job > 0) p[2 * m + bj] = __builtin_nontemporal_load((const u32x4*)(M + o)); }
#pragma unroll
            for (int m = 0; m < 4; ++m)
#pragma unroll
                for (int bj = 0; bj < 2; ++bj) { const size_t o = (size_t)(row0 + ai * HALF + m * 16) * D + cofs + bj * HALF; const u32x4 gg = g[2 * m + bj];
                    f32x4 v0 = acc[ai][bj][m][0], v1 = acc[ai][bj][m][1];
                    v0[0] *= bflo(gg.x); v0[1] *= bfhi(gg.x); v0[2] *= bflo(gg.y); v0[3] *= bfhi(gg.y); v1[0] *= bflo(gg.z); v1[1] *= bfhi(gg.z); v1[2] *= bflo(gg.w); v1[3] *= bfhi(gg.w);
                    if (u.job > 0) { const u32x4 pp = p[2 * m + bj];
                        v0[0] += bflo(pp.x); v0[1] += bfhi(pp.x); v0[2] += bflo(pp.y); v0[3] += bfhi(pp.y); v1[0] += bflo(pp.z); v1[1] += bfhi(pp.z); v1[2] += bflo(pp.w); v1[3] += bfhi(pp.w); }
                    *(u32x4*)(M + o) = pack8(v0, v1); }
        }
    }
};
struct EpiMergeC {
    typedef PreNone Pre;
    DEV void prefetch(PreNone&, const Unit&, int, int) const {}
    static constexpr bool PERM = true, AFTER_DRAIN = false, CHAIN = true;
    bf16_t* M; const bf16_t* G;
    static DEV float gl(unsigned w) { return fmaxf(bflo(w), 9.094947e-13f); }
    static DEV float gh(unsigned w) { return fmaxf(bfhi(w), 9.094947e-13f); }
    DEV void operator()(Acc& acc, const Unit& u, int wr, int wc, int fr, int fq, const PreNone&) const {
        EPI_ROWS(u); const size_t cofs = (size_t)u.pn * 256 + wc * 32 + 8 * fq; const bf16_t* gb = G + (size_t)u.job * T * D; const bool lastj = u.job == 2;
#pragma unroll
        for (int ai = 0; ai < 2; ++ai) {
            u32x4 g[8], gn[8];
#pragma unroll
            for (int m = 0; m < 4; ++m)
#pragma unroll
                for (int bj = 0; bj < 2; ++bj) { const size_t o = (size_t)(row0 + ai * HALF + m * 16) * D + cofs + bj * HALF; g[2 * m + bj] = *(const u32x4*)(gb + o);
                    if (!lastj) gn[2 * m + bj] = *(const u32x4*)(gb + (size_t)T * D + o); }
#pragma unroll
            for (int m = 0; m < 4; ++m)
#pragma unroll
                for (int bj = 0; bj < 2; ++bj) { const u32x4 a = g[2 * m + bj]; f32x4 s0 = {gl(a.x), gh(a.x), gl(a.y), gh(a.y)}, s1 = {gl(a.z), gh(a.z), gl(a.w), gh(a.w)};
                    if (!lastj) { const u32x4 b = gn[2 * m + bj];
                        s0[0] *= __builtin_amdgcn_rcpf(gl(b.x)); s0[1] *= __builtin_amdgcn_rcpf(gh(b.x)); s0[2] *= __builtin_amdgcn_rcpf(gl(b.y)); s0[3] *= __builtin_amdgcn_rcpf(gh(b.y));
                        s1[0] *= __builtin_amdgcn_rcpf(gl(b.z)); s1[1] *= __builtin_amdgcn_rcpf(gh(b.z)); s1[2] *= __builtin_amdgcn_rcpf(gl(b.w)); s1[3] *= __builtin_amdgcn_rcpf(gh(b.w)); }
                    acc[ai][bj][m][0] = acc[ai][bj][m][0] * s0; acc[ai][bj][m][1] = acc[ai][bj][m][1] * s1;
                    if (lastj) { const size_t o = (size_t)(row0 + ai * HALF + m * 16) * D + cofs + bj * HALF; *(u32x4*)(M + o) = pack8(acc[ai][bj][m][0], acc[ai][bj][m][1]); } }
        }
    }
};
template <bool IN_F32> struct EpiResid {
    typedef PreNone Pre;
    DEV void prefetch(PreNone&, const Unit&, int, int) const {}
    static constexpr bool PERM = true, AFTER_DRAIN = false;
    const void* xin; bf16_t* xb; u64* ss;
    DEV void operator()(const Acc& acc, const Unit& u, int wr, int wc, int fr, int fq, const PreNone&) const {
        EPI_ROWS(u); const size_t cofs = (size_t)u.pn * 256 + wc * 32 + 8 * fq;
#pragma unroll
        for (int ai = 0; ai < 2; ++ai) {
            f32x4 r0[8], r1[8];
#pragma unroll
            for (int m = 0; m < 4; ++m)
#pragma unroll
                for (int bj = 0; bj < 2; ++bj) { const size_t o = (size_t)(row0 + ai * HALF + m * 16) * D + cofs + bj * HALF; const int k = 2 * m + bj;
                    if (IN_F32) { r0[k] = *(const f32x4*)((const float*)xin + o); r1[k] = *(const f32x4*)((const float*)xin + o + 4); }
                    else { const u32x4 p = *(const u32x4*)((const bf16_t*)xin + o); r0[k] = __builtin_bit_cast(f32x4, p); } }
#pragma unroll
            for (int m = 0; m < 4; ++m) { const size_t ro = (size_t)(row0 + ai * HALF + m * 16) * D + cofs; float sq = 0.f;
#pragma unroll
                for (int bj = 0; bj < 2; ++bj) { const size_t o = ro + bj * HALF; const int k = 2 * m + bj; f32x4 v0 = acc[ai][bj][m][0], v1 = acc[ai][bj][m][1];
                    if (IN_F32) { v0 = v0 + r0[k]; v1 = v1 + r1[k]; }
                    else { const u32x4 p = __builtin_bit_cast(u32x4, r0[k]);
                        v0[0] += bflo(p.x); v0[1] += bfhi(p.x); v0[2] += bflo(p.y); v0[3] += bfhi(p.y); v1[0] += bflo(p.z); v1[1] += bfhi(p.z); v1[2] += bflo(p.w); v1[3] += bfhi(p.w); }
                    *(u32x4*)(xb + o) = pack8(v0, v1);
                    sq += ((v0[0] * v0[0] + v0[1] * v0[1]) + (v0[2] * v0[2] + v0[3] * v0[3])) + ((v1[0] * v1[0] + v1[1] * v1[1]) + (v1[2] * v1[2] + v1[3] * v1[3])); }
                sq += __shfl_xor(sq, 16); sq += __shfl_xor(sq, 32);
                if (fq == 0) atomicAdd(ss + row0 + ai * HALF + m * 16, (u64)(sq * SS_SCALE + 0.5f)); }
        }
    }
};
DEV float gelu_t(float a) { return a * __builtin_amdgcn_rcpf(1.f + __builtin_amdgcn_exp2f(-1.5957691216057308f * LOG2E * (a + 0.044715f * a * a * a))); }
DEV float row_prev1(float cur, float prevm) { const int r = __builtin_amdgcn_update_dpp(0, (int)__float_as_uint(prevm), 0x121, 0xf, 0xf, false);
    return __uint_as_float((unsigned)__builtin_amdgcn_update_dpp(r, (int)__float_as_uint(cur), 0x111, 0xf, 0xf, false)); }
DEV float row_prev2(float cur, float prevm) { const int r = __builtin_amdgcn_update_dpp(0, (int)__float_as_uint(prevm), 0x122, 0xf, 0xf, false);
    return __uint_as_float((unsigned)__builtin_amdgcn_update_dpp(r, (int)__float_as_uint(cur), 0x112, 0xf, 0xf, false)); }
struct EpiUpF {
    typedef PreRs Pre;
    DEV void prefetch(PreRs& p, const Unit& u, int wr, int fr) const { pre_rs(p, ss, u.pm * BM + wr * 64 + fr); }
    static constexpr bool PERM = true, AFTER_DRAIN = false;
    bf16_t *fu, *sa, *su; const u64* ss; const float *cw, *cb;
    DEV void operator()(const Acc& acc, const Unit& u, int wr, int wc, int fr, int fq, const PreRs& pre) const {
        EPI_ROWS(u); float rs[2][4]; rs_of(rs, pre); const size_t cofs = (size_t)u.pn * 128 + wc * 32 + 8 * fq;
        f32x4 w0[2], w1[2], w2[2], bb[2];
#pragma unroll
        for (int n = 0; n < 2; ++n) { w0[n] = *(const f32x4*)(cw + cofs + 4 * n); w1[n] = *(const f32x4*)(cw + DFF + cofs + 4 * n); w2[n] = *(const f32x4*)(cw + 2 * DFF + cofs + 4 * n); bb[n] = *(const f32x4*)(cb + cofs + 4 * n); }
#pragma unroll
        for (int ai = 0; ai < 2; ++ai) {
            const size_t strip = (size_t)u.pm * 4 + ai * 2 + wr;
            f32x4 ap[2] = {{0.f, 0.f, 0.f, 0.f}, {0.f, 0.f, 0.f, 0.f}};
#pragma unroll
            for (int m = 0; m < 4; ++m) {
                f32x4 a[2], g[2];
#pragma unroll
                for (int n = 0; n < 2; ++n) { a[n] = acc[ai][0][m][n] * rs[ai][m];
#pragma unroll
                    for (int e = 0; e < 4; ++e) { const float a1 = row_prev1(a[n][e], ap[n][e]), a2 = row_prev2(a[n][e], ap[n][e]);
                        g[n][e] = gelu_t(bb[n][e] + w0[n][e] * a2 + w1[n][e] * a1 + w2[n][e] * a[n][e]) * (acc[ai][1][m][n][e] * rs[ai][m]); } }
                if (m == 0) {
                    if (fr < 2) { *(u32x4*)(sa + (strip * 4 + fr) * DFF + cofs) = pack8(a[0], a[1]); *(u32x4*)(su + (strip * 2 + fr) * DFF + cofs) = pack8(acc[ai][1][0][0] * rs[ai][0], acc[ai][1][0][1] * rs[ai][0]); }
                    else *(u32x4*)(fu + (size_t)(row0 + ai * HALF) * DFF + cofs) = pack8(g[0], g[1]);
                } else {
                    *(u32x4*)(fu + (size_t)(row0 + ai * HALF + m * 16) * DFF + cofs) = pack8(g[0], g[1]);
                    if (m == 3 && fr >= 14) *(u32x4*)(sa + (strip * 4 + 2 + (fr - 14)) * DFF + cofs) = pack8(a[0], a[1]);
                }
                ap[0] = a[0]; ap[1] = a[1];
            }
        }
    }
};
struct EpiPrep {
    typedef PreNone Pre;
    DEV void prefetch(PreNone&, const Unit&, int, int) const {}
    static constexpr bool PERM = true, AFTER_DRAIN = false;
    unsigned char* ws; int mode;
    DEV void operator()(const Acc& acc, const Unit& u, int wr, int wc, int fr, int fq, const PreNone&) const {
        EPI_ROWS(u); bf16_t* base; int ldc; float sc = 1.f;
        if (mode == 0) { base = (bf16_t*)(ws + WS_KVM + (size_t)u.job * 2 * MiB); ldc = 2 * D; }
        else if (mode == 1) { base = (bf16_t*)(ws + WS_GT + (size_t)(u.job >> 2) * 2 * MiB) + (size_t)(u.job & 3) * 256 * D; ldc = D; sc = XSCALE; }
        else { base = (bf16_t*)(ws + WS_HT + (size_t)(u.job >> 2) * 2 * MiB) + (u.job & 3) * 256; ldc = D; }
        base += (size_t)u.pn * 256 + wc * 32 + 8 * fq;
#pragma unroll
        for (int ai = 0; ai < 2; ++ai)
#pragma unroll
            for (int m = 0; m < 4; ++m) { bf16_t* rowp = base + (size_t)(row0 + ai * HALF + m * 16) * ldc;
#pragma unroll
                for (int bj = 0; bj < 2; ++bj) *(u32x4*)(rowp + bj * HALF) = pack8(acc[ai][bj][m][0] * sc, acc[ai][bj][m][1] * sc); }
    }
};
struct EpiSoftmax {
    typedef PreRs Pre;
    DEV void prefetch(PreRs& p, const Unit& u, int wr, int fr) const { pre_rs(p, ss, u.pm * BM + wr * 64 + fr); }
    static constexpr bool PERM = true, AFTER_DRAIN = true;
    bf16_t* P; const u64* ss;
    DEV void fused(Acc& acc, const Unit& u, int wr, int wc, int fr, int fq, LAS unsigned char* lds, int wid, int lane, const PreRs& pre) const {
        LAS float* PM = (LAS float*)lds; LAS float* PS = (LAS float*)(lds + 4096);
        { const int row0_ = u.pm * BM + wr * 64 + fr; float rs[2][4]; rs_of(rs, pre);
#pragma unroll
          for (int ai = 0; ai < 2; ++ai)
#pragma unroll
              for (int m = 0; m < 4; ++m)
#pragma unroll
                  for (int bj = 0; bj < 2; ++bj)
#pragma unroll
                      for (int n = 0; n < 2; ++n) acc[ai][bj][m][n] = acc[ai][bj][m][n] * rs[ai][m]; }
#pragma unroll
        for (int ai = 0; ai < 2; ++ai)
#pragma unroll
            for (int m = 0; m < 4; ++m) { float mx = -INFINITY;
#pragma unroll
                for (int bj = 0; bj < 2; ++bj)
#pragma unroll
                    for (int n = 0; n < 2; ++n) { const f32x4 x = acc[ai][bj][m][n]; mx = fmaxf(mx, fmaxf(fmaxf(x[0], x[1]), fmaxf(x[2], x[3]))); }
                mx = fmaxf(mx, __shfl_xor(mx, 16)); mx = fmaxf(mx, __shfl_xor(mx, 32));
                if (fq == 0) PM[(ai * HALF + wr * 64 + m * 16 + fr) * 4 + wc] = mx; }
        LDS_WAIT(); __builtin_amdgcn_s_barrier(); asm volatile("" ::: "memory");
#pragma unroll
        for (int ai = 0; ai < 2; ++ai)
#pragma unroll
            for (int m = 0; m < 4; ++m) { const int r = ai * HALF + wr * 64 + m * 16 + fr; const f32x4 q = *(const LAS f32x4*)(PM + r * 4);
                const float mx = fmaxf(fmaxf(q[0], q[1]), fmaxf(q[2], q[3])); float s = 0.f;
#pragma unroll
                for (int bj = 0; bj < 2; ++bj)
#pragma unroll
                    for (int n = 0; n < 2; ++n) { f32x4 x = acc[ai][bj][m][n];
#pragma unroll
                        for (int i = 0; i < 4; ++i) { x[i] = __builtin_amdgcn_exp2f(x[i] - mx); s += x[i]; } acc[ai][bj][m][n] = x; }
                s += __shfl_xor(s, 16); s += __shfl_xor(s, 32);
                if (fq == 0) PS[r * 4 + wc] = s; }
        LDS_WAIT(); __builtin_amdgcn_s_barrier(); asm volatile("" ::: "memory");
        EPI_ROWS(u); bf16_t* base = P + (size_t)u.pn * 256 + wc * 32 + 8 * fq;
#pragma unroll
        for (int ai = 0; ai < 2; ++ai)
#pragma unroll
            for (int m = 0; m < 4; ++m) { const int r = ai * HALF + wr * 64 + m * 16 + fr; const f32x4 q = *(const LAS f32x4*)(PS + r * 4);
                const float inv = 1.f / ((q[0] + q[1]) + (q[2] + q[3])); bf16_t* rowp = base + (size_t)(row0 + ai * HALF + m * 16) * D;
#pragma unroll
                for (int bj = 0; bj < 2; ++bj) *(u32x4*)(rowp + bj * HALF) = pack8(acc[ai][bj][m][0] * inv, acc[ai][bj][m][1] * inv); }
        LDS_WAIT(); __builtin_amdgcn_s_barrier();
    }
};
}

typedef GAS unsigned gu32;
#define XB_TMO      128
#define XB_XCNT(j)  (256  + 64 * (j))
#define XB_XSUB(j)  (1280 + 64 * (j))
#define XB_XGEN(j)  (2304 + 64 * (j))
#define XB_TOP      3328
#define XB_TOPGEN   3392
#define XCD_BAR_WORDS 3456
#define XB_SPIN_CAP (1u << 22)
DEV unsigned xb_ld(unsigned* p) { return __hip_atomic_load(p, __ATOMIC_RELAXED, __HIP_MEMORY_SCOPE_AGENT); }
DEV unsigned xb_add(unsigned* p, unsigned v) { return __hip_atomic_fetch_add(p, v, __ATOMIC_RELAXED, __HIP_MEMORY_SCOPE_AGENT); }
DEV unsigned xb_xcc_id() { return (unsigned)__builtin_amdgcn_s_getreg((3 << 11) | 20) & 0xFu; }
#define XB_SPIN(cond, bar) do { unsigned _sp = 0; while (cond) { __builtin_amdgcn_s_sleep(1); \
    if ((++_sp & 255u) == 0u) { if (xb_ld(&(bar)[XB_TMO])) break; if (_sp > XB_SPIN_CAP) { atomicAdd(&(bar)[XB_TMO], 1u); break; } } } } while (0)
struct XcdBarrier { unsigned* bar; unsigned x; volatile LAS unsigned* st; };
DEV XcdBarrier xcd_barrier_post(unsigned* bar, volatile LAS unsigned* st, int tid) {
    XcdBarrier b; b.bar = bar; b.x = xb_xcc_id(); b.st = st;
    if (tid == 0) (void)xb_add(&bar[XB_XCNT(b.x)], 1u);
    return b;
}
DEV void xcd_barrier_complete(unsigned* bar, unsigned x, unsigned& nloc, unsigned& nx) {
    const unsigned G = gridDim.x * gridDim.y * gridDim.z;
    unsigned sum, cnt, mine, sp = 0u;
    for (;;) {
        sum = 0u; cnt = 0u; mine = 0u;
#pragma unroll
        for (unsigned j = 0; j < 16; ++j) { const unsigned c = xb_ld(&bar[XB_XCNT(j)]); sum += c; cnt += (c > 0u) ? 1u : 0u; mine = (j == x) ? c : mine; }
        if (sum == G) break;
        __builtin_amdgcn_s_sleep(1);
        if ((++sp & 255u) == 0u) { if (xb_ld(&bar[XB_TMO])) break; if (sp > XB_SPIN_CAP) { atomicAdd(&bar[XB_TMO], 1u); break; } }
    }
    nloc = mine > 0u ? mine : 1u; nx = cnt > 0u ? cnt : 1u;
}
#define XB_BADMAP 192
DEV void xcd_barrier_local(const XcdBarrier& b, int tid) {
    asm volatile("s_waitcnt vmcnt(0)" ::: "memory");
    __syncthreads();
    if (tid == 0) {
        unsigned* bar = b.bar;
        __builtin_amdgcn_s_waitcnt(0);
        const unsigned nloc = b.st[0];
        const unsigned old = xb_add(&bar[XB_XSUB(b.x)], 1u);
        const unsigned gen = old / nloc;
        if (old + 1u == (gen + 1u) * nloc) xb_add(&bar[XB_XGEN(b.x)], 1u);
        else XB_SPIN(xb_ld(&bar[XB_XGEN(b.x)]) == gen, bar);
        __builtin_amdgcn_fence(__ATOMIC_ACQUIRE, "agent");
        asm volatile("s_waitcnt vmcnt(0)" ::: "memory");
    }
    __syncthreads();
}
DEV void xcd_barrier(const XcdBarrier& b, int tid) {
    asm volatile("s_waitcnt vmcnt(0)" ::: "memory");
    __syncthreads();
    if (tid == 0) {
        unsigned* bar = b.bar;
        __builtin_amdgcn_s_waitcnt(0);
        unsigned nloc = b.st[0], nx = b.st[1];
        if (nloc == 0u) { xcd_barrier_complete(bar, b.x, nloc, nx); b.st[0] = nloc; b.st[1] = nx; }
        const unsigned old = xb_add(&bar[XB_XSUB(b.x)], 1u);
        const unsigned gen = old / nloc;
        if (old + 1u == (gen + 1u) * nloc) {
            __builtin_amdgcn_fence(__ATOMIC_RELEASE, "agent");
            asm volatile("s_waitcnt vmcnt(0)" ::: "memory");
            const unsigned og = xb_add(&bar[XB_TOP], 1u);
            const unsigned tg = og / nx;
            if (og + 1u == (tg + 1u) * nx) xb_add(&bar[XB_TOPGEN], 1u);
            else XB_SPIN(xb_ld(&bar[XB_TOPGEN]) == tg, bar);
            __builtin_amdgcn_fence(__ATOMIC_ACQUIRE, "agent");
            xb_add(&bar[XB_XGEN(b.x)], 1u);
            asm volatile("s_waitcnt vmcnt(0)" ::: "memory");
        } else {
            XB_SPIN(xb_ld(&bar[XB_XGEN(b.x)]) == gen, bar);
            __builtin_amdgcn_fence(__ATOMIC_ACQUIRE, "agent");
            asm volatile("s_waitcnt vmcnt(0)" ::: "memory");
        }
    }
    __syncthreads();
}


using pg8::gelu_t;
struct WaveId { int gw, ngw, wave, lane; };
DEV unsigned f2bf_u(float f) { return (unsigned)f2bf(f); }
DEV unsigned pk2(float lo, float hi) { return cvt_pk_bf16(lo, hi); }

DEV void norm_rows(const WaveId& W, const float* x, const float* g, bf16_t* outb, float* outf, int rows) {
    for (int row = W.gw; row < rows; row += W.ngw) {
        const f32x4* xr = (const f32x4*)(x + (size_t)row * D) + W.lane;
        f32x4 v[4]; float s = 0.f;
#pragma unroll
        for (int j = 0; j < 4; ++j) { v[j] = xr[64 * j]; s += (v[j].x * v[j].x + v[j].y * v[j].y) + (v[j].z * v[j].z + v[j].w * v[j].w); }
        const float r = rsqrtf(wave_sum(s) * (1.f / D) + EPS);
#pragma unroll
        for (int j = 0; j < 4; ++j) {
            const f32x4 gg = ((const f32x4*)g)[W.lane + 64 * j];
            const f32x4 o = {v[j].x * r * gg.x, v[j].y * r * gg.y, v[j].z * r * gg.z, v[j].w * r * gg.w};
            if (outb) { u32x2 w; w.x = pk2(o.x, o.y); w.y = pk2(o.z, o.w); ((u32x2*)(outb + (size_t)row * D))[W.lane + 64 * j] = w; }
            else ((f32x4*)(outf + (size_t)row * D))[W.lane + 64 * j] = o;
        }
    }
}
DEV void cvt_piece(const WaveId& W, LAS float* scr, int& base, const float* Wsrc, int ldw, int K, int col0, int ncols, bf16_t* dst, int ldo, int row0, const float* gain = nullptr) {
    const int nblk = ncols / 32, nitems = (K / 64) * nblk;
    int first = (W.gw - base) % W.ngw; if (first < 0) first += W.ngw;
    base = (base + nitems) % W.ngw;
    for (int item = first; item < nitems; item += W.ngw) {
        const int kb = item / nblk, nb = item - kb * nblk, k0 = 64 * kb, n0 = 32 * nb;
        { const int lr = W.lane >> 3, lc = (W.lane & 7) * 4;
          f32x4 v[8]; float g[8];
#pragma unroll
          for (int i = 0; i < 8; ++i) { v[i] = *(const f32x4*)(Wsrc + (size_t)(k0 + lr + 8 * i) * ldw + col0 + n0 + lc); g[i] = gain ? gain[k0 + lr + 8 * i] : 1.f; }
#pragma unroll
          for (int i = 0; i < 8; ++i) { LAS float* d = scr + (lr + 8 * i) * 33 + lc; d[0] = v[i][0] * g[i]; d[1] = v[i][1] * g[i]; d[2] = v[i][2] * g[i]; d[3] = v[i][3] * g[i]; } }
        LDS_WAIT(); asm volatile("" ::: "memory");
        const int c = W.lane & 7;
#pragma unroll
        for (int j = 0; j < 4; ++j) { const int n = (W.lane >> 3) + 8 * j; const LAS float* s = scr + (8 * c) * 33 + n;
            u32x4 o; o.x = pk2(s[0 * 33], s[1 * 33]); o.y = pk2(s[2 * 33], s[3 * 33]); o.z = pk2(s[4 * 33], s[5 * 33]); o.w = pk2(s[6 * 33], s[7 * 33]);
            *(u32x4*)(dst + (size_t)(row0 + n0 + n) * ldo + k0 + 8 * c) = o; }
        LDS_WAIT(); asm volatile("" ::: "memory");
    }
}
DEV void convert_layer_weights(const WaveId& W, LAS float* scr, int& base, unsigned char* ws, const float* const* in, int l, int part = 7) {
    const float* wi = in[3] + (size_t)l * D * DIN;
    if (part & 1) {
    bf16_t* WIN = (bf16_t*)(ws + WS_WIN); const float* gm = in[2] + l * D;
    cvt_piece(W, scr, base, wi, DIN, D, 0, 1536, WIN, D, 0, gm);
    cvt_piece(W, scr, base, wi, DIN, D, 3072, 1536, WIN, D, 1536, gm);
    cvt_piece(W, scr, base, wi, DIN, D, 4608, 512, WIN, D, 3072, gm);
    cvt_piece(W, scr, base, wi, DIN, D, 1536, 512, WIN, D, 3584, gm);
#pragma unroll 1
    for (int j = 0; j < 4; ++j) { cvt_piece(W, scr, base, wi, DIN, D, 2048 + 128 * j, 128, WIN, D, 4096 + 256 * j, gm); cvt_piece(W, scr, base, wi, DIN, D, 2560 + 128 * j, 128, WIN, D, 4096 + 256 * j + 128, gm); }
    cvt_piece(W, scr, base, wi, DIN, D, 5120, 96, WIN, D, 5120, gm);
    cvt_piece(W, scr, base, wi, DIN, D, 5192, 3072, (bf16_t*)(ws + WS_WG), D, 0, gm);
#pragma unroll 1
    for (int i = 0; i < 3; ++i) cvt_piece(W, scr, base, in[5 + i] + (size_t)l * 512 * D, D, 512, 0, D, (bf16_t*)(ws + WS_WBR) + (size_t)i * D * 512, 512, 0);
    cvt_piece(W, scr, base, in[8] + (size_t)l * D * D, D, D, 0, D, (bf16_t*)(ws + WS_WMIX), D, 0);
    }
    if (part & 2) {
    const float* gf = in[14] + l * D;
    const float* wf = in[15] + (size_t)l * D * 2 * DFF;
#pragma unroll 1
    for (int j = 0; j < 22; ++j) { cvt_piece(W, scr, base, wf, 2 * DFF, D, 128 * j, 128, (bf16_t*)(ws + WS_WUP), D, 256 * j, gf); cvt_piece(W, scr, base, wf, 2 * DFF, D, DFF + 128 * j, 128, (bf16_t*)(ws + WS_WUP), D, 256 * j + 128, gf); }
    }
    if (part & 4) cvt_piece(W, scr, base, in[18] + (size_t)l * DFF * D, D, DFF, 0, D, (bf16_t*)(ws + WS_WDOWN), DFF, 0);
}
DEV void prep0_phase(const WaveId& W, LAS float* scr, unsigned char* ws, const float* const* in, bf16_t* XB) {
    int base = 0;
#pragma unroll 1
    for (int l = 0; l < DEPTH; ++l) {
        const float* wq = in[11] + (size_t)l * D * D; bf16_t* WQ = (bf16_t*)(ws + WS_WQ + (size_t)l * 2 * MiB); const float* gx = in[9] + l * D;
        for (size_t i = (size_t)(W.gw * 64 + W.lane) * 4; i < (size_t)D * D; i += (size_t)W.ngw * 256) { const float g = gx[i >> 10]; const f32x4 v = *(const f32x4*)(wq + i); u32x2 o; o.x = pk2(v.x * g, v.y * g); o.y = pk2(v.z * g, v.w * g); *(u32x2*)(WQ + i) = o; }
        cvt_piece(W, scr, base, in[13] + (size_t)l * D * D, D, D, 0, D, (bf16_t*)(ws + WS_WOT + (size_t)l * 2 * MiB), D, 0);
        cvt_piece(W, scr, base, in[12] + (size_t)l * D * 2 * D, 2 * D, D, 0, 2 * D, (bf16_t*)(ws + WS_WKVT + (size_t)l * 4 * MiB), D, 0);
        norm_rows(W, in[1], in[10] + l * D, (bf16_t*)(ws + WS_MEMN + (size_t)l * MiB), nullptr, NB * MEM);
    }
    convert_layer_weights(W, scr, base, ws, in, 0);
    pg8::u64* ss0 = (pg8::u64*)(ws + WS_SS);
    { unsigned zz = 0u; asm volatile("" : "+v"(zz)); const u32x4 z = {zz, zz, zz, zz};
      for (int i = W.gw * 64 + W.lane; i < 6 * T * 8 / 16; i += W.ngw * 64) ((u32x4*)(ss0 + T))[i] = z; }
    for (int row0 = W.gw; row0 < T; row0 += 4 * W.ngw) {
        f32x4 v[4][4];
#pragma unroll
        for (int u = 0; u < 4; ++u) { const f32x4* xr = (const f32x4*)(in[0] + (size_t)(row0 + u * W.ngw) * D) + W.lane;
#pragma unroll
            for (int j = 0; j < 4; ++j) v[u][j] = xr[64 * j]; }
#pragma unroll
        for (int u = 0; u < 4; ++u) { const int row = row0 + u * W.ngw; float s = 0.f;
#pragma unroll
            for (int j = 0; j < 4; ++j) { const f32x4 x = v[u][j]; s += (x.x * x.x + x.y * x.y) + (x.z * x.z + x.w * x.w);
                u32x2 w; w.x = pk2(x.x, x.y); w.y = pk2(x.z, x.w); ((u32x2*)(XB + (size_t)row * D))[W.lane + 64 * j] = w; }
            s = wave_sum(s); if (W.lane == 0) ss0[row] = (pg8::u64)(s * pg8::SS_SCALE + 0.5f); }
    }
}
DEV void final_norm(const WaveId& W, const bf16_t* x, float* out, const float* g, const pg8::u64* ss) {
    f32x4 gg[4];
#pragma unroll
    for (int j = 0; j < 4; ++j) gg[j] = ((const f32x4*)g)[W.lane + 64 * j];
    for (int row0 = W.gw; row0 < T; row0 += 4 * W.ngw) {
        u32x2 v[4][4]; pg8::u64 sq[4];
#pragma unroll
        for (int u = 0; u < 4; ++u) { const int row = row0 + u * W.ngw; sq[u] = ss[row]; const u32x2* xr = (const u32x2*)(x + (size_t)row * D) + W.lane;
#pragma unroll
            for (int j = 0; j < 4; ++j) v[u][j] = xr[64 * j]; }
#pragma unroll
        for (int u = 0; u < 4; ++u) { const int row = row0 + u * W.ngw; const float r = rsqrtf((float)sq[u] * (1.f / (pg8::SS_SCALE * D)) + EPS); f32x4* orow = (f32x4*)(out + (size_t)row * D) + W.lane;
#pragma unroll
            for (int j = 0; j < 4; ++j) { const u32x2 w = v[u][j];
                const f32x4 o = {bflo(w.x) * r * gg[j].x, bfhi(w.x) * r * gg[j].y, bflo(w.y) * r * gg[j].z, bfhi(w.y) * r * gg[j].w}; orow[64 * j] = o; } }
    }
}
DEV void conv_sc_phase(int gtid, int gthreads, bf16_t* scb, const bf16_t* cx, const float* w, bool dry) {
    const int c8 = (gtid & 63) * 8;
    const f32x4 w0a = *(const f32x4*)(w + c8), w0b = *(const f32x4*)(w + c8 + 4), w1a = *(const f32x4*)(w + 512 + c8), w1b = *(const f32x4*)(w + 512 + c8 + 4), w2a = *(const f32x4*)(w + 1024 + c8), w2b = *(const f32x4*)(w + 1024 + c8 + 4);
    const u32x4 z = {0u, 0u, 0u, 0u};
    for (int i0 = gtid; i0 < T * 64; i0 += 4 * gthreads) {
        u32x4 x2[4], x1[4], x0[4], bb[4];
#pragma unroll
        for (int u = 0; u < 4; ++u) { const int i = i0 + u * gthreads; if (i < T * 64) { const int t = i >> 6, tl = t & (S - 1); const size_t o = (size_t)t * 512 + c8;
            x2[u] = *(const u32x4*)(cx + o); x1[u] = tl >= 1 ? *(const u32x4*)(cx + o - 512) : z; x0[u] = tl >= 2 ? *(const u32x4*)(cx + o - 1024) : z; bb[u] = *(const u32x4*)(scb + o); } }
#pragma unroll
        for (int u = 0; u < 4; ++u) { const int i = i0 + u * gthreads; if (i < T * 64) { const size_t o = (size_t)(i >> 6) * 512 + c8;
            float r[8];
#define CONV1(k, W0, W1, W2, X0, X1, X2, BBv, F) r[k] = F(BBv) * (W0 * F(X0) + W1 * F(X1) + W2 * F(X2))
            CONV1(0, w0a.x, w1a.x, w2a.x, x0[u].x, x1[u].x, x2[u].x, bb[u].x, bflo); CONV1(1, w0a.y, w1a.y, w2a.y, x0[u].x, x1[u].x, x2[u].x, bb[u].x, bfhi);
            CONV1(2, w0a.z, w1a.z, w2a.z, x0[u].y, x1[u].y, x2[u].y, bb[u].y, bflo); CONV1(3, w0a.w, w1a.w, w2a.w, x0[u].y, x1[u].y, x2[u].y, bb[u].y, bfhi);
            CONV1(4, w0b.x, w1b.x, w2b.x, x0[u].z, x1[u].z, x2[u].z, bb[u].z, bflo); CONV1(5, w0b.y, w1b.y, w2b.y, x0[u].z, x1[u].z, x2[u].z, bb[u].z, bfhi);
            CONV1(6, w0b.z, w1b.z, w2b.z, x0[u].w, x1[u].w, x2[u].w, bb[u].w, bflo); CONV1(7, w0b.w, w1b.w, w2b.w, x0[u].w, x1[u].w, x2[u].w, bb[u].w, bfhi);
#undef CONV1
            u32x4 ov; ov.x = pk2(r[0], r[1]); ov.y = pk2(r[2], r[3]); ov.z = pk2(r[4], r[5]); ov.w = pk2(r[6], r[7]);
            if (!dry) *(u32x4*)(scb + o) = ov; else asm volatile("" :: "v"(ov)); } }
    }
}
DEV void ffn_fix_phase(int gtid, int gthreads, const bf16_t* sa, const bf16_t* su, bf16_t* fu, const float* cw, const float* cb, int strip0 = 0, int nstrip = T / 64) {
    constexpr int C8 = DFF / 8; const u32x4 z = {0u, 0u, 0u, 0u};
    for (int i0 = gtid; i0 < nstrip * 2 * C8; i0 += 3 * gthreads) {
        u32x4 x2[3], x1[3], x0[3], uu[3];
#pragma unroll
        for (int q = 0; q < 3; ++q) { const int i = i0 + q * gthreads; if (i < nstrip * 2 * C8) {
            const int sr = i / C8, c8 = (i - sr * C8) * 8, strip = strip0 + (sr >> 1), rr = sr & 1;
            const bool first = (strip & (S / 64 - 1)) == 0;
            const bf16_t* A = sa + (size_t)strip * 4 * DFF + c8; const bf16_t* Ap = A - 4 * DFF;
            x2[q] = *(const u32x4*)(A + rr * DFF);
            x1[q] = rr == 1 ? *(const u32x4*)A : (first ? z : *(const u32x4*)(Ap + 3 * DFF));
            x0[q] = first ? z : *(const u32x4*)(Ap + (2 + rr) * DFF);
            uu[q] = *(const u32x4*)(su + ((size_t)strip * 2 + rr) * DFF + c8); } }
#pragma unroll
        for (int q = 0; q < 3; ++q) { const int i = i0 + q * gthreads; if (i < nstrip * 2 * C8) {
            const int sr = i / C8, c8 = (i - sr * C8) * 8, strip = strip0 + (sr >> 1), rr = sr & 1, t = strip * 64 + rr;
            const f32x4 w0a = *(const f32x4*)(cw + c8), w0b = *(const f32x4*)(cw + c8 + 4), w1a = *(const f32x4*)(cw + DFF + c8), w1b = *(const f32x4*)(cw + DFF + c8 + 4), w2a = *(const f32x4*)(cw + 2 * DFF + c8), w2b = *(const f32x4*)(cw + 2 * DFF + c8 + 4);
            const f32x4 ba = *(const f32x4*)(cb + c8), bb = *(const f32x4*)(cb + c8 + 4);
            float r[8];
#define FM1(k, B0, W0, W1, W2, X0, X1, X2, Uv, F) r[k] = gelu_t(B0 + W0 * F(X0) + W1 * F(X1) + W2 * F(X2)) * F(Uv)
            FM1(0, ba.x, w0a.x, w1a.x, w2a.x, x0[q].x, x1[q].x, x2[q].x, uu[q].x, bflo); FM1(1, ba.y, w0a.y, w1a.y, w2a.y, x0[q].x, x1[q].x, x2[q].x, uu[q].x, bfhi);
            FM1(2, ba.z, w0a.z, w1a.z, w2a.z, x0[q].y, x1[q].y, x2[q].y, uu[q].y, bflo); FM1(3, ba.w, w0a.w, w1a.w, w2a.w, x0[q].y, x1[q].y, x2[q].y, uu[q].y, bfhi);
            FM1(4, bb.x, w0b.x, w1b.x, w2b.x, x0[q].z, x1[q].z, x2[q].z, uu[q].z, bflo); FM1(5, bb.y, w0b.y, w1b.y, w2b.y, x0[q].z, x1[q].z, x2[q].z, uu[q].z, bfhi);
            FM1(6, bb.z, w0b.z, w1b.z, w2b.z, x0[q].w, x1[q].w, x2[q].w, uu[q].w, bflo); FM1(7, bb.w, w0b.w, w1b.w, w2b.w, x0[q].w, x1[q].w, x2[q].w, uu[q].w, bfhi);
#undef FM1
            u32x4 ov; ov.x = pk2(r[0], r[1]); ov.y = pk2(r[2], r[3]); ov.z = pk2(r[4], r[5]); ov.w = pk2(r[6], r[7]);
            *(u32x4*)(fu + (size_t)t * DFF + c8) = ov; } }
    }
}

typedef short s16x4 __attribute__((ext_vector_type(4)));
DEV s16x4 vtr(const LAS unsigned char* p) { return __builtin_bit_cast(s16x4, __builtin_amdgcn_ds_read_tr16_b64_v4i16((LAS s16x4*)p)); }
DEV bf16x8 cat8(const s16x4 a, const s16x4 b) { return (bf16x8){a[0], a[1], a[2], a[3], b[0], b[1], b[2], b[3]}; }
DEV bf16x8 pk8(float a0, float a1, float a2, float a3, float a4, float a5, float a6, float a7) {
    u32x4 w; w.x = pk2(a0, a1); w.y = pk2(a2, a3); w.z = pk2(a4, a5); w.w = pk2(a6, a7); return __builtin_bit_cast(bf16x8, w); }
constexpr int VPITCH = 192;
DEV void pv_tile(f32x16& o0, f32x16& o1, const LAS unsigned char* vt, int lane, const bf16x8 (&pk)[4]) {
    const int hi = lane >> 5;
    const LAS unsigned char* vb = vt + (4 * hi + ((lane & 15) >> 2)) * VPITCH + ((lane >> 4) & 1) * 32 + (lane & 3) * 8;
    bf16x8 va[4];
#pragma unroll
    for (int ks = 0; ks < 4; ++ks) va[ks] = cat8(vtr(vb + (16 * ks) * VPITCH), vtr(vb + (16 * ks + 8) * VPITCH));
    asm volatile("" : "+v"(va[0]), "+v"(va[1]), "+v"(va[2]), "+v"(va[3]));
#pragma unroll
    for (int ks = 0; ks < 4; ++ks) o0 = __builtin_amdgcn_mfma_f32_32x32x16_bf16(va[ks], pk[ks], o0, 0, 0, 0);
#pragma unroll
    for (int ks = 0; ks < 4; ++ks) va[ks] = cat8(vtr(vb + (16 * ks) * VPITCH + 64), vtr(vb + (16 * ks + 8) * VPITCH + 64));
    asm volatile("" : "+v"(va[0]), "+v"(va[1]), "+v"(va[2]), "+v"(va[3]));
#pragma unroll
    for (int ks = 0; ks < 4; ++ks) o1 = __builtin_amdgcn_mfma_f32_32x32x16_bf16(va[ks], pk[ks], o1, 0, 0, 0);
}
DEV void store_ot(bf16_t* orow, const f32x16& o0, const f32x16& o1, int hi, float sc) {
#pragma unroll
    for (int g4 = 0; g4 < 4; ++g4) {
        u32x2 a; a.x = pk2(o0[4 * g4] * sc, o0[4 * g4 + 1] * sc); a.y = pk2(o0[4 * g4 + 2] * sc, o0[4 * g4 + 3] * sc);
        u32x2 b; b.x = pk2(o1[4 * g4] * sc, o1[4 * g4 + 1] * sc); b.y = pk2(o1[4 * g4 + 2] * sc, o1[4 * g4 + 3] * sc);
        *(u32x2*)(orow + 8 * g4 + 4 * hi) = a; *(u32x2*)(orow + 32 + 8 * g4 + 4 * hi) = b;
    }
}

DEV void sb_item(LAS unsigned char* vl, const bf16_t* Q, const bf16_t* Kk, const bf16_t* V, bf16_t* O, int b, int h, int qb, int lane, bool dry) {
    const int r32 = lane & 31, hi = lane >> 5, t0 = 32 * qb, t = t0 + r32; const size_t rowb = (size_t)b * S;
    bf16x8 qr[4]; { const bf16_t* qp = Q + (rowb + t0 + r32) * 512 + h * 64 + 8 * hi;
#pragma unroll
        for (int d0 = 0; d0 < 4; ++d0) qr[d0] = *(const bf16x8*)(qp + 16 * d0); }
    f32x16 o0, o1;
#pragma unroll
    for (int r = 0; r < 16; ++r) { o0[r] = 0.f; o1[r] = 0.f; }
    float carry = 1.f;
    const int c_hi = (t0 + 30) >> 6;
#pragma unroll 1
    for (int c = c_hi; c >= 0; --c) {
        const bf16_t* kp = Kk + (rowb + 64 * c + r32) * 512 + h * 64 + 8 * hi;
        bf16x8 k0[4], k1[4];
#pragma unroll
        for (int d0 = 0; d0 < 4; ++d0) { k0[d0] = *(const bf16x8*)(kp + 16 * d0); k1[d0] = *(const bf16x8*)(kp + (size_t)32 * 512 + 16 * d0); }
        u32x4 vreg[8];
#pragma unroll
        for (int j = 0; j < 8; ++j) { const int row = (lane >> 3) + 8 * j; vreg[j] = *(const u32x4*)(V + (rowb + 64 * c + row) * 512 + h * 64 + (lane & 7) * 8); }
        f32x16 p0, p1;
#pragma unroll
        for (int r = 0; r < 16; ++r) { p0[r] = 0.f; p1[r] = 0.f; }
#pragma unroll
        for (int d0 = 0; d0 < 4; ++d0) { p0 = __builtin_amdgcn_mfma_f32_32x32x16_bf16(k0[d0], qr[d0], p0, 0, 0, 0); p1 = __builtin_amdgcn_mfma_f32_32x32x16_bf16(k1[d0], qr[d0], p1, 0, 0, 0); }
        float u[32];
        const bool diag = (c == c_hi);
#pragma unroll
        for (int e = 0; e < 32; ++e) {
            const float z = e < 16 ? p0[e] : p1[e - 16];
            float uu = __builtin_amdgcn_rcpf(1.f + __builtin_amdgcn_exp2f(fminf(z, 126.f)));
            if (diag) { const int kv = 64 * c + 8 * ((e >> 2) & 3) + 4 * hi + (e & 3) + 32 * (e >> 4); if (kv >= t) uu = 1.f; }
            u[e] = uu;
        }
        float gl[8], gh[8];
#pragma unroll
        for (int i = 0; i < 8; ++i) { const float gp = (u[4 * i] * u[4 * i + 1]) * (u[4 * i + 2] * u[4 * i + 3]);
            const auto rr = __builtin_amdgcn_permlane32_swap(__float_as_uint(gp), __float_as_uint(gp), false, false); gl[i] = __uint_as_float(rr[0]); gh[i] = __uint_as_float(rr[1]); }
        float ag[8]; float run = carry;
#pragma unroll
        for (int i = 7; i >= 0; --i) { const float a_hi = run; run *= gh[i]; const float a_lo = run; run *= gl[i]; ag[i] = hi ? a_hi : a_lo; }
        carry = run;
        bf16x8 pk[4];
#pragma unroll
        for (int ks = 0; ks < 4; ++ks) { float w[8];
#pragma unroll
            for (int g = 0; g < 2; ++g) { const int i = 2 * ks + g;
                const float a3 = ag[i], a2 = a3 * u[4 * i + 3], a1 = a2 * u[4 * i + 2], a0 = a1 * u[4 * i + 1];
                w[4 * g] = (1.f - u[4 * i]) * a0; w[4 * g + 1] = (1.f - u[4 * i + 1]) * a1; w[4 * g + 2] = (1.f - u[4 * i + 2]) * a2; w[4 * g + 3] = (1.f - u[4 * i + 3]) * a3; }
            pk[ks] = pk8(w[0], w[1], w[2], w[3], w[4], w[5], w[6], w[7]); }
#pragma unroll
        for (int j = 0; j < 8; ++j) { const int row = (lane >> 3) + 8 * j; *(LAS u32x4*)(vl + row * VPITCH + (lane & 7) * 16) = vreg[j]; }
        pv_tile(o0, o1, vl, lane, pk);
        if (__all(carry < 7.8e-31f)) break;
    }
    if (!dry) store_ot(O + (rowb + t0 + r32) * 512 + h * 64, o0, o1, hi, 1.f); else asm volatile("" :: "v"(o0), "v"(o1));
}
DEV void sb_phase(const WaveId& W, LAS unsigned char* lds, unsigned char* ws, bool dry) {
    LAS unsigned char* vl = lds + W.wave * 12288;
    const bf16_t* Q = (const bf16_t*)(ws + WS_QA); const bf16_t* Kk = (const bf16_t*)(ws + WS_KA); const bf16_t* V = (const bf16_t*)(ws + WS_VA);
    constexpr int NITEM = NB * 8 * (S / 32);
    for (int it = W.gw; it < NITEM; it += W.ngw) {
        const int qb = it & 255, h = (it >> 8) & 7, b = it >> 11;
        sb_item(vl, Q, Kk, V, (bf16_t*)(ws + WS_QA), b, h, qb, W.lane, dry);
    }
}

constexpr int IDX_CTL_OFF = 131072 + 1024;
DEV unsigned fkey2(float v) { const int u = (int)__float_as_uint(v); return (unsigned)(u ^ ((u >> 31) | (int)0x80000000)); }
DEV float relu1(float x) { return __builtin_amdgcn_fmed3f(x, 0.f, 3.0e38f); }
DEV void idx_prefetch(bf16x8 (&afr)[4], float (&w)[16], bf16x8 (&b0)[4], bf16x8 (&b1)[4], const bf16_t* IQ, const bf16_t* IK, const float* IWp, int b, int t0, int wid, int lane) {
    const int r32 = lane & 31, hh = lane >> 5; const size_t rowb = (size_t)b * S;
    { const int qi = 2 * (r32 >> 4) + ((r32 >> 2) & 1), head = (r32 & 3) + 4 * ((r32 >> 3) & 1);
        const bf16_t* ap = IQ + (rowb + t0 + qi) * 512 + head * 64 + 8 * hh;
#pragma unroll
        for (int ks = 0; ks < 4; ++ks) afr[ks] = *(const bf16x8*)(ap + 16 * ks); }
#pragma unroll
    for (int r = 0; r < 16; ++r) w[r] = IWp[(rowb + t0 + 2 * (r >> 3) + hh) * 8 + (r & 7)];
    const int jmax = (t0 + 3) >> 5;
    { const int j0 = wid < jmax ? wid : jmax, j1 = wid + 8 < jmax ? wid + 8 : jmax;
      const bf16_t* p0 = IK + ((rowb >> 5) + j0) * 2048 + (hh * 32 + r32) * 8; const bf16_t* p1 = IK + ((rowb >> 5) + j1) * 2048 + (hh * 32 + r32) * 8;
#pragma unroll
      for (int ks = 0; ks < 4; ++ks) { b0[ks] = *(const bf16x8*)(p0 + ks * 512); b1[ks] = *(const bf16x8*)(p1 + ks * 512); } }
}
DEV void idx_ticket(unsigned tk, int& b, int& t0) { b = (int)(tk & 1u); t0 = (int)(S / 4 - 1 - (tk >> 1)) * 4; }
DEV void idx_unit(LAS unsigned char* lds, const bf16_t* IQ, const bf16_t* IK, const float* IWp, unsigned* BM, int b, int t0, unsigned* qhead, int par, unsigned& next_tk, int wid, int lane,
                  bf16x8 (&afr)[4], float (&w)[16], bf16x8 (&b0)[4], bf16x8 (&b1)[4]) {
    const int r32 = lane & 31, hh = lane >> 5; const size_t rowb = (size_t)b * S;
    LAS unsigned* QW = (LAS unsigned*)(lds + IDX_CTL_OFF + 32);
    unsigned tk_reg = 0u; if (wid == 0 && lane == 0) tk_reg = __hip_atomic_fetch_add(qhead, 1u, __ATOMIC_RELAXED, __HIP_MEMORY_SCOPE_AGENT);
    const int tmax = t0 + 3, jmax = tmax >> 5;
    LAS unsigned* SCO = (LAS unsigned*)lds;
    bf16x8 b2[4];
#pragma unroll
    for (int ks = 0; ks < 4; ++ks) b2[ks] = afr[ks];
#define IDX_LOADB(dst, jj) do { const int jc_ = (jj) < jmax ? (jj) : jmax; const bf16_t* bp_ = IK + ((rowb >> 5) + jc_) * 2048 + (hh * 32 + r32) * 8; \
        _Pragma("unroll") for (int ks = 0; ks < 4; ++ks) dst[ks] = *(const bf16x8*)(bp_ + ks * 512); } while (0)
#define IDX_COMP(src, jj) do { f32x16 acc; _Pragma("unroll") for (int r = 0; r < 16; ++r) acc[r] = 0.f; \
        _Pragma("unroll") for (int ks = 0; ks < 4; ++ks) acc = __builtin_amdgcn_mfma_f32_32x32x16_bf16(afr[ks], src[ks], acc, 0, 0, 0); \
        float s0 = 0.f, s1 = 0.f; _Pragma("unroll") for (int hd = 0; hd < 8; ++hd) { s0 += w[hd] * relu1(acc[hd]); s1 += w[8 + hd] * relu1(acc[8 + hd]); } \
        unsigned k0_ = fkey2(s0), k1_ = fkey2(s1); const int key = 32 * (jj) + r32; \
        if ((jj) >= jmax) { k0_ = key <= t0 + hh ? k0_ : 0u; k1_ = key <= t0 + 2 + hh ? k1_ : 0u; }     \
        if ((jj) <= jmax) { SCO[hh * 8192 + key] = k0_; SCO[(2 + hh) * 8192 + key] = k1_; } } while (0)
#ifndef IDX_REP_MFMA
#define IDX_REP_MFMA 1
#endif
#ifndef IDX_REP_SEL
#define IDX_REP_SEL 1
#endif
#ifdef IDX_DRY_COMPUTE
#pragma unroll 1
    for (int j = wid; j <= jmax; j += 24) { IDX_COMP(b0, j); asm volatile("" : "+v"(b0[0]), "+v"(b1[0]), "+v"(b2[0])); IDX_COMP(b1, j + 8); IDX_COMP(b2, j + 16); }
#endif
#pragma unroll 1
    for (int rpm = 0; rpm < IDX_REP_MFMA; ++rpm) {
#pragma unroll 1
    for (int j = wid; j <= jmax; j += 24) {
        IDX_LOADB(b2, j + 16); IDX_COMP(b0, j);
        IDX_LOADB(b0, j + 24); IDX_COMP(b1, j + 8);
        IDX_LOADB(b1, j + 32); IDX_COMP(b2, j + 16);
    }
    }
#undef IDX_LOADB
#undef IDX_COMP
    LAS unsigned* thr = (LAS unsigned*)(lds + IDX_CTL_OFF);
    if (wid == 0 && lane < 32) ((LAS unsigned*)(lds + IDX_CTL_OFF + 64))[lane] = 0u;
    if (wid == 0 && lane == 0) QW[par ^ 1] = tk_reg;
    LDS_WAIT(); __builtin_amdgcn_s_barrier(); asm volatile("" ::: "memory");
    next_tk = QW[par ^ 1];
    if (next_tk < (unsigned)(T / 4)) { int nb, nt0; idx_ticket(next_tk, nb, nt0); idx_prefetch(afr, w, b0, b1, IQ, IK, IWp, nb, nt0, wid, lane); }
    {
        const int q = wid & 3, h = wid >> 2, n = t0 + q + 1;
        volatile LAS unsigned* xme = (volatile LAS unsigned*)(lds + IDX_CTL_OFF + 64) + (q * 2 + h) * 4;
        volatile LAS unsigned* xpa = (volatile LAS unsigned*)(lds + IDX_CTL_OFF + 64) + (q * 2 + (h ^ 1)) * 4;
        unsigned T_ = 1u;
        if (n > 256) {
            LAS unsigned* row = SCO + q * 8192 + lane;
            unsigned r[64];
            const int nil = (jmax >> 1) >= h ? (((jmax >> 1) - h) >> 1) + 1 : 0;
#define IDX_FOR_LIVE(BODY) _Pragma("unroll") for (int g8_ = 0; g8_ < 8; ++g8_) if (8 * g8_ < nil) { _Pragma("unroll") for (int u8_ = 0; u8_ < 8; ++u8_) { const int il = 8 * g8_ + u8_; BODY } }
            IDX_FOR_LIVE( r[il] = (2 * (2 * il + h) + hh <= jmax) ? row[64 * (2 * il + h)] : 0u; )
            unsigned seq = 0u;
#define IDX_XCHG(val, out) do { ++seq; const int pb_ = (seq & 1u) * 2; if (lane == 0) { xme[pb_ + 1] = (val); xme[pb_] = seq; } \
                while (xpa[pb_] != seq) __builtin_amdgcn_s_sleep(0); (out) = xpa[pb_ + 1]; } while (0)
#define IDX_XCHG16(val, out) do { ++seq; const int pb_ = (seq & 1u) * 2; if (lane == 0) xme[pb_] = (seq << 16) | (val); unsigned w_; \
                while (((w_ = xpa[pb_]) >> 16) != (seq & 0xffffu)) __builtin_amdgcn_s_sleep(0); (out) = w_ & 0xffffu; } while (0)
#pragma unroll 1
            for (int rps = 0; rps < IDX_REP_SEL; ++rps) {
            unsigned mx = 0u;
            IDX_FOR_LIVE( mx = max(mx, r[il]); )
#pragma unroll
            for (int o = 1; o < 64; o <<= 1) mx = max(mx, (unsigned)__shfl_xor((int)mx, o));
            { unsigned pm_; IDX_XCHG(mx, pm_); mx = max(mx, pm_); }
            unsigned lo_ = 1u, hi_ = mx + 1u, chi_ = 0u, xgt_ = 1u, xeq_ = 0u, mt_ = 0u; bool done_ = false;
            if (mx > 0x82000000u) {
                const unsigned c1 = mx - (1u << 23), c2 = mx - (3u << 23);
                unsigned ca_ = 0, cb_ = 0, cc_ = 0, cd_ = 0; const unsigned c1v = c1, c2v = c2;
#define IDX_CNT4B(A, B, C, Dd) asm volatile("v_cmp_ge_u32_e64 s[88:89], %4, %8\n\tv_cmp_ge_u32_e64 s[90:91], %5, %8\n\tv_cmp_ge_u32_e64 s[92:93], %6, %8\n\tv_cmp_ge_u32_e64 s[94:95], %7, %8\n\t" \
                    "v_addc_co_u32_e64 %0, s[88:89], %0, 0, s[88:89]\n\tv_addc_co_u32_e64 %1, s[90:91], %1, 0, s[90:91]\n\tv_addc_co_u32_e64 %0, s[92:93], %0, 0, s[92:93]\n\tv_addc_co_u32_e64 %1, s[94:95], %1, 0, s[94:95]\n\t" \
                    "v_cmp_ge_u32_e64 s[88:89], %4, %9\n\tv_cmp_ge_u32_e64 s[90:91], %5, %9\n\tv_cmp_ge_u32_e64 s[92:93], %6, %9\n\tv_cmp_ge_u32_e64 s[94:95], %7, %9\n\t" \
                    "v_addc_co_u32_e64 %2, s[88:89], %2, 0, s[88:89]\n\tv_addc_co_u32_e64 %3, s[90:91], %3, 0, s[90:91]\n\tv_addc_co_u32_e64 %2, s[92:93], %2, 0, s[92:93]\n\tv_addc_co_u32_e64 %3, s[94:95], %3, 0, s[94:95]" \
                    : "+v"(ca_), "+v"(cb_), "+v"(cc_), "+v"(cd_) : "v"(A), "v"(B), "v"(C), "v"(Dd), "v"(c1v), "v"(c2v) : "s88", "s89", "s90", "s91", "s92", "s93", "s94", "s95")
#pragma unroll
                for (int g8_ = 0; g8_ < 8; ++g8_) if (8 * g8_ < nil) { IDX_CNT4B(r[8 * g8_], r[8 * g8_ + 1], r[8 * g8_ + 2], r[8 * g8_ + 3]); IDX_CNT4B(r[8 * g8_ + 4], r[8 * g8_ + 5], r[8 * g8_ + 6], r[8 * g8_ + 7]); }
#undef IDX_CNT4B
                int pk = (int)((ca_ + cb_) | ((cc_ + cd_) << 16));
                pk += __builtin_amdgcn_update_dpp(0, pk, 0x111, 0xf, 0xf, false);
                pk += __builtin_amdgcn_update_dpp(0, pk, 0x112, 0xf, 0xf, false);
                pk += __builtin_amdgcn_update_dpp(0, pk, 0x114, 0xf, 0xf, false);
                pk += __builtin_amdgcn_update_dpp(0, pk, 0x118, 0xf, 0xf, false);
                pk += __builtin_amdgcn_update_dpp(0, pk, 0x142, 0xa, 0xf, false);
                unsigned tot = (unsigned)__builtin_amdgcn_readlane(pk, 31) + (unsigned)__builtin_amdgcn_readlane(pk, 63);
                { unsigned pt_; IDX_XCHG(tot, pt_); tot += pt_; }
                const unsigned t1 = tot & 0xffffu, t2 = tot >> 16;
                if (t1 == 256u) { xgt_ = c1; mt_ = 0u; done_ = true; }
                else if (t1 > 256u) lo_ = c1;
                else { hi_ = c1; chi_ = t1;
                       if (t2 == 256u) { xgt_ = c2; mt_ = 0u; done_ = true; }
                       else if (t2 > 256u) lo_ = c2;
                       else { hi_ = c2; chi_ = t2; } }
                if (!done_ && hi_ - lo_ == 1u) { xgt_ = hi_; xeq_ = lo_; mt_ = 256u - chi_; done_ = true; }
            }
            { LAS unsigned* hist = (LAS unsigned*)(lds + IDX_CTL_OFF + 1024) + q * 256;
#pragma unroll 1
              for (int round = 0; round < 6 && !done_; ++round) {
                const unsigned wdt = hi_ - lo_;
                const int sh = wdt <= 256u ? 0 : 24 - (int)__builtin_clz(wdt - 1u);
                hist[128 * h + lane] = 0u; hist[128 * h + 64 + lane] = 0u;
                LDS_WAIT(); { unsigned d_; IDX_XCHG16(0u, d_); (void)d_; }
                const unsigned lov = lo_;
                if (round == 0) {
                    IDX_FOR_LIVE( const unsigned d = r[il] - lov; if (d < wdt) __hip_atomic_fetch_add(hist + (d >> sh), 1u, __ATOMIC_RELAXED, __HIP_MEMORY_SCOPE_WORKGROUP); )
                } else {
#pragma unroll
                    for (int g8_ = 0; g8_ < 8; ++g8_) if (8 * g8_ < nil) {
#pragma unroll
                        for (int u4_ = 0; u4_ < 2; ++u4_) { const int il = 8 * g8_ + 4 * u4_;
                            const unsigned d0 = r[il] - lov, d1 = r[il + 1] - lov, d2 = r[il + 2] - lov, d3 = r[il + 3] - lov;
                            if (min(min(d0, d1), min(d2, d3)) < wdt) {
                                if (d0 < wdt) __hip_atomic_fetch_add(hist + (d0 >> sh), 1u, __ATOMIC_RELAXED, __HIP_MEMORY_SCOPE_WORKGROUP);
                                if (d1 < wdt) __hip_atomic_fetch_add(hist + (d1 >> sh), 1u, __ATOMIC_RELAXED, __HIP_MEMORY_SCOPE_WORKGROUP);
                                if (d2 < wdt) __hip_atomic_fetch_add(hist + (d2 >> sh), 1u, __ATOMIC_RELAXED, __HIP_MEMORY_SCOPE_WORKGROUP);
                                if (d3 < wdt) __hip_atomic_fetch_add(hist + (d3 >> sh), 1u, __ATOMIC_RELAXED, __HIP_MEMORY_SCOPE_WORKGROUP); } } }
                }
                LDS_WAIT(); { unsigned d_; IDX_XCHG16(0u, d_); (void)d_; }
                const u32x4 hb = *(const LAS u32x4*)(hist + 4 * lane);
                const unsigned s4 = (hb.x + hb.y) + (hb.z + hb.w);
                unsigned suf = s4;
#pragma unroll
                for (int o = 1; o < 64; o <<= 1) { const unsigned tv = (unsigned)__shfl_down((int)suf, o); if (lane + o < 64) suf += tv; }
                const unsigned long long okm = __ballot(chi_ + suf >= 256u);
                const int L = 63 - (int)__builtin_clzll(okm);
                const unsigned above = chi_ + (unsigned)__builtin_amdgcn_readlane((int)(suf - s4), L);
                const unsigned h0 = (unsigned)__builtin_amdgcn_readlane((int)hb.x, L), h1 = (unsigned)__builtin_amdgcn_readlane((int)hb.y, L),
                               h2 = (unsigned)__builtin_amdgcn_readlane((int)hb.z, L), h3 = (unsigned)__builtin_amdgcn_readlane((int)hb.w, L);
                unsigned Bsel, cab, cnb;
                if (above + h3 >= 256u) { Bsel = 3u; cab = above; cnb = h3; }
                else if (above + h3 + h2 >= 256u) { Bsel = 2u; cab = above + h3; cnb = h2; }
                else if (above + h3 + h2 + h1 >= 256u) { Bsel = 1u; cab = above + h3 + h2; cnb = h1; }
                else { Bsel = 0u; cab = above + h3 + h2 + h1; cnb = h0; }
                Bsel += 4u * (unsigned)L;
                const unsigned nlo = lo_ + (Bsel << sh); unsigned nhi = nlo + (1u << sh); if (nhi > hi_ || nhi < nlo) nhi = hi_;
                if (cab + cnb == 256u) { xgt_ = nlo; mt_ = 0u; done_ = true; }
                else if (sh == 0) { xgt_ = nlo + 1u; xeq_ = nlo; mt_ = 256u - cab; done_ = true; }
                else { lo_ = nlo; hi_ = nhi; chi_ = cab; }
              } }
#ifdef IDX_XTRA
#pragma unroll 1
            for (int xr = 0; xr < IDX_XTRA; ++xr) { unsigned dsum = 0; const unsigned cv = xgt_ + (unsigned)xr;
                IDX_FOR_LIVE( dsum += r[il] >= cv; )
                int pk = (int)dsum;
                pk += __builtin_amdgcn_update_dpp(0, pk, 0x111, 0xf, 0xf, false); pk += __builtin_amdgcn_update_dpp(0, pk, 0x112, 0xf, 0xf, false); pk += __builtin_amdgcn_update_dpp(0, pk, 0x114, 0xf, 0xf, false);
                pk += __builtin_amdgcn_update_dpp(0, pk, 0x118, 0xf, 0xf, false); pk += __builtin_amdgcn_update_dpp(0, pk, 0x142, 0xa, 0xf, false);
                unsigned tot = (unsigned)__builtin_amdgcn_readlane(pk, 31) + (unsigned)__builtin_amdgcn_readlane(pk, 63);
                { unsigned pt_; IDX_XCHG16(tot, pt_); tot += pt_; } asm volatile("" :: "s"(tot)); }
#endif
            T_ = xgt_;
            if (mt_ != 0u) {
                if (h == 0) { unsigned run = 0u;
#pragma unroll 1
                    for (int i = 0; i <= (jmax >> 1); ++i) { const bool ok_ = 2 * i + hh <= jmax; const unsigned kv = ok_ ? row[64 * i] : 0u; const bool eq = kv == xeq_; const unsigned long long bm = __ballot(eq);
                        const unsigned rank = run + __builtin_amdgcn_mbcnt_hi((unsigned)(bm >> 32), __builtin_amdgcn_mbcnt_lo((unsigned)bm, 0u));
                        if (eq && rank >= mt_) row[64 * i] = 0u;
                        run += (unsigned)__popcll(bm); } }
                T_ = xeq_;
            }
            }
#undef IDX_XCHG
#undef IDX_XCHG16
#undef IDX_FOR_LIVE
        }
        if (lane == 0 && h == 0) thr[q] = T_;
    }
#ifdef PROBE_VALU
    { float a0 = (float)lane, a1 = a0 + 1.f, a2 = a0 + 2.f, a3 = a0 + 3.f, a4 = a0 + 4.f, a5 = a0 + 5.f, a6 = a0 + 6.f, a7 = a0 + 7.f; const float m = 1.0000001f, c = 1e-9f;
#pragma unroll 1
      for (int it = 0; it < 64; ++it) {
#pragma unroll
          for (int u = 0; u < 8; ++u) { a0 = a0 * m + c; a1 = a1 * m + c; a2 = a2 * m + c; a3 = a3 * m + c; a4 = a4 * m + c; a5 = a5 * m + c; a6 = a6 * m + c; a7 = a7 * m + c; } }
      asm volatile("" :: "v"(a0), "v"(a1), "v"(a2), "v"(a3), "v"(a4), "v"(a5), "v"(a6), "v"(a7)); }
#endif
    LDS_WAIT(); __builtin_amdgcn_s_barrier(); asm volatile("" ::: "memory");
    { const unsigned tq0 = thr[hh], tq1 = thr[2 + hh];
#pragma unroll 4
      for (int j = wid; j <= ((t0 | 255) >> 5); j += 8) {
          bool s0 = false, s1 = false;
          if (j <= jmax) { s0 = SCO[hh * 8192 + 32 * j + r32] >= tq0; s1 = SCO[(2 + hh) * 8192 + 32 * j + r32] >= tq1; }
          const unsigned long long b0_ = __ballot(s0), b1_ = __ballot(s1);
          if (lane == 0) { u32x4 o; o.x = (unsigned)b0_; o.y = (unsigned)(b0_ >> 32); o.z = (unsigned)b1_; o.w = (unsigned)(b1_ >> 32); *(u32x4*)(BM + ((size_t)b * 256 + j) * S + t0) = o; }
      } }
    LDS_WAIT(); __builtin_amdgcn_s_barrier();
}
DEV void idx_phase(LAS unsigned char* lds, unsigned char* ws, unsigned* qhead, int wid, int lane) {
    constexpr unsigned NUNIT = T / 4;
    const bf16_t* IQ = (const bf16_t*)(ws + WS_IQ); const bf16_t* IK = (const bf16_t*)(ws + WS_IK); const float* IW = (const float*)(ws + WS_IW);
    LAS unsigned* QW = (LAS unsigned*)(lds + IDX_CTL_OFF + 32);
    if (wid == 0 && lane == 0) QW[0] = __hip_atomic_fetch_add(qhead, 1u, __ATOMIC_RELAXED, __HIP_MEMORY_SCOPE_AGENT);
    LDS_WAIT(); __builtin_amdgcn_s_barrier(); asm volatile("" ::: "memory");
    unsigned tk = QW[0];
    bf16x8 afr[4], b0[4], b1[4]; float w[16];
    if (tk < NUNIT) { int b, t0; idx_ticket(tk, b, t0); idx_prefetch(afr, w, b0, b1, IQ, IK, IW, b, t0, wid, lane); }
#pragma unroll 1
    for (int k = 0; tk < NUNIT; ++k) {
        int b, t0; idx_ticket(tk, b, t0); unsigned ntk = NUNIT;
        idx_unit(lds, IQ, IK, IW, (unsigned*)(ws + WS_BM), b, t0, qhead, k & 1, ntk, wid, lane, afr, w, b0, b1);
        tk = ntk;
    }
}

DEV void kn_phase(const WaveId& W, const bf16_t* Kk, float* KN) {
    for (int item = W.gw; item < NB * 8 * (S / 64); item += W.ngw) {
        const int b = item / (8 * (S / 64)), h = (item / (S / 64)) & 7, tile = item % (S / 64);
        const bf16_t* kp = Kk + ((size_t)b * S + tile * 64 + W.lane) * 512 + h * 64;
        float ss = 0.f;
#pragma unroll
        for (int c = 0; c < 8; ++c) { const u32x4 v = *(const u32x4*)(kp + 8 * c);
#pragma unroll
            for (int e = 0; e < 4; ++e) { const float lo = __uint_as_float(v[e] << 16), hi = __uint_as_float(v[e] & 0xffff0000u); ss += lo * lo + hi * hi; } }
        const float m = wave_max(ss);
        if (W.lane == 0) KN[item] = sqrtf(m) * 1.01f;
    }
}
#include <hip/hip_bf16.h>
namespace attn_body {
using bf16=__hip_bfloat16;
using bf16x8=__attribute__((ext_vector_type(8)))short;
using s16x4=__attribute__((ext_vector_type(4)))short;
using f32x16=__attribute__((ext_vector_type(16)))float;
using u32x4=__attribute__((ext_vector_type(4)))unsigned;
constexpr int BATCH=2,NHEAD=8,SEQ=8192,D=64,DM=NHEAD*D;
constexpr int NW=8,QBLK=32,QB=QBLK*NW,KVBLK=64,NQB=SEQ/QB;
constexpr int ATTN_PITCH=DM, ATTN_UNIT_ROWS=QB;
__device__ __forceinline__ int crow(int r,int hi){return (r&3)+8*(r>>2)+4*hi;}
#define SBAR() __builtin_amdgcn_sched_barrier(0)
__device__ __forceinline__ void cmask(f32x16&p0,f32x16&p1,int jb,int qrel,int hi){
  const float NEG=-INFINITY; int kb=64*jb+4*hi;
  #pragma unroll
  for(int r=0;r<16;++r){int kv=kb+(r&3)+8*(r>>2); if(kv>qrel)p0[r]=NEG; if(kv+32>qrel)p1[r]=NEG;}
}

constexpr int NSLOT=3, SLOTB=8192;
constexpr int LDS_K=0, LDS_V=NSLOT*SLOTB, LDS_WS=2*NSLOT*SLOTB, LDS_OST=LDS_WS+NW*64*4, LDS_BYTES=LDS_OST+NW*4096;
constexpr float C2=0.125f*1.4426950408889634f;
__device__ __forceinline__ void glds16(const void*gsrc,unsigned lds_dst){unsigned keep;
  asm volatile("s_mov_b32 %0, m0\n\ts_mov_b32 m0, %2\n\ts_nop 0\n\tglobal_load_lds_dwordx4 %1, off\n\ts_mov_b32 m0, %0":"=&s"(keep):"v"(gsrc),"s"(lds_dst):"memory");}
__device__ __forceinline__ float max3f(float a,float b,float c){float r;asm("v_max3_f32 %0, %1, %2, %3":"=v"(r):"v"(a),"v"(b),"v"(c));return r;}
__device__ __forceinline__ float max2f(float a,float b){float r;asm("v_max_f32_e32 %0, %1, %2":"=v"(r):"v"(a),"v"(b));return r;}
__device__ __forceinline__ float fadd_s(float a,float b){float r;asm("v_add_f32_e32 %0, %1, %2":"=v"(r):"v"(a),"v"(b));return r;}
__device__ __forceinline__ float fsub_s(float a,float b){float r;asm("v_sub_f32_e32 %0, %1, %2":"=v"(r):"v"(a),"v"(b));return r;}
typedef float f32x2_t __attribute__((ext_vector_type(2))); typedef __bf16 bf16x2_t __attribute__((ext_vector_type(2)));
__device__ __forceinline__ unsigned cvtpk_s(float lo,float hi){f32x2_t v={lo,hi};bf16x2_t b=__builtin_convertvector(v,bf16x2_t);return __builtin_bit_cast(unsigned,b);}
#define WAIT_BAR(N) asm volatile("s_waitcnt vmcnt(" #N ") lgkmcnt(0)\n\ts_barrier":::"memory")

__device__ __forceinline__ void qkt(f32x16&p0,f32x16&p1,const char*Kslot,const bf16x8*qr,const f32x16&negm,int r32,int hi){
  const char*kb=Kslot+hi*1024+r32*16;
  #pragma unroll
  for(int d0=0;d0<4;++d0){
    const bf16x8 b0=*reinterpret_cast<const bf16x8*>(kb+d0*2048);
    const bf16x8 b1=*reinterpret_cast<const bf16x8*>(kb+d0*2048+512);
    if(d0==0){p0=__builtin_amdgcn_mfma_f32_32x32x16_bf16(b0,qr[0],negm,0,0,0);p1=__builtin_amdgcn_mfma_f32_32x32x16_bf16(b1,qr[0],negm,0,0,0);}
    else{p0=__builtin_amdgcn_mfma_f32_32x32x16_bf16(b0,qr[d0],p0,0,0,0);p1=__builtin_amdgcn_mfma_f32_32x32x16_bf16(b1,qr[d0],p1,0,0,0);}}
}
typedef __attribute__((address_space(3))) const char* lds_cptr;
typedef short v4i16_t __attribute__((ext_vector_type(4)));
__device__ __forceinline__ void kload8(bf16x8*kf,lds_cptr kp){
  kf[0]=*(const __attribute__((address_space(3))) bf16x8*)(kp);      kf[1]=*(const __attribute__((address_space(3))) bf16x8*)(kp+512);
  kf[2]=*(const __attribute__((address_space(3))) bf16x8*)(kp+2048); kf[3]=*(const __attribute__((address_space(3))) bf16x8*)(kp+2560);
  kf[4]=*(const __attribute__((address_space(3))) bf16x8*)(kp+4096); kf[5]=*(const __attribute__((address_space(3))) bf16x8*)(kp+4608);
  kf[6]=*(const __attribute__((address_space(3))) bf16x8*)(kp+6144); kf[7]=*(const __attribute__((address_space(3))) bf16x8*)(kp+6656);
}
__device__ __forceinline__ void kload2(bf16x8*kf,lds_cptr kp,int j){ kf[2*j]=*(const __attribute__((address_space(3))) bf16x8*)(kp+j*2048); kf[2*j+1]=*(const __attribute__((address_space(3))) bf16x8*)(kp+j*2048+512); }
__device__ __forceinline__ s16x4 vtr(lds_cptr p){ return __builtin_bit_cast(s16x4,__builtin_amdgcn_ds_read_tr16_b64_v4i16((__attribute__((address_space(3))) v4i16_t*)p)); }
__device__ __forceinline__ float rowmax(const f32x16&p0,const f32x16&p1){
  float a=max3f(p0[0],p0[1],p1[0]),b=max3f(p0[2],p0[3],p1[1]);a=max3f(a,p1[2],p1[3]);
  #pragma unroll
  for(int r=4;r<16;r+=4){a=max3f(a,p0[r],p0[r+1]);b=max3f(b,p0[r+2],p0[r+3]);a=max3f(a,p1[r],p1[r+1]);b=max3f(b,p1[r+2],p1[r+3]);}
  const float m=max2f(a,b);
  auto rr=__builtin_amdgcn_permlane32_swap(__float_as_uint(m),__float_as_uint(m),false,false);
  return max2f(__uint_as_float(rr[0]),__uint_as_float(rr[1]));
}
__device__ __forceinline__ void pv(f32x16*o,int vb,bf16x8 pa0,bf16x8 pa1,bf16x8 pa2,bf16x8 pa3){
  #pragma unroll
  for(int d0=0;d0<2;++d0){s16x4 lo[4],hi[4];
    #pragma unroll
    for(int ks=0;ks<4;++ks){
      asm volatile("ds_read_b64_tr_b16 %0,%1 offset:%c2":"=&v"(lo[ks]):"v"(vb),"i"(d0*4096+ks*1024):"memory");
      asm volatile("ds_read_b64_tr_b16 %0,%1 offset:%c2":"=&v"(hi[ks]):"v"(vb),"i"(d0*4096+ks*1024+512):"memory");}
    asm volatile("s_waitcnt lgkmcnt(0)":::"memory");SBAR();
    #define PK(k) (bf16x8){lo[k][0],lo[k][1],lo[k][2],lo[k][3],hi[k][0],hi[k][1],hi[k][2],hi[k][3]}
    o[d0]=__builtin_amdgcn_mfma_f32_32x32x16_bf16(pa0,PK(0),o[d0],0,0,0);
    o[d0]=__builtin_amdgcn_mfma_f32_32x32x16_bf16(pa1,PK(1),o[d0],0,0,0);
    o[d0]=__builtin_amdgcn_mfma_f32_32x32x16_bf16(pa2,PK(2),o[d0],0,0,0);
    o[d0]=__builtin_amdgcn_mfma_f32_32x32x16_bf16(pa3,PK(3),o[d0],0,0,0);
    #undef PK
  }
}

#ifndef ATTN_STORE16
#define ATTN_STORE16(p,v) (*(u32x4*)(p)=(v))
#endif
template<int THRL> __device__ __forceinline__ void attn_unit(int b,int h,int qb,const bf16*Q,const bf16*__restrict__ K,const bf16*__restrict__ V,bf16*O,char*shm,const unsigned*__restrict__ BMb,const float*KNbh,const int tid){
  const int lane=tid&63,r32=lane&31,hi=lane>>5; const int wid=__builtin_amdgcn_readfirstlane(tid>>6);
  const long rowbase=(long)b*SEQ; const int q0=qb*QB;
  const bf16*Qw=Q+(rowbase+q0+wid*QBLK)*DM+h*D;
  const bf16*Kh=K+rowbase*DM+h*D,*Vh=V+rowbase*DM+h*D;
  const unsigned lds0=(unsigned)(uintptr_t)shm;
  float*wsf=(float*)(shm+LDS_WS)+wid*64;
  const bf16*ksrc=Kh+(long)lane*DM+wid*8;
  const bf16*vsrc=Vh+(long)(16*(wid&3)+(lane>>2))*DM+(wid>>2)*32+(lane&3)*8;
  const unsigned kdst=lds0+LDS_K+wid*1024, vdst=lds0+LDS_V+wid*1024;
  #define DMA_K(t,slot) glds16(ksrc+(long)(t)*KVBLK*DM,(unsigned)__builtin_amdgcn_readfirstlane(kdst+(slot)))
  #define DMA_V(t,slot) glds16(vsrc+(long)(t)*KVBLK*DM,(unsigned)__builtin_amdgcn_readfirstlane(vdst+(slot)))
  const int vb0=(int)(lds0+LDS_V)+((lane>>4)&1)*32+(lane&3)*8+(4*hi+((lane&15)>>2))*64;
  const char*Kbase=shm+LDS_K; bf16x8 kf[8];
  const lds_cptr shm3=(lds_cptr)shm; const lds_cptr kp0=shm3+LDS_K+hi*1024+r32*16; const lds_cptr vp0=shm3+LDS_V+((lane>>4)&1)*32+(lane&3)*8+(4*hi+((lane&15)>>2))*64;
  const int NT=(q0+QB)/KVBLK;
  DMA_K(0,0);DMA_V(0,0);DMA_K(1,SLOTB);
  bf16x8 qr[4];
  #pragma unroll
  for(int d0=0;d0<4;++d0)qr[d0]=*reinterpret_cast<const bf16x8*>(&Qw[(long)r32*DM+d0*16+hi*8]);
  const unsigned*bmp=BMb+(q0+wid*QBLK+r32);
  unsigned mwE0=bmp[0],mwE1=bmp[(size_t)SEQ],mwO0=0u,mwO1=0u;
  bool seen=false;
  float qn; { float qs=0.f;
    _Pragma("unroll") for(int d0=0;d0<4;++d0) _Pragma("unroll") for(int e=0;e<8;++e){ const float x=__uint_as_float(((unsigned)(unsigned short)qr[d0][e])<<16); qs+=x*x; }
    auto rr=__builtin_amdgcn_permlane32_swap(__float_as_uint(qs),__float_as_uint(qs),false,false); qn=__builtin_sqrtf(__uint_as_float(rr[0])+__uint_as_float(rr[1]))*1.01f; }
  constexpr float FASTB=60.f;
  int zlane=0; asm volatile("":"+v"(zlane));
  const float*knp=KNbh+zlane;
  float knE=knp[0],knO=0.f;
  bool anysel_=false;
  #define SLOWT(PS) (__any(!(qn*kn##PS<=FASTB)||mhat!=0.f))
  float mhat=0.f,l_reg=0.f;f32x16 o[2];o[0]=f32x16{};o[1]=f32x16{};const f32x16 zero16=f32x16{};
  const int qrel=wid*QBLK+r32;
  #define CMASK(P0,P1,SLOW,PS) do{ const unsigned m0_=mw##PS##0>>(4*hi), m1_=mw##PS##1>>(4*hi); anysel_=(mw##PS##0|mw##PS##1)!=0u; \
    if(SLOW){ _Pragma("unroll") for(int r=0;r<16;++r){ P0[r]-=mhat; P1[r]-=mhat; } } \
    _Pragma("unroll") for(int r=0;r<16;++r){ const int bit_=(r&3)+8*(r>>2); \
      const unsigned e0_=(unsigned)__builtin_amdgcn_sbfe((int)m0_,bit_,1), e1_=(unsigned)__builtin_amdgcn_sbfe((int)m1_,bit_,1); \
      P0[r]=__uint_as_float((__float_as_uint(P0[r])&e0_)|(0xff800000u&~e0_)); P1[r]=__uint_as_float((__float_as_uint(P1[r])&e1_)|(0xff800000u&~e1_)); } \
    }while(0)
  bool resc=false;
  #define START(P0,P1,SLOW) do{ resc=false; seen=anysel_; \
    if(SLOW){ const float rm=rowmax(P0,P1); const float dl=(rm==-INFINITY)?0.f:rm; mhat=fadd_s(mhat,dl); \
      _Pragma("unroll") for(int r=0;r<16;++r){P0[r]=fsub_s(P0[r],dl);P1[r]=fsub_s(P1[r],dl);} \
      } \
    _Pragma("unroll") for(int r=0;r<16;++r)P0[r]=__builtin_amdgcn_exp2f(P0[r]); }while(0)
  #define RESC() do{ if(resc){ asm volatile("s_waitcnt lgkmcnt(0)":::"memory"); \
      _Pragma("unroll") for(int d_=0;d_<2;++d_) _Pragma("unroll") for(int r=0;r<16;++r)o[d_][r]*=wsf[crow(r,hi)]; } }while(0)
  f32x16 pA0,pA1,pB0,pB1;
  int sl_prev=0,sl_cur=0,sl_next=SLOTB;
  #define ROT() do{sl_prev=sl_cur;sl_cur=sl_next;sl_next=(sl_next==(NSLOT-1)*SLOTB)?0:sl_next+SLOTB;}while(0)
  DMA_K(2,2*SLOTB);
  WAIT_BAR(3);
  { mwO0=bmp[(size_t)2*SEQ]; mwO1=bmp[(size_t)3*SEQ]; knO=knp[1];
  const bool slow0_=SLOWT(E);
  qkt(pA0,pA1,Kbase,qr,zero16,r32,hi);asm volatile("s_nop 15\n\ts_nop 7":"+v"(pA0),"+v"(pA1));CMASK(pA0,pA1,slow0_,E);
  START(pA0,pA1,slow0_); }
  _Pragma("unroll") for(int r=0;r<16;++r)pA1[r]=__builtin_amdgcn_exp2f(pA1[r]);
  WAIT_BAR(0);
  DMA_K(3,0);DMA_V(1,SLOTB);
  ROT();
  kload8(kf,kp0+sl_cur);
  WAIT_BAR(2);
  s16x4 vlo[8],vhi[8]; u32x4 pw0,pw1,pw2,pw3;
  #define PKW(P,B) cvtpk_s(P[B],P[B+1])
  #define PAF(k) __builtin_bit_cast(bf16x8,pw##k)
  #define VFR(i) (bf16x8){vlo[i][0],vlo[i][1],vlo[i][2],vlo[i][3],vhi[i][0],vhi[i][1],vhi[i][2],vhi[i][3]}
  #define PIN(x) asm volatile("":"+v"(x))
  #define MX3(a,b,c) __builtin_fmaxf(__builtin_fmaxf((a),(b)),(c))
  #define GAPA(MF,A0,A1,A2,A3,W0,W1,PW) do{ MF; sacc+=A0; sacc+=A1; sacc+=A2; sacc+=A3; PIN(sacc); W0; W1; PIN(PW); SBAR(); }while(0)
  #define EX(v) __builtin_amdgcn_exp2f(v)
  #define GAPB(MF,X,B) do{ MF; X[B]=EX(X[B]); X[B+1]=EX(X[B+1]); X[B+2]=EX(X[B+2]); X[B+3]=EX(X[B+3]); PIN(X); SBAR(); }while(0)
  #define VRD(i) do{ vlo[i]=vtr(vp_+(((i)>>2)*4096+((i)&3)*1024)); vhi[i]=vtr(vp_+(((i)>>2)*4096+((i)&3)*1024+512)); }while(0)
  #define KRD(G,j) do{ if(G){ kload2(kf,kp0+sl_next,j); SBAR(); } }while(0)
  #define STEP(C0,C1,P0,P1,t,GK,GV,GL,PS,NS) do{ SBAR(); \
    if((t)+1<NT){ mw##NS##0=bmp[(size_t)(2*(t)+2)*SEQ]; mw##NS##1=bmp[(size_t)(2*(t)+3)*SEQ]; kn##NS=knp[(t)+1]; }     \
    const lds_cptr vp_=vp0+sl_prev; \
    VRD(0); SBAR(); float sacc=(P0[0]+P0[1]); \
    GAPA(C0=__builtin_amdgcn_mfma_f32_32x32x16_bf16(kf[0],qr[0],zero16,0,0,0), P0[2],P0[3],P0[4],P0[5],     pw0[0]=PKW(P0,0), pw0[1]=PKW(P0,2), pw0); \
    VRD(4); SBAR(); GAPA(C1=__builtin_amdgcn_mfma_f32_32x32x16_bf16(kf[1],qr[0],zero16,0,0,0), P0[6],P0[7],P0[8],P0[9],     pw0[2]=PKW(P0,4), pw0[3]=PKW(P0,6), pw0); \
    VRD(1); SBAR(); GAPA(C0=__builtin_amdgcn_mfma_f32_32x32x16_bf16(kf[2],qr[1],C0,0,0,0),   P0[10],P0[11],P0[12],P0[13], pw1[0]=PKW(P0,8), pw1[1]=PKW(P0,10), pw1); \
    VRD(5); SBAR(); GAPA(C1=__builtin_amdgcn_mfma_f32_32x32x16_bf16(kf[3],qr[1],C1,0,0,0),   P0[14],P0[15],P1[0],P1[1],   pw1[2]=PKW(P0,12),pw1[3]=PKW(P0,14), pw1); \
    VRD(2); SBAR(); GAPA(C0=__builtin_amdgcn_mfma_f32_32x32x16_bf16(kf[4],qr[2],C0,0,0,0),   P1[2],P1[3],P1[4],P1[5],     pw2[0]=PKW(P1,0), pw2[1]=PKW(P1,2), pw2); \
    VRD(6); SBAR(); GAPA(C1=__builtin_amdgcn_mfma_f32_32x32x16_bf16(kf[5],qr[2],C1,0,0,0),   P1[6],P1[7],P1[8],P1[9],     pw2[2]=PKW(P1,4), pw2[3]=PKW(P1,6), pw2); \
    VRD(3); SBAR(); GAPA(C0=__builtin_amdgcn_mfma_f32_32x32x16_bf16(kf[6],qr[3],C0,0,0,0),   P1[10],P1[11],P1[12],P1[13], pw3[0]=PKW(P1,8), pw3[1]=PKW(P1,10), pw3); \
    VRD(7); SBAR(); GAPA(C1=__builtin_amdgcn_mfma_f32_32x32x16_bf16(kf[7],qr[3],C1,0,0,0),   P1[14],P1[15],0.f,0.f,       pw3[2]=PKW(P1,12),pw3[3]=PKW(P1,14), pw3); \
    l_reg+=sacc; \
    if(GK){DMA_K((t)+3,sl_cur);} if(GV){DMA_V((t)+1,sl_next);} \
    const bool slow_=SLOWT(PS); CMASK(C0,C1,slow_,PS); resc=false; \
    if(__builtin_expect(slow_,0)){ float a=MX3(C0[0],C0[1],C1[0]),b=MX3(C0[2],C0[3],C1[1]); a=MX3(a,C1[2],C1[3]); \
      _Pragma("unroll") for(int r=4;r<16;r+=4){a=MX3(a,C0[r],C0[r+1]);b=MX3(b,C0[r+2],C0[r+3]);a=MX3(a,C1[r],C1[r+1]);b=MX3(b,C1[r+2],C1[r+3]);} \
      float rm=__builtin_fmaxf(a,b); { auto rr=__builtin_amdgcn_permlane32_swap(__float_as_uint(rm),__float_as_uint(rm),false,false); rm=__builtin_fmaxf(__uint_as_float(rr[0]),__uint_as_float(rr[1])); } \
      const bool fresh_=!seen&&rm>-INFINITY;     \
      if(__builtin_expect(__any(rm>(float)THRL||(fresh_&&rm<-(float)THRL)),0)){ const float dl=fresh_?rm:__builtin_fmaxf(rm,0.f); mhat+=dl; \
        _Pragma("unroll") for(int r=0;r<16;++r){C0[r]-=dl;C1[r]-=dl;} \
        const float f=dl>0.f?__builtin_amdgcn_exp2f(-dl):1.f; l_reg*=f; if(hi==0)wsf[r32]=f; resc=true; } } \
    seen=seen||anysel_; \
    SBAR(); \
    GAPB(o[0]=__builtin_amdgcn_mfma_f32_32x32x16_bf16(PAF(0),VFR(0),o[0],0,0,0), C0,0); \
    GAPB(o[1]=__builtin_amdgcn_mfma_f32_32x32x16_bf16(PAF(0),VFR(4),o[1],0,0,0), C0,4); \
    KRD(GL,0); GAPB(o[0]=__builtin_amdgcn_mfma_f32_32x32x16_bf16(PAF(1),VFR(1),o[0],0,0,0), C0,8); \
    KRD(GL,1); GAPB(o[1]=__builtin_amdgcn_mfma_f32_32x32x16_bf16(PAF(1),VFR(5),o[1],0,0,0), C0,12); \
    KRD(GL,2); GAPB(o[0]=__builtin_amdgcn_mfma_f32_32x32x16_bf16(PAF(2),VFR(2),o[0],0,0,0), C1,0); \
    KRD(GL,3); GAPB(o[1]=__builtin_amdgcn_mfma_f32_32x32x16_bf16(PAF(2),VFR(6),o[1],0,0,0), C1,4); \
    GAPB(o[0]=__builtin_amdgcn_mfma_f32_32x32x16_bf16(PAF(3),VFR(3),o[0],0,0,0), C1,8); \
    GAPB(o[1]=__builtin_amdgcn_mfma_f32_32x32x16_bf16(PAF(3),VFR(7),o[1],0,0,0), C1,12); \
    }while(0)
  int t=1;
  for(;t+5<NT;t+=2){
    STEP(pB0,pB1,pA0,pA1,t,true,true,true,O,E);     WAIT_BAR(2); RESC(); ROT();
    STEP(pA0,pA1,pB0,pB1,t+1,true,true,true,E,O);   WAIT_BAR(2); RESC(); ROT();
  }
  #define ENDW(tt) do{ if((tt)+3<NT){WAIT_BAR(2);} else if((tt)+2<NT){WAIT_BAR(1);} else {WAIT_BAR(0);} }while(0)
  for(;t+1<NT;t+=2){
    STEP(pB0,pB1,pA0,pA1,t,(t+3<NT),(t+1<NT),(t+1<NT),O,E);       ENDW(t);   RESC(); ROT();
    STEP(pA0,pA1,pB0,pB1,t+1,(t+4<NT),(t+2<NT),(t+2<NT),E,O);     ENDW(t+1); RESC(); ROT();
  }
  STEP(pB0,pB1,pA0,pA1,NT-1,false,false,false,O,E); RESC();
  { float sacc=pB0[0]+pB0[1]; _Pragma("unroll") for(int r=2;r<16;++r)sacc+=pB0[r]; _Pragma("unroll") for(int r=0;r<16;++r)sacc+=pB1[r]; l_reg+=sacc;
    pw0=(u32x4){PKW(pB0,0),PKW(pB0,2),PKW(pB0,4),PKW(pB0,6)};pw1=(u32x4){PKW(pB0,8),PKW(pB0,10),PKW(pB0,12),PKW(pB0,14)};pw2=(u32x4){PKW(pB1,0),PKW(pB1,2),PKW(pB1,4),PKW(pB1,6)};pw3=(u32x4){PKW(pB1,8),PKW(pB1,10),PKW(pB1,12),PKW(pB1,14)};
    SBAR(); pv(o,vb0+sl_cur,PAF(0),PAF(1),PAF(2),PAF(3)); }
  #undef PKW
  #undef PAF
  #undef VFR
  #undef PIN
  #undef MX3
  #undef GAPA
  #undef GAPB
  #undef EX
  #undef VRD
  #undef KRD
  #undef STEP
  #undef ENDW
  {auto rr=__builtin_amdgcn_permlane32_swap(__float_as_uint(l_reg),__float_as_uint(l_reg),false,false);l_reg=__uint_as_float(rr[0])+__uint_as_float(rr[1]);}
  if(hi==0)wsf[32+r32]=l_reg;asm volatile("s_waitcnt lgkmcnt(0)":::"memory");
  float rli[16];
  #pragma unroll
  for(int r=0;r<16;++r)rli[r]=__builtin_amdgcn_rcpf(wsf[32+crow(r,hi)]);
  bf16*Ow=O+(rowbase+q0+wid*QBLK)*DM+h*D;
  { bf16*stg=(bf16*)(shm+LDS_OST)+wid*2048;
    #pragma unroll
    for(int r=0;r<16;++r){const int orow=crow(r,hi);
      #pragma unroll
      for(int d0=0;d0<2;++d0)stg[orow*64+d0*32+r32]=__float2bfloat16(o[d0][r]*rli[r]);}
    asm volatile("s_waitcnt lgkmcnt(0)":::"memory");
    #pragma unroll
    for(int i=0;i<4;++i){const int row=i*8+(lane>>3),ch=lane&7; const u32x4 v=*(const u32x4*)(stg+row*64+ch*8); ATTN_STORE16(Ow+(long)row*DM+ch*8,v);} }
  asm volatile("s_waitcnt lgkmcnt(0)\n\ts_barrier":::"memory");
  #undef DMA_K
  #undef DMA_V
  #undef CMASK
  #undef SLOWT
  #undef START
  #undef RESC
  #undef ROT
}
constexpr int ATTN_LDS_BYTES=LDS_BYTES;
#undef SBAR
#undef WAIT_BAR
}
constexpr int MK_THREADS = 512;
constexpr int RING_BYTES = 131072, MISC_OFF = RING_BYTES + 320, MK_LDS_BYTES = 147456;
constexpr size_t WS_CTL = 0, CTL_ZERO_BYTES = 65536; constexpr int CW_BAR = 4096;
constexpr int PH_PREP0 = 0, PH_L0 = 1, PH_PER_LAYER = 14, NPH = PH_L0 + 2 * PH_PER_LAYER;
enum { Q_INPROJ = 0, Q_SBIDX, Q_DSA, Q_GATES, Q_MERGE, Q_MIX, Q_NORMXA, Q_XALOG, Q_XAOUT, Q_NORMFFN, Q_UP, Q_FFNMID, Q_DOWN, Q_NEXT };

#ifndef QBUILD
#define QBUILD 0xffffu
#endif
#define QON(x) ((QBUILD >> (x)) & 1u)
struct Args { const float* in[20]; float* out; unsigned char* ws; int ph_lo, ph_hi; };

__global__ void __launch_bounds__(MK_THREADS, 2) mk_fwd(Args args) {
    __shared__ __attribute__((aligned(16))) unsigned char lds_raw[MK_LDS_BYTES];
    LAS unsigned char* lds = (LAS unsigned char*)lds_raw;
    volatile LAS unsigned* MISC = (volatile LAS unsigned*)(lds + MISC_OFF);
    const int G = gridDim.x, bx = blockIdx.x;
    unsigned char* ws0 = args.ws;
    const int wave_s = __builtin_amdgcn_readfirstlane((int)threadIdx.x >> 6);
    for (int u = mk_tid(wave_s); u < (MK_LDS_BYTES - RING_BYTES) / 4; u += MK_THREADS) ((LAS unsigned*)(lds + RING_BYTES))[u] = 0u;
    __syncthreads();
    const int lo = args.ph_lo, hi = args.ph_hi;
    XcdBarrier bar; bar.bar = (unsigned*)(ws0 + WS_CTL) + CW_BAR; bar.x = 0; bar.st = nullptr;
    if (hi - lo > 1) bar = xcd_barrier_post((unsigned*)(ws0 + WS_CTL) + CW_BAR, MISC + 8, mk_tid(wave_s));
#define BPW(off) ((bf16_t*)(ws + (off)))
    const int vcu = (G % 8 == 0) ? (bx % 8) * (G / 8) + bx / 8 : bx;
    bool use_local = false;
    for (int p = lo; p < hi; ++p) {
#ifdef PROBE_REP
        const int reps = (p >= PH_L0 && ((PROBE_REP >> ((p - PH_L0) % PH_PER_LAYER)) & 1)) ? 2 : 1;
#else
        const int reps = 1;
#endif
#ifdef PROBE_REP
#pragma unroll 1
        for (int rep = 0; rep < reps; ++rep) {
        const bool dry = rep + 1 < reps;
#else
        { constexpr bool dry = false;
#endif
        int oz = 0; asm volatile("" : "+s"(oz));
        int tid = mk_tid(wave_s); asm volatile("" : "+v"(tid));
        const int wave = __builtin_amdgcn_readfirstlane(tid >> 6), lane = tid & 63;
        WaveId W; W.gw = vcu * 8 + wave; W.ngw = G * 8; W.wave = wave; W.lane = lane;
        unsigned char* ws = args.ws + oz; float* X = args.out + oz;
#define INP(k) (args.in[(k) + oz])
        if (p == PH_PREP0) {
            prep0_phase(W, (LAS float*)(lds + wave * 16384), ws, args.in + oz, (bf16_t*)X);
        } else if (p >= PH_L0) {
            const int l = (p - PH_L0) / PH_PER_LAYER, q = (p - PH_L0) % PH_PER_LAYER;
            const float* Xin = l == 0 ? INP(0) : X;
            pg8::u64* SSb = (pg8::u64*)(ws + WS_SS);
#define SSA(i) (SSb + (size_t)(i) * T)
            if (q == Q_SBIDX) {
                sb_phase(W, lds, ws, dry);
                conv_sc_phase(vcu * MK_THREADS + tid, G * MK_THREADS, BPW(WS_SCB), BPW(WS_CX), INP(4) + l * 3 * 512, dry);
                kn_phase(W, BPW(WS_KC), (float*)(ws + WS_KN));
                if (l == 0 && !dry && QON(15)) {
                    __syncthreads();
                    { pg8::Order S; S.init(1, 4, 16, G, bx); pg8::PtrG P{(const char*)(ws + WS_KVM), (const char*)(ws + WS_WQ)}; pg8::EpiPrep E{ws, 1};
                      pg8::gemm_phase<pg8::EpiPrep, pg8::PtrG, true, true>(lds, tid, 2 * D, D, 256, S, P, E); }
                    { pg8::Order S; S.init(4, 1, 16, G, (bx + 64) % G); pg8::PtrH P{(const char*)(ws + WS_KVM), (const char*)(ws + WS_WOT)}; pg8::EpiPrep E{ws, 2};
                      pg8::gemm_phase<pg8::EpiPrep, pg8::PtrH, true, true>(lds, tid, D, 2 * D, 256, S, P, E); }
                }
                __syncthreads();
                idx_phase(lds, ws, (unsigned*)(ws + WS_CTL) + 1024 + 64 * l, wave, lane);
            } else if (q == Q_DSA) {
#ifndef NO_DSA
                {
                    for (int pr = vcu; pr < NB * 8 * 16; pr += G) { const int bh = pr >> 4, sx = pr & 15, bb = bh >> 3, hh = bh & 7;
#pragma unroll 1
                        for (int k2 = 0; k2 < 2; ++k2)
                            attn_body::attn_unit<8>(bb, hh, k2 == 0 ? sx : 31 - sx, (const attn_body::bf16*)BPW(WS_QC), (const attn_body::bf16*)BPW(WS_KC), (const attn_body::bf16*)BPW(WS_VC),
                                                    (attn_body::bf16*)(dry ? BPW(WS_KA) : BPW(WS_QC)), (char*)lds_raw, (const unsigned*)(ws + WS_BM) + (size_t)bb * 256 * S,
                                                    (const float*)(ws + WS_KN) + bh * (S / 64), tid); }
                }
#endif
            } else if (q == Q_FFNMID) {
            } else if (q == Q_NEXT) {
                if (l + 1 == DEPTH && !dry) final_norm(W, BPW(WS_XN), X, INP(19), SSA(6));
            } else if (q == Q_INPROJ && QON(Q_INPROJ)) {
                pg8::Order S; S.init(T / 256, NIN / 256, 1, G, bx);
                pg8::PtrStd P{(const char*)X, (const char*)(ws + WS_WIN), 0, 0, 0, (size_t)256 * D * 2, (size_t)256 * D * 2};
                if (l > 0 && !dry) { int base = 0; convert_layer_weights(W, (LAS float*)(lds + wave * 16384), base, ws, args.in + oz, l, 4); __syncthreads(); }
                pg8::EpiInProj E{ws, SSA(3 * l)};
                pg8::gemm_phase<pg8::EpiInProj, pg8::PtrStd, true, true>(lds, tid, D, D, D, S, P, E);
                if (l == 0 && !dry && QON(14)) {
                    pg8::Order S2; S2.init(2, 8, 2, G, (bx + G - 64) % G);
                    pg8::PtrStd P2{(const char*)(ws + WS_MEMN), (const char*)(ws + WS_WKVT), 1 * MiB, 4 * MiB, 0, (size_t)256 * D * 2, (size_t)256 * D * 2};
                    pg8::EpiPrep E2{ws, 0};
                    pg8::gemm_phase<pg8::EpiPrep, pg8::PtrStd, true, true>(lds, tid, D, D, D, S2, P2, E2);
                }
            } else if (q == Q_GATES && QON(Q_GATES)) {
                pg8::Order S; S.init(T / 256, 12, 1, G, bx);
                pg8::PtrStd P{(const char*)X, (const char*)(ws + WS_WG), 0, 0, 0, (size_t)256 * D * 2, (size_t)256 * D * 2};
                pg8::EpiGates E{BPW(WS_GATES), SSA(3 * l)};
                pg8::gemm_phase<pg8::EpiGates, pg8::PtrStd, true, true>(lds, tid, D, D, D, S, P, E);
            } else if (q == Q_MERGE && QON(Q_MERGE)) {
                pg8::Order S; S.init(T / 256, 4, 3, G, bx);
                pg8::PtrStd P{(const char*)(ws + WS_QA), (const char*)(ws + WS_WBR), 16 * MiB, (size_t)D * 512 * 2, 0, (size_t)256 * 512 * 2, (size_t)256 * 512 * 2};
                pg8::EpiMergeC E{BPW(WS_XN), BPW(WS_GATES)};
                pg8::gemm_phase<pg8::EpiMergeC, pg8::PtrStd, true, true>(lds, tid, 512, 512, 512, S, P, E);
            } else if (q == Q_MIX && QON(Q_MIX)) {
                pg8::Order S; S.init(T / 256, 4, 1, G, bx);
                pg8::PtrStd P{(const char*)(ws + WS_XN), (const char*)(ws + WS_WMIX), 0, 0, 0, (size_t)256 * D * 2, (size_t)256 * D * 2};
                if (l == 0) { pg8::EpiResid<true> E{(const void*)INP(0), dry ? BPW(WS_FU) : BPW(WS_XBXA), dry ? SSA(0) : SSA(1)};
                    pg8::gemm_phase<pg8::EpiResid<true>, pg8::PtrStd, true, true>(lds, tid, D, D, D, S, P, E); }
                else { pg8::EpiResid<false> E{(const void*)X, dry ? BPW(WS_FU) : BPW(WS_XBXA), dry ? SSA(0) : SSA(4)};
                    pg8::gemm_phase<pg8::EpiResid<false>, pg8::PtrStd, true, true>(lds, tid, D, D, D, S, P, E); }

            } else if (q == Q_XALOG && QON(Q_XALOG)) {
                pg8::Order S; S.init(T / 256, 4, 1, G, bx);
                pg8::PtrStd P{(const char*)(ws + WS_XBXA), (const char*)(ws + WS_GT + (size_t)l * 4 * MiB), 0, 0, 2 * MiB, (size_t)256 * D * 2, (size_t)256 * D * 2};
                pg8::EpiSoftmax E{BPW(WS_PXA), SSA(1 + 3 * l)};
                pg8::gemm_phase<pg8::EpiSoftmax, pg8::PtrStd, false, true>(lds, tid, D, D, D, S, P, E);
            } else if (q == Q_XAOUT && QON(Q_XAOUT)) {
                pg8::Order S; S.init(T / 256, 4, 1, G, bx);
                pg8::PtrStd P{(const char*)(ws + WS_PXA), (const char*)(ws + WS_HT + (size_t)l * 4 * MiB), 0, 0, 2 * MiB, (size_t)256 * D * 2, (size_t)256 * D * 2};
                pg8::EpiResid<false> E{(const void*)BPW(WS_XBXA), dry ? BPW(WS_FU) : BPW(WS_XN), dry ? SSA(0) : SSA(2 + 3 * l)};
                pg8::gemm_phase<pg8::EpiResid<false>, pg8::PtrStd, true, true>(lds, tid, D, D, D, S, P, E);
            } else if (q == Q_UP && QON(Q_UP)) {
                pg8::Order S; S.init(T / 256, 22, 1, G, bx);
                pg8::PtrStd P{(const char*)(ws + WS_XN), (const char*)(ws + WS_WUP), 0, 0, 0, (size_t)256 * D * 2, (size_t)256 * D * 2};
                pg8::EpiUpF E{BPW(WS_FU), BPW(WS_SIDEA), BPW(WS_SIDEU), SSA(2 + 3 * l), INP(16) + l * 3 * DFF, INP(17) + l * DFF};
                pg8::gemm_phase<pg8::EpiUpF, pg8::PtrStd, true, true>(lds, tid, D, D, D, S, P, E);
            } else if (q == Q_DOWN && QON(Q_DOWN)) {
                pg8::Order S; S.init(T / 256, 4, 1, G, bx);
                if (!dry) {
#pragma unroll 1
                    for (int i = 0; ; ++i) { pg8::Unit u0; if (!S.next(i, u0)) break; ffn_fix_phase(tid, MK_THREADS, BPW(WS_SIDEA), BPW(WS_SIDEU), BPW(WS_FU), INP(16) + l * 3 * DFF, INP(17) + l * DFF, 4 * u0.pm, 4); }
                    asm volatile("s_waitcnt vmcnt(0)" ::: "memory"); __syncthreads();
                }
                pg8::PtrStd P{(const char*)(ws + WS_FU), (const char*)(ws + WS_WDOWN), 0, 0, 0, (size_t)256 * DFF * 2, (size_t)256 * DFF * 2};
                pg8::EpiResid<false> E{(const void*)BPW(WS_XN), dry ? BPW(WS_QA) : (l + 1 < DEPTH ? (bf16_t*)X : BPW(WS_XN)), dry ? SSA(0) : SSA(3 + 3 * l)};
                pg8::gemm_phase<pg8::EpiResid<false>, pg8::PtrStd, true, true>(lds, tid, DFF, DFF, DFF, S, P, E);
                if (l + 1 < DEPTH && !dry) {
                    __syncthreads(); int base = 0; convert_layer_weights(W, (LAS float*)(lds + wave * 16384), base, ws, args.in + oz, l + 1, 3); }
            }
        }
        }
        if (p + 1 < hi && !(p >= PH_L0 && ((p - PH_L0) % PH_PER_LAYER == Q_NORMXA || (p - PH_L0) % PH_PER_LAYER == Q_NORMFFN || (p - PH_L0) % PH_PER_LAYER == Q_FFNMID || ((p - PH_L0) % PH_PER_LAYER == Q_NEXT && (p - PH_L0) / PH_PER_LAYER + 1 < DEPTH)))) {
            const int qq = p >= PH_L0 ? (p - PH_L0) % PH_PER_LAYER : -1;
            const bool chain = qq == Q_GATES || qq == Q_MERGE || qq == Q_MIX || qq == Q_XALOG || qq == Q_XAOUT;
            if (chain && use_local) xcd_barrier_local(bar, mk_tid(wave_s)); else xcd_barrier(bar, mk_tid(wave_s));
            if (p == lo) {
                if (mk_tid(wave_s) == 0 && (bar.x != (unsigned)(bx & 7) || bar.st[0] != (unsigned)(G >> 3) || bar.st[1] != 8u || (G & 7))) (void)xb_add(&bar.bar[XB_BADMAP], 1u);
            } else if (p == lo + 1) {
                if (mk_tid(wave_s) == 0) MISC[12] = xb_ld(&bar.bar[XB_BADMAP]);
                __syncthreads(); use_local = MISC[12] == 0u;
            }
        }
    }
}

extern "C" void kernel_launch(void* const* d_in, const int* in_sizes, int n_in, void* d_out, int out_size, void* d_ws, size_t ws_size, hipStream_t st) {
    if (n_in != 20 || ws_size < WS_NEED || out_size != T * D) { fprintf(stderr, "kernel_launch: unexpected sizes n_in %d ws %zu out %d\n", n_in, ws_size, out_size); return; }
    static int grid = 0;
    if (grid == 0) {
        int dev = 0, cus = 0, per_cu = 0;
        (void)hipGetDevice(&dev); (void)hipDeviceGetAttribute(&cus, hipDeviceAttributeMultiprocessorCount, dev);
        if (hipOccupancyMaxActiveBlocksPerMultiprocessor(&per_cu, (const void*)mk_fwd, MK_THREADS, 0) != hipSuccess || per_cu < 1) { fprintf(stderr, "kernel_launch: occupancy query says %d blocks/CU\n", per_cu); grid = -1; return; }
        (void)hipGetLastError();
        if (cus != 256) { fprintf(stderr, "kernel_launch: built for a 256-CU device, found %d\n", cus); grid = -1; return; }
        grid = cus;
    }
    if (grid < 0) return;
    (void)hipMemsetAsync((char*)d_ws + WS_CTL, 0, CTL_ZERO_BYTES, st);
    Args a{};
    for (int i = 0; i < 20; ++i) a.in[i] = (const float*)d_in[i];
    a.out = (float*)d_out; a.ws = (unsigned char*)d_ws; a.ph_lo = 0; a.ph_hi = NPH;
    hipLaunchKernelGGL(mk_fwd, dim3(grid), dim3(MK_THREADS), 0, st, a);
}
```

```cpp
#include <hip/hip_runtime.h>
#include <stdint.h>
#include <stdio.h>

typedef unsigned short bf16_t;
typedef short bf16x8 __attribute__((ext_vector_type(8)));
typedef float f32x16 __attribute__((ext_vector_type(16)));
typedef float f32x4 __attribute__((ext_vector_type(4)));
#define DEV __device__ __forceinline__

constexpr int NB = 2, S = 8192, D = 1024, T = NB * S, DEPTH = 2;
constexpr int DIN = 8264, DFF = 2816, MEM = 256;
constexpr int NIN = 5376;
constexpr float LOG2E = 1.4426950408889634f;
constexpr float QSCALE = 0.125f * LOG2E;
constexpr float WSCALE = 0.125f * 0.35355339059327373f;
constexpr float XSCALE = 0.0625f * LOG2E;
constexpr float EPS = 1e-6f;
#ifndef MK_FUSE
#define MK_FUSE 1
#endif

constexpr size_t MiB = 1u << 20;
constexpr size_t WS_SIDEA = 88 * MiB, WS_SIDEU = 96 * MiB;
constexpr size_t WS_KN = 983040;
constexpr size_t WS_GT = 1 * MiB;
constexpr size_t WS_HT = 9 * MiB;
constexpr size_t WS_WUP = 17 * MiB, WS_WDOWN = 28 * MiB;
constexpr size_t WS_XN = 34 * MiB;
constexpr size_t WS_WMIX = 66 * MiB, WS_WBR = 68 * MiB, WS_WG = 71 * MiB, WS_WIN = 77 * MiB;
constexpr size_t WS_QA = 88 * MiB, WS_SCB = 104 * MiB, WS_QC = 120 * MiB, WS_KA = 136 * MiB, WS_VA = 152 * MiB, WS_KC = 168 * MiB, WS_VC = 184 * MiB,
                 WS_IQ = 200 * MiB, WS_CX = 216 * MiB, WS_IK = 232 * MiB, WS_IW = 234 * MiB, WS_BM = 235 * MiB;
constexpr size_t WS_GATES = 136 * MiB;
constexpr size_t WS_XTMP = 235 * MiB;
constexpr size_t WS_LOG = 88 * MiB, WS_PXA = 168 * MiB;
constexpr size_t WS_XBXA = 136 * MiB;
constexpr size_t WS_SS = 65536;
constexpr size_t WS_FA = 66 * MiB, WS_FU = 154 * MiB;
constexpr size_t WS_WQ = 34 * MiB  , WS_WOT = 38 * MiB  , WS_WKVT = 42 * MiB  , WS_MEMN = 50 * MiB  , WS_KVM = 52 * MiB  ;
constexpr size_t WS_NEED = 256 * MiB;

DEV bf16_t f2bf(float f) { unsigned u = __float_as_uint(f); u += 0x7fffu + ((u >> 16) & 1u); return (bf16_t)(u >> 16); }
DEV float bf2f(bf16_t h) { return __uint_as_float(((unsigned)h) << 16); }
DEV float wave_sum(float v) {
#pragma unroll
    for (int o = 1; o < 64; o <<= 1) v += __shfl_xor(v, o);
    return v;
}
DEV float wave_max(float v) {
#pragma unroll
    for (int o = 1; o < 64; o <<= 1) v = fmaxf(v, __shfl_xor(v, o));
    return v;
}


#define LAS __attribute__((address_space(3)))
#define GAS __attribute__((address_space(1)))
typedef unsigned u32x4 __attribute__((ext_vector_type(4)));
typedef unsigned u32x2 __attribute__((ext_vector_type(2)));
typedef float f32x2 __attribute__((ext_vector_type(2)));
#define LDS_WAIT() asm volatile("s_waitcnt lgkmcnt(0)" ::: "memory")
DEV int mk_tid(int wave_s) { unsigned ones = ~0u; asm volatile("" : "+s"(ones)); return wave_s * 64 + (int)__builtin_amdgcn_mbcnt_hi(ones, __builtin_amdgcn_mbcnt_lo(ones, 0u)); }
#define VM_WAIT() asm volatile("s_waitcnt vmcnt(0)" ::: "memory")
typedef __bf16 bf16x2_t __attribute__((ext_vector_type(2)));
DEV unsigned cvt_pk_bf16(float lo, float hi) { const f32x2 v = {lo, hi}; return __builtin_bit_cast(unsigned, __builtin_convertvector(v, bf16x2_t)); }
DEV float bflo(unsigned w) { return __uint_as_float(w << 16); }
DEV float bfhi(unsigned w) { return __uint_as_float(w & 0xffff0000u); }

namespace pg8 {
constexpr int BM = 256, BK = 64, HALF = 128, HTB = HALF * BK * 2, STAGE_BYTES = 8 * HTB, NXCD = 8, WGM = 4;
__host__ __device__ __forceinline__ int lds_byte(int r, int c) { const int st = (r >> 4) * 2 + (c >> 5), rr = r & 15, cc = c & 31, ob = rr * 64 + cc * 2; return st * 1024 + (ob ^ (((ob >> 9) & 1) << 5)); }
__host__ __device__ __forceinline__ void stage_rc(int b, int& R, int& C) { const int st = b / 1024, sb = b % 1024, swz = sb ^ (((sb >> 9) & 1) << 5); R = (st >> 1) * 16 + swz / 64; C = (st & 1) * 32 + (swz % 64) / 2; }
__host__ __device__ __forceinline__ int perm32(int rho) { const int n = rho >> 4, i = rho & 15; return 8 * (i >> 2) + 4 * n + (i & 3); }

struct Unit { int pm, pn, job; };
struct Order {
    int nM, nN, nwg, ntot, G, c;
    DEV void init(int nM_, int nN_, int njob, int G_, int c_) { nM = nM_; nN = nN_; nwg = nM * nN; ntot = nwg * njob; G = G_; c = c_; }
    DEV bool next(int i, Unit& u) const {
        const int L = i * G + c; if (L >= ntot) return false;
        u.job = L / nwg; int wgid = L - u.job * nwg;
        { const int q = nwg / NXCD, r = nwg % NXCD, xcd = wgid % NXCD, off = wgid / NXCD; wgid = (xcd < r ? xcd * (q + 1) : r * (q + 1) + (xcd - r) * q) + off; }
        const int nig = WGM * nN, gid = wgid / nig, fm = gid * WGM, gsz = (nM - fm) < WGM ? (nM - fm) : WGM;
        u.pm = fm + ((wgid % nig) % gsz); u.pn = (wgid % nig) / gsz; return true;
    }
};
template <class T, class = void> struct epi_chain { static constexpr bool value = false; };
template <class T> struct epi_chain<T, decltype((void)T::CHAIN)> { static constexpr bool value = T::CHAIN; };
template <class Epi, class Ptr, bool ALIGN_EPI, bool SP2>
DEV void gemm_phase(LAS unsigned char* lds, const int tid_in, const int lda, const int ldb, const int K, const Order& S, const Ptr& P, const Epi& E) {
    int tid_ = tid_in; asm volatile("" : "+v"(tid_));
    const int tid = tid_, wid = __builtin_amdgcn_readfirstlane(tid >> 6), lane = tid & 63, wr = wid >> 2, wc = wid & 3, fr = lane & 15, fq = lane >> 4;
    const int nt = K / BK;
    unsigned voffA[2], voffB[2];
#pragma unroll
    for (int i = 0; i < 2; ++i) { int R, C; stage_rc(tid * 16 + i * 8192, R, C); const int Rb = Epi::PERM ? ((R & ~31) + perm32(R & 31)) : R;
        voffA[i] = (unsigned)(R * lda + C) * 2u; voffB[i] = (unsigned)(Rb * ldb + C) * 2u; }
    const size_t kstep = (size_t)(BK * 2);
    const size_t hstepA = (size_t)HALF * lda * 2, hstepB = (size_t)HALF * ldb * 2;
    const unsigned ldsw = (unsigned)wid * 1024u;
    const int aoff = lds_byte(wr * 64 + fr, fq * 8), boff = lds_byte(wc * 32 + fr, fq * 8);
#define PG8_SA(b, h) (((b) * 2 + (h)) * HTB)
#define PG8_SB(b, h) ((4 + (b) * 2 + (h)) * HTB)
#define PG8_STAGE(bufoff, gbase, voff) do { _Pragma("unroll") for (int _i = 0; _i < 2; ++_i) \
        __builtin_amdgcn_global_load_lds((const unsigned*)((const char*)(gbase) + (voff)[_i]), (LAS unsigned*)(lds + (bufoff) + ldsw + _i * 8192), 16, 0, 0); } while (0)
#define PG8_LDA(dst, b, h) do { _Pragma("unroll") for (int m = 0; m < 4; ++m) _Pragma("unroll") for (int k = 0; k < 2; ++k) dst[m][k] = *(const LAS bf16x8*)(lds + PG8_SA(b, h) + aoff + m * 2048 + k * 1024); } while (0)
#define PG8_LDB(dst, b, h) do { _Pragma("unroll") for (int n = 0; n < 2; ++n) _Pragma("unroll") for (int k = 0; k < 2; ++k) dst[n][k] = *(const LAS bf16x8*)(lds + PG8_SB(b, h) + boff + n * 2048 + k * 1024); } while (0)
#define PG8_MMA(ai, bj, At, Bt) do { __builtin_amdgcn_s_setprio(1); _Pragma("unroll") for (int m = 0; m < 4; ++m) _Pragma("unroll") for (int n = 0; n < 2; ++n) _Pragma("unroll") for (int k = 0; k < 2; ++k) \
        acc[ai][bj][m][n] = __builtin_amdgcn_mfma_f32_16x16x32_bf16(Bt[n][k], At[m][k], acc[ai][bj][m][n], 0, 0, 0); __builtin_amdgcn_s_setprio(0); } while (0)
#define PG8_WAIT_V(n) asm volatile("s_waitcnt vmcnt(" #n ")" ::: "memory")
#define PG8_WAIT_L(n) asm volatile("s_waitcnt lgkmcnt(" #n ")" ::: "memory")
#define PG8_BAR __builtin_amdgcn_s_barrier()
#define PG8_SCHED __builtin_amdgcn_sched_barrier(0)
    Unit cur, nxt; int ui = 0;
    if (!S.next(0, cur)) return;
    f32x4 acc[2][2][4][2];
#pragma unroll
    for (int a = 0; a < 2; ++a)
#pragma unroll
        for (int b = 0; b < 2; ++b)
#pragma unroll
            for (int m = 0; m < 4; ++m)
#pragma unroll
                for (int n = 0; n < 2; ++n) acc[a][b][m][n] = (f32x4){0.f, 0.f, 0.f, 0.f};
    bf16x8 At[4][2], B0[2][2], B1[2][2];
    const char* cA = P.a(cur); const char* cB = P.b(cur);
    typename Epi::Pre pre; E.prefetch(pre, cur, wr, fr);
    if constexpr (SP2) {
        PG8_STAGE(PG8_SB(0, 0), cB, voffB); PG8_STAGE(PG8_SB(0, 1), cB + hstepB, voffB); PG8_STAGE(PG8_SA(0, 0), cA, voffA); PG8_STAGE(PG8_SA(0, 1), cA + hstepA, voffA);
        if (wr == 1) PG8_BAR;
        PG8_WAIT_V(2); PG8_BAR;
        PG8_STAGE(PG8_SB(1, 0), cB + kstep, voffB); PG8_STAGE(PG8_SA(1, 0), cA + kstep, voffA); PG8_STAGE(PG8_SB(1, 1), cB + hstepB + kstep, voffB);
        PG8_WAIT_V(6); PG8_BAR;
    } else {
        PG8_STAGE(PG8_SB(0, 0), cB, voffB); PG8_STAGE(PG8_SA(0, 0), cA, voffA); PG8_STAGE(PG8_SB(0, 1), cB + hstepB, voffB); PG8_STAGE(PG8_SA(0, 1), cA + hstepA, voffA);
        if (wr == 1) PG8_BAR;
        PG8_WAIT_V(4); PG8_BAR;
        PG8_STAGE(PG8_SB(1, 0), cB + kstep, voffB); PG8_STAGE(PG8_SA(1, 0), cA + kstep, voffA); PG8_STAGE(PG8_SB(1, 1), cB + hstepB + kstep, voffB);
        PG8_WAIT_V(6); PG8_BAR;
    }
#pragma unroll 1
    for (;;) {
        const bool has_next = S.next(ui + 1, nxt);
        const char* nA = has_next ? P.a(nxt) : cA; const char* nB = has_next ? P.b(nxt) : cB;
#pragma unroll 1
        for (int t = 0; t < nt; t += 2) {
            const bool last = (t == nt - 2);
            const char* a1 = cA + (size_t)(t + 1) * kstep;
            const char* a2 = last ? nA : cA + (size_t)(t + 2) * kstep; const char* b2 = last ? nB : cB + (size_t)(t + 2) * kstep;
            const char* a3 = a2 + kstep; const char* b3 = b2 + kstep;
            if constexpr (SP2) {
            PG8_LDB(B0, 0, 0); PG8_LDB(B1, 0, 1); PG8_SCHED; PG8_LDA(At, 0, 0); PG8_STAGE(PG8_SA(1, 1), a1 + hstepA, voffA);
            PG8_WAIT_V(8); PG8_WAIT_L(0); PG8_BAR; PG8_MMA(0, 0, At, B0); PG8_MMA(0, 1, At, B1); PG8_BAR; PG8_SCHED;
            PG8_LDA(At, 0, 1); PG8_STAGE(PG8_SB(0, 0), b2, voffB); PG8_STAGE(PG8_SB(0, 1), b2 + hstepB, voffB); PG8_STAGE(PG8_SA(0, 0), a2, voffA);
            PG8_WAIT_V(8); PG8_WAIT_L(0); PG8_BAR; PG8_MMA(1, 0, At, B0); PG8_MMA(1, 1, At, B1); PG8_BAR; PG8_SCHED;
            PG8_LDB(B0, 1, 0); PG8_LDB(B1, 1, 1); PG8_SCHED; PG8_LDA(At, 1, 0); PG8_STAGE(PG8_SA(0, 1), a2 + hstepA, voffA);
            PG8_WAIT_V(8); PG8_WAIT_L(0); PG8_BAR; PG8_MMA(0, 0, At, B0); PG8_MMA(0, 1, At, B1); PG8_BAR; PG8_SCHED;
            PG8_LDA(At, 1, 1); PG8_STAGE(PG8_SB(1, 0), b3, voffB); PG8_STAGE(PG8_SB(1, 1), b3 + hstepB, voffB); PG8_STAGE(PG8_SA(1, 0), a3, voffA);
            PG8_WAIT_V(8); PG8_WAIT_L(0); PG8_BAR; PG8_MMA(1, 0, At, B0); PG8_MMA(1, 1, At, B1); PG8_BAR; PG8_SCHED;
            } else {
            PG8_LDB(B0, 0, 0); PG8_SCHED; PG8_LDA(At, 0, 0); PG8_STAGE(PG8_SA(1, 1), a1 + hstepA, voffA);
            PG8_WAIT_L(8); PG8_BAR; PG8_WAIT_L(0); PG8_MMA(0, 0, At, B0); PG8_BAR; PG8_SCHED;
            PG8_LDB(B1, 0, 1); PG8_STAGE(PG8_SB(0, 0), b2, voffB);
            PG8_BAR; PG8_WAIT_L(0); PG8_MMA(0, 1, At, B1); PG8_BAR;
            PG8_LDA(At, 0, 1); PG8_STAGE(PG8_SA(0, 0), a2, voffA);
            PG8_BAR; PG8_WAIT_L(0); PG8_MMA(1, 0, At, B0); PG8_BAR; PG8_SCHED;
            PG8_STAGE(PG8_SB(0, 1), b2 + hstepB, voffB);
            PG8_WAIT_V(6); PG8_BAR; PG8_MMA(1, 1, At, B1); PG8_BAR;
            PG8_LDB(B0, 1, 0); PG8_SCHED; PG8_LDA(At, 1, 0); PG8_STAGE(PG8_SA(0, 1), a2 + hstepA, voffA);
            PG8_WAIT_L(8); PG8_BAR; PG8_WAIT_L(0); PG8_MMA(0, 0, At, B0); PG8_BAR; PG8_SCHED;
            PG8_LDB(B1, 1, 1); PG8_STAGE(PG8_SB(1, 0), b3, voffB);
            PG8_BAR; PG8_WAIT_L(0); PG8_MMA(0, 1, At, B1); PG8_BAR;
            PG8_LDA(At, 1, 1); PG8_STAGE(PG8_SA(1, 0), a3, voffA);
            PG8_BAR; PG8_WAIT_L(0); PG8_MMA(1, 0, At, B0); PG8_BAR; PG8_SCHED;
            PG8_STAGE(PG8_SB(1, 1), b3 + hstepB, voffB);
            PG8_WAIT_V(6); PG8_BAR; PG8_MMA(1, 1, At, B1); PG8_BAR;
            }
        }
        if constexpr (ALIGN_EPI) { if (wr == 0) PG8_BAR; }
        if constexpr (!Epi::AFTER_DRAIN) { const int le_ = mk_tid(0);
            E(acc, cur, wr, wc, le_ & 15, le_ >> 4, pre); }
        if (!has_next) break;
        if (!epi_chain<Epi>::value || nxt.job == 0) {
#pragma unroll
        for (int a = 0; a < 2; ++a)
#pragma unroll
            for (int b = 0; b < 2; ++b)
#pragma unroll
                for (int m = 0; m < 4; ++m)
#pragma unroll
                    for (int n = 0; n < 2; ++n) acc[a][b][m][n] = (f32x4){0.f, 0.f, 0.f, 0.f};
        }
        cur = nxt; cA = nA; cB = nB; ++ui; E.prefetch(pre, cur, wr, fr);
        if constexpr (ALIGN_EPI) { if (wr == 1) PG8_BAR; }
    }
    PG8_WAIT_V(0);
    if constexpr (!ALIGN_EPI) { if (wr == 0) PG8_BAR; }
    PG8_BAR;
    if constexpr (Epi::AFTER_DRAIN) { const int le_ = mk_tid(0); E.fused(acc, cur, wr, wc, le_ & 15, le_ >> 4, lds, wid, le_, pre); }
#undef PG8_SA
#undef PG8_SB
#undef PG8_STAGE
#undef PG8_LDA
#undef PG8_LDB
#undef PG8_MMA
#undef PG8_WAIT_V
#undef PG8_WAIT_L
#undef PG8_BAR
#undef PG8_SCHED
}
typedef f32x4 Acc[2][2][4][2];

struct PtrStd {
    const char* A; const char* B; size_t aj, bj, bb, arow, brow;
    DEV const char* a(const Unit& u) const { return A + (size_t)u.job * aj + (size_t)u.pm * arow; }
    DEV const char* b(const Unit& u) const { return B + (size_t)u.job * bj + (size_t)(u.pm >> 5) * bb + (size_t)u.pn * brow; }
};
struct PtrG {
    const char* KVM; const char* WQ;
    DEV const char* a(const Unit& u) const { return KVM + (size_t)(u.job >> 2) * MiB + (size_t)(u.job & 3) * 512; }
    DEV const char* b(const Unit& u) const { return WQ + (size_t)(u.job >> 3) * 2 * MiB + (size_t)(u.job & 3) * 512 + (size_t)u.pn * 256 * 1024 * 2; }
};
struct PtrH {
    const char* KVM; const char* WOT;
    DEV const char* a(const Unit& u) const { return WOT + (size_t)(u.job >> 3) * 2 * MiB + (size_t)(u.job & 3) * 512 + (size_t)u.pm * 256 * 1024 * 2; }
    DEV const char* b(const Unit& u) const { return KVM + (size_t)(u.job >> 2) * MiB + 2048 + (size_t)(u.job & 3) * 512; }
};

#define EPI_ROWS(u) const int row0 = (u).pm * BM + wr * 64 + fr
DEV u32x4 pack8(const f32x4 v0, const f32x4 v1) { u32x4 w; w.x = cvt_pk_bf16(v0[0], v0[1]); w.y = cvt_pk_bf16(v0[2], v0[3]); w.z = cvt_pk_bf16(v1[0], v1[1]); w.w = cvt_pk_bf16(v1[2], v1[3]); return w; }

struct PreNone {};
typedef unsigned long long u64;
constexpr float SS_SCALE = 65536.f;
struct PreRs { u64 v[2][4]; };
DEV void pre_rs(PreRs& p, const u64* ss, int row0) {
#pragma unroll
    for (int ai = 0; ai < 2; ++ai)
#pragma unroll
        for (int m = 0; m < 4; ++m) p.v[ai][m] = __builtin_nontemporal_load(ss + row0 + ai * HALF + m * 16);
}
DEV void rs_of(float (&rs)[2][4], const PreRs& p) {
#pragma unroll
    for (int ai = 0; ai < 2; ++ai)
#pragma unroll
        for (int m = 0; m < 4; ++m) rs[ai][m] = rsqrtf((float)p.v[ai][m] * (1.f / (SS_SCALE * D)) + EPS);
}
struct EpiInProj {
    typedef PreRs Pre;
    DEV void prefetch(PreRs& p, const Unit& u, int wr, int fr) const { pre_rs(p, ss, u.pm * BM + wr * 64 + fr); }
    static constexpr bool PERM = true, AFTER_DRAIN = false;
    unsigned char* ws; const u64* ss;
    DEV void operator()(const Acc& acc, const Unit& u, int wr, int wc, int fr, int fq, const PreRs& pre) const {
        EPI_ROWS(u); const int pn = u.pn, cb = wc * 32 + 8 * fq;
        float rs[2][4]; rs_of(rs, pre);
        if (pn < 16) {
            const int g = pn >> 1;
            const size_t off = g == 0 ? WS_QA : g == 1 ? WS_KA : g == 2 ? WS_VA : g == 3 ? WS_QC : g == 4 ? WS_KC : g == 5 ? WS_VC : g == 6 ? WS_IQ : WS_SCB;
            const float sc = (g == 0 || g == 3) ? QSCALE : 1.f;
            bf16_t* base = (bf16_t*)(ws + off) + (pn & 1) * 256 + cb;
#pragma unroll
            for (int ai = 0; ai < 2; ++ai)
#pragma unroll
                for (int m = 0; m < 4; ++m) { bf16_t* rowp = base + (size_t)(row0 + ai * HALF + m * 16) * 512;
#pragma unroll
                    for (int bj = 0; bj < 2; ++bj) *(u32x4*)(rowp + bj * HALF) = pack8(acc[ai][bj][m][0] * (sc * rs[ai][m]), acc[ai][bj][m][1] * (sc * rs[ai][m])); }
        } else if (pn < 20) {
            bf16_t* base = (bf16_t*)(ws + WS_CX) + (pn - 16) * 128 + cb;
#pragma unroll
            for (int ai = 0; ai < 2; ++ai)
#pragma unroll
                for (int m = 0; m < 4; ++m) { const float r2 = rs[ai][m] * rs[ai][m]; *(u32x4*)(base + (size_t)(row0 + ai * HALF + m * 16) * 512) = pack8(acc[ai][0][m][0] * acc[ai][1][m][0] * r2, acc[ai][0][m][1] * acc[ai][1][m][1] * r2); }
        } else {
            if (wc < 2) { bf16_t* base = (bf16_t*)(ws + WS_IK);
#pragma unroll
                for (int ai = 0; ai < 2; ++ai)
#pragma unroll
                    for (int m = 0; m < 4; ++m) { const int t = row0 + ai * HALF + m * 16;
                        *(u32x4*)(base + (size_t)(t >> 5) * 2048 + (((cb >> 3) * 32 + (t & 31)) * 8)) = pack8(acc[ai][0][m][0] * rs[ai][m], acc[ai][0][m][1] * rs[ai][m]); }
            } else if (wc == 2 && fq == 0) { float* base = (float*)(ws + WS_IW);
#pragma unroll
                for (int ai = 0; ai < 2; ++ai)
#pragma unroll
                    for (int m = 0; m < 4; ++m) { float* p = base + (size_t)(row0 + ai * HALF + m * 16) * 8; *(f32x4*)p = acc[ai][0][m][0] * (WSCALE * rs[ai][m]); *(f32x4*)(p + 4) = acc[ai][0][m][1] * (WSCALE * rs[ai][m]); }
            }
        }
    }
};
DEV f32x4 sigm4(const f32x4 v) { f32x4 o;
#pragma unroll
    for (int i = 0; i < 4; ++i) o[i] = __builtin_amdgcn_rcpf(1.f + __builtin_amdgcn_exp2f(-LOG2E * v[i])); return o; }
struct EpiGates {
    typedef PreRs Pre;
    DEV void prefetch(PreRs& p, const Unit& u, int wr, int fr) const { pre_rs(p, ss, u.pm * BM + wr * 64 + fr); }
    static constexpr bool PERM = true, AFTER_DRAIN = false;
    bf16_t* G; const u64* ss;
    DEV void operator()(const Acc& acc, const Unit& u, int wr, int wc, int fr, int fq, const PreRs& pre) const {
        EPI_ROWS(u); float rs[2][4]; rs_of(rs, pre); bf16_t* base = G + (size_t)(u.pn >> 2) * T * D + (u.pn & 3) * 256 + wc * 32 + 8 * fq;
#pragma unroll
        for (int ai = 0; ai < 2; ++ai)
#pragma unroll
            for (int m = 0; m < 4; ++m) { bf16_t* rowp = base + (size_t)(row0 + ai * HALF + m * 16) * D;
#pragma unroll
                for (int bj = 0; bj < 2; ++bj) *(u32x4*)(rowp + bj * HALF) = pack8(sigm4(acc[ai][bj][m][0] * rs[ai][m]), sigm4(acc[ai][bj][m][1] * rs[ai][m])); }
    }
};
struct EpiMerge {
    typedef PreNone Pre;
    DEV void prefetch(PreNone&, const Unit&, int, int) const {}
    static constexpr bool PERM = true, AFTER_DRAIN = false;
    bf16_t* M; const bf16_t* G;
    DEV void operator()(const Acc& acc, const Unit& u, int wr, int wc, int fr, int fq, const PreNone&) const {
        EPI_ROWS(u); const size_t cofs = (size_t)u.pn * 256 + wc * 32 + 8 * fq; const bf16_t* gb = G + (size_t)u.job * T * D;
#pragma unroll
        for (int ai = 0; ai < 2; ++ai) {
            u32x4 g[8], p[8];
#pragma unroll
            for (int m = 0; m < 4; ++m)
#pragma unroll
                for (int bj = 0; bj < 2; ++bj) { const size_t o = (size_t)(row0 + ai * HALF + m * 16) * D + cofs + bj * HALF; g[2 * m + bj] = *(const u32x4*)(gb + o);
                    if (u.job > 0) p[2 * m + bj] = __builtin_nontemporal_load((const u32x4*)(M + o)); }
#pragma unroll
            for (int m = 0; m < 4; ++m)
#pragma unroll
                for (int bj = 0; bj < 2; ++bj) { const size_t o = (size_t)(row0 + ai * HALF + m * 16) * D + cofs + bj * HALF; const u32x4 gg = g[2 * m + bj];
                    f32x4 v0 = acc[ai][bj][m][0], v1 = acc[ai][bj][m][1];
                    v0[0] *= bflo(gg.x); v0[1] *= bfhi(gg.x); v0[2] *= bflo(gg.y); v0[3] *= bfhi(gg.y); v1[0] *= bflo(gg.z); v1[1] *= bfhi(gg.z); v1[2] *= bflo(gg.w); v1[3] *= bfhi(gg.w);
                    if (u.job > 0) { const u32x4 pp = p[2 * m + bj];
                        v0[0] += bflo(pp.x); v0[1] += bfhi(pp.x); v0[2] += bflo(pp.y); v0[3] += bfhi(pp.y); v1[0] += bflo(pp.z); v1[1] += bfhi(pp.z); v1[2] += bflo(pp.w); v1[3] += bfhi(pp.w); }
                    *(u32x4*)(M + o) = pack8(v0, v1); }
        }
    }
};
struct EpiMergeC {
    typedef PreNone Pre;
    DEV void prefetch(PreNone&, const Unit&, int, int) const {}
    static constexpr bool PERM = true, AFTER_DRAIN = false, CHAIN = true;
    bf16_t* M; const bf16_t* G;
    static DEV float gl(unsigned w) { return fmaxf(bflo(w), 9.094947e-13f); }
    static DEV float gh(unsigned w) { return fmaxf(bfhi(w), 9.094947e-13f); }
    DEV void operator()(Acc& acc, const Unit& u, int wr, int wc, int fr, int fq, const PreNone&) const {
        EPI_ROWS(u); const size_t cofs = (size_t)u.pn * 256 + wc * 32 + 8 * fq; const bf16_t* gb = G + (size_t)u.job * T * D; const bool lastj = u.job == 2;
#pragma unroll
        for (int ai = 0; ai < 2; ++ai) {
            u32x4 g[8], gn[8];
#pragma unroll
            for (int m = 0; m < 4; ++m)
#pragma unroll
                for (int bj = 0; bj < 2; ++bj) { const size_t o = (size_t)(row0 + ai * HALF + m * 16) * D + cofs + bj * HALF; g[2 * m + bj] = *(const u32x4*)(gb + o);
                    if (!lastj) gn[2 * m + bj] = *(const u32x4*)(gb + (size_t)T * D + o); }
#pragma unroll
            for (int m = 0; m < 4; ++m)
#pragma unroll
                for (int bj = 0; bj < 2; ++bj) { const u32x4 a = g[2 * m + bj]; f32x4 s0 = {gl(a.x), gh(a.x), gl(a.y), gh(a.y)}, s1 = {gl(a.z), gh(a.z), gl(a.w), gh(a.w)};
                    if (!lastj) { const u32x4 b = gn[2 * m + bj];
                        s0[0] *= __builtin_amdgcn_rcpf(gl(b.x)); s0[1] *= __builtin_amdgcn_rcpf(gh(b.x)); s0[2] *= __builtin_amdgcn_rcpf(gl(b.y)); s0[3] *= __builtin_amdgcn_rcpf(gh(b.y));
                        s1[0] *= __builtin_amdgcn_rcpf(gl(b.z)); s1[1] *= __builtin_amdgcn_rcpf(gh(b.z)); s1[2] *= __builtin_amdgcn_rcpf(gl(b.w)); s1[3] *= __builtin_amdgcn_rcpf(gh(b.w)); }
                    acc[ai][bj][m][0] = acc[ai][bj][m][0] * s0; acc[ai][bj][m][1] = acc[ai][bj][m][1] * s1;
                    if (lastj) { const size_t o = (size_t)(row0 + ai * HALF + m * 16) * D + cofs + bj * HALF; *(u32x4*)(M + o) = pack8(acc[ai][bj][m][0], acc[ai][bj][m][1]); } }
        }
    }
};
template <bool IN_F32> struct EpiResid {
    typedef PreNone Pre;
    DEV void prefetch(PreNone&, const Unit&, int, int) const {}
    static constexpr bool PERM = true, AFTER_DRAIN = true;
    const void* xin; bf16_t* xb; u64* ss;
    DEV void fused(Acc& acc, const Unit& u, int wr, int wc, int fr, int fq, LAS unsigned char* lds, int wid, int lane, const PreNone&) const {
        EPI_ROWS(u); const size_t cofs = (size_t)u.pn * 256 + wc * 32 + 8 * fq;
        LAS float* PS = (LAS float*)lds;
#pragma unroll
        for (int ai = 0; ai < 2; ++ai) {
            f32x4 r0[8], r1[8];
#pragma unroll
            for (int m = 0; m < 4; ++m)
#pragma unroll
                for (int bj = 0; bj < 2; ++bj) { const size_t o = (size_t)(row0 + ai * HALF + m * 16) * D + cofs + bj * HALF; const int k = 2 * m + bj;
                    if (IN_F32) { r0[k] = *(const f32x4*)((const float*)xin + o); r1[k] = *(const f32x4*)((const float*)xin + o + 4); }
                    else { const u32x4 p = *(const u32x4*)((const bf16_t*)xin + o); r0[k] = __builtin_bit_cast(f32x4, p); } }
#pragma unroll
            for (int m = 0; m < 4; ++m) { const size_t ro = (size_t)(row0 + ai * HALF + m * 16) * D + cofs; float sq = 0.f;
#pragma unroll
                for (int bj = 0; bj < 2; ++bj) { const size_t o = ro + bj * HALF; const int k = 2 * m + bj; f32x4 v0 = acc[ai][bj][m][0], v1 = acc[ai][bj][m][1];
                    if (IN_F32) { v0 = v0 + r0[k]; v1 = v1 + r1[k]; }
                    else { const u32x4 p = __builtin_bit_cast(u32x4, r0[k]);
                        v0[0] += bflo(p.x); v0[1] += bfhi(p.x); v0[2] += bflo(p.y); v0[3] += bfhi(p.y); v1[0] += bflo(p.z); v1[1] += bfhi(p.z); v1[2] += bflo(p.w); v1[3] += bfhi(p.w); }
                    *(u32x4*)(xb + o) = pack8(v0, v1);
                    sq += ((v0[0] * v0[0] + v0[1] * v0[1]) + (v0[2] * v0[2] + v0[3] * v0[3])) + ((v1[0] * v1[0] + v1[1] * v1[1]) + (v1[2] * v1[2] + v1[3] * v1[3])); }
                sq += __shfl_xor(sq, 16); sq += __shfl_xor(sq, 32);
                if (fq == 0) PS[(ai * HALF + wr * 64 + m * 16 + fr) * 4 + wc] = sq; }
        }
        LDS_WAIT(); __builtin_amdgcn_s_barrier(); asm volatile("" ::: "memory");
        { const int t = wid * 64 + lane; if (t < 256) { const f32x4 q = *(const LAS f32x4*)(PS + t * 4); atomicAdd(ss + u.pm * BM + t, (u64)(((q[0] + q[1]) + (q[2] + q[3])) * SS_SCALE + 0.5f)); } }
        LDS_WAIT(); __builtin_amdgcn_s_barrier();
    }
};
DEV float gelu_t(float a) { return a * __builtin_amdgcn_rcpf(1.f + __builtin_amdgcn_exp2f(-1.5957691216057308f * LOG2E * (a + 0.044715f * a * a * a))); }
DEV float row_prev1(float cur, float prevm) { const int r = __builtin_amdgcn_update_dpp(0, (int)__float_as_uint(prevm), 0x121, 0xf, 0xf, false);
    return __uint_as_float((unsigned)__builtin_amdgcn_update_dpp(r, (int)__float_as_uint(cur), 0x111, 0xf, 0xf, false)); }
DEV float row_prev2(float cur, float prevm) { const int r = __builtin_amdgcn_update_dpp(0, (int)__float_as_uint(prevm), 0x122, 0xf, 0xf, false);
    return __uint_as_float((unsigned)__builtin_amdgcn_update_dpp(r, (int)__float_as_uint(cur), 0x112, 0xf, 0xf, false)); }
struct EpiUpF {
    typedef PreRs Pre;
    DEV void prefetch(PreRs& p, const Unit& u, int wr, int fr) const { pre_rs(p, ss, u.pm * BM + wr * 64 + fr); }
    static constexpr bool PERM = true, AFTER_DRAIN = false;
    bf16_t *fu, *sa, *su; const u64* ss; const float *cw, *cb;
    DEV void operator()(const Acc& acc, const Unit& u, int wr, int wc, int fr, int fq, const PreRs& pre) const {
        EPI_ROWS(u); float rs[2][4]; rs_of(rs, pre); const size_t cofs = (size_t)u.pn * 128 + wc * 32 + 8 * fq;
        f32x4 w0[2], w1[2], w2[2], bb[2];
#pragma unroll
        for (int n = 0; n < 2; ++n) { w0[n] = *(const f32x4*)(cw + cofs + 4 * n); w1[n] = *(const f32x4*)(cw + DFF + cofs + 4 * n); w2[n] = *(const f32x4*)(cw + 2 * DFF + cofs + 4 * n); bb[n] = *(const f32x4*)(cb + cofs + 4 * n); }
#pragma unroll
        for (int ai = 0; ai < 2; ++ai) {
            const size_t strip = (size_t)u.pm * 4 + ai * 2 + wr;
            f32x4 ap[2] = {{0.f, 0.f, 0.f, 0.f}, {0.f, 0.f, 0.f, 0.f}};
#pragma unroll
            for (int m = 0; m < 4; ++m) {
                f32x4 a[2], g[2];
#pragma unroll
                for (int n = 0; n < 2; ++n) { a[n] = acc[ai][0][m][n] * rs[ai][m];
#pragma unroll
                    for (int e = 0; e < 4; ++e) { const float a1 = row_prev1(a[n][e], ap[n][e]), a2 = row_prev2(a[n][e], ap[n][e]);
                        g[n][e] = gelu_t(bb[n][e] + w0[n][e] * a2 + w1[n][e] * a1 + w2[n][e] * a[n][e]) * (acc[ai][1][m][n][e] * rs[ai][m]); } }
                if (m == 0) {
                    if (fr < 2) { *(u32x4*)(sa + (strip * 4 + fr) * DFF + cofs) = pack8(a[0], a[1]); *(u32x4*)(su + (strip * 2 + fr) * DFF + cofs) = pack8(acc[ai][1][0][0] * rs[ai][0], acc[ai][1][0][1] * rs[ai][0]); }
                    else *(u32x4*)(fu + (size_t)(row0 + ai * HALF) * DFF + cofs) = pack8(g[0], g[1]);
                } else {
                    *(u32x4*)(fu + (size_t)(row0 + ai * HALF + m * 16) * DFF + cofs) = pack8(g[0], g[1]);
                    if (m == 3 && fr >= 14) *(u32x4*)(sa + (strip * 4 + 2 + (fr - 14)) * DFF + cofs) = pack8(a[0], a[1]);
                }
                ap[0] = a[0]; ap[1] = a[1];
            }
        }
    }
};
struct EpiPrep {
    typedef PreNone Pre;
    DEV void prefetch(PreNone&, const Unit&, int, int) const {}
    static constexpr bool PERM = true, AFTER_DRAIN = false;
    unsigned char* ws; int mode;
    DEV void operator()(const Acc& acc, const Unit& u, int wr, int wc, int fr, int fq, const PreNone&) const {
        EPI_ROWS(u); bf16_t* base; int ldc; float sc = 1.f;
        if (mode == 0) { base = (bf16_t*)(ws + WS_KVM + (size_t)u.job * 2 * MiB); ldc = 2 * D; }
        else if (mode == 1) { base = (bf16_t*)(ws + WS_GT + (size_t)(u.job >> 2) * 2 * MiB) + (size_t)(u.job & 3) * 256 * D; ldc = D; sc = XSCALE; }
        else { base = (bf16_t*)(ws + WS_HT + (size_t)(u.job >> 2) * 2 * MiB) + (u.job & 3) * 256; ldc = D; }
        base += (size_t)u.pn * 256 + wc * 32 + 8 * fq;
#pragma unroll
        for (int ai = 0; ai < 2; ++ai)
#pragma unroll
            for (int m = 0; m < 4; ++m) { bf16_t* rowp = base + (size_t)(row0 + ai * HALF + m * 16) * ldc;
#pragma unroll
                for (int bj = 0; bj < 2; ++bj) *(u32x4*)(rowp + bj * HALF) = pack8(acc[ai][bj][m][0] * sc, acc[ai][bj][m][1] * sc); }
    }
};
struct EpiSoftmax {
    typedef PreRs Pre;
    DEV void prefetch(PreRs& p, const Unit& u, int wr, int fr) const { pre_rs(p, ss, u.pm * BM + wr * 64 + fr); }
    static constexpr bool PERM = true, AFTER_DRAIN = true;
    bf16_t* P; const u64* ss;
    DEV void fused(Acc& acc, const Unit& u, int wr, int wc, int fr, int fq, LAS unsigned char* lds, int wid, int lane, const PreRs& pre) const {
        LAS float* PM = (LAS float*)lds; LAS float* PS = (LAS float*)(lds + 4096);
        { const int row0_ = u.pm * BM + wr * 64 + fr; float rs[2][4]; rs_of(rs, pre);
#pragma unroll
          for (int ai = 0; ai < 2; ++ai)
#pragma unroll
              for (int m = 0; m < 4; ++m)
#pragma unroll
                  for (int bj = 0; bj < 2; ++bj)
#pragma unroll
                      for (int n = 0; n < 2; ++n) acc[ai][bj][m][n] = acc[ai][bj][m][n] * rs[ai][m]; }
#pragma unroll
        for (int ai = 0; ai < 2; ++ai)
#pragma unroll
            for (int m = 0; m < 4; ++m) { float mx = -INFINITY;
#pragma unroll
                for (int bj = 0; bj < 2; ++bj)
#pragma unroll
                    for (int n = 0; n < 2; ++n) { const f32x4 x = acc[ai][bj][m][n]; mx = fmaxf(mx, fmaxf(fmaxf(x[0], x[1]), fmaxf(x[2], x[3]))); }
                mx = fmaxf(mx, __shfl_xor(mx, 16)); mx = fmaxf(mx, __shfl_xor(mx, 32));
                if (fq == 0) PM[(ai * HALF + wr * 64 + m * 16 + fr) * 4 + wc] = mx; }
        LDS_WAIT(); __builtin_amdgcn_s_barrier(); asm volatile("" ::: "memory");
#pragma unroll
        for (int ai = 0; ai < 2; ++ai)
#pragma unroll
            for (int m = 0; m < 4; ++m) { const int r = ai * HALF + wr * 64 + m * 16 + fr; const f32x4 q = *(const LAS f32x4*)(PM + r * 4);
                const float mx = fmaxf(fmaxf(q[0], q[1]), fmaxf(q[2], q[3])); float s = 0.f;
#pragma unroll
                for (int bj = 0; bj < 2; ++bj)
#pragma unroll
                    for (int n = 0; n < 2; ++n) { f32x4 x = acc[ai][bj][m][n];
#pragma unroll
                        for (int i = 0; i < 4; ++i) { x[i] = __builtin_amdgcn_exp2f(x[i] - mx); s += x[i]; } acc[ai][bj][m][n] = x; }
                s += __shfl_xor(s, 16); s += __shfl_xor(s, 32);
                if (fq == 0) PS[r * 4 + wc] = s; }
        LDS_WAIT(); __builtin_amdgcn_s_barrier(); asm volatile("" ::: "memory");
        EPI_ROWS(u); bf16_t* base = P + (size_t)u.pn * 256 + wc * 32 + 8 * fq;
#pragma unroll
        for (int ai = 0; ai < 2; ++ai)
#pragma unroll
            for (int m = 0; m < 4; ++m) { const int r = ai * HALF + wr * 64 + m * 16 + fr; const f32x4 q = *(const LAS f32x4*)(PS + r * 4);
                const float inv = 1.f / ((q[0] + q[1]) + (q[2] + q[3])); bf16_t* rowp = base + (size_t)(row0 + ai * HALF + m * 16) * D;
#pragma unroll
                for (int bj = 0; bj < 2; ++bj) *(u32x4*)(rowp + bj * HALF) = pack8(acc[ai][bj][m][0] * inv, acc[ai][bj][m][1] * inv); }
        LDS_WAIT(); __builtin_amdgcn_s_barrier();
    }
};
}

typedef GAS unsigned gu32;
#define XB_TMO      128
#define XB_XCNT(j)  (256  + 64 * (j))
#define XB_XSUB(j)  (1280 + 64 * (j))
#define XB_XGEN(j)  (2304 + 64 * (j))
#define XB_TOP      3328
#define XB_TOPGEN   3392
#define XCD_BAR_WORDS 3456
#define XB_SPIN_CAP (1u << 22)
DEV unsigned xb_ld(unsigned* p) { return __hip_atomic_load(p, __ATOMIC_RELAXED, __HIP_MEMORY_SCOPE_AGENT); }
DEV unsigned xb_add(unsigned* p, unsigned v) { return __hip_atomic_fetch_add(p, v, __ATOMIC_RELAXED, __HIP_MEMORY_SCOPE_AGENT); }
DEV unsigned xb_xcc_id() { return (unsigned)__builtin_amdgcn_s_getreg((3 << 11) | 20) & 0xFu; }
#define XB_SPIN(cond, bar) do { unsigned _sp = 0; while (cond) { __builtin_amdgcn_s_sleep(1); \
    if ((++_sp & 255u) == 0u) { if (xb_ld(&(bar)[XB_TMO])) break; if (_sp > XB_SPIN_CAP) { atomicAdd(&(bar)[XB_TMO], 1u); break; } } } } while (0)
struct XcdBarrier { unsigned* bar; unsigned x; volatile LAS unsigned* st; };
DEV XcdBarrier xcd_barrier_post(unsigned* bar, volatile LAS unsigned* st, int tid) {
    XcdBarrier b; b.bar = bar; b.x = xb_xcc_id(); b.st = st;
    if (tid == 0) (void)xb_add(&bar[XB_XCNT(b.x)], 1u);
    return b;
}
DEV void xcd_barrier_complete(unsigned* bar, unsigned x, unsigned& nloc, unsigned& nx) {
    const unsigned G = gridDim.x * gridDim.y * gridDim.z;
    unsigned sum, cnt, mine, sp = 0u;
    for (;;) {
        sum = 0u; cnt = 0u; mine = 0u;
#pragma unroll
        for (unsigned j = 0; j < 16; ++j) { const unsigned c = xb_ld(&bar[XB_XCNT(j)]); sum += c; cnt += (c > 0u) ? 1u : 0u; mine = (j == x) ? c : mine; }
        if (sum == G) break;
        __builtin_amdgcn_s_sleep(1);
        if ((++sp & 255u) == 0u) { if (xb_ld(&bar[XB_TMO])) break; if (sp > XB_SPIN_CAP) { atomicAdd(&bar[XB_TMO], 1u); break; } }
    }
    nloc = mine > 0u ? mine : 1u; nx = cnt > 0u ? cnt : 1u;
}
#define XB_BADMAP 192
DEV void xcd_barrier_local(const XcdBarrier& b, int tid) {
    asm volatile("s_waitcnt vmcnt(0)" ::: "memory");
    __syncthreads();
    if (tid == 0) {
        unsigned* bar = b.bar;
        __builtin_amdgcn_s_waitcnt(0);
        const unsigned nloc = b.st[0];
        const unsigned old = xb_add(&bar[XB_XSUB(b.x)], 1u);
        const unsigned gen = old / nloc;
        if (old + 1u == (gen + 1u) * nloc) xb_add(&bar[XB_XGEN(b.x)], 1u);
        else XB_SPIN(xb_ld(&bar[XB_XGEN(b.x)]) == gen, bar);
        __builtin_amdgcn_fence(__ATOMIC_ACQUIRE, "agent");
        asm volatile("s_waitcnt vmcnt(0)" ::: "memory");
    }
    __syncthreads();
}
DEV void xcd_barrier(const XcdBarrier& b, int tid) {
    asm volatile("s_waitcnt vmcnt(0)" ::: "memory");
    __syncthreads();
    if (tid == 0) {
        unsigned* bar = b.bar;
        __builtin_amdgcn_s_waitcnt(0);
        unsigned nloc = b.st[0], nx = b.st[1];
        if (nloc == 0u) { xcd_barrier_complete(bar, b.x, nloc, nx); b.st[0] = nloc; b.st[1] = nx; }
        const unsigned old = xb_add(&bar[XB_XSUB(b.x)], 1u);
        const unsigned gen = old / nloc;
        if (old + 1u == (gen + 1u) * nloc) {
            __builtin_amdgcn_fence(__ATOMIC_RELEASE, "agent");
            asm volatile("s_waitcnt vmcnt(0)" ::: "memory");
            const unsigned og = xb_add(&bar[XB_TOP], 1u);
            const unsigned tg = og / nx;
            if (og + 1u == (tg + 1u) * nx) xb_add(&bar[XB_TOPGEN], 1u);
            else XB_SPIN(xb_ld(&bar[XB_TOPGEN]) == tg, bar);
            __builtin_amdgcn_fence(__ATOMIC_ACQUIRE, "agent");
            xb_add(&bar[XB_XGEN(b.x)], 1u);
            asm volatile("s_waitcnt vmcnt(0)" ::: "memory");
        } else {
            XB_SPIN(xb_ld(&bar[XB_XGEN(b.x)]) == gen, bar);
            __builtin_amdgcn_fence(__ATOMIC_ACQUIRE, "agent");
            asm volatile("s_waitcnt vmcnt(0)" ::: "memory");
        }
    }
    __syncthreads();
}


using pg8::gelu_t;
struct WaveId { int gw, ngw, wave, lane; };
DEV unsigned f2bf_u(float f) { return (unsigned)f2bf(f); }
DEV unsigned pk2(float lo, float hi) { return cvt_pk_bf16(lo, hi); }

DEV void norm_rows(const WaveId& W, const float* x, const float* g, bf16_t* outb, float* outf, int rows) {
    for (int row = W.gw; row < rows; row += W.ngw) {
        const f32x4* xr = (const f32x4*)(x + (size_t)row * D) + W.lane;
        f32x4 v[4]; float s = 0.f;
#pragma unroll
        for (int j = 0; j < 4; ++j) { v[j] = xr[64 * j]; s += (v[j].x * v[j].x + v[j].y * v[j].y) + (v[j].z * v[j].z + v[j].w * v[j].w); }
        const float r = rsqrtf(wave_sum(s) * (1.f / D) + EPS);
#pragma unroll
        for (int j = 0; j < 4; ++j) {
            const f32x4 gg = ((const f32x4*)g)[W.lane + 64 * j];
            const f32x4 o = {v[j].x * r * gg.x, v[j].y * r * gg.y, v[j].z * r * gg.z, v[j].w * r * gg.w};
            if (outb) { u32x2 w; w.x = pk2(o.x, o.y); w.y = pk2(o.z, o.w); ((u32x2*)(outb + (size_t)row * D))[W.lane + 64 * j] = w; }
            else ((f32x4*)(outf + (size_t)row * D))[W.lane + 64 * j] = o;
        }
    }
}
DEV void cvt_piece(const WaveId& W, LAS float* scr, int& base, const float* Wsrc, int ldw, int K, int col0, int ncols, bf16_t* dst, int ldo, int row0, const float* gain = nullptr) {
    const int nblk = ncols / 32, nitems = (K / 64) * nblk;
    int first = (W.gw - base) % W.ngw; if (first < 0) first += W.ngw;
    base = (base + nitems) % W.ngw;
    for (int item = first; item < nitems; item += W.ngw) {
        const int kb = item / nblk, nb = item - kb * nblk, k0 = 64 * kb, n0 = 32 * nb;
        { const int lr = W.lane >> 3, lc = (W.lane & 7) * 4;
          f32x4 v[8]; float g[8];
#pragma unroll
          for (int i = 0; i < 8; ++i) { v[i] = *(const f32x4*)(Wsrc + (size_t)(k0 + lr + 8 * i) * ldw + col0 + n0 + lc); g[i] = gain ? gain[k0 + lr + 8 * i] : 1.f; }
#pragma unroll
          for (int i = 0; i < 8; ++i) { LAS float* d = scr + (lr + 8 * i) * 33 + lc; d[0] = v[i][0] * g[i]; d[1] = v[i][1] * g[i]; d[2] = v[i][2] * g[i]; d[3] = v[i][3] * g[i]; } }
        LDS_WAIT(); asm volatile("" ::: "memory");
        const int c = W.lane & 7;
#pragma unroll
        for (int j = 0; j < 4; ++j) { const int n = (W.lane >> 3) + 8 * j; const LAS float* s = scr + (8 * c) * 33 + n;
            u32x4 o; o.x = pk2(s[0 * 33], s[1 * 33]); o.y = pk2(s[2 * 33], s[3 * 33]); o.z = pk2(s[4 * 33], s[5 * 33]); o.w = pk2(s[6 * 33], s[7 * 33]);
            *(u32x4*)(dst + (size_t)(row0 + n0 + n) * ldo + k0 + 8 * c) = o; }
        LDS_WAIT(); asm volatile("" ::: "memory");
    }
}
DEV void convert_layer_weights(const WaveId& W, LAS float* scr, int& base, unsigned char* ws, const float* const* in, int l, int part = 7) {
    const float* wi = in[3] + (size_t)l * D * DIN;
    if (part & 1) {
    bf16_t* WIN = (bf16_t*)(ws + WS_WIN); const float* gm = in[2] + l * D;
    cvt_piece(W, scr, base, wi, DIN, D, 0, 1536, WIN, D, 0, gm);
    cvt_piece(W, scr, base, wi, DIN, D, 3072, 1536, WIN, D, 1536, gm);
    cvt_piece(W, scr, base, wi, DIN, D, 4608, 512, WIN, D, 3072, gm);
    cvt_piece(W, scr, base, wi, DIN, D, 1536, 512, WIN, D, 3584, gm);
#pragma unroll 1
    for (int j = 0; j < 4; ++j) { cvt_piece(W, scr, base, wi, DIN, D, 2048 + 128 * j, 128, WIN, D, 4096 + 256 * j, gm); cvt_piece(W, scr, base, wi, DIN, D, 2560 + 128 * j, 128, WIN, D, 4096 + 256 * j + 128, gm); }
    cvt_piece(W, scr, base, wi, DIN, D, 5120, 96, WIN, D, 5120, gm);
    cvt_piece(W, scr, base, wi, DIN, D, 5192, 3072, (bf16_t*)(ws + WS_WG), D, 0, gm);
#pragma unroll 1
    for (int i = 0; i < 3; ++i) cvt_piece(W, scr, base, in[5 + i] + (size_t)l * 512 * D, D, 512, 0, D, (bf16_t*)(ws + WS_WBR) + (size_t)i * D * 512, 512, 0);
    cvt_piece(W, scr, base, in[8] + (size_t)l * D * D, D, D, 0, D, (bf16_t*)(ws + WS_WMIX), D, 0);
    }
    if (part & 2) {
    const float* gf = in[14] + l * D;
    const float* wf = in[15] + (size_t)l * D * 2 * DFF;
#pragma unroll 1
    for (int j = 0; j < 22; ++j) { cvt_piece(W, scr, base, wf, 2 * DFF, D, 128 * j, 128, (bf16_t*)(ws + WS_WUP), D, 256 * j, gf); cvt_piece(W, scr, base, wf, 2 * DFF, D, DFF + 128 * j, 128, (bf16_t*)(ws + WS_WUP), D, 256 * j + 128, gf); }
    }
    if (part & 4) cvt_piece(W, scr, base, in[18] + (size_t)l * DFF * D, D, DFF, 0, D, (bf16_t*)(ws + WS_WDOWN), DFF, 0);
}
DEV void prep0_phase(const WaveId& W, LAS float* scr, unsigned char* ws, const float* const* in, bf16_t* XB) {
    int base = 0;
#pragma unroll 1
    for (int l = 0; l < DEPTH; ++l) {
        const float* wq = in[11] + (size_t)l * D * D; bf16_t* WQ = (bf16_t*)(ws + WS_WQ + (size_t)l * 2 * MiB); const float* gx = in[9] + l * D;
        for (size_t i = (size_t)(W.gw * 64 + W.lane) * 4; i < (size_t)D * D; i += (size_t)W.ngw * 256) { const float g = gx[i >> 10]; const f32x4 v = *(const f32x4*)(wq + i); u32x2 o; o.x = pk2(v.x * g, v.y * g); o.y = pk2(v.z * g, v.w * g); *(u32x2*)(WQ + i) = o; }
        cvt_piece(W, scr, base, in[13] + (size_t)l * D * D, D, D, 0, D, (bf16_t*)(ws + WS_WOT + (size_t)l * 2 * MiB), D, 0);
        cvt_piece(W, scr, base, in[12] + (size_t)l * D * 2 * D, 2 * D, D, 0, 2 * D, (bf16_t*)(ws + WS_WKVT + (size_t)l * 4 * MiB), D, 0);
        norm_rows(W, in[1], in[10] + l * D, (bf16_t*)(ws + WS_MEMN + (size_t)l * MiB), nullptr, NB * MEM);
    }
    convert_layer_weights(W, scr, base, ws, in, 0);
    pg8::u64* ss0 = (pg8::u64*)(ws + WS_SS);
    { unsigned zz = 0u; asm volatile("" : "+v"(zz)); const u32x4 z = {zz, zz, zz, zz};
      for (int i = W.gw * 64 + W.lane; i < 6 * T * 8 / 16; i += W.ngw * 64) ((u32x4*)(ss0 + T))[i] = z; }
    for (int row0 = W.gw; row0 < T; row0 += 4 * W.ngw) {
        f32x4 v[4][4];
#pragma unroll
        for (int u = 0; u < 4; ++u) { const f32x4* xr = (const f32x4*)(in[0] + (size_t)(row0 + u * W.ngw) * D) + W.lane;
#pragma unroll
            for (int j = 0; j < 4; ++j) v[u][j] = xr[64 * j]; }
#pragma unroll
        for (int u = 0; u < 4; ++u) { const int row = row0 + u * W.ngw; float s = 0.f;
#pragma unroll
            for (int j = 0; j < 4; ++j) { const f32x4 x = v[u][j]; s += (x.x * x.x + x.y * x.y) + (x.z * x.z + x.w * x.w);
                u32x2 w; w.x = pk2(x.x, x.y); w.y = pk2(x.z, x.w); ((u32x2*)(XB + (size_t)row * D))[W.lane + 64 * j] = w; }
            s = wave_sum(s); if (W.lane == 0) ss0[row] = (pg8::u64)(s * pg8::SS_SCALE + 0.5f); }
    }
}
DEV void final_norm(const WaveId& W, const bf16_t* x, float* out, const float* g, const pg8::u64* ss) {
    f32x4 gg[4];
#pragma unroll
    for (int j = 0; j < 4; ++j) gg[j] = ((const f32x4*)g)[W.lane + 64 * j];
    for (int row0 = W.gw; row0 < T; row0 += 4 * W.ngw) {
        u32x2 v[4][4]; pg8::u64 sq[4];
#pragma unroll
        for (int u = 0; u < 4; ++u) { const int row = row0 + u * W.ngw; sq[u] = ss[row]; const u32x2* xr = (const u32x2*)(x + (size_t)row * D) + W.lane;
#pragma unroll
            for (int j = 0; j < 4; ++j) v[u][j] = xr[64 * j]; }
#pragma unroll
        for (int u = 0; u < 4; ++u) { const int row = row0 + u * W.ngw; const float r = rsqrtf((float)sq[u] * (1.f / (pg8::SS_SCALE * D)) + EPS); f32x4* orow = (f32x4*)(out + (size_t)row * D) + W.lane;
#pragma unroll
            for (int j = 0; j < 4; ++j) { const u32x2 w = v[u][j];
                const f32x4 o = {bflo(w.x) * r * gg[j].x, bfhi(w.x) * r * gg[j].y, bflo(w.y) * r * gg[j].z, bfhi(w.y) * r * gg[j].w}; orow[64 * j] = o; } }
    }
}
DEV void conv_sc_phase(int gtid, int gthreads, bf16_t* scb, const bf16_t* cx, const float* w, bool dry) {
    const int c8 = (gtid & 63) * 8;
    const f32x4 w0a = *(const f32x4*)(w + c8), w0b = *(const f32x4*)(w + c8 + 4), w1a = *(const f32x4*)(w + 512 + c8), w1b = *(const f32x4*)(w + 512 + c8 + 4), w2a = *(const f32x4*)(w + 1024 + c8), w2b = *(const f32x4*)(w + 1024 + c8 + 4);
    const u32x4 z = {0u, 0u, 0u, 0u};
    for (int i0 = gtid; i0 < T * 64; i0 += 4 * gthreads) {
        u32x4 x2[4], x1[4], x0[4], bb[4];
#pragma unroll
        for (int u = 0; u < 4; ++u) { const int i = i0 + u * gthreads; if (i < T * 64) { const int t = i >> 6, tl = t & (S - 1); const size_t o = (size_t)t * 512 + c8;
            x2[u] = *(const u32x4*)(cx + o); x1[u] = tl >= 1 ? *(const u32x4*)(cx + o - 512) : z; x0[u] = tl >= 2 ? *(const u32x4*)(cx + o - 1024) : z; bb[u] = *(const u32x4*)(scb + o); } }
#pragma unroll
        for (int u = 0; u < 4; ++u) { const int i = i0 + u * gthreads; if (i < T * 64) { const size_t o = (size_t)(i >> 6) * 512 + c8;
            float r[8];
#define CONV1(k, W0, W1, W2, X0, X1, X2, BBv, F) r[k] = F(BBv) * (W0 * F(X0) + W1 * F(X1) + W2 * F(X2))
            CONV1(0, w0a.x, w1a.x, w2a.x, x0[u].x, x1[u].x, x2[u].x, bb[u].x, bflo); CONV1(1, w0a.y, w1a.y, w2a.y, x0[u].x, x1[u].x, x2[u].x, bb[u].x, bfhi);
            CONV1(2, w0a.z, w1a.z, w2a.z, x0[u].y, x1[u].y, x2[u].y, bb[u].y, bflo); CONV1(3, w0a.w, w1a.w, w2a.w, x0[u].y, x1[u].y, x2[u].y, bb[u].y, bfhi);
            CONV1(4, w0b.x, w1b.x, w2b.x, x0[u].z, x1[u].z, x2[u].z, bb[u].z, bflo); CONV1(5, w0b.y, w1b.y, w2b.y, x0[u].z, x1[u].z, x2[u].z, bb[u].z, bfhi);
            CONV1(6, w0b.z, w1b.z, w2b.z, x0[u].w, x1[u].w, x2[u].w, bb[u].w, bflo); CONV1(7, w0b.w, w1b.w, w2b.w, x0[u].w, x1[u].w, x2[u].w, bb[u].w, bfhi);
#undef CONV1
            u32x4 ov; ov.x = pk2(r[0], r[1]); ov.y = pk2(r[2], r[3]); ov.z = pk2(r[4], r[5]); ov.w = pk2(r[6], r[7]);
            if (!dry) *(u32x4*)(scb + o) = ov; else asm volatile("" :: "v"(ov)); } }
    }
}
DEV void ffn_fix_phase(int gtid, int gthreads, const bf16_t* sa, const bf16_t* su, bf16_t* fu, const float* cw, const float* cb, int strip0 = 0, int nstrip = T / 64) {
    constexpr int C8 = DFF / 8; const u32x4 z = {0u, 0u, 0u, 0u};
    for (int i0 = gtid; i0 < nstrip * 2 * C8; i0 += 3 * gthreads) {
        u32x4 x2[3], x1[3], x0[3], uu[3];
#pragma unroll
        for (int q = 0; q < 3; ++q) { const int i = i0 + q * gthreads; if (i < nstrip * 2 * C8) {
            const int sr = i / C8, c8 = (i - sr * C8) * 8, strip = strip0 + (sr >> 1), rr = sr & 1;
            const bool first = (strip & (S / 64 - 1)) == 0;
            const bf16_t* A = sa + (size_t)strip * 4 * DFF + c8; const bf16_t* Ap = A - 4 * DFF;
            x2[q] = *(const u32x4*)(A + rr * DFF);
            x1[q] = rr == 1 ? *(const u32x4*)A : (first ? z : *(const u32x4*)(Ap + 3 * DFF));
            x0[q] = first ? z : *(const u32x4*)(Ap + (2 + rr) * DFF);
            uu[q] = *(const u32x4*)(su + ((size_t)strip * 2 + rr) * DFF + c8); } }
#pragma unroll
        for (int q = 0; q < 3; ++q) { const int i = i0 + q * gthreads; if (i < nstrip * 2 * C8) {
            const int sr = i / C8, c8 = (i - sr * C8) * 8, strip = strip0 + (sr >> 1), rr = sr & 1, t = strip * 64 + rr;
            const f32x4 w0a = *(const f32x4*)(cw + c8), w0b = *(const f32x4*)(cw + c8 + 4), w1a = *(const f32x4*)(cw + DFF + c8), w1b = *(const f32x4*)(cw + DFF + c8 + 4), w2a = *(const f32x4*)(cw + 2 * DFF + c8), w2b = *(const f32x4*)(cw + 2 * DFF + c8 + 4);
            const f32x4 ba = *(const f32x4*)(cb + c8), bb = *(const f32x4*)(cb + c8 + 4);
            float r[8];
#define FM1(k, B0, W0, W1, W2, X0, X1, X2, Uv, F) r[k] = gelu_t(B0 + W0 * F(X0) + W1 * F(X1) + W2 * F(X2)) * F(Uv)
            FM1(0, ba.x, w0a.x, w1a.x, w2a.x, x0[q].x, x1[q].x, x2[q].x, uu[q].x, bflo); FM1(1, ba.y, w0a.y, w1a.y, w2a.y, x0[q].x, x1[q].x, x2[q].x, uu[q].x, bfhi);
            FM1(2, ba.z, w0a.z, w1a.z, w2a.z, x0[q].y, x1[q].y, x2[q].y, uu[q].y, bflo); FM1(3, ba.w, w0a.w, w1a.w, w2a.w, x0[q].y, x1[q].y, x2[q].y, uu[q].y, bfhi);
            FM1(4, bb.x, w0b.x, w1b.x, w2b.x, x0[q].z, x1[q].z, x2[q].z, uu[q].z, bflo); FM1(5, bb.y, w0b.y, w1b.y, w2b.y, x0[q].z, x1[q].z, x2[q].z, uu[q].z, bfhi);
            FM1(6, bb.z, w0b.z, w1b.z, w2b.z, x0[q].w, x1[q].w, x2[q].w, uu[q].w, bflo); FM1(7, bb.w, w0b.w, w1b.w, w2b.w, x0[q].w, x1[q].w, x2[q].w, uu[q].w, bfhi);
#undef FM1
            u32x4 ov; ov.x = pk2(r[0], r[1]); ov.y = pk2(r[2], r[3]); ov.z = pk2(r[4], r[5]); ov.w = pk2(r[6], r[7]);
            *(u32x4*)(fu + (size_t)t * DFF + c8) = ov; } }
    }
}

typedef short s16x4 __attribute__((ext_vector_type(4)));
DEV s16x4 vtr(const LAS unsigned char* p) { return __builtin_bit_cast(s16x4, __builtin_amdgcn_ds_read_tr16_b64_v4i16((LAS s16x4*)p)); }
DEV bf16x8 cat8(const s16x4 a, const s16x4 b) { return (bf16x8){a[0], a[1], a[2], a[3], b[0], b[1], b[2], b[3]}; }
DEV bf16x8 pk8(float a0, float a1, float a2, float a3, float a4, float a5, float a6, float a7) {
    u32x4 w; w.x = pk2(a0, a1); w.y = pk2(a2, a3); w.z = pk2(a4, a5); w.w = pk2(a6, a7); return __builtin_bit_cast(bf16x8, w); }
constexpr int VPITCH = 192;
DEV void pv_tile(f32x16& o0, f32x16& o1, const LAS unsigned char* vt, int lane, const bf16x8 (&pk)[4]) {
    const int hi = lane >> 5;
    const LAS unsigned char* vb = vt + (4 * hi + ((lane & 15) >> 2)) * VPITCH + ((lane >> 4) & 1) * 32 + (lane & 3) * 8;
    bf16x8 va[4];
#pragma unroll
    for (int ks = 0; ks < 4; ++ks) va[ks] = cat8(vtr(vb + (16 * ks) * VPITCH), vtr(vb + (16 * ks + 8) * VPITCH));
    asm volatile("" : "+v"(va[0]), "+v"(va[1]), "+v"(va[2]), "+v"(va[3]));
#pragma unroll
    for (int ks = 0; ks < 4; ++ks) o0 = __builtin_amdgcn_mfma_f32_32x32x16_bf16(va[ks], pk[ks], o0, 0, 0, 0);
#pragma unroll
    for (int ks = 0; ks < 4; ++ks) va[ks] = cat8(vtr(vb + (16 * ks) * VPITCH + 64), vtr(vb + (16 * ks + 8) * VPITCH + 64));
    asm volatile("" : "+v"(va[0]), "+v"(va[1]), "+v"(va[2]), "+v"(va[3]));
#pragma unroll
    for (int ks = 0; ks < 4; ++ks) o1 = __builtin_amdgcn_mfma_f32_32x32x16_bf16(va[ks], pk[ks], o1, 0, 0, 0);
}
DEV void store_ot(bf16_t* orow, const f32x16& o0, const f32x16& o1, int hi, float sc) {
#pragma unroll
    for (int g4 = 0; g4 < 4; ++g4) {
        u32x2 a; a.x = pk2(o0[4 * g4] * sc, o0[4 * g4 + 1] * sc); a.y = pk2(o0[4 * g4 + 2] * sc, o0[4 * g4 + 3] * sc);
        u32x2 b; b.x = pk2(o1[4 * g4] * sc, o1[4 * g4 + 1] * sc); b.y = pk2(o1[4 * g4 + 2] * sc, o1[4 * g4 + 3] * sc);
        *(u32x2*)(orow + 8 * g4 + 4 * hi) = a; *(u32x2*)(orow + 32 + 8 * g4 + 4 * hi) = b;
    }
}

DEV void sb_item(LAS unsigned char* vl, const bf16_t* Q, const bf16_t* Kk, const bf16_t* V, bf16_t* O, int b, int h, int qb, int lane, bool dry) {
    const int r32 = lane & 31, hi = lane >> 5, t0 = 32 * qb, t = t0 + r32; const size_t rowb = (size_t)b * S;
    bf16x8 qr[4]; { const bf16_t* qp = Q + (rowb + t0 + r32) * 512 + h * 64 + 8 * hi;
#pragma unroll
        for (int d0 = 0; d0 < 4; ++d0) qr[d0] = *(const bf16x8*)(qp + 16 * d0); }
    f32x16 o0, o1;
#pragma unroll
    for (int r = 0; r < 16; ++r) { o0[r] = 0.f; o1[r] = 0.f; }
    float carry = 1.f;
    const int c_hi = (t0 + 30) >> 6;
#pragma unroll 1
    for (int c = c_hi; c >= 0; --c) {
        const bf16_t* kp = Kk + (rowb + 64 * c + r32) * 512 + h * 64 + 8 * hi;
        bf16x8 k0[4], k1[4];
#pragma unroll
        for (int d0 = 0; d0 < 4; ++d0) { k0[d0] = *(const bf16x8*)(kp + 16 * d0); k1[d0] = *(const bf16x8*)(kp + (size_t)32 * 512 + 16 * d0); }
        u32x4 vreg[8];
#pragma unroll
        for (int j = 0; j < 8; ++j) { const int row = (lane >> 3) + 8 * j; vreg[j] = *(const u32x4*)(V + (rowb + 64 * c + row) * 512 + h * 64 + (lane & 7) * 8); }
        f32x16 p0, p1;
#pragma unroll
        for (int r = 0; r < 16; ++r) { p0[r] = 0.f; p1[r] = 0.f; }
#pragma unroll
        for (int d0 = 0; d0 < 4; ++d0) { p0 = __builtin_amdgcn_mfma_f32_32x32x16_bf16(k0[d0], qr[d0], p0, 0, 0, 0); p1 = __builtin_amdgcn_mfma_f32_32x32x16_bf16(k1[d0], qr[d0], p1, 0, 0, 0); }
        float u[32];
        const bool diag = (c == c_hi);
#pragma unroll
        for (int e = 0; e < 32; ++e) {
            const float z = e < 16 ? p0[e] : p1[e - 16];
            float uu = __builtin_amdgcn_rcpf(1.f + __builtin_amdgcn_exp2f(fminf(z, 126.f)));
            if (diag) { const int kv = 64 * c + 8 * ((e >> 2) & 3) + 4 * hi + (e & 3) + 32 * (e >> 4); if (kv >= t) uu = 1.f; }
            u[e] = uu;
        }
        float gl[8], gh[8];
#pragma unroll
        for (int i = 0; i < 8; ++i) { const float gp = (u[4 * i] * u[4 * i + 1]) * (u[4 * i + 2] * u[4 * i + 3]);
            const auto rr = __builtin_amdgcn_permlane32_swap(__float_as_uint(gp), __float_as_uint(gp), false, false); gl[i] = __uint_as_float(rr[0]); gh[i] = __uint_as_float(rr[1]); }
        float ag[8]; float run = carry;
#pragma unroll
        for (int i = 7; i >= 0; --i) { const float a_hi = run; run *= gh[i]; const float a_lo = run; run *= gl[i]; ag[i] = hi ? a_hi : a_lo; }
        carry = run;
        bf16x8 pk[4];
#pragma unroll
        for (int ks = 0; ks < 4; ++ks) { float w[8];
#pragma unroll
            for (int g = 0; g < 2; ++g) { const int i = 2 * ks + g;
                const float a3 = ag[i], a2 = a3 * u[4 * i + 3], a1 = a2 * u[4 * i + 2], a0 = a1 * u[4 * i + 1];
                w[4 * g] = (1.f - u[4 * i]) * a0; w[4 * g + 1] = (1.f - u[4 * i + 1]) * a1; w[4 * g + 2] = (1.f - u[4 * i + 2]) * a2; w[4 * g + 3] = (1.f - u[4 * i + 3]) * a3; }
            pk[ks] = pk8(w[0], w[1], w[2], w[3], w[4], w[5], w[6], w[7]); }
#pragma unroll
        for (int j = 0; j < 8; ++j) { const int row = (lane >> 3) + 8 * j; *(LAS u32x4*)(vl + row * VPITCH + (lane & 7) * 16) = vreg[j]; }
        pv_tile(o0, o1, vl, lane, pk);
        if (__all(carry < 7.8e-31f)) break;
    }
    if (!dry) store_ot(O + (rowb + t0 + r32) * 512 + h * 64, o0, o1, hi, 1.f); else asm volatile("" :: "v"(o0), "v"(o1));
}
DEV void sb_phase(const WaveId& W, LAS unsigned char* lds, unsigned char* ws, bool dry) {
    LAS unsigned char* vl = lds + W.wave * 12288;
    const bf16_t* Q = (const bf16_t*)(ws + WS_QA); const bf16_t* Kk = (const bf16_t*)(ws + WS_KA); const bf16_t* V = (const bf16_t*)(ws + WS_VA);
    constexpr int NITEM = NB * 8 * (S / 32);
    for (int it = W.gw; it < NITEM; it += W.ngw) {
        const int qb = it & 255, h = (it >> 8) & 7, b = it >> 11;
        sb_item(vl, Q, Kk, V, (bf16_t*)(ws + WS_QA), b, h, qb, W.lane, dry);
    }
}

constexpr int IDX_CTL_OFF = 131072 + 1024;
DEV unsigned fkey2(float v) { const int u = (int)__float_as_uint(v); return (unsigned)(u ^ ((u >> 31) | (int)0x80000000)); }
DEV float relu1(float x) { return __builtin_amdgcn_fmed3f(x, 0.f, 3.0e38f); }
DEV void idx_prefetch(bf16x8 (&afr)[4], float (&w)[16], bf16x8 (&b0)[4], bf16x8 (&b1)[4], const bf16_t* IQ, const bf16_t* IK, const float* IWp, int b, int t0, int wid, int lane) {
    const int r32 = lane & 31, hh = lane >> 5; const size_t rowb = (size_t)b * S;
    { const int qi = 2 * (r32 >> 4) + ((r32 >> 2) & 1), head = (r32 & 3) + 4 * ((r32 >> 3) & 1);
        const bf16_t* ap = IQ + (rowb + t0 + qi) * 512 + head * 64 + 8 * hh;
#pragma unroll
        for (int ks = 0; ks < 4; ++ks) afr[ks] = *(const bf16x8*)(ap + 16 * ks); }
#pragma unroll
    for (int r = 0; r < 16; ++r) w[r] = IWp[(rowb + t0 + 2 * (r >> 3) + hh) * 8 + (r & 7)];
    const int jmax = (t0 + 3) >> 5;
    { const int j0 = wid < jmax ? wid : jmax, j1 = wid + 8 < jmax ? wid + 8 : jmax;
      const bf16_t* p0 = IK + ((rowb >> 5) + j0) * 2048 + (hh * 32 + r32) * 8; const bf16_t* p1 = IK + ((rowb >> 5) + j1) * 2048 + (hh * 32 + r32) * 8;
#pragma unroll
      for (int ks = 0; ks < 4; ++ks) { b0[ks] = *(const bf16x8*)(p0 + ks * 512); b1[ks] = *(const bf16x8*)(p1 + ks * 512); } }
}
DEV void idx_ticket(unsigned tk, int& b, int& t0) { b = (int)(tk & 1u); t0 = (int)(S / 4 - 1 - (tk >> 1)) * 4; }
DEV void idx_unit(LAS unsigned char* lds, const bf16_t* IQ, const bf16_t* IK, const float* IWp, unsigned* BM, int b, int t0, unsigned* qhead, int par, unsigned& next_tk, int wid, int lane,
                  bf16x8 (&afr)[4], float (&w)[16], bf16x8 (&b0)[4], bf16x8 (&b1)[4]) {
    const int r32 = lane & 31, hh = lane >> 5; const size_t rowb = (size_t)b * S;
    LAS unsigned* QW = (LAS unsigned*)(lds + IDX_CTL_OFF + 32);
    unsigned tk_reg = 0u; if (wid == 0 && lane == 0) tk_reg = __hip_atomic_fetch_add(qhead, 1u, __ATOMIC_RELAXED, __HIP_MEMORY_SCOPE_AGENT);
    const int tmax = t0 + 3, jmax = tmax >> 5;
    LAS unsigned* SCO = (LAS unsigned*)lds;
    bf16x8 b2[4];
#pragma unroll
    for (int ks = 0; ks < 4; ++ks) b2[ks] = afr[ks];
#define IDX_LOADB(dst, jj) do { const int jc_ = (jj) < jmax ? (jj) : jmax; const bf16_t* bp_ = IK + ((rowb >> 5) + jc_) * 2048 + (hh * 32 + r32) * 8; \
        _Pragma("unroll") for (int ks = 0; ks < 4; ++ks) dst[ks] = *(const bf16x8*)(bp_ + ks * 512); } while (0)
#define IDX_COMP(src, jj) do { f32x16 acc; _Pragma("unroll") for (int r = 0; r < 16; ++r) acc[r] = 0.f; \
        _Pragma("unroll") for (int ks = 0; ks < 4; ++ks) acc = __builtin_amdgcn_mfma_f32_32x32x16_bf16(afr[ks], src[ks], acc, 0, 0, 0); \
        float s0 = 0.f, s1 = 0.f; _Pragma("unroll") for (int hd = 0; hd < 8; ++hd) { s0 += w[hd] * relu1(acc[hd]); s1 += w[8 + hd] * relu1(acc[8 + hd]); } \
        unsigned k0_ = fkey2(s0), k1_ = fkey2(s1); const int key = 32 * (jj) + r32; \
        if ((jj) >= jmax) { k0_ = key <= t0 + hh ? k0_ : 0u; k1_ = key <= t0 + 2 + hh ? k1_ : 0u; }     \
        if ((jj) <= jmax) { SCO[hh * 8192 + key] = k0_; SCO[(2 + hh) * 8192 + key] = k1_; } } while (0)
#ifndef IDX_REP_MFMA
#define IDX_REP_MFMA 1
#endif
#ifndef IDX_REP_SEL
#define IDX_REP_SEL 1
#endif
#ifdef IDX_DRY_COMPUTE
#pragma unroll 1
    for (int j = wid; j <= jmax; j += 24) { IDX_COMP(b0, j); asm volatile("" : "+v"(b0[0]), "+v"(b1[0]), "+v"(b2[0])); IDX_COMP(b1, j + 8); IDX_COMP(b2, j + 16); }
#endif
#pragma unroll 1
    for (int rpm = 0; rpm < IDX_REP_MFMA; ++rpm) {
#pragma unroll 1
    for (int j = wid; j <= jmax; j += 24) {
        IDX_LOADB(b2, j + 16); IDX_COMP(b0, j);
        IDX_LOADB(b0, j + 24); IDX_COMP(b1, j + 8);
        IDX_LOADB(b1, j + 32); IDX_COMP(b2, j + 16);
    }
    }
#undef IDX_LOADB
#undef IDX_COMP
    LAS unsigned* thr = (LAS unsigned*)(lds + IDX_CTL_OFF);
    if (wid == 0 && lane < 32) ((LAS unsigned*)(lds + IDX_CTL_OFF + 64))[lane] = 0u;
    if (wid == 0 && lane == 0) QW[par ^ 1] = tk_reg;
    LDS_WAIT(); __builtin_amdgcn_s_barrier(); asm volatile("" ::: "memory");
    next_tk = QW[par ^ 1];
    if (next_tk < (unsigned)(T / 4)) { int nb, nt0; idx_ticket(next_tk, nb, nt0); idx_prefetch(afr, w, b0, b1, IQ, IK, IWp, nb, nt0, wid, lane); }
    {
        const int q = wid & 3, h = wid >> 2, n = t0 + q + 1;
        volatile LAS unsigned* xme = (volatile LAS unsigned*)(lds + IDX_CTL_OFF + 64) + (q * 2 + h) * 4;
        volatile LAS unsigned* xpa = (volatile LAS unsigned*)(lds + IDX_CTL_OFF + 64) + (q * 2 + (h ^ 1)) * 4;
        unsigned T_ = 1u;
        if (n > 256) {
            LAS unsigned* row = SCO + q * 8192 + lane;
            unsigned r[64];
            const int nil = (jmax >> 1) >= h ? (((jmax >> 1) - h) >> 1) + 1 : 0;
#define IDX_FOR_LIVE(BODY) _Pragma("unroll") for (int g8_ = 0; g8_ < 8; ++g8_) if (8 * g8_ < nil) { _Pragma("unroll") for (int u8_ = 0; u8_ < 8; ++u8_) { const int il = 8 * g8_ + u8_; BODY } }
            IDX_FOR_LIVE( r[il] = (2 * (2 * il + h) + hh <= jmax) ? row[64 * (2 * il + h)] : 0u; )
            unsigned seq = 0u;
#define IDX_XCHG(val, out) do { ++seq; const int pb_ = (seq & 1u) * 2; if (lane == 0) { xme[pb_ + 1] = (val); xme[pb_] = seq; } \
                while (xpa[pb_] != seq) __builtin_amdgcn_s_sleep(0); (out) = xpa[pb_ + 1]; } while (0)
#define IDX_XCHG16(val, out) do { ++seq; const int pb_ = (seq & 1u) * 2; if (lane == 0) xme[pb_] = (seq << 16) | (val); unsigned w_; \
                while (((w_ = xpa[pb_]) >> 16) != (seq & 0xffffu)) __builtin_amdgcn_s_sleep(0); (out) = w_ & 0xffffu; } while (0)
#pragma unroll 1
            for (int rps = 0; rps < IDX_REP_SEL; ++rps) {
            unsigned mx = 0u;
            IDX_FOR_LIVE( mx = max(mx, r[il]); )
#pragma unroll
            for (int o = 1; o < 64; o <<= 1) mx = max(mx, (unsigned)__shfl_xor((int)mx, o));
            { unsigned pm_; IDX_XCHG(mx, pm_); mx = max(mx, pm_); }
            unsigned lo_ = 1u, hi_ = mx + 1u, chi_ = 0u, xgt_ = 1u, xeq_ = 0u, mt_ = 0u; bool done_ = false;
            if (mx > 0x82000000u) {
                const unsigned c1 = mx - (1u << 23), c2 = mx - (3u << 23);
                unsigned ca_ = 0, cb_ = 0, cc_ = 0, cd_ = 0; const unsigned c1v = c1, c2v = c2;
#define IDX_CNT4B(A, B, C, Dd) asm volatile("v_cmp_ge_u32_e64 s[88:89], %4, %8\n\tv_cmp_ge_u32_e64 s[90:91], %5, %8\n\tv_cmp_ge_u32_e64 s[92:93], %6, %8\n\tv_cmp_ge_u32_e64 s[94:95], %7, %8\n\t" \
                    "v_addc_co_u32_e64 %0, s[88:89], %0, 0, s[88:89]\n\tv_addc_co_u32_e64 %1, s[90:91], %1, 0, s[90:91]\n\tv_addc_co_u32_e64 %0, s[92:93], %0, 0, s[92:93]\n\tv_addc_co_u32_e64 %1, s[94:95], %1, 0, s[94:95]\n\t" \
                    "v_cmp_ge_u32_e64 s[88:89], %4, %9\n\tv_cmp_ge_u32_e64 s[90:91], %5, %9\n\tv_cmp_ge_u32_e64 s[92:93], %6, %9\n\tv_cmp_ge_u32_e64 s[94:95], %7, %9\n\t" \
                    "v_addc_co_u32_e64 %2, s[88:89], %2, 0, s[88:89]\n\tv_addc_co_u32_e64 %3, s[90:91], %3, 0, s[90:91]\n\tv_addc_co_u32_e64 %2, s[92:93], %2, 0, s[92:93]\n\tv_addc_co_u32_e64 %3, s[94:95], %3, 0, s[94:95]" \
                    : "+v"(ca_), "+v"(cb_), "+v"(cc_), "+v"(cd_) : "v"(A), "v"(B), "v"(C), "v"(Dd), "v"(c1v), "v"(c2v) : "s88", "s89", "s90", "s91", "s92", "s93", "s94", "s95")
#pragma unroll
                for (int g8_ = 0; g8_ < 8; ++g8_) if (8 * g8_ < nil) { IDX_CNT4B(r[8 * g8_], r[8 * g8_ + 1], r[8 * g8_ + 2], r[8 * g8_ + 3]); IDX_CNT4B(r[8 * g8_ + 4], r[8 * g8_ + 5], r[8 * g8_ + 6], r[8 * g8_ + 7]); }
#undef IDX_CNT4B
                int pk = (int)((ca_ + cb_) | ((cc_ + cd_) << 16));
                pk += __builtin_amdgcn_update_dpp(0, pk, 0x111, 0xf, 0xf, false);
                pk += __builtin_amdgcn_update_dpp(0, pk, 0x112, 0xf, 0xf, false);
                pk += __builtin_amdgcn_update_dpp(0, pk, 0x114, 0xf, 0xf, false);
                pk += __builtin_amdgcn_update_dpp(0, pk, 0x118, 0xf, 0xf, false);
                pk += __builtin_amdgcn_update_dpp(0, pk, 0x142, 0xa, 0xf, false);
                unsigned tot = (unsigned)__builtin_amdgcn_readlane(pk, 31) + (unsigned)__builtin_amdgcn_readlane(pk, 63);
                { unsigned pt_; IDX_XCHG(tot, pt_); tot += pt_; }
                const unsigned t1 = tot & 0xffffu, t2 = tot >> 16;
                if (t1 == 256u) { xgt_ = c1; mt_ = 0u; done_ = true; }
                else if (t1 > 256u) lo_ = c1;
                else { hi_ = c1; chi_ = t1;
                       if (t2 == 256u) { xgt_ = c2; mt_ = 0u; done_ = true; }
                       else if (t2 > 256u) lo_ = c2;
                       else { hi_ = c2; chi_ = t2; } }
                if (!done_ && hi_ - lo_ == 1u) { xgt_ = hi_; xeq_ = lo_; mt_ = 256u - chi_; done_ = true; }
            }
            { LAS unsigned* hist = (LAS unsigned*)(lds + IDX_CTL_OFF + 1024) + q * 256;
#pragma unroll 1
              for (int round = 0; round < 6 && !done_; ++round) {
                const unsigned wdt = hi_ - lo_;
                const int sh = wdt <= 256u ? 0 : 24 - (int)__builtin_clz(wdt - 1u);
                hist[128 * h + lane] = 0u; hist[128 * h + 64 + lane] = 0u;
                LDS_WAIT(); { unsigned d_; IDX_XCHG16(0u, d_); (void)d_; }
                const unsigned lov = lo_;
                if (round == 0) {
                    IDX_FOR_LIVE( const unsigned d = r[il] - lov; if (d < wdt) __hip_atomic_fetch_add(hist + (d >> sh), 1u, __ATOMIC_RELAXED, __HIP_MEMORY_SCOPE_WORKGROUP); )
                } else {
#pragma unroll
                    for (int g8_ = 0; g8_ < 8; ++g8_) if (8 * g8_ < nil) {
#pragma unroll
                        for (int u4_ = 0; u4_ < 2; ++u4_) { const int il = 8 * g8_ + 4 * u4_;
                            const unsigned d0 = r[il] - lov, d1 = r[il + 1] - lov, d2 = r[il + 2] - lov, d3 = r[il + 3] - lov;
                            if (min(min(d0, d1), min(d2, d3)) < wdt) {
                                if (d0 < wdt) __hip_atomic_fetch_add(hist + (d0 >> sh), 1u, __ATOMIC_RELAXED, __HIP_MEMORY_SCOPE_WORKGROUP);
                                if (d1 < wdt) __hip_atomic_fetch_add(hist + (d1 >> sh), 1u, __ATOMIC_RELAXED, __HIP_MEMORY_SCOPE_WORKGROUP);
                                if (d2 < wdt) __hip_atomic_fetch_add(hist + (d2 >> sh), 1u, __ATOMIC_RELAXED, __HIP_MEMORY_SCOPE_WORKGROUP);
                                if (d3 < wdt) __hip_atomic_fetch_add(hist + (d3 >> sh), 1u, __ATOMIC_RELAXED, __HIP_MEMORY_SCOPE_WORKGROUP); } } }
                }
                LDS_WAIT(); { unsigned d_; IDX_XCHG16(0u, d_); (void)d_; }
                const u32x4 hb = *(const LAS u32x4*)(hist + 4 * lane);
                const unsigned s4 = (hb.x + hb.y) + (hb.z + hb.w);
                unsigned suf = s4;
#pragma unroll
                for (int o = 1; o < 64; o <<= 1) { const unsigned tv = (unsigned)__shfl_down((int)suf, o); if (lane + o < 64) suf += tv; }
                const unsigned long long okm = __ballot(chi_ + suf >= 256u);
                const int L = 63 - (int)__builtin_clzll(okm);
                const unsigned above = chi_ + (unsigned)__builtin_amdgcn_readlane((int)(suf - s4), L);
                const unsigned h0 = (unsigned)__builtin_amdgcn_readlane((int)hb.x, L), h1 = (unsigned)__builtin_amdgcn_readlane((int)hb.y, L),
                               h2 = (unsigned)__builtin_amdgcn_readlane((int)hb.z, L), h3 = (unsigned)__builtin_amdgcn_readlane((int)hb.w, L);
                unsigned Bsel, cab, cnb;
                if (above + h3 >= 256u) { Bsel = 3u; cab = above; cnb = h3; }
                else if (above + h3 + h2 >= 256u) { Bsel = 2u; cab = above + h3; cnb = h2; }
                else if (above + h3 + h2 + h1 >= 256u) { Bsel = 1u; cab = above + h3 + h2; cnb = h1; }
                else { Bsel = 0u; cab = above + h3 + h2 + h1; cnb = h0; }
                Bsel += 4u * (unsigned)L;
                const unsigned nlo = lo_ + (Bsel << sh); unsigned nhi = nlo + (1u << sh); if (nhi > hi_ || nhi < nlo) nhi = hi_;
                if (cab + cnb == 256u) { xgt_ = nlo; mt_ = 0u; done_ = true; }
                else if (sh == 0) { xgt_ = nlo + 1u; xeq_ = nlo; mt_ = 256u - cab; done_ = true; }
                else { lo_ = nlo; hi_ = nhi; chi_ = cab; }
              } }
#ifdef IDX_XTRA
#pragma unroll 1
            for (int xr = 0; xr < IDX_XTRA; ++xr) { unsigned dsum = 0; const unsigned cv = xgt_ + (unsigned)xr;
                IDX_FOR_LIVE( dsum += r[il] >= cv; )
                int pk = (int)dsum;
                pk += __builtin_amdgcn_update_dpp(0, pk, 0x111, 0xf, 0xf, false); pk += __builtin_amdgcn_update_dpp(0, pk, 0x112, 0xf, 0xf, false); pk += __builtin_amdgcn_update_dpp(0, pk, 0x114, 0xf, 0xf, false);
                pk += __builtin_amdgcn_update_dpp(0, pk, 0x118, 0xf, 0xf, false); pk += __builtin_amdgcn_update_dpp(0, pk, 0x142, 0xa, 0xf, false);
                unsigned tot = (unsigned)__builtin_amdgcn_readlane(pk, 31) + (unsigned)__builtin_amdgcn_readlane(pk, 63);
                { unsigned pt_; IDX_XCHG16(tot, pt_); tot += pt_; } asm volatile("" :: "s"(tot)); }
#endif
            T_ = xgt_;
            if (mt_ != 0u) {
                if (h == 0) { unsigned run = 0u;
#pragma unroll 1
                    for (int i = 0; i <= (jmax >> 1); ++i) { const bool ok_ = 2 * i + hh <= jmax; const unsigned kv = ok_ ? row[64 * i] : 0u; const bool eq = kv == xeq_; const unsigned long long bm = __ballot(eq);
                        const unsigned rank = run + __builtin_amdgcn_mbcnt_hi((unsigned)(bm >> 32), __builtin_amdgcn_mbcnt_lo((unsigned)bm, 0u));
                        if (eq && rank >= mt_) row[64 * i] = 0u;
                        run += (unsigned)__popcll(bm); } }
                T_ = xeq_;
            }
            }
#undef IDX_XCHG
#undef IDX_XCHG16
#undef IDX_FOR_LIVE
        }
        if (lane == 0 && h == 0) thr[q] = T_;
    }
#ifdef PROBE_VALU
    { float a0 = (float)lane, a1 = a0 + 1.f, a2 = a0 + 2.f, a3 = a0 + 3.f, a4 = a0 + 4.f, a5 = a0 + 5.f, a6 = a0 + 6.f, a7 = a0 + 7.f; const float m = 1.0000001f, c = 1e-9f;
#pragma unroll 1
      for (int it = 0; it < 64; ++it) {
#pragma unroll
          for (int u = 0; u < 8; ++u) { a0 = a0 * m + c; a1 = a1 * m + c; a2 = a2 * m + c; a3 = a3 * m + c; a4 = a4 * m + c; a5 = a5 * m + c; a6 = a6 * m + c; a7 = a7 * m + c; } }
      asm volatile("" :: "v"(a0), "v"(a1), "v"(a2), "v"(a3), "v"(a4), "v"(a5), "v"(a6), "v"(a7)); }
#endif
    LDS_WAIT(); __builtin_amdgcn_s_barrier(); asm volatile("" ::: "memory");
    { const unsigned tq0 = thr[hh], tq1 = thr[2 + hh];
#pragma unroll 4
      for (int j = wid; j <= ((t0 | 255) >> 5); j += 8) {
          bool s0 = false, s1 = false;
          if (j <= jmax) { s0 = SCO[hh * 8192 + 32 * j + r32] >= tq0; s1 = SCO[(2 + hh) * 8192 + 32 * j + r32] >= tq1; }
          const unsigned long long b0_ = __ballot(s0), b1_ = __ballot(s1);
          if (lane == 0) { u32x4 o; o.x = (unsigned)b0_; o.y = (unsigned)(b0_ >> 32); o.z = (unsigned)b1_; o.w = (unsigned)(b1_ >> 32); *(u32x4*)(BM + ((size_t)b * 256 + j) * S + t0) = o; }
      } }
    LDS_WAIT(); __builtin_amdgcn_s_barrier();
}
DEV void idx_phase(LAS unsigned char* lds, unsigned char* ws, unsigned* qhead, int wid, int lane) {
    constexpr unsigned NUNIT = T / 4;
    const bf16_t* IQ = (const bf16_t*)(ws + WS_IQ); const bf16_t* IK = (const bf16_t*)(ws + WS_IK); const float* IW = (const float*)(ws + WS_IW);
    LAS unsigned* QW = (LAS unsigned*)(lds + IDX_CTL_OFF + 32);
    if (wid == 0 && lane == 0) QW[0] = __hip_atomic_fetch_add(qhead, 1u, __ATOMIC_RELAXED, __HIP_MEMORY_SCOPE_AGENT);
    LDS_WAIT(); __builtin_amdgcn_s_barrier(); asm volatile("" ::: "memory");
    unsigned tk = QW[0];
    bf16x8 afr[4], b0[4], b1[4]; float w[16];
    if (tk < NUNIT) { int b, t0; idx_ticket(tk, b, t0); idx_prefetch(afr, w, b0, b1, IQ, IK, IW, b, t0, wid, lane); }
#pragma unroll 1
    for (int k = 0; tk < NUNIT; ++k) {
        int b, t0; idx_ticket(tk, b, t0); unsigned ntk = NUNIT;
        idx_unit(lds, IQ, IK, IW, (unsigned*)(ws + WS_BM), b, t0, qhead, k & 1, ntk, wid, lane, afr, w, b0, b1);
        tk = ntk;
    }
}

DEV void kn_phase(const WaveId& W, const bf16_t* Kk, float* KN) {
    for (int item = W.gw; item < NB * 8 * (S / 64); item += W.ngw) {
        const int b = item / (8 * (S / 64)), h = (item / (S / 64)) & 7, tile = item % (S / 64);
        const bf16_t* kp = Kk + ((size_t)b * S + tile * 64 + W.lane) * 512 + h * 64;
        float ss = 0.f;
#pragma unroll
        for (int c = 0; c < 8; ++c) { const u32x4 v = *(const u32x4*)(kp + 8 * c);
#pragma unroll
            for (int e = 0; e < 4; ++e) { const float lo = __uint_as_float(v[e] << 16), hi = __uint_as_float(v[e] & 0xffff0000u); ss += lo * lo + hi * hi; } }
        const float m = wave_max(ss);
        if (W.lane == 0) KN[item] = sqrtf(m) * 1.01f;
    }
}
#include <hip/hip_bf16.h>
namespace attn_body {
using bf16=__hip_bfloat16;
using bf16x8=__attribute__((ext_vector_type(8)))short;
using s16x4=__attribute__((ext_vector_type(4)))short;
using f32x16=__attribute__((ext_vector_type(16)))float;
using u32x4=__attribute__((ext_vector_type(4)))unsigned;
constexpr int BATCH=2,NHEAD=8,SEQ=8192,D=64,DM=NHEAD*D;
constexpr int NW=8,QBLK=32,QB=QBLK*NW,KVBLK=64,NQB=SEQ/QB;
constexpr int ATTN_PITCH=DM, ATTN_UNIT_ROWS=QB;
__device__ __forceinline__ int crow(int r,int hi){return (r&3)+8*(r>>2)+4*hi;}
#define SBAR() __builtin_amdgcn_sched_barrier(0)
__device__ __forceinline__ void cmask(f32x16&p0,f32x16&p1,int jb,int qrel,int hi){
  const float NEG=-INFINITY; int kb=64*jb+4*hi;
  #pragma unroll
  for(int r=0;r<16;++r){int kv=kb+(r&3)+8*(r>>2); if(kv>qrel)p0[r]=NEG; if(kv+32>qrel)p1[r]=NEG;}
}

constexpr int NSLOT=3, SLOTB=8192;
constexpr int LDS_K=0, LDS_V=NSLOT*SLOTB, LDS_WS=2*NSLOT*SLOTB, LDS_OST=LDS_WS+NW*64*4, LDS_BYTES=LDS_OST+NW*4096;
constexpr float C2=0.125f*1.4426950408889634f;
__device__ __forceinline__ void glds16(const void*gsrc,unsigned lds_dst){unsigned keep;
  asm volatile("s_mov_b32 %0, m0\n\ts_mov_b32 m0, %2\n\ts_nop 0\n\tglobal_load_lds_dwordx4 %1, off\n\ts_mov_b32 m0, %0":"=&s"(keep):"v"(gsrc),"s"(lds_dst):"memory");}
__device__ __forceinline__ float max3f(float a,float b,float c){float r;asm("v_max3_f32 %0, %1, %2, %3":"=v"(r):"v"(a),"v"(b),"v"(c));return r;}
__device__ __forceinline__ float max2f(float a,float b){float r;asm("v_max_f32_e32 %0, %1, %2":"=v"(r):"v"(a),"v"(b));return r;}
__device__ __forceinline__ float fadd_s(float a,float b){float r;asm("v_add_f32_e32 %0, %1, %2":"=v"(r):"v"(a),"v"(b));return r;}
__device__ __forceinline__ float fsub_s(float a,float b){float r;asm("v_sub_f32_e32 %0, %1, %2":"=v"(r):"v"(a),"v"(b));return r;}
typedef float f32x2_t __attribute__((ext_vector_type(2))); typedef __bf16 bf16x2_t __attribute__((ext_vector_type(2)));
__device__ __forceinline__ unsigned cvtpk_s(float lo,float hi){f32x2_t v={lo,hi};bf16x2_t b=__builtin_convertvector(v,bf16x2_t);return __builtin_bit_cast(unsigned,b);}
#define WAIT_BAR(N) asm volatile("s_waitcnt vmcnt(" #N ") lgkmcnt(0)\n\ts_barrier":::"memory")

__device__ __forceinline__ void qkt(f32x16&p0,f32x16&p1,const char*Kslot,const bf16x8*qr,const f32x16&negm,int r32,int hi){
  const char*kb=Kslot+hi*1024+r32*16;
  #pragma unroll
  for(int d0=0;d0<4;++d0){
    const bf16x8 b0=*reinterpret_cast<const bf16x8*>(kb+d0*2048);
    const bf16x8 b1=*reinterpret_cast<const bf16x8*>(kb+d0*2048+512);
    if(d0==0){p0=__builtin_amdgcn_mfma_f32_32x32x16_bf16(b0,qr[0],negm,0,0,0);p1=__builtin_amdgcn_mfma_f32_32x32x16_bf16(b1,qr[0],negm,0,0,0);}
    else{p0=__builtin_amdgcn_mfma_f32_32x32x16_bf16(b0,qr[d0],p0,0,0,0);p1=__builtin_amdgcn_mfma_f32_32x32x16_bf16(b1,qr[d0],p1,0,0,0);}}
}
typedef __attribute__((address_space(3))) const char* lds_cptr;
typedef short v4i16_t __attribute__((ext_vector_type(4)));
__device__ __forceinline__ void kload8(bf16x8*kf,lds_cptr kp){
  kf[0]=*(const __attribute__((address_space(3))) bf16x8*)(kp);      kf[1]=*(const __attribute__((address_space(3))) bf16x8*)(kp+512);
  kf[2]=*(const __attribute__((address_space(3))) bf16x8*)(kp+2048); kf[3]=*(const __attribute__((address_space(3))) bf16x8*)(kp+2560);
  kf[4]=*(const __attribute__((address_space(3))) bf16x8*)(kp+4096); kf[5]=*(const __attribute__((address_space(3))) bf16x8*)(kp+4608);
  kf[6]=*(const __attribute__((address_space(3))) bf16x8*)(kp+6144); kf[7]=*(const __attribute__((address_space(3))) bf16x8*)(kp+6656);
}
__device__ __forceinline__ void kload2(bf16x8*kf,lds_cptr kp,int j){ kf[2*j]=*(const __attribute__((address_space(3))) bf16x8*)(kp+j*2048); kf[2*j+1]=*(const __attribute__((address_space(3))) bf16x8*)(kp+j*2048+512); }
__device__ __forceinline__ s16x4 vtr(lds_cptr p){ return __builtin_bit_cast(s16x4,__builtin_amdgcn_ds_read_tr16_b64_v4i16((__attribute__((address_space(3))) v4i16_t*)p)); }
__device__ __forceinline__ float rowmax(const f32x16&p0,const f32x16&p1){
  float a=max3f(p0[0],p0[1],p1[0]),b=max3f(p0[2],p0[3],p1[1]);a=max3f(a,p1[2],p1[3]);
  #pragma unroll
  for(int r=4;r<16;r+=4){a=max3f(a,p0[r],p0[r+1]);b=max3f(b,p0[r+2],p0[r+3]);a=max3f(a,p1[r],p1[r+1]);b=max3f(b,p1[r+2],p1[r+3]);}
  const float m=max2f(a,b);
  auto rr=__builtin_amdgcn_permlane32_swap(__float_as_uint(m),__float_as_uint(m),false,false);
  return max2f(__uint_as_float(rr[0]),__uint_as_float(rr[1]));
}
__device__ __forceinline__ void pv(f32x16*o,int vb,bf16x8 pa0,bf16x8 pa1,bf16x8 pa2,bf16x8 pa3){
  #pragma unroll
  for(int d0=0;d0<2;++d0){s16x4 lo[4],hi[4];
    #pragma unroll
    for(int ks=0;ks<4;++ks){
      asm volatile("ds_read_b64_tr_b16 %0,%1 offset:%c2":"=&v"(lo[ks]):"v"(vb),"i"(d0*4096+ks*1024):"memory");
      asm volatile("ds_read_b64_tr_b16 %0,%1 offset:%c2":"=&v"(hi[ks]):"v"(vb),"i"(d0*4096+ks*1024+512):"memory");}
    asm volatile("s_waitcnt lgkmcnt(0)":::"memory");SBAR();
    #define PK(k) (bf16x8){lo[k][0],lo[k][1],lo[k][2],lo[k][3],hi[k][0],hi[k][1],hi[k][2],hi[k][3]}
    o[d0]=__builtin_amdgcn_mfma_f32_32x32x16_bf16(pa0,PK(0),o[d0],0,0,0);
    o[d0]=__builtin_amdgcn_mfma_f32_32x32x16_bf16(pa1,PK(1),o[d0],0,0,0);
    o[d0]=__builtin_amdgcn_mfma_f32_32x32x16_bf16(pa2,PK(2),o[d0],0,0,0);
    o[d0]=__builtin_amdgcn_mfma_f32_32x32x16_bf16(pa3,PK(3),o[d0],0,0,0);
    #undef PK
  }
}

#ifndef ATTN_STORE16
#define ATTN_STORE16(p,v) (*(u32x4*)(p)=(v))
#endif
template<int THRL> __device__ __forceinline__ void attn_unit(int b,int h,int qb,const bf16*Q,const bf16*__restrict__ K,const bf16*__restrict__ V,bf16*O,char*shm,const unsigned*__restrict__ BMb,const float*KNbh,const int tid){
  const int lane=tid&63,r32=lane&31,hi=lane>>5; const int wid=__builtin_amdgcn_readfirstlane(tid>>6);
  const long rowbase=(long)b*SEQ; const int q0=qb*QB;
  const bf16*Qw=Q+(rowbase+q0+wid*QBLK)*DM+h*D;
  const bf16*Kh=K+rowbase*DM+h*D,*Vh=V+rowbase*DM+h*D;
  const unsigned lds0=(unsigned)(uintptr_t)shm;
  float*wsf=(float*)(shm+LDS_WS)+wid*64;
  const bf16*ksrc=Kh+(long)lane*DM+wid*8;
  const bf16*vsrc=Vh+(long)(16*(wid&3)+(lane>>2))*DM+(wid>>2)*32+(lane&3)*8;
  const unsigned kdst=lds0+LDS_K+wid*1024, vdst=lds0+LDS_V+wid*1024;
  #define DMA_K(t,slot) glds16(ksrc+(long)(t)*KVBLK*DM,(unsigned)__builtin_amdgcn_readfirstlane(kdst+(slot)))
  #define DMA_V(t,slot) glds16(vsrc+(long)(t)*KVBLK*DM,(unsigned)__builtin_amdgcn_readfirstlane(vdst+(slot)))
  const int vb0=(int)(lds0+LDS_V)+((lane>>4)&1)*32+(lane&3)*8+(4*hi+((lane&15)>>2))*64;
  const char*Kbase=shm+LDS_K; bf16x8 kf[8];
  const lds_cptr shm3=(lds_cptr)shm; const lds_cptr kp0=shm3+LDS_K+hi*1024+r32*16; const lds_cptr vp0=shm3+LDS_V+((lane>>4)&1)*32+(lane&3)*8+(4*hi+((lane&15)>>2))*64;
  const int NT=(q0+QB)/KVBLK;
  DMA_K(0,0);DMA_V(0,0);DMA_K(1,SLOTB);
  bf16x8 qr[4];
  #pragma unroll
  for(int d0=0;d0<4;++d0)qr[d0]=*reinterpret_cast<const bf16x8*>(&Qw[(long)r32*DM+d0*16+hi*8]);
  const unsigned*bmp=BMb+(q0+wid*QBLK+r32);
  unsigned mwE0=bmp[0],mwE1=bmp[(size_t)SEQ],mwO0=0u,mwO1=0u;
  bool seen=false;
  float qn; { float qs=0.f;
    _Pragma("unroll") for(int d0=0;d0<4;++d0) _Pragma("unroll") for(int e=0;e<8;++e){ const float x=__uint_as_float(((unsigned)(unsigned short)qr[d0][e])<<16); qs+=x*x; }
    auto rr=__builtin_amdgcn_permlane32_swap(__float_as_uint(qs),__float_as_uint(qs),false,false); qn=__builtin_sqrtf(__uint_as_float(rr[0])+__uint_as_float(rr[1]))*1.01f; }
  constexpr float FASTB=60.f;
  int zlane=0; asm volatile("":"+v"(zlane));
  const float*knp=KNbh+zlane;
  float knE=knp[0],knO=0.f;
  bool anysel_=false;
  #define SLOWT(PS) (__any(!(qn*kn##PS<=FASTB)||mhat!=0.f))
  float mhat=0.f,l_reg=0.f;f32x16 o[2];o[0]=f32x16{};o[1]=f32x16{};const f32x16 zero16=f32x16{};
  const int qrel=wid*QBLK+r32;
  #define CMASK(P0,P1,SLOW,PS) do{ const unsigned m0_=mw##PS##0>>(4*hi), m1_=mw##PS##1>>(4*hi); anysel_=(mw##PS##0|mw##PS##1)!=0u; \
    if(SLOW){ _Pragma("unroll") for(int r=0;r<16;++r){ P0[r]-=mhat; P1[r]-=mhat; } } \
    _Pragma("unroll") for(int r=0;r<16;++r){ const int bit_=(r&3)+8*(r>>2); \
      const unsigned e0_=(unsigned)__builtin_amdgcn_sbfe((int)m0_,bit_,1), e1_=(unsigned)__builtin_amdgcn_sbfe((int)m1_,bit_,1); \
      P0[r]=__uint_as_float((__float_as_uint(P0[r])&e0_)|(0xff800000u&~e0_)); P1[r]=__uint_as_float((__float_as_uint(P1[r])&e1_)|(0xff800000u&~e1_)); } \
    }while(0)
  bool resc=false;
  #define START(P0,P1,SLOW) do{ resc=false; seen=anysel_; \
    if(SLOW){ const float rm=rowmax(P0,P1); const float dl=(rm==-INFINITY)?0.f:rm; mhat=fadd_s(mhat,dl); \
      _Pragma("unroll") for(int r=0;r<16;++r){P0[r]=fsub_s(P0[r],dl);P1[r]=fsub_s(P1[r],dl);} \
      } \
    _Pragma("unroll") for(int r=0;r<16;++r)P0[r]=__builtin_amdgcn_exp2f(P0[r]); }while(0)
  #define RESC() do{ if(resc){ asm volatile("s_waitcnt lgkmcnt(0)":::"memory"); \
      _Pragma("unroll") for(int d_=0;d_<2;++d_) _Pragma("unroll") for(int r=0;r<16;++r)o[d_][r]*=wsf[crow(r,hi)]; } }while(0)
  f32x16 pA0,pA1,pB0,pB1;
  int sl_prev=0,sl_cur=0,sl_next=SLOTB;
  #define ROT() do{sl_prev=sl_cur;sl_cur=sl_next;sl_next=(sl_next==(NSLOT-1)*SLOTB)?0:sl_next+SLOTB;}while(0)
  DMA_K(2,2*SLOTB);
  WAIT_BAR(3);
  { mwO0=bmp[(size_t)2*SEQ]; mwO1=bmp[(size_t)3*SEQ]; knO=knp[1];
  const bool slow0_=SLOWT(E);
  qkt(pA0,pA1,Kbase,qr,zero16,r32,hi);asm volatile("s_nop 15\n\ts_nop 7":"+v"(pA0),"+v"(pA1));CMASK(pA0,pA1,slow0_,E);
  START(pA0,pA1,slow0_); }
  _Pragma("unroll") for(int r=0;r<16;++r)pA1[r]=__builtin_amdgcn_exp2f(pA1[r]);
  WAIT_BAR(0);
  DMA_K(3,0);DMA_V(1,SLOTB);
  ROT();
  kload8(kf,kp0+sl_cur);
  WAIT_BAR(2);
  s16x4 vlo[8],vhi[8]; u32x4 pw0,pw1,pw2,pw3;
  #define PKW(P,B) cvtpk_s(P[B],P[B+1])
  #define PAF(k) __builtin_bit_cast(bf16x8,pw##k)
  #define VFR(i) (bf16x8){vlo[i][0],vlo[i][1],vlo[i][2],vlo[i][3],vhi[i][0],vhi[i][1],vhi[i][2],vhi[i][3]}
  #define PIN(x) asm volatile("":"+v"(x))
  #define MX3(a,b,c) __builtin_fmaxf(__builtin_fmaxf((a),(b)),(c))
  #define GAPA(MF,A0,A1,A2,A3,W0,W1,PW) do{ MF; sacc+=A0; sacc+=A1; sacc+=A2; sacc+=A3; PIN(sacc); W0; W1; PIN(PW); SBAR(); }while(0)
  #define EX(v) __builtin_amdgcn_exp2f(v)
  #define GAPB(MF,X,B) do{ MF; X[B]=EX(X[B]); X[B+1]=EX(X[B+1]); X[B+2]=EX(X[B+2]); X[B+3]=EX(X[B+3]); PIN(X); SBAR(); }while(0)
  #define VRD(i) do{ vlo[i]=vtr(vp_+(((i)>>2)*4096+((i)&3)*1024)); vhi[i]=vtr(vp_+(((i)>>2)*4096+((i)&3)*1024+512)); }while(0)
  #define KRD(G,j) do{ if(G){ kload2(kf,kp0+sl_next,j); SBAR(); } }while(0)
  #define STEP(C0,C1,P0,P1,t,GK,GV,GL,PS,NS) do{ SBAR(); \
    if((t)+1<NT){ mw##NS##0=bmp[(size_t)(2*(t)+2)*SEQ]; mw##NS##1=bmp[(size_t)(2*(t)+3)*SEQ]; kn##NS=knp[(t)+1]; }     \
    const lds_cptr vp_=vp0+sl_prev; \
    VRD(0); SBAR(); float sacc=(P0[0]+P0[1]); \
    GAPA(C0=__builtin_amdgcn_mfma_f32_32x32x16_bf16(kf[0],qr[0],zero16,0,0,0), P0[2],P0[3],P0[4],P0[5],     pw0[0]=PKW(P0,0), pw0[1]=PKW(P0,2), pw0); \
    VRD(4); SBAR(); GAPA(C1=__builtin_amdgcn_mfma_f32_32x32x16_bf16(kf[1],qr[0],zero16,0,0,0), P0[6],P0[7],P0[8],P0[9],     pw0[2]=PKW(P0,4), pw0[3]=PKW(P0,6), pw0); \
    VRD(1); SBAR(); GAPA(C0=__builtin_amdgcn_mfma_f32_32x32x16_bf16(kf[2],qr[1],C0,0,0,0),   P0[10],P0[11],P0[12],P0[13], pw1[0]=PKW(P0,8), pw1[1]=PKW(P0,10), pw1); \
    VRD(5); SBAR(); GAPA(C1=__builtin_amdgcn_mfma_f32_32x32x16_bf16(kf[3],qr[1],C1,0,0,0),   P0[14],P0[15],P1[0],P1[1],   pw1[2]=PKW(P0,12),pw1[3]=PKW(P0,14), pw1); \
    VRD(2); SBAR(); GAPA(C0=__builtin_amdgcn_mfma_f32_32x32x16_bf16(kf[4],qr[2],C0,0,0,0),   P1[2],P1[3],P1[4],P1[5],     pw2[0]=PKW(P1,0), pw2[1]=PKW(P1,2), pw2); \
    VRD(6); SBAR(); GAPA(C1=__builtin_amdgcn_mfma_f32_32x32x16_bf16(kf[5],qr[2],C1,0,0,0),   P1[6],P1[7],P1[8],P1[9],     pw2[2]=PKW(P1,4), pw2[3]=PKW(P1,6), pw2); \
    VRD(3); SBAR(); GAPA(C0=__builtin_amdgcn_mfma_f32_32x32x16_bf16(kf[6],qr[3],C0,0,0,0),   P1[10],P1[11],P1[12],P1[13], pw3[0]=PKW(P1,8), pw3[1]=PKW(P1,10), pw3); \
    VRD(7); SBAR(); GAPA(C1=__builtin_amdgcn_mfma_f32_32x32x16_bf16(kf[7],qr[3],C1,0,0,0),   P1[14],P1[15],0.f,0.f,       pw3[2]=PKW(P1,12),pw3[3]=PKW(P1,14), pw3); \
    l_reg+=sacc; \
    if(GK){DMA_K((t)+3,sl_cur);} if(GV){DMA_V((t)+1,sl_next);} \
    const bool slow_=SLOWT(PS); CMASK(C0,C1,slow_,PS); resc=false; \
    if(__builtin_expect(slow_,0)){ float a=MX3(C0[0],C0[1],C1[0]),b=MX3(C0[2],C0[3],C1[1]); a=MX3(a,C1[2],C1[3]); \
      _Pragma("unroll") for(int r=4;r<16;r+=4){a=MX3(a,C0[r],C0[r+1]);b=MX3(b,C0[r+2],C0[r+3]);a=MX3(a,C1[r],C1[r+1]);b=MX3(b,C1[r+2],C1[r+3]);} \
      float rm=__builtin_fmaxf(a,b); { auto rr=__builtin_amdgcn_permlane32_swap(__float_as_uint(rm),__float_as_uint(rm),false,false); rm=__builtin_fmaxf(__uint_as_float(rr[0]),__uint_as_float(rr[1])); } \
      const bool fresh_=!seen&&rm>-INFINITY;     \
      if(__builtin_expect(__any(rm>(float)THRL||(fresh_&&rm<-(float)THRL)),0)){ const float dl=fresh_?rm:__builtin_fmaxf(rm,0.f); mhat+=dl; \
        _Pragma("unroll") for(int r=0;r<16;++r){C0[r]-=dl;C1[r]-=dl;} \
        const float f=dl>0.f?__builtin_amdgcn_exp2f(-dl):1.f; l_reg*=f; if(hi==0)wsf[r32]=f; resc=true; } } \
    seen=seen||anysel_; \
    SBAR(); \
    GAPB(o[0]=__builtin_amdgcn_mfma_f32_32x32x16_bf16(PAF(0),VFR(0),o[0],0,0,0), C0,0); \
    GAPB(o[1]=__builtin_amdgcn_mfma_f32_32x32x16_bf16(PAF(0),VFR(4),o[1],0,0,0), C0,4); \
    KRD(GL,0); GAPB(o[0]=__builtin_amdgcn_mfma_f32_32x32x16_bf16(PAF(1),VFR(1),o[0],0,0,0), C0,8); \
    KRD(GL,1); GAPB(o[1]=__builtin_amdgcn_mfma_f32_32x32x16_bf16(PAF(1),VFR(5),o[1],0,0,0), C0,12); \
    KRD(GL,2); GAPB(o[0]=__builtin_amdgcn_mfma_f32_32x32x16_bf16(PAF(2),VFR(2),o[0],0,0,0), C1,0); \
    KRD(GL,3); GAPB(o[1]=__builtin_amdgcn_mfma_f32_32x32x16_bf16(PAF(2),VFR(6),o[1],0,0,0), C1,4); \
    GAPB(o[0]=__builtin_amdgcn_mfma_f32_32x32x16_bf16(PAF(3),VFR(3),o[0],0,0,0), C1,8); \
    GAPB(o[1]=__builtin_amdgcn_mfma_f32_32x32x16_bf16(PAF(3),VFR(7),o[1],0,0,0), C1,12); \
    }while(0)
  int t=1;
  for(;t+5<NT;t+=2){
    STEP(pB0,pB1,pA0,pA1,t,true,true,true,O,E);     WAIT_BAR(2); RESC(); ROT();
    STEP(pA0,pA1,pB0,pB1,t+1,true,true,true,E,O);   WAIT_BAR(2); RESC(); ROT();
  }
  #define ENDW(tt) do{ if((tt)+3<NT){WAIT_BAR(2);} else if((tt)+2<NT){WAIT_BAR(1);} else {WAIT_BAR(0);} }while(0)
  for(;t+1<NT;t+=2){
    STEP(pB0,pB1,pA0,pA1,t,(t+3<NT),(t+1<NT),(t+1<NT),O,E);       ENDW(t);   RESC(); ROT();
    STEP(pA0,pA1,pB0,pB1,t+1,(t+4<NT),(t+2<NT),(t+2<NT),E,O);     ENDW(t+1); RESC(); ROT();
  }
  STEP(pB0,pB1,pA0,pA1,NT-1,false,false,false,O,E); RESC();
  { float sacc=pB0[0]+pB0[1]; _Pragma("unroll") for(int r=2;r<16;++r)sacc+=pB0[r]; _Pragma("unroll") for(int r=0;r<16;++r)sacc+=pB1[r]; l_reg+=sacc;
    pw0=(u32x4){PKW(pB0,0),PKW(pB0,2),PKW(pB0,4),PKW(pB0,6)};pw1=(u32x4){PKW(pB0,8),PKW(pB0,10),PKW(pB0,12),PKW(pB0,14)};pw2=(u32x4){PKW(pB1,0),PKW(pB1,2),PKW(pB1,4),PKW(pB1,6)};pw3=(u32x4){PKW(pB1,8),PKW(pB1,10),PKW(pB1,12),PKW(pB1,14)};
    SBAR(); pv(o,vb0+sl_cur,PAF(0),PAF(1),PAF(2),PAF(3)); }
  #undef PKW
  #undef PAF
  #undef VFR
  #undef PIN
  #undef MX3
  #undef GAPA
  #undef GAPB
  #undef EX
  #undef VRD
  #undef KRD
  #undef STEP
  #undef ENDW
  {auto rr=__builtin_amdgcn_permlane32_swap(__float_as_uint(l_reg),__float_as_uint(l_reg),false,false);l_reg=__uint_as_float(rr[0])+__uint_as_float(rr[1]);}
  if(hi==0)wsf[32+r32]=l_reg;asm volatile("s_waitcnt lgkmcnt(0)":::"memory");
  float rli[16];
  #pragma unroll
  for(int r=0;r<16;++r)rli[r]=__builtin_amdgcn_rcpf(wsf[32+crow(r,hi)]);
  bf16*Ow=O+(rowbase+q0+wid*QBLK)*DM+h*D;
  { bf16*stg=(bf16*)(shm+LDS_OST)+wid*2048;
    #pragma unroll
    for(int r=0;r<16;++r){const int orow=crow(r,hi);
      #pragma unroll
      for(int d0=0;d0<2;++d0)stg[orow*64+d0*32+r32]=__float2bfloat16(o[d0][r]*rli[r]);}
    asm volatile("s_waitcnt lgkmcnt(0)":::"memory");
    #pragma unroll
    for(int i=0;i<4;++i){const int row=i*8+(lane>>3),ch=lane&7; const u32x4 v=*(const u32x4*)(stg+row*64+ch*8); ATTN_STORE16(Ow+(long)row*DM+ch*8,v);} }
  asm volatile("s_waitcnt lgkmcnt(0)\n\ts_barrier":::"memory");
  #undef DMA_K
  #undef DMA_V
  #undef CMASK
  #undef SLOWT
  #undef START
  #undef RESC
  #undef ROT
}
constexpr int ATTN_LDS_BYTES=LDS_BYTES;
#undef SBAR
#undef WAIT_BAR
}
constexpr int MK_THREADS = 512;
constexpr int RING_BYTES = 131072, MISC_OFF = RING_BYTES + 320, MK_LDS_BYTES = 147456;
constexpr size_t WS_CTL = 0, CTL_ZERO_BYTES = 65536; constexpr int CW_BAR = 4096;
constexpr int PH_PREP0 = 0, PH_L0 = 1, PH_PER_LAYER = 14, NPH = PH_L0 + 2 * PH_PER_LAYER;
enum { Q_INPROJ = 0, Q_SBIDX, Q_DSA, Q_GATES, Q_MERGE, Q_MIX, Q_NORMXA, Q_XALOG, Q_XAOUT, Q_NORMFFN, Q_UP, Q_FFNMID, Q_DOWN, Q_NEXT };

#ifndef QBUILD
#define QBUILD 0xffffu
#endif
#define QON(x) ((QBUILD >> (x)) & 1u)
struct Args { const float* in[20]; float* out; unsigned char* ws; int ph_lo, ph_hi; };

__global__ void __launch_bounds__(MK_THREADS, 2) mk_fwd(Args args) {
    __shared__ __attribute__((aligned(16))) unsigned char lds_raw[MK_LDS_BYTES];
    LAS unsigned char* lds = (LAS unsigned char*)lds_raw;
    volatile LAS unsigned* MISC = (volatile LAS unsigned*)(lds + MISC_OFF);
    const int G = gridDim.x, bx = blockIdx.x;
    unsigned char* ws0 = args.ws;
    const int wave_s = __builtin_amdgcn_readfirstlane((int)threadIdx.x >> 6);
    for (int u = mk_tid(wave_s); u < (MK_LDS_BYTES - RING_BYTES) / 4; u += MK_THREADS) ((LAS unsigned*)(lds + RING_BYTES))[u] = 0u;
    __syncthreads();
    const int lo = args.ph_lo, hi = args.ph_hi;
    XcdBarrier bar; bar.bar = (unsigned*)(ws0 + WS_CTL) + CW_BAR; bar.x = 0; bar.st = nullptr;
    if (hi - lo > 1) bar = xcd_barrier_post((unsigned*)(ws0 + WS_CTL) + CW_BAR, MISC + 8, mk_tid(wave_s));
#define BPW(off) ((bf16_t*)(ws + (off)))
    const int vcu = (G % 8 == 0) ? (bx % 8) * (G / 8) + bx / 8 : bx;
    bool use_local = false;
    for (int p = lo; p < hi; ++p) {
#ifdef PROBE_REP
        const int reps = (p >= PH_L0 && ((PROBE_REP >> ((p - PH_L0) % PH_PER_LAYER)) & 1)) ? 2 : 1;
#else
        const int reps = 1;
#endif
#ifdef PROBE_REP
#pragma unroll 1
        for (int rep = 0; rep < reps; ++rep) {
        const bool dry = rep + 1 < reps;
#else
        { constexpr bool dry = false;
#endif
        int oz = 0; asm volatile("" : "+s"(oz));
        int tid = mk_tid(wave_s); asm volatile("" : "+v"(tid));
        const int wave = __builtin_amdgcn_readfirstlane(tid >> 6), lane = tid & 63;
        WaveId W; W.gw = vcu * 8 + wave; W.ngw = G * 8; W.wave = wave; W.lane = lane;
        unsigned char* ws = args.ws + oz; float* X = args.out + oz;
#define INP(k) (args.in[(k) + oz])
        if (p == PH_PREP0) {
            prep0_phase(W, (LAS float*)(lds + wave * 16384), ws, args.in + oz, (bf16_t*)X);
        } else if (p >= PH_L0) {
            const int l = (p - PH_L0) / PH_PER_LAYER, q = (p - PH_L0) % PH_PER_LAYER;
            const float* Xin = l == 0 ? INP(0) : X;
            pg8::u64* SSb = (pg8::u64*)(ws + WS_SS);
#define SSA(i) (SSb + (size_t)(i) * T)
            if (q == Q_SBIDX) {
                sb_phase(W, lds, ws, dry);
                conv_sc_phase(vcu * MK_THREADS + tid, G * MK_THREADS, BPW(WS_SCB), BPW(WS_CX), INP(4) + l * 3 * 512, dry);
                kn_phase(W, BPW(WS_KC), (float*)(ws + WS_KN));
                if (l == 0 && !dry && QON(15)) {
                    __syncthreads();
                    { pg8::Order S; S.init(1, 4, 16, G, bx); pg8::PtrG P{(const char*)(ws + WS_KVM), (const char*)(ws + WS_WQ)}; pg8::EpiPrep E{ws, 1};
                      pg8::gemm_phase<pg8::EpiPrep, pg8::PtrG, true, true>(lds, tid, 2 * D, D, 256, S, P, E); }
                    { pg8::Order S; S.init(4, 1, 16, G, (bx + 64) % G); pg8::PtrH P{(const char*)(ws + WS_KVM), (const char*)(ws + WS_WOT)}; pg8::EpiPrep E{ws, 2};
                      pg8::gemm_phase<pg8::EpiPrep, pg8::PtrH, true, true>(lds, tid, D, 2 * D, 256, S, P, E); }
                }
                __syncthreads();
                idx_phase(lds, ws, (unsigned*)(ws + WS_CTL) + 1024 + 64 * l, wave, lane);
            } else if (q == Q_DSA) {
#ifndef NO_DSA
                {
                    for (int pr = vcu; pr < NB * 8 * 16; pr += G) { const int bh = pr >> 4, sx = pr & 15, bb = bh >> 3, hh = bh & 7;
#pragma unroll 1
                        for (int k2 = 0; k2 < 2; ++k2)
                            attn_body::attn_unit<8>(bb, hh, k2 == 0 ? sx : 31 - sx, (const attn_body::bf16*)BPW(WS_QC), (const attn_body::bf16*)BPW(WS_KC), (const attn_body::bf16*)BPW(WS_VC),
                                                    (attn_body::bf16*)(dry ? BPW(WS_KA) : BPW(WS_QC)), (char*)lds_raw, (const unsigned*)(ws + WS_BM) + (size_t)bb * 256 * S,
                                                    (const float*)(ws + WS_KN) + bh * (S / 64), tid); }
                }
#endif
            } else if (q == Q_FFNMID) {
            } else if (q == Q_NEXT) {
                if (l + 1 == DEPTH && !dry) final_norm(W, BPW(WS_XN), X, INP(19), SSA(6));
            } else if (q == Q_INPROJ && QON(Q_INPROJ)) {
                pg8::Order S; S.init(T / 256, NIN / 256, 1, G, bx);
                pg8::PtrStd P{(const char*)X, (const char*)(ws + WS_WIN), 0, 0, 0, (size_t)256 * D * 2, (size_t)256 * D * 2};
                if (l > 0 && !dry) { int base = 0; convert_layer_weights(W, (LAS float*)(lds + wave * 16384), base, ws, args.in + oz, l, 4); __syncthreads(); }
                pg8::EpiInProj E{ws, SSA(3 * l)};
                pg8::gemm_phase<pg8::EpiInProj, pg8::PtrStd, true, true>(lds, tid, D, D, D, S, P, E);
                if (l == 0 && !dry && QON(14)) {
                    pg8::Order S2; S2.init(2, 8, 2, G, (bx + G - 64) % G);
                    pg8::PtrStd P2{(const char*)(ws + WS_MEMN), (const char*)(ws + WS_WKVT), 1 * MiB, 4 * MiB, 0, (size_t)256 * D * 2, (size_t)256 * D * 2};
                    pg8::EpiPrep E2{ws, 0};
                    pg8::gemm_phase<pg8::EpiPrep, pg8::PtrStd, true, true>(lds, tid, D, D, D, S2, P2, E2);
                }
            } else if (q == Q_GATES && QON(Q_GATES)) {
                pg8::Order S; S.init(T / 256, 12, 1, G, bx);
                pg8::PtrStd P{(const char*)X, (const char*)(ws + WS_WG), 0, 0, 0, (size_t)256 * D * 2, (size_t)256 * D * 2};
                pg8::EpiGates E{BPW(WS_GATES), SSA(3 * l)};
                pg8::gemm_phase<pg8::EpiGates, pg8::PtrStd, true, true>(lds, tid, D, D, D, S, P, E);
            } else if (q == Q_MERGE && QON(Q_MERGE)) {
                pg8::Order S; S.init(T / 256, 4, 3, G, bx);
                pg8::PtrStd P{(const char*)(ws + WS_QA), (const char*)(ws + WS_WBR), 16 * MiB, (size_t)D * 512 * 2, 0, (size_t)256 * 512 * 2, (size_t)256 * 512 * 2};
                pg8::EpiMergeC E{BPW(WS_XN), BPW(WS_GATES)};
                pg8::gemm_phase<pg8::EpiMergeC, pg8::PtrStd, true, true>(lds, tid, 512, 512, 512, S, P, E);
            } else if (q == Q_MIX && QON(Q_MIX)) {
                pg8::Order S; S.init(T / 256, 4, 1, G, bx);
                pg8::PtrStd P{(const char*)(ws + WS_XN), (const char*)(ws + WS_WMIX), 0, 0, 0, (size_t)256 * D * 2, (size_t)256 * D * 2};
                if (l == 0) { pg8::EpiResid<true> E{(const void*)INP(0), dry ? BPW(WS_FU) : BPW(WS_XBXA), dry ? SSA(0) : SSA(1)};
                    pg8::gemm_phase<pg8::EpiResid<true>, pg8::PtrStd, true, true>(lds, tid, D, D, D, S, P, E); }
                else { pg8::EpiResid<false> E{(const void*)X, dry ? BPW(WS_FU) : BPW(WS_XBXA), dry ? SSA(0) : SSA(4)};
                    pg8::gemm_phase<pg8::EpiResid<false>, pg8::PtrStd, true, true>(lds, tid, D, D, D, S, P, E); }

            } else if (q == Q_XALOG && QON(Q_XALOG)) {
                pg8::Order S; S.init(T / 256, 4, 1, G, bx);
                pg8::PtrStd P{(const char*)(ws + WS_XBXA), (const char*)(ws + WS_GT + (size_t)l * 4 * MiB), 0, 0, 2 * MiB, (size_t)256 * D * 2, (size_t)256 * D * 2};
                pg8::EpiSoftmax E{BPW(WS_PXA), SSA(1 + 3 * l)};
                pg8::gemm_phase<pg8::EpiSoftmax, pg8::PtrStd, false, true>(lds, tid, D, D, D, S, P, E);
            } else if (q == Q_XAOUT && QON(Q_XAOUT)) {
                pg8::Order S; S.init(T / 256, 4, 1, G, bx);
                pg8::PtrStd P{(const char*)(ws + WS_PXA), (const char*)(ws + WS_HT + (size_t)l * 4 * MiB), 0, 0, 2 * MiB, (size_t)256 * D * 2, (size_t)256 * D * 2};
                pg8::EpiResid<false> E{(const void*)BPW(WS_XBXA), dry ? BPW(WS_FU) : BPW(WS_XN), dry ? SSA(0) : SSA(2 + 3 * l)};
                pg8::gemm_phase<pg8::EpiResid<false>, pg8::PtrStd, true, true>(lds, tid, D, D, D, S, P, E);
            } else if (q == Q_UP && QON(Q_UP)) {
                pg8::Order S; S.init(T / 256, 22, 1, G, bx);
                pg8::PtrStd P{(const char*)(ws + WS_XN), (const char*)(ws + WS_WUP), 0, 0, 0, (size_t)256 * D * 2, (size_t)256 * D * 2};
                pg8::EpiUpF E{BPW(WS_FU), BPW(WS_SIDEA), BPW(WS_SIDEU), SSA(2 + 3 * l), INP(16) + l * 3 * DFF, INP(17) + l * DFF};
                pg8::gemm_phase<pg8::EpiUpF, pg8::PtrStd, true, true>(lds, tid, D, D, D, S, P, E);
            } else if (q == Q_DOWN && QON(Q_DOWN)) {
                pg8::Order S; S.init(T / 256, 4, 1, G, bx);
                if (!dry) {
#pragma unroll 1
                    for (int i = 0; ; ++i) { pg8::Unit u0; if (!S.next(i, u0)) break; ffn_fix_phase(tid, MK_THREADS, BPW(WS_SIDEA), BPW(WS_SIDEU), BPW(WS_FU), INP(16) + l * 3 * DFF, INP(17) + l * DFF, 4 * u0.pm, 4); }
                    asm volatile("s_waitcnt vmcnt(0)" ::: "memory"); __syncthreads();
                }
                pg8::PtrStd P{(const char*)(ws + WS_FU), (const char*)(ws + WS_WDOWN), 0, 0, 0, (size_t)256 * DFF * 2, (size_t)256 * DFF * 2};
                pg8::EpiResid<false> E{(const void*)BPW(WS_XN), dry ? BPW(WS_QA) : (l + 1 < DEPTH ? (bf16_t*)X : BPW(WS_XN)), dry ? SSA(0) : SSA(3 + 3 * l)};
                pg8::gemm_phase<pg8::EpiResid<false>, pg8::PtrStd, true, true>(lds, tid, DFF, DFF, DFF, S, P, E);
                if (l + 1 < DEPTH && !dry) {
                    __syncthreads(); int base = 0; convert_layer_weights(W, (LAS float*)(lds + wave * 16384), base, ws, args.in + oz, l + 1, 3); }
            }
        }
        }
        if (p + 1 < hi && !(p >= PH_L0 && ((p - PH_L0) % PH_PER_LAYER == Q_NORMXA || (p - PH_L0) % PH_PER_LAYER == Q_NORMFFN || (p - PH_L0) % PH_PER_LAYER == Q_FFNMID || ((p - PH_L0) % PH_PER_LAYER == Q_NEXT && (p - PH_L0) / PH_PER_LAYER + 1 < DEPTH)))) {
            const int qq = p >= PH_L0 ? (p - PH_L0) % PH_PER_LAYER : -1;
            const bool chain = qq == Q_GATES || qq == Q_MERGE || qq == Q_MIX || qq == Q_XALOG || qq == Q_XAOUT;
            if (chain && use_local) xcd_barrier_local(bar, mk_tid(wave_s)); else xcd_barrier(bar, mk_tid(wave_s));
            if (p == lo) {
                if (mk_tid(wave_s) == 0 && (bar.x != (unsigned)(bx & 7) || bar.st[0] != (unsigned)(G >> 3) || bar.st[1] != 8u || (G & 7))) (void)xb_add(&bar.bar[XB_BADMAP], 1u);
            } else if (p == lo + 1) {
                if (mk_tid(wave_s) == 0) MISC[12] = xb_ld(&bar.bar[XB_BADMAP]);
                __syncthreads(); use_local = MISC[12] == 0u;
            }
        }
    }
}

extern "C" void kernel_launch(void* const* d_in, const int* in_sizes, int n_in, void* d_out, int out_size, void* d_ws, size_t ws_size, hipStream_t st) {
    if (n_in != 20 || ws_size < WS_NEED || out_size != T * D) { fprintf(stderr, "kernel_launch: unexpected sizes n_in %d ws %zu out %d\n", n_in, ws_size, out_size); return; }
    static int grid = 0;
    if (grid == 0) {
        int dev = 0, cus = 0, per_cu = 0;
        (void)hipGetDevice(&dev); (void)hipDeviceGetAttribute(&cus, hipDeviceAttributeMultiprocessorCount, dev);
        if (hipOccupancyMaxActiveBlocksPerMultiprocessor(&per_cu, (const void*)mk_fwd, MK_THREADS, 0) != hipSuccess || per_cu < 1) { fprintf(stderr, "kernel_launch: occupancy query says %d blocks/CU\n", per_cu); grid = -1; return; }
        (void)hipGetLastError();
        if (cus != 256) { fprintf(stderr, "kernel_launch: built for a 256-CU device, found %d\n", cus); grid = -1; return; }
        grid = cus;
    }
    if (grid < 0) return;
    (void)hipMemsetAsync((char*)d_ws + WS_CTL, 0, CTL_ZERO_BYTES, st);
    Args a{};
    for (int i = 0; i < 20; ++i) a.in[i] = (const float*)d_in[i];
    a.out = (float*)d_out; a.ws = (unsigned char*)d_ws; a.ph_lo = 0; a.ph_hi = NPH;
    hipLaunchKernelGGL(mk_fwd, dim3(grid), dim3(MK_THREADS), 0, st, a);
}
```

```cpp
#include <hip/hip_runtime.h>
#include <stdint.h>
#include <stdio.h>

typedef unsigned short bf16_t;
typedef short bf16x8 __attribute__((ext_vector_type(8)));
typedef float f32x16 __attribute__((ext_vector_type(16)));
typedef float f32x4 __attribute__((ext_vector_type(4)));
#define DEV __device__ __forceinline__

constexpr int NB = 2, S = 8192, D = 1024, T = NB * S, DEPTH = 2;
constexpr int DIN = 8264, DFF = 2816, MEM = 256;
constexpr int NIN = 5376;
constexpr float LOG2E = 1.4426950408889634f;
constexpr float QSCALE = 0.125f * LOG2E;
constexpr float WSCALE = 0.125f * 0.35355339059327373f;
constexpr float XSCALE = 0.0625f * LOG2E;
constexpr float EPS = 1e-6f;
#ifndef MK_FUSE
#define MK_FUSE 1
#endif

constexpr size_t MiB = 1u << 20;
constexpr size_t WS_SIDEA = 88 * MiB, WS_SIDEU = 96 * MiB;
constexpr size_t WS_KN = 983040;
constexpr size_t WS_GT = 1 * MiB;
constexpr size_t WS_HT = 9 * MiB;
constexpr size_t WS_WUP = 17 * MiB, WS_WDOWN = 28 * MiB;
constexpr size_t WS_XN = 34 * MiB;
constexpr size_t WS_WMIX = 66 * MiB, WS_WBR = 68 * MiB, WS_WG = 71 * MiB, WS_WIN = 77 * MiB;
constexpr size_t WS_QA = 88 * MiB, WS_SCB = 104 * MiB, WS_QC = 120 * MiB, WS_KA = 136 * MiB, WS_VA = 152 * MiB, WS_KC = 168 * MiB, WS_VC = 184 * MiB,
                 WS_IQ = 200 * MiB, WS_CX = 216 * MiB, WS_IK = 232 * MiB, WS_IW = 234 * MiB, WS_BM = 235 * MiB;
constexpr size_t WS_GATES = 136 * MiB;
constexpr size_t WS_XTMP = 235 * MiB;
constexpr size_t WS_LOG = 88 * MiB, WS_PXA = 168 * MiB;
constexpr size_t WS_XBXA = 136 * MiB;
constexpr size_t WS_SS = 65536;
constexpr size_t WS_FA = 66 * MiB, WS_FU = 154 * MiB;
constexpr size_t WS_WQ = 34 * MiB  , WS_WOT = 38 * MiB  , WS_WKVT = 42 * MiB  , WS_MEMN = 50 * MiB  , WS_KVM = 52 * MiB  ;
constexpr size_t WS_NEED = 256 * MiB;

DEV bf16_t f2bf(float f) { unsigned u = __float_as_uint(f); u += 0x7fffu + ((u >> 16) & 1u); return (bf16_t)(u >> 16); }
DEV float bf2f(bf16_t h) { return __uint_as_float(((unsigned)h) << 16); }
DEV float wave_sum(float v) {
#pragma unroll
    for (int o = 1; o < 64; o <<= 1) v += __shfl_xor(v, o);
    return v;
}
DEV float wave_max(float v) {
#pragma unroll
    for (int o = 1; o < 64; o <<= 1) v = fmaxf(v, __shfl_xor(v, o));
    return v;
}


#define LAS __attribute__((address_space(3)))
#define GAS __attribute__((address_space(1)))
typedef unsigned u32x4 __attribute__((ext_vector_type(4)));
typedef unsigned u32x2 __attribute__((ext_vector_type(2)));
typedef float f32x2 __attribute__((ext_vector_type(2)));
#define LDS_WAIT() asm volatile("s_waitcnt lgkmcnt(0)" ::: "memory")
DEV int mk_tid(int wave_s) { unsigned ones = ~0u; asm volatile("" : "+s"(ones)); return wave_s * 64 + (int)__builtin_amdgcn_mbcnt_hi(ones, __builtin_amdgcn_mbcnt_lo(ones, 0u)); }
#define VM_WAIT() asm volatile("s_waitcnt vmcnt(0)" ::: "memory")
typedef __bf16 bf16x2_t __attribute__((ext_vector_type(2)));
DEV unsigned cvt_pk_bf16(float lo, float hi) { const f32x2 v = {lo, hi}; return __builtin_bit_cast(unsigned, __builtin_convertvector(v, bf16x2_t)); }
DEV float bflo(unsigned w) { return __uint_as_float(w << 16); }
DEV float bfhi(unsigned w) { return __uint_as_float(w & 0xffff0000u); }

namespace pg8 {
constexpr int BM = 256, BK = 64, HALF = 128, HTB = HALF * BK * 2, STAGE_BYTES = 8 * HTB, NXCD = 8, WGM = 4;
__host__ __device__ __forceinline__ int lds_byte(int r, int c) { const int st = (r >> 4) * 2 + (c >> 5), rr = r & 15, cc = c & 31, ob = rr * 64 + cc * 2; return st * 1024 + (ob ^ (((ob >> 9) & 1) << 5)); }
__host__ __device__ __forceinline__ void stage_rc(int b, int& R, int& C) { const int st = b / 1024, sb = b % 1024, swz = sb ^ (((sb >> 9) & 1) << 5); R = (st >> 1) * 16 + swz / 64; C = (st & 1) * 32 + (swz % 64) / 2; }
__host__ __device__ __forceinline__ int perm32(int rho) { const int n = rho >> 4, i = rho & 15; return 8 * (i >> 2) + 4 * n + (i & 3); }

struct Unit { int pm, pn, job; };
struct Order {
    int nM, nN, nwg, ntot, G, c;
    DEV void init(int nM_, int nN_, int njob, int G_, int c_) { nM = nM_; nN = nN_; nwg = nM * nN; ntot = nwg * njob; G = G_; c = c_; }
    DEV bool next(int i, Unit& u) const {
        const int L = i * G + c; if (L >= ntot) return false;
        u.job = L / nwg; int wgid = L - u.job * nwg;
        { const int q = nwg / NXCD, r = nwg % NXCD, xcd = wgid % NXCD, off = wgid / NXCD; wgid = (xcd < r ? xcd * (q + 1) : r * (q + 1) + (xcd - r) * q) + off; }
        const int nig = WGM * nN, gid = wgid / nig, fm = gid * WGM, gsz = (nM - fm) < WGM ? (nM - fm) : WGM;
        u.pm = fm + ((wgid % nig) % gsz); u.pn = (wgid % nig) / gsz; return true;
    }
};
template <class T, class = void> struct epi_chain { static constexpr bool value = false; };
template <class T> struct epi_chain<T, decltype((void)T::CHAIN)> { static constexpr bool value = T::CHAIN; };
template <class Epi, class Ptr, bool ALIGN_EPI, bool SP2>
DEV void gemm_phase(LAS unsigned char* lds, const int tid_in, const int lda, const int ldb, const int K, const Order& S, const Ptr& P, const Epi& E) {
    int tid_ = tid_in; asm volatile("" : "+v"(tid_));
    const int tid = tid_, wid = __builtin_amdgcn_readfirstlane(tid >> 6), lane = tid & 63, wr = wid >> 2, wc = wid & 3, fr = lane & 15, fq = lane >> 4;
    const int nt = K / BK;
    unsigned voffA[2], voffB[2];
#pragma unroll
    for (int i = 0; i < 2; ++i) { int R, C; stage_rc(tid * 16 + i * 8192, R, C); const int Rb = Epi::PERM ? ((R & ~31) + perm32(R & 31)) : R;
        voffA[i] = (unsigned)(R * lda + C) * 2u; voffB[i] = (unsigned)(Rb * ldb + C) * 2u; }
    const size_t kstep = (size_t)(BK * 2);
    const size_t hstepA = (size_t)HALF * lda * 2, hstepB = (size_t)HALF * ldb * 2;
    const unsigned ldsw = (unsigned)wid * 1024u;
    const int aoff = lds_byte(wr * 64 + fr, fq * 8), boff = lds_byte(wc * 32 + fr, fq * 8);
#define PG8_SA(b, h) (((b) * 2 + (h)) * HTB)
#define PG8_SB(b, h) ((4 + (b) * 2 + (h)) * HTB)
#define PG8_STAGE(bufoff, gbase, voff) do { _Pragma("unroll") for (int _i = 0; _i < 2; ++_i) \
        __builtin_amdgcn_global_load_lds((const unsigned*)((const char*)(gbase) + (voff)[_i]), (LAS unsigned*)(lds + (bufoff) + ldsw + _i * 8192), 16, 0, 0); } while (0)
#define PG8_LDA(dst, b, h) do { _Pragma("unroll") for (int m = 0; m < 4; ++m) _Pragma("unroll") for (int k = 0; k < 2; ++k) dst[m][k] = *(const LAS bf16x8*)(lds + PG8_SA(b, h) + aoff + m * 2048 + k * 1024); } while (0)
#define PG8_LDB(dst, b, h) do { _Pragma("unroll") for (int n = 0; n < 2; ++n) _Pragma("unroll") for (int k = 0; k < 2; ++k) dst[n][k] = *(const LAS bf16x8*)(lds + PG8_SB(b, h) + boff + n * 2048 + k * 1024); } while (0)
#define PG8_MMA(ai, bj, At, Bt) do { __builtin_amdgcn_s_setprio(1); _Pragma("unroll") for (int m = 0; m < 4; ++m) _Pragma("unroll") for (int n = 0; n < 2; ++n) _Pragma("unroll") for (int k = 0; k < 2; ++k) \
        acc[ai][bj][m][n] = __builtin_amdgcn_mfma_f32_16x16x32_bf16(Bt[n][k], At[m][k], acc[ai][bj][m][n], 0, 0, 0); __builtin_amdgcn_s_setprio(0); } while (0)
#define PG8_WAIT_V(n) asm volatile("s_waitcnt vmcnt(" #n ")" ::: "memory")
#define PG8_WAIT_L(n) asm volatile("s_waitcnt lgkmcnt(" #n ")" ::: "memory")
#define PG8_BAR __builtin_amdgcn_s_barrier()
#define PG8_SCHED __builtin_amdgcn_sched_barrier(0)
    Unit cur, nxt; int ui = 0;
    if (!S.next(0, cur)) return;
    f32x4 acc[2][2][4][2];
#pragma unroll
    for (int a = 0; a < 2; ++a)
#pragma unroll
        for (int b = 0; b < 2; ++b)
#pragma unroll
            for (int m = 0; m < 4; ++m)
#pragma unroll
                for (int n = 0; n < 2; ++n) acc[a][b][m][n] = (f32x4){0.f, 0.f, 0.f, 0.f};
    bf16x8 At[4][2], B0[2][2], B1[2][2];
    const char* cA = P.a(cur); const char* cB = P.b(cur);
    typename Epi::Pre pre; E.prefetch(pre, cur, wr, fr);
    if constexpr (SP2) {
        PG8_STAGE(PG8_SB(0, 0), cB, voffB); PG8_STAGE(PG8_SB(0, 1), cB + hstepB, voffB); PG8_STAGE(PG8_SA(0, 0), cA, voffA); PG8_STAGE(PG8_SA(0, 1), cA + hstepA, voffA);
        if (wr == 1) PG8_BAR;
        PG8_WAIT_V(2); PG8_BAR;
        PG8_STAGE(PG8_SB(1, 0), cB + kstep, voffB); PG8_STAGE(PG8_SA(1, 0), cA + kstep, voffA); PG8_STAGE(PG8_SB(1, 1), cB + hstepB + kstep, voffB);
        PG8_WAIT_V(6); PG8_BAR;
    } else {
        PG8_STAGE(PG8_SB(0, 0), cB, voffB); PG8_STAGE(PG8_SA(0, 0), cA, voffA); PG8_STAGE(PG8_SB(0, 1), cB + hstepB, voffB); PG8_STAGE(PG8_SA(0, 1), cA + hstepA, voffA);
        if (wr == 1) PG8_BAR;
        PG8_WAIT_V(4); PG8_BAR;
        PG8_STAGE(PG8_SB(1, 0), cB + kstep, voffB); PG8_STAGE(PG8_SA(1, 0), cA + kstep, voffA); PG8_STAGE(PG8_SB(1, 1), cB + hstepB + kstep, voffB);
        PG8_WAIT_V(6); PG8_BAR;
    }
#pragma unroll 1
    for (;;) {
        const bool has_next = S.next(ui + 1, nxt);
        const char* nA = has_next ? P.a(nxt) : cA; const char* nB = has_next ? P.b(nxt) : cB;
#pragma unroll 1
        for (int t = 0; t < nt; t += 2) {
            const bool last = (t == nt - 2);
            const char* a1 = cA + (size_t)(t + 1) * kstep;
            const char* a2 = last ? nA : cA + (size_t)(t + 2) * kstep; const char* b2 = last ? nB : cB + (size_t)(t + 2) * kstep;
            const char* a3 = a2 + kstep; const char* b3 = b2 + kstep;
            if constexpr (SP2) {
            PG8_LDB(B0, 0, 0); PG8_LDB(B1, 0, 1); PG8_SCHED; PG8_LDA(At, 0, 0); PG8_STAGE(PG8_SA(1, 1), a1 + hstepA, voffA);
            PG8_WAIT_V(8); PG8_WAIT_L(0); PG8_BAR; PG8_MMA(0, 0, At, B0); PG8_MMA(0, 1, At, B1); PG8_BAR; PG8_SCHED;
            PG8_LDA(At, 0, 1); PG8_STAGE(PG8_SB(0, 0), b2, voffB); PG8_STAGE(PG8_SB(0, 1), b2 + hstepB, voffB); PG8_STAGE(PG8_SA(0, 0), a2, voffA);
            PG8_WAIT_V(8); PG8_WAIT_L(0); PG8_BAR; PG8_MMA(1, 0, At, B0); PG8_MMA(1, 1, At, B1); PG8_BAR; PG8_SCHED;
            PG8_LDB(B0, 1, 0); PG8_LDB(B1, 1, 1); PG8_SCHED; PG8_LDA(At, 1, 0); PG8_STAGE(PG8_SA(0, 1), a2 + hstepA, voffA);
            PG8_WAIT_V(8); PG8_WAIT_L(0); PG8_BAR; PG8_MMA(0, 0, At, B0); PG8_MMA(0, 1, At, B1); PG8_BAR; PG8_SCHED;
            PG8_LDA(At, 1, 1); PG8_STAGE(PG8_SB(1, 0), b3, voffB); PG8_STAGE(PG8_SB(1, 1), b3 + hstepB, voffB); PG8_STAGE(PG8_SA(1, 0), a3, voffA);
            PG8_WAIT_V(8); PG8_WAIT_L(0); PG8_BAR; PG8_MMA(1, 0, At, B0); PG8_MMA(1, 1, At, B1); PG8_BAR; PG8_SCHED;
            } else {
            PG8_LDB(B0, 0, 0); PG8_SCHED; PG8_LDA(At, 0, 0); PG8_STAGE(PG8_SA(1, 1), a1 + hstepA, voffA);
            PG8_WAIT_L(8); PG8_BAR; PG8_WAIT_L(0); PG8_MMA(0, 0, At, B0); PG8_BAR; PG8_SCHED;
            PG8_LDB(B1, 0, 1); PG8_STAGE(PG8_SB(0, 0), b2, voffB);
            PG8_BAR; PG8_WAIT_L(0); PG8_MMA(0, 1, At, B1); PG8_BAR;
            PG8_LDA(At, 0, 1); PG8_STAGE(PG8_SA(0, 0), a2, voffA);
            PG8_BAR; PG8_WAIT_L(0); PG8_MMA(1, 0, At, B0); PG8_BAR; PG8_SCHED;
            PG8_STAGE(PG8_SB(0, 1), b2 + hstepB, voffB);
            PG8_WAIT_V(6); PG8_BAR; PG8_MMA(1, 1, At, B1); PG8_BAR;
            PG8_LDB(B0, 1, 0); PG8_SCHED; PG8_LDA(At, 1, 0); PG8_STAGE(PG8_SA(0, 1), a2 + hstepA, voffA);
            PG8_WAIT_L(8); PG8_BAR; PG8_WAIT_L(0); PG8_MMA(0, 0, At, B0); PG8_BAR; PG8_SCHED;
            PG8_LDB(B1, 1, 1); PG8_STAGE(PG8_SB(1, 0), b3, voffB);
            PG8_BAR; PG8_WAIT_L(0); PG8_MMA(0, 1, At, B1); PG8_BAR;
            PG8_LDA(At, 1, 1); PG8_STAGE(PG8_SA(1, 0), a3, voffA);
            PG8_BAR; PG8_WAIT_L(0); PG8_MMA(1, 0, At, B0); PG8_BAR; PG8_SCHED;
            PG8_STAGE(PG8_SB(1, 1), b3 + hstepB, voffB);
            PG8_WAIT_V(6); PG8_BAR; PG8_MMA(1, 1, At, B1); PG8_BAR;
            }
        }
        if constexpr (ALIGN_EPI) { if (wr == 0) PG8_BAR; }
        if constexpr (!Epi::AFTER_DRAIN) { const int le_ = mk_tid(0);
            E(acc, cur, wr, wc, le_ & 15, le_ >> 4, pre); }
        if (!has_next) break;
        if (!epi_chain<Epi>::value || nxt.job == 0) {
#pragma unroll
        for (int a = 0; a < 2; ++a)
#pragma unroll
            for (int b = 0; b < 2; ++b)
#pragma unroll
                for (int m = 0; m < 4; ++m)
#pragma unroll
                    for (int n = 0; n < 2; ++n) acc[a][b][m][n] = (f32x4){0.f, 0.f, 0.f, 0.f};
        }
        cur = nxt; cA = nA; cB = nB; ++ui; E.prefetch(pre, cur, wr, fr);
        if constexpr (ALIGN_EPI) { if (wr == 1) PG8_BAR; }
    }
    PG8_WAIT_V(0);
    if constexpr (!ALIGN_EPI) { if (wr == 0) PG8_BAR; }
    PG8_BAR;
    if constexpr (Epi::AFTER_DRAIN) { const int le_ = mk_tid(0); E.fused(acc, cur, wr, wc, le_ & 15, le_ >> 4, lds, wid, le_, pre); }
#undef PG8_SA
#undef PG8_SB
#undef PG8_STAGE
#undef PG8_LDA
#undef PG8_LDB
#undef PG8_MMA
#undef PG8_WAIT_V
#undef PG8_WAIT_L
#undef PG8_BAR
#undef PG8_SCHED
}
typedef f32x4 Acc[2][2][4][2];

struct PtrStd {
    const char* A; const char* B; size_t aj, bj, bb, arow, brow;
    DEV const char* a(const Unit& u) const { return A + (size_t)u.job * aj + (size_t)u.pm * arow; }
    DEV const char* b(const Unit& u) const { return B + (size_t)u.job * bj + (size_t)(u.pm >> 5) * bb + (size_t)u.pn * brow; }
};
struct PtrG {
    const char* KVM; const char* WQ;
    DEV const char* a(const Unit& u) const { return KVM + (size_t)(u.job >> 2) * MiB + (size_t)(u.job & 3) * 512; }
    DEV const char* b(const Unit& u) const { return WQ + (size_t)(u.job >> 3) * 2 * MiB + (size_t)(u.job & 3) * 512 + (size_t)u.pn * 256 * 1024 * 2; }
};
struct PtrH {
    const char* KVM; const char* WOT;
    DEV const char* a(const Unit& u) const { return WOT + (size_t)(u.job >> 3) * 2 * MiB + (size_t)(u.job & 3) * 512 + (size_t)u.pm * 256 * 1024 * 2; }
    DEV const char* b(const Unit& u) const { return KVM + (size_t)(u.job >> 2) * MiB + 2048 + (size_t)(u.job & 3) * 512; }
};

#define EPI_ROWS(u) const int row0 = (u).pm * BM + wr * 64 + fr
DEV u32x4 pack8(const f32x4 v0, const f32x4 v1) { u32x4 w; w.x = cvt_pk_bf16(v0[0], v0[1]); w.y = cvt_pk_bf16(v0[2], v0[3]); w.z = cvt_pk_bf16(v1[0], v1[1]); w.w = cvt_pk_bf16(v1[2], v1[3]); return w; }

struct PreNone {};
typedef unsigned long long u64;
constexpr float SS_SCALE = 65536.f;
struct PreRs { u64 v[2][4]; };
DEV void pre_rs(PreRs& p, const u64* ss, int row0) {
#pragma unroll
    for (int ai = 0; ai < 2; ++ai)
#pragma unroll
        for (int m = 0; m < 4; ++m) p.v[ai][m] = __builtin_nontemporal_load(ss + row0 + ai * HALF + m * 16);
}
DEV void rs_of(float (&rs)[2][4], const PreRs& p) {
#pragma unroll
    for (int ai = 0; ai < 2; ++ai)
#pragma unroll
        for (int m = 0; m < 4; ++m) rs[ai][m] = rsqrtf((float)p.v[ai][m] * (1.f / (SS_SCALE * D)) + EPS);
}
struct EpiInProj {
    typedef PreRs Pre;
    DEV void prefetch(PreRs& p, const Unit& u, int wr, int fr) const { pre_rs(p, ss, u.pm * BM + wr * 64 + fr); }
    static constexpr bool PERM = true, AFTER_DRAIN = false;
    unsigned char* ws; const u64* ss;
    DEV void operator()(const Acc& acc, const Unit& u, int wr, int wc, int fr, int fq, const PreRs& pre) const {
        EPI_ROWS(u); const int pn = u.pn, cb = wc * 32 + 8 * fq;
        float rs[2][4]; rs_of(rs, pre);
        if (pn < 16) {
            const int g = pn >> 1;
            const size_t off = g == 0 ? WS_QA : g == 1 ? WS_KA : g == 2 ? WS_VA : g == 3 ? WS_QC : g == 4 ? WS_KC : g == 5 ? WS_VC : g == 6 ? WS_IQ : WS_SCB;
            const float sc = (g == 0 || g == 3) ? QSCALE : 1.f;
            bf16_t* base = (bf16_t*)(ws + off) + (pn & 1) * 256 + cb;
#pragma unroll
            for (int ai = 0; ai < 2; ++ai)
#pragma unroll
                for (int m = 0; m < 4; ++m) { bf16_t* rowp = base + (size_t)(row0 + ai * HALF + m * 16) * 512;
#pragma unroll
                    for (int bj = 0; bj < 2; ++bj) *(u32x4*)(rowp + bj * HALF) = pack8(acc[ai][bj][m][0] * (sc * rs[ai][m]), acc[ai][bj][m][1] * (sc * rs[ai][m])); }
        } else if (pn < 20) {
            bf16_t* base = (bf16_t*)(ws + WS_CX) + (pn - 16) * 128 + cb;
#pragma unroll
            for (int ai = 0; ai < 2; ++ai)
#pragma unroll
                for (int m = 0; m < 4; ++m) { const float r2 = rs[ai][m] * rs[ai][m]; *(u32x4*)(base + (size_t)(row0 + ai * HALF + m * 16) * 512) = pack8(acc[ai][0][m][0] * acc[ai][1][m][0] * r2, acc[ai][0][m][1] * acc[ai][1][m][1] * r2); }
        } else {
            if (wc < 2) { bf16_t* base = (bf16_t*)(ws + WS_IK);
#pragma unroll
                for (int ai = 0; ai < 2; ++ai)
#pragma unroll
                    for (int m = 0; m < 4; ++m) { const int t = row0 + ai * HALF + m * 16;
                        *(u32x4*)(base + (size_t)(t >> 5) * 2048 + (((cb >> 3) * 32 + (t & 31)) * 8)) = pack8(acc[ai][0][m][0] * rs[ai][m], acc[ai][0][m][1] * rs[ai][m]); }
            } else if (wc == 2 && fq == 0) { float* base = (float*)(ws + WS_IW);
#pragma unroll
                for (int ai = 0; ai < 2; ++ai)
#pragma unroll
                    for (int m = 0; m < 4; ++m) { float* p = base + (size_t)(row0 + ai * HALF + m * 16) * 8; *(f32x4*)p = acc[ai][0][m][0] * (WSCALE * rs[ai][m]); *(f32x4*)(p + 4) = acc[ai][0][m][1] * (WSCALE * rs[ai][m]); }
            }
        }
    }
};
DEV f32x4 sigm4(const f32x4 v) { f32x4 o;
#pragma unroll
    for (int i = 0; i < 4; ++i) o[i] = __builtin_amdgcn_rcpf(1.f + __builtin_amdgcn_exp2f(v[i])); return o; }
struct EpiGates {
    typedef PreRs Pre;
    DEV void prefetch(PreRs& p, const Unit& u, int wr, int fr) const { pre_rs(p, ss, u.pm * BM + wr * 64 + fr); }
    static constexpr bool PERM = true, AFTER_DRAIN = false;
    bf16_t* G; const u64* ss;
    DEV void operator()(const Acc& acc, const Unit& u, int wr, int wc, int fr, int fq, const PreRs& pre) const {
        EPI_ROWS(u); float rs[2][4]; rs_of(rs, pre); bf16_t* base = G + (size_t)(u.pn >> 2) * T * D + (u.pn & 3) * 256 + wc * 32 + 8 * fq;
#pragma unroll
        for (int ai = 0; ai < 2; ++ai)
#pragma unroll
            for (int m = 0; m < 4; ++m) { bf16_t* rowp = base + (size_t)(row0 + ai * HALF + m * 16) * D;
#pragma unroll
                for (int bj = 0; bj < 2; ++bj) *(u32x4*)(rowp + bj * HALF) = pack8(sigm4(acc[ai][bj][m][0] * (-LOG2E * rs[ai][m])), sigm4(acc[ai][bj][m][1] * (-LOG2E * rs[ai][m]))); }
    }
};
struct EpiMerge {
    typedef PreNone Pre;
    DEV void prefetch(PreNone&, const Unit&, int, int) const {}
    static constexpr bool PERM = true, AFTER_DRAIN = false;
    bf16_t* M; const bf16_t* G;
    DEV void operator()(const Acc& acc, const Unit& u, int wr, int wc, int fr, int fq, const PreNone&) const {
        EPI_ROWS(u); const size_t cofs = (size_t)u.pn * 256 + wc * 32 + 8 * fq; const bf16_t* gb = G + (size_t)u.job * T * D;
#pragma unroll
        for (int ai = 0; ai < 2; ++ai) {
            u32x4 g[8], p[8];
#pragma unroll
            for (int m = 0; m < 4; ++m)
#pragma unroll
                for (int bj = 0; bj < 2; ++bj) { const size_t o = (size_t)(row0 + ai * HALF + m * 16) * D + cofs + bj * HALF; g[2 * m + bj] = *(const u32x4*)(gb + o);
                    if (u.job > 0) p[2 * m + bj] = __builtin_nontemporal_load((const u32x4*)(M + o)); }
#pragma unroll
            for (int m = 0; m < 4; ++m)
#pragma unroll
                for (int bj = 0; bj < 2; ++bj) { const size_t o = (size_t)(row0 + ai * HALF + m * 16) * D + cofs + bj * HALF; const u32x4 gg = g[2 * m + bj];
                    f32x4 v0 = acc[ai][bj][m][0], v1 = acc[ai][bj][m][1];
                    v0[0] *= bflo(gg.x); v0[1] *= bfhi(gg.x); v0[2] *= bflo(gg.y); v0[3] *= bfhi(gg.y); v1[0] *= bflo(gg.z); v1[1] *= bfhi(gg.z); v1[2] *= bflo(gg.w); v1[3] *= bfhi(gg.w);
                    if (u.job > 0) { const u32x4 pp = p[2 * m + bj];
                        v0[0] += bflo(pp.x); v0[1] += bfhi(pp.x); v0[2] += bflo(pp.y); v0[3] += bfhi(pp.y); v1[0] += bflo(pp.z); v1[1] += bfhi(pp.z); v1[2] += bflo(pp.w); v1[3] += bfhi(pp.w); }
                    *(u32x4*)(M + o) = pack8(v0, v1); }
        }
    }
};
struct EpiMergeC {
    typedef PreNone Pre;
    DEV void prefetch(PreNone&, const Unit&, int, int) const {}
    static constexpr bool PERM = true, AFTER_DRAIN = false, CHAIN = true;
    bf16_t* M; const bf16_t* G;
    static DEV float gl(unsigned w) { return fmaxf(bflo(w), 9.094947e-13f); }
    static DEV float gh(unsigned w) { return fmaxf(bfhi(w), 9.094947e-13f); }
    DEV void operator()(Acc& acc, const Unit& u, int wr, int wc, int fr, int fq, const PreNone&) const {
        EPI_ROWS(u); const size_t cofs = (size_t)u.pn * 256 + wc * 32 + 8 * fq; const bf16_t* gb = G + (size_t)u.job * T * D; const bool lastj = u.job == 2;
#pragma unroll
        for (int ai = 0; ai < 2; ++ai) {
            u32x4 g[8], gn[8];
#pragma unroll
            for (int m = 0; m < 4; ++m)
#pragma unroll
                for (int bj = 0; bj < 2; ++bj) { const size_t o = (size_t)(row0 + ai * HALF + m * 16) * D + cofs + bj * HALF; g[2 * m + bj] = *(const u32x4*)(gb + o);
                    if (!lastj) gn[2 * m + bj] = *(const u32x4*)(gb + (size_t)T * D + o); }
#pragma unroll
            for (int m = 0; m < 4; ++m)
#pragma unroll
                for (int bj = 0; bj < 2; ++bj) { const u32x4 a = g[2 * m + bj]; f32x4 s0 = {gl(a.x), gh(a.x), gl(a.y), gh(a.y)}, s1 = {gl(a.z), gh(a.z), gl(a.w), gh(a.w)};
                    if (!lastj) { const u32x4 b = gn[2 * m + bj];
                        s0[0] *= __builtin_amdgcn_rcpf(gl(b.x)); s0[1] *= __builtin_amdgcn_rcpf(gh(b.x)); s0[2] *= __builtin_amdgcn_rcpf(gl(b.y)); s0[3] *= __builtin_amdgcn_rcpf(gh(b.y));
                        s1[0] *= __builtin_amdgcn_rcpf(gl(b.z)); s1[1] *= __builtin_amdgcn_rcpf(gh(b.z)); s1[2] *= __builtin_amdgcn_rcpf(gl(b.w)); s1[3] *= __builtin_amdgcn_rcpf(gh(b.w)); }
                    acc[ai][bj][m][0] = acc[ai][bj][m][0] * s0; acc[ai][bj][m][1] = acc[ai][bj][m][1] * s1;
                    if (lastj) { const size_t o = (size_t)(row0 + ai * HALF + m * 16) * D + cofs + bj * HALF; *(u32x4*)(M + o) = pack8(acc[ai][bj][m][0], acc[ai][bj][m][1]); } }
        }
    }
};
template <bool IN_F32> struct EpiResid {
    typedef PreNone Pre;
    DEV void prefetch(PreNone&, const Unit&, int, int) const {}
    static constexpr bool PERM = true, AFTER_DRAIN = true;
    const void* xin; bf16_t* xb; u64* ss;
    DEV void fused(Acc& acc, const Unit& u, int wr, int wc, int fr, int fq, LAS unsigned char* lds, int wid, int lane, const PreNone&) const {
        EPI_ROWS(u); const size_t cofs = (size_t)u.pn * 256 + wc * 32 + 8 * fq;
        LAS float* PS = (LAS float*)lds;
#pragma unroll
        for (int ai = 0; ai < 2; ++ai) {
            f32x4 r0[8], r1[8];
#pragma unroll
            for (int m = 0; m < 4; ++m)
#pragma unroll
                for (int bj = 0; bj < 2; ++bj) { const size_t o = (size_t)(row0 + ai * HALF + m * 16) * D + cofs + bj * HALF; const int k = 2 * m + bj;
                    if (IN_F32) { r0[k] = *(const f32x4*)((const float*)xin + o); r1[k] = *(const f32x4*)((const float*)xin + o + 4); }
                    else { const u32x4 p = *(const u32x4*)((const bf16_t*)xin + o); r0[k] = __builtin_bit_cast(f32x4, p); } }
#pragma unroll
            for (int m = 0; m < 4; ++m) { const size_t ro = (size_t)(row0 + ai * HALF + m * 16) * D + cofs; float sq = 0.f;
#pragma unroll
                for (int bj = 0; bj < 2; ++bj) { const size_t o = ro + bj * HALF; const int k = 2 * m + bj; f32x4 v0 = acc[ai][bj][m][0], v1 = acc[ai][bj][m][1];
                    if (IN_F32) { v0 = v0 + r0[k]; v1 = v1 + r1[k]; }
                    else { const u32x4 p = __builtin_bit_cast(u32x4, r0[k]);
                        v0[0] += bflo(p.x); v0[1] += bfhi(p.x); v0[2] += bflo(p.y); v0[3] += bfhi(p.y); v1[0] += bflo(p.z); v1[1] += bfhi(p.z); v1[2] += bflo(p.w); v1[3] += bfhi(p.w); }
                    *(u32x4*)(xb + o) = pack8(v0, v1);
                    sq += ((v0[0] * v0[0] + v0[1] * v0[1]) + (v0[2] * v0[2] + v0[3] * v0[3])) + ((v1[0] * v1[0] + v1[1] * v1[1]) + (v1[2] * v1[2] + v1[3] * v1[3])); }
                sq += __shfl_xor(sq, 16); sq += __shfl_xor(sq, 32);
                if (fq == 0) PS[(ai * HALF + wr * 64 + m * 16 + fr) * 4 + wc] = sq; }
        }
        LDS_WAIT(); __builtin_amdgcn_s_barrier(); asm volatile("" ::: "memory");
        { const int t = wid * 64 + lane; if (t < 256) { const f32x4 q = *(const LAS f32x4*)(PS + t * 4); atomicAdd(ss + u.pm * BM + t, (u64)(((q[0] + q[1]) + (q[2] + q[3])) * SS_SCALE + 0.5f)); } }
        LDS_WAIT(); __builtin_amdgcn_s_barrier();
    }
};
DEV float gelu_t(float a) { return a * __builtin_amdgcn_rcpf(1.f + __builtin_amdgcn_exp2f(-1.5957691216057308f * LOG2E * (a + 0.044715f * a * a * a))); }
DEV float row_prev1(float cur, float prevm) { const int r = __builtin_amdgcn_update_dpp(0, (int)__float_as_uint(prevm), 0x121, 0xf, 0xf, false);
    return __uint_as_float((unsigned)__builtin_amdgcn_update_dpp(r, (int)__float_as_uint(cur), 0x111, 0xf, 0xf, false)); }
DEV float row_prev2(float cur, float prevm) { const int r = __builtin_amdgcn_update_dpp(0, (int)__float_as_uint(prevm), 0x122, 0xf, 0xf, false);
    return __uint_as_float((unsigned)__builtin_amdgcn_update_dpp(r, (int)__float_as_uint(cur), 0x112, 0xf, 0xf, false)); }
DEV float row_shr1z(float cur) { return __uint_as_float((unsigned)__builtin_amdgcn_update_dpp(0, (int)__float_as_uint(cur), 0x111, 0xf, 0xf, true)); }
DEV float row_shr2z(float cur) { return __uint_as_float((unsigned)__builtin_amdgcn_update_dpp(0, (int)__float_as_uint(cur), 0x112, 0xf, 0xf, true)); }
struct EpiUpF {
    typedef PreRs Pre;
    DEV void prefetch(PreRs& p, const Unit& u, int wr, int fr) const { pre_rs(p, ss, u.pm * BM + wr * 64 + fr); }
    static constexpr bool PERM = true, AFTER_DRAIN = false;
    bf16_t *fu, *sa, *su; const u64* ss; const float *cw, *cb;
    DEV void operator()(const Acc& acc, const Unit& u, int wr, int wc, int fr, int fq, const PreRs& pre) const {
        EPI_ROWS(u); float rs[2][4]; rs_of(rs, pre); const size_t cofs = (size_t)u.pn * 128 + wc * 32 + 8 * fq;
        f32x4 w0[2], w1[2], w2[2], bb[2];
#pragma unroll
        for (int n = 0; n < 2; ++n) { w0[n] = *(const f32x4*)(cw + cofs + 4 * n); w1[n] = *(const f32x4*)(cw + DFF + cofs + 4 * n); w2[n] = *(const f32x4*)(cw + 2 * DFF + cofs + 4 * n); bb[n] = *(const f32x4*)(cb + cofs + 4 * n); }
#pragma unroll
        for (int ai = 0; ai < 2; ++ai) {
            const size_t strip = (size_t)u.pm * 4 + ai * 2 + wr;
            f32x4 ap[2] = {{0.f, 0.f, 0.f, 0.f}, {0.f, 0.f, 0.f, 0.f}};
#pragma unroll
            for (int m = 0; m < 4; ++m) {
                f32x4 a[2], g[2];
#pragma unroll
                for (int n = 0; n < 2; ++n) { a[n] = acc[ai][0][m][n] * rs[ai][m];
#pragma unroll
                    for (int e = 0; e < 4; ++e) { const float a1 = m == 0 ? row_shr1z(a[n][e]) : row_prev1(a[n][e], ap[n][e]), a2 = m == 0 ? row_shr2z(a[n][e]) : row_prev2(a[n][e], ap[n][e]);
                        g[n][e] = gelu_t(bb[n][e] + w0[n][e] * a2 + w1[n][e] * a1 + w2[n][e] * a[n][e]) * (acc[ai][1][m][n][e] * rs[ai][m]); } }
                if (m == 0) {
                    if (fr < 2) { *(u32x4*)(sa + (strip * 4 + fr) * DFF + cofs) = pack8(a[0], a[1]); *(u32x4*)(su + (strip * 2 + fr) * DFF + cofs) = pack8(acc[ai][1][0][0] * rs[ai][0], acc[ai][1][0][1] * rs[ai][0]); }
                    else *(u32x4*)(fu + (size_t)(row0 + ai * HALF) * DFF + cofs) = pack8(g[0], g[1]);
                } else {
                    *(u32x4*)(fu + (size_t)(row0 + ai * HALF + m * 16) * DFF + cofs) = pack8(g[0], g[1]);
                    if (m == 3 && fr >= 14) *(u32x4*)(sa + (strip * 4 + 2 + (fr - 14)) * DFF + cofs) = pack8(a[0], a[1]);
                }
                ap[0] = a[0]; ap[1] = a[1];
            }
        }
    }
};
struct EpiPrep {
    typedef PreNone Pre;
    DEV void prefetch(PreNone&, const Unit&, int, int) const {}
    static constexpr bool PERM = true, AFTER_DRAIN = false;
    unsigned char* ws; int mode;
    DEV void operator()(const Acc& acc, const Unit& u, int wr, int wc, int fr, int fq, const PreNone&) const {
        EPI_ROWS(u); bf16_t* base; int ldc; float sc = 1.f;
        if (mode == 0) { base = (bf16_t*)(ws + WS_KVM + (size_t)u.job * 2 * MiB); ldc = 2 * D; }
        else if (mode == 1) { base = (bf16_t*)(ws + WS_GT + (size_t)(u.job >> 2) * 2 * MiB) + (size_t)(u.job & 3) * 256 * D; ldc = D; sc = XSCALE; }
        else { base = (bf16_t*)(ws + WS_HT + (size_t)(u.job >> 2) * 2 * MiB) + (u.job & 3) * 256; ldc = D; }
        base += (size_t)u.pn * 256 + wc * 32 + 8 * fq;
#pragma unroll
        for (int ai = 0; ai < 2; ++ai)
#pragma unroll
            for (int m = 0; m < 4; ++m) { bf16_t* rowp = base + (size_t)(row0 + ai * HALF + m * 16) * ldc;
#pragma unroll
                for (int bj = 0; bj < 2; ++bj) *(u32x4*)(rowp + bj * HALF) = pack8(acc[ai][bj][m][0] * sc, acc[ai][bj][m][1] * sc); }
    }
};
struct EpiSoftmax {
    typedef PreRs Pre;
    DEV void prefetch(PreRs& p, const Unit& u, int wr, int fr) const { pre_rs(p, ss, u.pm * BM + wr * 64 + fr); }
    static constexpr bool PERM = true, AFTER_DRAIN = true;
    bf16_t* P; const u64* ss;
    DEV void fused(Acc& acc, const Unit& u, int wr, int wc, int fr, int fq, LAS unsigned char* lds, int wid, int lane, const PreRs& pre) const {
        LAS float* PM = (LAS float*)lds; LAS float* PS = (LAS float*)(lds + 4096);
        { const int row0_ = u.pm * BM + wr * 64 + fr; float rs[2][4]; rs_of(rs, pre);
#pragma unroll
          for (int ai = 0; ai < 2; ++ai)
#pragma unroll
              for (int m = 0; m < 4; ++m)
#pragma unroll
                  for (int bj = 0; bj < 2; ++bj)
#pragma unroll
                      for (int n = 0; n < 2; ++n) acc[ai][bj][m][n] = acc[ai][bj][m][n] * rs[ai][m]; }
#pragma unroll
        for (int ai = 0; ai < 2; ++ai)
#pragma unroll
            for (int m = 0; m < 4; ++m) { float mx = -INFINITY;
#pragma unroll
                for (int bj = 0; bj < 2; ++bj)
#pragma unroll
                    for (int n = 0; n < 2; ++n) { const f32x4 x = acc[ai][bj][m][n]; mx = fmaxf(mx, fmaxf(fmaxf(x[0], x[1]), fmaxf(x[2], x[3]))); }
                mx = fmaxf(mx, __shfl_xor(mx, 16)); mx = fmaxf(mx, __shfl_xor(mx, 32));
                if (fq == 0) PM[(ai * HALF + wr * 64 + m * 16 + fr) * 4 + wc] = mx; }
        LDS_WAIT(); __builtin_amdgcn_s_barrier(); asm volatile("" ::: "memory");
#pragma unroll
        for (int ai = 0; ai < 2; ++ai)
#pragma unroll
            for (int m = 0; m < 4; ++m) { const int r = ai * HALF + wr * 64 + m * 16 + fr; const f32x4 q = *(const LAS f32x4*)(PM + r * 4);
                const float mx = fmaxf(fmaxf(q[0], q[1]), fmaxf(q[2], q[3])); float s = 0.f;
#pragma unroll
                for (int bj = 0; bj < 2; ++bj)
#pragma unroll
                    for (int n = 0; n < 2; ++n) { f32x4 x = acc[ai][bj][m][n];
#pragma unroll
                        for (int i = 0; i < 4; ++i) { x[i] = __builtin_amdgcn_exp2f(x[i] - mx); s += x[i]; } acc[ai][bj][m][n] = x; }
                s += __shfl_xor(s, 16); s += __shfl_xor(s, 32);
                if (fq == 0) PS[r * 4 + wc] = s; }
        LDS_WAIT(); __builtin_amdgcn_s_barrier(); asm volatile("" ::: "memory");
        EPI_ROWS(u); bf16_t* base = P + (size_t)u.pn * 256 + wc * 32 + 8 * fq;
#pragma unroll
        for (int ai = 0; ai < 2; ++ai)
#pragma unroll
            for (int m = 0; m < 4; ++m) { const int r = ai * HALF + wr * 64 + m * 16 + fr; const f32x4 q = *(const LAS f32x4*)(PS + r * 4);
                const float inv = 1.f / ((q[0] + q[1]) + (q[2] + q[3])); bf16_t* rowp = base + (size_t)(row0 + ai * HALF + m * 16) * D;
#pragma unroll
                for (int bj = 0; bj < 2; ++bj) *(u32x4*)(rowp + bj * HALF) = pack8(acc[ai][bj][m][0] * inv, acc[ai][bj][m][1] * inv); }
        LDS_WAIT(); __builtin_amdgcn_s_barrier();
    }
};
}

typedef GAS unsigned gu32;
#define XB_TMO      128
#define XB_XCNT(j)  (256  + 64 * (j))
#define XB_XSUB(j)  (1280 + 64 * (j))
#define XB_XGEN(j)  (2304 + 64 * (j))
#define XB_TOP      3328
#define XB_TOPGEN   3392
#define XCD_BAR_WORDS 3456
#define XB_SPIN_CAP (1u << 22)
DEV unsigned xb_ld(unsigned* p) { return __hip_atomic_load(p, __ATOMIC_RELAXED, __HIP_MEMORY_SCOPE_AGENT); }
DEV unsigned xb_add(unsigned* p, unsigned v) { return __hip_atomic_fetch_add(p, v, __ATOMIC_RELAXED, __HIP_MEMORY_SCOPE_AGENT); }
DEV unsigned xb_xcc_id() { return (unsigned)__builtin_amdgcn_s_getreg((3 << 11) | 20) & 0xFu; }
#define XB_SPIN(cond, bar) do { unsigned _sp = 0; while (cond) { __builtin_amdgcn_s_sleep(1); \
    if ((++_sp & 255u) == 0u) { if (xb_ld(&(bar)[XB_TMO])) break; if (_sp > XB_SPIN_CAP) { atomicAdd(&(bar)[XB_TMO], 1u); break; } } } } while (0)
struct XcdBarrier { unsigned* bar; unsigned x; volatile LAS unsigned* st; };
DEV XcdBarrier xcd_barrier_post(unsigned* bar, volatile LAS unsigned* st, int tid) {
    XcdBarrier b; b.bar = bar; b.x = xb_xcc_id(); b.st = st;
    if (tid == 0) (void)xb_add(&bar[XB_XCNT(b.x)], 1u);
    return b;
}
DEV void xcd_barrier_complete(unsigned* bar, unsigned x, unsigned& nloc, unsigned& nx) {
    const unsigned G = gridDim.x * gridDim.y * gridDim.z;
    unsigned sum, cnt, mine, sp = 0u;
    for (;;) {
        sum = 0u; cnt = 0u; mine = 0u;
#pragma unroll
        for (unsigned j = 0; j < 16; ++j) { const unsigned c = xb_ld(&bar[XB_XCNT(j)]); sum += c; cnt += (c > 0u) ? 1u : 0u; mine = (j == x) ? c : mine; }
        if (sum == G) break;
        __builtin_amdgcn_s_sleep(1);
        if ((++sp & 255u) == 0u) { if (xb_ld(&bar[XB_TMO])) break; if (sp > XB_SPIN_CAP) { atomicAdd(&bar[XB_TMO], 1u); break; } }
    }
    nloc = mine > 0u ? mine : 1u; nx = cnt > 0u ? cnt : 1u;
}
#define XB_BADMAP 192
DEV void xcd_barrier_local(const XcdBarrier& b, int tid) {
    asm volatile("s_waitcnt vmcnt(0)" ::: "memory");
    __syncthreads();
    if (tid == 0) {
        unsigned* bar = b.bar;
        __builtin_amdgcn_s_waitcnt(0);
        const unsigned nloc = b.st[0];
        const unsigned old = xb_add(&bar[XB_XSUB(b.x)], 1u);
        const unsigned gen = old / nloc;
        if (old + 1u == (gen + 1u) * nloc) xb_add(&bar[XB_XGEN(b.x)], 1u);
        else XB_SPIN(xb_ld(&bar[XB_XGEN(b.x)]) == gen, bar);
        __builtin_amdgcn_fence(__ATOMIC_ACQUIRE, "agent");
        asm volatile("s_waitcnt vmcnt(0)" ::: "memory");
    }
    __syncthreads();
}
DEV void xcd_barrier(const XcdBarrier& b, int tid) {
    asm volatile("s_waitcnt vmcnt(0)" ::: "memory");
    __syncthreads();
    if (tid == 0) {
        unsigned* bar = b.bar;
        __builtin_amdgcn_s_waitcnt(0);
        unsigned nloc = b.st[0], nx = b.st[1];
        if (nloc == 0u) { xcd_barrier_complete(bar, b.x, nloc, nx); b.st[0] = nloc; b.st[1] = nx; }
        const unsigned old = xb_add(&bar[XB_XSUB(b.x)], 1u);
        const unsigned gen = old / nloc;
        if (old + 1u == (gen + 1u) * nloc) {
            __builtin_amdgcn_fence(__ATOMIC_RELEASE, "agent");
            asm volatile("s_waitcnt vmcnt(0)" ::: "memory");
            const unsigned og = xb_add(&bar[XB_TOP], 1u);
            const unsigned tg = og / nx;
            if (og + 1u == (tg + 1u) * nx) xb_add(&bar[XB_TOPGEN], 1u);
            else XB_SPIN(xb_ld(&bar[XB_TOPGEN]) == tg, bar);
            __builtin_amdgcn_fence(__ATOMIC_ACQUIRE, "agent");
            xb_add(&bar[XB_XGEN(b.x)], 1u);
            asm volatile("s_waitcnt vmcnt(0)" ::: "memory");
        } else {
            XB_SPIN(xb_ld(&bar[XB_XGEN(b.x)]) == gen, bar);
            __builtin_amdgcn_fence(__ATOMIC_ACQUIRE, "agent");
            asm volatile("s_waitcnt vmcnt(0)" ::: "memory");
        }
    }
    __syncthreads();
}


using pg8::gelu_t;
struct WaveId { int gw, ngw, wave, lane; };
DEV unsigned f2bf_u(float f) { return (unsigned)f2bf(f); }
DEV unsigned pk2(float lo, float hi) { return cvt_pk_bf16(lo, hi); }

DEV void norm_rows(const WaveId& W, const float* x, const float* g, bf16_t* outb, float* outf, int rows) {
    for (int row = W.gw; row < rows; row += W.ngw) {
        const f32x4* xr = (const f32x4*)(x + (size_t)row * D) + W.lane;
        f32x4 v[4]; float s = 0.f;
#pragma unroll
        for (int j = 0; j < 4; ++j) { v[j] = xr[64 * j]; s += (v[j].x * v[j].x + v[j].y * v[j].y) + (v[j].z * v[j].z + v[j].w * v[j].w); }
        const float r = rsqrtf(wave_sum(s) * (1.f / D) + EPS);
#pragma unroll
        for (int j = 0; j < 4; ++j) {
            const f32x4 gg = ((const f32x4*)g)[W.lane + 64 * j];
            const f32x4 o = {v[j].x * r * gg.x, v[j].y * r * gg.y, v[j].z * r * gg.z, v[j].w * r * gg.w};
            if (outb) { u32x2 w; w.x = pk2(o.x, o.y); w.y = pk2(o.z, o.w); ((u32x2*)(outb + (size_t)row * D))[W.lane + 64 * j] = w; }
            else ((f32x4*)(outf + (size_t)row * D))[W.lane + 64 * j] = o;
        }
    }
}
DEV void cvt_piece(const WaveId& W, LAS float* scr, int& base, const float* Wsrc, int ldw, int K, int col0, int ncols, bf16_t* dst, int ldo, int row0, const float* gain = nullptr) {
    const int nblk = ncols / 32, nitems = (K / 64) * nblk;
    int first = (W.gw - base) % W.ngw; if (first < 0) first += W.ngw;
    base = (base + nitems) % W.ngw;
    for (int item = first; item < nitems; item += W.ngw) {
        const int kb = item / nblk, nb = item - kb * nblk, k0 = 64 * kb, n0 = 32 * nb;
        { const int lr = W.lane >> 3, lc = (W.lane & 7) * 4;
          f32x4 v[8]; float g[8];
#pragma unroll
          for (int i = 0; i < 8; ++i) { v[i] = *(const f32x4*)(Wsrc + (size_t)(k0 + lr + 8 * i) * ldw + col0 + n0 + lc); g[i] = gain ? gain[k0 + lr + 8 * i] : 1.f; }
#pragma unroll
          for (int i = 0; i < 8; ++i) { LAS float* d = scr + (lr + 8 * i) * 33 + lc; d[0] = v[i][0] * g[i]; d[1] = v[i][1] * g[i]; d[2] = v[i][2] * g[i]; d[3] = v[i][3] * g[i]; } }
        LDS_WAIT(); asm volatile("" ::: "memory");
        const int c = W.lane & 7;
#pragma unroll
        for (int j = 0; j < 4; ++j) { const int n = (W.lane >> 3) + 8 * j; const LAS float* s = scr + (8 * c) * 33 + n;
            u32x4 o; o.x = pk2(s[0 * 33], s[1 * 33]); o.y = pk2(s[2 * 33], s[3 * 33]); o.z = pk2(s[4 * 33], s[5 * 33]); o.w = pk2(s[6 * 33], s[7 * 33]);
            *(u32x4*)(dst + (size_t)(row0 + n0 + n) * ldo + k0 + 8 * c) = o; }
        LDS_WAIT(); asm volatile("" ::: "memory");
    }
}
struct CvtItem { int has; f32x4 v[8]; float g[8]; bf16_t* d; int ldo; };
DEV void cvt_load(CvtItem& it, const WaveId& W, int& base, const float* Wsrc, int ldw, int K, int col0, int ncols, bf16_t* dst, int ldo, int row0, const float* gain = nullptr) {
    const int nblk = ncols / 32, nitems = (K / 64) * nblk;
    int first = (W.gw - base) % W.ngw; if (first < 0) first += W.ngw;
    base = (base + nitems) % W.ngw;
    it.has = first < nitems ? 1 : 0;
    if (it.has) {
        const int kb = first / nblk, nb = first - kb * nblk, k0 = 64 * kb, n0 = 32 * nb, lr = W.lane >> 3, lc = (W.lane & 7) * 4;
#pragma unroll
        for (int i = 0; i < 8; ++i) { it.v[i] = *(const f32x4*)(Wsrc + (size_t)(k0 + lr + 8 * i) * ldw + col0 + n0 + lc); it.g[i] = gain ? gain[k0 + lr + 8 * i] : 1.f; }
        it.d = dst + (size_t)(row0 + n0) * ldo + k0; it.ldo = ldo;
    }
}
DEV void cvt_store(const CvtItem& it, const WaveId& W, LAS float* scr) {
    if (!it.has) return;
    const int lr = W.lane >> 3, lc = (W.lane & 7) * 4, c = W.lane & 7;
#pragma unroll
    for (int i = 0; i < 8; ++i) { LAS float* d = scr + (lr + 8 * i) * 33 + lc; d[0] = it.v[i][0] * it.g[i]; d[1] = it.v[i][1] * it.g[i]; d[2] = it.v[i][2] * it.g[i]; d[3] = it.v[i][3] * it.g[i]; }
    LDS_WAIT(); asm volatile("" ::: "memory");
#pragma unroll
    for (int j = 0; j < 4; ++j) { const int n = (W.lane >> 3) + 8 * j; const LAS float* s = scr + (8 * c) * 33 + n;
        u32x4 o; o.x = pk2(s[0 * 33], s[1 * 33]); o.y = pk2(s[2 * 33], s[3 * 33]); o.z = pk2(s[4 * 33], s[5 * 33]); o.w = pk2(s[6 * 33], s[7 * 33]);
        *(u32x4*)(it.d + (size_t)n * it.ldo + 8 * c) = o; }
    LDS_WAIT(); asm volatile("" ::: "memory");
}
DEV void convert_layer_weights(const WaveId& W, LAS float* scr, int& base, unsigned char* ws, const float* const* in, int l, int part = 7) {
    const float* wi = in[3] + (size_t)l * D * DIN;
    CvtItem cur; cur.has = 0;
#define CVT(...) do { CvtItem nx_; cvt_load(nx_, W, base, __VA_ARGS__); if (nx_.has) { cvt_store(cur, W, scr); cur = nx_; } } while (0)
    if (part & 1) {
    bf16_t* WIN = (bf16_t*)(ws + WS_WIN); const float* gm = in[2] + l * D;
    CVT(wi, DIN, D, 0, 1536, WIN, D, 0, gm);
    CVT(wi, DIN, D, 3072, 1536, WIN, D, 1536, gm);
    CVT(wi, DIN, D, 4608, 512, WIN, D, 3072, gm);
    CVT(wi, DIN, D, 1536, 512, WIN, D, 3584, gm);
#pragma unroll 1
    for (int j = 0; j < 4; ++j) { CVT(wi, DIN, D, 2048 + 128 * j, 128, WIN, D, 4096 + 256 * j, gm); CVT(wi, DIN, D, 2560 + 128 * j, 128, WIN, D, 4096 + 256 * j + 128, gm); }
    CVT(wi, DIN, D, 5120, 96, WIN, D, 5120, gm);
    CVT(wi, DIN, D, 5192, 3072, (bf16_t*)(ws + WS_WG), D, 0, gm);
#pragma unroll 1
    for (int i = 0; i < 3; ++i) CVT(in[5 + i] + (size_t)l * 512 * D, D, 512, 0, D, (bf16_t*)(ws + WS_WBR) + (size_t)i * D * 512, 512, 0);
    CVT(in[8] + (size_t)l * D * D, D, D, 0, D, (bf16_t*)(ws + WS_WMIX), D, 0);
    }
    if (part & 2) {
    const float* gf = in[14] + l * D;
    const float* wf = in[15] + (size_t)l * D * 2 * DFF;
#pragma unroll 1
    for (int j = 0; j < 22; ++j) { CVT(wf, 2 * DFF, D, 128 * j, 128, (bf16_t*)(ws + WS_WUP), D, 256 * j, gf); CVT(wf, 2 * DFF, D, DFF + 128 * j, 128, (bf16_t*)(ws + WS_WUP), D, 256 * j + 128, gf); }
    }
    if (part & 4) CVT(in[18] + (size_t)l * DFF * D, D, DFF, 0, D, (bf16_t*)(ws + WS_WDOWN), DFF, 0);
    cvt_store(cur, W, scr);
#undef CVT
}
DEV void prep0_phase(const WaveId& W, LAS float* scr, unsigned char* ws, const float* const* in, bf16_t* XB) {
    int base = 0;
#pragma unroll 1
    for (int l = 0; l < DEPTH; ++l) {
        const float* wq = in[11] + (size_t)l * D * D; bf16_t* WQ = (bf16_t*)(ws + WS_WQ + (size_t)l * 2 * MiB); const float* gx = in[9] + l * D;
        for (size_t i = (size_t)(W.gw * 64 + W.lane) * 4; i < (size_t)D * D; i += (size_t)W.ngw * 256) { const float g = gx[i >> 10]; const f32x4 v = *(const f32x4*)(wq + i); u32x2 o; o.x = pk2(v.x * g, v.y * g); o.y = pk2(v.z * g, v.w * g); *(u32x2*)(WQ + i) = o; }
        cvt_piece(W, scr, base, in[13] + (size_t)l * D * D, D, D, 0, D, (bf16_t*)(ws + WS_WOT + (size_t)l * 2 * MiB), D, 0);
        cvt_piece(W, scr, base, in[12] + (size_t)l * D * 2 * D, 2 * D, D, 0, 2 * D, (bf16_t*)(ws + WS_WKVT + (size_t)l * 4 * MiB), D, 0);
        norm_rows(W, in[1], in[10] + l * D, (bf16_t*)(ws + WS_MEMN + (size_t)l * MiB), nullptr, NB * MEM);
    }
    convert_layer_weights(W, scr, base, ws, in, 0);
    pg8::u64* ss0 = (pg8::u64*)(ws + WS_SS);
    { unsigned zz = 0u; asm volatile("" : "+v"(zz)); const u32x4 z = {zz, zz, zz, zz};
      for (int i = W.gw * 64 + W.lane; i < 6 * T * 8 / 16; i += W.ngw * 64) ((u32x4*)(ss0 + T))[i] = z; }
    for (int row0 = W.gw; row0 < T; row0 += 4 * W.ngw) {
        f32x4 v[4][4];
#pragma unroll
        for (int u = 0; u < 4; ++u) { const f32x4* xr = (const f32x4*)(in[0] + (size_t)(row0 + u * W.ngw) * D) + W.lane;
#pragma unroll
            for (int j = 0; j < 4; ++j) v[u][j] = xr[64 * j]; }
#pragma unroll
        for (int u = 0; u < 4; ++u) { const int row = row0 + u * W.ngw; float s = 0.f;
#pragma unroll
            for (int j = 0; j < 4; ++j) { const f32x4 x = v[u][j]; s += (x.x * x.x + x.y * x.y) + (x.z * x.z + x.w * x.w);
                u32x2 w; w.x = pk2(x.x, x.y); w.y = pk2(x.z, x.w); ((u32x2*)(XB + (size_t)row * D))[W.lane + 64 * j] = w; }
            s = wave_sum(s); if (W.lane == 0) ss0[row] = (pg8::u64)(s * pg8::SS_SCALE + 0.5f); }
    }
}
DEV void final_norm(const WaveId& W, const bf16_t* x, float* out, const float* g, const pg8::u64* ss) {
    f32x4 gg[4];
#pragma unroll
    for (int j = 0; j < 4; ++j) gg[j] = ((const f32x4*)g)[W.lane + 64 * j];
    const int rpw = T / W.ngw;
    for (int row0 = W.gw * rpw; row0 < (W.gw + 1) * rpw; row0 += 4) {
        u32x2 v[4][4]; pg8::u64 sq[4];
#pragma unroll
        for (int u = 0; u < 4; ++u) { const int row = row0 + u; sq[u] = ss[row]; const u32x2* xr = (const u32x2*)(x + (size_t)row * D) + W.lane;
#pragma unroll
            for (int j = 0; j < 4; ++j) v[u][j] = xr[64 * j]; }
#pragma unroll
        for (int u = 0; u < 4; ++u) { const int row = row0 + u; const float r = rsqrtf((float)sq[u] * (1.f / (pg8::SS_SCALE * D)) + EPS); f32x4* orow = (f32x4*)(out + (size_t)row * D) + W.lane;
#pragma unroll
            for (int j = 0; j < 4; ++j) { const u32x2 w = v[u][j];
                const f32x4 o = {bflo(w.x) * r * gg[j].x, bfhi(w.x) * r * gg[j].y, bflo(w.y) * r * gg[j].z, bfhi(w.y) * r * gg[j].w}; orow[64 * j] = o; } }
    }
}
DEV void conv_sc_phase(int gtid, int gthreads, bf16_t* scb, const bf16_t* cx, const float* w, bool dry) {
    const int c8 = (gtid & 63) * 8;
    const f32x4 w0a = *(const f32x4*)(w + c8), w0b = *(const f32x4*)(w + c8 + 4), w1a = *(const f32x4*)(w + 512 + c8), w1b = *(const f32x4*)(w + 512 + c8 + 4), w2a = *(const f32x4*)(w + 1024 + c8), w2b = *(const f32x4*)(w + 1024 + c8 + 4);
    const u32x4 z = {0u, 0u, 0u, 0u};
    constexpr int RB = 8;
    for (int blk = gtid >> 6; blk < T / RB; blk += gthreads >> 6) {
        const int t0 = blk * RB; const bool open = (t0 & (S - 1)) == 0;
        const bf16_t* cp = cx + (size_t)t0 * 512 + c8; bf16_t* sp = scb + (size_t)t0 * 512 + c8;
        u32x4 x[RB + 2], bb[RB];
        x[0] = open ? z : *(const u32x4*)(cp - 1024); x[1] = open ? z : *(const u32x4*)(cp - 512);
#pragma unroll
        for (int u = 0; u < RB; ++u) { x[u + 2] = *(const u32x4*)(cp + u * 512); bb[u] = *(const u32x4*)(sp + u * 512); }
#pragma unroll
        for (int u = 0; u < RB; ++u) {
            float r[8];
#define CONV1(k, W0, W1, W2, X0, X1, X2, BBv, F) r[k] = F(BBv) * (W0 * F(X0) + W1 * F(X1) + W2 * F(X2))
            CONV1(0, w0a.x, w1a.x, w2a.x, x[u].x, x[u + 1].x, x[u + 2].x, bb[u].x, bflo); CONV1(1, w0a.y, w1a.y, w2a.y, x[u].x, x[u + 1].x, x[u + 2].x, bb[u].x, bfhi);
            CONV1(2, w0a.z, w1a.z, w2a.z, x[u].y, x[u + 1].y, x[u + 2].y, bb[u].y, bflo); CONV1(3, w0a.w, w1a.w, w2a.w, x[u].y, x[u + 1].y, x[u + 2].y, bb[u].y, bfhi);
            CONV1(4, w0b.x, w1b.x, w2b.x, x[u].z, x[u + 1].z, x[u + 2].z, bb[u].z, bflo); CONV1(5, w0b.y, w1b.y, w2b.y, x[u].z, x[u + 1].z, x[u + 2].z, bb[u].z, bfhi);
            CONV1(6, w0b.z, w1b.z, w2b.z, x[u].w, x[u + 1].w, x[u + 2].w, bb[u].w, bflo); CONV1(7, w0b.w, w1b.w, w2b.w, x[u].w, x[u + 1].w, x[u + 2].w, bb[u].w, bfhi);
#undef CONV1
            u32x4 ov; ov.x = pk2(r[0], r[1]); ov.y = pk2(r[2], r[3]); ov.z = pk2(r[4], r[5]); ov.w = pk2(r[6], r[7]);
            if (!dry) *(u32x4*)(sp + u * 512) = ov; else asm volatile("" :: "v"(ov)); }
    }
}
DEV void ffn_fix_phase(int gtid, int gthreads, const bf16_t* sa, const bf16_t* su, bf16_t* fu, const float* cw, const float* cb, int strip0 = 0, int nstrip = T / 64) {
    constexpr int C8 = DFF / 8; const u32x4 z = {0u, 0u, 0u, 0u};
    for (int i0 = gtid; i0 < nstrip * 2 * C8; i0 += 3 * gthreads) {
        u32x4 x2[3], x1[3], x0[3], uu[3];
#pragma unroll
        for (int q = 0; q < 3; ++q) { const int i = i0 + q * gthreads; if (i < nstrip * 2 * C8) {
            const int sr = i / C8, c8 = (i - sr * C8) * 8, strip = strip0 + (sr >> 1), rr = sr & 1;
            const bool first = (strip & (S / 64 - 1)) == 0;
            const bf16_t* A = sa + (size_t)strip * 4 * DFF + c8; const bf16_t* Ap = A - 4 * DFF;
            x2[q] = *(const u32x4*)(A + rr * DFF);
            x1[q] = rr == 1 ? *(const u32x4*)A : (first ? z : *(const u32x4*)(Ap + 3 * DFF));
            x0[q] = first ? z : *(const u32x4*)(Ap + (2 + rr) * DFF);
            uu[q] = *(const u32x4*)(su + ((size_t)strip * 2 + rr) * DFF + c8); } }
#pragma unroll
        for (int q = 0; q < 3; ++q) { const int i = i0 + q * gthreads; if (i < nstrip * 2 * C8) {
            const int sr = i / C8, c8 = (i - sr * C8) * 8, strip = strip0 + (sr >> 1), rr = sr & 1, t = strip * 64 + rr;
            const f32x4 w0a = *(const f32x4*)(cw + c8), w0b = *(const f32x4*)(cw + c8 + 4), w1a = *(const f32x4*)(cw + DFF + c8), w1b = *(const f32x4*)(cw + DFF + c8 + 4), w2a = *(const f32x4*)(cw + 2 * DFF + c8), w2b = *(const f32x4*)(cw + 2 * DFF + c8 + 4);
            const f32x4 ba = *(const f32x4*)(cb + c8), bb = *(const f32x4*)(cb + c8 + 4);
            float r[8];
#define FM1(k, B0, W0, W1, W2, X0, X1, X2, Uv, F) r[k] = gelu_t(B0 + W0 * F(X0) + W1 * F(X1) + W2 * F(X2)) * F(Uv)
            FM1(0, ba.x, w0a.x, w1a.x, w2a.x, x0[q].x, x1[q].x, x2[q].x, uu[q].x, bflo); FM1(1, ba.y, w0a.y, w1a.y, w2a.y, x0[q].x, x1[q].x, x2[q].x, uu[q].x, bfhi);
            FM1(2, ba.z, w0a.z, w1a.z, w2a.z, x0[q].y, x1[q].y, x2[q].y, uu[q].y, bflo); FM1(3, ba.w, w0a.w, w1a.w, w2a.w, x0[q].y, x1[q].y, x2[q].y, uu[q].y, bfhi);
            FM1(4, bb.x, w0b.x, w1b.x, w2b.x, x0[q].z, x1[q].z, x2[q].z, uu[q].z, bflo); FM1(5, bb.y, w0b.y, w1b.y, w2b.y, x0[q].z, x1[q].z, x2[q].z, uu[q].z, bfhi);
            FM1(6, bb.z, w0b.z, w1b.z, w2b.z, x0[q].w, x1[q].w, x2[q].w, uu[q].w, bflo); FM1(7, bb.w, w0b.w, w1b.w, w2b.w, x0[q].w, x1[q].w, x2[q].w, uu[q].w, bfhi);
#undef FM1
            u32x4 ov; ov.x = pk2(r[0], r[1]); ov.y = pk2(r[2], r[3]); ov.z = pk2(r[4], r[5]); ov.w = pk2(r[6], r[7]);
            *(u32x4*)(fu + (size_t)t * DFF + c8) = ov; } }
    }
}

typedef short s16x4 __attribute__((ext_vector_type(4)));
DEV s16x4 vtr(const LAS unsigned char* p) { return __builtin_bit_cast(s16x4, __builtin_amdgcn_ds_read_tr16_b64_v4i16((LAS s16x4*)p)); }
DEV bf16x8 cat8(const s16x4 a, const s16x4 b) { return (bf16x8){a[0], a[1], a[2], a[3], b[0], b[1], b[2], b[3]}; }
DEV bf16x8 pk8(float a0, float a1, float a2, float a3, float a4, float a5, float a6, float a7) {
    u32x4 w; w.x = pk2(a0, a1); w.y = pk2(a2, a3); w.z = pk2(a4, a5); w.w = pk2(a6, a7); return __builtin_bit_cast(bf16x8, w); }
constexpr int VPITCH = 192;
DEV void pv_tile(f32x16& o0, f32x16& o1, const LAS unsigned char* vt, int lane, const bf16x8 (&pk)[4]) {
    const int hi = lane >> 5;
    const LAS unsigned char* vb = vt + (4 * hi + ((lane & 15) >> 2)) * VPITCH + ((lane >> 4) & 1) * 32 + (lane & 3) * 8;
    bf16x8 va[4];
#pragma unroll
    for (int ks = 0; ks < 4; ++ks) va[ks] = cat8(vtr(vb + (16 * ks) * VPITCH), vtr(vb + (16 * ks + 8) * VPITCH));
    asm volatile("" : "+v"(va[0]), "+v"(va[1]), "+v"(va[2]), "+v"(va[3]));
#pragma unroll
    for (int ks = 0; ks < 4; ++ks) o0 = __builtin_amdgcn_mfma_f32_32x32x16_bf16(va[ks], pk[ks], o0, 0, 0, 0);
#pragma unroll
    for (int ks = 0; ks < 4; ++ks) va[ks] = cat8(vtr(vb + (16 * ks) * VPITCH + 64), vtr(vb + (16 * ks + 8) * VPITCH + 64));
    asm volatile("" : "+v"(va[0]), "+v"(va[1]), "+v"(va[2]), "+v"(va[3]));
#pragma unroll
    for (int ks = 0; ks < 4; ++ks) o1 = __builtin_amdgcn_mfma_f32_32x32x16_bf16(va[ks], pk[ks], o1, 0, 0, 0);
}
DEV void store_ot(bf16_t* orow, const f32x16& o0, const f32x16& o1, int hi, float sc) {
#pragma unroll
    for (int g4 = 0; g4 < 4; ++g4) {
        u32x2 a; a.x = pk2(o0[4 * g4] * sc, o0[4 * g4 + 1] * sc); a.y = pk2(o0[4 * g4 + 2] * sc, o0[4 * g4 + 3] * sc);
        u32x2 b; b.x = pk2(o1[4 * g4] * sc, o1[4 * g4 + 1] * sc); b.y = pk2(o1[4 * g4 + 2] * sc, o1[4 * g4 + 3] * sc);
        *(u32x2*)(orow + 8 * g4 + 4 * hi) = a; *(u32x2*)(orow + 32 + 8 * g4 + 4 * hi) = b;
    }
}

DEV void sb_item(LAS unsigned char* vl, const bf16_t* Q, const bf16_t* Kk, const bf16_t* V, bf16_t* O, int b, int h, int qb, int lane, bool dry) {
    const int r32 = lane & 31, hi = lane >> 5, t0 = 32 * qb, t = t0 + r32; const size_t rowb = (size_t)b * S;
    bf16x8 qr[4]; { const bf16_t* qp = Q + (rowb + t0 + r32) * 512 + h * 64 + 8 * hi;
#pragma unroll
        for (int d0 = 0; d0 < 4; ++d0) qr[d0] = *(const bf16x8*)(qp + 16 * d0); }
    f32x16 o0, o1;
#pragma unroll
    for (int r = 0; r < 16; ++r) { o0[r] = 0.f; o1[r] = 0.f; }
    float carry = 1.f;
    const int c_hi = (t0 + 30) >> 6;
#pragma unroll 1
    for (int c = c_hi; c >= 0; --c) {
        const bf16_t* kp = Kk + (rowb + 64 * c + r32) * 512 + h * 64 + 8 * hi;
        bf16x8 k0[4], k1[4];
#pragma unroll
        for (int d0 = 0; d0 < 4; ++d0) { k0[d0] = *(const bf16x8*)(kp + 16 * d0); k1[d0] = *(const bf16x8*)(kp + (size_t)32 * 512 + 16 * d0); }
        u32x4 vreg[8];
#pragma unroll
        for (int j = 0; j < 8; ++j) { const int row = (lane >> 3) + 8 * j; vreg[j] = *(const u32x4*)(V + (rowb + 64 * c + row) * 512 + h * 64 + (lane & 7) * 8); }
        f32x16 p0, p1;
#pragma unroll
        for (int r = 0; r < 16; ++r) { p0[r] = 0.f; p1[r] = 0.f; }
#pragma unroll
        for (int d0 = 0; d0 < 4; ++d0) { p0 = __builtin_amdgcn_mfma_f32_32x32x16_bf16(k0[d0], qr[d0], p0, 0, 0, 0); p1 = __builtin_amdgcn_mfma_f32_32x32x16_bf16(k1[d0], qr[d0], p1, 0, 0, 0); }
        float u[32];
        const bool diag = (c == c_hi);
#pragma unroll
        for (int e = 0; e < 32; ++e) {
            const float z = e < 16 ? p0[e] : p1[e - 16];
            float uu = __builtin_amdgcn_rcpf(1.f + __builtin_amdgcn_exp2f(fminf(z, 126.f)));
            if (diag) { const int kv = 64 * c + 8 * ((e >> 2) & 3) + 4 * hi + (e & 3) + 32 * (e >> 4); if (kv >= t) uu = 1.f; }
            u[e] = uu;
        }
        float gl[8], gh[8];
#pragma unroll
        for (int i = 0; i < 8; ++i) { const float gp = (u[4 * i] * u[4 * i + 1]) * (u[4 * i + 2] * u[4 * i + 3]);
            const auto rr = __builtin_amdgcn_permlane32_swap(__float_as_uint(gp), __float_as_uint(gp), false, false); gl[i] = __uint_as_float(rr[0]); gh[i] = __uint_as_float(rr[1]); }
        float ag[8]; float run = carry;
#pragma unroll
        for (int i = 7; i >= 0; --i) { const float a_hi = run; run *= gh[i]; const float a_lo = run; run *= gl[i]; ag[i] = hi ? a_hi : a_lo; }
        carry = run;
        bf16x8 pk[4];
#pragma unroll
        for (int ks = 0; ks < 4; ++ks) { float w[8];
#pragma unroll
            for (int g = 0; g < 2; ++g) { const int i = 2 * ks + g;
                const float a3 = ag[i], a2 = a3 * u[4 * i + 3], a1 = a2 * u[4 * i + 2], a0 = a1 * u[4 * i + 1];
                w[4 * g] = (1.f - u[4 * i]) * a0; w[4 * g + 1] = (1.f - u[4 * i + 1]) * a1; w[4 * g + 2] = (1.f - u[4 * i + 2]) * a2; w[4 * g + 3] = (1.f - u[4 * i + 3]) * a3; }
            pk[ks] = pk8(w[0], w[1], w[2], w[3], w[4], w[5], w[6], w[7]); }
#pragma unroll
        for (int j = 0; j < 8; ++j) { const int row = (lane >> 3) + 8 * j; *(LAS u32x4*)(vl + row * VPITCH + (lane & 7) * 16) = vreg[j]; }
        pv_tile(o0, o1, vl, lane, pk);
        if (__all(carry < 7.8e-31f)) break;
    }
    if (!dry) store_ot(O + (rowb + t0 + r32) * 512 + h * 64, o0, o1, hi, 1.f); else asm volatile("" :: "v"(o0), "v"(o1));
}
DEV void sb_phase(const WaveId& W, LAS unsigned char* lds, unsigned char* ws, bool dry) {
    LAS unsigned char* vl = lds + W.wave * 12288;
    const bf16_t* Q = (const bf16_t*)(ws + WS_QA); const bf16_t* Kk = (const bf16_t*)(ws + WS_KA); const bf16_t* V = (const bf16_t*)(ws + WS_VA);
    constexpr int NITEM = NB * 8 * (S / 32);
    for (int it = W.gw; it < NITEM; it += W.ngw) {
        const int qb = it & 255, h = (it >> 8) & 7, b = it >> 11;
        sb_item(vl, Q, Kk, V, (bf16_t*)(ws + WS_QA), b, h, qb, W.lane, dry);
    }
}

constexpr int IDX_CTL_OFF = 131072 + 1024;
DEV unsigned fkey2(float v) { const int u = (int)__float_as_uint(v); const int a = u >> 31; unsigned k;
    asm("v_bitop3_b32 %0, %1, %2, %3 bitop3:0x36" : "=v"(k) : "v"(a), "v"(u), "s"(0x80000000u)); return k; }
DEV float relu1(float x) { return __builtin_amdgcn_fmed3f(x, 0.f, 3.0e38f); }
DEV void idx_prefetch(bf16x8 (&afr)[4], float (&w)[16], bf16x8 (&b0)[4], bf16x8 (&b1)[4], const bf16_t* IQ, const bf16_t* IK, const float* IWp, int b, int t0, int wid, int lane) {
    const int r32 = lane & 31, hh = lane >> 5; const size_t rowb = (size_t)b * S;
    { const int qi = 2 * (r32 >> 4) + ((r32 >> 2) & 1), head = (r32 & 3) + 4 * ((r32 >> 3) & 1);
        const bf16_t* ap = IQ + (rowb + t0 + qi) * 512 + head * 64 + 8 * hh;
#pragma unroll
        for (int ks = 0; ks < 4; ++ks) afr[ks] = *(const bf16x8*)(ap + 16 * ks); }
#pragma unroll
    for (int r = 0; r < 16; ++r) w[r] = IWp[(rowb + t0 + 2 * (r >> 3) + hh) * 8 + (r & 7)];
    const int jmax = (t0 + 3) >> 5;
    { const int j0 = wid < jmax ? wid : jmax, j1 = wid + 8 < jmax ? wid + 8 : jmax;
      const bf16_t* p0 = IK + ((rowb >> 5) + j0) * 2048 + (hh * 32 + r32) * 8; const bf16_t* p1 = IK + ((rowb >> 5) + j1) * 2048 + (hh * 32 + r32) * 8;
#pragma unroll
      for (int ks = 0; ks < 4; ++ks) { b0[ks] = *(const bf16x8*)(p0 + ks * 512); b1[ks] = *(const bf16x8*)(p1 + ks * 512); } }
}
DEV void idx_ticket(unsigned tk, int& b, int& t0) { b = (int)(tk & 1u); t0 = (int)(S / 4 - 1 - (tk >> 1)) * 4; }
DEV void idx_unit(LAS unsigned char* lds, const bf16_t* IQ, const bf16_t* IK, const float* IWp, unsigned* BM, int b, int t0, unsigned* qhead, int par, unsigned& next_tk, int wid, int lane,
                  bf16x8 (&afr)[4], float (&w)[16], bf16x8 (&b0)[4], bf16x8 (&b1)[4]) {
    const int r32 = lane & 31, hh = lane >> 5; const size_t rowb = (size_t)b * S;
    LAS unsigned* QW = (LAS unsigned*)(lds + IDX_CTL_OFF + 32);
    unsigned tk_reg = 0u; if (wid == 0 && lane == 0) tk_reg = __hip_atomic_fetch_add(qhead, 1u, __ATOMIC_RELAXED, __HIP_MEMORY_SCOPE_AGENT);
    const int tmax = t0 + 3, jmax = tmax >> 5;
    LAS unsigned* SCO = (LAS unsigned*)lds;
    bf16x8 b2[4];
#pragma unroll
    for (int ks = 0; ks < 4; ++ks) b2[ks] = afr[ks];
#define IDX_LOADB(dst, jj) do { const int jc_ = (jj) < jmax ? (jj) : jmax; const bf16_t* bp_ = IK + ((rowb >> 5) + jc_) * 2048 + (hh * 32 + r32) * 8; \
        _Pragma("unroll") for (int ks = 0; ks < 4; ++ks) dst[ks] = *(const bf16x8*)(bp_ + ks * 512); } while (0)
#define IDX_COMP(src, jj) do { f32x16 acc; _Pragma("unroll") for (int r = 0; r < 16; ++r) acc[r] = 0.f; \
        _Pragma("unroll") for (int ks = 0; ks < 4; ++ks) acc = __builtin_amdgcn_mfma_f32_32x32x16_bf16(afr[ks], src[ks], acc, 0, 0, 0); \
        float s0, s1;     \
        { const float ra_ = relu1(acc[0]), rb_ = relu1(acc[8]); asm("v_mul_f32_e32 %0, %1, %2" : "=v"(s0) : "v"(w[0]), "v"(ra_)); asm("v_mul_f32_e32 %0, %1, %2" : "=v"(s1) : "v"(w[8]), "v"(rb_)); } \
        _Pragma("unroll") for (int hd = 1; hd < 8; ++hd) { const float ra_ = relu1(acc[hd]), rb_ = relu1(acc[8 + hd]); \
            asm("v_fmac_f32_e32 %0, %1, %2" : "+v"(s0) : "v"(w[hd]), "v"(ra_)); asm("v_fmac_f32_e32 %0, %1, %2" : "+v"(s1) : "v"(w[8 + hd]), "v"(rb_)); } \
        unsigned k0_ = fkey2(s0), k1_ = fkey2(s1); const int key = 32 * (jj) + r32; \
        if ((jj) >= jmax) { asm volatile("" ::: "memory"); k0_ = key <= t0 + hh ? k0_ : 0u; k1_ = key <= t0 + 2 + hh ? k1_ : 0u; }     \
        if ((jj) <= jmax) { SCO[hh * 8192 + key] = k0_; SCO[(2 + hh) * 8192 + key] = k1_; } } while (0)
#ifndef IDX_REP_MFMA
#define IDX_REP_MFMA 1
#endif
#ifndef IDX_REP_SEL
#define IDX_REP_SEL 1
#endif
#ifdef IDX_DRY_COMPUTE
#pragma unroll 1
    for (int j = wid; j <= jmax; j += 24) { IDX_COMP(b0, j); asm volatile("" : "+v"(b0[0]), "+v"(b1[0]), "+v"(b2[0])); IDX_COMP(b1, j + 8); IDX_COMP(b2, j + 16); }
#endif
#pragma unroll 1
    for (int rpm = 0; rpm < IDX_REP_MFMA; ++rpm) {
#pragma unroll 1
    for (int j = wid; j <= jmax; j += 24) {
        IDX_LOADB(b2, j + 16); IDX_COMP(b0, j);
        IDX_LOADB(b0, j + 24); IDX_COMP(b1, j + 8);
        IDX_LOADB(b1, j + 32); IDX_COMP(b2, j + 16);
    }
    }
#undef IDX_LOADB
#undef IDX_COMP
    LAS unsigned* thr = (LAS unsigned*)(lds + IDX_CTL_OFF);
    if (wid == 0 && lane < 32) ((LAS unsigned*)(lds + IDX_CTL_OFF + 64))[lane] = 0u;
    if (wid == 0 && lane == 0) QW[par ^ 1] = tk_reg;
    LDS_WAIT(); __builtin_amdgcn_s_barrier(); asm volatile("" ::: "memory");
    next_tk = QW[par ^ 1];
    if (next_tk < (unsigned)(T / 4)) { int nb, nt0; idx_ticket(next_tk, nb, nt0); idx_prefetch(afr, w, b0, b1, IQ, IK, IWp, nb, nt0, wid, lane); }
    {
        const int q = wid & 3, h = wid >> 2, n = t0 + q + 1;
        volatile LAS unsigned* xme = (volatile LAS unsigned*)(lds + IDX_CTL_OFF + 64) + (q * 2 + h) * 4;
        volatile LAS unsigned* xpa = (volatile LAS unsigned*)(lds + IDX_CTL_OFF + 64) + (q * 2 + (h ^ 1)) * 4;
        unsigned T_ = 1u;
        if (n > 256) {
            LAS unsigned* row = SCO + q * 8192 + lane;
            unsigned r[64];
            const int nil = (jmax >> 1) >= h ? (((jmax >> 1) - h) >> 1) + 1 : 0;
#define IDX_FOR_LIVE(BODY) _Pragma("unroll") for (int g8_ = 0; g8_ < 8; ++g8_) if (8 * g8_ < nil) { _Pragma("unroll") for (int u8_ = 0; u8_ < 8; ++u8_) { const int il = 8 * g8_ + u8_; BODY } }
#pragma unroll
            for (int g8_ = 0; g8_ < 8; ++g8_) if (8 * g8_ < nil) {
                if (8 * g8_ + 8 < nil) {
#pragma unroll
                    for (int u8_ = 0; u8_ < 8; ++u8_) { const int il = 8 * g8_ + u8_; r[il] = row[64 * (2 * il + h)]; }
                } else {
#pragma unroll
                    for (int u8_ = 0; u8_ < 8; ++u8_) { const int il = 8 * g8_ + u8_; r[il] = (2 * (2 * il + h) + hh <= jmax) ? row[64 * (2 * il + h)] : 0u; }
                } }
            unsigned seq = 0u;
#define IDX_XCHG(val, out) do { ++seq; const int pb_ = (seq & 1u) * 2; if (lane == 0) { xme[pb_ + 1] = (val); xme[pb_] = seq; } \
                while (xpa[pb_] != seq) __builtin_amdgcn_s_sleep(0); (out) = xpa[pb_ + 1]; } while (0)
#define IDX_XCHG16(val, out) do { ++seq; const int pb_ = (seq & 1u) * 2; if (lane == 0) xme[pb_] = (seq << 16) | (val); unsigned w_; \
                while (((w_ = xpa[pb_]) >> 16) != (seq & 0xffffu)) __builtin_amdgcn_s_sleep(0); (out) = w_ & 0xffffu; } while (0)
#pragma unroll 1
            for (int rps = 0; rps < IDX_REP_SEL; ++rps) {
            unsigned mx = 0u;
            IDX_FOR_LIVE( mx = max(mx, r[il]); )
            mx = max(mx, (unsigned)__builtin_amdgcn_update_dpp(0, (int)mx, 0x111, 0xf, 0xf, false)); mx = max(mx, (unsigned)__builtin_amdgcn_update_dpp(0, (int)mx, 0x112, 0xf, 0xf, false));
            mx = max(mx, (unsigned)__builtin_amdgcn_update_dpp(0, (int)mx, 0x114, 0xf, 0xf, false)); mx = max(mx, (unsigned)__builtin_amdgcn_update_dpp(0, (int)mx, 0x118, 0xf, 0xf, false));
            mx = max(mx, (unsigned)__builtin_amdgcn_update_dpp(0, (int)mx, 0x142, 0xa, 0xf, false)); mx = max(mx, (unsigned)__builtin_amdgcn_update_dpp(0, (int)mx, 0x143, 0xc, 0xf, false));
            mx = (unsigned)__builtin_amdgcn_readlane((int)mx, 63);
            { LAS unsigned* h0_ = (LAS unsigned*)(lds + IDX_CTL_OFF + 1024) + q * 768; h0_[128 * h + lane] = 0u; h0_[128 * h + 64 + lane] = 0u; asm volatile("" ::: "memory"); }
            { unsigned pm_; IDX_XCHG(mx, pm_); mx = max(mx, pm_); }
            unsigned lo_ = 1u, hi_ = mx + 1u, chi_ = 0u, xgt_ = 1u, xeq_ = 0u, mt_ = 0u; bool done_ = false;
            if (mx > 0x82000000u) {
                const unsigned c1 = mx - (1u << 23), c2 = mx - (3u << 23);
                unsigned ca_ = 0, cb_ = 0, cc_ = 0, cd_ = 0; const unsigned c1v = c1, c2v = c2;
#define IDX_CNT4B(A, B, C, Dd) asm volatile("v_cmp_ge_u32_e64 s[88:89], %4, %8\n\tv_cmp_ge_u32_e64 s[90:91], %5, %8\n\tv_cmp_ge_u32_e64 s[92:93], %6, %8\n\tv_cmp_ge_u32_e64 s[94:95], %7, %8\n\t" \
                    "v_addc_co_u32_e64 %0, s[88:89], %0, 0, s[88:89]\n\tv_addc_co_u32_e64 %1, s[90:91], %1, 0, s[90:91]\n\tv_addc_co_u32_e64 %0, s[92:93], %0, 0, s[92:93]\n\tv_addc_co_u32_e64 %1, s[94:95], %1, 0, s[94:95]\n\t" \
                    "v_cmp_ge_u32_e64 s[88:89], %4, %9\n\tv_cmp_ge_u32_e64 s[90:91], %5, %9\n\tv_cmp_ge_u32_e64 s[92:93], %6, %9\n\tv_cmp_ge_u32_e64 s[94:95], %7, %9\n\t" \
                    "v_addc_co_u32_e64 %2, s[88:89], %2, 0, s[88:89]\n\tv_addc_co_u32_e64 %3, s[90:91], %3, 0, s[90:91]\n\tv_addc_co_u32_e64 %2, s[92:93], %2, 0, s[92:93]\n\tv_addc_co_u32_e64 %3, s[94:95], %3, 0, s[94:95]" \
                    : "+v"(ca_), "+v"(cb_), "+v"(cc_), "+v"(cd_) : "v"(A), "v"(B), "v"(C), "v"(Dd), "v"(c1v), "v"(c2v) : "s88", "s89", "s90", "s91", "s92", "s93", "s94", "s95")
#pragma unroll
                for (int g8_ = 0; g8_ < 8; ++g8_) if (8 * g8_ < nil) { IDX_CNT4B(r[8 * g8_], r[8 * g8_ + 1], r[8 * g8_ + 2], r[8 * g8_ + 3]); IDX_CNT4B(r[8 * g8_ + 4], r[8 * g8_ + 5], r[8 * g8_ + 6], r[8 * g8_ + 7]); }
#undef IDX_CNT4B
                int pk = (int)((ca_ + cb_) | ((cc_ + cd_) << 16));
                pk += __builtin_amdgcn_update_dpp(0, pk, 0x111, 0xf, 0xf, false);
                pk += __builtin_amdgcn_update_dpp(0, pk, 0x112, 0xf, 0xf, false);
                pk += __builtin_amdgcn_update_dpp(0, pk, 0x114, 0xf, 0xf, false);
                pk += __builtin_amdgcn_update_dpp(0, pk, 0x118, 0xf, 0xf, false);
                pk += __builtin_amdgcn_update_dpp(0, pk, 0x142, 0xa, 0xf, false);
                unsigned tot = (unsigned)__builtin_amdgcn_readlane(pk, 31) + (unsigned)__builtin_amdgcn_readlane(pk, 63);
                { unsigned pt_; IDX_XCHG(tot, pt_); tot += pt_; }
                const unsigned t1 = tot & 0xffffu, t2 = tot >> 16;
                if (t1 == 256u) { xgt_ = c1; mt_ = 0u; done_ = true; }
                else if (t1 > 256u) lo_ = c1;
                else { hi_ = c1; chi_ = t1;
                       if (t2 == 256u) { xgt_ = c2; mt_ = 0u; done_ = true; }
                       else if (t2 > 256u) lo_ = c2;
                       else { hi_ = c2; chi_ = t2; } }
                if (!done_ && hi_ - lo_ == 1u) { xgt_ = hi_; xeq_ = lo_; mt_ = 256u - chi_; done_ = true; }
            }
            { LAS unsigned* hist3 = (LAS unsigned*)(lds + IDX_CTL_OFF + 1024) + q * 768; int kb = 0;
#pragma unroll 1
              for (int round = 0; round < 6 && !done_; ++round) {
                const unsigned wdt = hi_ - lo_;
                const int sh = wdt <= 256u ? 0 : 24 - (int)__builtin_clz(wdt - 1u);
                LAS unsigned* hist = hist3 + 256 * kb; kb = kb == 2 ? 0 : kb + 1;
                { LAS unsigned* hn = hist3 + 256 * kb; hn[128 * h + lane] = 0u; hn[128 * h + 64 + lane] = 0u; }
                const unsigned lov = lo_;
                if (round == 0) {
                    IDX_FOR_LIVE( const unsigned d = r[il] - lov; if (d < wdt) __hip_atomic_fetch_add(hist + (d >> sh), 1u, __ATOMIC_RELAXED, __HIP_MEMORY_SCOPE_WORKGROUP); )
                } else {
#pragma unroll
                    for (int g8_ = 0; g8_ < 8; ++g8_) if (8 * g8_ < nil) {
#pragma unroll
                        for (int u4_ = 0; u4_ < 2; ++u4_) { const int il = 8 * g8_ + 4 * u4_;
                            const unsigned d0 = r[il] - lov, d1 = r[il + 1] - lov, d2 = r[il + 2] - lov, d3 = r[il + 3] - lov;
                            if (min(min(d0, d1), min(d2, d3)) < wdt) {
                                if (d0 < wdt) __hip_atomic_fetch_add(hist + (d0 >> sh), 1u, __ATOMIC_RELAXED, __HIP_MEMORY_SCOPE_WORKGROUP);
                                if (d1 < wdt) __hip_atomic_fetch_add(hist + (d1 >> sh), 1u, __ATOMIC_RELAXED, __HIP_MEMORY_SCOPE_WORKGROUP);
                                if (d2 < wdt) __hip_atomic_fetch_add(hist + (d2 >> sh), 1u, __ATOMIC_RELAXED, __HIP_MEMORY_SCOPE_WORKGROUP);
                                if (d3 < wdt) __hip_atomic_fetch_add(hist + (d3 >> sh), 1u, __ATOMIC_RELAXED, __HIP_MEMORY_SCOPE_WORKGROUP); } } }
                }
                LDS_WAIT(); { unsigned d_; IDX_XCHG16(0u, d_); (void)d_; }
                const u32x4 hb = *(const LAS u32x4*)(hist + 4 * lane);
                const unsigned s4 = (hb.x + hb.y) + (hb.z + hb.w);
                int pf = (int)s4;
                pf += __builtin_amdgcn_update_dpp(0, pf, 0x111, 0xf, 0xf, false); pf += __builtin_amdgcn_update_dpp(0, pf, 0x112, 0xf, 0xf, false);
                pf += __builtin_amdgcn_update_dpp(0, pf, 0x114, 0xf, 0xf, false); pf += __builtin_amdgcn_update_dpp(0, pf, 0x118, 0xf, 0xf, false);
                pf += __builtin_amdgcn_update_dpp(0, pf, 0x142, 0xa, 0xf, false); pf += __builtin_amdgcn_update_dpp(0, pf, 0x143, 0xc, 0xf, false);
                const unsigned suf = (unsigned)__builtin_amdgcn_readlane(pf, 63) - (unsigned)pf + s4;
                const unsigned long long okm = __ballot(chi_ + suf >= 256u);
                const int L = 63 - (int)__builtin_clzll(okm);
                const unsigned above = chi_ + (unsigned)__builtin_amdgcn_readlane((int)(suf - s4), L);
                const unsigned h0 = (unsigned)__builtin_amdgcn_readlane((int)hb.x, L), h1 = (unsigned)__builtin_amdgcn_readlane((int)hb.y, L),
                               h2 = (unsigned)__builtin_amdgcn_readlane((int)hb.z, L), h3 = (unsigned)__builtin_amdgcn_readlane((int)hb.w, L);
                unsigned Bsel, cab, cnb;
                if (above + h3 >= 256u) { Bsel = 3u; cab = above; cnb = h3; }
                else if (above + h3 + h2 >= 256u) { Bsel = 2u; cab = above + h3; cnb = h2; }
                else if (above + h3 + h2 + h1 >= 256u) { Bsel = 1u; cab = above + h3 + h2; cnb = h1; }
                else { Bsel = 0u; cab = above + h3 + h2 + h1; cnb = h0; }
                Bsel += 4u * (unsigned)L;
                const unsigned nlo = lo_ + (Bsel << sh); unsigned nhi = nlo + (1u << sh); if (nhi > hi_ || nhi < nlo) nhi = hi_;
                if (cab + cnb == 256u) { xgt_ = nlo; mt_ = 0u; done_ = true; }
                else if (sh == 0) { xgt_ = nlo + 1u; xeq_ = nlo; mt_ = 256u - cab; done_ = true; }
                else { lo_ = nlo; hi_ = nhi; chi_ = cab; }
              } }
#ifdef IDX_XTRA
#pragma unroll 1
            for (int xr = 0; xr < IDX_XTRA; ++xr) { unsigned dsum = 0; const unsigned cv = xgt_ + (unsigned)xr;
                IDX_FOR_LIVE( dsum += r[il] >= cv; )
                int pk = (int)dsum;
                pk += __builtin_amdgcn_update_dpp(0, pk, 0x111, 0xf, 0xf, false); pk += __builtin_amdgcn_update_dpp(0, pk, 0x112, 0xf, 0xf, false); pk += __builtin_amdgcn_update_dpp(0, pk, 0x114, 0xf, 0xf, false);
                pk += __builtin_amdgcn_update_dpp(0, pk, 0x118, 0xf, 0xf, false); pk += __builtin_amdgcn_update_dpp(0, pk, 0x142, 0xa, 0xf, false);
                unsigned tot = (unsigned)__builtin_amdgcn_readlane(pk, 31) + (unsigned)__builtin_amdgcn_readlane(pk, 63);
                { unsigned pt_; IDX_XCHG16(tot, pt_); tot += pt_; } asm volatile("" :: "s"(tot)); }
#endif
            T_ = xgt_;
            if (mt_ != 0u) {
                if (h == 0) { unsigned run = 0u;
#pragma unroll 1
                    for (int i = 0; i <= (jmax >> 1); ++i) { const bool ok_ = 2 * i + hh <= jmax; const unsigned kv = ok_ ? row[64 * i] : 0u; const bool eq = kv == xeq_; const unsigned long long bm = __ballot(eq);
                        const unsigned rank = run + __builtin_amdgcn_mbcnt_hi((unsigned)(bm >> 32), __builtin_amdgcn_mbcnt_lo((unsigned)bm, 0u));
                        if (eq && rank >= mt_) row[64 * i] = 0u;
                        run += (unsigned)__popcll(bm); } }
                T_ = xeq_;
            }
            if (mt_ != 0u) {
                LDS_WAIT(); { unsigned d_; IDX_XCHG16(0u, d_); (void)d_; }
                IDX_FOR_LIVE( r[il] = (2 * (2 * il + h) + hh <= jmax) ? row[64 * (2 * il + h)] : 0u; )
            }
            { int ov0 = 0, ov1 = 0; const unsigned tv_ = T_;
#define IDX_EMIT4(OV, A, B, C, Dd, L0) asm volatile("v_cmp_ge_u32_e64 s[88:89], %1, %5\n\tv_cmp_ge_u32_e64 s[90:91], %2, %5\n\tv_cmp_ge_u32_e64 s[92:93], %3, %5\n\tv_cmp_ge_u32_e64 s[94:95], %4, %5\n\t" \
                  "v_writelane_b32 %0, s88, %6\n\tv_writelane_b32 %0, s89, %7\n\tv_writelane_b32 %0, s90, %8\n\tv_writelane_b32 %0, s91, %9\n\t" \
                  "v_writelane_b32 %0, s92, %10\n\tv_writelane_b32 %0, s93, %11\n\tv_writelane_b32 %0, s94, %12\n\tv_writelane_b32 %0, s95, %13" \
                  : "+v"(OV) : "v"(A), "v"(B), "v"(C), "v"(Dd), "v"(tv_), "n"(L0), "n"((L0) + 1), "n"((L0) + 2), "n"((L0) + 3), "n"((L0) + 4), "n"((L0) + 5), "n"((L0) + 6), "n"((L0) + 7) \
                  : "s88", "s89", "s90", "s91", "s92", "s93", "s94", "s95")
#pragma unroll
              for (int g8_ = 0; g8_ < 8; ++g8_) if (8 * g8_ < nil) {
                  if (g8_ < 4) { IDX_EMIT4(ov0, r[8 * g8_], r[8 * g8_ + 1], r[8 * g8_ + 2], r[8 * g8_ + 3], 16 * g8_); IDX_EMIT4(ov0, r[8 * g8_ + 4], r[8 * g8_ + 5], r[8 * g8_ + 6], r[8 * g8_ + 7], 16 * g8_ + 8); }
                  else { IDX_EMIT4(ov1, r[8 * g8_], r[8 * g8_ + 1], r[8 * g8_ + 2], r[8 * g8_ + 3], 16 * (g8_ - 4)); IDX_EMIT4(ov1, r[8 * g8_ + 4], r[8 * g8_ + 5], r[8 * g8_ + 6], r[8 * g8_ + 7], 16 * (g8_ - 4) + 8); } }
#undef IDX_EMIT4
              const int jl_ = (t0 | 255) >> 5, tile0 = 4 * (lane >> 1) + 2 * h + (lane & 1);
              unsigned* bp_ = BM + ((size_t)b * 256 + tile0) * S + t0 + q;
              if (tile0 <= jl_) *bp_ = (unsigned)ov0;
              if (tile0 + 128 <= jl_) bp_[(size_t)128 * S] = (unsigned)ov1; }
            }
#undef IDX_XCHG
#undef IDX_XCHG16
#undef IDX_FOR_LIVE
        }
        if (lane == 0 && h == 0) thr[q] = T_;
    }
#ifdef PROBE_VALU
    { float a0 = (float)lane, a1 = a0 + 1.f, a2 = a0 + 2.f, a3 = a0 + 3.f, a4 = a0 + 4.f, a5 = a0 + 5.f, a6 = a0 + 6.f, a7 = a0 + 7.f; const float m = 1.0000001f, c = 1e-9f;
#pragma unroll 1
      for (int it = 0; it < 64; ++it) {
#pragma unroll
          for (int u = 0; u < 8; ++u) { a0 = a0 * m + c; a1 = a1 * m + c; a2 = a2 * m + c; a3 = a3 * m + c; a4 = a4 * m + c; a5 = a5 * m + c; a6 = a6 * m + c; a7 = a7 * m + c; } }
      asm volatile("" :: "v"(a0), "v"(a1), "v"(a2), "v"(a3), "v"(a4), "v"(a5), "v"(a6), "v"(a7)); }
#endif
    if (t0 < 256) {
    LDS_WAIT(); __builtin_amdgcn_s_barrier(); asm volatile("" ::: "memory");
    { const unsigned tq0 = thr[hh], tq1 = thr[2 + hh];
#pragma unroll 4
      for (int j = wid; j <= ((t0 | 255) >> 5); j += 8) {
          bool s0 = false, s1 = false;
          if (j <= jmax) { s0 = SCO[hh * 8192 + 32 * j + r32] >= tq0; s1 = SCO[(2 + hh) * 8192 + 32 * j + r32] >= tq1; }
          const unsigned long long b0_ = __ballot(s0), b1_ = __ballot(s1);
          if (lane == 0) { u32x4 o; o.x = (unsigned)b0_; o.y = (unsigned)(b0_ >> 32); o.z = (unsigned)b1_; o.w = (unsigned)(b1_ >> 32); *(u32x4*)(BM + ((size_t)b * 256 + j) * S + t0) = o; }
      } }
    }
    LDS_WAIT(); __builtin_amdgcn_s_barrier();
}
DEV void idx_phase(LAS unsigned char* lds, unsigned char* ws, unsigned* qhead, int wid, int lane) {
    constexpr unsigned NUNIT = T / 4;
    const bf16_t* IQ = (const bf16_t*)(ws + WS_IQ); const bf16_t* IK = (const bf16_t*)(ws + WS_IK); const float* IW = (const float*)(ws + WS_IW);
    LAS unsigned* QW = (LAS unsigned*)(lds + IDX_CTL_OFF + 32);
    if (wid == 0 && lane == 0) QW[0] = __hip_atomic_fetch_add(qhead, 1u, __ATOMIC_RELAXED, __HIP_MEMORY_SCOPE_AGENT);
    LDS_WAIT(); __builtin_amdgcn_s_barrier(); asm volatile("" ::: "memory");
    unsigned tk = QW[0];
    bf16x8 afr[4], b0[4], b1[4]; float w[16];
    if (tk < NUNIT) { int b, t0; idx_ticket(tk, b, t0); idx_prefetch(afr, w, b0, b1, IQ, IK, IW, b, t0, wid, lane); }
#pragma unroll 1
    for (int k = 0; tk < NUNIT; ++k) {
        int b, t0; idx_ticket(tk, b, t0); unsigned ntk = NUNIT;
        idx_unit(lds, IQ, IK, IW, (unsigned*)(ws + WS_BM), b, t0, qhead, k & 1, ntk, wid, lane, afr, w, b0, b1);
        tk = ntk;
    }
}

DEV void kn_phase(const WaveId& W, const bf16_t* Kk, float* KN) {
    for (int item = W.gw; item < NB * 8 * (S / 64); item += W.ngw) {
        const int b = item / (8 * (S / 64)), h = (item / (S / 64)) & 7, tile = item % (S / 64);
        const bf16_t* kp = Kk + ((size_t)b * S + tile * 64 + W.lane) * 512 + h * 64;
        float ss = 0.f;
#pragma unroll
        for (int c = 0; c < 8; ++c) { const u32x4 v = *(const u32x4*)(kp + 8 * c);
#pragma unroll
            for (int e = 0; e < 4; ++e) { const float lo = __uint_as_float(v[e] << 16), hi = __uint_as_float(v[e] & 0xffff0000u); ss += lo * lo + hi * hi; } }
        const float m = wave_max(ss);
        if (W.lane == 0) KN[item] = sqrtf(m) * 1.01f;
    }
}
#include <hip/hip_bf16.h>
namespace attn_body {
using bf16=__hip_bfloat16;
using bf16x8=__attribute__((ext_vector_type(8)))short;
using s16x4=__attribute__((ext_vector_type(4)))short;
using f32x16=__attribute__((ext_vector_type(16)))float;
using u32x4=__attribute__((ext_vector_type(4)))unsigned;
constexpr int BATCH=2,NHEAD=8,SEQ=8192,D=64,DM=NHEAD*D;
constexpr int NW=8,QBLK=32,QB=QBLK*NW,KVBLK=64,NQB=SEQ/QB;
constexpr int ATTN_PITCH=DM, ATTN_UNIT_ROWS=QB;
__device__ __forceinline__ int crow(int r,int hi){return (r&3)+8*(r>>2)+4*hi;}
#define SBAR() __builtin_amdgcn_sched_barrier(0)
__device__ __forceinline__ void cmask(f32x16&p0,f32x16&p1,int jb,int qrel,int hi){
  const float NEG=-INFINITY; int kb=64*jb+4*hi;
  #pragma unroll
  for(int r=0;r<16;++r){int kv=kb+(r&3)+8*(r>>2); if(kv>qrel)p0[r]=NEG; if(kv+32>qrel)p1[r]=NEG;}
}

constexpr int NSLOT=3, SLOTB=8192;
constexpr int LDS_K=0, LDS_V=NSLOT*SLOTB, LDS_WS=2*NSLOT*SLOTB, LDS_OST=LDS_WS+NW*64*4, LDS_BYTES=LDS_OST+NW*4096;
constexpr float C2=0.125f*1.4426950408889634f;
__device__ __forceinline__ void glds16(const void*gsrc,unsigned lds_dst){unsigned keep;
  asm volatile("s_mov_b32 %0, m0\n\ts_mov_b32 m0, %2\n\ts_nop 0\n\tglobal_load_lds_dwordx4 %1, off\n\ts_mov_b32 m0, %0":"=&s"(keep):"v"(gsrc),"s"(lds_dst):"memory");}
__device__ __forceinline__ float max3f(float a,float b,float c){float r;asm("v_max3_f32 %0, %1, %2, %3":"=v"(r):"v"(a),"v"(b),"v"(c));return r;}
__device__ __forceinline__ float max2f(float a,float b){float r;asm("v_max_f32_e32 %0, %1, %2":"=v"(r):"v"(a),"v"(b));return r;}
__device__ __forceinline__ float fadd_s(float a,float b){float r;asm("v_add_f32_e32 %0, %1, %2":"=v"(r):"v"(a),"v"(b));return r;}
__device__ __forceinline__ float fsub_s(float a,float b){float r;asm("v_sub_f32_e32 %0, %1, %2":"=v"(r):"v"(a),"v"(b));return r;}
typedef float f32x2_t __attribute__((ext_vector_type(2))); typedef __bf16 bf16x2_t __attribute__((ext_vector_type(2)));
__device__ __forceinline__ unsigned cvtpk_s(float lo,float hi){f32x2_t v={lo,hi};bf16x2_t b=__builtin_convertvector(v,bf16x2_t);return __builtin_bit_cast(unsigned,b);}
#define WAIT_BAR(N) asm volatile("s_waitcnt vmcnt(" #N ") lgkmcnt(0)\n\ts_barrier":::"memory")

__device__ __forceinline__ void qkt(f32x16&p0,f32x16&p1,const char*Kslot,const bf16x8*qr,const f32x16&negm,int r32,int hi){
  const char*kb=Kslot+hi*1024+r32*16;
  #pragma unroll
  for(int d0=0;d0<4;++d0){
    const bf16x8 b0=*reinterpret_cast<const bf16x8*>(kb+d0*2048);
    const bf16x8 b1=*reinterpret_cast<const bf16x8*>(kb+d0*2048+512);
    if(d0==0){p0=__builtin_amdgcn_mfma_f32_32x32x16_bf16(b0,qr[0],negm,0,0,0);p1=__builtin_amdgcn_mfma_f32_32x32x16_bf16(b1,qr[0],negm,0,0,0);}
    else{p0=__builtin_amdgcn_mfma_f32_32x32x16_bf16(b0,qr[d0],p0,0,0,0);p1=__builtin_amdgcn_mfma_f32_32x32x16_bf16(b1,qr[d0],p1,0,0,0);}}
}
typedef __attribute__((address_space(3))) const char* lds_cptr;
typedef short v4i16_t __attribute__((ext_vector_type(4)));
__device__ __forceinline__ void kload8(bf16x8*kf,lds_cptr kp){
  kf[0]=*(const __attribute__((address_space(3))) bf16x8*)(kp);      kf[1]=*(const __attribute__((address_space(3))) bf16x8*)(kp+512);
  kf[2]=*(const __attribute__((address_space(3))) bf16x8*)(kp+2048); kf[3]=*(const __attribute__((address_space(3))) bf16x8*)(kp+2560);
  kf[4]=*(const __attribute__((address_space(3))) bf16x8*)(kp+4096); kf[5]=*(const __attribute__((address_space(3))) bf16x8*)(kp+4608);
  kf[6]=*(const __attribute__((address_space(3))) bf16x8*)(kp+6144); kf[7]=*(const __attribute__((address_space(3))) bf16x8*)(kp+6656);
}
__device__ __forceinline__ void kload2(bf16x8*kf,lds_cptr kp,int j){ kf[2*j]=*(const __attribute__((address_space(3))) bf16x8*)(kp+j*2048); kf[2*j+1]=*(const __attribute__((address_space(3))) bf16x8*)(kp+j*2048+512); }
__device__ __forceinline__ s16x4 vtr(lds_cptr p){ return __builtin_bit_cast(s16x4,__builtin_amdgcn_ds_read_tr16_b64_v4i16((__attribute__((address_space(3))) v4i16_t*)p)); }
__device__ __forceinline__ float rowmax(const f32x16&p0,const f32x16&p1){
  float a=max3f(p0[0],p0[1],p1[0]),b=max3f(p0[2],p0[3],p1[1]);a=max3f(a,p1[2],p1[3]);
  #pragma unroll
  for(int r=4;r<16;r+=4){a=max3f(a,p0[r],p0[r+1]);b=max3f(b,p0[r+2],p0[r+3]);a=max3f(a,p1[r],p1[r+1]);b=max3f(b,p1[r+2],p1[r+3]);}
  const float m=max2f(a,b);
  auto rr=__builtin_amdgcn_permlane32_swap(__float_as_uint(m),__float_as_uint(m),false,false);
  return max2f(__uint_as_float(rr[0]),__uint_as_float(rr[1]));
}
__device__ __forceinline__ void pv(f32x16*o,int vb,bf16x8 pa0,bf16x8 pa1,bf16x8 pa2,bf16x8 pa3){
  #pragma unroll
  for(int d0=0;d0<2;++d0){s16x4 lo[4],hi[4];
    #pragma unroll
    for(int ks=0;ks<4;++ks){
      asm volatile("ds_read_b64_tr_b16 %0,%1 offset:%c2":"=&v"(lo[ks]):"v"(vb),"i"(d0*4096+ks*1024):"memory");
      asm volatile("ds_read_b64_tr_b16 %0,%1 offset:%c2":"=&v"(hi[ks]):"v"(vb),"i"(d0*4096+ks*1024+512):"memory");}
    asm volatile("s_waitcnt lgkmcnt(0)":::"memory");SBAR();
    #define PK(k) (bf16x8){lo[k][0],lo[k][1],lo[k][2],lo[k][3],hi[k][0],hi[k][1],hi[k][2],hi[k][3]}
    o[d0]=__builtin_amdgcn_mfma_f32_32x32x16_bf16(pa0,PK(0),o[d0],0,0,0);
    o[d0]=__builtin_amdgcn_mfma_f32_32x32x16_bf16(pa1,PK(1),o[d0],0,0,0);
    o[d0]=__builtin_amdgcn_mfma_f32_32x32x16_bf16(pa2,PK(2),o[d0],0,0,0);
    o[d0]=__builtin_amdgcn_mfma_f32_32x32x16_bf16(pa3,PK(3),o[d0],0,0,0);
    #undef PK
  }
}

#ifndef ATTN_STORE16
#define ATTN_STORE16(p,v) (*(u32x4*)(p)=(v))
#endif
template<int THRL> __device__ __forceinline__ void attn_unit(int b,int h,int qb,const bf16*Q,const bf16*__restrict__ K,const bf16*__restrict__ V,bf16*O,char*shm,const unsigned*__restrict__ BMb,const float*KNbh,const int tid){
  const int lane=tid&63,r32=lane&31,hi=lane>>5; const int wid=__builtin_amdgcn_readfirstlane(tid>>6);
  const long rowbase=(long)b*SEQ; const int q0=qb*QB;
  const bf16*Qw=Q+(rowbase+q0+wid*QBLK)*DM+h*D;
  const bf16*Kh=K+rowbase*DM+h*D,*Vh=V+rowbase*DM+h*D;
  const unsigned lds0=(unsigned)(uintptr_t)shm;
  float*wsf=(float*)(shm+LDS_WS)+wid*64;
  const bf16*ksrc=Kh+(long)lane*DM+wid*8;
  const bf16*vsrc=Vh+(long)(16*(wid&3)+(lane>>2))*DM+(wid>>2)*32+(lane&3)*8;
  const unsigned kdst=lds0+LDS_K+wid*1024, vdst=lds0+LDS_V+wid*1024;
  #define DMA_K(t,slot) glds16(ksrc+(long)(t)*KVBLK*DM,(unsigned)__builtin_amdgcn_readfirstlane(kdst+(slot)))
  #define DMA_V(t,slot) glds16(vsrc+(long)(t)*KVBLK*DM,(unsigned)__builtin_amdgcn_readfirstlane(vdst+(slot)))
  const int vb0=(int)(lds0+LDS_V)+((lane>>4)&1)*32+(lane&3)*8+(4*hi+((lane&15)>>2))*64;
  const char*Kbase=shm+LDS_K; bf16x8 kf[8];
  const lds_cptr shm3=(lds_cptr)shm; const lds_cptr kp0=shm3+LDS_K+hi*1024+r32*16; const lds_cptr vp0=shm3+LDS_V+((lane>>4)&1)*32+(lane&3)*8+(4*hi+((lane&15)>>2))*64;
  const int NT=(q0+QB)/KVBLK;
  DMA_K(0,0);DMA_V(0,0);DMA_K(1,SLOTB);
  bf16x8 qr[4];
  #pragma unroll
  for(int d0=0;d0<4;++d0)qr[d0]=*reinterpret_cast<const bf16x8*>(&Qw[(long)r32*DM+d0*16+hi*8]);
  const unsigned*bmp=BMb+(q0+wid*QBLK+r32);
  unsigned mwE0=bmp[0],mwE1=bmp[(size_t)SEQ],mwO0=0u,mwO1=0u;
  bool seen=false;
  float qn; { float qs=0.f;
    _Pragma("unroll") for(int d0=0;d0<4;++d0) _Pragma("unroll") for(int e=0;e<8;++e){ const float x=__uint_as_float(((unsigned)(unsigned short)qr[d0][e])<<16); qs+=x*x; }
    auto rr=__builtin_amdgcn_permlane32_swap(__float_as_uint(qs),__float_as_uint(qs),false,false); qn=__builtin_sqrtf(__uint_as_float(rr[0])+__uint_as_float(rr[1]))*1.01f; }
  constexpr float FASTB=60.f;
  int zlane=0; asm volatile("":"+v"(zlane));
  const float*knp=KNbh+zlane;
  float knE=knp[0],knO=0.f;
  bool anysel_=false;
  #define SLOWT(PS) (__any(!(qn*kn##PS<=FASTB)||mhat!=0.f))
  float mhat=0.f,l_reg=0.f;f32x16 o[2];o[0]=f32x16{};o[1]=f32x16{};const f32x16 zero16=f32x16{};
  const int qrel=wid*QBLK+r32;
  #define CMASK(P0,P1,SLOW,PS) do{ const unsigned m0_=mw##PS##0>>(4*hi), m1_=mw##PS##1>>(4*hi); anysel_=(mw##PS##0|mw##PS##1)!=0u; \
    if(SLOW){ _Pragma("unroll") for(int r=0;r<16;++r){ P0[r]-=mhat; P1[r]-=mhat; } } \
    _Pragma("unroll") for(int r=0;r<16;++r){ const int bit_=(r&3)+8*(r>>2); \
      const unsigned e0_=(unsigned)__builtin_amdgcn_sbfe((int)m0_,bit_,1), e1_=(unsigned)__builtin_amdgcn_sbfe((int)m1_,bit_,1); \
      P0[r]=__uint_as_float((__float_as_uint(P0[r])&e0_)|(0xff800000u&~e0_)); P1[r]=__uint_as_float((__float_as_uint(P1[r])&e1_)|(0xff800000u&~e1_)); } \
    }while(0)
  bool resc=false;
  #define START(P0,P1,SLOW) do{ resc=false; seen=anysel_; \
    if(SLOW){ const float rm=rowmax(P0,P1); const float dl=(rm==-INFINITY)?0.f:rm; mhat=fadd_s(mhat,dl); \
      _Pragma("unroll") for(int r=0;r<16;++r){P0[r]=fsub_s(P0[r],dl);P1[r]=fsub_s(P1[r],dl);} \
      } \
    _Pragma("unroll") for(int r=0;r<16;++r)P0[r]=__builtin_amdgcn_exp2f(P0[r]); }while(0)
  #define RESC() do{ if(resc){ asm volatile("s_waitcnt lgkmcnt(0)":::"memory"); \
      _Pragma("unroll") for(int d_=0;d_<2;++d_) _Pragma("unroll") for(int r=0;r<16;++r)o[d_][r]*=wsf[crow(r,hi)]; } }while(0)
  f32x16 pA0,pA1,pB0,pB1;
  int sl_prev=0,sl_cur=0,sl_next=SLOTB;
  #define ROT() do{sl_prev=sl_cur;sl_cur=sl_next;sl_next=(sl_next==(NSLOT-1)*SLOTB)?0:sl_next+SLOTB;}while(0)
  DMA_K(2,2*SLOTB);
  WAIT_BAR(3);
  { mwO0=bmp[(size_t)2*SEQ]; mwO1=bmp[(size_t)3*SEQ]; knO=knp[1];
  const bool slow0_=SLOWT(E);
  qkt(pA0,pA1,Kbase,qr,zero16,r32,hi);asm volatile("s_nop 15\n\ts_nop 7":"+v"(pA0),"+v"(pA1));CMASK(pA0,pA1,slow0_,E);
  START(pA0,pA1,slow0_); }
  _Pragma("unroll") for(int r=0;r<16;++r)pA1[r]=__builtin_amdgcn_exp2f(pA1[r]);
  WAIT_BAR(0);
  DMA_K(3,0);DMA_V(1,SLOTB);
  ROT();
  kload8(kf,kp0+sl_cur);
  WAIT_BAR(2);
  s16x4 vlo[8],vhi[8]; u32x4 pw0,pw1,pw2,pw3;
  #define PKW(P,B) cvtpk_s(P[B],P[B+1])
  #define PAF(k) __builtin_bit_cast(bf16x8,pw##k)
  #define VFR(i) (bf16x8){vlo[i][0],vlo[i][1],vlo[i][2],vlo[i][3],vhi[i][0],vhi[i][1],vhi[i][2],vhi[i][3]}
  #define PIN(x) asm volatile("":"+v"(x))
  #define MX3(a,b,c) __builtin_fmaxf(__builtin_fmaxf((a),(b)),(c))
  #define GAPA(MF,A0,A1,A2,A3,W0,W1,PW) do{ MF; sacc+=A0; sacc+=A1; sacc+=A2; sacc+=A3; PIN(sacc); W0; W1; PIN(PW); SBAR(); }while(0)
  #define EX(v) __builtin_amdgcn_exp2f(v)
  #define GAPB(MF,X,B) do{ MF; X[B]=EX(X[B]); X[B+1]=EX(X[B+1]); X[B+2]=EX(X[B+2]); X[B+3]=EX(X[B+3]); PIN(X); SBAR(); }while(0)
  #define VRD(i) do{ vlo[i]=vtr(vp_+(((i)>>2)*4096+((i)&3)*1024)); vhi[i]=vtr(vp_+(((i)>>2)*4096+((i)&3)*1024+512)); }while(0)
  #define KRD(G,j) do{ if(G){ kload2(kf,kp0+sl_next,j); SBAR(); } }while(0)
  #define STEP(C0,C1,P0,P1,t,GK,GV,GL,PS,NS) do{ SBAR(); \
    if((t)+1<NT){ mw##NS##0=bmp[(size_t)(2*(t)+2)*SEQ]; mw##NS##1=bmp[(size_t)(2*(t)+3)*SEQ]; kn##NS=knp[(t)+1]; }     \
    const lds_cptr vp_=vp0+sl_prev; \
    VRD(0); SBAR(); float sacc=(P0[0]+P0[1]); \
    GAPA(C0=__builtin_amdgcn_mfma_f32_32x32x16_bf16(kf[0],qr[0],zero16,0,0,0), P0[2],P0[3],P0[4],P0[5],     pw0[0]=PKW(P0,0), pw0[1]=PKW(P0,2), pw0); \
    VRD(4); SBAR(); GAPA(C1=__builtin_amdgcn_mfma_f32_32x32x16_bf16(kf[1],qr[0],zero16,0,0,0), P0[6],P0[7],P0[8],P0[9],     pw0[2]=PKW(P0,4), pw0[3]=PKW(P0,6), pw0); \
    VRD(1); SBAR(); GAPA(C0=__builtin_amdgcn_mfma_f32_32x32x16_bf16(kf[2],qr[1],C0,0,0,0),   P0[10],P0[11],P0[12],P0[13], pw1[0]=PKW(P0,8), pw1[1]=PKW(P0,10), pw1); \
    VRD(5); SBAR(); GAPA(C1=__builtin_amdgcn_mfma_f32_32x32x16_bf16(kf[3],qr[1],C1,0,0,0),   P0[14],P0[15],P1[0],P1[1],   pw1[2]=PKW(P0,12),pw1[3]=PKW(P0,14), pw1); \
    VRD(2); SBAR(); GAPA(C0=__builtin_amdgcn_mfma_f32_32x32x16_bf16(kf[4],qr[2],C0,0,0,0),   P1[2],P1[3],P1[4],P1[5],     pw2[0]=PKW(P1,0), pw2[1]=PKW(P1,2), pw2); \
    VRD(6); SBAR(); GAPA(C1=__builtin_amdgcn_mfma_f32_32x32x16_bf16(kf[5],qr[2],C1,0,0,0),   P1[6],P1[7],P1[8],P1[9],     pw2[2]=PKW(P1,4), pw2[3]=PKW(P1,6), pw2); \
    VRD(3); SBAR(); GAPA(C0=__builtin_amdgcn_mfma_f32_32x32x16_bf16(kf[6],qr[3],C0,0,0,0),   P1[10],P1[11],P1[12],P1[13], pw3[0]=PKW(P1,8), pw3[1]=PKW(P1,10), pw3); \
    VRD(7); SBAR(); GAPA(C1=__builtin_amdgcn_mfma_f32_32x32x16_bf16(kf[7],qr[3],C1,0,0,0),   P1[14],P1[15],0.f,0.f,       pw3[2]=PKW(P1,12),pw3[3]=PKW(P1,14), pw3); \
    l_reg+=sacc; \
    if(GK){DMA_K((t)+3,sl_cur);} if(GV){DMA_V((t)+1,sl_next);} \
    const bool slow_=SLOWT(PS); CMASK(C0,C1,slow_,PS); resc=false; \
    if(__builtin_expect(slow_,0)){ float a=MX3(C0[0],C0[1],C1[0]),b=MX3(C0[2],C0[3],C1[1]); a=MX3(a,C1[2],C1[3]); \
      _Pragma("unroll") for(int r=4;r<16;r+=4){a=MX3(a,C0[r],C0[r+1]);b=MX3(b,C0[r+2],C0[r+3]);a=MX3(a,C1[r],C1[r+1]);b=MX3(b,C1[r+2],C1[r+3]);} \
      float rm=__builtin_fmaxf(a,b); { auto rr=__builtin_amdgcn_permlane32_swap(__float_as_uint(rm),__float_as_uint(rm),false,false); rm=__builtin_fmaxf(__uint_as_float(rr[0]),__uint_as_float(rr[1])); } \
      const bool fresh_=!seen&&rm>-INFINITY;     \
      if(__builtin_expect(__any(rm>(float)THRL||(fresh_&&rm<-(float)THRL)),0)){ const float dl=fresh_?rm:__builtin_fmaxf(rm,0.f); mhat+=dl; \
        _Pragma("unroll") for(int r=0;r<16;++r){C0[r]-=dl;C1[r]-=dl;} \
        const float f=dl>0.f?__builtin_amdgcn_exp2f(-dl):1.f; l_reg*=f; if(hi==0)wsf[r32]=f; resc=true; } } \
    seen=seen||anysel_; \
    SBAR(); \
    GAPB(o[0]=__builtin_amdgcn_mfma_f32_32x32x16_bf16(PAF(0),VFR(0),o[0],0,0,0), C0,0); \
    GAPB(o[1]=__builtin_amdgcn_mfma_f32_32x32x16_bf16(PAF(0),VFR(4),o[1],0,0,0), C0,4); \
    KRD(GL,0); GAPB(o[0]=__builtin_amdgcn_mfma_f32_32x32x16_bf16(PAF(1),VFR(1),o[0],0,0,0), C0,8); \
    KRD(GL,1); GAPB(o[1]=__builtin_amdgcn_mfma_f32_32x32x16_bf16(PAF(1),VFR(5),o[1],0,0,0), C0,12); \
    KRD(GL,2); GAPB(o[0]=__builtin_amdgcn_mfma_f32_32x32x16_bf16(PAF(2),VFR(2),o[0],0,0,0), C1,0); \
    KRD(GL,3); GAPB(o[1]=__builtin_amdgcn_mfma_f32_32x32x16_bf16(PAF(2),VFR(6),o[1],0,0,0), C1,4); \
    GAPB(o[0]=__builtin_amdgcn_mfma_f32_32x32x16_bf16(PAF(3),VFR(3),o[0],0,0,0), C1,8); \
    GAPB(o[1]=__builtin_amdgcn_mfma_f32_32x32x16_bf16(PAF(3),VFR(7),o[1],0,0,0), C1,12); \
    }while(0)
  int t=1;
  for(;t+5<NT;t+=2){
    STEP(pB0,pB1,pA0,pA1,t,true,true,true,O,E);     WAIT_BAR(2); RESC(); ROT();
    STEP(pA0,pA1,pB0,pB1,t+1,true,true,true,E,O);   WAIT_BAR(2); RESC(); ROT();
  }
  #define ENDW(tt) do{ if((tt)+3<NT){WAIT_BAR(2);} else if((tt)+2<NT){WAIT_BAR(1);} else {WAIT_BAR(0);} }while(0)
  for(;t+1<NT;t+=2){
    STEP(pB0,pB1,pA0,pA1,t,(t+3<NT),(t+1<NT),(t+1<NT),O,E);       ENDW(t);   RESC(); ROT();
    STEP(pA0,pA1,pB0,pB1,t+1,(t+4<NT),(t+2<NT),(t+2<NT),E,O);     ENDW(t+1); RESC(); ROT();
  }
  STEP(pB0,pB1,pA0,pA1,NT-1,false,false,false,O,E); RESC();
  { float sacc=pB0[0]+pB0[1]; _Pragma("unroll") for(int r=2;r<16;++r)sacc+=pB0[r]; _Pragma("unroll") for(int r=0;r<16;++r)sacc+=pB1[r]; l_reg+=sacc;
    pw0=(u32x4){PKW(pB0,0),PKW(pB0,2),PKW(pB0,4),PKW(pB0,6)};pw1=(u32x4){PKW(pB0,8),PKW(pB0,10),PKW(pB0,12),PKW(pB0,14)};pw2=(u32x4){PKW(pB1,0),PKW(pB1,2),PKW(pB1,4),PKW(pB1,6)};pw3=(u32x4){PKW(pB1,8),PKW(pB1,10),PKW(pB1,12),PKW(pB1,14)};
    SBAR(); pv(o,vb0+sl_cur,PAF(0),PAF(1),PAF(2),PAF(3)); }
  #undef PKW
  #undef PAF
  #undef VFR
  #undef PIN
  #undef MX3
  #undef GAPA
  #undef GAPB
  #undef EX
  #undef VRD
  #undef KRD
  #undef STEP
  #undef ENDW
  {auto rr=__builtin_amdgcn_permlane32_swap(__float_as_uint(l_reg),__float_as_uint(l_reg),false,false);l_reg=__uint_as_float(rr[0])+__uint_as_float(rr[1]);}
  if(hi==0)wsf[32+r32]=l_reg;asm volatile("s_waitcnt lgkmcnt(0)":::"memory");
  float rli[16];
  #pragma unroll
  for(int r=0;r<16;++r)rli[r]=__builtin_amdgcn_rcpf(wsf[32+crow(r,hi)]);
  bf16*Ow=O+(rowbase+q0+wid*QBLK)*DM+h*D;
  { bf16*stg=(bf16*)(shm+LDS_OST)+wid*2048;
    #pragma unroll
    for(int r=0;r<16;++r){const int orow=crow(r,hi);
      #pragma unroll
      for(int d0=0;d0<2;++d0)stg[orow*64+d0*32+r32]=__float2bfloat16(o[d0][r]*rli[r]);}
    asm volatile("s_waitcnt lgkmcnt(0)":::"memory");
    #pragma unroll
    for(int i=0;i<4;++i){const int row=i*8+(lane>>3),ch=lane&7; const u32x4 v=*(const u32x4*)(stg+row*64+ch*8); ATTN_STORE16(Ow+(long)row*DM+ch*8,v);} }
  asm volatile("s_waitcnt lgkmcnt(0)\n\ts_barrier":::"memory");
  #undef DMA_K
  #undef DMA_V
  #undef CMASK
  #undef SLOWT
  #undef START
  #undef RESC
  #undef ROT
}
constexpr int ATTN_LDS_BYTES=LDS_BYTES;
#undef SBAR
#undef WAIT_BAR
}
constexpr int MK_THREADS = 512;
constexpr int RING_BYTES = 131072, MISC_OFF = RING_BYTES + 320, MK_LDS_BYTES = 147456;
constexpr size_t WS_CTL = 0, CTL_ZERO_BYTES = 65536; constexpr int CW_BAR = 4096;
constexpr int PH_PREP0 = 0, PH_L0 = 1, PH_PER_LAYER = 14, NPH = PH_L0 + 2 * PH_PER_LAYER;
enum { Q_INPROJ = 0, Q_SBIDX, Q_DSA, Q_GATES, Q_MERGE, Q_MIX, Q_NORMXA, Q_XALOG, Q_XAOUT, Q_NORMFFN, Q_UP, Q_FFNMID, Q_DOWN, Q_NEXT };

#ifndef QBUILD
#define QBUILD 0xffffu
#endif
#define QON(x) ((QBUILD >> (x)) & 1u)
struct Args { const float* in[20]; float* out; unsigned char* ws; int ph_lo, ph_hi; };

__global__ void __launch_bounds__(MK_THREADS, 2) mk_fwd(Args args) {
    __shared__ __attribute__((aligned(16))) unsigned char lds_raw[MK_LDS_BYTES];
    LAS unsigned char* lds = (LAS unsigned char*)lds_raw;
    volatile LAS unsigned* MISC = (volatile LAS unsigned*)(lds + MISC_OFF);
    const int G = gridDim.x, bx = blockIdx.x;
    unsigned char* ws0 = args.ws;
    const int wave_s = __builtin_amdgcn_readfirstlane((int)threadIdx.x >> 6);
    for (int u = mk_tid(wave_s); u < (MK_LDS_BYTES - RING_BYTES) / 4; u += MK_THREADS) ((LAS unsigned*)(lds + RING_BYTES))[u] = 0u;
    __syncthreads();
    const int lo = args.ph_lo, hi = args.ph_hi;
    XcdBarrier bar; bar.bar = (unsigned*)(ws0 + WS_CTL) + CW_BAR; bar.x = 0; bar.st = nullptr;
    if (hi - lo > 1) bar = xcd_barrier_post((unsigned*)(ws0 + WS_CTL) + CW_BAR, MISC + 8, mk_tid(wave_s));
#define BPW(off) ((bf16_t*)(ws + (off)))
    const int vcu = (G % 8 == 0) ? (bx % 8) * (G / 8) + bx / 8 : bx;
    bool use_local = false;
    for (int p = lo; p < hi; ++p) {
#ifdef PROBE_REP
        const int reps = (p >= PH_L0 && ((PROBE_REP >> ((p - PH_L0) % PH_PER_LAYER)) & 1)) ? 2 : 1;
#else
        const int reps = 1;
#endif
#ifdef PROBE_REP
#pragma unroll 1
        for (int rep = 0; rep < reps; ++rep) {
        const bool dry = rep + 1 < reps;
#else
        { constexpr bool dry = false;
#endif
        int oz = 0; asm volatile("" : "+s"(oz));
        int tid = mk_tid(wave_s); asm volatile("" : "+v"(tid));
        const int wave = __builtin_amdgcn_readfirstlane(tid >> 6), lane = tid & 63;
        WaveId W; W.gw = vcu * 8 + wave; W.ngw = G * 8; W.wave = wave; W.lane = lane;
        unsigned char* ws = args.ws + oz; float* X = args.out + oz;
#define INP(k) (args.in[(k) + oz])
        if (p == PH_PREP0) {
            prep0_phase(W, (LAS float*)(lds + wave * 16384), ws, args.in + oz, (bf16_t*)X);
        } else if (p >= PH_L0) {
            const int l = (p - PH_L0) / PH_PER_LAYER, q = (p - PH_L0) % PH_PER_LAYER;
            const float* Xin = l == 0 ? INP(0) : X;
            pg8::u64* SSb = (pg8::u64*)(ws + WS_SS);
#define SSA(i) (SSb + (size_t)(i) * T)
            if (q == Q_SBIDX) {
                sb_phase(W, lds, ws, dry);
                conv_sc_phase(vcu * MK_THREADS + tid, G * MK_THREADS, BPW(WS_SCB), BPW(WS_CX), INP(4) + l * 3 * 512, dry);
                kn_phase(W, BPW(WS_KC), (float*)(ws + WS_KN));
                if (l == 0 && !dry && QON(15)) {
                    __syncthreads();
                    { pg8::Order S; S.init(1, 4, 16, G, bx); pg8::PtrG P{(const char*)(ws + WS_KVM), (const char*)(ws + WS_WQ)}; pg8::EpiPrep E{ws, 1};
                      pg8::gemm_phase<pg8::EpiPrep, pg8::PtrG, true, true>(lds, tid, 2 * D, D, 256, S, P, E); }
                    { pg8::Order S; S.init(4, 1, 16, G, (bx + 64) % G); pg8::PtrH P{(const char*)(ws + WS_KVM), (const char*)(ws + WS_WOT)}; pg8::EpiPrep E{ws, 2};
                      pg8::gemm_phase<pg8::EpiPrep, pg8::PtrH, true, true>(lds, tid, D, 2 * D, 256, S, P, E); }
                }
                __syncthreads();
                idx_phase(lds, ws, (unsigned*)(ws + WS_CTL) + 1024 + 64 * l, wave, lane);
            } else if (q == Q_DSA) {
#ifndef NO_DSA
                {
                    for (int pr = vcu; pr < NB * 8 * 16; pr += G) { const int bh = pr >> 4, sx = pr & 15, bb = bh >> 3, hh = bh & 7;
#pragma unroll 1
                        for (int k2 = 0; k2 < 2; ++k2)
                            attn_body::attn_unit<8>(bb, hh, k2 == 0 ? sx : 31 - sx, (const attn_body::bf16*)BPW(WS_QC), (const attn_body::bf16*)BPW(WS_KC), (const attn_body::bf16*)BPW(WS_VC),
                                                    (attn_body::bf16*)(dry ? BPW(WS_KA) : BPW(WS_QC)), (char*)lds_raw, (const unsigned*)(ws + WS_BM) + (size_t)bb * 256 * S,
                                                    (const float*)(ws + WS_KN) + bh * (S / 64), tid); }
                }
#endif
            } else if (q == Q_FFNMID) {
            } else if (q == Q_NEXT) {
                if (l + 1 == DEPTH && !dry) final_norm(W, BPW(WS_XN), X, INP(19), SSA(6));
            } else if (q == Q_INPROJ && QON(Q_INPROJ)) {
                pg8::Order S; S.init(T / 256, NIN / 256, 1, G, bx);
                pg8::PtrStd P{(const char*)X, (const char*)(ws + WS_WIN), 0, 0, 0, (size_t)256 * D * 2, (size_t)256 * D * 2};
                if (l > 0 && !dry) { int base = 0; convert_layer_weights(W, (LAS float*)(lds + wave * 16384), base, ws, args.in + oz, l, 4); __syncthreads(); }
                pg8::EpiInProj E{ws, SSA(3 * l)};
                pg8::gemm_phase<pg8::EpiInProj, pg8::PtrStd, true, true>(lds, tid, D, D, D, S, P, E);
                if (l == 0 && !dry && QON(14)) {
                    pg8::Order S2; S2.init(2, 8, 2, G, (bx + G - 64) % G);
                    pg8::PtrStd P2{(const char*)(ws + WS_MEMN), (const char*)(ws + WS_WKVT), 1 * MiB, 4 * MiB, 0, (size_t)256 * D * 2, (size_t)256 * D * 2};
                    pg8::EpiPrep E2{ws, 0};
                    pg8::gemm_phase<pg8::EpiPrep, pg8::PtrStd, true, true>(lds, tid, D, D, D, S2, P2, E2);
                }
            } else if (q == Q_GATES && QON(Q_GATES)) {
                pg8::Order S; S.init(T / 256, 12, 1, G, bx);
                pg8::PtrStd P{(const char*)X, (const char*)(ws + WS_WG), 0, 0, 0, (size_t)256 * D * 2, (size_t)256 * D * 2};
                pg8::EpiGates E{BPW(WS_GATES), SSA(3 * l)};
                pg8::gemm_phase<pg8::EpiGates, pg8::PtrStd, true, true>(lds, tid, D, D, D, S, P, E);
            } else if (q == Q_MERGE && QON(Q_MERGE)) {
                pg8::Order S; S.init(T / 256, 4, 3, G, bx);
                pg8::PtrStd P{(const char*)(ws + WS_QA), (const char*)(ws + WS_WBR), 16 * MiB, (size_t)D * 512 * 2, 0, (size_t)256 * 512 * 2, (size_t)256 * 512 * 2};
                pg8::EpiMergeC E{BPW(WS_XN), BPW(WS_GATES)};
                pg8::gemm_phase<pg8::EpiMergeC, pg8::PtrStd, true, true>(lds, tid, 512, 512, 512, S, P, E);
            } else if (q == Q_MIX && QON(Q_MIX)) {
                pg8::Order S; S.init(T / 256, 4, 1, G, bx);
                pg8::PtrStd P{(const char*)(ws + WS_XN), (const char*)(ws + WS_WMIX), 0, 0, 0, (size_t)256 * D * 2, (size_t)256 * D * 2};
                if (l == 0) { pg8::EpiResid<true> E{(const void*)INP(0), dry ? BPW(WS_FU) : BPW(WS_XBXA), dry ? SSA(0) : SSA(1)};
                    pg8::gemm_phase<pg8::EpiResid<true>, pg8::PtrStd, true, true>(lds, tid, D, D, D, S, P, E); }
                else { pg8::EpiResid<false> E{(const void*)X, dry ? BPW(WS_FU) : BPW(WS_XBXA), dry ? SSA(0) : SSA(4)};
                    pg8::gemm_phase<pg8::EpiResid<false>, pg8::PtrStd, true, true>(lds, tid, D, D, D, S, P, E); }

            } else if (q == Q_XALOG && QON(Q_XALOG)) {
                pg8::Order S; S.init(T / 256, 4, 1, G, bx);
                pg8::PtrStd P{(const char*)(ws + WS_XBXA), (const char*)(ws + WS_GT + (size_t)l * 4 * MiB), 0, 0, 2 * MiB, (size_t)256 * D * 2, (size_t)256 * D * 2};
                pg8::EpiSoftmax E{BPW(WS_PXA), SSA(1 + 3 * l)};
                pg8::gemm_phase<pg8::EpiSoftmax, pg8::PtrStd, false, true>(lds, tid, D, D, D, S, P, E);
            } else if (q == Q_XAOUT && QON(Q_XAOUT)) {
                pg8::Order S; S.init(T / 256, 4, 1, G, bx);
                pg8::PtrStd P{(const char*)(ws + WS_PXA), (const char*)(ws + WS_HT + (size_t)l * 4 * MiB), 0, 0, 2 * MiB, (size_t)256 * D * 2, (size_t)256 * D * 2};
                pg8::EpiResid<false> E{(const void*)BPW(WS_XBXA), dry ? BPW(WS_FU) : BPW(WS_XN), dry ? SSA(0) : SSA(2 + 3 * l)};
                pg8::gemm_phase<pg8::EpiResid<false>, pg8::PtrStd, true, true>(lds, tid, D, D, D, S, P, E);
            } else if (q == Q_UP && QON(Q_UP)) {
                pg8::Order S; S.init(T / 256, 22, 1, G, bx);
                pg8::PtrStd P{(const char*)(ws + WS_XN), (const char*)(ws + WS_WUP), 0, 0, 0, (size_t)256 * D * 2, (size_t)256 * D * 2};
                pg8::EpiUpF E{BPW(WS_FU), BPW(WS_SIDEA), BPW(WS_SIDEU), SSA(2 + 3 * l), INP(16) + l * 3 * DFF, INP(17) + l * DFF};
                pg8::gemm_phase<pg8::EpiUpF, pg8::PtrStd, true, true>(lds, tid, D, D, D, S, P, E);
            } else if (q == Q_DOWN && QON(Q_DOWN)) {
                pg8::Order S; S.init(T / 256, 4, 1, G, bx);
                if (!dry) {
#pragma unroll 1
                    for (int i = 0; ; ++i) { pg8::Unit u0; if (!S.next(i, u0)) break; ffn_fix_phase(tid, MK_THREADS, BPW(WS_SIDEA), BPW(WS_SIDEU), BPW(WS_FU), INP(16) + l * 3 * DFF, INP(17) + l * DFF, 4 * u0.pm, 4); }
                    asm volatile("s_waitcnt vmcnt(0)" ::: "memory"); __syncthreads();
                }
                pg8::PtrStd P{(const char*)(ws + WS_FU), (const char*)(ws + WS_WDOWN), 0, 0, 0, (size_t)256 * DFF * 2, (size_t)256 * DFF * 2};
                pg8::EpiResid<false> E{(const void*)BPW(WS_XN), dry ? BPW(WS_QA) : (l + 1 < DEPTH ? (bf16_t*)X : BPW(WS_XN)), dry ? SSA(0) : SSA(3 + 3 * l)};
                pg8::gemm_phase<pg8::EpiResid<false>, pg8::PtrStd, true, true>(lds, tid, DFF, DFF, DFF, S, P, E);
                if (l + 1 < DEPTH && !dry) {
                    __syncthreads(); int base = 0; convert_layer_weights(W, (LAS float*)(lds + wave * 16384), base, ws, args.in + oz, l + 1, 3); }
            }
        }
        }
        if (p + 1 < hi && !(p >= PH_L0 && ((p - PH_L0) % PH_PER_LAYER == Q_NORMXA || (p - PH_L0) % PH_PER_LAYER == Q_NORMFFN || (p - PH_L0) % PH_PER_LAYER == Q_FFNMID || ((p - PH_L0) % PH_PER_LAYER == Q_NEXT && (p - PH_L0) / PH_PER_LAYER + 1 < DEPTH)))) {
            const int qq = p >= PH_L0 ? (p - PH_L0) % PH_PER_LAYER : -1;
            const bool chain = qq == Q_GATES || qq == Q_MERGE || qq == Q_MIX || qq == Q_XALOG || qq == Q_XAOUT || (qq == Q_DOWN && (p - PH_L0) / PH_PER_LAYER + 1 == DEPTH);
            if (chain && use_local) xcd_barrier_local(bar, mk_tid(wave_s)); else xcd_barrier(bar, mk_tid(wave_s));
            if (p == lo) {
                if (mk_tid(wave_s) == 0 && (bar.x != (unsigned)(bx & 7) || bar.st[0] != (unsigned)(G >> 3) || bar.st[1] != 8u || (G & 7))) (void)xb_add(&bar.bar[XB_BADMAP], 1u);
            } else if (p == lo + 1) {
                if (mk_tid(wave_s) == 0) MISC[12] = xb_ld(&bar.bar[XB_BADMAP]);
                __syncthreads(); use_local = MISC[12] == 0u;
            }
        }
    }
}

extern "C" void kernel_launch(void* const* d_in, const int* in_sizes, int n_in, void* d_out, int out_size, void* d_ws, size_t ws_size, hipStream_t st) {
    if (n_in != 20 || ws_size < WS_NEED || out_size != T * D) { fprintf(stderr, "kernel_launch: unexpected sizes n_in %d ws %zu out %d\n", n_in, ws_size, out_size); return; }
    static int grid = 0;
    if (grid == 0) {
        int dev = 0, cus = 0, per_cu = 0;
        (void)hipGetDevice(&dev); (void)hipDeviceGetAttribute(&cus, hipDeviceAttributeMultiprocessorCount, dev);
        if (hipOccupancyMaxActiveBlocksPerMultiprocessor(&per_cu, (const void*)mk_fwd, MK_THREADS, 0) != hipSuccess || per_cu < 1) { fprintf(stderr, "kernel_launch: occupancy query says %d blocks/CU\n", per_cu); grid = -1; return; }
        (void)hipGetLastError();
        if (cus != 256) { fprintf(stderr, "kernel_launch: built for a 256-CU device, found %d\n", cus); grid = -1; return; }
        grid = cus;
    }
    if (grid < 0) return;
    (void)hipMemsetAsync((char*)d_ws + WS_CTL, 0, CTL_ZERO_BYTES, st);
    Args a{};
    for (int i = 0; i < 20; ++i) a.in[i] = (const float*)d_in[i];
    a.out = (float*)d_out; a.ws = (unsigned char*)d_ws; a.ph_lo = 0; a.ph_hi = NPH;
    hipLaunchKernelGGL(mk_fwd, dim3(grid), dim3(MK_THREADS), 0, st, a);
}
```
